# Optimizing an MI355X kernel written in HIP

```python
import math
import jax, jax.numpy as jnp
from jax import lax
import numpy as np

D_MODEL = 2048
BATCH = 4
SEQ = 4096
DEPTH = 2

CTX_LEN = 256
GRID_W = 64

ATT_HEADS = 16
ATT_KV_HEADS = 4
ATT_HEAD_DIM = 64
ATT_GROUP = ATT_HEADS // ATT_KV_HEADS
ATT_WINDOW = 128
ATT_BLOCK = 128
ROPE_BASE = 10000.0
ATT_Q_W = ATT_HEADS * ATT_HEAD_DIM
ATT_KV_W = ATT_KV_HEADS * ATT_HEAD_DIM

DN_HEADS = 4
DN_HEAD_DIM = 128
DN_W = DN_HEADS * DN_HEAD_DIM
DN_CHUNK = 64

LRU_WIDTH = 512
LRU_BLOCKS = 8
LRU_BLOCK_DIM = LRU_WIDTH // LRU_BLOCKS
LRU_C = 8.0

CONV_W = 4
CONV_LEFT = CONV_W // 2

N_EXPERTS = 32
TOP_K = 4
D_EXPERT = 1024
SWIGLU_LIMIT = 7.0
SWIGLU_ALPHA = 1.702
MOE_BLOCK = 256

MIX_W = ATT_Q_W + DN_W + LRU_WIDTH
IN_SPLITS = (ATT_Q_W, ATT_KV_W, ATT_KV_W, DN_W, DN_W, DN_W, DN_W,
             2 * DN_HEADS, 2 * DN_HEADS, LRU_WIDTH, LRU_WIDTH)
IN_W = sum(IN_SPLITS)
EPS = 1e-6
NEG_INF = -1e30

kernel_name = 'hybrid_lru_deltanet_swa_moe_prefix_dit'


def _rmsnorm(x, g):
    xf = x.astype(jnp.float32)
    y = xf * lax.rsqrt(jnp.mean(xf * xf, axis=-1, keepdims=True) + EPS)
    return (y * g.astype(jnp.float32)).astype(x.dtype)


def _modulate(x, g, shift, scale):
    return _rmsnorm(x, g) * (1.0 + scale) + shift


def _centred_dwconv(x, w):
    t = x.shape[1]
    xp = jnp.pad(x, ((0, 0), (CONV_LEFT, CONV_W - 1 - CONV_LEFT), (0, 0)))
    return sum(xp[:, j:j + t] * w[j] for j in range(CONV_W))


def _l2norm(x):
    return x * lax.rsqrt(jnp.sum(x * x, axis=-1, keepdims=True) + EPS)


def _rotate(xa, pos):
    r = xa.shape[-1]
    inv = ROPE_BASE ** (-jnp.arange(0, r, 2, dtype=jnp.float32) / r)
    ang = pos.astype(jnp.float32)[:, None] * inv
    cos = jnp.cos(ang)[None, :, None, :].astype(xa.dtype)
    sin = jnp.sin(ang)[None, :, None, :].astype(xa.dtype)
    x1, x2 = xa[..., :r // 2], xa[..., r // 2:]
    return jnp.concatenate([x1 * cos - x2 * sin, x2 * cos + x1 * sin], axis=-1)


def _axial_rope(x, row, col):
    half = x.shape[-1] // 2
    return jnp.concatenate([_rotate(x[..., :half], row), _rotate(x[..., half:], col)], axis=-1)


def _sink_probs(logits, sink):
    m = jnp.maximum(jnp.max(logits, axis=-1, keepdims=True), sink)
    p = jnp.exp(logits - m)
    return p / (jnp.sum(p, axis=-1, keepdims=True) + jnp.exp(sink - m))


def _window_attention(q, k, v, kc, vc, sink_b):
    b, s = q.shape[:2]
    nblk = s // ATT_BLOCK
    scale = ATT_HEAD_DIM ** -0.5
    qb = jnp.moveaxis(q.reshape(b, nblk, ATT_BLOCK, ATT_KV_HEADS, ATT_GROUP, ATT_HEAD_DIM), 1, 0)
    pad = ((0, 0), (ATT_BLOCK, ATT_BLOCK), (0, 0), (0, 0))
    kp = jnp.pad(k, pad)
    vp = jnp.pad(v, pad)
    span = 3 * ATT_BLOCK
    rel = (jnp.arange(span)[None, :] - ATT_BLOCK) - jnp.arange(ATT_BLOCK)[:, None]

    def block(args):
        qi, i = args
        start = i * ATT_BLOCK
        ki = lax.dynamic_slice_in_dim(kp, start, span, axis=1)
        vi = lax.dynamic_slice_in_dim(vp, start, span, axis=1)
        kabs = start - ATT_BLOCK + jnp.arange(span)
        valid = (jnp.abs(rel) <= ATT_WINDOW) & (kabs >= 0)[None, :] & (kabs < s)[None, :]
        lg_l = jnp.einsum('bqkgd,bnkd->bkgqn', qi, ki, preferred_element_type=jnp.float32) * scale
        lg_l = jnp.where(valid, lg_l, NEG_INF)
        lg_c = jnp.einsum('bqkgd,bckd->bkgqc', qi, kc, preferred_element_type=jnp.float32) * scale
        p = _sink_probs(jnp.concatenate([lg_l, lg_c], axis=-1), sink_b).astype(v.dtype)
        return (jnp.einsum('bkgqn,bnkd->bqkgd', p[..., :span], vi)
                + jnp.einsum('bkgqc,bckd->bqkgd', p[..., span:], vc))

    o = lax.map(block, (qb, jnp.arange(nblk)))
    return jnp.moveaxis(o, 0, 1).reshape(b, s, ATT_Q_W)


def _context_attention(qc, kc, vc, sink_b):
    b, l = qc.shape[:2]
    lg = jnp.einsum('bqkgd,bckd->bkgqc', qc, kc, preferred_element_type=jnp.float32) * ATT_HEAD_DIM ** -0.5
    p = _sink_probs(lg, sink_b).astype(vc.dtype)
    return jnp.einsum('bkgqc,bckd->bqkgd', p, vc).reshape(b, l, ATT_Q_W)


def _attention_mixer(lat, ctxp, sink, row, col, need_ctx):
    ql, kl, vl = lat
    qc, kc, vc = ctxp
    b, s = ql.shape[:2]
    l = qc.shape[1]
    ql = _axial_rope(ql.reshape(b, s, ATT_HEADS, ATT_HEAD_DIM), row, col)
    kl = _axial_rope(kl.reshape(b, s, ATT_KV_HEADS, ATT_HEAD_DIM), row, col)
    vl = vl.reshape(b, s, ATT_KV_HEADS, ATT_HEAD_DIM)
    kc = kc.reshape(b, l, ATT_KV_HEADS, ATT_HEAD_DIM)
    vc = vc.reshape(b, l, ATT_KV_HEADS, ATT_HEAD_DIM)
    sink_b = sink.astype(jnp.float32).reshape(ATT_KV_HEADS, ATT_GROUP)[None, :, :, None, None]
    out_l = _window_attention(ql, kl, vl, kc, vc, sink_b)
    out_c = None
    if need_ctx:
        out_c = _context_attention(qc.reshape(b, l, ATT_KV_HEADS, ATT_GROUP, ATT_HEAD_DIM), kc, vc, sink_b)
    return out_l, out_c


def _gated_delta_chunked(q, k, v, beta, g, s0):
    b, t, h, dk = q.shape
    dv = v.shape[-1]
    n = t // DN_CHUNK

    def chunks(a):
        a = a.reshape((b, n, DN_CHUNK) + a.shape[2:])
        return jnp.moveaxis(jnp.moveaxis(a, 3, 2), 1, 0)

    qc, kc, vc, bc, gc = chunks(q), chunks(k), chunks(v), chunks(beta), chunks(g)
    gcum = jnp.cumsum(gc, axis=-1)
    tri_incl = jnp.tril(jnp.ones((DN_CHUNK, DN_CHUNK), bool))
    tri_strict = jnp.tril(jnp.ones((DN_CHUNK, DN_CHUNK), bool), -1)
    decay = jnp.exp(jnp.where(tri_incl, gcum[..., :, None] - gcum[..., None, :], -jnp.inf))
    kb = kc * bc[..., None]
    a_strict = jnp.where(tri_strict, jnp.einsum('nbhrd,nbhjd->nbhrj', kb, kc) * decay, 0.0)
    rhs = jnp.concatenate([vc * bc[..., None], kb * jnp.exp(gcum)[..., None]], axis=-1)
    sol = lax.linalg.triangular_solve(a_strict, rhs, left_side=True, lower=True, unit_diagonal=True)
    u, w = sol[..., :dv], sol[..., dv:]
    qk = jnp.einsum('nbhrd,nbhjd->nbhrj', qc, kc) * decay

    def step(state, xs):
        qk_i, q_i, k_i, u_i, w_i, g_i = xs
        v_new = u_i - jnp.einsum('bhcd,bhde->bhce', w_i, state)
        o = (jnp.einsum('bhcd,bhde->bhce', q_i * jnp.exp(g_i)[..., None], state)
             + jnp.einsum('bhcj,bhje->bhce', qk_i, v_new))
        g_last = g_i[..., -1:]
        state = (state * jnp.exp(g_last)[..., None]
                 + jnp.einsum('bhcd,bhce->bhde', k_i * jnp.exp(g_last - g_i)[..., None], v_new))
        return state, o

    s_fin, o = lax.scan(step, s0, (qk, qc, kc, u, w, gcum))
    o = jnp.moveaxis(jnp.moveaxis(o, 0, 1), 2, 3).reshape(b, t, h, dv)
    return o, s_fin


def _deltanet_prep(pq, pk, pv, pb, pa, conv_w, a_log, dt_bias):
    b, t = pq.shape[:2]
    qkv = jax.nn.silu(_centred_dwconv(jnp.concatenate([pq, pk, pv], axis=-1), conv_w)).astype(jnp.float32)
    q, k, v = jnp.split(qkv, 3, axis=-1)
    q = _l2norm(q.reshape(b, t, DN_HEADS, DN_HEAD_DIM)) * DN_HEAD_DIM ** -0.5
    k = _l2norm(k.reshape(b, t, DN_HEADS, DN_HEAD_DIM))
    v = v.reshape(b, t, DN_HEADS, DN_HEAD_DIM)
    beta = jax.nn.sigmoid(pb.astype(jnp.float32)).reshape(b, t, 2, DN_HEADS)
    g = (-jnp.exp(a_log.astype(jnp.float32))
         * jax.nn.softplus(pa.astype(jnp.float32).reshape(b, t, 2, DN_HEADS) + dt_bias.astype(jnp.float32)))
    return q, k, v, beta, g


def _deltanet_gated_out(o, gate, norm_g, dtype):
    b, t = o.shape[:2]
    y = o * lax.rsqrt(jnp.mean(o * o, axis=-1, keepdims=True) + EPS) * norm_g.astype(jnp.float32)
    y = y * jax.nn.silu(gate.astype(jnp.float32).reshape(b, t, DN_HEADS, DN_HEAD_DIM))
    return y.reshape(b, t, DN_W).astype(dtype)


def _deltanet_mixer(lat, ctxp, conv_w, a_log, dt_bias, norm_g, need_ctx):
    ql, kl, vl, bl, gl = _deltanet_prep(lat[0], lat[1], lat[2], lat[4], lat[5], conv_w, a_log, dt_bias)
    qc, kc, vc, bc, gc = _deltanet_prep(ctxp[0], ctxp[1], ctxp[2], ctxp[4], ctxp[5], conv_w, a_log, dt_bias)
    s0 = jnp.zeros((ql.shape[0], DN_HEADS, DN_HEAD_DIM, DN_HEAD_DIM), jnp.float32)
    fl = lambda a: jnp.flip(a, axis=1)
    oc_f, sc_f = _gated_delta_chunked(qc, kc, vc, bc[:, :, 0], gc[:, :, 0], s0)
    ol_f, _ = _gated_delta_chunked(ql, kl, vl, bl[:, :, 0], gl[:, :, 0], sc_f)
    oc_b, sc_b = _gated_delta_chunked(fl(qc), fl(kc), fl(vc), fl(bc[:, :, 1]), fl(gc[:, :, 1]), s0)
    ol_b, _ = _gated_delta_chunked(fl(ql), fl(kl), fl(vl), fl(bl[:, :, 1]), fl(gl[:, :, 1]), sc_b)
    out_l = _deltanet_gated_out(ol_f + fl(ol_b), lat[3], norm_g, lat[0].dtype)
    out_c = _deltanet_gated_out(oc_f + fl(oc_b), ctxp[3], norm_g, ctxp[0].dtype) if need_ctx else None
    return out_l, out_c


def _rglru_coeffs(xc, w_r, b_r, w_i, b_i, lam):
    b, t = xc.shape[:2]
    xr = xc.reshape(b, t, LRU_BLOCKS, LRU_BLOCK_DIM)
    r = jax.nn.sigmoid(jnp.einsum('btni,nij->btnj', xr, w_r.astype(jnp.float32)).reshape(b, t, LRU_WIDTH) + b_r)
    i = jax.nn.sigmoid(jnp.einsum('btni,nij->btnj', xr, w_i.astype(jnp.float32)).reshape(b, t, LRU_WIDTH) + b_i)
    log_a = LRU_C * r * jax.nn.log_sigmoid(lam.astype(jnp.float32))
    return jnp.exp(log_a), jnp.sqrt(-jnp.expm1(2.0 * log_a)) * (i * xc)


def _linear_scan(a, u, h0):
    def combine(lhs, rhs):
        return lhs[0] * rhs[0], rhs[0] * lhs[1] + rhs[1]
    a_cum, u_cum = lax.associative_scan(combine, (a, u), axis=1)
    return a_cum * h0[:, None, :] + u_cum


def _ctx_then_latent(ac, uc, al, ul, h0):
    hc = _linear_scan(ac, uc, h0)
    return hc, _linear_scan(al, ul, hc[:, -1])


def _lru_mixer(lat, ctxp, conv_w, conv_b, w_r, b_r, w_i, b_i, lam, need_ctx):
    xl, yl = lat
    xc, yc = ctxp
    ul_in = (_centred_dwconv(xl, conv_w) + conv_b).astype(jnp.float32)
    uc_in = (_centred_dwconv(xc, conv_w) + conv_b).astype(jnp.float32)
    h0 = jnp.zeros((xl.shape[0], LRU_WIDTH), jnp.float32)
    fl = lambda a: jnp.flip(a, axis=1)
    acf, ucf = _rglru_coeffs(uc_in, w_r[0], b_r[0], w_i[0], b_i[0], lam[0])
    alf, ulf = _rglru_coeffs(ul_in, w_r[0], b_r[0], w_i[0], b_i[0], lam[0])
    hc_f, hl_f = _ctx_then_latent(acf, ucf, alf, ulf, h0)
    acb, ucb = _rglru_coeffs(uc_in, w_r[1], b_r[1], w_i[1], b_i[1], lam[1])
    alb, ulb = _rglru_coeffs(ul_in, w_r[1], b_r[1], w_i[1], b_i[1], lam[1])
    hc_b, hl_b = _ctx_then_latent(fl(acb), fl(ucb), fl(alb), fl(ulb), h0)
    out_l = ((hl_f + fl(hl_b)) * jax.nn.gelu(yl.astype(jnp.float32))).astype(xl.dtype)
    out_c = ((hc_f + fl(hc_b)) * jax.nn.gelu(yc.astype(jnp.float32))).astype(xc.dtype) if need_ctx else None
    return out_l, out_c


def _moe(h, w_router, b_router, w_gu, b_gu, w_down, b_down):
    n, d = h.shape
    logits = (h @ w_router + b_router).astype(jnp.float32)
    top_val, top_idx = lax.top_k(logits, TOP_K)
    gates = jax.nn.softmax(top_val, axis=-1)
    e_flat = top_idx.reshape(-1)
    tok_flat = jnp.repeat(jnp.arange(n), TOP_K)
    order = jnp.argsort(e_flat)
    e_s, tok_s, g_s = e_flat[order], tok_flat[order], gates.reshape(-1)[order]
    counts = jnp.bincount(e_flat, length=N_EXPERTS)
    padded = (counts + MOE_BLOCK - 1) // MOE_BLOCK * MOE_BLOCK
    start = jnp.cumsum(counts) - counts
    pend = jnp.cumsum(padded)
    dest = (pend - padded)[e_s] + (jnp.arange(n * TOP_K) - start[e_s])
    n_blocks = -(-(n * TOP_K + N_EXPERTS * (MOE_BLOCK - 1)) // MOE_BLOCK)
    rows = n_blocks * MOE_BLOCK
    row_tok = jnp.full((rows,), n, jnp.int32).at[dest].set(tok_s.astype(jnp.int32))
    row_gate = jnp.zeros((rows,), jnp.float32).at[dest].set(g_s)
    blk_exp = jnp.minimum(jnp.searchsorted(pend, jnp.arange(n_blocks) * MOE_BLOCK, side='right'), N_EXPERTS - 1)
    h_pad = jnp.concatenate([h, jnp.zeros((1, d), h.dtype)], axis=0)

    def run_block(acc, args):
        tok, gate, e = args
        xb = h_pad[tok]
        gu = xb @ w_gu[e] + b_gu[e]
        glu = jnp.minimum(gu[:, :D_EXPERT], SWIGLU_LIMIT)
        lin = jnp.clip(gu[:, D_EXPERT:], -SWIGLU_LIMIT, SWIGLU_LIMIT)
        act = (lin + 1.0) * glu * jax.nn.sigmoid(SWIGLU_ALPHA * glu)
        y = (act @ w_down[e] + b_down[e]) * gate[:, None].astype(h.dtype)
        return acc.at[tok].add(y.astype(acc.dtype)), None

    acc, _ = lax.scan(run_block, jnp.zeros((n + 1, d), h.dtype),
                      (row_tok.reshape(n_blocks, MOE_BLOCK), row_gate.reshape(n_blocks, MOE_BLOCK), blk_exp))
    return acc[:n]


def setup_inputs(seed: int = 0) -> dict:
    key = jax.random.key(seed)
    ks = jax.random.split(key, 32)
    f32 = jnp.float32
    L, D = DEPTH, D_MODEL

    def nrm(k, shape, s):
        return jax.random.normal(k, shape, f32) * s

    dt = jnp.exp(jax.random.uniform(ks[13], (L, 2, DN_HEADS), f32, math.log(1e-3), math.log(1e-1)))
    a_base = jax.random.uniform(ks[21], (L, 2, LRU_WIDTH), f32, 0.9, 0.999) ** (1.0 / LRU_C)
    return {
        'x': nrm(ks[0], (BATCH, SEQ, D), 1.0),
        'c': nrm(ks[1], (BATCH, D), 1.0),
        'ctx': nrm(ks[2], (BATCH, CTX_LEN, D), 1.0),
        'c_ctx': nrm(ks[3], (D,), 1.0),
        'w_mod': nrm(ks[4], (L, D, 6 * D), 0.5 * D ** -0.5),
        'b_mod': nrm(ks[5], (L, 6 * D), 0.02),
        'norm_mix_g': 1.0 + nrm(ks[6], (L, D), 0.02),
        'norm_ffn_g': 1.0 + nrm(ks[7], (L, D), 0.02),
        'w_in': nrm(ks[8], (L, D, IN_W), D ** -0.5),
        'w_out': nrm(ks[9], (L, MIX_W, D), MIX_W ** -0.5),
        'attn_sink': nrm(ks[10], (L, ATT_HEADS), 0.5),
        'dn_conv_w': nrm(ks[11], (L, CONV_W, 3 * DN_W), CONV_W ** -0.5),
        'dn_a_log': jnp.log(jax.random.uniform(ks[12], (L, 2, DN_HEADS), f32, 1.0, 16.0)),
        'dn_dt_bias': dt + jnp.log(-jnp.expm1(-dt)),
        'dn_norm_g': 1.0 + nrm(ks[14], (L, DN_HEAD_DIM), 0.02),
        'lru_conv_w': nrm(ks[15], (L, CONV_W, LRU_WIDTH), CONV_W ** -0.5),
        'lru_conv_b': nrm(ks[16], (L, LRU_WIDTH), 0.02),
        'lru_w_rgate': nrm(ks[17], (L, 2, LRU_BLOCKS, LRU_BLOCK_DIM, LRU_BLOCK_DIM), LRU_BLOCK_DIM ** -0.5),
        'lru_b_rgate': nrm(ks[18], (L, 2, LRU_WIDTH), 0.02),
        'lru_w_igate': nrm(ks[19], (L, 2, LRU_BLOCKS, LRU_BLOCK_DIM, LRU_BLOCK_DIM), LRU_BLOCK_DIM ** -0.5),
        'lru_b_igate': nrm(ks[20], (L, 2, LRU_WIDTH), 0.02),
        'lru_lambda': jnp.log(a_base) - jnp.log1p(-a_base),
        'w_router': nrm(ks[22], (L, D, N_EXPERTS), D ** -0.5),
        'b_router': nrm(ks[23], (L, N_EXPERTS), 0.01),
        'w_gu': nrm(ks[24], (L, N_EXPERTS, D, 2 * D_EXPERT), D ** -0.5),
        'b_gu': nrm(ks[25], (L, N_EXPERTS, 2 * D_EXPERT), 0.02),
        'w_down': nrm(ks[26], (L, N_EXPERTS, D_EXPERT, D), D_EXPERT ** -0.5),
        'b_down': nrm(ks[27], (L, N_EXPERTS, D), 0.02),
        'final_norm_g': 1.0 + nrm(ks[28], (D,), 0.02),
    }


def reference(x, c, ctx, c_ctx, w_mod, b_mod, norm_mix_g, norm_ffn_g, w_in, w_out, attn_sink,
              dn_conv_w, dn_a_log, dn_dt_bias, dn_norm_g, lru_conv_w, lru_conv_b,
              lru_w_rgate, lru_b_rgate, lru_w_igate, lru_b_igate, lru_lambda,
              w_router, b_router, w_gu, b_gu, w_down, b_down, final_norm_g):
    b, s, d = x.shape
    rows = s // GRID_W
    row = jnp.repeat(jnp.arange(rows), GRID_W)
    col = jnp.arange(rows * GRID_W) % GRID_W
    split_idx = np.cumsum(IN_SPLITS)[:-1].tolist()
    sc = jax.nn.silu(c)
    scc = jax.nn.silu(c_ctx)
    xl, xc = x, ctx
    for l in range(DEPTH):
        need_ctx = l < DEPTH - 1
        mod_l = jnp.split((sc @ w_mod[l] + b_mod[l])[:, None, :], 6, axis=-1)
        mod_c = jnp.split(scc @ w_mod[l] + b_mod[l], 6, axis=-1)
        hl = _modulate(xl, norm_mix_g[l], mod_l[0], mod_l[1])
        hc = _modulate(xc, norm_mix_g[l], mod_c[0], mod_c[1])
        pl = jnp.split(hl @ w_in[l], split_idx, axis=-1)
        pc = jnp.split(hc @ w_in[l], split_idx, axis=-1)
        att_l, att_c = _attention_mixer(pl[0:3], pc[0:3], attn_sink[l], row, col, need_ctx)
        dn_l, dn_c = _deltanet_mixer(pl[3:9], pc[3:9], dn_conv_w[l], dn_a_log[l], dn_dt_bias[l],
                                     dn_norm_g[l], need_ctx)
        lru_l, lru_c = _lru_mixer(pl[9:11], pc[9:11], lru_conv_w[l], lru_conv_b[l], lru_w_rgate[l],
                                  lru_b_rgate[l], lru_w_igate[l], lru_b_igate[l], lru_lambda[l], need_ctx)
        xl = xl + mod_l[2] * (jnp.concatenate([att_l, dn_l, lru_l], axis=-1) @ w_out[l])
        hl = _modulate(xl, norm_ffn_g[l], mod_l[3], mod_l[4])
        if need_ctx:
            xc = xc + mod_c[2] * (jnp.concatenate([att_c, dn_c, lru_c], axis=-1) @ w_out[l])
            hc = _modulate(xc, norm_ffn_g[l], mod_c[3], mod_c[4])
            y = _moe(jnp.concatenate([hl.reshape(-1, d), hc.reshape(-1, d)], axis=0),
                     w_router[l], b_router[l], w_gu[l], b_gu[l], w_down[l], b_down[l])
            xl = xl + mod_l[5] * y[:b * s].reshape(b, s, d)
            xc = xc + mod_c[5] * y[b * s:].reshape(xc.shape)
        else:
            y = _moe(hl.reshape(-1, d), w_router[l], b_router[l], w_gu[l], b_gu[l], w_down[l], b_down[l])
            xl = xl + mod_l[5] * y.reshape(b, s, d)
    return _rmsnorm(xl, final_norm_g)
```

```cpp
#include <hip/hip_runtime.h>
#include <cstdio>
#include <cstdint>

constexpr int DM = 2048, NB = 4, SEQ = 4096, CTXL = 256, DEPTH = 2;
constexpr int NLAT = NB * SEQ, NCTX = NB * CTXL, NTOK = NLAT + NCTX;
constexpr int NCT = NTOK / 64;
constexpr int IN_W = 4624, PW = 4864;
constexpr int PC_Q = 0, PC_K = 1024, PC_V = 1280, PC_DQ = 1536, PC_DK = 2048, PC_DV = 2560, PC_DG = 3072, PC_LX = 3584, PC_LY = 4096, PC_BETA = 4608, PC_DEC = 4616;
constexpr int NEXP = 32, TOPK = 4, DEXP = 1024;
constexpr int MOE_ROWS = 304 * 256;
constexpr float EPS = 1e-6f;
#ifndef MK_STAGE
#define MK_STAGE 99
#endif
namespace pg8 {
#define PG8_LAS __attribute__((address_space(3)))
typedef unsigned short bf16_t;
typedef short bf16x8 __attribute__((ext_vector_type(8)));
typedef float f32x4 __attribute__((ext_vector_type(4)));
typedef unsigned u32x4 __attribute__((ext_vector_type(4)));
typedef float f32x2 __attribute__((ext_vector_type(2)));
constexpr int BM = 256, BK = 64, HALF = 128, HTB = HALF * BK * 2  , STAGE_BYTES = 8 * HTB, NXCD = 8, WGM = 8;

__host__ __device__ __forceinline__ int lds_byte(int r, int c) { const int st = (r >> 4) * 2 + (c >> 5), rr = r & 15, cc = c & 31, ob = rr * 64 + cc * 2; return st * 1024 + (ob ^ (((ob >> 9) & 1) << 5)); }
__host__ __device__ __forceinline__ void stage_rc(int b, int& R, int& C) { const int st = b / 1024, sb = b % 1024, swz = sb ^ (((sb >> 9) & 1) << 5); R = (st >> 1) * 16 + swz / 64; C = (st & 1) * 32 + (swz % 64) / 2; }
__host__ __device__ __forceinline__ int perm32(int rho) { const int n = rho >> 4, i = rho & 15; return 8 * (i >> 2) + 4 * n + (i & 3); }

struct Unit { int pm, pn, e; };
struct Gemm { const bf16_t* A; const bf16_t* Bt; int M, N, K; };

struct StaticOrder {
    int nM, nN, nwg, G, c; const char* A; const char* Bt; size_t tstep;
    __device__ void init(const Gemm& g, int G_, int c_) { nM = g.M / BM; nN = g.N / BM; nwg = nM * nN; G = G_; c = c_; A = (const char*)g.A; Bt = (const char*)g.Bt; tstep = (size_t)BM * g.K * 2; }
    __device__ bool next(int i, Unit& u) const {
        const long L = (long)i * G + c; if (L >= nwg) return false;
        int wgid = (int)L; { const int q = nwg / NXCD, r = nwg % NXCD, xcd = wgid % NXCD, off = wgid / NXCD; wgid = (xcd < r ? xcd * (q + 1) : r * (q + 1) + (xcd - r) * q) + off; }
        const int nig = WGM * nN, gid = wgid / nig, fm = gid * WGM, gsz = (nM - fm) < WGM ? (nM - fm) : WGM;
        u.pm = fm + ((wgid % nig) % gsz); u.pn = (wgid % nig) / gsz; u.e = 0; return true;
    }
    __device__ __forceinline__ const char* a_ptr(const Unit& u) const { return A + (size_t)u.pm * tstep; }
    __device__ __forceinline__ const char* b_ptr(const Unit& u) const { return Bt + (size_t)u.pn * tstep; }
    __device__ __forceinline__ void a_ready(const Unit&) const {}
    __device__ __forceinline__ void done(const Unit&) const {}
};
__device__ __forceinline__ unsigned cvt_pk_bf16(float lo, float hi) { unsigned r; asm volatile("v_cvt_pk_bf16_f32 %0, %1, %2" : "=v"(r) : "v"(lo), "v"(hi)); return r; }
struct EpiBf16Plain {
    static constexpr bool PERM = true, AFTER_DRAIN = false;
    bf16_t* O; int ldc;
    __device__ __forceinline__ void operator()(const f32x4 (&acc)[2][2][4][2], const Unit& u, int wr, int wc, int fr, int fq) const {
        const int row0 = u.pm * BM + wr * 64 + fr, col0 = u.pn * BM + wc * 32 + 8 * fq;
#pragma unroll
        for (int ai = 0; ai < 2; ++ai)
#pragma unroll
            for (int m = 0; m < 4; ++m) { bf16_t* rowp = O + (size_t)(row0 + ai * HALF + m * 16) * ldc + col0;
#pragma unroll
                for (int bj = 0; bj < 2; ++bj) { const f32x4 v0 = acc[ai][bj][m][0], v1 = acc[ai][bj][m][1];
                    u32x4 w; w.x = cvt_pk_bf16(v0[0], v0[1]); w.y = cvt_pk_bf16(v0[2], v0[3]); w.z = cvt_pk_bf16(v1[0], v1[1]); w.w = cvt_pk_bf16(v1[2], v1[3]);
                    *(u32x4*)(rowp + bj * HALF) = w; } }
    }
};
struct EpiResGate {
    static constexpr bool PERM = false, AFTER_DRAIN = false;
    const float* base_lat; const float* base_ctx; float* out; const float* modg;
    __device__ __forceinline__ void operator()(const f32x4 (&acc)[2][2][4][2], const Unit& u, int wr, int wc, int fr, int fq) const {
        const int r = u.pm < 64 ? (u.pm >> 4) : 4; const int col0 = u.pn * BM + wc * 32 + 4 * fq;
        const float* g = modg + (size_t)r * 12288 + col0;
        f32x4 gv[2][2];
#pragma unroll
        for (int bj = 0; bj < 2; ++bj)
#pragma unroll
            for (int n = 0; n < 2; ++n) gv[bj][n] = *(const f32x4*)(g + bj * HALF + n * 16);
#pragma unroll
        for (int ai = 0; ai < 2; ++ai)
#pragma unroll
            for (int m = 0; m < 4; ++m) { const int row = u.pm * BM + ai * HALF + wr * 64 + m * 16 + fr;
                const float* bp = (row < 16384 ? base_lat + (size_t)row * 2048 : base_ctx + (size_t)(row - 16384) * 2048) + col0; float* op = out + (size_t)row * 2048 + col0;
#pragma unroll
                for (int bj = 0; bj < 2; ++bj)
#pragma unroll
                    for (int n = 0; n < 2; ++n) { const f32x4 b = *(const f32x4*)(bp + bj * HALF + n * 16); *(f32x4*)(op + bj * HALF + n * 16) = b + gv[bj][n] * acc[ai][bj][m][n]; }
                asm volatile("" ::: "memory"); }
    }
};
struct EpiSwiglu {
    static constexpr bool PERM = true, AFTER_DRAIN = false;
    bf16_t* O; const float* bgu;
    __device__ __forceinline__ void operator()(const f32x4 (&acc)[2][2][4][2], const Unit& u, int wr, int wc, int fr, int fq) const {
        const int row0 = u.pm * BM + wr * 64 + fr, cc0 = wc * 32 + 8 * fq;
        const float* bg = bgu + (size_t)u.e * 2048 + u.pn * 128 + cc0;
        f32x4 bglu[2], blin[2];
#pragma unroll
        for (int n = 0; n < 2; ++n) { bglu[n] = *(const f32x4*)(bg + 4 * n); blin[n] = *(const f32x4*)(bg + 1024 + 4 * n); }
#pragma unroll
        for (int ai = 0; ai < 2; ++ai)
#pragma unroll
            for (int m = 0; m < 4; ++m) { bf16_t* rowp = O + (size_t)(row0 + ai * HALF + m * 16) * 1024 + u.pn * 128 + cc0;
                float r[8];
#pragma unroll
                for (int n = 0; n < 2; ++n) { const f32x4 g = acc[ai][0][m][n] + bglu[n], l = acc[ai][1][m][n] + blin[n];
#pragma unroll
                    for (int i = 0; i < 4; ++i) { const float gg = fminf(g[i], 7.0f); const float ll = fminf(fmaxf(l[i], -7.0f), 7.0f);
                        r[4 * n + i] = (ll + 1.0f) * gg * (1.0f / (1.0f + __expf(-1.702f * gg))); } }
                u32x4 w; w.x = cvt_pk_bf16(r[0], r[1]); w.y = cvt_pk_bf16(r[2], r[3]); w.z = cvt_pk_bf16(r[4], r[5]); w.w = cvt_pk_bf16(r[6], r[7]);
                *(u32x4*)rowp = w; }
    }
};
struct EpiDown {
    static constexpr bool PERM = true, AFTER_DRAIN = false;
    bf16_t* O; const float* bdn; const float* rowg;
    __device__ __forceinline__ void operator()(const f32x4 (&acc)[2][2][4][2], const Unit& u, int wr, int wc, int fr, int fq) const {
        const int row0 = u.pm * BM + wr * 64 + fr, col0 = u.pn * BM + wc * 32 + 8 * fq;
        const float* bb = bdn + (size_t)u.e * 2048 + col0;
        f32x4 bv[2][2];
#pragma unroll
        for (int bj = 0; bj < 2; ++bj)
#pragma unroll
            for (int n = 0; n < 2; ++n) bv[bj][n] = *(const f32x4*)(bb + bj * HALF + 4 * n);
#pragma unroll
        for (int ai = 0; ai < 2; ++ai)
#pragma unroll
            for (int m = 0; m < 4; ++m) { const int row = row0 + ai * HALF + m * 16; const float gt = rowg[row]; bf16_t* rowp = O + (size_t)row * 2048 + col0;
#pragma unroll
                for (int bj = 0; bj < 2; ++bj) { const f32x4 v0 = (acc[ai][bj][m][0] + bv[bj][0]) * gt, v1 = (acc[ai][bj][m][1] + bv[bj][1]) * gt;
                    u32x4 w; w.x = cvt_pk_bf16(v0[0], v0[1]); w.y = cvt_pk_bf16(v0[2], v0[3]); w.z = cvt_pk_bf16(v1[0], v1[1]); w.w = cvt_pk_bf16(v1[2], v1[3]);
                    *(u32x4*)(rowp + bj * HALF) = w; } }
    }
};
struct MoeOrder {
    int c, nblk; const char* A; const char* Bt; size_t a_tstep, b_estep, b_tstep; const PG8_LAS int* blk_end;
    __device__ __forceinline__ bool next(int i, Unit& u) const {
        const int x = c & 7, j = c >> 3, gi = i * 8 + x, rb = 4 * gi + (j >> 3);
        if (rb >= nblk) return false;
        int e = 0;
        for (int k = 0; k < 31; ++k) e += (rb >= blk_end[k]) ? 1 : 0;
        u.pm = rb; u.pn = j & 7; u.e = __builtin_amdgcn_readfirstlane(e); return true;
    }
    __device__ __forceinline__ const char* a_ptr(const Unit& u) const { return A + (size_t)u.pm * a_tstep; }
    __device__ __forceinline__ const char* b_ptr(const Unit& u) const { return Bt + (size_t)u.e * b_estep + (size_t)u.pn * b_tstep; }
    __device__ __forceinline__ void a_ready(const Unit&) const {}
    __device__ __forceinline__ void done(const Unit&) const {}
};
template <class Epi, class Sched, bool ALIGN_EPI = false, bool SP2 = false>
__device__ __forceinline__ void gemm_phase(PG8_LAS unsigned char* lds, const Gemm g, const Sched& S, const Epi& E) {
    int tid = threadIdx.x; asm volatile("" : "+v"(tid));
    const int wid = __builtin_amdgcn_readfirstlane(tid >> 6), lane = tid & 63, wr = wid >> 2, wc = wid & 3, fr = lane & 15, fq = lane >> 4;
    const int K = g.K, nt = K / BK;
    unsigned voffA[2], voffB[2];
#pragma unroll
    for (int i = 0; i < 2; ++i) { int R, C; stage_rc(tid * 16 + i * 8192, R, C); const int Rb = Epi::PERM ? ((R & ~31) + perm32(R & 31)) : R;
        voffA[i] = (unsigned)(R * K + C) * 2u; voffB[i] = (unsigned)(Rb * K + C) * 2u; }
    const size_t kstep = (size_t)(BK * 2);
    const size_t hstep = (size_t)HALF * K * 2;
    const size_t tstep = 2 * hstep;
    const unsigned ldsw = (unsigned)wid * 1024u;
    const int aoff = lds_byte(wr * 64 + fr, fq * 8), boff = lds_byte(wc * 32 + fr, fq * 8);
#define PG8_SA(b, h) (((b) * 2 + (h)) * HTB)
#define PG8_SB(b, h) ((4 + (b) * 2 + (h)) * HTB)
#define PG8_STAGE(bufoff, gbase, voff) do { _Pragma("unroll") for (int _i = 0; _i < 2; ++_i) \
        __builtin_amdgcn_global_load_lds((const unsigned*)((const char*)(gbase) + (voff)[_i]), (PG8_LAS unsigned*)(lds + (bufoff) + ldsw + _i * 8192), 16, 0, 0); } while (0)
#define PG8_LDA(dst, b, h) do { _Pragma("unroll") for (int m = 0; m < 4; ++m) _Pragma("unroll") for (int k = 0; k < 2; ++k) dst[m][k] = *(const PG8_LAS bf16x8*)(lds + PG8_SA(b, h) + aoff + m * 2048 + k * 1024); } while (0)
#define PG8_LDB(dst, b, h) do { _Pragma("unroll") for (int n = 0; n < 2; ++n) _Pragma("unroll") for (int k = 0; k < 2; ++k) dst[n][k] = *(const PG8_LAS bf16x8*)(lds + PG8_SB(b, h) + boff + n * 2048 + k * 1024); } while (0)
#define PG8_MMA(ai, bj, At, Bt) do { __builtin_amdgcn_s_setprio(1); _Pragma("unroll") for (int m = 0; m < 4; ++m) _Pragma("unroll") for (int n = 0; n < 2; ++n) _Pragma("unroll") for (int k = 0; k < 2; ++k) \
        acc[ai][bj][m][n] = __builtin_amdgcn_mfma_f32_16x16x32_bf16(Bt[n][k], At[m][k], acc[ai][bj][m][n], 0, 0, 0); __builtin_amdgcn_s_setprio(0); } while (0)
#define PG8_WAIT_V(n) asm volatile("s_waitcnt vmcnt(" #n ")" ::: "memory")
#define PG8_WAIT_L(n) asm volatile("s_waitcnt lgkmcnt(" #n ")" ::: "memory")
#define PG8_BAR __builtin_amdgcn_s_barrier()
#define PG8_SCHED __builtin_amdgcn_sched_barrier(0)
    Unit cur, nxt; int ui = 0;
    if (!S.next(0, cur)) return;
    f32x4 acc[2][2][4][2];
#pragma unroll
    for (int a = 0; a < 2; ++a)
#pragma unroll
        for (int b = 0; b < 2; ++b)
#pragma unroll
            for (int m = 0; m < 4; ++m)
#pragma unroll
                for (int n = 0; n < 2; ++n) acc[a][b][m][n] = (f32x4){0.f, 0.f, 0.f, 0.f};
    bf16x8 At[4][2], B0[2][2], B1[2][2];
    const char* cA = S.a_ptr(cur); const char* cB = S.b_ptr(cur);
    S.a_ready(cur);
    if constexpr (SP2) {
        PG8_STAGE(PG8_SB(0, 0), cB, voffB); PG8_STAGE(PG8_SB(0, 1), cB + hstep, voffB); PG8_STAGE(PG8_SA(0, 0), cA, voffA); PG8_STAGE(PG8_SA(0, 1), cA + hstep, voffA);
        if (wr == 1) PG8_BAR;
        PG8_WAIT_V(2); PG8_BAR;
        PG8_STAGE(PG8_SB(1, 0), cB + kstep, voffB); PG8_STAGE(PG8_SA(1, 0), cA + kstep, voffA); PG8_STAGE(PG8_SB(1, 1), cB + hstep + kstep, voffB);
        PG8_WAIT_V(6); PG8_BAR;
    } else {
        PG8_STAGE(PG8_SB(0, 0), cB, voffB); PG8_STAGE(PG8_SA(0, 0), cA, voffA); PG8_STAGE(PG8_SB(0, 1), cB + hstep, voffB); PG8_STAGE(PG8_SA(0, 1), cA + hstep, voffA);
        if (wr == 1) PG8_BAR;
        PG8_WAIT_V(4); PG8_BAR;
        PG8_STAGE(PG8_SB(1, 0), cB + kstep, voffB); PG8_STAGE(PG8_SA(1, 0), cA + kstep, voffA); PG8_STAGE(PG8_SB(1, 1), cB + hstep + kstep, voffB);
        PG8_WAIT_V(6); PG8_BAR;
    }
    for (;;) {
        const bool has_next = S.next(ui + 1, nxt);
        const char* nA = has_next ? S.a_ptr(nxt) : cA; const char* nB = has_next ? S.b_ptr(nxt) : cB;
        for (int t = 0; t < nt; t += 2) {
            const bool last = (t == nt - 2);
            const char* a1 = cA + (size_t)(t + 1) * kstep;
            const char* a2 = last ? nA : cA + (size_t)(t + 2) * kstep; const char* b2 = last ? nB : cB + (size_t)(t + 2) * kstep;
            const char* a3 = a2 + kstep; const char* b3 = b2 + kstep;
            if (last && has_next) S.a_ready(nxt);
            if constexpr (SP2) {
            PG8_LDB(B0, 0, 0); PG8_LDB(B1, 0, 1); PG8_SCHED; PG8_LDA(At, 0, 0); PG8_STAGE(PG8_SA(1, 1), a1 + hstep, voffA);
            PG8_WAIT_V(8); PG8_WAIT_L(0); PG8_BAR; PG8_MMA(0, 0, At, B0); PG8_MMA(0, 1, At, B1); PG8_BAR; PG8_SCHED;
            PG8_LDA(At, 0, 1); PG8_STAGE(PG8_SB(0, 0), b2, voffB); PG8_STAGE(PG8_SB(0, 1), b2 + hstep, voffB); PG8_STAGE(PG8_SA(0, 0), a2, voffA);
            PG8_WAIT_V(8); PG8_WAIT_L(0); PG8_BAR; PG8_MMA(1, 0, At, B0); PG8_MMA(1, 1, At, B1); PG8_BAR; PG8_SCHED;
            PG8_LDB(B0, 1, 0); PG8_LDB(B1, 1, 1); PG8_SCHED; PG8_LDA(At, 1, 0); PG8_STAGE(PG8_SA(0, 1), a2 + hstep, voffA);
            PG8_WAIT_V(8); PG8_WAIT_L(0); PG8_BAR; PG8_MMA(0, 0, At, B0); PG8_MMA(0, 1, At, B1); PG8_BAR; PG8_SCHED;
            PG8_LDA(At, 1, 1); PG8_STAGE(PG8_SB(1, 0), b3, voffB); PG8_STAGE(PG8_SB(1, 1), b3 + hstep, voffB); PG8_STAGE(PG8_SA(1, 0), a3, voffA);
            PG8_WAIT_V(8); PG8_WAIT_L(0); PG8_BAR; PG8_MMA(1, 0, At, B0); PG8_MMA(1, 1, At, B1); PG8_BAR; PG8_SCHED;
            } else {
            PG8_LDB(B0, 0, 0); PG8_SCHED; PG8_LDA(At, 0, 0); PG8_STAGE(PG8_SA(1, 1), a1 + hstep, voffA);
            PG8_WAIT_L(8); PG8_BAR; PG8_WAIT_L(0); PG8_MMA(0, 0, At, B0); PG8_BAR; PG8_SCHED;
            PG8_LDB(B1, 0, 1); PG8_STAGE(PG8_SB(0, 0), b2, voffB);
            PG8_BAR; PG8_WAIT_L(0); PG8_MMA(0, 1, At, B1); PG8_BAR;
            PG8_LDA(At, 0, 1); PG8_STAGE(PG8_SA(0, 0), a2, voffA);
            PG8_BAR; PG8_WAIT_L(0); PG8_MMA(1, 0, At, B0); PG8_BAR; PG8_SCHED;
            PG8_STAGE(PG8_SB(0, 1), b2 + hstep, voffB);
            PG8_WAIT_V(6); PG8_BAR; PG8_MMA(1, 1, At, B1); PG8_BAR;
            PG8_LDB(B0, 1, 0); PG8_SCHED; PG8_LDA(At, 1, 0); PG8_STAGE(PG8_SA(0, 1), a2 + hstep, voffA);
            PG8_WAIT_L(8); PG8_BAR; PG8_WAIT_L(0); PG8_MMA(0, 0, At, B0); PG8_BAR; PG8_SCHED;
            PG8_LDB(B1, 1, 1); PG8_STAGE(PG8_SB(1, 0), b3, voffB);
            PG8_BAR; PG8_WAIT_L(0); PG8_MMA(0, 1, At, B1); PG8_BAR;
            PG8_LDA(At, 1, 1); PG8_STAGE(PG8_SA(1, 0), a3, voffA);
            PG8_BAR; PG8_WAIT_L(0); PG8_MMA(1, 0, At, B0); PG8_BAR; PG8_SCHED;
            PG8_STAGE(PG8_SB(1, 1), b3 + hstep, voffB);
            PG8_WAIT_V(6); PG8_BAR; PG8_MMA(1, 1, At, B1); PG8_BAR;
            }
        }
        if constexpr (ALIGN_EPI) { if (wr == 0) PG8_BAR; }
        if constexpr (!Epi::AFTER_DRAIN) { int fr_e = fr, fq_e = fq; asm volatile("" : "+v"(fr_e), "+v"(fq_e));
            E(acc, cur, wr, wc, fr_e, fq_e); S.done(cur); }
        if (!has_next) break;
#pragma unroll
        for (int a = 0; a < 2; ++a)
#pragma unroll
            for (int b = 0; b < 2; ++b)
#pragma unroll
                for (int m = 0; m < 4; ++m)
#pragma unroll
                    for (int n = 0; n < 2; ++n) acc[a][b][m][n] = (f32x4){0.f, 0.f, 0.f, 0.f};
        cur = nxt; cA = nA; cB = nB; ++ui;
        if constexpr (ALIGN_EPI) { if (wr == 1) PG8_BAR; }
    }
    PG8_WAIT_V(0);
    if constexpr (!ALIGN_EPI) { if (wr == 0) PG8_BAR; }
    PG8_BAR;
    if constexpr (Epi::AFTER_DRAIN) { E.fused(acc, cur, wr, wc, fr, fq, lds, wid, lane); S.done(cur); }
#undef PG8_SA
#undef PG8_SB
#undef PG8_STAGE
#undef PG8_LDA
#undef PG8_LDB
#undef PG8_MMA
#undef PG8_WAIT_V
#undef PG8_WAIT_L
#undef PG8_BAR
#undef PG8_SCHED
}
}

constexpr size_t MiB = 1u << 20;
constexpr size_t WS_CTL = 0, CTL_ZERO_BYTES = 1 * MiB;
constexpr size_t WS_MOD  = 1 * MiB;
constexpr size_t WS_WRT  = 2 * MiB;
constexpr size_t WS_MOEI = 3 * MiB;
constexpr size_t WS_LRC  = 6 * MiB;
constexpr size_t WS_DNS  = 12 * MiB;
constexpr size_t WS_WIN  = 16 * MiB;
constexpr size_t WS_WOUT = 56 * MiB;
constexpr size_t WS_WGU  = 72 * MiB;
constexpr size_t WS_WDN  = 584 * MiB;
constexpr size_t WS_X    = 840 * MiB;
constexpr size_t WS_H    = 976 * MiB;
constexpr size_t WS_P    = 1044 * MiB;
constexpr size_t WS_CC   = 1206 * MiB;
constexpr size_t WS_VT   = 1274 * MiB;
constexpr size_t WS_VTC  = WS_VT + 8 * MiB;
constexpr size_t WS_DNT  = 1284 * MiB;
constexpr size_t DNT_BYTES = 90112;
constexpr size_t WS_DNO  = 1472 * MiB;
constexpr size_t WS_LRH  = 1540 * MiB;
constexpr size_t WS_LRA  = 1608 * MiB;
constexpr size_t WS_XS   = 1676 * MiB;
constexpr size_t WS_ACT  = 1980 * MiB;
constexpr size_t WS_YS   = 2132 * MiB;
constexpr size_t WS_END  = 2436 * MiB;
constexpr int CW_TMO = 0;
constexpr int CW_BAR = 4096;
constexpr int CW_CNT = 8192;
constexpr int CW_ATQ = 12288;

constexpr int RING_OFF = 0, RING_BYTES = 131072;
constexpr int LDSCTL_OFF = RING_BYTES, MISC_OFF = LDSCTL_OFF + 320;
constexpr int LDS_X_OFF = RING_BYTES + 1024;
constexpr int LDS_BYTES = 147456;
constexpr int NWAVES = 8, NTHREADS = 512;

#define GAS __attribute__((address_space(1)))
#define LAS __attribute__((address_space(3)))
typedef unsigned short bf16;
typedef unsigned v4u __attribute__((ext_vector_type(4)));
typedef unsigned v2u __attribute__((ext_vector_type(2)));
typedef float f32x4 __attribute__((ext_vector_type(4)));
typedef float f32x16 __attribute__((ext_vector_type(16)));
typedef short bf16x8 __attribute__((ext_vector_type(8)));
typedef short bf16x4 __attribute__((ext_vector_type(4)));
typedef GAS unsigned gu32;
#define RLX_AGENT __ATOMIC_RELAXED, __HIP_MEMORY_SCOPE_AGENT
#define LDS_WAIT() asm volatile("s_waitcnt lgkmcnt(0)" ::: "memory")
#define VM_WAIT() asm volatile("s_waitcnt vmcnt(0)" ::: "memory")
__device__ __forceinline__ unsigned f2bf(float f) { unsigned u = __builtin_bit_cast(unsigned, f); return (u + 0x7fffu + ((u >> 16) & 1u)) >> 16; }
__device__ __forceinline__ unsigned pk2(float lo, float hi) { return pg8::cvt_pk_bf16(lo, hi); }
__device__ __forceinline__ float bf2f(unsigned short b) { return __builtin_bit_cast(float, (unsigned)b << 16); }
__device__ __forceinline__ float bflo(unsigned w) { return __builtin_bit_cast(float, w << 16); }
__device__ __forceinline__ float bfhi(unsigned w) { return __builtin_bit_cast(float, w & 0xffff0000u); }
__device__ __forceinline__ float wave_sum(float v) {
#pragma unroll
    for (int o = 1; o < 64; o <<= 1) v += __shfl_xor(v, o);
    return v;
}
__device__ __forceinline__ float sigmoidf_(float x) { return 1.0f / (1.0f + __expf(-x)); }
__device__ __forceinline__ float siluf_(float x) { return x / (1.0f + __expf(-x)); }
__device__ __forceinline__ float softplusf_(float x) { return x > 20.f ? x : log1pf(__expf(x)); }

#define XB_TMO      128
#define XB_XCNT(j)  (256  + 64 * (j))
#define XB_XSUB(j)  (1280 + 64 * (j))
#define XB_XGEN(j)  (2304 + 64 * (j))
#define XB_TOP      3328
#define XB_TOPGEN   3392
#define XCD_BAR_WORDS 3456
#define XB_SPIN_CAP (1u << 18)

__device__ __forceinline__ unsigned xb_ld(unsigned* p)              { return __hip_atomic_load(p, __ATOMIC_RELAXED, __HIP_MEMORY_SCOPE_AGENT); }
__device__ __forceinline__ unsigned xb_add(unsigned* p, unsigned v) { return __hip_atomic_fetch_add(p, v, __ATOMIC_RELAXED, __HIP_MEMORY_SCOPE_AGENT); }
__device__ __forceinline__ unsigned xb_xcc_id() { return (unsigned)__builtin_amdgcn_s_getreg((3 << 11) | 20) & 0xFu; }
#define XB_SPIN(cond, bar) do { unsigned _sp = 0; while (cond) { __builtin_amdgcn_s_sleep(1); \
    if ((++_sp & 255u) == 0u) { if (xb_ld(&(bar)[XB_TMO])) break; if (_sp > XB_SPIN_CAP) { atomicAdd(&(bar)[XB_TMO], 1u); break; } } } } while (0)

struct XcdBarrier {
    unsigned* bar; unsigned x;
    volatile LAS unsigned* st;
};

__device__ __forceinline__ XcdBarrier xcd_barrier_post(unsigned* bar, volatile LAS unsigned* st) {
    XcdBarrier b; b.bar = bar; b.x = xb_xcc_id(); b.st = st;
    if (threadIdx.x == 0) (void)xb_add(&bar[XB_XCNT(b.x)], 1u);
    return b;
}
__device__ __forceinline__ void xcd_barrier_complete(unsigned* bar, unsigned x, unsigned& nloc, unsigned& nx) {
    const unsigned G = gridDim.x * gridDim.y * gridDim.z;
    unsigned sum, cnt, mine, sp = 0u;
    for (;;) {
        sum = 0u; cnt = 0u; mine = 0u;
#pragma unroll
        for (unsigned j = 0; j < 16; ++j) { const unsigned c = xb_ld(&bar[XB_XCNT(j)]); sum += c; cnt += (c > 0u) ? 1u : 0u; mine = (j == x) ? c : mine; }
        if (sum == G) break;
        __builtin_amdgcn_s_sleep(1);
        if ((++sp & 255u) == 0u) { if (xb_ld(&bar[XB_TMO])) break; if (sp > XB_SPIN_CAP) { atomicAdd(&bar[XB_TMO], 1u); break; } }
    }
    nloc = mine > 0u ? mine : 1u; nx = cnt > 0u ? cnt : 1u;
}

__device__ __forceinline__ void xcd_barrier(const XcdBarrier& b) {
    asm volatile("s_waitcnt vmcnt(0)" ::: "memory");
    __syncthreads();
    if (threadIdx.x == 0) {
        unsigned* bar = b.bar;
        __builtin_amdgcn_s_waitcnt(0);
        unsigned nloc = b.st[0], nx = b.st[1];
        if (nloc == 0u) { xcd_barrier_complete(bar, b.x, nloc, nx); b.st[0] = nloc; b.st[1] = nx; }
        const unsigned old = xb_add(&bar[XB_XSUB(b.x)], 1u);
        const unsigned gen = old / nloc;
        if (old + 1u == (gen + 1u) * nloc) {
            __builtin_amdgcn_fence(__ATOMIC_RELEASE, "agent");
            asm volatile("s_waitcnt vmcnt(0)" ::: "memory");
            const unsigned og = xb_add(&bar[XB_TOP], 1u);
            const unsigned tg = og / nx;
            if (og + 1u == (tg + 1u) * nx) xb_add(&bar[XB_TOPGEN], 1u);
            else XB_SPIN(xb_ld(&bar[XB_TOPGEN]) == tg, bar);
            __builtin_amdgcn_fence(__ATOMIC_ACQUIRE, "agent");
            xb_add(&bar[XB_XGEN(b.x)], 1u);
            asm volatile("s_waitcnt vmcnt(0)" ::: "memory");
        } else {
            XB_SPIN(xb_ld(&bar[XB_XGEN(b.x)]) == gen, bar);
            __builtin_amdgcn_fence(__ATOMIC_ACQUIRE, "agent");
            asm volatile("s_waitcnt vmcnt(0)" ::: "memory");
        }
    }
    __syncthreads();
}

enum InIdx { I_X = 0, I_C, I_CTX, I_CCTX, I_WMOD, I_BMOD, I_NMG, I_NFG, I_WIN, I_WOUT, I_SINK, I_DNCW, I_DNALOG, I_DNDT, I_DNNG, I_LRCW, I_LRCB, I_LRWR, I_LRBR, I_LRWI, I_LRBI, I_LRLAM,
             I_WROUT, I_BROUT, I_WGU, I_BGU, I_WDN, I_BDN, I_FNG, N_IN };
struct Frame {
    LAS unsigned char* lds;
    volatile LAS unsigned* MISC;
    gu32* ctl;
    int tid, lane, wave, G, bid;
    const float* const __attribute__((address_space(4)))* in;
    float* out; unsigned char* ws;
};
__device__ __forceinline__ int mod_row(int m) { return m < NLAT ? (m >> 12) : 4; }
__device__ __forceinline__ bool phase_enter(Frame& F) { int t = threadIdx.x; asm volatile("" : "+v"(t)); F.tid = t; F.lane = t & 63; F.wave = __builtin_amdgcn_readfirstlane(t >> 6); return true; }

__device__ __forceinline__ void transpose_item(const float* W, int K, int N, bf16* WT, int k0, int dstrow0, int srccol0, int nvalid, LAS float* scr, int lane) {
    const int j = lane & 31;
#pragma unroll 8
    for (int i = 0; i < 32; ++i) { const int kk = 2 * i + (lane >> 5); scr[kk * 33 + j] = (j < nvalid) ? W[(size_t)(k0 + kk) * N + srccol0 + j] : 0.f; }
    LDS_WAIT(); asm volatile("" ::: "memory");
    const int c = lane & 7;
#pragma unroll
    for (int jj = 0; jj < 4; ++jj) { const int n = (lane >> 3) + 8 * jj; const LAS float* s = scr + (8 * c) * 33 + n;
        v4u o; o.x = pk2(s[0 * 33], s[1 * 33]); o.y = pk2(s[2 * 33], s[3 * 33]); o.z = pk2(s[4 * 33], s[5 * 33]); o.w = pk2(s[6 * 33], s[7 * 33]);
        *(GAS v4u*)(WT + (size_t)(dstrow0 + n) * K + k0 + 8 * c) = o; }
    LDS_WAIT(); asm volatile("" ::: "memory");
}
__device__ __forceinline__ void p0_prologue(Frame& F) {
    {
        LAS float* sc = (LAS float*)(F.lds);
        LAS float* red = (LAS float*)(F.lds + 40960);
        bool have_sc = false;
        for (int wb = F.bid; wb < 192; wb += F.G) {
            if (!have_sc) {
                for (int i = F.tid; i < 5 * 2048; i += NTHREADS) { const int r = i >> 11, k = i & 2047; const float cv = r < 4 ? F.in[I_C][r * 2048 + k] : F.in[I_CCTX][k]; sc[i] = siluf_(cv); }
                have_sc = true; __syncthreads();
            }
            const int l = wb / 96, cb = wb % 96, kp = F.tid >> 5, cg = F.tid & 31, j0 = cb * 128 + cg * 4;
            const float* wp = F.in[I_WMOD] + ((size_t)l * 2048 + kp * 128) * 12288 + j0;
            f32x4 acc[5];
#pragma unroll
            for (int r = 0; r < 5; ++r) acc[r] = (f32x4){0.f, 0.f, 0.f, 0.f};
#pragma unroll 4
            for (int k = 0; k < 128; ++k) { const f32x4 w = *(const f32x4*)(wp + (size_t)k * 12288);
#pragma unroll
                for (int r = 0; r < 5; ++r) acc[r] += sc[r * 2048 + kp * 128 + k] * w; }
#pragma unroll
            for (int r = 0; r < 5; ++r) *(LAS f32x4*)(red + (kp * 5 + r) * 128 + cg * 4) = acc[r];
            __syncthreads();
            for (int i = F.tid; i < 640; i += NTHREADS) { const int r = i >> 7, col = i & 127; float s = F.in[I_BMOD][l * 12288 + cb * 128 + col];
#pragma unroll
                for (int q = 0; q < 16; ++q) s += red[(q * 5 + r) * 128 + col];
                ((float*)(F.ws + WS_MOD))[(size_t)(l * 5 + r) * 12288 + cb * 128 + col] = s; }
            __syncthreads();
        }
        __syncthreads();
    }
    {
        LAS float* scr = (LAS float*)(F.lds + F.wave * 16384);
        const int gw = F.bid * NWAVES + F.wave, NGW = F.G * NWAVES;
        constexpr int I_IN = 32 * 152, I_OUT = 32 * 64, I_RT = 32, I_GU = 32 * 32 * 64, I_DN = 32 * 16 * 64, PER_L = I_IN + I_OUT + I_RT + I_GU + I_DN;
        for (int it0 = gw; it0 < 2 * PER_L; it0 += NGW) {
            const int l = it0 / PER_L; int r = it0 % PER_L;
            if (r < I_IN) { const int nb = r % 152, kb = r / 152, d0 = nb * 32; int s0 = d0, nv = 32;
                if (d0 >= 4640) nv = 0; else if (d0 == 4608) { s0 = 3584; nv = 16; } else if (d0 >= 3584) s0 = d0 + 16;
                transpose_item(F.in[I_WIN] + (size_t)l * 2048 * IN_W, 2048, IN_W, (bf16*)(F.ws + WS_WIN) + (size_t)l * PW * 2048, kb * 64, d0, s0, nv, scr, F.lane); continue; }
            r -= I_IN;
            if (r < I_OUT) { const int nb = r % 64, kb = r / 64;
                transpose_item(F.in[I_WOUT] + (size_t)l * 2048 * 2048, 2048, 2048, (bf16*)(F.ws + WS_WOUT) + (size_t)l * 2048 * 2048, kb * 64, nb * 32, nb * 32, 32, scr, F.lane); continue; }
            r -= I_OUT;
            if (r < I_RT) { transpose_item(F.in[I_WROUT] + (size_t)l * 2048 * 32, 2048, 32, (bf16*)(F.ws + WS_WRT) + (size_t)l * 32 * 2048, r * 64, 0, 0, 32, scr, F.lane); continue; }
            r -= I_RT;
            if (r < I_GU) { const int e = r / 2048, q = r % 2048, nb = q % 64, kb = q / 64; const int s0 = ((nb >> 2) & 1) * 1024 + (nb >> 3) * 128 + (nb & 3) * 32;
                transpose_item(F.in[I_WGU] + (size_t)(l * 32 + e) * 2048 * 2048, 2048, 2048, (bf16*)(F.ws + WS_WGU) + (size_t)(l * 32 + e) * 2048 * 2048, kb * 64, nb * 32, s0, 32, scr, F.lane); continue; }
            r -= I_GU;
            { const int e = r / 1024, q = r % 1024, nb = q % 64, kb = q / 64;
                transpose_item(F.in[I_WDN] + (size_t)(l * 32 + e) * 1024 * 2048, 1024, 2048, (bf16*)(F.ws + WS_WDN) + (size_t)(l * 32 + e) * 2048 * 1024, kb * 64, nb * 32, nb * 32, 32, scr, F.lane); }
        }
    }
}

__device__ __forceinline__ void load_row(const float* src, int lane, f32x4 (&v)[8]) {
    const f32x4* p = (const f32x4*)src + lane;
#pragma unroll
    for (int j = 0; j < 8; ++j) v[j] = p[64 * j];
}
__device__ __forceinline__ void store_row(float* dst, int lane, const f32x4 (&v)[8]) {
    f32x4* p = (f32x4*)dst + lane;
#pragma unroll
    for (int j = 0; j < 8; ++j) p[64 * j] = v[j];
}
__device__ __forceinline__ void combine_row(Frame& F, int l, int m, int lane, f32x4 (&v)[8]) {
    const int* dest = (const int*)(F.ws + WS_MOEI + 2 * 512 * 1024) + m * 4;
    const float* g5 = (const float*)(F.ws + WS_MOD) + (size_t)(l * 5 + mod_row(m)) * 12288 + 5 * 2048;
    f32x4 acc[8];
#pragma unroll
    for (int j = 0; j < 8; ++j) acc[j] = (f32x4){0.f, 0.f, 0.f, 0.f};
#pragma unroll
    for (int k = 0; k < 4; ++k) { const int d = dest[k]; const v2u* yp = (const v2u*)((const bf16*)(F.ws + WS_YS) + (size_t)d * 2048) + lane;
#pragma unroll
        for (int j = 0; j < 8; ++j) { const v2u w = yp[64 * j]; acc[j] += (f32x4){bflo(w.x), bfhi(w.x), bflo(w.y), bfhi(w.y)}; } }
#pragma unroll
    for (int j = 0; j < 8; ++j) { const f32x4 gg = *((const f32x4*)g5 + lane + 64 * j); v[j] += gg * acc[j]; }
}
__device__ __forceinline__ void modnorm_store(const f32x4 (&v)[8], const float* g, const float* shift, const float* scale, bf16* hrow, int lane) {
    float ss = 0.f;
#pragma unroll
    for (int j = 0; j < 8; ++j) ss += (v[j].x * v[j].x + v[j].y * v[j].y) + (v[j].z * v[j].z + v[j].w * v[j].w);
    const float rstd = 1.0f / sqrtf(wave_sum(ss) * (1.0f / 2048.0f) + EPS);
    v2u* hp = (v2u*)hrow + lane;
#pragma unroll
    for (int j = 0; j < 8; ++j) { const f32x4 gg = *((const f32x4*)g + lane + 64 * j), sh = *((const f32x4*)shift + lane + 64 * j), sc = *((const f32x4*)scale + lane + 64 * j);
        const f32x4 y = (v[j] * rstd) * gg * (sc + 1.0f) + sh; v2u w; w.x = pk2(y.x, y.y); w.y = pk2(y.z, y.w); hp[64 * j] = w; }
}
__device__ __forceinline__ void phase_norm1(Frame& F, int l) {
    const int gw = F.bid * NWAVES + F.wave, NGW = F.G * NWAVES;
    float* X = (float*)(F.ws + WS_X); bf16* H = (bf16*)(F.ws + WS_H);
    const float* modp = (const float*)(F.ws + WS_MOD) + (size_t)l * 5 * 12288;
    for (int m = gw; m < NTOK; m += NGW) {
        f32x4 v[8];
        if (l == 0) load_row(m < NLAT ? F.in[I_X] + (size_t)m * DM : F.in[I_CTX] + (size_t)(m - NLAT) * DM, F.lane, v);
        else { load_row(X + (size_t)m * DM, F.lane, v); if (MK_STAGE >= 9) { combine_row(F, l - 1, m, F.lane, v); store_row(X + (size_t)m * DM, F.lane, v); } }
        const float* mr = modp + (size_t)mod_row(m) * 12288;
        modnorm_store(v, F.in[I_NMG] + l * DM, mr, mr + 2048, H + (size_t)m * DM, F.lane);
    }
}
__device__ __forceinline__ void phase_final(Frame& F, bool with_combine) {
    const int gw = F.bid * NWAVES + F.wave, NGW = F.G * NWAVES;
    const float* X = (const float*)(F.ws + WS_X);
    for (int m = gw; m < NLAT; m += NGW) {
        f32x4 v[8];
        if (with_combine) { load_row(X + (size_t)m * DM, F.lane, v); combine_row(F, 1, m, F.lane, v); }
        else load_row(F.in[I_X] + (size_t)m * DM, F.lane, v);
        float ss = 0.f;
#pragma unroll
        for (int j = 0; j < 8; ++j) ss += (v[j].x * v[j].x + v[j].y * v[j].y) + (v[j].z * v[j].z + v[j].w * v[j].w);
        const float rstd = 1.0f / sqrtf(wave_sum(ss) * (1.0f / 2048.0f) + EPS);
        f32x4* op = (f32x4*)(F.out + (size_t)m * DM) + F.lane;
#pragma unroll
        for (int j = 0; j < 8; ++j) { const f32x4 gg = *((const f32x4*)F.in[I_FNG] + F.lane + 64 * j); op[64 * j] = v[j] * rstd * gg; }
    }
}

__device__ __forceinline__ void phase_inproj(Frame& F, int l) {
    pg8::Gemm g{(const bf16*)(F.ws + WS_H), (const bf16*)(F.ws + WS_WIN) + (size_t)l * PW * 2048, NTOK, PW, 2048};
    pg8::StaticOrder S; S.init(g, F.G, F.bid);
    pg8::EpiBf16Plain E{(bf16*)(F.ws + WS_P), PW};
    pg8::gemm_phase<pg8::EpiBf16Plain, pg8::StaticOrder, true, true>(F.lds + RING_OFF, g, S, E);
}
__device__ __forceinline__ void phase_outproj(Frame& F, int l) {
    float* X = (float*)(F.ws + WS_X);
    pg8::Gemm g{(const bf16*)(F.ws + WS_CC), (const bf16*)(F.ws + WS_WOUT) + (size_t)l * 2048 * 2048, l == 0 ? NTOK : NLAT, 2048, 2048};
    pg8::StaticOrder S; S.init(g, F.G, F.bid);
    pg8::EpiResGate E{l == 0 ? F.in[I_X] : X, l == 0 ? F.in[I_CTX] : X + (size_t)NLAT * DM, X, (const float*)(F.ws + WS_MOD) + (size_t)l * 5 * 12288 + 2 * 2048};
    pg8::gemm_phase<pg8::EpiResGate, pg8::StaticOrder, true, true>(F.lds + RING_OFF, g, S, E);
}
#ifndef PHASE_INPROJ
#define PHASE_INPROJ(F, l) phase_inproj(F, l)
#endif
#ifndef PHASE_OUTPROJ
#define PHASE_OUTPROJ(F, l) phase_outproj(F, l)
#endif

constexpr size_t MOEI_TOPE = WS_MOEI, MOEI_TOPG = WS_MOEI + 512 * 1024, MOEI_DEST = WS_MOEI + 2 * 512 * 1024, MOEI_ROWG = WS_MOEI + 3 * 512 * 1024;
__device__ __forceinline__ void phase_norm2(Frame& F, int l) {
    const int nrows = (l == 0) ? NTOK : NLAT;
    constexpr int TROW = 4112;
    LAS unsigned char* tile = F.lds;
    LAS float* part = (LAS float*)(F.lds + 66048);
    LAS float* lg = (LAS float*)(F.lds + 66048 + 16384);
    const float* X = (const float*)(F.ws + WS_X); bf16* H = (bf16*)(F.ws + WS_H);
    const float* modp = (const float*)(F.ws + WS_MOD) + (size_t)l * 5 * 12288;
    const bf16* wrt = (const bf16*)(F.ws + WS_WRT) + (size_t)l * 32 * 2048;
    int* tope = (int*)(F.ws + MOEI_TOPE); float* topg = (float*)(F.ws + MOEI_TOPG);
    for (int r0 = F.bid * 16; r0 < nrows; r0 += F.G * 16) {
#pragma unroll 1
        for (int rr = 0; rr < 2; ++rr) {
            const int lr = 2 * F.wave + rr, m = r0 + lr;
            f32x4 v[8]; load_row(X + (size_t)m * DM, F.lane, v);
            float ss = 0.f;
#pragma unroll
            for (int j = 0; j < 8; ++j) ss += (v[j].x * v[j].x + v[j].y * v[j].y) + (v[j].z * v[j].z + v[j].w * v[j].w);
            const float rstd = 1.0f / sqrtf(wave_sum(ss) * (1.0f / 2048.0f) + EPS);
            const float* mr = modp + (size_t)mod_row(m) * 12288; const float* g = F.in[I_NFG] + l * DM;
            v2u* hp = (v2u*)(H + (size_t)m * DM) + F.lane; LAS v2u* tp = (LAS v2u*)(tile + lr * TROW) + F.lane;
#pragma unroll
            for (int j = 0; j < 8; ++j) { const f32x4 gg = *((const f32x4*)g + F.lane + 64 * j), sh = *((const f32x4*)(mr + 3 * 2048) + F.lane + 64 * j), sc = *((const f32x4*)(mr + 4 * 2048) + F.lane + 64 * j);
                const f32x4 y = (v[j] * rstd) * gg * (sc + 1.0f) + sh; v2u w; w.x = pk2(y.x, y.y); w.y = pk2(y.z, y.w); hp[64 * j] = w; tp[64 * j] = w; }
        }
        __syncthreads();
        {
            const int row = F.lane & 15, q = F.lane >> 4;
            f32x4 acc0 = {0.f, 0.f, 0.f, 0.f}, acc1 = {0.f, 0.f, 0.f, 0.f};
#pragma unroll
            for (int ks = 0; ks < 8; ++ks) { const int k0 = 256 * F.wave + 32 * ks + 8 * q;
                const bf16x8 a = *(const LAS bf16x8*)(tile + row * TROW + k0 * 2);
                const bf16x8 b0 = *(const bf16x8*)(wrt + (size_t)row * 2048 + k0), b1 = *(const bf16x8*)(wrt + (size_t)(16 + row) * 2048 + k0);
                acc0 = __builtin_amdgcn_mfma_f32_16x16x32_bf16(a, b0, acc0, 0, 0, 0); acc1 = __builtin_amdgcn_mfma_f32_16x16x32_bf16(a, b1, acc1, 0, 0, 0); }
#pragma unroll
            for (int i = 0; i < 4; ++i) { part[(F.wave * 16 + 4 * q + i) * 32 + row] = acc0[i]; part[(F.wave * 16 + 4 * q + i) * 32 + 16 + row] = acc1[i]; }
        }
        __syncthreads();
        { const int rw = F.tid >> 5, e = F.tid & 31; float s = F.in[I_BROUT][l * 32 + e];
#pragma unroll
          for (int w = 0; w < 8; ++w) s += part[(w * 16 + rw) * 32 + e];
          lg[rw * 32 + e] = s; }
        __syncthreads();
        if (F.tid < 16) { const int m = r0 + F.tid; float val[4]; int idx[4]; unsigned taken = 0u;
#pragma unroll
            for (int k = 0; k < 4; ++k) { float best = -3.0e38f; int bi = 0;
                for (int e = 0; e < 32; ++e) { const float x = lg[F.tid * 32 + e]; if (!((taken >> e) & 1u) && x > best) { best = x; bi = e; } }
                val[k] = best; idx[k] = bi; taken |= 1u << bi; }
            float p[4], sum = 0.f;
#pragma unroll
            for (int k = 0; k < 4; ++k) { p[k] = __expf(val[k] - val[0]); sum += p[k]; }
#pragma unroll
            for (int k = 0; k < 4; ++k) { const unsigned rank = __hip_atomic_fetch_add(F.ctl + CW_CNT + 64 * l + idx[k], 1u, RLX_AGENT);
                tope[m * 4 + k] = idx[k] | (int)(rank << 8); topg[m * 4 + k] = p[k] / sum; }
        }
        __syncthreads();
    }
}
__device__ __forceinline__ void moe_tables(Frame& F, int l) {
    LAS int* blk_end = (LAS int*)(F.lds + LDS_X_OFF); LAS int* pstart = blk_end + 32;
    if (F.tid == 0) { int nb = 0;
        for (int e = 0; e < 32; ++e) { const int c = (int)__hip_atomic_load(F.ctl + CW_CNT + 64 * l + e, RLX_AGENT); pstart[e] = nb * 256; nb += (c + 255) >> 8; blk_end[e] = nb; } }
    __syncthreads();
}
__device__ __forceinline__ void phase_scatter(Frame& F, int l) {
    const int nrows = (l == 0) ? NTOK : NLAT;
    moe_tables(F, l);
    const LAS int* pstart = (const LAS int*)(F.lds + LDS_X_OFF) + 32;
    const int* tope = (const int*)(F.ws + MOEI_TOPE); const float* topg = (const float*)(F.ws + MOEI_TOPG);
    int* dest = (int*)(F.ws + MOEI_DEST); float* rowg = (float*)(F.ws + MOEI_ROWG);
    const bf16* H = (const bf16*)(F.ws + WS_H); bf16* XS = (bf16*)(F.ws + WS_XS);
    const int gw = F.bid * NWAVES + F.wave, NGW = F.G * NWAVES;
    for (int a = gw; a < nrows * 4; a += NGW) {
        const int te = tope[a], e = te & 255, rank = (int)((unsigned)te >> 8), d = pstart[e] + rank, m = a >> 2;
        if (F.lane == 0) { dest[a] = d; rowg[d] = topg[a]; }
        const v4u* src = (const v4u*)(H + (size_t)m * DM) + F.lane; v4u* dst = (v4u*)(XS + (size_t)d * DM) + F.lane;
#pragma unroll
        for (int j = 0; j < 4; ++j) dst[64 * j] = src[64 * j];
    }
}
__device__ __forceinline__ void phase_gemm1(Frame& F, int l) {
    moe_tables(F, l);
    const LAS int* blk_end = (const LAS int*)(F.lds + LDS_X_OFF);
    pg8::Gemm g{(const bf16*)(F.ws + WS_XS), (const bf16*)(F.ws + WS_WGU) + (size_t)l * 32 * 2048 * 2048, MOE_ROWS, 2048, 2048};
    pg8::MoeOrder S{F.bid, __builtin_amdgcn_readfirstlane(blk_end[31]), (const char*)g.A, (const char*)g.Bt, (size_t)256 * 2048 * 2, (size_t)2048 * 2048 * 2, (size_t)256 * 2048 * 2, blk_end};
    pg8::EpiSwiglu E{(bf16*)(F.ws + WS_ACT), F.in[I_BGU] + (size_t)l * 32 * 2048};
    pg8::gemm_phase<pg8::EpiSwiglu, pg8::MoeOrder, true, true>(F.lds + RING_OFF, g, S, E);
}
__device__ __forceinline__ void phase_gemm2(Frame& F, int l) {
    moe_tables(F, l);
    const LAS int* blk_end = (const LAS int*)(F.lds + LDS_X_OFF);
    pg8::Gemm g{(const bf16*)(F.ws + WS_ACT), (const bf16*)(F.ws + WS_WDN) + (size_t)l * 32 * 2048 * 1024, MOE_ROWS, 2048, 1024};
    pg8::MoeOrder S{F.bid, __builtin_amdgcn_readfirstlane(blk_end[31]), (const char*)g.A, (const char*)g.Bt, (size_t)256 * 1024 * 2, (size_t)2048 * 1024 * 2, (size_t)256 * 1024 * 2, blk_end};
    pg8::EpiDown E{(bf16*)(F.ws + WS_YS), F.in[I_BDN] + (size_t)l * 32 * 2048, (const float*)(F.ws + MOEI_ROWG)};
    pg8::gemm_phase<pg8::EpiDown, pg8::MoeOrder, true, true>(F.lds + RING_OFF, g, S, E);
}
#ifndef PHASE_NORM2
#define PHASE_NORM2(F, l) phase_norm2(F, l)
#endif
#ifndef PHASE_SCATTER
#define PHASE_SCATTER(F, l) phase_scatter(F, l)
#endif
#ifndef PHASE_GEMM1
#define PHASE_GEMM1(F, l) phase_gemm1(F, l)
#endif
#ifndef PHASE_GEMM2
#define PHASE_GEMM2(F, l) phase_gemm2(F, l)
#endif

constexpr size_t WS_DNQ = WS_DNT;
constexpr size_t WS_BG = WS_DNS + 1 * MiB;
constexpr size_t WS_XC = WS_XS;
__device__ __forceinline__ void seq_of(int m, int& t, int& T, int& base) { if (m < NLAT) { t = m & 4095; T = SEQ; base = m - t; } else { t = (m - NLAT) & 255; T = CTXL; base = m - t; } }
__device__ __forceinline__ float gelu_tanh(float x) { const float u = 0.7978845608028654f * (x + 0.044715f * x * x * x); return 0.5f * x * (1.0f + tanhf(u)); }

__device__ __forceinline__ void naive_prep(Frame& F, int l) {
    const bf16* P = (const bf16*)(F.ws + WS_P);
    const int gw = F.bid * NWAVES + F.wave, NGW = F.G * NWAVES;
    {
        float* DNQ = (float*)(F.ws + WS_DNQ); float* BG = (float*)(F.ws + WS_BG);
        const float* cw = F.in[I_DNCW] + (size_t)l * 4 * 1536;
        for (int it = gw; it < NTOK * 4; it += NGW) {
            const int m = it >> 2, h = it & 3; int t, T, base; seq_of(m, t, T, base);
            float val[3][2];
#pragma unroll
            for (int part = 0; part < 3; ++part)
#pragma unroll
                for (int dd = 0; dd < 2; ++dd) { const int d = F.lane + 64 * dd, cch = part * 512 + h * 128 + d, col = PC_DQ + cch; float s = 0.f;
#pragma unroll
                    for (int j = 0; j < 4; ++j) { const int tt = t + j - 2; if (tt >= 0 && tt < T) s += cw[j * 1536 + cch] * bf2f(P[(size_t)(base + tt) * PW + col]); }
                    val[part][dd] = siluf_(s); }
            const float sq = wave_sum(val[0][0] * val[0][0] + val[0][1] * val[0][1]), sk = wave_sum(val[1][0] * val[1][0] + val[1][1] * val[1][1]);
            const float fq = 0.08838834764831845f / sqrtf(sq + EPS), fk = 1.0f / sqrtf(sk + EPS);
#pragma unroll
            for (int dd = 0; dd < 2; ++dd) { const int d = F.lane + 64 * dd; float* o = DNQ + (size_t)m * 1536 + h * 128 + d;
                o[0] = val[0][dd] * fq; o[512] = val[1][dd] * fk; o[1024] = val[2][dd]; }
            if (h == 0 && F.lane < 8) { const int dir = F.lane >> 2, hh = F.lane & 3;
                const float pb = bf2f(P[(size_t)m * PW + PC_BETA + F.lane]), pa = bf2f(P[(size_t)m * PW + PC_DEC + F.lane]);
                BG[m * 16 + F.lane] = sigmoidf_(pb);
                BG[m * 16 + 8 + F.lane] = -__expf(F.in[I_DNALOG][l * 8 + dir * 4 + hh]) * softplusf_(pa + F.in[I_DNDT][l * 8 + dir * 4 + hh]); }
        }
    }
    {
        LAS float* xc = (LAS float*)F.lds;
        float* A = (float*)(F.ws + WS_LRA); float* U = (float*)(F.ws + WS_LRH);
        const float* cw = F.in[I_LRCW] + (size_t)l * 4 * 512; const float* cb = F.in[I_LRCB] + l * 512;
        for (int m0 = F.bid * 8; m0 < NTOK; m0 += F.G * 8) {
            __syncthreads();
            for (int i = F.tid; i < 8 * 512; i += NTHREADS) { const int m = m0 + (i >> 9), ch = i & 511; int t, T, base; seq_of(m, t, T, base); float s = cb[ch];
#pragma unroll
                for (int j = 0; j < 4; ++j) { const int tt = t + j - 2; if (tt >= 0 && tt < T) s += cw[j * 512 + ch] * bf2f(P[(size_t)(base + tt) * PW + PC_LX + ch]); }
                xc[i] = s; }
            __syncthreads();
            for (int i = F.tid; i < 8 * 512 * 2; i += NTHREADS) { const int ch = i & 511, dir = (i >> 9) & 1, tk = i >> 10, m = m0 + tk, blk = ch >> 6, j = ch & 63;
                const float* wr = F.in[I_LRWR] + ((size_t)((l * 2 + dir) * 8 + blk)) * 4096 + j; const float* wi = F.in[I_LRWI] + ((size_t)((l * 2 + dir) * 8 + blk)) * 4096 + j;
                float sr = F.in[I_LRBR][(l * 2 + dir) * 512 + ch], si = F.in[I_LRBI][(l * 2 + dir) * 512 + ch];
#pragma unroll 8
                for (int ii = 0; ii < 64; ++ii) { const float x = xc[tk * 512 + blk * 64 + ii]; sr += x * wr[ii * 64]; si += x * wi[ii * 64]; }
                const float r = sigmoidf_(sr), ig = sigmoidf_(si); const float lam = F.in[I_LRLAM][(l * 2 + dir) * 512 + ch];
                const float logsig = -softplusf_(-lam);
                const float log_a = 8.0f * r * logsig; const float a = __expf(log_a);
                const float u = sqrtf(-expm1f(2.0f * log_a)) * (ig * xc[tk * 512 + ch]);
                A[((size_t)dir * NTOK + m) * 512 + ch] = a; U[((size_t)dir * NTOK + m) * 512 + ch] = u; }
        }
        __syncthreads();
    }
}

__device__ __forceinline__ void naive_attn_row(Frame& F, int l, int m, int hq) {
    const bf16* P = (const bf16*)(F.ws + WS_P); bf16* CC = (bf16*)(F.ws + WS_CC);
    const int d = F.lane, kvh = hq >> 2; int t, T, base; seq_of(m, t, T, base);
    const bool lat = m < NLAT; const int b = lat ? (m >> 12) : ((m - NLAT) >> 8);
    const int dd = d & 31, jf = dd & 15; const float inv = __powf(10000.0f, -(float)jf * (1.0f / 16.0f));
    const bool second = (dd >= 16), colhalf = (d >= 32);
    float q = bf2f(P[(size_t)m * PW + PC_Q + hq * 64 + d]);
    if (lat) { const float pos = (float)(colhalf ? (t & 63) : (t >> 6)); float sn, cs; sincosf(pos * inv, &sn, &cs); const float pr = __shfl_xor(q, 16); q = second ? (q * cs + pr * sn) : (q * cs - pr * sn); }
    q *= 0.125f;
    float mx = F.in[I_SINK][l * 16 + hq], den = 1.0f, acc = 0.f;
    if (lat) { const int t0 = t - 128 < 0 ? 0 : t - 128, t1 = t + 128 > SEQ - 1 ? SEQ - 1 : t + 128;
        for (int tk = t0; tk <= t1; ++tk) { const size_t r = (size_t)(base + tk) * PW; float k = bf2f(P[r + PC_K + kvh * 64 + d]); const float v = bf2f(P[r + PC_V + kvh * 64 + d]);
            const float pos = (float)(colhalf ? (tk & 63) : (tk >> 6)); float sn, cs; sincosf(pos * inv, &sn, &cs); const float pr = __shfl_xor(k, 16); k = second ? (k * cs + pr * sn) : (k * cs - pr * sn);
            const float s = wave_sum(q * k); const float mn = fmaxf(mx, s), f = __expf(mx - mn), p = __expf(s - mn); den = den * f + p; acc = acc * f + p * v; mx = mn; } }
    for (int c = 0; c < CTXL; ++c) { const size_t r = (size_t)(NLAT + b * CTXL + c) * PW; const float k = bf2f(P[r + PC_K + kvh * 64 + d]), v = bf2f(P[r + PC_V + kvh * 64 + d]);
        const float s = wave_sum(q * k); const float mn = fmaxf(mx, s), f = __expf(mx - mn), p = __expf(s - mn); den = den * f + p; acc = acc * f + p * v; mx = mn; }
    CC[(size_t)m * DM + hq * 64 + d] = (bf16)f2bf(acc / den);
}

__device__ __forceinline__ int scan_row(int n, int b, int dir) { if (n < CTXL) { const int t = dir ? (CTXL - 1 - n) : n; return NLAT + b * CTXL + t; } const int t = dir ? (SEQ - 1 - (n - CTXL)) : (n - CTXL); return b * SEQ + t; }
__device__ __forceinline__ void naive_scan(Frame& F, int l) {
    if (F.bid < 32) {
        const int b = F.bid >> 3, h = (F.bid >> 1) & 3, dir = F.bid & 1, dvc = F.tid & 127, kq = F.tid >> 7;
        const float* DNQ = (const float*)(F.ws + WS_DNQ); const float* BG = (const float*)(F.ws + WS_BG); float* O = (float*)(F.ws + WS_DNO);
        LAS float* buf = (LAS float*)F.lds;
        LAS float* red = buf + 768;
        LAS float* red2 = red + 512;
        float S[32];
#pragma unroll
        for (int i = 0; i < 32; ++i) S[i] = 0.f;
        constexpr int NT = CTXL + SEQ;
        { const int m = scan_row(0, b, dir); if (F.tid < 384) buf[F.tid] = DNQ[(size_t)m * 1536 + (F.tid >> 7) * 512 + h * 128 + (F.tid & 127)]; }
        __syncthreads();
#pragma unroll 1
        for (int n = 0; n < NT; ++n) {
            const int m = scan_row(n, b, dir); const LAS float* cur = buf + (n & 1) * 384;
            float nextv = 0.f; if (n + 1 < NT && F.tid < 384) { const int m2 = scan_row(n + 1, b, dir); nextv = DNQ[(size_t)m2 * 1536 + (F.tid >> 7) * 512 + h * 128 + (F.tid & 127)]; }
            const float beta = BG[m * 16 + dir * 4 + h], decay = __expf(BG[m * 16 + 8 + dir * 4 + h]);
            float ks = 0.f;
#pragma unroll
            for (int i = 0; i < 32; ++i) ks += cur[128 + kq * 32 + i] * S[i];
            red[kq * 128 + dvc] = ks;
            __syncthreads();
            const float kS = (red[dvc] + red[128 + dvc]) + (red[256 + dvc] + red[384 + dvc]);
            const float upd = beta * (cur[256 + dvc] - decay * kS);
            float os = 0.f;
#pragma unroll
            for (int i = 0; i < 32; ++i) { S[i] = decay * S[i] + cur[128 + kq * 32 + i] * upd; os += cur[kq * 32 + i] * S[i]; }
            red2[kq * 128 + dvc] = os;
            if (F.tid < 384) buf[((n + 1) & 1) * 384 + F.tid] = nextv;
            __syncthreads();
            if (kq == 0) O[((size_t)dir * NTOK + m) * 512 + h * 128 + dvc] = (red2[dvc] + red2[128 + dvc]) + (red2[256 + dvc] + red2[384 + dvc]);
        }
    }
    else if (F.bid < 40) {
        const int idx = (F.bid - 32) * NTHREADS + F.tid, ch = idx & 511, dir = (idx >> 9) & 1, b = idx >> 10;
        const float* A = (const float*)(F.ws + WS_LRA); float* U = (float*)(F.ws + WS_LRH);
        float hs = 0.f;
#pragma unroll 4
        for (int n = 0; n < CTXL + SEQ; ++n) { int m; if (n < CTXL) { const int t = dir ? (CTXL - 1 - n) : n; m = NLAT + b * CTXL + t; } else { const int t = dir ? (SEQ - 1 - (n - CTXL)) : (n - CTXL); m = b * SEQ + t; }
            const size_t o = ((size_t)dir * NTOK + m) * 512 + ch; hs = A[o] * hs + U[o]; U[o] = hs; }
    }
    {
        const int nrows = (l == 0) ? NTOK : NLAT;
        for (;;) { int m = 0; if (F.lane == 0) m = (int)__hip_atomic_fetch_add(F.ctl + CW_ATQ + 64 * l, 1u, RLX_AGENT); m = __builtin_amdgcn_readfirstlane(m);
            if (m >= nrows) break;
#pragma unroll 1
            for (int hq = 0; hq < 16; ++hq) naive_attn_row(F, l, m, hq); }
    }
}

__device__ __forceinline__ void naive_fin(Frame& F, int l) {
    const int nrows = (l == 0) ? NTOK : NLAT;
    const bf16* P = (const bf16*)(F.ws + WS_P); bf16* CC = (bf16*)(F.ws + WS_CC);
    const int gw = F.bid * NWAVES + F.wave, NGW = F.G * NWAVES;
    const float* O = (const float*)(F.ws + WS_DNO); const float* HS = (const float*)(F.ws + WS_LRH);
    for (int it = gw; it < nrows * 4; it += NGW) { const int m = it >> 2, h = it & 3; float o[2];
#pragma unroll
        for (int dd = 0; dd < 2; ++dd) { const int c = h * 128 + F.lane + 64 * dd; o[dd] = O[(size_t)m * 512 + c] + O[((size_t)NTOK + m) * 512 + c]; }
        const float rstd = 1.0f / sqrtf(wave_sum(o[0] * o[0] + o[1] * o[1]) * (1.0f / 128.0f) + EPS);
#pragma unroll
        for (int dd = 0; dd < 2; ++dd) { const int d = F.lane + 64 * dd; const float gt = bf2f(P[(size_t)m * PW + PC_DG + h * 128 + d]);
            CC[(size_t)m * DM + 1024 + h * 128 + d] = (bf16)f2bf(o[dd] * rstd * F.in[I_DNNG][l * 128 + d] * siluf_(gt)); }
    }
    for (size_t i = (size_t)F.bid * NTHREADS + F.tid; i < (size_t)nrows * 512; i += (size_t)F.G * NTHREADS) { const int m = (int)(i >> 9), ch = (int)(i & 511);
        const float hsum = HS[(size_t)m * 512 + ch] + HS[((size_t)NTOK + m) * 512 + ch]; const float y = bf2f(P[(size_t)m * PW + PC_LY + ch]);
        CC[(size_t)m * DM + 1536 + ch] = (bf16)f2bf(hsum * gelu_tanh(y)); }
}
#ifndef PHASE_PREP
#define PHASE_PREP(F, l) naive_prep(F, l)
#endif
#ifndef PHASE_SCAN
#define PHASE_SCAN(F, l) naive_scan(F, l)
#endif
#ifndef PHASE_FIN
#define PHASE_FIN(F, l) naive_fin(F, l)
#endif

#ifndef PHASE_INPROJ
#define PHASE_INPROJ(F, l) do {} while (0)
#endif
#ifndef PHASE_PREP
#define PHASE_PREP(F, l) do {} while (0)
#endif
#ifndef PHASE_SCAN
#define PHASE_SCAN(F, l) do {} while (0)
#endif
#ifndef PHASE_FIN
#define PHASE_FIN(F, l) do {} while (0)
#endif
#ifndef PHASE_OUTPROJ
#define PHASE_OUTPROJ(F, l) do {} while (0)
#endif
#ifndef PHASE_NORM2
#define PHASE_NORM2(F, l) do {} while (0)
#endif
#ifndef PHASE_SCATTER
#define PHASE_SCATTER(F, l) do {} while (0)
#endif
#ifndef PHASE_GEMM1
#define PHASE_GEMM1(F, l) do {} while (0)
#endif
#ifndef PHASE_GEMM2
#define PHASE_GEMM2(F, l) do {} while (0)
#endif

#ifndef MK_SPLIT
#define MK_SPLIT 0
#endif
#ifndef MK_STAGE
#define MK_STAGE 99
#endif
constexpr int N_PHASES = 22;
struct Args { const float* in[N_IN]; float* out; unsigned char* ws; int ph_lo, ph_hi; };
static_assert(sizeof(Args) == (N_IN + 2) * 8 + 8, "Args has no padding");

__global__ void __launch_bounds__(NTHREADS, 2) fwd_kernel(Args args) {
    extern __shared__ __attribute__((aligned(16))) unsigned char lds[];
    Frame F;
    F.lds = (LAS unsigned char*)lds;
    F.MISC = (volatile LAS unsigned*)(F.lds + MISC_OFF);
    F.tid = threadIdx.x; F.lane = F.tid & 63; F.wave = __builtin_amdgcn_readfirstlane(F.tid >> 6);
    F.G = gridDim.x; F.bid = blockIdx.x;
    F.ws = args.ws; F.out = args.out; F.ctl = (gu32*)(args.ws + WS_CTL);
    F.in = (const float* const __attribute__((address_space(4)))*)__builtin_amdgcn_kernarg_segment_ptr();
    for (int u = F.tid; u < (LDS_BYTES - LDSCTL_OFF) / 4; u += NTHREADS) ((LAS unsigned*)(F.lds + LDSCTL_OFF))[u] = 0u;
    __syncthreads();
    XcdBarrier bar; bar.bar = (unsigned*)(F.ctl + CW_BAR); bar.x = 0; bar.st = nullptr;
    if (!MK_SPLIT) bar = xcd_barrier_post((unsigned*)(F.ctl + CW_BAR), F.MISC + 8);
    const int lo = args.ph_lo, hi = args.ph_hi;
#define IN(k) (lo <= (k) && (k) < hi && phase_enter(F))
#define INR(k) (lo <= (k) && (k) < hi)
#define SEAM(k) do { if (INR(k) && INR((k) + 1)) xcd_barrier(bar); } while (0)

    if (IN(0)) { p0_prologue(F); } SEAM(0);
#pragma unroll 1
    for (int l = 0; l < DEPTH; ++l) {
        const int pb = 1 + 10 * l;
        if (IN(pb + 0)) { phase_norm1(F, l); } SEAM(pb + 0);
        if (IN(pb + 1)) { PHASE_INPROJ(F, l); } SEAM(pb + 1);
        if (IN(pb + 2)) { PHASE_PREP(F, l); } SEAM(pb + 2);
        if (IN(pb + 3)) { PHASE_SCAN(F, l); } SEAM(pb + 3);
        if (IN(pb + 4)) { PHASE_FIN(F, l); } SEAM(pb + 4);
        if (IN(pb + 5)) { PHASE_OUTPROJ(F, l); } SEAM(pb + 5);
        if (IN(pb + 6)) { PHASE_NORM2(F, l); } SEAM(pb + 6);
        if (IN(pb + 7)) { PHASE_SCATTER(F, l); } SEAM(pb + 7);
        if (IN(pb + 8)) { PHASE_GEMM1(F, l); } SEAM(pb + 8);
        if (IN(pb + 9)) { PHASE_GEMM2(F, l); } SEAM(pb + 9);
    }
    if (IN(21)) { phase_final(F, MK_STAGE >= 9); }
#undef IN
#undef SEAM
}

extern "C" void kernel_launch(void* const* d_in, const int* in_sizes, int n_in, void* d_out, int out_size, void* d_ws, size_t ws_size, hipStream_t stream) {
    static int grid = 0;
    if (grid == 0) {
        if (n_in != N_IN || out_size != NLAT * DM || ws_size < WS_END) { fprintf(stderr, "kernel_launch: unexpected shapes (n_in %d, out %d, ws %zu); nothing launched\n", n_in, out_size, ws_size); grid = -1; return; }
        int dev = 0, cus = 0, per_cu = 0;
        if (hipGetDevice(&dev) != hipSuccess || hipDeviceGetAttribute(&cus, hipDeviceAttributeMultiprocessorCount, dev) != hipSuccess) { grid = -1; return; }
        if (hipFuncSetAttribute((const void*)fwd_kernel, hipFuncAttributeMaxDynamicSharedMemorySize, LDS_BYTES) != hipSuccess) { fprintf(stderr, "kernel_launch: hipFuncSetAttribute failed\n"); grid = -1; return; }
        if (hipOccupancyMaxActiveBlocksPerMultiprocessor(&per_cu, (const void*)fwd_kernel, NTHREADS, LDS_BYTES) != hipSuccess || per_cu < 1) { fprintf(stderr, "kernel_launch: occupancy query says %d\n", per_cu); }
        (void)hipGetLastError();
        grid = cus;
        if (grid != 256) { fprintf(stderr, "kernel_launch: built for 256 CUs, device has %d; nothing launched\n", cus); grid = -1; return; }
    }
    if (grid < 0) return;
    if (hipMemsetAsync((char*)d_ws + WS_CTL, 0, CTL_ZERO_BYTES, stream) != hipSuccess) return;
    Args a{};
    for (int i = 0; i < N_IN; ++i) a.in[i] = (const float*)d_in[i];
    a.out = (float*)d_out; a.ws = (unsigned char*)d_ws;
#if MK_SPLIT
    for (int p = 0; p < N_PHASES; ++p) { a.ph_lo = p; a.ph_hi = p + 1; hipLaunchKernelGGL(fwd_kernel, dim3(grid), dim3(NTHREADS), LDS_BYTES, stream, a); }
#else
    a.ph_lo = 0; a.ph_hi = N_PHASES;
    hipLaunchKernelGGL(fwd_kernel, dim3(grid), dim3(NTHREADS), LDS_BYTES, stream, a);
#endif
    const hipError_t le = hipPeekAtLastError();
    if (le != hipSuccess) fprintf(stderr, "kernel_launch: launch failed: %s\n", hipGetErrorName(le));
}
```

```cpp
#include <hip/hip_runtime.h>
#include <cstdio>
#include <cstdint>

constexpr int DM = 2048, NB = 4, SEQ = 4096, CTXL = 256, DEPTH = 2;
constexpr int NLAT = NB * SEQ, NCTX = NB * CTXL, NTOK = NLAT + NCTX;
constexpr int NCT = NTOK / 64;
constexpr int IN_W = 4624, PW = 4864;
constexpr int PC_Q = 0, PC_K = 1024, PC_V = 1280, PC_DQ = 1536, PC_DK = 2048, PC_DV = 2560, PC_DG = 3072, PC_LX = 3584, PC_LY = 4096, PC_BETA = 4608, PC_DEC = 4616;
constexpr int NEXP = 32, TOPK = 4, DEXP = 1024;
constexpr int MOE_ROWS = 304 * 256;
constexpr float EPS = 1e-6f;
#ifndef MK_STAGE
#define MK_STAGE 99
#endif
namespace pg8 {
#define PG8_LAS __attribute__((address_space(3)))
typedef unsigned short bf16_t;
typedef short bf16x8 __attribute__((ext_vector_type(8)));
typedef float f32x4 __attribute__((ext_vector_type(4)));
typedef unsigned u32x4 __attribute__((ext_vector_type(4)));
typedef float f32x2 __attribute__((ext_vector_type(2)));
constexpr int BM = 256, BK = 64, HALF = 128, HTB = HALF * BK * 2  , STAGE_BYTES = 8 * HTB, NXCD = 8, WGM = 8;

__host__ __device__ __forceinline__ int lds_byte(int r, int c) { const int st = (r >> 4) * 2 + (c >> 5), rr = r & 15, cc = c & 31, ob = rr * 64 + cc * 2; return st * 1024 + (ob ^ (((ob >> 9) & 1) << 5)); }
__host__ __device__ __forceinline__ void stage_rc(int b, int& R, int& C) { const int st = b / 1024, sb = b % 1024, swz = sb ^ (((sb >> 9) & 1) << 5); R = (st >> 1) * 16 + swz / 64; C = (st & 1) * 32 + (swz % 64) / 2; }
__host__ __device__ __forceinline__ int perm32(int rho) { const int n = rho >> 4, i = rho & 15; return 8 * (i >> 2) + 4 * n + (i & 3); }

struct Unit { int pm, pn, e; };
struct Gemm { const bf16_t* A; const bf16_t* Bt; int M, N, K; };

struct StaticOrder {
    int nM, nN, nwg, G, c; const char* A; const char* Bt; size_t tstep;
    __device__ void init(const Gemm& g, int G_, int c_) { nM = g.M / BM; nN = g.N / BM; nwg = nM * nN; G = G_; c = c_; A = (const char*)g.A; Bt = (const char*)g.Bt; tstep = (size_t)BM * g.K * 2; }
    __device__ bool next(int i, Unit& u) const {
        const long L = (long)i * G + c; if (L >= nwg) return false;
        int wgid = (int)L; { const int q = nwg / NXCD, r = nwg % NXCD, xcd = wgid % NXCD, off = wgid / NXCD; wgid = (xcd < r ? xcd * (q + 1) : r * (q + 1) + (xcd - r) * q) + off; }
        const int nig = WGM * nN, gid = wgid / nig, fm = gid * WGM, gsz = (nM - fm) < WGM ? (nM - fm) : WGM;
        u.pm = fm + ((wgid % nig) % gsz); u.pn = (wgid % nig) / gsz; u.e = 0; return true;
    }
    __device__ __forceinline__ const char* a_ptr(const Unit& u) const { return A + (size_t)u.pm * tstep; }
    __device__ __forceinline__ const char* b_ptr(const Unit& u) const { return Bt + (size_t)u.pn * tstep; }
    __device__ __forceinline__ void a_ready(const Unit&) const {}
    __device__ __forceinline__ void done(const Unit&) const {}
};
__device__ __forceinline__ unsigned cvt_pk_bf16(float lo, float hi) { unsigned r; asm volatile("v_cvt_pk_bf16_f32 %0, %1, %2" : "=v"(r) : "v"(lo), "v"(hi)); return r; }
struct EpiBf16Plain {
    static constexpr bool PERM = true, AFTER_DRAIN = false;
    bf16_t* O; int ldc;
    __device__ __forceinline__ void operator()(const f32x4 (&acc)[2][2][4][2], const Unit& u, int wr, int wc, int fr, int fq) const {
        const int row0 = u.pm * BM + wr * 64 + fr, col0 = u.pn * BM + wc * 32 + 8 * fq;
#pragma unroll
        for (int ai = 0; ai < 2; ++ai)
#pragma unroll
            for (int m = 0; m < 4; ++m) { bf16_t* rowp = O + (size_t)(row0 + ai * HALF + m * 16) * ldc + col0;
#pragma unroll
                for (int bj = 0; bj < 2; ++bj) { const f32x4 v0 = acc[ai][bj][m][0], v1 = acc[ai][bj][m][1];
                    u32x4 w; w.x = cvt_pk_bf16(v0[0], v0[1]); w.y = cvt_pk_bf16(v0[2], v0[3]); w.z = cvt_pk_bf16(v1[0], v1[1]); w.w = cvt_pk_bf16(v1[2], v1[3]);
                    *(u32x4*)(rowp + bj * HALF) = w; } }
    }
};
struct EpiResGate {
    static constexpr bool PERM = false, AFTER_DRAIN = false;
    const float* base_lat; const float* base_ctx; float* out; const float* modg;
    __device__ __forceinline__ void operator()(const f32x4 (&acc)[2][2][4][2], const Unit& u, int wr, int wc, int fr, int fq) const {
        const int r = u.pm < 64 ? (u.pm >> 4) : 4; const int col0 = u.pn * BM + wc * 32 + 4 * fq;
        const float* g = modg + (size_t)r * 12288 + col0;
        f32x4 gv[2][2];
#pragma unroll
        for (int bj = 0; bj < 2; ++bj)
#pragma unroll
            for (int n = 0; n < 2; ++n) gv[bj][n] = *(const f32x4*)(g + bj * HALF + n * 16);
#pragma unroll
        for (int ai = 0; ai < 2; ++ai)
#pragma unroll
            for (int m = 0; m < 4; ++m) { const int row = u.pm * BM + ai * HALF + wr * 64 + m * 16 + fr;
                const float* bp = (row < 16384 ? base_lat + (size_t)row * 2048 : base_ctx + (size_t)(row - 16384) * 2048) + col0; float* op = out + (size_t)row * 2048 + col0;
#pragma unroll
                for (int bj = 0; bj < 2; ++bj)
#pragma unroll
                    for (int n = 0; n < 2; ++n) { const f32x4 b = *(const f32x4*)(bp + bj * HALF + n * 16); *(f32x4*)(op + bj * HALF + n * 16) = b + gv[bj][n] * acc[ai][bj][m][n]; }
                asm volatile("" ::: "memory"); }
    }
};
struct EpiSwiglu {
    static constexpr bool PERM = true, AFTER_DRAIN = false;
    bf16_t* O; const float* bgu;
    __device__ __forceinline__ void operator()(const f32x4 (&acc)[2][2][4][2], const Unit& u, int wr, int wc, int fr, int fq) const {
        const int row0 = u.pm * BM + wr * 64 + fr, cc0 = wc * 32 + 8 * fq;
        const float* bg = bgu + (size_t)u.e * 2048 + u.pn * 128 + cc0;
        f32x4 bglu[2], blin[2];
#pragma unroll
        for (int n = 0; n < 2; ++n) { bglu[n] = *(const f32x4*)(bg + 4 * n); blin[n] = *(const f32x4*)(bg + 1024 + 4 * n); }
#pragma unroll
        for (int ai = 0; ai < 2; ++ai)
#pragma unroll
            for (int m = 0; m < 4; ++m) { bf16_t* rowp = O + (size_t)(row0 + ai * HALF + m * 16) * 1024 + u.pn * 128 + cc0;
                float r[8];
#pragma unroll
                for (int n = 0; n < 2; ++n) { const f32x4 g = acc[ai][0][m][n] + bglu[n], l = acc[ai][1][m][n] + blin[n];
#pragma unroll
                    for (int i = 0; i < 4; ++i) { const float gg = fminf(g[i], 7.0f); const float ll = fminf(fmaxf(l[i], -7.0f), 7.0f);
                        r[4 * n + i] = (ll + 1.0f) * gg * (1.0f / (1.0f + __expf(-1.702f * gg))); } }
                u32x4 w; w.x = cvt_pk_bf16(r[0], r[1]); w.y = cvt_pk_bf16(r[2], r[3]); w.z = cvt_pk_bf16(r[4], r[5]); w.w = cvt_pk_bf16(r[6], r[7]);
                *(u32x4*)rowp = w; }
    }
};
struct EpiDown {
    static constexpr bool PERM = true, AFTER_DRAIN = false;
    bf16_t* O; const float* bdn; const float* rowg;
    __device__ __forceinline__ void operator()(const f32x4 (&acc)[2][2][4][2], const Unit& u, int wr, int wc, int fr, int fq) const {
        const int row0 = u.pm * BM + wr * 64 + fr, col0 = u.pn * BM + wc * 32 + 8 * fq;
        const float* bb = bdn + (size_t)u.e * 2048 + col0;
        f32x4 bv[2][2];
#pragma unroll
        for (int bj = 0; bj < 2; ++bj)
#pragma unroll
            for (int n = 0; n < 2; ++n) bv[bj][n] = *(const f32x4*)(bb + bj * HALF + 4 * n);
#pragma unroll
        for (int ai = 0; ai < 2; ++ai)
#pragma unroll
            for (int m = 0; m < 4; ++m) { const int row = row0 + ai * HALF + m * 16; const float gt = rowg[row]; bf16_t* rowp = O + (size_t)row * 2048 + col0;
#pragma unroll
                for (int bj = 0; bj < 2; ++bj) { const f32x4 v0 = (acc[ai][bj][m][0] + bv[bj][0]) * gt, v1 = (acc[ai][bj][m][1] + bv[bj][1]) * gt;
                    u32x4 w; w.x = cvt_pk_bf16(v0[0], v0[1]); w.y = cvt_pk_bf16(v0[2], v0[3]); w.z = cvt_pk_bf16(v1[0], v1[1]); w.w = cvt_pk_bf16(v1[2], v1[3]);
                    *(u32x4*)(rowp + bj * HALF) = w; } }
    }
};
struct MoeOrder {
    int c, nblk; const char* A; const char* Bt; size_t a_tstep, b_estep, b_tstep; const PG8_LAS int* blk_end;
    __device__ __forceinline__ bool next(int i, Unit& u) const {
        const int x = c & 7, j = c >> 3, gi = i * 8 + x, rb = 4 * gi + (j >> 3);
        if (rb >= nblk) return false;
        int e = 0;
        for (int k = 0; k < 31; ++k) e += (rb >= blk_end[k]) ? 1 : 0;
        u.pm = rb; u.pn = j & 7; u.e = __builtin_amdgcn_readfirstlane(e); return true;
    }
    __device__ __forceinline__ const char* a_ptr(const Unit& u) const { return A + (size_t)u.pm * a_tstep; }
    __device__ __forceinline__ const char* b_ptr(const Unit& u) const { return Bt + (size_t)u.e * b_estep + (size_t)u.pn * b_tstep; }
    __device__ __forceinline__ void a_ready(const Unit&) const {}
    __device__ __forceinline__ void done(const Unit&) const {}
};
template <class Epi, class Sched, bool ALIGN_EPI = false, bool SP2 = false>
__device__ __forceinline__ void gemm_phase(PG8_LAS unsigned char* lds, const Gemm g, const Sched& S, const Epi& E) {
    int tid = threadIdx.x; asm volatile("" : "+v"(tid));
    const int wid = __builtin_amdgcn_readfirstlane(tid >> 6), lane = tid & 63, wr = wid >> 2, wc = wid & 3, fr = lane & 15, fq = lane >> 4;
    const int K = g.K, nt = K / BK;
    unsigned voffA[2], voffB[2];
#pragma unroll
    for (int i = 0; i < 2; ++i) { int R, C; stage_rc(tid * 16 + i * 8192, R, C); const int Rb = Epi::PERM ? ((R & ~31) + perm32(R & 31)) : R;
        voffA[i] = (unsigned)(R * K + C) * 2u; voffB[i] = (unsigned)(Rb * K + C) * 2u; }
    const size_t kstep = (size_t)(BK * 2);
    const size_t hstep = (size_t)HALF * K * 2;
    const size_t tstep = 2 * hstep;
    const unsigned ldsw = (unsigned)wid * 1024u;
    const int aoff = lds_byte(wr * 64 + fr, fq * 8), boff = lds_byte(wc * 32 + fr, fq * 8);
#define PG8_SA(b, h) (((b) * 2 + (h)) * HTB)
#define PG8_SB(b, h) ((4 + (b) * 2 + (h)) * HTB)
#define PG8_STAGE(bufoff, gbase, voff) do { _Pragma("unroll") for (int _i = 0; _i < 2; ++_i) \
        __builtin_amdgcn_global_load_lds((const unsigned*)((const char*)(gbase) + (voff)[_i]), (PG8_LAS unsigned*)(lds + (bufoff) + ldsw + _i * 8192), 16, 0, 0); } while (0)
#define PG8_LDA(dst, b, h) do { _Pragma("unroll") for (int m = 0; m < 4; ++m) _Pragma("unroll") for (int k = 0; k < 2; ++k) dst[m][k] = *(const PG8_LAS bf16x8*)(lds + PG8_SA(b, h) + aoff + m * 2048 + k * 1024); } while (0)
#define PG8_LDB(dst, b, h) do { _Pragma("unroll") for (int n = 0; n < 2; ++n) _Pragma("unroll") for (int k = 0; k < 2; ++k) dst[n][k] = *(const PG8_LAS bf16x8*)(lds + PG8_SB(b, h) + boff + n * 2048 + k * 1024); } while (0)
#define PG8_MMA(ai, bj, At, Bt) do { __builtin_amdgcn_s_setprio(1); _Pragma("unroll") for (int m = 0; m < 4; ++m) _Pragma("unroll") for (int n = 0; n < 2; ++n) _Pragma("unroll") for (int k = 0; k < 2; ++k) \
        acc[ai][bj][m][n] = __builtin_amdgcn_mfma_f32_16x16x32_bf16(Bt[n][k], At[m][k], acc[ai][bj][m][n], 0, 0, 0); __builtin_amdgcn_s_setprio(0); } while (0)
#define PG8_WAIT_V(n) asm volatile("s_waitcnt vmcnt(" #n ")" ::: "memory")
#define PG8_WAIT_L(n) asm volatile("s_waitcnt lgkmcnt(" #n ")" ::: "memory")
#define PG8_BAR __builtin_amdgcn_s_barrier()
#define PG8_SCHED __builtin_amdgcn_sched_barrier(0)
    Unit cur, nxt; int ui = 0;
    if (!S.next(0, cur)) return;
    f32x4 acc[2][2][4][2];
#pragma unroll
    for (int a = 0; a < 2; ++a)
#pragma unroll
        for (int b = 0; b < 2; ++b)
#pragma unroll
            for (int m = 0; m < 4; ++m)
#pragma unroll
                for (int n = 0; n < 2; ++n) acc[a][b][m][n] = (f32x4){0.f, 0.f, 0.f, 0.f};
    bf16x8 At[4][2], B0[2][2], B1[2][2];
    const char* cA = S.a_ptr(cur); const char* cB = S.b_ptr(cur);
    S.a_ready(cur);
    if constexpr (SP2) {
        PG8_STAGE(PG8_SB(0, 0), cB, voffB); PG8_STAGE(PG8_SB(0, 1), cB + hstep, voffB); PG8_STAGE(PG8_SA(0, 0), cA, voffA); PG8_STAGE(PG8_SA(0, 1), cA + hstep, voffA);
        if (wr == 1) PG8_BAR;
        PG8_WAIT_V(2); PG8_BAR;
        PG8_STAGE(PG8_SB(1, 0), cB + kstep, voffB); PG8_STAGE(PG8_SA(1, 0), cA + kstep, voffA); PG8_STAGE(PG8_SB(1, 1), cB + hstep + kstep, voffB);
        PG8_WAIT_V(6); PG8_BAR;
    } else {
        PG8_STAGE(PG8_SB(0, 0), cB, voffB); PG8_STAGE(PG8_SA(0, 0), cA, voffA); PG8_STAGE(PG8_SB(0, 1), cB + hstep, voffB); PG8_STAGE(PG8_SA(0, 1), cA + hstep, voffA);
        if (wr == 1) PG8_BAR;
        PG8_WAIT_V(4); PG8_BAR;
        PG8_STAGE(PG8_SB(1, 0), cB + kstep, voffB); PG8_STAGE(PG8_SA(1, 0), cA + kstep, voffA); PG8_STAGE(PG8_SB(1, 1), cB + hstep + kstep, voffB);
        PG8_WAIT_V(6); PG8_BAR;
    }
    for (;;) {
        const bool has_next = S.next(ui + 1, nxt);
        const char* nA = has_next ? S.a_ptr(nxt) : cA; const char* nB = has_next ? S.b_ptr(nxt) : cB;
        for (int t = 0; t < nt; t += 2) {
            const bool last = (t == nt - 2);
            const char* a1 = cA + (size_t)(t + 1) * kstep;
            const char* a2 = last ? nA : cA + (size_t)(t + 2) * kstep; const char* b2 = last ? nB : cB + (size_t)(t + 2) * kstep;
            const char* a3 = a2 + kstep; const char* b3 = b2 + kstep;
            if (last && has_next) S.a_ready(nxt);
            if constexpr (SP2) {
            PG8_LDB(B0, 0, 0); PG8_LDB(B1, 0, 1); PG8_SCHED; PG8_LDA(At, 0, 0); PG8_STAGE(PG8_SA(1, 1), a1 + hstep, voffA);
            PG8_WAIT_V(8); PG8_WAIT_L(0); PG8_BAR; PG8_MMA(0, 0, At, B0); PG8_MMA(0, 1, At, B1); PG8_BAR; PG8_SCHED;
            PG8_LDA(At, 0, 1); PG8_STAGE(PG8_SB(0, 0), b2, voffB); PG8_STAGE(PG8_SB(0, 1), b2 + hstep, voffB); PG8_STAGE(PG8_SA(0, 0), a2, voffA);
            PG8_WAIT_V(8); PG8_WAIT_L(0); PG8_BAR; PG8_MMA(1, 0, At, B0); PG8_MMA(1, 1, At, B1); PG8_BAR; PG8_SCHED;
            PG8_LDB(B0, 1, 0); PG8_LDB(B1, 1, 1); PG8_SCHED; PG8_LDA(At, 1, 0); PG8_STAGE(PG8_SA(0, 1), a2 + hstep, voffA);
            PG8_WAIT_V(8); PG8_WAIT_L(0); PG8_BAR; PG8_MMA(0, 0, At, B0); PG8_MMA(0, 1, At, B1); PG8_BAR; PG8_SCHED;
            PG8_LDA(At, 1, 1); PG8_STAGE(PG8_SB(1, 0), b3, voffB); PG8_STAGE(PG8_SB(1, 1), b3 + hstep, voffB); PG8_STAGE(PG8_SA(1, 0), a3, voffA);
            PG8_WAIT_V(8); PG8_WAIT_L(0); PG8_BAR; PG8_MMA(1, 0, At, B0); PG8_MMA(1, 1, At, B1); PG8_BAR; PG8_SCHED;
            } else {
            PG8_LDB(B0, 0, 0); PG8_SCHED; PG8_LDA(At, 0, 0); PG8_STAGE(PG8_SA(1, 1), a1 + hstep, voffA);
            PG8_WAIT_L(8); PG8_BAR; PG8_WAIT_L(0); PG8_MMA(0, 0, At, B0); PG8_BAR; PG8_SCHED;
            PG8_LDB(B1, 0, 1); PG8_STAGE(PG8_SB(0, 0), b2, voffB);
            PG8_BAR; PG8_WAIT_L(0); PG8_MMA(0, 1, At, B1); PG8_BAR;
            PG8_LDA(At, 0, 1); PG8_STAGE(PG8_SA(0, 0), a2, voffA);
            PG8_BAR; PG8_WAIT_L(0); PG8_MMA(1, 0, At, B0); PG8_BAR; PG8_SCHED;
            PG8_STAGE(PG8_SB(0, 1), b2 + hstep, voffB);
            PG8_WAIT_V(6); PG8_BAR; PG8_MMA(1, 1, At, B1); PG8_BAR;
            PG8_LDB(B0, 1, 0); PG8_SCHED; PG8_LDA(At, 1, 0); PG8_STAGE(PG8_SA(0, 1), a2 + hstep, voffA);
            PG8_WAIT_L(8); PG8_BAR; PG8_WAIT_L(0); PG8_MMA(0, 0, At, B0); PG8_BAR; PG8_SCHED;
            PG8_LDB(B1, 1, 1); PG8_STAGE(PG8_SB(1, 0), b3, voffB);
            PG8_BAR; PG8_WAIT_L(0); PG8_MMA(0, 1, At, B1); PG8_BAR;
            PG8_LDA(At, 1, 1); PG8_STAGE(PG8_SA(1, 0), a3, voffA);
            PG8_BAR; PG8_WAIT_L(0); PG8_MMA(1, 0, At, B0); PG8_BAR; PG8_SCHED;
            PG8_STAGE(PG8_SB(1, 1), b3 + hstep, voffB);
            PG8_WAIT_V(6); PG8_BAR; PG8_MMA(1, 1, At, B1); PG8_BAR;
            }
        }
        if constexpr (ALIGN_EPI) { if (wr == 0) PG8_BAR; }
        if constexpr (!Epi::AFTER_DRAIN) { int fr_e = fr, fq_e = fq; asm volatile("" : "+v"(fr_e), "+v"(fq_e));
            E(acc, cur, wr, wc, fr_e, fq_e); S.done(cur); }
        if (!has_next) break;
#pragma unroll
        for (int a = 0; a < 2; ++a)
#pragma unroll
            for (int b = 0; b < 2; ++b)
#pragma unroll
                for (int m = 0; m < 4; ++m)
#pragma unroll
                    for (int n = 0; n < 2; ++n) acc[a][b][m][n] = (f32x4){0.f, 0.f, 0.f, 0.f};
        cur = nxt; cA = nA; cB = nB; ++ui;
        if constexpr (ALIGN_EPI) { if (wr == 1) PG8_BAR; }
    }
    PG8_WAIT_V(0);
    if constexpr (!ALIGN_EPI) { if (wr == 0) PG8_BAR; }
    PG8_BAR;
    if constexpr (Epi::AFTER_DRAIN) { E.fused(acc, cur, wr, wc, fr, fq, lds, wid, lane); S.done(cur); }
#undef PG8_SA
#undef PG8_SB
#undef PG8_STAGE
#undef PG8_LDA
#undef PG8_LDB
#undef PG8_MMA
#undef PG8_WAIT_V
#undef PG8_WAIT_L
#undef PG8_BAR
#undef PG8_SCHED
}
}

constexpr size_t MiB = 1u << 20;
constexpr size_t WS_CTL = 0, CTL_ZERO_BYTES = 1 * MiB;
constexpr size_t WS_MOD  = 1 * MiB;
constexpr size_t WS_WRT  = 2 * MiB;
constexpr size_t WS_MOEI = 3 * MiB;
constexpr size_t WS_LRC  = 6 * MiB;
constexpr size_t WS_DNS  = 12 * MiB;
constexpr size_t WS_WIN  = 16 * MiB;
constexpr size_t WS_WOUT = 56 * MiB;
constexpr size_t WS_WGU  = 72 * MiB;
constexpr size_t WS_WDN  = 584 * MiB;
constexpr size_t WS_X    = 840 * MiB;
constexpr size_t WS_H    = 976 * MiB;
constexpr size_t WS_P    = 1044 * MiB;
constexpr size_t WS_CC   = 1206 * MiB;
constexpr size_t WS_VT   = 1274 * MiB;
constexpr size_t WS_VTC  = WS_VT + 8 * MiB;
constexpr size_t WS_DNT  = 1284 * MiB;
constexpr size_t DNT_BYTES = 90112;
constexpr size_t WS_DNO  = 1472 * MiB;
constexpr size_t WS_LRH  = 1540 * MiB;
constexpr size_t WS_LRA  = 1608 * MiB;
constexpr size_t WS_XS   = 1676 * MiB;
constexpr size_t WS_ACT  = 1980 * MiB;
constexpr size_t WS_YS   = 2132 * MiB;
constexpr size_t WS_END  = 2436 * MiB;
constexpr int CW_TMO = 0;
constexpr int CW_BAR = 4096;
constexpr int CW_CNT = 8192;
constexpr int CW_ATQ = 12288;

constexpr int RING_OFF = 0, RING_BYTES = 131072;
constexpr int LDSCTL_OFF = RING_BYTES, MISC_OFF = LDSCTL_OFF + 320;
constexpr int LDS_X_OFF = RING_BYTES + 1024;
constexpr int LDS_BYTES = 147456;
constexpr int NWAVES = 8, NTHREADS = 512;

#define GAS __attribute__((address_space(1)))
#define LAS __attribute__((address_space(3)))
typedef unsigned short bf16;
typedef unsigned v4u __attribute__((ext_vector_type(4)));
typedef unsigned v2u __attribute__((ext_vector_type(2)));
typedef float f32x4 __attribute__((ext_vector_type(4)));
typedef float f32x16 __attribute__((ext_vector_type(16)));
typedef short bf16x8 __attribute__((ext_vector_type(8)));
typedef short bf16x4 __attribute__((ext_vector_type(4)));
typedef GAS unsigned gu32;
#define RLX_AGENT __ATOMIC_RELAXED, __HIP_MEMORY_SCOPE_AGENT
#define LDS_WAIT() asm volatile("s_waitcnt lgkmcnt(0)" ::: "memory")
#define VM_WAIT() asm volatile("s_waitcnt vmcnt(0)" ::: "memory")
__device__ __forceinline__ unsigned f2bf(float f) { unsigned u = __builtin_bit_cast(unsigned, f); return (u + 0x7fffu + ((u >> 16) & 1u)) >> 16; }
__device__ __forceinline__ unsigned pk2(float lo, float hi) { return pg8::cvt_pk_bf16(lo, hi); }
__device__ __forceinline__ float bf2f(unsigned short b) { return __builtin_bit_cast(float, (unsigned)b << 16); }
__device__ __forceinline__ float bflo(unsigned w) { return __builtin_bit_cast(float, w << 16); }
__device__ __forceinline__ float bfhi(unsigned w) { return __builtin_bit_cast(float, w & 0xffff0000u); }
__device__ __forceinline__ float wave_sum(float v) {
#pragma unroll
    for (int o = 1; o < 64; o <<= 1) v += __shfl_xor(v, o);
    return v;
}
__device__ __forceinline__ float sigmoidf_(float x) { return 1.0f / (1.0f + __expf(-x)); }
__device__ __forceinline__ float siluf_(float x) { return x / (1.0f + __expf(-x)); }
__device__ __forceinline__ float softplusf_(float x) { return x > 20.f ? x : log1pf(__expf(x)); }

#define XB_TMO      128
#define XB_XCNT(j)  (256  + 64 * (j))
#define XB_XSUB(j)  (1280 + 64 * (j))
#define XB_XGEN(j)  (2304 + 64 * (j))
#define XB_TOP      3328
#define XB_TOPGEN   3392
#define XCD_BAR_WORDS 3456
#define XB_SPIN_CAP (1u << 18)

__device__ __forceinline__ unsigned xb_ld(unsigned* p)              { return __hip_atomic_load(p, __ATOMIC_RELAXED, __HIP_MEMORY_SCOPE_AGENT); }
__device__ __forceinline__ unsigned xb_add(unsigned* p, unsigned v) { return __hip_atomic_fetch_add(p, v, __ATOMIC_RELAXED, __HIP_MEMORY_SCOPE_AGENT); }
__device__ __forceinline__ unsigned xb_xcc_id() { return (unsigned)__builtin_amdgcn_s_getreg((3 << 11) | 20) & 0xFu; }
#define XB_SPIN(cond, bar) do { unsigned _sp = 0; while (cond) { __builtin_amdgcn_s_sleep(1); \
    if ((++_sp & 255u) == 0u) { if (xb_ld(&(bar)[XB_TMO])) break; if (_sp > XB_SPIN_CAP) { atomicAdd(&(bar)[XB_TMO], 1u); break; } } } } while (0)

struct XcdBarrier {
    unsigned* bar; unsigned x;
    volatile LAS unsigned* st;
};

__device__ __forceinline__ XcdBarrier xcd_barrier_post(unsigned* bar, volatile LAS unsigned* st) {
    XcdBarrier b; b.bar = bar; b.x = xb_xcc_id(); b.st = st;
    if (threadIdx.x == 0) (void)xb_add(&bar[XB_XCNT(b.x)], 1u);
    return b;
}
__device__ __forceinline__ void xcd_barrier_complete(unsigned* bar, unsigned x, unsigned& nloc, unsigned& nx) {
    const unsigned G = gridDim.x * gridDim.y * gridDim.z;
    unsigned sum, cnt, mine, sp = 0u;
    for (;;) {
        sum = 0u; cnt = 0u; mine = 0u;
#pragma unroll
        for (unsigned j = 0; j < 16; ++j) { const unsigned c = xb_ld(&bar[XB_XCNT(j)]); sum += c; cnt += (c > 0u) ? 1u : 0u; mine = (j == x) ? c : mine; }
        if (sum == G) break;
        __builtin_amdgcn_s_sleep(1);
        if ((++sp & 255u) == 0u) { if (xb_ld(&bar[XB_TMO])) break; if (sp > XB_SPIN_CAP) { atomicAdd(&bar[XB_TMO], 1u); break; } }
    }
    nloc = mine > 0u ? mine : 1u; nx = cnt > 0u ? cnt : 1u;
}

__device__ __forceinline__ void xcd_barrier(const XcdBarrier& b) {
    asm volatile("s_waitcnt vmcnt(0)" ::: "memory");
    __syncthreads();
    if (threadIdx.x == 0) {
        unsigned* bar = b.bar;
        __builtin_amdgcn_s_waitcnt(0);
        unsigned nloc = b.st[0], nx = b.st[1];
        if (nloc == 0u) { xcd_barrier_complete(bar, b.x, nloc, nx); b.st[0] = nloc; b.st[1] = nx; }
        const unsigned old = xb_add(&bar[XB_XSUB(b.x)], 1u);
        const unsigned gen = old / nloc;
        if (old + 1u == (gen + 1u) * nloc) {
            __builtin_amdgcn_fence(__ATOMIC_RELEASE, "agent");
            asm volatile("s_waitcnt vmcnt(0)" ::: "memory");
            const unsigned og = xb_add(&bar[XB_TOP], 1u);
            const unsigned tg = og / nx;
            if (og + 1u == (tg + 1u) * nx) xb_add(&bar[XB_TOPGEN], 1u);
            else XB_SPIN(xb_ld(&bar[XB_TOPGEN]) == tg, bar);
            __builtin_amdgcn_fence(__ATOMIC_ACQUIRE, "agent");
            xb_add(&bar[XB_XGEN(b.x)], 1u);
            asm volatile("s_waitcnt vmcnt(0)" ::: "memory");
        } else {
            XB_SPIN(xb_ld(&bar[XB_XGEN(b.x)]) == gen, bar);
            __builtin_amdgcn_fence(__ATOMIC_ACQUIRE, "agent");
            asm volatile("s_waitcnt vmcnt(0)" ::: "memory");
        }
    }
    __syncthreads();
}

enum InIdx { I_X = 0, I_C, I_CTX, I_CCTX, I_WMOD, I_BMOD, I_NMG, I_NFG, I_WIN, I_WOUT, I_SINK, I_DNCW, I_DNALOG, I_DNDT, I_DNNG, I_LRCW, I_LRCB, I_LRWR, I_LRBR, I_LRWI, I_LRBI, I_LRLAM,
             I_WROUT, I_BROUT, I_WGU, I_BGU, I_WDN, I_BDN, I_FNG, N_IN };
struct Frame {
    LAS unsigned char* lds;
    volatile LAS unsigned* MISC;
    gu32* ctl;
    int tid, lane, wave, G, bid;
    const float* const __attribute__((address_space(4)))* in;
    float* out; unsigned char* ws;
};
__device__ __forceinline__ int mod_row(int m) { return m < NLAT ? (m >> 12) : 4; }
__device__ __forceinline__ bool phase_enter(Frame& F) { int t = threadIdx.x; asm volatile("" : "+v"(t)); F.tid = t; F.lane = t & 63; F.wave = __builtin_amdgcn_readfirstlane(t >> 6); return true; }

__device__ __forceinline__ void transpose_item(const float* W, int K, int N, bf16* WT, int k0, int dstrow0, int srccol0, int nvalid, LAS float* scr, int lane) {
    const int j = lane & 31;
#pragma unroll 8
    for (int i = 0; i < 32; ++i) { const int kk = 2 * i + (lane >> 5); scr[kk * 33 + j] = (j < nvalid) ? W[(size_t)(k0 + kk) * N + srccol0 + j] : 0.f; }
    LDS_WAIT(); asm volatile("" ::: "memory");
    const int c = lane & 7;
#pragma unroll
    for (int jj = 0; jj < 4; ++jj) { const int n = (lane >> 3) + 8 * jj; const LAS float* s = scr + (8 * c) * 33 + n;
        v4u o; o.x = pk2(s[0 * 33], s[1 * 33]); o.y = pk2(s[2 * 33], s[3 * 33]); o.z = pk2(s[4 * 33], s[5 * 33]); o.w = pk2(s[6 * 33], s[7 * 33]);
        *(GAS v4u*)(WT + (size_t)(dstrow0 + n) * K + k0 + 8 * c) = o; }
    LDS_WAIT(); asm volatile("" ::: "memory");
}
__device__ __forceinline__ void p0_prologue(Frame& F) {
    {
        LAS float* sc = (LAS float*)(F.lds);
        LAS float* red = (LAS float*)(F.lds + 40960);
        bool have_sc = false;
        for (int wb = F.bid; wb < 192; wb += F.G) {
            if (!have_sc) {
                for (int i = F.tid; i < 5 * 2048; i += NTHREADS) { const int r = i >> 11, k = i & 2047; const float cv = r < 4 ? F.in[I_C][r * 2048 + k] : F.in[I_CCTX][k]; sc[i] = siluf_(cv); }
                have_sc = true; __syncthreads();
            }
            const int l = wb / 96, cb = wb % 96, kp = F.tid >> 5, cg = F.tid & 31, j0 = cb * 128 + cg * 4;
            const float* wp = F.in[I_WMOD] + ((size_t)l * 2048 + kp * 128) * 12288 + j0;
            f32x4 acc[5];
#pragma unroll
            for (int r = 0; r < 5; ++r) acc[r] = (f32x4){0.f, 0.f, 0.f, 0.f};
#pragma unroll 4
            for (int k = 0; k < 128; ++k) { const f32x4 w = *(const f32x4*)(wp + (size_t)k * 12288);
#pragma unroll
                for (int r = 0; r < 5; ++r) acc[r] += sc[r * 2048 + kp * 128 + k] * w; }
#pragma unroll
            for (int r = 0; r < 5; ++r) *(LAS f32x4*)(red + (kp * 5 + r) * 128 + cg * 4) = acc[r];
            __syncthreads();
            for (int i = F.tid; i < 640; i += NTHREADS) { const int r = i >> 7, col = i & 127; float s = F.in[I_BMOD][l * 12288 + cb * 128 + col];
#pragma unroll
                for (int q = 0; q < 16; ++q) s += red[(q * 5 + r) * 128 + col];
                ((float*)(F.ws + WS_MOD))[(size_t)(l * 5 + r) * 12288 + cb * 128 + col] = s; }
            __syncthreads();
        }
        __syncthreads();
    }
    {
        LAS float* scr = (LAS float*)(F.lds + F.wave * 16384);
        const int gw = F.bid * NWAVES + F.wave, NGW = F.G * NWAVES;
        constexpr int I_IN = 32 * 152, I_OUT = 32 * 64, I_RT = 32, I_GU = 32 * 32 * 64, I_DN = 32 * 16 * 64, PER_L = I_IN + I_OUT + I_RT + I_GU + I_DN;
        for (int it0 = gw; it0 < 2 * PER_L; it0 += NGW) {
            const int l = it0 / PER_L; int r = it0 % PER_L;
            if (r < I_IN) { const int nb = r % 152, kb = r / 152, d0 = nb * 32; int s0 = d0, nv = 32;
                if (d0 >= 4640) nv = 0; else if (d0 == 4608) { s0 = 3584; nv = 16; } else if (d0 >= 3584) s0 = d0 + 16;
                transpose_item(F.in[I_WIN] + (size_t)l * 2048 * IN_W, 2048, IN_W, (bf16*)(F.ws + WS_WIN) + (size_t)l * PW * 2048, kb * 64, d0, s0, nv, scr, F.lane); continue; }
            r -= I_IN;
            if (r < I_OUT) { const int nb = r % 64, kb = r / 64;
                transpose_item(F.in[I_WOUT] + (size_t)l * 2048 * 2048, 2048, 2048, (bf16*)(F.ws + WS_WOUT) + (size_t)l * 2048 * 2048, kb * 64, nb * 32, nb * 32, 32, scr, F.lane); continue; }
            r -= I_OUT;
            if (r < I_RT) { transpose_item(F.in[I_WROUT] + (size_t)l * 2048 * 32, 2048, 32, (bf16*)(F.ws + WS_WRT) + (size_t)l * 32 * 2048, r * 64, 0, 0, 32, scr, F.lane); continue; }
            r -= I_RT;
            if (r < I_GU) { const int e = r / 2048, q = r % 2048, nb = q % 64, kb = q / 64; const int s0 = ((nb >> 2) & 1) * 1024 + (nb >> 3) * 128 + (nb & 3) * 32;
                transpose_item(F.in[I_WGU] + (size_t)(l * 32 + e) * 2048 * 2048, 2048, 2048, (bf16*)(F.ws + WS_WGU) + (size_t)(l * 32 + e) * 2048 * 2048, kb * 64, nb * 32, s0, 32, scr, F.lane); continue; }
            r -= I_GU;
            { const int e = r / 1024, q = r % 1024, nb = q % 64, kb = q / 64;
                transpose_item(F.in[I_WDN] + (size_t)(l * 32 + e) * 1024 * 2048, 1024, 2048, (bf16*)(F.ws + WS_WDN) + (size_t)(l * 32 + e) * 2048 * 1024, kb * 64, nb * 32, nb * 32, 32, scr, F.lane); }
        }
    }
}

__device__ __forceinline__ void load_row(const float* src, int lane, f32x4 (&v)[8]) {
    const f32x4* p = (const f32x4*)src + lane;
#pragma unroll
    for (int j = 0; j < 8; ++j) v[j] = p[64 * j];
}
__device__ __forceinline__ void store_row(float* dst, int lane, const f32x4 (&v)[8]) {
    f32x4* p = (f32x4*)dst + lane;
#pragma unroll
    for (int j = 0; j < 8; ++j) p[64 * j] = v[j];
}
__device__ __forceinline__ void combine_row(Frame& F, int l, int m, int lane, f32x4 (&v)[8]) {
    const int* dest = (const int*)(F.ws + WS_MOEI + 2 * 512 * 1024) + m * 4;
    const float* g5 = (const float*)(F.ws + WS_MOD) + (size_t)(l * 5 + mod_row(m)) * 12288 + 5 * 2048;
    f32x4 acc[8];
#pragma unroll
    for (int j = 0; j < 8; ++j) acc[j] = (f32x4){0.f, 0.f, 0.f, 0.f};
#pragma unroll
    for (int k = 0; k < 4; ++k) { const int d = dest[k]; const v2u* yp = (const v2u*)((const bf16*)(F.ws + WS_YS) + (size_t)d * 2048) + lane;
#pragma unroll
        for (int j = 0; j < 8; ++j) { const v2u w = yp[64 * j]; acc[j] += (f32x4){bflo(w.x), bfhi(w.x), bflo(w.y), bfhi(w.y)}; } }
#pragma unroll
    for (int j = 0; j < 8; ++j) { const f32x4 gg = *((const f32x4*)g5 + lane + 64 * j); v[j] += gg * acc[j]; }
}
__device__ __forceinline__ void modnorm_store(const f32x4 (&v)[8], const float* g, const float* shift, const float* scale, bf16* hrow, int lane) {
    float ss = 0.f;
#pragma unroll
    for (int j = 0; j < 8; ++j) ss += (v[j].x * v[j].x + v[j].y * v[j].y) + (v[j].z * v[j].z + v[j].w * v[j].w);
    const float rstd = 1.0f / sqrtf(wave_sum(ss) * (1.0f / 2048.0f) + EPS);
    v2u* hp = (v2u*)hrow + lane;
#pragma unroll
    for (int j = 0; j < 8; ++j) { const f32x4 gg = *((const f32x4*)g + lane + 64 * j), sh = *((const f32x4*)shift + lane + 64 * j), sc = *((const f32x4*)scale + lane + 64 * j);
        const f32x4 y = (v[j] * rstd) * gg * (sc + 1.0f) + sh; v2u w; w.x = pk2(y.x, y.y); w.y = pk2(y.z, y.w); hp[64 * j] = w; }
}
__device__ __forceinline__ void phase_norm1(Frame& F, int l) {
    const int gw = F.bid * NWAVES + F.wave, NGW = F.G * NWAVES;
    float* X = (float*)(F.ws + WS_X); bf16* H = (bf16*)(F.ws + WS_H);
    const float* modp = (const float*)(F.ws + WS_MOD) + (size_t)l * 5 * 12288;
    for (int m = gw; m < NTOK; m += NGW) {
        f32x4 v[8];
        if (l == 0) load_row(m < NLAT ? F.in[I_X] + (size_t)m * DM : F.in[I_CTX] + (size_t)(m - NLAT) * DM, F.lane, v);
        else { load_row(X + (size_t)m * DM, F.lane, v); if (MK_STAGE >= 9) { combine_row(F, l - 1, m, F.lane, v); store_row(X + (size_t)m * DM, F.lane, v); } }
        const float* mr = modp + (size_t)mod_row(m) * 12288;
        modnorm_store(v, F.in[I_NMG] + l * DM, mr, mr + 2048, H + (size_t)m * DM, F.lane);
    }
}
__device__ __forceinline__ void phase_final(Frame& F, bool with_combine) {
    const int gw = F.bid * NWAVES + F.wave, NGW = F.G * NWAVES;
    const float* X = (const float*)(F.ws + WS_X);
    for (int m = gw; m < NLAT; m += NGW) {
        f32x4 v[8];
        if (with_combine) { load_row(X + (size_t)m * DM, F.lane, v); combine_row(F, 1, m, F.lane, v); }
        else load_row(F.in[I_X] + (size_t)m * DM, F.lane, v);
        float ss = 0.f;
#pragma unroll
        for (int j = 0; j < 8; ++j) ss += (v[j].x * v[j].x + v[j].y * v[j].y) + (v[j].z * v[j].z + v[j].w * v[j].w);
        const float rstd = 1.0f / sqrtf(wave_sum(ss) * (1.0f / 2048.0f) + EPS);
        f32x4* op = (f32x4*)(F.out + (size_t)m * DM) + F.lane;
#pragma unroll
        for (int j = 0; j < 8; ++j) { const f32x4 gg = *((const f32x4*)F.in[I_FNG] + F.lane + 64 * j); op[64 * j] = v[j] * rstd * gg; }
    }
}

__device__ __forceinline__ void phase_inproj(Frame& F, int l) {
    pg8::Gemm g{(const bf16*)(F.ws + WS_H), (const bf16*)(F.ws + WS_WIN) + (size_t)l * PW * 2048, NTOK, PW, 2048};
    pg8::StaticOrder S; S.init(g, F.G, F.bid);
    pg8::EpiBf16Plain E{(bf16*)(F.ws + WS_P), PW};
    pg8::gemm_phase<pg8::EpiBf16Plain, pg8::StaticOrder, true, true>(F.lds + RING_OFF, g, S, E);
}
__device__ __forceinline__ void phase_outproj(Frame& F, int l) {
    float* X = (float*)(F.ws + WS_X);
    pg8::Gemm g{(const bf16*)(F.ws + WS_CC), (const bf16*)(F.ws + WS_WOUT) + (size_t)l * 2048 * 2048, l == 0 ? NTOK : NLAT, 2048, 2048};
    pg8::StaticOrder S; S.init(g, F.G, F.bid);
    pg8::EpiResGate E{l == 0 ? F.in[I_X] : X, l == 0 ? F.in[I_CTX] : X + (size_t)NLAT * DM, X, (const float*)(F.ws + WS_MOD) + (size_t)l * 5 * 12288 + 2 * 2048};
    pg8::gemm_phase<pg8::EpiResGate, pg8::StaticOrder, true, true>(F.lds + RING_OFF, g, S, E);
}
#ifndef PHASE_INPROJ
#define PHASE_INPROJ(F, l) phase_inproj(F, l)
#endif
#ifndef PHASE_OUTPROJ
#define PHASE_OUTPROJ(F, l) phase_outproj(F, l)
#endif

constexpr size_t MOEI_TOPE = WS_MOEI, MOEI_TOPG = WS_MOEI + 512 * 1024, MOEI_DEST = WS_MOEI + 2 * 512 * 1024, MOEI_ROWG = WS_MOEI + 3 * 512 * 1024;
__device__ __forceinline__ void phase_norm2(Frame& F, int l) {
    const int nrows = (l == 0) ? NTOK : NLAT;
    constexpr int TROW = 4112;
    LAS unsigned char* tile = F.lds;
    LAS float* part = (LAS float*)(F.lds + 66048);
    LAS float* lg = (LAS float*)(F.lds + 66048 + 16384);
    const float* X = (const float*)(F.ws + WS_X); bf16* H = (bf16*)(F.ws + WS_H);
    const float* modp = (const float*)(F.ws + WS_MOD) + (size_t)l * 5 * 12288;
    const bf16* wrt = (const bf16*)(F.ws + WS_WRT) + (size_t)l * 32 * 2048;
    int* tope = (int*)(F.ws + MOEI_TOPE); float* topg = (float*)(F.ws + MOEI_TOPG);
    for (int r0 = F.bid * 16; r0 < nrows; r0 += F.G * 16) {
#pragma unroll 1
        for (int rr = 0; rr < 2; ++rr) {
            const int lr = 2 * F.wave + rr, m = r0 + lr;
            f32x4 v[8]; load_row(X + (size_t)m * DM, F.lane, v);
            float ss = 0.f;
#pragma unroll
            for (int j = 0; j < 8; ++j) ss += (v[j].x * v[j].x + v[j].y * v[j].y) + (v[j].z * v[j].z + v[j].w * v[j].w);
            const float rstd = 1.0f / sqrtf(wave_sum(ss) * (1.0f / 2048.0f) + EPS);
            const float* mr = modp + (size_t)mod_row(m) * 12288; const float* g = F.in[I_NFG] + l * DM;
            v2u* hp = (v2u*)(H + (size_t)m * DM) + F.lane; LAS v2u* tp = (LAS v2u*)(tile + lr * TROW) + F.lane;
#pragma unroll
            for (int j = 0; j < 8; ++j) { const f32x4 gg = *((const f32x4*)g + F.lane + 64 * j), sh = *((const f32x4*)(mr + 3 * 2048) + F.lane + 64 * j), sc = *((const f32x4*)(mr + 4 * 2048) + F.lane + 64 * j);
                const f32x4 y = (v[j] * rstd) * gg * (sc + 1.0f) + sh; v2u w; w.x = pk2(y.x, y.y); w.y = pk2(y.z, y.w); hp[64 * j] = w; tp[64 * j] = w; }
        }
        __syncthreads();
        {
            const int row = F.lane & 15, q = F.lane >> 4;
            f32x4 acc0 = {0.f, 0.f, 0.f, 0.f}, acc1 = {0.f, 0.f, 0.f, 0.f};
#pragma unroll
            for (int ks = 0; ks < 8; ++ks) { const int k0 = 256 * F.wave + 32 * ks + 8 * q;
                const bf16x8 a = *(const LAS bf16x8*)(tile + row * TROW + k0 * 2);
                const bf16x8 b0 = *(const bf16x8*)(wrt + (size_t)row * 2048 + k0), b1 = *(const bf16x8*)(wrt + (size_t)(16 + row) * 2048 + k0);
                acc0 = __builtin_amdgcn_mfma_f32_16x16x32_bf16(a, b0, acc0, 0, 0, 0); acc1 = __builtin_amdgcn_mfma_f32_16x16x32_bf16(a, b1, acc1, 0, 0, 0); }
#pragma unroll
            for (int i = 0; i < 4; ++i) { part[(F.wave * 16 + 4 * q + i) * 32 + row] = acc0[i]; part[(F.wave * 16 + 4 * q + i) * 32 + 16 + row] = acc1[i]; }
        }
        __syncthreads();
        { const int rw = F.tid >> 5, e = F.tid & 31; float s = F.in[I_BROUT][l * 32 + e];
#pragma unroll
          for (int w = 0; w < 8; ++w) s += part[(w * 16 + rw) * 32 + e];
          lg[rw * 32 + e] = s; }
        __syncthreads();
        if (F.tid < 16) { const int m = r0 + F.tid; float val[4]; int idx[4]; unsigned taken = 0u;
#pragma unroll
            for (int k = 0; k < 4; ++k) { float best = -3.0e38f; int bi = 0;
                for (int e = 0; e < 32; ++e) { const float x = lg[F.tid * 32 + e]; if (!((taken >> e) & 1u) && x > best) { best = x; bi = e; } }
                val[k] = best; idx[k] = bi; taken |= 1u << bi; }
            float p[4], sum = 0.f;
#pragma unroll
            for (int k = 0; k < 4; ++k) { p[k] = __expf(val[k] - val[0]); sum += p[k]; }
#pragma unroll
            for (int k = 0; k < 4; ++k) { const unsigned rank = __hip_atomic_fetch_add(F.ctl + CW_CNT + 64 * l + idx[k], 1u, RLX_AGENT);
                tope[m * 4 + k] = idx[k] | (int)(rank << 8); topg[m * 4 + k] = p[k] / sum; }
        }
        __syncthreads();
    }
}
__device__ __forceinline__ void moe_tables(Frame& F, int l) {
    LAS int* blk_end = (LAS int*)(F.lds + LDS_X_OFF); LAS int* pstart = blk_end + 32;
    if (F.tid == 0) { int nb = 0;
        for (int e = 0; e < 32; ++e) { const int c = (int)__hip_atomic_load(F.ctl + CW_CNT + 64 * l + e, RLX_AGENT); pstart[e] = nb * 256; nb += (c + 255) >> 8; blk_end[e] = nb; } }
    __syncthreads();
}
__device__ __forceinline__ void phase_scatter(Frame& F, int l) {
    const int nrows = (l == 0) ? NTOK : NLAT;
    moe_tables(F, l);
    const LAS int* pstart = (const LAS int*)(F.lds + LDS_X_OFF) + 32;
    const int* tope = (const int*)(F.ws + MOEI_TOPE); const float* topg = (const float*)(F.ws + MOEI_TOPG);
    int* dest = (int*)(F.ws + MOEI_DEST); float* rowg = (float*)(F.ws + MOEI_ROWG);
    const bf16* H = (const bf16*)(F.ws + WS_H); bf16* XS = (bf16*)(F.ws + WS_XS);
    const int gw = F.bid * NWAVES + F.wave, NGW = F.G * NWAVES;
    for (int a = gw; a < nrows * 4; a += NGW) {
        const int te = tope[a], e = te & 255, rank = (int)((unsigned)te >> 8), d = pstart[e] + rank, m = a >> 2;
        if (F.lane == 0) { dest[a] = d; rowg[d] = topg[a]; }
        const v4u* src = (const v4u*)(H + (size_t)m * DM) + F.lane; v4u* dst = (v4u*)(XS + (size_t)d * DM) + F.lane;
#pragma unroll
        for (int j = 0; j < 4; ++j) dst[64 * j] = src[64 * j];
    }
}
__device__ __forceinline__ void phase_gemm1(Frame& F, int l) {
    moe_tables(F, l);
    const LAS int* blk_end = (const LAS int*)(F.lds + LDS_X_OFF);
    pg8::Gemm g{(const bf16*)(F.ws + WS_XS), (const bf16*)(F.ws + WS_WGU) + (size_t)l * 32 * 2048 * 2048, MOE_ROWS, 2048, 2048};
    pg8::MoeOrder S{F.bid, __builtin_amdgcn_readfirstlane(blk_end[31]), (const char*)g.A, (const char*)g.Bt, (size_t)256 * 2048 * 2, (size_t)2048 * 2048 * 2, (size_t)256 * 2048 * 2, blk_end};
    pg8::EpiSwiglu E{(bf16*)(F.ws + WS_ACT), F.in[I_BGU] + (size_t)l * 32 * 2048};
    pg8::gemm_phase<pg8::EpiSwiglu, pg8::MoeOrder, true, true>(F.lds + RING_OFF, g, S, E);
}
__device__ __forceinline__ void phase_gemm2(Frame& F, int l) {
    moe_tables(F, l);
    const LAS int* blk_end = (const LAS int*)(F.lds + LDS_X_OFF);
    pg8::Gemm g{(const bf16*)(F.ws + WS_ACT), (const bf16*)(F.ws + WS_WDN) + (size_t)l * 32 * 2048 * 1024, MOE_ROWS, 2048, 1024};
    pg8::MoeOrder S{F.bid, __builtin_amdgcn_readfirstlane(blk_end[31]), (const char*)g.A, (const char*)g.Bt, (size_t)256 * 1024 * 2, (size_t)2048 * 1024 * 2, (size_t)256 * 1024 * 2, blk_end};
    pg8::EpiDown E{(bf16*)(F.ws + WS_YS), F.in[I_BDN] + (size_t)l * 32 * 2048, (const float*)(F.ws + MOEI_ROWG)};
    pg8::gemm_phase<pg8::EpiDown, pg8::MoeOrder, true, true>(F.lds + RING_OFF, g, S, E);
}
#ifndef PHASE_NORM2
#define PHASE_NORM2(F, l) phase_norm2(F, l)
#endif
#ifndef PHASE_SCATTER
#define PHASE_SCATTER(F, l) phase_scatter(F, l)
#endif
#ifndef PHASE_GEMM1
#define PHASE_GEMM1(F, l) phase_gemm1(F, l)
#endif
#ifndef PHASE_GEMM2
#define PHASE_GEMM2(F, l) phase_gemm2(F, l)
#endif
#define USE_MFMA_ATTN 1

__device__ __forceinline__ void attn_prep(Frame& F, int l) {
    bf16* P = (bf16*)(F.ws + WS_P);
    LAS unsigned short* vt = (LAS unsigned short*)F.lds;
    for (int ct = F.bid; ct < NCT; ct += F.G) {
        const int m0 = ct * 64; const bool lat = m0 < NLAT;
        __syncthreads();
        for (int i = F.tid; i < 64 * 32; i += NTHREADS) { const int tk = i >> 5, c8 = i & 31;
            const v4u w = *(const v4u*)(P + (size_t)(m0 + tk) * PW + PC_V + c8 * 8);
            const unsigned ww[4] = {w.x, w.y, w.z, w.w};
#pragma unroll
            for (int q = 0; q < 4; ++q) { vt[(c8 * 8 + 2 * q) * 66 + tk] = (unsigned short)(ww[q] & 0xffffu); vt[(c8 * 8 + 2 * q + 1) * 66 + tk] = (unsigned short)(ww[q] >> 16); } }
        if (lat) for (int i = F.tid; i < 64 * 128; i += NTHREADS) { const int tk = i >> 7, pi = i & 127, kvh = pi >> 5, hf = (pi >> 4) & 1, j = pi & 15; const int t = (m0 + tk) & 4095;
            bf16* kp = P + (size_t)(m0 + tk) * PW + PC_K + kvh * 64 + hf * 32 + j;
            const float x1 = bf2f(kp[0]), x2 = bf2f(kp[16]); const float pos = (float)(hf ? (t & 63) : (t >> 6)); const float inv = __builtin_amdgcn_exp2f(-(float)j * 0.8304820237218406f);
            const float sn = __sinf(pos * inv), cs = __cosf(pos * inv);
            kp[0] = (bf16)f2bf(x1 * cs - x2 * sn); kp[16] = (bf16)f2bf(x2 * cs + x1 * sn); }
        __syncthreads();
        for (int i = F.tid; i < 256 * 8; i += NTHREADS) { const int col = i >> 3, c = i & 7, kvh = col >> 6, d = col & 63;
            v4u o; const LAS unsigned short* s = vt + col * 66 + c * 8;
            o.x = s[0] | ((unsigned)s[1] << 16); o.y = s[2] | ((unsigned)s[3] << 16); o.z = s[4] | ((unsigned)s[5] << 16); o.w = s[6] | ((unsigned)s[7] << 16);
            if (lat) { const int b = m0 >> 12, t0 = m0 & 4095; *(v4u*)((bf16*)(F.ws + WS_VT) + ((size_t)(b * 4 + kvh) * 64 + d) * SEQ + t0 + c * 8) = o; }
            else { const int mm = m0 - NLAT, b = mm >> 8, t0 = mm & 255; *(v4u*)((bf16*)(F.ws + WS_VTC) + ((size_t)(b * 4 + kvh) * 64 + d) * CTXL + t0 + c * 8) = o; } }
    }
    __syncthreads();
}

constexpr int AT_KP = 144, AT_VP = 136;
constexpr int AT_KOFF = 0, AT_VOFF = 64 * AT_KP, AT_TILE = 64 * AT_KP + 64 * AT_VP;
__device__ __forceinline__ void attn_unit(Frame& F, int l, int b, int kvh, int qi, int is_ctx) {
    const bf16* P = (const bf16*)(F.ws + WS_P); bf16* CC = (bf16*)(F.ws + WS_CC);
    int lane_o = F.lane; asm volatile("" : "+v"(lane_o));
    const int g = F.wave >> 1, qh = F.wave & 1, hq = kvh * 4 + g, r32 = lane_o & 31, hi = lane_o >> 5;
    const int rowbase = is_ctx ? NLAT + b * CTXL : b * SEQ;
    const int qa = qi * 128 + qh * 64;
    const float LOG2E = 1.4426950408889634f;
    bf16x8 qf[2][4];
#pragma unroll
    for (int qt = 0; qt < 2; ++qt) { const int tq = qa + 32 * qt + r32; const bf16* qp = P + (size_t)(rowbase + tq) * PW + PC_Q + hq * 64 + 8 * hi;
        float x[4][8];
#pragma unroll
        for (int s = 0; s < 4; ++s) { const v4u w = *(const v4u*)(qp + 16 * s); x[s][0] = bflo(w.x); x[s][1] = bfhi(w.x); x[s][2] = bflo(w.y); x[s][3] = bfhi(w.y); x[s][4] = bflo(w.z); x[s][5] = bfhi(w.z); x[s][6] = bflo(w.w); x[s][7] = bfhi(w.w); }
        if (!is_ctx) {
#pragma unroll
            for (int hf = 0; hf < 2; ++hf) { const float pos = (float)(hf ? (tq & 63) : (tq >> 6));
#pragma unroll
                for (int j = 0; j < 8; ++j) { const float inv = __builtin_amdgcn_exp2f(-(float)(8 * hi + j) * 0.8304820237218406f); const float sn = __sinf(pos * inv), cs = __cosf(pos * inv);
                    const float x1 = x[2 * hf][j], x2 = x[2 * hf + 1][j]; x[2 * hf][j] = x1 * cs - x2 * sn; x[2 * hf + 1][j] = x2 * cs + x1 * sn; } } }
        const float sc = 0.125f * LOG2E;
#pragma unroll
        for (int s = 0; s < 4; ++s) { v4u w; w.x = pk2(x[s][0] * sc, x[s][1] * sc); w.y = pk2(x[s][2] * sc, x[s][3] * sc); w.z = pk2(x[s][4] * sc, x[s][5] * sc); w.w = pk2(x[s][6] * sc, x[s][7] * sc); qf[qt][s] = __builtin_bit_cast(bf16x8, w); }
    }
    float mrun[2], lrun[2]; f32x16 O[2][2];
    { const float sk = F.in[I_SINK][l * 16 + hq] * LOG2E;
#pragma unroll
      for (int qt = 0; qt < 2; ++qt) { mrun[qt] = sk; lrun[qt] = hi ? 0.f : 1.f;
#pragma unroll
        for (int db = 0; db < 2; ++db)
#pragma unroll
            for (int r = 0; r < 16; ++r) O[qt][db][r] = 0.f; } }
    const int ntl = is_ctx ? 0 : 6;
#pragma unroll 1
    for (int kt = 0; kt < ntl + 4; ++kt) {
        const bool local = kt < ntl; const int k0 = local ? 128 * (qi - 1) + 64 * kt : 64 * (kt - ntl);
        if (local && (k0 < 0 || k0 >= SEQ)) continue;
        __syncthreads();
        { const int rr = F.tid >> 3, c = F.tid & 7;
          const bf16* ksrc = P + (size_t)((local ? b * SEQ : NLAT + b * CTXL) + k0 + rr) * PW + PC_K + kvh * 64 + c * 8;
          const bf16* vsrc = local ? (const bf16*)(F.ws + WS_VT) + ((size_t)(b * 4 + kvh) * 64 + rr) * SEQ + k0 + c * 8 : (const bf16*)(F.ws + WS_VTC) + ((size_t)(b * 4 + kvh) * 64 + rr) * CTXL + k0 + c * 8;
          const v4u kw = *(const v4u*)ksrc, vw = *(const v4u*)vsrc;
          *(LAS v4u*)(F.lds + AT_KOFF + rr * AT_KP + c * 16) = kw;
          LAS v2u* vd = (LAS v2u*)(F.lds + AT_VOFF + rr * AT_VP + c * 16); vd[0] = (v2u){vw.x, vw.y}; vd[1] = (v2u){vw.z, vw.w}; }
        __syncthreads();
        if (local && (k0 + 63 < qa - 128 || k0 > qa + 63 + 128)) continue;
#pragma unroll 1
        for (int kb = 0; kb < 2; ++kb) {
            bf16x8 kf[4];
#pragma unroll
            for (int ss = 0; ss < 4; ++ss) kf[ss] = *(const LAS bf16x8*)(F.lds + AT_KOFF + (32 * kb + r32) * AT_KP + (16 * ss + 8 * hi) * 2);
            bf16x8 pb[2][2];
#pragma unroll
            for (int qt = 0; qt < 2; ++qt) { const int tq = qa + 32 * qt + r32;
                f32x16 s;
#pragma unroll
                for (int r = 0; r < 16; ++r) s[r] = 0.f;
#pragma unroll
                for (int ss = 0; ss < 4; ++ss) s = __builtin_amdgcn_mfma_f32_32x32x16_bf16(kf[ss], qf[qt][ss], s, 0, 0, 0);
                if (local) {
#pragma unroll
                    for (int r = 0; r < 16; ++r) { const int kidx = k0 + 32 * kb + (r & 3) + 8 * (r >> 2) + 4 * hi; const int dlt = kidx - tq; if (dlt > 128 || dlt < -128) s[r] = -1.0e30f; } }
                float mloc = s[0];
#pragma unroll
                for (int r = 1; r < 16; ++r) mloc = fmaxf(mloc, s[r]);
                mloc = fmaxf(mloc, __shfl_xor(mloc, 32));
                const float mnew = fmaxf(mrun[qt], mloc), alpha = __builtin_amdgcn_exp2f(mrun[qt] - mnew); mrun[qt] = mnew;
                float psum = 0.f;
#pragma unroll
                for (int r = 0; r < 16; ++r) { s[r] = __builtin_amdgcn_exp2f(s[r] - mnew); psum += s[r]; }
                lrun[qt] = lrun[qt] * alpha + psum;
#pragma unroll
                for (int db = 0; db < 2; ++db)
#pragma unroll
                    for (int r = 0; r < 16; ++r) O[qt][db][r] *= alpha;
#pragma unroll
                for (int s2 = 0; s2 < 2; ++s2) { v4u pw; pw.x = pk2(s[8 * s2 + 0], s[8 * s2 + 1]); pw.y = pk2(s[8 * s2 + 2], s[8 * s2 + 3]); pw.z = pk2(s[8 * s2 + 4], s[8 * s2 + 5]); pw.w = pk2(s[8 * s2 + 6], s[8 * s2 + 7]);
                    pb[qt][s2] = __builtin_bit_cast(bf16x8, pw); }
            }
#pragma unroll
            for (int s2 = 0; s2 < 2; ++s2)
#pragma unroll
                for (int db = 0; db < 2; ++db) { const LAS v2u* vp = (const LAS v2u*)(F.lds + AT_VOFF + (32 * db + r32) * AT_VP + (32 * kb + 16 * s2 + 4 * hi) * 2);
                    const v2u a0 = vp[0], a1 = vp[2]; v4u aw; aw.x = a0.x; aw.y = a0.y; aw.z = a1.x; aw.w = a1.y; const bf16x8 va = __builtin_bit_cast(bf16x8, aw);
                    O[0][db] = __builtin_amdgcn_mfma_f32_32x32x16_bf16(va, pb[0][s2], O[0][db], 0, 0, 0);
                    O[1][db] = __builtin_amdgcn_mfma_f32_32x32x16_bf16(va, pb[1][s2], O[1][db], 0, 0, 0); }
        }
    }
    int r32e = r32, hie = hi; asm volatile("" : "+v"(r32e), "+v"(hie));
#pragma unroll
    for (int qt = 0; qt < 2; ++qt) { const float lt = lrun[qt] + __shfl_xor(lrun[qt], 32); const float rl = 1.0f / lt; const int tq = qa + 32 * qt + r32e;
        bf16* op = CC + (size_t)(rowbase + tq) * DM + hq * 64 + 4 * hie;
#pragma unroll
        for (int db = 0; db < 2; ++db)
#pragma unroll
            for (int rq = 0; rq < 4; ++rq) { v2u w; w.x = pk2(O[qt][db][4 * rq] * rl, O[qt][db][4 * rq + 1] * rl); w.y = pk2(O[qt][db][4 * rq + 2] * rl, O[qt][db][4 * rq + 3] * rl);
                *(v2u*)(op + 32 * db + 8 * rq) = w; } }
}
__device__ __forceinline__ void attn_phase(Frame& F, int l) {
    const int nunits = 512 + (l == 0 ? 32 : 0);
    LAS int* slot = (LAS int*)(F.lds + LDS_X_OFF + 512);
    for (;;) {
        __syncthreads();
        if (F.tid == 0) *slot = (int)__hip_atomic_fetch_add(F.ctl + CW_ATQ + 64 * l, 1u, RLX_AGENT);
        __syncthreads();
        const int u = __builtin_amdgcn_readfirstlane(*slot);
        if (u >= nunits) break;
        if (u < 512) attn_unit(F, l, u >> 7, (u >> 5) & 3, u & 31, 0); else { const int v = u - 512; attn_unit(F, l, v >> 3, (v >> 1) & 3, v & 1, 1); }
    }
}

constexpr size_t WS_DNQ = WS_DNT;
constexpr size_t WS_BG = WS_DNS + 1 * MiB;
constexpr size_t WS_XC = WS_XS;
__device__ __forceinline__ void seq_of(int m, int& t, int& T, int& base) { if (m < NLAT) { t = m & 4095; T = SEQ; base = m - t; } else { t = (m - NLAT) & 255; T = CTXL; base = m - t; } }
__device__ __forceinline__ float gelu_tanh(float x) { const float u = 0.7978845608028654f * (x + 0.044715f * x * x * x); return 0.5f * x * (1.0f + tanhf(u)); }

__device__ __forceinline__ void naive_prep(Frame& F, int l) {
    const bf16* P = (const bf16*)(F.ws + WS_P);
    const int gw = F.bid * NWAVES + F.wave, NGW = F.G * NWAVES;
    {
        float* DNQ = (float*)(F.ws + WS_DNQ); float* BG = (float*)(F.ws + WS_BG);
        const float* cw = F.in[I_DNCW] + (size_t)l * 4 * 1536;
        for (int it = gw; it < NTOK * 4; it += NGW) {
            const int m = it >> 2, h = it & 3; int t, T, base; seq_of(m, t, T, base);
            float val[3][2];
#pragma unroll
            for (int part = 0; part < 3; ++part)
#pragma unroll
                for (int dd = 0; dd < 2; ++dd) { const int d = F.lane + 64 * dd, cch = part * 512 + h * 128 + d, col = PC_DQ + cch; float s = 0.f;
#pragma unroll
                    for (int j = 0; j < 4; ++j) { const int tt = t + j - 2; if (tt >= 0 && tt < T) s += cw[j * 1536 + cch] * bf2f(P[(size_t)(base + tt) * PW + col]); }
                    val[part][dd] = siluf_(s); }
            const float sq = wave_sum(val[0][0] * val[0][0] + val[0][1] * val[0][1]), sk = wave_sum(val[1][0] * val[1][0] + val[1][1] * val[1][1]);
            const float fq = 0.08838834764831845f / sqrtf(sq + EPS), fk = 1.0f / sqrtf(sk + EPS);
#pragma unroll
            for (int dd = 0; dd < 2; ++dd) { const int d = F.lane + 64 * dd; float* o = DNQ + (size_t)m * 1536 + h * 128 + d;
                o[0] = val[0][dd] * fq; o[512] = val[1][dd] * fk; o[1024] = val[2][dd]; }
            if (h == 0 && F.lane < 8) { const int dir = F.lane >> 2, hh = F.lane & 3;
                const float pb = bf2f(P[(size_t)m * PW + PC_BETA + F.lane]), pa = bf2f(P[(size_t)m * PW + PC_DEC + F.lane]);
                BG[m * 16 + F.lane] = sigmoidf_(pb);
                BG[m * 16 + 8 + F.lane] = -__expf(F.in[I_DNALOG][l * 8 + dir * 4 + hh]) * softplusf_(pa + F.in[I_DNDT][l * 8 + dir * 4 + hh]); }
        }
    }
    {
        LAS float* xc = (LAS float*)F.lds;
        float* A = (float*)(F.ws + WS_LRA); float* U = (float*)(F.ws + WS_LRH);
        const float* cw = F.in[I_LRCW] + (size_t)l * 4 * 512; const float* cb = F.in[I_LRCB] + l * 512;
        for (int m0 = F.bid * 8; m0 < NTOK; m0 += F.G * 8) {
            __syncthreads();
            for (int i = F.tid; i < 8 * 512; i += NTHREADS) { const int m = m0 + (i >> 9), ch = i & 511; int t, T, base; seq_of(m, t, T, base); float s = cb[ch];
#pragma unroll
                for (int j = 0; j < 4; ++j) { const int tt = t + j - 2; if (tt >= 0 && tt < T) s += cw[j * 512 + ch] * bf2f(P[(size_t)(base + tt) * PW + PC_LX + ch]); }
                xc[i] = s; }
            __syncthreads();
            for (int i = F.tid; i < 8 * 512 * 2; i += NTHREADS) { const int ch = i & 511, dir = (i >> 9) & 1, tk = i >> 10, m = m0 + tk, blk = ch >> 6, j = ch & 63;
                const float* wr = F.in[I_LRWR] + ((size_t)((l * 2 + dir) * 8 + blk)) * 4096 + j; const float* wi = F.in[I_LRWI] + ((size_t)((l * 2 + dir) * 8 + blk)) * 4096 + j;
                float sr = F.in[I_LRBR][(l * 2 + dir) * 512 + ch], si = F.in[I_LRBI][(l * 2 + dir) * 512 + ch];
#pragma unroll 8
                for (int ii = 0; ii < 64; ++ii) { const float x = xc[tk * 512 + blk * 64 + ii]; sr += x * wr[ii * 64]; si += x * wi[ii * 64]; }
                const float r = sigmoidf_(sr), ig = sigmoidf_(si); const float lam = F.in[I_LRLAM][(l * 2 + dir) * 512 + ch];
                const float logsig = -softplusf_(-lam);
                const float log_a = 8.0f * r * logsig; const float a = __expf(log_a);
                const float u = sqrtf(-expm1f(2.0f * log_a)) * (ig * xc[tk * 512 + ch]);
                A[((size_t)dir * NTOK + m) * 512 + ch] = a; U[((size_t)dir * NTOK + m) * 512 + ch] = u; }
        }
        __syncthreads();
    }
}

__device__ __forceinline__ void naive_attn_row(Frame& F, int l, int m, int hq) {
    const bf16* P = (const bf16*)(F.ws + WS_P); bf16* CC = (bf16*)(F.ws + WS_CC);
    const int d = F.lane, kvh = hq >> 2; int t, T, base; seq_of(m, t, T, base);
    const bool lat = m < NLAT; const int b = lat ? (m >> 12) : ((m - NLAT) >> 8);
    const int dd = d & 31, jf = dd & 15; const float inv = __powf(10000.0f, -(float)jf * (1.0f / 16.0f));
    const bool second = (dd >= 16), colhalf = (d >= 32);
    float q = bf2f(P[(size_t)m * PW + PC_Q + hq * 64 + d]);
    if (lat) { const float pos = (float)(colhalf ? (t & 63) : (t >> 6)); float sn, cs; sincosf(pos * inv, &sn, &cs); const float pr = __shfl_xor(q, 16); q = second ? (q * cs + pr * sn) : (q * cs - pr * sn); }
    q *= 0.125f;
    float mx = F.in[I_SINK][l * 16 + hq], den = 1.0f, acc = 0.f;
    if (lat) { const int t0 = t - 128 < 0 ? 0 : t - 128, t1 = t + 128 > SEQ - 1 ? SEQ - 1 : t + 128;
        for (int tk = t0; tk <= t1; ++tk) { const size_t r = (size_t)(base + tk) * PW; float k = bf2f(P[r + PC_K + kvh * 64 + d]); const float v = bf2f(P[r + PC_V + kvh * 64 + d]);
            const float pos = (float)(colhalf ? (tk & 63) : (tk >> 6)); float sn, cs; sincosf(pos * inv, &sn, &cs); const float pr = __shfl_xor(k, 16); k = second ? (k * cs + pr * sn) : (k * cs - pr * sn);
            const float s = wave_sum(q * k); const float mn = fmaxf(mx, s), f = __expf(mx - mn), p = __expf(s - mn); den = den * f + p; acc = acc * f + p * v; mx = mn; } }
    for (int c = 0; c < CTXL; ++c) { const size_t r = (size_t)(NLAT + b * CTXL + c) * PW; const float k = bf2f(P[r + PC_K + kvh * 64 + d]), v = bf2f(P[r + PC_V + kvh * 64 + d]);
        const float s = wave_sum(q * k); const float mn = fmaxf(mx, s), f = __expf(mx - mn), p = __expf(s - mn); den = den * f + p; acc = acc * f + p * v; mx = mn; }
    CC[(size_t)m * DM + hq * 64 + d] = (bf16)f2bf(acc / den);
}

__device__ __forceinline__ int scan_row(int n, int b, int dir) { if (n < CTXL) { const int t = dir ? (CTXL - 1 - n) : n; return NLAT + b * CTXL + t; } const int t = dir ? (SEQ - 1 - (n - CTXL)) : (n - CTXL); return b * SEQ + t; }
__device__ __forceinline__ void naive_scan(Frame& F, int l) {
    if (F.bid < 32) {
        const int b = F.bid >> 3, h = (F.bid >> 1) & 3, dir = F.bid & 1, dvc = F.tid & 127, kq = F.tid >> 7;
        const float* DNQ = (const float*)(F.ws + WS_DNQ); const float* BG = (const float*)(F.ws + WS_BG); float* O = (float*)(F.ws + WS_DNO);
        LAS float* buf = (LAS float*)F.lds;
        LAS float* red = buf + 768;
        LAS float* red2 = red + 512;
        float S[32];
#pragma unroll
        for (int i = 0; i < 32; ++i) S[i] = 0.f;
        constexpr int NT = CTXL + SEQ;
        { const int m = scan_row(0, b, dir); if (F.tid < 384) buf[F.tid] = DNQ[(size_t)m * 1536 + (F.tid >> 7) * 512 + h * 128 + (F.tid & 127)]; }
        __syncthreads();
#pragma unroll 1
        for (int n = 0; n < NT; ++n) {
            const int m = scan_row(n, b, dir); const LAS float* cur = buf + (n & 1) * 384;
            float nextv = 0.f; if (n + 1 < NT && F.tid < 384) { const int m2 = scan_row(n + 1, b, dir); nextv = DNQ[(size_t)m2 * 1536 + (F.tid >> 7) * 512 + h * 128 + (F.tid & 127)]; }
            const float beta = BG[m * 16 + dir * 4 + h], decay = __expf(BG[m * 16 + 8 + dir * 4 + h]);
            float ks = 0.f;
#pragma unroll
            for (int i = 0; i < 32; ++i) ks += cur[128 + kq * 32 + i] * S[i];
            red[kq * 128 + dvc] = ks;
            __syncthreads();
            const float kS = (red[dvc] + red[128 + dvc]) + (red[256 + dvc] + red[384 + dvc]);
            const float upd = beta * (cur[256 + dvc] - decay * kS);
            float os = 0.f;
#pragma unroll
            for (int i = 0; i < 32; ++i) { S[i] = decay * S[i] + cur[128 + kq * 32 + i] * upd; os += cur[kq * 32 + i] * S[i]; }
            red2[kq * 128 + dvc] = os;
            if (F.tid < 384) buf[((n + 1) & 1) * 384 + F.tid] = nextv;
            __syncthreads();
            if (kq == 0) O[((size_t)dir * NTOK + m) * 512 + h * 128 + dvc] = (red2[dvc] + red2[128 + dvc]) + (red2[256 + dvc] + red2[384 + dvc]);
        }
    }
    else if (F.bid < 40) {
        const int idx = (F.bid - 32) * NTHREADS + F.tid, ch = idx & 511, dir = (idx >> 9) & 1, b = idx >> 10;
        const float* A = (const float*)(F.ws + WS_LRA); float* U = (float*)(F.ws + WS_LRH);
        float hs = 0.f;
#pragma unroll 4
        for (int n = 0; n < CTXL + SEQ; ++n) { int m; if (n < CTXL) { const int t = dir ? (CTXL - 1 - n) : n; m = NLAT + b * CTXL + t; } else { const int t = dir ? (SEQ - 1 - (n - CTXL)) : (n - CTXL); m = b * SEQ + t; }
            const size_t o = ((size_t)dir * NTOK + m) * 512 + ch; hs = A[o] * hs + U[o]; U[o] = hs; }
    }
#if defined(USE_MFMA_ATTN)
    attn_phase(F, l);
#else
    {
        const int nrows = (l == 0) ? NTOK : NLAT;
        for (;;) { int m = 0; if (F.lane == 0) m = (int)__hip_atomic_fetch_add(F.ctl + CW_ATQ + 64 * l, 1u, RLX_AGENT); m = __builtin_amdgcn_readfirstlane(m);
            if (m >= nrows) break;
#pragma unroll 1
            for (int hq = 0; hq < 16; ++hq) naive_attn_row(F, l, m, hq); }
    }
#endif
}

__device__ __forceinline__ void naive_fin(Frame& F, int l) {
    const int nrows = (l == 0) ? NTOK : NLAT;
    const bf16* P = (const bf16*)(F.ws + WS_P); bf16* CC = (bf16*)(F.ws + WS_CC);
    const int gw = F.bid * NWAVES + F.wave, NGW = F.G * NWAVES;
    const float* O = (const float*)(F.ws + WS_DNO); const float* HS = (const float*)(F.ws + WS_LRH);
    for (int it = gw; it < nrows * 4; it += NGW) { const int m = it >> 2, h = it & 3; float o[2];
#pragma unroll
        for (int dd = 0; dd < 2; ++dd) { const int c = h * 128 + F.lane + 64 * dd; o[dd] = O[(size_t)m * 512 + c] + O[((size_t)NTOK + m) * 512 + c]; }
        const float rstd = 1.0f / sqrtf(wave_sum(o[0] * o[0] + o[1] * o[1]) * (1.0f / 128.0f) + EPS);
#pragma unroll
        for (int dd = 0; dd < 2; ++dd) { const int d = F.lane + 64 * dd; const float gt = bf2f(P[(size_t)m * PW + PC_DG + h * 128 + d]);
            CC[(size_t)m * DM + 1024 + h * 128 + d] = (bf16)f2bf(o[dd] * rstd * F.in[I_DNNG][l * 128 + d] * siluf_(gt)); }
    }
    for (size_t i = (size_t)F.bid * NTHREADS + F.tid; i < (size_t)nrows * 512; i += (size_t)F.G * NTHREADS) { const int m = (int)(i >> 9), ch = (int)(i & 511);
        const float hsum = HS[(size_t)m * 512 + ch] + HS[((size_t)NTOK + m) * 512 + ch]; const float y = bf2f(P[(size_t)m * PW + PC_LY + ch]);
        CC[(size_t)m * DM + 1536 + ch] = (bf16)f2bf(hsum * gelu_tanh(y)); }
}
#ifndef PHASE_PREP
#if defined(USE_MFMA_ATTN)
#define PHASE_PREP(F, l) do { naive_prep(F, l); attn_prep(F, l); } while (0)
#else
#define PHASE_PREP(F, l) naive_prep(F, l)
#endif
#endif
#ifndef PHASE_SCAN
#define PHASE_SCAN(F, l) naive_scan(F, l)
#endif
#ifndef PHASE_FIN
#define PHASE_FIN(F, l) naive_fin(F, l)
#endif

#ifndef PHASE_INPROJ
#define PHASE_INPROJ(F, l) do {} while (0)
#endif
#ifndef PHASE_PREP
#define PHASE_PREP(F, l) do {} while (0)
#endif
#ifndef PHASE_SCAN
#define PHASE_SCAN(F, l) do {} while (0)
#endif
#ifndef PHASE_FIN
#define PHASE_FIN(F, l) do {} while (0)
#endif
#ifndef PHASE_OUTPROJ
#define PHASE_OUTPROJ(F, l) do {} while (0)
#endif
#ifndef PHASE_NORM2
#define PHASE_NORM2(F, l) do {} while (0)
#endif
#ifndef PHASE_SCATTER
#define PHASE_SCATTER(F, l) do {} while (0)
#endif
#ifndef PHASE_GEMM1
#define PHASE_GEMM1(F, l) do {} while (0)
#endif
#ifndef PHASE_GEMM2
#define PHASE_GEMM2(F, l) do {} while (0)
#endif

#ifndef MK_SPLIT
#define MK_SPLIT 0
#endif
#ifndef MK_STAGE
#define MK_STAGE 99
#endif
constexpr int N_PHASES = 22;
struct Args { const float* in[N_IN]; float* out; unsigned char* ws; int ph_lo, ph_hi; };
static_assert(sizeof(Args) == (N_IN + 2) * 8 + 8, "Args has no padding");

__global__ void __launch_bounds__(NTHREADS, 2) fwd_kernel(Args args) {
    extern __shared__ __attribute__((aligned(16))) unsigned char lds[];
    Frame F;
    F.lds = (LAS unsigned char*)lds;
    F.MISC = (volatile LAS unsigned*)(F.lds + MISC_OFF);
    F.tid = threadIdx.x; F.lane = F.tid & 63; F.wave = __builtin_amdgcn_readfirstlane(F.tid >> 6);
    F.G = gridDim.x; F.bid = blockIdx.x;
    F.ws = args.ws; F.out = args.out; F.ctl = (gu32*)(args.ws + WS_CTL);
    F.in = (const float* const __attribute__((address_space(4)))*)__builtin_amdgcn_kernarg_segment_ptr();
    for (int u = F.tid; u < (LDS_BYTES - LDSCTL_OFF) / 4; u += NTHREADS) ((LAS unsigned*)(F.lds + LDSCTL_OFF))[u] = 0u;
    __syncthreads();
    XcdBarrier bar; bar.bar = (unsigned*)(F.ctl + CW_BAR); bar.x = 0; bar.st = nullptr;
    if (!MK_SPLIT) bar = xcd_barrier_post((unsigned*)(F.ctl + CW_BAR), F.MISC + 8);
    const int lo = args.ph_lo, hi = args.ph_hi;
#define IN(k) (lo <= (k) && (k) < hi && phase_enter(F))
#define INR(k) (lo <= (k) && (k) < hi)
#define SEAM(k) do { if (INR(k) && INR((k) + 1)) xcd_barrier(bar); } while (0)

    if (IN(0)) { p0_prologue(F); } SEAM(0);
#pragma unroll 1
    for (int l = 0; l < DEPTH; ++l) {
        const int pb = 1 + 10 * l;
        if (IN(pb + 0)) { phase_norm1(F, l); } SEAM(pb + 0);
        if (IN(pb + 1)) { PHASE_INPROJ(F, l); } SEAM(pb + 1);
        if (IN(pb + 2)) { PHASE_PREP(F, l); } SEAM(pb + 2);
        if (IN(pb + 3)) { PHASE_SCAN(F, l); } SEAM(pb + 3);
        if (IN(pb + 4)) { PHASE_FIN(F, l); } SEAM(pb + 4);
        if (IN(pb + 5)) { PHASE_OUTPROJ(F, l); } SEAM(pb + 5);
        if (IN(pb + 6)) { PHASE_NORM2(F, l); } SEAM(pb + 6);
        if (IN(pb + 7)) { PHASE_SCATTER(F, l); } SEAM(pb + 7);
        if (IN(pb + 8)) { PHASE_GEMM1(F, l); } SEAM(pb + 8);
        if (IN(pb + 9)) { PHASE_GEMM2(F, l); } SEAM(pb + 9);
    }
    if (IN(21)) { phase_final(F, MK_STAGE >= 9); }
#undef IN
#undef SEAM
}

extern "C" void kernel_launch(void* const* d_in, const int* in_sizes, int n_in, void* d_out, int out_size, void* d_ws, size_t ws_size, hipStream_t stream) {
    static int grid = 0;
    if (grid == 0) {
        if (n_in != N_IN || out_size != NLAT * DM || ws_size < WS_END) { fprintf(stderr, "kernel_launch: unexpected shapes (n_in %d, out %d, ws %zu); nothing launched\n", n_in, out_size, ws_size); grid = -1; return; }
        int dev = 0, cus = 0, per_cu = 0;
        if (hipGetDevice(&dev) != hipSuccess || hipDeviceGetAttribute(&cus, hipDeviceAttributeMultiprocessorCount, dev) != hipSuccess) { grid = -1; return; }
        if (hipFuncSetAttribute((const void*)fwd_kernel, hipFuncAttributeMaxDynamicSharedMemorySize, LDS_BYTES) != hipSuccess) { fprintf(stderr, "kernel_launch: hipFuncSetAttribute failed\n"); grid = -1; return; }
        if (hipOccupancyMaxActiveBlocksPerMultiprocessor(&per_cu, (const void*)fwd_kernel, NTHREADS, LDS_BYTES) != hipSuccess || per_cu < 1) { fprintf(stderr, "kernel_launch: occupancy query says %d\n", per_cu); }
        (void)hipGetLastError();
        grid = cus;
        if (grid != 256) { fprintf(stderr, "kernel_launch: built for 256 CUs, device has %d; nothing launched\n", cus); grid = -1; return; }
    }
    if (grid < 0) return;
    if (hipMemsetAsync((char*)d_ws + WS_CTL, 0, CTL_ZERO_BYTES, stream) != hipSuccess) return;
    Args a{};
    for (int i = 0; i < N_IN; ++i) a.in[i] = (const float*)d_in[i];
    a.out = (float*)d_out; a.ws = (unsigned char*)d_ws;
#if MK_SPLIT
    for (int p = 0; p < N_PHASES; ++p) { a.ph_lo = p; a.ph_hi = p + 1; hipLaunchKernelGGL(fwd_kernel, dim3(grid), dim3(NTHREADS), LDS_BYTES, stream, a); }
#else
    a.ph_lo = 0; a.ph_hi = N_PHASES;
    hipLaunchKernelGGL(fwd_kernel, dim3(grid), dim3(NTHREADS), LDS_BYTES, stream, a);
#endif
    const hipError_t le = hipPeekAtLastError();
    if (le != hipSuccess) fprintf(stderr, "kernel_launch: launch failed: %s\n", hipGetErrorName(le));
}
```

```cpp
#include <hip/hip_runtime.h>
#include <cstdio>
#include <cstdint>

constexpr int DM = 2048, NB = 4, SEQ = 4096, CTXL = 256, DEPTH = 2;
constexpr int NLAT = NB * SEQ, NCTX = NB * CTXL, NTOK = NLAT + NCTX;
constexpr int NCT = NTOK / 64;
constexpr int IN_W = 4624, PW = 4864;
constexpr int PC_Q = 0, PC_K = 1024, PC_V = 1280, PC_DQ = 1536, PC_DK = 2048, PC_DV = 2560, PC_DG = 3072, PC_LX = 3584, PC_LY = 4096, PC_BETA = 4608, PC_DEC = 4616;
constexpr int NEXP = 32, TOPK = 4, DEXP = 1024;
constexpr int MOE_ROWS = 304 * 256;
constexpr float EPS = 1e-6f;
#ifndef MK_STAGE
#define MK_STAGE 99
#endif
namespace pg8 {
#define PG8_LAS __attribute__((address_space(3)))
typedef unsigned short bf16_t;
typedef short bf16x8 __attribute__((ext_vector_type(8)));
typedef float f32x4 __attribute__((ext_vector_type(4)));
typedef unsigned u32x4 __attribute__((ext_vector_type(4)));
typedef float f32x2 __attribute__((ext_vector_type(2)));
constexpr int BM = 256, BK = 64, HALF = 128, HTB = HALF * BK * 2  , STAGE_BYTES = 8 * HTB, NXCD = 8, WGM = 8;

__host__ __device__ __forceinline__ int lds_byte(int r, int c) { const int st = (r >> 4) * 2 + (c >> 5), rr = r & 15, cc = c & 31, ob = rr * 64 + cc * 2; return st * 1024 + (ob ^ (((ob >> 9) & 1) << 5)); }
__host__ __device__ __forceinline__ void stage_rc(int b, int& R, int& C) { const int st = b / 1024, sb = b % 1024, swz = sb ^ (((sb >> 9) & 1) << 5); R = (st >> 1) * 16 + swz / 64; C = (st & 1) * 32 + (swz % 64) / 2; }
__host__ __device__ __forceinline__ int perm32(int rho) { const int n = rho >> 4, i = rho & 15; return 8 * (i >> 2) + 4 * n + (i & 3); }

struct Unit { int pm, pn, e; };
struct Gemm { const bf16_t* A; const bf16_t* Bt; int M, N, K; };

struct StaticOrder {
    int nM, nN, nwg, G, c; const char* A; const char* Bt; size_t tstep;
    __device__ void init(const Gemm& g, int G_, int c_) { nM = g.M / BM; nN = g.N / BM; nwg = nM * nN; G = G_; c = c_; A = (const char*)g.A; Bt = (const char*)g.Bt; tstep = (size_t)BM * g.K * 2; }
    __device__ bool next(int i, Unit& u) const {
        const long L = (long)i * G + c; if (L >= nwg) return false;
        int wgid = (int)L; { const int q = nwg / NXCD, r = nwg % NXCD, xcd = wgid % NXCD, off = wgid / NXCD; wgid = (xcd < r ? xcd * (q + 1) : r * (q + 1) + (xcd - r) * q) + off; }
        const int nig = WGM * nN, gid = wgid / nig, fm = gid * WGM, gsz = (nM - fm) < WGM ? (nM - fm) : WGM;
        u.pm = fm + ((wgid % nig) % gsz); u.pn = (wgid % nig) / gsz; u.e = 0; return true;
    }
    __device__ __forceinline__ const char* a_ptr(const Unit& u) const { return A + (size_t)u.pm * tstep; }
    __device__ __forceinline__ const char* b_ptr(const Unit& u) const { return Bt + (size_t)u.pn * tstep; }
    __device__ __forceinline__ void a_ready(const Unit&) const {}
    __device__ __forceinline__ void done(const Unit&) const {}
};
__device__ __forceinline__ unsigned cvt_pk_bf16(float lo, float hi) { unsigned r; asm volatile("v_cvt_pk_bf16_f32 %0, %1, %2" : "=v"(r) : "v"(lo), "v"(hi)); return r; }
struct EpiBf16Plain {
    static constexpr bool PERM = true, AFTER_DRAIN = false;
    bf16_t* O; int ldc;
    __device__ __forceinline__ void operator()(const f32x4 (&acc)[2][2][4][2], const Unit& u, int wr, int wc, int fr, int fq) const {
        const int row0 = u.pm * BM + wr * 64 + fr, col0 = u.pn * BM + wc * 32 + 8 * fq;
#pragma unroll
        for (int ai = 0; ai < 2; ++ai)
#pragma unroll
            for (int m = 0; m < 4; ++m) { bf16_t* rowp = O + (size_t)(row0 + ai * HALF + m * 16) * ldc + col0;
#pragma unroll
                for (int bj = 0; bj < 2; ++bj) { const f32x4 v0 = acc[ai][bj][m][0], v1 = acc[ai][bj][m][1];
                    u32x4 w; w.x = cvt_pk_bf16(v0[0], v0[1]); w.y = cvt_pk_bf16(v0[2], v0[3]); w.z = cvt_pk_bf16(v1[0], v1[1]); w.w = cvt_pk_bf16(v1[2], v1[3]);
                    *(u32x4*)(rowp + bj * HALF) = w; } }
    }
};
struct EpiResGate {
    static constexpr bool PERM = false, AFTER_DRAIN = false;
    const float* base_lat; const float* base_ctx; float* out; const float* modg;
    __device__ __forceinline__ void operator()(const f32x4 (&acc)[2][2][4][2], const Unit& u, int wr, int wc, int fr, int fq) const {
        const int r = u.pm < 64 ? (u.pm >> 4) : 4; const int col0 = u.pn * BM + wc * 32 + 4 * fq;
        const float* g = modg + (size_t)r * 12288 + col0;
        f32x4 gv[2][2];
#pragma unroll
        for (int bj = 0; bj < 2; ++bj)
#pragma unroll
            for (int n = 0; n < 2; ++n) gv[bj][n] = *(const f32x4*)(g + bj * HALF + n * 16);
#pragma unroll
        for (int ai = 0; ai < 2; ++ai)
#pragma unroll
            for (int m = 0; m < 4; ++m) { const int row = u.pm * BM + ai * HALF + wr * 64 + m * 16 + fr;
                const float* bp = (row < 16384 ? base_lat + (size_t)row * 2048 : base_ctx + (size_t)(row - 16384) * 2048) + col0; float* op = out + (size_t)row * 2048 + col0;
#pragma unroll
                for (int bj = 0; bj < 2; ++bj)
#pragma unroll
                    for (int n = 0; n < 2; ++n) { const f32x4 b = *(const f32x4*)(bp + bj * HALF + n * 16); *(f32x4*)(op + bj * HALF + n * 16) = b + gv[bj][n] * acc[ai][bj][m][n]; }
                asm volatile("" ::: "memory"); }
    }
};
struct EpiSwiglu {
    static constexpr bool PERM = true, AFTER_DRAIN = false;
    bf16_t* O; const float* bgu;
    __device__ __forceinline__ void operator()(const f32x4 (&acc)[2][2][4][2], const Unit& u, int wr, int wc, int fr, int fq) const {
        const int row0 = u.pm * BM + wr * 64 + fr, cc0 = wc * 32 + 8 * fq;
        const float* bg = bgu + (size_t)u.e * 2048 + u.pn * 128 + cc0;
        f32x4 bglu[2], blin[2];
#pragma unroll
        for (int n = 0; n < 2; ++n) { bglu[n] = *(const f32x4*)(bg + 4 * n); blin[n] = *(const f32x4*)(bg + 1024 + 4 * n); }
#pragma unroll
        for (int ai = 0; ai < 2; ++ai)
#pragma unroll
            for (int m = 0; m < 4; ++m) { bf16_t* rowp = O + (size_t)(row0 + ai * HALF + m * 16) * 1024 + u.pn * 128 + cc0;
                float r[8];
#pragma unroll
                for (int n = 0; n < 2; ++n) { const f32x4 g = acc[ai][0][m][n] + bglu[n], l = acc[ai][1][m][n] + blin[n];
#pragma unroll
                    for (int i = 0; i < 4; ++i) { const float gg = fminf(g[i], 7.0f); const float ll = fminf(fmaxf(l[i], -7.0f), 7.0f);
                        r[4 * n + i] = (ll + 1.0f) * gg * (1.0f / (1.0f + __expf(-1.702f * gg))); } }
                u32x4 w; w.x = cvt_pk_bf16(r[0], r[1]); w.y = cvt_pk_bf16(r[2], r[3]); w.z = cvt_pk_bf16(r[4], r[5]); w.w = cvt_pk_bf16(r[6], r[7]);
                *(u32x4*)rowp = w; }
    }
};
struct EpiDown {
    static constexpr bool PERM = true, AFTER_DRAIN = false;
    bf16_t* O; const float* bdn; const float* rowg;
    __device__ __forceinline__ void operator()(const f32x4 (&acc)[2][2][4][2], const Unit& u, int wr, int wc, int fr, int fq) const {
        const int row0 = u.pm * BM + wr * 64 + fr, col0 = u.pn * BM + wc * 32 + 8 * fq;
        const float* bb = bdn + (size_t)u.e * 2048 + col0;
        f32x4 bv[2][2];
#pragma unroll
        for (int bj = 0; bj < 2; ++bj)
#pragma unroll
            for (int n = 0; n < 2; ++n) bv[bj][n] = *(const f32x4*)(bb + bj * HALF + 4 * n);
#pragma unroll
        for (int ai = 0; ai < 2; ++ai)
#pragma unroll
            for (int m = 0; m < 4; ++m) { const int row = row0 + ai * HALF + m * 16; const float gt = rowg[row]; bf16_t* rowp = O + (size_t)row * 2048 + col0;
#pragma unroll
                for (int bj = 0; bj < 2; ++bj) { const f32x4 v0 = (acc[ai][bj][m][0] + bv[bj][0]) * gt, v1 = (acc[ai][bj][m][1] + bv[bj][1]) * gt;
                    u32x4 w; w.x = cvt_pk_bf16(v0[0], v0[1]); w.y = cvt_pk_bf16(v0[2], v0[3]); w.z = cvt_pk_bf16(v1[0], v1[1]); w.w = cvt_pk_bf16(v1[2], v1[3]);
                    *(u32x4*)(rowp + bj * HALF) = w; } }
    }
};
struct MoeOrder {
    int c, nblk; const char* A; const char* Bt; size_t a_tstep, b_estep, b_tstep; const PG8_LAS int* blk_end;
    __device__ __forceinline__ bool next(int i, Unit& u) const {
        const int x = c & 7, j = c >> 3, gi = i * 8 + x, rb = 4 * gi + (j >> 3);
        if (rb >= nblk) return false;
        int e = 0;
        for (int k = 0; k < 31; ++k) e += (rb >= blk_end[k]) ? 1 : 0;
        u.pm = rb; u.pn = j & 7; u.e = __builtin_amdgcn_readfirstlane(e); return true;
    }
    __device__ __forceinline__ const char* a_ptr(const Unit& u) const { return A + (size_t)u.pm * a_tstep; }
    __device__ __forceinline__ const char* b_ptr(const Unit& u) const { return Bt + (size_t)u.e * b_estep + (size_t)u.pn * b_tstep; }
    __device__ __forceinline__ void a_ready(const Unit&) const {}
    __device__ __forceinline__ void done(const Unit&) const {}
};
template <class Epi, class Sched, bool ALIGN_EPI = false, bool SP2 = false>
__device__ __forceinline__ void gemm_phase(PG8_LAS unsigned char* lds, const Gemm g, const Sched& S, const Epi& E) {
    int tid = threadIdx.x; asm volatile("" : "+v"(tid));
    const int wid = __builtin_amdgcn_readfirstlane(tid >> 6), lane = tid & 63, wr = wid >> 2, wc = wid & 3, fr = lane & 15, fq = lane >> 4;
    const int K = g.K, nt = K / BK;
    unsigned voffA[2], voffB[2];
#pragma unroll
    for (int i = 0; i < 2; ++i) { int R, C; stage_rc(tid * 16 + i * 8192, R, C); const int Rb = Epi::PERM ? ((R & ~31) + perm32(R & 31)) : R;
        voffA[i] = (unsigned)(R * K + C) * 2u; voffB[i] = (unsigned)(Rb * K + C) * 2u; }
    const size_t kstep = (size_t)(BK * 2);
    const size_t hstep = (size_t)HALF * K * 2;
    const size_t tstep = 2 * hstep;
    const unsigned ldsw = (unsigned)wid * 1024u;
    const int aoff = lds_byte(wr * 64 + fr, fq * 8), boff = lds_byte(wc * 32 + fr, fq * 8);
#define PG8_SA(b, h) (((b) * 2 + (h)) * HTB)
#define PG8_SB(b, h) ((4 + (b) * 2 + (h)) * HTB)
#define PG8_STAGE(bufoff, gbase, voff) do { _Pragma("unroll") for (int _i = 0; _i < 2; ++_i) \
        __builtin_amdgcn_global_load_lds((const unsigned*)((const char*)(gbase) + (voff)[_i]), (PG8_LAS unsigned*)(lds + (bufoff) + ldsw + _i * 8192), 16, 0, 0); } while (0)
#define PG8_LDA(dst, b, h) do { _Pragma("unroll") for (int m = 0; m < 4; ++m) _Pragma("unroll") for (int k = 0; k < 2; ++k) dst[m][k] = *(const PG8_LAS bf16x8*)(lds + PG8_SA(b, h) + aoff + m * 2048 + k * 1024); } while (0)
#define PG8_LDB(dst, b, h) do { _Pragma("unroll") for (int n = 0; n < 2; ++n) _Pragma("unroll") for (int k = 0; k < 2; ++k) dst[n][k] = *(const PG8_LAS bf16x8*)(lds + PG8_SB(b, h) + boff + n * 2048 + k * 1024); } while (0)
#define PG8_MMA(ai, bj, At, Bt) do { __builtin_amdgcn_s_setprio(1); _Pragma("unroll") for (int m = 0; m < 4; ++m) _Pragma("unroll") for (int n = 0; n < 2; ++n) _Pragma("unroll") for (int k = 0; k < 2; ++k) \
        acc[ai][bj][m][n] = __builtin_amdgcn_mfma_f32_16x16x32_bf16(Bt[n][k], At[m][k], acc[ai][bj][m][n], 0, 0, 0); __builtin_amdgcn_s_setprio(0); } while (0)
#define PG8_WAIT_V(n) asm volatile("s_waitcnt vmcnt(" #n ")" ::: "memory")
#define PG8_WAIT_L(n) asm volatile("s_waitcnt lgkmcnt(" #n ")" ::: "memory")
#define PG8_BAR __builtin_amdgcn_s_barrier()
#define PG8_SCHED __builtin_amdgcn_sched_barrier(0)
    Unit cur, nxt; int ui = 0;
    if (!S.next(0, cur)) return;
    f32x4 acc[2][2][4][2];
#pragma unroll
    for (int a = 0; a < 2; ++a)
#pragma unroll
        for (int b = 0; b < 2; ++b)
#pragma unroll
            for (int m = 0; m < 4; ++m)
#pragma unroll
                for (int n = 0; n < 2; ++n) acc[a][b][m][n] = (f32x4){0.f, 0.f, 0.f, 0.f};
    bf16x8 At[4][2], B0[2][2], B1[2][2];
    const char* cA = S.a_ptr(cur); const char* cB = S.b_ptr(cur);
    S.a_ready(cur);
    if constexpr (SP2) {
        PG8_STAGE(PG8_SB(0, 0), cB, voffB); PG8_STAGE(PG8_SB(0, 1), cB + hstep, voffB); PG8_STAGE(PG8_SA(0, 0), cA, voffA); PG8_STAGE(PG8_SA(0, 1), cA + hstep, voffA);
        if (wr == 1) PG8_BAR;
        PG8_WAIT_V(2); PG8_BAR;
        PG8_STAGE(PG8_SB(1, 0), cB + kstep, voffB); PG8_STAGE(PG8_SA(1, 0), cA + kstep, voffA); PG8_STAGE(PG8_SB(1, 1), cB + hstep + kstep, voffB);
        PG8_WAIT_V(6); PG8_BAR;
    } else {
        PG8_STAGE(PG8_SB(0, 0), cB, voffB); PG8_STAGE(PG8_SA(0, 0), cA, voffA); PG8_STAGE(PG8_SB(0, 1), cB + hstep, voffB); PG8_STAGE(PG8_SA(0, 1), cA + hstep, voffA);
        if (wr == 1) PG8_BAR;
        PG8_WAIT_V(4); PG8_BAR;
        PG8_STAGE(PG8_SB(1, 0), cB + kstep, voffB); PG8_STAGE(PG8_SA(1, 0), cA + kstep, voffA); PG8_STAGE(PG8_SB(1, 1), cB + hstep + kstep, voffB);
        PG8_WAIT_V(6); PG8_BAR;
    }
    for (;;) {
        const bool has_next = S.next(ui + 1, nxt);
        const char* nA = has_next ? S.a_ptr(nxt) : cA; const char* nB = has_next ? S.b_ptr(nxt) : cB;
        for (int t = 0; t < nt; t += 2) {
            const bool last = (t == nt - 2);
            const char* a1 = cA + (size_t)(t + 1) * kstep;
            const char* a2 = last ? nA : cA + (size_t)(t + 2) * kstep; const char* b2 = last ? nB : cB + (size_t)(t + 2) * kstep;
            const char* a3 = a2 + kstep; const char* b3 = b2 + kstep;
            if (last && has_next) S.a_ready(nxt);
            if constexpr (SP2) {
            PG8_LDB(B0, 0, 0); PG8_LDB(B1, 0, 1); PG8_SCHED; PG8_LDA(At, 0, 0); PG8_STAGE(PG8_SA(1, 1), a1 + hstep, voffA);
            PG8_WAIT_V(8); PG8_WAIT_L(0); PG8_BAR; PG8_MMA(0, 0, At, B0); PG8_MMA(0, 1, At, B1); PG8_BAR; PG8_SCHED;
            PG8_LDA(At, 0, 1); PG8_STAGE(PG8_SB(0, 0), b2, voffB); PG8_STAGE(PG8_SB(0, 1), b2 + hstep, voffB); PG8_STAGE(PG8_SA(0, 0), a2, voffA);
            PG8_WAIT_V(8); PG8_WAIT_L(0); PG8_BAR; PG8_MMA(1, 0, At, B0); PG8_MMA(1, 1, At, B1); PG8_BAR; PG8_SCHED;
            PG8_LDB(B0, 1, 0); PG8_LDB(B1, 1, 1); PG8_SCHED; PG8_LDA(At, 1, 0); PG8_STAGE(PG8_SA(0, 1), a2 + hstep, voffA);
            PG8_WAIT_V(8); PG8_WAIT_L(0); PG8_BAR; PG8_MMA(0, 0, At, B0); PG8_MMA(0, 1, At, B1); PG8_BAR; PG8_SCHED;
            PG8_LDA(At, 1, 1); PG8_STAGE(PG8_SB(1, 0), b3, voffB); PG8_STAGE(PG8_SB(1, 1), b3 + hstep, voffB); PG8_STAGE(PG8_SA(1, 0), a3, voffA);
            PG8_WAIT_V(8); PG8_WAIT_L(0); PG8_BAR; PG8_MMA(1, 0, At, B0); PG8_MMA(1, 1, At, B1); PG8_BAR; PG8_SCHED;
            } else {
            PG8_LDB(B0, 0, 0); PG8_SCHED; PG8_LDA(At, 0, 0); PG8_STAGE(PG8_SA(1, 1), a1 + hstep, voffA);
            PG8_WAIT_L(8); PG8_BAR; PG8_WAIT_L(0); PG8_MMA(0, 0, At, B0); PG8_BAR; PG8_SCHED;
            PG8_LDB(B1, 0, 1); PG8_STAGE(PG8_SB(0, 0), b2, voffB);
            PG8_BAR; PG8_WAIT_L(0); PG8_MMA(0, 1, At, B1); PG8_BAR;
            PG8_LDA(At, 0, 1); PG8_STAGE(PG8_SA(0, 0), a2, voffA);
            PG8_BAR; PG8_WAIT_L(0); PG8_MMA(1, 0, At, B0); PG8_BAR; PG8_SCHED;
            PG8_STAGE(PG8_SB(0, 1), b2 + hstep, voffB);
            PG8_WAIT_V(6); PG8_BAR; PG8_MMA(1, 1, At, B1); PG8_BAR;
            PG8_LDB(B0, 1, 0); PG8_SCHED; PG8_LDA(At, 1, 0); PG8_STAGE(PG8_SA(0, 1), a2 + hstep, voffA);
            PG8_WAIT_L(8); PG8_BAR; PG8_WAIT_L(0); PG8_MMA(0, 0, At, B0); PG8_BAR; PG8_SCHED;
            PG8_LDB(B1, 1, 1); PG8_STAGE(PG8_SB(1, 0), b3, voffB);
            PG8_BAR; PG8_WAIT_L(0); PG8_MMA(0, 1, At, B1); PG8_BAR;
            PG8_LDA(At, 1, 1); PG8_STAGE(PG8_SA(1, 0), a3, voffA);
            PG8_BAR; PG8_WAIT_L(0); PG8_MMA(1, 0, At, B0); PG8_BAR; PG8_SCHED;
            PG8_STAGE(PG8_SB(1, 1), b3 + hstep, voffB);
            PG8_WAIT_V(6); PG8_BAR; PG8_MMA(1, 1, At, B1); PG8_BAR;
            }
        }
        if constexpr (ALIGN_EPI) { if (wr == 0) PG8_BAR; }
        if constexpr (!Epi::AFTER_DRAIN) { int fr_e = fr, fq_e = fq; asm volatile("" : "+v"(fr_e), "+v"(fq_e));
            E(acc, cur, wr, wc, fr_e, fq_e); S.done(cur); }
        if (!has_next) break;
#pragma unroll
        for (int a = 0; a < 2; ++a)
#pragma unroll
            for (int b = 0; b < 2; ++b)
#pragma unroll
                for (int m = 0; m < 4; ++m)
#pragma unroll
                    for (int n = 0; n < 2; ++n) acc[a][b][m][n] = (f32x4){0.f, 0.f, 0.f, 0.f};
        cur = nxt; cA = nA; cB = nB; ++ui;
        if constexpr (ALIGN_EPI) { if (wr == 1) PG8_BAR; }
    }
    PG8_WAIT_V(0);
    if constexpr (!ALIGN_EPI) { if (wr == 0) PG8_BAR; }
    PG8_BAR;
    if constexpr (Epi::AFTER_DRAIN) { E.fused(acc, cur, wr, wc, fr, fq, lds, wid, lane); S.done(cur); }
#undef PG8_SA
#undef PG8_SB
#undef PG8_STAGE
#undef PG8_LDA
#undef PG8_LDB
#undef PG8_MMA
#undef PG8_WAIT_V
#undef PG8_WAIT_L
#undef PG8_BAR
#undef PG8_SCHED
}
}

constexpr size_t MiB = 1u << 20;
constexpr size_t WS_CTL = 0, CTL_ZERO_BYTES = 1 * MiB;
constexpr size_t WS_MOD  = 1 * MiB;
constexpr size_t WS_WRT  = 2 * MiB;
constexpr size_t WS_MOEI = 3 * MiB;
constexpr size_t WS_LRC  = 6 * MiB;
constexpr size_t WS_DNS  = 12 * MiB;
constexpr size_t WS_WIN  = 16 * MiB;
constexpr size_t WS_WOUT = 56 * MiB;
constexpr size_t WS_WGU  = 72 * MiB;
constexpr size_t WS_WDN  = 584 * MiB;
constexpr size_t WS_X    = 840 * MiB;
constexpr size_t WS_H    = 976 * MiB;
constexpr size_t WS_P    = 1044 * MiB;
constexpr size_t WS_CC   = 1206 * MiB;
constexpr size_t WS_VT   = 1274 * MiB;
constexpr size_t WS_VTC  = WS_VT + 8 * MiB;
constexpr size_t WS_DNT  = 1284 * MiB;
constexpr size_t DNT_BYTES = 90112;
constexpr size_t WS_DNO  = 1472 * MiB;
constexpr size_t WS_LRH  = 1540 * MiB;
constexpr size_t WS_LRA  = 1608 * MiB;
constexpr size_t WS_XS   = 1676 * MiB;
constexpr size_t WS_ACT  = 1980 * MiB;
constexpr size_t WS_YS   = 2132 * MiB;
constexpr size_t WS_END  = 2436 * MiB;
constexpr int CW_TMO = 0;
constexpr int CW_BAR = 4096;
constexpr int CW_CNT = 8192;
constexpr int CW_ATQ = 12288;

constexpr int RING_OFF = 0, RING_BYTES = 131072;
constexpr int LDSCTL_OFF = RING_BYTES, MISC_OFF = LDSCTL_OFF + 320;
constexpr int LDS_X_OFF = RING_BYTES + 1024;
constexpr int LDS_BYTES = 147456;
constexpr int NWAVES = 8, NTHREADS = 512;

#define GAS __attribute__((address_space(1)))
#define LAS __attribute__((address_space(3)))
typedef unsigned short bf16;
typedef unsigned v4u __attribute__((ext_vector_type(4)));
typedef unsigned v2u __attribute__((ext_vector_type(2)));
typedef float f32x4 __attribute__((ext_vector_type(4)));
typedef float f32x16 __attribute__((ext_vector_type(16)));
typedef short bf16x8 __attribute__((ext_vector_type(8)));
typedef short bf16x4 __attribute__((ext_vector_type(4)));
typedef GAS unsigned gu32;
#define RLX_AGENT __ATOMIC_RELAXED, __HIP_MEMORY_SCOPE_AGENT
#define LDS_WAIT() asm volatile("s_waitcnt lgkmcnt(0)" ::: "memory")
#define VM_WAIT() asm volatile("s_waitcnt vmcnt(0)" ::: "memory")
__device__ __forceinline__ unsigned f2bf(float f) { unsigned u = __builtin_bit_cast(unsigned, f); return (u + 0x7fffu + ((u >> 16) & 1u)) >> 16; }
__device__ __forceinline__ unsigned pk2(float lo, float hi) { return pg8::cvt_pk_bf16(lo, hi); }
__device__ __forceinline__ float bf2f(unsigned short b) { return __builtin_bit_cast(float, (unsigned)b << 16); }
__device__ __forceinline__ float bflo(unsigned w) { return __builtin_bit_cast(float, w << 16); }
__device__ __forceinline__ float bfhi(unsigned w) { return __builtin_bit_cast(float, w & 0xffff0000u); }
__device__ __forceinline__ float wave_sum(float v) {
#pragma unroll
    for (int o = 1; o < 64; o <<= 1) v += __shfl_xor(v, o);
    return v;
}
__device__ __forceinline__ float sigmoidf_(float x) { return 1.0f / (1.0f + __expf(-x)); }
__device__ __forceinline__ float siluf_(float x) { return x / (1.0f + __expf(-x)); }
__device__ __forceinline__ float softplusf_(float x) { return x > 20.f ? x : log1pf(__expf(x)); }

#define XB_TMO      128
#define XB_XCNT(j)  (256  + 64 * (j))
#define XB_XSUB(j)  (1280 + 64 * (j))
#define XB_XGEN(j)  (2304 + 64 * (j))
#define XB_TOP      3328
#define XB_TOPGEN   3392
#define XCD_BAR_WORDS 3456
#define XB_SPIN_CAP (1u << 18)

__device__ __forceinline__ unsigned xb_ld(unsigned* p)              { return __hip_atomic_load(p, __ATOMIC_RELAXED, __HIP_MEMORY_SCOPE_AGENT); }
__device__ __forceinline__ unsigned xb_add(unsigned* p, unsigned v) { return __hip_atomic_fetch_add(p, v, __ATOMIC_RELAXED, __HIP_MEMORY_SCOPE_AGENT); }
__device__ __forceinline__ unsigned xb_xcc_id() { return (unsigned)__builtin_amdgcn_s_getreg((3 << 11) | 20) & 0xFu; }
#define XB_SPIN(cond, bar) do { unsigned _sp = 0; while (cond) { __builtin_amdgcn_s_sleep(1); \
    if ((++_sp & 255u) == 0u) { if (xb_ld(&(bar)[XB_TMO])) break; if (_sp > XB_SPIN_CAP) { atomicAdd(&(bar)[XB_TMO], 1u); break; } } } } while (0)

struct XcdBarrier {
    unsigned* bar; unsigned x;
    volatile LAS unsigned* st;
};

__device__ __forceinline__ XcdBarrier xcd_barrier_post(unsigned* bar, volatile LAS unsigned* st) {
    XcdBarrier b; b.bar = bar; b.x = xb_xcc_id(); b.st = st;
    if (threadIdx.x == 0) (void)xb_add(&bar[XB_XCNT(b.x)], 1u);
    return b;
}
__device__ __forceinline__ void xcd_barrier_complete(unsigned* bar, unsigned x, unsigned& nloc, unsigned& nx) {
    const unsigned G = gridDim.x * gridDim.y * gridDim.z;
    unsigned sum, cnt, mine, sp = 0u;
    for (;;) {
        sum = 0u; cnt = 0u; mine = 0u;
#pragma unroll
        for (unsigned j = 0; j < 16; ++j) { const unsigned c = xb_ld(&bar[XB_XCNT(j)]); sum += c; cnt += (c > 0u) ? 1u : 0u; mine = (j == x) ? c : mine; }
        if (sum == G) break;
        __builtin_amdgcn_s_sleep(1);
        if ((++sp & 255u) == 0u) { if (xb_ld(&bar[XB_TMO])) break; if (sp > XB_SPIN_CAP) { atomicAdd(&bar[XB_TMO], 1u); break; } }
    }
    nloc = mine > 0u ? mine : 1u; nx = cnt > 0u ? cnt : 1u;
}

__device__ __forceinline__ void xcd_barrier(const XcdBarrier& b) {
    asm volatile("s_waitcnt vmcnt(0)" ::: "memory");
    __syncthreads();
    if (threadIdx.x == 0) {
        unsigned* bar = b.bar;
        __builtin_amdgcn_s_waitcnt(0);
        unsigned nloc = b.st[0], nx = b.st[1];
        if (nloc == 0u) { xcd_barrier_complete(bar, b.x, nloc, nx); b.st[0] = nloc; b.st[1] = nx; }
        const unsigned old = xb_add(&bar[XB_XSUB(b.x)], 1u);
        const unsigned gen = old / nloc;
        if (old + 1u == (gen + 1u) * nloc) {
            __builtin_amdgcn_fence(__ATOMIC_RELEASE, "agent");
            asm volatile("s_waitcnt vmcnt(0)" ::: "memory");
            const unsigned og = xb_add(&bar[XB_TOP], 1u);
            const unsigned tg = og / nx;
            if (og + 1u == (tg + 1u) * nx) xb_add(&bar[XB_TOPGEN], 1u);
            else XB_SPIN(xb_ld(&bar[XB_TOPGEN]) == tg, bar);
            __builtin_amdgcn_fence(__ATOMIC_ACQUIRE, "agent");
            xb_add(&bar[XB_XGEN(b.x)], 1u);
            asm volatile("s_waitcnt vmcnt(0)" ::: "memory");
        } else {
            XB_SPIN(xb_ld(&bar[XB_XGEN(b.x)]) == gen, bar);
            __builtin_amdgcn_fence(__ATOMIC_ACQUIRE, "agent");
            asm volatile("s_waitcnt vmcnt(0)" ::: "memory");
        }
    }
    __syncthreads();
}

enum InIdx { I_X = 0, I_C, I_CTX, I_CCTX, I_WMOD, I_BMOD, I_NMG, I_NFG, I_WIN, I_WOUT, I_SINK, I_DNCW, I_DNALOG, I_DNDT, I_DNNG, I_LRCW, I_LRCB, I_LRWR, I_LRBR, I_LRWI, I_LRBI, I_LRLAM,
             I_WROUT, I_BROUT, I_WGU, I_BGU, I_WDN, I_BDN, I_FNG, N_IN };
struct Frame {
    LAS unsigned char* lds;
    volatile LAS unsigned* MISC;
    gu32* ctl;
    int tid, lane, wave, G, bid;
    const float* const __attribute__((address_space(4)))* in;
    float* out; unsigned char* ws;
};
__device__ __forceinline__ int mod_row(int m) { return m < NLAT ? (m >> 12) : 4; }
__device__ __forceinline__ bool phase_enter(Frame& F) { int t = threadIdx.x; asm volatile("" : "+v"(t)); F.tid = t; F.lane = t & 63; F.wave = __builtin_amdgcn_readfirstlane(t >> 6); return true; }
__device__ __forceinline__ void seq_of(int m, int& t, int& T, int& base) { if (m < NLAT) { t = m & 4095; T = SEQ; base = m - t; } else { t = (m - NLAT) & 255; T = CTXL; base = m - t; } }
__device__ __forceinline__ float gelu_tanh(float x) { const float u = 0.7978845608028654f * (x + 0.044715f * x * x * x); return 0.5f * x * (1.0f + tanhf(u)); }

__device__ __forceinline__ void transpose_item(const float* W, int K, int N, bf16* WT, int k0, int dstrow0, int srccol0, int nvalid, LAS float* scr, int lane) {
    const int j = lane & 31;
#pragma unroll 8
    for (int i = 0; i < 32; ++i) { const int kk = 2 * i + (lane >> 5); scr[kk * 33 + j] = (j < nvalid) ? W[(size_t)(k0 + kk) * N + srccol0 + j] : 0.f; }
    LDS_WAIT(); asm volatile("" ::: "memory");
    const int c = lane & 7;
#pragma unroll
    for (int jj = 0; jj < 4; ++jj) { const int n = (lane >> 3) + 8 * jj; const LAS float* s = scr + (8 * c) * 33 + n;
        v4u o; o.x = pk2(s[0 * 33], s[1 * 33]); o.y = pk2(s[2 * 33], s[3 * 33]); o.z = pk2(s[4 * 33], s[5 * 33]); o.w = pk2(s[6 * 33], s[7 * 33]);
        *(GAS v4u*)(WT + (size_t)(dstrow0 + n) * K + k0 + 8 * c) = o; }
    LDS_WAIT(); asm volatile("" ::: "memory");
}
__device__ __forceinline__ void p0_prologue(Frame& F) {
    {
        LAS float* sc = (LAS float*)(F.lds);
        LAS float* red = (LAS float*)(F.lds + 40960);
        bool have_sc = false;
        for (int wb = F.bid; wb < 192; wb += F.G) {
            if (!have_sc) {
                for (int i = F.tid; i < 5 * 2048; i += NTHREADS) { const int r = i >> 11, k = i & 2047; const float cv = r < 4 ? F.in[I_C][r * 2048 + k] : F.in[I_CCTX][k]; sc[i] = siluf_(cv); }
                have_sc = true; __syncthreads();
            }
            const int l = wb / 96, cb = wb % 96, kp = F.tid >> 5, cg = F.tid & 31, j0 = cb * 128 + cg * 4;
            const float* wp = F.in[I_WMOD] + ((size_t)l * 2048 + kp * 128) * 12288 + j0;
            f32x4 acc[5];
#pragma unroll
            for (int r = 0; r < 5; ++r) acc[r] = (f32x4){0.f, 0.f, 0.f, 0.f};
#pragma unroll 4
            for (int k = 0; k < 128; ++k) { const f32x4 w = *(const f32x4*)(wp + (size_t)k * 12288);
#pragma unroll
                for (int r = 0; r < 5; ++r) acc[r] += sc[r * 2048 + kp * 128 + k] * w; }
#pragma unroll
            for (int r = 0; r < 5; ++r) *(LAS f32x4*)(red + (kp * 5 + r) * 128 + cg * 4) = acc[r];
            __syncthreads();
            for (int i = F.tid; i < 640; i += NTHREADS) { const int r = i >> 7, col = i & 127; float s = F.in[I_BMOD][l * 12288 + cb * 128 + col];
#pragma unroll
                for (int q = 0; q < 16; ++q) s += red[(q * 5 + r) * 128 + col];
                ((float*)(F.ws + WS_MOD))[(size_t)(l * 5 + r) * 12288 + cb * 128 + col] = s; }
            __syncthreads();
        }
        __syncthreads();
    }
    {
        LAS float* scr = (LAS float*)(F.lds + F.wave * 16384);
        const int gw = F.bid * NWAVES + F.wave, NGW = F.G * NWAVES;
        constexpr int I_IN = 32 * 152, I_OUT = 32 * 64, I_RT = 32, I_GU = 32 * 32 * 64, I_DN = 32 * 16 * 64, PER_L = I_IN + I_OUT + I_RT + I_GU + I_DN;
        for (int it0 = gw; it0 < 2 * PER_L; it0 += NGW) {
            const int l = it0 / PER_L; int r = it0 % PER_L;
            if (r < I_IN) { const int nb = r % 152, kb = r / 152, d0 = nb * 32; int s0 = d0, nv = 32;
                if (d0 >= 4640) nv = 0; else if (d0 == 4608) { s0 = 3584; nv = 16; } else if (d0 >= 3584) s0 = d0 + 16;
                transpose_item(F.in[I_WIN] + (size_t)l * 2048 * IN_W, 2048, IN_W, (bf16*)(F.ws + WS_WIN) + (size_t)l * PW * 2048, kb * 64, d0, s0, nv, scr, F.lane); continue; }
            r -= I_IN;
            if (r < I_OUT) { const int nb = r % 64, kb = r / 64;
                transpose_item(F.in[I_WOUT] + (size_t)l * 2048 * 2048, 2048, 2048, (bf16*)(F.ws + WS_WOUT) + (size_t)l * 2048 * 2048, kb * 64, nb * 32, nb * 32, 32, scr, F.lane); continue; }
            r -= I_OUT;
            if (r < I_RT) { transpose_item(F.in[I_WROUT] + (size_t)l * 2048 * 32, 2048, 32, (bf16*)(F.ws + WS_WRT) + (size_t)l * 32 * 2048, r * 64, 0, 0, 32, scr, F.lane); continue; }
            r -= I_RT;
            if (r < I_GU) { const int e = r / 2048, q = r % 2048, nb = q % 64, kb = q / 64; const int s0 = ((nb >> 2) & 1) * 1024 + (nb >> 3) * 128 + (nb & 3) * 32;
                transpose_item(F.in[I_WGU] + (size_t)(l * 32 + e) * 2048 * 2048, 2048, 2048, (bf16*)(F.ws + WS_WGU) + (size_t)(l * 32 + e) * 2048 * 2048, kb * 64, nb * 32, s0, 32, scr, F.lane); continue; }
            r -= I_GU;
            { const int e = r / 1024, q = r % 1024, nb = q % 64, kb = q / 64;
                transpose_item(F.in[I_WDN] + (size_t)(l * 32 + e) * 1024 * 2048, 1024, 2048, (bf16*)(F.ws + WS_WDN) + (size_t)(l * 32 + e) * 2048 * 1024, kb * 64, nb * 32, nb * 32, 32, scr, F.lane); }
        }
    }
}

__device__ __forceinline__ void load_row(const float* src, int lane, f32x4 (&v)[8]) {
    const f32x4* p = (const f32x4*)src + lane;
#pragma unroll
    for (int j = 0; j < 8; ++j) v[j] = p[64 * j];
}
__device__ __forceinline__ void store_row(float* dst, int lane, const f32x4 (&v)[8]) {
    f32x4* p = (f32x4*)dst + lane;
#pragma unroll
    for (int j = 0; j < 8; ++j) p[64 * j] = v[j];
}
__device__ __forceinline__ void combine_row(Frame& F, int l, int m, int lane, f32x4 (&v)[8]) {
    const int* dest = (const int*)(F.ws + WS_MOEI + 2 * 512 * 1024) + m * 4;
    const float* g5 = (const float*)(F.ws + WS_MOD) + (size_t)(l * 5 + mod_row(m)) * 12288 + 5 * 2048;
    f32x4 acc[8];
#pragma unroll
    for (int j = 0; j < 8; ++j) acc[j] = (f32x4){0.f, 0.f, 0.f, 0.f};
#pragma unroll
    for (int k = 0; k < 4; ++k) { const int d = dest[k]; const v2u* yp = (const v2u*)((const bf16*)(F.ws + WS_YS) + (size_t)d * 2048) + lane;
#pragma unroll
        for (int j = 0; j < 8; ++j) { const v2u w = yp[64 * j]; acc[j] += (f32x4){bflo(w.x), bfhi(w.x), bflo(w.y), bfhi(w.y)}; } }
#pragma unroll
    for (int j = 0; j < 8; ++j) { const f32x4 gg = *((const f32x4*)g5 + lane + 64 * j); v[j] += gg * acc[j]; }
}
__device__ __forceinline__ void modnorm_store(const f32x4 (&v)[8], const float* g, const float* shift, const float* scale, bf16* hrow, int lane) {
    float ss = 0.f;
#pragma unroll
    for (int j = 0; j < 8; ++j) ss += (v[j].x * v[j].x + v[j].y * v[j].y) + (v[j].z * v[j].z + v[j].w * v[j].w);
    const float rstd = 1.0f / sqrtf(wave_sum(ss) * (1.0f / 2048.0f) + EPS);
    v2u* hp = (v2u*)hrow + lane;
#pragma unroll
    for (int j = 0; j < 8; ++j) { const f32x4 gg = *((const f32x4*)g + lane + 64 * j), sh = *((const f32x4*)shift + lane + 64 * j), sc = *((const f32x4*)scale + lane + 64 * j);
        const f32x4 y = (v[j] * rstd) * gg * (sc + 1.0f) + sh; v2u w; w.x = pk2(y.x, y.y); w.y = pk2(y.z, y.w); hp[64 * j] = w; }
}
__device__ __forceinline__ void phase_norm1(Frame& F, int l) {
    const int gw = F.bid * NWAVES + F.wave, NGW = F.G * NWAVES;
    float* X = (float*)(F.ws + WS_X); bf16* H = (bf16*)(F.ws + WS_H);
    const float* modp = (const float*)(F.ws + WS_MOD) + (size_t)l * 5 * 12288;
    for (int m = gw; m < NTOK; m += NGW) {
        f32x4 v[8];
        if (l == 0) load_row(m < NLAT ? F.in[I_X] + (size_t)m * DM : F.in[I_CTX] + (size_t)(m - NLAT) * DM, F.lane, v);
        else { load_row(X + (size_t)m * DM, F.lane, v); if (MK_STAGE >= 9) { combine_row(F, l - 1, m, F.lane, v); store_row(X + (size_t)m * DM, F.lane, v); } }
        const float* mr = modp + (size_t)mod_row(m) * 12288;
        modnorm_store(v, F.in[I_NMG] + l * DM, mr, mr + 2048, H + (size_t)m * DM, F.lane);
    }
}
__device__ __forceinline__ void phase_final(Frame& F, bool with_combine) {
    const int gw = F.bid * NWAVES + F.wave, NGW = F.G * NWAVES;
    const float* X = (const float*)(F.ws + WS_X);
    for (int m = gw; m < NLAT; m += NGW) {
        f32x4 v[8];
        if (with_combine) { load_row(X + (size_t)m * DM, F.lane, v); combine_row(F, 1, m, F.lane, v); }
        else load_row(F.in[I_X] + (size_t)m * DM, F.lane, v);
        float ss = 0.f;
#pragma unroll
        for (int j = 0; j < 8; ++j) ss += (v[j].x * v[j].x + v[j].y * v[j].y) + (v[j].z * v[j].z + v[j].w * v[j].w);
        const float rstd = 1.0f / sqrtf(wave_sum(ss) * (1.0f / 2048.0f) + EPS);
        f32x4* op = (f32x4*)(F.out + (size_t)m * DM) + F.lane;
#pragma unroll
        for (int j = 0; j < 8; ++j) { const f32x4 gg = *((const f32x4*)F.in[I_FNG] + F.lane + 64 * j); op[64 * j] = v[j] * rstd * gg; }
    }
}

__device__ __forceinline__ void phase_inproj(Frame& F, int l) {
    pg8::Gemm g{(const bf16*)(F.ws + WS_H), (const bf16*)(F.ws + WS_WIN) + (size_t)l * PW * 2048, NTOK, PW, 2048};
    pg8::StaticOrder S; S.init(g, F.G, F.bid);
    pg8::EpiBf16Plain E{(bf16*)(F.ws + WS_P), PW};
    pg8::gemm_phase<pg8::EpiBf16Plain, pg8::StaticOrder, true, true>(F.lds + RING_OFF, g, S, E);
}
__device__ __forceinline__ void phase_outproj(Frame& F, int l) {
    float* X = (float*)(F.ws + WS_X);
    pg8::Gemm g{(const bf16*)(F.ws + WS_CC), (const bf16*)(F.ws + WS_WOUT) + (size_t)l * 2048 * 2048, l == 0 ? NTOK : NLAT, 2048, 2048};
    pg8::StaticOrder S; S.init(g, F.G, F.bid);
    pg8::EpiResGate E{l == 0 ? F.in[I_X] : X, l == 0 ? F.in[I_CTX] : X + (size_t)NLAT * DM, X, (const float*)(F.ws + WS_MOD) + (size_t)l * 5 * 12288 + 2 * 2048};
    pg8::gemm_phase<pg8::EpiResGate, pg8::StaticOrder, true, true>(F.lds + RING_OFF, g, S, E);
}
#ifndef PHASE_INPROJ
#define PHASE_INPROJ(F, l) phase_inproj(F, l)
#endif
#ifndef PHASE_OUTPROJ
#define PHASE_OUTPROJ(F, l) phase_outproj(F, l)
#endif

constexpr size_t MOEI_TOPE = WS_MOEI, MOEI_TOPG = WS_MOEI + 512 * 1024, MOEI_DEST = WS_MOEI + 2 * 512 * 1024, MOEI_ROWG = WS_MOEI + 3 * 512 * 1024;
__device__ __forceinline__ void phase_norm2(Frame& F, int l) {
    const int nrows = (l == 0) ? NTOK : NLAT;
    constexpr int TROW = 4112;
    LAS unsigned char* tile = F.lds;
    LAS float* part = (LAS float*)(F.lds + 66048);
    LAS float* lg = (LAS float*)(F.lds + 66048 + 16384);
    const float* X = (const float*)(F.ws + WS_X); bf16* H = (bf16*)(F.ws + WS_H);
    const float* modp = (const float*)(F.ws + WS_MOD) + (size_t)l * 5 * 12288;
    const bf16* wrt = (const bf16*)(F.ws + WS_WRT) + (size_t)l * 32 * 2048;
    int* tope = (int*)(F.ws + MOEI_TOPE); float* topg = (float*)(F.ws + MOEI_TOPG);
    for (int r0 = F.bid * 16; r0 < nrows; r0 += F.G * 16) {
#pragma unroll 1
        for (int rr = 0; rr < 2; ++rr) {
            const int lr = 2 * F.wave + rr, m = r0 + lr;
            f32x4 v[8]; load_row(X + (size_t)m * DM, F.lane, v);
            float ss = 0.f;
#pragma unroll
            for (int j = 0; j < 8; ++j) ss += (v[j].x * v[j].x + v[j].y * v[j].y) + (v[j].z * v[j].z + v[j].w * v[j].w);
            const float rstd = 1.0f / sqrtf(wave_sum(ss) * (1.0f / 2048.0f) + EPS);
            const float* mr = modp + (size_t)mod_row(m) * 12288; const float* g = F.in[I_NFG] + l * DM;
            v2u* hp = (v2u*)(H + (size_t)m * DM) + F.lane; LAS v2u* tp = (LAS v2u*)(tile + lr * TROW) + F.lane;
#pragma unroll
            for (int j = 0; j < 8; ++j) { const f32x4 gg = *((const f32x4*)g + F.lane + 64 * j), sh = *((const f32x4*)(mr + 3 * 2048) + F.lane + 64 * j), sc = *((const f32x4*)(mr + 4 * 2048) + F.lane + 64 * j);
                const f32x4 y = (v[j] * rstd) * gg * (sc + 1.0f) + sh; v2u w; w.x = pk2(y.x, y.y); w.y = pk2(y.z, y.w); hp[64 * j] = w; tp[64 * j] = w; }
        }
        __syncthreads();
        {
            const int row = F.lane & 15, q = F.lane >> 4;
            f32x4 acc0 = {0.f, 0.f, 0.f, 0.f}, acc1 = {0.f, 0.f, 0.f, 0.f};
#pragma unroll
            for (int ks = 0; ks < 8; ++ks) { const int k0 = 256 * F.wave + 32 * ks + 8 * q;
                const bf16x8 a = *(const LAS bf16x8*)(tile + row * TROW + k0 * 2);
                const bf16x8 b0 = *(const bf16x8*)(wrt + (size_t)row * 2048 + k0), b1 = *(const bf16x8*)(wrt + (size_t)(16 + row) * 2048 + k0);
                acc0 = __builtin_amdgcn_mfma_f32_16x16x32_bf16(a, b0, acc0, 0, 0, 0); acc1 = __builtin_amdgcn_mfma_f32_16x16x32_bf16(a, b1, acc1, 0, 0, 0); }
#pragma unroll
            for (int i = 0; i < 4; ++i) { part[(F.wave * 16 + 4 * q + i) * 32 + row] = acc0[i]; part[(F.wave * 16 + 4 * q + i) * 32 + 16 + row] = acc1[i]; }
        }
        __syncthreads();
        { const int rw = F.tid >> 5, e = F.tid & 31; float s = F.in[I_BROUT][l * 32 + e];
#pragma unroll
          for (int w = 0; w < 8; ++w) s += part[(w * 16 + rw) * 32 + e];
          lg[rw * 32 + e] = s; }
        __syncthreads();
        if (F.tid < 16) { const int m = r0 + F.tid; float val[4]; int idx[4]; unsigned taken = 0u;
#pragma unroll
            for (int k = 0; k < 4; ++k) { float best = -3.0e38f; int bi = 0;
                for (int e = 0; e < 32; ++e) { const float x = lg[F.tid * 32 + e]; if (!((taken >> e) & 1u) && x > best) { best = x; bi = e; } }
                val[k] = best; idx[k] = bi; taken |= 1u << bi; }
            float p[4], sum = 0.f;
#pragma unroll
            for (int k = 0; k < 4; ++k) { p[k] = __expf(val[k] - val[0]); sum += p[k]; }
#pragma unroll
            for (int k = 0; k < 4; ++k) { const unsigned rank = __hip_atomic_fetch_add(F.ctl + CW_CNT + 64 * l + idx[k], 1u, RLX_AGENT);
                tope[m * 4 + k] = idx[k] | (int)(rank << 8); topg[m * 4 + k] = p[k] / sum; }
        }
        __syncthreads();
    }
}
__device__ __forceinline__ void moe_tables(Frame& F, int l) {
    LAS int* blk_end = (LAS int*)(F.lds + LDS_X_OFF); LAS int* pstart = blk_end + 32;
    if (F.tid == 0) { int nb = 0;
        for (int e = 0; e < 32; ++e) { const int c = (int)__hip_atomic_load(F.ctl + CW_CNT + 64 * l + e, RLX_AGENT); pstart[e] = nb * 256; nb += (c + 255) >> 8; blk_end[e] = nb; } }
    __syncthreads();
}
__device__ __forceinline__ void phase_scatter(Frame& F, int l) {
    const int nrows = (l == 0) ? NTOK : NLAT;
    moe_tables(F, l);
    const LAS int* pstart = (const LAS int*)(F.lds + LDS_X_OFF) + 32;
    const int* tope = (const int*)(F.ws + MOEI_TOPE); const float* topg = (const float*)(F.ws + MOEI_TOPG);
    int* dest = (int*)(F.ws + MOEI_DEST); float* rowg = (float*)(F.ws + MOEI_ROWG);
    const bf16* H = (const bf16*)(F.ws + WS_H); bf16* XS = (bf16*)(F.ws + WS_XS);
    const int gw = F.bid * NWAVES + F.wave, NGW = F.G * NWAVES;
    for (int a = gw; a < nrows * 4; a += NGW) {
        const int te = tope[a], e = te & 255, rank = (int)((unsigned)te >> 8), d = pstart[e] + rank, m = a >> 2;
        if (F.lane == 0) { dest[a] = d; rowg[d] = topg[a]; }
        const v4u* src = (const v4u*)(H + (size_t)m * DM) + F.lane; v4u* dst = (v4u*)(XS + (size_t)d * DM) + F.lane;
#pragma unroll
        for (int j = 0; j < 4; ++j) dst[64 * j] = src[64 * j];
    }
}
__device__ __forceinline__ void phase_gemm1(Frame& F, int l) {
    moe_tables(F, l);
    const LAS int* blk_end = (const LAS int*)(F.lds + LDS_X_OFF);
    pg8::Gemm g{(const bf16*)(F.ws + WS_XS), (const bf16*)(F.ws + WS_WGU) + (size_t)l * 32 * 2048 * 2048, MOE_ROWS, 2048, 2048};
    pg8::MoeOrder S{F.bid, __builtin_amdgcn_readfirstlane(blk_end[31]), (const char*)g.A, (const char*)g.Bt, (size_t)256 * 2048 * 2, (size_t)2048 * 2048 * 2, (size_t)256 * 2048 * 2, blk_end};
    pg8::EpiSwiglu E{(bf16*)(F.ws + WS_ACT), F.in[I_BGU] + (size_t)l * 32 * 2048};
    pg8::gemm_phase<pg8::EpiSwiglu, pg8::MoeOrder, true, true>(F.lds + RING_OFF, g, S, E);
}
__device__ __forceinline__ void phase_gemm2(Frame& F, int l) {
    moe_tables(F, l);
    const LAS int* blk_end = (const LAS int*)(F.lds + LDS_X_OFF);
    pg8::Gemm g{(const bf16*)(F.ws + WS_ACT), (const bf16*)(F.ws + WS_WDN) + (size_t)l * 32 * 2048 * 1024, MOE_ROWS, 2048, 1024};
    pg8::MoeOrder S{F.bid, __builtin_amdgcn_readfirstlane(blk_end[31]), (const char*)g.A, (const char*)g.Bt, (size_t)256 * 1024 * 2, (size_t)2048 * 1024 * 2, (size_t)256 * 1024 * 2, blk_end};
    pg8::EpiDown E{(bf16*)(F.ws + WS_YS), F.in[I_BDN] + (size_t)l * 32 * 2048, (const float*)(F.ws + MOEI_ROWG)};
    pg8::gemm_phase<pg8::EpiDown, pg8::MoeOrder, true, true>(F.lds + RING_OFF, g, S, E);
}
#ifndef PHASE_NORM2
#define PHASE_NORM2(F, l) phase_norm2(F, l)
#endif
#ifndef PHASE_SCATTER
#define PHASE_SCATTER(F, l) phase_scatter(F, l)
#endif
#ifndef PHASE_GEMM1
#define PHASE_GEMM1(F, l) phase_gemm1(F, l)
#endif
#ifndef PHASE_GEMM2
#define PHASE_GEMM2(F, l) phase_gemm2(F, l)
#endif
#define USE_MFMA_ATTN 1

__device__ __forceinline__ void attn_prep(Frame& F, int l) {
    bf16* P = (bf16*)(F.ws + WS_P);
    LAS unsigned short* vt = (LAS unsigned short*)F.lds;
    for (int ct = F.bid; ct < NCT; ct += F.G) {
        const int m0 = ct * 64; const bool lat = m0 < NLAT;
        __syncthreads();
        for (int i = F.tid; i < 64 * 32; i += NTHREADS) { const int tk = i >> 5, c8 = i & 31;
            const v4u w = *(const v4u*)(P + (size_t)(m0 + tk) * PW + PC_V + c8 * 8);
            const unsigned ww[4] = {w.x, w.y, w.z, w.w};
#pragma unroll
            for (int q = 0; q < 4; ++q) { vt[(c8 * 8 + 2 * q) * 66 + tk] = (unsigned short)(ww[q] & 0xffffu); vt[(c8 * 8 + 2 * q + 1) * 66 + tk] = (unsigned short)(ww[q] >> 16); } }
        if (lat) for (int i = F.tid; i < 64 * 128; i += NTHREADS) { const int tk = i >> 7, pi = i & 127, kvh = pi >> 5, hf = (pi >> 4) & 1, j = pi & 15; const int t = (m0 + tk) & 4095;
            bf16* kp = P + (size_t)(m0 + tk) * PW + PC_K + kvh * 64 + hf * 32 + j;
            const float x1 = bf2f(kp[0]), x2 = bf2f(kp[16]); const float pos = (float)(hf ? (t & 63) : (t >> 6)); const float inv = __builtin_amdgcn_exp2f(-(float)j * 0.8304820237218406f);
            const float sn = __sinf(pos * inv), cs = __cosf(pos * inv);
            kp[0] = (bf16)f2bf(x1 * cs - x2 * sn); kp[16] = (bf16)f2bf(x2 * cs + x1 * sn); }
        __syncthreads();
        for (int i = F.tid; i < 256 * 8; i += NTHREADS) { const int col = i >> 3, c = i & 7, kvh = col >> 6, d = col & 63;
            v4u o; const LAS unsigned short* s = vt + col * 66 + c * 8;
            o.x = s[0] | ((unsigned)s[1] << 16); o.y = s[2] | ((unsigned)s[3] << 16); o.z = s[4] | ((unsigned)s[5] << 16); o.w = s[6] | ((unsigned)s[7] << 16);
            if (lat) { const int b = m0 >> 12, t0 = m0 & 4095; *(v4u*)((bf16*)(F.ws + WS_VT) + ((size_t)(b * 4 + kvh) * 64 + d) * SEQ + t0 + c * 8) = o; }
            else { const int mm = m0 - NLAT, b = mm >> 8, t0 = mm & 255; *(v4u*)((bf16*)(F.ws + WS_VTC) + ((size_t)(b * 4 + kvh) * 64 + d) * CTXL + t0 + c * 8) = o; } }
    }
    __syncthreads();
}

constexpr int AT_KP = 144, AT_VP = 136;
constexpr int AT_KOFF = 0, AT_VOFF = 64 * AT_KP, AT_TILE = 64 * AT_KP + 64 * AT_VP;
__device__ __forceinline__ void attn_unit(Frame& F, int l, int b, int kvh, int qi, int is_ctx) {
    const bf16* P = (const bf16*)(F.ws + WS_P); bf16* CC = (bf16*)(F.ws + WS_CC);
    int lane_o = F.lane; asm volatile("" : "+v"(lane_o));
    const int g = F.wave >> 1, qh = F.wave & 1, hq = kvh * 4 + g, r32 = lane_o & 31, hi = lane_o >> 5;
    const int rowbase = is_ctx ? NLAT + b * CTXL : b * SEQ;
    const int qa = qi * 128 + qh * 64;
    const float LOG2E = 1.4426950408889634f;
    bf16x8 qf[2][4];
#pragma unroll
    for (int qt = 0; qt < 2; ++qt) { const int tq = qa + 32 * qt + r32; const bf16* qp = P + (size_t)(rowbase + tq) * PW + PC_Q + hq * 64 + 8 * hi;
        float x[4][8];
#pragma unroll
        for (int s = 0; s < 4; ++s) { const v4u w = *(const v4u*)(qp + 16 * s); x[s][0] = bflo(w.x); x[s][1] = bfhi(w.x); x[s][2] = bflo(w.y); x[s][3] = bfhi(w.y); x[s][4] = bflo(w.z); x[s][5] = bfhi(w.z); x[s][6] = bflo(w.w); x[s][7] = bfhi(w.w); }
        if (!is_ctx) {
#pragma unroll
            for (int hf = 0; hf < 2; ++hf) { const float pos = (float)(hf ? (tq & 63) : (tq >> 6));
#pragma unroll
                for (int j = 0; j < 8; ++j) { const float inv = __builtin_amdgcn_exp2f(-(float)(8 * hi + j) * 0.8304820237218406f); const float sn = __sinf(pos * inv), cs = __cosf(pos * inv);
                    const float x1 = x[2 * hf][j], x2 = x[2 * hf + 1][j]; x[2 * hf][j] = x1 * cs - x2 * sn; x[2 * hf + 1][j] = x2 * cs + x1 * sn; } } }
        const float sc = 0.125f * LOG2E;
#pragma unroll
        for (int s = 0; s < 4; ++s) { v4u w; w.x = pk2(x[s][0] * sc, x[s][1] * sc); w.y = pk2(x[s][2] * sc, x[s][3] * sc); w.z = pk2(x[s][4] * sc, x[s][5] * sc); w.w = pk2(x[s][6] * sc, x[s][7] * sc); qf[qt][s] = __builtin_bit_cast(bf16x8, w); }
    }
    float mrun[2], lrun[2]; f32x16 O[2][2];
    { const float sk = F.in[I_SINK][l * 16 + hq] * LOG2E;
#pragma unroll
      for (int qt = 0; qt < 2; ++qt) { mrun[qt] = sk; lrun[qt] = hi ? 0.f : 1.f;
#pragma unroll
        for (int db = 0; db < 2; ++db)
#pragma unroll
            for (int r = 0; r < 16; ++r) O[qt][db][r] = 0.f; } }
    const int ntl = is_ctx ? 0 : 6;
#pragma unroll 1
    for (int kt = 0; kt < ntl + 4; ++kt) {
        const bool local = kt < ntl; const int k0 = local ? 128 * (qi - 1) + 64 * kt : 64 * (kt - ntl);
        if (local && (k0 < 0 || k0 >= SEQ)) continue;
        __syncthreads();
        { const int rr = F.tid >> 3, c = F.tid & 7;
          const bf16* ksrc = P + (size_t)((local ? b * SEQ : NLAT + b * CTXL) + k0 + rr) * PW + PC_K + kvh * 64 + c * 8;
          const bf16* vsrc = local ? (const bf16*)(F.ws + WS_VT) + ((size_t)(b * 4 + kvh) * 64 + rr) * SEQ + k0 + c * 8 : (const bf16*)(F.ws + WS_VTC) + ((size_t)(b * 4 + kvh) * 64 + rr) * CTXL + k0 + c * 8;
          const v4u kw = *(const v4u*)ksrc, vw = *(const v4u*)vsrc;
          *(LAS v4u*)(F.lds + AT_KOFF + rr * AT_KP + c * 16) = kw;
          LAS v2u* vd = (LAS v2u*)(F.lds + AT_VOFF + rr * AT_VP + c * 16); vd[0] = (v2u){vw.x, vw.y}; vd[1] = (v2u){vw.z, vw.w}; }
        __syncthreads();
        if (local && (k0 + 63 < qa - 128 || k0 > qa + 63 + 128)) continue;
#pragma unroll 1
        for (int kb = 0; kb < 2; ++kb) {
            bf16x8 kf[4];
#pragma unroll
            for (int ss = 0; ss < 4; ++ss) kf[ss] = *(const LAS bf16x8*)(F.lds + AT_KOFF + (32 * kb + r32) * AT_KP + (16 * ss + 8 * hi) * 2);
            bf16x8 pb[2][2];
#pragma unroll
            for (int qt = 0; qt < 2; ++qt) { const int tq = qa + 32 * qt + r32;
                f32x16 s;
#pragma unroll
                for (int r = 0; r < 16; ++r) s[r] = 0.f;
#pragma unroll
                for (int ss = 0; ss < 4; ++ss) s = __builtin_amdgcn_mfma_f32_32x32x16_bf16(kf[ss], qf[qt][ss], s, 0, 0, 0);
                if (local) {
#pragma unroll
                    for (int r = 0; r < 16; ++r) { const int kidx = k0 + 32 * kb + (r & 3) + 8 * (r >> 2) + 4 * hi; const int dlt = kidx - tq; if (dlt > 128 || dlt < -128) s[r] = -1.0e30f; } }
                float mloc = s[0];
#pragma unroll
                for (int r = 1; r < 16; ++r) mloc = fmaxf(mloc, s[r]);
                mloc = fmaxf(mloc, __shfl_xor(mloc, 32));
                const float mnew = fmaxf(mrun[qt], mloc), alpha = __builtin_amdgcn_exp2f(mrun[qt] - mnew); mrun[qt] = mnew;
                float psum = 0.f;
#pragma unroll
                for (int r = 0; r < 16; ++r) { s[r] = __builtin_amdgcn_exp2f(s[r] - mnew); psum += s[r]; }
                lrun[qt] = lrun[qt] * alpha + psum;
#pragma unroll
                for (int db = 0; db < 2; ++db)
#pragma unroll
                    for (int r = 0; r < 16; ++r) O[qt][db][r] *= alpha;
#pragma unroll
                for (int s2 = 0; s2 < 2; ++s2) { v4u pw; pw.x = pk2(s[8 * s2 + 0], s[8 * s2 + 1]); pw.y = pk2(s[8 * s2 + 2], s[8 * s2 + 3]); pw.z = pk2(s[8 * s2 + 4], s[8 * s2 + 5]); pw.w = pk2(s[8 * s2 + 6], s[8 * s2 + 7]);
                    pb[qt][s2] = __builtin_bit_cast(bf16x8, pw); }
            }
#pragma unroll
            for (int s2 = 0; s2 < 2; ++s2)
#pragma unroll
                for (int db = 0; db < 2; ++db) { const LAS v2u* vp = (const LAS v2u*)(F.lds + AT_VOFF + (32 * db + r32) * AT_VP + (32 * kb + 16 * s2 + 4 * hi) * 2);
                    const v2u a0 = vp[0], a1 = vp[2]; v4u aw; aw.x = a0.x; aw.y = a0.y; aw.z = a1.x; aw.w = a1.y; const bf16x8 va = __builtin_bit_cast(bf16x8, aw);
                    O[0][db] = __builtin_amdgcn_mfma_f32_32x32x16_bf16(va, pb[0][s2], O[0][db], 0, 0, 0);
                    O[1][db] = __builtin_amdgcn_mfma_f32_32x32x16_bf16(va, pb[1][s2], O[1][db], 0, 0, 0); }
        }
    }
    int r32e = r32, hie = hi; asm volatile("" : "+v"(r32e), "+v"(hie));
#pragma unroll
    for (int qt = 0; qt < 2; ++qt) { const float lt = lrun[qt] + __shfl_xor(lrun[qt], 32); const float rl = 1.0f / lt; const int tq = qa + 32 * qt + r32e;
        bf16* op = CC + (size_t)(rowbase + tq) * DM + hq * 64 + 4 * hie;
#pragma unroll
        for (int db = 0; db < 2; ++db)
#pragma unroll
            for (int rq = 0; rq < 4; ++rq) { v2u w; w.x = pk2(O[qt][db][4 * rq] * rl, O[qt][db][4 * rq + 1] * rl); w.y = pk2(O[qt][db][4 * rq + 2] * rl, O[qt][db][4 * rq + 3] * rl);
                *(v2u*)(op + 32 * db + 8 * rq) = w; } }
}
__device__ __forceinline__ void attn_phase(Frame& F, int l) {
    const int nunits = 512 + (l == 0 ? 32 : 0);
    LAS int* slot = (LAS int*)(F.lds + LDS_X_OFF + 512);
    for (;;) {
        __syncthreads();
        if (F.tid == 0) *slot = (int)__hip_atomic_fetch_add(F.ctl + CW_ATQ + 64 * l, 1u, RLX_AGENT);
        __syncthreads();
        const int u = __builtin_amdgcn_readfirstlane(*slot);
        if (u >= nunits) break;
        if (u < 512) attn_unit(F, l, u >> 7, (u >> 5) & 3, u & 31, 0); else { const int v = u - 512; attn_unit(F, l, v >> 3, (v >> 1) & 3, v & 1, 1); }
    }
}
#define USE_CHUNK_DN 1

constexpr int DN_F_NEGW = 0, DN_F_QG = 16, DN_F_QK = 32, DN_F_KGT = 40, DN_NFRAG = 56, DN_U_OFF = 57344;
constexpr int DP_QS = 0, DP_KS = 17408, DP_VS = 34816, DP_AS = 52224  , DP_TB = 69632, DP_TW = 78848, DP_QK = 88064, DP_SC = 97280;
constexpr int DP_P = 272, DP_P2 = 144;
__device__ __forceinline__ int dn_rec(int b, int h, int dir, int np) { return ((b * 4 + h) * 2 + dir) * 68 + np; }
__device__ __forceinline__ void dn_chunk_of(int ct, int dir, int& b, int& np) { if (ct < 256) { b = ct >> 6; const int c = ct & 63; np = 4 + (dir ? 63 - c : c); } else { b = (ct - 256) >> 2; const int c = (ct - 256) & 3; np = dir ? 3 - c : c; } }
__device__ __forceinline__ unsigned short lds_u16(const LAS unsigned char* p) { return *(const LAS unsigned short*)p; }

__device__ __forceinline__ void dn_prep_unit(Frame& F, int l, int ct, int h, int dir) {
    const bf16* P = (const bf16*)(F.ws + WS_P);
    int lane = F.lane; asm volatile("" : "+v"(lane));
    const int wave = F.wave, i16 = lane & 15, q = lane >> 4;
    const int m0 = ct * 64; int t0, T, base; seq_of(m0, t0, T, base);
    int b, np; dn_chunk_of(ct, dir, b, np);
    unsigned char* tile = F.ws + WS_DNT + (size_t)dn_rec(b, h, dir, np) * DNT_BYTES;
    LAS unsigned char* L = F.lds;
    LAS float* SC = (LAS float*)(L + DP_SC);
    __syncthreads();
    {
        const float* cw = F.in[I_DNCW] + (size_t)l * 4 * 1536;
#pragma unroll 1
        for (int i = 0; i < 24; ++i) { const int rid = wave * 24 + i, part = rid >> 6, tok = rid & 63, cch = part * 512 + h * 128 + 2 * lane;
            float s0 = 0.f, s1 = 0.f;
#pragma unroll
            for (int j = 0; j < 4; ++j) { const int tt = t0 + tok + j - 2; if (tt >= 0 && tt < T) { const unsigned w = *(const unsigned*)(P + (size_t)(base + tt) * PW + PC_DQ + cch); const float2 cf = *(const float2*)(cw + j * 1536 + cch);
                s0 += cf.x * bflo(w); s1 += cf.y * bfhi(w); } }
            s0 = siluf_(s0); s1 = siluf_(s1);
            if (part < 2) { const float ss = wave_sum(s0 * s0 + s1 * s1); const float f = (part == 0 ? 0.08838834764831845f : 1.0f) / sqrtf(ss + EPS); s0 *= f; s1 *= f; }
            *(LAS unsigned*)(L + (part == 0 ? DP_QS : (part == 1 ? DP_KS : DP_VS)) + tok * DP_P + lane * 4) = pk2(s0, s1); }
        if (wave == 0) {
            const int tok = dir ? 63 - lane : lane;
            const float pb = bf2f(P[(size_t)(m0 + tok) * PW + PC_BETA + dir * 4 + h]), pa = bf2f(P[(size_t)(m0 + tok) * PW + PC_DEC + dir * 4 + h]);
            const float beta = sigmoidf_(pb); float gc = -__expf(F.in[I_DNALOG][l * 8 + dir * 4 + h]) * softplusf_(pa + F.in[I_DNDT][l * 8 + dir * 4 + h]);
#pragma unroll
            for (int o = 1; o < 64; o <<= 1) { const float v = __shfl_up(gc, o); if (lane >= o) gc += v; }
            const float glast = __shfl(gc, 63);
            SC[lane] = beta; SC[64 + lane] = gc; SC[128 + lane] = __expf(gc); SC[192 + lane] = __expf(glast - gc);
            if (lane == 63) ((float*)(F.ws + WS_DNS))[dn_rec(b, h, dir, np)] = __expf(glast);
        }
    }
    __syncthreads();
#define DN_TOK(r) (dir ? 63 - (r) : (r))
    {
        const int mb = wave & 3, which = wave >> 2;
        f32x4 acc[4];
#pragma unroll
        for (int nb = 0; nb < 4; ++nb) acc[nb] = (f32x4){0.f, 0.f, 0.f, 0.f};
        const LAS unsigned char* arow = L + (which ? DP_QS : DP_KS) + DN_TOK(16 * mb + i16) * DP_P + 16 * q;
#pragma unroll
        for (int ks = 0; ks < 4; ++ks) { const bf16x8 a = *(const LAS bf16x8*)(arow + 64 * ks);
#pragma unroll
            for (int nb = 0; nb < 4; ++nb) { const bf16x8 bb = *(const LAS bf16x8*)(L + DP_KS + DN_TOK(16 * nb + i16) * DP_P + 16 * q + 64 * ks);
                acc[nb] = __builtin_amdgcn_mfma_f32_16x16x32_bf16(a, bb, acc[nb], 0, 0, 0); } }
#pragma unroll
        for (int nb = 0; nb < 4; ++nb)
#pragma unroll
            for (int i = 0; i < 4; ++i) { const int r = 16 * mb + 4 * q + i, c = 16 * nb + i16; const float dec = __expf(SC[64 + r] - SC[64 + c]);
                if (which == 0) ((LAS float*)(L + DP_AS))[r * 68 + c] = (r > c) ? SC[r] * acc[nb][i] * dec : 0.f;
                else *(LAS unsigned short*)(L + DP_QK + r * DP_P2 + c * 2) = (unsigned short)f2bf((r >= c) ? acc[nb][i] * dec : 0.f); }
    }
    __syncthreads();
    if (wave == 0) {
        const LAS float* As = (const LAS float*)(L + DP_AS);
        float t[64];
#pragma unroll
        for (int r = 0; r < 64; ++r) { float a0 = (lane == r) ? 1.f : 0.f, a1 = 0.f, a2 = 0.f, a3 = 0.f;
#pragma unroll
            for (int j4 = 0; j4 < (r + 3) / 4; ++j4) { const f32x4 av = *(const LAS f32x4*)(As + r * 68 + 4 * j4);
                if (4 * j4 + 0 < r) a0 -= av.x * t[4 * j4 + 0]; if (4 * j4 + 1 < r) a1 -= av.y * t[4 * j4 + 1]; if (4 * j4 + 2 < r) a2 -= av.z * t[4 * j4 + 2]; if (4 * j4 + 3 < r) a3 -= av.w * t[4 * j4 + 3]; }
            t[r] = (a0 + a1) + (a2 + a3); }
        const float bl = SC[lane], bw = bl * SC[128 + lane];
#pragma unroll
        for (int r = 0; r < 64; ++r) { *(LAS unsigned short*)(L + DP_TB + r * DP_P2 + lane * 2) = (unsigned short)f2bf(t[r] * bl); *(LAS unsigned short*)(L + DP_TW + r * DP_P2 + lane * 2) = (unsigned short)f2bf(t[r] * bw); }
    }
    __syncthreads();
    {
        const int nbp = wave & 3, which = wave >> 2;
        f32x4 acc[4][2];
#pragma unroll
        for (int mb = 0; mb < 4; ++mb) { acc[mb][0] = (f32x4){0.f, 0.f, 0.f, 0.f}; acc[mb][1] = (f32x4){0.f, 0.f, 0.f, 0.f}; }
#pragma unroll
        for (int ks = 0; ks < 2; ++ks) {
            bf16x8 bb[2];
#pragma unroll
            for (int nn = 0; nn < 2; ++nn) { const int n = 16 * (2 * nbp + nn) + i16; unsigned short e[8];
#pragma unroll
                for (int jj = 0; jj < 8; ++jj) e[jj] = lds_u16(L + (which ? DP_KS : DP_VS) + DN_TOK(32 * ks + 8 * q + jj) * DP_P + n * 2);
                v4u w; w.x = e[0] | ((unsigned)e[1] << 16); w.y = e[2] | ((unsigned)e[3] << 16); w.z = e[4] | ((unsigned)e[5] << 16); w.w = e[6] | ((unsigned)e[7] << 16); bb[nn] = __builtin_bit_cast(bf16x8, w); }
#pragma unroll
            for (int mb = 0; mb < 4; ++mb) { const bf16x8 a = *(const LAS bf16x8*)(L + (which ? DP_TW : DP_TB) + (16 * mb + i16) * DP_P2 + 64 * ks + 16 * q);
                acc[mb][0] = __builtin_amdgcn_mfma_f32_16x16x32_bf16(a, bb[0], acc[mb][0], 0, 0, 0); acc[mb][1] = __builtin_amdgcn_mfma_f32_16x16x32_bf16(a, bb[1], acc[mb][1], 0, 0, 0); } }
        if (which == 0) {
#pragma unroll
            for (int mb = 0; mb < 4; ++mb)
#pragma unroll
                for (int nn = 0; nn < 2; ++nn) *(f32x4*)(tile + DN_U_OFF + (size_t)((((2 * nbp + nn) * 4 + mb) * 64 + lane) * 16)) = acc[mb][nn];
        } else {
#pragma unroll
            for (int mb = 0; mb < 4; ++mb)
#pragma unroll
                for (int nn = 0; nn < 2; ++nn)
#pragma unroll
                    for (int i = 0; i < 4; ++i) *(LAS unsigned short*)(L + DP_AS + (16 * mb + 4 * q + i) * DP_P + (16 * (2 * nbp + nn) + i16) * 2) = (unsigned short)f2bf(-acc[mb][nn][i]);
        }
    }
    __syncthreads();
#pragma unroll 1
    for (int fi = 0; fi < 7; ++fi) { const int f = wave * 7 + fi; v4u o;
        if (f < DN_F_QG) { const int mb = f >> 2, ks = f & 3; const LAS unsigned char* rp = L + DP_AS + (16 * mb + i16) * DP_P + (32 * ks + 4 * q) * 2;
            const v2u a = *(const LAS v2u*)rp, c = *(const LAS v2u*)(rp + 32); o.x = a.x; o.y = a.y; o.z = c.x; o.w = c.y; }
        else if (f < DN_F_QK) { const int ff = f - DN_F_QG, mb = ff >> 2, ks = ff & 3, r = 16 * mb + i16; const LAS unsigned char* rp = L + DP_QS + DN_TOK(r) * DP_P + (32 * ks + 4 * q) * 2; const float eg = SC[128 + r];
            const v2u a = *(const LAS v2u*)rp, c = *(const LAS v2u*)(rp + 32);
            o.x = pk2(bflo(a.x) * eg, bfhi(a.x) * eg); o.y = pk2(bflo(a.y) * eg, bfhi(a.y) * eg); o.z = pk2(bflo(c.x) * eg, bfhi(c.x) * eg); o.w = pk2(bflo(c.y) * eg, bfhi(c.y) * eg); }
        else if (f < DN_F_KGT) { const int ff = f - DN_F_QK, mb = ff >> 1, ks = ff & 1; const LAS unsigned char* rp = L + DP_QK + (16 * mb + i16) * DP_P2 + (32 * ks + 4 * q) * 2;
            const v2u a = *(const LAS v2u*)rp, c = *(const LAS v2u*)(rp + 32); o.x = a.x; o.y = a.y; o.z = c.x; o.w = c.y; }
        else { const int ff = f - DN_F_KGT, mb = ff >> 1, ks = ff & 1, dk = 16 * mb + i16; float e[8];
#pragma unroll
            for (int jj = 0; jj < 8; ++jj) { const int key = 32 * ks + 16 * (jj >> 2) + 4 * q + (jj & 3); e[jj] = bf2f(lds_u16(L + DP_KS + DN_TOK(key) * DP_P + dk * 2)) * SC[192 + key]; }
            o.x = pk2(e[0], e[1]); o.y = pk2(e[2], e[3]); o.z = pk2(e[4], e[5]); o.w = pk2(e[6], e[7]); }
        *(v4u*)(tile + (size_t)f * 1024 + lane * 16) = o; }
#undef DN_TOK
}
__device__ __forceinline__ void dn_prep(Frame& F, int l) {
    for (int u = F.bid; u < NCT * 4 * 2; u += F.G) dn_prep_unit(F, l, u >> 3, (u >> 1) & 3, u & 1);
    __syncthreads();
}

__device__ __forceinline__ void dn_scan(Frame& F, int l, int b, int h, int dir) {
    int lane = F.lane; asm volatile("" : "+v"(lane));
    const int w = F.wave, i16 = lane & 15, q = lane >> 4;
    const unsigned char* tiles = F.ws + WS_DNT + (size_t)dn_rec(b, h, dir, 0) * DNT_BYTES;
    const float* egl = (const float*)(F.ws + WS_DNS) + dn_rec(b, h, dir, 0);
    float* O = (float*)(F.ws + WS_DNO);
    LAS unsigned char* L = F.lds;
    f32x4 S[8];
#pragma unroll
    for (int i = 0; i < 8; ++i) S[i] = (f32x4){0.f, 0.f, 0.f, 0.f};
    v4u st[7];
    __syncthreads();
#pragma unroll
    for (int i = 0; i < 7; ++i) st[i] = *(const v4u*)(tiles + (size_t)(F.tid + i * NTHREADS) * 16);
#pragma unroll
    for (int i = 0; i < 7; ++i) *(LAS v4u*)(L + (F.tid + i * NTHREADS) * 16) = st[i];
    __syncthreads();
#pragma unroll 1
    for (int n = 0; n < 68; ++n) {
        const unsigned char* tile = tiles + (size_t)n * DNT_BYTES; const LAS unsigned char* cur = L + (n & 1) * 57344;
        if (n + 1 < 68) {
#pragma unroll
            for (int i = 0; i < 7; ++i) st[i] = *(const v4u*)(tile + DNT_BYTES + (size_t)(F.tid + i * NTHREADS) * 16); }
        f32x4 vn[4];
#pragma unroll
        for (int mb = 0; mb < 4; ++mb) vn[mb] = *(const f32x4*)(tile + DN_U_OFF + (size_t)(((w * 4 + mb) * 64 + lane) * 16));
        const float el = egl[n];
        bf16x8 bS[4];
#pragma unroll
        for (int ks = 0; ks < 4; ++ks) { v4u x; x.x = pk2(S[2 * ks][0], S[2 * ks][1]); x.y = pk2(S[2 * ks][2], S[2 * ks][3]); x.z = pk2(S[2 * ks + 1][0], S[2 * ks + 1][1]); x.w = pk2(S[2 * ks + 1][2], S[2 * ks + 1][3]); bS[ks] = __builtin_bit_cast(bf16x8, x); }
        f32x4 o[4];
#pragma unroll
        for (int mb = 0; mb < 4; ++mb) { o[mb] = (f32x4){0.f, 0.f, 0.f, 0.f};
#pragma unroll
            for (int ks = 0; ks < 4; ++ks) { const bf16x8 aw = *(const LAS bf16x8*)(cur + (DN_F_NEGW + mb * 4 + ks) * 1024 + lane * 16), aq = *(const LAS bf16x8*)(cur + (DN_F_QG + mb * 4 + ks) * 1024 + lane * 16);
                vn[mb] = __builtin_amdgcn_mfma_f32_16x16x32_bf16(aw, bS[ks], vn[mb], 0, 0, 0); o[mb] = __builtin_amdgcn_mfma_f32_16x16x32_bf16(aq, bS[ks], o[mb], 0, 0, 0); } }
        bf16x8 bV[2];
#pragma unroll
        for (int ks = 0; ks < 2; ++ks) { v4u x; x.x = pk2(vn[2 * ks][0], vn[2 * ks][1]); x.y = pk2(vn[2 * ks][2], vn[2 * ks][3]); x.z = pk2(vn[2 * ks + 1][0], vn[2 * ks + 1][1]); x.w = pk2(vn[2 * ks + 1][2], vn[2 * ks + 1][3]); bV[ks] = __builtin_bit_cast(bf16x8, x); }
#pragma unroll
        for (int mb = 0; mb < 8; ++mb) { S[mb] = S[mb] * el;
#pragma unroll
            for (int ks = 0; ks < 2; ++ks) { const bf16x8 ak = *(const LAS bf16x8*)(cur + (DN_F_KGT + mb * 2 + ks) * 1024 + lane * 16); S[mb] = __builtin_amdgcn_mfma_f32_16x16x32_bf16(ak, bV[ks], S[mb], 0, 0, 0); } }
#pragma unroll
        for (int mb = 0; mb < 4; ++mb)
#pragma unroll
            for (int ks = 0; ks < 2; ++ks) { const bf16x8 aqk = *(const LAS bf16x8*)(cur + (DN_F_QK + mb * 2 + ks) * 1024 + lane * 16); o[mb] = __builtin_amdgcn_mfma_f32_16x16x32_bf16(aqk, bV[ks], o[mb], 0, 0, 0); }
        { int m0; if (n < 4) m0 = NLAT + b * CTXL + 64 * (dir ? 3 - n : n); else m0 = b * SEQ + 64 * (dir ? 63 - (n - 4) : (n - 4));
#pragma unroll
          for (int mb = 0; mb < 4; ++mb)
#pragma unroll
            for (int i = 0; i < 4; ++i) { const int r = 16 * mb + 4 * q + i, tok = dir ? 63 - r : r; O[((size_t)dir * NTOK + m0 + tok) * 512 + h * 128 + 16 * w + i16] = o[mb][i]; } }
        if (n + 1 < 68) {
#pragma unroll
            for (int i = 0; i < 7; ++i) *(LAS v4u*)(L + ((n + 1) & 1) * 57344 + (F.tid + i * NTHREADS) * 16) = st[i]; }
        __syncthreads();
    }
}

constexpr size_t WS_DNQ = WS_DNT;
constexpr size_t WS_BG = WS_DNS + 1 * MiB;
constexpr size_t WS_XC = WS_XS;

__device__ __forceinline__ void naive_prep(Frame& F, int l) {
    const bf16* P = (const bf16*)(F.ws + WS_P);
    const int gw = F.bid * NWAVES + F.wave, NGW = F.G * NWAVES;
#if !defined(USE_CHUNK_DN)
    {
        float* DNQ = (float*)(F.ws + WS_DNQ); float* BG = (float*)(F.ws + WS_BG);
        const float* cw = F.in[I_DNCW] + (size_t)l * 4 * 1536;
        for (int it = gw; it < NTOK * 4; it += NGW) {
            const int m = it >> 2, h = it & 3; int t, T, base; seq_of(m, t, T, base);
            float val[3][2];
#pragma unroll
            for (int part = 0; part < 3; ++part)
#pragma unroll
                for (int dd = 0; dd < 2; ++dd) { const int d = F.lane + 64 * dd, cch = part * 512 + h * 128 + d, col = PC_DQ + cch; float s = 0.f;
#pragma unroll
                    for (int j = 0; j < 4; ++j) { const int tt = t + j - 2; if (tt >= 0 && tt < T) s += cw[j * 1536 + cch] * bf2f(P[(size_t)(base + tt) * PW + col]); }
                    val[part][dd] = siluf_(s); }
            const float sq = wave_sum(val[0][0] * val[0][0] + val[0][1] * val[0][1]), sk = wave_sum(val[1][0] * val[1][0] + val[1][1] * val[1][1]);
            const float fq = 0.08838834764831845f / sqrtf(sq + EPS), fk = 1.0f / sqrtf(sk + EPS);
#pragma unroll
            for (int dd = 0; dd < 2; ++dd) { const int d = F.lane + 64 * dd; float* o = DNQ + (size_t)m * 1536 + h * 128 + d;
                o[0] = val[0][dd] * fq; o[512] = val[1][dd] * fk; o[1024] = val[2][dd]; }
            if (h == 0 && F.lane < 8) { const int dir = F.lane >> 2, hh = F.lane & 3;
                const float pb = bf2f(P[(size_t)m * PW + PC_BETA + F.lane]), pa = bf2f(P[(size_t)m * PW + PC_DEC + F.lane]);
                BG[m * 16 + F.lane] = sigmoidf_(pb);
                BG[m * 16 + 8 + F.lane] = -__expf(F.in[I_DNALOG][l * 8 + dir * 4 + hh]) * softplusf_(pa + F.in[I_DNDT][l * 8 + dir * 4 + hh]); }
        }
    }
#endif
    {
        LAS float* xc = (LAS float*)F.lds;
        float* A = (float*)(F.ws + WS_LRA); float* U = (float*)(F.ws + WS_LRH);
        const float* cw = F.in[I_LRCW] + (size_t)l * 4 * 512; const float* cb = F.in[I_LRCB] + l * 512;
        for (int m0 = F.bid * 8; m0 < NTOK; m0 += F.G * 8) {
            __syncthreads();
            for (int i = F.tid; i < 8 * 512; i += NTHREADS) { const int m = m0 + (i >> 9), ch = i & 511; int t, T, base; seq_of(m, t, T, base); float s = cb[ch];
#pragma unroll
                for (int j = 0; j < 4; ++j) { const int tt = t + j - 2; if (tt >= 0 && tt < T) s += cw[j * 512 + ch] * bf2f(P[(size_t)(base + tt) * PW + PC_LX + ch]); }
                xc[i] = s; }
            __syncthreads();
            for (int i = F.tid; i < 8 * 512 * 2; i += NTHREADS) { const int ch = i & 511, dir = (i >> 9) & 1, tk = i >> 10, m = m0 + tk, blk = ch >> 6, j = ch & 63;
                const float* wr = F.in[I_LRWR] + ((size_t)((l * 2 + dir) * 8 + blk)) * 4096 + j; const float* wi = F.in[I_LRWI] + ((size_t)((l * 2 + dir) * 8 + blk)) * 4096 + j;
                float sr = F.in[I_LRBR][(l * 2 + dir) * 512 + ch], si = F.in[I_LRBI][(l * 2 + dir) * 512 + ch];
#pragma unroll 8
                for (int ii = 0; ii < 64; ++ii) { const float x = xc[tk * 512 + blk * 64 + ii]; sr += x * wr[ii * 64]; si += x * wi[ii * 64]; }
                const float r = sigmoidf_(sr), ig = sigmoidf_(si); const float lam = F.in[I_LRLAM][(l * 2 + dir) * 512 + ch];
                const float logsig = -softplusf_(-lam);
                const float log_a = 8.0f * r * logsig; const float a = __expf(log_a);
                const float u = sqrtf(-expm1f(2.0f * log_a)) * (ig * xc[tk * 512 + ch]);
                A[((size_t)dir * NTOK + m) * 512 + ch] = a; U[((size_t)dir * NTOK + m) * 512 + ch] = u; }
        }
        __syncthreads();
    }
}

__device__ __forceinline__ void naive_attn_row(Frame& F, int l, int m, int hq) {
    const bf16* P = (const bf16*)(F.ws + WS_P); bf16* CC = (bf16*)(F.ws + WS_CC);
    const int d = F.lane, kvh = hq >> 2; int t, T, base; seq_of(m, t, T, base);
    const bool lat = m < NLAT; const int b = lat ? (m >> 12) : ((m - NLAT) >> 8);
    const int dd = d & 31, jf = dd & 15; const float inv = __powf(10000.0f, -(float)jf * (1.0f / 16.0f));
    const bool second = (dd >= 16), colhalf = (d >= 32);
    float q = bf2f(P[(size_t)m * PW + PC_Q + hq * 64 + d]);
    if (lat) { const float pos = (float)(colhalf ? (t & 63) : (t >> 6)); float sn, cs; sincosf(pos * inv, &sn, &cs); const float pr = __shfl_xor(q, 16); q = second ? (q * cs + pr * sn) : (q * cs - pr * sn); }
    q *= 0.125f;
    float mx = F.in[I_SINK][l * 16 + hq], den = 1.0f, acc = 0.f;
    if (lat) { const int t0 = t - 128 < 0 ? 0 : t - 128, t1 = t + 128 > SEQ - 1 ? SEQ - 1 : t + 128;
        for (int tk = t0; tk <= t1; ++tk) { const size_t r = (size_t)(base + tk) * PW; float k = bf2f(P[r + PC_K + kvh * 64 + d]); const float v = bf2f(P[r + PC_V + kvh * 64 + d]);
            const float pos = (float)(colhalf ? (tk & 63) : (tk >> 6)); float sn, cs; sincosf(pos * inv, &sn, &cs); const float pr = __shfl_xor(k, 16); k = second ? (k * cs + pr * sn) : (k * cs - pr * sn);
            const float s = wave_sum(q * k); const float mn = fmaxf(mx, s), f = __expf(mx - mn), p = __expf(s - mn); den = den * f + p; acc = acc * f + p * v; mx = mn; } }
    for (int c = 0; c < CTXL; ++c) { const size_t r = (size_t)(NLAT + b * CTXL + c) * PW; const float k = bf2f(P[r + PC_K + kvh * 64 + d]), v = bf2f(P[r + PC_V + kvh * 64 + d]);
        const float s = wave_sum(q * k); const float mn = fmaxf(mx, s), f = __expf(mx - mn), p = __expf(s - mn); den = den * f + p; acc = acc * f + p * v; mx = mn; }
    CC[(size_t)m * DM + hq * 64 + d] = (bf16)f2bf(acc / den);
}

__device__ __forceinline__ int scan_row(int n, int b, int dir) { if (n < CTXL) { const int t = dir ? (CTXL - 1 - n) : n; return NLAT + b * CTXL + t; } const int t = dir ? (SEQ - 1 - (n - CTXL)) : (n - CTXL); return b * SEQ + t; }
__device__ __forceinline__ void naive_scan(Frame& F, int l) {
#if defined(USE_CHUNK_DN)
    if (F.bid < 32) { dn_scan(F, l, F.bid >> 3, (F.bid >> 1) & 3, F.bid & 1); }
#else
    if (F.bid < 32) {
        const int b = F.bid >> 3, h = (F.bid >> 1) & 3, dir = F.bid & 1, dvc = F.tid & 127, kq = F.tid >> 7;
        const float* DNQ = (const float*)(F.ws + WS_DNQ); const float* BG = (const float*)(F.ws + WS_BG); float* O = (float*)(F.ws + WS_DNO);
        LAS float* buf = (LAS float*)F.lds;
        LAS float* red = buf + 768;
        LAS float* red2 = red + 512;
        float S[32];
#pragma unroll
        for (int i = 0; i < 32; ++i) S[i] = 0.f;
        constexpr int NT = CTXL + SEQ;
        { const int m = scan_row(0, b, dir); if (F.tid < 384) buf[F.tid] = DNQ[(size_t)m * 1536 + (F.tid >> 7) * 512 + h * 128 + (F.tid & 127)]; }
        __syncthreads();
#pragma unroll 1
        for (int n = 0; n < NT; ++n) {
            const int m = scan_row(n, b, dir); const LAS float* cur = buf + (n & 1) * 384;
            float nextv = 0.f; if (n + 1 < NT && F.tid < 384) { const int m2 = scan_row(n + 1, b, dir); nextv = DNQ[(size_t)m2 * 1536 + (F.tid >> 7) * 512 + h * 128 + (F.tid & 127)]; }
            const float beta = BG[m * 16 + dir * 4 + h], decay = __expf(BG[m * 16 + 8 + dir * 4 + h]);
            float ks = 0.f;
#pragma unroll
            for (int i = 0; i < 32; ++i) ks += cur[128 + kq * 32 + i] * S[i];
            red[kq * 128 + dvc] = ks;
            __syncthreads();
            const float kS = (red[dvc] + red[128 + dvc]) + (red[256 + dvc] + red[384 + dvc]);
            const float upd = beta * (cur[256 + dvc] - decay * kS);
            float os = 0.f;
#pragma unroll
            for (int i = 0; i < 32; ++i) { S[i] = decay * S[i] + cur[128 + kq * 32 + i] * upd; os += cur[kq * 32 + i] * S[i]; }
            red2[kq * 128 + dvc] = os;
            if (F.tid < 384) buf[((n + 1) & 1) * 384 + F.tid] = nextv;
            __syncthreads();
            if (kq == 0) O[((size_t)dir * NTOK + m) * 512 + h * 128 + dvc] = (red2[dvc] + red2[128 + dvc]) + (red2[256 + dvc] + red2[384 + dvc]);
        }
    }
#endif
    else if (F.bid < 40) {
        const int idx = (F.bid - 32) * NTHREADS + F.tid, ch = idx & 511, dir = (idx >> 9) & 1, b = idx >> 10;
        const float* A = (const float*)(F.ws + WS_LRA); float* U = (float*)(F.ws + WS_LRH);
        float hs = 0.f;
#pragma unroll 4
        for (int n = 0; n < CTXL + SEQ; ++n) { int m; if (n < CTXL) { const int t = dir ? (CTXL - 1 - n) : n; m = NLAT + b * CTXL + t; } else { const int t = dir ? (SEQ - 1 - (n - CTXL)) : (n - CTXL); m = b * SEQ + t; }
            const size_t o = ((size_t)dir * NTOK + m) * 512 + ch; hs = A[o] * hs + U[o]; U[o] = hs; }
    }
#if defined(USE_MFMA_ATTN)
    attn_phase(F, l);
#else
    {
        const int nrows = (l == 0) ? NTOK : NLAT;
        for (;;) { int m = 0; if (F.lane == 0) m = (int)__hip_atomic_fetch_add(F.ctl + CW_ATQ + 64 * l, 1u, RLX_AGENT); m = __builtin_amdgcn_readfirstlane(m);
            if (m >= nrows) break;
#pragma unroll 1
            for (int hq = 0; hq < 16; ++hq) naive_attn_row(F, l, m, hq); }
    }
#endif
}

__device__ __forceinline__ void naive_fin(Frame& F, int l) {
    const int nrows = (l == 0) ? NTOK : NLAT;
    const bf16* P = (const bf16*)(F.ws + WS_P); bf16* CC = (bf16*)(F.ws + WS_CC);
    const int gw = F.bid * NWAVES + F.wave, NGW = F.G * NWAVES;
    const float* O = (const float*)(F.ws + WS_DNO); const float* HS = (const float*)(F.ws + WS_LRH);
    for (int it = gw; it < nrows * 4; it += NGW) { const int m = it >> 2, h = it & 3; float o[2];
#pragma unroll
        for (int dd = 0; dd < 2; ++dd) { const int c = h * 128 + F.lane + 64 * dd; o[dd] = O[(size_t)m * 512 + c] + O[((size_t)NTOK + m) * 512 + c]; }
        const float rstd = 1.0f / sqrtf(wave_sum(o[0] * o[0] + o[1] * o[1]) * (1.0f / 128.0f) + EPS);
#pragma unroll
        for (int dd = 0; dd < 2; ++dd) { const int d = F.lane + 64 * dd; const float gt = bf2f(P[(size_t)m * PW + PC_DG + h * 128 + d]);
            CC[(size_t)m * DM + 1024 + h * 128 + d] = (bf16)f2bf(o[dd] * rstd * F.in[I_DNNG][l * 128 + d] * siluf_(gt)); }
    }
    for (size_t i = (size_t)F.bid * NTHREADS + F.tid; i < (size_t)nrows * 512; i += (size_t)F.G * NTHREADS) { const int m = (int)(i >> 9), ch = (int)(i & 511);
        const float hsum = HS[(size_t)m * 512 + ch] + HS[((size_t)NTOK + m) * 512 + ch]; const float y = bf2f(P[(size_t)m * PW + PC_LY + ch]);
        CC[(size_t)m * DM + 1536 + ch] = (bf16)f2bf(hsum * gelu_tanh(y)); }
}
#ifndef PHASE_PREP
#if defined(USE_MFMA_ATTN)
#if defined(USE_CHUNK_DN)
#define PHASE_PREP(F, l) do { naive_prep(F, l); attn_prep(F, l); dn_prep(F, l); } while (0)
#else
#define PHASE_PREP(F, l) do { naive_prep(F, l); attn_prep(F, l); } while (0)
#endif
#else
#define PHASE_PREP(F, l) naive_prep(F, l)
#endif
#endif
#ifndef PHASE_SCAN
#define PHASE_SCAN(F, l) naive_scan(F, l)
#endif
#ifndef PHASE_FIN
#define PHASE_FIN(F, l) naive_fin(F, l)
#endif

#ifndef PHASE_INPROJ
#define PHASE_INPROJ(F, l) do {} while (0)
#endif
#ifndef PHASE_PREP
#define PHASE_PREP(F, l) do {} while (0)
#endif
#ifndef PHASE_SCAN
#define PHASE_SCAN(F, l) do {} while (0)
#endif
#ifndef PHASE_FIN
#define PHASE_FIN(F, l) do {} while (0)
#endif
#ifndef PHASE_OUTPROJ
#define PHASE_OUTPROJ(F, l) do {} while (0)
#endif
#ifndef PHASE_NORM2
#define PHASE_NORM2(F, l) do {} while (0)
#endif
#ifndef PHASE_SCATTER
#define PHASE_SCATTER(F, l) do {} while (0)
#endif
#ifndef PHASE_GEMM1
#define PHASE_GEMM1(F, l) do {} while (0)
#endif
#ifndef PHASE_GEMM2
#define PHASE_GEMM2(F, l) do {} while (0)
#endif

#ifndef MK_SPLIT
#define MK_SPLIT 0
#endif
#ifndef MK_STAGE
#define MK_STAGE 99
#endif
constexpr int N_PHASES = 22;
struct Args { const float* in[N_IN]; float* out; unsigned char* ws; int ph_lo, ph_hi; };
static_assert(sizeof(Args) == (N_IN + 2) * 8 + 8, "Args has no padding");

__global__ void __launch_bounds__(NTHREADS, 2) fwd_kernel(Args args) {
    extern __shared__ __attribute__((aligned(16))) unsigned char lds[];
    Frame F;
    F.lds = (LAS unsigned char*)lds;
    F.MISC = (volatile LAS unsigned*)(F.lds + MISC_OFF);
    F.tid = threadIdx.x; F.lane = F.tid & 63; F.wave = __builtin_amdgcn_readfirstlane(F.tid >> 6);
    F.G = gridDim.x; F.bid = blockIdx.x;
    F.ws = args.ws; F.out = args.out; F.ctl = (gu32*)(args.ws + WS_CTL);
    F.in = (const float* const __attribute__((address_space(4)))*)__builtin_amdgcn_kernarg_segment_ptr();
    for (int u = F.tid; u < (LDS_BYTES - LDSCTL_OFF) / 4; u += NTHREADS) ((LAS unsigned*)(F.lds + LDSCTL_OFF))[u] = 0u;
    __syncthreads();
    XcdBarrier bar; bar.bar = (unsigned*)(F.ctl + CW_BAR); bar.x = 0; bar.st = nullptr;
    if (!MK_SPLIT) bar = xcd_barrier_post((unsigned*)(F.ctl + CW_BAR), F.MISC + 8);
    const int lo = args.ph_lo, hi = args.ph_hi;
#define IN(k) (lo <= (k) && (k) < hi && phase_enter(F))
#define INR(k) (lo <= (k) && (k) < hi)
#define SEAM(k) do { if (INR(k) && INR((k) + 1)) xcd_barrier(bar); } while (0)

    if (IN(0)) { p0_prologue(F); } SEAM(0);
#pragma unroll 1
    for (int l = 0; l < DEPTH; ++l) {
        const int pb = 1 + 10 * l;
        if (IN(pb + 0)) { phase_norm1(F, l); } SEAM(pb + 0);
        if (IN(pb + 1)) { PHASE_INPROJ(F, l); } SEAM(pb + 1);
        if (IN(pb + 2)) { PHASE_PREP(F, l); } SEAM(pb + 2);
        if (IN(pb + 3)) { PHASE_SCAN(F, l); } SEAM(pb + 3);
        if (IN(pb + 4)) { PHASE_FIN(F, l); } SEAM(pb + 4);
        if (IN(pb + 5)) { PHASE_OUTPROJ(F, l); } SEAM(pb + 5);
        if (IN(pb + 6)) { PHASE_NORM2(F, l); } SEAM(pb + 6);
        if (IN(pb + 7)) { PHASE_SCATTER(F, l); } SEAM(pb + 7);
        if (IN(pb + 8)) { PHASE_GEMM1(F, l); } SEAM(pb + 8);
        if (IN(pb + 9)) { PHASE_GEMM2(F, l); } SEAM(pb + 9);
    }
    if (IN(21)) { phase_final(F, MK_STAGE >= 9); }
#undef IN
#undef SEAM
}

extern "C" void kernel_launch(void* const* d_in, const int* in_sizes, int n_in, void* d_out, int out_size, void* d_ws, size_t ws_size, hipStream_t stream) {
    static int grid = 0;
    if (grid == 0) {
        if (n_in != N_IN || out_size != NLAT * DM || ws_size < WS_END) { fprintf(stderr, "kernel_launch: unexpected shapes (n_in %d, out %d, ws %zu); nothing launched\n", n_in, out_size, ws_size); grid = -1; return; }
        int dev = 0, cus = 0, per_cu = 0;
        if (hipGetDevice(&dev) != hipSuccess || hipDeviceGetAttribute(&cus, hipDeviceAttributeMultiprocessorCount, dev) != hipSuccess) { grid = -1; return; }
        if (hipFuncSetAttribute((const void*)fwd_kernel, hipFuncAttributeMaxDynamicSharedMemorySize, LDS_BYTES) != hipSuccess) { fprintf(stderr, "kernel_launch: hipFuncSetAttribute failed\n"); grid = -1; return; }
        if (hipOccupancyMaxActiveBlocksPerMultiprocessor(&per_cu, (const void*)fwd_kernel, NTHREADS, LDS_BYTES) != hipSuccess || per_cu < 1) { fprintf(stderr, "kernel_launch: occupancy query says %d\n", per_cu); }
        (void)hipGetLastError();
        grid = cus;
        if (grid != 256) { fprintf(stderr, "kernel_launch: built for 256 CUs, device has %d; nothing launched\n", cus); grid = -1; return; }
    }
    if (grid < 0) return;
    if (hipMemsetAsync((char*)d_ws + WS_CTL, 0, CTL_ZERO_BYTES, stream) != hipSuccess) return;
    Args a{};
    for (int i = 0; i < N_IN; ++i) a.in[i] = (const float*)d_in[i];
    a.out = (float*)d_out; a.ws = (unsigned char*)d_ws;
#if MK_SPLIT
    for (int p = 0; p < N_PHASES; ++p) { a.ph_lo = p; a.ph_hi = p + 1; hipLaunchKernelGGL(fwd_kernel, dim3(grid), dim3(NTHREADS), LDS_BYTES, stream, a); }
#else
    a.ph_lo = 0; a.ph_hi = N_PHASES;
    hipLaunchKernelGGL(fwd_kernel, dim3(grid), dim3(NTHREADS), LDS_BYTES, stream, a);
#endif
    const hipError_t le = hipPeekAtLastError();
    if (le != hipSuccess) fprintf(stderr, "kernel_launch: launch failed: %s\n", hipGetErrorName(le));
}
```

```cpp
#include <hip/hip_runtime.h>
#include <cstdio>
#include <cstdint>

constexpr int DM = 2048, NB = 4, SEQ = 4096, CTXL = 256, DEPTH = 2;
constexpr int NLAT = NB * SEQ, NCTX = NB * CTXL, NTOK = NLAT + NCTX;
constexpr int NCT = NTOK / 64;
constexpr int IN_W = 4624, PW = 4864;
constexpr int PC_Q = 0, PC_K = 1024, PC_V = 1280, PC_DQ = 1536, PC_DK = 2048, PC_DV = 2560, PC_DG = 3072, PC_LX = 3584, PC_LY = 4096, PC_BETA = 4608, PC_DEC = 4616;
constexpr int NEXP = 32, TOPK = 4, DEXP = 1024;
constexpr int MOE_ROWS = 304 * 256;
constexpr float EPS = 1e-6f;
#ifndef MK_STAGE
#define MK_STAGE 99
#endif
namespace pg8 {
#define PG8_LAS __attribute__((address_space(3)))
typedef unsigned short bf16_t;
typedef short bf16x8 __attribute__((ext_vector_type(8)));
typedef float f32x4 __attribute__((ext_vector_type(4)));
typedef unsigned u32x4 __attribute__((ext_vector_type(4)));
typedef float f32x2 __attribute__((ext_vector_type(2)));
constexpr int BM = 256, BK = 64, HALF = 128, HTB = HALF * BK * 2  , STAGE_BYTES = 8 * HTB, NXCD = 8, WGM = 8;

__host__ __device__ __forceinline__ int lds_byte(int r, int c) { const int st = (r >> 4) * 2 + (c >> 5), rr = r & 15, cc = c & 31, ob = rr * 64 + cc * 2; return st * 1024 + (ob ^ (((ob >> 9) & 1) << 5)); }
__host__ __device__ __forceinline__ void stage_rc(int b, int& R, int& C) { const int st = b / 1024, sb = b % 1024, swz = sb ^ (((sb >> 9) & 1) << 5); R = (st >> 1) * 16 + swz / 64; C = (st & 1) * 32 + (swz % 64) / 2; }
__host__ __device__ __forceinline__ int perm32(int rho) { const int n = rho >> 4, i = rho & 15; return 8 * (i >> 2) + 4 * n + (i & 3); }

struct Unit { int pm, pn, e; };
struct Gemm { const bf16_t* A; const bf16_t* Bt; int M, N, K; };

struct StaticOrder {
    int nM, nN, nwg, G, c; const char* A; const char* Bt; size_t tstep;
    __device__ void init(const Gemm& g, int G_, int c_) { nM = g.M / BM; nN = g.N / BM; nwg = nM * nN; G = G_; c = c_; A = (const char*)g.A; Bt = (const char*)g.Bt; tstep = (size_t)BM * g.K * 2; }
    __device__ bool next(int i, Unit& u) const {
        const long L = (long)i * G + c; if (L >= nwg) return false;
        int wgid = (int)L; { const int q = nwg / NXCD, r = nwg % NXCD, xcd = wgid % NXCD, off = wgid / NXCD; wgid = (xcd < r ? xcd * (q + 1) : r * (q + 1) + (xcd - r) * q) + off; }
        const int nig = WGM * nN, gid = wgid / nig, fm = gid * WGM, gsz = (nM - fm) < WGM ? (nM - fm) : WGM;
        u.pm = fm + ((wgid % nig) % gsz); u.pn = (wgid % nig) / gsz; u.e = 0; return true;
    }
    __device__ __forceinline__ const char* a_ptr(const Unit& u) const { return A + (size_t)u.pm * tstep; }
    __device__ __forceinline__ const char* b_ptr(const Unit& u) const { return Bt + (size_t)u.pn * tstep; }
    __device__ __forceinline__ void a_ready(const Unit&) const {}
    __device__ __forceinline__ void done(const Unit&) const {}
};
__device__ __forceinline__ unsigned cvt_pk_bf16(float lo, float hi) { unsigned r; asm volatile("v_cvt_pk_bf16_f32 %0, %1, %2" : "=v"(r) : "v"(lo), "v"(hi)); return r; }
struct EpiBf16Plain {
    static constexpr bool PERM = true, AFTER_DRAIN = false;
    bf16_t* O; int ldc;
    __device__ __forceinline__ void operator()(const f32x4 (&acc)[2][2][4][2], const Unit& u, int wr, int wc, int fr, int fq) const {
        const int row0 = u.pm * BM + wr * 64 + fr, col0 = u.pn * BM + wc * 32 + 8 * fq;
#pragma unroll
        for (int ai = 0; ai < 2; ++ai)
#pragma unroll
            for (int m = 0; m < 4; ++m) { bf16_t* rowp = O + (size_t)(row0 + ai * HALF + m * 16) * ldc + col0;
#pragma unroll
                for (int bj = 0; bj < 2; ++bj) { const f32x4 v0 = acc[ai][bj][m][0], v1 = acc[ai][bj][m][1];
                    u32x4 w; w.x = cvt_pk_bf16(v0[0], v0[1]); w.y = cvt_pk_bf16(v0[2], v0[3]); w.z = cvt_pk_bf16(v1[0], v1[1]); w.w = cvt_pk_bf16(v1[2], v1[3]);
                    *(u32x4*)(rowp + bj * HALF) = w; } }
    }
};
struct EpiResGate {
    static constexpr bool PERM = false, AFTER_DRAIN = false;
    const float* base_lat; const float* base_ctx; float* out; const float* modg;
    __device__ __forceinline__ void operator()(const f32x4 (&acc)[2][2][4][2], const Unit& u, int wr, int wc, int fr, int fq) const {
        const int r = u.pm < 64 ? (u.pm >> 4) : 4; const int col0 = u.pn * BM + wc * 32 + 4 * fq;
        const float* g = modg + (size_t)r * 12288 + col0;
        f32x4 gv[2][2];
#pragma unroll
        for (int bj = 0; bj < 2; ++bj)
#pragma unroll
            for (int n = 0; n < 2; ++n) gv[bj][n] = *(const f32x4*)(g + bj * HALF + n * 16);
#pragma unroll
        for (int ai = 0; ai < 2; ++ai)
#pragma unroll
            for (int m = 0; m < 4; ++m) { const int row = u.pm * BM + ai * HALF + wr * 64 + m * 16 + fr;
                const float* bp = (row < 16384 ? base_lat + (size_t)row * 2048 : base_ctx + (size_t)(row - 16384) * 2048) + col0; float* op = out + (size_t)row * 2048 + col0;
#pragma unroll
                for (int bj = 0; bj < 2; ++bj)
#pragma unroll
                    for (int n = 0; n < 2; ++n) { const f32x4 b = *(const f32x4*)(bp + bj * HALF + n * 16); *(f32x4*)(op + bj * HALF + n * 16) = b + gv[bj][n] * acc[ai][bj][m][n]; }
                asm volatile("" ::: "memory"); }
    }
};
struct EpiSwiglu {
    static constexpr bool PERM = true, AFTER_DRAIN = false;
    bf16_t* O; const float* bgu;
    __device__ __forceinline__ void operator()(const f32x4 (&acc)[2][2][4][2], const Unit& u, int wr, int wc, int fr, int fq) const {
        const int row0 = u.pm * BM + wr * 64 + fr, cc0 = wc * 32 + 8 * fq;
        const float* bg = bgu + (size_t)u.e * 2048 + u.pn * 128 + cc0;
        f32x4 bglu[2], blin[2];
#pragma unroll
        for (int n = 0; n < 2; ++n) { bglu[n] = *(const f32x4*)(bg + 4 * n); blin[n] = *(const f32x4*)(bg + 1024 + 4 * n); }
#pragma unroll
        for (int ai = 0; ai < 2; ++ai)
#pragma unroll
            for (int m = 0; m < 4; ++m) { bf16_t* rowp = O + (size_t)(row0 + ai * HALF + m * 16) * 1024 + u.pn * 128 + cc0;
                float r[8];
#pragma unroll
                for (int n = 0; n < 2; ++n) { const f32x4 g = acc[ai][0][m][n] + bglu[n], l = acc[ai][1][m][n] + blin[n];
#pragma unroll
                    for (int i = 0; i < 4; ++i) { const float gg = fminf(g[i], 7.0f); const float ll = fminf(fmaxf(l[i], -7.0f), 7.0f);
                        r[4 * n + i] = (ll + 1.0f) * gg * (1.0f / (1.0f + __expf(-1.702f * gg))); } }
                u32x4 w; w.x = cvt_pk_bf16(r[0], r[1]); w.y = cvt_pk_bf16(r[2], r[3]); w.z = cvt_pk_bf16(r[4], r[5]); w.w = cvt_pk_bf16(r[6], r[7]);
                *(u32x4*)rowp = w; }
    }
};
struct EpiDown {
    static constexpr bool PERM = true, AFTER_DRAIN = false;
    bf16_t* O; const float* bdn; const float* rowg;
    __device__ __forceinline__ void operator()(const f32x4 (&acc)[2][2][4][2], const Unit& u, int wr, int wc, int fr, int fq) const {
        const int row0 = u.pm * BM + wr * 64 + fr, col0 = u.pn * BM + wc * 32 + 8 * fq;
        const float* bb = bdn + (size_t)u.e * 2048 + col0;
        f32x4 bv[2][2];
#pragma unroll
        for (int bj = 0; bj < 2; ++bj)
#pragma unroll
            for (int n = 0; n < 2; ++n) bv[bj][n] = *(const f32x4*)(bb + bj * HALF + 4 * n);
#pragma unroll
        for (int ai = 0; ai < 2; ++ai)
#pragma unroll
            for (int m = 0; m < 4; ++m) { const int row = row0 + ai * HALF + m * 16; const float gt = rowg[row]; bf16_t* rowp = O + (size_t)row * 2048 + col0;
#pragma unroll
                for (int bj = 0; bj < 2; ++bj) { const f32x4 v0 = (acc[ai][bj][m][0] + bv[bj][0]) * gt, v1 = (acc[ai][bj][m][1] + bv[bj][1]) * gt;
                    u32x4 w; w.x = cvt_pk_bf16(v0[0], v0[1]); w.y = cvt_pk_bf16(v0[2], v0[3]); w.z = cvt_pk_bf16(v1[0], v1[1]); w.w = cvt_pk_bf16(v1[2], v1[3]);
                    *(u32x4*)(rowp + bj * HALF) = w; } }
    }
};
struct MoeOrder {
    int c, nblk; const char* A; const char* Bt; size_t a_tstep, b_estep, b_tstep; const PG8_LAS int* blk_end;
    __device__ __forceinline__ bool next(int i, Unit& u) const {
        const int x = c & 7, j = c >> 3, gi = i * 8 + x, rb = 4 * gi + (j >> 3);
        if (rb >= nblk) return false;
        int e = 0;
        for (int k = 0; k < 31; ++k) e += (rb >= blk_end[k]) ? 1 : 0;
        u.pm = rb; u.pn = j & 7; u.e = __builtin_amdgcn_readfirstlane(e); return true;
    }
    __device__ __forceinline__ const char* a_ptr(const Unit& u) const { return A + (size_t)u.pm * a_tstep; }
    __device__ __forceinline__ const char* b_ptr(const Unit& u) const { return Bt + (size_t)u.e * b_estep + (size_t)u.pn * b_tstep; }
    __device__ __forceinline__ void a_ready(const Unit&) const {}
    __device__ __forceinline__ void done(const Unit&) const {}
};
template <class Epi, class Sched, bool ALIGN_EPI = false, bool SP2 = false>
__device__ __forceinline__ void gemm_phase(PG8_LAS unsigned char* lds, const Gemm g, const Sched& S, const Epi& E) {
    int tid = threadIdx.x; asm volatile("" : "+v"(tid));
    const int wid = __builtin_amdgcn_readfirstlane(tid >> 6), lane = tid & 63, wr = wid >> 2, wc = wid & 3, fr = lane & 15, fq = lane >> 4;
    const int K = g.K, nt = K / BK;
    unsigned voffA[2], voffB[2];
#pragma unroll
    for (int i = 0; i < 2; ++i) { int R, C; stage_rc(tid * 16 + i * 8192, R, C); const int Rb = Epi::PERM ? ((R & ~31) + perm32(R & 31)) : R;
        voffA[i] = (unsigned)(R * K + C) * 2u; voffB[i] = (unsigned)(Rb * K + C) * 2u; }
    const size_t kstep = (size_t)(BK * 2);
    const size_t hstep = (size_t)HALF * K * 2;
    const size_t tstep = 2 * hstep;
    const unsigned ldsw = (unsigned)wid * 1024u;
    const int aoff = lds_byte(wr * 64 + fr, fq * 8), boff = lds_byte(wc * 32 + fr, fq * 8);
#define PG8_SA(b, h) (((b) * 2 + (h)) * HTB)
#define PG8_SB(b, h) ((4 + (b) * 2 + (h)) * HTB)
#define PG8_STAGE(bufoff, gbase, voff) do { _Pragma("unroll") for (int _i = 0; _i < 2; ++_i) \
        __builtin_amdgcn_global_load_lds((const unsigned*)((const char*)(gbase) + (voff)[_i]), (PG8_LAS unsigned*)(lds + (bufoff) + ldsw + _i * 8192), 16, 0, 0); } while (0)
#define PG8_LDA(dst, b, h) do { _Pragma("unroll") for (int m = 0; m < 4; ++m) _Pragma("unroll") for (int k = 0; k < 2; ++k) dst[m][k] = *(const PG8_LAS bf16x8*)(lds + PG8_SA(b, h) + aoff + m * 2048 + k * 1024); } while (0)
#define PG8_LDB(dst, b, h) do { _Pragma("unroll") for (int n = 0; n < 2; ++n) _Pragma("unroll") for (int k = 0; k < 2; ++k) dst[n][k] = *(const PG8_LAS bf16x8*)(lds + PG8_SB(b, h) + boff + n * 2048 + k * 1024); } while (0)
#define PG8_MMA(ai, bj, At, Bt) do { __builtin_amdgcn_s_setprio(1); _Pragma("unroll") for (int m = 0; m < 4; ++m) _Pragma("unroll") for (int n = 0; n < 2; ++n) _Pragma("unroll") for (int k = 0; k < 2; ++k) \
        acc[ai][bj][m][n] = __builtin_amdgcn_mfma_f32_16x16x32_bf16(Bt[n][k], At[m][k], acc[ai][bj][m][n], 0, 0, 0); __builtin_amdgcn_s_setprio(0); } while (0)
#define PG8_WAIT_V(n) asm volatile("s_waitcnt vmcnt(" #n ")" ::: "memory")
#define PG8_WAIT_L(n) asm volatile("s_waitcnt lgkmcnt(" #n ")" ::: "memory")
#define PG8_BAR __builtin_amdgcn_s_barrier()
#define PG8_SCHED __builtin_amdgcn_sched_barrier(0)
    Unit cur, nxt; int ui = 0;
    if (!S.next(0, cur)) return;
    f32x4 acc[2][2][4][2];
#pragma unroll
    for (int a = 0; a < 2; ++a)
#pragma unroll
        for (int b = 0; b < 2; ++b)
#pragma unroll
            for (int m = 0; m < 4; ++m)
#pragma unroll
                for (int n = 0; n < 2; ++n) acc[a][b][m][n] = (f32x4){0.f, 0.f, 0.f, 0.f};
    bf16x8 At[4][2], B0[2][2], B1[2][2];
    const char* cA = S.a_ptr(cur); const char* cB = S.b_ptr(cur);
    S.a_ready(cur);
    if constexpr (SP2) {
        PG8_STAGE(PG8_SB(0, 0), cB, voffB); PG8_STAGE(PG8_SB(0, 1), cB + hstep, voffB); PG8_STAGE(PG8_SA(0, 0), cA, voffA); PG8_STAGE(PG8_SA(0, 1), cA + hstep, voffA);
        if (wr == 1) PG8_BAR;
        PG8_WAIT_V(2); PG8_BAR;
        PG8_STAGE(PG8_SB(1, 0), cB + kstep, voffB); PG8_STAGE(PG8_SA(1, 0), cA + kstep, voffA); PG8_STAGE(PG8_SB(1, 1), cB + hstep + kstep, voffB);
        PG8_WAIT_V(6); PG8_BAR;
    } else {
        PG8_STAGE(PG8_SB(0, 0), cB, voffB); PG8_STAGE(PG8_SA(0, 0), cA, voffA); PG8_STAGE(PG8_SB(0, 1), cB + hstep, voffB); PG8_STAGE(PG8_SA(0, 1), cA + hstep, voffA);
        if (wr == 1) PG8_BAR;
        PG8_WAIT_V(4); PG8_BAR;
        PG8_STAGE(PG8_SB(1, 0), cB + kstep, voffB); PG8_STAGE(PG8_SA(1, 0), cA + kstep, voffA); PG8_STAGE(PG8_SB(1, 1), cB + hstep + kstep, voffB);
        PG8_WAIT_V(6); PG8_BAR;
    }
    for (;;) {
        const bool has_next = S.next(ui + 1, nxt);
        const char* nA = has_next ? S.a_ptr(nxt) : cA; const char* nB = has_next ? S.b_ptr(nxt) : cB;
        for (int t = 0; t < nt; t += 2) {
            const bool last = (t == nt - 2);
            const char* a1 = cA + (size_t)(t + 1) * kstep;
            const char* a2 = last ? nA : cA + (size_t)(t + 2) * kstep; const char* b2 = last ? nB : cB + (size_t)(t + 2) * kstep;
            const char* a3 = a2 + kstep; const char* b3 = b2 + kstep;
            if (last && has_next) S.a_ready(nxt);
            if constexpr (SP2) {
            PG8_LDB(B0, 0, 0); PG8_LDB(B1, 0, 1); PG8_SCHED; PG8_LDA(At, 0, 0); PG8_STAGE(PG8_SA(1, 1), a1 + hstep, voffA);
            PG8_WAIT_V(8); PG8_WAIT_L(0); PG8_BAR; PG8_MMA(0, 0, At, B0); PG8_MMA(0, 1, At, B1); PG8_BAR; PG8_SCHED;
            PG8_LDA(At, 0, 1); PG8_STAGE(PG8_SB(0, 0), b2, voffB); PG8_STAGE(PG8_SB(0, 1), b2 + hstep, voffB); PG8_STAGE(PG8_SA(0, 0), a2, voffA);
            PG8_WAIT_V(8); PG8_WAIT_L(0); PG8_BAR; PG8_MMA(1, 0, At, B0); PG8_MMA(1, 1, At, B1); PG8_BAR; PG8_SCHED;
            PG8_LDB(B0, 1, 0); PG8_LDB(B1, 1, 1); PG8_SCHED; PG8_LDA(At, 1, 0); PG8_STAGE(PG8_SA(0, 1), a2 + hstep, voffA);
            PG8_WAIT_V(8); PG8_WAIT_L(0); PG8_BAR; PG8_MMA(0, 0, At, B0); PG8_MMA(0, 1, At, B1); PG8_BAR; PG8_SCHED;
            PG8_LDA(At, 1, 1); PG8_STAGE(PG8_SB(1, 0), b3, voffB); PG8_STAGE(PG8_SB(1, 1), b3 + hstep, voffB); PG8_STAGE(PG8_SA(1, 0), a3, voffA);
            PG8_WAIT_V(8); PG8_WAIT_L(0); PG8_BAR; PG8_MMA(1, 0, At, B0); PG8_MMA(1, 1, At, B1); PG8_BAR; PG8_SCHED;
            } else {
            PG8_LDB(B0, 0, 0); PG8_SCHED; PG8_LDA(At, 0, 0); PG8_STAGE(PG8_SA(1, 1), a1 + hstep, voffA);
            PG8_WAIT_L(8); PG8_BAR; PG8_WAIT_L(0); PG8_MMA(0, 0, At, B0); PG8_BAR; PG8_SCHED;
            PG8_LDB(B1, 0, 1); PG8_STAGE(PG8_SB(0, 0), b2, voffB);
            PG8_BAR; PG8_WAIT_L(0); PG8_MMA(0, 1, At, B1); PG8_BAR;
            PG8_LDA(At, 0, 1); PG8_STAGE(PG8_SA(0, 0), a2, voffA);
            PG8_BAR; PG8_WAIT_L(0); PG8_MMA(1, 0, At, B0); PG8_BAR; PG8_SCHED;
            PG8_STAGE(PG8_SB(0, 1), b2 + hstep, voffB);
            PG8_WAIT_V(6); PG8_BAR; PG8_MMA(1, 1, At, B1); PG8_BAR;
            PG8_LDB(B0, 1, 0); PG8_SCHED; PG8_LDA(At, 1, 0); PG8_STAGE(PG8_SA(0, 1), a2 + hstep, voffA);
            PG8_WAIT_L(8); PG8_BAR; PG8_WAIT_L(0); PG8_MMA(0, 0, At, B0); PG8_BAR; PG8_SCHED;
            PG8_LDB(B1, 1, 1); PG8_STAGE(PG8_SB(1, 0), b3, voffB);
            PG8_BAR; PG8_WAIT_L(0); PG8_MMA(0, 1, At, B1); PG8_BAR;
            PG8_LDA(At, 1, 1); PG8_STAGE(PG8_SA(1, 0), a3, voffA);
            PG8_BAR; PG8_WAIT_L(0); PG8_MMA(1, 0, At, B0); PG8_BAR; PG8_SCHED;
            PG8_STAGE(PG8_SB(1, 1), b3 + hstep, voffB);
            PG8_WAIT_V(6); PG8_BAR; PG8_MMA(1, 1, At, B1); PG8_BAR;
            }
        }
        if constexpr (ALIGN_EPI) { if (wr == 0) PG8_BAR; }
        if constexpr (!Epi::AFTER_DRAIN) { int fr_e = fr, fq_e = fq; asm volatile("" : "+v"(fr_e), "+v"(fq_e));
            E(acc, cur, wr, wc, fr_e, fq_e); S.done(cur); }
        if (!has_next) break;
#pragma unroll
        for (int a = 0; a < 2; ++a)
#pragma unroll
            for (int b = 0; b < 2; ++b)
#pragma unroll
                for (int m = 0; m < 4; ++m)
#pragma unroll
                    for (int n = 0; n < 2; ++n) acc[a][b][m][n] = (f32x4){0.f, 0.f, 0.f, 0.f};
        cur = nxt; cA = nA; cB = nB; ++ui;
        if constexpr (ALIGN_EPI) { if (wr == 1) PG8_BAR; }
    }
    PG8_WAIT_V(0);
    if constexpr (!ALIGN_EPI) { if (wr == 0) PG8_BAR; }
    PG8_BAR;
    if constexpr (Epi::AFTER_DRAIN) { E.fused(acc, cur, wr, wc, fr, fq, lds, wid, lane); S.done(cur); }
#undef PG8_SA
#undef PG8_SB
#undef PG8_STAGE
#undef PG8_LDA
#undef PG8_LDB
#undef PG8_MMA
#undef PG8_WAIT_V
#undef PG8_WAIT_L
#undef PG8_BAR
#undef PG8_SCHED
}
}

constexpr size_t MiB = 1u << 20;
constexpr size_t WS_CTL = 0, CTL_ZERO_BYTES = 1 * MiB;
constexpr size_t WS_MOD  = 1 * MiB;
constexpr size_t WS_WRT  = 2 * MiB;
constexpr size_t WS_MOEI = 3 * MiB;
constexpr size_t WS_LRC  = 6 * MiB;
constexpr size_t WS_DNS  = 12 * MiB;
constexpr size_t WS_WIN  = 16 * MiB;
constexpr size_t WS_WOUT = 56 * MiB;
constexpr size_t WS_WGU  = 72 * MiB;
constexpr size_t WS_WDN  = 584 * MiB;
constexpr size_t WS_X    = 840 * MiB;
constexpr size_t WS_H    = 976 * MiB;
constexpr size_t WS_P    = 1044 * MiB;
constexpr size_t WS_CC   = 1206 * MiB;
constexpr size_t WS_VT   = 1274 * MiB;
constexpr size_t WS_VTC  = WS_VT + 8 * MiB;
constexpr size_t WS_DNT  = 1284 * MiB;
constexpr size_t DNT_BYTES = 90112;
constexpr size_t WS_DNO  = 1472 * MiB;
constexpr size_t WS_LRH  = 1540 * MiB;
constexpr size_t WS_LRA  = 1608 * MiB;
constexpr size_t WS_XS   = 1676 * MiB;
constexpr size_t WS_ACT  = 1980 * MiB;
constexpr size_t WS_YS   = 2132 * MiB;
constexpr size_t WS_END  = 2436 * MiB;
constexpr int CW_TMO = 0;
constexpr int CW_BAR = 4096;
constexpr int CW_CNT = 8192;
constexpr int CW_ATQ = 12288;

constexpr int RING_OFF = 0, RING_BYTES = 131072;
constexpr int LDSCTL_OFF = RING_BYTES, MISC_OFF = LDSCTL_OFF + 320;
constexpr int LDS_X_OFF = RING_BYTES + 1024;
constexpr int LDS_BYTES = 147456;
constexpr int NWAVES = 8, NTHREADS = 512;

#define GAS __attribute__((address_space(1)))
#define LAS __attribute__((address_space(3)))
typedef unsigned short bf16;
typedef unsigned v4u __attribute__((ext_vector_type(4)));
typedef unsigned v2u __attribute__((ext_vector_type(2)));
typedef float f32x4 __attribute__((ext_vector_type(4)));
typedef float f32x16 __attribute__((ext_vector_type(16)));
typedef short bf16x8 __attribute__((ext_vector_type(8)));
typedef short bf16x4 __attribute__((ext_vector_type(4)));
typedef GAS unsigned gu32;
#define RLX_AGENT __ATOMIC_RELAXED, __HIP_MEMORY_SCOPE_AGENT
#define LDS_WAIT() asm volatile("s_waitcnt lgkmcnt(0)" ::: "memory")
#define VM_WAIT() asm volatile("s_waitcnt vmcnt(0)" ::: "memory")
__device__ __forceinline__ unsigned f2bf(float f) { unsigned u = __builtin_bit_cast(unsigned, f); return (u + 0x7fffu + ((u >> 16) & 1u)) >> 16; }
__device__ __forceinline__ unsigned pk2(float lo, float hi) { return pg8::cvt_pk_bf16(lo, hi); }
__device__ __forceinline__ float bf2f(unsigned short b) { return __builtin_bit_cast(float, (unsigned)b << 16); }
__device__ __forceinline__ float bflo(unsigned w) { return __builtin_bit_cast(float, w << 16); }
__device__ __forceinline__ float bfhi(unsigned w) { return __builtin_bit_cast(float, w & 0xffff0000u); }
__device__ __forceinline__ float wave_sum(float v) {
#pragma unroll
    for (int o = 1; o < 64; o <<= 1) v += __shfl_xor(v, o);
    return v;
}
__device__ __forceinline__ float sigmoidf_(float x) { return 1.0f / (1.0f + __expf(-x)); }
__device__ __forceinline__ float siluf_(float x) { return x / (1.0f + __expf(-x)); }
__device__ __forceinline__ float softplusf_(float x) { return x > 20.f ? x : log1pf(__expf(x)); }

#define XB_TMO      128
#define XB_XCNT(j)  (256  + 64 * (j))
#define XB_XSUB(j)  (1280 + 64 * (j))
#define XB_XGEN(j)  (2304 + 64 * (j))
#define XB_TOP      3328
#define XB_TOPGEN   3392
#define XCD_BAR_WORDS 3456
#define XB_SPIN_CAP (1u << 18)

__device__ __forceinline__ unsigned xb_ld(unsigned* p)              { return __hip_atomic_load(p, __ATOMIC_RELAXED, __HIP_MEMORY_SCOPE_AGENT); }
__device__ __forceinline__ unsigned xb_add(unsigned* p, unsigned v) { return __hip_atomic_fetch_add(p, v, __ATOMIC_RELAXED, __HIP_MEMORY_SCOPE_AGENT); }
__device__ __forceinline__ unsigned xb_xcc_id() { return (unsigned)__builtin_amdgcn_s_getreg((3 << 11) | 20) & 0xFu; }
#define XB_SPIN(cond, bar) do { unsigned _sp = 0; while (cond) { __builtin_amdgcn_s_sleep(1); \
    if ((++_sp & 255u) == 0u) { if (xb_ld(&(bar)[XB_TMO])) break; if (_sp > XB_SPIN_CAP) { atomicAdd(&(bar)[XB_TMO], 1u); break; } } } } while (0)

struct XcdBarrier {
    unsigned* bar; unsigned x;
    volatile LAS unsigned* st;
};

__device__ __forceinline__ XcdBarrier xcd_barrier_post(unsigned* bar, volatile LAS unsigned* st) {
    XcdBarrier b; b.bar = bar; b.x = xb_xcc_id(); b.st = st;
    if (threadIdx.x == 0) (void)xb_add(&bar[XB_XCNT(b.x)], 1u);
    return b;
}
__device__ __forceinline__ void xcd_barrier_complete(unsigned* bar, unsigned x, unsigned& nloc, unsigned& nx) {
    const unsigned G = gridDim.x * gridDim.y * gridDim.z;
    unsigned sum, cnt, mine, sp = 0u;
    for (;;) {
        sum = 0u; cnt = 0u; mine = 0u;
#pragma unroll
        for (unsigned j = 0; j < 16; ++j) { const unsigned c = xb_ld(&bar[XB_XCNT(j)]); sum += c; cnt += (c > 0u) ? 1u : 0u; mine = (j == x) ? c : mine; }
        if (sum == G) break;
        __builtin_amdgcn_s_sleep(1);
        if ((++sp & 255u) == 0u) { if (xb_ld(&bar[XB_TMO])) break; if (sp > XB_SPIN_CAP) { atomicAdd(&bar[XB_TMO], 1u); break; } }
    }
    nloc = mine > 0u ? mine : 1u; nx = cnt > 0u ? cnt : 1u;
}

__device__ __forceinline__ void xcd_barrier(const XcdBarrier& b) {
    asm volatile("s_waitcnt vmcnt(0)" ::: "memory");
    __syncthreads();
    if (threadIdx.x == 0) {
        unsigned* bar = b.bar;
        __builtin_amdgcn_s_waitcnt(0);
        unsigned nloc = b.st[0], nx = b.st[1];
        if (nloc == 0u) { xcd_barrier_complete(bar, b.x, nloc, nx); b.st[0] = nloc; b.st[1] = nx; }
        const unsigned old = xb_add(&bar[XB_XSUB(b.x)], 1u);
        const unsigned gen = old / nloc;
        if (old + 1u == (gen + 1u) * nloc) {
            __builtin_amdgcn_fence(__ATOMIC_RELEASE, "agent");
            asm volatile("s_waitcnt vmcnt(0)" ::: "memory");
            const unsigned og = xb_add(&bar[XB_TOP], 1u);
            const unsigned tg = og / nx;
            if (og + 1u == (tg + 1u) * nx) xb_add(&bar[XB_TOPGEN], 1u);
            else XB_SPIN(xb_ld(&bar[XB_TOPGEN]) == tg, bar);
            __builtin_amdgcn_fence(__ATOMIC_ACQUIRE, "agent");
            xb_add(&bar[XB_XGEN(b.x)], 1u);
            asm volatile("s_waitcnt vmcnt(0)" ::: "memory");
        } else {
            XB_SPIN(xb_ld(&bar[XB_XGEN(b.x)]) == gen, bar);
            __builtin_amdgcn_fence(__ATOMIC_ACQUIRE, "agent");
            asm volatile("s_waitcnt vmcnt(0)" ::: "memory");
        }
    }
    __syncthreads();
}

enum InIdx { I_X = 0, I_C, I_CTX, I_CCTX, I_WMOD, I_BMOD, I_NMG, I_NFG, I_WIN, I_WOUT, I_SINK, I_DNCW, I_DNALOG, I_DNDT, I_DNNG, I_LRCW, I_LRCB, I_LRWR, I_LRBR, I_LRWI, I_LRBI, I_LRLAM,
             I_WROUT, I_BROUT, I_WGU, I_BGU, I_WDN, I_BDN, I_FNG, N_IN };
struct Frame {
    LAS unsigned char* lds;
    volatile LAS unsigned* MISC;
    gu32* ctl;
    int tid, lane, wave, G, bid;
    const float* const __attribute__((address_space(4)))* in;
    float* out; unsigned char* ws;
};
__device__ __forceinline__ int mod_row(int m) { return m < NLAT ? (m >> 12) : 4; }
__device__ __forceinline__ bool phase_enter(Frame& F) { int t = threadIdx.x; asm volatile("" : "+v"(t)); F.tid = t; F.lane = t & 63; F.wave = __builtin_amdgcn_readfirstlane(t >> 6); return true; }
__device__ __forceinline__ void seq_of(int m, int& t, int& T, int& base) { if (m < NLAT) { t = m & 4095; T = SEQ; base = m - t; } else { t = (m - NLAT) & 255; T = CTXL; base = m - t; } }
__device__ __forceinline__ float gelu_tanh(float x) { const float u = 0.7978845608028654f * (x + 0.044715f * x * x * x); return 0.5f * x * (1.0f + tanhf(u)); }

__device__ __forceinline__ void transpose_item(const float* W, int K, int N, bf16* WT, int k0, int dstrow0, int srccol0, int nvalid, LAS float* scr, int lane) {
    const int j = lane & 31;
#pragma unroll 8
    for (int i = 0; i < 32; ++i) { const int kk = 2 * i + (lane >> 5); scr[kk * 33 + j] = (j < nvalid) ? W[(size_t)(k0 + kk) * N + srccol0 + j] : 0.f; }
    LDS_WAIT(); asm volatile("" ::: "memory");
    const int c = lane & 7;
#pragma unroll
    for (int jj = 0; jj < 4; ++jj) { const int n = (lane >> 3) + 8 * jj; const LAS float* s = scr + (8 * c) * 33 + n;
        v4u o; o.x = pk2(s[0 * 33], s[1 * 33]); o.y = pk2(s[2 * 33], s[3 * 33]); o.z = pk2(s[4 * 33], s[5 * 33]); o.w = pk2(s[6 * 33], s[7 * 33]);
        *(GAS v4u*)(WT + (size_t)(dstrow0 + n) * K + k0 + 8 * c) = o; }
    LDS_WAIT(); asm volatile("" ::: "memory");
}
__device__ __forceinline__ void p0_prologue(Frame& F) {
    {
        LAS float* sc = (LAS float*)(F.lds);
        LAS float* red = (LAS float*)(F.lds + 40960);
        bool have_sc = false;
        for (int wb = F.bid; wb < 192; wb += F.G) {
            if (!have_sc) {
                for (int i = F.tid; i < 5 * 2048; i += NTHREADS) { const int r = i >> 11, k = i & 2047; const float cv = r < 4 ? F.in[I_C][r * 2048 + k] : F.in[I_CCTX][k]; sc[i] = siluf_(cv); }
                have_sc = true; __syncthreads();
            }
            const int l = wb / 96, cb = wb % 96, kp = F.tid >> 5, cg = F.tid & 31, j0 = cb * 128 + cg * 4;
            const float* wp = F.in[I_WMOD] + ((size_t)l * 2048 + kp * 128) * 12288 + j0;
            f32x4 acc[5];
#pragma unroll
            for (int r = 0; r < 5; ++r) acc[r] = (f32x4){0.f, 0.f, 0.f, 0.f};
#pragma unroll 4
            for (int k = 0; k < 128; ++k) { const f32x4 w = *(const f32x4*)(wp + (size_t)k * 12288);
#pragma unroll
                for (int r = 0; r < 5; ++r) acc[r] += sc[r * 2048 + kp * 128 + k] * w; }
#pragma unroll
            for (int r = 0; r < 5; ++r) *(LAS f32x4*)(red + (kp * 5 + r) * 128 + cg * 4) = acc[r];
            __syncthreads();
            for (int i = F.tid; i < 640; i += NTHREADS) { const int r = i >> 7, col = i & 127; float s = F.in[I_BMOD][l * 12288 + cb * 128 + col];
#pragma unroll
                for (int q = 0; q < 16; ++q) s += red[(q * 5 + r) * 128 + col];
                ((float*)(F.ws + WS_MOD))[(size_t)(l * 5 + r) * 12288 + cb * 128 + col] = s; }
            __syncthreads();
        }
        __syncthreads();
    }
    {
        LAS float* scr = (LAS float*)(F.lds + F.wave * 16384);
        const int gw = F.bid * NWAVES + F.wave, NGW = F.G * NWAVES;
        constexpr int I_IN = 32 * 152, I_OUT = 32 * 64, I_RT = 32, I_GU = 32 * 32 * 64, I_DN = 32 * 16 * 64, PER_L = I_IN + I_OUT + I_RT + I_GU + I_DN;
        for (int it0 = gw; it0 < 2 * PER_L; it0 += NGW) {
            const int l = it0 / PER_L; int r = it0 % PER_L;
            if (r < I_IN) { const int nb = r % 152, kb = r / 152, d0 = nb * 32; int s0 = d0, nv = 32;
                if (d0 >= 4640) nv = 0; else if (d0 == 4608) { s0 = 3584; nv = 16; } else if (d0 >= 3584) s0 = d0 + 16;
                transpose_item(F.in[I_WIN] + (size_t)l * 2048 * IN_W, 2048, IN_W, (bf16*)(F.ws + WS_WIN) + (size_t)l * PW * 2048, kb * 64, d0, s0, nv, scr, F.lane); continue; }
            r -= I_IN;
            if (r < I_OUT) { const int nb = r % 64, kb = r / 64;
                transpose_item(F.in[I_WOUT] + (size_t)l * 2048 * 2048, 2048, 2048, (bf16*)(F.ws + WS_WOUT) + (size_t)l * 2048 * 2048, kb * 64, nb * 32, nb * 32, 32, scr, F.lane); continue; }
            r -= I_OUT;
            if (r < I_RT) { transpose_item(F.in[I_WROUT] + (size_t)l * 2048 * 32, 2048, 32, (bf16*)(F.ws + WS_WRT) + (size_t)l * 32 * 2048, r * 64, 0, 0, 32, scr, F.lane); continue; }
            r -= I_RT;
            if (r < I_GU) { const int e = r / 2048, q = r % 2048, nb = q % 64, kb = q / 64; const int s0 = ((nb >> 2) & 1) * 1024 + (nb >> 3) * 128 + (nb & 3) * 32;
                transpose_item(F.in[I_WGU] + (size_t)(l * 32 + e) * 2048 * 2048, 2048, 2048, (bf16*)(F.ws + WS_WGU) + (size_t)(l * 32 + e) * 2048 * 2048, kb * 64, nb * 32, s0, 32, scr, F.lane); continue; }
            r -= I_GU;
            { const int e = r / 1024, q = r % 1024, nb = q % 64, kb = q / 64;
                transpose_item(F.in[I_WDN] + (size_t)(l * 32 + e) * 1024 * 2048, 1024, 2048, (bf16*)(F.ws + WS_WDN) + (size_t)(l * 32 + e) * 2048 * 1024, kb * 64, nb * 32, nb * 32, 32, scr, F.lane); }
        }
    }
}

__device__ __forceinline__ void load_row(const float* src, int lane, f32x4 (&v)[8]) {
    const f32x4* p = (const f32x4*)src + lane;
#pragma unroll
    for (int j = 0; j < 8; ++j) v[j] = p[64 * j];
}
__device__ __forceinline__ void store_row(float* dst, int lane, const f32x4 (&v)[8]) {
    f32x4* p = (f32x4*)dst + lane;
#pragma unroll
    for (int j = 0; j < 8; ++j) p[64 * j] = v[j];
}
__device__ __forceinline__ void combine_row(Frame& F, int l, int m, int lane, f32x4 (&v)[8]) {
    const int* dest = (const int*)(F.ws + WS_MOEI + 2 * 512 * 1024) + m * 4;
    const float* g5 = (const float*)(F.ws + WS_MOD) + (size_t)(l * 5 + mod_row(m)) * 12288 + 5 * 2048;
    f32x4 acc[8];
#pragma unroll
    for (int j = 0; j < 8; ++j) acc[j] = (f32x4){0.f, 0.f, 0.f, 0.f};
#pragma unroll
    for (int k = 0; k < 4; ++k) { const int d = dest[k]; const v2u* yp = (const v2u*)((const bf16*)(F.ws + WS_YS) + (size_t)d * 2048) + lane;
#pragma unroll
        for (int j = 0; j < 8; ++j) { const v2u w = yp[64 * j]; acc[j] += (f32x4){bflo(w.x), bfhi(w.x), bflo(w.y), bfhi(w.y)}; } }
#pragma unroll
    for (int j = 0; j < 8; ++j) { const f32x4 gg = *((const f32x4*)g5 + lane + 64 * j); v[j] += gg * acc[j]; }
}
__device__ __forceinline__ void modnorm_store(const f32x4 (&v)[8], const float* g, const float* shift, const float* scale, bf16* hrow, int lane) {
    float ss = 0.f;
#pragma unroll
    for (int j = 0; j < 8; ++j) ss += (v[j].x * v[j].x + v[j].y * v[j].y) + (v[j].z * v[j].z + v[j].w * v[j].w);
    const float rstd = 1.0f / sqrtf(wave_sum(ss) * (1.0f / 2048.0f) + EPS);
    v2u* hp = (v2u*)hrow + lane;
#pragma unroll
    for (int j = 0; j < 8; ++j) { const f32x4 gg = *((const f32x4*)g + lane + 64 * j), sh = *((const f32x4*)shift + lane + 64 * j), sc = *((const f32x4*)scale + lane + 64 * j);
        const f32x4 y = (v[j] * rstd) * gg * (sc + 1.0f) + sh; v2u w; w.x = pk2(y.x, y.y); w.y = pk2(y.z, y.w); hp[64 * j] = w; }
}
__device__ __forceinline__ void phase_norm1(Frame& F, int l) {
    const int gw = F.bid * NWAVES + F.wave, NGW = F.G * NWAVES;
    float* X = (float*)(F.ws + WS_X); bf16* H = (bf16*)(F.ws + WS_H);
    const float* modp = (const float*)(F.ws + WS_MOD) + (size_t)l * 5 * 12288;
    for (int m = gw; m < NTOK; m += NGW) {
        f32x4 v[8];
        if (l == 0) load_row(m < NLAT ? F.in[I_X] + (size_t)m * DM : F.in[I_CTX] + (size_t)(m - NLAT) * DM, F.lane, v);
        else { load_row(X + (size_t)m * DM, F.lane, v); if (MK_STAGE >= 9) { combine_row(F, l - 1, m, F.lane, v); store_row(X + (size_t)m * DM, F.lane, v); } }
        const float* mr = modp + (size_t)mod_row(m) * 12288;
        modnorm_store(v, F.in[I_NMG] + l * DM, mr, mr + 2048, H + (size_t)m * DM, F.lane);
    }
}
__device__ __forceinline__ void phase_final(Frame& F, bool with_combine) {
    const int gw = F.bid * NWAVES + F.wave, NGW = F.G * NWAVES;
    const float* X = (const float*)(F.ws + WS_X);
    for (int m = gw; m < NLAT; m += NGW) {
        f32x4 v[8];
        if (with_combine) { load_row(X + (size_t)m * DM, F.lane, v); combine_row(F, 1, m, F.lane, v); }
        else load_row(F.in[I_X] + (size_t)m * DM, F.lane, v);
        float ss = 0.f;
#pragma unroll
        for (int j = 0; j < 8; ++j) ss += (v[j].x * v[j].x + v[j].y * v[j].y) + (v[j].z * v[j].z + v[j].w * v[j].w);
        const float rstd = 1.0f / sqrtf(wave_sum(ss) * (1.0f / 2048.0f) + EPS);
        f32x4* op = (f32x4*)(F.out + (size_t)m * DM) + F.lane;
#pragma unroll
        for (int j = 0; j < 8; ++j) { const f32x4 gg = *((const f32x4*)F.in[I_FNG] + F.lane + 64 * j); op[64 * j] = v[j] * rstd * gg; }
    }
}

__device__ __forceinline__ void phase_inproj(Frame& F, int l) {
    pg8::Gemm g{(const bf16*)(F.ws + WS_H), (const bf16*)(F.ws + WS_WIN) + (size_t)l * PW * 2048, NTOK, PW, 2048};
    pg8::StaticOrder S; S.init(g, F.G, F.bid);
    pg8::EpiBf16Plain E{(bf16*)(F.ws + WS_P), PW};
    pg8::gemm_phase<pg8::EpiBf16Plain, pg8::StaticOrder, true, true>(F.lds + RING_OFF, g, S, E);
}
__device__ __forceinline__ void phase_outproj(Frame& F, int l) {
    float* X = (float*)(F.ws + WS_X);
    pg8::Gemm g{(const bf16*)(F.ws + WS_CC), (const bf16*)(F.ws + WS_WOUT) + (size_t)l * 2048 * 2048, l == 0 ? NTOK : NLAT, 2048, 2048};
    pg8::StaticOrder S; S.init(g, F.G, F.bid);
    pg8::EpiResGate E{l == 0 ? F.in[I_X] : X, l == 0 ? F.in[I_CTX] : X + (size_t)NLAT * DM, X, (const float*)(F.ws + WS_MOD) + (size_t)l * 5 * 12288 + 2 * 2048};
    pg8::gemm_phase<pg8::EpiResGate, pg8::StaticOrder, true, true>(F.lds + RING_OFF, g, S, E);
}
#ifndef PHASE_INPROJ
#define PHASE_INPROJ(F, l) phase_inproj(F, l)
#endif
#ifndef PHASE_OUTPROJ
#define PHASE_OUTPROJ(F, l) phase_outproj(F, l)
#endif

constexpr size_t MOEI_TOPE = WS_MOEI, MOEI_TOPG = WS_MOEI + 512 * 1024, MOEI_DEST = WS_MOEI + 2 * 512 * 1024, MOEI_ROWG = WS_MOEI + 3 * 512 * 1024;
__device__ __forceinline__ void phase_norm2(Frame& F, int l) {
    const int nrows = (l == 0) ? NTOK : NLAT;
    constexpr int TROW = 4112;
    LAS unsigned char* tile = F.lds;
    LAS float* part = (LAS float*)(F.lds + 66048);
    LAS float* lg = (LAS float*)(F.lds + 66048 + 16384);
    const float* X = (const float*)(F.ws + WS_X); bf16* H = (bf16*)(F.ws + WS_H);
    const float* modp = (const float*)(F.ws + WS_MOD) + (size_t)l * 5 * 12288;
    const bf16* wrt = (const bf16*)(F.ws + WS_WRT) + (size_t)l * 32 * 2048;
    int* tope = (int*)(F.ws + MOEI_TOPE); float* topg = (float*)(F.ws + MOEI_TOPG);
    for (int r0 = F.bid * 16; r0 < nrows; r0 += F.G * 16) {
#pragma unroll 1
        for (int rr = 0; rr < 2; ++rr) {
            const int lr = 2 * F.wave + rr, m = r0 + lr;
            f32x4 v[8]; load_row(X + (size_t)m * DM, F.lane, v);
            float ss = 0.f;
#pragma unroll
            for (int j = 0; j < 8; ++j) ss += (v[j].x * v[j].x + v[j].y * v[j].y) + (v[j].z * v[j].z + v[j].w * v[j].w);
            const float rstd = 1.0f / sqrtf(wave_sum(ss) * (1.0f / 2048.0f) + EPS);
            const float* mr = modp + (size_t)mod_row(m) * 12288; const float* g = F.in[I_NFG] + l * DM;
            v2u* hp = (v2u*)(H + (size_t)m * DM) + F.lane; LAS v2u* tp = (LAS v2u*)(tile + lr * TROW) + F.lane;
#pragma unroll
            for (int j = 0; j < 8; ++j) { const f32x4 gg = *((const f32x4*)g + F.lane + 64 * j), sh = *((const f32x4*)(mr + 3 * 2048) + F.lane + 64 * j), sc = *((const f32x4*)(mr + 4 * 2048) + F.lane + 64 * j);
                const f32x4 y = (v[j] * rstd) * gg * (sc + 1.0f) + sh; v2u w; w.x = pk2(y.x, y.y); w.y = pk2(y.z, y.w); hp[64 * j] = w; tp[64 * j] = w; }
        }
        __syncthreads();
        {
            const int row = F.lane & 15, q = F.lane >> 4;
            f32x4 acc0 = {0.f, 0.f, 0.f, 0.f}, acc1 = {0.f, 0.f, 0.f, 0.f};
#pragma unroll
            for (int ks = 0; ks < 8; ++ks) { const int k0 = 256 * F.wave + 32 * ks + 8 * q;
                const bf16x8 a = *(const LAS bf16x8*)(tile + row * TROW + k0 * 2);
                const bf16x8 b0 = *(const bf16x8*)(wrt + (size_t)row * 2048 + k0), b1 = *(const bf16x8*)(wrt + (size_t)(16 + row) * 2048 + k0);
                acc0 = __builtin_amdgcn_mfma_f32_16x16x32_bf16(a, b0, acc0, 0, 0, 0); acc1 = __builtin_amdgcn_mfma_f32_16x16x32_bf16(a, b1, acc1, 0, 0, 0); }
#pragma unroll
            for (int i = 0; i < 4; ++i) { part[(F.wave * 16 + 4 * q + i) * 32 + row] = acc0[i]; part[(F.wave * 16 + 4 * q + i) * 32 + 16 + row] = acc1[i]; }
        }
        __syncthreads();
        { const int rw = F.tid >> 5, e = F.tid & 31; float s = F.in[I_BROUT][l * 32 + e];
#pragma unroll
          for (int w = 0; w < 8; ++w) s += part[(w * 16 + rw) * 32 + e];
          lg[rw * 32 + e] = s; }
        __syncthreads();
        if (F.tid < 16) { const int m = r0 + F.tid; float val[4]; int idx[4]; unsigned taken = 0u;
#pragma unroll
            for (int k = 0; k < 4; ++k) { float best = -3.0e38f; int bi = 0;
                for (int e = 0; e < 32; ++e) { const float x = lg[F.tid * 32 + e]; if (!((taken >> e) & 1u) && x > best) { best = x; bi = e; } }
                val[k] = best; idx[k] = bi; taken |= 1u << bi; }
            float p[4], sum = 0.f;
#pragma unroll
            for (int k = 0; k < 4; ++k) { p[k] = __expf(val[k] - val[0]); sum += p[k]; }
#pragma unroll
            for (int k = 0; k < 4; ++k) { const unsigned rank = __hip_atomic_fetch_add(F.ctl + CW_CNT + 64 * l + idx[k], 1u, RLX_AGENT);
                tope[m * 4 + k] = idx[k] | (int)(rank << 8); topg[m * 4 + k] = p[k] / sum; }
        }
        __syncthreads();
    }
}
__device__ __forceinline__ void moe_tables(Frame& F, int l) {
    LAS int* blk_end = (LAS int*)(F.lds + LDS_X_OFF); LAS int* pstart = blk_end + 32;
    if (F.tid == 0) { int nb = 0;
        for (int e = 0; e < 32; ++e) { const int c = (int)__hip_atomic_load(F.ctl + CW_CNT + 64 * l + e, RLX_AGENT); pstart[e] = nb * 256; nb += (c + 255) >> 8; blk_end[e] = nb; } }
    __syncthreads();
}
__device__ __forceinline__ void phase_scatter(Frame& F, int l) {
    const int nrows = (l == 0) ? NTOK : NLAT;
    moe_tables(F, l);
    const LAS int* pstart = (const LAS int*)(F.lds + LDS_X_OFF) + 32;
    const int* tope = (const int*)(F.ws + MOEI_TOPE); const float* topg = (const float*)(F.ws + MOEI_TOPG);
    int* dest = (int*)(F.ws + MOEI_DEST); float* rowg = (float*)(F.ws + MOEI_ROWG);
    const bf16* H = (const bf16*)(F.ws + WS_H); bf16* XS = (bf16*)(F.ws + WS_XS);
    const int gw = F.bid * NWAVES + F.wave, NGW = F.G * NWAVES;
    for (int a = gw; a < nrows * 4; a += NGW) {
        const int te = tope[a], e = te & 255, rank = (int)((unsigned)te >> 8), d = pstart[e] + rank, m = a >> 2;
        if (F.lane == 0) { dest[a] = d; rowg[d] = topg[a]; }
        const v4u* src = (const v4u*)(H + (size_t)m * DM) + F.lane; v4u* dst = (v4u*)(XS + (size_t)d * DM) + F.lane;
#pragma unroll
        for (int j = 0; j < 4; ++j) dst[64 * j] = src[64 * j];
    }
}
__device__ __forceinline__ void phase_gemm1(Frame& F, int l) {
    moe_tables(F, l);
    const LAS int* blk_end = (const LAS int*)(F.lds + LDS_X_OFF);
    pg8::Gemm g{(const bf16*)(F.ws + WS_XS), (const bf16*)(F.ws + WS_WGU) + (size_t)l * 32 * 2048 * 2048, MOE_ROWS, 2048, 2048};
    pg8::MoeOrder S{F.bid, __builtin_amdgcn_readfirstlane(blk_end[31]), (const char*)g.A, (const char*)g.Bt, (size_t)256 * 2048 * 2, (size_t)2048 * 2048 * 2, (size_t)256 * 2048 * 2, blk_end};
    pg8::EpiSwiglu E{(bf16*)(F.ws + WS_ACT), F.in[I_BGU] + (size_t)l * 32 * 2048};
    pg8::gemm_phase<pg8::EpiSwiglu, pg8::MoeOrder, true, true>(F.lds + RING_OFF, g, S, E);
}
__device__ __forceinline__ void phase_gemm2(Frame& F, int l) {
    moe_tables(F, l);
    const LAS int* blk_end = (const LAS int*)(F.lds + LDS_X_OFF);
    pg8::Gemm g{(const bf16*)(F.ws + WS_ACT), (const bf16*)(F.ws + WS_WDN) + (size_t)l * 32 * 2048 * 1024, MOE_ROWS, 2048, 1024};
    pg8::MoeOrder S{F.bid, __builtin_amdgcn_readfirstlane(blk_end[31]), (const char*)g.A, (const char*)g.Bt, (size_t)256 * 1024 * 2, (size_t)2048 * 1024 * 2, (size_t)256 * 1024 * 2, blk_end};
    pg8::EpiDown E{(bf16*)(F.ws + WS_YS), F.in[I_BDN] + (size_t)l * 32 * 2048, (const float*)(F.ws + MOEI_ROWG)};
    pg8::gemm_phase<pg8::EpiDown, pg8::MoeOrder, true, true>(F.lds + RING_OFF, g, S, E);
}
#ifndef PHASE_NORM2
#define PHASE_NORM2(F, l) phase_norm2(F, l)
#endif
#ifndef PHASE_SCATTER
#define PHASE_SCATTER(F, l) phase_scatter(F, l)
#endif
#ifndef PHASE_GEMM1
#define PHASE_GEMM1(F, l) phase_gemm1(F, l)
#endif
#ifndef PHASE_GEMM2
#define PHASE_GEMM2(F, l) phase_gemm2(F, l)
#endif
#define USE_MFMA_ATTN 1

__device__ __forceinline__ void attn_prep(Frame& F, int l) {
    bf16* P = (bf16*)(F.ws + WS_P);
    LAS unsigned short* vt = (LAS unsigned short*)F.lds;
    for (int ct = F.bid; ct < NCT; ct += F.G) {
        const int m0 = ct * 64; const bool lat = m0 < NLAT;
        __syncthreads();
        for (int i = F.tid; i < 64 * 32; i += NTHREADS) { const int tk = i >> 5, c8 = i & 31;
            const v4u w = *(const v4u*)(P + (size_t)(m0 + tk) * PW + PC_V + c8 * 8);
            const unsigned ww[4] = {w.x, w.y, w.z, w.w};
#pragma unroll
            for (int q = 0; q < 4; ++q) { vt[(c8 * 8 + 2 * q) * 66 + tk] = (unsigned short)(ww[q] & 0xffffu); vt[(c8 * 8 + 2 * q + 1) * 66 + tk] = (unsigned short)(ww[q] >> 16); } }
        if (lat) for (int i = F.tid; i < 64 * 128; i += NTHREADS) { const int tk = i >> 7, pi = i & 127, kvh = pi >> 5, hf = (pi >> 4) & 1, j = pi & 15; const int t = (m0 + tk) & 4095;
            bf16* kp = P + (size_t)(m0 + tk) * PW + PC_K + kvh * 64 + hf * 32 + j;
            const float x1 = bf2f(kp[0]), x2 = bf2f(kp[16]); const float pos = (float)(hf ? (t & 63) : (t >> 6)); const float inv = __builtin_amdgcn_exp2f(-(float)j * 0.8304820237218406f);
            const float sn = __sinf(pos * inv), cs = __cosf(pos * inv);
            kp[0] = (bf16)f2bf(x1 * cs - x2 * sn); kp[16] = (bf16)f2bf(x2 * cs + x1 * sn); }
        __syncthreads();
        for (int i = F.tid; i < 256 * 8; i += NTHREADS) { const int col = i >> 3, c = i & 7, kvh = col >> 6, d = col & 63;
            v4u o; const LAS unsigned short* s = vt + col * 66 + c * 8;
            o.x = s[0] | ((unsigned)s[1] << 16); o.y = s[2] | ((unsigned)s[3] << 16); o.z = s[4] | ((unsigned)s[5] << 16); o.w = s[6] | ((unsigned)s[7] << 16);
            if (lat) { const int b = m0 >> 12, t0 = m0 & 4095; *(v4u*)((bf16*)(F.ws + WS_VT) + ((size_t)(b * 4 + kvh) * 64 + d) * SEQ + t0 + c * 8) = o; }
            else { const int mm = m0 - NLAT, b = mm >> 8, t0 = mm & 255; *(v4u*)((bf16*)(F.ws + WS_VTC) + ((size_t)(b * 4 + kvh) * 64 + d) * CTXL + t0 + c * 8) = o; } }
    }
    __syncthreads();
}

constexpr int AT_KP = 144, AT_VP = 136;
constexpr int AT_KOFF = 0, AT_VOFF = 64 * AT_KP, AT_TILE = 64 * AT_KP + 64 * AT_VP;
__device__ __forceinline__ void attn_unit(Frame& F, int l, int b, int kvh, int qi, int is_ctx) {
    const bf16* P = (const bf16*)(F.ws + WS_P); bf16* CC = (bf16*)(F.ws + WS_CC);
    int lane_o = F.lane; asm volatile("" : "+v"(lane_o));
    const int g = F.wave >> 1, qh = F.wave & 1, hq = kvh * 4 + g, r32 = lane_o & 31, hi = lane_o >> 5;
    const int rowbase = is_ctx ? NLAT + b * CTXL : b * SEQ;
    const int qa = qi * 128 + qh * 64;
    const float LOG2E = 1.4426950408889634f;
    bf16x8 qf[2][4];
#pragma unroll
    for (int qt = 0; qt < 2; ++qt) { const int tq = qa + 32 * qt + r32; const bf16* qp = P + (size_t)(rowbase + tq) * PW + PC_Q + hq * 64 + 8 * hi;
        float x[4][8];
#pragma unroll
        for (int s = 0; s < 4; ++s) { const v4u w = *(const v4u*)(qp + 16 * s); x[s][0] = bflo(w.x); x[s][1] = bfhi(w.x); x[s][2] = bflo(w.y); x[s][3] = bfhi(w.y); x[s][4] = bflo(w.z); x[s][5] = bfhi(w.z); x[s][6] = bflo(w.w); x[s][7] = bfhi(w.w); }
        if (!is_ctx) {
#pragma unroll
            for (int hf = 0; hf < 2; ++hf) { const float pos = (float)(hf ? (tq & 63) : (tq >> 6));
#pragma unroll
                for (int j = 0; j < 8; ++j) { const float inv = __builtin_amdgcn_exp2f(-(float)(8 * hi + j) * 0.8304820237218406f); const float sn = __sinf(pos * inv), cs = __cosf(pos * inv);
                    const float x1 = x[2 * hf][j], x2 = x[2 * hf + 1][j]; x[2 * hf][j] = x1 * cs - x2 * sn; x[2 * hf + 1][j] = x2 * cs + x1 * sn; } } }
        const float sc = 0.125f * LOG2E;
#pragma unroll
        for (int s = 0; s < 4; ++s) { v4u w; w.x = pk2(x[s][0] * sc, x[s][1] * sc); w.y = pk2(x[s][2] * sc, x[s][3] * sc); w.z = pk2(x[s][4] * sc, x[s][5] * sc); w.w = pk2(x[s][6] * sc, x[s][7] * sc); qf[qt][s] = __builtin_bit_cast(bf16x8, w); }
    }
    float mrun[2], lrun[2]; f32x16 O[2][2];
    { const float sk = F.in[I_SINK][l * 16 + hq] * LOG2E;
#pragma unroll
      for (int qt = 0; qt < 2; ++qt) { mrun[qt] = sk; lrun[qt] = hi ? 0.f : 1.f;
#pragma unroll
        for (int db = 0; db < 2; ++db)
#pragma unroll
            for (int r = 0; r < 16; ++r) O[qt][db][r] = 0.f; } }
    const int ntl = is_ctx ? 0 : 6;
#pragma unroll 1
    for (int kt = 0; kt < ntl + 4; ++kt) {
        const bool local = kt < ntl; const int k0 = local ? 128 * (qi - 1) + 64 * kt : 64 * (kt - ntl);
        if (local && (k0 < 0 || k0 >= SEQ)) continue;
        __syncthreads();
        { const int rr = F.tid >> 3, c = F.tid & 7;
          const bf16* ksrc = P + (size_t)((local ? b * SEQ : NLAT + b * CTXL) + k0 + rr) * PW + PC_K + kvh * 64 + c * 8;
          const bf16* vsrc = local ? (const bf16*)(F.ws + WS_VT) + ((size_t)(b * 4 + kvh) * 64 + rr) * SEQ + k0 + c * 8 : (const bf16*)(F.ws + WS_VTC) + ((size_t)(b * 4 + kvh) * 64 + rr) * CTXL + k0 + c * 8;
          const v4u kw = *(const v4u*)ksrc, vw = *(const v4u*)vsrc;
          *(LAS v4u*)(F.lds + AT_KOFF + rr * AT_KP + c * 16) = kw;
          LAS v2u* vd = (LAS v2u*)(F.lds + AT_VOFF + rr * AT_VP + c * 16); vd[0] = (v2u){vw.x, vw.y}; vd[1] = (v2u){vw.z, vw.w}; }
        __syncthreads();
        if (local && (k0 + 63 < qa - 128 || k0 > qa + 63 + 128)) continue;
#pragma unroll 1
        for (int kb = 0; kb < 2; ++kb) {
            bf16x8 kf[4];
#pragma unroll
            for (int ss = 0; ss < 4; ++ss) kf[ss] = *(const LAS bf16x8*)(F.lds + AT_KOFF + (32 * kb + r32) * AT_KP + (16 * ss + 8 * hi) * 2);
            bf16x8 pb[2][2];
#pragma unroll
            for (int qt = 0; qt < 2; ++qt) { const int tq = qa + 32 * qt + r32;
                f32x16 s;
#pragma unroll
                for (int r = 0; r < 16; ++r) s[r] = 0.f;
#pragma unroll
                for (int ss = 0; ss < 4; ++ss) s = __builtin_amdgcn_mfma_f32_32x32x16_bf16(kf[ss], qf[qt][ss], s, 0, 0, 0);
                if (local) {
#pragma unroll
                    for (int r = 0; r < 16; ++r) { const int kidx = k0 + 32 * kb + (r & 3) + 8 * (r >> 2) + 4 * hi; const int dlt = kidx - tq; if (dlt > 128 || dlt < -128) s[r] = -1.0e30f; } }
                float mloc = s[0];
#pragma unroll
                for (int r = 1; r < 16; ++r) mloc = fmaxf(mloc, s[r]);
                mloc = fmaxf(mloc, __shfl_xor(mloc, 32));
                const float mnew = fmaxf(mrun[qt], mloc), alpha = __builtin_amdgcn_exp2f(mrun[qt] - mnew); mrun[qt] = mnew;
                float psum = 0.f;
#pragma unroll
                for (int r = 0; r < 16; ++r) { s[r] = __builtin_amdgcn_exp2f(s[r] - mnew); psum += s[r]; }
                lrun[qt] = lrun[qt] * alpha + psum;
#pragma unroll
                for (int db = 0; db < 2; ++db)
#pragma unroll
                    for (int r = 0; r < 16; ++r) O[qt][db][r] *= alpha;
#pragma unroll
                for (int s2 = 0; s2 < 2; ++s2) { v4u pw; pw.x = pk2(s[8 * s2 + 0], s[8 * s2 + 1]); pw.y = pk2(s[8 * s2 + 2], s[8 * s2 + 3]); pw.z = pk2(s[8 * s2 + 4], s[8 * s2 + 5]); pw.w = pk2(s[8 * s2 + 6], s[8 * s2 + 7]);
                    pb[qt][s2] = __builtin_bit_cast(bf16x8, pw); }
            }
#pragma unroll
            for (int s2 = 0; s2 < 2; ++s2)
#pragma unroll
                for (int db = 0; db < 2; ++db) { const LAS v2u* vp = (const LAS v2u*)(F.lds + AT_VOFF + (32 * db + r32) * AT_VP + (32 * kb + 16 * s2 + 4 * hi) * 2);
                    const v2u a0 = vp[0], a1 = vp[2]; v4u aw; aw.x = a0.x; aw.y = a0.y; aw.z = a1.x; aw.w = a1.y; const bf16x8 va = __builtin_bit_cast(bf16x8, aw);
                    O[0][db] = __builtin_amdgcn_mfma_f32_32x32x16_bf16(va, pb[0][s2], O[0][db], 0, 0, 0);
                    O[1][db] = __builtin_amdgcn_mfma_f32_32x32x16_bf16(va, pb[1][s2], O[1][db], 0, 0, 0); }
        }
    }
    int r32e = r32, hie = hi; asm volatile("" : "+v"(r32e), "+v"(hie));
#pragma unroll
    for (int qt = 0; qt < 2; ++qt) { const float lt = lrun[qt] + __shfl_xor(lrun[qt], 32); const float rl = 1.0f / lt; const int tq = qa + 32 * qt + r32e;
        bf16* op = CC + (size_t)(rowbase + tq) * DM + hq * 64 + 4 * hie;
#pragma unroll
        for (int db = 0; db < 2; ++db)
#pragma unroll
            for (int rq = 0; rq < 4; ++rq) { v2u w; w.x = pk2(O[qt][db][4 * rq] * rl, O[qt][db][4 * rq + 1] * rl); w.y = pk2(O[qt][db][4 * rq + 2] * rl, O[qt][db][4 * rq + 3] * rl);
                *(v2u*)(op + 32 * db + 8 * rq) = w; } }
}
__device__ __forceinline__ void attn_phase(Frame& F, int l) {
    const int nunits = 512 + (l == 0 ? 32 : 0);
    LAS int* slot = (LAS int*)(F.lds + LDS_X_OFF + 512);
    for (;;) {
        __syncthreads();
        if (F.tid == 0) *slot = (int)__hip_atomic_fetch_add(F.ctl + CW_ATQ + 64 * l, 1u, RLX_AGENT);
        __syncthreads();
        const int u = __builtin_amdgcn_readfirstlane(*slot);
        if (u >= nunits) break;
        if (u < 512) attn_unit(F, l, u >> 7, (u >> 5) & 3, u & 31, 0); else { const int v = u - 512; attn_unit(F, l, v >> 3, (v >> 1) & 3, v & 1, 1); }
    }
}
#define USE_CHUNK_DN 1

constexpr int DN_F_NEGW = 0, DN_F_QG = 16, DN_F_QK = 32, DN_F_KGT = 40, DN_NFRAG = 56, DN_U_OFF = 57344;
constexpr int DP_QS = 0, DP_KS = 17408, DP_VS = 34816, DP_AS = 52224  , DP_TB = 69632, DP_TW = 78848, DP_QK = 88064, DP_SC = 97280;
constexpr int DP_P = 272, DP_P2 = 144;
__device__ __forceinline__ int dn_rec(int b, int h, int dir, int np) { return ((b * 4 + h) * 2 + dir) * 68 + np; }
__device__ __forceinline__ void dn_chunk_of(int ct, int dir, int& b, int& np) { if (ct < 256) { b = ct >> 6; const int c = ct & 63; np = 4 + (dir ? 63 - c : c); } else { b = (ct - 256) >> 2; const int c = (ct - 256) & 3; np = dir ? 3 - c : c; } }
__device__ __forceinline__ unsigned short lds_u16(const LAS unsigned char* p) { return *(const LAS unsigned short*)p; }

__device__ __forceinline__ void dn_prep_unit(Frame& F, int l, int ct, int h, int dir) {
    const bf16* P = (const bf16*)(F.ws + WS_P);
    int lane = F.lane; asm volatile("" : "+v"(lane));
    const int wave = F.wave, i16 = lane & 15, q = lane >> 4;
    const int m0 = ct * 64; int t0, T, base; seq_of(m0, t0, T, base);
    int b, np; dn_chunk_of(ct, dir, b, np);
    unsigned char* tile = F.ws + WS_DNT + (size_t)dn_rec(b, h, dir, np) * DNT_BYTES;
    LAS unsigned char* L = F.lds;
    LAS float* SC = (LAS float*)(L + DP_SC);
    __syncthreads();
    {
        const float* cw = F.in[I_DNCW] + (size_t)l * 4 * 1536;
#pragma unroll 1
        for (int i = 0; i < 24; ++i) { const int rid = wave * 24 + i, part = rid >> 6, tok = rid & 63, cch = part * 512 + h * 128 + 2 * lane;
            float s0 = 0.f, s1 = 0.f;
#pragma unroll
            for (int j = 0; j < 4; ++j) { const int tt = t0 + tok + j - 2; if (tt >= 0 && tt < T) { const unsigned w = *(const unsigned*)(P + (size_t)(base + tt) * PW + PC_DQ + cch); const float2 cf = *(const float2*)(cw + j * 1536 + cch);
                s0 += cf.x * bflo(w); s1 += cf.y * bfhi(w); } }
            s0 = siluf_(s0); s1 = siluf_(s1);
            if (part < 2) { const float ss = wave_sum(s0 * s0 + s1 * s1); const float f = (part == 0 ? 0.08838834764831845f : 1.0f) / sqrtf(ss + EPS); s0 *= f; s1 *= f; }
            *(LAS unsigned*)(L + (part == 0 ? DP_QS : (part == 1 ? DP_KS : DP_VS)) + tok * DP_P + lane * 4) = pk2(s0, s1); }
        if (wave == 0) {
            const int tok = dir ? 63 - lane : lane;
            const float pb = bf2f(P[(size_t)(m0 + tok) * PW + PC_BETA + dir * 4 + h]), pa = bf2f(P[(size_t)(m0 + tok) * PW + PC_DEC + dir * 4 + h]);
            const float beta = sigmoidf_(pb); float gc = -__expf(F.in[I_DNALOG][l * 8 + dir * 4 + h]) * softplusf_(pa + F.in[I_DNDT][l * 8 + dir * 4 + h]);
#pragma unroll
            for (int o = 1; o < 64; o <<= 1) { const float v = __shfl_up(gc, o); if (lane >= o) gc += v; }
            const float glast = __shfl(gc, 63);
            SC[lane] = beta; SC[64 + lane] = gc; SC[128 + lane] = __expf(gc); SC[192 + lane] = __expf(glast - gc);
            if (lane == 63) ((float*)(F.ws + WS_DNS))[dn_rec(b, h, dir, np)] = __expf(glast);
        }
    }
    __syncthreads();
#define DN_TOK(r) (dir ? 63 - (r) : (r))
    {
        const int mb = wave & 3, which = wave >> 2;
        f32x4 acc[4];
#pragma unroll
        for (int nb = 0; nb < 4; ++nb) acc[nb] = (f32x4){0.f, 0.f, 0.f, 0.f};
        const LAS unsigned char* arow = L + (which ? DP_QS : DP_KS) + DN_TOK(16 * mb + i16) * DP_P + 16 * q;
#pragma unroll
        for (int ks = 0; ks < 4; ++ks) { const bf16x8 a = *(const LAS bf16x8*)(arow + 64 * ks);
#pragma unroll
            for (int nb = 0; nb < 4; ++nb) { const bf16x8 bb = *(const LAS bf16x8*)(L + DP_KS + DN_TOK(16 * nb + i16) * DP_P + 16 * q + 64 * ks);
                acc[nb] = __builtin_amdgcn_mfma_f32_16x16x32_bf16(a, bb, acc[nb], 0, 0, 0); } }
#pragma unroll
        for (int nb = 0; nb < 4; ++nb)
#pragma unroll
            for (int i = 0; i < 4; ++i) { const int r = 16 * mb + 4 * q + i, c = 16 * nb + i16; const float dec = __expf(SC[64 + r] - SC[64 + c]);
                if (which == 0) ((LAS float*)(L + DP_AS))[r * 68 + c] = (r > c) ? SC[r] * acc[nb][i] * dec : 0.f;
                else *(LAS unsigned short*)(L + DP_QK + r * DP_P2 + c * 2) = (unsigned short)f2bf((r >= c) ? acc[nb][i] * dec : 0.f); }
    }
    __syncthreads();
    if (wave == 0) {
        const LAS float* As = (const LAS float*)(L + DP_AS);
        float t[64];
#pragma unroll
        for (int r = 0; r < 64; ++r) { float a0 = (lane == r) ? 1.f : 0.f, a1 = 0.f, a2 = 0.f, a3 = 0.f;
#pragma unroll
            for (int j4 = 0; j4 < (r + 3) / 4; ++j4) { const f32x4 av = *(const LAS f32x4*)(As + r * 68 + 4 * j4);
                if (4 * j4 + 0 < r) a0 -= av.x * t[4 * j4 + 0]; if (4 * j4 + 1 < r) a1 -= av.y * t[4 * j4 + 1]; if (4 * j4 + 2 < r) a2 -= av.z * t[4 * j4 + 2]; if (4 * j4 + 3 < r) a3 -= av.w * t[4 * j4 + 3]; }
            t[r] = (a0 + a1) + (a2 + a3); }
        const float bl = SC[lane], bw = bl * SC[128 + lane];
#pragma unroll
        for (int r = 0; r < 64; ++r) { *(LAS unsigned short*)(L + DP_TB + r * DP_P2 + lane * 2) = (unsigned short)f2bf(t[r] * bl); *(LAS unsigned short*)(L + DP_TW + r * DP_P2 + lane * 2) = (unsigned short)f2bf(t[r] * bw); }
    }
    __syncthreads();
    {
        const int nbp = wave & 3, which = wave >> 2;
        f32x4 acc[4][2];
#pragma unroll
        for (int mb = 0; mb < 4; ++mb) { acc[mb][0] = (f32x4){0.f, 0.f, 0.f, 0.f}; acc[mb][1] = (f32x4){0.f, 0.f, 0.f, 0.f}; }
#pragma unroll
        for (int ks = 0; ks < 2; ++ks) {
            bf16x8 bb[2];
#pragma unroll
            for (int nn = 0; nn < 2; ++nn) { const int n = 16 * (2 * nbp + nn) + i16; unsigned short e[8];
#pragma unroll
                for (int jj = 0; jj < 8; ++jj) e[jj] = lds_u16(L + (which ? DP_KS : DP_VS) + DN_TOK(32 * ks + 8 * q + jj) * DP_P + n * 2);
                v4u w; w.x = e[0] | ((unsigned)e[1] << 16); w.y = e[2] | ((unsigned)e[3] << 16); w.z = e[4] | ((unsigned)e[5] << 16); w.w = e[6] | ((unsigned)e[7] << 16); bb[nn] = __builtin_bit_cast(bf16x8, w); }
#pragma unroll
            for (int mb = 0; mb < 4; ++mb) { const bf16x8 a = *(const LAS bf16x8*)(L + (which ? DP_TW : DP_TB) + (16 * mb + i16) * DP_P2 + 64 * ks + 16 * q);
                acc[mb][0] = __builtin_amdgcn_mfma_f32_16x16x32_bf16(a, bb[0], acc[mb][0], 0, 0, 0); acc[mb][1] = __builtin_amdgcn_mfma_f32_16x16x32_bf16(a, bb[1], acc[mb][1], 0, 0, 0); } }
        if (which == 0) {
#pragma unroll
            for (int mb = 0; mb < 4; ++mb)
#pragma unroll
                for (int nn = 0; nn < 2; ++nn) *(f32x4*)(tile + DN_U_OFF + (size_t)((((2 * nbp + nn) * 4 + mb) * 64 + lane) * 16)) = acc[mb][nn];
        } else {
#pragma unroll
            for (int mb = 0; mb < 4; ++mb)
#pragma unroll
                for (int nn = 0; nn < 2; ++nn)
#pragma unroll
                    for (int i = 0; i < 4; ++i) *(LAS unsigned short*)(L + DP_AS + (16 * mb + 4 * q + i) * DP_P + (16 * (2 * nbp + nn) + i16) * 2) = (unsigned short)f2bf(-acc[mb][nn][i]);
        }
    }
    __syncthreads();
#pragma unroll 1
    for (int fi = 0; fi < 7; ++fi) { const int f = wave * 7 + fi; v4u o;
        if (f < DN_F_QG) { const int mb = f >> 2, ks = f & 3; const LAS unsigned char* rp = L + DP_AS + (16 * mb + i16) * DP_P + (32 * ks + 4 * q) * 2;
            const v2u a = *(const LAS v2u*)rp, c = *(const LAS v2u*)(rp + 32); o.x = a.x; o.y = a.y; o.z = c.x; o.w = c.y; }
        else if (f < DN_F_QK) { const int ff = f - DN_F_QG, mb = ff >> 2, ks = ff & 3, r = 16 * mb + i16; const LAS unsigned char* rp = L + DP_QS + DN_TOK(r) * DP_P + (32 * ks + 4 * q) * 2; const float eg = SC[128 + r];
            const v2u a = *(const LAS v2u*)rp, c = *(const LAS v2u*)(rp + 32);
            o.x = pk2(bflo(a.x) * eg, bfhi(a.x) * eg); o.y = pk2(bflo(a.y) * eg, bfhi(a.y) * eg); o.z = pk2(bflo(c.x) * eg, bfhi(c.x) * eg); o.w = pk2(bflo(c.y) * eg, bfhi(c.y) * eg); }
        else if (f < DN_F_KGT) { const int ff = f - DN_F_QK, mb = ff >> 1, ks = ff & 1; const LAS unsigned char* rp = L + DP_QK + (16 * mb + i16) * DP_P2 + (32 * ks + 4 * q) * 2;
            const v2u a = *(const LAS v2u*)rp, c = *(const LAS v2u*)(rp + 32); o.x = a.x; o.y = a.y; o.z = c.x; o.w = c.y; }
        else { const int ff = f - DN_F_KGT, mb = ff >> 1, ks = ff & 1, dk = 16 * mb + i16; float e[8];
#pragma unroll
            for (int jj = 0; jj < 8; ++jj) { const int key = 32 * ks + 16 * (jj >> 2) + 4 * q + (jj & 3); e[jj] = bf2f(lds_u16(L + DP_KS + DN_TOK(key) * DP_P + dk * 2)) * SC[192 + key]; }
            o.x = pk2(e[0], e[1]); o.y = pk2(e[2], e[3]); o.z = pk2(e[4], e[5]); o.w = pk2(e[6], e[7]); }
        *(v4u*)(tile + (size_t)f * 1024 + lane * 16) = o; }
#undef DN_TOK
}
__device__ __forceinline__ void dn_prep(Frame& F, int l) {
    for (int u = F.bid; u < NCT * 4 * 2; u += F.G) dn_prep_unit(F, l, u >> 3, (u >> 1) & 3, u & 1);
    __syncthreads();
}

__device__ __forceinline__ void dn_scan(Frame& F, int l, int b, int h, int dir) {
    int lane = F.lane; asm volatile("" : "+v"(lane));
    const int w = F.wave, i16 = lane & 15, q = lane >> 4;
    const unsigned char* tiles = F.ws + WS_DNT + (size_t)dn_rec(b, h, dir, 0) * DNT_BYTES;
    const float* egl = (const float*)(F.ws + WS_DNS) + dn_rec(b, h, dir, 0);
    float* O = (float*)(F.ws + WS_DNO);
    LAS unsigned char* L = F.lds;
    f32x4 S[8];
#pragma unroll
    for (int i = 0; i < 8; ++i) S[i] = (f32x4){0.f, 0.f, 0.f, 0.f};
    v4u st[7];
    __syncthreads();
#pragma unroll
    for (int i = 0; i < 7; ++i) st[i] = *(const v4u*)(tiles + (size_t)(F.tid + i * NTHREADS) * 16);
#pragma unroll
    for (int i = 0; i < 7; ++i) *(LAS v4u*)(L + (F.tid + i * NTHREADS) * 16) = st[i];
    __syncthreads();
#pragma unroll 1
    for (int n = 0; n < 68; ++n) {
        const unsigned char* tile = tiles + (size_t)n * DNT_BYTES; const LAS unsigned char* cur = L + (n & 1) * 57344;
        if (n + 1 < 68) {
#pragma unroll
            for (int i = 0; i < 7; ++i) st[i] = *(const v4u*)(tile + DNT_BYTES + (size_t)(F.tid + i * NTHREADS) * 16); }
        f32x4 vn[4];
#pragma unroll
        for (int mb = 0; mb < 4; ++mb) vn[mb] = *(const f32x4*)(tile + DN_U_OFF + (size_t)(((w * 4 + mb) * 64 + lane) * 16));
        const float el = egl[n];
        bf16x8 bS[4];
#pragma unroll
        for (int ks = 0; ks < 4; ++ks) { v4u x; x.x = pk2(S[2 * ks][0], S[2 * ks][1]); x.y = pk2(S[2 * ks][2], S[2 * ks][3]); x.z = pk2(S[2 * ks + 1][0], S[2 * ks + 1][1]); x.w = pk2(S[2 * ks + 1][2], S[2 * ks + 1][3]); bS[ks] = __builtin_bit_cast(bf16x8, x); }
        f32x4 o[4];
#pragma unroll
        for (int mb = 0; mb < 4; ++mb) { o[mb] = (f32x4){0.f, 0.f, 0.f, 0.f};
#pragma unroll
            for (int ks = 0; ks < 4; ++ks) { const bf16x8 aw = *(const LAS bf16x8*)(cur + (DN_F_NEGW + mb * 4 + ks) * 1024 + lane * 16), aq = *(const LAS bf16x8*)(cur + (DN_F_QG + mb * 4 + ks) * 1024 + lane * 16);
                vn[mb] = __builtin_amdgcn_mfma_f32_16x16x32_bf16(aw, bS[ks], vn[mb], 0, 0, 0); o[mb] = __builtin_amdgcn_mfma_f32_16x16x32_bf16(aq, bS[ks], o[mb], 0, 0, 0); } }
        bf16x8 bV[2];
#pragma unroll
        for (int ks = 0; ks < 2; ++ks) { v4u x; x.x = pk2(vn[2 * ks][0], vn[2 * ks][1]); x.y = pk2(vn[2 * ks][2], vn[2 * ks][3]); x.z = pk2(vn[2 * ks + 1][0], vn[2 * ks + 1][1]); x.w = pk2(vn[2 * ks + 1][2], vn[2 * ks + 1][3]); bV[ks] = __builtin_bit_cast(bf16x8, x); }
#pragma unroll
        for (int mb = 0; mb < 8; ++mb) { S[mb] = S[mb] * el;
#pragma unroll
            for (int ks = 0; ks < 2; ++ks) { const bf16x8 ak = *(const LAS bf16x8*)(cur + (DN_F_KGT + mb * 2 + ks) * 1024 + lane * 16); S[mb] = __builtin_amdgcn_mfma_f32_16x16x32_bf16(ak, bV[ks], S[mb], 0, 0, 0); } }
#pragma unroll
        for (int mb = 0; mb < 4; ++mb)
#pragma unroll
            for (int ks = 0; ks < 2; ++ks) { const bf16x8 aqk = *(const LAS bf16x8*)(cur + (DN_F_QK + mb * 2 + ks) * 1024 + lane * 16); o[mb] = __builtin_amdgcn_mfma_f32_16x16x32_bf16(aqk, bV[ks], o[mb], 0, 0, 0); }
        { int m0; if (n < 4) m0 = NLAT + b * CTXL + 64 * (dir ? 3 - n : n); else m0 = b * SEQ + 64 * (dir ? 63 - (n - 4) : (n - 4));
#pragma unroll
          for (int mb = 0; mb < 4; ++mb)
#pragma unroll
            for (int i = 0; i < 4; ++i) { const int r = 16 * mb + 4 * q + i, tok = dir ? 63 - r : r; O[((size_t)dir * NTOK + m0 + tok) * 512 + h * 128 + 16 * w + i16] = o[mb][i]; } }
        if (n + 1 < 68) {
#pragma unroll
            for (int i = 0; i < 7; ++i) *(LAS v4u*)(L + ((n + 1) & 1) * 57344 + (F.tid + i * NTHREADS) * 16) = st[i]; }
        __syncthreads();
    }
}
#define USE_CHUNK_LRU 1

constexpr int LR_XF = 0  , LR_XB = 16640  , LR_WT = 25856  , LR_AA = 62720  , LR_UU = 96000  , LR_END = 129280;
constexpr size_t WS_LCA = WS_LRC, WS_LCH = WS_LRC + 2 * MiB, WS_LCI = WS_LRC + 4 * MiB;
__device__ __forceinline__ void lru_prep(Frame& F, int l) {
    const bf16* P = (const bf16*)(F.ws + WS_P);
    int lane = F.lane; asm volatile("" : "+v"(lane));
    const int wave = F.wave, i16 = lane & 15, q = lane >> 4, nb = F.bid & 7;
    LAS unsigned char* L = F.lds;
    LAS float* XF = (LAS float*)(L + LR_XF); LAS float* AA = (LAS float*)(L + LR_AA); LAS float* UU = (LAS float*)(L + LR_UU);
    float* HL = (float*)(F.ws + WS_LRH); float* AC = (float*)(F.ws + WS_LRA);
    __syncthreads();
    for (int e = F.tid; e < 4 * 4096; e += NTHREADS) { const int mat = e >> 12, ii = (e >> 6) & 63, j = e & 63, dir = mat >> 1;
        const float w = (mat & 1 ? F.in[I_LRWI] : F.in[I_LRWR])[((size_t)((l * 2 + dir) * 8 + nb)) * 4096 + ii * 64 + j];
        *(LAS unsigned short*)(L + LR_WT + (mat * 64 + j) * 144 + ii * 2) = (unsigned short)f2bf(w); }
    for (int ct = F.bid >> 3; ct < NCT; ct += F.G >> 3) {
        const int m0 = ct * 64; int t0, T, base; seq_of(m0, t0, T, base);
        __syncthreads();
        { const int tok = F.tid >> 3, c8 = (F.tid & 7) * 8, ch0 = nb * 64 + c8; float s[8];
          const float* cb = F.in[I_LRCB] + l * 512 + ch0; const float* cw = F.in[I_LRCW] + (size_t)l * 4 * 512 + ch0;
#pragma unroll
          for (int k = 0; k < 8; ++k) s[k] = cb[k];
#pragma unroll
          for (int j = 0; j < 4; ++j) { const int tt = t0 + tok + j - 2; if (tt >= 0 && tt < T) { const v4u w = *(const v4u*)(P + (size_t)(base + tt) * PW + PC_LX + ch0);
              const f32x4 c0 = *(const f32x4*)(cw + j * 512), c1 = *(const f32x4*)(cw + j * 512 + 4);
              s[0] += c0.x * bflo(w.x); s[1] += c0.y * bfhi(w.x); s[2] += c0.z * bflo(w.y); s[3] += c0.w * bfhi(w.y); s[4] += c1.x * bflo(w.z); s[5] += c1.y * bfhi(w.z); s[6] += c1.z * bflo(w.w); s[7] += c1.w * bfhi(w.w); } }
#pragma unroll
          for (int k = 0; k < 8; ++k) XF[tok * 65 + c8 + k] = s[k];
          v4u o; o.x = pk2(s[0], s[1]); o.y = pk2(s[2], s[3]); o.z = pk2(s[4], s[5]); o.w = pk2(s[6], s[7]); *(LAS v4u*)(L + LR_XB + tok * 144 + c8 * 2) = o; }
        __syncthreads();
        { const int dir = wave >> 2, mb = wave & 3;
          f32x4 ar[4], ai[4];
#pragma unroll
          for (int n = 0; n < 4; ++n) { ar[n] = (f32x4){0.f, 0.f, 0.f, 0.f}; ai[n] = (f32x4){0.f, 0.f, 0.f, 0.f}; }
#pragma unroll
          for (int ks = 0; ks < 2; ++ks) { const bf16x8 a = *(const LAS bf16x8*)(L + LR_XB + (16 * mb + i16) * 144 + 64 * ks + 16 * q);
#pragma unroll
              for (int n = 0; n < 4; ++n) { const bf16x8 br = *(const LAS bf16x8*)(L + LR_WT + ((dir * 2 + 0) * 64 + 16 * n + i16) * 144 + 64 * ks + 16 * q), bi = *(const LAS bf16x8*)(L + LR_WT + ((dir * 2 + 1) * 64 + 16 * n + i16) * 144 + 64 * ks + 16 * q);
                  ar[n] = __builtin_amdgcn_mfma_f32_16x16x32_bf16(a, br, ar[n], 0, 0, 0); ai[n] = __builtin_amdgcn_mfma_f32_16x16x32_bf16(a, bi, ai[n], 0, 0, 0); } }
#pragma unroll
          for (int n = 0; n < 4; ++n) { const int j = 16 * n + i16, ch = nb * 64 + j; const float br_ = F.in[I_LRBR][(l * 2 + dir) * 512 + ch], bi_ = F.in[I_LRBI][(l * 2 + dir) * 512 + ch];
              const float logsig = -softplusf_(-F.in[I_LRLAM][(l * 2 + dir) * 512 + ch]);
#pragma unroll
              for (int i = 0; i < 4; ++i) { const int tok = 16 * mb + 4 * q + i; const float r = sigmoidf_(ar[n][i] + br_), ig = sigmoidf_(ai[n][i] + bi_);
                  const float log_a = 8.0f * r * logsig, a = __expf(log_a), u = sqrtf(-expm1f(2.0f * log_a)) * (ig * XF[tok * 65 + j]);
                  AA[(dir * 64 + tok) * 65 + j] = a; UU[(dir * 64 + tok) * 65 + j] = u; } } }
        __syncthreads();
        if (F.tid < 128) { const int dir = F.tid >> 6, j = F.tid & 63, ch = nb * 64 + j; float h = 0.f, ac = 1.f;
#pragma unroll 4
            for (int s = 0; s < 64; ++s) { const int tok = dir ? 63 - s : s; const float a = AA[(dir * 64 + tok) * 65 + j], u = UU[(dir * 64 + tok) * 65 + j];
                h = a * h + u; ac *= a; const size_t o = ((size_t)dir * NTOK + m0 + tok) * 512 + ch; HL[o] = h; AC[o] = ac; }
            ((float*)(F.ws + WS_LCA))[((size_t)dir * NCT + ct) * 512 + ch] = ac; ((float*)(F.ws + WS_LCH))[((size_t)dir * NCT + ct) * 512 + ch] = h; }
    }
    __syncthreads();
}
__device__ __forceinline__ void lru_carry(Frame& F, int idx) {
    const int ch = idx & 511, dir = (idx >> 9) & 1, b = idx >> 10;
    const float* CA = (const float*)(F.ws + WS_LCA); const float* CH = (const float*)(F.ws + WS_LCH); float* CI = (float*)(F.ws + WS_LCI);
    float h = 0.f;
#pragma unroll 4
    for (int n = 0; n < 68; ++n) { const int ct = n < 4 ? 256 + b * 4 + (dir ? 3 - n : n) : b * 64 + (dir ? 63 - (n - 4) : (n - 4)); const size_t o = ((size_t)dir * NCT + ct) * 512 + ch;
        CI[o] = h; h = CA[o] * h + CH[o]; }
}
__device__ __forceinline__ void lru_fin(Frame& F, int l) {
    const int nrows = (l == 0) ? NTOK : NLAT;
    const bf16* P = (const bf16*)(F.ws + WS_P); bf16* CC = (bf16*)(F.ws + WS_CC);
    const float* HL = (const float*)(F.ws + WS_LRH); const float* AC = (const float*)(F.ws + WS_LRA); const float* CI = (const float*)(F.ws + WS_LCI);
    for (size_t i = (size_t)F.bid * NTHREADS + F.tid; i < (size_t)nrows * 128; i += (size_t)F.G * NTHREADS) { const int m = (int)(i >> 7), c4 = (int)(i & 127) * 4, ct = m >> 6;
        const f32x4 h0 = *(const f32x4*)(HL + (size_t)m * 512 + c4), a0 = *(const f32x4*)(AC + (size_t)m * 512 + c4), i0 = *(const f32x4*)(CI + (size_t)ct * 512 + c4);
        const f32x4 h1 = *(const f32x4*)(HL + ((size_t)NTOK + m) * 512 + c4), a1 = *(const f32x4*)(AC + ((size_t)NTOK + m) * 512 + c4), i1 = *(const f32x4*)(CI + ((size_t)NCT + ct) * 512 + c4);
        const f32x4 hs = (a0 * i0 + h0) + (a1 * i1 + h1); const v2u yw = *(const v2u*)(P + (size_t)m * PW + PC_LY + c4);
        v2u o; o.x = pk2(hs.x * gelu_tanh(bflo(yw.x)), hs.y * gelu_tanh(bfhi(yw.x))); o.y = pk2(hs.z * gelu_tanh(bflo(yw.y)), hs.w * gelu_tanh(bfhi(yw.y)));
        *(v2u*)(CC + (size_t)m * DM + 1536 + c4) = o; }
}

constexpr size_t WS_DNQ = WS_DNT;
constexpr size_t WS_BG = WS_DNS + 1 * MiB;
constexpr size_t WS_XC = WS_XS;

__device__ __forceinline__ void naive_prep(Frame& F, int l) {
    const bf16* P = (const bf16*)(F.ws + WS_P);
    const int gw = F.bid * NWAVES + F.wave, NGW = F.G * NWAVES;
#if !defined(USE_CHUNK_DN)
    {
        float* DNQ = (float*)(F.ws + WS_DNQ); float* BG = (float*)(F.ws + WS_BG);
        const float* cw = F.in[I_DNCW] + (size_t)l * 4 * 1536;
        for (int it = gw; it < NTOK * 4; it += NGW) {
            const int m = it >> 2, h = it & 3; int t, T, base; seq_of(m, t, T, base);
            float val[3][2];
#pragma unroll
            for (int part = 0; part < 3; ++part)
#pragma unroll
                for (int dd = 0; dd < 2; ++dd) { const int d = F.lane + 64 * dd, cch = part * 512 + h * 128 + d, col = PC_DQ + cch; float s = 0.f;
#pragma unroll
                    for (int j = 0; j < 4; ++j) { const int tt = t + j - 2; if (tt >= 0 && tt < T) s += cw[j * 1536 + cch] * bf2f(P[(size_t)(base + tt) * PW + col]); }
                    val[part][dd] = siluf_(s); }
            const float sq = wave_sum(val[0][0] * val[0][0] + val[0][1] * val[0][1]), sk = wave_sum(val[1][0] * val[1][0] + val[1][1] * val[1][1]);
            const float fq = 0.08838834764831845f / sqrtf(sq + EPS), fk = 1.0f / sqrtf(sk + EPS);
#pragma unroll
            for (int dd = 0; dd < 2; ++dd) { const int d = F.lane + 64 * dd; float* o = DNQ + (size_t)m * 1536 + h * 128 + d;
                o[0] = val[0][dd] * fq; o[512] = val[1][dd] * fk; o[1024] = val[2][dd]; }
            if (h == 0 && F.lane < 8) { const int dir = F.lane >> 2, hh = F.lane & 3;
                const float pb = bf2f(P[(size_t)m * PW + PC_BETA + F.lane]), pa = bf2f(P[(size_t)m * PW + PC_DEC + F.lane]);
                BG[m * 16 + F.lane] = sigmoidf_(pb);
                BG[m * 16 + 8 + F.lane] = -__expf(F.in[I_DNALOG][l * 8 + dir * 4 + hh]) * softplusf_(pa + F.in[I_DNDT][l * 8 + dir * 4 + hh]); }
        }
    }
#endif
#if !defined(USE_CHUNK_LRU)
    {
        LAS float* xc = (LAS float*)F.lds;
        float* A = (float*)(F.ws + WS_LRA); float* U = (float*)(F.ws + WS_LRH);
        const float* cw = F.in[I_LRCW] + (size_t)l * 4 * 512; const float* cb = F.in[I_LRCB] + l * 512;
        for (int m0 = F.bid * 8; m0 < NTOK; m0 += F.G * 8) {
            __syncthreads();
            for (int i = F.tid; i < 8 * 512; i += NTHREADS) { const int m = m0 + (i >> 9), ch = i & 511; int t, T, base; seq_of(m, t, T, base); float s = cb[ch];
#pragma unroll
                for (int j = 0; j < 4; ++j) { const int tt = t + j - 2; if (tt >= 0 && tt < T) s += cw[j * 512 + ch] * bf2f(P[(size_t)(base + tt) * PW + PC_LX + ch]); }
                xc[i] = s; }
            __syncthreads();
            for (int i = F.tid; i < 8 * 512 * 2; i += NTHREADS) { const int ch = i & 511, dir = (i >> 9) & 1, tk = i >> 10, m = m0 + tk, blk = ch >> 6, j = ch & 63;
                const float* wr = F.in[I_LRWR] + ((size_t)((l * 2 + dir) * 8 + blk)) * 4096 + j; const float* wi = F.in[I_LRWI] + ((size_t)((l * 2 + dir) * 8 + blk)) * 4096 + j;
                float sr = F.in[I_LRBR][(l * 2 + dir) * 512 + ch], si = F.in[I_LRBI][(l * 2 + dir) * 512 + ch];
#pragma unroll 8
                for (int ii = 0; ii < 64; ++ii) { const float x = xc[tk * 512 + blk * 64 + ii]; sr += x * wr[ii * 64]; si += x * wi[ii * 64]; }
                const float r = sigmoidf_(sr), ig = sigmoidf_(si); const float lam = F.in[I_LRLAM][(l * 2 + dir) * 512 + ch];
                const float logsig = -softplusf_(-lam);
                const float log_a = 8.0f * r * logsig; const float a = __expf(log_a);
                const float u = sqrtf(-expm1f(2.0f * log_a)) * (ig * xc[tk * 512 + ch]);
                A[((size_t)dir * NTOK + m) * 512 + ch] = a; U[((size_t)dir * NTOK + m) * 512 + ch] = u; }
        }
        __syncthreads();
    }
#endif
}

__device__ __forceinline__ void naive_attn_row(Frame& F, int l, int m, int hq) {
    const bf16* P = (const bf16*)(F.ws + WS_P); bf16* CC = (bf16*)(F.ws + WS_CC);
    const int d = F.lane, kvh = hq >> 2; int t, T, base; seq_of(m, t, T, base);
    const bool lat = m < NLAT; const int b = lat ? (m >> 12) : ((m - NLAT) >> 8);
    const int dd = d & 31, jf = dd & 15; const float inv = __powf(10000.0f, -(float)jf * (1.0f / 16.0f));
    const bool second = (dd >= 16), colhalf = (d >= 32);
    float q = bf2f(P[(size_t)m * PW + PC_Q + hq * 64 + d]);
    if (lat) { const float pos = (float)(colhalf ? (t & 63) : (t >> 6)); float sn, cs; sincosf(pos * inv, &sn, &cs); const float pr = __shfl_xor(q, 16); q = second ? (q * cs + pr * sn) : (q * cs - pr * sn); }
    q *= 0.125f;
    float mx = F.in[I_SINK][l * 16 + hq], den = 1.0f, acc = 0.f;
    if (lat) { const int t0 = t - 128 < 0 ? 0 : t - 128, t1 = t + 128 > SEQ - 1 ? SEQ - 1 : t + 128;
        for (int tk = t0; tk <= t1; ++tk) { const size_t r = (size_t)(base + tk) * PW; float k = bf2f(P[r + PC_K + kvh * 64 + d]); const float v = bf2f(P[r + PC_V + kvh * 64 + d]);
            const float pos = (float)(colhalf ? (tk & 63) : (tk >> 6)); float sn, cs; sincosf(pos * inv, &sn, &cs); const float pr = __shfl_xor(k, 16); k = second ? (k * cs + pr * sn) : (k * cs - pr * sn);
            const float s = wave_sum(q * k); const float mn = fmaxf(mx, s), f = __expf(mx - mn), p = __expf(s - mn); den = den * f + p; acc = acc * f + p * v; mx = mn; } }
    for (int c = 0; c < CTXL; ++c) { const size_t r = (size_t)(NLAT + b * CTXL + c) * PW; const float k = bf2f(P[r + PC_K + kvh * 64 + d]), v = bf2f(P[r + PC_V + kvh * 64 + d]);
        const float s = wave_sum(q * k); const float mn = fmaxf(mx, s), f = __expf(mx - mn), p = __expf(s - mn); den = den * f + p; acc = acc * f + p * v; mx = mn; }
    CC[(size_t)m * DM + hq * 64 + d] = (bf16)f2bf(acc / den);
}

__device__ __forceinline__ int scan_row(int n, int b, int dir) { if (n < CTXL) { const int t = dir ? (CTXL - 1 - n) : n; return NLAT + b * CTXL + t; } const int t = dir ? (SEQ - 1 - (n - CTXL)) : (n - CTXL); return b * SEQ + t; }
__device__ __forceinline__ void naive_scan(Frame& F, int l) {
#if defined(USE_CHUNK_DN)
    if (F.bid < 32) { dn_scan(F, l, F.bid >> 3, (F.bid >> 1) & 3, F.bid & 1); }
#else
    if (F.bid < 32) {
        const int b = F.bid >> 3, h = (F.bid >> 1) & 3, dir = F.bid & 1, dvc = F.tid & 127, kq = F.tid >> 7;
        const float* DNQ = (const float*)(F.ws + WS_DNQ); const float* BG = (const float*)(F.ws + WS_BG); float* O = (float*)(F.ws + WS_DNO);
        LAS float* buf = (LAS float*)F.lds;
        LAS float* red = buf + 768;
        LAS float* red2 = red + 512;
        float S[32];
#pragma unroll
        for (int i = 0; i < 32; ++i) S[i] = 0.f;
        constexpr int NT = CTXL + SEQ;
        { const int m = scan_row(0, b, dir); if (F.tid < 384) buf[F.tid] = DNQ[(size_t)m * 1536 + (F.tid >> 7) * 512 + h * 128 + (F.tid & 127)]; }
        __syncthreads();
#pragma unroll 1
        for (int n = 0; n < NT; ++n) {
            const int m = scan_row(n, b, dir); const LAS float* cur = buf + (n & 1) * 384;
            float nextv = 0.f; if (n + 1 < NT && F.tid < 384) { const int m2 = scan_row(n + 1, b, dir); nextv = DNQ[(size_t)m2 * 1536 + (F.tid >> 7) * 512 + h * 128 + (F.tid & 127)]; }
            const float beta = BG[m * 16 + dir * 4 + h], decay = __expf(BG[m * 16 + 8 + dir * 4 + h]);
            float ks = 0.f;
#pragma unroll
            for (int i = 0; i < 32; ++i) ks += cur[128 + kq * 32 + i] * S[i];
            red[kq * 128 + dvc] = ks;
            __syncthreads();
            const float kS = (red[dvc] + red[128 + dvc]) + (red[256 + dvc] + red[384 + dvc]);
            const float upd = beta * (cur[256 + dvc] - decay * kS);
            float os = 0.f;
#pragma unroll
            for (int i = 0; i < 32; ++i) { S[i] = decay * S[i] + cur[128 + kq * 32 + i] * upd; os += cur[kq * 32 + i] * S[i]; }
            red2[kq * 128 + dvc] = os;
            if (F.tid < 384) buf[((n + 1) & 1) * 384 + F.tid] = nextv;
            __syncthreads();
            if (kq == 0) O[((size_t)dir * NTOK + m) * 512 + h * 128 + dvc] = (red2[dvc] + red2[128 + dvc]) + (red2[256 + dvc] + red2[384 + dvc]);
        }
    }
#endif
#if defined(USE_CHUNK_LRU)
    else if (F.bid < 40) { lru_carry(F, (F.bid - 32) * NTHREADS + F.tid); }
#else
    else if (F.bid < 40) {
        const int idx = (F.bid - 32) * NTHREADS + F.tid, ch = idx & 511, dir = (idx >> 9) & 1, b = idx >> 10;
        const float* A = (const float*)(F.ws + WS_LRA); float* U = (float*)(F.ws + WS_LRH);
        float hs = 0.f;
#pragma unroll 4
        for (int n = 0; n < CTXL + SEQ; ++n) { int m; if (n < CTXL) { const int t = dir ? (CTXL - 1 - n) : n; m = NLAT + b * CTXL + t; } else { const int t = dir ? (SEQ - 1 - (n - CTXL)) : (n - CTXL); m = b * SEQ + t; }
            const size_t o = ((size_t)dir * NTOK + m) * 512 + ch; hs = A[o] * hs + U[o]; U[o] = hs; }
    }
#endif
#if defined(USE_MFMA_ATTN)
    attn_phase(F, l);
#else
    {
        const int nrows = (l == 0) ? NTOK : NLAT;
        for (;;) { int m = 0; if (F.lane == 0) m = (int)__hip_atomic_fetch_add(F.ctl + CW_ATQ + 64 * l, 1u, RLX_AGENT); m = __builtin_amdgcn_readfirstlane(m);
            if (m >= nrows) break;
#pragma unroll 1
            for (int hq = 0; hq < 16; ++hq) naive_attn_row(F, l, m, hq); }
    }
#endif
}

__device__ __forceinline__ void naive_fin(Frame& F, int l) {
    const int nrows = (l == 0) ? NTOK : NLAT;
    const bf16* P = (const bf16*)(F.ws + WS_P); bf16* CC = (bf16*)(F.ws + WS_CC);
    const int gw = F.bid * NWAVES + F.wave, NGW = F.G * NWAVES;
    const float* O = (const float*)(F.ws + WS_DNO); const float* HS = (const float*)(F.ws + WS_LRH);
    for (int it = gw; it < nrows * 4; it += NGW) { const int m = it >> 2, h = it & 3; float o[2];
#pragma unroll
        for (int dd = 0; dd < 2; ++dd) { const int c = h * 128 + F.lane + 64 * dd; o[dd] = O[(size_t)m * 512 + c] + O[((size_t)NTOK + m) * 512 + c]; }
        const float rstd = 1.0f / sqrtf(wave_sum(o[0] * o[0] + o[1] * o[1]) * (1.0f / 128.0f) + EPS);
#pragma unroll
        for (int dd = 0; dd < 2; ++dd) { const int d = F.lane + 64 * dd; const float gt = bf2f(P[(size_t)m * PW + PC_DG + h * 128 + d]);
            CC[(size_t)m * DM + 1024 + h * 128 + d] = (bf16)f2bf(o[dd] * rstd * F.in[I_DNNG][l * 128 + d] * siluf_(gt)); }
    }
#if defined(USE_CHUNK_LRU)
    lru_fin(F, l);
#else
    for (size_t i = (size_t)F.bid * NTHREADS + F.tid; i < (size_t)nrows * 512; i += (size_t)F.G * NTHREADS) { const int m = (int)(i >> 9), ch = (int)(i & 511);
        const float hsum = HS[(size_t)m * 512 + ch] + HS[((size_t)NTOK + m) * 512 + ch]; const float y = bf2f(P[(size_t)m * PW + PC_LY + ch]);
        CC[(size_t)m * DM + 1536 + ch] = (bf16)f2bf(hsum * gelu_tanh(y)); }
#endif
}
#ifndef PHASE_PREP
#if defined(USE_MFMA_ATTN)
#if defined(USE_CHUNK_DN)
#define PHASE_PREP(F, l) do { attn_prep(F, l); lru_prep(F, l); dn_prep(F, l); } while (0)
#else
#define PHASE_PREP(F, l) do { naive_prep(F, l); attn_prep(F, l); } while (0)
#endif
#else
#define PHASE_PREP(F, l) naive_prep(F, l)
#endif
#endif
#ifndef PHASE_SCAN
#define PHASE_SCAN(F, l) naive_scan(F, l)
#endif
#ifndef PHASE_FIN
#define PHASE_FIN(F, l) naive_fin(F, l)
#endif

#ifndef PHASE_INPROJ
#define PHASE_INPROJ(F, l) do {} while (0)
#endif
#ifndef PHASE_PREP
#define PHASE_PREP(F, l) do {} while (0)
#endif
#ifndef PHASE_SCAN
#define PHASE_SCAN(F, l) do {} while (0)
#endif
#ifndef PHASE_FIN
#define PHASE_FIN(F, l) do {} while (0)
#endif
#ifndef PHASE_OUTPROJ
#define PHASE_OUTPROJ(F, l) do {} while (0)
#endif
#ifndef PHASE_NORM2
#define PHASE_NORM2(F, l) do {} while (0)
#endif
#ifndef PHASE_SCATTER
#define PHASE_SCATTER(F, l) do {} while (0)
#endif
#ifndef PHASE_GEMM1
#define PHASE_GEMM1(F, l) do {} while (0)
#endif
#ifndef PHASE_GEMM2
#define PHASE_GEMM2(F, l) do {} while (0)
#endif

#ifndef MK_SPLIT
#define MK_SPLIT 0
#endif
#ifndef MK_STAGE
#define MK_STAGE 99
#endif
constexpr int N_PHASES = 22;
struct Args { const float* in[N_IN]; float* out; unsigned char* ws; int ph_lo, ph_hi; };
static_assert(sizeof(Args) == (N_IN + 2) * 8 + 8, "Args has no padding");

__global__ void __launch_bounds__(NTHREADS, 2) fwd_kernel(Args args) {
    extern __shared__ __attribute__((aligned(16))) unsigned char lds[];
    Frame F;
    F.lds = (LAS unsigned char*)lds;
    F.MISC = (volatile LAS unsigned*)(F.lds + MISC_OFF);
    F.tid = threadIdx.x; F.lane = F.tid & 63; F.wave = __builtin_amdgcn_readfirstlane(F.tid >> 6);
    F.G = gridDim.x; F.bid = blockIdx.x;
    F.ws = args.ws; F.out = args.out; F.ctl = (gu32*)(args.ws + WS_CTL);
    F.in = (const float* const __attribute__((address_space(4)))*)__builtin_amdgcn_kernarg_segment_ptr();
    for (int u = F.tid; u < (LDS_BYTES - LDSCTL_OFF) / 4; u += NTHREADS) ((LAS unsigned*)(F.lds + LDSCTL_OFF))[u] = 0u;
    __syncthreads();
    XcdBarrier bar; bar.bar = (unsigned*)(F.ctl + CW_BAR); bar.x = 0; bar.st = nullptr;
    if (!MK_SPLIT) bar = xcd_barrier_post((unsigned*)(F.ctl + CW_BAR), F.MISC + 8);
    const int lo = args.ph_lo, hi = args.ph_hi;
#define IN(k) (lo <= (k) && (k) < hi && phase_enter(F))
#define INR(k) (lo <= (k) && (k) < hi)
#define SEAM(k) do { if (INR(k) && INR((k) + 1)) xcd_barrier(bar); } while (0)

    if (IN(0)) { p0_prologue(F); } SEAM(0);
#pragma unroll 1
    for (int l = 0; l < DEPTH; ++l) {
        const int pb = 1 + 10 * l;
        if (IN(pb + 0)) { phase_norm1(F, l); } SEAM(pb + 0);
        if (IN(pb + 1)) { PHASE_INPROJ(F, l); } SEAM(pb + 1);
        if (IN(pb + 2)) { PHASE_PREP(F, l); } SEAM(pb + 2);
        if (IN(pb + 3)) { PHASE_SCAN(F, l); } SEAM(pb + 3);
        if (IN(pb + 4)) { PHASE_FIN(F, l); } SEAM(pb + 4);
        if (IN(pb + 5)) { PHASE_OUTPROJ(F, l); } SEAM(pb + 5);
        if (IN(pb + 6)) { PHASE_NORM2(F, l); } SEAM(pb + 6);
        if (IN(pb + 7)) { PHASE_SCATTER(F, l); } SEAM(pb + 7);
        if (IN(pb + 8)) { PHASE_GEMM1(F, l); } SEAM(pb + 8);
        if (IN(pb + 9)) { PHASE_GEMM2(F, l); } SEAM(pb + 9);
    }
    if (IN(21)) { phase_final(F, MK_STAGE >= 9); }
#undef IN
#undef SEAM
}

extern "C" void kernel_launch(void* const* d_in, const int* in_sizes, int n_in, void* d_out, int out_size, void* d_ws, size_t ws_size, hipStream_t stream) {
    static int grid = 0;
    if (grid == 0) {
        if (n_in != N_IN || out_size != NLAT * DM || ws_size < WS_END) { fprintf(stderr, "kernel_launch: unexpected shapes (n_in %d, out %d, ws %zu); nothing launched\n", n_in, out_size, ws_size); grid = -1; return; }
        int dev = 0, cus = 0, per_cu = 0;
        if (hipGetDevice(&dev) != hipSuccess || hipDeviceGetAttribute(&cus, hipDeviceAttributeMultiprocessorCount, dev) != hipSuccess) { grid = -1; return; }
        if (hipFuncSetAttribute((const void*)fwd_kernel, hipFuncAttributeMaxDynamicSharedMemorySize, LDS_BYTES) != hipSuccess) { fprintf(stderr, "kernel_launch: hipFuncSetAttribute failed\n"); grid = -1; return; }
        if (hipOccupancyMaxActiveBlocksPerMultiprocessor(&per_cu, (const void*)fwd_kernel, NTHREADS, LDS_BYTES) != hipSuccess || per_cu < 1) { fprintf(stderr, "kernel_launch: occupancy query says %d\n", per_cu); }
        (void)hipGetLastError();
        grid = cus;
        if (grid != 256) { fprintf(stderr, "kernel_launch: built for 256 CUs, device has %d; nothing launched\n", cus); grid = -1; return; }
    }
    if (grid < 0) return;
    if (hipMemsetAsync((char*)d_ws + WS_CTL, 0, CTL_ZERO_BYTES, stream) != hipSuccess) return;
    Args a{};
    for (int i = 0; i < N_IN; ++i) a.in[i] = (const float*)d_in[i];
    a.out = (float*)d_out; a.ws = (unsigned char*)d_ws;
#if MK_SPLIT
    for (int p = 0; p < N_PHASES; ++p) { a.ph_lo = p; a.ph_hi = p + 1; hipLaunchKernelGGL(fwd_kernel, dim3(grid), dim3(NTHREADS), LDS_BYTES, stream, a); }
#else
    a.ph_lo = 0; a.ph_hi = N_PHASES;
    hipLaunchKernelGGL(fwd_kernel, dim3(grid), dim3(NTHREADS), LDS_BYTES, stream, a);
#endif
    const hipError_t le = hipPeekAtLastError();
    if (le != hipSuccess) fprintf(stderr, "kernel_launch: launch failed: %s\n", hipGetErrorName(le));
}
```

```cpp
#include <hip/hip_runtime.h>
#include <cstdio>
#include <cstdint>

constexpr int DM = 2048, NB = 4, SEQ = 4096, CTXL = 256, DEPTH = 2;
constexpr int NLAT = NB * SEQ, NCTX = NB * CTXL, NTOK = NLAT + NCTX;
constexpr int NCT = NTOK / 64;
constexpr int IN_W = 4624, PW = 4864;
constexpr int PC_Q = 0, PC_K = 1024, PC_V = 1280, PC_DQ = 1536, PC_DK = 2048, PC_DV = 2560, PC_DG = 3072, PC_LX = 3584, PC_LY = 4096, PC_BETA = 4608, PC_DEC = 4616;
constexpr int NEXP = 32, TOPK = 4, DEXP = 1024;
constexpr int MOE_ROWS = 304 * 256;
constexpr float EPS = 1e-6f;
#ifndef MK_STAGE
#define MK_STAGE 99
#endif
namespace pg8 {
#define PG8_LAS __attribute__((address_space(3)))
typedef unsigned short bf16_t;
typedef short bf16x8 __attribute__((ext_vector_type(8)));
typedef float f32x4 __attribute__((ext_vector_type(4)));
typedef unsigned u32x4 __attribute__((ext_vector_type(4)));
typedef float f32x2 __attribute__((ext_vector_type(2)));
constexpr int BM = 256, BK = 64, HALF = 128, HTB = HALF * BK * 2  , STAGE_BYTES = 8 * HTB, NXCD = 8, WGM = 8;

__host__ __device__ __forceinline__ int lds_byte(int r, int c) { const int st = (r >> 4) * 2 + (c >> 5), rr = r & 15, cc = c & 31, ob = rr * 64 + cc * 2; return st * 1024 + (ob ^ (((ob >> 9) & 1) << 5)); }
__host__ __device__ __forceinline__ void stage_rc(int b, int& R, int& C) { const int st = b / 1024, sb = b % 1024, swz = sb ^ (((sb >> 9) & 1) << 5); R = (st >> 1) * 16 + swz / 64; C = (st & 1) * 32 + (swz % 64) / 2; }
__host__ __device__ __forceinline__ int perm32(int rho) { const int n = rho >> 4, i = rho & 15; return 8 * (i >> 2) + 4 * n + (i & 3); }

struct Unit { int pm, pn, e; };
struct Gemm { const bf16_t* A; const bf16_t* Bt; int M, N, K; };

struct StaticOrder {
    int nM, nN, nwg, G, c; const char* A; const char* Bt; size_t tstep;
    __device__ void init(const Gemm& g, int G_, int c_) { nM = g.M / BM; nN = g.N / BM; nwg = nM * nN; G = G_; c = c_; A = (const char*)g.A; Bt = (const char*)g.Bt; tstep = (size_t)BM * g.K * 2; }
    __device__ bool next(int i, Unit& u) const {
        const long L = (long)i * G + c; if (L >= nwg) return false;
        int wgid = (int)L; { const int q = nwg / NXCD, r = nwg % NXCD, xcd = wgid % NXCD, off = wgid / NXCD; wgid = (xcd < r ? xcd * (q + 1) : r * (q + 1) + (xcd - r) * q) + off; }
        const int nig = WGM * nN, gid = wgid / nig, fm = gid * WGM, gsz = (nM - fm) < WGM ? (nM - fm) : WGM;
        u.pm = fm + ((wgid % nig) % gsz); u.pn = (wgid % nig) / gsz; u.e = 0; return true;
    }
    __device__ __forceinline__ const char* a_ptr(const Unit& u) const { return A + (size_t)u.pm * tstep; }
    __device__ __forceinline__ const char* b_ptr(const Unit& u) const { return Bt + (size_t)u.pn * tstep; }
    __device__ __forceinline__ void a_ready(const Unit&) const {}
    __device__ __forceinline__ void done(const Unit&) const {}
};
__device__ __forceinline__ unsigned cvt_pk_bf16(float lo, float hi) { unsigned r; asm volatile("v_cvt_pk_bf16_f32 %0, %1, %2" : "=v"(r) : "v"(lo), "v"(hi)); return r; }
struct EpiBf16Plain {
    static constexpr bool PERM = true, AFTER_DRAIN = false;
    bf16_t* O; int ldc;
    __device__ __forceinline__ void operator()(const f32x4 (&acc)[2][2][4][2], const Unit& u, int wr, int wc, int fr, int fq) const {
        const int row0 = u.pm * BM + wr * 64 + fr, col0 = u.pn * BM + wc * 32 + 8 * fq;
#pragma unroll
        for (int ai = 0; ai < 2; ++ai)
#pragma unroll
            for (int m = 0; m < 4; ++m) { bf16_t* rowp = O + (size_t)(row0 + ai * HALF + m * 16) * ldc + col0;
#pragma unroll
                for (int bj = 0; bj < 2; ++bj) { const f32x4 v0 = acc[ai][bj][m][0], v1 = acc[ai][bj][m][1];
                    u32x4 w; w.x = cvt_pk_bf16(v0[0], v0[1]); w.y = cvt_pk_bf16(v0[2], v0[3]); w.z = cvt_pk_bf16(v1[0], v1[1]); w.w = cvt_pk_bf16(v1[2], v1[3]);
                    *(u32x4*)(rowp + bj * HALF) = w; } }
    }
};
struct EpiResGate {
    static constexpr bool PERM = false, AFTER_DRAIN = false;
    const float* base_lat; const float* base_ctx; float* out; const float* modg;
    __device__ __forceinline__ void operator()(const f32x4 (&acc)[2][2][4][2], const Unit& u, int wr, int wc, int fr, int fq) const {
        const int r = u.pm < 64 ? (u.pm >> 4) : 4; const int col0 = u.pn * BM + wc * 32 + 4 * fq;
        const float* g = modg + (size_t)r * 12288 + col0;
        f32x4 gv[2][2];
#pragma unroll
        for (int bj = 0; bj < 2; ++bj)
#pragma unroll
            for (int n = 0; n < 2; ++n) gv[bj][n] = *(const f32x4*)(g + bj * HALF + n * 16);
#pragma unroll
        for (int ai = 0; ai < 2; ++ai)
#pragma unroll
            for (int m = 0; m < 4; ++m) { const int row = u.pm * BM + ai * HALF + wr * 64 + m * 16 + fr;
                const float* bp = (row < 16384 ? base_lat + (size_t)row * 2048 : base_ctx + (size_t)(row - 16384) * 2048) + col0; float* op = out + (size_t)row * 2048 + col0;
#pragma unroll
                for (int bj = 0; bj < 2; ++bj)
#pragma unroll
                    for (int n = 0; n < 2; ++n) { const f32x4 b = *(const f32x4*)(bp + bj * HALF + n * 16); *(f32x4*)(op + bj * HALF + n * 16) = b + gv[bj][n] * acc[ai][bj][m][n]; }
                asm volatile("" ::: "memory"); }
    }
};
struct EpiSwiglu {
    static constexpr bool PERM = true, AFTER_DRAIN = false;
    bf16_t* O; const float* bgu;
    __device__ __forceinline__ void operator()(const f32x4 (&acc)[2][2][4][2], const Unit& u, int wr, int wc, int fr, int fq) const {
        const int row0 = u.pm * BM + wr * 64 + fr, cc0 = wc * 32 + 8 * fq;
        const float* bg = bgu + (size_t)u.e * 2048 + u.pn * 128 + cc0;
        f32x4 bglu[2], blin[2];
#pragma unroll
        for (int n = 0; n < 2; ++n) { bglu[n] = *(const f32x4*)(bg + 4 * n); blin[n] = *(const f32x4*)(bg + 1024 + 4 * n); }
#pragma unroll
        for (int ai = 0; ai < 2; ++ai)
#pragma unroll
            for (int m = 0; m < 4; ++m) { bf16_t* rowp = O + (size_t)(row0 + ai * HALF + m * 16) * 1024 + u.pn * 128 + cc0;
                float r[8];
#pragma unroll
                for (int n = 0; n < 2; ++n) { const f32x4 g = acc[ai][0][m][n] + bglu[n], l = acc[ai][1][m][n] + blin[n];
#pragma unroll
                    for (int i = 0; i < 4; ++i) { const float gg = fminf(g[i], 7.0f); const float ll = fminf(fmaxf(l[i], -7.0f), 7.0f);
                        r[4 * n + i] = (ll + 1.0f) * gg * (1.0f / (1.0f + __expf(-1.702f * gg))); } }
                u32x4 w; w.x = cvt_pk_bf16(r[0], r[1]); w.y = cvt_pk_bf16(r[2], r[3]); w.z = cvt_pk_bf16(r[4], r[5]); w.w = cvt_pk_bf16(r[6], r[7]);
                *(u32x4*)rowp = w; }
    }
};
struct EpiDown {
    static constexpr bool PERM = true, AFTER_DRAIN = false;
    bf16_t* O; const float* bdn; const float* rowg;
    __device__ __forceinline__ void operator()(const f32x4 (&acc)[2][2][4][2], const Unit& u, int wr, int wc, int fr, int fq) const {
        const int row0 = u.pm * BM + wr * 64 + fr, col0 = u.pn * BM + wc * 32 + 8 * fq;
        const float* bb = bdn + (size_t)u.e * 2048 + col0;
        f32x4 bv[2][2];
#pragma unroll
        for (int bj = 0; bj < 2; ++bj)
#pragma unroll
            for (int n = 0; n < 2; ++n) bv[bj][n] = *(const f32x4*)(bb + bj * HALF + 4 * n);
#pragma unroll
        for (int ai = 0; ai < 2; ++ai)
#pragma unroll
            for (int m = 0; m < 4; ++m) { const int row = row0 + ai * HALF + m * 16; const float gt = rowg[row]; bf16_t* rowp = O + (size_t)row * 2048 + col0;
#pragma unroll
                for (int bj = 0; bj < 2; ++bj) { const f32x4 v0 = (acc[ai][bj][m][0] + bv[bj][0]) * gt, v1 = (acc[ai][bj][m][1] + bv[bj][1]) * gt;
                    u32x4 w; w.x = cvt_pk_bf16(v0[0], v0[1]); w.y = cvt_pk_bf16(v0[2], v0[3]); w.z = cvt_pk_bf16(v1[0], v1[1]); w.w = cvt_pk_bf16(v1[2], v1[3]);
                    *(u32x4*)(rowp + bj * HALF) = w; } }
    }
};
struct MoeOrder {
    int c, nblk; const char* A; const char* Bt; size_t a_tstep, b_estep, b_tstep; const PG8_LAS int* blk_end;
    __device__ __forceinline__ bool next(int i, Unit& u) const {
        const int x = c & 7, j = c >> 3, gi = i * 8 + x, rb = 4 * gi + (j >> 3);
        if (rb >= nblk) return false;
        int e = 0;
        for (int k = 0; k < 31; ++k) e += (rb >= blk_end[k]) ? 1 : 0;
        u.pm = rb; u.pn = j & 7; u.e = __builtin_amdgcn_readfirstlane(e); return true;
    }
    __device__ __forceinline__ const char* a_ptr(const Unit& u) const { return A + (size_t)u.pm * a_tstep; }
    __device__ __forceinline__ const char* b_ptr(const Unit& u) const { return Bt + (size_t)u.e * b_estep + (size_t)u.pn * b_tstep; }
    __device__ __forceinline__ void a_ready(const Unit&) const {}
    __device__ __forceinline__ void done(const Unit&) const {}
};
template <class Epi, class Sched, bool ALIGN_EPI = false, bool SP2 = false>
__device__ __forceinline__ void gemm_phase(PG8_LAS unsigned char* lds, const Gemm g, const Sched& S, const Epi& E) {
    int tid = threadIdx.x; asm volatile("" : "+v"(tid));
    const int wid = __builtin_amdgcn_readfirstlane(tid >> 6), lane = tid & 63, wr = wid >> 2, wc = wid & 3, fr = lane & 15, fq = lane >> 4;
    const int K = g.K, nt = K / BK;
    unsigned voffA[2], voffB[2];
#pragma unroll
    for (int i = 0; i < 2; ++i) { int R, C; stage_rc(tid * 16 + i * 8192, R, C); const int Rb = Epi::PERM ? ((R & ~31) + perm32(R & 31)) : R;
        voffA[i] = (unsigned)(R * K + C) * 2u; voffB[i] = (unsigned)(Rb * K + C) * 2u; }
    const size_t kstep = (size_t)(BK * 2);
    const size_t hstep = (size_t)HALF * K * 2;
    const size_t tstep = 2 * hstep;
    const unsigned ldsw = (unsigned)wid * 1024u;
    const int aoff = lds_byte(wr * 64 + fr, fq * 8), boff = lds_byte(wc * 32 + fr, fq * 8);
#define PG8_SA(b, h) (((b) * 2 + (h)) * HTB)
#define PG8_SB(b, h) ((4 + (b) * 2 + (h)) * HTB)
#define PG8_STAGE(bufoff, gbase, voff) do { _Pragma("unroll") for (int _i = 0; _i < 2; ++_i) \
        __builtin_amdgcn_global_load_lds((const unsigned*)((const char*)(gbase) + (voff)[_i]), (PG8_LAS unsigned*)(lds + (bufoff) + ldsw + _i * 8192), 16, 0, 0); } while (0)
#define PG8_LDA(dst, b, h) do { _Pragma("unroll") for (int m = 0; m < 4; ++m) _Pragma("unroll") for (int k = 0; k < 2; ++k) dst[m][k] = *(const PG8_LAS bf16x8*)(lds + PG8_SA(b, h) + aoff + m * 2048 + k * 1024); } while (0)
#define PG8_LDB(dst, b, h) do { _Pragma("unroll") for (int n = 0; n < 2; ++n) _Pragma("unroll") for (int k = 0; k < 2; ++k) dst[n][k] = *(const PG8_LAS bf16x8*)(lds + PG8_SB(b, h) + boff + n * 2048 + k * 1024); } while (0)
#define PG8_MMA(ai, bj, At, Bt) do { __builtin_amdgcn_s_setprio(1); _Pragma("unroll") for (int m = 0; m < 4; ++m) _Pragma("unroll") for (int n = 0; n < 2; ++n) _Pragma("unroll") for (int k = 0; k < 2; ++k) \
        acc[ai][bj][m][n] = __builtin_amdgcn_mfma_f32_16x16x32_bf16(Bt[n][k], At[m][k], acc[ai][bj][m][n], 0, 0, 0); __builtin_amdgcn_s_setprio(0); } while (0)
#define PG8_WAIT_V(n) asm volatile("s_waitcnt vmcnt(" #n ")" ::: "memory")
#define PG8_WAIT_L(n) asm volatile("s_waitcnt lgkmcnt(" #n ")" ::: "memory")
#define PG8_BAR __builtin_amdgcn_s_barrier()
#define PG8_SCHED __builtin_amdgcn_sched_barrier(0)
    Unit cur, nxt; int ui = 0;
    if (!S.next(0, cur)) return;
    f32x4 acc[2][2][4][2];
#pragma unroll
    for (int a = 0; a < 2; ++a)
#pragma unroll
        for (int b = 0; b < 2; ++b)
#pragma unroll
            for (int m = 0; m < 4; ++m)
#pragma unroll
                for (int n = 0; n < 2; ++n) acc[a][b][m][n] = (f32x4){0.f, 0.f, 0.f, 0.f};
    bf16x8 At[4][2], B0[2][2], B1[2][2];
    const char* cA = S.a_ptr(cur); const char* cB = S.b_ptr(cur);
    S.a_ready(cur);
    if constexpr (SP2) {
        PG8_STAGE(PG8_SB(0, 0), cB, voffB); PG8_STAGE(PG8_SB(0, 1), cB + hstep, voffB); PG8_STAGE(PG8_SA(0, 0), cA, voffA); PG8_STAGE(PG8_SA(0, 1), cA + hstep, voffA);
        if (wr == 1) PG8_BAR;
        PG8_WAIT_V(2); PG8_BAR;
        PG8_STAGE(PG8_SB(1, 0), cB + kstep, voffB); PG8_STAGE(PG8_SA(1, 0), cA + kstep, voffA); PG8_STAGE(PG8_SB(1, 1), cB + hstep + kstep, voffB);
        PG8_WAIT_V(6); PG8_BAR;
    } else {
        PG8_STAGE(PG8_SB(0, 0), cB, voffB); PG8_STAGE(PG8_SA(0, 0), cA, voffA); PG8_STAGE(PG8_SB(0, 1), cB + hstep, voffB); PG8_STAGE(PG8_SA(0, 1), cA + hstep, voffA);
        if (wr == 1) PG8_BAR;
        PG8_WAIT_V(4); PG8_BAR;
        PG8_STAGE(PG8_SB(1, 0), cB + kstep, voffB); PG8_STAGE(PG8_SA(1, 0), cA + kstep, voffA); PG8_STAGE(PG8_SB(1, 1), cB + hstep + kstep, voffB);
        PG8_WAIT_V(6); PG8_BAR;
    }
    for (;;) {
        const bool has_next = S.next(ui + 1, nxt);
        const char* nA = has_next ? S.a_ptr(nxt) : cA; const char* nB = has_next ? S.b_ptr(nxt) : cB;
        for (int t = 0; t < nt; t += 2) {
            const bool last = (t == nt - 2);
            const char* a1 = cA + (size_t)(t + 1) * kstep;
            const char* a2 = last ? nA : cA + (size_t)(t + 2) * kstep; const char* b2 = last ? nB : cB + (size_t)(t + 2) * kstep;
            const char* a3 = a2 + kstep; const char* b3 = b2 + kstep;
            if (last && has_next) S.a_ready(nxt);
            if constexpr (SP2) {
            PG8_LDB(B0, 0, 0); PG8_LDB(B1, 0, 1); PG8_SCHED; PG8_LDA(At, 0, 0); PG8_STAGE(PG8_SA(1, 1), a1 + hstep, voffA);
            PG8_WAIT_V(8); PG8_WAIT_L(0); PG8_BAR; PG8_MMA(0, 0, At, B0); PG8_MMA(0, 1, At, B1); PG8_BAR; PG8_SCHED;
            PG8_LDA(At, 0, 1); PG8_STAGE(PG8_SB(0, 0), b2, voffB); PG8_STAGE(PG8_SB(0, 1), b2 + hstep, voffB); PG8_STAGE(PG8_SA(0, 0), a2, voffA);
            PG8_WAIT_V(8); PG8_WAIT_L(0); PG8_BAR; PG8_MMA(1, 0, At, B0); PG8_MMA(1, 1, At, B1); PG8_BAR; PG8_SCHED;
            PG8_LDB(B0, 1, 0); PG8_LDB(B1, 1, 1); PG8_SCHED; PG8_LDA(At, 1, 0); PG8_STAGE(PG8_SA(0, 1), a2 + hstep, voffA);
            PG8_WAIT_V(8); PG8_WAIT_L(0); PG8_BAR; PG8_MMA(0, 0, At, B0); PG8_MMA(0, 1, At, B1); PG8_BAR; PG8_SCHED;
            PG8_LDA(At, 1, 1); PG8_STAGE(PG8_SB(1, 0), b3, voffB); PG8_STAGE(PG8_SB(1, 1), b3 + hstep, voffB); PG8_STAGE(PG8_SA(1, 0), a3, voffA);
            PG8_WAIT_V(8); PG8_WAIT_L(0); PG8_BAR; PG8_MMA(1, 0, At, B0); PG8_MMA(1, 1, At, B1); PG8_BAR; PG8_SCHED;
            } else {
            PG8_LDB(B0, 0, 0); PG8_SCHED; PG8_LDA(At, 0, 0); PG8_STAGE(PG8_SA(1, 1), a1 + hstep, voffA);
            PG8_WAIT_L(8); PG8_BAR; PG8_WAIT_L(0); PG8_MMA(0, 0, At, B0); PG8_BAR; PG8_SCHED;
            PG8_LDB(B1, 0, 1); PG8_STAGE(PG8_SB(0, 0), b2, voffB);
            PG8_BAR; PG8_WAIT_L(0); PG8_MMA(0, 1, At, B1); PG8_BAR;
            PG8_LDA(At, 0, 1); PG8_STAGE(PG8_SA(0, 0), a2, voffA);
            PG8_BAR; PG8_WAIT_L(0); PG8_MMA(1, 0, At, B0); PG8_BAR; PG8_SCHED;
            PG8_STAGE(PG8_SB(0, 1), b2 + hstep, voffB);
            PG8_WAIT_V(6); PG8_BAR; PG8_MMA(1, 1, At, B1); PG8_BAR;
            PG8_LDB(B0, 1, 0); PG8_SCHED; PG8_LDA(At, 1, 0); PG8_STAGE(PG8_SA(0, 1), a2 + hstep, voffA);
            PG8_WAIT_L(8); PG8_BAR; PG8_WAIT_L(0); PG8_MMA(0, 0, At, B0); PG8_BAR; PG8_SCHED;
            PG8_LDB(B1, 1, 1); PG8_STAGE(PG8_SB(1, 0), b3, voffB);
            PG8_BAR; PG8_WAIT_L(0); PG8_MMA(0, 1, At, B1); PG8_BAR;
            PG8_LDA(At, 1, 1); PG8_STAGE(PG8_SA(1, 0), a3, voffA);
            PG8_BAR; PG8_WAIT_L(0); PG8_MMA(1, 0, At, B0); PG8_BAR; PG8_SCHED;
            PG8_STAGE(PG8_SB(1, 1), b3 + hstep, voffB);
            PG8_WAIT_V(6); PG8_BAR; PG8_MMA(1, 1, At, B1); PG8_BAR;
            }
        }
        if constexpr (ALIGN_EPI) { if (wr == 0) PG8_BAR; }
        if constexpr (!Epi::AFTER_DRAIN) { int fr_e = fr, fq_e = fq; asm volatile("" : "+v"(fr_e), "+v"(fq_e));
            E(acc, cur, wr, wc, fr_e, fq_e); S.done(cur); }
        if (!has_next) break;
#pragma unroll
        for (int a = 0; a < 2; ++a)
#pragma unroll
            for (int b = 0; b < 2; ++b)
#pragma unroll
                for (int m = 0; m < 4; ++m)
#pragma unroll
                    for (int n = 0; n < 2; ++n) acc[a][b][m][n] = (f32x4){0.f, 0.f, 0.f, 0.f};
        cur = nxt; cA = nA; cB = nB; ++ui;
        if constexpr (ALIGN_EPI) { if (wr == 1) PG8_BAR; }
    }
    PG8_WAIT_V(0);
    if constexpr (!ALIGN_EPI) { if (wr == 0) PG8_BAR; }
    PG8_BAR;
    if constexpr (Epi::AFTER_DRAIN) { E.fused(acc, cur, wr, wc, fr, fq, lds, wid, lane); S.done(cur); }
#undef PG8_SA
#undef PG8_SB
#undef PG8_STAGE
#undef PG8_LDA
#undef PG8_LDB
#undef PG8_MMA
#undef PG8_WAIT_V
#undef PG8_WAIT_L
#undef PG8_BAR
#undef PG8_SCHED
}
}

constexpr size_t MiB = 1u << 20;
constexpr size_t WS_CTL = 0, CTL_ZERO_BYTES = 1 * MiB;
constexpr size_t WS_MOD  = 1 * MiB;
constexpr size_t WS_WRT  = 2 * MiB;
constexpr size_t WS_MOEI = 3 * MiB;
constexpr size_t WS_LRC  = 6 * MiB;
constexpr size_t WS_DNS  = 12 * MiB;
constexpr size_t WS_WIN  = 16 * MiB;
constexpr size_t WS_WOUT = 56 * MiB;
constexpr size_t WS_WGU  = 72 * MiB;
constexpr size_t WS_WDN  = 584 * MiB;
constexpr size_t WS_X    = 840 * MiB;
constexpr size_t WS_H    = 976 * MiB;
constexpr size_t WS_P    = 1044 * MiB;
constexpr size_t WS_CC   = 1206 * MiB;
constexpr size_t WS_VT   = 1274 * MiB;
constexpr size_t WS_VTC  = WS_VT + 8 * MiB;
constexpr size_t WS_DNT  = 1284 * MiB;
constexpr size_t DNT_BYTES = 90112;
constexpr size_t WS_DNO  = 1472 * MiB;
constexpr size_t WS_LRH  = 1540 * MiB;
constexpr size_t WS_LRA  = 1608 * MiB;
constexpr size_t WS_XS   = 1676 * MiB;
constexpr size_t WS_ACT  = 1980 * MiB;
constexpr size_t WS_YS   = 2132 * MiB;
constexpr size_t WS_END  = 2436 * MiB;
constexpr int CW_TMO = 0;
constexpr int CW_BAR = 4096;
constexpr int CW_CNT = 8192;
constexpr int CW_ATQ = 12288;

constexpr int RING_OFF = 0, RING_BYTES = 131072;
constexpr int LDSCTL_OFF = RING_BYTES, MISC_OFF = LDSCTL_OFF + 320;
constexpr int LDS_X_OFF = RING_BYTES + 1024;
constexpr int LDS_BYTES = 147456;
constexpr int NWAVES = 8, NTHREADS = 512;

#define GAS __attribute__((address_space(1)))
#define LAS __attribute__((address_space(3)))
typedef unsigned short bf16;
typedef unsigned v4u __attribute__((ext_vector_type(4)));
typedef unsigned v2u __attribute__((ext_vector_type(2)));
typedef float f32x4 __attribute__((ext_vector_type(4)));
typedef float f32x16 __attribute__((ext_vector_type(16)));
typedef short bf16x8 __attribute__((ext_vector_type(8)));
typedef short bf16x4 __attribute__((ext_vector_type(4)));
typedef GAS unsigned gu32;
#define RLX_AGENT __ATOMIC_RELAXED, __HIP_MEMORY_SCOPE_AGENT
#define LDS_WAIT() asm volatile("s_waitcnt lgkmcnt(0)" ::: "memory")
#define VM_WAIT() asm volatile("s_waitcnt vmcnt(0)" ::: "memory")
__device__ __forceinline__ unsigned f2bf(float f) { unsigned u = __builtin_bit_cast(unsigned, f); return (u + 0x7fffu + ((u >> 16) & 1u)) >> 16; }
__device__ __forceinline__ unsigned pk2(float lo, float hi) { return pg8::cvt_pk_bf16(lo, hi); }
__device__ __forceinline__ float bf2f(unsigned short b) { return __builtin_bit_cast(float, (unsigned)b << 16); }
__device__ __forceinline__ float bflo(unsigned w) { return __builtin_bit_cast(float, w << 16); }
__device__ __forceinline__ float bfhi(unsigned w) { return __builtin_bit_cast(float, w & 0xffff0000u); }
template <int CTRL> __device__ __forceinline__ float dpp_mov(float v) { return __builtin_bit_cast(float, __builtin_amdgcn_update_dpp(0, __builtin_bit_cast(int, v), CTRL, 0xF, 0xF, false)); }
__device__ __forceinline__ float wave_sum(float v) {
    v += dpp_mov<0xB1>(v); v += dpp_mov<0x4E>(v); v += dpp_mov<0x141>(v); v += dpp_mov<0x140>(v);
    const int iv = __builtin_bit_cast(int, v);
    const float r0 = __builtin_bit_cast(float, __builtin_amdgcn_readlane(iv, 0)), r1 = __builtin_bit_cast(float, __builtin_amdgcn_readlane(iv, 16)), r2 = __builtin_bit_cast(float, __builtin_amdgcn_readlane(iv, 32)), r3 = __builtin_bit_cast(float, __builtin_amdgcn_readlane(iv, 48));
    return (r0 + r1) + (r2 + r3);
}
__device__ __forceinline__ float sigmoidf_(float x) { return 1.0f / (1.0f + __expf(-x)); }
__device__ __forceinline__ float siluf_(float x) { return x / (1.0f + __expf(-x)); }
__device__ __forceinline__ float softplusf_(float x) { return x > 20.f ? x : log1pf(__expf(x)); }

#define XB_TMO      128
#define XB_XCNT(j)  (256  + 64 * (j))
#define XB_XSUB(j)  (1280 + 64 * (j))
#define XB_XGEN(j)  (2304 + 64 * (j))
#define XB_TOP      3328
#define XB_TOPGEN   3392
#define XCD_BAR_WORDS 3456
#define XB_SPIN_CAP (1u << 18)

__device__ __forceinline__ unsigned xb_ld(unsigned* p)              { return __hip_atomic_load(p, __ATOMIC_RELAXED, __HIP_MEMORY_SCOPE_AGENT); }
__device__ __forceinline__ unsigned xb_add(unsigned* p, unsigned v) { return __hip_atomic_fetch_add(p, v, __ATOMIC_RELAXED, __HIP_MEMORY_SCOPE_AGENT); }
__device__ __forceinline__ unsigned xb_xcc_id() { return (unsigned)__builtin_amdgcn_s_getreg((3 << 11) | 20) & 0xFu; }
#define XB_SPIN(cond, bar) do { unsigned _sp = 0; while (cond) { __builtin_amdgcn_s_sleep(1); \
    if ((++_sp & 255u) == 0u) { if (xb_ld(&(bar)[XB_TMO])) break; if (_sp > XB_SPIN_CAP) { atomicAdd(&(bar)[XB_TMO], 1u); break; } } } } while (0)

struct XcdBarrier {
    unsigned* bar; unsigned x;
    volatile LAS unsigned* st;
};

__device__ __forceinline__ XcdBarrier xcd_barrier_post(unsigned* bar, volatile LAS unsigned* st) {
    XcdBarrier b; b.bar = bar; b.x = xb_xcc_id(); b.st = st;
    if (threadIdx.x == 0) (void)xb_add(&bar[XB_XCNT(b.x)], 1u);
    return b;
}
__device__ __forceinline__ void xcd_barrier_complete(unsigned* bar, unsigned x, unsigned& nloc, unsigned& nx) {
    const unsigned G = gridDim.x * gridDim.y * gridDim.z;
    unsigned sum, cnt, mine, sp = 0u;
    for (;;) {
        sum = 0u; cnt = 0u; mine = 0u;
#pragma unroll
        for (unsigned j = 0; j < 16; ++j) { const unsigned c = xb_ld(&bar[XB_XCNT(j)]); sum += c; cnt += (c > 0u) ? 1u : 0u; mine = (j == x) ? c : mine; }
        if (sum == G) break;
        __builtin_amdgcn_s_sleep(1);
        if ((++sp & 255u) == 0u) { if (xb_ld(&bar[XB_TMO])) break; if (sp > XB_SPIN_CAP) { atomicAdd(&bar[XB_TMO], 1u); break; } }
    }
    nloc = mine > 0u ? mine : 1u; nx = cnt > 0u ? cnt : 1u;
}

__device__ __forceinline__ void xcd_barrier(const XcdBarrier& b) {
    asm volatile("s_waitcnt vmcnt(0)" ::: "memory");
    __syncthreads();
    if (threadIdx.x == 0) {
        unsigned* bar = b.bar;
        __builtin_amdgcn_s_waitcnt(0);
        unsigned nloc = b.st[0], nx = b.st[1];
        if (nloc == 0u) { xcd_barrier_complete(bar, b.x, nloc, nx); b.st[0] = nloc; b.st[1] = nx; }
        const unsigned old = xb_add(&bar[XB_XSUB(b.x)], 1u);
        const unsigned gen = old / nloc;
        if (old + 1u == (gen + 1u) * nloc) {
            __builtin_amdgcn_fence(__ATOMIC_RELEASE, "agent");
            asm volatile("s_waitcnt vmcnt(0)" ::: "memory");
            const unsigned og = xb_add(&bar[XB_TOP], 1u);
            const unsigned tg = og / nx;
            if (og + 1u == (tg + 1u) * nx) xb_add(&bar[XB_TOPGEN], 1u);
            else XB_SPIN(xb_ld(&bar[XB_TOPGEN]) == tg, bar);
            __builtin_amdgcn_fence(__ATOMIC_ACQUIRE, "agent");
            xb_add(&bar[XB_XGEN(b.x)], 1u);
            asm volatile("s_waitcnt vmcnt(0)" ::: "memory");
        } else {
            XB_SPIN(xb_ld(&bar[XB_XGEN(b.x)]) == gen, bar);
            __builtin_amdgcn_fence(__ATOMIC_ACQUIRE, "agent");
            asm volatile("s_waitcnt vmcnt(0)" ::: "memory");
        }
    }
    __syncthreads();
}

enum InIdx { I_X = 0, I_C, I_CTX, I_CCTX, I_WMOD, I_BMOD, I_NMG, I_NFG, I_WIN, I_WOUT, I_SINK, I_DNCW, I_DNALOG, I_DNDT, I_DNNG, I_LRCW, I_LRCB, I_LRWR, I_LRBR, I_LRWI, I_LRBI, I_LRLAM,
             I_WROUT, I_BROUT, I_WGU, I_BGU, I_WDN, I_BDN, I_FNG, N_IN };
struct Frame {
    LAS unsigned char* lds;
    volatile LAS unsigned* MISC;
    gu32* ctl;
    int tid, lane, wave, G, bid;
    const float* const __attribute__((address_space(4)))* in;
    float* out; unsigned char* ws;
};
__device__ __forceinline__ int mod_row(int m) { return m < NLAT ? (m >> 12) : 4; }
__device__ __forceinline__ bool phase_enter(Frame& F) { int t = threadIdx.x; asm volatile("" : "+v"(t)); F.tid = t; F.lane = t & 63; F.wave = __builtin_amdgcn_readfirstlane(t >> 6); return true; }
__device__ __forceinline__ void seq_of(int m, int& t, int& T, int& base) { if (m < NLAT) { t = m & 4095; T = SEQ; base = m - t; } else { t = (m - NLAT) & 255; T = CTXL; base = m - t; } }
__device__ __forceinline__ float gelu_tanh(float x) { const float u = 0.7978845608028654f * (x + 0.044715f * x * x * x); return 0.5f * x * (1.0f + tanhf(u)); }

__device__ __forceinline__ void transpose_item(const float* W, int K, int N, bf16* WT, int k0, int dstrow0, int srccol0, int nvalid, LAS float* scr, int lane) {
    { const int c4 = (lane & 7) * 4, kr = lane >> 3; f32x4 v[8];
#pragma unroll
      for (int i = 0; i < 8; ++i) { v[i] = (f32x4){0.f, 0.f, 0.f, 0.f}; if (c4 < nvalid) v[i] = *(const f32x4*)(W + (size_t)(k0 + 8 * i + kr) * N + srccol0 + c4); }
#pragma unroll
      for (int i = 0; i < 8; ++i) { LAS float* d = scr + (8 * i + kr) * 33 + c4; d[0] = v[i].x; d[1] = v[i].y; d[2] = v[i].z; d[3] = v[i].w; } }
    LDS_WAIT(); asm volatile("" ::: "memory");
    const int c = lane & 7;
#pragma unroll
    for (int jj = 0; jj < 4; ++jj) { const int n = (lane >> 3) + 8 * jj; const LAS float* s = scr + (8 * c) * 33 + n;
        v4u o; o.x = pk2(s[0 * 33], s[1 * 33]); o.y = pk2(s[2 * 33], s[3 * 33]); o.z = pk2(s[4 * 33], s[5 * 33]); o.w = pk2(s[6 * 33], s[7 * 33]);
        *(GAS v4u*)(WT + (size_t)(dstrow0 + n) * K + k0 + 8 * c) = o; }
    LDS_WAIT(); asm volatile("" ::: "memory");
}
__device__ __forceinline__ void p0_prologue(Frame& F) {
    {
        LAS float* sc = (LAS float*)(F.lds);
        LAS float* red = (LAS float*)(F.lds + 40960);
        bool have_sc = false;
        for (int wb = F.bid; wb < 192; wb += F.G) {
            if (!have_sc) {
                for (int i = F.tid; i < 5 * 2048; i += NTHREADS) { const int r = i >> 11, k = i & 2047; const float cv = r < 4 ? F.in[I_C][r * 2048 + k] : F.in[I_CCTX][k]; sc[i] = siluf_(cv); }
                have_sc = true; __syncthreads();
            }
            const int l = wb / 96, cb = wb % 96, kp = F.tid >> 5, cg = F.tid & 31, j0 = cb * 128 + cg * 4;
            const float* wp = F.in[I_WMOD] + ((size_t)l * 2048 + kp * 128) * 12288 + j0;
            f32x4 acc[5];
#pragma unroll
            for (int r = 0; r < 5; ++r) acc[r] = (f32x4){0.f, 0.f, 0.f, 0.f};
#pragma unroll 4
            for (int k = 0; k < 128; ++k) { const f32x4 w = *(const f32x4*)(wp + (size_t)k * 12288);
#pragma unroll
                for (int r = 0; r < 5; ++r) acc[r] += sc[r * 2048 + kp * 128 + k] * w; }
#pragma unroll
            for (int r = 0; r < 5; ++r) *(LAS f32x4*)(red + (kp * 5 + r) * 128 + cg * 4) = acc[r];
            __syncthreads();
            for (int i = F.tid; i < 640; i += NTHREADS) { const int r = i >> 7, col = i & 127; float s = F.in[I_BMOD][l * 12288 + cb * 128 + col];
#pragma unroll
                for (int q = 0; q < 16; ++q) s += red[(q * 5 + r) * 128 + col];
                ((float*)(F.ws + WS_MOD))[(size_t)(l * 5 + r) * 12288 + cb * 128 + col] = s; }
            __syncthreads();
        }
        __syncthreads();
    }
    {
        LAS float* scr = (LAS float*)(F.lds + F.wave * 16384);
        const int gw = F.bid * NWAVES + F.wave, NGW = F.G * NWAVES;
        constexpr int I_IN = 32 * 152, I_OUT = 32 * 64, I_RT = 32, PER_L = I_IN + I_OUT + I_RT;
        for (int it0 = gw; it0 < 2 * PER_L; it0 += NGW) {
            const int l = it0 / PER_L; int r = it0 % PER_L;
            if (r < I_IN) { const int nb = r % 152, kb = r / 152, d0 = nb * 32; int s0 = d0, nv = 32;
                if (d0 >= 4640) nv = 0; else if (d0 == 4608) { s0 = 3584; nv = 16; } else if (d0 >= 3584) s0 = d0 + 16;
                transpose_item(F.in[I_WIN] + (size_t)l * 2048 * IN_W, 2048, IN_W, (bf16*)(F.ws + WS_WIN) + (size_t)l * PW * 2048, kb * 64, d0, s0, nv, scr, F.lane); continue; }
            r -= I_IN;
            if (r < I_OUT) { const int nb = r % 64, kb = r / 64;
                transpose_item(F.in[I_WOUT] + (size_t)l * 2048 * 2048, 2048, 2048, (bf16*)(F.ws + WS_WOUT) + (size_t)l * 2048 * 2048, kb * 64, nb * 32, nb * 32, 32, scr, F.lane); continue; }
            r -= I_OUT;
            transpose_item(F.in[I_WROUT] + (size_t)l * 2048 * 32, 2048, 32, (bf16*)(F.ws + WS_WRT) + (size_t)l * 32 * 2048, r * 64, 0, 0, 32, scr, F.lane);
        }
    }
}
constexpr int CW_CVQ = 12288 + 512;
__device__ __forceinline__ void convert_moe_item(Frame& F, int l, int r, LAS float* scr) {
    constexpr int I_GU = 32 * 32 * 64;
    if (r < I_GU) { const int e = r / 2048, q = r % 2048, nb = q % 64, kb = q / 64; const int s0 = ((nb >> 2) & 1) * 1024 + (nb >> 3) * 128 + (nb & 3) * 32;
        transpose_item(F.in[I_WGU] + (size_t)(l * 32 + e) * 2048 * 2048, 2048, 2048, (bf16*)(F.ws + WS_WGU) + (size_t)(l * 32 + e) * 2048 * 2048, kb * 64, nb * 32, s0, 32, scr, F.lane); return; }
    r -= I_GU;
    { const int e = r / 1024, q = r % 1024, nb = q % 64, kb = q / 64;
        transpose_item(F.in[I_WDN] + (size_t)(l * 32 + e) * 1024 * 2048, 1024, 2048, (bf16*)(F.ws + WS_WDN) + (size_t)(l * 32 + e) * 2048 * 1024, kb * 64, nb * 32, nb * 32, 32, scr, F.lane); }
}
__device__ __forceinline__ void convert_moe_queue(Frame& F, int l, int rep = 0) {
    constexpr int NIT = 32 * 32 * 64 + 32 * 16 * 64;
    LAS float* scr = (LAS float*)(F.lds + F.wave * 16384);
    __syncthreads();
    for (;;) { int g = 0; if (F.lane == 0) g = (int)__hip_atomic_fetch_add(F.ctl + CW_CVQ + 64 * l + 8 * rep, 1u, RLX_AGENT); g = __builtin_amdgcn_readfirstlane(g);
        if (g * 8 >= NIT) break;
#pragma unroll 1
        for (int k = 0; k < 8; ++k) convert_moe_item(F, l, g * 8 + k, scr); }
    __syncthreads();
}

__device__ __forceinline__ void load_row(const float* src, int lane, f32x4 (&v)[8]) {
    const f32x4* p = (const f32x4*)src + lane;
#pragma unroll
    for (int j = 0; j < 8; ++j) v[j] = p[64 * j];
}
__device__ __forceinline__ void store_row(float* dst, int lane, const f32x4 (&v)[8]) {
    f32x4* p = (f32x4*)dst + lane;
#pragma unroll
    for (int j = 0; j < 8; ++j) p[64 * j] = v[j];
}
__device__ __forceinline__ void combine_row(Frame& F, int l, int m, int lane, f32x4 (&v)[8]) {
    const int* dest = (const int*)(F.ws + WS_MOEI + 2 * 512 * 1024) + m * 4;
    const float* g5 = (const float*)(F.ws + WS_MOD) + (size_t)(l * 5 + mod_row(m)) * 12288 + 5 * 2048;
    f32x4 acc[8];
#pragma unroll
    for (int j = 0; j < 8; ++j) acc[j] = (f32x4){0.f, 0.f, 0.f, 0.f};
#pragma unroll
    for (int k = 0; k < 4; ++k) { const int d = dest[k]; const v2u* yp = (const v2u*)((const bf16*)(F.ws + WS_YS) + (size_t)d * 2048) + lane;
#pragma unroll
        for (int j = 0; j < 8; ++j) { const v2u w = yp[64 * j]; acc[j] += (f32x4){bflo(w.x), bfhi(w.x), bflo(w.y), bfhi(w.y)}; } }
#pragma unroll
    for (int j = 0; j < 8; ++j) { const f32x4 gg = *((const f32x4*)g5 + lane + 64 * j); v[j] += gg * acc[j]; }
}
__device__ __forceinline__ void modnorm_store(const f32x4 (&v)[8], const float* g, const float* shift, const float* scale, bf16* hrow, int lane) {
    float ss = 0.f;
#pragma unroll
    for (int j = 0; j < 8; ++j) ss += (v[j].x * v[j].x + v[j].y * v[j].y) + (v[j].z * v[j].z + v[j].w * v[j].w);
    const float rstd = 1.0f / sqrtf(wave_sum(ss) * (1.0f / 2048.0f) + EPS);
    v2u* hp = (v2u*)hrow + lane;
#pragma unroll
    for (int j = 0; j < 8; ++j) { const f32x4 gg = *((const f32x4*)g + lane + 64 * j), sh = *((const f32x4*)shift + lane + 64 * j), sc = *((const f32x4*)scale + lane + 64 * j);
        const f32x4 y = (v[j] * rstd) * gg * (sc + 1.0f) + sh; v2u w; w.x = pk2(y.x, y.y); w.y = pk2(y.z, y.w); hp[64 * j] = w; }
}
__device__ __forceinline__ void phase_norm1(Frame& F, int l) {
    const int gw = F.bid * NWAVES + F.wave, NGW = F.G * NWAVES;
    float* X = (float*)(F.ws + WS_X); bf16* H = (bf16*)(F.ws + WS_H);
    const float* modp = (const float*)(F.ws + WS_MOD) + (size_t)l * 5 * 12288;
    for (int m = gw; m < NTOK; m += NGW) {
        f32x4 v[8];
        if (l == 0) load_row(m < NLAT ? F.in[I_X] + (size_t)m * DM : F.in[I_CTX] + (size_t)(m - NLAT) * DM, F.lane, v);
        else { load_row(X + (size_t)m * DM, F.lane, v); if (MK_STAGE >= 9) { combine_row(F, l - 1, m, F.lane, v); store_row(X + (size_t)m * DM, F.lane, v); } }
        const float* mr = modp + (size_t)mod_row(m) * 12288;
        modnorm_store(v, F.in[I_NMG] + l * DM, mr, mr + 2048, H + (size_t)m * DM, F.lane);
    }
}
__device__ __forceinline__ void phase_final(Frame& F, bool with_combine) {
    const int gw = F.bid * NWAVES + F.wave, NGW = F.G * NWAVES;
    const float* X = (const float*)(F.ws + WS_X);
    for (int m = gw; m < NLAT; m += NGW) {
        f32x4 v[8];
        if (with_combine) { load_row(X + (size_t)m * DM, F.lane, v); combine_row(F, 1, m, F.lane, v); }
        else load_row(F.in[I_X] + (size_t)m * DM, F.lane, v);
        float ss = 0.f;
#pragma unroll
        for (int j = 0; j < 8; ++j) ss += (v[j].x * v[j].x + v[j].y * v[j].y) + (v[j].z * v[j].z + v[j].w * v[j].w);
        const float rstd = 1.0f / sqrtf(wave_sum(ss) * (1.0f / 2048.0f) + EPS);
        f32x4* op = (f32x4*)(F.out + (size_t)m * DM) + F.lane;
#pragma unroll
        for (int j = 0; j < 8; ++j) { const f32x4 gg = *((const f32x4*)F.in[I_FNG] + F.lane + 64 * j); op[64 * j] = v[j] * rstd * gg; }
    }
}

__device__ __forceinline__ void phase_inproj(Frame& F, int l) {
    pg8::Gemm g{(const bf16*)(F.ws + WS_H), (const bf16*)(F.ws + WS_WIN) + (size_t)l * PW * 2048, NTOK, PW, 2048};
    pg8::StaticOrder S; S.init(g, F.G, F.bid);
    pg8::EpiBf16Plain E{(bf16*)(F.ws + WS_P), PW};
    pg8::gemm_phase<pg8::EpiBf16Plain, pg8::StaticOrder, true, true>(F.lds + RING_OFF, g, S, E);
}
__device__ __forceinline__ void phase_outproj(Frame& F, int l) {
    float* X = (float*)(F.ws + WS_X);
    pg8::Gemm g{(const bf16*)(F.ws + WS_CC), (const bf16*)(F.ws + WS_WOUT) + (size_t)l * 2048 * 2048, l == 0 ? NTOK : NLAT, 2048, 2048};
    pg8::StaticOrder S; S.init(g, F.G, F.bid);
    pg8::EpiResGate E{l == 0 ? F.in[I_X] : X, l == 0 ? F.in[I_CTX] : X + (size_t)NLAT * DM, X, (const float*)(F.ws + WS_MOD) + (size_t)l * 5 * 12288 + 2 * 2048};
    pg8::gemm_phase<pg8::EpiResGate, pg8::StaticOrder, true, true>(F.lds + RING_OFF, g, S, E);
}
#ifndef PHASE_INPROJ
#define PHASE_INPROJ(F, l) phase_inproj(F, l)
#endif
#ifndef PHASE_OUTPROJ
#define PHASE_OUTPROJ(F, l) phase_outproj(F, l)
#endif

constexpr size_t MOEI_TOPE = WS_MOEI, MOEI_TOPG = WS_MOEI + 512 * 1024, MOEI_DEST = WS_MOEI + 2 * 512 * 1024, MOEI_ROWG = WS_MOEI + 3 * 512 * 1024;
__device__ __forceinline__ void phase_norm2(Frame& F, int l) {
    const int nrows = (l == 0) ? NTOK : NLAT;
    constexpr int TROW = 4112;
    LAS unsigned char* tile = F.lds;
    LAS float* part = (LAS float*)(F.lds + 66048);
    LAS float* lg = (LAS float*)(F.lds + 66048 + 16384);
    const float* X = (const float*)(F.ws + WS_X); bf16* H = (bf16*)(F.ws + WS_H);
    const float* modp = (const float*)(F.ws + WS_MOD) + (size_t)l * 5 * 12288;
    const bf16* wrt = (const bf16*)(F.ws + WS_WRT) + (size_t)l * 32 * 2048;
    int* tope = (int*)(F.ws + MOEI_TOPE); float* topg = (float*)(F.ws + MOEI_TOPG);
    for (int r0 = F.bid * 16; r0 < nrows; r0 += F.G * 16) {
#pragma unroll 1
        for (int rr = 0; rr < 2; ++rr) {
            const int lr = 2 * F.wave + rr, m = r0 + lr;
            f32x4 v[8]; load_row(X + (size_t)m * DM, F.lane, v);
            float ss = 0.f;
#pragma unroll
            for (int j = 0; j < 8; ++j) ss += (v[j].x * v[j].x + v[j].y * v[j].y) + (v[j].z * v[j].z + v[j].w * v[j].w);
            const float rstd = 1.0f / sqrtf(wave_sum(ss) * (1.0f / 2048.0f) + EPS);
            const float* mr = modp + (size_t)mod_row(m) * 12288; const float* g = F.in[I_NFG] + l * DM;
            v2u* hp = (v2u*)(H + (size_t)m * DM) + F.lane; LAS v2u* tp = (LAS v2u*)(tile + lr * TROW) + F.lane;
#pragma unroll
            for (int j = 0; j < 8; ++j) { const f32x4 gg = *((const f32x4*)g + F.lane + 64 * j), sh = *((const f32x4*)(mr + 3 * 2048) + F.lane + 64 * j), sc = *((const f32x4*)(mr + 4 * 2048) + F.lane + 64 * j);
                const f32x4 y = (v[j] * rstd) * gg * (sc + 1.0f) + sh; v2u w; w.x = pk2(y.x, y.y); w.y = pk2(y.z, y.w); hp[64 * j] = w; tp[64 * j] = w; }
        }
        __syncthreads();
        {
            const int row = F.lane & 15, q = F.lane >> 4;
            f32x4 acc0 = {0.f, 0.f, 0.f, 0.f}, acc1 = {0.f, 0.f, 0.f, 0.f};
#pragma unroll
            for (int ks = 0; ks < 8; ++ks) { const int k0 = 256 * F.wave + 32 * ks + 8 * q;
                const bf16x8 a = *(const LAS bf16x8*)(tile + row * TROW + k0 * 2);
                const bf16x8 b0 = *(const bf16x8*)(wrt + (size_t)row * 2048 + k0), b1 = *(const bf16x8*)(wrt + (size_t)(16 + row) * 2048 + k0);
                acc0 = __builtin_amdgcn_mfma_f32_16x16x32_bf16(a, b0, acc0, 0, 0, 0); acc1 = __builtin_amdgcn_mfma_f32_16x16x32_bf16(a, b1, acc1, 0, 0, 0); }
#pragma unroll
            for (int i = 0; i < 4; ++i) { part[(F.wave * 16 + 4 * q + i) * 32 + row] = acc0[i]; part[(F.wave * 16 + 4 * q + i) * 32 + 16 + row] = acc1[i]; }
        }
        __syncthreads();
        { const int rw = F.tid >> 5, e = F.tid & 31; float s = F.in[I_BROUT][l * 32 + e];
#pragma unroll
          for (int w = 0; w < 8; ++w) s += part[(w * 16 + rw) * 32 + e];
          lg[rw * 32 + e] = s; }
        __syncthreads();
        if (F.tid < 16) { const int m = r0 + F.tid; float val[4]; int idx[4]; unsigned taken = 0u;
#pragma unroll
            for (int k = 0; k < 4; ++k) { float best = -3.0e38f; int bi = 0;
                for (int e = 0; e < 32; ++e) { const float x = lg[F.tid * 32 + e]; if (!((taken >> e) & 1u) && x > best) { best = x; bi = e; } }
                val[k] = best; idx[k] = bi; taken |= 1u << bi; }
            float p[4], sum = 0.f;
#pragma unroll
            for (int k = 0; k < 4; ++k) { p[k] = __expf(val[k] - val[0]); sum += p[k]; }
#pragma unroll
            for (int k = 0; k < 4; ++k) { const unsigned rank = __hip_atomic_fetch_add(F.ctl + CW_CNT + 64 * l + idx[k], 1u, RLX_AGENT);
                tope[m * 4 + k] = idx[k] | (int)(rank << 8); topg[m * 4 + k] = p[k] / sum; }
        }
        __syncthreads();
    }
}
__device__ __forceinline__ void moe_tables(Frame& F, int l) {
    LAS int* blk_end = (LAS int*)(F.lds + LDS_X_OFF); LAS int* pstart = blk_end + 32;
    if (F.tid == 0) { int nb = 0;
        for (int e = 0; e < 32; ++e) { const int c = (int)__hip_atomic_load(F.ctl + CW_CNT + 64 * l + e, RLX_AGENT); pstart[e] = nb * 256; nb += (c + 255) >> 8; blk_end[e] = nb; } }
    __syncthreads();
}
__device__ __forceinline__ void phase_scatter(Frame& F, int l) {
    const int nrows = (l == 0) ? NTOK : NLAT;
    moe_tables(F, l);
    const LAS int* pstart = (const LAS int*)(F.lds + LDS_X_OFF) + 32;
    const int* tope = (const int*)(F.ws + MOEI_TOPE); const float* topg = (const float*)(F.ws + MOEI_TOPG);
    int* dest = (int*)(F.ws + MOEI_DEST); float* rowg = (float*)(F.ws + MOEI_ROWG);
    const bf16* H = (const bf16*)(F.ws + WS_H); bf16* XS = (bf16*)(F.ws + WS_XS);
    const int gw = F.bid * NWAVES + F.wave, NGW = F.G * NWAVES;
    for (int a = gw; a < nrows * 4; a += NGW) {
        const int te = tope[a], e = te & 255, rank = (int)((unsigned)te >> 8), d = pstart[e] + rank, m = a >> 2;
        if (F.lane == 0) { dest[a] = d; rowg[d] = topg[a]; }
        const v4u* src = (const v4u*)(H + (size_t)m * DM) + F.lane; v4u* dst = (v4u*)(XS + (size_t)d * DM) + F.lane;
#pragma unroll
        for (int j = 0; j < 4; ++j) dst[64 * j] = src[64 * j];
    }
}
__device__ __forceinline__ void phase_gemm1(Frame& F, int l) {
    moe_tables(F, l);
    const LAS int* blk_end = (const LAS int*)(F.lds + LDS_X_OFF);
    pg8::Gemm g{(const bf16*)(F.ws + WS_XS), (const bf16*)(F.ws + WS_WGU) + (size_t)l * 32 * 2048 * 2048, MOE_ROWS, 2048, 2048};
    pg8::MoeOrder S{F.bid, __builtin_amdgcn_readfirstlane(blk_end[31]), (const char*)g.A, (const char*)g.Bt, (size_t)256 * 2048 * 2, (size_t)2048 * 2048 * 2, (size_t)256 * 2048 * 2, blk_end};
    pg8::EpiSwiglu E{(bf16*)(F.ws + WS_ACT), F.in[I_BGU] + (size_t)l * 32 * 2048};
    pg8::gemm_phase<pg8::EpiSwiglu, pg8::MoeOrder, true, true>(F.lds + RING_OFF, g, S, E);
}
__device__ __forceinline__ void phase_gemm2(Frame& F, int l) {
    moe_tables(F, l);
    const LAS int* blk_end = (const LAS int*)(F.lds + LDS_X_OFF);
    pg8::Gemm g{(const bf16*)(F.ws + WS_ACT), (const bf16*)(F.ws + WS_WDN) + (size_t)l * 32 * 2048 * 1024, MOE_ROWS, 2048, 1024};
    pg8::MoeOrder S{F.bid, __builtin_amdgcn_readfirstlane(blk_end[31]), (const char*)g.A, (const char*)g.Bt, (size_t)256 * 1024 * 2, (size_t)2048 * 1024 * 2, (size_t)256 * 1024 * 2, blk_end};
    pg8::EpiDown E{(bf16*)(F.ws + WS_YS), F.in[I_BDN] + (size_t)l * 32 * 2048, (const float*)(F.ws + MOEI_ROWG)};
    pg8::gemm_phase<pg8::EpiDown, pg8::MoeOrder, true, true>(F.lds + RING_OFF, g, S, E);
}
#ifndef PHASE_NORM2
#define PHASE_NORM2(F, l) phase_norm2(F, l)
#endif
#ifndef PHASE_SCATTER
#define PHASE_SCATTER(F, l) phase_scatter(F, l)
#endif
#ifndef PHASE_GEMM1
#define PHASE_GEMM1(F, l) phase_gemm1(F, l)
#endif
#ifndef PHASE_GEMM2
#define PHASE_GEMM2(F, l) phase_gemm2(F, l)
#endif
#define USE_MFMA_ATTN 1

__device__ __forceinline__ void attn_prep(Frame& F, int l) {
    bf16* P = (bf16*)(F.ws + WS_P);
    LAS unsigned short* vt = (LAS unsigned short*)F.lds;
    for (int ct = F.bid; ct < NCT; ct += F.G) {
        const int m0 = ct * 64; const bool lat = m0 < NLAT;
        __syncthreads();
        for (int i = F.tid; i < 64 * 32; i += NTHREADS) { const int tk = i >> 5, c8 = i & 31;
            const v4u w = *(const v4u*)(P + (size_t)(m0 + tk) * PW + PC_V + c8 * 8);
            const unsigned ww[4] = {w.x, w.y, w.z, w.w};
#pragma unroll
            for (int q = 0; q < 4; ++q) { vt[(c8 * 8 + 2 * q) * 66 + tk] = (unsigned short)(ww[q] & 0xffffu); vt[(c8 * 8 + 2 * q + 1) * 66 + tk] = (unsigned short)(ww[q] >> 16); } }
        if (lat) for (int i = F.tid; i < 64 * 128; i += NTHREADS) { const int tk = i >> 7, pi = i & 127, kvh = pi >> 5, hf = (pi >> 4) & 1, j = pi & 15; const int t = (m0 + tk) & 4095;
            bf16* kp = P + (size_t)(m0 + tk) * PW + PC_K + kvh * 64 + hf * 32 + j;
            const float x1 = bf2f(kp[0]), x2 = bf2f(kp[16]); const float pos = (float)(hf ? (t & 63) : (t >> 6)); const float inv = __builtin_amdgcn_exp2f(-(float)j * 0.8304820237218406f);
            const float sn = __sinf(pos * inv), cs = __cosf(pos * inv);
            kp[0] = (bf16)f2bf(x1 * cs - x2 * sn); kp[16] = (bf16)f2bf(x2 * cs + x1 * sn); }
        __syncthreads();
        for (int i = F.tid; i < 256 * 8; i += NTHREADS) { const int col = i >> 3, c = i & 7, kvh = col >> 6, d = col & 63;
            v4u o; const LAS unsigned short* s = vt + col * 66 + c * 8;
            o.x = s[0] | ((unsigned)s[1] << 16); o.y = s[2] | ((unsigned)s[3] << 16); o.z = s[4] | ((unsigned)s[5] << 16); o.w = s[6] | ((unsigned)s[7] << 16);
            if (lat) { const int b = m0 >> 12, t0 = m0 & 4095; *(v4u*)((bf16*)(F.ws + WS_VT) + ((size_t)(b * 4 + kvh) * 64 + d) * SEQ + t0 + c * 8) = o; }
            else { const int mm = m0 - NLAT, b = mm >> 8, t0 = mm & 255; *(v4u*)((bf16*)(F.ws + WS_VTC) + ((size_t)(b * 4 + kvh) * 64 + d) * CTXL + t0 + c * 8) = o; } }
    }
    __syncthreads();
}

constexpr int AT_KP = 144, AT_VP = 136;
constexpr int AT_KOFF = 0, AT_VOFF = 64 * AT_KP, AT_TILE = 64 * AT_KP + 64 * AT_VP;
__device__ __forceinline__ void attn_unit(Frame& F, int l, int b, int kvh, int qi, int is_ctx) {
    const bf16* P = (const bf16*)(F.ws + WS_P); bf16* CC = (bf16*)(F.ws + WS_CC);
    int lane_o = F.lane; asm volatile("" : "+v"(lane_o));
    const int g = F.wave >> 1, qh = F.wave & 1, hq = kvh * 4 + g, r32 = lane_o & 31, hi = lane_o >> 5;
    const int rowbase = is_ctx ? NLAT + b * CTXL : b * SEQ;
    const int qa = qi * 128 + qh * 64;
    const float LOG2E = 1.4426950408889634f;
    bf16x8 qf[2][4];
#pragma unroll
    for (int qt = 0; qt < 2; ++qt) { const int tq = qa + 32 * qt + r32; const bf16* qp = P + (size_t)(rowbase + tq) * PW + PC_Q + hq * 64 + 8 * hi;
        float x[4][8];
#pragma unroll
        for (int s = 0; s < 4; ++s) { const v4u w = *(const v4u*)(qp + 16 * s); x[s][0] = bflo(w.x); x[s][1] = bfhi(w.x); x[s][2] = bflo(w.y); x[s][3] = bfhi(w.y); x[s][4] = bflo(w.z); x[s][5] = bfhi(w.z); x[s][6] = bflo(w.w); x[s][7] = bfhi(w.w); }
        if (!is_ctx) {
#pragma unroll
            for (int hf = 0; hf < 2; ++hf) { const float pos = (float)(hf ? (tq & 63) : (tq >> 6));
#pragma unroll
                for (int j = 0; j < 8; ++j) { const float inv = __builtin_amdgcn_exp2f(-(float)(8 * hi + j) * 0.8304820237218406f); const float sn = __sinf(pos * inv), cs = __cosf(pos * inv);
                    const float x1 = x[2 * hf][j], x2 = x[2 * hf + 1][j]; x[2 * hf][j] = x1 * cs - x2 * sn; x[2 * hf + 1][j] = x2 * cs + x1 * sn; } } }
        const float sc = 0.125f * LOG2E;
#pragma unroll
        for (int s = 0; s < 4; ++s) { v4u w; w.x = pk2(x[s][0] * sc, x[s][1] * sc); w.y = pk2(x[s][2] * sc, x[s][3] * sc); w.z = pk2(x[s][4] * sc, x[s][5] * sc); w.w = pk2(x[s][6] * sc, x[s][7] * sc); qf[qt][s] = __builtin_bit_cast(bf16x8, w); }
    }
    float mrun[2], lrun[2]; f32x16 O[2][2];
    { const float sk = F.in[I_SINK][l * 16 + hq] * LOG2E;
#pragma unroll
      for (int qt = 0; qt < 2; ++qt) { mrun[qt] = sk; lrun[qt] = hi ? 0.f : 1.f;
#pragma unroll
        for (int db = 0; db < 2; ++db)
#pragma unroll
            for (int r = 0; r < 16; ++r) O[qt][db][r] = 0.f; } }
    const int ntl = is_ctx ? 0 : 6;
#pragma unroll 1
    for (int kt = 0; kt < ntl + 4; ++kt) {
        const bool local = kt < ntl; const int k0 = local ? 128 * (qi - 1) + 64 * kt : 64 * (kt - ntl);
        if (local && (k0 < 0 || k0 >= SEQ)) continue;
        __syncthreads();
        { const int rr = F.tid >> 3, c = F.tid & 7;
          const bf16* ksrc = P + (size_t)((local ? b * SEQ : NLAT + b * CTXL) + k0 + rr) * PW + PC_K + kvh * 64 + c * 8;
          const bf16* vsrc = local ? (const bf16*)(F.ws + WS_VT) + ((size_t)(b * 4 + kvh) * 64 + rr) * SEQ + k0 + c * 8 : (const bf16*)(F.ws + WS_VTC) + ((size_t)(b * 4 + kvh) * 64 + rr) * CTXL + k0 + c * 8;
          const v4u kw = *(const v4u*)ksrc, vw = *(const v4u*)vsrc;
          *(LAS v4u*)(F.lds + AT_KOFF + rr * AT_KP + c * 16) = kw;
          LAS v2u* vd = (LAS v2u*)(F.lds + AT_VOFF + rr * AT_VP + c * 16); vd[0] = (v2u){vw.x, vw.y}; vd[1] = (v2u){vw.z, vw.w}; }
        __syncthreads();
        if (local && (k0 + 63 < qa - 128 || k0 > qa + 63 + 128)) continue;
#pragma unroll 1
        for (int kb = 0; kb < 2; ++kb) {
            bf16x8 kf[4];
#pragma unroll
            for (int ss = 0; ss < 4; ++ss) kf[ss] = *(const LAS bf16x8*)(F.lds + AT_KOFF + (32 * kb + r32) * AT_KP + (16 * ss + 8 * hi) * 2);
            bf16x8 pb[2][2];
#pragma unroll
            for (int qt = 0; qt < 2; ++qt) { const int tq = qa + 32 * qt + r32;
                f32x16 s;
#pragma unroll
                for (int r = 0; r < 16; ++r) s[r] = 0.f;
#pragma unroll
                for (int ss = 0; ss < 4; ++ss) s = __builtin_amdgcn_mfma_f32_32x32x16_bf16(kf[ss], qf[qt][ss], s, 0, 0, 0);
                if (local) {
#pragma unroll
                    for (int r = 0; r < 16; ++r) { const int kidx = k0 + 32 * kb + (r & 3) + 8 * (r >> 2) + 4 * hi; const int dlt = kidx - tq; if (dlt > 128 || dlt < -128) s[r] = -1.0e30f; } }
                float mloc = s[0];
#pragma unroll
                for (int r = 1; r < 16; ++r) mloc = fmaxf(mloc, s[r]);
                mloc = fmaxf(mloc, __shfl_xor(mloc, 32));
                const float mnew = fmaxf(mrun[qt], mloc), alpha = __builtin_amdgcn_exp2f(mrun[qt] - mnew); mrun[qt] = mnew;
                float psum = 0.f;
#pragma unroll
                for (int r = 0; r < 16; ++r) { s[r] = __builtin_amdgcn_exp2f(s[r] - mnew); psum += s[r]; }
                lrun[qt] = lrun[qt] * alpha + psum;
#pragma unroll
                for (int db = 0; db < 2; ++db)
#pragma unroll
                    for (int r = 0; r < 16; ++r) O[qt][db][r] *= alpha;
#pragma unroll
                for (int s2 = 0; s2 < 2; ++s2) { v4u pw; pw.x = pk2(s[8 * s2 + 0], s[8 * s2 + 1]); pw.y = pk2(s[8 * s2 + 2], s[8 * s2 + 3]); pw.z = pk2(s[8 * s2 + 4], s[8 * s2 + 5]); pw.w = pk2(s[8 * s2 + 6], s[8 * s2 + 7]);
                    pb[qt][s2] = __builtin_bit_cast(bf16x8, pw); }
            }
#pragma unroll
            for (int s2 = 0; s2 < 2; ++s2)
#pragma unroll
                for (int db = 0; db < 2; ++db) { const LAS v2u* vp = (const LAS v2u*)(F.lds + AT_VOFF + (32 * db + r32) * AT_VP + (32 * kb + 16 * s2 + 4 * hi) * 2);
                    const v2u a0 = vp[0], a1 = vp[2]; v4u aw; aw.x = a0.x; aw.y = a0.y; aw.z = a1.x; aw.w = a1.y; const bf16x8 va = __builtin_bit_cast(bf16x8, aw);
                    O[0][db] = __builtin_amdgcn_mfma_f32_32x32x16_bf16(va, pb[0][s2], O[0][db], 0, 0, 0);
                    O[1][db] = __builtin_amdgcn_mfma_f32_32x32x16_bf16(va, pb[1][s2], O[1][db], 0, 0, 0); }
        }
    }
    int r32e = r32, hie = hi; asm volatile("" : "+v"(r32e), "+v"(hie));
#pragma unroll
    for (int qt = 0; qt < 2; ++qt) { const float lt = lrun[qt] + __shfl_xor(lrun[qt], 32); const float rl = 1.0f / lt; const int tq = qa + 32 * qt + r32e;
        bf16* op = CC + (size_t)(rowbase + tq) * DM + hq * 64 + 4 * hie;
#pragma unroll
        for (int db = 0; db < 2; ++db)
#pragma unroll
            for (int rq = 0; rq < 4; ++rq) { v2u w; w.x = pk2(O[qt][db][4 * rq] * rl, O[qt][db][4 * rq + 1] * rl); w.y = pk2(O[qt][db][4 * rq + 2] * rl, O[qt][db][4 * rq + 3] * rl);
                *(v2u*)(op + 32 * db + 8 * rq) = w; } }
}
__device__ __forceinline__ void attn_phase(Frame& F, int l, int rep = 0) {
    const int nunits = 512 + (l == 0 ? 32 : 0);
    LAS int* slot = (LAS int*)(F.lds + LDS_X_OFF + 512);
    for (;;) {
        __syncthreads();
        if (F.tid == 0) *slot = (int)__hip_atomic_fetch_add(F.ctl + CW_ATQ + 64 * l + 8 * rep, 1u, RLX_AGENT);
        __syncthreads();
        const int u = __builtin_amdgcn_readfirstlane(*slot);
        if (u >= nunits) break;
        if (u < 512) attn_unit(F, l, u >> 7, (u >> 5) & 3, u & 31, 0); else { const int v = u - 512; attn_unit(F, l, v >> 3, (v >> 1) & 3, v & 1, 1); }
    }
}
#define USE_CHUNK_DN 1
#ifndef DN_REP_S1
#define DN_REP_S1 1
#endif
#ifndef DN_REP_S3B
#define DN_REP_S3B 1
#endif
#ifndef DN_REP_S3A
#define DN_REP_S3A 1
#endif
#ifndef DN_REP_S4
#define DN_REP_S4 1
#endif

constexpr int DN_F_NEGW = 0, DN_F_QG = 16, DN_F_QK = 32, DN_F_KGT = 40, DN_NFRAG = 56, DN_U_OFF = 57344;
constexpr int DP_QS = 0, DP_KS = 17408, DP_VS = 34816, DP_AS = 52224  , DP_TB = 69632, DP_TW = 78848, DP_QK = 88064, DP_RAW = 52224  , DP_SC = 104960, DP_TF = 106496  , DP_XS = 123904  ;
constexpr int DP_P = 272, DP_P2 = 144;
__device__ __forceinline__ int dn_rec(int b, int h, int dir, int np) { return ((b * 4 + h) * 2 + dir) * 68 + np; }
__device__ __forceinline__ void dn_chunk_of(int ct, int dir, int& b, int& np) { if (ct < 256) { b = ct >> 6; const int c = ct & 63; np = 4 + (dir ? 63 - c : c); } else { b = (ct - 256) >> 2; const int c = (ct - 256) & 3; np = dir ? 3 - c : c; } }
__device__ __forceinline__ unsigned short lds_u16(const LAS unsigned char* p) { return *(const LAS unsigned short*)p; }

__device__ __forceinline__ void dn_prep_unit(Frame& F, int l, int ct, int h, int dir) {
    const bf16* P = (const bf16*)(F.ws + WS_P);
    int lane = F.lane; asm volatile("" : "+v"(lane));
    const int wave = F.wave, i16 = lane & 15, q = lane >> 4;
    const int m0 = ct * 64; int t0, T, base; seq_of(m0, t0, T, base);
    int b, np; dn_chunk_of(ct, dir, b, np);
    unsigned char* tile = F.ws + WS_DNT + (size_t)dn_rec(b, h, dir, np) * DNT_BYTES;
    LAS unsigned char* L = F.lds;
    LAS float* SC = (LAS float*)(L + DP_SC);
    __syncthreads();
    {
        const float* cw = F.in[I_DNCW] + (size_t)l * 4 * 1536;
        float2 cwr[3][4];
#pragma unroll
        for (int part = 0; part < 3; ++part)
#pragma unroll
            for (int j = 0; j < 4; ++j) cwr[part][j] = *(const float2*)(cw + j * 1536 + part * 512 + h * 128 + 2 * lane);
        unsigned short pbw = 0, paw = 0;
        if (wave == 0) { const int tok = dir ? 63 - lane : lane; pbw = P[(size_t)(m0 + tok) * PW + PC_BETA + dir * 4 + h]; paw = P[(size_t)(m0 + tok) * PW + PC_DEC + dir * 4 + h]; }
        for (int c = F.tid; c < 67 * 48; c += NTHREADS) { const int row = c / 48, ch = c % 48, part = ch >> 4, cc = ch & 15, tt = t0 + row - 2;
            v4u v = (v4u){0u, 0u, 0u, 0u};
            if (tt >= 0 && tt < T) v = *(const v4u*)(P + (size_t)(base + tt) * PW + PC_DQ + part * 512 + h * 128 + cc * 8);
            *(LAS v4u*)(L + DP_RAW + row * 784 + part * 256 + cc * 16) = v; }
        __syncthreads();
#pragma unroll 1
        for (int rep = 0; rep < DN_REP_S1; ++rep)
#pragma unroll
        for (int part = 0; part < 3; ++part)
#pragma unroll 2
            for (int i = 0; i < 8; ++i) { const int tok = wave * 8 + i;
                float s0 = 0.f, s1 = 0.f;
#pragma unroll
                for (int j = 0; j < 4; ++j) { const unsigned w = *(const LAS unsigned*)(L + DP_RAW + (tok + j) * 784 + part * 256 + lane * 4); s0 += cwr[part][j].x * bflo(w); s1 += cwr[part][j].y * bfhi(w); }
                s0 = siluf_(s0); s1 = siluf_(s1);
                if (part < 2) { const float ss = wave_sum(s0 * s0 + s1 * s1); const float f = (part == 0 ? 0.08838834764831845f : 1.0f) / sqrtf(ss + EPS); s0 *= f; s1 *= f; }
                *(LAS unsigned*)(L + (part == 0 ? DP_QS : (part == 1 ? DP_KS : DP_VS)) + tok * DP_P + lane * 4) = pk2(s0, s1); }
        if (wave == 0) {
            const float pb = bf2f(pbw), pa = bf2f(paw);
            const float beta = sigmoidf_(pb); float gc = -__expf(F.in[I_DNALOG][l * 8 + dir * 4 + h]) * softplusf_(pa + F.in[I_DNDT][l * 8 + dir * 4 + h]);
#pragma unroll
            for (int o = 1; o < 64; o <<= 1) { const float v = __shfl_up(gc, o); if (lane >= o) gc += v; }
            const float glast = __shfl(gc, 63);
            SC[lane] = beta; SC[64 + lane] = gc; SC[128 + lane] = __expf(gc); SC[192 + lane] = __expf(glast - gc);
            if (lane == 63) ((float*)(F.ws + WS_DNS))[dn_rec(b, h, dir, np)] = __expf(glast);
        }
    }
    __syncthreads();
#define DN_TOK(r) (dir ? 63 - (r) : (r))
#pragma unroll 1
    for (int rep = 0; rep < DN_REP_S3A; ++rep)
    {
        const int mb = wave & 3, which = wave >> 2;
        f32x4 acc[4];
#pragma unroll
        for (int nb = 0; nb < 4; ++nb) acc[nb] = (f32x4){0.f, 0.f, 0.f, 0.f};
        const LAS unsigned char* arow = L + (which ? DP_QS : DP_KS) + DN_TOK(16 * mb + i16) * DP_P + 16 * q;
#pragma unroll
        for (int ks = 0; ks < 4; ++ks) { const bf16x8 a = *(const LAS bf16x8*)(arow + 64 * ks);
#pragma unroll
            for (int nb = 0; nb < 4; ++nb) { const bf16x8 bb = *(const LAS bf16x8*)(L + DP_KS + DN_TOK(16 * nb + i16) * DP_P + 16 * q + 64 * ks);
                acc[nb] = __builtin_amdgcn_mfma_f32_16x16x32_bf16(a, bb, acc[nb], 0, 0, 0); } }
#pragma unroll
        for (int nb = 0; nb < 4; ++nb)
#pragma unroll
            for (int i = 0; i < 4; ++i) { const int r = 16 * mb + 4 * q + i, c = 16 * nb + i16; const float dec = __expf(SC[64 + r] - SC[64 + c]);
                if (which == 0) ((LAS float*)(L + DP_AS))[r * 68 + c] = (r > c) ? SC[r] * acc[nb][i] * dec : 0.f;
                else *(LAS unsigned short*)(L + DP_QK + r * DP_P2 + c * 2) = (unsigned short)f2bf((r >= c) ? acc[nb][i] * dec : 0.f); }
    }
    __syncthreads();
#pragma unroll 1
    for (int rep = 0; rep < DN_REP_S3B; ++rep) {
    if (wave == 0) {
        const LAS float* As = (const LAS float*)(L + DP_AS); LAS float* Tf = (LAS float*)(L + DP_TF);
        const int g = lane >> 4, c = lane & 15;
        f32x4 ar[16][4];
#pragma unroll
        for (int r = 1; r < 16; ++r)
#pragma unroll
            for (int j4 = 0; j4 < (r + 3) / 4; ++j4) ar[r][j4] = *(const LAS f32x4*)(As + (16 * g + r) * 68 + 16 * g + 4 * j4);
        float t[16];
#pragma unroll
        for (int r = 0; r < 16; ++r) { float a0 = (c == r) ? 1.f : 0.f, a1 = 0.f;
#pragma unroll
            for (int j = 0; j < r; ++j) { const float av = ar[r][j >> 2][j & 3]; if (j & 1) a1 -= av * t[j]; else a0 -= av * t[j]; }
            t[r] = a0 + a1; Tf[(16 * g + r) * 68 + 16 * g + c] = t[r]; }
    }
    __syncthreads();
    if (wave < 3) {
        const LAS float* As = (const LAS float*)(L + DP_AS); LAS float* Tf = (LAS float*)(L + DP_TF); LAS float* Xs = (LAS float*)(L + DP_XS) + wave * 272;
        const int J = wave;
#pragma unroll 1
        for (int I = J + 1; I < 4; ++I) {
            f32x4 acc = {0.f, 0.f, 0.f, 0.f};
#pragma unroll 1
            for (int K = J; K < I; ++K)
#pragma unroll
                for (int sk = 0; sk < 4; ++sk) acc = __builtin_amdgcn_mfma_f32_16x16x4f32(As[(16 * I + i16) * 68 + 16 * K + 4 * sk + q], Tf[(16 * K + 4 * sk + q) * 68 + 16 * J + i16], acc, 0, 0, 0);
#pragma unroll
            for (int i = 0; i < 4; ++i) Xs[(4 * q + i) * 17 + i16] = acc[i];
            LDS_WAIT(); asm volatile("" ::: "memory");
            f32x4 acc2 = {0.f, 0.f, 0.f, 0.f};
#pragma unroll
            for (int sk = 0; sk < 4; ++sk) acc2 = __builtin_amdgcn_mfma_f32_16x16x4f32(Tf[(16 * I + i16) * 68 + 16 * I + 4 * sk + q], Xs[(4 * sk + q) * 17 + i16], acc2, 0, 0, 0);
#pragma unroll
            for (int i = 0; i < 4; ++i) Tf[(16 * I + 4 * q + i) * 68 + 16 * J + i16] = -acc2[i];
            LDS_WAIT(); asm volatile("" ::: "memory");
        }
    }
    __syncthreads();
    { const LAS float* Tf = (const LAS float*)(L + DP_TF); const int r = F.tid >> 3, c0 = (F.tid & 7) * 8; float vb[8], vw[8];
#pragma unroll
      for (int k = 0; k < 8; ++k) { const int c = c0 + k; const float v = ((r >> 4) >= (c >> 4)) ? Tf[r * 68 + c] : 0.f; const float bl = SC[c]; vb[k] = v * bl; vw[k] = vb[k] * SC[128 + c]; }
      v4u ob, ow; ob.x = pk2(vb[0], vb[1]); ob.y = pk2(vb[2], vb[3]); ob.z = pk2(vb[4], vb[5]); ob.w = pk2(vb[6], vb[7]); ow.x = pk2(vw[0], vw[1]); ow.y = pk2(vw[2], vw[3]); ow.z = pk2(vw[4], vw[5]); ow.w = pk2(vw[6], vw[7]);
      *(LAS v4u*)(L + DP_TB + r * DP_P2 + c0 * 2) = ob; *(LAS v4u*)(L + DP_TW + r * DP_P2 + c0 * 2) = ow; }
    }
    __syncthreads();
    {
        const int nbp = wave & 3, which = wave >> 2;
        f32x4 acc[4][2];
#pragma unroll
        for (int mb = 0; mb < 4; ++mb) { acc[mb][0] = (f32x4){0.f, 0.f, 0.f, 0.f}; acc[mb][1] = (f32x4){0.f, 0.f, 0.f, 0.f}; }
#pragma unroll
        for (int ks = 0; ks < 2; ++ks) {
            bf16x8 bb[2];
#pragma unroll
            for (int nn = 0; nn < 2; ++nn) { const int n = 16 * (2 * nbp + nn) + i16; unsigned short e[8];
#pragma unroll
                for (int jj = 0; jj < 8; ++jj) e[jj] = lds_u16(L + (which ? DP_KS : DP_VS) + DN_TOK(32 * ks + 8 * q + jj) * DP_P + n * 2);
                v4u w; w.x = e[0] | ((unsigned)e[1] << 16); w.y = e[2] | ((unsigned)e[3] << 16); w.z = e[4] | ((unsigned)e[5] << 16); w.w = e[6] | ((unsigned)e[7] << 16); bb[nn] = __builtin_bit_cast(bf16x8, w); }
#pragma unroll
            for (int mb = 0; mb < 4; ++mb) { const bf16x8 a = *(const LAS bf16x8*)(L + (which ? DP_TW : DP_TB) + (16 * mb + i16) * DP_P2 + 64 * ks + 16 * q);
                acc[mb][0] = __builtin_amdgcn_mfma_f32_16x16x32_bf16(a, bb[0], acc[mb][0], 0, 0, 0); acc[mb][1] = __builtin_amdgcn_mfma_f32_16x16x32_bf16(a, bb[1], acc[mb][1], 0, 0, 0); } }
        if (which == 0) {
#pragma unroll
            for (int mb = 0; mb < 4; ++mb)
#pragma unroll
                for (int nn = 0; nn < 2; ++nn) *(f32x4*)(tile + DN_U_OFF + (size_t)((((2 * nbp + nn) * 4 + mb) * 64 + lane) * 16)) = acc[mb][nn];
        } else {
#pragma unroll
            for (int mb = 0; mb < 4; ++mb)
#pragma unroll
                for (int nn = 0; nn < 2; ++nn)
#pragma unroll
                    for (int i = 0; i < 4; ++i) *(LAS unsigned short*)(L + DP_AS + (16 * mb + 4 * q + i) * DP_P + (16 * (2 * nbp + nn) + i16) * 2) = (unsigned short)f2bf(-acc[mb][nn][i]);
        }
    }
    __syncthreads();
#pragma unroll 1
    for (int rep = 0; rep < DN_REP_S4; ++rep)
#pragma unroll 1
    for (int fi = 0; fi < 7; ++fi) { const int f = wave * 7 + fi; v4u o;
        if (f < DN_F_QG) { const int mb = f >> 2, ks = f & 3; const LAS unsigned char* rp = L + DP_AS + (16 * mb + i16) * DP_P + (32 * ks + 4 * q) * 2;
            const v2u a = *(const LAS v2u*)rp, c = *(const LAS v2u*)(rp + 32); o.x = a.x; o.y = a.y; o.z = c.x; o.w = c.y; }
        else if (f < DN_F_QK) { const int ff = f - DN_F_QG, mb = ff >> 2, ks = ff & 3, r = 16 * mb + i16; const LAS unsigned char* rp = L + DP_QS + DN_TOK(r) * DP_P + (32 * ks + 4 * q) * 2; const float eg = SC[128 + r];
            const v2u a = *(const LAS v2u*)rp, c = *(const LAS v2u*)(rp + 32);
            o.x = pk2(bflo(a.x) * eg, bfhi(a.x) * eg); o.y = pk2(bflo(a.y) * eg, bfhi(a.y) * eg); o.z = pk2(bflo(c.x) * eg, bfhi(c.x) * eg); o.w = pk2(bflo(c.y) * eg, bfhi(c.y) * eg); }
        else if (f < DN_F_KGT) { const int ff = f - DN_F_QK, mb = ff >> 1, ks = ff & 1; const LAS unsigned char* rp = L + DP_QK + (16 * mb + i16) * DP_P2 + (32 * ks + 4 * q) * 2;
            const v2u a = *(const LAS v2u*)rp, c = *(const LAS v2u*)(rp + 32); o.x = a.x; o.y = a.y; o.z = c.x; o.w = c.y; }
        else { const int ff = f - DN_F_KGT, mb = ff >> 1, ks = ff & 1, dk = 16 * mb + i16; float e[8];
#pragma unroll
            for (int jj = 0; jj < 8; ++jj) { const int key = 32 * ks + 16 * (jj >> 2) + 4 * q + (jj & 3); e[jj] = bf2f(lds_u16(L + DP_KS + DN_TOK(key) * DP_P + dk * 2)) * SC[192 + key]; }
            o.x = pk2(e[0], e[1]); o.y = pk2(e[2], e[3]); o.z = pk2(e[4], e[5]); o.w = pk2(e[6], e[7]); }
        *(v4u*)(tile + (size_t)f * 1024 + lane * 16) = o; }
#undef DN_TOK
}
__device__ __forceinline__ void dn_prep(Frame& F, int l) {
    for (int u = F.bid; u < NCT * 4 * 2; u += F.G) dn_prep_unit(F, l, u >> 3, (u >> 1) & 3, u & 1);
    __syncthreads();
}

__device__ __forceinline__ void dn_scan(Frame& F, int l, int b, int h, int dir) {
    int lane = F.lane; asm volatile("" : "+v"(lane));
    const int w = F.wave, i16 = lane & 15, q = lane >> 4;
    const unsigned char* tiles = F.ws + WS_DNT + (size_t)dn_rec(b, h, dir, 0) * DNT_BYTES;
    const float* egl = (const float*)(F.ws + WS_DNS) + dn_rec(b, h, dir, 0);
    float* O = (float*)(F.ws + WS_DNO);
    LAS unsigned char* L = F.lds;
    f32x4 S[8];
#pragma unroll
    for (int i = 0; i < 8; ++i) S[i] = (f32x4){0.f, 0.f, 0.f, 0.f};
    v4u st[7]; f32x4 un[4];
#pragma unroll
    for (int mb = 0; mb < 4; ++mb) un[mb] = *(const f32x4*)(tiles + DN_U_OFF + (size_t)(((w * 4 + mb) * 64 + lane) * 16));
    __syncthreads();
#pragma unroll
    for (int i = 0; i < 7; ++i) st[i] = *(const v4u*)(tiles + (size_t)(F.tid + i * NTHREADS) * 16);
#pragma unroll
    for (int i = 0; i < 7; ++i) *(LAS v4u*)(L + (F.tid + i * NTHREADS) * 16) = st[i];
    __syncthreads();
#pragma unroll 1
    for (int n = 0; n < 68; ++n) {
        const unsigned char* tile = tiles + (size_t)n * DNT_BYTES; const LAS unsigned char* cur = L + (n & 1) * 57344;
        if (n + 1 < 68) {
#pragma unroll
            for (int i = 0; i < 7; ++i) st[i] = *(const v4u*)(tile + DNT_BYTES + (size_t)(F.tid + i * NTHREADS) * 16); }
        f32x4 vn[4];
#pragma unroll
        for (int mb = 0; mb < 4; ++mb) vn[mb] = un[mb];
        if (n + 1 < 68) {
#pragma unroll
            for (int mb = 0; mb < 4; ++mb) un[mb] = *(const f32x4*)(tile + DNT_BYTES + DN_U_OFF + (size_t)(((w * 4 + mb) * 64 + lane) * 16)); }
        const float el = egl[n];
        bf16x8 bS[4];
#pragma unroll
        for (int ks = 0; ks < 4; ++ks) { v4u x; x.x = pk2(S[2 * ks][0], S[2 * ks][1]); x.y = pk2(S[2 * ks][2], S[2 * ks][3]); x.z = pk2(S[2 * ks + 1][0], S[2 * ks + 1][1]); x.w = pk2(S[2 * ks + 1][2], S[2 * ks + 1][3]); bS[ks] = __builtin_bit_cast(bf16x8, x); }
        f32x4 o[4];
#pragma unroll
        for (int mb = 0; mb < 4; ++mb) { o[mb] = (f32x4){0.f, 0.f, 0.f, 0.f};
#pragma unroll
            for (int ks = 0; ks < 4; ++ks) { const bf16x8 aw = *(const LAS bf16x8*)(cur + (DN_F_NEGW + mb * 4 + ks) * 1024 + lane * 16), aq = *(const LAS bf16x8*)(cur + (DN_F_QG + mb * 4 + ks) * 1024 + lane * 16);
                vn[mb] = __builtin_amdgcn_mfma_f32_16x16x32_bf16(aw, bS[ks], vn[mb], 0, 0, 0); o[mb] = __builtin_amdgcn_mfma_f32_16x16x32_bf16(aq, bS[ks], o[mb], 0, 0, 0); } }
        bf16x8 bV[2];
#pragma unroll
        for (int ks = 0; ks < 2; ++ks) { v4u x; x.x = pk2(vn[2 * ks][0], vn[2 * ks][1]); x.y = pk2(vn[2 * ks][2], vn[2 * ks][3]); x.z = pk2(vn[2 * ks + 1][0], vn[2 * ks + 1][1]); x.w = pk2(vn[2 * ks + 1][2], vn[2 * ks + 1][3]); bV[ks] = __builtin_bit_cast(bf16x8, x); }
#pragma unroll
        for (int mb = 0; mb < 8; ++mb) { S[mb] = S[mb] * el;
#pragma unroll
            for (int ks = 0; ks < 2; ++ks) { const bf16x8 ak = *(const LAS bf16x8*)(cur + (DN_F_KGT + mb * 2 + ks) * 1024 + lane * 16); S[mb] = __builtin_amdgcn_mfma_f32_16x16x32_bf16(ak, bV[ks], S[mb], 0, 0, 0); } }
#pragma unroll
        for (int mb = 0; mb < 4; ++mb)
#pragma unroll
            for (int ks = 0; ks < 2; ++ks) { const bf16x8 aqk = *(const LAS bf16x8*)(cur + (DN_F_QK + mb * 2 + ks) * 1024 + lane * 16); o[mb] = __builtin_amdgcn_mfma_f32_16x16x32_bf16(aqk, bV[ks], o[mb], 0, 0, 0); }
        { int m0; if (n < 4) m0 = NLAT + b * CTXL + 64 * (dir ? 3 - n : n); else m0 = b * SEQ + 64 * (dir ? 63 - (n - 4) : (n - 4));
#pragma unroll
          for (int mb = 0; mb < 4; ++mb)
#pragma unroll
            for (int i = 0; i < 4; ++i) { const int r = 16 * mb + 4 * q + i, tok = dir ? 63 - r : r; O[((size_t)dir * NTOK + m0 + tok) * 512 + h * 128 + 16 * w + i16] = o[mb][i]; } }
        if (n + 1 < 68) {
#pragma unroll
            for (int i = 0; i < 7; ++i) *(LAS v4u*)(L + ((n + 1) & 1) * 57344 + (F.tid + i * NTHREADS) * 16) = st[i]; }
        __syncthreads();
    }
}
#define USE_CHUNK_LRU 1

constexpr int LR_XF = 0  , LR_XB = 16640  , LR_WT = 25856  , LR_AA = 62720  , LR_UU = 96000  , LR_END = 129280;
constexpr size_t WS_LCA = WS_LRC, WS_LCH = WS_LRC + 2 * MiB, WS_LCI = WS_LRC + 4 * MiB;
__device__ __forceinline__ void lru_prep(Frame& F, int l) {
    const bf16* P = (const bf16*)(F.ws + WS_P);
    int lane = F.lane; asm volatile("" : "+v"(lane));
    const int wave = F.wave, i16 = lane & 15, q = lane >> 4, nb = F.bid & 7;
    LAS unsigned char* L = F.lds;
    LAS float* XF = (LAS float*)(L + LR_XF); LAS float* AA = (LAS float*)(L + LR_AA); LAS float* UU = (LAS float*)(L + LR_UU);
    float* HL = (float*)(F.ws + WS_LRH); float* AC = (float*)(F.ws + WS_LRA);
    __syncthreads();
    for (int e = F.tid; e < 4 * 4096; e += NTHREADS) { const int mat = e >> 12, ii = (e >> 6) & 63, j = e & 63, dir = mat >> 1;
        const float w = (mat & 1 ? F.in[I_LRWI] : F.in[I_LRWR])[((size_t)((l * 2 + dir) * 8 + nb)) * 4096 + ii * 64 + j];
        *(LAS unsigned short*)(L + LR_WT + (mat * 64 + j) * 144 + ii * 2) = (unsigned short)f2bf(w); }
    float cwv[4][8], cbv[8];
    { const int c8 = (F.tid & 7) * 8, ch0 = nb * 64 + c8; const float* cb = F.in[I_LRCB] + l * 512 + ch0; const float* cw = F.in[I_LRCW] + (size_t)l * 4 * 512 + ch0;
#pragma unroll
      for (int k = 0; k < 8; ++k) cbv[k] = cb[k];
#pragma unroll
      for (int j = 0; j < 4; ++j)
#pragma unroll
        for (int k = 0; k < 8; ++k) cwv[j][k] = cw[j * 512 + k]; }
    float gbr[4], gbi[4], gls[4];
    { const int dir = wave >> 2;
#pragma unroll
      for (int n = 0; n < 4; ++n) { const int ch = nb * 64 + 16 * n + i16; gbr[n] = F.in[I_LRBR][(l * 2 + dir) * 512 + ch]; gbi[n] = F.in[I_LRBI][(l * 2 + dir) * 512 + ch]; gls[n] = -softplusf_(-F.in[I_LRLAM][(l * 2 + dir) * 512 + ch]); } }
    for (int ct = F.bid >> 3; ct < NCT; ct += F.G >> 3) {
        const int m0 = ct * 64; int t0, T, base; seq_of(m0, t0, T, base);
        __syncthreads();
        { const int tok = F.tid >> 3, c8 = (F.tid & 7) * 8, ch0 = nb * 64 + c8; float s[8];
#pragma unroll
          for (int k = 0; k < 8; ++k) s[k] = cbv[k];
          v4u wv[4];
#pragma unroll
          for (int j = 0; j < 4; ++j) { const int tt = t0 + tok + j - 2; wv[j] = (v4u){0u, 0u, 0u, 0u}; if (tt >= 0 && tt < T) wv[j] = *(const v4u*)(P + (size_t)(base + tt) * PW + PC_LX + ch0); }
#pragma unroll
          for (int j = 0; j < 4; ++j) { const v4u w = wv[j];
              s[0] += cwv[j][0] * bflo(w.x); s[1] += cwv[j][1] * bfhi(w.x); s[2] += cwv[j][2] * bflo(w.y); s[3] += cwv[j][3] * bfhi(w.y); s[4] += cwv[j][4] * bflo(w.z); s[5] += cwv[j][5] * bfhi(w.z); s[6] += cwv[j][6] * bflo(w.w); s[7] += cwv[j][7] * bfhi(w.w); }
#pragma unroll
          for (int k = 0; k < 8; ++k) XF[tok * 65 + c8 + k] = s[k];
          v4u o; o.x = pk2(s[0], s[1]); o.y = pk2(s[2], s[3]); o.z = pk2(s[4], s[5]); o.w = pk2(s[6], s[7]); *(LAS v4u*)(L + LR_XB + tok * 144 + c8 * 2) = o; }
        __syncthreads();
        { const int dir = wave >> 2, mb = wave & 3;
          f32x4 ar[4], ai[4];
#pragma unroll
          for (int n = 0; n < 4; ++n) { ar[n] = (f32x4){0.f, 0.f, 0.f, 0.f}; ai[n] = (f32x4){0.f, 0.f, 0.f, 0.f}; }
#pragma unroll
          for (int ks = 0; ks < 2; ++ks) { const bf16x8 a = *(const LAS bf16x8*)(L + LR_XB + (16 * mb + i16) * 144 + 64 * ks + 16 * q);
#pragma unroll
              for (int n = 0; n < 4; ++n) { const bf16x8 br = *(const LAS bf16x8*)(L + LR_WT + ((dir * 2 + 0) * 64 + 16 * n + i16) * 144 + 64 * ks + 16 * q), bi = *(const LAS bf16x8*)(L + LR_WT + ((dir * 2 + 1) * 64 + 16 * n + i16) * 144 + 64 * ks + 16 * q);
                  ar[n] = __builtin_amdgcn_mfma_f32_16x16x32_bf16(a, br, ar[n], 0, 0, 0); ai[n] = __builtin_amdgcn_mfma_f32_16x16x32_bf16(a, bi, ai[n], 0, 0, 0); } }
#pragma unroll
          for (int n = 0; n < 4; ++n) { const int j = 16 * n + i16; const float br_ = gbr[n], bi_ = gbi[n], logsig = gls[n];
#pragma unroll
              for (int i = 0; i < 4; ++i) { const int tok = 16 * mb + 4 * q + i; const float r = sigmoidf_(ar[n][i] + br_), ig = sigmoidf_(ai[n][i] + bi_);
                  const float log_a = 8.0f * r * logsig, a = __expf(log_a), u = sqrtf(-expm1f(2.0f * log_a)) * (ig * XF[tok * 65 + j]);
                  AA[(dir * 64 + tok) * 65 + j] = a; UU[(dir * 64 + tok) * 65 + j] = u; } } }
        __syncthreads();
        if (F.tid < 128) { const int dir = F.tid >> 6, j = F.tid & 63, ch = nb * 64 + j; float h = 0.f, ac = 1.f;
            long o = (long)(((size_t)dir * NTOK + m0 + (dir ? 63 : 0)) * 512 + ch); const long ostep = dir ? -512 : 512;
#pragma unroll 1
            for (int s0 = 0; s0 < 64; s0 += 8) { float av[8], uv[8];
#pragma unroll
                for (int k = 0; k < 8; ++k) { const int tok = dir ? 63 - (s0 + k) : (s0 + k); av[k] = AA[(dir * 64 + tok) * 65 + j]; uv[k] = UU[(dir * 64 + tok) * 65 + j]; }
#pragma unroll
                for (int k = 0; k < 8; ++k) { h = av[k] * h + uv[k]; ac *= av[k]; HL[o] = h; AC[o] = ac; o += ostep; } }
            ((float*)(F.ws + WS_LCA))[((size_t)dir * NCT + ct) * 512 + ch] = ac; ((float*)(F.ws + WS_LCH))[((size_t)dir * NCT + ct) * 512 + ch] = h; }
    }
    __syncthreads();
}
__device__ __forceinline__ void lru_carry(Frame& F, int idx) {
    const int ch = idx & 511, dir = (idx >> 9) & 1, b = idx >> 10;
    const float* CA = (const float*)(F.ws + WS_LCA); const float* CH = (const float*)(F.ws + WS_LCH); float* CI = (float*)(F.ws + WS_LCI);
    float h = 0.f;
#pragma unroll 4
    for (int n = 0; n < 68; ++n) { const int ct = n < 4 ? 256 + b * 4 + (dir ? 3 - n : n) : b * 64 + (dir ? 63 - (n - 4) : (n - 4)); const size_t o = ((size_t)dir * NCT + ct) * 512 + ch;
        CI[o] = h; h = CA[o] * h + CH[o]; }
}
__device__ __forceinline__ void lru_fin(Frame& F, int l) {
    const int nrows = (l == 0) ? NTOK : NLAT;
    const bf16* P = (const bf16*)(F.ws + WS_P); bf16* CC = (bf16*)(F.ws + WS_CC);
    const float* HL = (const float*)(F.ws + WS_LRH); const float* AC = (const float*)(F.ws + WS_LRA); const float* CI = (const float*)(F.ws + WS_LCI);
    for (size_t i = (size_t)F.bid * NTHREADS + F.tid; i < (size_t)nrows * 128; i += (size_t)F.G * NTHREADS) { const int m = (int)(i >> 7), c4 = (int)(i & 127) * 4, ct = m >> 6;
        const f32x4 h0 = *(const f32x4*)(HL + (size_t)m * 512 + c4), a0 = *(const f32x4*)(AC + (size_t)m * 512 + c4), i0 = *(const f32x4*)(CI + (size_t)ct * 512 + c4);
        const f32x4 h1 = *(const f32x4*)(HL + ((size_t)NTOK + m) * 512 + c4), a1 = *(const f32x4*)(AC + ((size_t)NTOK + m) * 512 + c4), i1 = *(const f32x4*)(CI + ((size_t)NCT + ct) * 512 + c4);
        const f32x4 hs = (a0 * i0 + h0) + (a1 * i1 + h1); const v2u yw = *(const v2u*)(P + (size_t)m * PW + PC_LY + c4);
        v2u o; o.x = pk2(hs.x * gelu_tanh(bflo(yw.x)), hs.y * gelu_tanh(bfhi(yw.x))); o.y = pk2(hs.z * gelu_tanh(bflo(yw.y)), hs.w * gelu_tanh(bfhi(yw.y)));
        *(v2u*)(CC + (size_t)m * DM + 1536 + c4) = o; }
}

constexpr size_t WS_DNQ = WS_DNT;
constexpr size_t WS_BG = WS_DNS + 1 * MiB;
constexpr size_t WS_XC = WS_XS;

__device__ __forceinline__ void naive_prep(Frame& F, int l) {
    const bf16* P = (const bf16*)(F.ws + WS_P);
    const int gw = F.bid * NWAVES + F.wave, NGW = F.G * NWAVES;
#if !defined(USE_CHUNK_DN)
    {
        float* DNQ = (float*)(F.ws + WS_DNQ); float* BG = (float*)(F.ws + WS_BG);
        const float* cw = F.in[I_DNCW] + (size_t)l * 4 * 1536;
        for (int it = gw; it < NTOK * 4; it += NGW) {
            const int m = it >> 2, h = it & 3; int t, T, base; seq_of(m, t, T, base);
            float val[3][2];
#pragma unroll
            for (int part = 0; part < 3; ++part)
#pragma unroll
                for (int dd = 0; dd < 2; ++dd) { const int d = F.lane + 64 * dd, cch = part * 512 + h * 128 + d, col = PC_DQ + cch; float s = 0.f;
#pragma unroll
                    for (int j = 0; j < 4; ++j) { const int tt = t + j - 2; if (tt >= 0 && tt < T) s += cw[j * 1536 + cch] * bf2f(P[(size_t)(base + tt) * PW + col]); }
                    val[part][dd] = siluf_(s); }
            const float sq = wave_sum(val[0][0] * val[0][0] + val[0][1] * val[0][1]), sk = wave_sum(val[1][0] * val[1][0] + val[1][1] * val[1][1]);
            const float fq = 0.08838834764831845f / sqrtf(sq + EPS), fk = 1.0f / sqrtf(sk + EPS);
#pragma unroll
            for (int dd = 0; dd < 2; ++dd) { const int d = F.lane + 64 * dd; float* o = DNQ + (size_t)m * 1536 + h * 128 + d;
                o[0] = val[0][dd] * fq; o[512] = val[1][dd] * fk; o[1024] = val[2][dd]; }
            if (h == 0 && F.lane < 8) { const int dir = F.lane >> 2, hh = F.lane & 3;
                const float pb = bf2f(P[(size_t)m * PW + PC_BETA + F.lane]), pa = bf2f(P[(size_t)m * PW + PC_DEC + F.lane]);
                BG[m * 16 + F.lane] = sigmoidf_(pb);
                BG[m * 16 + 8 + F.lane] = -__expf(F.in[I_DNALOG][l * 8 + dir * 4 + hh]) * softplusf_(pa + F.in[I_DNDT][l * 8 + dir * 4 + hh]); }
        }
    }
#endif
#if !defined(USE_CHUNK_LRU)
    {
        LAS float* xc = (LAS float*)F.lds;
        float* A = (float*)(F.ws + WS_LRA); float* U = (float*)(F.ws + WS_LRH);
        const float* cw = F.in[I_LRCW] + (size_t)l * 4 * 512; const float* cb = F.in[I_LRCB] + l * 512;
        for (int m0 = F.bid * 8; m0 < NTOK; m0 += F.G * 8) {
            __syncthreads();
            for (int i = F.tid; i < 8 * 512; i += NTHREADS) { const int m = m0 + (i >> 9), ch = i & 511; int t, T, base; seq_of(m, t, T, base); float s = cb[ch];
#pragma unroll
                for (int j = 0; j < 4; ++j) { const int tt = t + j - 2; if (tt >= 0 && tt < T) s += cw[j * 512 + ch] * bf2f(P[(size_t)(base + tt) * PW + PC_LX + ch]); }
                xc[i] = s; }
            __syncthreads();
            for (int i = F.tid; i < 8 * 512 * 2; i += NTHREADS) { const int ch = i & 511, dir = (i >> 9) & 1, tk = i >> 10, m = m0 + tk, blk = ch >> 6, j = ch & 63;
                const float* wr = F.in[I_LRWR] + ((size_t)((l * 2 + dir) * 8 + blk)) * 4096 + j; const float* wi = F.in[I_LRWI] + ((size_t)((l * 2 + dir) * 8 + blk)) * 4096 + j;
                float sr = F.in[I_LRBR][(l * 2 + dir) * 512 + ch], si = F.in[I_LRBI][(l * 2 + dir) * 512 + ch];
#pragma unroll 8
                for (int ii = 0; ii < 64; ++ii) { const float x = xc[tk * 512 + blk * 64 + ii]; sr += x * wr[ii * 64]; si += x * wi[ii * 64]; }
                const float r = sigmoidf_(sr), ig = sigmoidf_(si); const float lam = F.in[I_LRLAM][(l * 2 + dir) * 512 + ch];
                const float logsig = -softplusf_(-lam);
                const float log_a = 8.0f * r * logsig; const float a = __expf(log_a);
                const float u = sqrtf(-expm1f(2.0f * log_a)) * (ig * xc[tk * 512 + ch]);
                A[((size_t)dir * NTOK + m) * 512 + ch] = a; U[((size_t)dir * NTOK + m) * 512 + ch] = u; }
        }
        __syncthreads();
    }
#endif
}

__device__ __forceinline__ void naive_attn_row(Frame& F, int l, int m, int hq) {
    const bf16* P = (const bf16*)(F.ws + WS_P); bf16* CC = (bf16*)(F.ws + WS_CC);
    const int d = F.lane, kvh = hq >> 2; int t, T, base; seq_of(m, t, T, base);
    const bool lat = m < NLAT; const int b = lat ? (m >> 12) : ((m - NLAT) >> 8);
    const int dd = d & 31, jf = dd & 15; const float inv = __powf(10000.0f, -(float)jf * (1.0f / 16.0f));
    const bool second = (dd >= 16), colhalf = (d >= 32);
    float q = bf2f(P[(size_t)m * PW + PC_Q + hq * 64 + d]);
    if (lat) { const float pos = (float)(colhalf ? (t & 63) : (t >> 6)); float sn, cs; sincosf(pos * inv, &sn, &cs); const float pr = __shfl_xor(q, 16); q = second ? (q * cs + pr * sn) : (q * cs - pr * sn); }
    q *= 0.125f;
    float mx = F.in[I_SINK][l * 16 + hq], den = 1.0f, acc = 0.f;
    if (lat) { const int t0 = t - 128 < 0 ? 0 : t - 128, t1 = t + 128 > SEQ - 1 ? SEQ - 1 : t + 128;
        for (int tk = t0; tk <= t1; ++tk) { const size_t r = (size_t)(base + tk) * PW; float k = bf2f(P[r + PC_K + kvh * 64 + d]); const float v = bf2f(P[r + PC_V + kvh * 64 + d]);
            const float pos = (float)(colhalf ? (tk & 63) : (tk >> 6)); float sn, cs; sincosf(pos * inv, &sn, &cs); const float pr = __shfl_xor(k, 16); k = second ? (k * cs + pr * sn) : (k * cs - pr * sn);
            const float s = wave_sum(q * k); const float mn = fmaxf(mx, s), f = __expf(mx - mn), p = __expf(s - mn); den = den * f + p; acc = acc * f + p * v; mx = mn; } }
    for (int c = 0; c < CTXL; ++c) { const size_t r = (size_t)(NLAT + b * CTXL + c) * PW; const float k = bf2f(P[r + PC_K + kvh * 64 + d]), v = bf2f(P[r + PC_V + kvh * 64 + d]);
        const float s = wave_sum(q * k); const float mn = fmaxf(mx, s), f = __expf(mx - mn), p = __expf(s - mn); den = den * f + p; acc = acc * f + p * v; mx = mn; }
    CC[(size_t)m * DM + hq * 64 + d] = (bf16)f2bf(acc / den);
}

__device__ __forceinline__ int scan_row(int n, int b, int dir) { if (n < CTXL) { const int t = dir ? (CTXL - 1 - n) : n; return NLAT + b * CTXL + t; } const int t = dir ? (SEQ - 1 - (n - CTXL)) : (n - CTXL); return b * SEQ + t; }
__device__ __forceinline__ void naive_scan(Frame& F, int l, int rep = 0) {
#if defined(USE_CHUNK_DN)
    if (F.bid < 32) { dn_scan(F, l, F.bid >> 3, (F.bid >> 1) & 3, F.bid & 1); }
#else
    if (F.bid < 32) {
        const int b = F.bid >> 3, h = (F.bid >> 1) & 3, dir = F.bid & 1, dvc = F.tid & 127, kq = F.tid >> 7;
        const float* DNQ = (const float*)(F.ws + WS_DNQ); const float* BG = (const float*)(F.ws + WS_BG); float* O = (float*)(F.ws + WS_DNO);
        LAS float* buf = (LAS float*)F.lds;
        LAS float* red = buf + 768;
        LAS float* red2 = red + 512;
        float S[32];
#pragma unroll
        for (int i = 0; i < 32; ++i) S[i] = 0.f;
        constexpr int NT = CTXL + SEQ;
        { const int m = scan_row(0, b, dir); if (F.tid < 384) buf[F.tid] = DNQ[(size_t)m * 1536 + (F.tid >> 7) * 512 + h * 128 + (F.tid & 127)]; }
        __syncthreads();
#pragma unroll 1
        for (int n = 0; n < NT; ++n) {
            const int m = scan_row(n, b, dir); const LAS float* cur = buf + (n & 1) * 384;
            float nextv = 0.f; if (n + 1 < NT && F.tid < 384) { const int m2 = scan_row(n + 1, b, dir); nextv = DNQ[(size_t)m2 * 1536 + (F.tid >> 7) * 512 + h * 128 + (F.tid & 127)]; }
            const float beta = BG[m * 16 + dir * 4 + h], decay = __expf(BG[m * 16 + 8 + dir * 4 + h]);
            float ks = 0.f;
#pragma unroll
            for (int i = 0; i < 32; ++i) ks += cur[128 + kq * 32 + i] * S[i];
            red[kq * 128 + dvc] = ks;
            __syncthreads();
            const float kS = (red[dvc] + red[128 + dvc]) + (red[256 + dvc] + red[384 + dvc]);
            const float upd = beta * (cur[256 + dvc] - decay * kS);
            float os = 0.f;
#pragma unroll
            for (int i = 0; i < 32; ++i) { S[i] = decay * S[i] + cur[128 + kq * 32 + i] * upd; os += cur[kq * 32 + i] * S[i]; }
            red2[kq * 128 + dvc] = os;
            if (F.tid < 384) buf[((n + 1) & 1) * 384 + F.tid] = nextv;
            __syncthreads();
            if (kq == 0) O[((size_t)dir * NTOK + m) * 512 + h * 128 + dvc] = (red2[dvc] + red2[128 + dvc]) + (red2[256 + dvc] + red2[384 + dvc]);
        }
    }
#endif
#if defined(USE_CHUNK_LRU)
    else if (F.bid < 40) { lru_carry(F, (F.bid - 32) * NTHREADS + F.tid); }
#else
    else if (F.bid < 40) {
        const int idx = (F.bid - 32) * NTHREADS + F.tid, ch = idx & 511, dir = (idx >> 9) & 1, b = idx >> 10;
        const float* A = (const float*)(F.ws + WS_LRA); float* U = (float*)(F.ws + WS_LRH);
        float hs = 0.f;
#pragma unroll 4
        for (int n = 0; n < CTXL + SEQ; ++n) { int m; if (n < CTXL) { const int t = dir ? (CTXL - 1 - n) : n; m = NLAT + b * CTXL + t; } else { const int t = dir ? (SEQ - 1 - (n - CTXL)) : (n - CTXL); m = b * SEQ + t; }
            const size_t o = ((size_t)dir * NTOK + m) * 512 + ch; hs = A[o] * hs + U[o]; U[o] = hs; }
    }
#endif
#if defined(USE_MFMA_ATTN)
    attn_phase(F, l, rep);
    convert_moe_queue(F, l, rep);
#else
    {
        const int nrows = (l == 0) ? NTOK : NLAT;
        for (;;) { int m = 0; if (F.lane == 0) m = (int)__hip_atomic_fetch_add(F.ctl + CW_ATQ + 64 * l, 1u, RLX_AGENT); m = __builtin_amdgcn_readfirstlane(m);
            if (m >= nrows) break;
#pragma unroll 1
            for (int hq = 0; hq < 16; ++hq) naive_attn_row(F, l, m, hq); }
    }
#endif
}

__device__ __forceinline__ void naive_fin(Frame& F, int l) {
    const int nrows = (l == 0) ? NTOK : NLAT;
    const bf16* P = (const bf16*)(F.ws + WS_P); bf16* CC = (bf16*)(F.ws + WS_CC);
    const int gw = F.bid * NWAVES + F.wave, NGW = F.G * NWAVES;
    const float* O = (const float*)(F.ws + WS_DNO); const float* HS = (const float*)(F.ws + WS_LRH);
    for (int it = gw; it < nrows * 4; it += NGW) { const int m = it >> 2, h = it & 3; float o[2];
#pragma unroll
        for (int dd = 0; dd < 2; ++dd) { const int c = h * 128 + F.lane + 64 * dd; o[dd] = O[(size_t)m * 512 + c] + O[((size_t)NTOK + m) * 512 + c]; }
        const float rstd = 1.0f / sqrtf(wave_sum(o[0] * o[0] + o[1] * o[1]) * (1.0f / 128.0f) + EPS);
#pragma unroll
        for (int dd = 0; dd < 2; ++dd) { const int d = F.lane + 64 * dd; const float gt = bf2f(P[(size_t)m * PW + PC_DG + h * 128 + d]);
            CC[(size_t)m * DM + 1024 + h * 128 + d] = (bf16)f2bf(o[dd] * rstd * F.in[I_DNNG][l * 128 + d] * siluf_(gt)); }
    }
#if defined(USE_CHUNK_LRU)
    lru_fin(F, l);
#else
    for (size_t i = (size_t)F.bid * NTHREADS + F.tid; i < (size_t)nrows * 512; i += (size_t)F.G * NTHREADS) { const int m = (int)(i >> 9), ch = (int)(i & 511);
        const float hsum = HS[(size_t)m * 512 + ch] + HS[((size_t)NTOK + m) * 512 + ch]; const float y = bf2f(P[(size_t)m * PW + PC_LY + ch]);
        CC[(size_t)m * DM + 1536 + ch] = (bf16)f2bf(hsum * gelu_tanh(y)); }
#endif
}
#ifndef PHASE_PREP
#if defined(USE_MFMA_ATTN)
#if defined(USE_CHUNK_DN)
#define PHASE_PREP(F, l) do { attn_prep(F, l); lru_prep(F, l); dn_prep(F, l); } while (0)
#else
#define PHASE_PREP(F, l) do { naive_prep(F, l); attn_prep(F, l); } while (0)
#endif
#else
#define PHASE_PREP(F, l) naive_prep(F, l)
#endif
#endif
#ifndef PHASE_SCAN
#define PHASE_SCAN(F, l) naive_scan(F, l)
#endif
#ifndef PHASE_FIN
#define PHASE_FIN(F, l) naive_fin(F, l)
#endif

#ifndef PHASE_INPROJ
#define PHASE_INPROJ(F, l) do {} while (0)
#endif
#ifndef PHASE_PREP
#define PHASE_PREP(F, l) do {} while (0)
#endif
#ifndef PHASE_SCAN
#define PHASE_SCAN(F, l) do {} while (0)
#endif
#ifndef PHASE_FIN
#define PHASE_FIN(F, l) do {} while (0)
#endif
#ifndef PHASE_OUTPROJ
#define PHASE_OUTPROJ(F, l) do {} while (0)
#endif
#ifndef PHASE_NORM2
#define PHASE_NORM2(F, l) do {} while (0)
#endif
#ifndef PHASE_SCATTER
#define PHASE_SCATTER(F, l) do {} while (0)
#endif
#ifndef PHASE_GEMM1
#define PHASE_GEMM1(F, l) do {} while (0)
#endif
#ifndef PHASE_GEMM2
#define PHASE_GEMM2(F, l) do {} while (0)
#endif

#ifndef MK_SPLIT
#define MK_SPLIT 0
#endif
#ifndef MK_STAGE
#define MK_STAGE 99
#endif
#ifndef MK_DUP
#define MK_DUP 0
#endif
#define DUP(k) ((MK_DUP >> (k)) & 1)
constexpr int N_PHASES = 22;
struct Args { const float* in[N_IN]; float* out; unsigned char* ws; int ph_lo, ph_hi; };
static_assert(sizeof(Args) == (N_IN + 2) * 8 + 8, "Args has no padding");

__global__ void __launch_bounds__(NTHREADS, 2) fwd_kernel(Args args) {
    extern __shared__ __attribute__((aligned(16))) unsigned char lds[];
    Frame F;
    F.lds = (LAS unsigned char*)lds;
    F.MISC = (volatile LAS unsigned*)(F.lds + MISC_OFF);
    F.tid = threadIdx.x; F.lane = F.tid & 63; F.wave = __builtin_amdgcn_readfirstlane(F.tid >> 6);
    F.G = gridDim.x; F.bid = blockIdx.x;
    F.ws = args.ws; F.out = args.out; F.ctl = (gu32*)(args.ws + WS_CTL);
    F.in = (const float* const __attribute__((address_space(4)))*)__builtin_amdgcn_kernarg_segment_ptr();
    for (int u = F.tid; u < (LDS_BYTES - LDSCTL_OFF) / 4; u += NTHREADS) ((LAS unsigned*)(F.lds + LDSCTL_OFF))[u] = 0u;
    __syncthreads();
    XcdBarrier bar; bar.bar = (unsigned*)(F.ctl + CW_BAR); bar.x = 0; bar.st = nullptr;
    if (!MK_SPLIT) bar = xcd_barrier_post((unsigned*)(F.ctl + CW_BAR), F.MISC + 8);
    const int lo = args.ph_lo, hi = args.ph_hi;
#define IN(k) (lo <= (k) && (k) < hi && phase_enter(F))
#define INR(k) (lo <= (k) && (k) < hi)
#define SEAM(k) do { if (INR(k) && INR((k) + 1)) xcd_barrier(bar); } while (0)

    if (IN(0)) { p0_prologue(F); if (DUP(0)) { __syncthreads(); p0_prologue(F); } } SEAM(0);
#pragma unroll 1
    for (int l = 0; l < DEPTH; ++l) {
        const int pb = 1 + 10 * l;
        if (IN(pb + 0)) { phase_norm1(F, l); } SEAM(pb + 0);
        if (IN(pb + 1)) { PHASE_INPROJ(F, l); if (DUP(1)) { __syncthreads(); PHASE_INPROJ(F, l); } } SEAM(pb + 1);
        if (IN(pb + 2)) { PHASE_PREP(F, l); if (DUP(2)) { __syncthreads(); dn_prep(F, l); } if (DUP(6)) { __syncthreads(); lru_prep(F, l); } } SEAM(pb + 2);
        if (IN(pb + 3)) { if (DUP(3) && F.bid < 32) dn_scan(F, l, F.bid >> 3, (F.bid >> 1) & 3, F.bid & 1); PHASE_SCAN(F, l); if (DUP(10)) { __syncthreads(); naive_scan(F, l, 1); } if (DUP(11)) { __syncthreads(); attn_phase(F, l, 2); } if (DUP(12)) { __syncthreads(); convert_moe_queue(F, l, 3); } } SEAM(pb + 3);
        if (IN(pb + 4)) { PHASE_FIN(F, l); if (DUP(4)) { __syncthreads(); PHASE_FIN(F, l); } } SEAM(pb + 4);
        if (IN(pb + 5)) { PHASE_OUTPROJ(F, l); } SEAM(pb + 5);
        if (IN(pb + 6)) { PHASE_NORM2(F, l); } SEAM(pb + 6);
        if (IN(pb + 7)) { PHASE_SCATTER(F, l); if (DUP(7)) { __syncthreads(); PHASE_SCATTER(F, l); } } SEAM(pb + 7);
        if (IN(pb + 8)) { PHASE_GEMM1(F, l); if (DUP(8)) { __syncthreads(); PHASE_GEMM1(F, l); } } SEAM(pb + 8);
        if (IN(pb + 9)) { PHASE_GEMM2(F, l); if (DUP(9)) { __syncthreads(); PHASE_GEMM2(F, l); } } SEAM(pb + 9);
    }
    if (IN(21)) { phase_final(F, MK_STAGE >= 9); }
#undef IN
#undef SEAM
}

extern "C" void kernel_launch(void* const* d_in, const int* in_sizes, int n_in, void* d_out, int out_size, void* d_ws, size_t ws_size, hipStream_t stream) {
    static int grid = 0;
    if (grid == 0) {
        if (n_in != N_IN || out_size != NLAT * DM || ws_size < WS_END) { fprintf(stderr, "kernel_launch: unexpected shapes (n_in %d, out %d, ws %zu); nothing launched\n", n_in, out_size, ws_size); grid = -1; return; }
        int dev = 0, cus = 0, per_cu = 0;
        if (hipGetDevice(&dev) != hipSuccess || hipDeviceGetAttribute(&cus, hipDeviceAttributeMultiprocessorCount, dev) != hipSuccess) { grid = -1; return; }
        if (hipFuncSetAttribute((const void*)fwd_kernel, hipFuncAttributeMaxDynamicSharedMemorySize, LDS_BYTES) != hipSuccess) { fprintf(stderr, "kernel_launch: hipFuncSetAttribute failed\n"); grid = -1; return; }
        if (hipOccupancyMaxActiveBlocksPerMultiprocessor(&per_cu, (const void*)fwd_kernel, NTHREADS, LDS_BYTES) != hipSuccess || per_cu < 1) { fprintf(stderr, "kernel_launch: occupancy query says %d\n", per_cu); }
        (void)hipGetLastError();
        grid = cus;
        if (grid != 256) { fprintf(stderr, "kernel_launch: built for 256 CUs, device has %d; nothing launched\n", cus); grid = -1; return; }
    }
    if (grid < 0) return;
    if (hipMemsetAsync((char*)d_ws + WS_CTL, 0, CTL_ZERO_BYTES, stream) != hipSuccess) return;
    Args a{};
    for (int i = 0; i < N_IN; ++i) a.in[i] = (const float*)d_in[i];
    a.out = (float*)d_out; a.ws = (unsigned char*)d_ws;
#if MK_SPLIT
    for (int p = 0; p < N_PHASES; ++p) { a.ph_lo = p; a.ph_hi = p + 1; hipLaunchKernelGGL(fwd_kernel, dim3(grid), dim3(NTHREADS), LDS_BYTES, stream, a); }
#else
    a.ph_lo = 0; a.ph_hi = N_PHASES;
    hipLaunchKernelGGL(fwd_kernel, dim3(grid), dim3(NTHREADS), LDS_BYTES, stream, a);
#endif
    const hipError_t le = hipPeekAtLastError();
    if (le != hipSuccess) fprintf(stderr, "kernel_launch: launch failed: %s\n", hipGetErrorName(le));
}
```

```cpp
#include <hip/hip_runtime.h>
#include <cstdio>
#include <cstdint>

constexpr int DM = 2048, NB = 4, SEQ = 4096, CTXL = 256, DEPTH = 2;
constexpr int NLAT = NB * SEQ, NCTX = NB * CTXL, NTOK = NLAT + NCTX;
constexpr int NCT = NTOK / 64;
constexpr int IN_W = 4624, PW = 4864;
constexpr int PC_Q = 0, PC_K = 1024, PC_V = 1280, PC_DQ = 1536, PC_DK = 2048, PC_DV = 2560, PC_DG = 3072, PC_LX = 3584, PC_LY = 4096, PC_BETA = 4608, PC_DEC = 4616;
constexpr int NEXP = 32, TOPK = 4, DEXP = 1024;
constexpr int MOE_ROWS = 304 * 256;
constexpr float EPS = 1e-6f;
#ifndef MK_STAGE
#define MK_STAGE 99
#endif
namespace pg8 {
#define PG8_LAS __attribute__((address_space(3)))
typedef unsigned short bf16_t;
typedef short bf16x8 __attribute__((ext_vector_type(8)));
typedef float f32x4 __attribute__((ext_vector_type(4)));
typedef unsigned u32x4 __attribute__((ext_vector_type(4)));
typedef float f32x2 __attribute__((ext_vector_type(2)));
constexpr int BM = 256, BK = 64, HALF = 128, HTB = HALF * BK * 2  , STAGE_BYTES = 8 * HTB, NXCD = 8, WGM = 8;

__host__ __device__ __forceinline__ int lds_byte(int r, int c) { const int st = (r >> 4) * 2 + (c >> 5), rr = r & 15, cc = c & 31, ob = rr * 64 + cc * 2; return st * 1024 + (ob ^ (((ob >> 9) & 1) << 5)); }
__host__ __device__ __forceinline__ void stage_rc(int b, int& R, int& C) { const int st = b / 1024, sb = b % 1024, swz = sb ^ (((sb >> 9) & 1) << 5); R = (st >> 1) * 16 + swz / 64; C = (st & 1) * 32 + (swz % 64) / 2; }
__host__ __device__ __forceinline__ int perm32(int rho) { const int n = rho >> 4, i = rho & 15; return 8 * (i >> 2) + 4 * n + (i & 3); }

struct Unit { int pm, pn, e; };
struct Gemm { const bf16_t* A; const bf16_t* Bt; int M, N, K; };

struct StaticOrder {
    static constexpr bool GATHER = false; const int* row_tab = nullptr;
    int nM, nN, nwg, G, c; const char* A; const char* Bt; size_t tstep;
    __device__ void init(const Gemm& g, int G_, int c_) { nM = g.M / BM; nN = g.N / BM; nwg = nM * nN; G = G_; c = c_; A = (const char*)g.A; Bt = (const char*)g.Bt; tstep = (size_t)BM * g.K * 2; }
    __device__ bool next(int i, Unit& u) const {
        const long L = (long)i * G + c; if (L >= nwg) return false;
        int wgid = (int)L; { const int q = nwg / NXCD, r = nwg % NXCD, xcd = wgid % NXCD, off = wgid / NXCD; wgid = (xcd < r ? xcd * (q + 1) : r * (q + 1) + (xcd - r) * q) + off; }
        const int nig = WGM * nN, gid = wgid / nig, fm = gid * WGM, gsz = (nM - fm) < WGM ? (nM - fm) : WGM;
        u.pm = fm + ((wgid % nig) % gsz); u.pn = (wgid % nig) / gsz; u.e = 0; return true;
    }
    __device__ __forceinline__ const char* a_ptr(const Unit& u) const { return A + (size_t)u.pm * tstep; }
    __device__ __forceinline__ const char* b_ptr(const Unit& u) const { return Bt + (size_t)u.pn * tstep; }
    __device__ __forceinline__ void a_ready(const Unit&) const {}
    __device__ __forceinline__ void done(const Unit&) const {}
};
__device__ __forceinline__ unsigned cvt_pk_bf16(float lo, float hi) { unsigned r; asm volatile("v_cvt_pk_bf16_f32 %0, %1, %2" : "=v"(r) : "v"(lo), "v"(hi)); return r; }
struct EpiBf16Plain {
    static constexpr bool PERM = true, AFTER_DRAIN = false;
    bf16_t* O; int ldc;
    __device__ __forceinline__ void operator()(const f32x4 (&acc)[2][2][4][2], const Unit& u, int wr, int wc, int fr, int fq) const {
        const int row0 = u.pm * BM + wr * 64 + fr, col0 = u.pn * BM + wc * 32 + 8 * fq;
#pragma unroll
        for (int ai = 0; ai < 2; ++ai)
#pragma unroll
            for (int m = 0; m < 4; ++m) { bf16_t* rowp = O + (size_t)(row0 + ai * HALF + m * 16) * ldc + col0;
#pragma unroll
                for (int bj = 0; bj < 2; ++bj) { const f32x4 v0 = acc[ai][bj][m][0], v1 = acc[ai][bj][m][1];
                    u32x4 w; w.x = cvt_pk_bf16(v0[0], v0[1]); w.y = cvt_pk_bf16(v0[2], v0[3]); w.z = cvt_pk_bf16(v1[0], v1[1]); w.w = cvt_pk_bf16(v1[2], v1[3]);
                    *(u32x4*)(rowp + bj * HALF) = w; } }
    }
};
struct EpiResGate {
    static constexpr bool PERM = false, AFTER_DRAIN = false;
    const float* base_lat; const float* base_ctx; float* out; const float* modg;
    __device__ __forceinline__ void operator()(const f32x4 (&acc)[2][2][4][2], const Unit& u, int wr, int wc, int fr, int fq) const {
        const int r = u.pm < 64 ? (u.pm >> 4) : 4; const int col0 = u.pn * BM + wc * 32 + 4 * fq;
        const float* g = modg + (size_t)r * 12288 + col0;
        f32x4 gv[2][2];
#pragma unroll
        for (int bj = 0; bj < 2; ++bj)
#pragma unroll
            for (int n = 0; n < 2; ++n) gv[bj][n] = *(const f32x4*)(g + bj * HALF + n * 16);
#pragma unroll
        for (int ai = 0; ai < 2; ++ai)
#pragma unroll
            for (int m = 0; m < 4; ++m) { const int row = u.pm * BM + ai * HALF + wr * 64 + m * 16 + fr;
                const float* bp = (row < 16384 ? base_lat + (size_t)row * 2048 : base_ctx + (size_t)(row - 16384) * 2048) + col0; float* op = out + (size_t)row * 2048 + col0;
#pragma unroll
                for (int bj = 0; bj < 2; ++bj)
#pragma unroll
                    for (int n = 0; n < 2; ++n) { const f32x4 b = *(const f32x4*)(bp + bj * HALF + n * 16); *(f32x4*)(op + bj * HALF + n * 16) = b + gv[bj][n] * acc[ai][bj][m][n]; }
                asm volatile("" ::: "memory"); }
    }
};
struct EpiSwiglu {
    static constexpr bool PERM = true, AFTER_DRAIN = false;
    bf16_t* O; const float* bgu;
    __device__ __forceinline__ void operator()(const f32x4 (&acc)[2][2][4][2], const Unit& u, int wr, int wc, int fr, int fq) const {
        const int row0 = u.pm * BM + wr * 64 + fr, cc0 = wc * 32 + 8 * fq;
        const float* bg = bgu + (size_t)u.e * 2048 + u.pn * 128 + cc0;
        f32x4 bglu[2], blin[2];
#pragma unroll
        for (int n = 0; n < 2; ++n) { bglu[n] = *(const f32x4*)(bg + 4 * n); blin[n] = *(const f32x4*)(bg + 1024 + 4 * n); }
#pragma unroll
        for (int ai = 0; ai < 2; ++ai)
#pragma unroll
            for (int m = 0; m < 4; ++m) { bf16_t* rowp = O + (size_t)(row0 + ai * HALF + m * 16) * 1024 + u.pn * 128 + cc0;
                float r[8];
#pragma unroll
                for (int n = 0; n < 2; ++n) { const f32x4 g = acc[ai][0][m][n] + bglu[n], l = acc[ai][1][m][n] + blin[n];
#pragma unroll
                    for (int i = 0; i < 4; ++i) { const float gg = fminf(g[i], 7.0f); const float ll = fminf(fmaxf(l[i], -7.0f), 7.0f);
                        r[4 * n + i] = (ll + 1.0f) * gg * (1.0f / (1.0f + __expf(-1.702f * gg))); } }
                u32x4 w; w.x = cvt_pk_bf16(r[0], r[1]); w.y = cvt_pk_bf16(r[2], r[3]); w.z = cvt_pk_bf16(r[4], r[5]); w.w = cvt_pk_bf16(r[6], r[7]);
                *(u32x4*)rowp = w; }
    }
};
struct EpiDown {
    static constexpr bool PERM = true, AFTER_DRAIN = false;
    bf16_t* O; const float* bdn; const float* rowg;
    __device__ __forceinline__ void operator()(const f32x4 (&acc)[2][2][4][2], const Unit& u, int wr, int wc, int fr, int fq) const {
        const int row0 = u.pm * BM + wr * 64 + fr, col0 = u.pn * BM + wc * 32 + 8 * fq;
        const float* bb = bdn + (size_t)u.e * 2048 + col0;
        f32x4 bv[2][2];
#pragma unroll
        for (int bj = 0; bj < 2; ++bj)
#pragma unroll
            for (int n = 0; n < 2; ++n) bv[bj][n] = *(const f32x4*)(bb + bj * HALF + 4 * n);
#pragma unroll
        for (int ai = 0; ai < 2; ++ai)
#pragma unroll
            for (int m = 0; m < 4; ++m) { const int row = row0 + ai * HALF + m * 16; const float gt = rowg[row]; bf16_t* rowp = O + (size_t)row * 2048 + col0;
#pragma unroll
                for (int bj = 0; bj < 2; ++bj) { const f32x4 v0 = (acc[ai][bj][m][0] + bv[bj][0]) * gt, v1 = (acc[ai][bj][m][1] + bv[bj][1]) * gt;
                    u32x4 w; w.x = cvt_pk_bf16(v0[0], v0[1]); w.y = cvt_pk_bf16(v0[2], v0[3]); w.z = cvt_pk_bf16(v1[0], v1[1]); w.w = cvt_pk_bf16(v1[2], v1[3]);
                    *(u32x4*)(rowp + bj * HALF) = w; } }
    }
};
template <bool GATHER_> struct MoeOrderT {
    static constexpr bool GATHER = GATHER_;
    int c, nblk; const char* A; const char* Bt; size_t a_tstep, b_estep, b_tstep; const PG8_LAS int* blk_end; const int* row_tab;
    __device__ __forceinline__ bool next(int i, Unit& u) const {
        const int x = c & 7, j = c >> 3, gi = i * 8 + x, rb = 4 * gi + (j >> 3);
        if (rb >= nblk) return false;
        int e = 0;
        for (int k = 0; k < 31; ++k) e += (rb >= blk_end[k]) ? 1 : 0;
        u.pm = rb; u.pn = j & 7; u.e = __builtin_amdgcn_readfirstlane(e); return true;
    }
    __device__ __forceinline__ const char* a_ptr(const Unit& u) const { return GATHER ? A : A + (size_t)u.pm * a_tstep; }
    __device__ __forceinline__ const char* b_ptr(const Unit& u) const { return Bt + (size_t)u.e * b_estep + (size_t)u.pn * b_tstep; }
    __device__ __forceinline__ void a_ready(const Unit&) const {}
    __device__ __forceinline__ void done(const Unit&) const {}
};
typedef MoeOrderT<false> MoeOrder;
typedef MoeOrderT<true> MoeOrderG;
template <class Epi, class Sched, bool ALIGN_EPI = false, bool SP2 = false>
__device__ __forceinline__ void gemm_phase(PG8_LAS unsigned char* lds, const Gemm g, const Sched& S, const Epi& E) {
    int tid = threadIdx.x; asm volatile("" : "+v"(tid));
    const int wid = __builtin_amdgcn_readfirstlane(tid >> 6), lane = tid & 63, wr = wid >> 2, wc = wid & 3, fr = lane & 15, fq = lane >> 4;
    const int K = g.K, nt = K / BK;
    unsigned voffA[2], voffB[2];
#pragma unroll
    for (int i = 0; i < 2; ++i) { int R, C; stage_rc(tid * 16 + i * 8192, R, C); const int Rb = Epi::PERM ? ((R & ~31) + perm32(R & 31)) : R;
        voffA[i] = (unsigned)(R * K + C) * 2u; voffB[i] = (unsigned)(Rb * K + C) * 2u; }
    unsigned gc0[2] = {0u, 0u}, gc1[2] = {0u, 0u}; int gR = 0, gC = 0;
    if constexpr (Sched::GATHER) { stage_rc(tid * 16, gR, gC); }
#define PG8_GLOAD(dst0, dst1, u) do { const int* _rt = S.row_tab + (size_t)(u).pm * BM + gR; \
        dst0[0] = (unsigned)_rt[0] * (unsigned)(K * 2) + (unsigned)(gC * 2); dst0[1] = (unsigned)_rt[64] * (unsigned)(K * 2) + (unsigned)(gC * 2); \
        dst1[0] = (unsigned)_rt[128] * (unsigned)(K * 2) + (unsigned)(gC * 2); dst1[1] = (unsigned)_rt[192] * (unsigned)(K * 2) + (unsigned)(gC * 2); } while (0)
    const size_t kstep = (size_t)(BK * 2);
    const size_t hstep = (size_t)HALF * K * 2;
    const size_t tstep = 2 * hstep;
    const unsigned ldsw = (unsigned)wid * 1024u;
    const int aoff = lds_byte(wr * 64 + fr, fq * 8), boff = lds_byte(wc * 32 + fr, fq * 8);
#define PG8_SA(b, h) (((b) * 2 + (h)) * HTB)
#define PG8_SB(b, h) ((4 + (b) * 2 + (h)) * HTB)
#define PG8_STAGE(bufoff, gbase, voff) do { _Pragma("unroll") for (int _i = 0; _i < 2; ++_i) \
        __builtin_amdgcn_global_load_lds((const unsigned*)((const char*)(gbase) + (voff)[_i]), (PG8_LAS unsigned*)(lds + (bufoff) + ldsw + _i * 8192), 16, 0, 0); } while (0)
#define PG8_LDA(dst, b, h) do { _Pragma("unroll") for (int m = 0; m < 4; ++m) _Pragma("unroll") for (int k = 0; k < 2; ++k) dst[m][k] = *(const PG8_LAS bf16x8*)(lds + PG8_SA(b, h) + aoff + m * 2048 + k * 1024); } while (0)
#define PG8_LDB(dst, b, h) do { _Pragma("unroll") for (int n = 0; n < 2; ++n) _Pragma("unroll") for (int k = 0; k < 2; ++k) dst[n][k] = *(const PG8_LAS bf16x8*)(lds + PG8_SB(b, h) + boff + n * 2048 + k * 1024); } while (0)
#define PG8_MMA(ai, bj, At, Bt) do { __builtin_amdgcn_s_setprio(1); _Pragma("unroll") for (int m = 0; m < 4; ++m) _Pragma("unroll") for (int n = 0; n < 2; ++n) _Pragma("unroll") for (int k = 0; k < 2; ++k) \
        acc[ai][bj][m][n] = __builtin_amdgcn_mfma_f32_16x16x32_bf16(Bt[n][k], At[m][k], acc[ai][bj][m][n], 0, 0, 0); __builtin_amdgcn_s_setprio(0); } while (0)
#define PG8_WAIT_V(n) asm volatile("s_waitcnt vmcnt(" #n ")" ::: "memory")
#define PG8_WAIT_L(n) asm volatile("s_waitcnt lgkmcnt(" #n ")" ::: "memory")
#define PG8_BAR __builtin_amdgcn_s_barrier()
#define PG8_SCHED __builtin_amdgcn_sched_barrier(0)
    Unit cur, nxt; int ui = 0;
    if (!S.next(0, cur)) return;
    f32x4 acc[2][2][4][2];
#pragma unroll
    for (int a = 0; a < 2; ++a)
#pragma unroll
        for (int b = 0; b < 2; ++b)
#pragma unroll
            for (int m = 0; m < 4; ++m)
#pragma unroll
                for (int n = 0; n < 2; ++n) acc[a][b][m][n] = (f32x4){0.f, 0.f, 0.f, 0.f};
    bf16x8 At[4][2], B0[2][2], B1[2][2];
    const char* cA = S.a_ptr(cur); const char* cB = S.b_ptr(cur);
    S.a_ready(cur);
    if constexpr (SP2) {
        if constexpr (Sched::GATHER) { PG8_GLOAD(gc0, gc1, cur);
        PG8_STAGE(PG8_SB(0, 0), cB, voffB); PG8_STAGE(PG8_SB(0, 1), cB + hstep, voffB); PG8_STAGE(PG8_SA(0, 0), cA, gc0); PG8_STAGE(PG8_SA(0, 1), cA, gc1);
        if (wr == 1) PG8_BAR;
        PG8_WAIT_V(2); PG8_BAR;
        PG8_STAGE(PG8_SB(1, 0), cB + kstep, voffB); PG8_STAGE(PG8_SA(1, 0), cA + kstep, gc0); PG8_STAGE(PG8_SB(1, 1), cB + hstep + kstep, voffB);
        } else {
        PG8_STAGE(PG8_SB(0, 0), cB, voffB); PG8_STAGE(PG8_SB(0, 1), cB + hstep, voffB); PG8_STAGE(PG8_SA(0, 0), cA, voffA); PG8_STAGE(PG8_SA(0, 1), cA + hstep, voffA);
        if (wr == 1) PG8_BAR;
        PG8_WAIT_V(2); PG8_BAR;
        PG8_STAGE(PG8_SB(1, 0), cB + kstep, voffB); PG8_STAGE(PG8_SA(1, 0), cA + kstep, voffA); PG8_STAGE(PG8_SB(1, 1), cB + hstep + kstep, voffB);
        }
        PG8_WAIT_V(6); PG8_BAR;
    } else {
        PG8_STAGE(PG8_SB(0, 0), cB, voffB); PG8_STAGE(PG8_SA(0, 0), cA, voffA); PG8_STAGE(PG8_SB(0, 1), cB + hstep, voffB); PG8_STAGE(PG8_SA(0, 1), cA + hstep, voffA);
        if (wr == 1) PG8_BAR;
        PG8_WAIT_V(4); PG8_BAR;
        PG8_STAGE(PG8_SB(1, 0), cB + kstep, voffB); PG8_STAGE(PG8_SA(1, 0), cA + kstep, voffA); PG8_STAGE(PG8_SB(1, 1), cB + hstep + kstep, voffB);
        PG8_WAIT_V(6); PG8_BAR;
    }
    for (;;) {
        const bool has_next = S.next(ui + 1, nxt);
        const char* nA = has_next ? S.a_ptr(nxt) : cA; const char* nB = has_next ? S.b_ptr(nxt) : cB;
        for (int t = 0; t < nt; t += 2) {
            const bool last = (t == nt - 2);
            const char* a1 = cA + (size_t)(t + 1) * kstep;
            const char* a2 = last ? nA : cA + (size_t)(t + 2) * kstep; const char* b2 = last ? nB : cB + (size_t)(t + 2) * kstep;
            const char* a3 = a2 + kstep; const char* b3 = b2 + kstep;
            if (last && has_next) S.a_ready(nxt);

            if constexpr (SP2) {
            PG8_LDB(B0, 0, 0); PG8_LDB(B1, 0, 1); PG8_SCHED; PG8_LDA(At, 0, 0); if constexpr (Sched::GATHER) PG8_STAGE(PG8_SA(1, 1), a1, gc1); else PG8_STAGE(PG8_SA(1, 1), a1 + hstep, voffA);
            if constexpr (Sched::GATHER) { if (last && has_next) PG8_GLOAD(gc0, gc1, nxt); }
            PG8_WAIT_V(8); PG8_WAIT_L(0); PG8_BAR; PG8_MMA(0, 0, At, B0); PG8_MMA(0, 1, At, B1); PG8_BAR; PG8_SCHED;
            PG8_LDA(At, 0, 1); PG8_STAGE(PG8_SB(0, 0), b2, voffB); PG8_STAGE(PG8_SB(0, 1), b2 + hstep, voffB); if constexpr (Sched::GATHER) PG8_STAGE(PG8_SA(0, 0), a2, gc0); else PG8_STAGE(PG8_SA(0, 0), a2, voffA);
            PG8_WAIT_V(8); PG8_WAIT_L(0); PG8_BAR; PG8_MMA(1, 0, At, B0); PG8_MMA(1, 1, At, B1); PG8_BAR; PG8_SCHED;
            PG8_LDB(B0, 1, 0); PG8_LDB(B1, 1, 1); PG8_SCHED; PG8_LDA(At, 1, 0); if constexpr (Sched::GATHER) PG8_STAGE(PG8_SA(0, 1), a2, gc1); else PG8_STAGE(PG8_SA(0, 1), a2 + hstep, voffA);
            PG8_WAIT_V(8); PG8_WAIT_L(0); PG8_BAR; PG8_MMA(0, 0, At, B0); PG8_MMA(0, 1, At, B1); PG8_BAR; PG8_SCHED;
            PG8_LDA(At, 1, 1); PG8_STAGE(PG8_SB(1, 0), b3, voffB); PG8_STAGE(PG8_SB(1, 1), b3 + hstep, voffB); if constexpr (Sched::GATHER) PG8_STAGE(PG8_SA(1, 0), a3, gc0); else PG8_STAGE(PG8_SA(1, 0), a3, voffA);
            PG8_WAIT_V(8); PG8_WAIT_L(0); PG8_BAR; PG8_MMA(1, 0, At, B0); PG8_MMA(1, 1, At, B1); PG8_BAR; PG8_SCHED;
            } else {
            PG8_LDB(B0, 0, 0); PG8_SCHED; PG8_LDA(At, 0, 0); PG8_STAGE(PG8_SA(1, 1), a1 + hstep, voffA);
            PG8_WAIT_L(8); PG8_BAR; PG8_WAIT_L(0); PG8_MMA(0, 0, At, B0); PG8_BAR; PG8_SCHED;
            PG8_LDB(B1, 0, 1); PG8_STAGE(PG8_SB(0, 0), b2, voffB);
            PG8_BAR; PG8_WAIT_L(0); PG8_MMA(0, 1, At, B1); PG8_BAR;
            PG8_LDA(At, 0, 1); PG8_STAGE(PG8_SA(0, 0), a2, voffA);
            PG8_BAR; PG8_WAIT_L(0); PG8_MMA(1, 0, At, B0); PG8_BAR; PG8_SCHED;
            PG8_STAGE(PG8_SB(0, 1), b2 + hstep, voffB);
            PG8_WAIT_V(6); PG8_BAR; PG8_MMA(1, 1, At, B1); PG8_BAR;
            PG8_LDB(B0, 1, 0); PG8_SCHED; PG8_LDA(At, 1, 0); PG8_STAGE(PG8_SA(0, 1), a2 + hstep, voffA);
            PG8_WAIT_L(8); PG8_BAR; PG8_WAIT_L(0); PG8_MMA(0, 0, At, B0); PG8_BAR; PG8_SCHED;
            PG8_LDB(B1, 1, 1); PG8_STAGE(PG8_SB(1, 0), b3, voffB);
            PG8_BAR; PG8_WAIT_L(0); PG8_MMA(0, 1, At, B1); PG8_BAR;
            PG8_LDA(At, 1, 1); PG8_STAGE(PG8_SA(1, 0), a3, voffA);
            PG8_BAR; PG8_WAIT_L(0); PG8_MMA(1, 0, At, B0); PG8_BAR; PG8_SCHED;
            PG8_STAGE(PG8_SB(1, 1), b3 + hstep, voffB);
            PG8_WAIT_V(6); PG8_BAR; PG8_MMA(1, 1, At, B1); PG8_BAR;
            }
        }
        if constexpr (ALIGN_EPI) { if (wr == 0) PG8_BAR; }
        if constexpr (!Epi::AFTER_DRAIN) { int fr_e = fr, fq_e = fq; asm volatile("" : "+v"(fr_e), "+v"(fq_e));
            E(acc, cur, wr, wc, fr_e, fq_e); S.done(cur); }
        if (!has_next) break;
#pragma unroll
        for (int a = 0; a < 2; ++a)
#pragma unroll
            for (int b = 0; b < 2; ++b)
#pragma unroll
                for (int m = 0; m < 4; ++m)
#pragma unroll
                    for (int n = 0; n < 2; ++n) acc[a][b][m][n] = (f32x4){0.f, 0.f, 0.f, 0.f};
        cur = nxt; cA = nA; cB = nB; ++ui;
        if constexpr (ALIGN_EPI) { if (wr == 1) PG8_BAR; }
    }
    PG8_WAIT_V(0);
    if constexpr (!ALIGN_EPI) { if (wr == 0) PG8_BAR; }
    PG8_BAR;
    if constexpr (Epi::AFTER_DRAIN) { E.fused(acc, cur, wr, wc, fr, fq, lds, wid, lane); S.done(cur); }
#undef PG8_GLOAD
#undef PG8_SA
#undef PG8_SB
#undef PG8_STAGE
#undef PG8_LDA
#undef PG8_LDB
#undef PG8_MMA
#undef PG8_WAIT_V
#undef PG8_WAIT_L
#undef PG8_BAR
#undef PG8_SCHED
}
}

constexpr size_t MiB = 1u << 20;
constexpr size_t WS_CTL = 0, CTL_ZERO_BYTES = 1 * MiB;
constexpr size_t WS_MOD  = 1 * MiB;
constexpr size_t WS_WRT  = 2 * MiB;
constexpr size_t WS_MOEI = 3 * MiB;
constexpr size_t WS_LRC  = 6 * MiB;
constexpr size_t WS_DNS  = 12 * MiB;
constexpr size_t WS_WIN  = 16 * MiB;
constexpr size_t WS_WOUT = 56 * MiB;
constexpr size_t WS_WGU  = 72 * MiB;
constexpr size_t WS_WDN  = 584 * MiB;
constexpr size_t WS_X    = 840 * MiB;
constexpr size_t WS_H    = 976 * MiB;
constexpr size_t WS_P    = 1044 * MiB;
constexpr size_t WS_CC   = 1206 * MiB;
constexpr size_t WS_VT   = 1274 * MiB;
constexpr size_t WS_VTC  = WS_VT + 8 * MiB;
constexpr size_t WS_DNT  = 1284 * MiB;
constexpr size_t DNT_BYTES = 90112;
constexpr size_t WS_DNO  = 1472 * MiB;
constexpr size_t WS_LRH  = 1540 * MiB;
constexpr size_t WS_LRA  = 1608 * MiB;
constexpr size_t WS_XS   = 1676 * MiB;
constexpr size_t WS_ACT  = 1980 * MiB;
constexpr size_t WS_YS   = 2132 * MiB;
constexpr size_t WS_END  = 2436 * MiB;
constexpr int CW_TMO = 0;
constexpr int CW_BAR = 4096;
constexpr int CW_CNT = 8192;
constexpr int CW_ATQ = 12288;

constexpr int RING_OFF = 0, RING_BYTES = 131072;
constexpr int LDSCTL_OFF = RING_BYTES, MISC_OFF = LDSCTL_OFF + 320;
constexpr int LDS_X_OFF = RING_BYTES + 1024;
constexpr int LDS_BYTES = 147456;
constexpr int NWAVES = 8, NTHREADS = 512;

#define GAS __attribute__((address_space(1)))
#define LAS __attribute__((address_space(3)))
typedef unsigned short bf16;
typedef unsigned v4u __attribute__((ext_vector_type(4)));
typedef unsigned v2u __attribute__((ext_vector_type(2)));
typedef float f32x4 __attribute__((ext_vector_type(4)));
typedef float f32x16 __attribute__((ext_vector_type(16)));
typedef short bf16x8 __attribute__((ext_vector_type(8)));
typedef short bf16x4 __attribute__((ext_vector_type(4)));
typedef GAS unsigned gu32;
#define RLX_AGENT __ATOMIC_RELAXED, __HIP_MEMORY_SCOPE_AGENT
#define LDS_WAIT() asm volatile("s_waitcnt lgkmcnt(0)" ::: "memory")
#define VM_WAIT() asm volatile("s_waitcnt vmcnt(0)" ::: "memory")
__device__ __forceinline__ unsigned f2bf(float f) { unsigned u = __builtin_bit_cast(unsigned, f); return (u + 0x7fffu + ((u >> 16) & 1u)) >> 16; }
__device__ __forceinline__ unsigned pk2(float lo, float hi) { return pg8::cvt_pk_bf16(lo, hi); }
__device__ __forceinline__ float bf2f(unsigned short b) { return __builtin_bit_cast(float, (unsigned)b << 16); }
__device__ __forceinline__ float bflo(unsigned w) { return __builtin_bit_cast(float, w << 16); }
__device__ __forceinline__ float bfhi(unsigned w) { return __builtin_bit_cast(float, w & 0xffff0000u); }
template <int CTRL> __device__ __forceinline__ float dpp_mov(float v) { return __builtin_bit_cast(float, __builtin_amdgcn_update_dpp(0, __builtin_bit_cast(int, v), CTRL, 0xF, 0xF, false)); }
__device__ __forceinline__ float wave_sum(float v) {
    v += dpp_mov<0xB1>(v); v += dpp_mov<0x4E>(v); v += dpp_mov<0x141>(v); v += dpp_mov<0x140>(v);
    const int iv = __builtin_bit_cast(int, v);
    const float r0 = __builtin_bit_cast(float, __builtin_amdgcn_readlane(iv, 0)), r1 = __builtin_bit_cast(float, __builtin_amdgcn_readlane(iv, 16)), r2 = __builtin_bit_cast(float, __builtin_amdgcn_readlane(iv, 32)), r3 = __builtin_bit_cast(float, __builtin_amdgcn_readlane(iv, 48));
    return (r0 + r1) + (r2 + r3);
}
__device__ __forceinline__ float sigmoidf_(float x) { return 1.0f / (1.0f + __expf(-x)); }
__device__ __forceinline__ float siluf_(float x) { return x / (1.0f + __expf(-x)); }
__device__ __forceinline__ float softplusf_(float x) { return x > 20.f ? x : log1pf(__expf(x)); }

#define XB_TMO      128
#define XB_XCNT(j)  (256  + 64 * (j))
#define XB_XSUB(j)  (1280 + 64 * (j))
#define XB_XGEN(j)  (2304 + 64 * (j))
#define XB_TOP      3328
#define XB_TOPGEN   3392
#define XCD_BAR_WORDS 3456
#define XB_SPIN_CAP (1u << 18)

__device__ __forceinline__ unsigned xb_ld(unsigned* p)              { return __hip_atomic_load(p, __ATOMIC_RELAXED, __HIP_MEMORY_SCOPE_AGENT); }
__device__ __forceinline__ unsigned xb_add(unsigned* p, unsigned v) { return __hip_atomic_fetch_add(p, v, __ATOMIC_RELAXED, __HIP_MEMORY_SCOPE_AGENT); }
__device__ __forceinline__ unsigned xb_xcc_id() { return (unsigned)__builtin_amdgcn_s_getreg((3 << 11) | 20) & 0xFu; }
#define XB_SPIN(cond, bar) do { unsigned _sp = 0; while (cond) { __builtin_amdgcn_s_sleep(1); \
    if ((++_sp & 255u) == 0u) { if (xb_ld(&(bar)[XB_TMO])) break; if (_sp > XB_SPIN_CAP) { atomicAdd(&(bar)[XB_TMO], 1u); break; } } } } while (0)

struct XcdBarrier {
    unsigned* bar; unsigned x;
    volatile LAS unsigned* st;
};

__device__ __forceinline__ XcdBarrier xcd_barrier_post(unsigned* bar, volatile LAS unsigned* st) {
    XcdBarrier b; b.bar = bar; b.x = xb_xcc_id(); b.st = st;
    if (threadIdx.x == 0) (void)xb_add(&bar[XB_XCNT(b.x)], 1u);
    return b;
}
__device__ __forceinline__ void xcd_barrier_complete(unsigned* bar, unsigned x, unsigned& nloc, unsigned& nx) {
    const unsigned G = gridDim.x * gridDim.y * gridDim.z;
    unsigned sum, cnt, mine, sp = 0u;
    for (;;) {
        sum = 0u; cnt = 0u; mine = 0u;
#pragma unroll
        for (unsigned j = 0; j < 16; ++j) { const unsigned c = xb_ld(&bar[XB_XCNT(j)]); sum += c; cnt += (c > 0u) ? 1u : 0u; mine = (j == x) ? c : mine; }
        if (sum == G) break;
        __builtin_amdgcn_s_sleep(1);
        if ((++sp & 255u) == 0u) { if (xb_ld(&bar[XB_TMO])) break; if (sp > XB_SPIN_CAP) { atomicAdd(&bar[XB_TMO], 1u); break; } }
    }
    nloc = mine > 0u ? mine : 1u; nx = cnt > 0u ? cnt : 1u;
}

__device__ __forceinline__ void xcd_barrier(const XcdBarrier& b) {
    asm volatile("s_waitcnt vmcnt(0)" ::: "memory");
    __syncthreads();
    if (threadIdx.x == 0) {
        unsigned* bar = b.bar;
        __builtin_amdgcn_s_waitcnt(0);
        unsigned nloc = b.st[0], nx = b.st[1];
        if (nloc == 0u) { xcd_barrier_complete(bar, b.x, nloc, nx); b.st[0] = nloc; b.st[1] = nx; }
        const unsigned old = xb_add(&bar[XB_XSUB(b.x)], 1u);
        const unsigned gen = old / nloc;
        if (old + 1u == (gen + 1u) * nloc) {
            __builtin_amdgcn_fence(__ATOMIC_RELEASE, "agent");
            asm volatile("s_waitcnt vmcnt(0)" ::: "memory");
            const unsigned og = xb_add(&bar[XB_TOP], 1u);
            const unsigned tg = og / nx;
            if (og + 1u == (tg + 1u) * nx) xb_add(&bar[XB_TOPGEN], 1u);
            else XB_SPIN(xb_ld(&bar[XB_TOPGEN]) == tg, bar);
            __builtin_amdgcn_fence(__ATOMIC_ACQUIRE, "agent");
            xb_add(&bar[XB_XGEN(b.x)], 1u);
            asm volatile("s_waitcnt vmcnt(0)" ::: "memory");
        } else {
            XB_SPIN(xb_ld(&bar[XB_XGEN(b.x)]) == gen, bar);
            __builtin_amdgcn_fence(__ATOMIC_ACQUIRE, "agent");
            asm volatile("s_waitcnt vmcnt(0)" ::: "memory");
        }
    }
    __syncthreads();
}

enum InIdx { I_X = 0, I_C, I_CTX, I_CCTX, I_WMOD, I_BMOD, I_NMG, I_NFG, I_WIN, I_WOUT, I_SINK, I_DNCW, I_DNALOG, I_DNDT, I_DNNG, I_LRCW, I_LRCB, I_LRWR, I_LRBR, I_LRWI, I_LRBI, I_LRLAM,
             I_WROUT, I_BROUT, I_WGU, I_BGU, I_WDN, I_BDN, I_FNG, N_IN };
struct Frame {
    LAS unsigned char* lds;
    volatile LAS unsigned* MISC;
    gu32* ctl;
    int tid, lane, wave, G, bid;
    const float* const __attribute__((address_space(4)))* in;
    float* out; unsigned char* ws;
};
__device__ __forceinline__ int mod_row(int m) { return m < NLAT ? (m >> 12) : 4; }
__device__ __forceinline__ bool phase_enter(Frame& F) { int t = threadIdx.x; asm volatile("" : "+v"(t)); F.tid = t; F.lane = t & 63; F.wave = __builtin_amdgcn_readfirstlane(t >> 6); return true; }
__device__ __forceinline__ void seq_of(int m, int& t, int& T, int& base) { if (m < NLAT) { t = m & 4095; T = SEQ; base = m - t; } else { t = (m - NLAT) & 255; T = CTXL; base = m - t; } }
__device__ __forceinline__ float gelu_tanh(float x) { const float u = 0.7978845608028654f * (x + 0.044715f * x * x * x); return 0.5f * x * (1.0f + tanhf(u)); }

__device__ __forceinline__ void transpose_item(const float* W, int K, int N, bf16* WT, int k0, int dstrow0, int srccol0, int nvalid, LAS float* scr, int lane) {
    { const int c4 = (lane & 7) * 4, kr = lane >> 3; f32x4 v[8];
#pragma unroll
      for (int i = 0; i < 8; ++i) { v[i] = (f32x4){0.f, 0.f, 0.f, 0.f}; if (c4 < nvalid) v[i] = *(const f32x4*)(W + (size_t)(k0 + 8 * i + kr) * N + srccol0 + c4); }
#pragma unroll
      for (int i = 0; i < 8; ++i) { LAS float* d = scr + (8 * i + kr) * 33 + c4; d[0] = v[i].x; d[1] = v[i].y; d[2] = v[i].z; d[3] = v[i].w; } }
    LDS_WAIT(); asm volatile("" ::: "memory");
    const int c = lane & 7;
#pragma unroll
    for (int jj = 0; jj < 4; ++jj) { const int n = (lane >> 3) + 8 * jj; const LAS float* s = scr + (8 * c) * 33 + n;
        v4u o; o.x = pk2(s[0 * 33], s[1 * 33]); o.y = pk2(s[2 * 33], s[3 * 33]); o.z = pk2(s[4 * 33], s[5 * 33]); o.w = pk2(s[6 * 33], s[7 * 33]);
        *(GAS v4u*)(WT + (size_t)(dstrow0 + n) * K + k0 + 8 * c) = o; }
    LDS_WAIT(); asm volatile("" ::: "memory");
}
__device__ __forceinline__ void p0_prologue(Frame& F) {
    {
        LAS float* sc = (LAS float*)(F.lds);
        LAS float* red = (LAS float*)(F.lds + 40960);
        bool have_sc = false;
        for (int wb = F.bid; wb < 192; wb += F.G) {
            if (!have_sc) {
                for (int i = F.tid; i < 5 * 2048; i += NTHREADS) { const int r = i >> 11, k = i & 2047; const float cv = r < 4 ? F.in[I_C][r * 2048 + k] : F.in[I_CCTX][k]; sc[i] = siluf_(cv); }
                have_sc = true; __syncthreads();
            }
            const int l = wb / 96, cb = wb % 96, kp = F.tid >> 5, cg = F.tid & 31, j0 = cb * 128 + cg * 4;
            const float* wp = F.in[I_WMOD] + ((size_t)l * 2048 + kp * 128) * 12288 + j0;
            f32x4 acc[5];
#pragma unroll
            for (int r = 0; r < 5; ++r) acc[r] = (f32x4){0.f, 0.f, 0.f, 0.f};
#pragma unroll 4
            for (int k = 0; k < 128; ++k) { const f32x4 w = *(const f32x4*)(wp + (size_t)k * 12288);
#pragma unroll
                for (int r = 0; r < 5; ++r) acc[r] += sc[r * 2048 + kp * 128 + k] * w; }
#pragma unroll
            for (int r = 0; r < 5; ++r) *(LAS f32x4*)(red + (kp * 5 + r) * 128 + cg * 4) = acc[r];
            __syncthreads();
            for (int i = F.tid; i < 640; i += NTHREADS) { const int r = i >> 7, col = i & 127; float s = F.in[I_BMOD][l * 12288 + cb * 128 + col];
#pragma unroll
                for (int q = 0; q < 16; ++q) s += red[(q * 5 + r) * 128 + col];
                ((float*)(F.ws + WS_MOD))[(size_t)(l * 5 + r) * 12288 + cb * 128 + col] = s; }
            __syncthreads();
        }
        __syncthreads();
    }
    {
        LAS float* scr = (LAS float*)(F.lds + F.wave * 16384);
        const int gw = F.bid * NWAVES + F.wave, NGW = F.G * NWAVES;
        constexpr int I_IN = 32 * 152, I_OUT = 32 * 64, I_RT = 32, PER_L = I_IN + I_OUT + I_RT;
        for (int it0 = gw; it0 < 2 * PER_L; it0 += NGW) {
            const int l = it0 / PER_L; int r = it0 % PER_L;
            if (r < I_IN) { const int nb = r % 152, kb = r / 152, d0 = nb * 32; int s0 = d0, nv = 32;
                if (d0 >= 4640) nv = 0; else if (d0 == 4608) { s0 = 3584; nv = 16; } else if (d0 >= 3584) s0 = d0 + 16;
                transpose_item(F.in[I_WIN] + (size_t)l * 2048 * IN_W, 2048, IN_W, (bf16*)(F.ws + WS_WIN) + (size_t)l * PW * 2048, kb * 64, d0, s0, nv, scr, F.lane); continue; }
            r -= I_IN;
            if (r < I_OUT) { const int nb = r % 64, kb = r / 64;
                transpose_item(F.in[I_WOUT] + (size_t)l * 2048 * 2048, 2048, 2048, (bf16*)(F.ws + WS_WOUT) + (size_t)l * 2048 * 2048, kb * 64, nb * 32, nb * 32, 32, scr, F.lane); continue; }
            r -= I_OUT;
            transpose_item(F.in[I_WROUT] + (size_t)l * 2048 * 32, 2048, 32, (bf16*)(F.ws + WS_WRT) + (size_t)l * 32 * 2048, r * 64, 0, 0, 32, scr, F.lane);
        }
    }
}
constexpr int CW_CVQ = 12288 + 512;
__device__ __forceinline__ void convert_moe_item(Frame& F, int l, int r, LAS float* scr) {
    constexpr int I_GU = 32 * 32 * 64;
    if (r < I_GU) { const int e = r / 2048, q = r % 2048, nb = q % 64, kb = q / 64; const int s0 = ((nb >> 2) & 1) * 1024 + (nb >> 3) * 128 + (nb & 3) * 32;
        transpose_item(F.in[I_WGU] + (size_t)(l * 32 + e) * 2048 * 2048, 2048, 2048, (bf16*)(F.ws + WS_WGU) + (size_t)(l * 32 + e) * 2048 * 2048, kb * 64, nb * 32, s0, 32, scr, F.lane); return; }
    r -= I_GU;
    { const int e = r / 1024, q = r % 1024, nb = q % 64, kb = q / 64;
        transpose_item(F.in[I_WDN] + (size_t)(l * 32 + e) * 1024 * 2048, 1024, 2048, (bf16*)(F.ws + WS_WDN) + (size_t)(l * 32 + e) * 2048 * 1024, kb * 64, nb * 32, nb * 32, 32, scr, F.lane); }
}
__device__ __forceinline__ void convert_moe_queue(Frame& F, int l, int rep = 0) {
    constexpr int NIT = 32 * 32 * 64 + 32 * 16 * 64;
    LAS float* scr = (LAS float*)(F.lds + F.wave * 16384);
    __syncthreads();
    for (;;) { int g = 0; if (F.lane == 0) g = (int)__hip_atomic_fetch_add(F.ctl + CW_CVQ + 64 * l + 8 * rep, 1u, RLX_AGENT); g = __builtin_amdgcn_readfirstlane(g);
        if (g * 8 >= NIT) break;
#pragma unroll 1
        for (int k = 0; k < 8; ++k) convert_moe_item(F, l, g * 8 + k, scr); }
    __syncthreads();
}

__device__ __forceinline__ void load_row(const float* src, int lane, f32x4 (&v)[8]) {
    const f32x4* p = (const f32x4*)src + lane;
#pragma unroll
    for (int j = 0; j < 8; ++j) v[j] = p[64 * j];
}
__device__ __forceinline__ void store_row(float* dst, int lane, const f32x4 (&v)[8]) {
    f32x4* p = (f32x4*)dst + lane;
#pragma unroll
    for (int j = 0; j < 8; ++j) p[64 * j] = v[j];
}
__device__ __forceinline__ void combine_row(Frame& F, int l, int m, int lane, f32x4 (&v)[8]) {
    const int* dest = (const int*)(F.ws + WS_MOEI + 2 * 512 * 1024) + m * 4;
    const float* g5 = (const float*)(F.ws + WS_MOD) + (size_t)(l * 5 + mod_row(m)) * 12288 + 5 * 2048;
    f32x4 acc[8];
#pragma unroll
    for (int j = 0; j < 8; ++j) acc[j] = (f32x4){0.f, 0.f, 0.f, 0.f};
#pragma unroll
    for (int k = 0; k < 4; ++k) { const int d = dest[k]; const v2u* yp = (const v2u*)((const bf16*)(F.ws + WS_YS) + (size_t)d * 2048) + lane;
#pragma unroll
        for (int j = 0; j < 8; ++j) { const v2u w = yp[64 * j]; acc[j] += (f32x4){bflo(w.x), bfhi(w.x), bflo(w.y), bfhi(w.y)}; } }
#pragma unroll
    for (int j = 0; j < 8; ++j) { const f32x4 gg = *((const f32x4*)g5 + lane + 64 * j); v[j] += gg * acc[j]; }
}
__device__ __forceinline__ void modnorm_store(const f32x4 (&v)[8], const float* g, const float* shift, const float* scale, bf16* hrow, int lane) {
    float ss = 0.f;
#pragma unroll
    for (int j = 0; j < 8; ++j) ss += (v[j].x * v[j].x + v[j].y * v[j].y) + (v[j].z * v[j].z + v[j].w * v[j].w);
    const float rstd = 1.0f / sqrtf(wave_sum(ss) * (1.0f / 2048.0f) + EPS);
    v2u* hp = (v2u*)hrow + lane;
#pragma unroll
    for (int j = 0; j < 8; ++j) { const f32x4 gg = *((const f32x4*)g + lane + 64 * j), sh = *((const f32x4*)shift + lane + 64 * j), sc = *((const f32x4*)scale + lane + 64 * j);
        const f32x4 y = (v[j] * rstd) * gg * (sc + 1.0f) + sh; v2u w; w.x = pk2(y.x, y.y); w.y = pk2(y.z, y.w); hp[64 * j] = w; }
}
__device__ __forceinline__ void phase_norm1(Frame& F, int l) {
    const int gw = F.bid * NWAVES + F.wave, NGW = F.G * NWAVES;
    float* X = (float*)(F.ws + WS_X); bf16* H = (bf16*)(F.ws + WS_H);
    const float* modp = (const float*)(F.ws + WS_MOD) + (size_t)l * 5 * 12288;
    for (int m = gw; m < NTOK; m += NGW) {
        f32x4 v[8];
        if (l == 0) load_row(m < NLAT ? F.in[I_X] + (size_t)m * DM : F.in[I_CTX] + (size_t)(m - NLAT) * DM, F.lane, v);
        else { load_row(X + (size_t)m * DM, F.lane, v); if (MK_STAGE >= 9) { combine_row(F, l - 1, m, F.lane, v); store_row(X + (size_t)m * DM, F.lane, v); } }
        const float* mr = modp + (size_t)mod_row(m) * 12288;
        modnorm_store(v, F.in[I_NMG] + l * DM, mr, mr + 2048, H + (size_t)m * DM, F.lane);
    }
}
__device__ __forceinline__ void phase_final(Frame& F, bool with_combine) {
    const int gw = F.bid * NWAVES + F.wave, NGW = F.G * NWAVES;
    const float* X = (const float*)(F.ws + WS_X);
    for (int m = gw; m < NLAT; m += NGW) {
        f32x4 v[8];
        if (with_combine) { load_row(X + (size_t)m * DM, F.lane, v); combine_row(F, 1, m, F.lane, v); }
        else load_row(F.in[I_X] + (size_t)m * DM, F.lane, v);
        float ss = 0.f;
#pragma unroll
        for (int j = 0; j < 8; ++j) ss += (v[j].x * v[j].x + v[j].y * v[j].y) + (v[j].z * v[j].z + v[j].w * v[j].w);
        const float rstd = 1.0f / sqrtf(wave_sum(ss) * (1.0f / 2048.0f) + EPS);
        f32x4* op = (f32x4*)(F.out + (size_t)m * DM) + F.lane;
#pragma unroll
        for (int j = 0; j < 8; ++j) { const f32x4 gg = *((const f32x4*)F.in[I_FNG] + F.lane + 64 * j); op[64 * j] = v[j] * rstd * gg; }
    }
}

__device__ __forceinline__ void phase_inproj(Frame& F, int l) {
    pg8::Gemm g{(const bf16*)(F.ws + WS_H), (const bf16*)(F.ws + WS_WIN) + (size_t)l * PW * 2048, NTOK, PW, 2048};
    pg8::StaticOrder S; S.init(g, F.G, F.bid);
    pg8::EpiBf16Plain E{(bf16*)(F.ws + WS_P), PW};
    pg8::gemm_phase<pg8::EpiBf16Plain, pg8::StaticOrder, true, true>(F.lds + RING_OFF, g, S, E);
}
__device__ __forceinline__ void phase_outproj(Frame& F, int l) {
    float* X = (float*)(F.ws + WS_X);
    pg8::Gemm g{(const bf16*)(F.ws + WS_CC), (const bf16*)(F.ws + WS_WOUT) + (size_t)l * 2048 * 2048, l == 0 ? NTOK : NLAT, 2048, 2048};
    pg8::StaticOrder S; S.init(g, F.G, F.bid);
    pg8::EpiResGate E{l == 0 ? F.in[I_X] : X, l == 0 ? F.in[I_CTX] : X + (size_t)NLAT * DM, X, (const float*)(F.ws + WS_MOD) + (size_t)l * 5 * 12288 + 2 * 2048};
    pg8::gemm_phase<pg8::EpiResGate, pg8::StaticOrder, true, true>(F.lds + RING_OFF, g, S, E);
}
#ifndef PHASE_INPROJ
#define PHASE_INPROJ(F, l) phase_inproj(F, l)
#endif
#ifndef PHASE_OUTPROJ
#define PHASE_OUTPROJ(F, l) phase_outproj(F, l)
#endif

constexpr size_t MOEI_TOPE = WS_MOEI, MOEI_TOPG = WS_MOEI + 512 * 1024, MOEI_DEST = WS_MOEI + 2 * 512 * 1024, MOEI_ROWG = WS_MOEI + 3 * 512 * 1024, MOEI_ROWT = WS_MOEI + 4 * 512 * 1024;
__device__ __forceinline__ void phase_norm2(Frame& F, int l) {
    const int nrows = (l == 0) ? NTOK : NLAT;
    constexpr int TROW = 4112;
    LAS unsigned char* tile = F.lds;
    LAS float* part = (LAS float*)(F.lds + 66048);
    LAS float* lg = (LAS float*)(F.lds + 66048 + 16384);
    const float* X = (const float*)(F.ws + WS_X); bf16* H = (bf16*)(F.ws + WS_H);
    const float* modp = (const float*)(F.ws + WS_MOD) + (size_t)l * 5 * 12288;
    const bf16* wrt = (const bf16*)(F.ws + WS_WRT) + (size_t)l * 32 * 2048;
    int* tope = (int*)(F.ws + MOEI_TOPE); float* topg = (float*)(F.ws + MOEI_TOPG);
    for (int r0 = F.bid * 16; r0 < nrows; r0 += F.G * 16) {
#pragma unroll 1
        for (int rr = 0; rr < 2; ++rr) {
            const int lr = 2 * F.wave + rr, m = r0 + lr;
            f32x4 v[8]; load_row(X + (size_t)m * DM, F.lane, v);
            float ss = 0.f;
#pragma unroll
            for (int j = 0; j < 8; ++j) ss += (v[j].x * v[j].x + v[j].y * v[j].y) + (v[j].z * v[j].z + v[j].w * v[j].w);
            const float rstd = 1.0f / sqrtf(wave_sum(ss) * (1.0f / 2048.0f) + EPS);
            const float* mr = modp + (size_t)mod_row(m) * 12288; const float* g = F.in[I_NFG] + l * DM;
            v2u* hp = (v2u*)(H + (size_t)m * DM) + F.lane; LAS v2u* tp = (LAS v2u*)(tile + lr * TROW) + F.lane;
#pragma unroll
            for (int j = 0; j < 8; ++j) { const f32x4 gg = *((const f32x4*)g + F.lane + 64 * j), sh = *((const f32x4*)(mr + 3 * 2048) + F.lane + 64 * j), sc = *((const f32x4*)(mr + 4 * 2048) + F.lane + 64 * j);
                const f32x4 y = (v[j] * rstd) * gg * (sc + 1.0f) + sh; v2u w; w.x = pk2(y.x, y.y); w.y = pk2(y.z, y.w); hp[64 * j] = w; tp[64 * j] = w; }
        }
        __syncthreads();
        {
            const int row = F.lane & 15, q = F.lane >> 4;
            f32x4 acc0 = {0.f, 0.f, 0.f, 0.f}, acc1 = {0.f, 0.f, 0.f, 0.f};
#pragma unroll
            for (int ks = 0; ks < 8; ++ks) { const int k0 = 256 * F.wave + 32 * ks + 8 * q;
                const bf16x8 a = *(const LAS bf16x8*)(tile + row * TROW + k0 * 2);
                const bf16x8 b0 = *(const bf16x8*)(wrt + (size_t)row * 2048 + k0), b1 = *(const bf16x8*)(wrt + (size_t)(16 + row) * 2048 + k0);
                acc0 = __builtin_amdgcn_mfma_f32_16x16x32_bf16(a, b0, acc0, 0, 0, 0); acc1 = __builtin_amdgcn_mfma_f32_16x16x32_bf16(a, b1, acc1, 0, 0, 0); }
#pragma unroll
            for (int i = 0; i < 4; ++i) { part[(F.wave * 16 + 4 * q + i) * 32 + row] = acc0[i]; part[(F.wave * 16 + 4 * q + i) * 32 + 16 + row] = acc1[i]; }
        }
        __syncthreads();
        { const int rw = F.tid >> 5, e = F.tid & 31; float s = F.in[I_BROUT][l * 32 + e];
#pragma unroll
          for (int w = 0; w < 8; ++w) s += part[(w * 16 + rw) * 32 + e];
          lg[rw * 32 + e] = s; }
        __syncthreads();
        if (F.tid < 16) { const int m = r0 + F.tid; float val[4]; int idx[4]; unsigned taken = 0u;
#pragma unroll
            for (int k = 0; k < 4; ++k) { float best = -3.0e38f; int bi = 0;
                for (int e = 0; e < 32; ++e) { const float x = lg[F.tid * 32 + e]; if (!((taken >> e) & 1u) && x > best) { best = x; bi = e; } }
                val[k] = best; idx[k] = bi; taken |= 1u << bi; }
            float p[4], sum = 0.f;
#pragma unroll
            for (int k = 0; k < 4; ++k) { p[k] = __expf(val[k] - val[0]); sum += p[k]; }
#pragma unroll
            for (int k = 0; k < 4; ++k) { const unsigned rank = __hip_atomic_fetch_add(F.ctl + CW_CNT + 64 * l + idx[k], 1u, RLX_AGENT);
                tope[m * 4 + k] = idx[k] | (int)(rank << 8); topg[m * 4 + k] = p[k] / sum; }
        }
        __syncthreads();
    }
}
__device__ __forceinline__ void moe_tables(Frame& F, int l) {
    LAS int* blk_end = (LAS int*)(F.lds + LDS_X_OFF); LAS int* pstart = blk_end + 32; LAS int* cnts = blk_end + 64;
    if (F.tid == 0) { int nb = 0;
        for (int e = 0; e < 32; ++e) { const int c = (int)__hip_atomic_load(F.ctl + CW_CNT + 64 * l + e, RLX_AGENT); cnts[e] = c; pstart[e] = nb * 256; nb += (c + 255) >> 8; blk_end[e] = nb; } }
    __syncthreads();
}
__device__ __forceinline__ void phase_scatter(Frame& F, int l) {
    const int nrows = (l == 0) ? NTOK : NLAT;
    moe_tables(F, l);
    const LAS int* blk_end = (const LAS int*)(F.lds + LDS_X_OFF); const LAS int* pstart = blk_end + 32; const LAS int* cnts = blk_end + 64;
    const int* tope = (const int*)(F.ws + MOEI_TOPE); const float* topg = (const float*)(F.ws + MOEI_TOPG);
    int* dest = (int*)(F.ws + MOEI_DEST); float* rowg = (float*)(F.ws + MOEI_ROWG); int* rowt = (int*)(F.ws + MOEI_ROWT);
    for (int a = F.bid * NTHREADS + F.tid; a < nrows * 4; a += F.G * NTHREADS) {
        const int te = tope[a], e = te & 255, rank = (int)((unsigned)te >> 8), d = pstart[e] + rank;
        dest[a] = d; rowg[d] = topg[a]; rowt[d] = a >> 2; }
    if (F.bid < 32) { const int e = F.bid, r0 = pstart[e] + cnts[e], r1 = blk_end[e] * 256;
        for (int r = r0 + F.tid; r < r1; r += NTHREADS) { rowt[r] = 0; rowg[r] = 0.f; } }
}
__device__ __forceinline__ void phase_gemm1(Frame& F, int l) {
    moe_tables(F, l);
    const LAS int* blk_end = (const LAS int*)(F.lds + LDS_X_OFF);
    pg8::Gemm g{(const bf16*)(F.ws + WS_H), (const bf16*)(F.ws + WS_WGU) + (size_t)l * 32 * 2048 * 2048, MOE_ROWS, 2048, 2048};
    pg8::MoeOrderG S{F.bid, __builtin_amdgcn_readfirstlane(blk_end[31]), (const char*)g.A, (const char*)g.Bt, (size_t)256 * 2048 * 2, (size_t)2048 * 2048 * 2, (size_t)256 * 2048 * 2, blk_end, (const int*)(F.ws + MOEI_ROWT)};
    pg8::EpiSwiglu E{(bf16*)(F.ws + WS_ACT), F.in[I_BGU] + (size_t)l * 32 * 2048};
    pg8::gemm_phase<pg8::EpiSwiglu, pg8::MoeOrderG, true, true>(F.lds + RING_OFF, g, S, E);
}
__device__ __forceinline__ void phase_gemm2(Frame& F, int l) {
    moe_tables(F, l);
    const LAS int* blk_end = (const LAS int*)(F.lds + LDS_X_OFF);
    pg8::Gemm g{(const bf16*)(F.ws + WS_ACT), (const bf16*)(F.ws + WS_WDN) + (size_t)l * 32 * 2048 * 1024, MOE_ROWS, 2048, 1024};
    pg8::MoeOrder S{F.bid, __builtin_amdgcn_readfirstlane(blk_end[31]), (const char*)g.A, (const char*)g.Bt, (size_t)256 * 1024 * 2, (size_t)2048 * 1024 * 2, (size_t)256 * 1024 * 2, blk_end, nullptr};
    pg8::EpiDown E{(bf16*)(F.ws + WS_YS), F.in[I_BDN] + (size_t)l * 32 * 2048, (const float*)(F.ws + MOEI_ROWG)};
    pg8::gemm_phase<pg8::EpiDown, pg8::MoeOrder, true, true>(F.lds + RING_OFF, g, S, E);
}
#ifndef PHASE_NORM2
#define PHASE_NORM2(F, l) phase_norm2(F, l)
#endif
#ifndef PHASE_SCATTER
#define PHASE_SCATTER(F, l) phase_scatter(F, l)
#endif
#ifndef PHASE_GEMM1
#define PHASE_GEMM1(F, l) phase_gemm1(F, l)
#endif
#ifndef PHASE_GEMM2
#define PHASE_GEMM2(F, l) phase_gemm2(F, l)
#endif
#define USE_MFMA_ATTN 1

__device__ __forceinline__ void attn_prep(Frame& F, int l) {
    bf16* P = (bf16*)(F.ws + WS_P);
    LAS unsigned short* vt = (LAS unsigned short*)F.lds;
    for (int ct = F.bid; ct < NCT; ct += F.G) {
        const int m0 = ct * 64; const bool lat = m0 < NLAT;
        __syncthreads();
        for (int i = F.tid; i < 64 * 32; i += NTHREADS) { const int tk = i >> 5, c8 = i & 31;
            const v4u w = *(const v4u*)(P + (size_t)(m0 + tk) * PW + PC_V + c8 * 8);
            const unsigned ww[4] = {w.x, w.y, w.z, w.w};
#pragma unroll
            for (int q = 0; q < 4; ++q) { vt[(c8 * 8 + 2 * q) * 66 + tk] = (unsigned short)(ww[q] & 0xffffu); vt[(c8 * 8 + 2 * q + 1) * 66 + tk] = (unsigned short)(ww[q] >> 16); } }
        if (lat) for (int i = F.tid; i < 64 * 128; i += NTHREADS) { const int tk = i >> 7, pi = i & 127, kvh = pi >> 5, hf = (pi >> 4) & 1, j = pi & 15; const int t = (m0 + tk) & 4095;
            bf16* kp = P + (size_t)(m0 + tk) * PW + PC_K + kvh * 64 + hf * 32 + j;
            const float x1 = bf2f(kp[0]), x2 = bf2f(kp[16]); const float pos = (float)(hf ? (t & 63) : (t >> 6)); const float inv = __builtin_amdgcn_exp2f(-(float)j * 0.8304820237218406f);
            const float sn = __sinf(pos * inv), cs = __cosf(pos * inv);
            kp[0] = (bf16)f2bf(x1 * cs - x2 * sn); kp[16] = (bf16)f2bf(x2 * cs + x1 * sn); }
        __syncthreads();
        for (int i = F.tid; i < 256 * 8; i += NTHREADS) { const int col = i >> 3, c = i & 7, kvh = col >> 6, d = col & 63;
            v4u o; const LAS unsigned short* s = vt + col * 66 + c * 8;
            o.x = s[0] | ((unsigned)s[1] << 16); o.y = s[2] | ((unsigned)s[3] << 16); o.z = s[4] | ((unsigned)s[5] << 16); o.w = s[6] | ((unsigned)s[7] << 16);
            if (lat) { const int b = m0 >> 12, t0 = m0 & 4095; *(v4u*)((bf16*)(F.ws + WS_VT) + ((size_t)(b * 4 + kvh) * 64 + d) * SEQ + t0 + c * 8) = o; }
            else { const int mm = m0 - NLAT, b = mm >> 8, t0 = mm & 255; *(v4u*)((bf16*)(F.ws + WS_VTC) + ((size_t)(b * 4 + kvh) * 64 + d) * CTXL + t0 + c * 8) = o; } }
    }
    __syncthreads();
}

constexpr int AT_KP = 144, AT_VP = 136;
constexpr int AT_KOFF = 0, AT_VOFF = 64 * AT_KP, AT_TILE = 64 * AT_KP + 64 * AT_VP;
__device__ __forceinline__ void attn_unit(Frame& F, int l, int b, int kvh, int qi, int is_ctx) {
    const bf16* P = (const bf16*)(F.ws + WS_P); bf16* CC = (bf16*)(F.ws + WS_CC);
    int lane_o = F.lane; asm volatile("" : "+v"(lane_o));
    const int g = F.wave >> 1, qh = F.wave & 1, hq = kvh * 4 + g, r32 = lane_o & 31, hi = lane_o >> 5;
    const int rowbase = is_ctx ? NLAT + b * CTXL : b * SEQ;
    const int qa = qi * 128 + qh * 64;
    const float LOG2E = 1.4426950408889634f;
    bf16x8 qf[2][4];
#pragma unroll
    for (int qt = 0; qt < 2; ++qt) { const int tq = qa + 32 * qt + r32; const bf16* qp = P + (size_t)(rowbase + tq) * PW + PC_Q + hq * 64 + 8 * hi;
        float x[4][8];
#pragma unroll
        for (int s = 0; s < 4; ++s) { const v4u w = *(const v4u*)(qp + 16 * s); x[s][0] = bflo(w.x); x[s][1] = bfhi(w.x); x[s][2] = bflo(w.y); x[s][3] = bfhi(w.y); x[s][4] = bflo(w.z); x[s][5] = bfhi(w.z); x[s][6] = bflo(w.w); x[s][7] = bfhi(w.w); }
        if (!is_ctx) {
#pragma unroll
            for (int hf = 0; hf < 2; ++hf) { const float pos = (float)(hf ? (tq & 63) : (tq >> 6));
#pragma unroll
                for (int j = 0; j < 8; ++j) { const float inv = __builtin_amdgcn_exp2f(-(float)(8 * hi + j) * 0.8304820237218406f); const float sn = __sinf(pos * inv), cs = __cosf(pos * inv);
                    const float x1 = x[2 * hf][j], x2 = x[2 * hf + 1][j]; x[2 * hf][j] = x1 * cs - x2 * sn; x[2 * hf + 1][j] = x2 * cs + x1 * sn; } } }
        const float sc = 0.125f * LOG2E;
#pragma unroll
        for (int s = 0; s < 4; ++s) { v4u w; w.x = pk2(x[s][0] * sc, x[s][1] * sc); w.y = pk2(x[s][2] * sc, x[s][3] * sc); w.z = pk2(x[s][4] * sc, x[s][5] * sc); w.w = pk2(x[s][6] * sc, x[s][7] * sc); qf[qt][s] = __builtin_bit_cast(bf16x8, w); }
    }
    float mrun[2], lrun[2]; f32x16 O[2][2];
    { const float sk = F.in[I_SINK][l * 16 + hq] * LOG2E;
#pragma unroll
      for (int qt = 0; qt < 2; ++qt) { mrun[qt] = sk; lrun[qt] = hi ? 0.f : 1.f;
#pragma unroll
        for (int db = 0; db < 2; ++db)
#pragma unroll
            for (int r = 0; r < 16; ++r) O[qt][db][r] = 0.f; } }
    const int ntl = is_ctx ? 0 : 6;
#pragma unroll 1
    for (int kt = 0; kt < ntl + 4; ++kt) {
        const bool local = kt < ntl; const int k0 = local ? 128 * (qi - 1) + 64 * kt : 64 * (kt - ntl);
        if (local && (k0 < 0 || k0 >= SEQ)) continue;
        __syncthreads();
        { const int rr = F.tid >> 3, c = F.tid & 7;
          const bf16* ksrc = P + (size_t)((local ? b * SEQ : NLAT + b * CTXL) + k0 + rr) * PW + PC_K + kvh * 64 + c * 8;
          const bf16* vsrc = local ? (const bf16*)(F.ws + WS_VT) + ((size_t)(b * 4 + kvh) * 64 + rr) * SEQ + k0 + c * 8 : (const bf16*)(F.ws + WS_VTC) + ((size_t)(b * 4 + kvh) * 64 + rr) * CTXL + k0 + c * 8;
          const v4u kw = *(const v4u*)ksrc, vw = *(const v4u*)vsrc;
          *(LAS v4u*)(F.lds + AT_KOFF + rr * AT_KP + c * 16) = kw;
          LAS v2u* vd = (LAS v2u*)(F.lds + AT_VOFF + rr * AT_VP + c * 16); vd[0] = (v2u){vw.x, vw.y}; vd[1] = (v2u){vw.z, vw.w}; }
        __syncthreads();
        if (local && (k0 + 63 < qa - 128 || k0 > qa + 63 + 128)) continue;
#pragma unroll 1
        for (int kb = 0; kb < 2; ++kb) {
            bf16x8 kf[4];
#pragma unroll
            for (int ss = 0; ss < 4; ++ss) kf[ss] = *(const LAS bf16x8*)(F.lds + AT_KOFF + (32 * kb + r32) * AT_KP + (16 * ss + 8 * hi) * 2);
            bf16x8 pb[2][2];
#pragma unroll
            for (int qt = 0; qt < 2; ++qt) { const int tq = qa + 32 * qt + r32;
                f32x16 s;
#pragma unroll
                for (int r = 0; r < 16; ++r) s[r] = 0.f;
#pragma unroll
                for (int ss = 0; ss < 4; ++ss) s = __builtin_amdgcn_mfma_f32_32x32x16_bf16(kf[ss], qf[qt][ss], s, 0, 0, 0);
                if (local) {
#pragma unroll
                    for (int r = 0; r < 16; ++r) { const int kidx = k0 + 32 * kb + (r & 3) + 8 * (r >> 2) + 4 * hi; const int dlt = kidx - tq; if (dlt > 128 || dlt < -128) s[r] = -1.0e30f; } }
                float mloc = s[0];
#pragma unroll
                for (int r = 1; r < 16; ++r) mloc = fmaxf(mloc, s[r]);
                mloc = fmaxf(mloc, __shfl_xor(mloc, 32));
                const float mnew = fmaxf(mrun[qt], mloc), alpha = __builtin_amdgcn_exp2f(mrun[qt] - mnew); mrun[qt] = mnew;
                float psum = 0.f;
#pragma unroll
                for (int r = 0; r < 16; ++r) { s[r] = __builtin_amdgcn_exp2f(s[r] - mnew); psum += s[r]; }
                lrun[qt] = lrun[qt] * alpha + psum;
#pragma unroll
                for (int db = 0; db < 2; ++db)
#pragma unroll
                    for (int r = 0; r < 16; ++r) O[qt][db][r] *= alpha;
#pragma unroll
                for (int s2 = 0; s2 < 2; ++s2) { v4u pw; pw.x = pk2(s[8 * s2 + 0], s[8 * s2 + 1]); pw.y = pk2(s[8 * s2 + 2], s[8 * s2 + 3]); pw.z = pk2(s[8 * s2 + 4], s[8 * s2 + 5]); pw.w = pk2(s[8 * s2 + 6], s[8 * s2 + 7]);
                    pb[qt][s2] = __builtin_bit_cast(bf16x8, pw); }
            }
#pragma unroll
            for (int s2 = 0; s2 < 2; ++s2)
#pragma unroll
                for (int db = 0; db < 2; ++db) { const LAS v2u* vp = (const LAS v2u*)(F.lds + AT_VOFF + (32 * db + r32) * AT_VP + (32 * kb + 16 * s2 + 4 * hi) * 2);
                    const v2u a0 = vp[0], a1 = vp[2]; v4u aw; aw.x = a0.x; aw.y = a0.y; aw.z = a1.x; aw.w = a1.y; const bf16x8 va = __builtin_bit_cast(bf16x8, aw);
                    O[0][db] = __builtin_amdgcn_mfma_f32_32x32x16_bf16(va, pb[0][s2], O[0][db], 0, 0, 0);
                    O[1][db] = __builtin_amdgcn_mfma_f32_32x32x16_bf16(va, pb[1][s2], O[1][db], 0, 0, 0); }
        }
    }
    int r32e = r32, hie = hi; asm volatile("" : "+v"(r32e), "+v"(hie));
#pragma unroll
    for (int qt = 0; qt < 2; ++qt) { const float lt = lrun[qt] + __shfl_xor(lrun[qt], 32); const float rl = 1.0f / lt; const int tq = qa + 32 * qt + r32e;
        bf16* op = CC + (size_t)(rowbase + tq) * DM + hq * 64 + 4 * hie;
#pragma unroll
        for (int db = 0; db < 2; ++db)
#pragma unroll
            for (int rq = 0; rq < 4; ++rq) { v2u w; w.x = pk2(O[qt][db][4 * rq] * rl, O[qt][db][4 * rq + 1] * rl); w.y = pk2(O[qt][db][4 * rq + 2] * rl, O[qt][db][4 * rq + 3] * rl);
                *(v2u*)(op + 32 * db + 8 * rq) = w; } }
}
__device__ __forceinline__ void attn_phase(Frame& F, int l, int rep = 0) {
    const int nunits = 512 + (l == 0 ? 32 : 0);
    LAS int* slot = (LAS int*)(F.lds + LDS_X_OFF + 512);
    for (;;) {
        __syncthreads();
        if (F.tid == 0) *slot = (int)__hip_atomic_fetch_add(F.ctl + CW_ATQ + 64 * l + 8 * rep, 1u, RLX_AGENT);
        __syncthreads();
        const int u = __builtin_amdgcn_readfirstlane(*slot);
        if (u >= nunits) break;
        if (u < 512) attn_unit(F, l, u >> 7, (u >> 5) & 3, u & 31, 0); else { const int v = u - 512; attn_unit(F, l, v >> 3, (v >> 1) & 3, v & 1, 1); }
    }
}
#define USE_CHUNK_DN 1
#ifndef DN_REP_S1
#define DN_REP_S1 1
#endif
#ifndef DN_REP_S3B
#define DN_REP_S3B 1
#endif
#ifndef DN_REP_S3A
#define DN_REP_S3A 1
#endif
#ifndef DN_REP_S4
#define DN_REP_S4 1
#endif

constexpr int DN_F_NEGW = 0, DN_F_QG = 16, DN_F_QK = 32, DN_F_KGT = 40, DN_NFRAG = 56, DN_U_OFF = 57344;
constexpr int DP_QS = 0, DP_KS = 17408, DP_VS = 34816, DP_AS = 52224  , DP_TB = 69632, DP_TW = 78848, DP_QK = 88064, DP_RAW = 52224  , DP_SC = 104960, DP_TF = 106496  , DP_XS = 123904  ;
constexpr int DP_P = 272, DP_P2 = 144;
__device__ __forceinline__ int dn_rec(int b, int h, int dir, int np) { return ((b * 4 + h) * 2 + dir) * 68 + np; }
__device__ __forceinline__ void dn_chunk_of(int ct, int dir, int& b, int& np) { if (ct < 256) { b = ct >> 6; const int c = ct & 63; np = 4 + (dir ? 63 - c : c); } else { b = (ct - 256) >> 2; const int c = (ct - 256) & 3; np = dir ? 3 - c : c; } }
__device__ __forceinline__ unsigned short lds_u16(const LAS unsigned char* p) { return *(const LAS unsigned short*)p; }

__device__ __forceinline__ void dn_prep_unit(Frame& F, int l, int ct, int h, int dir) {
    const bf16* P = (const bf16*)(F.ws + WS_P);
    int lane = F.lane; asm volatile("" : "+v"(lane));
    const int wave = F.wave, i16 = lane & 15, q = lane >> 4;
    const int m0 = ct * 64; int t0, T, base; seq_of(m0, t0, T, base);
    int b, np; dn_chunk_of(ct, dir, b, np);
    unsigned char* tile = F.ws + WS_DNT + (size_t)dn_rec(b, h, dir, np) * DNT_BYTES;
    LAS unsigned char* L = F.lds;
    LAS float* SC = (LAS float*)(L + DP_SC);
    __syncthreads();
    {
        const float* cw = F.in[I_DNCW] + (size_t)l * 4 * 1536;
        float2 cwr[3][4];
#pragma unroll
        for (int part = 0; part < 3; ++part)
#pragma unroll
            for (int j = 0; j < 4; ++j) cwr[part][j] = *(const float2*)(cw + j * 1536 + part * 512 + h * 128 + 2 * lane);
        unsigned short pbw = 0, paw = 0;
        if (wave == 0) { const int tok = dir ? 63 - lane : lane; pbw = P[(size_t)(m0 + tok) * PW + PC_BETA + dir * 4 + h]; paw = P[(size_t)(m0 + tok) * PW + PC_DEC + dir * 4 + h]; }
        for (int c = F.tid; c < 67 * 48; c += NTHREADS) { const int row = c / 48, ch = c % 48, part = ch >> 4, cc = ch & 15, tt = t0 + row - 2;
            v4u v = (v4u){0u, 0u, 0u, 0u};
            if (tt >= 0 && tt < T) v = *(const v4u*)(P + (size_t)(base + tt) * PW + PC_DQ + part * 512 + h * 128 + cc * 8);
            *(LAS v4u*)(L + DP_RAW + row * 784 + part * 256 + cc * 16) = v; }
        __syncthreads();
#pragma unroll 1
        for (int rep = 0; rep < DN_REP_S1; ++rep)
#pragma unroll
        for (int part = 0; part < 3; ++part)
#pragma unroll 2
            for (int i = 0; i < 8; ++i) { const int tok = wave * 8 + i;
                float s0 = 0.f, s1 = 0.f;
#pragma unroll
                for (int j = 0; j < 4; ++j) { const unsigned w = *(const LAS unsigned*)(L + DP_RAW + (tok + j) * 784 + part * 256 + lane * 4); s0 += cwr[part][j].x * bflo(w); s1 += cwr[part][j].y * bfhi(w); }
                s0 = siluf_(s0); s1 = siluf_(s1);
                if (part < 2) { const float ss = wave_sum(s0 * s0 + s1 * s1); const float f = (part == 0 ? 0.08838834764831845f : 1.0f) / sqrtf(ss + EPS); s0 *= f; s1 *= f; }
                *(LAS unsigned*)(L + (part == 0 ? DP_QS : (part == 1 ? DP_KS : DP_VS)) + tok * DP_P + lane * 4) = pk2(s0, s1); }
        if (wave == 0) {
            const float pb = bf2f(pbw), pa = bf2f(paw);
            const float beta = sigmoidf_(pb); float gc = -__expf(F.in[I_DNALOG][l * 8 + dir * 4 + h]) * softplusf_(pa + F.in[I_DNDT][l * 8 + dir * 4 + h]);
#pragma unroll
            for (int o = 1; o < 64; o <<= 1) { const float v = __shfl_up(gc, o); if (lane >= o) gc += v; }
            const float glast = __shfl(gc, 63);
            SC[lane] = beta; SC[64 + lane] = gc; SC[128 + lane] = __expf(gc); SC[192 + lane] = __expf(glast - gc);
            if (lane == 63) ((float*)(F.ws + WS_DNS))[dn_rec(b, h, dir, np)] = __expf(glast);
        }
    }
    __syncthreads();
#define DN_TOK(r) (dir ? 63 - (r) : (r))
#pragma unroll 1
    for (int rep = 0; rep < DN_REP_S3A; ++rep)
    {
        const int mb = wave & 3, which = wave >> 2;
        f32x4 acc[4];
#pragma unroll
        for (int nb = 0; nb < 4; ++nb) acc[nb] = (f32x4){0.f, 0.f, 0.f, 0.f};
        const LAS unsigned char* arow = L + (which ? DP_QS : DP_KS) + DN_TOK(16 * mb + i16) * DP_P + 16 * q;
#pragma unroll
        for (int ks = 0; ks < 4; ++ks) { const bf16x8 a = *(const LAS bf16x8*)(arow + 64 * ks);
#pragma unroll
            for (int nb = 0; nb < 4; ++nb) { const bf16x8 bb = *(const LAS bf16x8*)(L + DP_KS + DN_TOK(16 * nb + i16) * DP_P + 16 * q + 64 * ks);
                acc[nb] = __builtin_amdgcn_mfma_f32_16x16x32_bf16(a, bb, acc[nb], 0, 0, 0); } }
#pragma unroll
        for (int nb = 0; nb < 4; ++nb)
#pragma unroll
            for (int i = 0; i < 4; ++i) { const int r = 16 * mb + 4 * q + i, c = 16 * nb + i16; const float dec = __expf(SC[64 + r] - SC[64 + c]);
                if (which == 0) ((LAS float*)(L + DP_AS))[r * 68 + c] = (r > c) ? SC[r] * acc[nb][i] * dec : 0.f;
                else *(LAS unsigned short*)(L + DP_QK + r * DP_P2 + c * 2) = (unsigned short)f2bf((r >= c) ? acc[nb][i] * dec : 0.f); }
    }
    __syncthreads();
#pragma unroll 1
    for (int rep = 0; rep < DN_REP_S3B; ++rep) {
    if (wave == 0) {
        const LAS float* As = (const LAS float*)(L + DP_AS); LAS float* Tf = (LAS float*)(L + DP_TF);
        const int g = lane >> 4, c = lane & 15;
        f32x4 ar[16][4];
#pragma unroll
        for (int r = 1; r < 16; ++r)
#pragma unroll
            for (int j4 = 0; j4 < (r + 3) / 4; ++j4) ar[r][j4] = *(const LAS f32x4*)(As + (16 * g + r) * 68 + 16 * g + 4 * j4);
        float t[16];
#pragma unroll
        for (int r = 0; r < 16; ++r) { float a0 = (c == r) ? 1.f : 0.f, a1 = 0.f;
#pragma unroll
            for (int j = 0; j < r; ++j) { const float av = ar[r][j >> 2][j & 3]; if (j & 1) a1 -= av * t[j]; else a0 -= av * t[j]; }
            t[r] = a0 + a1; Tf[(16 * g + r) * 68 + 16 * g + c] = t[r]; }
    }
    __syncthreads();
    if (wave < 3) {
        const LAS float* As = (const LAS float*)(L + DP_AS); LAS float* Tf = (LAS float*)(L + DP_TF); LAS float* Xs = (LAS float*)(L + DP_XS) + wave * 272;
        const int J = wave;
#pragma unroll 1
        for (int I = J + 1; I < 4; ++I) {
            f32x4 acc = {0.f, 0.f, 0.f, 0.f};
#pragma unroll 1
            for (int K = J; K < I; ++K)
#pragma unroll
                for (int sk = 0; sk < 4; ++sk) acc = __builtin_amdgcn_mfma_f32_16x16x4f32(As[(16 * I + i16) * 68 + 16 * K + 4 * sk + q], Tf[(16 * K + 4 * sk + q) * 68 + 16 * J + i16], acc, 0, 0, 0);
#pragma unroll
            for (int i = 0; i < 4; ++i) Xs[(4 * q + i) * 17 + i16] = acc[i];
            LDS_WAIT(); asm volatile("" ::: "memory");
            f32x4 acc2 = {0.f, 0.f, 0.f, 0.f};
#pragma unroll
            for (int sk = 0; sk < 4; ++sk) acc2 = __builtin_amdgcn_mfma_f32_16x16x4f32(Tf[(16 * I + i16) * 68 + 16 * I + 4 * sk + q], Xs[(4 * sk + q) * 17 + i16], acc2, 0, 0, 0);
#pragma unroll
            for (int i = 0; i < 4; ++i) Tf[(16 * I + 4 * q + i) * 68 + 16 * J + i16] = -acc2[i];
            LDS_WAIT(); asm volatile("" ::: "memory");
        }
    }
    __syncthreads();
    { const LAS float* Tf = (const LAS float*)(L + DP_TF); const int r = F.tid >> 3, c0 = (F.tid & 7) * 8; float vb[8], vw[8];
#pragma unroll
      for (int k = 0; k < 8; ++k) { const int c = c0 + k; const float v = ((r >> 4) >= (c >> 4)) ? Tf[r * 68 + c] : 0.f; const float bl = SC[c]; vb[k] = v * bl; vw[k] = vb[k] * SC[128 + c]; }
      v4u ob, ow; ob.x = pk2(vb[0], vb[1]); ob.y = pk2(vb[2], vb[3]); ob.z = pk2(vb[4], vb[5]); ob.w = pk2(vb[6], vb[7]); ow.x = pk2(vw[0], vw[1]); ow.y = pk2(vw[2], vw[3]); ow.z = pk2(vw[4], vw[5]); ow.w = pk2(vw[6], vw[7]);
      *(LAS v4u*)(L + DP_TB + r * DP_P2 + c0 * 2) = ob; *(LAS v4u*)(L + DP_TW + r * DP_P2 + c0 * 2) = ow; }
    }
    __syncthreads();
    {
        const int nbp = wave & 3, which = wave >> 2;
        f32x4 acc[4][2];
#pragma unroll
        for (int mb = 0; mb < 4; ++mb) { acc[mb][0] = (f32x4){0.f, 0.f, 0.f, 0.f}; acc[mb][1] = (f32x4){0.f, 0.f, 0.f, 0.f}; }
#pragma unroll
        for (int ks = 0; ks < 2; ++ks) {
            bf16x8 bb[2];
#pragma unroll
            for (int nn = 0; nn < 2; ++nn) { const int n = 16 * (2 * nbp + nn) + i16; unsigned short e[8];
#pragma unroll
                for (int jj = 0; jj < 8; ++jj) e[jj] = lds_u16(L + (which ? DP_KS : DP_VS) + DN_TOK(32 * ks + 8 * q + jj) * DP_P + n * 2);
                v4u w; w.x = e[0] | ((unsigned)e[1] << 16); w.y = e[2] | ((unsigned)e[3] << 16); w.z = e[4] | ((unsigned)e[5] << 16); w.w = e[6] | ((unsigned)e[7] << 16); bb[nn] = __builtin_bit_cast(bf16x8, w); }
#pragma unroll
            for (int mb = 0; mb < 4; ++mb) { const bf16x8 a = *(const LAS bf16x8*)(L + (which ? DP_TW : DP_TB) + (16 * mb + i16) * DP_P2 + 64 * ks + 16 * q);
                acc[mb][0] = __builtin_amdgcn_mfma_f32_16x16x32_bf16(a, bb[0], acc[mb][0], 0, 0, 0); acc[mb][1] = __builtin_amdgcn_mfma_f32_16x16x32_bf16(a, bb[1], acc[mb][1], 0, 0, 0); } }
        if (which == 0) {
#pragma unroll
            for (int mb = 0; mb < 4; ++mb)
#pragma unroll
                for (int nn = 0; nn < 2; ++nn) *(f32x4*)(tile + DN_U_OFF + (size_t)((((2 * nbp + nn) * 4 + mb) * 64 + lane) * 16)) = acc[mb][nn];
        } else {
#pragma unroll
            for (int mb = 0; mb < 4; ++mb)
#pragma unroll
                for (int nn = 0; nn < 2; ++nn)
#pragma unroll
                    for (int i = 0; i < 4; ++i) *(LAS unsigned short*)(L + DP_AS + (16 * mb + 4 * q + i) * DP_P + (16 * (2 * nbp + nn) + i16) * 2) = (unsigned short)f2bf(-acc[mb][nn][i]);
        }
    }
    __syncthreads();
#pragma unroll 1
    for (int rep = 0; rep < DN_REP_S4; ++rep)
#pragma unroll 1
    for (int fi = 0; fi < 7; ++fi) { const int f = wave * 7 + fi; v4u o;
        if (f < DN_F_QG) { const int mb = f >> 2, ks = f & 3; const LAS unsigned char* rp = L + DP_AS + (16 * mb + i16) * DP_P + (32 * ks + 4 * q) * 2;
            const v2u a = *(const LAS v2u*)rp, c = *(const LAS v2u*)(rp + 32); o.x = a.x; o.y = a.y; o.z = c.x; o.w = c.y; }
        else if (f < DN_F_QK) { const int ff = f - DN_F_QG, mb = ff >> 2, ks = ff & 3, r = 16 * mb + i16; const LAS unsigned char* rp = L + DP_QS + DN_TOK(r) * DP_P + (32 * ks + 4 * q) * 2; const float eg = SC[128 + r];
            const v2u a = *(const LAS v2u*)rp, c = *(const LAS v2u*)(rp + 32);
            o.x = pk2(bflo(a.x) * eg, bfhi(a.x) * eg); o.y = pk2(bflo(a.y) * eg, bfhi(a.y) * eg); o.z = pk2(bflo(c.x) * eg, bfhi(c.x) * eg); o.w = pk2(bflo(c.y) * eg, bfhi(c.y) * eg); }
        else if (f < DN_F_KGT) { const int ff = f - DN_F_QK, mb = ff >> 1, ks = ff & 1; const LAS unsigned char* rp = L + DP_QK + (16 * mb + i16) * DP_P2 + (32 * ks + 4 * q) * 2;
            const v2u a = *(const LAS v2u*)rp, c = *(const LAS v2u*)(rp + 32); o.x = a.x; o.y = a.y; o.z = c.x; o.w = c.y; }
        else { const int ff = f - DN_F_KGT, mb = ff >> 1, ks = ff & 1, dk = 16 * mb + i16; float e[8];
#pragma unroll
            for (int jj = 0; jj < 8; ++jj) { const int key = 32 * ks + 16 * (jj >> 2) + 4 * q + (jj & 3); e[jj] = bf2f(lds_u16(L + DP_KS + DN_TOK(key) * DP_P + dk * 2)) * SC[192 + key]; }
            o.x = pk2(e[0], e[1]); o.y = pk2(e[2], e[3]); o.z = pk2(e[4], e[5]); o.w = pk2(e[6], e[7]); }
        *(v4u*)(tile + (size_t)f * 1024 + lane * 16) = o; }
#undef DN_TOK
}
__device__ __forceinline__ void dn_prep(Frame& F, int l) {
    for (int u = F.bid; u < NCT * 4 * 2; u += F.G) dn_prep_unit(F, l, u >> 3, (u >> 1) & 3, u & 1);
    __syncthreads();
}

__device__ __forceinline__ void dn_scan(Frame& F, int l, int b, int h, int dir) {
    int lane = F.lane; asm volatile("" : "+v"(lane));
    const int w = F.wave, i16 = lane & 15, q = lane >> 4;
    const unsigned char* tiles = F.ws + WS_DNT + (size_t)dn_rec(b, h, dir, 0) * DNT_BYTES;
    const float* egl = (const float*)(F.ws + WS_DNS) + dn_rec(b, h, dir, 0);
    float* O = (float*)(F.ws + WS_DNO);
    LAS unsigned char* L = F.lds;
    f32x4 S[8];
#pragma unroll
    for (int i = 0; i < 8; ++i) S[i] = (f32x4){0.f, 0.f, 0.f, 0.f};
    v4u st[7]; f32x4 un[4];
#pragma unroll
    for (int mb = 0; mb < 4; ++mb) un[mb] = *(const f32x4*)(tiles + DN_U_OFF + (size_t)(((w * 4 + mb) * 64 + lane) * 16));
    __syncthreads();
#pragma unroll
    for (int i = 0; i < 7; ++i) st[i] = *(const v4u*)(tiles + (size_t)(F.tid + i * NTHREADS) * 16);
#pragma unroll
    for (int i = 0; i < 7; ++i) *(LAS v4u*)(L + (F.tid + i * NTHREADS) * 16) = st[i];
    __syncthreads();
#pragma unroll 1
    for (int n = 0; n < 68; ++n) {
        const unsigned char* tile = tiles + (size_t)n * DNT_BYTES; const LAS unsigned char* cur = L + (n & 1) * 57344;
        if (n + 1 < 68) {
#pragma unroll
            for (int i = 0; i < 7; ++i) st[i] = *(const v4u*)(tile + DNT_BYTES + (size_t)(F.tid + i * NTHREADS) * 16); }
        f32x4 vn[4];
#pragma unroll
        for (int mb = 0; mb < 4; ++mb) vn[mb] = un[mb];
        if (n + 1 < 68) {
#pragma unroll
            for (int mb = 0; mb < 4; ++mb) un[mb] = *(const f32x4*)(tile + DNT_BYTES + DN_U_OFF + (size_t)(((w * 4 + mb) * 64 + lane) * 16)); }
        const float el = egl[n];
        bf16x8 bS[4];
#pragma unroll
        for (int ks = 0; ks < 4; ++ks) { v4u x; x.x = pk2(S[2 * ks][0], S[2 * ks][1]); x.y = pk2(S[2 * ks][2], S[2 * ks][3]); x.z = pk2(S[2 * ks + 1][0], S[2 * ks + 1][1]); x.w = pk2(S[2 * ks + 1][2], S[2 * ks + 1][3]); bS[ks] = __builtin_bit_cast(bf16x8, x); }
        f32x4 o[4];
#pragma unroll
        for (int mb = 0; mb < 4; ++mb) { o[mb] = (f32x4){0.f, 0.f, 0.f, 0.f};
#pragma unroll
            for (int ks = 0; ks < 4; ++ks) { const bf16x8 aw = *(const LAS bf16x8*)(cur + (DN_F_NEGW + mb * 4 + ks) * 1024 + lane * 16), aq = *(const LAS bf16x8*)(cur + (DN_F_QG + mb * 4 + ks) * 1024 + lane * 16);
                vn[mb] = __builtin_amdgcn_mfma_f32_16x16x32_bf16(aw, bS[ks], vn[mb], 0, 0, 0); o[mb] = __builtin_amdgcn_mfma_f32_16x16x32_bf16(aq, bS[ks], o[mb], 0, 0, 0); } }
        bf16x8 bV[2];
#pragma unroll
        for (int ks = 0; ks < 2; ++ks) { v4u x; x.x = pk2(vn[2 * ks][0], vn[2 * ks][1]); x.y = pk2(vn[2 * ks][2], vn[2 * ks][3]); x.z = pk2(vn[2 * ks + 1][0], vn[2 * ks + 1][1]); x.w = pk2(vn[2 * ks + 1][2], vn[2 * ks + 1][3]); bV[ks] = __builtin_bit_cast(bf16x8, x); }
#pragma unroll
        for (int mb = 0; mb < 8; ++mb) { S[mb] = S[mb] * el;
#pragma unroll
            for (int ks = 0; ks < 2; ++ks) { const bf16x8 ak = *(const LAS bf16x8*)(cur + (DN_F_KGT + mb * 2 + ks) * 1024 + lane * 16); S[mb] = __builtin_amdgcn_mfma_f32_16x16x32_bf16(ak, bV[ks], S[mb], 0, 0, 0); } }
#pragma unroll
        for (int mb = 0; mb < 4; ++mb)
#pragma unroll
            for (int ks = 0; ks < 2; ++ks) { const bf16x8 aqk = *(const LAS bf16x8*)(cur + (DN_F_QK + mb * 2 + ks) * 1024 + lane * 16); o[mb] = __builtin_amdgcn_mfma_f32_16x16x32_bf16(aqk, bV[ks], o[mb], 0, 0, 0); }
        { int m0; if (n < 4) m0 = NLAT + b * CTXL + 64 * (dir ? 3 - n : n); else m0 = b * SEQ + 64 * (dir ? 63 - (n - 4) : (n - 4));
#pragma unroll
          for (int mb = 0; mb < 4; ++mb)
#pragma unroll
            for (int i = 0; i < 4; ++i) { const int r = 16 * mb + 4 * q + i, tok = dir ? 63 - r : r; O[((size_t)dir * NTOK + m0 + tok) * 512 + h * 128 + 16 * w + i16] = o[mb][i]; } }
        if (n + 1 < 68) {
#pragma unroll
            for (int i = 0; i < 7; ++i) *(LAS v4u*)(L + ((n + 1) & 1) * 57344 + (F.tid + i * NTHREADS) * 16) = st[i]; }
        __syncthreads();
    }
}
#define USE_CHUNK_LRU 1

constexpr int LR_XF = 0  , LR_XB = 16640  , LR_WT = 25856  , LR_AA = 62720  , LR_UU = 96000  , LR_END = 129280;
constexpr size_t WS_LCA = WS_LRC, WS_LCH = WS_LRC + 2 * MiB, WS_LCI = WS_LRC + 4 * MiB;
__device__ __forceinline__ void lru_prep(Frame& F, int l) {
    const bf16* P = (const bf16*)(F.ws + WS_P);
    int lane = F.lane; asm volatile("" : "+v"(lane));
    const int wave = F.wave, i16 = lane & 15, q = lane >> 4, nb = F.bid & 7;
    LAS unsigned char* L = F.lds;
    LAS float* XF = (LAS float*)(L + LR_XF); LAS float* AA = (LAS float*)(L + LR_AA); LAS float* UU = (LAS float*)(L + LR_UU);
    bf16* HL = (bf16*)(F.ws + WS_LRH); bf16* AC = (bf16*)(F.ws + WS_LRA);
    __syncthreads();
    for (int e = F.tid; e < 4 * 4096; e += NTHREADS) { const int mat = e >> 12, ii = (e >> 6) & 63, j = e & 63, dir = mat >> 1;
        const float w = (mat & 1 ? F.in[I_LRWI] : F.in[I_LRWR])[((size_t)((l * 2 + dir) * 8 + nb)) * 4096 + ii * 64 + j];
        *(LAS unsigned short*)(L + LR_WT + (mat * 64 + j) * 144 + ii * 2) = (unsigned short)f2bf(w); }
    float cwv[4][8], cbv[8];
    { const int c8 = (F.tid & 7) * 8, ch0 = nb * 64 + c8; const float* cb = F.in[I_LRCB] + l * 512 + ch0; const float* cw = F.in[I_LRCW] + (size_t)l * 4 * 512 + ch0;
#pragma unroll
      for (int k = 0; k < 8; ++k) cbv[k] = cb[k];
#pragma unroll
      for (int j = 0; j < 4; ++j)
#pragma unroll
        for (int k = 0; k < 8; ++k) cwv[j][k] = cw[j * 512 + k]; }
    float gbr[4], gbi[4], gls[4];
    { const int dir = wave >> 2;
#pragma unroll
      for (int n = 0; n < 4; ++n) { const int ch = nb * 64 + 16 * n + i16; gbr[n] = F.in[I_LRBR][(l * 2 + dir) * 512 + ch]; gbi[n] = F.in[I_LRBI][(l * 2 + dir) * 512 + ch]; gls[n] = -softplusf_(-F.in[I_LRLAM][(l * 2 + dir) * 512 + ch]); } }
    for (int ct = F.bid >> 3; ct < NCT; ct += F.G >> 3) {
        const int m0 = ct * 64; int t0, T, base; seq_of(m0, t0, T, base);
        __syncthreads();
        { const int tok = F.tid >> 3, c8 = (F.tid & 7) * 8, ch0 = nb * 64 + c8; float s[8];
#pragma unroll
          for (int k = 0; k < 8; ++k) s[k] = cbv[k];
          v4u wv[4];
#pragma unroll
          for (int j = 0; j < 4; ++j) { const int tt = t0 + tok + j - 2; wv[j] = (v4u){0u, 0u, 0u, 0u}; if (tt >= 0 && tt < T) wv[j] = *(const v4u*)(P + (size_t)(base + tt) * PW + PC_LX + ch0); }
#pragma unroll
          for (int j = 0; j < 4; ++j) { const v4u w = wv[j];
              s[0] += cwv[j][0] * bflo(w.x); s[1] += cwv[j][1] * bfhi(w.x); s[2] += cwv[j][2] * bflo(w.y); s[3] += cwv[j][3] * bfhi(w.y); s[4] += cwv[j][4] * bflo(w.z); s[5] += cwv[j][5] * bfhi(w.z); s[6] += cwv[j][6] * bflo(w.w); s[7] += cwv[j][7] * bfhi(w.w); }
#pragma unroll
          for (int k = 0; k < 8; ++k) XF[tok * 65 + c8 + k] = s[k];
          v4u o; o.x = pk2(s[0], s[1]); o.y = pk2(s[2], s[3]); o.z = pk2(s[4], s[5]); o.w = pk2(s[6], s[7]); *(LAS v4u*)(L + LR_XB + tok * 144 + c8 * 2) = o; }
        __syncthreads();
        { const int dir = wave >> 2, mb = wave & 3;
          f32x4 ar[4], ai[4];
#pragma unroll
          for (int n = 0; n < 4; ++n) { ar[n] = (f32x4){0.f, 0.f, 0.f, 0.f}; ai[n] = (f32x4){0.f, 0.f, 0.f, 0.f}; }
#pragma unroll
          for (int ks = 0; ks < 2; ++ks) { const bf16x8 a = *(const LAS bf16x8*)(L + LR_XB + (16 * mb + i16) * 144 + 64 * ks + 16 * q);
#pragma unroll
              for (int n = 0; n < 4; ++n) { const bf16x8 br = *(const LAS bf16x8*)(L + LR_WT + ((dir * 2 + 0) * 64 + 16 * n + i16) * 144 + 64 * ks + 16 * q), bi = *(const LAS bf16x8*)(L + LR_WT + ((dir * 2 + 1) * 64 + 16 * n + i16) * 144 + 64 * ks + 16 * q);
                  ar[n] = __builtin_amdgcn_mfma_f32_16x16x32_bf16(a, br, ar[n], 0, 0, 0); ai[n] = __builtin_amdgcn_mfma_f32_16x16x32_bf16(a, bi, ai[n], 0, 0, 0); } }
#pragma unroll
          for (int n = 0; n < 4; ++n) { const int j = 16 * n + i16; const float br_ = gbr[n], bi_ = gbi[n], logsig = gls[n];
#pragma unroll
              for (int i = 0; i < 4; ++i) { const int tok = 16 * mb + 4 * q + i; const float r = sigmoidf_(ar[n][i] + br_), ig = sigmoidf_(ai[n][i] + bi_);
                  const float log_a = 8.0f * r * logsig, a = __expf(log_a), u = sqrtf(-expm1f(2.0f * log_a)) * (ig * XF[tok * 65 + j]);
                  AA[(dir * 64 + tok) * 65 + j] = a; UU[(dir * 64 + tok) * 65 + j] = u; } } }
        __syncthreads();
        if (F.tid < 128) { const int dir = F.tid >> 6, j = F.tid & 63, ch = nb * 64 + j; float h = 0.f, ac = 1.f;
            long o = (long)(((size_t)dir * NTOK + m0 + (dir ? 63 : 0)) * 512 + ch); const long ostep = dir ? -512 : 512;
#pragma unroll 1
            for (int s0 = 0; s0 < 64; s0 += 8) { float av[8], uv[8];
#pragma unroll
                for (int k = 0; k < 8; ++k) { const int tok = dir ? 63 - (s0 + k) : (s0 + k); av[k] = AA[(dir * 64 + tok) * 65 + j]; uv[k] = UU[(dir * 64 + tok) * 65 + j]; }
#pragma unroll
                for (int k = 0; k < 8; ++k) { h = av[k] * h + uv[k]; ac *= av[k]; HL[o] = (bf16)f2bf(h); AC[o] = (bf16)f2bf(ac); o += ostep; } }
            ((float*)(F.ws + WS_LCA))[((size_t)dir * NCT + ct) * 512 + ch] = ac; ((float*)(F.ws + WS_LCH))[((size_t)dir * NCT + ct) * 512 + ch] = h; }
    }
    __syncthreads();
}
__device__ __forceinline__ void lru_carry(Frame& F, int idx) {
    const int ch = idx & 511, dir = (idx >> 9) & 1, b = idx >> 10;
    const float* CA = (const float*)(F.ws + WS_LCA); const float* CH = (const float*)(F.ws + WS_LCH); float* CI = (float*)(F.ws + WS_LCI);
    float h = 0.f;
#pragma unroll 4
    for (int n = 0; n < 68; ++n) { const int ct = n < 4 ? 256 + b * 4 + (dir ? 3 - n : n) : b * 64 + (dir ? 63 - (n - 4) : (n - 4)); const size_t o = ((size_t)dir * NCT + ct) * 512 + ch;
        CI[o] = h; h = CA[o] * h + CH[o]; }
}
__device__ __forceinline__ void lru_fin(Frame& F, int l) {
    const int nrows = (l == 0) ? NTOK : NLAT;
    const bf16* P = (const bf16*)(F.ws + WS_P); bf16* CC = (bf16*)(F.ws + WS_CC);
    const bf16* HL = (const bf16*)(F.ws + WS_LRH); const bf16* AC = (const bf16*)(F.ws + WS_LRA); const float* CI = (const float*)(F.ws + WS_LCI);
    for (size_t i = (size_t)F.bid * NTHREADS + F.tid; i < (size_t)nrows * 128; i += (size_t)F.G * NTHREADS) { const int m = (int)(i >> 7), c4 = (int)(i & 127) * 4, ct = m >> 6;
        const v2u hw0 = *(const v2u*)(HL + (size_t)m * 512 + c4), aw0 = *(const v2u*)(AC + (size_t)m * 512 + c4), hw1 = *(const v2u*)(HL + ((size_t)NTOK + m) * 512 + c4), aw1 = *(const v2u*)(AC + ((size_t)NTOK + m) * 512 + c4);
        const f32x4 h0 = {bflo(hw0.x), bfhi(hw0.x), bflo(hw0.y), bfhi(hw0.y)}, a0 = {bflo(aw0.x), bfhi(aw0.x), bflo(aw0.y), bfhi(aw0.y)}, h1 = {bflo(hw1.x), bfhi(hw1.x), bflo(hw1.y), bfhi(hw1.y)}, a1 = {bflo(aw1.x), bfhi(aw1.x), bflo(aw1.y), bfhi(aw1.y)};
        const f32x4 i0 = *(const f32x4*)(CI + (size_t)ct * 512 + c4), i1 = *(const f32x4*)(CI + ((size_t)NCT + ct) * 512 + c4);
        const f32x4 hs = (a0 * i0 + h0) + (a1 * i1 + h1); const v2u yw = *(const v2u*)(P + (size_t)m * PW + PC_LY + c4);
        v2u o; o.x = pk2(hs.x * gelu_tanh(bflo(yw.x)), hs.y * gelu_tanh(bfhi(yw.x))); o.y = pk2(hs.z * gelu_tanh(bflo(yw.y)), hs.w * gelu_tanh(bfhi(yw.y)));
        *(v2u*)(CC + (size_t)m * DM + 1536 + c4) = o; }
}

constexpr size_t WS_DNQ = WS_DNT;
constexpr size_t WS_BG = WS_DNS + 1 * MiB;
constexpr size_t WS_XC = WS_XS;

__device__ __forceinline__ void naive_prep(Frame& F, int l) {
    const bf16* P = (const bf16*)(F.ws + WS_P);
    const int gw = F.bid * NWAVES + F.wave, NGW = F.G * NWAVES;
#if !defined(USE_CHUNK_DN)
    {
        float* DNQ = (float*)(F.ws + WS_DNQ); float* BG = (float*)(F.ws + WS_BG);
        const float* cw = F.in[I_DNCW] + (size_t)l * 4 * 1536;
        for (int it = gw; it < NTOK * 4; it += NGW) {
            const int m = it >> 2, h = it & 3; int t, T, base; seq_of(m, t, T, base);
            float val[3][2];
#pragma unroll
            for (int part = 0; part < 3; ++part)
#pragma unroll
                for (int dd = 0; dd < 2; ++dd) { const int d = F.lane + 64 * dd, cch = part * 512 + h * 128 + d, col = PC_DQ + cch; float s = 0.f;
#pragma unroll
                    for (int j = 0; j < 4; ++j) { const int tt = t + j - 2; if (tt >= 0 && tt < T) s += cw[j * 1536 + cch] * bf2f(P[(size_t)(base + tt) * PW + col]); }
                    val[part][dd] = siluf_(s); }
            const float sq = wave_sum(val[0][0] * val[0][0] + val[0][1] * val[0][1]), sk = wave_sum(val[1][0] * val[1][0] + val[1][1] * val[1][1]);
            const float fq = 0.08838834764831845f / sqrtf(sq + EPS), fk = 1.0f / sqrtf(sk + EPS);
#pragma unroll
            for (int dd = 0; dd < 2; ++dd) { const int d = F.lane + 64 * dd; float* o = DNQ + (size_t)m * 1536 + h * 128 + d;
                o[0] = val[0][dd] * fq; o[512] = val[1][dd] * fk; o[1024] = val[2][dd]; }
            if (h == 0 && F.lane < 8) { const int dir = F.lane >> 2, hh = F.lane & 3;
                const float pb = bf2f(P[(size_t)m * PW + PC_BETA + F.lane]), pa = bf2f(P[(size_t)m * PW + PC_DEC + F.lane]);
                BG[m * 16 + F.lane] = sigmoidf_(pb);
                BG[m * 16 + 8 + F.lane] = -__expf(F.in[I_DNALOG][l * 8 + dir * 4 + hh]) * softplusf_(pa + F.in[I_DNDT][l * 8 + dir * 4 + hh]); }
        }
    }
#endif
#if !defined(USE_CHUNK_LRU)
    {
        LAS float* xc = (LAS float*)F.lds;
        float* A = (float*)(F.ws + WS_LRA); float* U = (float*)(F.ws + WS_LRH);
        const float* cw = F.in[I_LRCW] + (size_t)l * 4 * 512; const float* cb = F.in[I_LRCB] + l * 512;
        for (int m0 = F.bid * 8; m0 < NTOK; m0 += F.G * 8) {
            __syncthreads();
            for (int i = F.tid; i < 8 * 512; i += NTHREADS) { const int m = m0 + (i >> 9), ch = i & 511; int t, T, base; seq_of(m, t, T, base); float s = cb[ch];
#pragma unroll
                for (int j = 0; j < 4; ++j) { const int tt = t + j - 2; if (tt >= 0 && tt < T) s += cw[j * 512 + ch] * bf2f(P[(size_t)(base + tt) * PW + PC_LX + ch]); }
                xc[i] = s; }
            __syncthreads();
            for (int i = F.tid; i < 8 * 512 * 2; i += NTHREADS) { const int ch = i & 511, dir = (i >> 9) & 1, tk = i >> 10, m = m0 + tk, blk = ch >> 6, j = ch & 63;
                const float* wr = F.in[I_LRWR] + ((size_t)((l * 2 + dir) * 8 + blk)) * 4096 + j; const float* wi = F.in[I_LRWI] + ((size_t)((l * 2 + dir) * 8 + blk)) * 4096 + j;
                float sr = F.in[I_LRBR][(l * 2 + dir) * 512 + ch], si = F.in[I_LRBI][(l * 2 + dir) * 512 + ch];
#pragma unroll 8
                for (int ii = 0; ii < 64; ++ii) { const float x = xc[tk * 512 + blk * 64 + ii]; sr += x * wr[ii * 64]; si += x * wi[ii * 64]; }
                const float r = sigmoidf_(sr), ig = sigmoidf_(si); const float lam = F.in[I_LRLAM][(l * 2 + dir) * 512 + ch];
                const float logsig = -softplusf_(-lam);
                const float log_a = 8.0f * r * logsig; const float a = __expf(log_a);
                const float u = sqrtf(-expm1f(2.0f * log_a)) * (ig * xc[tk * 512 + ch]);
                A[((size_t)dir * NTOK + m) * 512 + ch] = a; U[((size_t)dir * NTOK + m) * 512 + ch] = u; }
        }
        __syncthreads();
    }
#endif
}

__device__ __forceinline__ void naive_attn_row(Frame& F, int l, int m, int hq) {
    const bf16* P = (const bf16*)(F.ws + WS_P); bf16* CC = (bf16*)(F.ws + WS_CC);
    const int d = F.lane, kvh = hq >> 2; int t, T, base; seq_of(m, t, T, base);
    const bool lat = m < NLAT; const int b = lat ? (m >> 12) : ((m - NLAT) >> 8);
    const int dd = d & 31, jf = dd & 15; const float inv = __powf(10000.0f, -(float)jf * (1.0f / 16.0f));
    const bool second = (dd >= 16), colhalf = (d >= 32);
    float q = bf2f(P[(size_t)m * PW + PC_Q + hq * 64 + d]);
    if (lat) { const float pos = (float)(colhalf ? (t & 63) : (t >> 6)); float sn, cs; sincosf(pos * inv, &sn, &cs); const float pr = __shfl_xor(q, 16); q = second ? (q * cs + pr * sn) : (q * cs - pr * sn); }
    q *= 0.125f;
    float mx = F.in[I_SINK][l * 16 + hq], den = 1.0f, acc = 0.f;
    if (lat) { const int t0 = t - 128 < 0 ? 0 : t - 128, t1 = t + 128 > SEQ - 1 ? SEQ - 1 : t + 128;
        for (int tk = t0; tk <= t1; ++tk) { const size_t r = (size_t)(base + tk) * PW; float k = bf2f(P[r + PC_K + kvh * 64 + d]); const float v = bf2f(P[r + PC_V + kvh * 64 + d]);
            const float pos = (float)(colhalf ? (tk & 63) : (tk >> 6)); float sn, cs; sincosf(pos * inv, &sn, &cs); const float pr = __shfl_xor(k, 16); k = second ? (k * cs + pr * sn) : (k * cs - pr * sn);
            const float s = wave_sum(q * k); const float mn = fmaxf(mx, s), f = __expf(mx - mn), p = __expf(s - mn); den = den * f + p; acc = acc * f + p * v; mx = mn; } }
    for (int c = 0; c < CTXL; ++c) { const size_t r = (size_t)(NLAT + b * CTXL + c) * PW; const float k = bf2f(P[r + PC_K + kvh * 64 + d]), v = bf2f(P[r + PC_V + kvh * 64 + d]);
        const float s = wave_sum(q * k); const float mn = fmaxf(mx, s), f = __expf(mx - mn), p = __expf(s - mn); den = den * f + p; acc = acc * f + p * v; mx = mn; }
    CC[(size_t)m * DM + hq * 64 + d] = (bf16)f2bf(acc / den);
}

__device__ __forceinline__ int scan_row(int n, int b, int dir) { if (n < CTXL) { const int t = dir ? (CTXL - 1 - n) : n; return NLAT + b * CTXL + t; } const int t = dir ? (SEQ - 1 - (n - CTXL)) : (n - CTXL); return b * SEQ + t; }
__device__ __forceinline__ void naive_scan(Frame& F, int l, int rep = 0) {
#if defined(USE_CHUNK_DN)
    if (F.bid < 32) { dn_scan(F, l, F.bid >> 3, (F.bid >> 1) & 3, F.bid & 1); }
#else
    if (F.bid < 32) {
        const int b = F.bid >> 3, h = (F.bid >> 1) & 3, dir = F.bid & 1, dvc = F.tid & 127, kq = F.tid >> 7;
        const float* DNQ = (const float*)(F.ws + WS_DNQ); const float* BG = (const float*)(F.ws + WS_BG); float* O = (float*)(F.ws + WS_DNO);
        LAS float* buf = (LAS float*)F.lds;
        LAS float* red = buf + 768;
        LAS float* red2 = red + 512;
        float S[32];
#pragma unroll
        for (int i = 0; i < 32; ++i) S[i] = 0.f;
        constexpr int NT = CTXL + SEQ;
        { const int m = scan_row(0, b, dir); if (F.tid < 384) buf[F.tid] = DNQ[(size_t)m * 1536 + (F.tid >> 7) * 512 + h * 128 + (F.tid & 127)]; }
        __syncthreads();
#pragma unroll 1
        for (int n = 0; n < NT; ++n) {
            const int m = scan_row(n, b, dir); const LAS float* cur = buf + (n & 1) * 384;
            float nextv = 0.f; if (n + 1 < NT && F.tid < 384) { const int m2 = scan_row(n + 1, b, dir); nextv = DNQ[(size_t)m2 * 1536 + (F.tid >> 7) * 512 + h * 128 + (F.tid & 127)]; }
            const float beta = BG[m * 16 + dir * 4 + h], decay = __expf(BG[m * 16 + 8 + dir * 4 + h]);
            float ks = 0.f;
#pragma unroll
            for (int i = 0; i < 32; ++i) ks += cur[128 + kq * 32 + i] * S[i];
            red[kq * 128 + dvc] = ks;
            __syncthreads();
            const float kS = (red[dvc] + red[128 + dvc]) + (red[256 + dvc] + red[384 + dvc]);
            const float upd = beta * (cur[256 + dvc] - decay * kS);
            float os = 0.f;
#pragma unroll
            for (int i = 0; i < 32; ++i) { S[i] = decay * S[i] + cur[128 + kq * 32 + i] * upd; os += cur[kq * 32 + i] * S[i]; }
            red2[kq * 128 + dvc] = os;
            if (F.tid < 384) buf[((n + 1) & 1) * 384 + F.tid] = nextv;
            __syncthreads();
            if (kq == 0) O[((size_t)dir * NTOK + m) * 512 + h * 128 + dvc] = (red2[dvc] + red2[128 + dvc]) + (red2[256 + dvc] + red2[384 + dvc]);
        }
    }
#endif
#if defined(USE_CHUNK_LRU)
    else if (F.bid < 40) { lru_carry(F, (F.bid - 32) * NTHREADS + F.tid); }
#else
    else if (F.bid < 40) {
        const int idx = (F.bid - 32) * NTHREADS + F.tid, ch = idx & 511, dir = (idx >> 9) & 1, b = idx >> 10;
        const float* A = (const float*)(F.ws + WS_LRA); float* U = (float*)(F.ws + WS_LRH);
        float hs = 0.f;
#pragma unroll 4
        for (int n = 0; n < CTXL + SEQ; ++n) { int m; if (n < CTXL) { const int t = dir ? (CTXL - 1 - n) : n; m = NLAT + b * CTXL + t; } else { const int t = dir ? (SEQ - 1 - (n - CTXL)) : (n - CTXL); m = b * SEQ + t; }
            const size_t o = ((size_t)dir * NTOK + m) * 512 + ch; hs = A[o] * hs + U[o]; U[o] = hs; }
    }
#endif
#if defined(USE_MFMA_ATTN)
    attn_phase(F, l, rep);
    convert_moe_queue(F, l, rep);
#else
    {
        const int nrows = (l == 0) ? NTOK : NLAT;
        for (;;) { int m = 0; if (F.lane == 0) m = (int)__hip_atomic_fetch_add(F.ctl + CW_ATQ + 64 * l, 1u, RLX_AGENT); m = __builtin_amdgcn_readfirstlane(m);
            if (m >= nrows) break;
#pragma unroll 1
            for (int hq = 0; hq < 16; ++hq) naive_attn_row(F, l, m, hq); }
    }
#endif
}

__device__ __forceinline__ void naive_fin(Frame& F, int l) {
    const int nrows = (l == 0) ? NTOK : NLAT;
    const bf16* P = (const bf16*)(F.ws + WS_P); bf16* CC = (bf16*)(F.ws + WS_CC);
    const int gw = F.bid * NWAVES + F.wave, NGW = F.G * NWAVES;
    const float* O = (const float*)(F.ws + WS_DNO); const float* HS = (const float*)(F.ws + WS_LRH);
    for (int it = gw; it < nrows * 4; it += NGW) { const int m = it >> 2, h = it & 3; float o[2];
#pragma unroll
        for (int dd = 0; dd < 2; ++dd) { const int c = h * 128 + F.lane + 64 * dd; o[dd] = O[(size_t)m * 512 + c] + O[((size_t)NTOK + m) * 512 + c]; }
        const float rstd = 1.0f / sqrtf(wave_sum(o[0] * o[0] + o[1] * o[1]) * (1.0f / 128.0f) + EPS);
#pragma unroll
        for (int dd = 0; dd < 2; ++dd) { const int d = F.lane + 64 * dd; const float gt = bf2f(P[(size_t)m * PW + PC_DG + h * 128 + d]);
            CC[(size_t)m * DM + 1024 + h * 128 + d] = (bf16)f2bf(o[dd] * rstd * F.in[I_DNNG][l * 128 + d] * siluf_(gt)); }
    }
#if defined(USE_CHUNK_LRU)
    lru_fin(F, l);
#else
    for (size_t i = (size_t)F.bid * NTHREADS + F.tid; i < (size_t)nrows * 512; i += (size_t)F.G * NTHREADS) { const int m = (int)(i >> 9), ch = (int)(i & 511);
        const float hsum = HS[(size_t)m * 512 + ch] + HS[((size_t)NTOK + m) * 512 + ch]; const float y = bf2f(P[(size_t)m * PW + PC_LY + ch]);
        CC[(size_t)m * DM + 1536 + ch] = (bf16)f2bf(hsum * gelu_tanh(y)); }
#endif
}
#ifndef PHASE_PREP
#if defined(USE_MFMA_ATTN)
#if defined(USE_CHUNK_DN)
#define PHASE_PREP(F, l) do { attn_prep(F, l); lru_prep(F, l); dn_prep(F, l); } while (0)
#else
#define PHASE_PREP(F, l) do { naive_prep(F, l); attn_prep(F, l); } while (0)
#endif
#else
#define PHASE_PREP(F, l) naive_prep(F, l)
#endif
#endif
#ifndef PHASE_SCAN
#define PHASE_SCAN(F, l) naive_scan(F, l)
#endif
#ifndef PHASE_FIN
#define PHASE_FIN(F, l) naive_fin(F, l)
#endif

#ifndef PHASE_INPROJ
#define PHASE_INPROJ(F, l) do {} while (0)
#endif
#ifndef PHASE_PREP
#define PHASE_PREP(F, l) do {} while (0)
#endif
#ifndef PHASE_SCAN
#define PHASE_SCAN(F, l) do {} while (0)
#endif
#ifndef PHASE_FIN
#define PHASE_FIN(F, l) do {} while (0)
#endif
#ifndef PHASE_OUTPROJ
#define PHASE_OUTPROJ(F, l) do {} while (0)
#endif
#ifndef PHASE_NORM2
#define PHASE_NORM2(F, l) do {} while (0)
#endif
#ifndef PHASE_SCATTER
#define PHASE_SCATTER(F, l) do {} while (0)
#endif
#ifndef PHASE_GEMM1
#define PHASE_GEMM1(F, l) do {} while (0)
#endif
#ifndef PHASE_GEMM2
#define PHASE_GEMM2(F, l) do {} while (0)
#endif

#ifndef MK_SPLIT
#define MK_SPLIT 0
#endif
#ifndef MK_STAGE
#define MK_STAGE 99
#endif
#ifndef MK_DUP
#define MK_DUP 0
#endif
#define DUP(k) ((MK_DUP >> (k)) & 1)
constexpr int N_PHASES = 22;
struct Args { const float* in[N_IN]; float* out; unsigned char* ws; int ph_lo, ph_hi; };
static_assert(sizeof(Args) == (N_IN + 2) * 8 + 8, "Args has no padding");

__global__ void __launch_bounds__(NTHREADS, 2) fwd_kernel(Args args) {
    extern __shared__ __attribute__((aligned(16))) unsigned char lds[];
    Frame F;
    F.lds = (LAS unsigned char*)lds;
    F.MISC = (volatile LAS unsigned*)(F.lds + MISC_OFF);
    F.tid = threadIdx.x; F.lane = F.tid & 63; F.wave = __builtin_amdgcn_readfirstlane(F.tid >> 6);
    F.G = gridDim.x; F.bid = blockIdx.x;
    F.ws = args.ws; F.out = args.out; F.ctl = (gu32*)(args.ws + WS_CTL);
    F.in = (const float* const __attribute__((address_space(4)))*)__builtin_amdgcn_kernarg_segment_ptr();
    for (int u = F.tid; u < (LDS_BYTES - LDSCTL_OFF) / 4; u += NTHREADS) ((LAS unsigned*)(F.lds + LDSCTL_OFF))[u] = 0u;
    __syncthreads();
    XcdBarrier bar; bar.bar = (unsigned*)(F.ctl + CW_BAR); bar.x = 0; bar.st = nullptr;
    if (!MK_SPLIT) bar = xcd_barrier_post((unsigned*)(F.ctl + CW_BAR), F.MISC + 8);
    const int lo = args.ph_lo, hi = args.ph_hi;
#define IN(k) (lo <= (k) && (k) < hi && phase_enter(F))
#define INR(k) (lo <= (k) && (k) < hi)
#define SEAM(k) do { if (INR(k) && INR((k) + 1)) xcd_barrier(bar); } while (0)

    if (IN(0)) { p0_prologue(F); if (DUP(0)) { __syncthreads(); p0_prologue(F); } } SEAM(0);
#pragma unroll 1
    for (int l = 0; l < DEPTH; ++l) {
        const int pb = 1 + 10 * l;
        if (IN(pb + 0)) { phase_norm1(F, l); if (DUP(13) && l == 0) { __syncthreads(); phase_norm1(F, l); } } SEAM(pb + 0);
        if (IN(pb + 1)) { PHASE_INPROJ(F, l); if (DUP(1)) { __syncthreads(); PHASE_INPROJ(F, l); } } SEAM(pb + 1);
        if (IN(pb + 2)) { PHASE_PREP(F, l); if (DUP(2)) { __syncthreads(); dn_prep(F, l); } if (DUP(6)) { __syncthreads(); lru_prep(F, l); } } SEAM(pb + 2);
        if (IN(pb + 3)) { if (DUP(3) && F.bid < 32) dn_scan(F, l, F.bid >> 3, (F.bid >> 1) & 3, F.bid & 1); PHASE_SCAN(F, l); if (DUP(10)) { __syncthreads(); naive_scan(F, l, 1); } if (DUP(11)) { __syncthreads(); attn_phase(F, l, 2); } if (DUP(12)) { __syncthreads(); convert_moe_queue(F, l, 3); } } SEAM(pb + 3);
        if (IN(pb + 4)) { PHASE_FIN(F, l); if (DUP(4)) { __syncthreads(); PHASE_FIN(F, l); } } SEAM(pb + 4);
        if (IN(pb + 5)) { PHASE_OUTPROJ(F, l); if (DUP(5) && l == 0) { __syncthreads(); PHASE_OUTPROJ(F, l); } } SEAM(pb + 5);
        if (IN(pb + 6)) { PHASE_NORM2(F, l); } SEAM(pb + 6);
        if (IN(pb + 7)) { PHASE_SCATTER(F, l); if (DUP(7)) { __syncthreads(); PHASE_SCATTER(F, l); } } SEAM(pb + 7);
        if (IN(pb + 8)) { PHASE_GEMM1(F, l); if (DUP(8)) { __syncthreads(); PHASE_GEMM1(F, l); } } SEAM(pb + 8);
        if (IN(pb + 9)) { PHASE_GEMM2(F, l); if (DUP(9)) { __syncthreads(); PHASE_GEMM2(F, l); } } SEAM(pb + 9);
    }
    if (IN(21)) { phase_final(F, MK_STAGE >= 9); if (DUP(13)) { __syncthreads(); phase_final(F, MK_STAGE >= 9); } }
#undef IN
#undef SEAM
}

extern "C" void kernel_launch(void* const* d_in, const int* in_sizes, int n_in, void* d_out, int out_size, void* d_ws, size_t ws_size, hipStream_t stream) {
    static int grid = 0;
    if (grid == 0) {
        if (n_in != N_IN || out_size != NLAT * DM || ws_size < WS_END) { fprintf(stderr, "kernel_launch: unexpected shapes (n_in %d, out %d, ws %zu); nothing launched\n", n_in, out_size, ws_size); grid = -1; return; }
        int dev = 0, cus = 0, per_cu = 0;
        if (hipGetDevice(&dev) != hipSuccess || hipDeviceGetAttribute(&cus, hipDeviceAttributeMultiprocessorCount, dev) != hipSuccess) { grid = -1; return; }
        if (hipFuncSetAttribute((const void*)fwd_kernel, hipFuncAttributeMaxDynamicSharedMemorySize, LDS_BYTES) != hipSuccess) { fprintf(stderr, "kernel_launch: hipFuncSetAttribute failed\n"); grid = -1; return; }
        if (hipOccupancyMaxActiveBlocksPerMultiprocessor(&per_cu, (const void*)fwd_kernel, NTHREADS, LDS_BYTES) != hipSuccess || per_cu < 1) { fprintf(stderr, "kernel_launch: occupancy query says %d\n", per_cu); }
        (void)hipGetLastError();
        grid = cus;
        if (grid != 256) { fprintf(stderr, "kernel_launch: built for 256 CUs, device has %d; nothing launched\n", cus); grid = -1; return; }
    }
    if (grid < 0) return;
    if (hipMemsetAsync((char*)d_ws + WS_CTL, 0, CTL_ZERO_BYTES, stream) != hipSuccess) return;
    Args a{};
    for (int i = 0; i < N_IN; ++i) a.in[i] = (const float*)d_in[i];
    a.out = (float*)d_out; a.ws = (unsigned char*)d_ws;
#if MK_SPLIT
    for (int p = 0; p < N_PHASES; ++p) { a.ph_lo = p; a.ph_hi = p + 1; hipLaunchKernelGGL(fwd_kernel, dim3(grid), dim3(NTHREADS), LDS_BYTES, stream, a); }
#else
    a.ph_lo = 0; a.ph_hi = N_PHASES;
    hipLaunchKernelGGL(fwd_kernel, dim3(grid), dim3(NTHREADS), LDS_BYTES, stream, a);
#endif
    const hipError_t le = hipPeekAtLastError();
    if (le != hipSuccess) fprintf(stderr, "kernel_launch: launch failed: %s\n", hipGetErrorName(le));
}
```

```cpp
#include <hip/hip_runtime.h>
#include <cstdio>
#include <cstdint>

constexpr int DM = 2048, NB = 4, SEQ = 4096, CTXL = 256, DEPTH = 2;
constexpr int NLAT = NB * SEQ, NCTX = NB * CTXL, NTOK = NLAT + NCTX;
constexpr int NCT = NTOK / 64;
constexpr int IN_W = 4624, PW = 4864;
constexpr int PC_Q = 0, PC_K = 1024, PC_V = 1280, PC_DQ = 1536, PC_DK = 2048, PC_DV = 2560, PC_DG = 3072, PC_LX = 3584, PC_LY = 4096, PC_BETA = 4608, PC_DEC = 4616;
constexpr int NEXP = 32, TOPK = 4, DEXP = 1024;
constexpr int MOE_ROWS = 304 * 256;
constexpr float EPS = 1e-6f;
#ifndef MK_STAGE
#define MK_STAGE 99
#endif
namespace pg8 {
#define PG8_LAS __attribute__((address_space(3)))
typedef unsigned short bf16_t;
typedef short bf16x8 __attribute__((ext_vector_type(8)));
typedef float f32x4 __attribute__((ext_vector_type(4)));
typedef unsigned u32x4 __attribute__((ext_vector_type(4)));
typedef float f32x2 __attribute__((ext_vector_type(2)));
constexpr int BM = 256, BK = 64, HALF = 128, HTB = HALF * BK * 2  , STAGE_BYTES = 8 * HTB, NXCD = 8, WGM = 8;

__host__ __device__ __forceinline__ int lds_byte(int r, int c) { const int st = (r >> 4) * 2 + (c >> 5), rr = r & 15, cc = c & 31, ob = rr * 64 + cc * 2; return st * 1024 + (ob ^ (((ob >> 9) & 1) << 5)); }
__host__ __device__ __forceinline__ void stage_rc(int b, int& R, int& C) { const int st = b / 1024, sb = b % 1024, swz = sb ^ (((sb >> 9) & 1) << 5); R = (st >> 1) * 16 + swz / 64; C = (st & 1) * 32 + (swz % 64) / 2; }
__host__ __device__ __forceinline__ int perm32(int rho) { const int n = rho >> 4, i = rho & 15; return 8 * (i >> 2) + 4 * n + (i & 3); }

struct Unit { int pm, pn, e; };
struct Gemm { const bf16_t* A; const bf16_t* Bt; int M, N, K; };

struct StaticOrder {
    static constexpr bool GATHER = false; const int* row_tab = nullptr;
    int nM, nN, nwg, G, c; const char* A; const char* Bt; size_t tstep;
    __device__ void init(const Gemm& g, int G_, int c_) { nM = g.M / BM; nN = g.N / BM; nwg = nM * nN; G = G_; c = c_; A = (const char*)g.A; Bt = (const char*)g.Bt; tstep = (size_t)BM * g.K * 2; }
    __device__ bool next(int i, Unit& u) const {
        const long L = (long)i * G + c; if (L >= nwg) return false;
        int wgid = (int)L; { const int q = nwg / NXCD, r = nwg % NXCD, xcd = wgid % NXCD, off = wgid / NXCD; wgid = (xcd < r ? xcd * (q + 1) : r * (q + 1) + (xcd - r) * q) + off; }
        const int nig = WGM * nN, gid = wgid / nig, fm = gid * WGM, gsz = (nM - fm) < WGM ? (nM - fm) : WGM;
        u.pm = fm + ((wgid % nig) % gsz); u.pn = (wgid % nig) / gsz; u.e = 0; return true;
    }
    __device__ __forceinline__ const char* a_ptr(const Unit& u) const { return A + (size_t)u.pm * tstep; }
    __device__ __forceinline__ const char* b_ptr(const Unit& u) const { return Bt + (size_t)u.pn * tstep; }
    __device__ __forceinline__ void a_ready(const Unit&) const {}
    __device__ __forceinline__ void done(const Unit&) const {}
};
__device__ __forceinline__ unsigned cvt_pk_bf16(float lo, float hi) { unsigned r; asm volatile("v_cvt_pk_bf16_f32 %0, %1, %2" : "=v"(r) : "v"(lo), "v"(hi)); return r; }
struct EpiBf16Plain {
    static constexpr bool PERM = true, AFTER_DRAIN = false;
    bf16_t* O; int ldc;
    __device__ __forceinline__ void operator()(const f32x4 (&acc)[2][2][4][2], const Unit& u, int wr, int wc, int fr, int fq) const {
        const int row0 = u.pm * BM + wr * 64 + fr, col0 = u.pn * BM + wc * 32 + 8 * fq;
#pragma unroll
        for (int ai = 0; ai < 2; ++ai)
#pragma unroll
            for (int m = 0; m < 4; ++m) { bf16_t* rowp = O + (size_t)(row0 + ai * HALF + m * 16) * ldc + col0;
#pragma unroll
                for (int bj = 0; bj < 2; ++bj) { const f32x4 v0 = acc[ai][bj][m][0], v1 = acc[ai][bj][m][1];
                    u32x4 w; w.x = cvt_pk_bf16(v0[0], v0[1]); w.y = cvt_pk_bf16(v0[2], v0[3]); w.z = cvt_pk_bf16(v1[0], v1[1]); w.w = cvt_pk_bf16(v1[2], v1[3]);
                    *(u32x4*)(rowp + bj * HALF) = w; } }
    }
};
struct EpiResGate {
    static constexpr bool PERM = false, AFTER_DRAIN = false;
    const float* base_lat; const float* base_ctx; float* out; const float* modg;
    __device__ __forceinline__ void operator()(const f32x4 (&acc)[2][2][4][2], const Unit& u, int wr, int wc, int fr, int fq) const {
        const int r = u.pm < 64 ? (u.pm >> 4) : 4; const int col0 = u.pn * BM + wc * 32 + 4 * fq;
        const float* g = modg + (size_t)r * 12288 + col0;
        f32x4 gv[2][2];
#pragma unroll
        for (int bj = 0; bj < 2; ++bj)
#pragma unroll
            for (int n = 0; n < 2; ++n) gv[bj][n] = *(const f32x4*)(g + bj * HALF + n * 16);
#pragma unroll
        for (int ai = 0; ai < 2; ++ai)
#pragma unroll
            for (int m = 0; m < 4; ++m) { const int row = u.pm * BM + ai * HALF + wr * 64 + m * 16 + fr;
                const float* bp = (row < 16384 ? base_lat + (size_t)row * 2048 : base_ctx + (size_t)(row - 16384) * 2048) + col0; float* op = out + (size_t)row * 2048 + col0;
#pragma unroll
                for (int bj = 0; bj < 2; ++bj)
#pragma unroll
                    for (int n = 0; n < 2; ++n) { const f32x4 b = *(const f32x4*)(bp + bj * HALF + n * 16); *(f32x4*)(op + bj * HALF + n * 16) = b + gv[bj][n] * acc[ai][bj][m][n]; }
                asm volatile("" ::: "memory"); }
    }
};
struct EpiSwiglu {
    static constexpr bool PERM = true, AFTER_DRAIN = false;
    bf16_t* O; const float* bgu;
    __device__ __forceinline__ void operator()(const f32x4 (&acc)[2][2][4][2], const Unit& u, int wr, int wc, int fr, int fq) const {
        const int row0 = u.pm * BM + wr * 64 + fr, cc0 = wc * 32 + 8 * fq;
        const float* bg = bgu + (size_t)u.e * 2048 + u.pn * 128 + cc0;
        f32x4 bglu[2], blin[2];
#pragma unroll
        for (int n = 0; n < 2; ++n) { bglu[n] = *(const f32x4*)(bg + 4 * n); blin[n] = *(const f32x4*)(bg + 1024 + 4 * n); }
#pragma unroll
        for (int ai = 0; ai < 2; ++ai)
#pragma unroll
            for (int m = 0; m < 4; ++m) { bf16_t* rowp = O + (size_t)(row0 + ai * HALF + m * 16) * 1024 + u.pn * 128 + cc0;
                float r[8];
#pragma unroll
                for (int n = 0; n < 2; ++n) { const f32x4 g = acc[ai][0][m][n] + bglu[n], l = acc[ai][1][m][n] + blin[n];
#pragma unroll
                    for (int i = 0; i < 4; ++i) { const float gg = fminf(g[i], 7.0f); const float ll = fminf(fmaxf(l[i], -7.0f), 7.0f);
                        r[4 * n + i] = (ll + 1.0f) * gg * (1.0f / (1.0f + __expf(-1.702f * gg))); } }
                u32x4 w; w.x = cvt_pk_bf16(r[0], r[1]); w.y = cvt_pk_bf16(r[2], r[3]); w.z = cvt_pk_bf16(r[4], r[5]); w.w = cvt_pk_bf16(r[6], r[7]);
                *(u32x4*)rowp = w; }
    }
};
struct EpiDown {
    static constexpr bool PERM = true, AFTER_DRAIN = false;
    bf16_t* O; const float* bdn; const float* rowg;
    __device__ __forceinline__ void operator()(const f32x4 (&acc)[2][2][4][2], const Unit& u, int wr, int wc, int fr, int fq) const {
        const int row0 = u.pm * BM + wr * 64 + fr, col0 = u.pn * BM + wc * 32 + 8 * fq;
        const float* bb = bdn + (size_t)u.e * 2048 + col0;
        f32x4 bv[2][2];
#pragma unroll
        for (int bj = 0; bj < 2; ++bj)
#pragma unroll
            for (int n = 0; n < 2; ++n) bv[bj][n] = *(const f32x4*)(bb + bj * HALF + 4 * n);
#pragma unroll
        for (int ai = 0; ai < 2; ++ai)
#pragma unroll
            for (int m = 0; m < 4; ++m) { const int row = row0 + ai * HALF + m * 16; const float gt = rowg[row]; bf16_t* rowp = O + (size_t)row * 2048 + col0;
#pragma unroll
                for (int bj = 0; bj < 2; ++bj) { const f32x4 v0 = (acc[ai][bj][m][0] + bv[bj][0]) * gt, v1 = (acc[ai][bj][m][1] + bv[bj][1]) * gt;
                    u32x4 w; w.x = cvt_pk_bf16(v0[0], v0[1]); w.y = cvt_pk_bf16(v0[2], v0[3]); w.z = cvt_pk_bf16(v1[0], v1[1]); w.w = cvt_pk_bf16(v1[2], v1[3]);
                    *(u32x4*)(rowp + bj * HALF) = w; } }
    }
};
template <bool GATHER_> struct MoeOrderT {
    static constexpr bool GATHER = GATHER_;
    int c, nblk; const char* A; const char* Bt; size_t a_tstep, b_estep, b_tstep; const PG8_LAS int* blk_end; const int* row_tab;
    __device__ __forceinline__ bool next(int i, Unit& u) const {
        const int x = c & 7, j = c >> 3, gi = i * 8 + x, rb = 4 * gi + (j >> 3);
        if (rb >= nblk) return false;
        int e = 0;
        for (int k = 0; k < 31; ++k) e += (rb >= blk_end[k]) ? 1 : 0;
        u.pm = rb; u.pn = j & 7; u.e = __builtin_amdgcn_readfirstlane(e); return true;
    }
    __device__ __forceinline__ const char* a_ptr(const Unit& u) const { return GATHER ? A : A + (size_t)u.pm * a_tstep; }
    __device__ __forceinline__ const char* b_ptr(const Unit& u) const { return Bt + (size_t)u.e * b_estep + (size_t)u.pn * b_tstep; }
    __device__ __forceinline__ void a_ready(const Unit&) const {}
    __device__ __forceinline__ void done(const Unit&) const {}
};
typedef MoeOrderT<false> MoeOrder;
typedef MoeOrderT<true> MoeOrderG;
template <class Epi, class Sched, bool ALIGN_EPI = false, bool SP2 = false>
__device__ __forceinline__ void gemm_phase(PG8_LAS unsigned char* lds, const Gemm g, const Sched& S, const Epi& E) {
    int tid = threadIdx.x; asm volatile("" : "+v"(tid));
    const int wid = __builtin_amdgcn_readfirstlane(tid >> 6), lane = tid & 63, wr = wid >> 2, wc = wid & 3, fr = lane & 15, fq = lane >> 4;
    const int K = g.K, nt = K / BK;
    unsigned voffA[2], voffB[2];
#pragma unroll
    for (int i = 0; i < 2; ++i) { int R, C; stage_rc(tid * 16 + i * 8192, R, C); const int Rb = Epi::PERM ? ((R & ~31) + perm32(R & 31)) : R;
        voffA[i] = (unsigned)(R * K + C) * 2u; voffB[i] = (unsigned)(Rb * K + C) * 2u; }
    unsigned gc0[2] = {0u, 0u}, gc1[2] = {0u, 0u}; int gR = 0, gC = 0;
    if constexpr (Sched::GATHER) { stage_rc(tid * 16, gR, gC); }
#define PG8_GLOAD(dst0, dst1, u) do { const int* _rt = S.row_tab + (size_t)(u).pm * BM + gR; \
        dst0[0] = (unsigned)_rt[0] * (unsigned)(K * 2) + (unsigned)(gC * 2); dst0[1] = (unsigned)_rt[64] * (unsigned)(K * 2) + (unsigned)(gC * 2); \
        dst1[0] = (unsigned)_rt[128] * (unsigned)(K * 2) + (unsigned)(gC * 2); dst1[1] = (unsigned)_rt[192] * (unsigned)(K * 2) + (unsigned)(gC * 2); } while (0)
    const size_t kstep = (size_t)(BK * 2);
    const size_t hstep = (size_t)HALF * K * 2;
    const size_t tstep = 2 * hstep;
    const unsigned ldsw = (unsigned)wid * 1024u;
    const int aoff = lds_byte(wr * 64 + fr, fq * 8), boff = lds_byte(wc * 32 + fr, fq * 8);
#define PG8_SA(b, h) (((b) * 2 + (h)) * HTB)
#define PG8_SB(b, h) ((4 + (b) * 2 + (h)) * HTB)
#define PG8_STAGE(bufoff, gbase, voff) do { _Pragma("unroll") for (int _i = 0; _i < 2; ++_i) \
        __builtin_amdgcn_global_load_lds((const unsigned*)((const char*)(gbase) + (voff)[_i]), (PG8_LAS unsigned*)(lds + (bufoff) + ldsw + _i * 8192), 16, 0, 0); } while (0)
#define PG8_LDA(dst, b, h) do { _Pragma("unroll") for (int m = 0; m < 4; ++m) _Pragma("unroll") for (int k = 0; k < 2; ++k) dst[m][k] = *(const PG8_LAS bf16x8*)(lds + PG8_SA(b, h) + aoff + m * 2048 + k * 1024); } while (0)
#define PG8_LDB(dst, b, h) do { _Pragma("unroll") for (int n = 0; n < 2; ++n) _Pragma("unroll") for (int k = 0; k < 2; ++k) dst[n][k] = *(const PG8_LAS bf16x8*)(lds + PG8_SB(b, h) + boff + n * 2048 + k * 1024); } while (0)
#define PG8_MMA(ai, bj, At, Bt) do { __builtin_amdgcn_s_setprio(1); _Pragma("unroll") for (int m = 0; m < 4; ++m) _Pragma("unroll") for (int n = 0; n < 2; ++n) _Pragma("unroll") for (int k = 0; k < 2; ++k) \
        acc[ai][bj][m][n] = __builtin_amdgcn_mfma_f32_16x16x32_bf16(Bt[n][k], At[m][k], acc[ai][bj][m][n], 0, 0, 0); __builtin_amdgcn_s_setprio(0); } while (0)
#define PG8_WAIT_V(n) asm volatile("s_waitcnt vmcnt(" #n ")" ::: "memory")
#define PG8_WAIT_L(n) asm volatile("s_waitcnt lgkmcnt(" #n ")" ::: "memory")
#define PG8_BAR __builtin_amdgcn_s_barrier()
#define PG8_SCHED __builtin_amdgcn_sched_barrier(0)
    Unit cur, nxt; int ui = 0;
    if (!S.next(0, cur)) return;
    f32x4 acc[2][2][4][2];
#pragma unroll
    for (int a = 0; a < 2; ++a)
#pragma unroll
        for (int b = 0; b < 2; ++b)
#pragma unroll
            for (int m = 0; m < 4; ++m)
#pragma unroll
                for (int n = 0; n < 2; ++n) acc[a][b][m][n] = (f32x4){0.f, 0.f, 0.f, 0.f};
    bf16x8 At[4][2], B0[2][2], B1[2][2];
    const char* cA = S.a_ptr(cur); const char* cB = S.b_ptr(cur);
    S.a_ready(cur);
    if constexpr (SP2) {
        if constexpr (Sched::GATHER) { PG8_GLOAD(gc0, gc1, cur);
        PG8_STAGE(PG8_SB(0, 0), cB, voffB); PG8_STAGE(PG8_SB(0, 1), cB + hstep, voffB); PG8_STAGE(PG8_SA(0, 0), cA, gc0); PG8_STAGE(PG8_SA(0, 1), cA, gc1);
        if (wr == 1) PG8_BAR;
        PG8_WAIT_V(2); PG8_BAR;
        PG8_STAGE(PG8_SB(1, 0), cB + kstep, voffB); PG8_STAGE(PG8_SA(1, 0), cA + kstep, gc0); PG8_STAGE(PG8_SB(1, 1), cB + hstep + kstep, voffB);
        } else {
        PG8_STAGE(PG8_SB(0, 0), cB, voffB); PG8_STAGE(PG8_SB(0, 1), cB + hstep, voffB); PG8_STAGE(PG8_SA(0, 0), cA, voffA); PG8_STAGE(PG8_SA(0, 1), cA + hstep, voffA);
        if (wr == 1) PG8_BAR;
        PG8_WAIT_V(2); PG8_BAR;
        PG8_STAGE(PG8_SB(1, 0), cB + kstep, voffB); PG8_STAGE(PG8_SA(1, 0), cA + kstep, voffA); PG8_STAGE(PG8_SB(1, 1), cB + hstep + kstep, voffB);
        }
        PG8_WAIT_V(6); PG8_BAR;
    } else {
        PG8_STAGE(PG8_SB(0, 0), cB, voffB); PG8_STAGE(PG8_SA(0, 0), cA, voffA); PG8_STAGE(PG8_SB(0, 1), cB + hstep, voffB); PG8_STAGE(PG8_SA(0, 1), cA + hstep, voffA);
        if (wr == 1) PG8_BAR;
        PG8_WAIT_V(4); PG8_BAR;
        PG8_STAGE(PG8_SB(1, 0), cB + kstep, voffB); PG8_STAGE(PG8_SA(1, 0), cA + kstep, voffA); PG8_STAGE(PG8_SB(1, 1), cB + hstep + kstep, voffB);
        PG8_WAIT_V(6); PG8_BAR;
    }
    for (;;) {
        const bool has_next = S.next(ui + 1, nxt);
        const char* nA = has_next ? S.a_ptr(nxt) : cA; const char* nB = has_next ? S.b_ptr(nxt) : cB;
        for (int t = 0; t < nt; t += 2) {
            const bool last = (t == nt - 2);
            const char* a1 = cA + (size_t)(t + 1) * kstep;
            const char* a2 = last ? nA : cA + (size_t)(t + 2) * kstep; const char* b2 = last ? nB : cB + (size_t)(t + 2) * kstep;
            const char* a3 = a2 + kstep; const char* b3 = b2 + kstep;
            if (last && has_next) S.a_ready(nxt);

            if constexpr (SP2) {
            PG8_LDB(B0, 0, 0); PG8_LDB(B1, 0, 1); PG8_SCHED; PG8_LDA(At, 0, 0); if constexpr (Sched::GATHER) PG8_STAGE(PG8_SA(1, 1), a1, gc1); else PG8_STAGE(PG8_SA(1, 1), a1 + hstep, voffA);
            if constexpr (Sched::GATHER) { if (last && has_next) PG8_GLOAD(gc0, gc1, nxt); }
            PG8_WAIT_V(8); PG8_WAIT_L(0); PG8_BAR; PG8_MMA(0, 0, At, B0); PG8_MMA(0, 1, At, B1); PG8_BAR; PG8_SCHED;
            PG8_LDA(At, 0, 1); PG8_STAGE(PG8_SB(0, 0), b2, voffB); PG8_STAGE(PG8_SB(0, 1), b2 + hstep, voffB); if constexpr (Sched::GATHER) PG8_STAGE(PG8_SA(0, 0), a2, gc0); else PG8_STAGE(PG8_SA(0, 0), a2, voffA);
            PG8_WAIT_V(8); PG8_WAIT_L(0); PG8_BAR; PG8_MMA(1, 0, At, B0); PG8_MMA(1, 1, At, B1); PG8_BAR; PG8_SCHED;
            PG8_LDB(B0, 1, 0); PG8_LDB(B1, 1, 1); PG8_SCHED; PG8_LDA(At, 1, 0); if constexpr (Sched::GATHER) PG8_STAGE(PG8_SA(0, 1), a2, gc1); else PG8_STAGE(PG8_SA(0, 1), a2 + hstep, voffA);
            PG8_WAIT_V(8); PG8_WAIT_L(0); PG8_BAR; PG8_MMA(0, 0, At, B0); PG8_MMA(0, 1, At, B1); PG8_BAR; PG8_SCHED;
            PG8_LDA(At, 1, 1); PG8_STAGE(PG8_SB(1, 0), b3, voffB); PG8_STAGE(PG8_SB(1, 1), b3 + hstep, voffB); if constexpr (Sched::GATHER) PG8_STAGE(PG8_SA(1, 0), a3, gc0); else PG8_STAGE(PG8_SA(1, 0), a3, voffA);
            PG8_WAIT_V(8); PG8_WAIT_L(0); PG8_BAR; PG8_MMA(1, 0, At, B0); PG8_MMA(1, 1, At, B1); PG8_BAR; PG8_SCHED;
            } else {
            PG8_LDB(B0, 0, 0); PG8_SCHED; PG8_LDA(At, 0, 0); PG8_STAGE(PG8_SA(1, 1), a1 + hstep, voffA);
            PG8_WAIT_L(8); PG8_BAR; PG8_WAIT_L(0); PG8_MMA(0, 0, At, B0); PG8_BAR; PG8_SCHED;
            PG8_LDB(B1, 0, 1); PG8_STAGE(PG8_SB(0, 0), b2, voffB);
            PG8_BAR; PG8_WAIT_L(0); PG8_MMA(0, 1, At, B1); PG8_BAR;
            PG8_LDA(At, 0, 1); PG8_STAGE(PG8_SA(0, 0), a2, voffA);
            PG8_BAR; PG8_WAIT_L(0); PG8_MMA(1, 0, At, B0); PG8_BAR; PG8_SCHED;
            PG8_STAGE(PG8_SB(0, 1), b2 + hstep, voffB);
            PG8_WAIT_V(6); PG8_BAR; PG8_MMA(1, 1, At, B1); PG8_BAR;
            PG8_LDB(B0, 1, 0); PG8_SCHED; PG8_LDA(At, 1, 0); PG8_STAGE(PG8_SA(0, 1), a2 + hstep, voffA);
            PG8_WAIT_L(8); PG8_BAR; PG8_WAIT_L(0); PG8_MMA(0, 0, At, B0); PG8_BAR; PG8_SCHED;
            PG8_LDB(B1, 1, 1); PG8_STAGE(PG8_SB(1, 0), b3, voffB);
            PG8_BAR; PG8_WAIT_L(0); PG8_MMA(0, 1, At, B1); PG8_BAR;
            PG8_LDA(At, 1, 1); PG8_STAGE(PG8_SA(1, 0), a3, voffA);
            PG8_BAR; PG8_WAIT_L(0); PG8_MMA(1, 0, At, B0); PG8_BAR; PG8_SCHED;
            PG8_STAGE(PG8_SB(1, 1), b3 + hstep, voffB);
            PG8_WAIT_V(6); PG8_BAR; PG8_MMA(1, 1, At, B1); PG8_BAR;
            }
        }
        if constexpr (ALIGN_EPI) { if (wr == 0) PG8_BAR; }
        if constexpr (!Epi::AFTER_DRAIN) { int fr_e = fr, fq_e = fq; asm volatile("" : "+v"(fr_e), "+v"(fq_e));
            E(acc, cur, wr, wc, fr_e, fq_e); S.done(cur); }
        if (!has_next) break;
#pragma unroll
        for (int a = 0; a < 2; ++a)
#pragma unroll
            for (int b = 0; b < 2; ++b)
#pragma unroll
                for (int m = 0; m < 4; ++m)
#pragma unroll
                    for (int n = 0; n < 2; ++n) acc[a][b][m][n] = (f32x4){0.f, 0.f, 0.f, 0.f};
        cur = nxt; cA = nA; cB = nB; ++ui;
        if constexpr (ALIGN_EPI) { if (wr == 1) PG8_BAR; }
    }
    PG8_WAIT_V(0);
    if constexpr (!ALIGN_EPI) { if (wr == 0) PG8_BAR; }
    PG8_BAR;
    if constexpr (Epi::AFTER_DRAIN) { E.fused(acc, cur, wr, wc, fr, fq, lds, wid, lane); S.done(cur); }
#undef PG8_GLOAD
#undef PG8_SA
#undef PG8_SB
#undef PG8_STAGE
#undef PG8_LDA
#undef PG8_LDB
#undef PG8_MMA
#undef PG8_WAIT_V
#undef PG8_WAIT_L
#undef PG8_BAR
#undef PG8_SCHED
}
}

constexpr size_t MiB = 1u << 20;
constexpr size_t WS_CTL = 0, CTL_ZERO_BYTES = 1 * MiB;
constexpr size_t WS_MOD  = 1 * MiB;
constexpr size_t WS_WRT  = 2 * MiB;
constexpr size_t WS_MOEI = 3 * MiB;
constexpr size_t WS_LRC  = 6 * MiB;
constexpr size_t WS_DNS  = 12 * MiB;
constexpr size_t WS_WIN  = 16 * MiB;
constexpr size_t WS_WOUT = 56 * MiB;
constexpr size_t WS_WGU  = 72 * MiB;
constexpr size_t WS_WDN  = 584 * MiB;
constexpr size_t WS_X    = 840 * MiB;
constexpr size_t WS_H    = 976 * MiB;
constexpr size_t WS_P    = 1044 * MiB;
constexpr size_t WS_CC   = 1206 * MiB;
constexpr size_t WS_VT   = 1274 * MiB;
constexpr size_t WS_VTC  = WS_VT + 8 * MiB;
constexpr size_t WS_DNT  = 1284 * MiB;
constexpr size_t DNT_BYTES = 90112;
constexpr size_t WS_DNO  = 1472 * MiB;
constexpr size_t WS_LRH  = 1540 * MiB;
constexpr size_t WS_LRA  = 1608 * MiB;
constexpr size_t WS_XS   = 1676 * MiB;
constexpr size_t WS_ACT  = 1980 * MiB;
constexpr size_t WS_YS   = 2132 * MiB;
constexpr size_t WS_END  = 2436 * MiB;
constexpr int CW_TMO = 0;
constexpr int CW_BAR = 4096;
constexpr int CW_CNT = 8192;
constexpr int CW_ATQ = 12288;

constexpr int RING_OFF = 0, RING_BYTES = 131072;
constexpr int LDSCTL_OFF = RING_BYTES, MISC_OFF = LDSCTL_OFF + 320;
constexpr int LDS_X_OFF = RING_BYTES + 1024;
constexpr int LDS_BYTES = 147456;
constexpr int NWAVES = 8, NTHREADS = 512;

#define GAS __attribute__((address_space(1)))
#define LAS __attribute__((address_space(3)))
typedef unsigned short bf16;
typedef unsigned v4u __attribute__((ext_vector_type(4)));
typedef unsigned v2u __attribute__((ext_vector_type(2)));
typedef float f32x4 __attribute__((ext_vector_type(4)));
typedef float f32x16 __attribute__((ext_vector_type(16)));
typedef short bf16x8 __attribute__((ext_vector_type(8)));
typedef short bf16x4 __attribute__((ext_vector_type(4)));
typedef GAS unsigned gu32;
#define RLX_AGENT __ATOMIC_RELAXED, __HIP_MEMORY_SCOPE_AGENT
#define LDS_WAIT() asm volatile("s_waitcnt lgkmcnt(0)" ::: "memory")
#define VM_WAIT() asm volatile("s_waitcnt vmcnt(0)" ::: "memory")
__device__ __forceinline__ unsigned f2bf(float f) { unsigned u = __builtin_bit_cast(unsigned, f); return (u + 0x7fffu + ((u >> 16) & 1u)) >> 16; }
__device__ __forceinline__ unsigned pk2(float lo, float hi) { return pg8::cvt_pk_bf16(lo, hi); }
__device__ __forceinline__ float bf2f(unsigned short b) { return __builtin_bit_cast(float, (unsigned)b << 16); }
__device__ __forceinline__ float bflo(unsigned w) { return __builtin_bit_cast(float, w << 16); }
__device__ __forceinline__ float bfhi(unsigned w) { return __builtin_bit_cast(float, w & 0xffff0000u); }
template <int CTRL> __device__ __forceinline__ float dpp_mov(float v) { return __builtin_bit_cast(float, __builtin_amdgcn_update_dpp(0, __builtin_bit_cast(int, v), CTRL, 0xF, 0xF, false)); }
__device__ __forceinline__ float wave_sum(float v) {
    v += dpp_mov<0xB1>(v); v += dpp_mov<0x4E>(v); v += dpp_mov<0x141>(v); v += dpp_mov<0x140>(v);
    const int iv = __builtin_bit_cast(int, v);
    const float r0 = __builtin_bit_cast(float, __builtin_amdgcn_readlane(iv, 0)), r1 = __builtin_bit_cast(float, __builtin_amdgcn_readlane(iv, 16)), r2 = __builtin_bit_cast(float, __builtin_amdgcn_readlane(iv, 32)), r3 = __builtin_bit_cast(float, __builtin_amdgcn_readlane(iv, 48));
    return (r0 + r1) + (r2 + r3);
}
__device__ __forceinline__ float sigmoidf_(float x) { return 1.0f / (1.0f + __expf(-x)); }
__device__ __forceinline__ float siluf_(float x) { return x / (1.0f + __expf(-x)); }
__device__ __forceinline__ float softplusf_(float x) { return x > 20.f ? x : log1pf(__expf(x)); }

#define XB_TMO      128
#define XB_XCNT(j)  (256  + 64 * (j))
#define XB_XSUB(j)  (1280 + 64 * (j))
#define XB_XGEN(j)  (2304 + 64 * (j))
#define XB_TOP      3328
#define XB_TOPGEN   3392
#define XCD_BAR_WORDS 3456
#define XB_SPIN_CAP (1u << 18)

__device__ __forceinline__ unsigned xb_ld(unsigned* p)              { return __hip_atomic_load(p, __ATOMIC_RELAXED, __HIP_MEMORY_SCOPE_AGENT); }
__device__ __forceinline__ unsigned xb_add(unsigned* p, unsigned v) { return __hip_atomic_fetch_add(p, v, __ATOMIC_RELAXED, __HIP_MEMORY_SCOPE_AGENT); }
__device__ __forceinline__ unsigned xb_xcc_id() { return (unsigned)__builtin_amdgcn_s_getreg((3 << 11) | 20) & 0xFu; }
#define XB_SPIN(cond, bar) do { unsigned _sp = 0; while (cond) { __builtin_amdgcn_s_sleep(1); \
    if ((++_sp & 255u) == 0u) { if (xb_ld(&(bar)[XB_TMO])) break; if (_sp > XB_SPIN_CAP) { atomicAdd(&(bar)[XB_TMO], 1u); break; } } } } while (0)

struct XcdBarrier {
    unsigned* bar; unsigned x;
    volatile LAS unsigned* st;
};

__device__ __forceinline__ XcdBarrier xcd_barrier_post(unsigned* bar, volatile LAS unsigned* st) {
    XcdBarrier b; b.bar = bar; b.x = xb_xcc_id(); b.st = st;
    if (threadIdx.x == 0) (void)xb_add(&bar[XB_XCNT(b.x)], 1u);
    return b;
}
__device__ __forceinline__ void xcd_barrier_complete(unsigned* bar, unsigned x, unsigned& nloc, unsigned& nx) {
    const unsigned G = gridDim.x * gridDim.y * gridDim.z;
    unsigned sum, cnt, mine, sp = 0u;
    for (;;) {
        sum = 0u; cnt = 0u; mine = 0u;
#pragma unroll
        for (unsigned j = 0; j < 16; ++j) { const unsigned c = xb_ld(&bar[XB_XCNT(j)]); sum += c; cnt += (c > 0u) ? 1u : 0u; mine = (j == x) ? c : mine; }
        if (sum == G) break;
        __builtin_amdgcn_s_sleep(1);
        if ((++sp & 255u) == 0u) { if (xb_ld(&bar[XB_TMO])) break; if (sp > XB_SPIN_CAP) { atomicAdd(&bar[XB_TMO], 1u); break; } }
    }
    nloc = mine > 0u ? mine : 1u; nx = cnt > 0u ? cnt : 1u;
}

__device__ __forceinline__ void xcd_barrier(const XcdBarrier& b) {
    asm volatile("s_waitcnt vmcnt(0)" ::: "memory");
    __syncthreads();
    if (threadIdx.x == 0) {
        unsigned* bar = b.bar;
        __builtin_amdgcn_s_waitcnt(0);
        unsigned nloc = b.st[0], nx = b.st[1];
        if (nloc == 0u) { xcd_barrier_complete(bar, b.x, nloc, nx); b.st[0] = nloc; b.st[1] = nx; }
        const unsigned old = xb_add(&bar[XB_XSUB(b.x)], 1u);
        const unsigned gen = old / nloc;
        if (old + 1u == (gen + 1u) * nloc) {
            __builtin_amdgcn_fence(__ATOMIC_RELEASE, "agent");
            asm volatile("s_waitcnt vmcnt(0)" ::: "memory");
            const unsigned og = xb_add(&bar[XB_TOP], 1u);
            const unsigned tg = og / nx;
            if (og + 1u == (tg + 1u) * nx) xb_add(&bar[XB_TOPGEN], 1u);
            else XB_SPIN(xb_ld(&bar[XB_TOPGEN]) == tg, bar);
            __builtin_amdgcn_fence(__ATOMIC_ACQUIRE, "agent");
            xb_add(&bar[XB_XGEN(b.x)], 1u);
            asm volatile("s_waitcnt vmcnt(0)" ::: "memory");
        } else {
            XB_SPIN(xb_ld(&bar[XB_XGEN(b.x)]) == gen, bar);
            __builtin_amdgcn_fence(__ATOMIC_ACQUIRE, "agent");
            asm volatile("s_waitcnt vmcnt(0)" ::: "memory");
        }
    }
    __syncthreads();
}

enum InIdx { I_X = 0, I_C, I_CTX, I_CCTX, I_WMOD, I_BMOD, I_NMG, I_NFG, I_WIN, I_WOUT, I_SINK, I_DNCW, I_DNALOG, I_DNDT, I_DNNG, I_LRCW, I_LRCB, I_LRWR, I_LRBR, I_LRWI, I_LRBI, I_LRLAM,
             I_WROUT, I_BROUT, I_WGU, I_BGU, I_WDN, I_BDN, I_FNG, N_IN };
struct Frame {
    LAS unsigned char* lds;
    volatile LAS unsigned* MISC;
    gu32* ctl;
    int tid, lane, wave, G, bid;
    const float* const __attribute__((address_space(4)))* in;
    float* out; unsigned char* ws;
};
__device__ __forceinline__ int mod_row(int m) { return m < NLAT ? (m >> 12) : 4; }
__device__ __forceinline__ bool phase_enter(Frame& F) { int t = threadIdx.x; asm volatile("" : "+v"(t)); F.tid = t; F.lane = t & 63; F.wave = __builtin_amdgcn_readfirstlane(t >> 6); return true; }
__device__ __forceinline__ void seq_of(int m, int& t, int& T, int& base) { if (m < NLAT) { t = m & 4095; T = SEQ; base = m - t; } else { t = (m - NLAT) & 255; T = CTXL; base = m - t; } }
__device__ __forceinline__ float gelu_tanh(float x) { const float u = 0.7978845608028654f * (x + 0.044715f * x * x * x); return 0.5f * x * (1.0f + tanhf(u)); }

__device__ __forceinline__ void transpose_item(const float* W, int K, int N, bf16* WT, int k0, int dstrow0, int srccol0, int nvalid, LAS float* scr, int lane) {
    { const int c4 = (lane & 7) * 4, kr = lane >> 3; f32x4 v[8];
#pragma unroll
      for (int i = 0; i < 8; ++i) { v[i] = (f32x4){0.f, 0.f, 0.f, 0.f}; if (c4 < nvalid) v[i] = *(const f32x4*)(W + (size_t)(k0 + 8 * i + kr) * N + srccol0 + c4); }
#pragma unroll
      for (int i = 0; i < 8; ++i) { LAS float* d = scr + (8 * i + kr) * 33 + c4; d[0] = v[i].x; d[1] = v[i].y; d[2] = v[i].z; d[3] = v[i].w; } }
    LDS_WAIT(); asm volatile("" ::: "memory");
    const int c = lane & 7;
#pragma unroll
    for (int jj = 0; jj < 4; ++jj) { const int n = (lane >> 3) + 8 * jj; const LAS float* s = scr + (8 * c) * 33 + n;
        v4u o; o.x = pk2(s[0 * 33], s[1 * 33]); o.y = pk2(s[2 * 33], s[3 * 33]); o.z = pk2(s[4 * 33], s[5 * 33]); o.w = pk2(s[6 * 33], s[7 * 33]);
        *(GAS v4u*)(WT + (size_t)(dstrow0 + n) * K + k0 + 8 * c) = o; }
    LDS_WAIT(); asm volatile("" ::: "memory");
}
__device__ __forceinline__ void p0_prologue(Frame& F) {
    {
        LAS float* sc = (LAS float*)(F.lds);
        LAS float* red = (LAS float*)(F.lds + 40960);
        bool have_sc = false;
        for (int wb = F.bid; wb < 192; wb += F.G) {
            if (!have_sc) {
                for (int i = F.tid; i < 5 * 2048; i += NTHREADS) { const int r = i >> 11, k = i & 2047; const float cv = r < 4 ? F.in[I_C][r * 2048 + k] : F.in[I_CCTX][k]; sc[i] = siluf_(cv); }
                have_sc = true; __syncthreads();
            }
            const int l = wb / 96, cb = wb % 96, kp = F.tid >> 5, cg = F.tid & 31, j0 = cb * 128 + cg * 4;
            const float* wp = F.in[I_WMOD] + ((size_t)l * 2048 + kp * 128) * 12288 + j0;
            f32x4 acc[5];
#pragma unroll
            for (int r = 0; r < 5; ++r) acc[r] = (f32x4){0.f, 0.f, 0.f, 0.f};
#pragma unroll 4
            for (int k = 0; k < 128; ++k) { const f32x4 w = *(const f32x4*)(wp + (size_t)k * 12288);
#pragma unroll
                for (int r = 0; r < 5; ++r) acc[r] += sc[r * 2048 + kp * 128 + k] * w; }
#pragma unroll
            for (int r = 0; r < 5; ++r) *(LAS f32x4*)(red + (kp * 5 + r) * 128 + cg * 4) = acc[r];
            __syncthreads();
            for (int i = F.tid; i < 640; i += NTHREADS) { const int r = i >> 7, col = i & 127; float s = F.in[I_BMOD][l * 12288 + cb * 128 + col];
#pragma unroll
                for (int q = 0; q < 16; ++q) s += red[(q * 5 + r) * 128 + col];
                ((float*)(F.ws + WS_MOD))[(size_t)(l * 5 + r) * 12288 + cb * 128 + col] = s; }
            __syncthreads();
        }
        __syncthreads();
    }
    {
        LAS float* scr = (LAS float*)(F.lds + F.wave * 16384);
        const int gw = F.bid * NWAVES + F.wave, NGW = F.G * NWAVES;
        constexpr int I_IN = 32 * 152, I_OUT = 32 * 64, I_RT = 32, PER_L = I_IN + I_OUT + I_RT;
        for (int it0 = gw; it0 < 2 * PER_L; it0 += NGW) {
            const int l = it0 / PER_L; int r = it0 % PER_L;
            if (r < I_IN) { const int nb = r % 152, kb = r / 152, d0 = nb * 32; int s0 = d0, nv = 32;
                if (d0 >= 4640) nv = 0; else if (d0 == 4608) { s0 = 3584; nv = 16; } else if (d0 >= 3584) s0 = d0 + 16;
                transpose_item(F.in[I_WIN] + (size_t)l * 2048 * IN_W, 2048, IN_W, (bf16*)(F.ws + WS_WIN) + (size_t)l * PW * 2048, kb * 64, d0, s0, nv, scr, F.lane); continue; }
            r -= I_IN;
            if (r < I_OUT) { const int nb = r % 64, kb = r / 64;
                transpose_item(F.in[I_WOUT] + (size_t)l * 2048 * 2048, 2048, 2048, (bf16*)(F.ws + WS_WOUT) + (size_t)l * 2048 * 2048, kb * 64, nb * 32, nb * 32, 32, scr, F.lane); continue; }
            r -= I_OUT;
            transpose_item(F.in[I_WROUT] + (size_t)l * 2048 * 32, 2048, 32, (bf16*)(F.ws + WS_WRT) + (size_t)l * 32 * 2048, r * 64, 0, 0, 32, scr, F.lane);
        }
    }
}
constexpr int CW_CVQ = 12288 + 512;
__device__ __forceinline__ void convert_moe_item(Frame& F, int l, int r, LAS float* scr) {
    constexpr int I_GU = 32 * 32 * 64;
    if (r < I_GU) { const int e = r / 2048, q = r % 2048, nb = q % 64, kb = q / 64; const int s0 = ((nb >> 2) & 1) * 1024 + (nb >> 3) * 128 + (nb & 3) * 32;
        transpose_item(F.in[I_WGU] + (size_t)(l * 32 + e) * 2048 * 2048, 2048, 2048, (bf16*)(F.ws + WS_WGU) + (size_t)(l * 32 + e) * 2048 * 2048, kb * 64, nb * 32, s0, 32, scr, F.lane); return; }
    r -= I_GU;
    { const int e = r / 1024, q = r % 1024, nb = q % 64, kb = q / 64;
        transpose_item(F.in[I_WDN] + (size_t)(l * 32 + e) * 1024 * 2048, 1024, 2048, (bf16*)(F.ws + WS_WDN) + (size_t)(l * 32 + e) * 2048 * 1024, kb * 64, nb * 32, nb * 32, 32, scr, F.lane); }
}
constexpr int CVG = 8;
__device__ __forceinline__ bool convert_grab(Frame& F, int l, int rep, LAS float* scr) {
    constexpr int NIT = 32 * 32 * 64 + 32 * 16 * 64;
    int g = 0; if (F.lane == 0) g = (int)__hip_atomic_fetch_add(F.ctl + CW_CVQ + 64 * l + 8 * rep, 1u, RLX_AGENT); g = __builtin_amdgcn_readfirstlane(g);
    if (g * CVG >= NIT) return false;
#pragma unroll 1
    for (int k = 0; k < CVG; ++k) convert_moe_item(F, l, g * CVG + k, scr);
    return true;
}
__device__ __forceinline__ void convert_moe_queue(Frame& F, int l, int rep = 0) {
    LAS float* scr = (LAS float*)(F.lds + F.wave * 16384);
    __syncthreads();
    while (convert_grab(F, l, rep, scr)) {}
    __syncthreads();
}
constexpr int CW_TAIL = 16384;
__device__ __forceinline__ void tail_fill(Frame& F, int seam, int lt) {
    LAS int* flag = (LAS int*)(F.lds + LDS_X_OFF + 768);
    LAS float* scr = (LAS float*)(F.lds + F.wave * 16384);
    __syncthreads();
    if (F.tid == 0) (void)__hip_atomic_fetch_add(F.ctl + CW_TAIL + 64 * seam, 1u, RLX_AGENT);
    bool more = true;
    for (int it = 0; it < 4096; ++it) {
        if (F.tid == 0) *flag = (__hip_atomic_load(F.ctl + CW_TAIL + 64 * seam, RLX_AGENT) >= (unsigned)F.G) ? 1 : 0;
        __syncthreads();
        const int done = *flag;
        __syncthreads();
        if (done) break;
        if (more) more = convert_grab(F, lt, 0, scr); else __builtin_amdgcn_s_sleep(32);
    }
}

__device__ __forceinline__ void load_row(const float* src, int lane, f32x4 (&v)[8]) {
    const f32x4* p = (const f32x4*)src + lane;
#pragma unroll
    for (int j = 0; j < 8; ++j) v[j] = p[64 * j];
}
__device__ __forceinline__ void store_row(float* dst, int lane, const f32x4 (&v)[8]) {
    f32x4* p = (f32x4*)dst + lane;
#pragma unroll
    for (int j = 0; j < 8; ++j) p[64 * j] = v[j];
}
__device__ __forceinline__ void combine_row(Frame& F, int l, int m, int lane, f32x4 (&v)[8]) {
    const int* dest = (const int*)(F.ws + WS_MOEI + 2 * 512 * 1024) + m * 4;
    const float* g5 = (const float*)(F.ws + WS_MOD) + (size_t)(l * 5 + mod_row(m)) * 12288 + 5 * 2048;
    f32x4 acc[8];
#pragma unroll
    for (int j = 0; j < 8; ++j) acc[j] = (f32x4){0.f, 0.f, 0.f, 0.f};
#pragma unroll
    for (int k = 0; k < 4; ++k) { const int d = dest[k]; const v2u* yp = (const v2u*)((const bf16*)(F.ws + WS_YS) + (size_t)d * 2048) + lane;
#pragma unroll
        for (int j = 0; j < 8; ++j) { const v2u w = yp[64 * j]; acc[j] += (f32x4){bflo(w.x), bfhi(w.x), bflo(w.y), bfhi(w.y)}; } }
#pragma unroll
    for (int j = 0; j < 8; ++j) { const f32x4 gg = *((const f32x4*)g5 + lane + 64 * j); v[j] += gg * acc[j]; }
}
__device__ __forceinline__ void modnorm_store(const f32x4 (&v)[8], const float* g, const float* shift, const float* scale, bf16* hrow, int lane) {
    float ss = 0.f;
#pragma unroll
    for (int j = 0; j < 8; ++j) ss += (v[j].x * v[j].x + v[j].y * v[j].y) + (v[j].z * v[j].z + v[j].w * v[j].w);
    const float rstd = 1.0f / sqrtf(wave_sum(ss) * (1.0f / 2048.0f) + EPS);
    v2u* hp = (v2u*)hrow + lane;
#pragma unroll
    for (int j = 0; j < 8; ++j) { const f32x4 gg = *((const f32x4*)g + lane + 64 * j), sh = *((const f32x4*)shift + lane + 64 * j), sc = *((const f32x4*)scale + lane + 64 * j);
        const f32x4 y = (v[j] * rstd) * gg * (sc + 1.0f) + sh; v2u w; w.x = pk2(y.x, y.y); w.y = pk2(y.z, y.w); hp[64 * j] = w; }
}
__device__ __forceinline__ void phase_norm1(Frame& F, int l) {
    const int gw = F.bid * NWAVES + F.wave, NGW = F.G * NWAVES;
    float* X = (float*)(F.ws + WS_X); bf16* H = (bf16*)(F.ws + WS_H);
    const float* modp = (const float*)(F.ws + WS_MOD) + (size_t)l * 5 * 12288;
    for (int m = gw; m < NTOK; m += NGW) {
        f32x4 v[8];
        if (l == 0) load_row(m < NLAT ? F.in[I_X] + (size_t)m * DM : F.in[I_CTX] + (size_t)(m - NLAT) * DM, F.lane, v);
        else { load_row(X + (size_t)m * DM, F.lane, v); if (MK_STAGE >= 9) { combine_row(F, l - 1, m, F.lane, v); store_row(X + (size_t)m * DM, F.lane, v); } }
        const float* mr = modp + (size_t)mod_row(m) * 12288;
        modnorm_store(v, F.in[I_NMG] + l * DM, mr, mr + 2048, H + (size_t)m * DM, F.lane);
    }
}
__device__ __forceinline__ void phase_final(Frame& F, bool with_combine) {
    const int gw = F.bid * NWAVES + F.wave, NGW = F.G * NWAVES;
    const float* X = (const float*)(F.ws + WS_X);
    for (int m = gw; m < NLAT; m += NGW) {
        f32x4 v[8];
        if (with_combine) { load_row(X + (size_t)m * DM, F.lane, v); combine_row(F, 1, m, F.lane, v); }
        else load_row(F.in[I_X] + (size_t)m * DM, F.lane, v);
        float ss = 0.f;
#pragma unroll
        for (int j = 0; j < 8; ++j) ss += (v[j].x * v[j].x + v[j].y * v[j].y) + (v[j].z * v[j].z + v[j].w * v[j].w);
        const float rstd = 1.0f / sqrtf(wave_sum(ss) * (1.0f / 2048.0f) + EPS);
        f32x4* op = (f32x4*)(F.out + (size_t)m * DM) + F.lane;
#pragma unroll
        for (int j = 0; j < 8; ++j) { const f32x4 gg = *((const f32x4*)F.in[I_FNG] + F.lane + 64 * j); op[64 * j] = v[j] * rstd * gg; }
    }
}

__device__ __forceinline__ void phase_inproj(Frame& F, int l) {
    pg8::Gemm g{(const bf16*)(F.ws + WS_H), (const bf16*)(F.ws + WS_WIN) + (size_t)l * PW * 2048, NTOK, PW, 2048};
    pg8::StaticOrder S; S.init(g, F.G, F.bid);
    pg8::EpiBf16Plain E{(bf16*)(F.ws + WS_P), PW};
    pg8::gemm_phase<pg8::EpiBf16Plain, pg8::StaticOrder, true, true>(F.lds + RING_OFF, g, S, E);
}
__device__ __forceinline__ void phase_outproj(Frame& F, int l) {
    float* X = (float*)(F.ws + WS_X);
    pg8::Gemm g{(const bf16*)(F.ws + WS_CC), (const bf16*)(F.ws + WS_WOUT) + (size_t)l * 2048 * 2048, l == 0 ? NTOK : NLAT, 2048, 2048};
    pg8::StaticOrder S; S.init(g, F.G, F.bid);
    pg8::EpiResGate E{l == 0 ? F.in[I_X] : X, l == 0 ? F.in[I_CTX] : X + (size_t)NLAT * DM, X, (const float*)(F.ws + WS_MOD) + (size_t)l * 5 * 12288 + 2 * 2048};
    pg8::gemm_phase<pg8::EpiResGate, pg8::StaticOrder, true, true>(F.lds + RING_OFF, g, S, E);
}
#ifndef PHASE_INPROJ
#define PHASE_INPROJ(F, l) phase_inproj(F, l)
#endif
#ifndef PHASE_OUTPROJ
#define PHASE_OUTPROJ(F, l) phase_outproj(F, l)
#endif

constexpr size_t MOEI_TOPE = WS_MOEI, MOEI_TOPG = WS_MOEI + 512 * 1024, MOEI_DEST = WS_MOEI + 2 * 512 * 1024, MOEI_ROWG = WS_MOEI + 3 * 512 * 1024, MOEI_ROWT = WS_MOEI + 4 * 512 * 1024;
__device__ __forceinline__ void phase_norm2(Frame& F, int l) {
    const int nrows = (l == 0) ? NTOK : NLAT;
    constexpr int TROW = 4112;
    LAS unsigned char* tile = F.lds;
    LAS float* part = (LAS float*)(F.lds + 66048);
    LAS float* lg = (LAS float*)(F.lds + 66048 + 16384);
    const float* X = (const float*)(F.ws + WS_X); bf16* H = (bf16*)(F.ws + WS_H);
    const float* modp = (const float*)(F.ws + WS_MOD) + (size_t)l * 5 * 12288;
    const bf16* wrt = (const bf16*)(F.ws + WS_WRT) + (size_t)l * 32 * 2048;
    int* tope = (int*)(F.ws + MOEI_TOPE); float* topg = (float*)(F.ws + MOEI_TOPG);
    for (int r0 = F.bid * 16; r0 < nrows; r0 += F.G * 16) {
#pragma unroll 1
        for (int rr = 0; rr < 2; ++rr) {
            const int lr = 2 * F.wave + rr, m = r0 + lr;
            f32x4 v[8]; load_row(X + (size_t)m * DM, F.lane, v);
            float ss = 0.f;
#pragma unroll
            for (int j = 0; j < 8; ++j) ss += (v[j].x * v[j].x + v[j].y * v[j].y) + (v[j].z * v[j].z + v[j].w * v[j].w);
            const float rstd = 1.0f / sqrtf(wave_sum(ss) * (1.0f / 2048.0f) + EPS);
            const float* mr = modp + (size_t)mod_row(m) * 12288; const float* g = F.in[I_NFG] + l * DM;
            v2u* hp = (v2u*)(H + (size_t)m * DM) + F.lane; LAS v2u* tp = (LAS v2u*)(tile + lr * TROW) + F.lane;
#pragma unroll
            for (int j = 0; j < 8; ++j) { const f32x4 gg = *((const f32x4*)g + F.lane + 64 * j), sh = *((const f32x4*)(mr + 3 * 2048) + F.lane + 64 * j), sc = *((const f32x4*)(mr + 4 * 2048) + F.lane + 64 * j);
                const f32x4 y = (v[j] * rstd) * gg * (sc + 1.0f) + sh; v2u w; w.x = pk2(y.x, y.y); w.y = pk2(y.z, y.w); hp[64 * j] = w; tp[64 * j] = w; }
        }
        __syncthreads();
        {
            const int row = F.lane & 15, q = F.lane >> 4;
            f32x4 acc0 = {0.f, 0.f, 0.f, 0.f}, acc1 = {0.f, 0.f, 0.f, 0.f};
#pragma unroll
            for (int ks = 0; ks < 8; ++ks) { const int k0 = 256 * F.wave + 32 * ks + 8 * q;
                const bf16x8 a = *(const LAS bf16x8*)(tile + row * TROW + k0 * 2);
                const bf16x8 b0 = *(const bf16x8*)(wrt + (size_t)row * 2048 + k0), b1 = *(const bf16x8*)(wrt + (size_t)(16 + row) * 2048 + k0);
                acc0 = __builtin_amdgcn_mfma_f32_16x16x32_bf16(a, b0, acc0, 0, 0, 0); acc1 = __builtin_amdgcn_mfma_f32_16x16x32_bf16(a, b1, acc1, 0, 0, 0); }
#pragma unroll
            for (int i = 0; i < 4; ++i) { part[(F.wave * 16 + 4 * q + i) * 32 + row] = acc0[i]; part[(F.wave * 16 + 4 * q + i) * 32 + 16 + row] = acc1[i]; }
        }
        __syncthreads();
        { const int rw = F.tid >> 5, e = F.tid & 31; float s = F.in[I_BROUT][l * 32 + e];
#pragma unroll
          for (int w = 0; w < 8; ++w) s += part[(w * 16 + rw) * 32 + e];
          lg[rw * 32 + e] = s; }
        __syncthreads();
        if (F.tid < 16) { const int m = r0 + F.tid; float val[4]; int idx[4]; unsigned taken = 0u;
#pragma unroll
            for (int k = 0; k < 4; ++k) { float best = -3.0e38f; int bi = 0;
                for (int e = 0; e < 32; ++e) { const float x = lg[F.tid * 32 + e]; if (!((taken >> e) & 1u) && x > best) { best = x; bi = e; } }
                val[k] = best; idx[k] = bi; taken |= 1u << bi; }
            float p[4], sum = 0.f;
#pragma unroll
            for (int k = 0; k < 4; ++k) { p[k] = __expf(val[k] - val[0]); sum += p[k]; }
#pragma unroll
            for (int k = 0; k < 4; ++k) { const unsigned rank = __hip_atomic_fetch_add(F.ctl + CW_CNT + 64 * l + idx[k], 1u, RLX_AGENT);
                tope[m * 4 + k] = idx[k] | (int)(rank << 8); topg[m * 4 + k] = p[k] / sum; }
        }
        __syncthreads();
    }
}
__device__ __forceinline__ void moe_tables(Frame& F, int l) {
    LAS int* blk_end = (LAS int*)(F.lds + LDS_X_OFF); LAS int* pstart = blk_end + 32; LAS int* cnts = blk_end + 64;
    if (F.tid == 0) { int nb = 0;
        for (int e = 0; e < 32; ++e) { const int c = (int)__hip_atomic_load(F.ctl + CW_CNT + 64 * l + e, RLX_AGENT); cnts[e] = c; pstart[e] = nb * 256; nb += (c + 255) >> 8; blk_end[e] = nb; } }
    __syncthreads();
}
__device__ __forceinline__ void phase_scatter(Frame& F, int l) {
    const int nrows = (l == 0) ? NTOK : NLAT;
    moe_tables(F, l);
    const LAS int* blk_end = (const LAS int*)(F.lds + LDS_X_OFF); const LAS int* pstart = blk_end + 32; const LAS int* cnts = blk_end + 64;
    const int* tope = (const int*)(F.ws + MOEI_TOPE); const float* topg = (const float*)(F.ws + MOEI_TOPG);
    int* dest = (int*)(F.ws + MOEI_DEST); float* rowg = (float*)(F.ws + MOEI_ROWG); int* rowt = (int*)(F.ws + MOEI_ROWT);
    for (int a = F.bid * NTHREADS + F.tid; a < nrows * 4; a += F.G * NTHREADS) {
        const int te = tope[a], e = te & 255, rank = (int)((unsigned)te >> 8), d = pstart[e] + rank;
        dest[a] = d; rowg[d] = topg[a]; rowt[d] = a >> 2; }
    if (F.bid < 32) { const int e = F.bid, r0 = pstart[e] + cnts[e], r1 = blk_end[e] * 256;
        for (int r = r0 + F.tid; r < r1; r += NTHREADS) { rowt[r] = 0; rowg[r] = 0.f; } }
}
__device__ __forceinline__ void phase_gemm1(Frame& F, int l) {
    moe_tables(F, l);
    const LAS int* blk_end = (const LAS int*)(F.lds + LDS_X_OFF);
    pg8::Gemm g{(const bf16*)(F.ws + WS_H), (const bf16*)(F.ws + WS_WGU) + (size_t)l * 32 * 2048 * 2048, MOE_ROWS, 2048, 2048};
    pg8::MoeOrderG S{F.bid, __builtin_amdgcn_readfirstlane(blk_end[31]), (const char*)g.A, (const char*)g.Bt, (size_t)256 * 2048 * 2, (size_t)2048 * 2048 * 2, (size_t)256 * 2048 * 2, blk_end, (const int*)(F.ws + MOEI_ROWT)};
    pg8::EpiSwiglu E{(bf16*)(F.ws + WS_ACT), F.in[I_BGU] + (size_t)l * 32 * 2048};
    pg8::gemm_phase<pg8::EpiSwiglu, pg8::MoeOrderG, true, true>(F.lds + RING_OFF, g, S, E);
}
__device__ __forceinline__ void phase_gemm2(Frame& F, int l) {
    moe_tables(F, l);
    const LAS int* blk_end = (const LAS int*)(F.lds + LDS_X_OFF);
    pg8::Gemm g{(const bf16*)(F.ws + WS_ACT), (const bf16*)(F.ws + WS_WDN) + (size_t)l * 32 * 2048 * 1024, MOE_ROWS, 2048, 1024};
    pg8::MoeOrder S{F.bid, __builtin_amdgcn_readfirstlane(blk_end[31]), (const char*)g.A, (const char*)g.Bt, (size_t)256 * 1024 * 2, (size_t)2048 * 1024 * 2, (size_t)256 * 1024 * 2, blk_end, nullptr};
    pg8::EpiDown E{(bf16*)(F.ws + WS_YS), F.in[I_BDN] + (size_t)l * 32 * 2048, (const float*)(F.ws + MOEI_ROWG)};
    pg8::gemm_phase<pg8::EpiDown, pg8::MoeOrder, true, true>(F.lds + RING_OFF, g, S, E);
}
#ifndef PHASE_NORM2
#define PHASE_NORM2(F, l) phase_norm2(F, l)
#endif
#ifndef PHASE_SCATTER
#define PHASE_SCATTER(F, l) phase_scatter(F, l)
#endif
#ifndef PHASE_GEMM1
#define PHASE_GEMM1(F, l) phase_gemm1(F, l)
#endif
#ifndef PHASE_GEMM2
#define PHASE_GEMM2(F, l) phase_gemm2(F, l)
#endif
#define USE_MFMA_ATTN 1

__device__ __forceinline__ void attn_prep(Frame& F, int l) {
    bf16* P = (bf16*)(F.ws + WS_P);
    LAS unsigned short* vt = (LAS unsigned short*)F.lds;
    for (int ct = F.bid; ct < NCT; ct += F.G) {
        const int m0 = ct * 64; const bool lat = m0 < NLAT;
        __syncthreads();
        for (int i = F.tid; i < 64 * 32; i += NTHREADS) { const int tk = i >> 5, c8 = i & 31;
            const v4u w = *(const v4u*)(P + (size_t)(m0 + tk) * PW + PC_V + c8 * 8);
            const unsigned ww[4] = {w.x, w.y, w.z, w.w};
#pragma unroll
            for (int q = 0; q < 4; ++q) { vt[(c8 * 8 + 2 * q) * 66 + tk] = (unsigned short)(ww[q] & 0xffffu); vt[(c8 * 8 + 2 * q + 1) * 66 + tk] = (unsigned short)(ww[q] >> 16); } }
        if (lat) { const int tk = F.tid >> 3, kvh = (F.tid >> 1) & 3, hf = F.tid & 1; const int t = (m0 + tk) & 4095;
            bf16* kp = P + (size_t)(m0 + tk) * PW + PC_K + kvh * 64 + hf * 32;
            const v4u w0 = *(const v4u*)kp, w1 = *(const v4u*)(kp + 8), w2 = *(const v4u*)(kp + 16), w3 = *(const v4u*)(kp + 24);
            const unsigned lo[8] = {w0.x, w0.y, w0.z, w0.w, w1.x, w1.y, w1.z, w1.w}, hi_[8] = {w2.x, w2.y, w2.z, w2.w, w3.x, w3.y, w3.z, w3.w};
            const float pos = (float)(hf ? (t & 63) : (t >> 6)); unsigned o1[8], o2[8];
#pragma unroll
            for (int jj = 0; jj < 8; ++jj) { float r1[2], r2[2];
#pragma unroll
                for (int e = 0; e < 2; ++e) { const int j = 2 * jj + e; const float inv = __builtin_amdgcn_exp2f(-(float)j * 0.8304820237218406f); const float sn = __sinf(pos * inv), cs = __cosf(pos * inv);
                    const float x1 = e ? bfhi(lo[jj]) : bflo(lo[jj]), x2 = e ? bfhi(hi_[jj]) : bflo(hi_[jj]); r1[e] = x1 * cs - x2 * sn; r2[e] = x2 * cs + x1 * sn; }
                o1[jj] = pk2(r1[0], r1[1]); o2[jj] = pk2(r2[0], r2[1]); }
            *(v4u*)kp = (v4u){o1[0], o1[1], o1[2], o1[3]}; *(v4u*)(kp + 8) = (v4u){o1[4], o1[5], o1[6], o1[7]}; *(v4u*)(kp + 16) = (v4u){o2[0], o2[1], o2[2], o2[3]}; *(v4u*)(kp + 24) = (v4u){o2[4], o2[5], o2[6], o2[7]}; }
        __syncthreads();
        for (int i = F.tid; i < 256 * 8; i += NTHREADS) { const int col = i >> 3, c = i & 7, kvh = col >> 6, d = col & 63;
            v4u o; const LAS unsigned short* s = vt + col * 66 + c * 8;
            o.x = s[0] | ((unsigned)s[1] << 16); o.y = s[2] | ((unsigned)s[3] << 16); o.z = s[4] | ((unsigned)s[5] << 16); o.w = s[6] | ((unsigned)s[7] << 16);
            if (lat) { const int b = m0 >> 12, t0 = m0 & 4095; *(v4u*)((bf16*)(F.ws + WS_VT) + ((size_t)(b * 4 + kvh) * 64 + d) * SEQ + t0 + c * 8) = o; }
            else { const int mm = m0 - NLAT, b = mm >> 8, t0 = mm & 255; *(v4u*)((bf16*)(F.ws + WS_VTC) + ((size_t)(b * 4 + kvh) * 64 + d) * CTXL + t0 + c * 8) = o; } }
    }
    __syncthreads();
}

constexpr int AT_KP = 144, AT_VP = 136;
constexpr int AT_KOFF = 0, AT_VOFF = 64 * AT_KP, AT_TILE = 64 * AT_KP + 64 * AT_VP;
__device__ __forceinline__ void attn_unit(Frame& F, int l, int b, int kvh, int qi, int is_ctx) {
    const bf16* P = (const bf16*)(F.ws + WS_P); bf16* CC = (bf16*)(F.ws + WS_CC);
    int lane_o = F.lane; asm volatile("" : "+v"(lane_o));
    const int g = F.wave >> 1, qh = F.wave & 1, hq = kvh * 4 + g, r32 = lane_o & 31, hi = lane_o >> 5;
    const int rowbase = is_ctx ? NLAT + b * CTXL : b * SEQ;
    const int qa = qi * 128 + qh * 64;
    const float LOG2E = 1.4426950408889634f;
    bf16x8 qf[2][4];
#pragma unroll
    for (int qt = 0; qt < 2; ++qt) { const int tq = qa + 32 * qt + r32; const bf16* qp = P + (size_t)(rowbase + tq) * PW + PC_Q + hq * 64 + 8 * hi;
        float x[4][8];
#pragma unroll
        for (int s = 0; s < 4; ++s) { const v4u w = *(const v4u*)(qp + 16 * s); x[s][0] = bflo(w.x); x[s][1] = bfhi(w.x); x[s][2] = bflo(w.y); x[s][3] = bfhi(w.y); x[s][4] = bflo(w.z); x[s][5] = bfhi(w.z); x[s][6] = bflo(w.w); x[s][7] = bfhi(w.w); }
        if (!is_ctx) {
#pragma unroll
            for (int hf = 0; hf < 2; ++hf) { const float pos = (float)(hf ? (tq & 63) : (tq >> 6));
#pragma unroll
                for (int j = 0; j < 8; ++j) { const float inv = __builtin_amdgcn_exp2f(-(float)(8 * hi + j) * 0.8304820237218406f); const float sn = __sinf(pos * inv), cs = __cosf(pos * inv);
                    const float x1 = x[2 * hf][j], x2 = x[2 * hf + 1][j]; x[2 * hf][j] = x1 * cs - x2 * sn; x[2 * hf + 1][j] = x2 * cs + x1 * sn; } } }
        const float sc = 0.125f * LOG2E;
#pragma unroll
        for (int s = 0; s < 4; ++s) { v4u w; w.x = pk2(x[s][0] * sc, x[s][1] * sc); w.y = pk2(x[s][2] * sc, x[s][3] * sc); w.z = pk2(x[s][4] * sc, x[s][5] * sc); w.w = pk2(x[s][6] * sc, x[s][7] * sc); qf[qt][s] = __builtin_bit_cast(bf16x8, w); }
    }
    float mrun[2], lrun[2]; f32x16 O[2][2];
    { const float sk = F.in[I_SINK][l * 16 + hq] * LOG2E;
#pragma unroll
      for (int qt = 0; qt < 2; ++qt) { mrun[qt] = sk; lrun[qt] = hi ? 0.f : 1.f;
#pragma unroll
        for (int db = 0; db < 2; ++db)
#pragma unroll
            for (int r = 0; r < 16; ++r) O[qt][db][r] = 0.f; } }
    const int kt_lo = is_ctx ? 0 : (qi == 0 ? 2 : 0), nl = is_ctx ? 0 : (6 - (qi == 0 ? 2 : 0) - (qi == 31 ? 2 : 0)), ntile = nl + 4;
    const int rr = F.tid >> 3, cch = F.tid & 7;
    const bf16* kbase_l = P + (size_t)(b * SEQ + rr) * PW + PC_K + kvh * 64 + cch * 8; const bf16* kbase_c = P + (size_t)(NLAT + b * CTXL + rr) * PW + PC_K + kvh * 64 + cch * 8;
    const bf16* vbase_l = (const bf16*)(F.ws + WS_VT) + ((size_t)(b * 4 + kvh) * 64 + rr) * SEQ + cch * 8; const bf16* vbase_c = (const bf16*)(F.ws + WS_VTC) + ((size_t)(b * 4 + kvh) * 64 + rr) * CTXL + cch * 8;
    v4u kw, vw;
    { const bool loc0 = nl > 0; const int k00 = loc0 ? 128 * (qi - 1) + 64 * kt_lo : 0; kw = *(const v4u*)((loc0 ? kbase_l : kbase_c) + (size_t)k00 * PW); vw = *(const v4u*)((loc0 ? vbase_l : vbase_c) + k00); }
    __syncthreads();
#pragma unroll 1
    for (int jt = 0; jt < ntile; ++jt) {
        const bool local = jt < nl; const int k0 = local ? 128 * (qi - 1) + 64 * (kt_lo + jt) : 64 * (jt - nl);
        const LAS unsigned char* KS = F.lds + (jt & 1) * AT_TILE + AT_KOFF; const LAS unsigned char* VS = F.lds + (jt & 1) * AT_TILE + AT_VOFF;
        { *(LAS v4u*)(F.lds + (jt & 1) * AT_TILE + AT_KOFF + rr * AT_KP + cch * 16) = kw;
          LAS v2u* vd = (LAS v2u*)(F.lds + (jt & 1) * AT_TILE + AT_VOFF + rr * AT_VP + cch * 16); vd[0] = (v2u){vw.x, vw.y}; vd[1] = (v2u){vw.z, vw.w}; }
        if (jt + 1 < ntile) { const bool ln = jt + 1 < nl; const int kn = ln ? 128 * (qi - 1) + 64 * (kt_lo + jt + 1) : 64 * (jt + 1 - nl);
            kw = *(const v4u*)((ln ? kbase_l : kbase_c) + (size_t)kn * PW); vw = *(const v4u*)((ln ? vbase_l : vbase_c) + kn); }
        __syncthreads();
        if (local && (k0 + 63 < qa - 128 || k0 > qa + 63 + 128)) continue;
#pragma unroll 1
        for (int kb = 0; kb < 2; ++kb) {
            bf16x8 kf[4];
#pragma unroll
            for (int ss = 0; ss < 4; ++ss) kf[ss] = *(const LAS bf16x8*)(KS + (32 * kb + r32) * AT_KP + (16 * ss + 8 * hi) * 2);
            bf16x8 pb[2][2];
#pragma unroll
            for (int qt = 0; qt < 2; ++qt) { const int tq = qa + 32 * qt + r32;
                f32x16 s;
#pragma unroll
                for (int r = 0; r < 16; ++r) s[r] = 0.f;
#pragma unroll
                for (int ss = 0; ss < 4; ++ss) s = __builtin_amdgcn_mfma_f32_32x32x16_bf16(kf[ss], qf[qt][ss], s, 0, 0, 0);
                if (local) {
#pragma unroll
                    for (int r = 0; r < 16; ++r) { const int kidx = k0 + 32 * kb + (r & 3) + 8 * (r >> 2) + 4 * hi; const int dlt = kidx - tq; if (dlt > 128 || dlt < -128) s[r] = -1.0e30f; } }
                float mloc = s[0];
#pragma unroll
                for (int r = 1; r < 16; ++r) mloc = fmaxf(mloc, s[r]);
                mloc = fmaxf(mloc, __shfl_xor(mloc, 32));
                const float mnew = fmaxf(mrun[qt], mloc), alpha = __builtin_amdgcn_exp2f(mrun[qt] - mnew); mrun[qt] = mnew;
                float psum = 0.f;
#pragma unroll
                for (int r = 0; r < 16; ++r) { s[r] = __builtin_amdgcn_exp2f(s[r] - mnew); psum += s[r]; }
                lrun[qt] = lrun[qt] * alpha + psum;
#pragma unroll
                for (int db = 0; db < 2; ++db)
#pragma unroll
                    for (int r = 0; r < 16; ++r) O[qt][db][r] *= alpha;
#pragma unroll
                for (int s2 = 0; s2 < 2; ++s2) { v4u pw; pw.x = pk2(s[8 * s2 + 0], s[8 * s2 + 1]); pw.y = pk2(s[8 * s2 + 2], s[8 * s2 + 3]); pw.z = pk2(s[8 * s2 + 4], s[8 * s2 + 5]); pw.w = pk2(s[8 * s2 + 6], s[8 * s2 + 7]);
                    pb[qt][s2] = __builtin_bit_cast(bf16x8, pw); }
            }
#pragma unroll
            for (int s2 = 0; s2 < 2; ++s2)
#pragma unroll
                for (int db = 0; db < 2; ++db) { const LAS v2u* vp = (const LAS v2u*)(VS + (32 * db + r32) * AT_VP + (32 * kb + 16 * s2 + 4 * hi) * 2);
                    const v2u a0 = vp[0], a1 = vp[2]; v4u aw; aw.x = a0.x; aw.y = a0.y; aw.z = a1.x; aw.w = a1.y; const bf16x8 va = __builtin_bit_cast(bf16x8, aw);
                    O[0][db] = __builtin_amdgcn_mfma_f32_32x32x16_bf16(va, pb[0][s2], O[0][db], 0, 0, 0);
                    O[1][db] = __builtin_amdgcn_mfma_f32_32x32x16_bf16(va, pb[1][s2], O[1][db], 0, 0, 0); }
        }
    }
    int r32e = r32, hie = hi; asm volatile("" : "+v"(r32e), "+v"(hie));
#pragma unroll
    for (int qt = 0; qt < 2; ++qt) { const float lt = lrun[qt] + __shfl_xor(lrun[qt], 32); const float rl = 1.0f / lt; const int tq = qa + 32 * qt + r32e;
        bf16* op = CC + (size_t)(rowbase + tq) * DM + hq * 64 + 4 * hie;
#pragma unroll
        for (int db = 0; db < 2; ++db)
#pragma unroll
            for (int rq = 0; rq < 4; ++rq) { v2u w; w.x = pk2(O[qt][db][4 * rq] * rl, O[qt][db][4 * rq + 1] * rl); w.y = pk2(O[qt][db][4 * rq + 2] * rl, O[qt][db][4 * rq + 3] * rl);
                *(v2u*)(op + 32 * db + 8 * rq) = w; } }
}
__device__ __forceinline__ void attn_phase(Frame& F, int l, int rep = 0) {
    const int nunits = 512 + (l == 0 ? 32 : 0);
    LAS int* slot = (LAS int*)(F.lds + LDS_X_OFF + 512);
    for (;;) {
        __syncthreads();
        if (F.tid == 0) *slot = (int)__hip_atomic_fetch_add(F.ctl + CW_ATQ + 64 * l + 8 * rep, 1u, RLX_AGENT);
        __syncthreads();
        const int u = __builtin_amdgcn_readfirstlane(*slot);
        if (u >= nunits) break;
        if (u < 512) attn_unit(F, l, u >> 7, (u >> 5) & 3, u & 31, 0); else { const int v = u - 512; attn_unit(F, l, v >> 3, (v >> 1) & 3, v & 1, 1); }
    }
}
#define USE_CHUNK_DN 1
#ifndef DN_REP_S1
#define DN_REP_S1 1
#endif
#ifndef DN_REP_S3B
#define DN_REP_S3B 1
#endif
#ifndef DN_REP_S3A
#define DN_REP_S3A 1
#endif
#ifndef DN_REP_S4
#define DN_REP_S4 1
#endif

constexpr int DN_F_NEGW = 0, DN_F_QG = 16, DN_F_QK = 32, DN_F_KGT = 40, DN_NFRAG = 56, DN_U_OFF = 57344;
constexpr int DP_QS = 0, DP_KS = 17408, DP_VS = 34816, DP_AS = 52224  , DP_TB = 69632, DP_TW = 78848, DP_QK = 88064, DP_RAW = 52224  , DP_SC = 104960, DP_TF = 106496  , DP_XS = 123904  ;
constexpr int DP_P = 272, DP_P2 = 144;
__device__ __forceinline__ int dn_rec(int b, int h, int dir, int np) { return ((b * 4 + h) * 2 + dir) * 68 + np; }
__device__ __forceinline__ void dn_chunk_of(int ct, int dir, int& b, int& np) { if (ct < 256) { b = ct >> 6; const int c = ct & 63; np = 4 + (dir ? 63 - c : c); } else { b = (ct - 256) >> 2; const int c = (ct - 256) & 3; np = dir ? 3 - c : c; } }
__device__ __forceinline__ unsigned short lds_u16(const LAS unsigned char* p) { return *(const LAS unsigned short*)p; }

__device__ __forceinline__ void dn_prep_unit(Frame& F, int l, int ct, int h, int dir) {
    const bf16* P = (const bf16*)(F.ws + WS_P);
    int lane = F.lane; asm volatile("" : "+v"(lane));
    const int wave = F.wave, i16 = lane & 15, q = lane >> 4;
    const int m0 = ct * 64; int t0, T, base; seq_of(m0, t0, T, base);
    int b, np; dn_chunk_of(ct, dir, b, np);
    unsigned char* tile = F.ws + WS_DNT + (size_t)dn_rec(b, h, dir, np) * DNT_BYTES;
    LAS unsigned char* L = F.lds;
    LAS float* SC = (LAS float*)(L + DP_SC);
    __syncthreads();
    {
        const float* cw = F.in[I_DNCW] + (size_t)l * 4 * 1536;
        float2 cwr[3][4];
#pragma unroll
        for (int part = 0; part < 3; ++part)
#pragma unroll
            for (int j = 0; j < 4; ++j) cwr[part][j] = *(const float2*)(cw + j * 1536 + part * 512 + h * 128 + 2 * lane);
        unsigned short pbw = 0, paw = 0;
        if (wave == 0) { const int tok = dir ? 63 - lane : lane; pbw = P[(size_t)(m0 + tok) * PW + PC_BETA + dir * 4 + h]; paw = P[(size_t)(m0 + tok) * PW + PC_DEC + dir * 4 + h]; }
        for (int c = F.tid; c < 67 * 48; c += NTHREADS) { const int row = c / 48, ch = c % 48, part = ch >> 4, cc = ch & 15, tt = t0 + row - 2;
            v4u v = (v4u){0u, 0u, 0u, 0u};
            if (tt >= 0 && tt < T) v = *(const v4u*)(P + (size_t)(base + tt) * PW + PC_DQ + part * 512 + h * 128 + cc * 8);
            *(LAS v4u*)(L + DP_RAW + row * 784 + part * 256 + cc * 16) = v; }
        __syncthreads();
#pragma unroll 1
        for (int rep = 0; rep < DN_REP_S1; ++rep)
#pragma unroll
        for (int part = 0; part < 3; ++part)
#pragma unroll 2
            for (int i = 0; i < 8; ++i) { const int tok = wave * 8 + i;
                float s0 = 0.f, s1 = 0.f;
#pragma unroll
                for (int j = 0; j < 4; ++j) { const unsigned w = *(const LAS unsigned*)(L + DP_RAW + (tok + j) * 784 + part * 256 + lane * 4); s0 += cwr[part][j].x * bflo(w); s1 += cwr[part][j].y * bfhi(w); }
                s0 = siluf_(s0); s1 = siluf_(s1);
                if (part < 2) { const float ss = wave_sum(s0 * s0 + s1 * s1); const float f = (part == 0 ? 0.08838834764831845f : 1.0f) / sqrtf(ss + EPS); s0 *= f; s1 *= f; }
                *(LAS unsigned*)(L + (part == 0 ? DP_QS : (part == 1 ? DP_KS : DP_VS)) + tok * DP_P + lane * 4) = pk2(s0, s1); }
        if (wave == 0) {
            const float pb = bf2f(pbw), pa = bf2f(paw);
            const float beta = sigmoidf_(pb); float gc = -__expf(F.in[I_DNALOG][l * 8 + dir * 4 + h]) * softplusf_(pa + F.in[I_DNDT][l * 8 + dir * 4 + h]);
#pragma unroll
            for (int o = 1; o < 64; o <<= 1) { const float v = __shfl_up(gc, o); if (lane >= o) gc += v; }
            const float glast = __shfl(gc, 63);
            SC[lane] = beta; SC[64 + lane] = gc; SC[128 + lane] = __expf(gc); SC[192 + lane] = __expf(glast - gc);
            if (lane == 63) ((float*)(F.ws + WS_DNS))[dn_rec(b, h, dir, np)] = __expf(glast);
        }
    }
    __syncthreads();
#define DN_TOK(r) (dir ? 63 - (r) : (r))
#pragma unroll 1
    for (int rep = 0; rep < DN_REP_S3A; ++rep)
    {
        const int mb = wave & 3, which = wave >> 2;
        f32x4 acc[4];
#pragma unroll
        for (int nb = 0; nb < 4; ++nb) acc[nb] = (f32x4){0.f, 0.f, 0.f, 0.f};
        const LAS unsigned char* arow = L + (which ? DP_QS : DP_KS) + DN_TOK(16 * mb + i16) * DP_P + 16 * q;
#pragma unroll
        for (int ks = 0; ks < 4; ++ks) { const bf16x8 a = *(const LAS bf16x8*)(arow + 64 * ks);
#pragma unroll
            for (int nb = 0; nb < 4; ++nb) { const bf16x8 bb = *(const LAS bf16x8*)(L + DP_KS + DN_TOK(16 * nb + i16) * DP_P + 16 * q + 64 * ks);
                acc[nb] = __builtin_amdgcn_mfma_f32_16x16x32_bf16(a, bb, acc[nb], 0, 0, 0); } }
#pragma unroll
        for (int nb = 0; nb < 4; ++nb)
#pragma unroll
            for (int i = 0; i < 4; ++i) { const int r = 16 * mb + 4 * q + i, c = 16 * nb + i16; const float dec = __expf(SC[64 + r] - SC[64 + c]);
                if (which == 0) ((LAS float*)(L + DP_AS))[r * 68 + c] = (r > c) ? SC[r] * acc[nb][i] * dec : 0.f;
                else *(LAS unsigned short*)(L + DP_QK + r * DP_P2 + c * 2) = (unsigned short)f2bf((r >= c) ? acc[nb][i] * dec : 0.f); }
    }
    __syncthreads();
#pragma unroll 1
    for (int rep = 0; rep < DN_REP_S3B; ++rep) {
    if (wave == 0) {
        const LAS float* As = (const LAS float*)(L + DP_AS); LAS float* Tf = (LAS float*)(L + DP_TF);
        const int g = lane >> 4, c = lane & 15;
        f32x4 ar[16][4];
#pragma unroll
        for (int r = 1; r < 16; ++r)
#pragma unroll
            for (int j4 = 0; j4 < (r + 3) / 4; ++j4) ar[r][j4] = *(const LAS f32x4*)(As + (16 * g + r) * 68 + 16 * g + 4 * j4);
        float t[16];
#pragma unroll
        for (int r = 0; r < 16; ++r) { float a0 = (c == r) ? 1.f : 0.f, a1 = 0.f;
#pragma unroll
            for (int j = 0; j < r; ++j) { const float av = ar[r][j >> 2][j & 3]; if (j & 1) a1 -= av * t[j]; else a0 -= av * t[j]; }
            t[r] = a0 + a1; Tf[(16 * g + r) * 68 + 16 * g + c] = t[r]; }
    }
    __syncthreads();
    if (wave < 3) {
        const LAS float* As = (const LAS float*)(L + DP_AS); LAS float* Tf = (LAS float*)(L + DP_TF); LAS float* Xs = (LAS float*)(L + DP_XS) + wave * 272;
        const int J = wave;
#pragma unroll 1
        for (int I = J + 1; I < 4; ++I) {
            f32x4 acc = {0.f, 0.f, 0.f, 0.f};
#pragma unroll 1
            for (int K = J; K < I; ++K)
#pragma unroll
                for (int sk = 0; sk < 4; ++sk) acc = __builtin_amdgcn_mfma_f32_16x16x4f32(As[(16 * I + i16) * 68 + 16 * K + 4 * sk + q], Tf[(16 * K + 4 * sk + q) * 68 + 16 * J + i16], acc, 0, 0, 0);
#pragma unroll
            for (int i = 0; i < 4; ++i) Xs[(4 * q + i) * 17 + i16] = acc[i];
            LDS_WAIT(); asm volatile("" ::: "memory");
            f32x4 acc2 = {0.f, 0.f, 0.f, 0.f};
#pragma unroll
            for (int sk = 0; sk < 4; ++sk) acc2 = __builtin_amdgcn_mfma_f32_16x16x4f32(Tf[(16 * I + i16) * 68 + 16 * I + 4 * sk + q], Xs[(4 * sk + q) * 17 + i16], acc2, 0, 0, 0);
#pragma unroll
            for (int i = 0; i < 4; ++i) Tf[(16 * I + 4 * q + i) * 68 + 16 * J + i16] = -acc2[i];
            LDS_WAIT(); asm volatile("" ::: "memory");
        }
    }
    __syncthreads();
    { const LAS float* Tf = (const LAS float*)(L + DP_TF); const int r = F.tid >> 3, c0 = (F.tid & 7) * 8; float vb[8], vw[8];
#pragma unroll
      for (int k = 0; k < 8; ++k) { const int c = c0 + k; const float v = ((r >> 4) >= (c >> 4)) ? Tf[r * 68 + c] : 0.f; const float bl = SC[c]; vb[k] = v * bl; vw[k] = vb[k] * SC[128 + c]; }
      v4u ob, ow; ob.x = pk2(vb[0], vb[1]); ob.y = pk2(vb[2], vb[3]); ob.z = pk2(vb[4], vb[5]); ob.w = pk2(vb[6], vb[7]); ow.x = pk2(vw[0], vw[1]); ow.y = pk2(vw[2], vw[3]); ow.z = pk2(vw[4], vw[5]); ow.w = pk2(vw[6], vw[7]);
      *(LAS v4u*)(L + DP_TB + r * DP_P2 + c0 * 2) = ob; *(LAS v4u*)(L + DP_TW + r * DP_P2 + c0 * 2) = ow; }
    }
    __syncthreads();
    {
        const int nbp = wave & 3, which = wave >> 2;
        f32x4 acc[4][2];
#pragma unroll
        for (int mb = 0; mb < 4; ++mb) { acc[mb][0] = (f32x4){0.f, 0.f, 0.f, 0.f}; acc[mb][1] = (f32x4){0.f, 0.f, 0.f, 0.f}; }
#pragma unroll
        for (int ks = 0; ks < 2; ++ks) {
            bf16x8 bb[2];
#pragma unroll
            for (int nn = 0; nn < 2; ++nn) { const int n = 16 * (2 * nbp + nn) + i16; unsigned short e[8];
#pragma unroll
                for (int jj = 0; jj < 8; ++jj) e[jj] = lds_u16(L + (which ? DP_KS : DP_VS) + DN_TOK(32 * ks + 8 * q + jj) * DP_P + n * 2);
                v4u w; w.x = e[0] | ((unsigned)e[1] << 16); w.y = e[2] | ((unsigned)e[3] << 16); w.z = e[4] | ((unsigned)e[5] << 16); w.w = e[6] | ((unsigned)e[7] << 16); bb[nn] = __builtin_bit_cast(bf16x8, w); }
#pragma unroll
            for (int mb = 0; mb < 4; ++mb) { const bf16x8 a = *(const LAS bf16x8*)(L + (which ? DP_TW : DP_TB) + (16 * mb + i16) * DP_P2 + 64 * ks + 16 * q);
                acc[mb][0] = __builtin_amdgcn_mfma_f32_16x16x32_bf16(a, bb[0], acc[mb][0], 0, 0, 0); acc[mb][1] = __builtin_amdgcn_mfma_f32_16x16x32_bf16(a, bb[1], acc[mb][1], 0, 0, 0); } }
        if (which == 0) {
#pragma unroll
            for (int mb = 0; mb < 4; ++mb)
#pragma unroll
                for (int nn = 0; nn < 2; ++nn) *(f32x4*)(tile + DN_U_OFF + (size_t)((((2 * nbp + nn) * 4 + mb) * 64 + lane) * 16)) = acc[mb][nn];
        } else {
#pragma unroll
            for (int mb = 0; mb < 4; ++mb)
#pragma unroll
                for (int nn = 0; nn < 2; ++nn)
#pragma unroll
                    for (int i = 0; i < 4; ++i) *(LAS unsigned short*)(L + DP_AS + (16 * mb + 4 * q + i) * DP_P + (16 * (2 * nbp + nn) + i16) * 2) = (unsigned short)f2bf(-acc[mb][nn][i]);
        }
    }
    __syncthreads();
#pragma unroll 1
    for (int rep = 0; rep < DN_REP_S4; ++rep)
#pragma unroll 1
    for (int fi = 0; fi < 7; ++fi) { const int f = wave * 7 + fi; v4u o;
        if (f < DN_F_QG) { const int mb = f >> 2, ks = f & 3; const LAS unsigned char* rp = L + DP_AS + (16 * mb + i16) * DP_P + (32 * ks + 4 * q) * 2;
            const v2u a = *(const LAS v2u*)rp, c = *(const LAS v2u*)(rp + 32); o.x = a.x; o.y = a.y; o.z = c.x; o.w = c.y; }
        else if (f < DN_F_QK) { const int ff = f - DN_F_QG, mb = ff >> 2, ks = ff & 3, r = 16 * mb + i16; const LAS unsigned char* rp = L + DP_QS + DN_TOK(r) * DP_P + (32 * ks + 4 * q) * 2; const float eg = SC[128 + r];
            const v2u a = *(const LAS v2u*)rp, c = *(const LAS v2u*)(rp + 32);
            o.x = pk2(bflo(a.x) * eg, bfhi(a.x) * eg); o.y = pk2(bflo(a.y) * eg, bfhi(a.y) * eg); o.z = pk2(bflo(c.x) * eg, bfhi(c.x) * eg); o.w = pk2(bflo(c.y) * eg, bfhi(c.y) * eg); }
        else if (f < DN_F_KGT) { const int ff = f - DN_F_QK, mb = ff >> 1, ks = ff & 1; const LAS unsigned char* rp = L + DP_QK + (16 * mb + i16) * DP_P2 + (32 * ks + 4 * q) * 2;
            const v2u a = *(const LAS v2u*)rp, c = *(const LAS v2u*)(rp + 32); o.x = a.x; o.y = a.y; o.z = c.x; o.w = c.y; }
        else { const int ff = f - DN_F_KGT, mb = ff >> 1, ks = ff & 1, dk = 16 * mb + i16; float e[8];
#pragma unroll
            for (int jj = 0; jj < 8; ++jj) { const int key = 32 * ks + 16 * (jj >> 2) + 4 * q + (jj & 3); e[jj] = bf2f(lds_u16(L + DP_KS + DN_TOK(key) * DP_P + dk * 2)) * SC[192 + key]; }
            o.x = pk2(e[0], e[1]); o.y = pk2(e[2], e[3]); o.z = pk2(e[4], e[5]); o.w = pk2(e[6], e[7]); }
        *(v4u*)(tile + (size_t)f * 1024 + lane * 16) = o; }
#undef DN_TOK
}
__device__ __forceinline__ void dn_prep(Frame& F, int l) {
    for (int u = F.bid; u < NCT * 4 * 2; u += F.G) dn_prep_unit(F, l, u >> 3, (u >> 1) & 3, u & 1);
    __syncthreads();
}

__device__ __forceinline__ void dn_scan(Frame& F, int l, int b, int h, int dir, int half) {
    int lane = F.lane; asm volatile("" : "+v"(lane));
    const int w = half * 4 + (F.wave & 3), i16 = lane & 15, q = lane >> 4; const bool active = F.wave < 4;
    const unsigned char* tiles = F.ws + WS_DNT + (size_t)dn_rec(b, h, dir, 0) * DNT_BYTES;
    const float* egl = (const float*)(F.ws + WS_DNS) + dn_rec(b, h, dir, 0);
    float* O = (float*)(F.ws + WS_DNO);
    LAS unsigned char* L = F.lds;
    f32x4 S[8];
#pragma unroll
    for (int i = 0; i < 8; ++i) S[i] = (f32x4){0.f, 0.f, 0.f, 0.f};
    v4u st[7]; f32x4 un[4];
#pragma unroll
    for (int mb = 0; mb < 4; ++mb) un[mb] = *(const f32x4*)(tiles + DN_U_OFF + (size_t)(((w * 4 + mb) * 64 + lane) * 16));
    __syncthreads();
#pragma unroll
    for (int i = 0; i < 7; ++i) st[i] = *(const v4u*)(tiles + (size_t)(F.tid + i * NTHREADS) * 16);
#pragma unroll
    for (int i = 0; i < 7; ++i) *(LAS v4u*)(L + (F.tid + i * NTHREADS) * 16) = st[i];
    __syncthreads();
#pragma unroll 1
    for (int n = 0; n < 68; ++n) {
        const unsigned char* tile = tiles + (size_t)n * DNT_BYTES; const LAS unsigned char* cur = L + (n & 1) * 57344;
        if (n + 1 < 68) {
#pragma unroll
            for (int i = 0; i < 7; ++i) st[i] = *(const v4u*)(tile + DNT_BYTES + (size_t)(F.tid + i * NTHREADS) * 16); }
        if (active) {
        f32x4 vn[4];
#pragma unroll
        for (int mb = 0; mb < 4; ++mb) vn[mb] = un[mb];
        if (n + 1 < 68) {
#pragma unroll
            for (int mb = 0; mb < 4; ++mb) un[mb] = *(const f32x4*)(tile + DNT_BYTES + DN_U_OFF + (size_t)(((w * 4 + mb) * 64 + lane) * 16)); }
        const float el = egl[n];
        bf16x8 bS[4];
#pragma unroll
        for (int ks = 0; ks < 4; ++ks) { v4u x; x.x = pk2(S[2 * ks][0], S[2 * ks][1]); x.y = pk2(S[2 * ks][2], S[2 * ks][3]); x.z = pk2(S[2 * ks + 1][0], S[2 * ks + 1][1]); x.w = pk2(S[2 * ks + 1][2], S[2 * ks + 1][3]); bS[ks] = __builtin_bit_cast(bf16x8, x); }
        f32x4 o[4];
#pragma unroll
        for (int mb = 0; mb < 4; ++mb) { o[mb] = (f32x4){0.f, 0.f, 0.f, 0.f};
#pragma unroll
            for (int ks = 0; ks < 4; ++ks) { const bf16x8 aw = *(const LAS bf16x8*)(cur + (DN_F_NEGW + mb * 4 + ks) * 1024 + lane * 16), aq = *(const LAS bf16x8*)(cur + (DN_F_QG + mb * 4 + ks) * 1024 + lane * 16);
                vn[mb] = __builtin_amdgcn_mfma_f32_16x16x32_bf16(aw, bS[ks], vn[mb], 0, 0, 0); o[mb] = __builtin_amdgcn_mfma_f32_16x16x32_bf16(aq, bS[ks], o[mb], 0, 0, 0); } }
        bf16x8 bV[2];
#pragma unroll
        for (int ks = 0; ks < 2; ++ks) { v4u x; x.x = pk2(vn[2 * ks][0], vn[2 * ks][1]); x.y = pk2(vn[2 * ks][2], vn[2 * ks][3]); x.z = pk2(vn[2 * ks + 1][0], vn[2 * ks + 1][1]); x.w = pk2(vn[2 * ks + 1][2], vn[2 * ks + 1][3]); bV[ks] = __builtin_bit_cast(bf16x8, x); }
#pragma unroll
        for (int mb = 0; mb < 8; ++mb) { S[mb] = S[mb] * el;
#pragma unroll
            for (int ks = 0; ks < 2; ++ks) { const bf16x8 ak = *(const LAS bf16x8*)(cur + (DN_F_KGT + mb * 2 + ks) * 1024 + lane * 16); S[mb] = __builtin_amdgcn_mfma_f32_16x16x32_bf16(ak, bV[ks], S[mb], 0, 0, 0); } }
#pragma unroll
        for (int mb = 0; mb < 4; ++mb)
#pragma unroll
            for (int ks = 0; ks < 2; ++ks) { const bf16x8 aqk = *(const LAS bf16x8*)(cur + (DN_F_QK + mb * 2 + ks) * 1024 + lane * 16); o[mb] = __builtin_amdgcn_mfma_f32_16x16x32_bf16(aqk, bV[ks], o[mb], 0, 0, 0); }
        { int m0; if (n < 4) m0 = NLAT + b * CTXL + 64 * (dir ? 3 - n : n); else m0 = b * SEQ + 64 * (dir ? 63 - (n - 4) : (n - 4));
#pragma unroll
          for (int mb = 0; mb < 4; ++mb)
#pragma unroll
            for (int i = 0; i < 4; ++i) { const int r = 16 * mb + 4 * q + i, tok = dir ? 63 - r : r; O[((size_t)dir * NTOK + m0 + tok) * 512 + h * 128 + 16 * w + i16] = o[mb][i]; } }
        }
        if (n + 1 < 68) {
#pragma unroll
            for (int i = 0; i < 7; ++i) *(LAS v4u*)(L + ((n + 1) & 1) * 57344 + (F.tid + i * NTHREADS) * 16) = st[i]; }
        __syncthreads();
    }
}
#define USE_CHUNK_LRU 1

constexpr int LR_XF = 0  , LR_XB = 16640  , LR_WT = 25856  , LR_AA = 62720  , LR_UU = 96000  , LR_END = 129280;
constexpr size_t WS_LCA = WS_LRC, WS_LCH = WS_LRC + 2 * MiB, WS_LCI = WS_LRC + 4 * MiB;
__device__ __forceinline__ void lru_prep(Frame& F, int l) {
    const bf16* P = (const bf16*)(F.ws + WS_P);
    int lane = F.lane; asm volatile("" : "+v"(lane));
    const int wave = F.wave, i16 = lane & 15, q = lane >> 4, nb = F.bid & 7;
    LAS unsigned char* L = F.lds;
    LAS float* XF = (LAS float*)(L + LR_XF); LAS float* AA = (LAS float*)(L + LR_AA); LAS float* UU = (LAS float*)(L + LR_UU);
    bf16* HL = (bf16*)(F.ws + WS_LRH); bf16* AC = (bf16*)(F.ws + WS_LRA);
    __syncthreads();
    for (int e = F.tid; e < 4 * 4096; e += NTHREADS) { const int mat = e >> 12, ii = (e >> 6) & 63, j = e & 63, dir = mat >> 1;
        const float w = (mat & 1 ? F.in[I_LRWI] : F.in[I_LRWR])[((size_t)((l * 2 + dir) * 8 + nb)) * 4096 + ii * 64 + j];
        *(LAS unsigned short*)(L + LR_WT + (mat * 64 + j) * 144 + ii * 2) = (unsigned short)f2bf(w); }
    float cwv[4][8], cbv[8];
    { const int c8 = (F.tid & 7) * 8, ch0 = nb * 64 + c8; const float* cb = F.in[I_LRCB] + l * 512 + ch0; const float* cw = F.in[I_LRCW] + (size_t)l * 4 * 512 + ch0;
#pragma unroll
      for (int k = 0; k < 8; ++k) cbv[k] = cb[k];
#pragma unroll
      for (int j = 0; j < 4; ++j)
#pragma unroll
        for (int k = 0; k < 8; ++k) cwv[j][k] = cw[j * 512 + k]; }
    float gbr[4], gbi[4], gls[4];
    { const int dir = wave >> 2;
#pragma unroll
      for (int n = 0; n < 4; ++n) { const int ch = nb * 64 + 16 * n + i16; gbr[n] = F.in[I_LRBR][(l * 2 + dir) * 512 + ch]; gbi[n] = F.in[I_LRBI][(l * 2 + dir) * 512 + ch]; gls[n] = -softplusf_(-F.in[I_LRLAM][(l * 2 + dir) * 512 + ch]); } }
    for (int ct = F.bid >> 3; ct < NCT; ct += F.G >> 3) {
        const int m0 = ct * 64; int t0, T, base; seq_of(m0, t0, T, base);
        __syncthreads();
        { const int tok = F.tid >> 3, c8 = (F.tid & 7) * 8, ch0 = nb * 64 + c8; float s[8];
#pragma unroll
          for (int k = 0; k < 8; ++k) s[k] = cbv[k];
          v4u wv[4];
#pragma unroll
          for (int j = 0; j < 4; ++j) { const int tt = t0 + tok + j - 2; wv[j] = (v4u){0u, 0u, 0u, 0u}; if (tt >= 0 && tt < T) wv[j] = *(const v4u*)(P + (size_t)(base + tt) * PW + PC_LX + ch0); }
#pragma unroll
          for (int j = 0; j < 4; ++j) { const v4u w = wv[j];
              s[0] += cwv[j][0] * bflo(w.x); s[1] += cwv[j][1] * bfhi(w.x); s[2] += cwv[j][2] * bflo(w.y); s[3] += cwv[j][3] * bfhi(w.y); s[4] += cwv[j][4] * bflo(w.z); s[5] += cwv[j][5] * bfhi(w.z); s[6] += cwv[j][6] * bflo(w.w); s[7] += cwv[j][7] * bfhi(w.w); }
#pragma unroll
          for (int k = 0; k < 8; ++k) XF[tok * 65 + c8 + k] = s[k];
          v4u o; o.x = pk2(s[0], s[1]); o.y = pk2(s[2], s[3]); o.z = pk2(s[4], s[5]); o.w = pk2(s[6], s[7]); *(LAS v4u*)(L + LR_XB + tok * 144 + c8 * 2) = o; }
        __syncthreads();
        { const int dir = wave >> 2, mb = wave & 3;
          f32x4 ar[4], ai[4];
#pragma unroll
          for (int n = 0; n < 4; ++n) { ar[n] = (f32x4){0.f, 0.f, 0.f, 0.f}; ai[n] = (f32x4){0.f, 0.f, 0.f, 0.f}; }
#pragma unroll
          for (int ks = 0; ks < 2; ++ks) { const bf16x8 a = *(const LAS bf16x8*)(L + LR_XB + (16 * mb + i16) * 144 + 64 * ks + 16 * q);
#pragma unroll
              for (int n = 0; n < 4; ++n) { const bf16x8 br = *(const LAS bf16x8*)(L + LR_WT + ((dir * 2 + 0) * 64 + 16 * n + i16) * 144 + 64 * ks + 16 * q), bi = *(const LAS bf16x8*)(L + LR_WT + ((dir * 2 + 1) * 64 + 16 * n + i16) * 144 + 64 * ks + 16 * q);
                  ar[n] = __builtin_amdgcn_mfma_f32_16x16x32_bf16(a, br, ar[n], 0, 0, 0); ai[n] = __builtin_amdgcn_mfma_f32_16x16x32_bf16(a, bi, ai[n], 0, 0, 0); } }
#pragma unroll
          for (int n = 0; n < 4; ++n) { const int j = 16 * n + i16; const float br_ = gbr[n], bi_ = gbi[n], logsig = gls[n];
#pragma unroll
              for (int i = 0; i < 4; ++i) { const int tok = 16 * mb + 4 * q + i; const float r = sigmoidf_(ar[n][i] + br_), ig = sigmoidf_(ai[n][i] + bi_);
                  const float log_a = 8.0f * r * logsig, a = __expf(log_a), u = sqrtf(-expm1f(2.0f * log_a)) * (ig * XF[tok * 65 + j]);
                  AA[(dir * 64 + tok) * 65 + j] = a; UU[(dir * 64 + tok) * 65 + j] = u; } } }
        __syncthreads();
        if (F.tid < 128) { const int dir = F.tid >> 6, j = F.tid & 63, ch = nb * 64 + j; float h = 0.f, ac = 1.f;
            long o = (long)(((size_t)dir * NTOK + m0 + (dir ? 63 : 0)) * 512 + ch); const long ostep = dir ? -512 : 512;
#pragma unroll 1
            for (int s0 = 0; s0 < 64; s0 += 8) { float av[8], uv[8];
#pragma unroll
                for (int k = 0; k < 8; ++k) { const int tok = dir ? 63 - (s0 + k) : (s0 + k); av[k] = AA[(dir * 64 + tok) * 65 + j]; uv[k] = UU[(dir * 64 + tok) * 65 + j]; }
#pragma unroll
                for (int k = 0; k < 8; ++k) { h = av[k] * h + uv[k]; ac *= av[k]; HL[o] = (bf16)f2bf(h); AC[o] = (bf16)f2bf(ac); o += ostep; } }
            ((float*)(F.ws + WS_LCA))[((size_t)dir * NCT + ct) * 512 + ch] = ac; ((float*)(F.ws + WS_LCH))[((size_t)dir * NCT + ct) * 512 + ch] = h; }
    }
    __syncthreads();
}
__device__ __forceinline__ void lru_carry(Frame& F, int idx) {
    const int ch = idx & 511, dir = (idx >> 9) & 1, b = idx >> 10;
    const float* CA = (const float*)(F.ws + WS_LCA); const float* CH = (const float*)(F.ws + WS_LCH); float* CI = (float*)(F.ws + WS_LCI);
    float h = 0.f;
#pragma unroll 4
    for (int n = 0; n < 68; ++n) { const int ct = n < 4 ? 256 + b * 4 + (dir ? 3 - n : n) : b * 64 + (dir ? 63 - (n - 4) : (n - 4)); const size_t o = ((size_t)dir * NCT + ct) * 512 + ch;
        CI[o] = h; h = CA[o] * h + CH[o]; }
}
__device__ __forceinline__ void lru_fin(Frame& F, int l) {
    const int nrows = (l == 0) ? NTOK : NLAT;
    const bf16* P = (const bf16*)(F.ws + WS_P); bf16* CC = (bf16*)(F.ws + WS_CC);
    const bf16* HL = (const bf16*)(F.ws + WS_LRH); const bf16* AC = (const bf16*)(F.ws + WS_LRA); const float* CI = (const float*)(F.ws + WS_LCI);
    for (size_t i = (size_t)F.bid * NTHREADS + F.tid; i < (size_t)nrows * 128; i += (size_t)F.G * NTHREADS) { const int m = (int)(i >> 7), c4 = (int)(i & 127) * 4, ct = m >> 6;
        const v2u hw0 = *(const v2u*)(HL + (size_t)m * 512 + c4), aw0 = *(const v2u*)(AC + (size_t)m * 512 + c4), hw1 = *(const v2u*)(HL + ((size_t)NTOK + m) * 512 + c4), aw1 = *(const v2u*)(AC + ((size_t)NTOK + m) * 512 + c4);
        const f32x4 h0 = {bflo(hw0.x), bfhi(hw0.x), bflo(hw0.y), bfhi(hw0.y)}, a0 = {bflo(aw0.x), bfhi(aw0.x), bflo(aw0.y), bfhi(aw0.y)}, h1 = {bflo(hw1.x), bfhi(hw1.x), bflo(hw1.y), bfhi(hw1.y)}, a1 = {bflo(aw1.x), bfhi(aw1.x), bflo(aw1.y), bfhi(aw1.y)};
        const f32x4 i0 = *(const f32x4*)(CI + (size_t)ct * 512 + c4), i1 = *(const f32x4*)(CI + ((size_t)NCT + ct) * 512 + c4);
        const f32x4 hs = (a0 * i0 + h0) + (a1 * i1 + h1); const v2u yw = *(const v2u*)(P + (size_t)m * PW + PC_LY + c4);
        v2u o; o.x = pk2(hs.x * gelu_tanh(bflo(yw.x)), hs.y * gelu_tanh(bfhi(yw.x))); o.y = pk2(hs.z * gelu_tanh(bflo(yw.y)), hs.w * gelu_tanh(bfhi(yw.y)));
        *(v2u*)(CC + (size_t)m * DM + 1536 + c4) = o; }
}

constexpr size_t WS_DNQ = WS_DNT;
constexpr size_t WS_BG = WS_DNS + 1 * MiB;
constexpr size_t WS_XC = WS_XS;

__device__ __forceinline__ void naive_prep(Frame& F, int l) {
    const bf16* P = (const bf16*)(F.ws + WS_P);
    const int gw = F.bid * NWAVES + F.wave, NGW = F.G * NWAVES;
#if !defined(USE_CHUNK_DN)
    {
        float* DNQ = (float*)(F.ws + WS_DNQ); float* BG = (float*)(F.ws + WS_BG);
        const float* cw = F.in[I_DNCW] + (size_t)l * 4 * 1536;
        for (int it = gw; it < NTOK * 4; it += NGW) {
            const int m = it >> 2, h = it & 3; int t, T, base; seq_of(m, t, T, base);
            float val[3][2];
#pragma unroll
            for (int part = 0; part < 3; ++part)
#pragma unroll
                for (int dd = 0; dd < 2; ++dd) { const int d = F.lane + 64 * dd, cch = part * 512 + h * 128 + d, col = PC_DQ + cch; float s = 0.f;
#pragma unroll
                    for (int j = 0; j < 4; ++j) { const int tt = t + j - 2; if (tt >= 0 && tt < T) s += cw[j * 1536 + cch] * bf2f(P[(size_t)(base + tt) * PW + col]); }
                    val[part][dd] = siluf_(s); }
            const float sq = wave_sum(val[0][0] * val[0][0] + val[0][1] * val[0][1]), sk = wave_sum(val[1][0] * val[1][0] + val[1][1] * val[1][1]);
            const float fq = 0.08838834764831845f / sqrtf(sq + EPS), fk = 1.0f / sqrtf(sk + EPS);
#pragma unroll
            for (int dd = 0; dd < 2; ++dd) { const int d = F.lane + 64 * dd; float* o = DNQ + (size_t)m * 1536 + h * 128 + d;
                o[0] = val[0][dd] * fq; o[512] = val[1][dd] * fk; o[1024] = val[2][dd]; }
            if (h == 0 && F.lane < 8) { const int dir = F.lane >> 2, hh = F.lane & 3;
                const float pb = bf2f(P[(size_t)m * PW + PC_BETA + F.lane]), pa = bf2f(P[(size_t)m * PW + PC_DEC + F.lane]);
                BG[m * 16 + F.lane] = sigmoidf_(pb);
                BG[m * 16 + 8 + F.lane] = -__expf(F.in[I_DNALOG][l * 8 + dir * 4 + hh]) * softplusf_(pa + F.in[I_DNDT][l * 8 + dir * 4 + hh]); }
        }
    }
#endif
#if !defined(USE_CHUNK_LRU)
    {
        LAS float* xc = (LAS float*)F.lds;
        float* A = (float*)(F.ws + WS_LRA); float* U = (float*)(F.ws + WS_LRH);
        const float* cw = F.in[I_LRCW] + (size_t)l * 4 * 512; const float* cb = F.in[I_LRCB] + l * 512;
        for (int m0 = F.bid * 8; m0 < NTOK; m0 += F.G * 8) {
            __syncthreads();
            for (int i = F.tid; i < 8 * 512; i += NTHREADS) { const int m = m0 + (i >> 9), ch = i & 511; int t, T, base; seq_of(m, t, T, base); float s = cb[ch];
#pragma unroll
                for (int j = 0; j < 4; ++j) { const int tt = t + j - 2; if (tt >= 0 && tt < T) s += cw[j * 512 + ch] * bf2f(P[(size_t)(base + tt) * PW + PC_LX + ch]); }
                xc[i] = s; }
            __syncthreads();
            for (int i = F.tid; i < 8 * 512 * 2; i += NTHREADS) { const int ch = i & 511, dir = (i >> 9) & 1, tk = i >> 10, m = m0 + tk, blk = ch >> 6, j = ch & 63;
                const float* wr = F.in[I_LRWR] + ((size_t)((l * 2 + dir) * 8 + blk)) * 4096 + j; const float* wi = F.in[I_LRWI] + ((size_t)((l * 2 + dir) * 8 + blk)) * 4096 + j;
                float sr = F.in[I_LRBR][(l * 2 + dir) * 512 + ch], si = F.in[I_LRBI][(l * 2 + dir) * 512 + ch];
#pragma unroll 8
                for (int ii = 0; ii < 64; ++ii) { const float x = xc[tk * 512 + blk * 64 + ii]; sr += x * wr[ii * 64]; si += x * wi[ii * 64]; }
                const float r = sigmoidf_(sr), ig = sigmoidf_(si); const float lam = F.in[I_LRLAM][(l * 2 + dir) * 512 + ch];
                const float logsig = -softplusf_(-lam);
                const float log_a = 8.0f * r * logsig; const float a = __expf(log_a);
                const float u = sqrtf(-expm1f(2.0f * log_a)) * (ig * xc[tk * 512 + ch]);
                A[((size_t)dir * NTOK + m) * 512 + ch] = a; U[((size_t)dir * NTOK + m) * 512 + ch] = u; }
        }
        __syncthreads();
    }
#endif
}

__device__ __forceinline__ void naive_attn_row(Frame& F, int l, int m, int hq) {
    const bf16* P = (const bf16*)(F.ws + WS_P); bf16* CC = (bf16*)(F.ws + WS_CC);
    const int d = F.lane, kvh = hq >> 2; int t, T, base; seq_of(m, t, T, base);
    const bool lat = m < NLAT; const int b = lat ? (m >> 12) : ((m - NLAT) >> 8);
    const int dd = d & 31, jf = dd & 15; const float inv = __powf(10000.0f, -(float)jf * (1.0f / 16.0f));
    const bool second = (dd >= 16), colhalf = (d >= 32);
    float q = bf2f(P[(size_t)m * PW + PC_Q + hq * 64 + d]);
    if (lat) { const float pos = (float)(colhalf ? (t & 63) : (t >> 6)); float sn, cs; sincosf(pos * inv, &sn, &cs); const float pr = __shfl_xor(q, 16); q = second ? (q * cs + pr * sn) : (q * cs - pr * sn); }
    q *= 0.125f;
    float mx = F.in[I_SINK][l * 16 + hq], den = 1.0f, acc = 0.f;
    if (lat) { const int t0 = t - 128 < 0 ? 0 : t - 128, t1 = t + 128 > SEQ - 1 ? SEQ - 1 : t + 128;
        for (int tk = t0; tk <= t1; ++tk) { const size_t r = (size_t)(base + tk) * PW; float k = bf2f(P[r + PC_K + kvh * 64 + d]); const float v = bf2f(P[r + PC_V + kvh * 64 + d]);
            const float pos = (float)(colhalf ? (tk & 63) : (tk >> 6)); float sn, cs; sincosf(pos * inv, &sn, &cs); const float pr = __shfl_xor(k, 16); k = second ? (k * cs + pr * sn) : (k * cs - pr * sn);
            const float s = wave_sum(q * k); const float mn = fmaxf(mx, s), f = __expf(mx - mn), p = __expf(s - mn); den = den * f + p; acc = acc * f + p * v; mx = mn; } }
    for (int c = 0; c < CTXL; ++c) { const size_t r = (size_t)(NLAT + b * CTXL + c) * PW; const float k = bf2f(P[r + PC_K + kvh * 64 + d]), v = bf2f(P[r + PC_V + kvh * 64 + d]);
        const float s = wave_sum(q * k); const float mn = fmaxf(mx, s), f = __expf(mx - mn), p = __expf(s - mn); den = den * f + p; acc = acc * f + p * v; mx = mn; }
    CC[(size_t)m * DM + hq * 64 + d] = (bf16)f2bf(acc / den);
}

__device__ __forceinline__ int scan_row(int n, int b, int dir) { if (n < CTXL) { const int t = dir ? (CTXL - 1 - n) : n; return NLAT + b * CTXL + t; } const int t = dir ? (SEQ - 1 - (n - CTXL)) : (n - CTXL); return b * SEQ + t; }
__device__ __forceinline__ void naive_scan(Frame& F, int l, int rep = 0) {
#if defined(USE_CHUNK_DN)
    if (F.bid < 64) { dn_scan(F, l, F.bid >> 4, (F.bid >> 2) & 3, (F.bid >> 1) & 1, F.bid & 1); }
#else
    if (F.bid < 32) {
        const int b = F.bid >> 3, h = (F.bid >> 1) & 3, dir = F.bid & 1, dvc = F.tid & 127, kq = F.tid >> 7;
        const float* DNQ = (const float*)(F.ws + WS_DNQ); const float* BG = (const float*)(F.ws + WS_BG); float* O = (float*)(F.ws + WS_DNO);
        LAS float* buf = (LAS float*)F.lds;
        LAS float* red = buf + 768;
        LAS float* red2 = red + 512;
        float S[32];
#pragma unroll
        for (int i = 0; i < 32; ++i) S[i] = 0.f;
        constexpr int NT = CTXL + SEQ;
        { const int m = scan_row(0, b, dir); if (F.tid < 384) buf[F.tid] = DNQ[(size_t)m * 1536 + (F.tid >> 7) * 512 + h * 128 + (F.tid & 127)]; }
        __syncthreads();
#pragma unroll 1
        for (int n = 0; n < NT; ++n) {
            const int m = scan_row(n, b, dir); const LAS float* cur = buf + (n & 1) * 384;
            float nextv = 0.f; if (n + 1 < NT && F.tid < 384) { const int m2 = scan_row(n + 1, b, dir); nextv = DNQ[(size_t)m2 * 1536 + (F.tid >> 7) * 512 + h * 128 + (F.tid & 127)]; }
            const float beta = BG[m * 16 + dir * 4 + h], decay = __expf(BG[m * 16 + 8 + dir * 4 + h]);
            float ks = 0.f;
#pragma unroll
            for (int i = 0; i < 32; ++i) ks += cur[128 + kq * 32 + i] * S[i];
            red[kq * 128 + dvc] = ks;
            __syncthreads();
            const float kS = (red[dvc] + red[128 + dvc]) + (red[256 + dvc] + red[384 + dvc]);
            const float upd = beta * (cur[256 + dvc] - decay * kS);
            float os = 0.f;
#pragma unroll
            for (int i = 0; i < 32; ++i) { S[i] = decay * S[i] + cur[128 + kq * 32 + i] * upd; os += cur[kq * 32 + i] * S[i]; }
            red2[kq * 128 + dvc] = os;
            if (F.tid < 384) buf[((n + 1) & 1) * 384 + F.tid] = nextv;
            __syncthreads();
            if (kq == 0) O[((size_t)dir * NTOK + m) * 512 + h * 128 + dvc] = (red2[dvc] + red2[128 + dvc]) + (red2[256 + dvc] + red2[384 + dvc]);
        }
    }
#endif
#if defined(USE_CHUNK_LRU)
    else if (F.bid < 72) { lru_carry(F, (F.bid - 64) * NTHREADS + F.tid); }
#else
    else if (F.bid < 40) {
        const int idx = (F.bid - 32) * NTHREADS + F.tid, ch = idx & 511, dir = (idx >> 9) & 1, b = idx >> 10;
        const float* A = (const float*)(F.ws + WS_LRA); float* U = (float*)(F.ws + WS_LRH);
        float hs = 0.f;
#pragma unroll 4
        for (int n = 0; n < CTXL + SEQ; ++n) { int m; if (n < CTXL) { const int t = dir ? (CTXL - 1 - n) : n; m = NLAT + b * CTXL + t; } else { const int t = dir ? (SEQ - 1 - (n - CTXL)) : (n - CTXL); m = b * SEQ + t; }
            const size_t o = ((size_t)dir * NTOK + m) * 512 + ch; hs = A[o] * hs + U[o]; U[o] = hs; }
    }
#endif
#if defined(USE_MFMA_ATTN)
    attn_phase(F, l, rep);
    convert_moe_queue(F, l, rep);
#else
    {
        const int nrows = (l == 0) ? NTOK : NLAT;
        for (;;) { int m = 0; if (F.lane == 0) m = (int)__hip_atomic_fetch_add(F.ctl + CW_ATQ + 64 * l, 1u, RLX_AGENT); m = __builtin_amdgcn_readfirstlane(m);
            if (m >= nrows) break;
#pragma unroll 1
            for (int hq = 0; hq < 16; ++hq) naive_attn_row(F, l, m, hq); }
    }
#endif
}

__device__ __forceinline__ void naive_fin(Frame& F, int l) {
    const int nrows = (l == 0) ? NTOK : NLAT;
    const bf16* P = (const bf16*)(F.ws + WS_P); bf16* CC = (bf16*)(F.ws + WS_CC);
    const int gw = F.bid * NWAVES + F.wave, NGW = F.G * NWAVES;
    const float* O = (const float*)(F.ws + WS_DNO); const float* HS = (const float*)(F.ws + WS_LRH);
    for (int it0 = gw * 2; it0 < nrows * 4; it0 += NGW * 2) {
        float2 oa[2], ob[2]; unsigned gw_[2];
#pragma unroll
        for (int k = 0; k < 2; ++k) { const int it = it0 + k, m = it >> 2, h = it & 3; const int c = h * 128 + 2 * F.lane;
            oa[k] = *(const float2*)(O + (size_t)m * 512 + c); ob[k] = *(const float2*)(O + ((size_t)NTOK + m) * 512 + c); gw_[k] = *(const unsigned*)(P + (size_t)m * PW + PC_DG + c); }
        const float2 ng = *(const float2*)(F.in[I_DNNG] + l * 128 + 2 * F.lane);
#pragma unroll
        for (int k = 0; k < 2; ++k) { const int it = it0 + k, m = it >> 2, h = it & 3; const float o0 = oa[k].x + ob[k].x, o1 = oa[k].y + ob[k].y;
            const float rstd = 1.0f / sqrtf(wave_sum(o0 * o0 + o1 * o1) * (1.0f / 128.0f) + EPS);
            *(unsigned*)(CC + (size_t)m * DM + 1024 + h * 128 + 2 * F.lane) = pk2(o0 * rstd * ng.x * siluf_(bflo(gw_[k])), o1 * rstd * ng.y * siluf_(bfhi(gw_[k]))); }
    }
#if defined(USE_CHUNK_LRU)
    lru_fin(F, l);
#else
    for (size_t i = (size_t)F.bid * NTHREADS + F.tid; i < (size_t)nrows * 512; i += (size_t)F.G * NTHREADS) { const int m = (int)(i >> 9), ch = (int)(i & 511);
        const float hsum = HS[(size_t)m * 512 + ch] + HS[((size_t)NTOK + m) * 512 + ch]; const float y = bf2f(P[(size_t)m * PW + PC_LY + ch]);
        CC[(size_t)m * DM + 1536 + ch] = (bf16)f2bf(hsum * gelu_tanh(y)); }
#endif
}
#ifndef PHASE_PREP
#if defined(USE_MFMA_ATTN)
#if defined(USE_CHUNK_DN)
#define PHASE_PREP(F, l) do { attn_prep(F, l); lru_prep(F, l); dn_prep(F, l); } while (0)
#else
#define PHASE_PREP(F, l) do { naive_prep(F, l); attn_prep(F, l); } while (0)
#endif
#else
#define PHASE_PREP(F, l) naive_prep(F, l)
#endif
#endif
#ifndef PHASE_SCAN
#define PHASE_SCAN(F, l) naive_scan(F, l)
#endif
#ifndef PHASE_FIN
#define PHASE_FIN(F, l) naive_fin(F, l)
#endif

#ifndef PHASE_INPROJ
#define PHASE_INPROJ(F, l) do {} while (0)
#endif
#ifndef PHASE_PREP
#define PHASE_PREP(F, l) do {} while (0)
#endif
#ifndef PHASE_SCAN
#define PHASE_SCAN(F, l) do {} while (0)
#endif
#ifndef PHASE_FIN
#define PHASE_FIN(F, l) do {} while (0)
#endif
#ifndef PHASE_OUTPROJ
#define PHASE_OUTPROJ(F, l) do {} while (0)
#endif
#ifndef PHASE_NORM2
#define PHASE_NORM2(F, l) do {} while (0)
#endif
#ifndef PHASE_SCATTER
#define PHASE_SCATTER(F, l) do {} while (0)
#endif
#ifndef PHASE_GEMM1
#define PHASE_GEMM1(F, l) do {} while (0)
#endif
#ifndef PHASE_GEMM2
#define PHASE_GEMM2(F, l) do {} while (0)
#endif

#ifndef MK_SPLIT
#define MK_SPLIT 0
#endif
#ifndef MK_STAGE
#define MK_STAGE 99
#endif
#ifndef MK_TAILFILL
#define MK_TAILFILL 0
#endif
#ifndef MK_DUP
#define MK_DUP 0
#endif
#define DUP(k) ((MK_DUP >> (k)) & 1)
constexpr int N_PHASES = 22;
struct Args { const float* in[N_IN]; float* out; unsigned char* ws; int ph_lo, ph_hi; };
static_assert(sizeof(Args) == (N_IN + 2) * 8 + 8, "Args has no padding");

__global__ void __launch_bounds__(NTHREADS, 2) fwd_kernel(Args args) {
    extern __shared__ __attribute__((aligned(16))) unsigned char lds[];
    Frame F;
    F.lds = (LAS unsigned char*)lds;
    F.MISC = (volatile LAS unsigned*)(F.lds + MISC_OFF);
    F.tid = threadIdx.x; F.lane = F.tid & 63; F.wave = __builtin_amdgcn_readfirstlane(F.tid >> 6);
    F.G = gridDim.x; F.bid = blockIdx.x;
    F.ws = args.ws; F.out = args.out; F.ctl = (gu32*)(args.ws + WS_CTL);
    F.in = (const float* const __attribute__((address_space(4)))*)__builtin_amdgcn_kernarg_segment_ptr();
    for (int u = F.tid; u < (LDS_BYTES - LDSCTL_OFF) / 4; u += NTHREADS) ((LAS unsigned*)(F.lds + LDSCTL_OFF))[u] = 0u;
    __syncthreads();
    XcdBarrier bar; bar.bar = (unsigned*)(F.ctl + CW_BAR); bar.x = 0; bar.st = nullptr;
    if (!MK_SPLIT) bar = xcd_barrier_post((unsigned*)(F.ctl + CW_BAR), F.MISC + 8);
    const int lo = args.ph_lo, hi = args.ph_hi;
#define IN(k) (lo <= (k) && (k) < hi && phase_enter(F))
#define INR(k) (lo <= (k) && (k) < hi)
#define SEAM(k) do { if (INR(k) && INR((k) + 1)) { if (MK_TAILFILL && (k) < 14) tail_fill(F, (k), (k) < 4 ? 0 : 1); xcd_barrier(bar); } } while (0)

    if (IN(0)) { p0_prologue(F); if (DUP(0)) { __syncthreads(); p0_prologue(F); } } SEAM(0);
#pragma unroll 1
    for (int l = 0; l < DEPTH; ++l) {
        const int pb = 1 + 10 * l;
        if (IN(pb + 0)) { phase_norm1(F, l); if (DUP(13) && l == 0) { __syncthreads(); phase_norm1(F, l); } } SEAM(pb + 0);
        if (IN(pb + 1)) { PHASE_INPROJ(F, l); if (DUP(1)) { __syncthreads(); PHASE_INPROJ(F, l); } } SEAM(pb + 1);
        if (IN(pb + 2)) { PHASE_PREP(F, l); if (DUP(2)) { __syncthreads(); dn_prep(F, l); } if (DUP(6)) { __syncthreads(); lru_prep(F, l); } } SEAM(pb + 2);
        if (IN(pb + 3)) { if (DUP(3) && F.bid < 64) dn_scan(F, l, F.bid >> 4, (F.bid >> 2) & 3, (F.bid >> 1) & 1, F.bid & 1); PHASE_SCAN(F, l); if (DUP(10)) { __syncthreads(); naive_scan(F, l, 1); } if (DUP(11)) { __syncthreads(); attn_phase(F, l, 2); } if (DUP(12)) { __syncthreads(); convert_moe_queue(F, l, 3); } } SEAM(pb + 3);
        if (IN(pb + 4)) { PHASE_FIN(F, l); if (DUP(4)) { __syncthreads(); PHASE_FIN(F, l); } } SEAM(pb + 4);
        if (IN(pb + 5)) { PHASE_OUTPROJ(F, l); if (DUP(5) && l == 0) { __syncthreads(); PHASE_OUTPROJ(F, l); } } SEAM(pb + 5);
        if (IN(pb + 6)) { PHASE_NORM2(F, l); } SEAM(pb + 6);
        if (IN(pb + 7)) { PHASE_SCATTER(F, l); if (DUP(7)) { __syncthreads(); PHASE_SCATTER(F, l); } } SEAM(pb + 7);
        if (IN(pb + 8)) { PHASE_GEMM1(F, l); if (DUP(8)) { __syncthreads(); PHASE_GEMM1(F, l); } } SEAM(pb + 8);
        if (IN(pb + 9)) { PHASE_GEMM2(F, l); if (DUP(9)) { __syncthreads(); PHASE_GEMM2(F, l); } } SEAM(pb + 9);
    }
    if (IN(21)) { phase_final(F, MK_STAGE >= 9); if (DUP(13)) { __syncthreads(); phase_final(F, MK_STAGE >= 9); } }
#undef IN
#undef SEAM
}

extern "C" void kernel_launch(void* const* d_in, const int* in_sizes, int n_in, void* d_out, int out_size, void* d_ws, size_t ws_size, hipStream_t stream) {
    static int grid = 0;
    if (grid == 0) {
        if (n_in != N_IN || out_size != NLAT * DM || ws_size < WS_END) { fprintf(stderr, "kernel_launch: unexpected shapes (n_in %d, out %d, ws %zu); nothing launched\n", n_in, out_size, ws_size); grid = -1; return; }
        int dev = 0, cus = 0, per_cu = 0;
        if (hipGetDevice(&dev) != hipSuccess || hipDeviceGetAttribute(&cus, hipDeviceAttributeMultiprocessorCount, dev) != hipSuccess) { grid = -1; return; }
        if (hipFuncSetAttribute((const void*)fwd_kernel, hipFuncAttributeMaxDynamicSharedMemorySize, LDS_BYTES) != hipSuccess) { fprintf(stderr, "kernel_launch: hipFuncSetAttribute failed\n"); grid = -1; return; }
        if (hipOccupancyMaxActiveBlocksPerMultiprocessor(&per_cu, (const void*)fwd_kernel, NTHREADS, LDS_BYTES) != hipSuccess || per_cu < 1) { fprintf(stderr, "kernel_launch: occupancy query says %d\n", per_cu); }
        (void)hipGetLastError();
        grid = cus;
        if (grid != 256) { fprintf(stderr, "kernel_launch: built for 256 CUs, device has %d; nothing launched\n", cus); grid = -1; return; }
    }
    if (grid < 0) return;
    if (hipMemsetAsync((char*)d_ws + WS_CTL, 0, CTL_ZERO_BYTES, stream) != hipSuccess) return;
    Args a{};
    for (int i = 0; i < N_IN; ++i) a.in[i] = (const float*)d_in[i];
    a.out = (float*)d_out; a.ws = (unsigned char*)d_ws;
#if MK_SPLIT
    for (int p = 0; p < N_PHASES; ++p) { a.ph_lo = p; a.ph_hi = p + 1; hipLaunchKernelGGL(fwd_kernel, dim3(grid), dim3(NTHREADS), LDS_BYTES, stream, a); }
#else
    a.ph_lo = 0; a.ph_hi = N_PHASES;
    hipLaunchKernelGGL(fwd_kernel, dim3(grid), dim3(NTHREADS), LDS_BYTES, stream, a);
#endif
    const hipError_t le = hipPeekAtLastError();
    if (le != hipSuccess) fprintf(stderr, "kernel_launch: launch failed: %s\n", hipGetErrorName(le));
}
```

```cpp
#include <hip/hip_runtime.h>
#include <cstdio>
#include <cstdint>

constexpr int DM = 2048, NB = 4, SEQ = 4096, CTXL = 256, DEPTH = 2;
constexpr int NLAT = NB * SEQ, NCTX = NB * CTXL, NTOK = NLAT + NCTX;
constexpr int NCT = NTOK / 64;
constexpr int IN_W = 4624, PW = 4864;
constexpr int PC_Q = 0, PC_K = 1024, PC_V = 1280, PC_DQ = 1536, PC_DK = 2048, PC_DV = 2560, PC_DG = 3072, PC_LX = 3584, PC_LY = 4096, PC_BETA = 4608, PC_DEC = 4616;
constexpr int NEXP = 32, TOPK = 4, DEXP = 1024;
constexpr int MOE_ROWS = 304 * 256;
constexpr float EPS = 1e-6f;
#ifndef MK_STAGE
#define MK_STAGE 99
#endif
namespace pg8 {
#define PG8_LAS __attribute__((address_space(3)))
typedef unsigned short bf16_t;
typedef short bf16x8 __attribute__((ext_vector_type(8)));
typedef float f32x4 __attribute__((ext_vector_type(4)));
typedef unsigned u32x4 __attribute__((ext_vector_type(4)));
typedef float f32x2 __attribute__((ext_vector_type(2)));
constexpr int BM = 256, BK = 64, HALF = 128, HTB = HALF * BK * 2  , STAGE_BYTES = 8 * HTB, NXCD = 8, WGM = 8;

__host__ __device__ __forceinline__ int lds_byte(int r, int c) { const int st = (r >> 4) * 2 + (c >> 5), rr = r & 15, cc = c & 31, ob = rr * 64 + cc * 2; return st * 1024 + (ob ^ (((ob >> 9) & 1) << 5)); }
__host__ __device__ __forceinline__ void stage_rc(int b, int& R, int& C) { const int st = b / 1024, sb = b % 1024, swz = sb ^ (((sb >> 9) & 1) << 5); R = (st >> 1) * 16 + swz / 64; C = (st & 1) * 32 + (swz % 64) / 2; }
__host__ __device__ __forceinline__ int perm32(int rho) { const int n = rho >> 4, i = rho & 15; return 8 * (i >> 2) + 4 * n + (i & 3); }

struct Unit { int pm, pn, e; };
struct Gemm { const bf16_t* A; const bf16_t* Bt; int M, N, K; };

struct StaticOrder {
    static constexpr bool GATHER = false; const int* row_tab = nullptr;
    int nM, nN, nwg, G, c; const char* A; const char* Bt; size_t tstep;
    __device__ void init(const Gemm& g, int G_, int c_) { nM = g.M / BM; nN = g.N / BM; nwg = nM * nN; G = G_; c = c_; A = (const char*)g.A; Bt = (const char*)g.Bt; tstep = (size_t)BM * g.K * 2; }
    __device__ bool next(int i, Unit& u) const {
        const long L = (long)i * G + c; if (L >= nwg) return false;
        int wgid = (int)L; { const int q = nwg / NXCD, r = nwg % NXCD, xcd = wgid % NXCD, off = wgid / NXCD; wgid = (xcd < r ? xcd * (q + 1) : r * (q + 1) + (xcd - r) * q) + off; }
        const int nig = WGM * nN, gid = wgid / nig, fm = gid * WGM, gsz = (nM - fm) < WGM ? (nM - fm) : WGM;
        u.pm = fm + ((wgid % nig) % gsz); u.pn = (wgid % nig) / gsz; u.e = 0; return true;
    }
    __device__ __forceinline__ const char* a_ptr(const Unit& u) const { return A + (size_t)u.pm * tstep; }
    __device__ __forceinline__ const char* b_ptr(const Unit& u) const { return Bt + (size_t)u.pn * tstep; }
    __device__ __forceinline__ void a_ready(const Unit&) const {}
    __device__ __forceinline__ void done(const Unit&) const {}
};
__device__ __forceinline__ unsigned cvt_pk_bf16(float lo, float hi) { unsigned r; asm volatile("v_cvt_pk_bf16_f32 %0, %1, %2" : "=v"(r) : "v"(lo), "v"(hi)); return r; }
struct EpiBf16Plain {
    static constexpr bool PERM = true, AFTER_DRAIN = false;
    bf16_t* O; int ldc;
    __device__ __forceinline__ void operator()(const f32x4 (&acc)[2][2][4][2], const Unit& u, int wr, int wc, int fr, int fq) const {
        const int row0 = u.pm * BM + wr * 64 + fr, col0 = u.pn * BM + wc * 32 + 8 * fq;
#pragma unroll
        for (int ai = 0; ai < 2; ++ai)
#pragma unroll
            for (int m = 0; m < 4; ++m) { bf16_t* rowp = O + (size_t)(row0 + ai * HALF + m * 16) * ldc + col0;
#pragma unroll
                for (int bj = 0; bj < 2; ++bj) { const f32x4 v0 = acc[ai][bj][m][0], v1 = acc[ai][bj][m][1];
                    u32x4 w; w.x = cvt_pk_bf16(v0[0], v0[1]); w.y = cvt_pk_bf16(v0[2], v0[3]); w.z = cvt_pk_bf16(v1[0], v1[1]); w.w = cvt_pk_bf16(v1[2], v1[3]);
                    *(u32x4*)(rowp + bj * HALF) = w; } }
    }
};
struct EpiResGate {
    static constexpr bool PERM = false, AFTER_DRAIN = false;
    const float* base_lat; const float* base_ctx; float* out; const float* modg;
    __device__ __forceinline__ void operator()(const f32x4 (&acc)[2][2][4][2], const Unit& u, int wr, int wc, int fr, int fq) const {
        const int r = u.pm < 64 ? (u.pm >> 4) : 4; const int col0 = u.pn * BM + wc * 32 + 4 * fq;
        const float* g = modg + (size_t)r * 12288 + col0;
        f32x4 gv[2][2];
#pragma unroll
        for (int bj = 0; bj < 2; ++bj)
#pragma unroll
            for (int n = 0; n < 2; ++n) gv[bj][n] = *(const f32x4*)(g + bj * HALF + n * 16);
#pragma unroll
        for (int ai = 0; ai < 2; ++ai)
#pragma unroll
            for (int m = 0; m < 4; ++m) { const int row = u.pm * BM + ai * HALF + wr * 64 + m * 16 + fr;
                const float* bp = (row < 16384 ? base_lat + (size_t)row * 2048 : base_ctx + (size_t)(row - 16384) * 2048) + col0; float* op = out + (size_t)row * 2048 + col0;
#pragma unroll
                for (int bj = 0; bj < 2; ++bj)
#pragma unroll
                    for (int n = 0; n < 2; ++n) { const f32x4 b = *(const f32x4*)(bp + bj * HALF + n * 16); *(f32x4*)(op + bj * HALF + n * 16) = b + gv[bj][n] * acc[ai][bj][m][n]; }
                asm volatile("" ::: "memory"); }
    }
};
struct EpiSwiglu {
    static constexpr bool PERM = true, AFTER_DRAIN = false;
    bf16_t* O; const float* bgu;
    __device__ __forceinline__ void operator()(const f32x4 (&acc)[2][2][4][2], const Unit& u, int wr, int wc, int fr, int fq) const {
        const int row0 = u.pm * BM + wr * 64 + fr, cc0 = wc * 32 + 8 * fq;
        const float* bg = bgu + (size_t)u.e * 2048 + u.pn * 128 + cc0;
        f32x4 bglu[2], blin[2];
#pragma unroll
        for (int n = 0; n < 2; ++n) { bglu[n] = *(const f32x4*)(bg + 4 * n); blin[n] = *(const f32x4*)(bg + 1024 + 4 * n); }
#pragma unroll
        for (int ai = 0; ai < 2; ++ai)
#pragma unroll
            for (int m = 0; m < 4; ++m) { bf16_t* rowp = O + (size_t)(row0 + ai * HALF + m * 16) * 1024 + u.pn * 128 + cc0;
                float r[8];
#pragma unroll
                for (int n = 0; n < 2; ++n) { const f32x4 g = acc[ai][0][m][n] + bglu[n], l = acc[ai][1][m][n] + blin[n];
#pragma unroll
                    for (int i = 0; i < 4; ++i) { const float gg = fminf(g[i], 7.0f); const float ll = fminf(fmaxf(l[i], -7.0f), 7.0f);
                        r[4 * n + i] = (ll + 1.0f) * gg * __builtin_amdgcn_rcpf(1.0f + __builtin_amdgcn_exp2f(-1.702f * 1.4426950408889634f * gg)); } }
                u32x4 w; w.x = cvt_pk_bf16(r[0], r[1]); w.y = cvt_pk_bf16(r[2], r[3]); w.z = cvt_pk_bf16(r[4], r[5]); w.w = cvt_pk_bf16(r[6], r[7]);
                *(u32x4*)rowp = w; }
    }
};
struct EpiDown {
    static constexpr bool PERM = true, AFTER_DRAIN = false;
    bf16_t* O; const float* bdn; const float* rowg;
    __device__ __forceinline__ void operator()(const f32x4 (&acc)[2][2][4][2], const Unit& u, int wr, int wc, int fr, int fq) const {
        const int row0 = u.pm * BM + wr * 64 + fr, col0 = u.pn * BM + wc * 32 + 8 * fq;
        const float* bb = bdn + (size_t)u.e * 2048 + col0;
        f32x4 bv[2][2];
#pragma unroll
        for (int bj = 0; bj < 2; ++bj)
#pragma unroll
            for (int n = 0; n < 2; ++n) bv[bj][n] = *(const f32x4*)(bb + bj * HALF + 4 * n);
#pragma unroll
        for (int ai = 0; ai < 2; ++ai)
#pragma unroll
            for (int m = 0; m < 4; ++m) { const int row = row0 + ai * HALF + m * 16; const float gt = rowg[row]; bf16_t* rowp = O + (size_t)row * 2048 + col0;
#pragma unroll
                for (int bj = 0; bj < 2; ++bj) { const f32x4 v0 = (acc[ai][bj][m][0] + bv[bj][0]) * gt, v1 = (acc[ai][bj][m][1] + bv[bj][1]) * gt;
                    u32x4 w; w.x = cvt_pk_bf16(v0[0], v0[1]); w.y = cvt_pk_bf16(v0[2], v0[3]); w.z = cvt_pk_bf16(v1[0], v1[1]); w.w = cvt_pk_bf16(v1[2], v1[3]);
                    *(u32x4*)(rowp + bj * HALF) = w; } }
    }
};
template <bool GATHER_> struct MoeOrderT {
    static constexpr bool GATHER = GATHER_;
    int c, nblk; const char* A; const char* Bt; size_t a_tstep, b_estep, b_tstep; const PG8_LAS int* blk_end; const int* row_tab;
    __device__ __forceinline__ bool next(int i, Unit& u) const {
#if defined(MOE_MAP) && MOE_MAP == 1
        const int L = i * 256 + c, rb = L >> 3, j = (L & 7);
#elif defined(MOE_MAP) && MOE_MAP == 2
        const int x = c & 7, jj = c >> 3, gi = i * 8 + x, rb = 8 * (gi >> 1) + (jj >> 2), j = (jj & 3) + 4 * (gi & 1);
#else
        const int x = c & 7, j = c >> 3, gi = i * 8 + x, rb = 4 * gi + (j >> 3);
#endif
        if (rb >= nblk) return false;
        int e = 0;
        for (int k = 0; k < 31; ++k) e += (rb >= blk_end[k]) ? 1 : 0;
        u.pm = rb; u.pn = j & 7; u.e = __builtin_amdgcn_readfirstlane(e); return true;
    }
    __device__ __forceinline__ const char* a_ptr(const Unit& u) const { return GATHER ? A : A + (size_t)u.pm * a_tstep; }
    __device__ __forceinline__ const char* b_ptr(const Unit& u) const { return Bt + (size_t)u.e * b_estep + (size_t)u.pn * b_tstep; }
    __device__ __forceinline__ void a_ready(const Unit&) const {}
    __device__ __forceinline__ void done(const Unit&) const {}
};
typedef MoeOrderT<false> MoeOrder;
typedef MoeOrderT<true> MoeOrderG;
template <class Epi, class Sched, bool ALIGN_EPI = false, bool SP2 = false>
__device__ __forceinline__ void gemm_phase(PG8_LAS unsigned char* lds, const Gemm g, const Sched& S, const Epi& E) {
    int tid = threadIdx.x; asm volatile("" : "+v"(tid));
    const int wid = __builtin_amdgcn_readfirstlane(tid >> 6), lane = tid & 63, wr = wid >> 2, wc = wid & 3, fr = lane & 15, fq = lane >> 4;
    const int K = g.K, nt = K / BK;
    unsigned voffA[2], voffB[2];
#pragma unroll
    for (int i = 0; i < 2; ++i) { int R, C; stage_rc(tid * 16 + i * 8192, R, C); const int Rb = Epi::PERM ? ((R & ~31) + perm32(R & 31)) : R;
        voffA[i] = (unsigned)(R * K + C) * 2u; voffB[i] = (unsigned)(Rb * K + C) * 2u; }
    unsigned gc0[2] = {0u, 0u}, gc1[2] = {0u, 0u}; int gR = 0, gC = 0;
    if constexpr (Sched::GATHER) { stage_rc(tid * 16, gR, gC); }
#define PG8_GLOAD(dst0, dst1, u) do { const int* _rt = S.row_tab + (size_t)(u).pm * BM + gR; \
        dst0[0] = (unsigned)_rt[0] * (unsigned)(K * 2) + (unsigned)(gC * 2); dst0[1] = (unsigned)_rt[64] * (unsigned)(K * 2) + (unsigned)(gC * 2); \
        dst1[0] = (unsigned)_rt[128] * (unsigned)(K * 2) + (unsigned)(gC * 2); dst1[1] = (unsigned)_rt[192] * (unsigned)(K * 2) + (unsigned)(gC * 2); } while (0)
    const size_t kstep = (size_t)(BK * 2);
    const size_t hstep = (size_t)HALF * K * 2;
    const size_t tstep = 2 * hstep;
    const unsigned ldsw = (unsigned)wid * 1024u;
    const int aoff = lds_byte(wr * 64 + fr, fq * 8), boff = lds_byte(wc * 32 + fr, fq * 8);
#define PG8_SA(b, h) (((b) * 2 + (h)) * HTB)
#define PG8_SB(b, h) ((4 + (b) * 2 + (h)) * HTB)
#define PG8_STAGE(bufoff, gbase, voff) do { _Pragma("unroll") for (int _i = 0; _i < 2; ++_i) \
        __builtin_amdgcn_global_load_lds((const unsigned*)((const char*)(gbase) + (voff)[_i]), (PG8_LAS unsigned*)(lds + (bufoff) + ldsw + _i * 8192), 16, 0, 0); } while (0)
#define PG8_LDA(dst, b, h) do { _Pragma("unroll") for (int m = 0; m < 4; ++m) _Pragma("unroll") for (int k = 0; k < 2; ++k) dst[m][k] = *(const PG8_LAS bf16x8*)(lds + PG8_SA(b, h) + aoff + m * 2048 + k * 1024); } while (0)
#define PG8_LDB(dst, b, h) do { _Pragma("unroll") for (int n = 0; n < 2; ++n) _Pragma("unroll") for (int k = 0; k < 2; ++k) dst[n][k] = *(const PG8_LAS bf16x8*)(lds + PG8_SB(b, h) + boff + n * 2048 + k * 1024); } while (0)
#define PG8_MMA(ai, bj, At, Bt) do { __builtin_amdgcn_s_setprio(1); _Pragma("unroll") for (int m = 0; m < 4; ++m) _Pragma("unroll") for (int n = 0; n < 2; ++n) _Pragma("unroll") for (int k = 0; k < 2; ++k) \
        acc[ai][bj][m][n] = __builtin_amdgcn_mfma_f32_16x16x32_bf16(Bt[n][k], At[m][k], acc[ai][bj][m][n], 0, 0, 0); __builtin_amdgcn_s_setprio(0); } while (0)
#define PG8_WAIT_V(n) asm volatile("s_waitcnt vmcnt(" #n ")" ::: "memory")
#define PG8_WAIT_L(n) asm volatile("s_waitcnt lgkmcnt(" #n ")" ::: "memory")
#define PG8_BAR __builtin_amdgcn_s_barrier()
#define PG8_SCHED __builtin_amdgcn_sched_barrier(0)
    Unit cur, nxt; int ui = 0;
    if (!S.next(0, cur)) return;
    f32x4 acc[2][2][4][2];
#pragma unroll
    for (int a = 0; a < 2; ++a)
#pragma unroll
        for (int b = 0; b < 2; ++b)
#pragma unroll
            for (int m = 0; m < 4; ++m)
#pragma unroll
                for (int n = 0; n < 2; ++n) acc[a][b][m][n] = (f32x4){0.f, 0.f, 0.f, 0.f};
    bf16x8 At[4][2], B0[2][2], B1[2][2];
    const char* cA = S.a_ptr(cur); const char* cB = S.b_ptr(cur);
    S.a_ready(cur);
    if constexpr (SP2) {
        if constexpr (Sched::GATHER) { PG8_GLOAD(gc0, gc1, cur);
        PG8_STAGE(PG8_SB(0, 0), cB, voffB); PG8_STAGE(PG8_SB(0, 1), cB + hstep, voffB); PG8_STAGE(PG8_SA(0, 0), cA, gc0); PG8_STAGE(PG8_SA(0, 1), cA, gc1);
        if (wr == 1) PG8_BAR;
        PG8_WAIT_V(2); PG8_BAR;
        PG8_STAGE(PG8_SB(1, 0), cB + kstep, voffB); PG8_STAGE(PG8_SA(1, 0), cA + kstep, gc0); PG8_STAGE(PG8_SB(1, 1), cB + hstep + kstep, voffB);
        } else {
        PG8_STAGE(PG8_SB(0, 0), cB, voffB); PG8_STAGE(PG8_SB(0, 1), cB + hstep, voffB); PG8_STAGE(PG8_SA(0, 0), cA, voffA); PG8_STAGE(PG8_SA(0, 1), cA + hstep, voffA);
        if (wr == 1) PG8_BAR;
        PG8_WAIT_V(2); PG8_BAR;
        PG8_STAGE(PG8_SB(1, 0), cB + kstep, voffB); PG8_STAGE(PG8_SA(1, 0), cA + kstep, voffA); PG8_STAGE(PG8_SB(1, 1), cB + hstep + kstep, voffB);
        }
        PG8_WAIT_V(6); PG8_BAR;
    } else {
        PG8_STAGE(PG8_SB(0, 0), cB, voffB); PG8_STAGE(PG8_SA(0, 0), cA, voffA); PG8_STAGE(PG8_SB(0, 1), cB + hstep, voffB); PG8_STAGE(PG8_SA(0, 1), cA + hstep, voffA);
        if (wr == 1) PG8_BAR;
        PG8_WAIT_V(4); PG8_BAR;
        PG8_STAGE(PG8_SB(1, 0), cB + kstep, voffB); PG8_STAGE(PG8_SA(1, 0), cA + kstep, voffA); PG8_STAGE(PG8_SB(1, 1), cB + hstep + kstep, voffB);
        PG8_WAIT_V(6); PG8_BAR;
    }
    for (;;) {
        const bool has_next = S.next(ui + 1, nxt);
        const char* nA = has_next ? S.a_ptr(nxt) : cA; const char* nB = has_next ? S.b_ptr(nxt) : cB;
        for (int t = 0; t < nt; t += 2) {
            const bool last = (t == nt - 2);
            const char* a1 = cA + (size_t)(t + 1) * kstep;
            const char* a2 = last ? nA : cA + (size_t)(t + 2) * kstep; const char* b2 = last ? nB : cB + (size_t)(t + 2) * kstep;
            const char* a3 = a2 + kstep; const char* b3 = b2 + kstep;
            if (last && has_next) S.a_ready(nxt);

            if constexpr (SP2) {
            PG8_LDB(B0, 0, 0); PG8_LDB(B1, 0, 1); PG8_SCHED; PG8_LDA(At, 0, 0); if constexpr (Sched::GATHER) PG8_STAGE(PG8_SA(1, 1), a1, gc1); else PG8_STAGE(PG8_SA(1, 1), a1 + hstep, voffA);
            if constexpr (Sched::GATHER) { if (last && has_next) PG8_GLOAD(gc0, gc1, nxt); }
            PG8_WAIT_V(8); PG8_WAIT_L(0); PG8_BAR; PG8_MMA(0, 0, At, B0); PG8_MMA(0, 1, At, B1); PG8_BAR; PG8_SCHED;
            PG8_LDA(At, 0, 1); PG8_STAGE(PG8_SB(0, 0), b2, voffB); PG8_STAGE(PG8_SB(0, 1), b2 + hstep, voffB); if constexpr (Sched::GATHER) PG8_STAGE(PG8_SA(0, 0), a2, gc0); else PG8_STAGE(PG8_SA(0, 0), a2, voffA);
            PG8_WAIT_V(8); PG8_WAIT_L(0); PG8_BAR; PG8_MMA(1, 0, At, B0); PG8_MMA(1, 1, At, B1); PG8_BAR; PG8_SCHED;
            PG8_LDB(B0, 1, 0); PG8_LDB(B1, 1, 1); PG8_SCHED; PG8_LDA(At, 1, 0); if constexpr (Sched::GATHER) PG8_STAGE(PG8_SA(0, 1), a2, gc1); else PG8_STAGE(PG8_SA(0, 1), a2 + hstep, voffA);
            PG8_WAIT_V(8); PG8_WAIT_L(0); PG8_BAR; PG8_MMA(0, 0, At, B0); PG8_MMA(0, 1, At, B1); PG8_BAR; PG8_SCHED;
            PG8_LDA(At, 1, 1); PG8_STAGE(PG8_SB(1, 0), b3, voffB); PG8_STAGE(PG8_SB(1, 1), b3 + hstep, voffB); if constexpr (Sched::GATHER) PG8_STAGE(PG8_SA(1, 0), a3, gc0); else PG8_STAGE(PG8_SA(1, 0), a3, voffA);
            PG8_WAIT_V(8); PG8_WAIT_L(0); PG8_BAR; PG8_MMA(1, 0, At, B0); PG8_MMA(1, 1, At, B1); PG8_BAR; PG8_SCHED;
            } else {
            PG8_LDB(B0, 0, 0); PG8_SCHED; PG8_LDA(At, 0, 0); PG8_STAGE(PG8_SA(1, 1), a1 + hstep, voffA);
            PG8_WAIT_L(8); PG8_BAR; PG8_WAIT_L(0); PG8_MMA(0, 0, At, B0); PG8_BAR; PG8_SCHED;
            PG8_LDB(B1, 0, 1); PG8_STAGE(PG8_SB(0, 0), b2, voffB);
            PG8_BAR; PG8_WAIT_L(0); PG8_MMA(0, 1, At, B1); PG8_BAR;
            PG8_LDA(At, 0, 1); PG8_STAGE(PG8_SA(0, 0), a2, voffA);
            PG8_BAR; PG8_WAIT_L(0); PG8_MMA(1, 0, At, B0); PG8_BAR; PG8_SCHED;
            PG8_STAGE(PG8_SB(0, 1), b2 + hstep, voffB);
            PG8_WAIT_V(6); PG8_BAR; PG8_MMA(1, 1, At, B1); PG8_BAR;
            PG8_LDB(B0, 1, 0); PG8_SCHED; PG8_LDA(At, 1, 0); PG8_STAGE(PG8_SA(0, 1), a2 + hstep, voffA);
            PG8_WAIT_L(8); PG8_BAR; PG8_WAIT_L(0); PG8_MMA(0, 0, At, B0); PG8_BAR; PG8_SCHED;
            PG8_LDB(B1, 1, 1); PG8_STAGE(PG8_SB(1, 0), b3, voffB);
            PG8_BAR; PG8_WAIT_L(0); PG8_MMA(0, 1, At, B1); PG8_BAR;
            PG8_LDA(At, 1, 1); PG8_STAGE(PG8_SA(1, 0), a3, voffA);
            PG8_BAR; PG8_WAIT_L(0); PG8_MMA(1, 0, At, B0); PG8_BAR; PG8_SCHED;
            PG8_STAGE(PG8_SB(1, 1), b3 + hstep, voffB);
            PG8_WAIT_V(6); PG8_BAR; PG8_MMA(1, 1, At, B1); PG8_BAR;
            }
        }
        if constexpr (ALIGN_EPI) { if (wr == 0) PG8_BAR; }
        if constexpr (!Epi::AFTER_DRAIN) { int fr_e = fr, fq_e = fq; asm volatile("" : "+v"(fr_e), "+v"(fq_e));
            E(acc, cur, wr, wc, fr_e, fq_e); S.done(cur); }
        if (!has_next) break;
#pragma unroll
        for (int a = 0; a < 2; ++a)
#pragma unroll
            for (int b = 0; b < 2; ++b)
#pragma unroll
                for (int m = 0; m < 4; ++m)
#pragma unroll
                    for (int n = 0; n < 2; ++n) acc[a][b][m][n] = (f32x4){0.f, 0.f, 0.f, 0.f};
        cur = nxt; cA = nA; cB = nB; ++ui;
        if constexpr (ALIGN_EPI) { if (wr == 1) PG8_BAR; }
    }
    PG8_WAIT_V(0);
    if constexpr (!ALIGN_EPI) { if (wr == 0) PG8_BAR; }
    PG8_BAR;
    if constexpr (Epi::AFTER_DRAIN) { E.fused(acc, cur, wr, wc, fr, fq, lds, wid, lane); S.done(cur); }
#undef PG8_GLOAD
#undef PG8_SA
#undef PG8_SB
#undef PG8_STAGE
#undef PG8_LDA
#undef PG8_LDB
#undef PG8_MMA
#undef PG8_WAIT_V
#undef PG8_WAIT_L
#undef PG8_BAR
#undef PG8_SCHED
}
}

constexpr size_t MiB = 1u << 20;
constexpr size_t WS_CTL = 0, CTL_ZERO_BYTES = 1 * MiB;
constexpr size_t WS_MOD  = 1 * MiB;
constexpr size_t WS_WRT  = 2 * MiB;
constexpr size_t WS_MOEI = 3 * MiB;
constexpr size_t WS_LRC  = 6 * MiB;
constexpr size_t WS_DNS  = 12 * MiB;
constexpr size_t WS_WIN  = 16 * MiB;
constexpr size_t WS_WOUT = 56 * MiB;
constexpr size_t WS_WGU  = 72 * MiB;
constexpr size_t WS_WDN  = 584 * MiB;
constexpr size_t WS_X    = 840 * MiB;
constexpr size_t WS_H    = 976 * MiB;
constexpr size_t WS_P    = 1044 * MiB;
constexpr size_t WS_CC   = 1206 * MiB;
constexpr size_t WS_VT   = 1274 * MiB;
constexpr size_t WS_VTC  = WS_VT + 8 * MiB;
constexpr size_t WS_DNT  = 1284 * MiB;
constexpr size_t DNT_BYTES = 90112;
constexpr size_t WS_DNO  = 1472 * MiB;
constexpr size_t WS_LRH  = 1540 * MiB;
constexpr size_t WS_LRA  = 1608 * MiB;
constexpr size_t WS_XS   = 1676 * MiB;
constexpr size_t WS_ACT  = 1980 * MiB;
constexpr size_t WS_YS   = 2132 * MiB;
constexpr size_t WS_END  = 2436 * MiB;
constexpr int CW_TMO = 0;
constexpr int CW_BAR = 4096;
constexpr int CW_CNT = 8192;
constexpr int CW_ATQ = 12288;

constexpr int RING_OFF = 0, RING_BYTES = 131072;
constexpr int LDSCTL_OFF = RING_BYTES, MISC_OFF = LDSCTL_OFF + 320;
constexpr int LDS_X_OFF = RING_BYTES + 1024;
constexpr int LDS_BYTES = 147456;
constexpr int NWAVES = 8, NTHREADS = 512;

#define GAS __attribute__((address_space(1)))
#define LAS __attribute__((address_space(3)))
typedef unsigned short bf16;
typedef unsigned v4u __attribute__((ext_vector_type(4)));
typedef unsigned v2u __attribute__((ext_vector_type(2)));
typedef float f32x4 __attribute__((ext_vector_type(4)));
typedef float f32x16 __attribute__((ext_vector_type(16)));
typedef short bf16x8 __attribute__((ext_vector_type(8)));
typedef short bf16x4 __attribute__((ext_vector_type(4)));
typedef GAS unsigned gu32;
#define RLX_AGENT __ATOMIC_RELAXED, __HIP_MEMORY_SCOPE_AGENT
#define LDS_WAIT() asm volatile("s_waitcnt lgkmcnt(0)" ::: "memory")
#define VM_WAIT() asm volatile("s_waitcnt vmcnt(0)" ::: "memory")
typedef __bf16 bf16x2_t __attribute__((ext_vector_type(2)));
typedef float f32x2_t __attribute__((ext_vector_type(2)));
__device__ __forceinline__ unsigned pk2(float lo, float hi) { const f32x2_t v = {lo, hi}; const bf16x2_t b = __builtin_convertvector(v, bf16x2_t); return __builtin_bit_cast(unsigned, b); }
__device__ __forceinline__ unsigned f2bf(float f) { return pk2(f, 0.f) & 0xffffu; }
__device__ __forceinline__ float bf2f(unsigned short b) { return __builtin_bit_cast(float, (unsigned)b << 16); }
__device__ __forceinline__ float bflo(unsigned w) { return __builtin_bit_cast(float, w << 16); }
__device__ __forceinline__ float bfhi(unsigned w) { return __builtin_bit_cast(float, w & 0xffff0000u); }
template <int CTRL> __device__ __forceinline__ float dpp_mov(float v) { return __builtin_bit_cast(float, __builtin_amdgcn_update_dpp(0, __builtin_bit_cast(int, v), CTRL, 0xF, 0xF, false)); }
__device__ __forceinline__ float wave_sum(float v) {
    v += dpp_mov<0xB1>(v); v += dpp_mov<0x4E>(v); v += dpp_mov<0x141>(v); v += dpp_mov<0x140>(v);
    const int iv = __builtin_bit_cast(int, v);
    const float r0 = __builtin_bit_cast(float, __builtin_amdgcn_readlane(iv, 0)), r1 = __builtin_bit_cast(float, __builtin_amdgcn_readlane(iv, 16)), r2 = __builtin_bit_cast(float, __builtin_amdgcn_readlane(iv, 32)), r3 = __builtin_bit_cast(float, __builtin_amdgcn_readlane(iv, 48));
    return (r0 + r1) + (r2 + r3);
}
__device__ __forceinline__ float sigmoidf_(float x) { return __builtin_amdgcn_rcpf(1.0f + __builtin_amdgcn_exp2f(-1.4426950408889634f * x)); }
__device__ __forceinline__ float siluf_(float x) { return x * sigmoidf_(x); }
__device__ __forceinline__ float softplusf_(float x) { return x > 20.f ? x : log1pf(__expf(x)); }

#define XB_TMO      128
#define XB_XCNT(j)  (256  + 64 * (j))
#define XB_XSUB(j)  (1280 + 64 * (j))
#define XB_XGEN(j)  (2304 + 64 * (j))
#define XB_TOP      3328
#define XB_TOPGEN   3392
#define XCD_BAR_WORDS 3456
#define XB_SPIN_CAP (1u << 18)

__device__ __forceinline__ unsigned xb_ld(unsigned* p)              { return __hip_atomic_load(p, __ATOMIC_RELAXED, __HIP_MEMORY_SCOPE_AGENT); }
__device__ __forceinline__ unsigned xb_add(unsigned* p, unsigned v) { return __hip_atomic_fetch_add(p, v, __ATOMIC_RELAXED, __HIP_MEMORY_SCOPE_AGENT); }
__device__ __forceinline__ unsigned xb_xcc_id() { return (unsigned)__builtin_amdgcn_s_getreg((3 << 11) | 20) & 0xFu; }
#define XB_SPIN(cond, bar) do { unsigned _sp = 0; while (cond) { __builtin_amdgcn_s_sleep(1); \
    if ((++_sp & 255u) == 0u) { if (xb_ld(&(bar)[XB_TMO])) break; if (_sp > XB_SPIN_CAP) { atomicAdd(&(bar)[XB_TMO], 1u); break; } } } } while (0)

struct XcdBarrier {
    unsigned* bar; unsigned x;
    volatile LAS unsigned* st;
};

__device__ __forceinline__ XcdBarrier xcd_barrier_post(unsigned* bar, volatile LAS unsigned* st) {
    XcdBarrier b; b.bar = bar; b.x = xb_xcc_id(); b.st = st;
    if (threadIdx.x == 0) (void)xb_add(&bar[XB_XCNT(b.x)], 1u);
    return b;
}
__device__ __forceinline__ void xcd_barrier_complete(unsigned* bar, unsigned x, unsigned& nloc, unsigned& nx) {
    const unsigned G = gridDim.x * gridDim.y * gridDim.z;
    unsigned sum, cnt, mine, sp = 0u;
    for (;;) {
        sum = 0u; cnt = 0u; mine = 0u;
#pragma unroll
        for (unsigned j = 0; j < 16; ++j) { const unsigned c = xb_ld(&bar[XB_XCNT(j)]); sum += c; cnt += (c > 0u) ? 1u : 0u; mine = (j == x) ? c : mine; }
        if (sum == G) break;
        __builtin_amdgcn_s_sleep(1);
        if ((++sp & 255u) == 0u) { if (xb_ld(&bar[XB_TMO])) break; if (sp > XB_SPIN_CAP) { atomicAdd(&bar[XB_TMO], 1u); break; } }
    }
    nloc = mine > 0u ? mine : 1u; nx = cnt > 0u ? cnt : 1u;
}

__device__ __forceinline__ void xcd_barrier(const XcdBarrier& b) {
    asm volatile("s_waitcnt vmcnt(0)" ::: "memory");
    __syncthreads();
    if (threadIdx.x == 0) {
        unsigned* bar = b.bar;
        __builtin_amdgcn_s_waitcnt(0);
        unsigned nloc = b.st[0], nx = b.st[1];
        if (nloc == 0u) { xcd_barrier_complete(bar, b.x, nloc, nx); b.st[0] = nloc; b.st[1] = nx; }
        const unsigned old = xb_add(&bar[XB_XSUB(b.x)], 1u);
        const unsigned gen = old / nloc;
        if (old + 1u == (gen + 1u) * nloc) {
            __builtin_amdgcn_fence(__ATOMIC_RELEASE, "agent");
            asm volatile("s_waitcnt vmcnt(0)" ::: "memory");
            const unsigned og = xb_add(&bar[XB_TOP], 1u);
            const unsigned tg = og / nx;
            if (og + 1u == (tg + 1u) * nx) xb_add(&bar[XB_TOPGEN], 1u);
            else XB_SPIN(xb_ld(&bar[XB_TOPGEN]) == tg, bar);
            __builtin_amdgcn_fence(__ATOMIC_ACQUIRE, "agent");
            xb_add(&bar[XB_XGEN(b.x)], 1u);
            asm volatile("s_waitcnt vmcnt(0)" ::: "memory");
        } else {
            XB_SPIN(xb_ld(&bar[XB_XGEN(b.x)]) == gen, bar);
            __builtin_amdgcn_fence(__ATOMIC_ACQUIRE, "agent");
            asm volatile("s_waitcnt vmcnt(0)" ::: "memory");
        }
    }
    __syncthreads();
}

enum InIdx { I_X = 0, I_C, I_CTX, I_CCTX, I_WMOD, I_BMOD, I_NMG, I_NFG, I_WIN, I_WOUT, I_SINK, I_DNCW, I_DNALOG, I_DNDT, I_DNNG, I_LRCW, I_LRCB, I_LRWR, I_LRBR, I_LRWI, I_LRBI, I_LRLAM,
             I_WROUT, I_BROUT, I_WGU, I_BGU, I_WDN, I_BDN, I_FNG, N_IN };
struct Frame {
    LAS unsigned char* lds;
    volatile LAS unsigned* MISC;
    gu32* ctl;
    int tid, lane, wave, G, bid;
    const float* const __attribute__((address_space(4)))* in;
    float* out; unsigned char* ws;
};
__device__ __forceinline__ int mod_row(int m) { return m < NLAT ? (m >> 12) : 4; }
__device__ __forceinline__ bool phase_enter(Frame& F) { int t = threadIdx.x; asm volatile("" : "+v"(t)); F.tid = t; F.lane = t & 63; F.wave = __builtin_amdgcn_readfirstlane(t >> 6); return true; }
__device__ __forceinline__ void seq_of(int m, int& t, int& T, int& base) { if (m < NLAT) { t = m & 4095; T = SEQ; base = m - t; } else { t = (m - NLAT) & 255; T = CTXL; base = m - t; } }
__device__ __forceinline__ float gelu_tanh(float x) { const float u = 0.7978845608028654f * (x + 0.044715f * x * x * x); return x * sigmoidf_(2.0f * u); }

__device__ __forceinline__ void transpose_item(const float* W, int K, int N, bf16* WT, int k0, int dstrow0, int srccol0, int nvalid, LAS float* scr, int lane) {
    { const int c4 = (lane & 7) * 4, kr = lane >> 3; f32x4 v[8];
#pragma unroll
      for (int i = 0; i < 8; ++i) { v[i] = (f32x4){0.f, 0.f, 0.f, 0.f}; if (c4 < nvalid) v[i] = *(const f32x4*)(W + (size_t)(k0 + 8 * i + kr) * N + srccol0 + c4); }
#pragma unroll
      for (int i = 0; i < 8; ++i) { LAS float* d = scr + (8 * i + kr) * 33 + c4; d[0] = v[i].x; d[1] = v[i].y; d[2] = v[i].z; d[3] = v[i].w; } }
    LDS_WAIT(); asm volatile("" ::: "memory");
    const int c = lane & 7;
#pragma unroll
    for (int jj = 0; jj < 4; ++jj) { const int n = (lane >> 3) + 8 * jj; const LAS float* s = scr + (8 * c) * 33 + n;
        v4u o; o.x = pk2(s[0 * 33], s[1 * 33]); o.y = pk2(s[2 * 33], s[3 * 33]); o.z = pk2(s[4 * 33], s[5 * 33]); o.w = pk2(s[6 * 33], s[7 * 33]);
        *(GAS v4u*)(WT + (size_t)(dstrow0 + n) * K + k0 + 8 * c) = o; }
    LDS_WAIT(); asm volatile("" ::: "memory");
}
__device__ __forceinline__ void p0_prologue(Frame& F) {
    {
        LAS float* sc = (LAS float*)(F.lds);
        LAS float* red = (LAS float*)(F.lds + 40960);
        bool have_sc = false;
        for (int wb = F.bid; wb < 192; wb += F.G) {
            if (!have_sc) {
                for (int i = F.tid; i < 5 * 2048; i += NTHREADS) { const int r = i >> 11, k = i & 2047; const float cv = r < 4 ? F.in[I_C][r * 2048 + k] : F.in[I_CCTX][k]; sc[i] = siluf_(cv); }
                have_sc = true; __syncthreads();
            }
            const int l = wb / 96, cb = wb % 96, kp = F.tid >> 5, cg = F.tid & 31, j0 = cb * 128 + cg * 4;
            const float* wp = F.in[I_WMOD] + ((size_t)l * 2048 + kp * 128) * 12288 + j0;
            f32x4 acc[5];
#pragma unroll
            for (int r = 0; r < 5; ++r) acc[r] = (f32x4){0.f, 0.f, 0.f, 0.f};
#pragma unroll 4
            for (int k = 0; k < 128; ++k) { const f32x4 w = *(const f32x4*)(wp + (size_t)k * 12288);
#pragma unroll
                for (int r = 0; r < 5; ++r) acc[r] += sc[r * 2048 + kp * 128 + k] * w; }
#pragma unroll
            for (int r = 0; r < 5; ++r) *(LAS f32x4*)(red + (kp * 5 + r) * 128 + cg * 4) = acc[r];
            __syncthreads();
            for (int i = F.tid; i < 640; i += NTHREADS) { const int r = i >> 7, col = i & 127; float s = F.in[I_BMOD][l * 12288 + cb * 128 + col];
#pragma unroll
                for (int q = 0; q < 16; ++q) s += red[(q * 5 + r) * 128 + col];
                ((float*)(F.ws + WS_MOD))[(size_t)(l * 5 + r) * 12288 + cb * 128 + col] = s; }
            __syncthreads();
        }
        __syncthreads();
    }
    {
        LAS float* scr = (LAS float*)(F.lds + F.wave * 16384);
        const int gw = F.bid * NWAVES + F.wave, NGW = F.G * NWAVES;
        constexpr int I_IN = 32 * 144, I_OUT = 32 * 64, I_RT = 32, I_16 = 32, PER_L = I_IN + I_OUT + I_RT + I_16;
        for (int it0 = gw; it0 < 2 * PER_L; it0 += NGW) {
            const int l = it0 / PER_L; int r = it0 % PER_L;
            if (r < I_IN) { const int nb = r % 144, kb = r / 144, d0 = nb * 32; int s0 = d0, nv = 32;
                if (d0 >= 3584) s0 = d0 + 16;
                transpose_item(F.in[I_WIN] + (size_t)l * 2048 * IN_W, 2048, IN_W, (bf16*)(F.ws + WS_WIN) + (size_t)l * PW * 2048, kb * 64, d0, s0, nv, scr, F.lane); continue; }
            r -= I_IN;
            if (r < I_OUT) { const int nb = r % 64, kb = r / 64;
                transpose_item(F.in[I_WOUT] + (size_t)l * 2048 * 2048, 2048, 2048, (bf16*)(F.ws + WS_WOUT) + (size_t)l * 2048 * 2048, kb * 64, nb * 32, nb * 32, 32, scr, F.lane); continue; }
            r -= I_OUT;
            if (r < I_RT) { transpose_item(F.in[I_WROUT] + (size_t)l * 2048 * 32, 2048, 32, (bf16*)(F.ws + WS_WRT) + (size_t)l * 32 * 2048, r * 64, 0, 0, 32, scr, F.lane); continue; }
            r -= I_RT;
            transpose_item(F.in[I_WIN] + (size_t)l * 2048 * IN_W, 2048, IN_W, (bf16*)(F.ws + WS_WRT + 512 * 1024) + (size_t)l * 32 * 2048, r * 64, 0, 3584, 16, scr, F.lane);
        }
    }
}
constexpr int CW_CVQ = 12288 + 512;
__device__ __forceinline__ void convert_moe_item(Frame& F, int l, int r, LAS float* scr) {
    constexpr int I_GU = 32 * 32 * 64;
    if (r < I_GU) { const int e = r / 2048, q = r % 2048, nb = q % 64, kb = q / 64; const int s0 = ((nb >> 2) & 1) * 1024 + (nb >> 3) * 128 + (nb & 3) * 32;
        transpose_item(F.in[I_WGU] + (size_t)(l * 32 + e) * 2048 * 2048, 2048, 2048, (bf16*)(F.ws + WS_WGU) + (size_t)(l * 32 + e) * 2048 * 2048, kb * 64, nb * 32, s0, 32, scr, F.lane); return; }
    r -= I_GU;
    { const int e = r / 1024, q = r % 1024, nb = q % 64, kb = q / 64;
        transpose_item(F.in[I_WDN] + (size_t)(l * 32 + e) * 1024 * 2048, 1024, 2048, (bf16*)(F.ws + WS_WDN) + (size_t)(l * 32 + e) * 2048 * 1024, kb * 64, nb * 32, nb * 32, 32, scr, F.lane); }
}
constexpr int CVG = 8;
__device__ __forceinline__ bool convert_grab(Frame& F, int l, int rep, LAS float* scr) {
    constexpr int NIT = 32 * 32 * 64 + 32 * 16 * 64;
    int g = 0; if (F.lane == 0) g = (int)__hip_atomic_fetch_add(F.ctl + CW_CVQ + 64 * l + 8 * rep, 1u, RLX_AGENT); g = __builtin_amdgcn_readfirstlane(g);
    if (g * CVG >= NIT) return false;
#pragma unroll 1
    for (int k = 0; k < CVG; ++k) convert_moe_item(F, l, g * CVG + k, scr);
    return true;
}
__device__ __forceinline__ void convert_moe_queue(Frame& F, int l, int rep = 0) {
    LAS float* scr = (LAS float*)(F.lds + F.wave * 16384);
    __syncthreads();
    while (convert_grab(F, l, rep, scr)) {}
    __syncthreads();
}
constexpr int CW_TAIL = 16384;
__device__ __forceinline__ void tail_fill(Frame& F, int seam, int lt) {
    LAS int* flag = (LAS int*)(F.lds + LDS_X_OFF + 768);
    LAS float* scr = (LAS float*)(F.lds + F.wave * 16384);
    __syncthreads();
    if (F.tid == 0) (void)__hip_atomic_fetch_add(F.ctl + CW_TAIL + 64 * seam, 1u, RLX_AGENT);
    bool more = true;
    for (int it = 0; it < 4096; ++it) {
        if (F.tid == 0) *flag = (__hip_atomic_load(F.ctl + CW_TAIL + 64 * seam, RLX_AGENT) >= (unsigned)F.G) ? 1 : 0;
        __syncthreads();
        const int done = *flag;
        __syncthreads();
        if (done) break;
        if (more) more = convert_grab(F, lt, 0, scr); else __builtin_amdgcn_s_sleep(32);
    }
}

__device__ __forceinline__ void load_row(const float* src, int lane, f32x4 (&v)[8]) {
    const f32x4* p = (const f32x4*)src + lane;
#pragma unroll
    for (int j = 0; j < 8; ++j) v[j] = p[64 * j];
}
__device__ __forceinline__ void store_row(float* dst, int lane, const f32x4 (&v)[8]) {
    f32x4* p = (f32x4*)dst + lane;
#pragma unroll
    for (int j = 0; j < 8; ++j) p[64 * j] = v[j];
}
__device__ __forceinline__ void combine_row(Frame& F, int l, int m, int lane, f32x4 (&v)[8]) {
    const int* dest = (const int*)(F.ws + WS_MOEI + 2 * 512 * 1024) + m * 4;
    const float* g5 = (const float*)(F.ws + WS_MOD) + (size_t)(l * 5 + mod_row(m)) * 12288 + 5 * 2048;
    f32x4 acc[8];
#pragma unroll
    for (int j = 0; j < 8; ++j) acc[j] = (f32x4){0.f, 0.f, 0.f, 0.f};
#pragma unroll
    for (int k = 0; k < 4; ++k) { const int d = dest[k]; const v2u* yp = (const v2u*)((const bf16*)(F.ws + WS_YS) + (size_t)d * 2048) + lane;
#pragma unroll
        for (int j = 0; j < 8; ++j) { const v2u w = yp[64 * j]; acc[j] += (f32x4){bflo(w.x), bfhi(w.x), bflo(w.y), bfhi(w.y)}; } }
#pragma unroll
    for (int j = 0; j < 8; ++j) { const f32x4 gg = *((const f32x4*)g5 + lane + 64 * j); v[j] += gg * acc[j]; }
}
__device__ __forceinline__ void modnorm_store(const f32x4 (&v)[8], const float* g, const float* shift, const float* scale, bf16* hrow, int lane) {
    float ss = 0.f;
#pragma unroll
    for (int j = 0; j < 8; ++j) ss += (v[j].x * v[j].x + v[j].y * v[j].y) + (v[j].z * v[j].z + v[j].w * v[j].w);
    const float rstd = 1.0f / sqrtf(wave_sum(ss) * (1.0f / 2048.0f) + EPS);
    v2u* hp = (v2u*)hrow + lane;
#pragma unroll
    for (int j = 0; j < 8; ++j) { const f32x4 gg = *((const f32x4*)g + lane + 64 * j), sh = *((const f32x4*)shift + lane + 64 * j), sc = *((const f32x4*)scale + lane + 64 * j);
        const f32x4 y = (v[j] * rstd) * gg * (sc + 1.0f) + sh; v2u w; w.x = pk2(y.x, y.y); w.y = pk2(y.z, y.w); hp[64 * j] = w; }
}
constexpr size_t WS_W16 = WS_WRT + 512 * 1024;
__device__ __forceinline__ void phase_norm1(Frame& F, int l) {
    constexpr int TROW = 4112;
    LAS unsigned char* tile = F.lds; LAS float* part = (LAS float*)(F.lds + 66048);
    float* X = (float*)(F.ws + WS_X); bf16* H = (bf16*)(F.ws + WS_H); bf16* P = (bf16*)(F.ws + WS_P);
    const float* modp = (const float*)(F.ws + WS_MOD) + (size_t)l * 5 * 12288;
    const bf16* w16 = (const bf16*)(F.ws + WS_W16) + (size_t)l * 32 * 2048;
    for (int r0 = F.bid * 16; r0 < NTOK; r0 += F.G * 16) {
#pragma unroll 1
        for (int rr = 0; rr < 2; ++rr) { const int lr = 2 * F.wave + rr, m = r0 + lr;
            f32x4 v[8];
            if (l == 0) load_row(m < NLAT ? F.in[I_X] + (size_t)m * DM : F.in[I_CTX] + (size_t)(m - NLAT) * DM, F.lane, v);
            else { load_row(X + (size_t)m * DM, F.lane, v); if (MK_STAGE >= 9) { combine_row(F, l - 1, m, F.lane, v); store_row(X + (size_t)m * DM, F.lane, v); } }
            float ss = 0.f;
#pragma unroll
            for (int j = 0; j < 8; ++j) ss += (v[j].x * v[j].x + v[j].y * v[j].y) + (v[j].z * v[j].z + v[j].w * v[j].w);
            const float rstd = 1.0f / sqrtf(wave_sum(ss) * (1.0f / 2048.0f) + EPS);
            const float* mr = modp + (size_t)mod_row(m) * 12288; const float* g = F.in[I_NMG] + l * DM;
            v2u* hp = (v2u*)(H + (size_t)m * DM) + F.lane; LAS v2u* tp = (LAS v2u*)(tile + lr * TROW) + F.lane;
#pragma unroll
            for (int j = 0; j < 8; ++j) { const f32x4 gg = *((const f32x4*)g + F.lane + 64 * j), sh = *((const f32x4*)mr + F.lane + 64 * j), sc = *((const f32x4*)(mr + 2048) + F.lane + 64 * j);
                const f32x4 y = (v[j] * rstd) * gg * (sc + 1.0f) + sh; v2u w; w.x = pk2(y.x, y.y); w.y = pk2(y.z, y.w); hp[64 * j] = w; tp[64 * j] = w; }
        }
        __syncthreads();
        { const int row = F.lane & 15, q = F.lane >> 4; f32x4 acc = {0.f, 0.f, 0.f, 0.f};
#pragma unroll
          for (int ks = 0; ks < 8; ++ks) { const int k0 = 256 * F.wave + 32 * ks + 8 * q;
              const bf16x8 a = *(const LAS bf16x8*)(tile + row * TROW + k0 * 2); const bf16x8 b = *(const bf16x8*)(w16 + (size_t)row * 2048 + k0);
              acc = __builtin_amdgcn_mfma_f32_16x16x32_bf16(a, b, acc, 0, 0, 0); }
#pragma unroll
          for (int i = 0; i < 4; ++i) part[(F.wave * 16 + 4 * q + i) * 16 + row] = acc[i]; }
        __syncthreads();
        if (F.tid < 256) { const int rw = F.tid >> 4, c = F.tid & 15; float sacc = 0.f;
#pragma unroll
            for (int w = 0; w < 8; ++w) sacc += part[(w * 16 + rw) * 16 + c];
            P[(size_t)(r0 + rw) * PW + PC_BETA + c] = (bf16)f2bf(sacc); }
        __syncthreads();
    }
}
__device__ __forceinline__ void phase_final(Frame& F, bool with_combine) {
    const int gw = F.bid * NWAVES + F.wave, NGW = F.G * NWAVES;
    const float* X = (const float*)(F.ws + WS_X);
    for (int m = gw; m < NLAT; m += NGW) {
        f32x4 v[8];
        if (with_combine) { load_row(X + (size_t)m * DM, F.lane, v); combine_row(F, 1, m, F.lane, v); }
        else load_row(F.in[I_X] + (size_t)m * DM, F.lane, v);
        float ss = 0.f;
#pragma unroll
        for (int j = 0; j < 8; ++j) ss += (v[j].x * v[j].x + v[j].y * v[j].y) + (v[j].z * v[j].z + v[j].w * v[j].w);
        const float rstd = 1.0f / sqrtf(wave_sum(ss) * (1.0f / 2048.0f) + EPS);
        f32x4* op = (f32x4*)(F.out + (size_t)m * DM) + F.lane;
#pragma unroll
        for (int j = 0; j < 8; ++j) { const f32x4 gg = *((const f32x4*)F.in[I_FNG] + F.lane + 64 * j); op[64 * j] = v[j] * rstd * gg; }
    }
}

__device__ __forceinline__ void phase_inproj(Frame& F, int l) {
    pg8::Gemm g{(const bf16*)(F.ws + WS_H), (const bf16*)(F.ws + WS_WIN) + (size_t)l * PW * 2048, NTOK, 4608, 2048};
    pg8::StaticOrder S; S.init(g, F.G, F.bid);
    pg8::EpiBf16Plain E{(bf16*)(F.ws + WS_P), PW};
    pg8::gemm_phase<pg8::EpiBf16Plain, pg8::StaticOrder, true, true>(F.lds + RING_OFF, g, S, E);
}
__device__ __forceinline__ void phase_outproj(Frame& F, int l) {
    float* X = (float*)(F.ws + WS_X);
    pg8::Gemm g{(const bf16*)(F.ws + WS_CC), (const bf16*)(F.ws + WS_WOUT) + (size_t)l * 2048 * 2048, l == 0 ? NTOK : NLAT, 2048, 2048};
    pg8::StaticOrder S; S.init(g, F.G, F.bid);
    pg8::EpiResGate E{l == 0 ? F.in[I_X] : X, l == 0 ? F.in[I_CTX] : X + (size_t)NLAT * DM, X, (const float*)(F.ws + WS_MOD) + (size_t)l * 5 * 12288 + 2 * 2048};
    pg8::gemm_phase<pg8::EpiResGate, pg8::StaticOrder, true, true>(F.lds + RING_OFF, g, S, E);
}
#ifndef PHASE_INPROJ
#define PHASE_INPROJ(F, l) phase_inproj(F, l)
#endif
#ifndef PHASE_OUTPROJ
#define PHASE_OUTPROJ(F, l) phase_outproj(F, l)
#endif

constexpr size_t MOEI_TOPE = WS_MOEI, MOEI_TOPG = WS_MOEI + 512 * 1024, MOEI_DEST = WS_MOEI + 2 * 512 * 1024, MOEI_ROWG = WS_MOEI + 3 * 512 * 1024, MOEI_ROWT = WS_MOEI + 4 * 512 * 1024;
__device__ __forceinline__ void phase_norm2(Frame& F, int l) {
    const int nrows = (l == 0) ? NTOK : NLAT;
    constexpr int TROW = 4112;
    LAS unsigned char* tile = F.lds;
    LAS float* part = (LAS float*)(F.lds + 66048);
    LAS float* lg = (LAS float*)(F.lds + 66048 + 16384);
    const float* X = (const float*)(F.ws + WS_X); bf16* H = (bf16*)(F.ws + WS_H);
    const float* modp = (const float*)(F.ws + WS_MOD) + (size_t)l * 5 * 12288;
    const bf16* wrt = (const bf16*)(F.ws + WS_WRT) + (size_t)l * 32 * 2048;
    int* tope = (int*)(F.ws + MOEI_TOPE); float* topg = (float*)(F.ws + MOEI_TOPG);
    for (int r0 = F.bid * 16; r0 < nrows; r0 += F.G * 16) {
#pragma unroll 1
        for (int rr = 0; rr < 2; ++rr) {
            const int lr = 2 * F.wave + rr, m = r0 + lr;
            f32x4 v[8]; load_row(X + (size_t)m * DM, F.lane, v);
            float ss = 0.f;
#pragma unroll
            for (int j = 0; j < 8; ++j) ss += (v[j].x * v[j].x + v[j].y * v[j].y) + (v[j].z * v[j].z + v[j].w * v[j].w);
            const float rstd = 1.0f / sqrtf(wave_sum(ss) * (1.0f / 2048.0f) + EPS);
            const float* mr = modp + (size_t)mod_row(m) * 12288; const float* g = F.in[I_NFG] + l * DM;
            v2u* hp = (v2u*)(H + (size_t)m * DM) + F.lane; LAS v2u* tp = (LAS v2u*)(tile + lr * TROW) + F.lane;
#pragma unroll
            for (int j = 0; j < 8; ++j) { const f32x4 gg = *((const f32x4*)g + F.lane + 64 * j), sh = *((const f32x4*)(mr + 3 * 2048) + F.lane + 64 * j), sc = *((const f32x4*)(mr + 4 * 2048) + F.lane + 64 * j);
                const f32x4 y = (v[j] * rstd) * gg * (sc + 1.0f) + sh; v2u w; w.x = pk2(y.x, y.y); w.y = pk2(y.z, y.w); hp[64 * j] = w; tp[64 * j] = w; }
        }
        __syncthreads();
        {
            const int row = F.lane & 15, q = F.lane >> 4;
            f32x4 acc0 = {0.f, 0.f, 0.f, 0.f}, acc1 = {0.f, 0.f, 0.f, 0.f};
#pragma unroll
            for (int ks = 0; ks < 8; ++ks) { const int k0 = 256 * F.wave + 32 * ks + 8 * q;
                const bf16x8 a = *(const LAS bf16x8*)(tile + row * TROW + k0 * 2);
                const bf16x8 b0 = *(const bf16x8*)(wrt + (size_t)row * 2048 + k0), b1 = *(const bf16x8*)(wrt + (size_t)(16 + row) * 2048 + k0);
                acc0 = __builtin_amdgcn_mfma_f32_16x16x32_bf16(a, b0, acc0, 0, 0, 0); acc1 = __builtin_amdgcn_mfma_f32_16x16x32_bf16(a, b1, acc1, 0, 0, 0); }
#pragma unroll
            for (int i = 0; i < 4; ++i) { part[(F.wave * 16 + 4 * q + i) * 32 + row] = acc0[i]; part[(F.wave * 16 + 4 * q + i) * 32 + 16 + row] = acc1[i]; }
        }
        __syncthreads();
        { const int rw = F.tid >> 5, e = F.tid & 31; float s = F.in[I_BROUT][l * 32 + e];
#pragma unroll
          for (int w = 0; w < 8; ++w) s += part[(w * 16 + rw) * 32 + e];
          lg[rw * 32 + e] = s; }
        __syncthreads();
        if (F.tid < 16) { const int m = r0 + F.tid; float val[4]; int idx[4]; unsigned taken = 0u;
#pragma unroll
            for (int k = 0; k < 4; ++k) { float best = -3.0e38f; int bi = 0;
                for (int e = 0; e < 32; ++e) { const float x = lg[F.tid * 32 + e]; if (!((taken >> e) & 1u) && x > best) { best = x; bi = e; } }
                val[k] = best; idx[k] = bi; taken |= 1u << bi; }
            float p[4], sum = 0.f;
#pragma unroll
            for (int k = 0; k < 4; ++k) { p[k] = __expf(val[k] - val[0]); sum += p[k]; }
#pragma unroll
            for (int k = 0; k < 4; ++k) { const unsigned rank = __hip_atomic_fetch_add(F.ctl + CW_CNT + 64 * l + idx[k], 1u, RLX_AGENT);
                tope[m * 4 + k] = idx[k] | (int)(rank << 8); topg[m * 4 + k] = p[k] / sum; }
        }
        __syncthreads();
    }
}
__device__ __forceinline__ void moe_tables(Frame& F, int l) {
    LAS int* blk_end = (LAS int*)(F.lds + LDS_X_OFF); LAS int* pstart = blk_end + 32; LAS int* cnts = blk_end + 64;
    if (F.tid == 0) { int nb = 0;
        for (int e = 0; e < 32; ++e) { const int c = (int)__hip_atomic_load(F.ctl + CW_CNT + 64 * l + e, RLX_AGENT); cnts[e] = c; pstart[e] = nb * 256; nb += (c + 255) >> 8; blk_end[e] = nb; } }
    __syncthreads();
}
__device__ __forceinline__ void phase_scatter(Frame& F, int l) {
    const int nrows = (l == 0) ? NTOK : NLAT;
    moe_tables(F, l);
    const LAS int* blk_end = (const LAS int*)(F.lds + LDS_X_OFF); const LAS int* pstart = blk_end + 32; const LAS int* cnts = blk_end + 64;
    const int* tope = (const int*)(F.ws + MOEI_TOPE); const float* topg = (const float*)(F.ws + MOEI_TOPG);
    int* dest = (int*)(F.ws + MOEI_DEST); float* rowg = (float*)(F.ws + MOEI_ROWG); int* rowt = (int*)(F.ws + MOEI_ROWT);
    for (int a = F.bid * NTHREADS + F.tid; a < nrows * 4; a += F.G * NTHREADS) {
        const int te = tope[a], e = te & 255, rank = (int)((unsigned)te >> 8), d = pstart[e] + rank;
        dest[a] = d; rowg[d] = topg[a]; rowt[d] = a >> 2; }
    if (F.bid < 32) { const int e = F.bid, r0 = pstart[e] + cnts[e], r1 = blk_end[e] * 256;
        for (int r = r0 + F.tid; r < r1; r += NTHREADS) { rowt[r] = 0; rowg[r] = 0.f; } }
}
__device__ __forceinline__ void phase_gemm1(Frame& F, int l) {
    moe_tables(F, l);
    const LAS int* blk_end = (const LAS int*)(F.lds + LDS_X_OFF);
    pg8::Gemm g{(const bf16*)(F.ws + WS_H), (const bf16*)(F.ws + WS_WGU) + (size_t)l * 32 * 2048 * 2048, MOE_ROWS, 2048, 2048};
    pg8::MoeOrderG S{F.bid, __builtin_amdgcn_readfirstlane(blk_end[31]), (const char*)g.A, (const char*)g.Bt, (size_t)256 * 2048 * 2, (size_t)2048 * 2048 * 2, (size_t)256 * 2048 * 2, blk_end, (const int*)(F.ws + MOEI_ROWT)};
    pg8::EpiSwiglu E{(bf16*)(F.ws + WS_ACT), F.in[I_BGU] + (size_t)l * 32 * 2048};
    pg8::gemm_phase<pg8::EpiSwiglu, pg8::MoeOrderG, true, true>(F.lds + RING_OFF, g, S, E);
}
__device__ __forceinline__ void phase_gemm2(Frame& F, int l) {
    moe_tables(F, l);
    const LAS int* blk_end = (const LAS int*)(F.lds + LDS_X_OFF);
    pg8::Gemm g{(const bf16*)(F.ws + WS_ACT), (const bf16*)(F.ws + WS_WDN) + (size_t)l * 32 * 2048 * 1024, MOE_ROWS, 2048, 1024};
    pg8::MoeOrder S{F.bid, __builtin_amdgcn_readfirstlane(blk_end[31]), (const char*)g.A, (const char*)g.Bt, (size_t)256 * 1024 * 2, (size_t)2048 * 1024 * 2, (size_t)256 * 1024 * 2, blk_end, nullptr};
    pg8::EpiDown E{(bf16*)(F.ws + WS_YS), F.in[I_BDN] + (size_t)l * 32 * 2048, (const float*)(F.ws + MOEI_ROWG)};
    pg8::gemm_phase<pg8::EpiDown, pg8::MoeOrder, true, true>(F.lds + RING_OFF, g, S, E);
}
#ifndef PHASE_NORM2
#define PHASE_NORM2(F, l) phase_norm2(F, l)
#endif
#ifndef PHASE_SCATTER
#define PHASE_SCATTER(F, l) phase_scatter(F, l)
#endif
#ifndef PHASE_GEMM1
#define PHASE_GEMM1(F, l) phase_gemm1(F, l)
#endif
#ifndef PHASE_GEMM2
#define PHASE_GEMM2(F, l) phase_gemm2(F, l)
#endif
#define USE_MFMA_ATTN 1

__device__ __forceinline__ void attn_prep(Frame& F, int l) {
    bf16* P = (bf16*)(F.ws + WS_P);
    LAS unsigned short* vt = (LAS unsigned short*)F.lds;
    for (int ct = F.bid; ct < NCT; ct += F.G) {
        const int m0 = ct * 64; const bool lat = m0 < NLAT;
        __syncthreads();
        for (int i = F.tid; i < 64 * 32; i += NTHREADS) { const int tk = i >> 5, c8 = i & 31;
            const v4u w = *(const v4u*)(P + (size_t)(m0 + tk) * PW + PC_V + c8 * 8);
            const unsigned ww[4] = {w.x, w.y, w.z, w.w};
#pragma unroll
            for (int q = 0; q < 4; ++q) { vt[(c8 * 8 + 2 * q) * 66 + tk] = (unsigned short)(ww[q] & 0xffffu); vt[(c8 * 8 + 2 * q + 1) * 66 + tk] = (unsigned short)(ww[q] >> 16); } }
        if (lat) { const int tk = F.tid >> 3, kvh = (F.tid >> 1) & 3, hf = F.tid & 1; const int t = (m0 + tk) & 4095;
            bf16* kp = P + (size_t)(m0 + tk) * PW + PC_K + kvh * 64 + hf * 32;
            const v4u w0 = *(const v4u*)kp, w1 = *(const v4u*)(kp + 8), w2 = *(const v4u*)(kp + 16), w3 = *(const v4u*)(kp + 24);
            const unsigned lo[8] = {w0.x, w0.y, w0.z, w0.w, w1.x, w1.y, w1.z, w1.w}, hi_[8] = {w2.x, w2.y, w2.z, w2.w, w3.x, w3.y, w3.z, w3.w};
            const float pos = (float)(hf ? (t & 63) : (t >> 6)); unsigned o1[8], o2[8];
#pragma unroll
            for (int jj = 0; jj < 8; ++jj) { float r1[2], r2[2];
#pragma unroll
                for (int e = 0; e < 2; ++e) { const int j = 2 * jj + e; const float inv = __builtin_amdgcn_exp2f(-(float)j * 0.8304820237218406f); const float sn = __sinf(pos * inv), cs = __cosf(pos * inv);
                    const float x1 = e ? bfhi(lo[jj]) : bflo(lo[jj]), x2 = e ? bfhi(hi_[jj]) : bflo(hi_[jj]); r1[e] = x1 * cs - x2 * sn; r2[e] = x2 * cs + x1 * sn; }
                o1[jj] = pk2(r1[0], r1[1]); o2[jj] = pk2(r2[0], r2[1]); }
            *(v4u*)kp = (v4u){o1[0], o1[1], o1[2], o1[3]}; *(v4u*)(kp + 8) = (v4u){o1[4], o1[5], o1[6], o1[7]}; *(v4u*)(kp + 16) = (v4u){o2[0], o2[1], o2[2], o2[3]}; *(v4u*)(kp + 24) = (v4u){o2[4], o2[5], o2[6], o2[7]}; }
        __syncthreads();
        for (int i = F.tid; i < 256 * 8; i += NTHREADS) { const int col = i >> 3, c = i & 7, kvh = col >> 6, d = col & 63;
            v4u o; const LAS unsigned short* s = vt + col * 66 + c * 8;
            o.x = s[0] | ((unsigned)s[1] << 16); o.y = s[2] | ((unsigned)s[3] << 16); o.z = s[4] | ((unsigned)s[5] << 16); o.w = s[6] | ((unsigned)s[7] << 16);
            if (lat) { const int b = m0 >> 12, t0 = m0 & 4095; *(v4u*)((bf16*)(F.ws + WS_VT) + ((size_t)(b * 4 + kvh) * 64 + d) * SEQ + t0 + c * 8) = o; }
            else { const int mm = m0 - NLAT, b = mm >> 8, t0 = mm & 255; *(v4u*)((bf16*)(F.ws + WS_VTC) + ((size_t)(b * 4 + kvh) * 64 + d) * CTXL + t0 + c * 8) = o; } }
    }
    __syncthreads();
}

constexpr int AT_KP = 144, AT_VP = 136;
constexpr int AT_KOFF = 0, AT_VOFF = 64 * AT_KP, AT_TILE = 64 * AT_KP + 64 * AT_VP;
__device__ __forceinline__ void attn_unit(Frame& F, int l, int b, int kvh, int qi, int is_ctx) {
    const bf16* P = (const bf16*)(F.ws + WS_P); bf16* CC = (bf16*)(F.ws + WS_CC);
    int lane_o = F.lane; asm volatile("" : "+v"(lane_o));
    const int g = F.wave >> 1, qh = F.wave & 1, hq = kvh * 4 + g, r32 = lane_o & 31, hi = lane_o >> 5;
    const int rowbase = is_ctx ? NLAT + b * CTXL : b * SEQ;
    const int qa = qi * 128 + qh * 64;
    const float LOG2E = 1.4426950408889634f;
    bf16x8 qf[2][4];
#pragma unroll
    for (int qt = 0; qt < 2; ++qt) { const int tq = qa + 32 * qt + r32; const bf16* qp = P + (size_t)(rowbase + tq) * PW + PC_Q + hq * 64 + 8 * hi;
        float x[4][8];
#pragma unroll
        for (int s = 0; s < 4; ++s) { const v4u w = *(const v4u*)(qp + 16 * s); x[s][0] = bflo(w.x); x[s][1] = bfhi(w.x); x[s][2] = bflo(w.y); x[s][3] = bfhi(w.y); x[s][4] = bflo(w.z); x[s][5] = bfhi(w.z); x[s][6] = bflo(w.w); x[s][7] = bfhi(w.w); }
        if (!is_ctx) {
#pragma unroll
            for (int hf = 0; hf < 2; ++hf) { const float pos = (float)(hf ? (tq & 63) : (tq >> 6));
#pragma unroll
                for (int j = 0; j < 8; ++j) { const float inv = __builtin_amdgcn_exp2f(-(float)(8 * hi + j) * 0.8304820237218406f); const float sn = __sinf(pos * inv), cs = __cosf(pos * inv);
                    const float x1 = x[2 * hf][j], x2 = x[2 * hf + 1][j]; x[2 * hf][j] = x1 * cs - x2 * sn; x[2 * hf + 1][j] = x2 * cs + x1 * sn; } } }
        const float sc = 0.125f * LOG2E;
#pragma unroll
        for (int s = 0; s < 4; ++s) { v4u w; w.x = pk2(x[s][0] * sc, x[s][1] * sc); w.y = pk2(x[s][2] * sc, x[s][3] * sc); w.z = pk2(x[s][4] * sc, x[s][5] * sc); w.w = pk2(x[s][6] * sc, x[s][7] * sc); qf[qt][s] = __builtin_bit_cast(bf16x8, w); }
    }
    float mrun[2], lrun[2]; f32x16 O[2][2];
    { const float sk = F.in[I_SINK][l * 16 + hq] * LOG2E;
#pragma unroll
      for (int qt = 0; qt < 2; ++qt) { mrun[qt] = sk; lrun[qt] = hi ? 0.f : 1.f;
#pragma unroll
        for (int db = 0; db < 2; ++db)
#pragma unroll
            for (int r = 0; r < 16; ++r) O[qt][db][r] = 0.f; } }
    const int kt_lo = is_ctx ? 0 : (qi == 0 ? 2 : 0), nl = is_ctx ? 0 : (6 - (qi == 0 ? 2 : 0) - (qi == 31 ? 2 : 0)), ntile = nl + 4;
    const int rr = F.tid >> 3, cch = F.tid & 7;
    const bf16* kbase_l = P + (size_t)(b * SEQ + rr) * PW + PC_K + kvh * 64 + cch * 8; const bf16* kbase_c = P + (size_t)(NLAT + b * CTXL + rr) * PW + PC_K + kvh * 64 + cch * 8;
    const bf16* vbase_l = (const bf16*)(F.ws + WS_VT) + ((size_t)(b * 4 + kvh) * 64 + rr) * SEQ + cch * 8; const bf16* vbase_c = (const bf16*)(F.ws + WS_VTC) + ((size_t)(b * 4 + kvh) * 64 + rr) * CTXL + cch * 8;
    v4u kw, vw;
    { const bool loc0 = nl > 0; const int k00 = loc0 ? 128 * (qi - 1) + 64 * kt_lo : 0; kw = *(const v4u*)((loc0 ? kbase_l : kbase_c) + (size_t)k00 * PW); vw = *(const v4u*)((loc0 ? vbase_l : vbase_c) + k00); }
    __syncthreads();
#pragma unroll 1
    for (int jt = 0; jt < ntile; ++jt) {
        const bool local = jt < nl; const int k0 = local ? 128 * (qi - 1) + 64 * (kt_lo + jt) : 64 * (jt - nl);
        const LAS unsigned char* KS = F.lds + (jt & 1) * AT_TILE + AT_KOFF; const LAS unsigned char* VS = F.lds + (jt & 1) * AT_TILE + AT_VOFF;
        { *(LAS v4u*)(F.lds + (jt & 1) * AT_TILE + AT_KOFF + rr * AT_KP + cch * 16) = kw;
          LAS v2u* vd = (LAS v2u*)(F.lds + (jt & 1) * AT_TILE + AT_VOFF + rr * AT_VP + cch * 16); vd[0] = (v2u){vw.x, vw.y}; vd[1] = (v2u){vw.z, vw.w}; }
        if (jt + 1 < ntile) { const bool ln = jt + 1 < nl; const int kn = ln ? 128 * (qi - 1) + 64 * (kt_lo + jt + 1) : 64 * (jt + 1 - nl);
            kw = *(const v4u*)((ln ? kbase_l : kbase_c) + (size_t)kn * PW); vw = *(const v4u*)((ln ? vbase_l : vbase_c) + kn); }
        __syncthreads();
        if (local && (k0 + 63 < qa - 128 || k0 > qa + 63 + 128)) continue;
#pragma unroll 1
        for (int kb = 0; kb < 2; ++kb) {
            bf16x8 kf[4];
#pragma unroll
            for (int ss = 0; ss < 4; ++ss) kf[ss] = *(const LAS bf16x8*)(KS + (32 * kb + r32) * AT_KP + (16 * ss + 8 * hi) * 2);
            bf16x8 pb[2][2];
#pragma unroll
            for (int qt = 0; qt < 2; ++qt) { const int tq = qa + 32 * qt + r32;
                f32x16 s;
#pragma unroll
                for (int r = 0; r < 16; ++r) s[r] = 0.f;
#pragma unroll
                for (int ss = 0; ss < 4; ++ss) s = __builtin_amdgcn_mfma_f32_32x32x16_bf16(kf[ss], qf[qt][ss], s, 0, 0, 0);
                if (local) {
#pragma unroll
                    for (int r = 0; r < 16; ++r) { const int kidx = k0 + 32 * kb + (r & 3) + 8 * (r >> 2) + 4 * hi; const int dlt = kidx - tq; if (dlt > 128 || dlt < -128) s[r] = -1.0e30f; } }
                float mloc = s[0];
#pragma unroll
                for (int r = 1; r < 16; ++r) mloc = fmaxf(mloc, s[r]);
                mloc = fmaxf(mloc, __shfl_xor(mloc, 32));
                const float mnew = fmaxf(mrun[qt], mloc), alpha = __builtin_amdgcn_exp2f(mrun[qt] - mnew); mrun[qt] = mnew;
                float psum = 0.f;
#pragma unroll
                for (int r = 0; r < 16; ++r) { s[r] = __builtin_amdgcn_exp2f(s[r] - mnew); psum += s[r]; }
                lrun[qt] = lrun[qt] * alpha + psum;
#pragma unroll
                for (int db = 0; db < 2; ++db)
#pragma unroll
                    for (int r = 0; r < 16; ++r) O[qt][db][r] *= alpha;
#pragma unroll
                for (int s2 = 0; s2 < 2; ++s2) { v4u pw; pw.x = pk2(s[8 * s2 + 0], s[8 * s2 + 1]); pw.y = pk2(s[8 * s2 + 2], s[8 * s2 + 3]); pw.z = pk2(s[8 * s2 + 4], s[8 * s2 + 5]); pw.w = pk2(s[8 * s2 + 6], s[8 * s2 + 7]);
                    pb[qt][s2] = __builtin_bit_cast(bf16x8, pw); }
            }
#pragma unroll
            for (int s2 = 0; s2 < 2; ++s2)
#pragma unroll
                for (int db = 0; db < 2; ++db) { const LAS v2u* vp = (const LAS v2u*)(VS + (32 * db + r32) * AT_VP + (32 * kb + 16 * s2 + 4 * hi) * 2);
                    const v2u a0 = vp[0], a1 = vp[2]; v4u aw; aw.x = a0.x; aw.y = a0.y; aw.z = a1.x; aw.w = a1.y; const bf16x8 va = __builtin_bit_cast(bf16x8, aw);
                    O[0][db] = __builtin_amdgcn_mfma_f32_32x32x16_bf16(va, pb[0][s2], O[0][db], 0, 0, 0);
                    O[1][db] = __builtin_amdgcn_mfma_f32_32x32x16_bf16(va, pb[1][s2], O[1][db], 0, 0, 0); }
        }
    }
    int r32e = r32, hie = hi; asm volatile("" : "+v"(r32e), "+v"(hie));
#pragma unroll
    for (int qt = 0; qt < 2; ++qt) { const float lt = lrun[qt] + __shfl_xor(lrun[qt], 32); const float rl = 1.0f / lt; const int tq = qa + 32 * qt + r32e;
        bf16* op = CC + (size_t)(rowbase + tq) * DM + hq * 64 + 4 * hie;
#pragma unroll
        for (int db = 0; db < 2; ++db)
#pragma unroll
            for (int rq = 0; rq < 4; ++rq) { v2u w; w.x = pk2(O[qt][db][4 * rq] * rl, O[qt][db][4 * rq + 1] * rl); w.y = pk2(O[qt][db][4 * rq + 2] * rl, O[qt][db][4 * rq + 3] * rl);
                *(v2u*)(op + 32 * db + 8 * rq) = w; } }
}
__device__ __forceinline__ void attn_phase(Frame& F, int l, int rep = 0) {
    const int nunits = 512 + (l == 0 ? 32 : 0);
    LAS int* slot = (LAS int*)(F.lds + LDS_X_OFF + 512);
    for (;;) {
        __syncthreads();
        if (F.tid == 0) *slot = (int)__hip_atomic_fetch_add(F.ctl + CW_ATQ + 64 * l + 8 * rep, 1u, RLX_AGENT);
        __syncthreads();
        const int u = __builtin_amdgcn_readfirstlane(*slot);
        if (u >= nunits) break;
        if (u < 512) attn_unit(F, l, u >> 7, (u >> 5) & 3, u & 31, 0); else { const int v = u - 512; attn_unit(F, l, v >> 3, (v >> 1) & 3, v & 1, 1); }
    }
}
#define USE_CHUNK_DN 1
#ifndef DN_REP_S1
#define DN_REP_S1 1
#endif
#ifndef DN_REP_S3B
#define DN_REP_S3B 1
#endif
#ifndef DN_REP_S3A
#define DN_REP_S3A 1
#endif
#ifndef DN_REP_S4
#define DN_REP_S4 1
#endif

constexpr int DN_F_NEGW = 0, DN_F_QG = 16, DN_F_QK = 32, DN_F_KGT = 40, DN_NFRAG = 56, DN_U_OFF = 57344;
constexpr int DP_QS = 0, DP_KS = 17408, DP_VS = 34816, DP_AS = 52224  , DP_TB = 69632, DP_TW = 78848, DP_QK = 88064, DP_RAW = 52224  , DP_SC = 104960, DP_TF = 106496  , DP_XS = 123904  ;
constexpr int DP_P = 272, DP_P2 = 144;
__device__ __forceinline__ int dn_rec(int b, int h, int dir, int np) { return ((b * 4 + h) * 2 + dir) * 68 + np; }
__device__ __forceinline__ void dn_chunk_of(int ct, int dir, int& b, int& np) { if (ct < 256) { b = ct >> 6; const int c = ct & 63; np = 4 + (dir ? 63 - c : c); } else { b = (ct - 256) >> 2; const int c = (ct - 256) & 3; np = dir ? 3 - c : c; } }
__device__ __forceinline__ unsigned short lds_u16(const LAS unsigned char* p) { return *(const LAS unsigned short*)p; }

__device__ __forceinline__ void dn_prep_unit(Frame& F, int l, int ct, int h, int dir) {
    const bf16* P = (const bf16*)(F.ws + WS_P);
    int lane = F.lane; asm volatile("" : "+v"(lane));
    const int wave = F.wave, i16 = lane & 15, q = lane >> 4;
    const int m0 = ct * 64; int t0, T, base; seq_of(m0, t0, T, base);
    int b, np; dn_chunk_of(ct, dir, b, np);
    unsigned char* tile = F.ws + WS_DNT + (size_t)dn_rec(b, h, dir, np) * DNT_BYTES;
    LAS unsigned char* L = F.lds;
    LAS float* SC = (LAS float*)(L + DP_SC);
    __syncthreads();
    {
        const float* cw = F.in[I_DNCW] + (size_t)l * 4 * 1536;
        float2 cwr[3][4];
#pragma unroll
        for (int part = 0; part < 3; ++part)
#pragma unroll
            for (int j = 0; j < 4; ++j) cwr[part][j] = *(const float2*)(cw + j * 1536 + part * 512 + h * 128 + 2 * lane);
        unsigned short pbw = 0, paw = 0;
        if (wave == 0) { const int tok = dir ? 63 - lane : lane; pbw = P[(size_t)(m0 + tok) * PW + PC_BETA + dir * 4 + h]; paw = P[(size_t)(m0 + tok) * PW + PC_DEC + dir * 4 + h]; }
        for (int c = F.tid; c < 67 * 48; c += NTHREADS) { const int row = c / 48, ch = c % 48, part = ch >> 4, cc = ch & 15, tt = t0 + row - 2;
            v4u v = (v4u){0u, 0u, 0u, 0u};
            if (tt >= 0 && tt < T) v = *(const v4u*)(P + (size_t)(base + tt) * PW + PC_DQ + part * 512 + h * 128 + cc * 8);
            *(LAS v4u*)(L + DP_RAW + row * 784 + part * 256 + cc * 16) = v; }
        __syncthreads();
#pragma unroll 1
        for (int rep = 0; rep < DN_REP_S1; ++rep)
#pragma unroll
        for (int part = 0; part < 3; ++part)
#pragma unroll 2
            for (int i = 0; i < 8; ++i) { const int tok = wave * 8 + i;
                float s0 = 0.f, s1 = 0.f;
#pragma unroll
                for (int j = 0; j < 4; ++j) { const unsigned w = *(const LAS unsigned*)(L + DP_RAW + (tok + j) * 784 + part * 256 + lane * 4); s0 += cwr[part][j].x * bflo(w); s1 += cwr[part][j].y * bfhi(w); }
                s0 = siluf_(s0); s1 = siluf_(s1);
                if (part < 2) { const float ss = wave_sum(s0 * s0 + s1 * s1); const float f = (part == 0 ? 0.08838834764831845f : 1.0f) / sqrtf(ss + EPS); s0 *= f; s1 *= f; }
                *(LAS unsigned*)(L + (part == 0 ? DP_QS : (part == 1 ? DP_KS : DP_VS)) + tok * DP_P + lane * 4) = pk2(s0, s1); }
        if (wave == 0) {
            const float pb = bf2f(pbw), pa = bf2f(paw);
            const float beta = sigmoidf_(pb); float gc = -__expf(F.in[I_DNALOG][l * 8 + dir * 4 + h]) * softplusf_(pa + F.in[I_DNDT][l * 8 + dir * 4 + h]);
#pragma unroll
            for (int o = 1; o < 64; o <<= 1) { const float v = __shfl_up(gc, o); if (lane >= o) gc += v; }
            const float glast = __shfl(gc, 63);
            SC[lane] = beta; SC[64 + lane] = gc; SC[128 + lane] = __expf(gc); SC[192 + lane] = __expf(glast - gc);
            if (lane == 63) ((float*)(F.ws + WS_DNS))[dn_rec(b, h, dir, np)] = __expf(glast);
        }
    }
    __syncthreads();
#define DN_TOK(r) (dir ? 63 - (r) : (r))
#pragma unroll 1
    for (int rep = 0; rep < DN_REP_S3A; ++rep)
    {
        const int mb = wave & 3, which = wave >> 2;
        f32x4 acc[4];
#pragma unroll
        for (int nb = 0; nb < 4; ++nb) acc[nb] = (f32x4){0.f, 0.f, 0.f, 0.f};
        const LAS unsigned char* arow = L + (which ? DP_QS : DP_KS) + DN_TOK(16 * mb + i16) * DP_P + 16 * q;
#pragma unroll
        for (int ks = 0; ks < 4; ++ks) { const bf16x8 a = *(const LAS bf16x8*)(arow + 64 * ks);
#pragma unroll
            for (int nb = 0; nb < 4; ++nb) { const bf16x8 bb = *(const LAS bf16x8*)(L + DP_KS + DN_TOK(16 * nb + i16) * DP_P + 16 * q + 64 * ks);
                acc[nb] = __builtin_amdgcn_mfma_f32_16x16x32_bf16(a, bb, acc[nb], 0, 0, 0); } }
#pragma unroll
        for (int nb = 0; nb < 4; ++nb)
#pragma unroll
            for (int i = 0; i < 4; ++i) { const int r = 16 * mb + 4 * q + i, c = 16 * nb + i16; const float dec = __expf(SC[64 + r] - SC[64 + c]);
                if (which == 0) ((LAS float*)(L + DP_AS))[r * 68 + c] = (r > c) ? SC[r] * acc[nb][i] * dec : 0.f;
                else *(LAS unsigned short*)(L + DP_QK + r * DP_P2 + c * 2) = (unsigned short)f2bf((r >= c) ? acc[nb][i] * dec : 0.f); }
    }
    __syncthreads();
#pragma unroll 1
    for (int rep = 0; rep < DN_REP_S3B; ++rep) {
    if (wave == 0) {
        const LAS float* As = (const LAS float*)(L + DP_AS); LAS float* Tf = (LAS float*)(L + DP_TF);
        const int g = lane >> 4, c = lane & 15;
        f32x4 ar[16][4];
#pragma unroll
        for (int r = 1; r < 16; ++r)
#pragma unroll
            for (int j4 = 0; j4 < (r + 3) / 4; ++j4) ar[r][j4] = *(const LAS f32x4*)(As + (16 * g + r) * 68 + 16 * g + 4 * j4);
        float t[16];
#pragma unroll
        for (int r = 0; r < 16; ++r) { float a0 = (c == r) ? 1.f : 0.f, a1 = 0.f;
#pragma unroll
            for (int j = 0; j < r; ++j) { const float av = ar[r][j >> 2][j & 3]; if (j & 1) a1 -= av * t[j]; else a0 -= av * t[j]; }
            t[r] = a0 + a1; Tf[(16 * g + r) * 68 + 16 * g + c] = t[r]; }
    }
    __syncthreads();
    if (wave < 3) {
        const LAS float* As = (const LAS float*)(L + DP_AS); LAS float* Tf = (LAS float*)(L + DP_TF); LAS float* Xs = (LAS float*)(L + DP_XS) + wave * 272;
        const int J = wave;
#pragma unroll 1
        for (int I = J + 1; I < 4; ++I) {
            f32x4 acc = {0.f, 0.f, 0.f, 0.f};
#pragma unroll 1
            for (int K = J; K < I; ++K)
#pragma unroll
                for (int sk = 0; sk < 4; ++sk) acc = __builtin_amdgcn_mfma_f32_16x16x4f32(As[(16 * I + i16) * 68 + 16 * K + 4 * sk + q], Tf[(16 * K + 4 * sk + q) * 68 + 16 * J + i16], acc, 0, 0, 0);
#pragma unroll
            for (int i = 0; i < 4; ++i) Xs[(4 * q + i) * 17 + i16] = acc[i];
            LDS_WAIT(); asm volatile("" ::: "memory");
            f32x4 acc2 = {0.f, 0.f, 0.f, 0.f};
#pragma unroll
            for (int sk = 0; sk < 4; ++sk) acc2 = __builtin_amdgcn_mfma_f32_16x16x4f32(Tf[(16 * I + i16) * 68 + 16 * I + 4 * sk + q], Xs[(4 * sk + q) * 17 + i16], acc2, 0, 0, 0);
#pragma unroll
            for (int i = 0; i < 4; ++i) Tf[(16 * I + 4 * q + i) * 68 + 16 * J + i16] = -acc2[i];
            LDS_WAIT(); asm volatile("" ::: "memory");
        }
    }
    __syncthreads();
    { const LAS float* Tf = (const LAS float*)(L + DP_TF); const int r = F.tid >> 3, c0 = (F.tid & 7) * 8; float vb[8], vw[8];
#pragma unroll
      for (int k = 0; k < 8; ++k) { const int c = c0 + k; const float v = ((r >> 4) >= (c >> 4)) ? Tf[r * 68 + c] : 0.f; const float bl = SC[c]; vb[k] = v * bl; vw[k] = vb[k] * SC[128 + c]; }
      v4u ob, ow; ob.x = pk2(vb[0], vb[1]); ob.y = pk2(vb[2], vb[3]); ob.z = pk2(vb[4], vb[5]); ob.w = pk2(vb[6], vb[7]); ow.x = pk2(vw[0], vw[1]); ow.y = pk2(vw[2], vw[3]); ow.z = pk2(vw[4], vw[5]); ow.w = pk2(vw[6], vw[7]);
      *(LAS v4u*)(L + DP_TB + r * DP_P2 + c0 * 2) = ob; *(LAS v4u*)(L + DP_TW + r * DP_P2 + c0 * 2) = ow; }
    }
    __syncthreads();
    {
        const int nbp = wave & 3, which = wave >> 2;
        f32x4 acc[4][2];
#pragma unroll
        for (int mb = 0; mb < 4; ++mb) { acc[mb][0] = (f32x4){0.f, 0.f, 0.f, 0.f}; acc[mb][1] = (f32x4){0.f, 0.f, 0.f, 0.f}; }
#pragma unroll
        for (int ks = 0; ks < 2; ++ks) {
            bf16x8 bb[2];
#pragma unroll
            for (int nn = 0; nn < 2; ++nn) { const int n = 16 * (2 * nbp + nn) + i16; unsigned short e[8];
#pragma unroll
                for (int jj = 0; jj < 8; ++jj) e[jj] = lds_u16(L + (which ? DP_KS : DP_VS) + DN_TOK(32 * ks + 8 * q + jj) * DP_P + n * 2);
                v4u w; w.x = e[0] | ((unsigned)e[1] << 16); w.y = e[2] | ((unsigned)e[3] << 16); w.z = e[4] | ((unsigned)e[5] << 16); w.w = e[6] | ((unsigned)e[7] << 16); bb[nn] = __builtin_bit_cast(bf16x8, w); }
#pragma unroll
            for (int mb = 0; mb < 4; ++mb) { const bf16x8 a = *(const LAS bf16x8*)(L + (which ? DP_TW : DP_TB) + (16 * mb + i16) * DP_P2 + 64 * ks + 16 * q);
                acc[mb][0] = __builtin_amdgcn_mfma_f32_16x16x32_bf16(a, bb[0], acc[mb][0], 0, 0, 0); acc[mb][1] = __builtin_amdgcn_mfma_f32_16x16x32_bf16(a, bb[1], acc[mb][1], 0, 0, 0); } }
        if (which == 0) {
#pragma unroll
            for (int mb = 0; mb < 4; ++mb)
#pragma unroll
                for (int nn = 0; nn < 2; ++nn) *(f32x4*)(tile + DN_U_OFF + (size_t)((((2 * nbp + nn) * 4 + mb) * 64 + lane) * 16)) = acc[mb][nn];
        } else {
#pragma unroll
            for (int mb = 0; mb < 4; ++mb)
#pragma unroll
                for (int nn = 0; nn < 2; ++nn)
#pragma unroll
                    for (int i = 0; i < 4; ++i) *(LAS unsigned short*)(L + DP_AS + (16 * mb + 4 * q + i) * DP_P + (16 * (2 * nbp + nn) + i16) * 2) = (unsigned short)f2bf(-acc[mb][nn][i]);
        }
    }
    __syncthreads();
#pragma unroll 1
    for (int rep = 0; rep < DN_REP_S4; ++rep)
#pragma unroll 1
    for (int fi = 0; fi < 7; ++fi) { const int f = wave * 7 + fi; v4u o;
        if (f < DN_F_QG) { const int mb = f >> 2, ks = f & 3; const LAS unsigned char* rp = L + DP_AS + (16 * mb + i16) * DP_P + (32 * ks + 4 * q) * 2;
            const v2u a = *(const LAS v2u*)rp, c = *(const LAS v2u*)(rp + 32); o.x = a.x; o.y = a.y; o.z = c.x; o.w = c.y; }
        else if (f < DN_F_QK) { const int ff = f - DN_F_QG, mb = ff >> 2, ks = ff & 3, r = 16 * mb + i16; const LAS unsigned char* rp = L + DP_QS + DN_TOK(r) * DP_P + (32 * ks + 4 * q) * 2; const float eg = SC[128 + r];
            const v2u a = *(const LAS v2u*)rp, c = *(const LAS v2u*)(rp + 32);
            o.x = pk2(bflo(a.x) * eg, bfhi(a.x) * eg); o.y = pk2(bflo(a.y) * eg, bfhi(a.y) * eg); o.z = pk2(bflo(c.x) * eg, bfhi(c.x) * eg); o.w = pk2(bflo(c.y) * eg, bfhi(c.y) * eg); }
        else if (f < DN_F_KGT) { const int ff = f - DN_F_QK, mb = ff >> 1, ks = ff & 1; const LAS unsigned char* rp = L + DP_QK + (16 * mb + i16) * DP_P2 + (32 * ks + 4 * q) * 2;
            const v2u a = *(const LAS v2u*)rp, c = *(const LAS v2u*)(rp + 32); o.x = a.x; o.y = a.y; o.z = c.x; o.w = c.y; }
        else { const int ff = f - DN_F_KGT, mb = ff >> 1, ks = ff & 1, dk = 16 * mb + i16; float e[8];
#pragma unroll
            for (int jj = 0; jj < 8; ++jj) { const int key = 32 * ks + 16 * (jj >> 2) + 4 * q + (jj & 3); e[jj] = bf2f(lds_u16(L + DP_KS + DN_TOK(key) * DP_P + dk * 2)) * SC[192 + key]; }
            o.x = pk2(e[0], e[1]); o.y = pk2(e[2], e[3]); o.z = pk2(e[4], e[5]); o.w = pk2(e[6], e[7]); }
        *(v4u*)(tile + (size_t)f * 1024 + lane * 16) = o; }
#undef DN_TOK
}
__device__ __forceinline__ void dn_prep(Frame& F, int l) {
    for (int u = F.bid; u < NCT * 4 * 2; u += F.G) dn_prep_unit(F, l, u >> 3, (u >> 1) & 3, u & 1);
    __syncthreads();
}

__device__ __forceinline__ void dn_scan(Frame& F, int l, int b, int h, int dir, int half) {
    int lane = F.lane; asm volatile("" : "+v"(lane));
    const int w = half * 4 + (F.wave & 3), i16 = lane & 15, q = lane >> 4; const bool active = F.wave < 4;
    const unsigned char* tiles = F.ws + WS_DNT + (size_t)dn_rec(b, h, dir, 0) * DNT_BYTES;
    const float* egl = (const float*)(F.ws + WS_DNS) + dn_rec(b, h, dir, 0);
    float* O = (float*)(F.ws + WS_DNO);
    LAS unsigned char* L = F.lds;
    f32x4 S[8];
#pragma unroll
    for (int i = 0; i < 8; ++i) S[i] = (f32x4){0.f, 0.f, 0.f, 0.f};
    v4u st[7]; f32x4 un[4];
#pragma unroll
    for (int mb = 0; mb < 4; ++mb) un[mb] = *(const f32x4*)(tiles + DN_U_OFF + (size_t)(((w * 4 + mb) * 64 + lane) * 16));
    __syncthreads();
#pragma unroll
    for (int i = 0; i < 7; ++i) st[i] = *(const v4u*)(tiles + (size_t)(F.tid + i * NTHREADS) * 16);
#pragma unroll
    for (int i = 0; i < 7; ++i) *(LAS v4u*)(L + (F.tid + i * NTHREADS) * 16) = st[i];
    __syncthreads();
#pragma unroll 1
    for (int n = 0; n < 68; ++n) {
        const unsigned char* tile = tiles + (size_t)n * DNT_BYTES; const LAS unsigned char* cur = L + (n & 1) * 57344;
        if (n + 1 < 68) {
#pragma unroll
            for (int i = 0; i < 7; ++i) st[i] = *(const v4u*)(tile + DNT_BYTES + (size_t)(F.tid + i * NTHREADS) * 16); }
        if (active) {
        f32x4 vn[4];
#pragma unroll
        for (int mb = 0; mb < 4; ++mb) vn[mb] = un[mb];
        if (n + 1 < 68) {
#pragma unroll
            for (int mb = 0; mb < 4; ++mb) un[mb] = *(const f32x4*)(tile + DNT_BYTES + DN_U_OFF + (size_t)(((w * 4 + mb) * 64 + lane) * 16)); }
        const float el = egl[n];
        bf16x8 bS[4];
#pragma unroll
        for (int ks = 0; ks < 4; ++ks) { v4u x; x.x = pk2(S[2 * ks][0], S[2 * ks][1]); x.y = pk2(S[2 * ks][2], S[2 * ks][3]); x.z = pk2(S[2 * ks + 1][0], S[2 * ks + 1][1]); x.w = pk2(S[2 * ks + 1][2], S[2 * ks + 1][3]); bS[ks] = __builtin_bit_cast(bf16x8, x); }
        f32x4 o[4];
#pragma unroll
        for (int mb = 0; mb < 4; ++mb) { o[mb] = (f32x4){0.f, 0.f, 0.f, 0.f};
#pragma unroll
            for (int ks = 0; ks < 4; ++ks) { const bf16x8 aw = *(const LAS bf16x8*)(cur + (DN_F_NEGW + mb * 4 + ks) * 1024 + lane * 16), aq = *(const LAS bf16x8*)(cur + (DN_F_QG + mb * 4 + ks) * 1024 + lane * 16);
                vn[mb] = __builtin_amdgcn_mfma_f32_16x16x32_bf16(aw, bS[ks], vn[mb], 0, 0, 0); o[mb] = __builtin_amdgcn_mfma_f32_16x16x32_bf16(aq, bS[ks], o[mb], 0, 0, 0); } }
        bf16x8 bV[2];
#pragma unroll
        for (int ks = 0; ks < 2; ++ks) { v4u x; x.x = pk2(vn[2 * ks][0], vn[2 * ks][1]); x.y = pk2(vn[2 * ks][2], vn[2 * ks][3]); x.z = pk2(vn[2 * ks + 1][0], vn[2 * ks + 1][1]); x.w = pk2(vn[2 * ks + 1][2], vn[2 * ks + 1][3]); bV[ks] = __builtin_bit_cast(bf16x8, x); }
#pragma unroll
        for (int mb = 0; mb < 8; ++mb) { S[mb] = S[mb] * el;
#pragma unroll
            for (int ks = 0; ks < 2; ++ks) { const bf16x8 ak = *(const LAS bf16x8*)(cur + (DN_F_KGT + mb * 2 + ks) * 1024 + lane * 16); S[mb] = __builtin_amdgcn_mfma_f32_16x16x32_bf16(ak, bV[ks], S[mb], 0, 0, 0); } }
#pragma unroll
        for (int mb = 0; mb < 4; ++mb)
#pragma unroll
            for (int ks = 0; ks < 2; ++ks) { const bf16x8 aqk = *(const LAS bf16x8*)(cur + (DN_F_QK + mb * 2 + ks) * 1024 + lane * 16); o[mb] = __builtin_amdgcn_mfma_f32_16x16x32_bf16(aqk, bV[ks], o[mb], 0, 0, 0); }
        { int m0; if (n < 4) m0 = NLAT + b * CTXL + 64 * (dir ? 3 - n : n); else m0 = b * SEQ + 64 * (dir ? 63 - (n - 4) : (n - 4));
#pragma unroll
          for (int mb = 0; mb < 4; ++mb)
#pragma unroll
            for (int i = 0; i < 4; ++i) { const int r = 16 * mb + 4 * q + i, tok = dir ? 63 - r : r; O[((size_t)dir * NTOK + m0 + tok) * 512 + h * 128 + 16 * w + i16] = o[mb][i]; } }
        }
        if (n + 1 < 68) {
#pragma unroll
            for (int i = 0; i < 7; ++i) *(LAS v4u*)(L + ((n + 1) & 1) * 57344 + (F.tid + i * NTHREADS) * 16) = st[i]; }
        __syncthreads();
    }
}
#define USE_CHUNK_LRU 1

constexpr int LR_XF = 0  , LR_XB = 16640  , LR_WT = 25856  , LR_AA = 62720  , LR_UU = 96000  , LR_END = 129280;
constexpr size_t WS_LCA = WS_LRC, WS_LCH = WS_LRC + 2 * MiB, WS_LCI = WS_LRC + 4 * MiB;
__device__ __forceinline__ void lru_prep(Frame& F, int l) {
    const bf16* P = (const bf16*)(F.ws + WS_P);
    int lane = F.lane; asm volatile("" : "+v"(lane));
    const int wave = F.wave, i16 = lane & 15, q = lane >> 4, nb = F.bid & 7;
    LAS unsigned char* L = F.lds;
    LAS float* XF = (LAS float*)(L + LR_XF); LAS float* AA = (LAS float*)(L + LR_AA); LAS float* UU = (LAS float*)(L + LR_UU);
    bf16* HL = (bf16*)(F.ws + WS_LRH); bf16* AC = (bf16*)(F.ws + WS_LRA);
    __syncthreads();
    for (int e = F.tid; e < 4 * 4096; e += NTHREADS) { const int mat = e >> 12, ii = (e >> 6) & 63, j = e & 63, dir = mat >> 1;
        const float w = (mat & 1 ? F.in[I_LRWI] : F.in[I_LRWR])[((size_t)((l * 2 + dir) * 8 + nb)) * 4096 + ii * 64 + j];
        *(LAS unsigned short*)(L + LR_WT + (mat * 64 + j) * 144 + ii * 2) = (unsigned short)f2bf(w); }
    float cwv[4][8], cbv[8];
    { const int c8 = (F.tid & 7) * 8, ch0 = nb * 64 + c8; const float* cb = F.in[I_LRCB] + l * 512 + ch0; const float* cw = F.in[I_LRCW] + (size_t)l * 4 * 512 + ch0;
#pragma unroll
      for (int k = 0; k < 8; ++k) cbv[k] = cb[k];
#pragma unroll
      for (int j = 0; j < 4; ++j)
#pragma unroll
        for (int k = 0; k < 8; ++k) cwv[j][k] = cw[j * 512 + k]; }
    float gbr[4], gbi[4], gls[4];
    { const int dir = wave >> 2;
#pragma unroll
      for (int n = 0; n < 4; ++n) { const int ch = nb * 64 + 16 * n + i16; gbr[n] = F.in[I_LRBR][(l * 2 + dir) * 512 + ch]; gbi[n] = F.in[I_LRBI][(l * 2 + dir) * 512 + ch]; gls[n] = -softplusf_(-F.in[I_LRLAM][(l * 2 + dir) * 512 + ch]); } }
    for (int ct = F.bid >> 3; ct < NCT; ct += F.G >> 3) {
        const int m0 = ct * 64; int t0, T, base; seq_of(m0, t0, T, base);
        __syncthreads();
        { const int tok = F.tid >> 3, c8 = (F.tid & 7) * 8, ch0 = nb * 64 + c8; float s[8];
#pragma unroll
          for (int k = 0; k < 8; ++k) s[k] = cbv[k];
          v4u wv[4];
#pragma unroll
          for (int j = 0; j < 4; ++j) { const int tt = t0 + tok + j - 2; wv[j] = (v4u){0u, 0u, 0u, 0u}; if (tt >= 0 && tt < T) wv[j] = *(const v4u*)(P + (size_t)(base + tt) * PW + PC_LX + ch0); }
#pragma unroll
          for (int j = 0; j < 4; ++j) { const v4u w = wv[j];
              s[0] += cwv[j][0] * bflo(w.x); s[1] += cwv[j][1] * bfhi(w.x); s[2] += cwv[j][2] * bflo(w.y); s[3] += cwv[j][3] * bfhi(w.y); s[4] += cwv[j][4] * bflo(w.z); s[5] += cwv[j][5] * bfhi(w.z); s[6] += cwv[j][6] * bflo(w.w); s[7] += cwv[j][7] * bfhi(w.w); }
#pragma unroll
          for (int k = 0; k < 8; ++k) XF[tok * 65 + c8 + k] = s[k];
          v4u o; o.x = pk2(s[0], s[1]); o.y = pk2(s[2], s[3]); o.z = pk2(s[4], s[5]); o.w = pk2(s[6], s[7]); *(LAS v4u*)(L + LR_XB + tok * 144 + c8 * 2) = o; }
        __syncthreads();
        { const int dir = wave >> 2, mb = wave & 3;
          f32x4 ar[4], ai[4];
#pragma unroll
          for (int n = 0; n < 4; ++n) { ar[n] = (f32x4){0.f, 0.f, 0.f, 0.f}; ai[n] = (f32x4){0.f, 0.f, 0.f, 0.f}; }
#pragma unroll
          for (int ks = 0; ks < 2; ++ks) { const bf16x8 a = *(const LAS bf16x8*)(L + LR_XB + (16 * mb + i16) * 144 + 64 * ks + 16 * q);
#pragma unroll
              for (int n = 0; n < 4; ++n) { const bf16x8 br = *(const LAS bf16x8*)(L + LR_WT + ((dir * 2 + 0) * 64 + 16 * n + i16) * 144 + 64 * ks + 16 * q), bi = *(const LAS bf16x8*)(L + LR_WT + ((dir * 2 + 1) * 64 + 16 * n + i16) * 144 + 64 * ks + 16 * q);
                  ar[n] = __builtin_amdgcn_mfma_f32_16x16x32_bf16(a, br, ar[n], 0, 0, 0); ai[n] = __builtin_amdgcn_mfma_f32_16x16x32_bf16(a, bi, ai[n], 0, 0, 0); } }
#pragma unroll
          for (int n = 0; n < 4; ++n) { const int j = 16 * n + i16; const float br_ = gbr[n], bi_ = gbi[n], logsig = gls[n];
#pragma unroll
              for (int i = 0; i < 4; ++i) { const int tok = 16 * mb + 4 * q + i; const float r = sigmoidf_(ar[n][i] + br_), ig = sigmoidf_(ai[n][i] + bi_);
                  const float log_a = 8.0f * r * logsig, a = __expf(log_a), y2 = 2.0f * log_a;
                  const float om = (y2 > -0.1f) ? -y2 * (1.0f + y2 * (0.5f + y2 * (0.16666667f + y2 * 0.041666668f))) : 1.0f - __expf(y2);
                  const float u = __builtin_amdgcn_sqrtf(om) * (ig * XF[tok * 65 + j]);
                  AA[(dir * 64 + tok) * 65 + j] = a; UU[(dir * 64 + tok) * 65 + j] = u; } } }
        __syncthreads();
        if (F.tid < 128) { const int dir = F.tid >> 6, j = F.tid & 63, ch = nb * 64 + j; float h = 0.f, ac = 1.f;
            long o = (long)(((size_t)dir * NTOK + m0 + (dir ? 63 : 0)) * 512 + ch); const long ostep = dir ? -512 : 512;
#pragma unroll 1
            for (int s0 = 0; s0 < 64; s0 += 8) { float av[8], uv[8];
#pragma unroll
                for (int k = 0; k < 8; ++k) { const int tok = dir ? 63 - (s0 + k) : (s0 + k); av[k] = AA[(dir * 64 + tok) * 65 + j]; uv[k] = UU[(dir * 64 + tok) * 65 + j]; }
#pragma unroll
                for (int k = 0; k < 8; ++k) { h = av[k] * h + uv[k]; ac *= av[k]; HL[o] = (bf16)f2bf(h); AC[o] = (bf16)f2bf(ac); o += ostep; } }
            ((float*)(F.ws + WS_LCA))[((size_t)dir * NCT + ct) * 512 + ch] = ac; ((float*)(F.ws + WS_LCH))[((size_t)dir * NCT + ct) * 512 + ch] = h; }
    }
    __syncthreads();
}
__device__ __forceinline__ void lru_carry(Frame& F, int idx) {
    const int ch = idx & 511, dir = (idx >> 9) & 1, b = idx >> 10;
    const float* CA = (const float*)(F.ws + WS_LCA); const float* CH = (const float*)(F.ws + WS_LCH); float* CI = (float*)(F.ws + WS_LCI);
    float h = 0.f;
#pragma unroll 4
    for (int n = 0; n < 68; ++n) { const int ct = n < 4 ? 256 + b * 4 + (dir ? 3 - n : n) : b * 64 + (dir ? 63 - (n - 4) : (n - 4)); const size_t o = ((size_t)dir * NCT + ct) * 512 + ch;
        CI[o] = h; h = CA[o] * h + CH[o]; }
}
__device__ __forceinline__ void lru_fin(Frame& F, int l) {
    const int nrows = (l == 0) ? NTOK : NLAT;
    const bf16* P = (const bf16*)(F.ws + WS_P); bf16* CC = (bf16*)(F.ws + WS_CC);
    const bf16* HL = (const bf16*)(F.ws + WS_LRH); const bf16* AC = (const bf16*)(F.ws + WS_LRA); const float* CI = (const float*)(F.ws + WS_LCI);
    for (size_t i = (size_t)F.bid * NTHREADS + F.tid; i < (size_t)nrows * 128; i += (size_t)F.G * NTHREADS) { const int m = (int)(i >> 7), c4 = (int)(i & 127) * 4, ct = m >> 6;
        const v2u hw0 = *(const v2u*)(HL + (size_t)m * 512 + c4), aw0 = *(const v2u*)(AC + (size_t)m * 512 + c4), hw1 = *(const v2u*)(HL + ((size_t)NTOK + m) * 512 + c4), aw1 = *(const v2u*)(AC + ((size_t)NTOK + m) * 512 + c4);
        const f32x4 h0 = {bflo(hw0.x), bfhi(hw0.x), bflo(hw0.y), bfhi(hw0.y)}, a0 = {bflo(aw0.x), bfhi(aw0.x), bflo(aw0.y), bfhi(aw0.y)}, h1 = {bflo(hw1.x), bfhi(hw1.x), bflo(hw1.y), bfhi(hw1.y)}, a1 = {bflo(aw1.x), bfhi(aw1.x), bflo(aw1.y), bfhi(aw1.y)};
        const f32x4 i0 = *(const f32x4*)(CI + (size_t)ct * 512 + c4), i1 = *(const f32x4*)(CI + ((size_t)NCT + ct) * 512 + c4);
        const f32x4 hs = (a0 * i0 + h0) + (a1 * i1 + h1); const v2u yw = *(const v2u*)(P + (size_t)m * PW + PC_LY + c4);
        v2u o; o.x = pk2(hs.x * gelu_tanh(bflo(yw.x)), hs.y * gelu_tanh(bfhi(yw.x))); o.y = pk2(hs.z * gelu_tanh(bflo(yw.y)), hs.w * gelu_tanh(bfhi(yw.y)));
        *(v2u*)(CC + (size_t)m * DM + 1536 + c4) = o; }
}

constexpr size_t WS_DNQ = WS_DNT;
constexpr size_t WS_BG = WS_DNS + 1 * MiB;
constexpr size_t WS_XC = WS_XS;

__device__ __forceinline__ void naive_prep(Frame& F, int l) {
    const bf16* P = (const bf16*)(F.ws + WS_P);
    const int gw = F.bid * NWAVES + F.wave, NGW = F.G * NWAVES;
#if !defined(USE_CHUNK_DN)
    {
        float* DNQ = (float*)(F.ws + WS_DNQ); float* BG = (float*)(F.ws + WS_BG);
        const float* cw = F.in[I_DNCW] + (size_t)l * 4 * 1536;
        for (int it = gw; it < NTOK * 4; it += NGW) {
            const int m = it >> 2, h = it & 3; int t, T, base; seq_of(m, t, T, base);
            float val[3][2];
#pragma unroll
            for (int part = 0; part < 3; ++part)
#pragma unroll
                for (int dd = 0; dd < 2; ++dd) { const int d = F.lane + 64 * dd, cch = part * 512 + h * 128 + d, col = PC_DQ + cch; float s = 0.f;
#pragma unroll
                    for (int j = 0; j < 4; ++j) { const int tt = t + j - 2; if (tt >= 0 && tt < T) s += cw[j * 1536 + cch] * bf2f(P[(size_t)(base + tt) * PW + col]); }
                    val[part][dd] = siluf_(s); }
            const float sq = wave_sum(val[0][0] * val[0][0] + val[0][1] * val[0][1]), sk = wave_sum(val[1][0] * val[1][0] + val[1][1] * val[1][1]);
            const float fq = 0.08838834764831845f / sqrtf(sq + EPS), fk = 1.0f / sqrtf(sk + EPS);
#pragma unroll
            for (int dd = 0; dd < 2; ++dd) { const int d = F.lane + 64 * dd; float* o = DNQ + (size_t)m * 1536 + h * 128 + d;
                o[0] = val[0][dd] * fq; o[512] = val[1][dd] * fk; o[1024] = val[2][dd]; }
            if (h == 0 && F.lane < 8) { const int dir = F.lane >> 2, hh = F.lane & 3;
                const float pb = bf2f(P[(size_t)m * PW + PC_BETA + F.lane]), pa = bf2f(P[(size_t)m * PW + PC_DEC + F.lane]);
                BG[m * 16 + F.lane] = sigmoidf_(pb);
                BG[m * 16 + 8 + F.lane] = -__expf(F.in[I_DNALOG][l * 8 + dir * 4 + hh]) * softplusf_(pa + F.in[I_DNDT][l * 8 + dir * 4 + hh]); }
        }
    }
#endif
#if !defined(USE_CHUNK_LRU)
    {
        LAS float* xc = (LAS float*)F.lds;
        float* A = (float*)(F.ws + WS_LRA); float* U = (float*)(F.ws + WS_LRH);
        const float* cw = F.in[I_LRCW] + (size_t)l * 4 * 512; const float* cb = F.in[I_LRCB] + l * 512;
        for (int m0 = F.bid * 8; m0 < NTOK; m0 += F.G * 8) {
            __syncthreads();
            for (int i = F.tid; i < 8 * 512; i += NTHREADS) { const int m = m0 + (i >> 9), ch = i & 511; int t, T, base; seq_of(m, t, T, base); float s = cb[ch];
#pragma unroll
                for (int j = 0; j < 4; ++j) { const int tt = t + j - 2; if (tt >= 0 && tt < T) s += cw[j * 512 + ch] * bf2f(P[(size_t)(base + tt) * PW + PC_LX + ch]); }
                xc[i] = s; }
            __syncthreads();
            for (int i = F.tid; i < 8 * 512 * 2; i += NTHREADS) { const int ch = i & 511, dir = (i >> 9) & 1, tk = i >> 10, m = m0 + tk, blk = ch >> 6, j = ch & 63;
                const float* wr = F.in[I_LRWR] + ((size_t)((l * 2 + dir) * 8 + blk)) * 4096 + j; const float* wi = F.in[I_LRWI] + ((size_t)((l * 2 + dir) * 8 + blk)) * 4096 + j;
                float sr = F.in[I_LRBR][(l * 2 + dir) * 512 + ch], si = F.in[I_LRBI][(l * 2 + dir) * 512 + ch];
#pragma unroll 8
                for (int ii = 0; ii < 64; ++ii) { const float x = xc[tk * 512 + blk * 64 + ii]; sr += x * wr[ii * 64]; si += x * wi[ii * 64]; }
                const float r = sigmoidf_(sr), ig = sigmoidf_(si); const float lam = F.in[I_LRLAM][(l * 2 + dir) * 512 + ch];
                const float logsig = -softplusf_(-lam);
                const float log_a = 8.0f * r * logsig; const float a = __expf(log_a);
                const float u = sqrtf(-expm1f(2.0f * log_a)) * (ig * xc[tk * 512 + ch]);
                A[((size_t)dir * NTOK + m) * 512 + ch] = a; U[((size_t)dir * NTOK + m) * 512 + ch] = u; }
        }
        __syncthreads();
    }
#endif
}

__device__ __forceinline__ void naive_attn_row(Frame& F, int l, int m, int hq) {
    const bf16* P = (const bf16*)(F.ws + WS_P); bf16* CC = (bf16*)(F.ws + WS_CC);
    const int d = F.lane, kvh = hq >> 2; int t, T, base; seq_of(m, t, T, base);
    const bool lat = m < NLAT; const int b = lat ? (m >> 12) : ((m - NLAT) >> 8);
    const int dd = d & 31, jf = dd & 15; const float inv = __powf(10000.0f, -(float)jf * (1.0f / 16.0f));
    const bool second = (dd >= 16), colhalf = (d >= 32);
    float q = bf2f(P[(size_t)m * PW + PC_Q + hq * 64 + d]);
    if (lat) { const float pos = (float)(colhalf ? (t & 63) : (t >> 6)); float sn, cs; sincosf(pos * inv, &sn, &cs); const float pr = __shfl_xor(q, 16); q = second ? (q * cs + pr * sn) : (q * cs - pr * sn); }
    q *= 0.125f;
    float mx = F.in[I_SINK][l * 16 + hq], den = 1.0f, acc = 0.f;
    if (lat) { const int t0 = t - 128 < 0 ? 0 : t - 128, t1 = t + 128 > SEQ - 1 ? SEQ - 1 : t + 128;
        for (int tk = t0; tk <= t1; ++tk) { const size_t r = (size_t)(base + tk) * PW; float k = bf2f(P[r + PC_K + kvh * 64 + d]); const float v = bf2f(P[r + PC_V + kvh * 64 + d]);
            const float pos = (float)(colhalf ? (tk & 63) : (tk >> 6)); float sn, cs; sincosf(pos * inv, &sn, &cs); const float pr = __shfl_xor(k, 16); k = second ? (k * cs + pr * sn) : (k * cs - pr * sn);
            const float s = wave_sum(q * k); const float mn = fmaxf(mx, s), f = __expf(mx - mn), p = __expf(s - mn); den = den * f + p; acc = acc * f + p * v; mx = mn; } }
    for (int c = 0; c < CTXL; ++c) { const size_t r = (size_t)(NLAT + b * CTXL + c) * PW; const float k = bf2f(P[r + PC_K + kvh * 64 + d]), v = bf2f(P[r + PC_V + kvh * 64 + d]);
        const float s = wave_sum(q * k); const float mn = fmaxf(mx, s), f = __expf(mx - mn), p = __expf(s - mn); den = den * f + p; acc = acc * f + p * v; mx = mn; }
    CC[(size_t)m * DM + hq * 64 + d] = (bf16)f2bf(acc / den);
}

__device__ __forceinline__ int scan_row(int n, int b, int dir) { if (n < CTXL) { const int t = dir ? (CTXL - 1 - n) : n; return NLAT + b * CTXL + t; } const int t = dir ? (SEQ - 1 - (n - CTXL)) : (n - CTXL); return b * SEQ + t; }
__device__ __forceinline__ void naive_scan(Frame& F, int l, int rep = 0) {
#if defined(USE_CHUNK_DN)
    if (F.bid < 64) { dn_scan(F, l, F.bid >> 4, (F.bid >> 2) & 3, (F.bid >> 1) & 1, F.bid & 1); }
#else
    if (F.bid < 32) {
        const int b = F.bid >> 3, h = (F.bid >> 1) & 3, dir = F.bid & 1, dvc = F.tid & 127, kq = F.tid >> 7;
        const float* DNQ = (const float*)(F.ws + WS_DNQ); const float* BG = (const float*)(F.ws + WS_BG); float* O = (float*)(F.ws + WS_DNO);
        LAS float* buf = (LAS float*)F.lds;
        LAS float* red = buf + 768;
        LAS float* red2 = red + 512;
        float S[32];
#pragma unroll
        for (int i = 0; i < 32; ++i) S[i] = 0.f;
        constexpr int NT = CTXL + SEQ;
        { const int m = scan_row(0, b, dir); if (F.tid < 384) buf[F.tid] = DNQ[(size_t)m * 1536 + (F.tid >> 7) * 512 + h * 128 + (F.tid & 127)]; }
        __syncthreads();
#pragma unroll 1
        for (int n = 0; n < NT; ++n) {
            const int m = scan_row(n, b, dir); const LAS float* cur = buf + (n & 1) * 384;
            float nextv = 0.f; if (n + 1 < NT && F.tid < 384) { const int m2 = scan_row(n + 1, b, dir); nextv = DNQ[(size_t)m2 * 1536 + (F.tid >> 7) * 512 + h * 128 + (F.tid & 127)]; }
            const float beta = BG[m * 16 + dir * 4 + h], decay = __expf(BG[m * 16 + 8 + dir * 4 + h]);
            float ks = 0.f;
#pragma unroll
            for (int i = 0; i < 32; ++i) ks += cur[128 + kq * 32 + i] * S[i];
            red[kq * 128 + dvc] = ks;
            __syncthreads();
            const float kS = (red[dvc] + red[128 + dvc]) + (red[256 + dvc] + red[384 + dvc]);
            const float upd = beta * (cur[256 + dvc] - decay * kS);
            float os = 0.f;
#pragma unroll
            for (int i = 0; i < 32; ++i) { S[i] = decay * S[i] + cur[128 + kq * 32 + i] * upd; os += cur[kq * 32 + i] * S[i]; }
            red2[kq * 128 + dvc] = os;
            if (F.tid < 384) buf[((n + 1) & 1) * 384 + F.tid] = nextv;
            __syncthreads();
            if (kq == 0) O[((size_t)dir * NTOK + m) * 512 + h * 128 + dvc] = (red2[dvc] + red2[128 + dvc]) + (red2[256 + dvc] + red2[384 + dvc]);
        }
    }
#endif
#if defined(USE_CHUNK_LRU)
    else if (F.bid < 72) { lru_carry(F, (F.bid - 64) * NTHREADS + F.tid); }
#else
    else if (F.bid < 40) {
        const int idx = (F.bid - 32) * NTHREADS + F.tid, ch = idx & 511, dir = (idx >> 9) & 1, b = idx >> 10;
        const float* A = (const float*)(F.ws + WS_LRA); float* U = (float*)(F.ws + WS_LRH);
        float hs = 0.f;
#pragma unroll 4
        for (int n = 0; n < CTXL + SEQ; ++n) { int m; if (n < CTXL) { const int t = dir ? (CTXL - 1 - n) : n; m = NLAT + b * CTXL + t; } else { const int t = dir ? (SEQ - 1 - (n - CTXL)) : (n - CTXL); m = b * SEQ + t; }
            const size_t o = ((size_t)dir * NTOK + m) * 512 + ch; hs = A[o] * hs + U[o]; U[o] = hs; }
    }
#endif
#if defined(USE_MFMA_ATTN)
    attn_phase(F, l, rep);
    convert_moe_queue(F, l, rep);
#else
    {
        const int nrows = (l == 0) ? NTOK : NLAT;
        for (;;) { int m = 0; if (F.lane == 0) m = (int)__hip_atomic_fetch_add(F.ctl + CW_ATQ + 64 * l, 1u, RLX_AGENT); m = __builtin_amdgcn_readfirstlane(m);
            if (m >= nrows) break;
#pragma unroll 1
            for (int hq = 0; hq < 16; ++hq) naive_attn_row(F, l, m, hq); }
    }
#endif
}

__device__ __forceinline__ void naive_fin(Frame& F, int l) {
    const int nrows = (l == 0) ? NTOK : NLAT;
    const bf16* P = (const bf16*)(F.ws + WS_P); bf16* CC = (bf16*)(F.ws + WS_CC);
    const int gw = F.bid * NWAVES + F.wave, NGW = F.G * NWAVES;
    const float* O = (const float*)(F.ws + WS_DNO); const float* HS = (const float*)(F.ws + WS_LRH);
    for (int it0 = gw * 2; it0 < nrows * 4; it0 += NGW * 2) {
        float2 oa[2], ob[2]; unsigned gw_[2];
#pragma unroll
        for (int k = 0; k < 2; ++k) { const int it = it0 + k, m = it >> 2, h = it & 3; const int c = h * 128 + 2 * F.lane;
            oa[k] = *(const float2*)(O + (size_t)m * 512 + c); ob[k] = *(const float2*)(O + ((size_t)NTOK + m) * 512 + c); gw_[k] = *(const unsigned*)(P + (size_t)m * PW + PC_DG + c); }
        const float2 ng = *(const float2*)(F.in[I_DNNG] + l * 128 + 2 * F.lane);
#pragma unroll
        for (int k = 0; k < 2; ++k) { const int it = it0 + k, m = it >> 2, h = it & 3; const float o0 = oa[k].x + ob[k].x, o1 = oa[k].y + ob[k].y;
            const float rstd = 1.0f / sqrtf(wave_sum(o0 * o0 + o1 * o1) * (1.0f / 128.0f) + EPS);
            *(unsigned*)(CC + (size_t)m * DM + 1024 + h * 128 + 2 * F.lane) = pk2(o0 * rstd * ng.x * siluf_(bflo(gw_[k])), o1 * rstd * ng.y * siluf_(bfhi(gw_[k]))); }
    }
#if defined(USE_CHUNK_LRU)
    lru_fin(F, l);
#else
    for (size_t i = (size_t)F.bid * NTHREADS + F.tid; i < (size_t)nrows * 512; i += (size_t)F.G * NTHREADS) { const int m = (int)(i >> 9), ch = (int)(i & 511);
        const float hsum = HS[(size_t)m * 512 + ch] + HS[((size_t)NTOK + m) * 512 + ch]; const float y = bf2f(P[(size_t)m * PW + PC_LY + ch]);
        CC[(size_t)m * DM + 1536 + ch] = (bf16)f2bf(hsum * gelu_tanh(y)); }
#endif
}
#ifndef PHASE_PREP
#if defined(USE_MFMA_ATTN)
#if defined(USE_CHUNK_DN)
#define PHASE_PREP(F, l) do { attn_prep(F, l); lru_prep(F, l); dn_prep(F, l); } while (0)
#else
#define PHASE_PREP(F, l) do { naive_prep(F, l); attn_prep(F, l); } while (0)
#endif
#else
#define PHASE_PREP(F, l) naive_prep(F, l)
#endif
#endif
#ifndef PHASE_SCAN
#define PHASE_SCAN(F, l) naive_scan(F, l)
#endif
#ifndef PHASE_FIN
#define PHASE_FIN(F, l) naive_fin(F, l)
#endif

#ifndef PHASE_INPROJ
#define PHASE_INPROJ(F, l) do {} while (0)
#endif
#ifndef PHASE_PREP
#define PHASE_PREP(F, l) do {} while (0)
#endif
#ifndef PHASE_SCAN
#define PHASE_SCAN(F, l) do {} while (0)
#endif
#ifndef PHASE_FIN
#define PHASE_FIN(F, l) do {} while (0)
#endif
#ifndef PHASE_OUTPROJ
#define PHASE_OUTPROJ(F, l) do {} while (0)
#endif
#ifndef PHASE_NORM2
#define PHASE_NORM2(F, l) do {} while (0)
#endif
#ifndef PHASE_SCATTER
#define PHASE_SCATTER(F, l) do {} while (0)
#endif
#ifndef PHASE_GEMM1
#define PHASE_GEMM1(F, l) do {} while (0)
#endif
#ifndef PHASE_GEMM2
#define PHASE_GEMM2(F, l) do {} while (0)
#endif

#ifndef MK_SPLIT
#define MK_SPLIT 0
#endif
#ifndef MK_STAGE
#define MK_STAGE 99
#endif
#ifndef MK_TAILFILL
#define MK_TAILFILL 0
#endif
#ifndef MK_DUP
#define MK_DUP 0
#endif
#define DUP(k) ((MK_DUP >> (k)) & 1)
constexpr int N_PHASES = 22;
struct Args { const float* in[N_IN]; float* out; unsigned char* ws; int ph_lo, ph_hi; };
static_assert(sizeof(Args) == (N_IN + 2) * 8 + 8, "Args has no padding");

__global__ void __launch_bounds__(NTHREADS, 2) fwd_kernel(Args args) {
    extern __shared__ __attribute__((aligned(16))) unsigned char lds[];
    Frame F;
    F.lds = (LAS unsigned char*)lds;
    F.MISC = (volatile LAS unsigned*)(F.lds + MISC_OFF);
    F.tid = threadIdx.x; F.lane = F.tid & 63; F.wave = __builtin_amdgcn_readfirstlane(F.tid >> 6);
    F.G = gridDim.x; F.bid = blockIdx.x;
    F.ws = args.ws; F.out = args.out; F.ctl = (gu32*)(args.ws + WS_CTL);
    F.in = (const float* const __attribute__((address_space(4)))*)__builtin_amdgcn_kernarg_segment_ptr();
    for (int u = F.tid; u < (LDS_BYTES - LDSCTL_OFF) / 4; u += NTHREADS) ((LAS unsigned*)(F.lds + LDSCTL_OFF))[u] = 0u;
    __syncthreads();
    XcdBarrier bar; bar.bar = (unsigned*)(F.ctl + CW_BAR); bar.x = 0; bar.st = nullptr;
    if (!MK_SPLIT) bar = xcd_barrier_post((unsigned*)(F.ctl + CW_BAR), F.MISC + 8);
    const int lo = args.ph_lo, hi = args.ph_hi;
#define IN(k) (lo <= (k) && (k) < hi && phase_enter(F))
#define INR(k) (lo <= (k) && (k) < hi)
#define SEAM(k) do { if (INR(k) && INR((k) + 1)) { if (MK_TAILFILL && (k) < 14) tail_fill(F, (k), (k) < 4 ? 0 : 1); xcd_barrier(bar); } } while (0)

    if (IN(0)) { p0_prologue(F); if (DUP(0)) { __syncthreads(); p0_prologue(F); } } SEAM(0);
#pragma unroll 1
    for (int l = 0; l < DEPTH; ++l) {
        const int pb = 1 + 10 * l;
        if (IN(pb + 0)) { phase_norm1(F, l); if (DUP(13) && l == 0) { __syncthreads(); phase_norm1(F, l); } } SEAM(pb + 0);
        if (IN(pb + 1)) { PHASE_INPROJ(F, l); if (DUP(1)) { __syncthreads(); PHASE_INPROJ(F, l); } } SEAM(pb + 1);
        if (IN(pb + 2)) { PHASE_PREP(F, l); if (DUP(2)) { __syncthreads(); dn_prep(F, l); } if (DUP(6)) { __syncthreads(); lru_prep(F, l); } } SEAM(pb + 2);
        if (IN(pb + 3)) { if (DUP(3) && F.bid < 64) dn_scan(F, l, F.bid >> 4, (F.bid >> 2) & 3, (F.bid >> 1) & 1, F.bid & 1); PHASE_SCAN(F, l); if (DUP(10)) { __syncthreads(); naive_scan(F, l, 1); } if (DUP(11)) { __syncthreads(); attn_phase(F, l, 2); } if (DUP(12)) { __syncthreads(); convert_moe_queue(F, l, 3); } } SEAM(pb + 3);
        if (IN(pb + 4)) { PHASE_FIN(F, l); if (DUP(4)) { __syncthreads(); PHASE_FIN(F, l); } } SEAM(pb + 4);
        if (IN(pb + 5)) { PHASE_OUTPROJ(F, l); if (DUP(5) && l == 0) { __syncthreads(); PHASE_OUTPROJ(F, l); } } SEAM(pb + 5);
        if (IN(pb + 6)) { PHASE_NORM2(F, l); } SEAM(pb + 6);
        if (IN(pb + 7)) { PHASE_SCATTER(F, l); if (DUP(7)) { __syncthreads(); PHASE_SCATTER(F, l); } } SEAM(pb + 7);
        if (IN(pb + 8)) { PHASE_GEMM1(F, l); if (DUP(8)) { __syncthreads(); PHASE_GEMM1(F, l); } } SEAM(pb + 8);
        if (IN(pb + 9)) { PHASE_GEMM2(F, l); if (DUP(9)) { __syncthreads(); PHASE_GEMM2(F, l); } } SEAM(pb + 9);
    }
    if (IN(21)) { phase_final(F, MK_STAGE >= 9); if (DUP(13)) { __syncthreads(); phase_final(F, MK_STAGE >= 9); } }
#undef IN
#undef SEAM
}

extern "C" void kernel_launch(void* const* d_in, const int* in_sizes, int n_in, void* d_out, int out_size, void* d_ws, size_t ws_size, hipStream_t stream) {
    static int grid = 0;
    if (grid == 0) {
        if (n_in != N_IN || out_size != NLAT * DM || ws_size < WS_END) { fprintf(stderr, "kernel_launch: unexpected shapes (n_in %d, out %d, ws %zu); nothing launched\n", n_in, out_size, ws_size); grid = -1; return; }
        int dev = 0, cus = 0, per_cu = 0;
        if (hipGetDevice(&dev) != hipSuccess || hipDeviceGetAttribute(&cus, hipDeviceAttributeMultiprocessorCount, dev) != hipSuccess) { grid = -1; return; }
        if (hipFuncSetAttribute((const void*)fwd_kernel, hipFuncAttributeMaxDynamicSharedMemorySize, LDS_BYTES) != hipSuccess) { fprintf(stderr, "kernel_launch: hipFuncSetAttribute failed\n"); grid = -1; return; }
        if (hipOccupancyMaxActiveBlocksPerMultiprocessor(&per_cu, (const void*)fwd_kernel, NTHREADS, LDS_BYTES) != hipSuccess || per_cu < 1) { fprintf(stderr, "kernel_launch: occupancy query says %d\n", per_cu); }
        (void)hipGetLastError();
        grid = cus;
        if (grid != 256) { fprintf(stderr, "kernel_launch: built for 256 CUs, device has %d; nothing launched\n", cus); grid = -1; return; }
    }
    if (grid < 0) return;
    if (hipMemsetAsync((char*)d_ws + WS_CTL, 0, CTL_ZERO_BYTES, stream) != hipSuccess) return;
    Args a{};
    for (int i = 0; i < N_IN; ++i) a.in[i] = (const float*)d_in[i];
    a.out = (float*)d_out; a.ws = (unsigned char*)d_ws;
#if MK_SPLIT
    for (int p = 0; p < N_PHASES; ++p) { a.ph_lo = p; a.ph_hi = p + 1; hipLaunchKernelGGL(fwd_kernel, dim3(grid), dim3(NTHREADS), LDS_BYTES, stream, a); }
#else
    a.ph_lo = 0; a.ph_hi = N_PHASES;
    hipLaunchKernelGGL(fwd_kernel, dim3(grid), dim3(NTHREADS), LDS_BYTES, stream, a);
#endif
    const hipError_t le = hipPeekAtLastError();
    if (le != hipSuccess) fprintf(stderr, "kernel_launch: launch failed: %s\n", hipGetErrorName(le));
}
```

```cpp
#include <hip/hip_runtime.h>
#include <cstdio>
#include <cstdint>

constexpr int DM = 2048, NB = 4, SEQ = 4096, CTXL = 256, DEPTH = 2;
constexpr int NLAT = NB * SEQ, NCTX = NB * CTXL, NTOK = NLAT + NCTX;
constexpr int NCT = NTOK / 64;
constexpr int IN_W = 4624, PW = 4864;
constexpr int PC_Q = 0, PC_K = 1024, PC_V = 1280, PC_DQ = 1536, PC_DK = 2048, PC_DV = 2560, PC_DG = 3072, PC_LX = 3584, PC_LY = 4096, PC_BETA = 4608, PC_DEC = 4616;
constexpr int NEXP = 32, TOPK = 4, DEXP = 1024;
constexpr int MOE_ROWS = 304 * 256;
constexpr float EPS = 1e-6f;
#ifndef MK_STAGE
#define MK_STAGE 99
#endif
namespace pg8 {
#define PG8_LAS __attribute__((address_space(3)))
typedef unsigned short bf16_t;
typedef short bf16x8 __attribute__((ext_vector_type(8)));
typedef float f32x4 __attribute__((ext_vector_type(4)));
typedef unsigned u32x4 __attribute__((ext_vector_type(4)));
typedef float f32x2 __attribute__((ext_vector_type(2)));
constexpr int BM = 256, BK = 64, HALF = 128, HTB = HALF * BK * 2  , STAGE_BYTES = 8 * HTB, NXCD = 8, WGM = 8;

__host__ __device__ __forceinline__ int lds_byte(int r, int c) { const int st = (r >> 4) * 2 + (c >> 5), rr = r & 15, cc = c & 31, ob = rr * 64 + cc * 2; return st * 1024 + (ob ^ (((ob >> 9) & 1) << 5)); }
__host__ __device__ __forceinline__ void stage_rc(int b, int& R, int& C) { const int st = b / 1024, sb = b % 1024, swz = sb ^ (((sb >> 9) & 1) << 5); R = (st >> 1) * 16 + swz / 64; C = (st & 1) * 32 + (swz % 64) / 2; }
__host__ __device__ __forceinline__ int perm32(int rho) { const int n = rho >> 4, i = rho & 15; return 8 * (i >> 2) + 4 * n + (i & 3); }

struct Unit { int pm, pn, e; };
struct Gemm { const bf16_t* A; const bf16_t* Bt; int M, N, K; };

struct StaticOrder {
    static constexpr bool GATHER = false; const int* row_tab = nullptr;
    int nM, nN, nwg, G, c; const char* A; const char* Bt; size_t tstep;
    __device__ void init(const Gemm& g, int G_, int c_) { nM = g.M / BM; nN = g.N / BM; nwg = nM * nN; G = G_; c = c_; A = (const char*)g.A; Bt = (const char*)g.Bt; tstep = (size_t)BM * g.K * 2; }
    __device__ bool next(int i, Unit& u) const {
        const long L = (long)i * G + c; if (L >= nwg) return false;
        int wgid = (int)L; { const int q = nwg / NXCD, r = nwg % NXCD, xcd = wgid % NXCD, off = wgid / NXCD; wgid = (xcd < r ? xcd * (q + 1) : r * (q + 1) + (xcd - r) * q) + off; }
        const int nig = WGM * nN, gid = wgid / nig, fm = gid * WGM, gsz = (nM - fm) < WGM ? (nM - fm) : WGM;
        u.pm = fm + ((wgid % nig) % gsz); u.pn = (wgid % nig) / gsz; u.e = 0; return true;
    }
    __device__ __forceinline__ const char* a_ptr(const Unit& u) const { return A + (size_t)u.pm * tstep; }
    __device__ __forceinline__ const char* b_ptr(const Unit& u) const { return Bt + (size_t)u.pn * tstep; }
    __device__ __forceinline__ void a_ready(const Unit&) const {}
    __device__ __forceinline__ void done(const Unit&) const {}
};
__device__ __forceinline__ unsigned cvt_pk_bf16(float lo, float hi) { unsigned r; asm volatile("v_cvt_pk_bf16_f32 %0, %1, %2" : "=v"(r) : "v"(lo), "v"(hi)); return r; }
struct EpiBf16Plain {
    static constexpr bool PERM = true, AFTER_DRAIN = false;
    bf16_t* O; int ldc;
    __device__ __forceinline__ void operator()(const f32x4 (&acc)[2][2][4][2], const Unit& u, int wr, int wc, int fr, int fq) const {
        const int row0 = u.pm * BM + wr * 64 + fr, col0 = u.pn * BM + wc * 32 + 8 * fq;
#pragma unroll
        for (int ai = 0; ai < 2; ++ai)
#pragma unroll
            for (int m = 0; m < 4; ++m) { bf16_t* rowp = O + (size_t)(row0 + ai * HALF + m * 16) * ldc + col0;
#pragma unroll
                for (int bj = 0; bj < 2; ++bj) { const f32x4 v0 = acc[ai][bj][m][0], v1 = acc[ai][bj][m][1];
                    u32x4 w; w.x = cvt_pk_bf16(v0[0], v0[1]); w.y = cvt_pk_bf16(v0[2], v0[3]); w.z = cvt_pk_bf16(v1[0], v1[1]); w.w = cvt_pk_bf16(v1[2], v1[3]);
                    *(u32x4*)(rowp + bj * HALF) = w; } }
    }
};
struct EpiResGate {
    static constexpr bool PERM = false, AFTER_DRAIN = false;
    const float* base_lat; const float* base_ctx; float* out; const float* modg;
    __device__ __forceinline__ void operator()(const f32x4 (&acc)[2][2][4][2], const Unit& u, int wr, int wc, int fr, int fq) const {
        const int r = u.pm < 64 ? (u.pm >> 4) : 4; const int col0 = u.pn * BM + wc * 32 + 4 * fq;
        const float* g = modg + (size_t)r * 12288 + col0;
        f32x4 gv[2][2];
#pragma unroll
        for (int bj = 0; bj < 2; ++bj)
#pragma unroll
            for (int n = 0; n < 2; ++n) gv[bj][n] = *(const f32x4*)(g + bj * HALF + n * 16);
#pragma unroll
        for (int ai = 0; ai < 2; ++ai)
#pragma unroll
            for (int m = 0; m < 4; ++m) { const int row = u.pm * BM + ai * HALF + wr * 64 + m * 16 + fr;
                const float* bp = (row < 16384 ? base_lat + (size_t)row * 2048 : base_ctx + (size_t)(row - 16384) * 2048) + col0; float* op = out + (size_t)row * 2048 + col0;
#pragma unroll
                for (int bj = 0; bj < 2; ++bj)
#pragma unroll
                    for (int n = 0; n < 2; ++n) { const f32x4 b = *(const f32x4*)(bp + bj * HALF + n * 16); *(f32x4*)(op + bj * HALF + n * 16) = b + gv[bj][n] * acc[ai][bj][m][n]; }
                asm volatile("" ::: "memory"); }
    }
};
struct EpiSwiglu {
    static constexpr bool PERM = true, AFTER_DRAIN = false;
    bf16_t* O; const float* bgu;
    __device__ __forceinline__ void operator()(const f32x4 (&acc)[2][2][4][2], const Unit& u, int wr, int wc, int fr, int fq) const {
        const int row0 = u.pm * BM + wr * 64 + fr, cc0 = wc * 32 + 8 * fq;
        const float* bg = bgu + (size_t)u.e * 2048 + u.pn * 128 + cc0;
        f32x4 bglu[2], blin[2];
#pragma unroll
        for (int n = 0; n < 2; ++n) { bglu[n] = *(const f32x4*)(bg + 4 * n); blin[n] = *(const f32x4*)(bg + 1024 + 4 * n); }
#pragma unroll
        for (int ai = 0; ai < 2; ++ai)
#pragma unroll
            for (int m = 0; m < 4; ++m) { bf16_t* rowp = O + (size_t)(row0 + ai * HALF + m * 16) * 1024 + u.pn * 128 + cc0;
                float r[8];
#pragma unroll
                for (int n = 0; n < 2; ++n) { const f32x4 g = acc[ai][0][m][n] + bglu[n], l = acc[ai][1][m][n] + blin[n];
#pragma unroll
                    for (int i = 0; i < 4; ++i) { const float gg = fminf(g[i], 7.0f); const float ll = fminf(fmaxf(l[i], -7.0f), 7.0f);
                        r[4 * n + i] = (ll + 1.0f) * gg * __builtin_amdgcn_rcpf(1.0f + __builtin_amdgcn_exp2f(-1.702f * 1.4426950408889634f * gg)); } }
                u32x4 w; w.x = cvt_pk_bf16(r[0], r[1]); w.y = cvt_pk_bf16(r[2], r[3]); w.z = cvt_pk_bf16(r[4], r[5]); w.w = cvt_pk_bf16(r[6], r[7]);
                *(u32x4*)rowp = w; }
    }
};
struct EpiDown {
    static constexpr bool PERM = true, AFTER_DRAIN = false;
    bf16_t* O; const float* bdn; const float* rowg;
    __device__ __forceinline__ void operator()(const f32x4 (&acc)[2][2][4][2], const Unit& u, int wr, int wc, int fr, int fq) const {
        const int row0 = u.pm * BM + wr * 64 + fr, col0 = u.pn * BM + wc * 32 + 8 * fq;
        const float* bb = bdn + (size_t)u.e * 2048 + col0;
        f32x4 bv[2][2];
#pragma unroll
        for (int bj = 0; bj < 2; ++bj)
#pragma unroll
            for (int n = 0; n < 2; ++n) bv[bj][n] = *(const f32x4*)(bb + bj * HALF + 4 * n);
#pragma unroll
        for (int ai = 0; ai < 2; ++ai)
#pragma unroll
            for (int m = 0; m < 4; ++m) { const int row = row0 + ai * HALF + m * 16; const float gt = rowg[row]; bf16_t* rowp = O + (size_t)row * 2048 + col0;
#pragma unroll
                for (int bj = 0; bj < 2; ++bj) { const f32x4 v0 = (acc[ai][bj][m][0] + bv[bj][0]) * gt, v1 = (acc[ai][bj][m][1] + bv[bj][1]) * gt;
                    u32x4 w; w.x = cvt_pk_bf16(v0[0], v0[1]); w.y = cvt_pk_bf16(v0[2], v0[3]); w.z = cvt_pk_bf16(v1[0], v1[1]); w.w = cvt_pk_bf16(v1[2], v1[3]);
                    *(u32x4*)(rowp + bj * HALF) = w; } }
    }
};
template <bool GATHER_> struct MoeOrderT {
    static constexpr bool GATHER = GATHER_;
    int c, nblk; const char* A; const char* Bt; size_t a_tstep, b_estep, b_tstep; const PG8_LAS int* blk_end; const int* row_tab;
    __device__ __forceinline__ bool next(int i, Unit& u) const {
#if defined(MOE_MAP) && MOE_MAP == 1
        const int L = i * 256 + c, rb = L >> 3, j = (L & 7);
#elif defined(MOE_MAP) && MOE_MAP == 2
        const int x = c & 7, jj = c >> 3, gi = i * 8 + x, rb = 8 * (gi >> 1) + (jj >> 2), j = (jj & 3) + 4 * (gi & 1);
#else
        const int x = c & 7, j = c >> 3, gi = i * 8 + x, rb = 4 * gi + (j >> 3);
#endif
        if (rb >= nblk) return false;
        int e = 0;
        for (int k = 0; k < 31; ++k) e += (rb >= blk_end[k]) ? 1 : 0;
        u.pm = rb; u.pn = j & 7; u.e = __builtin_amdgcn_readfirstlane(e); return true;
    }
    __device__ __forceinline__ const char* a_ptr(const Unit& u) const { return GATHER ? A : A + (size_t)u.pm * a_tstep; }
    __device__ __forceinline__ const char* b_ptr(const Unit& u) const { return Bt + (size_t)u.e * b_estep + (size_t)u.pn * b_tstep; }
    __device__ __forceinline__ void a_ready(const Unit&) const {}
    __device__ __forceinline__ void done(const Unit&) const {}
};
typedef MoeOrderT<false> MoeOrder;
typedef MoeOrderT<true> MoeOrderG;
template <class Epi, class Sched, bool ALIGN_EPI = false, bool SP2 = false>
__device__ __forceinline__ void gemm_phase(PG8_LAS unsigned char* lds, const Gemm g, const Sched& S, const Epi& E) {
    int tid = threadIdx.x; asm volatile("" : "+v"(tid));
    const int wid = __builtin_amdgcn_readfirstlane(tid >> 6), lane = tid & 63, wr = wid >> 2, wc = wid & 3, fr = lane & 15, fq = lane >> 4;
    const int K = g.K, nt = K / BK;
    unsigned voffA[2], voffB[2];
#pragma unroll
    for (int i = 0; i < 2; ++i) { int R, C; stage_rc(tid * 16 + i * 8192, R, C); const int Rb = Epi::PERM ? ((R & ~31) + perm32(R & 31)) : R;
        voffA[i] = (unsigned)(R * K + C) * 2u; voffB[i] = (unsigned)(Rb * K + C) * 2u; }
    unsigned gc0[2] = {0u, 0u}, gc1[2] = {0u, 0u}; int gR = 0, gC = 0;
    if constexpr (Sched::GATHER) { stage_rc(tid * 16, gR, gC); }
#define PG8_GLOAD(dst0, dst1, u) do { const int* _rt = S.row_tab + (size_t)(u).pm * BM + gR; \
        dst0[0] = (unsigned)_rt[0] * (unsigned)(K * 2) + (unsigned)(gC * 2); dst0[1] = (unsigned)_rt[64] * (unsigned)(K * 2) + (unsigned)(gC * 2); \
        dst1[0] = (unsigned)_rt[128] * (unsigned)(K * 2) + (unsigned)(gC * 2); dst1[1] = (unsigned)_rt[192] * (unsigned)(K * 2) + (unsigned)(gC * 2); } while (0)
    const size_t kstep = (size_t)(BK * 2);
    const size_t hstep = (size_t)HALF * K * 2;
    const size_t tstep = 2 * hstep;
    const unsigned ldsw = (unsigned)wid * 1024u;
    const int aoff = lds_byte(wr * 64 + fr, fq * 8), boff = lds_byte(wc * 32 + fr, fq * 8);
#define PG8_SA(b, h) (((b) * 2 + (h)) * HTB)
#define PG8_SB(b, h) ((4 + (b) * 2 + (h)) * HTB)
#define PG8_STAGE(bufoff, gbase, voff) do { _Pragma("unroll") for (int _i = 0; _i < 2; ++_i) \
        __builtin_amdgcn_global_load_lds((const unsigned*)((const char*)(gbase) + (voff)[_i]), (PG8_LAS unsigned*)(lds + (bufoff) + ldsw + _i * 8192), 16, 0, 0); } while (0)
#define PG8_LDA(dst, b, h) do { _Pragma("unroll") for (int m = 0; m < 4; ++m) _Pragma("unroll") for (int k = 0; k < 2; ++k) dst[m][k] = *(const PG8_LAS bf16x8*)(lds + PG8_SA(b, h) + aoff + m * 2048 + k * 1024); } while (0)
#define PG8_LDB(dst, b, h) do { _Pragma("unroll") for (int n = 0; n < 2; ++n) _Pragma("unroll") for (int k = 0; k < 2; ++k) dst[n][k] = *(const PG8_LAS bf16x8*)(lds + PG8_SB(b, h) + boff + n * 2048 + k * 1024); } while (0)
#define PG8_MMA(ai, bj, At, Bt) do { __builtin_amdgcn_s_setprio(1); _Pragma("unroll") for (int m = 0; m < 4; ++m) _Pragma("unroll") for (int n = 0; n < 2; ++n) _Pragma("unroll") for (int k = 0; k < 2; ++k) \
        acc[ai][bj][m][n] = __builtin_amdgcn_mfma_f32_16x16x32_bf16(Bt[n][k], At[m][k], acc[ai][bj][m][n], 0, 0, 0); __builtin_amdgcn_s_setprio(0); } while (0)
#define PG8_WAIT_V(n) asm volatile("s_waitcnt vmcnt(" #n ")" ::: "memory")
#define PG8_WAIT_L(n) asm volatile("s_waitcnt lgkmcnt(" #n ")" ::: "memory")
#define PG8_BAR __builtin_amdgcn_s_barrier()
#define PG8_SCHED __builtin_amdgcn_sched_barrier(0)
    Unit cur, nxt; int ui = 0;
    if (!S.next(0, cur)) return;
    f32x4 acc[2][2][4][2];
#pragma unroll
    for (int a = 0; a < 2; ++a)
#pragma unroll
        for (int b = 0; b < 2; ++b)
#pragma unroll
            for (int m = 0; m < 4; ++m)
#pragma unroll
                for (int n = 0; n < 2; ++n) acc[a][b][m][n] = (f32x4){0.f, 0.f, 0.f, 0.f};
    bf16x8 At[4][2], B0[2][2], B1[2][2];
    const char* cA = S.a_ptr(cur); const char* cB = S.b_ptr(cur);
    S.a_ready(cur);
    if constexpr (SP2) {
        if constexpr (Sched::GATHER) { PG8_GLOAD(gc0, gc1, cur);
        PG8_STAGE(PG8_SB(0, 0), cB, voffB); PG8_STAGE(PG8_SB(0, 1), cB + hstep, voffB); PG8_STAGE(PG8_SA(0, 0), cA, gc0); PG8_STAGE(PG8_SA(0, 1), cA, gc1);
        if (wr == 1) PG8_BAR;
        PG8_WAIT_V(2); PG8_BAR;
        PG8_STAGE(PG8_SB(1, 0), cB + kstep, voffB); PG8_STAGE(PG8_SA(1, 0), cA + kstep, gc0); PG8_STAGE(PG8_SB(1, 1), cB + hstep + kstep, voffB);
        } else {
        PG8_STAGE(PG8_SB(0, 0), cB, voffB); PG8_STAGE(PG8_SB(0, 1), cB + hstep, voffB); PG8_STAGE(PG8_SA(0, 0), cA, voffA); PG8_STAGE(PG8_SA(0, 1), cA + hstep, voffA);
        if (wr == 1) PG8_BAR;
        PG8_WAIT_V(2); PG8_BAR;
        PG8_STAGE(PG8_SB(1, 0), cB + kstep, voffB); PG8_STAGE(PG8_SA(1, 0), cA + kstep, voffA); PG8_STAGE(PG8_SB(1, 1), cB + hstep + kstep, voffB);
        }
        PG8_WAIT_V(6); PG8_BAR;
    } else {
        PG8_STAGE(PG8_SB(0, 0), cB, voffB); PG8_STAGE(PG8_SA(0, 0), cA, voffA); PG8_STAGE(PG8_SB(0, 1), cB + hstep, voffB); PG8_STAGE(PG8_SA(0, 1), cA + hstep, voffA);
        if (wr == 1) PG8_BAR;
        PG8_WAIT_V(4); PG8_BAR;
        PG8_STAGE(PG8_SB(1, 0), cB + kstep, voffB); PG8_STAGE(PG8_SA(1, 0), cA + kstep, voffA); PG8_STAGE(PG8_SB(1, 1), cB + hstep + kstep, voffB);
        PG8_WAIT_V(6); PG8_BAR;
    }
    for (;;) {
        const bool has_next = S.next(ui + 1, nxt);
        const char* nA = has_next ? S.a_ptr(nxt) : cA; const char* nB = has_next ? S.b_ptr(nxt) : cB;
        for (int t = 0; t < nt; t += 2) {
            const bool last = (t == nt - 2);
            const char* a1 = cA + (size_t)(t + 1) * kstep;
            const char* a2 = last ? nA : cA + (size_t)(t + 2) * kstep; const char* b2 = last ? nB : cB + (size_t)(t + 2) * kstep;
            const char* a3 = a2 + kstep; const char* b3 = b2 + kstep;
            if (last && has_next) S.a_ready(nxt);

            if constexpr (SP2) {
            PG8_LDB(B0, 0, 0); PG8_LDB(B1, 0, 1); PG8_SCHED; PG8_LDA(At, 0, 0); if constexpr (Sched::GATHER) PG8_STAGE(PG8_SA(1, 1), a1, gc1); else PG8_STAGE(PG8_SA(1, 1), a1 + hstep, voffA);
            if constexpr (Sched::GATHER) { if (last && has_next) PG8_GLOAD(gc0, gc1, nxt); }
            PG8_WAIT_V(8); PG8_WAIT_L(0); PG8_BAR; PG8_MMA(0, 0, At, B0); PG8_MMA(0, 1, At, B1); PG8_BAR; PG8_SCHED;
            PG8_LDA(At, 0, 1); PG8_STAGE(PG8_SB(0, 0), b2, voffB); PG8_STAGE(PG8_SB(0, 1), b2 + hstep, voffB); if constexpr (Sched::GATHER) PG8_STAGE(PG8_SA(0, 0), a2, gc0); else PG8_STAGE(PG8_SA(0, 0), a2, voffA);
            PG8_WAIT_V(8); PG8_WAIT_L(0); PG8_BAR; PG8_MMA(1, 0, At, B0); PG8_MMA(1, 1, At, B1); PG8_BAR; PG8_SCHED;
            PG8_LDB(B0, 1, 0); PG8_LDB(B1, 1, 1); PG8_SCHED; PG8_LDA(At, 1, 0); if constexpr (Sched::GATHER) PG8_STAGE(PG8_SA(0, 1), a2, gc1); else PG8_STAGE(PG8_SA(0, 1), a2 + hstep, voffA);
            PG8_WAIT_V(8); PG8_WAIT_L(0); PG8_BAR; PG8_MMA(0, 0, At, B0); PG8_MMA(0, 1, At, B1); PG8_BAR; PG8_SCHED;
            PG8_LDA(At, 1, 1); PG8_STAGE(PG8_SB(1, 0), b3, voffB); PG8_STAGE(PG8_SB(1, 1), b3 + hstep, voffB); if constexpr (Sched::GATHER) PG8_STAGE(PG8_SA(1, 0), a3, gc0); else PG8_STAGE(PG8_SA(1, 0), a3, voffA);
            PG8_WAIT_V(8); PG8_WAIT_L(0); PG8_BAR; PG8_MMA(1, 0, At, B0); PG8_MMA(1, 1, At, B1); PG8_BAR; PG8_SCHED;
            } else {
            PG8_LDB(B0, 0, 0); PG8_SCHED; PG8_LDA(At, 0, 0); PG8_STAGE(PG8_SA(1, 1), a1 + hstep, voffA);
            PG8_WAIT_L(8); PG8_BAR; PG8_WAIT_L(0); PG8_MMA(0, 0, At, B0); PG8_BAR; PG8_SCHED;
            PG8_LDB(B1, 0, 1); PG8_STAGE(PG8_SB(0, 0), b2, voffB);
            PG8_BAR; PG8_WAIT_L(0); PG8_MMA(0, 1, At, B1); PG8_BAR;
            PG8_LDA(At, 0, 1); PG8_STAGE(PG8_SA(0, 0), a2, voffA);
            PG8_BAR; PG8_WAIT_L(0); PG8_MMA(1, 0, At, B0); PG8_BAR; PG8_SCHED;
            PG8_STAGE(PG8_SB(0, 1), b2 + hstep, voffB);
            PG8_WAIT_V(6); PG8_BAR; PG8_MMA(1, 1, At, B1); PG8_BAR;
            PG8_LDB(B0, 1, 0); PG8_SCHED; PG8_LDA(At, 1, 0); PG8_STAGE(PG8_SA(0, 1), a2 + hstep, voffA);
            PG8_WAIT_L(8); PG8_BAR; PG8_WAIT_L(0); PG8_MMA(0, 0, At, B0); PG8_BAR; PG8_SCHED;
            PG8_LDB(B1, 1, 1); PG8_STAGE(PG8_SB(1, 0), b3, voffB);
            PG8_BAR; PG8_WAIT_L(0); PG8_MMA(0, 1, At, B1); PG8_BAR;
            PG8_LDA(At, 1, 1); PG8_STAGE(PG8_SA(1, 0), a3, voffA);
            PG8_BAR; PG8_WAIT_L(0); PG8_MMA(1, 0, At, B0); PG8_BAR; PG8_SCHED;
            PG8_STAGE(PG8_SB(1, 1), b3 + hstep, voffB);
            PG8_WAIT_V(6); PG8_BAR; PG8_MMA(1, 1, At, B1); PG8_BAR;
            }
        }
        if constexpr (ALIGN_EPI) { if (wr == 0) PG8_BAR; }
        if constexpr (!Epi::AFTER_DRAIN) { int fr_e = fr, fq_e = fq; asm volatile("" : "+v"(fr_e), "+v"(fq_e));
            E(acc, cur, wr, wc, fr_e, fq_e); S.done(cur); }
        if (!has_next) break;
#pragma unroll
        for (int a = 0; a < 2; ++a)
#pragma unroll
            for (int b = 0; b < 2; ++b)
#pragma unroll
                for (int m = 0; m < 4; ++m)
#pragma unroll
                    for (int n = 0; n < 2; ++n) acc[a][b][m][n] = (f32x4){0.f, 0.f, 0.f, 0.f};
        cur = nxt; cA = nA; cB = nB; ++ui;
        if constexpr (ALIGN_EPI) { if (wr == 1) PG8_BAR; }
    }
    PG8_WAIT_V(0);
    if constexpr (!ALIGN_EPI) { if (wr == 0) PG8_BAR; }
    PG8_BAR;
    if constexpr (Epi::AFTER_DRAIN) { E.fused(acc, cur, wr, wc, fr, fq, lds, wid, lane); S.done(cur); }
#undef PG8_GLOAD
#undef PG8_SA
#undef PG8_SB
#undef PG8_STAGE
#undef PG8_LDA
#undef PG8_LDB
#undef PG8_MMA
#undef PG8_WAIT_V
#undef PG8_WAIT_L
#undef PG8_BAR
#undef PG8_SCHED
}
}

constexpr size_t MiB = 1u << 20;
constexpr size_t WS_CTL = 0, CTL_ZERO_BYTES = 1 * MiB;
constexpr size_t WS_MOD  = 1 * MiB;
constexpr size_t WS_WRT  = 2 * MiB;
constexpr size_t WS_MOEI = 3 * MiB;
constexpr size_t WS_LRC  = 6 * MiB;
constexpr size_t WS_DNS  = 12 * MiB;
constexpr size_t WS_WIN  = 16 * MiB;
constexpr size_t WS_WOUT = 56 * MiB;
constexpr size_t WS_WGU  = 72 * MiB;
constexpr size_t WS_WDN  = 584 * MiB;
constexpr size_t WS_X    = 840 * MiB;
constexpr size_t WS_H    = 976 * MiB;
constexpr size_t WS_P    = 1044 * MiB;
constexpr size_t WS_CC   = 1206 * MiB;
constexpr size_t WS_VT   = 1274 * MiB;
constexpr size_t WS_VTC  = WS_VT + 8 * MiB;
constexpr size_t WS_DNT  = 1284 * MiB;
constexpr size_t DNT_BYTES = 90112;
constexpr size_t WS_DNO  = 1472 * MiB;
constexpr size_t WS_LRH  = 1540 * MiB;
constexpr size_t WS_LRA  = 1608 * MiB;
constexpr size_t WS_XS   = 1676 * MiB;
constexpr size_t WS_ACT  = 1980 * MiB;
constexpr size_t WS_YS   = 2132 * MiB;
constexpr size_t WS_END  = 2436 * MiB;
constexpr int CW_TMO = 0;
constexpr int CW_BAR = 4096;
constexpr int CW_CNT = 8192;
constexpr int CW_ATQ = 12288;

constexpr int RING_OFF = 0, RING_BYTES = 131072;
constexpr int LDSCTL_OFF = RING_BYTES, MISC_OFF = LDSCTL_OFF + 320;
constexpr int LDS_X_OFF = RING_BYTES + 1024;
constexpr int LDS_BYTES = 147456;
constexpr int NWAVES = 8, NTHREADS = 512;

#define GAS __attribute__((address_space(1)))
#define LAS __attribute__((address_space(3)))
typedef unsigned short bf16;
typedef unsigned v4u __attribute__((ext_vector_type(4)));
typedef unsigned v2u __attribute__((ext_vector_type(2)));
typedef float f32x4 __attribute__((ext_vector_type(4)));
typedef float f32x16 __attribute__((ext_vector_type(16)));
typedef short bf16x8 __attribute__((ext_vector_type(8)));
typedef short bf16x4 __attribute__((ext_vector_type(4)));
typedef GAS unsigned gu32;
#define RLX_AGENT __ATOMIC_RELAXED, __HIP_MEMORY_SCOPE_AGENT
#define LDS_WAIT() asm volatile("s_waitcnt lgkmcnt(0)" ::: "memory")
#define VM_WAIT() asm volatile("s_waitcnt vmcnt(0)" ::: "memory")
#define LDS_BARRIER() asm volatile("s_waitcnt lgkmcnt(0)\n\ts_barrier" ::: "memory")
typedef __bf16 bf16x2_t __attribute__((ext_vector_type(2)));
typedef float f32x2_t __attribute__((ext_vector_type(2)));
__device__ __forceinline__ unsigned pk2(float lo, float hi) { const f32x2_t v = {lo, hi}; const bf16x2_t b = __builtin_convertvector(v, bf16x2_t); return __builtin_bit_cast(unsigned, b); }
__device__ __forceinline__ unsigned f2bf(float f) { return pk2(f, 0.f) & 0xffffu; }
__device__ __forceinline__ float bf2f(unsigned short b) { return __builtin_bit_cast(float, (unsigned)b << 16); }
__device__ __forceinline__ float bflo(unsigned w) { return __builtin_bit_cast(float, w << 16); }
__device__ __forceinline__ float bfhi(unsigned w) { return __builtin_bit_cast(float, w & 0xffff0000u); }
template <int CTRL> __device__ __forceinline__ float dpp_mov(float v) { return __builtin_bit_cast(float, __builtin_amdgcn_update_dpp(0, __builtin_bit_cast(int, v), CTRL, 0xF, 0xF, false)); }
__device__ __forceinline__ float wave_sum(float v) {
    v += dpp_mov<0xB1>(v); v += dpp_mov<0x4E>(v); v += dpp_mov<0x141>(v); v += dpp_mov<0x140>(v);
    const int iv = __builtin_bit_cast(int, v);
    const float r0 = __builtin_bit_cast(float, __builtin_amdgcn_readlane(iv, 0)), r1 = __builtin_bit_cast(float, __builtin_amdgcn_readlane(iv, 16)), r2 = __builtin_bit_cast(float, __builtin_amdgcn_readlane(iv, 32)), r3 = __builtin_bit_cast(float, __builtin_amdgcn_readlane(iv, 48));
    return (r0 + r1) + (r2 + r3);
}
__device__ __forceinline__ float sigmoidf_(float x) { return __builtin_amdgcn_rcpf(1.0f + __builtin_amdgcn_exp2f(-1.4426950408889634f * x)); }
__device__ __forceinline__ float siluf_(float x) { return x * sigmoidf_(x); }
__device__ __forceinline__ float softplusf_(float x) { return x > 20.f ? x : log1pf(__expf(x)); }

#define XB_TMO      128
#define XB_XCNT(j)  (256  + 64 * (j))
#define XB_XSUB(j)  (1280 + 64 * (j))
#define XB_XGEN(j)  (2304 + 64 * (j))
#define XB_TOP      3328
#define XB_TOPGEN   3392
#define XCD_BAR_WORDS 3456
#define XB_SPIN_CAP (1u << 18)

__device__ __forceinline__ unsigned xb_ld(unsigned* p)              { return __hip_atomic_load(p, __ATOMIC_RELAXED, __HIP_MEMORY_SCOPE_AGENT); }
__device__ __forceinline__ unsigned xb_add(unsigned* p, unsigned v) { return __hip_atomic_fetch_add(p, v, __ATOMIC_RELAXED, __HIP_MEMORY_SCOPE_AGENT); }
__device__ __forceinline__ unsigned xb_xcc_id() { return (unsigned)__builtin_amdgcn_s_getreg((3 << 11) | 20) & 0xFu; }
#define XB_SPIN(cond, bar) do { unsigned _sp = 0; while (cond) { __builtin_amdgcn_s_sleep(1); \
    if ((++_sp & 255u) == 0u) { if (xb_ld(&(bar)[XB_TMO])) break; if (_sp > XB_SPIN_CAP) { atomicAdd(&(bar)[XB_TMO], 1u); break; } } } } while (0)

struct XcdBarrier {
    unsigned* bar; unsigned x;
    volatile LAS unsigned* st;
};

__device__ __forceinline__ XcdBarrier xcd_barrier_post(unsigned* bar, volatile LAS unsigned* st) {
    XcdBarrier b; b.bar = bar; b.x = xb_xcc_id(); b.st = st;
    if (threadIdx.x == 0) (void)xb_add(&bar[XB_XCNT(b.x)], 1u);
    return b;
}
__device__ __forceinline__ void xcd_barrier_complete(unsigned* bar, unsigned x, unsigned& nloc, unsigned& nx) {
    const unsigned G = gridDim.x * gridDim.y * gridDim.z;
    unsigned sum, cnt, mine, sp = 0u;
    for (;;) {
        sum = 0u; cnt = 0u; mine = 0u;
#pragma unroll
        for (unsigned j = 0; j < 16; ++j) { const unsigned c = xb_ld(&bar[XB_XCNT(j)]); sum += c; cnt += (c > 0u) ? 1u : 0u; mine = (j == x) ? c : mine; }
        if (sum == G) break;
        __builtin_amdgcn_s_sleep(1);
        if ((++sp & 255u) == 0u) { if (xb_ld(&bar[XB_TMO])) break; if (sp > XB_SPIN_CAP) { atomicAdd(&bar[XB_TMO], 1u); break; } }
    }
    nloc = mine > 0u ? mine : 1u; nx = cnt > 0u ? cnt : 1u;
}

__device__ __forceinline__ void xcd_barrier(const XcdBarrier& b) {
    asm volatile("s_waitcnt vmcnt(0)" ::: "memory");
    __syncthreads();
    if (threadIdx.x == 0) {
        unsigned* bar = b.bar;
        __builtin_amdgcn_s_waitcnt(0);
        unsigned nloc = b.st[0], nx = b.st[1];
        if (nloc == 0u) { xcd_barrier_complete(bar, b.x, nloc, nx); b.st[0] = nloc; b.st[1] = nx; }
        const unsigned old = xb_add(&bar[XB_XSUB(b.x)], 1u);
        const unsigned gen = old / nloc;
        if (old + 1u == (gen + 1u) * nloc) {
            __builtin_amdgcn_fence(__ATOMIC_RELEASE, "agent");
            asm volatile("s_waitcnt vmcnt(0)" ::: "memory");
            const unsigned og = xb_add(&bar[XB_TOP], 1u);
            const unsigned tg = og / nx;
            if (og + 1u == (tg + 1u) * nx) xb_add(&bar[XB_TOPGEN], 1u);
            else XB_SPIN(xb_ld(&bar[XB_TOPGEN]) == tg, bar);
            __builtin_amdgcn_fence(__ATOMIC_ACQUIRE, "agent");
            xb_add(&bar[XB_XGEN(b.x)], 1u);
            asm volatile("s_waitcnt vmcnt(0)" ::: "memory");
        } else {
            XB_SPIN(xb_ld(&bar[XB_XGEN(b.x)]) == gen, bar);
            __builtin_amdgcn_fence(__ATOMIC_ACQUIRE, "agent");
            asm volatile("s_waitcnt vmcnt(0)" ::: "memory");
        }
    }
    __syncthreads();
}

enum InIdx { I_X = 0, I_C, I_CTX, I_CCTX, I_WMOD, I_BMOD, I_NMG, I_NFG, I_WIN, I_WOUT, I_SINK, I_DNCW, I_DNALOG, I_DNDT, I_DNNG, I_LRCW, I_LRCB, I_LRWR, I_LRBR, I_LRWI, I_LRBI, I_LRLAM,
             I_WROUT, I_BROUT, I_WGU, I_BGU, I_WDN, I_BDN, I_FNG, N_IN };
struct Frame {
    LAS unsigned char* lds;
    volatile LAS unsigned* MISC;
    gu32* ctl;
    int tid, lane, wave, G, bid;
    const float* const __attribute__((address_space(4)))* in;
    float* out; unsigned char* ws;
};
__device__ __forceinline__ int mod_row(int m) { return m < NLAT ? (m >> 12) : 4; }
__device__ __forceinline__ bool phase_enter(Frame& F) { int t = threadIdx.x; asm volatile("" : "+v"(t)); F.tid = t; F.lane = t & 63; F.wave = __builtin_amdgcn_readfirstlane(t >> 6); return true; }
__device__ __forceinline__ void seq_of(int m, int& t, int& T, int& base) { if (m < NLAT) { t = m & 4095; T = SEQ; base = m - t; } else { t = (m - NLAT) & 255; T = CTXL; base = m - t; } }
__device__ __forceinline__ float gelu_tanh(float x) { const float u = 0.7978845608028654f * (x + 0.044715f * x * x * x); return x * sigmoidf_(2.0f * u); }

__device__ __forceinline__ void transpose_item(const float* W, int K, int N, bf16* WT, int k0, int dstrow0, int srccol0, int nvalid, LAS float* scr, int lane) {
    { const int c4 = (lane & 7) * 4, kr = lane >> 3; f32x4 v[8];
#pragma unroll
      for (int i = 0; i < 8; ++i) { v[i] = (f32x4){0.f, 0.f, 0.f, 0.f}; if (c4 < nvalid) v[i] = __builtin_nontemporal_load((const f32x4*)(W + (size_t)(k0 + 8 * i + kr) * N + srccol0 + c4)); }
#pragma unroll
      for (int i = 0; i < 8; ++i) { LAS float* d = scr + (8 * i + kr) * 33 + c4; d[0] = v[i].x; d[1] = v[i].y; d[2] = v[i].z; d[3] = v[i].w; } }
    LDS_WAIT(); asm volatile("" ::: "memory");
    const int c = lane & 7;
#pragma unroll
    for (int jj = 0; jj < 4; ++jj) { const int n = (lane >> 3) + 8 * jj; const LAS float* s = scr + (8 * c) * 33 + n;
        v4u o; o.x = pk2(s[0 * 33], s[1 * 33]); o.y = pk2(s[2 * 33], s[3 * 33]); o.z = pk2(s[4 * 33], s[5 * 33]); o.w = pk2(s[6 * 33], s[7 * 33]);
        *(GAS v4u*)(WT + (size_t)(dstrow0 + n) * K + k0 + 8 * c) = o; }
    LDS_WAIT(); asm volatile("" ::: "memory");
}
__device__ __forceinline__ void p0_prologue(Frame& F) {
    {
        LAS float* sc = (LAS float*)(F.lds);
        LAS float* red = (LAS float*)(F.lds + 40960);
        bool have_sc = false;
        for (int wb = F.bid; wb < 192; wb += F.G) {
            if (!have_sc) {
                for (int i = F.tid; i < 5 * 2048; i += NTHREADS) { const int r = i >> 11, k = i & 2047; const float cv = r < 4 ? F.in[I_C][r * 2048 + k] : F.in[I_CCTX][k]; sc[i] = siluf_(cv); }
                have_sc = true; __syncthreads();
            }
            const int l = wb / 96, cb = wb % 96, kp = F.tid >> 5, cg = F.tid & 31, j0 = cb * 128 + cg * 4;
            const float* wp = F.in[I_WMOD] + ((size_t)l * 2048 + kp * 128) * 12288 + j0;
            f32x4 acc[5];
#pragma unroll
            for (int r = 0; r < 5; ++r) acc[r] = (f32x4){0.f, 0.f, 0.f, 0.f};
#pragma unroll 4
            for (int k = 0; k < 128; ++k) { const f32x4 w = *(const f32x4*)(wp + (size_t)k * 12288);
#pragma unroll
                for (int r = 0; r < 5; ++r) acc[r] += sc[r * 2048 + kp * 128 + k] * w; }
#pragma unroll
            for (int r = 0; r < 5; ++r) *(LAS f32x4*)(red + (kp * 5 + r) * 128 + cg * 4) = acc[r];
            __syncthreads();
            for (int i = F.tid; i < 640; i += NTHREADS) { const int r = i >> 7, col = i & 127; float s = F.in[I_BMOD][l * 12288 + cb * 128 + col];
#pragma unroll
                for (int q = 0; q < 16; ++q) s += red[(q * 5 + r) * 128 + col];
                ((float*)(F.ws + WS_MOD))[(size_t)(l * 5 + r) * 12288 + cb * 128 + col] = s; }
            __syncthreads();
        }
        __syncthreads();
    }
    {
        LAS float* scr = (LAS float*)(F.lds + F.wave * 16384);
        const int gw = F.bid * NWAVES + F.wave, NGW = F.G * NWAVES;
        constexpr int I_IN = 32 * 144, I_OUT = 32 * 64, I_RT = 32, I_16 = 32, PER_L = I_IN + I_OUT + I_RT + I_16;
        for (int it0 = gw; it0 < 2 * PER_L; it0 += NGW) {
            const int l = it0 / PER_L; int r = it0 % PER_L;
            if (r < I_IN) { const int nb = r % 144, kb = r / 144, d0 = nb * 32; int s0 = d0, nv = 32;
                if (d0 >= 3584) s0 = d0 + 16;
                transpose_item(F.in[I_WIN] + (size_t)l * 2048 * IN_W, 2048, IN_W, (bf16*)(F.ws + WS_WIN) + (size_t)l * PW * 2048, kb * 64, d0, s0, nv, scr, F.lane); continue; }
            r -= I_IN;
            if (r < I_OUT) { const int nb = r % 64, kb = r / 64;
                transpose_item(F.in[I_WOUT] + (size_t)l * 2048 * 2048, 2048, 2048, (bf16*)(F.ws + WS_WOUT) + (size_t)l * 2048 * 2048, kb * 64, nb * 32, nb * 32, 32, scr, F.lane); continue; }
            r -= I_OUT;
            if (r < I_RT) { transpose_item(F.in[I_WROUT] + (size_t)l * 2048 * 32, 2048, 32, (bf16*)(F.ws + WS_WRT) + (size_t)l * 32 * 2048, r * 64, 0, 0, 32, scr, F.lane); continue; }
            r -= I_RT;
            transpose_item(F.in[I_WIN] + (size_t)l * 2048 * IN_W, 2048, IN_W, (bf16*)(F.ws + WS_WRT + 512 * 1024) + (size_t)l * 32 * 2048, r * 64, 0, 3584, 16, scr, F.lane);
        }
    }
}
constexpr int CW_CVQ = 12288 + 512;
__device__ __forceinline__ void convert_moe_item(Frame& F, int l, int r, LAS float* scr) {
    constexpr int I_GU = 32 * 32 * 64;
    if (r < I_GU) { const int e = r / 2048, q = r % 2048, nb = q % 64, kb = q / 64; const int s0 = ((nb >> 2) & 1) * 1024 + (nb >> 3) * 128 + (nb & 3) * 32;
        transpose_item(F.in[I_WGU] + (size_t)(l * 32 + e) * 2048 * 2048, 2048, 2048, (bf16*)(F.ws + WS_WGU) + (size_t)(l * 32 + e) * 2048 * 2048, kb * 64, nb * 32, s0, 32, scr, F.lane); return; }
    r -= I_GU;
    { const int e = r / 1024, q = r % 1024, nb = q % 64, kb = q / 64;
        transpose_item(F.in[I_WDN] + (size_t)(l * 32 + e) * 1024 * 2048, 1024, 2048, (bf16*)(F.ws + WS_WDN) + (size_t)(l * 32 + e) * 2048 * 1024, kb * 64, nb * 32, nb * 32, 32, scr, F.lane); }
}
constexpr int CVG = 8;
__device__ __forceinline__ bool convert_grab(Frame& F, int l, int rep, LAS float* scr) {
    constexpr int NIT = 32 * 32 * 64 + 32 * 16 * 64;
    int g = 0; if (F.lane == 0) g = (int)__hip_atomic_fetch_add(F.ctl + CW_CVQ + 64 * l + 8 * rep, 1u, RLX_AGENT); g = __builtin_amdgcn_readfirstlane(g);
    if (g * CVG >= NIT) return false;
#pragma unroll 1
    for (int k = 0; k < CVG; ++k) convert_moe_item(F, l, g * CVG + k, scr);
    return true;
}
__device__ __forceinline__ void convert_moe_queue(Frame& F, int l, int rep = 0) {
    LAS float* scr = (LAS float*)(F.lds + F.wave * 16384);
    __syncthreads();
    while (convert_grab(F, l, rep, scr)) {}
    __syncthreads();
}
constexpr int CW_TAIL = 16384;
__device__ __forceinline__ void tail_fill(Frame& F, int seam, int lt) {
    LAS int* flag = (LAS int*)(F.lds + LDS_X_OFF + 768);
    LAS float* scr = (LAS float*)(F.lds + F.wave * 16384);
    __syncthreads();
    if (F.tid == 0) (void)__hip_atomic_fetch_add(F.ctl + CW_TAIL + 64 * seam, 1u, RLX_AGENT);
    bool more = true;
    for (int it = 0; it < 4096; ++it) {
        if (F.tid == 0) *flag = (__hip_atomic_load(F.ctl + CW_TAIL + 64 * seam, RLX_AGENT) >= (unsigned)F.G) ? 1 : 0;
        __syncthreads();
        const int done = *flag;
        __syncthreads();
        if (done) break;
        if (more) more = convert_grab(F, lt, 0, scr); else __builtin_amdgcn_s_sleep(32);
    }
}

__device__ __forceinline__ void load_row(const float* src, int lane, f32x4 (&v)[8]) {
    const f32x4* p = (const f32x4*)src + lane;
#pragma unroll
    for (int j = 0; j < 8; ++j) v[j] = p[64 * j];
}
__device__ __forceinline__ void store_row(float* dst, int lane, const f32x4 (&v)[8]) {
    f32x4* p = (f32x4*)dst + lane;
#pragma unroll
    for (int j = 0; j < 8; ++j) p[64 * j] = v[j];
}
__device__ __forceinline__ void combine_row(Frame& F, int l, int m, int lane, f32x4 (&v)[8]) {
    const int* dest = (const int*)(F.ws + WS_MOEI + 2 * 512 * 1024) + m * 4;
    const float* g5 = (const float*)(F.ws + WS_MOD) + (size_t)(l * 5 + mod_row(m)) * 12288 + 5 * 2048;
    f32x4 acc[8];
#pragma unroll
    for (int j = 0; j < 8; ++j) acc[j] = (f32x4){0.f, 0.f, 0.f, 0.f};
#pragma unroll
    for (int k = 0; k < 4; ++k) { const int d = dest[k]; const v2u* yp = (const v2u*)((const bf16*)(F.ws + WS_YS) + (size_t)d * 2048) + lane;
#pragma unroll
        for (int j = 0; j < 8; ++j) { const v2u w = yp[64 * j]; acc[j] += (f32x4){bflo(w.x), bfhi(w.x), bflo(w.y), bfhi(w.y)}; } }
#pragma unroll
    for (int j = 0; j < 8; ++j) { const f32x4 gg = *((const f32x4*)g5 + lane + 64 * j); v[j] += gg * acc[j]; }
}
__device__ __forceinline__ void modnorm_store(const f32x4 (&v)[8], const float* g, const float* shift, const float* scale, bf16* hrow, int lane) {
    float ss = 0.f;
#pragma unroll
    for (int j = 0; j < 8; ++j) ss += (v[j].x * v[j].x + v[j].y * v[j].y) + (v[j].z * v[j].z + v[j].w * v[j].w);
    const float rstd = 1.0f / sqrtf(wave_sum(ss) * (1.0f / 2048.0f) + EPS);
    v2u* hp = (v2u*)hrow + lane;
#pragma unroll
    for (int j = 0; j < 8; ++j) { const f32x4 gg = *((const f32x4*)g + lane + 64 * j), sh = *((const f32x4*)shift + lane + 64 * j), sc = *((const f32x4*)scale + lane + 64 * j);
        const f32x4 y = (v[j] * rstd) * gg * (sc + 1.0f) + sh; v2u w; w.x = pk2(y.x, y.y); w.y = pk2(y.z, y.w); hp[64 * j] = w; }
}
constexpr size_t WS_W16 = WS_WRT + 512 * 1024;
__device__ __forceinline__ void phase_norm1(Frame& F, int l) {
    constexpr int TROW = 4112;
    LAS unsigned char* tile = F.lds; LAS float* part = (LAS float*)(F.lds + 66048);
    float* X = (float*)(F.ws + WS_X); bf16* H = (bf16*)(F.ws + WS_H); bf16* P = (bf16*)(F.ws + WS_P);
    const float* modp = (const float*)(F.ws + WS_MOD) + (size_t)l * 5 * 12288;
    const bf16* w16 = (const bf16*)(F.ws + WS_W16) + (size_t)l * 32 * 2048;
    for (int r0 = F.bid * 16; r0 < NTOK; r0 += F.G * 16) {
#pragma unroll 1
        for (int rr = 0; rr < 2; ++rr) { const int lr = 2 * F.wave + rr, m = r0 + lr;
            f32x4 v[8];
            if (l == 0) load_row(m < NLAT ? F.in[I_X] + (size_t)m * DM : F.in[I_CTX] + (size_t)(m - NLAT) * DM, F.lane, v);
            else { load_row(X + (size_t)m * DM, F.lane, v); if (MK_STAGE >= 9) { combine_row(F, l - 1, m, F.lane, v); store_row(X + (size_t)m * DM, F.lane, v); } }
            float ss = 0.f;
#pragma unroll
            for (int j = 0; j < 8; ++j) ss += (v[j].x * v[j].x + v[j].y * v[j].y) + (v[j].z * v[j].z + v[j].w * v[j].w);
            const float rstd = 1.0f / sqrtf(wave_sum(ss) * (1.0f / 2048.0f) + EPS);
            const float* mr = modp + (size_t)mod_row(m) * 12288; const float* g = F.in[I_NMG] + l * DM;
            v2u* hp = (v2u*)(H + (size_t)m * DM) + F.lane; LAS v2u* tp = (LAS v2u*)(tile + lr * TROW) + F.lane;
#pragma unroll
            for (int j = 0; j < 8; ++j) { const f32x4 gg = *((const f32x4*)g + F.lane + 64 * j), sh = *((const f32x4*)mr + F.lane + 64 * j), sc = *((const f32x4*)(mr + 2048) + F.lane + 64 * j);
                const f32x4 y = (v[j] * rstd) * gg * (sc + 1.0f) + sh; v2u w; w.x = pk2(y.x, y.y); w.y = pk2(y.z, y.w); hp[64 * j] = w; tp[64 * j] = w; }
        }
        __syncthreads();
        { const int row = F.lane & 15, q = F.lane >> 4; f32x4 acc = {0.f, 0.f, 0.f, 0.f};
#pragma unroll
          for (int ks = 0; ks < 8; ++ks) { const int k0 = 256 * F.wave + 32 * ks + 8 * q;
              const bf16x8 a = *(const LAS bf16x8*)(tile + row * TROW + k0 * 2); const bf16x8 b = *(const bf16x8*)(w16 + (size_t)row * 2048 + k0);
              acc = __builtin_amdgcn_mfma_f32_16x16x32_bf16(a, b, acc, 0, 0, 0); }
#pragma unroll
          for (int i = 0; i < 4; ++i) part[(F.wave * 16 + 4 * q + i) * 16 + row] = acc[i]; }
        __syncthreads();
        if (F.tid < 256) { const int rw = F.tid >> 4, c = F.tid & 15; float sacc = 0.f;
#pragma unroll
            for (int w = 0; w < 8; ++w) sacc += part[(w * 16 + rw) * 16 + c];
            P[(size_t)(r0 + rw) * PW + PC_BETA + c] = (bf16)f2bf(sacc); }
        __syncthreads();
    }
}
__device__ __forceinline__ void phase_final(Frame& F, bool with_combine) {
    const int gw = F.bid * NWAVES + F.wave, NGW = F.G * NWAVES;
    const float* X = (const float*)(F.ws + WS_X);
    for (int m = gw; m < NLAT; m += NGW) {
        f32x4 v[8];
        if (with_combine) { load_row(X + (size_t)m * DM, F.lane, v); combine_row(F, 1, m, F.lane, v); }
        else load_row(F.in[I_X] + (size_t)m * DM, F.lane, v);
        float ss = 0.f;
#pragma unroll
        for (int j = 0; j < 8; ++j) ss += (v[j].x * v[j].x + v[j].y * v[j].y) + (v[j].z * v[j].z + v[j].w * v[j].w);
        const float rstd = 1.0f / sqrtf(wave_sum(ss) * (1.0f / 2048.0f) + EPS);
        f32x4* op = (f32x4*)(F.out + (size_t)m * DM) + F.lane;
#pragma unroll
        for (int j = 0; j < 8; ++j) { const f32x4 gg = *((const f32x4*)F.in[I_FNG] + F.lane + 64 * j); op[64 * j] = v[j] * rstd * gg; }
    }
}

__device__ __forceinline__ void phase_inproj(Frame& F, int l) {
    pg8::Gemm g{(const bf16*)(F.ws + WS_H), (const bf16*)(F.ws + WS_WIN) + (size_t)l * PW * 2048, NTOK, 4608, 2048};
    pg8::StaticOrder S; S.init(g, F.G, F.bid);
    pg8::EpiBf16Plain E{(bf16*)(F.ws + WS_P), PW};
    pg8::gemm_phase<pg8::EpiBf16Plain, pg8::StaticOrder, true, true>(F.lds + RING_OFF, g, S, E);
}
__device__ __forceinline__ void phase_outproj(Frame& F, int l) {
    float* X = (float*)(F.ws + WS_X);
    pg8::Gemm g{(const bf16*)(F.ws + WS_CC), (const bf16*)(F.ws + WS_WOUT) + (size_t)l * 2048 * 2048, l == 0 ? NTOK : NLAT, 2048, 2048};
    pg8::StaticOrder S; S.init(g, F.G, F.bid);
    pg8::EpiResGate E{l == 0 ? F.in[I_X] : X, l == 0 ? F.in[I_CTX] : X + (size_t)NLAT * DM, X, (const float*)(F.ws + WS_MOD) + (size_t)l * 5 * 12288 + 2 * 2048};
    pg8::gemm_phase<pg8::EpiResGate, pg8::StaticOrder, true, true>(F.lds + RING_OFF, g, S, E);
}
#ifndef PHASE_INPROJ
#define PHASE_INPROJ(F, l) phase_inproj(F, l)
#endif
#ifndef PHASE_OUTPROJ
#define PHASE_OUTPROJ(F, l) phase_outproj(F, l)
#endif

constexpr size_t MOEI_TOPE = WS_MOEI, MOEI_TOPG = WS_MOEI + 512 * 1024, MOEI_DEST = WS_MOEI + 2 * 512 * 1024, MOEI_ROWG = WS_MOEI + 3 * 512 * 1024, MOEI_ROWT = WS_MOEI + 4 * 512 * 1024;
__device__ __forceinline__ void phase_norm2(Frame& F, int l) {
    const int nrows = (l == 0) ? NTOK : NLAT;
    constexpr int TROW = 4112;
    LAS unsigned char* tile = F.lds;
    LAS float* part = (LAS float*)(F.lds + 66048);
    LAS float* lg = (LAS float*)(F.lds + 66048 + 16384);
    const float* X = (const float*)(F.ws + WS_X); bf16* H = (bf16*)(F.ws + WS_H);
    const float* modp = (const float*)(F.ws + WS_MOD) + (size_t)l * 5 * 12288;
    const bf16* wrt = (const bf16*)(F.ws + WS_WRT) + (size_t)l * 32 * 2048;
    int* tope = (int*)(F.ws + MOEI_TOPE); float* topg = (float*)(F.ws + MOEI_TOPG);
    for (int r0 = F.bid * 16; r0 < nrows; r0 += F.G * 16) {
#pragma unroll 1
        for (int rr = 0; rr < 2; ++rr) {
            const int lr = 2 * F.wave + rr, m = r0 + lr;
            f32x4 v[8]; load_row(X + (size_t)m * DM, F.lane, v);
            float ss = 0.f;
#pragma unroll
            for (int j = 0; j < 8; ++j) ss += (v[j].x * v[j].x + v[j].y * v[j].y) + (v[j].z * v[j].z + v[j].w * v[j].w);
            const float rstd = 1.0f / sqrtf(wave_sum(ss) * (1.0f / 2048.0f) + EPS);
            const float* mr = modp + (size_t)mod_row(m) * 12288; const float* g = F.in[I_NFG] + l * DM;
            v2u* hp = (v2u*)(H + (size_t)m * DM) + F.lane; LAS v2u* tp = (LAS v2u*)(tile + lr * TROW) + F.lane;
#pragma unroll
            for (int j = 0; j < 8; ++j) { const f32x4 gg = *((const f32x4*)g + F.lane + 64 * j), sh = *((const f32x4*)(mr + 3 * 2048) + F.lane + 64 * j), sc = *((const f32x4*)(mr + 4 * 2048) + F.lane + 64 * j);
                const f32x4 y = (v[j] * rstd) * gg * (sc + 1.0f) + sh; v2u w; w.x = pk2(y.x, y.y); w.y = pk2(y.z, y.w); hp[64 * j] = w; tp[64 * j] = w; }
        }
        __syncthreads();
        {
            const int row = F.lane & 15, q = F.lane >> 4;
            f32x4 acc0 = {0.f, 0.f, 0.f, 0.f}, acc1 = {0.f, 0.f, 0.f, 0.f};
#pragma unroll
            for (int ks = 0; ks < 8; ++ks) { const int k0 = 256 * F.wave + 32 * ks + 8 * q;
                const bf16x8 a = *(const LAS bf16x8*)(tile + row * TROW + k0 * 2);
                const bf16x8 b0 = *(const bf16x8*)(wrt + (size_t)row * 2048 + k0), b1 = *(const bf16x8*)(wrt + (size_t)(16 + row) * 2048 + k0);
                acc0 = __builtin_amdgcn_mfma_f32_16x16x32_bf16(a, b0, acc0, 0, 0, 0); acc1 = __builtin_amdgcn_mfma_f32_16x16x32_bf16(a, b1, acc1, 0, 0, 0); }
#pragma unroll
            for (int i = 0; i < 4; ++i) { part[(F.wave * 16 + 4 * q + i) * 32 + row] = acc0[i]; part[(F.wave * 16 + 4 * q + i) * 32 + 16 + row] = acc1[i]; }
        }
        __syncthreads();
        { const int rw = F.tid >> 5, e = F.tid & 31; float s = F.in[I_BROUT][l * 32 + e];
#pragma unroll
          for (int w = 0; w < 8; ++w) s += part[(w * 16 + rw) * 32 + e];
          lg[rw * 32 + e] = s; }
        __syncthreads();
        if (F.tid < 16) { const int m = r0 + F.tid; float val[4]; int idx[4]; unsigned taken = 0u;
#pragma unroll
            for (int k = 0; k < 4; ++k) { float best = -3.0e38f; int bi = 0;
                for (int e = 0; e < 32; ++e) { const float x = lg[F.tid * 32 + e]; if (!((taken >> e) & 1u) && x > best) { best = x; bi = e; } }
                val[k] = best; idx[k] = bi; taken |= 1u << bi; }
            float p[4], sum = 0.f;
#pragma unroll
            for (int k = 0; k < 4; ++k) { p[k] = __expf(val[k] - val[0]); sum += p[k]; }
#pragma unroll
            for (int k = 0; k < 4; ++k) { const unsigned rank = __hip_atomic_fetch_add(F.ctl + CW_CNT + 64 * l + idx[k], 1u, RLX_AGENT);
                tope[m * 4 + k] = idx[k] | (int)(rank << 8); topg[m * 4 + k] = p[k] / sum; }
        }
        __syncthreads();
    }
}
__device__ __forceinline__ void moe_tables(Frame& F, int l) {
    LAS int* blk_end = (LAS int*)(F.lds + LDS_X_OFF); LAS int* pstart = blk_end + 32; LAS int* cnts = blk_end + 64;
    if (F.tid == 0) { int nb = 0;
        for (int e = 0; e < 32; ++e) { const int c = (int)__hip_atomic_load(F.ctl + CW_CNT + 64 * l + e, RLX_AGENT); cnts[e] = c; pstart[e] = nb * 256; nb += (c + 255) >> 8; blk_end[e] = nb; } }
    __syncthreads();
}
__device__ __forceinline__ void phase_scatter(Frame& F, int l) {
    const int nrows = (l == 0) ? NTOK : NLAT;
    moe_tables(F, l);
    const LAS int* blk_end = (const LAS int*)(F.lds + LDS_X_OFF); const LAS int* pstart = blk_end + 32; const LAS int* cnts = blk_end + 64;
    const int* tope = (const int*)(F.ws + MOEI_TOPE); const float* topg = (const float*)(F.ws + MOEI_TOPG);
    int* dest = (int*)(F.ws + MOEI_DEST); float* rowg = (float*)(F.ws + MOEI_ROWG); int* rowt = (int*)(F.ws + MOEI_ROWT);
    for (int a = F.bid * NTHREADS + F.tid; a < nrows * 4; a += F.G * NTHREADS) {
        const int te = tope[a], e = te & 255, rank = (int)((unsigned)te >> 8), d = pstart[e] + rank;
        dest[a] = d; rowg[d] = topg[a]; rowt[d] = a >> 2; }
    if (F.bid < 32) { const int e = F.bid, r0 = pstart[e] + cnts[e], r1 = blk_end[e] * 256;
        for (int r = r0 + F.tid; r < r1; r += NTHREADS) { rowt[r] = 0; rowg[r] = 0.f; } }
}
__device__ __forceinline__ void phase_gemm1(Frame& F, int l) {
    moe_tables(F, l);
    const LAS int* blk_end = (const LAS int*)(F.lds + LDS_X_OFF);
    pg8::Gemm g{(const bf16*)(F.ws + WS_H), (const bf16*)(F.ws + WS_WGU) + (size_t)l * 32 * 2048 * 2048, MOE_ROWS, 2048, 2048};
    pg8::MoeOrderG S{F.bid, __builtin_amdgcn_readfirstlane(blk_end[31]), (const char*)g.A, (const char*)g.Bt, (size_t)256 * 2048 * 2, (size_t)2048 * 2048 * 2, (size_t)256 * 2048 * 2, blk_end, (const int*)(F.ws + MOEI_ROWT)};
    pg8::EpiSwiglu E{(bf16*)(F.ws + WS_ACT), F.in[I_BGU] + (size_t)l * 32 * 2048};
    pg8::gemm_phase<pg8::EpiSwiglu, pg8::MoeOrderG, true, true>(F.lds + RING_OFF, g, S, E);
}
__device__ __forceinline__ void phase_gemm2(Frame& F, int l) {
    moe_tables(F, l);
    const LAS int* blk_end = (const LAS int*)(F.lds + LDS_X_OFF);
    pg8::Gemm g{(const bf16*)(F.ws + WS_ACT), (const bf16*)(F.ws + WS_WDN) + (size_t)l * 32 * 2048 * 1024, MOE_ROWS, 2048, 1024};
    pg8::MoeOrder S{F.bid, __builtin_amdgcn_readfirstlane(blk_end[31]), (const char*)g.A, (const char*)g.Bt, (size_t)256 * 1024 * 2, (size_t)2048 * 1024 * 2, (size_t)256 * 1024 * 2, blk_end, nullptr};
    pg8::EpiDown E{(bf16*)(F.ws + WS_YS), F.in[I_BDN] + (size_t)l * 32 * 2048, (const float*)(F.ws + MOEI_ROWG)};
    pg8::gemm_phase<pg8::EpiDown, pg8::MoeOrder, true, true>(F.lds + RING_OFF, g, S, E);
}
#ifndef PHASE_NORM2
#define PHASE_NORM2(F, l) phase_norm2(F, l)
#endif
#ifndef PHASE_SCATTER
#define PHASE_SCATTER(F, l) phase_scatter(F, l)
#endif
#ifndef PHASE_GEMM1
#define PHASE_GEMM1(F, l) phase_gemm1(F, l)
#endif
#ifndef PHASE_GEMM2
#define PHASE_GEMM2(F, l) phase_gemm2(F, l)
#endif
#define USE_MFMA_ATTN 1

__device__ __forceinline__ void attn_prep(Frame& F, int l) {
    bf16* P = (bf16*)(F.ws + WS_P);
    LAS unsigned short* vt = (LAS unsigned short*)F.lds;
    for (int ct = F.bid; ct < NCT; ct += F.G) {
        const int m0 = ct * 64; const bool lat = m0 < NLAT;
        __syncthreads();
        for (int i = F.tid; i < 64 * 32; i += NTHREADS) { const int tk = i >> 5, c8 = i & 31;
            const v4u w = *(const v4u*)(P + (size_t)(m0 + tk) * PW + PC_V + c8 * 8);
            const unsigned ww[4] = {w.x, w.y, w.z, w.w};
#pragma unroll
            for (int q = 0; q < 4; ++q) { vt[(c8 * 8 + 2 * q) * 66 + tk] = (unsigned short)(ww[q] & 0xffffu); vt[(c8 * 8 + 2 * q + 1) * 66 + tk] = (unsigned short)(ww[q] >> 16); } }
        if (lat) { const int tk = F.tid >> 3, kvh = (F.tid >> 1) & 3, hf = F.tid & 1; const int t = (m0 + tk) & 4095;
            bf16* kp = P + (size_t)(m0 + tk) * PW + PC_K + kvh * 64 + hf * 32;
            const v4u w0 = *(const v4u*)kp, w1 = *(const v4u*)(kp + 8), w2 = *(const v4u*)(kp + 16), w3 = *(const v4u*)(kp + 24);
            const unsigned lo[8] = {w0.x, w0.y, w0.z, w0.w, w1.x, w1.y, w1.z, w1.w}, hi_[8] = {w2.x, w2.y, w2.z, w2.w, w3.x, w3.y, w3.z, w3.w};
            const float pos = (float)(hf ? (t & 63) : (t >> 6)); unsigned o1[8], o2[8];
#pragma unroll
            for (int jj = 0; jj < 8; ++jj) { float r1[2], r2[2];
#pragma unroll
                for (int e = 0; e < 2; ++e) { const int j = 2 * jj + e; const float inv = __builtin_amdgcn_exp2f(-(float)j * 0.8304820237218406f); const float sn = __sinf(pos * inv), cs = __cosf(pos * inv);
                    const float x1 = e ? bfhi(lo[jj]) : bflo(lo[jj]), x2 = e ? bfhi(hi_[jj]) : bflo(hi_[jj]); r1[e] = x1 * cs - x2 * sn; r2[e] = x2 * cs + x1 * sn; }
                o1[jj] = pk2(r1[0], r1[1]); o2[jj] = pk2(r2[0], r2[1]); }
            *(v4u*)kp = (v4u){o1[0], o1[1], o1[2], o1[3]}; *(v4u*)(kp + 8) = (v4u){o1[4], o1[5], o1[6], o1[7]}; *(v4u*)(kp + 16) = (v4u){o2[0], o2[1], o2[2], o2[3]}; *(v4u*)(kp + 24) = (v4u){o2[4], o2[5], o2[6], o2[7]}; }
        __syncthreads();
        for (int i = F.tid; i < 256 * 8; i += NTHREADS) { const int col = i >> 3, c = i & 7, kvh = col >> 6, d = col & 63;
            v4u o; const LAS unsigned short* s = vt + col * 66 + c * 8;
            o.x = s[0] | ((unsigned)s[1] << 16); o.y = s[2] | ((unsigned)s[3] << 16); o.z = s[4] | ((unsigned)s[5] << 16); o.w = s[6] | ((unsigned)s[7] << 16);
            if (lat) { const int b = m0 >> 12, t0 = m0 & 4095; *(v4u*)((bf16*)(F.ws + WS_VT) + ((size_t)(b * 4 + kvh) * 64 + d) * SEQ + t0 + c * 8) = o; }
            else { const int mm = m0 - NLAT, b = mm >> 8, t0 = mm & 255; *(v4u*)((bf16*)(F.ws + WS_VTC) + ((size_t)(b * 4 + kvh) * 64 + d) * CTXL + t0 + c * 8) = o; } }
    }
    __syncthreads();
}

constexpr int AT_KP = 144, AT_VP = 136;
constexpr int AT_KOFF = 0, AT_VOFF = 64 * AT_KP, AT_TILE = 64 * AT_KP + 64 * AT_VP;
__device__ __forceinline__ void attn_unit(Frame& F, int l, int b, int kvh, int qi, int is_ctx) {
    const bf16* P = (const bf16*)(F.ws + WS_P); bf16* CC = (bf16*)(F.ws + WS_CC);
    int lane_o = F.lane; asm volatile("" : "+v"(lane_o));
    const int g = F.wave >> 1, qh = F.wave & 1, hq = kvh * 4 + g, r32 = lane_o & 31, hi = lane_o >> 5;
    const int rowbase = is_ctx ? NLAT + b * CTXL : b * SEQ;
    const int qa = qi * 128 + qh * 64;
    const float LOG2E = 1.4426950408889634f;
    bf16x8 qf[2][4];
#pragma unroll
    for (int qt = 0; qt < 2; ++qt) { const int tq = qa + 32 * qt + r32; const bf16* qp = P + (size_t)(rowbase + tq) * PW + PC_Q + hq * 64 + 8 * hi;
        float x[4][8];
#pragma unroll
        for (int s = 0; s < 4; ++s) { const v4u w = *(const v4u*)(qp + 16 * s); x[s][0] = bflo(w.x); x[s][1] = bfhi(w.x); x[s][2] = bflo(w.y); x[s][3] = bfhi(w.y); x[s][4] = bflo(w.z); x[s][5] = bfhi(w.z); x[s][6] = bflo(w.w); x[s][7] = bfhi(w.w); }
        if (!is_ctx) {
#pragma unroll
            for (int hf = 0; hf < 2; ++hf) { const float pos = (float)(hf ? (tq & 63) : (tq >> 6));
#pragma unroll
                for (int j = 0; j < 8; ++j) { const float inv = __builtin_amdgcn_exp2f(-(float)(8 * hi + j) * 0.8304820237218406f); const float sn = __sinf(pos * inv), cs = __cosf(pos * inv);
                    const float x1 = x[2 * hf][j], x2 = x[2 * hf + 1][j]; x[2 * hf][j] = x1 * cs - x2 * sn; x[2 * hf + 1][j] = x2 * cs + x1 * sn; } } }
        const float sc = 0.125f * LOG2E;
#pragma unroll
        for (int s = 0; s < 4; ++s) { v4u w; w.x = pk2(x[s][0] * sc, x[s][1] * sc); w.y = pk2(x[s][2] * sc, x[s][3] * sc); w.z = pk2(x[s][4] * sc, x[s][5] * sc); w.w = pk2(x[s][6] * sc, x[s][7] * sc); qf[qt][s] = __builtin_bit_cast(bf16x8, w); }
    }
    float mrun[2], lrun[2]; f32x16 O[2][2];
    { const float sk = F.in[I_SINK][l * 16 + hq] * LOG2E;
#pragma unroll
      for (int qt = 0; qt < 2; ++qt) { mrun[qt] = sk; lrun[qt] = hi ? 0.f : 1.f;
#pragma unroll
        for (int db = 0; db < 2; ++db)
#pragma unroll
            for (int r = 0; r < 16; ++r) O[qt][db][r] = 0.f; } }
    const int kt_lo = is_ctx ? 0 : (qi == 0 ? 2 : 0), nl = is_ctx ? 0 : (6 - (qi == 0 ? 2 : 0) - (qi == 31 ? 2 : 0)), ntile = nl + 4;
    const int rr = F.tid >> 3, cch = F.tid & 7;
    const bf16* kbase_l = P + (size_t)(b * SEQ + rr) * PW + PC_K + kvh * 64 + cch * 8; const bf16* kbase_c = P + (size_t)(NLAT + b * CTXL + rr) * PW + PC_K + kvh * 64 + cch * 8;
    const bf16* vbase_l = (const bf16*)(F.ws + WS_VT) + ((size_t)(b * 4 + kvh) * 64 + rr) * SEQ + cch * 8; const bf16* vbase_c = (const bf16*)(F.ws + WS_VTC) + ((size_t)(b * 4 + kvh) * 64 + rr) * CTXL + cch * 8;
    v4u kw, vw;
    { const bool loc0 = nl > 0; const int k00 = loc0 ? 128 * (qi - 1) + 64 * kt_lo : 0; kw = *(const v4u*)((loc0 ? kbase_l : kbase_c) + (size_t)k00 * PW); vw = *(const v4u*)((loc0 ? vbase_l : vbase_c) + k00); }
    LDS_BARRIER();
#pragma unroll 1
    for (int jt = 0; jt < ntile; ++jt) {
        const bool local = jt < nl; const int k0 = local ? 128 * (qi - 1) + 64 * (kt_lo + jt) : 64 * (jt - nl);
        const LAS unsigned char* KS = F.lds + (jt & 1) * AT_TILE + AT_KOFF; const LAS unsigned char* VS = F.lds + (jt & 1) * AT_TILE + AT_VOFF;
        { *(LAS v4u*)(F.lds + (jt & 1) * AT_TILE + AT_KOFF + rr * AT_KP + cch * 16) = kw;
          LAS v2u* vd = (LAS v2u*)(F.lds + (jt & 1) * AT_TILE + AT_VOFF + rr * AT_VP + cch * 16); vd[0] = (v2u){vw.x, vw.y}; vd[1] = (v2u){vw.z, vw.w}; }
        if (jt + 1 < ntile) { const bool ln = jt + 1 < nl; const int kn = ln ? 128 * (qi - 1) + 64 * (kt_lo + jt + 1) : 64 * (jt + 1 - nl);
            kw = *(const v4u*)((ln ? kbase_l : kbase_c) + (size_t)kn * PW); vw = *(const v4u*)((ln ? vbase_l : vbase_c) + kn); }
        LDS_BARRIER();
        if (local && (k0 + 63 < qa - 128 || k0 > qa + 63 + 128)) continue;
#pragma unroll 1
        for (int kb = 0; kb < 2; ++kb) {
            bf16x8 kf[4];
#pragma unroll
            for (int ss = 0; ss < 4; ++ss) kf[ss] = *(const LAS bf16x8*)(KS + (32 * kb + r32) * AT_KP + (16 * ss + 8 * hi) * 2);
            bf16x8 pb[2][2];
#pragma unroll
            for (int qt = 0; qt < 2; ++qt) { const int tq = qa + 32 * qt + r32;
                f32x16 s;
#pragma unroll
                for (int r = 0; r < 16; ++r) s[r] = 0.f;
#pragma unroll
                for (int ss = 0; ss < 4; ++ss) s = __builtin_amdgcn_mfma_f32_32x32x16_bf16(kf[ss], qf[qt][ss], s, 0, 0, 0);
                if (local) {
#pragma unroll
                    for (int r = 0; r < 16; ++r) { const int kidx = k0 + 32 * kb + (r & 3) + 8 * (r >> 2) + 4 * hi; const int dlt = kidx - tq; if (dlt > 128 || dlt < -128) s[r] = -1.0e30f; } }
                float mloc = s[0];
#pragma unroll
                for (int r = 1; r < 16; ++r) mloc = fmaxf(mloc, s[r]);
                mloc = fmaxf(mloc, __shfl_xor(mloc, 32));
                const float mnew = fmaxf(mrun[qt], mloc), alpha = __builtin_amdgcn_exp2f(mrun[qt] - mnew); mrun[qt] = mnew;
                float psum = 0.f;
#pragma unroll
                for (int r = 0; r < 16; ++r) { s[r] = __builtin_amdgcn_exp2f(s[r] - mnew); psum += s[r]; }
                lrun[qt] = lrun[qt] * alpha + psum;
#pragma unroll
                for (int db = 0; db < 2; ++db)
#pragma unroll
                    for (int r = 0; r < 16; ++r) O[qt][db][r] *= alpha;
#pragma unroll
                for (int s2 = 0; s2 < 2; ++s2) { v4u pw; pw.x = pk2(s[8 * s2 + 0], s[8 * s2 + 1]); pw.y = pk2(s[8 * s2 + 2], s[8 * s2 + 3]); pw.z = pk2(s[8 * s2 + 4], s[8 * s2 + 5]); pw.w = pk2(s[8 * s2 + 6], s[8 * s2 + 7]);
                    pb[qt][s2] = __builtin_bit_cast(bf16x8, pw); }
            }
#pragma unroll
            for (int s2 = 0; s2 < 2; ++s2)
#pragma unroll
                for (int db = 0; db < 2; ++db) { const LAS v2u* vp = (const LAS v2u*)(VS + (32 * db + r32) * AT_VP + (32 * kb + 16 * s2 + 4 * hi) * 2);
                    const v2u a0 = vp[0], a1 = vp[2]; v4u aw; aw.x = a0.x; aw.y = a0.y; aw.z = a1.x; aw.w = a1.y; const bf16x8 va = __builtin_bit_cast(bf16x8, aw);
                    O[0][db] = __builtin_amdgcn_mfma_f32_32x32x16_bf16(va, pb[0][s2], O[0][db], 0, 0, 0);
                    O[1][db] = __builtin_amdgcn_mfma_f32_32x32x16_bf16(va, pb[1][s2], O[1][db], 0, 0, 0); }
        }
    }
    int r32e = r32, hie = hi; asm volatile("" : "+v"(r32e), "+v"(hie));
#pragma unroll
    for (int qt = 0; qt < 2; ++qt) { const float lt = lrun[qt] + __shfl_xor(lrun[qt], 32); const float rl = 1.0f / lt; const int tq = qa + 32 * qt + r32e;
        bf16* op = CC + (size_t)(rowbase + tq) * DM + hq * 64 + 4 * hie;
#pragma unroll
        for (int db = 0; db < 2; ++db)
#pragma unroll
            for (int rq = 0; rq < 4; ++rq) { v2u w; w.x = pk2(O[qt][db][4 * rq] * rl, O[qt][db][4 * rq + 1] * rl); w.y = pk2(O[qt][db][4 * rq + 2] * rl, O[qt][db][4 * rq + 3] * rl);
                *(v2u*)(op + 32 * db + 8 * rq) = w; } }
}
__device__ __forceinline__ void attn_phase(Frame& F, int l, int rep = 0) {
    const int nunits = 512 + (l == 0 ? 32 : 0);
    LAS int* slot = (LAS int*)(F.lds + LDS_X_OFF + 512);
    for (;;) {
        __syncthreads();
        if (F.tid == 0) *slot = (int)__hip_atomic_fetch_add(F.ctl + CW_ATQ + 64 * l + 8 * rep, 1u, RLX_AGENT);
        __syncthreads();
        const int u = __builtin_amdgcn_readfirstlane(*slot);
        if (u >= nunits) break;
        if (u < 512) attn_unit(F, l, u >> 7, (u >> 5) & 3, u & 31, 0); else { const int v = u - 512; attn_unit(F, l, v >> 3, (v >> 1) & 3, v & 1, 1); }
    }
}
#define USE_CHUNK_DN 1
#ifndef DN_SPLIT
#define DN_SPLIT 2
#endif
#ifndef DN_REP_S1
#define DN_REP_S1 1
#endif
#ifndef DN_REP_S3B
#define DN_REP_S3B 1
#endif
#ifndef DN_REP_S3A
#define DN_REP_S3A 1
#endif
#ifndef DN_REP_S4
#define DN_REP_S4 1
#endif

constexpr int DN_F_NEGW = 0, DN_F_QG = 16, DN_F_QK = 32, DN_F_KGT = 40, DN_NFRAG = 56, DN_U_OFF = 57344;
constexpr int DP_QS = 0, DP_KS = 17408, DP_VS = 34816, DP_AS = 52224  , DP_TB = 69632, DP_TW = 78848, DP_QK = 88064, DP_RAW = 52224  , DP_SC = 104960, DP_TF = 106496  , DP_XS = 123904  ;
constexpr int DP_P = 272, DP_P2 = 144;
__device__ __forceinline__ int dn_rec(int b, int h, int dir, int np) { return ((b * 4 + h) * 2 + dir) * 68 + np; }
__device__ __forceinline__ void dn_chunk_of(int ct, int dir, int& b, int& np) { if (ct < 256) { b = ct >> 6; const int c = ct & 63; np = 4 + (dir ? 63 - c : c); } else { b = (ct - 256) >> 2; const int c = (ct - 256) & 3; np = dir ? 3 - c : c; } }
__device__ __forceinline__ unsigned short lds_u16(const LAS unsigned char* p) { return *(const LAS unsigned short*)p; }

__device__ __forceinline__ void dn_prep_unit(Frame& F, int l, int ct, int h, int dir) {
    const bf16* P = (const bf16*)(F.ws + WS_P);
    int lane = F.lane; asm volatile("" : "+v"(lane));
    const int wave = F.wave, i16 = lane & 15, q = lane >> 4;
    const int m0 = ct * 64; int t0, T, base; seq_of(m0, t0, T, base);
    int b, np; dn_chunk_of(ct, dir, b, np);
    unsigned char* tile = F.ws + WS_DNT + (size_t)dn_rec(b, h, dir, np) * DNT_BYTES;
    LAS unsigned char* L = F.lds;
    LAS float* SC = (LAS float*)(L + DP_SC);
    LDS_BARRIER();
    {
        const float* cw = F.in[I_DNCW] + (size_t)l * 4 * 1536;
        LAS float* cwl = (LAS float*)(L + DP_TF);
        for (int i = F.tid; i < 3 * 4 * 128; i += NTHREADS) { const int part = i >> 9, j = (i >> 7) & 3, ch = i & 127; cwl[i] = cw[j * 1536 + part * 512 + h * 128 + ch]; }
        unsigned short pbw = 0, paw = 0;
        if (wave == 0) { const int tok = dir ? 63 - lane : lane; pbw = P[(size_t)(m0 + tok) * PW + PC_BETA + dir * 4 + h]; paw = P[(size_t)(m0 + tok) * PW + PC_DEC + dir * 4 + h]; }
        for (int c = F.tid; c < 67 * 48; c += NTHREADS) { const int row = c / 48, ch = c % 48, part = ch >> 4, cc = ch & 15, tt = t0 + row - 2;
            v4u v = (v4u){0u, 0u, 0u, 0u};
            if (tt >= 0 && tt < T) v = *(const v4u*)(P + (size_t)(base + tt) * PW + PC_DQ + part * 512 + h * 128 + cc * 8);
            *(LAS v4u*)(L + DP_RAW + row * 784 + part * 256 + cc * 16) = v; }
        LDS_BARRIER();
#pragma unroll 1
        for (int rep = 0; rep < DN_REP_S1; ++rep)
#pragma unroll
        for (int part = 0; part < 3; ++part) { const int tok = F.tid >> 3, g8 = F.tid & 7;
            float sv[16];
#pragma unroll
            for (int k = 0; k < 16; ++k) sv[k] = 0.f;
#pragma unroll
            for (int j = 0; j < 4; ++j) { const LAS v4u* rp = (const LAS v4u*)(L + DP_RAW + (tok + j) * 784 + part * 256 + g8 * 32); const v4u r0 = rp[0], r1 = rp[1];
                const LAS f32x4* wp = (const LAS f32x4*)(cwl + (part * 4 + j) * 128 + g8 * 16); const f32x4 w0 = wp[0], w1 = wp[1], w2 = wp[2], w3 = wp[3];
                sv[0] += w0.x * bflo(r0.x); sv[1] += w0.y * bfhi(r0.x); sv[2] += w0.z * bflo(r0.y); sv[3] += w0.w * bfhi(r0.y); sv[4] += w1.x * bflo(r0.z); sv[5] += w1.y * bfhi(r0.z); sv[6] += w1.z * bflo(r0.w); sv[7] += w1.w * bfhi(r0.w);
                sv[8] += w2.x * bflo(r1.x); sv[9] += w2.y * bfhi(r1.x); sv[10] += w2.z * bflo(r1.y); sv[11] += w2.w * bfhi(r1.y); sv[12] += w3.x * bflo(r1.z); sv[13] += w3.y * bfhi(r1.z); sv[14] += w3.z * bflo(r1.w); sv[15] += w3.w * bfhi(r1.w); }
            float ss = 0.f;
#pragma unroll
            for (int k = 0; k < 16; ++k) { sv[k] = siluf_(sv[k]); ss += sv[k] * sv[k]; }
            if (part < 2) { ss += dpp_mov<0xB1>(ss); ss += dpp_mov<0x4E>(ss); ss += dpp_mov<0x141>(ss);
                const float f = (part == 0 ? 0.08838834764831845f : 1.0f) * __builtin_amdgcn_rsqf(ss + EPS);
#pragma unroll
                for (int k = 0; k < 16; ++k) sv[k] *= f; }
            LAS v4u* op = (LAS v4u*)(L + (part == 0 ? DP_QS : (part == 1 ? DP_KS : DP_VS)) + tok * DP_P + g8 * 32);
            op[0] = (v4u){pk2(sv[0], sv[1]), pk2(sv[2], sv[3]), pk2(sv[4], sv[5]), pk2(sv[6], sv[7])}; op[1] = (v4u){pk2(sv[8], sv[9]), pk2(sv[10], sv[11]), pk2(sv[12], sv[13]), pk2(sv[14], sv[15])}; }
        if (wave == 0) {
            const float pb = bf2f(pbw), pa = bf2f(paw);
            const float beta = sigmoidf_(pb); float gc = -__expf(F.in[I_DNALOG][l * 8 + dir * 4 + h]) * softplusf_(pa + F.in[I_DNDT][l * 8 + dir * 4 + h]);
#pragma unroll
            for (int o = 1; o < 64; o <<= 1) { const float v = __shfl_up(gc, o); if (lane >= o) gc += v; }
            const float glast = __shfl(gc, 63);
            SC[lane] = beta; SC[64 + lane] = gc; SC[128 + lane] = __expf(gc); SC[192 + lane] = __expf(glast - gc);
            if (lane == 63) ((float*)(F.ws + WS_DNS))[dn_rec(b, h, dir, np)] = __expf(glast);
        }
    }
    LDS_BARRIER();
#define DN_TOK(r) (dir ? 63 - (r) : (r))
#pragma unroll 1
    for (int rep = 0; rep < DN_REP_S3A; ++rep)
    {
        const int mb = wave & 3, which = wave >> 2;
        f32x4 acc[4];
#pragma unroll
        for (int nb = 0; nb < 4; ++nb) acc[nb] = (f32x4){0.f, 0.f, 0.f, 0.f};
        const LAS unsigned char* arow = L + (which ? DP_QS : DP_KS) + DN_TOK(16 * mb + i16) * DP_P + 16 * q;
#pragma unroll
        for (int ks = 0; ks < 4; ++ks) { const bf16x8 a = *(const LAS bf16x8*)(arow + 64 * ks);
#pragma unroll
            for (int nb = 0; nb < 4; ++nb) { const bf16x8 bb = *(const LAS bf16x8*)(L + DP_KS + DN_TOK(16 * nb + i16) * DP_P + 16 * q + 64 * ks);
                acc[nb] = __builtin_amdgcn_mfma_f32_16x16x32_bf16(a, bb, acc[nb], 0, 0, 0); } }
#pragma unroll
        for (int nb = 0; nb < 4; ++nb)
#pragma unroll
            for (int i = 0; i < 4; ++i) { const int r = 16 * mb + 4 * q + i, c = 16 * nb + i16; const float dec = __expf(SC[64 + r] - SC[64 + c]);
                if (which == 0) ((LAS float*)(L + DP_AS))[r * 68 + c] = (r > c) ? SC[r] * acc[nb][i] * dec : 0.f;
                else *(LAS unsigned short*)(L + DP_QK + r * DP_P2 + c * 2) = (unsigned short)f2bf((r >= c) ? acc[nb][i] * dec : 0.f); }
    }
    LDS_BARRIER();
#pragma unroll 1
    for (int rep = 0; rep < DN_REP_S3B; ++rep) {
    if (wave == 0) {
        const LAS float* As = (const LAS float*)(L + DP_AS); LAS float* Tf = (LAS float*)(L + DP_TF);
        const int g = lane >> 4, c = lane & 15;
        f32x4 ar[16][4];
#pragma unroll
        for (int r = 1; r < 16; ++r)
#pragma unroll
            for (int j4 = 0; j4 < (r + 3) / 4; ++j4) ar[r][j4] = *(const LAS f32x4*)(As + (16 * g + r) * 68 + 16 * g + 4 * j4);
        float t[16];
#pragma unroll
        for (int r = 0; r < 16; ++r) { float a0 = (c == r) ? 1.f : 0.f, a1 = 0.f;
#pragma unroll
            for (int j = 0; j < r; ++j) { const float av = ar[r][j >> 2][j & 3]; if (j & 1) a1 -= av * t[j]; else a0 -= av * t[j]; }
            t[r] = a0 + a1; Tf[(16 * g + r) * 68 + 16 * g + c] = t[r]; }
    }
    LDS_BARRIER();
    if (wave < 3) {
        const LAS float* As = (const LAS float*)(L + DP_AS); LAS float* Tf = (LAS float*)(L + DP_TF); LAS float* Xs = (LAS float*)(L + DP_XS) + wave * 272;
        const int J = wave;
#pragma unroll 1
        for (int I = J + 1; I < 4; ++I) {
            f32x4 acc = {0.f, 0.f, 0.f, 0.f};
#pragma unroll 1
            for (int K = J; K < I; ++K)
#pragma unroll
                for (int sk = 0; sk < 4; ++sk) acc = __builtin_amdgcn_mfma_f32_16x16x4f32(As[(16 * I + i16) * 68 + 16 * K + 4 * sk + q], Tf[(16 * K + 4 * sk + q) * 68 + 16 * J + i16], acc, 0, 0, 0);
#pragma unroll
            for (int i = 0; i < 4; ++i) Xs[(4 * q + i) * 17 + i16] = acc[i];
            LDS_WAIT(); asm volatile("" ::: "memory");
            f32x4 acc2 = {0.f, 0.f, 0.f, 0.f};
#pragma unroll
            for (int sk = 0; sk < 4; ++sk) acc2 = __builtin_amdgcn_mfma_f32_16x16x4f32(Tf[(16 * I + i16) * 68 + 16 * I + 4 * sk + q], Xs[(4 * sk + q) * 17 + i16], acc2, 0, 0, 0);
#pragma unroll
            for (int i = 0; i < 4; ++i) Tf[(16 * I + 4 * q + i) * 68 + 16 * J + i16] = -acc2[i];
            LDS_WAIT(); asm volatile("" ::: "memory");
        }
    }
    LDS_BARRIER();
    { const LAS float* Tf = (const LAS float*)(L + DP_TF); const int r = F.tid >> 3, c0 = (F.tid & 7) * 8; float vb[8], vw[8];
#pragma unroll
      for (int k = 0; k < 8; ++k) { const int c = c0 + k; const float v = ((r >> 4) >= (c >> 4)) ? Tf[r * 68 + c] : 0.f; const float bl = SC[c]; vb[k] = v * bl; vw[k] = vb[k] * SC[128 + c]; }
      v4u ob, ow; ob.x = pk2(vb[0], vb[1]); ob.y = pk2(vb[2], vb[3]); ob.z = pk2(vb[4], vb[5]); ob.w = pk2(vb[6], vb[7]); ow.x = pk2(vw[0], vw[1]); ow.y = pk2(vw[2], vw[3]); ow.z = pk2(vw[4], vw[5]); ow.w = pk2(vw[6], vw[7]);
      *(LAS v4u*)(L + DP_TB + r * DP_P2 + c0 * 2) = ob; *(LAS v4u*)(L + DP_TW + r * DP_P2 + c0 * 2) = ow; }
    }
    LDS_BARRIER();
    {
        const int nbp = wave & 3, which = wave >> 2;
        f32x4 acc[4][2];
#pragma unroll
        for (int mb = 0; mb < 4; ++mb) { acc[mb][0] = (f32x4){0.f, 0.f, 0.f, 0.f}; acc[mb][1] = (f32x4){0.f, 0.f, 0.f, 0.f}; }
#pragma unroll
        for (int ks = 0; ks < 2; ++ks) {
            bf16x8 bb[2];
#pragma unroll
            for (int nn = 0; nn < 2; ++nn) { const int n = 16 * (2 * nbp + nn) + i16; unsigned short e[8];
#pragma unroll
                for (int jj = 0; jj < 8; ++jj) e[jj] = lds_u16(L + (which ? DP_KS : DP_VS) + DN_TOK(32 * ks + 8 * q + jj) * DP_P + n * 2);
                v4u w; w.x = e[0] | ((unsigned)e[1] << 16); w.y = e[2] | ((unsigned)e[3] << 16); w.z = e[4] | ((unsigned)e[5] << 16); w.w = e[6] | ((unsigned)e[7] << 16); bb[nn] = __builtin_bit_cast(bf16x8, w); }
#pragma unroll
            for (int mb = 0; mb < 4; ++mb) { const bf16x8 a = *(const LAS bf16x8*)(L + (which ? DP_TW : DP_TB) + (16 * mb + i16) * DP_P2 + 64 * ks + 16 * q);
                acc[mb][0] = __builtin_amdgcn_mfma_f32_16x16x32_bf16(a, bb[0], acc[mb][0], 0, 0, 0); acc[mb][1] = __builtin_amdgcn_mfma_f32_16x16x32_bf16(a, bb[1], acc[mb][1], 0, 0, 0); } }
        if (which == 0) {
#pragma unroll
            for (int mb = 0; mb < 4; ++mb)
#pragma unroll
                for (int nn = 0; nn < 2; ++nn) *(f32x4*)(tile + DN_U_OFF + (size_t)((((2 * nbp + nn) * 4 + mb) * 64 + lane) * 16)) = acc[mb][nn];
        } else {
#pragma unroll
            for (int mb = 0; mb < 4; ++mb)
#pragma unroll
                for (int nn = 0; nn < 2; ++nn)
#pragma unroll
                    for (int i = 0; i < 4; ++i) *(LAS unsigned short*)(L + DP_AS + (16 * mb + 4 * q + i) * DP_P + (16 * (2 * nbp + nn) + i16) * 2) = (unsigned short)f2bf(-acc[mb][nn][i]);
        }
    }
    LDS_BARRIER();
#pragma unroll 1
    for (int rep = 0; rep < DN_REP_S4; ++rep)
#pragma unroll 1
    for (int fi = 0; fi < 7; ++fi) { const int f = wave * 7 + fi; v4u o;
        if (f < DN_F_QG) { const int mb = f >> 2, ks = f & 3; const LAS unsigned char* rp = L + DP_AS + (16 * mb + i16) * DP_P + (32 * ks + 4 * q) * 2;
            const v2u a = *(const LAS v2u*)rp, c = *(const LAS v2u*)(rp + 32); o.x = a.x; o.y = a.y; o.z = c.x; o.w = c.y; }
        else if (f < DN_F_QK) { const int ff = f - DN_F_QG, mb = ff >> 2, ks = ff & 3, r = 16 * mb + i16; const LAS unsigned char* rp = L + DP_QS + DN_TOK(r) * DP_P + (32 * ks + 4 * q) * 2; const float eg = SC[128 + r];
            const v2u a = *(const LAS v2u*)rp, c = *(const LAS v2u*)(rp + 32);
            o.x = pk2(bflo(a.x) * eg, bfhi(a.x) * eg); o.y = pk2(bflo(a.y) * eg, bfhi(a.y) * eg); o.z = pk2(bflo(c.x) * eg, bfhi(c.x) * eg); o.w = pk2(bflo(c.y) * eg, bfhi(c.y) * eg); }
        else if (f < DN_F_KGT) { const int ff = f - DN_F_QK, mb = ff >> 1, ks = ff & 1; const LAS unsigned char* rp = L + DP_QK + (16 * mb + i16) * DP_P2 + (32 * ks + 4 * q) * 2;
            const v2u a = *(const LAS v2u*)rp, c = *(const LAS v2u*)(rp + 32); o.x = a.x; o.y = a.y; o.z = c.x; o.w = c.y; }
        else { const int ff = f - DN_F_KGT, mb = ff >> 1, ks = ff & 1, dk = 16 * mb + i16; float e[8];
#pragma unroll
            for (int jj = 0; jj < 8; ++jj) { const int key = 32 * ks + 16 * (jj >> 2) + 4 * q + (jj & 3); e[jj] = bf2f(lds_u16(L + DP_KS + DN_TOK(key) * DP_P + dk * 2)) * SC[192 + key]; }
            o.x = pk2(e[0], e[1]); o.y = pk2(e[2], e[3]); o.z = pk2(e[4], e[5]); o.w = pk2(e[6], e[7]); }
        *(v4u*)(tile + (size_t)f * 1024 + lane * 16) = o; }
#undef DN_TOK
}
__device__ __forceinline__ void dn_prep(Frame& F, int l) {
    for (int u = F.bid; u < NCT * 4 * 2; u += F.G) dn_prep_unit(F, l, u >> 3, (u >> 1) & 3, u & 1);
    __syncthreads();
}

__device__ __forceinline__ void dn_scan(Frame& F, int l, int b, int h, int dir, int half) {
    int lane = F.lane; asm volatile("" : "+v"(lane));
    const int w = (DN_SPLIT == 2) ? half * 4 + (F.wave & 3) : F.wave, i16 = lane & 15, q = lane >> 4; const bool active = (DN_SPLIT == 2) ? (F.wave < 4) : true;
    const unsigned char* tiles = F.ws + WS_DNT + (size_t)dn_rec(b, h, dir, 0) * DNT_BYTES;
    const float* egl = (const float*)(F.ws + WS_DNS) + dn_rec(b, h, dir, 0);
    float* O = (float*)(F.ws + WS_DNO);
    LAS unsigned char* L = F.lds;
    f32x4 S[8];
#pragma unroll
    for (int i = 0; i < 8; ++i) S[i] = (f32x4){0.f, 0.f, 0.f, 0.f};
    v4u st[7]; f32x4 un[4];
#pragma unroll
    for (int mb = 0; mb < 4; ++mb) un[mb] = *(const f32x4*)(tiles + DN_U_OFF + (size_t)(((w * 4 + mb) * 64 + lane) * 16));
    LDS_BARRIER();
#pragma unroll
    for (int i = 0; i < 7; ++i) st[i] = *(const v4u*)(tiles + (size_t)(F.tid + i * NTHREADS) * 16);
#pragma unroll
    for (int i = 0; i < 7; ++i) *(LAS v4u*)(L + (F.tid + i * NTHREADS) * 16) = st[i];
#pragma unroll
    for (int i = 0; i < 7; ++i) st[i] = *(const v4u*)(tiles + DNT_BYTES + (size_t)(F.tid + i * NTHREADS) * 16);
    LDS_BARRIER();
#pragma unroll 1
    for (int n = 0; n < 68; ++n) {
        const unsigned char* tile = tiles + (size_t)n * DNT_BYTES; const LAS unsigned char* cur = L + (n & 1) * 57344;
        if (n + 1 < 68) {
#pragma unroll
            for (int i = 0; i < 7; ++i) *(LAS v4u*)(L + ((n + 1) & 1) * 57344 + (F.tid + i * NTHREADS) * 16) = st[i]; }
        if (n + 2 < 68) {
#pragma unroll
            for (int i = 0; i < 7; ++i) st[i] = *(const v4u*)(tile + 2 * DNT_BYTES + (size_t)(F.tid + i * NTHREADS) * 16); }
        if (active) {
        f32x4 vn[4];
#pragma unroll
        for (int mb = 0; mb < 4; ++mb) vn[mb] = un[mb];
        if (n + 1 < 68) {
#pragma unroll
            for (int mb = 0; mb < 4; ++mb) un[mb] = *(const f32x4*)(tile + DNT_BYTES + DN_U_OFF + (size_t)(((w * 4 + mb) * 64 + lane) * 16)); }
        const float el = egl[n];
        bf16x8 bS[4];
#pragma unroll
        for (int ks = 0; ks < 4; ++ks) { v4u x; x.x = pk2(S[2 * ks][0], S[2 * ks][1]); x.y = pk2(S[2 * ks][2], S[2 * ks][3]); x.z = pk2(S[2 * ks + 1][0], S[2 * ks + 1][1]); x.w = pk2(S[2 * ks + 1][2], S[2 * ks + 1][3]); bS[ks] = __builtin_bit_cast(bf16x8, x); }
        f32x4 o[4];
#pragma unroll
        for (int mb = 0; mb < 4; ++mb) { o[mb] = (f32x4){0.f, 0.f, 0.f, 0.f};
#pragma unroll
            for (int ks = 0; ks < 4; ++ks) { const bf16x8 aw = *(const LAS bf16x8*)(cur + (DN_F_NEGW + mb * 4 + ks) * 1024 + lane * 16), aq = *(const LAS bf16x8*)(cur + (DN_F_QG + mb * 4 + ks) * 1024 + lane * 16);
                vn[mb] = __builtin_amdgcn_mfma_f32_16x16x32_bf16(aw, bS[ks], vn[mb], 0, 0, 0); o[mb] = __builtin_amdgcn_mfma_f32_16x16x32_bf16(aq, bS[ks], o[mb], 0, 0, 0); } }
        bf16x8 bV[2];
#pragma unroll
        for (int ks = 0; ks < 2; ++ks) { v4u x; x.x = pk2(vn[2 * ks][0], vn[2 * ks][1]); x.y = pk2(vn[2 * ks][2], vn[2 * ks][3]); x.z = pk2(vn[2 * ks + 1][0], vn[2 * ks + 1][1]); x.w = pk2(vn[2 * ks + 1][2], vn[2 * ks + 1][3]); bV[ks] = __builtin_bit_cast(bf16x8, x); }
#pragma unroll
        for (int mb = 0; mb < 8; ++mb) { S[mb] = S[mb] * el;
#pragma unroll
            for (int ks = 0; ks < 2; ++ks) { const bf16x8 ak = *(const LAS bf16x8*)(cur + (DN_F_KGT + mb * 2 + ks) * 1024 + lane * 16); S[mb] = __builtin_amdgcn_mfma_f32_16x16x32_bf16(ak, bV[ks], S[mb], 0, 0, 0); } }
#pragma unroll
        for (int mb = 0; mb < 4; ++mb)
#pragma unroll
            for (int ks = 0; ks < 2; ++ks) { const bf16x8 aqk = *(const LAS bf16x8*)(cur + (DN_F_QK + mb * 2 + ks) * 1024 + lane * 16); o[mb] = __builtin_amdgcn_mfma_f32_16x16x32_bf16(aqk, bV[ks], o[mb], 0, 0, 0); }
        { int m0; if (n < 4) m0 = NLAT + b * CTXL + 64 * (dir ? 3 - n : n); else m0 = b * SEQ + 64 * (dir ? 63 - (n - 4) : (n - 4));
#pragma unroll
          for (int mb = 0; mb < 4; ++mb)
#pragma unroll
            for (int i = 0; i < 4; ++i) { const int r = 16 * mb + 4 * q + i, tok = dir ? 63 - r : r; O[((size_t)dir * NTOK + m0 + tok) * 512 + h * 128 + 16 * w + i16] = o[mb][i]; } }
        }
        LDS_BARRIER();
    }
}
#define USE_CHUNK_LRU 1

constexpr int LR_XF = 0  , LR_XB = 16640  , LR_WT = 25856  , LR_AA = 62720  , LR_UU = 96000  , LR_END = 129280;
constexpr size_t WS_LCA = WS_LRC, WS_LCH = WS_LRC + 2 * MiB, WS_LCI = WS_LRC + 4 * MiB;
__device__ __forceinline__ void lru_prep(Frame& F, int l) {
    const bf16* P = (const bf16*)(F.ws + WS_P);
    int lane = F.lane; asm volatile("" : "+v"(lane));
    const int wave = F.wave, i16 = lane & 15, q = lane >> 4, nb = F.bid & 7;
    LAS unsigned char* L = F.lds;
    LAS float* XF = (LAS float*)(L + LR_XF); LAS float* AA = (LAS float*)(L + LR_AA); LAS float* UU = (LAS float*)(L + LR_UU);
    bf16* HL = (bf16*)(F.ws + WS_LRH); bf16* AC = (bf16*)(F.ws + WS_LRA);
    __syncthreads();
    for (int e = F.tid; e < 4 * 4096; e += NTHREADS) { const int mat = e >> 12, ii = (e >> 6) & 63, j = e & 63, dir = mat >> 1;
        const float w = (mat & 1 ? F.in[I_LRWI] : F.in[I_LRWR])[((size_t)((l * 2 + dir) * 8 + nb)) * 4096 + ii * 64 + j];
        *(LAS unsigned short*)(L + LR_WT + (mat * 64 + j) * 144 + ii * 2) = (unsigned short)f2bf(w); }
    float cwv[4][8], cbv[8];
    { const int c8 = (F.tid & 7) * 8, ch0 = nb * 64 + c8; const float* cb = F.in[I_LRCB] + l * 512 + ch0; const float* cw = F.in[I_LRCW] + (size_t)l * 4 * 512 + ch0;
#pragma unroll
      for (int k = 0; k < 8; ++k) cbv[k] = cb[k];
#pragma unroll
      for (int j = 0; j < 4; ++j)
#pragma unroll
        for (int k = 0; k < 8; ++k) cwv[j][k] = cw[j * 512 + k]; }
    float gbr[4], gbi[4], gls[4];
    { const int dir = wave >> 2;
#pragma unroll
      for (int n = 0; n < 4; ++n) { const int ch = nb * 64 + 16 * n + i16; gbr[n] = F.in[I_LRBR][(l * 2 + dir) * 512 + ch]; gbi[n] = F.in[I_LRBI][(l * 2 + dir) * 512 + ch]; gls[n] = -softplusf_(-F.in[I_LRLAM][(l * 2 + dir) * 512 + ch]); } }
    v4u wv[4];
#define LR_LOADRAW(ctx) do { const int _m0 = (ctx) * 64; int _t0, _T, _base; seq_of(_m0, _t0, _T, _base); const int _tok = F.tid >> 3, _ch0 = nb * 64 + (F.tid & 7) * 8; \
        _Pragma("unroll") for (int j = 0; j < 4; ++j) { const int tt = _t0 + _tok + j - 2; wv[j] = (v4u){0u, 0u, 0u, 0u}; if (tt >= 0 && tt < _T) wv[j] = *(const v4u*)(P + (size_t)(_base + tt) * PW + PC_LX + _ch0); } } while (0)
    if ((F.bid >> 3) < NCT) LR_LOADRAW(F.bid >> 3);
    for (int ct = F.bid >> 3; ct < NCT; ct += F.G >> 3) {
        const int m0 = ct * 64;
        LDS_BARRIER();
        { const int tok = F.tid >> 3, c8 = (F.tid & 7) * 8, ch0 = nb * 64 + c8; float s[8];
#pragma unroll
          for (int k = 0; k < 8; ++k) s[k] = cbv[k];
#pragma unroll
          for (int j = 0; j < 4; ++j) { const v4u w = wv[j];
              s[0] += cwv[j][0] * bflo(w.x); s[1] += cwv[j][1] * bfhi(w.x); s[2] += cwv[j][2] * bflo(w.y); s[3] += cwv[j][3] * bfhi(w.y); s[4] += cwv[j][4] * bflo(w.z); s[5] += cwv[j][5] * bfhi(w.z); s[6] += cwv[j][6] * bflo(w.w); s[7] += cwv[j][7] * bfhi(w.w); }
#pragma unroll
          for (int k = 0; k < 8; ++k) XF[tok * 65 + c8 + k] = s[k];
          v4u o; o.x = pk2(s[0], s[1]); o.y = pk2(s[2], s[3]); o.z = pk2(s[4], s[5]); o.w = pk2(s[6], s[7]); *(LAS v4u*)(L + LR_XB + tok * 144 + c8 * 2) = o; }
        if (ct + (F.G >> 3) < NCT) LR_LOADRAW(ct + (F.G >> 3));
        LDS_BARRIER();
        { const int dir = wave >> 2, mb = wave & 3;
          f32x4 ar[4], ai[4];
#pragma unroll
          for (int n = 0; n < 4; ++n) { ar[n] = (f32x4){0.f, 0.f, 0.f, 0.f}; ai[n] = (f32x4){0.f, 0.f, 0.f, 0.f}; }
#pragma unroll
          for (int ks = 0; ks < 2; ++ks) { const bf16x8 a = *(const LAS bf16x8*)(L + LR_XB + (16 * mb + i16) * 144 + 64 * ks + 16 * q);
#pragma unroll
              for (int n = 0; n < 4; ++n) { const bf16x8 br = *(const LAS bf16x8*)(L + LR_WT + ((dir * 2 + 0) * 64 + 16 * n + i16) * 144 + 64 * ks + 16 * q), bi = *(const LAS bf16x8*)(L + LR_WT + ((dir * 2 + 1) * 64 + 16 * n + i16) * 144 + 64 * ks + 16 * q);
                  ar[n] = __builtin_amdgcn_mfma_f32_16x16x32_bf16(a, br, ar[n], 0, 0, 0); ai[n] = __builtin_amdgcn_mfma_f32_16x16x32_bf16(a, bi, ai[n], 0, 0, 0); } }
#pragma unroll
          for (int n = 0; n < 4; ++n) { const int j = 16 * n + i16; const float br_ = gbr[n], bi_ = gbi[n], logsig = gls[n];
#pragma unroll
              for (int i = 0; i < 4; ++i) { const int tok = 16 * mb + 4 * q + i; const float r = sigmoidf_(ar[n][i] + br_), ig = sigmoidf_(ai[n][i] + bi_);
                  const float log_a = 8.0f * r * logsig, a = __expf(log_a), y2 = 2.0f * log_a;
                  const float om = (y2 > -0.1f) ? -y2 * (1.0f + y2 * (0.5f + y2 * (0.16666667f + y2 * 0.041666668f))) : 1.0f - __expf(y2);
                  const float u = __builtin_amdgcn_sqrtf(om) * (ig * XF[tok * 65 + j]);
                  AA[(dir * 64 + tok) * 65 + j] = a; UU[(dir * 64 + tok) * 65 + j] = u; } } }
        LDS_BARRIER();
        if (F.tid < 128) { const int dir = F.tid >> 6, j = F.tid & 63, ch = nb * 64 + j; float h = 0.f, ac = 1.f;
            long o = (long)(((size_t)dir * NTOK + m0 + (dir ? 63 : 0)) * 512 + ch); const long ostep = dir ? -512 : 512;
#pragma unroll 1
            for (int s0 = 0; s0 < 64; s0 += 8) { float av[8], uv[8];
#pragma unroll
                for (int k = 0; k < 8; ++k) { const int tok = dir ? 63 - (s0 + k) : (s0 + k); av[k] = AA[(dir * 64 + tok) * 65 + j]; uv[k] = UU[(dir * 64 + tok) * 65 + j]; }
#pragma unroll
                for (int k = 0; k < 8; ++k) { h = av[k] * h + uv[k]; ac *= av[k]; HL[o] = (bf16)f2bf(h); AC[o] = (bf16)f2bf(ac); o += ostep; } }
            ((float*)(F.ws + WS_LCA))[((size_t)dir * NCT + ct) * 512 + ch] = ac; ((float*)(F.ws + WS_LCH))[((size_t)dir * NCT + ct) * 512 + ch] = h; }
    }
    LDS_BARRIER();
}
__device__ __forceinline__ void lru_carry(Frame& F, int idx) {
    const int ch = idx & 511, dir = (idx >> 9) & 1, b = idx >> 10;
    const float* CA = (const float*)(F.ws + WS_LCA); const float* CH = (const float*)(F.ws + WS_LCH); float* CI = (float*)(F.ws + WS_LCI);
    float h = 0.f;
#pragma unroll 4
    for (int n = 0; n < 68; ++n) { const int ct = n < 4 ? 256 + b * 4 + (dir ? 3 - n : n) : b * 64 + (dir ? 63 - (n - 4) : (n - 4)); const size_t o = ((size_t)dir * NCT + ct) * 512 + ch;
        CI[o] = h; h = CA[o] * h + CH[o]; }
}
__device__ __forceinline__ void lru_fin(Frame& F, int l) {
    const int nrows = (l == 0) ? NTOK : NLAT;
    const bf16* P = (const bf16*)(F.ws + WS_P); bf16* CC = (bf16*)(F.ws + WS_CC);
    const bf16* HL = (const bf16*)(F.ws + WS_LRH); const bf16* AC = (const bf16*)(F.ws + WS_LRA); const float* CI = (const float*)(F.ws + WS_LCI);
    for (size_t i = (size_t)F.bid * NTHREADS + F.tid; i < (size_t)nrows * 128; i += (size_t)F.G * NTHREADS) { const int m = (int)(i >> 7), c4 = (int)(i & 127) * 4, ct = m >> 6;
        const v2u hw0 = *(const v2u*)(HL + (size_t)m * 512 + c4), aw0 = *(const v2u*)(AC + (size_t)m * 512 + c4), hw1 = *(const v2u*)(HL + ((size_t)NTOK + m) * 512 + c4), aw1 = *(const v2u*)(AC + ((size_t)NTOK + m) * 512 + c4);
        const f32x4 h0 = {bflo(hw0.x), bfhi(hw0.x), bflo(hw0.y), bfhi(hw0.y)}, a0 = {bflo(aw0.x), bfhi(aw0.x), bflo(aw0.y), bfhi(aw0.y)}, h1 = {bflo(hw1.x), bfhi(hw1.x), bflo(hw1.y), bfhi(hw1.y)}, a1 = {bflo(aw1.x), bfhi(aw1.x), bflo(aw1.y), bfhi(aw1.y)};
        const f32x4 i0 = *(const f32x4*)(CI + (size_t)ct * 512 + c4), i1 = *(const f32x4*)(CI + ((size_t)NCT + ct) * 512 + c4);
        const f32x4 hs = (a0 * i0 + h0) + (a1 * i1 + h1); const v2u yw = *(const v2u*)(P + (size_t)m * PW + PC_LY + c4);
        v2u o; o.x = pk2(hs.x * gelu_tanh(bflo(yw.x)), hs.y * gelu_tanh(bfhi(yw.x))); o.y = pk2(hs.z * gelu_tanh(bflo(yw.y)), hs.w * gelu_tanh(bfhi(yw.y)));
        *(v2u*)(CC + (size_t)m * DM + 1536 + c4) = o; }
}

constexpr size_t WS_DNQ = WS_DNT;
constexpr size_t WS_BG = WS_DNS + 1 * MiB;
constexpr size_t WS_XC = WS_XS;

__device__ __forceinline__ void naive_prep(Frame& F, int l) {
    const bf16* P = (const bf16*)(F.ws + WS_P);
    const int gw = F.bid * NWAVES + F.wave, NGW = F.G * NWAVES;
#if !defined(USE_CHUNK_DN)
    {
        float* DNQ = (float*)(F.ws + WS_DNQ); float* BG = (float*)(F.ws + WS_BG);
        const float* cw = F.in[I_DNCW] + (size_t)l * 4 * 1536;
        for (int it = gw; it < NTOK * 4; it += NGW) {
            const int m = it >> 2, h = it & 3; int t, T, base; seq_of(m, t, T, base);
            float val[3][2];
#pragma unroll
            for (int part = 0; part < 3; ++part)
#pragma unroll
                for (int dd = 0; dd < 2; ++dd) { const int d = F.lane + 64 * dd, cch = part * 512 + h * 128 + d, col = PC_DQ + cch; float s = 0.f;
#pragma unroll
                    for (int j = 0; j < 4; ++j) { const int tt = t + j - 2; if (tt >= 0 && tt < T) s += cw[j * 1536 + cch] * bf2f(P[(size_t)(base + tt) * PW + col]); }
                    val[part][dd] = siluf_(s); }
            const float sq = wave_sum(val[0][0] * val[0][0] + val[0][1] * val[0][1]), sk = wave_sum(val[1][0] * val[1][0] + val[1][1] * val[1][1]);
            const float fq = 0.08838834764831845f / sqrtf(sq + EPS), fk = 1.0f / sqrtf(sk + EPS);
#pragma unroll
            for (int dd = 0; dd < 2; ++dd) { const int d = F.lane + 64 * dd; float* o = DNQ + (size_t)m * 1536 + h * 128 + d;
                o[0] = val[0][dd] * fq; o[512] = val[1][dd] * fk; o[1024] = val[2][dd]; }
            if (h == 0 && F.lane < 8) { const int dir = F.lane >> 2, hh = F.lane & 3;
                const float pb = bf2f(P[(size_t)m * PW + PC_BETA + F.lane]), pa = bf2f(P[(size_t)m * PW + PC_DEC + F.lane]);
                BG[m * 16 + F.lane] = sigmoidf_(pb);
                BG[m * 16 + 8 + F.lane] = -__expf(F.in[I_DNALOG][l * 8 + dir * 4 + hh]) * softplusf_(pa + F.in[I_DNDT][l * 8 + dir * 4 + hh]); }
        }
    }
#endif
#if !defined(USE_CHUNK_LRU)
    {
        LAS float* xc = (LAS float*)F.lds;
        float* A = (float*)(F.ws + WS_LRA); float* U = (float*)(F.ws + WS_LRH);
        const float* cw = F.in[I_LRCW] + (size_t)l * 4 * 512; const float* cb = F.in[I_LRCB] + l * 512;
        for (int m0 = F.bid * 8; m0 < NTOK; m0 += F.G * 8) {
            __syncthreads();
            for (int i = F.tid; i < 8 * 512; i += NTHREADS) { const int m = m0 + (i >> 9), ch = i & 511; int t, T, base; seq_of(m, t, T, base); float s = cb[ch];
#pragma unroll
                for (int j = 0; j < 4; ++j) { const int tt = t + j - 2; if (tt >= 0 && tt < T) s += cw[j * 512 + ch] * bf2f(P[(size_t)(base + tt) * PW + PC_LX + ch]); }
                xc[i] = s; }
            __syncthreads();
            for (int i = F.tid; i < 8 * 512 * 2; i += NTHREADS) { const int ch = i & 511, dir = (i >> 9) & 1, tk = i >> 10, m = m0 + tk, blk = ch >> 6, j = ch & 63;
                const float* wr = F.in[I_LRWR] + ((size_t)((l * 2 + dir) * 8 + blk)) * 4096 + j; const float* wi = F.in[I_LRWI] + ((size_t)((l * 2 + dir) * 8 + blk)) * 4096 + j;
                float sr = F.in[I_LRBR][(l * 2 + dir) * 512 + ch], si = F.in[I_LRBI][(l * 2 + dir) * 512 + ch];
#pragma unroll 8
                for (int ii = 0; ii < 64; ++ii) { const float x = xc[tk * 512 + blk * 64 + ii]; sr += x * wr[ii * 64]; si += x * wi[ii * 64]; }
                const float r = sigmoidf_(sr), ig = sigmoidf_(si); const float lam = F.in[I_LRLAM][(l * 2 + dir) * 512 + ch];
                const float logsig = -softplusf_(-lam);
                const float log_a = 8.0f * r * logsig; const float a = __expf(log_a);
                const float u = sqrtf(-expm1f(2.0f * log_a)) * (ig * xc[tk * 512 + ch]);
                A[((size_t)dir * NTOK + m) * 512 + ch] = a; U[((size_t)dir * NTOK + m) * 512 + ch] = u; }
        }
        __syncthreads();
    }
#endif
}

__device__ __forceinline__ void naive_attn_row(Frame& F, int l, int m, int hq) {
    const bf16* P = (const bf16*)(F.ws + WS_P); bf16* CC = (bf16*)(F.ws + WS_CC);
    const int d = F.lane, kvh = hq >> 2; int t, T, base; seq_of(m, t, T, base);
    const bool lat = m < NLAT; const int b = lat ? (m >> 12) : ((m - NLAT) >> 8);
    const int dd = d & 31, jf = dd & 15; const float inv = __powf(10000.0f, -(float)jf * (1.0f / 16.0f));
    const bool second = (dd >= 16), colhalf = (d >= 32);
    float q = bf2f(P[(size_t)m * PW + PC_Q + hq * 64 + d]);
    if (lat) { const float pos = (float)(colhalf ? (t & 63) : (t >> 6)); float sn, cs; sincosf(pos * inv, &sn, &cs); const float pr = __shfl_xor(q, 16); q = second ? (q * cs + pr * sn) : (q * cs - pr * sn); }
    q *= 0.125f;
    float mx = F.in[I_SINK][l * 16 + hq], den = 1.0f, acc = 0.f;
    if (lat) { const int t0 = t - 128 < 0 ? 0 : t - 128, t1 = t + 128 > SEQ - 1 ? SEQ - 1 : t + 128;
        for (int tk = t0; tk <= t1; ++tk) { const size_t r = (size_t)(base + tk) * PW; float k = bf2f(P[r + PC_K + kvh * 64 + d]); const float v = bf2f(P[r + PC_V + kvh * 64 + d]);
            const float pos = (float)(colhalf ? (tk & 63) : (tk >> 6)); float sn, cs; sincosf(pos * inv, &sn, &cs); const float pr = __shfl_xor(k, 16); k = second ? (k * cs + pr * sn) : (k * cs - pr * sn);
            const float s = wave_sum(q * k); const float mn = fmaxf(mx, s), f = __expf(mx - mn), p = __expf(s - mn); den = den * f + p; acc = acc * f + p * v; mx = mn; } }
    for (int c = 0; c < CTXL; ++c) { const size_t r = (size_t)(NLAT + b * CTXL + c) * PW; const float k = bf2f(P[r + PC_K + kvh * 64 + d]), v = bf2f(P[r + PC_V + kvh * 64 + d]);
        const float s = wave_sum(q * k); const float mn = fmaxf(mx, s), f = __expf(mx - mn), p = __expf(s - mn); den = den * f + p; acc = acc * f + p * v; mx = mn; }
    CC[(size_t)m * DM + hq * 64 + d] = (bf16)f2bf(acc / den);
}

__device__ __forceinline__ int scan_row(int n, int b, int dir) { if (n < CTXL) { const int t = dir ? (CTXL - 1 - n) : n; return NLAT + b * CTXL + t; } const int t = dir ? (SEQ - 1 - (n - CTXL)) : (n - CTXL); return b * SEQ + t; }
__device__ __forceinline__ void naive_scan(Frame& F, int l, int rep = 0) {
#if defined(USE_CHUNK_DN)
    if (F.bid < 32 * DN_SPLIT) { if (DN_SPLIT == 2) dn_scan(F, l, F.bid >> 4, (F.bid >> 2) & 3, (F.bid >> 1) & 1, F.bid & 1); else dn_scan(F, l, F.bid >> 3, (F.bid >> 1) & 3, F.bid & 1, 0); }
#else
    if (F.bid < 32) {
        const int b = F.bid >> 3, h = (F.bid >> 1) & 3, dir = F.bid & 1, dvc = F.tid & 127, kq = F.tid >> 7;
        const float* DNQ = (const float*)(F.ws + WS_DNQ); const float* BG = (const float*)(F.ws + WS_BG); float* O = (float*)(F.ws + WS_DNO);
        LAS float* buf = (LAS float*)F.lds;
        LAS float* red = buf + 768;
        LAS float* red2 = red + 512;
        float S[32];
#pragma unroll
        for (int i = 0; i < 32; ++i) S[i] = 0.f;
        constexpr int NT = CTXL + SEQ;
        { const int m = scan_row(0, b, dir); if (F.tid < 384) buf[F.tid] = DNQ[(size_t)m * 1536 + (F.tid >> 7) * 512 + h * 128 + (F.tid & 127)]; }
        __syncthreads();
#pragma unroll 1
        for (int n = 0; n < NT; ++n) {
            const int m = scan_row(n, b, dir); const LAS float* cur = buf + (n & 1) * 384;
            float nextv = 0.f; if (n + 1 < NT && F.tid < 384) { const int m2 = scan_row(n + 1, b, dir); nextv = DNQ[(size_t)m2 * 1536 + (F.tid >> 7) * 512 + h * 128 + (F.tid & 127)]; }
            const float beta = BG[m * 16 + dir * 4 + h], decay = __expf(BG[m * 16 + 8 + dir * 4 + h]);
            float ks = 0.f;
#pragma unroll
            for (int i = 0; i < 32; ++i) ks += cur[128 + kq * 32 + i] * S[i];
            red[kq * 128 + dvc] = ks;
            __syncthreads();
            const float kS = (red[dvc] + red[128 + dvc]) + (red[256 + dvc] + red[384 + dvc]);
            const float upd = beta * (cur[256 + dvc] - decay * kS);
            float os = 0.f;
#pragma unroll
            for (int i = 0; i < 32; ++i) { S[i] = decay * S[i] + cur[128 + kq * 32 + i] * upd; os += cur[kq * 32 + i] * S[i]; }
            red2[kq * 128 + dvc] = os;
            if (F.tid < 384) buf[((n + 1) & 1) * 384 + F.tid] = nextv;
            __syncthreads();
            if (kq == 0) O[((size_t)dir * NTOK + m) * 512 + h * 128 + dvc] = (red2[dvc] + red2[128 + dvc]) + (red2[256 + dvc] + red2[384 + dvc]);
        }
    }
#endif
#if defined(USE_CHUNK_LRU)
    else if (F.bid < 32 * DN_SPLIT + 8) { lru_carry(F, (F.bid - 32 * DN_SPLIT) * NTHREADS + F.tid); }
#else
    else if (F.bid < 40) {
        const int idx = (F.bid - 32) * NTHREADS + F.tid, ch = idx & 511, dir = (idx >> 9) & 1, b = idx >> 10;
        const float* A = (const float*)(F.ws + WS_LRA); float* U = (float*)(F.ws + WS_LRH);
        float hs = 0.f;
#pragma unroll 4
        for (int n = 0; n < CTXL + SEQ; ++n) { int m; if (n < CTXL) { const int t = dir ? (CTXL - 1 - n) : n; m = NLAT + b * CTXL + t; } else { const int t = dir ? (SEQ - 1 - (n - CTXL)) : (n - CTXL); m = b * SEQ + t; }
            const size_t o = ((size_t)dir * NTOK + m) * 512 + ch; hs = A[o] * hs + U[o]; U[o] = hs; }
    }
#endif
#if defined(USE_MFMA_ATTN)
    attn_phase(F, l, rep);
    convert_moe_queue(F, l, rep);
#else
    {
        const int nrows = (l == 0) ? NTOK : NLAT;
        for (;;) { int m = 0; if (F.lane == 0) m = (int)__hip_atomic_fetch_add(F.ctl + CW_ATQ + 64 * l, 1u, RLX_AGENT); m = __builtin_amdgcn_readfirstlane(m);
            if (m >= nrows) break;
#pragma unroll 1
            for (int hq = 0; hq < 16; ++hq) naive_attn_row(F, l, m, hq); }
    }
#endif
}

__device__ __forceinline__ void naive_fin(Frame& F, int l) {
    const int nrows = (l == 0) ? NTOK : NLAT;
    const bf16* P = (const bf16*)(F.ws + WS_P); bf16* CC = (bf16*)(F.ws + WS_CC);
    const int gw = F.bid * NWAVES + F.wave, NGW = F.G * NWAVES;
    const float* O = (const float*)(F.ws + WS_DNO); const float* HS = (const float*)(F.ws + WS_LRH);
    for (int it0 = gw * 2; it0 < nrows * 4; it0 += NGW * 2) {
        float2 oa[2], ob[2]; unsigned gw_[2];
#pragma unroll
        for (int k = 0; k < 2; ++k) { const int it = it0 + k, m = it >> 2, h = it & 3; const int c = h * 128 + 2 * F.lane;
            oa[k] = *(const float2*)(O + (size_t)m * 512 + c); ob[k] = *(const float2*)(O + ((size_t)NTOK + m) * 512 + c); gw_[k] = *(const unsigned*)(P + (size_t)m * PW + PC_DG + c); }
        const float2 ng = *(const float2*)(F.in[I_DNNG] + l * 128 + 2 * F.lane);
#pragma unroll
        for (int k = 0; k < 2; ++k) { const int it = it0 + k, m = it >> 2, h = it & 3; const float o0 = oa[k].x + ob[k].x, o1 = oa[k].y + ob[k].y;
            const float rstd = 1.0f / sqrtf(wave_sum(o0 * o0 + o1 * o1) * (1.0f / 128.0f) + EPS);
            *(unsigned*)(CC + (size_t)m * DM + 1024 + h * 128 + 2 * F.lane) = pk2(o0 * rstd * ng.x * siluf_(bflo(gw_[k])), o1 * rstd * ng.y * siluf_(bfhi(gw_[k]))); }
    }
#if defined(USE_CHUNK_LRU)
    lru_fin(F, l);
#else
    for (size_t i = (size_t)F.bid * NTHREADS + F.tid; i < (size_t)nrows * 512; i += (size_t)F.G * NTHREADS) { const int m = (int)(i >> 9), ch = (int)(i & 511);
        const float hsum = HS[(size_t)m * 512 + ch] + HS[((size_t)NTOK + m) * 512 + ch]; const float y = bf2f(P[(size_t)m * PW + PC_LY + ch]);
        CC[(size_t)m * DM + 1536 + ch] = (bf16)f2bf(hsum * gelu_tanh(y)); }
#endif
}
#ifndef PHASE_PREP
#if defined(USE_MFMA_ATTN)
#if defined(USE_CHUNK_DN)
#define PHASE_PREP(F, l) do { attn_prep(F, l); lru_prep(F, l); dn_prep(F, l); } while (0)
#else
#define PHASE_PREP(F, l) do { naive_prep(F, l); attn_prep(F, l); } while (0)
#endif
#else
#define PHASE_PREP(F, l) naive_prep(F, l)
#endif
#endif
#ifndef PHASE_SCAN
#define PHASE_SCAN(F, l) naive_scan(F, l)
#endif
#ifndef PHASE_FIN
#define PHASE_FIN(F, l) naive_fin(F, l)
#endif

#ifndef PHASE_INPROJ
#define PHASE_INPROJ(F, l) do {} while (0)
#endif
#ifndef PHASE_PREP
#define PHASE_PREP(F, l) do {} while (0)
#endif
#ifndef PHASE_SCAN
#define PHASE_SCAN(F, l) do {} while (0)
#endif
#ifndef PHASE_FIN
#define PHASE_FIN(F, l) do {} while (0)
#endif
#ifndef PHASE_OUTPROJ
#define PHASE_OUTPROJ(F, l) do {} while (0)
#endif
#ifndef PHASE_NORM2
#define PHASE_NORM2(F, l) do {} while (0)
#endif
#ifndef PHASE_SCATTER
#define PHASE_SCATTER(F, l) do {} while (0)
#endif
#ifndef PHASE_GEMM1
#define PHASE_GEMM1(F, l) do {} while (0)
#endif
#ifndef PHASE_GEMM2
#define PHASE_GEMM2(F, l) do {} while (0)
#endif

#ifndef MK_SPLIT
#define MK_SPLIT 0
#endif
#ifndef MK_STAGE
#define MK_STAGE 99
#endif
#ifndef MK_TAILFILL
#define MK_TAILFILL 0
#endif
#ifndef MK_DUP
#define MK_DUP 0
#endif
#define DUP(k) ((MK_DUP >> (k)) & 1)
constexpr int N_PHASES = 22;
struct Args { const float* in[N_IN]; float* out; unsigned char* ws; int ph_lo, ph_hi; };
static_assert(sizeof(Args) == (N_IN + 2) * 8 + 8, "Args has no padding");

__global__ void __launch_bounds__(NTHREADS, 2) fwd_kernel(Args args) {
    extern __shared__ __attribute__((aligned(16))) unsigned char lds[];
    Frame F;
    F.lds = (LAS unsigned char*)lds;
    F.MISC = (volatile LAS unsigned*)(F.lds + MISC_OFF);
    F.tid = threadIdx.x; F.lane = F.tid & 63; F.wave = __builtin_amdgcn_readfirstlane(F.tid >> 6);
    F.G = gridDim.x; F.bid = blockIdx.x;
    F.ws = args.ws; F.out = args.out; F.ctl = (gu32*)(args.ws + WS_CTL);
    F.in = (const float* const __attribute__((address_space(4)))*)__builtin_amdgcn_kernarg_segment_ptr();
    for (int u = F.tid; u < (LDS_BYTES - LDSCTL_OFF) / 4; u += NTHREADS) ((LAS unsigned*)(F.lds + LDSCTL_OFF))[u] = 0u;
    __syncthreads();
    XcdBarrier bar; bar.bar = (unsigned*)(F.ctl + CW_BAR); bar.x = 0; bar.st = nullptr;
    if (!MK_SPLIT) bar = xcd_barrier_post((unsigned*)(F.ctl + CW_BAR), F.MISC + 8);
    const int lo = args.ph_lo, hi = args.ph_hi;
#define IN(k) (lo <= (k) && (k) < hi && phase_enter(F))
#define INR(k) (lo <= (k) && (k) < hi)
#define SEAM(k) do { if (INR(k) && INR((k) + 1)) { if (MK_TAILFILL && (k) < 14) tail_fill(F, (k), (k) < 4 ? 0 : 1); xcd_barrier(bar); } } while (0)

    if (IN(0)) { p0_prologue(F); if (DUP(0)) { __syncthreads(); p0_prologue(F); } } SEAM(0);
#pragma unroll 1
    for (int l = 0; l < DEPTH; ++l) {
        const int pb = 1 + 10 * l;
        if (IN(pb + 0)) { phase_norm1(F, l); if (DUP(13) && l == 0) { __syncthreads(); phase_norm1(F, l); } } SEAM(pb + 0);
        if (IN(pb + 1)) { PHASE_INPROJ(F, l); if (DUP(1)) { __syncthreads(); PHASE_INPROJ(F, l); } } SEAM(pb + 1);
        if (IN(pb + 2)) { PHASE_PREP(F, l); if (DUP(2)) { __syncthreads(); dn_prep(F, l); } if (DUP(6)) { __syncthreads(); lru_prep(F, l); } } SEAM(pb + 2);
        if (IN(pb + 3)) { if (DUP(3) && F.bid < 64) dn_scan(F, l, F.bid >> 4, (F.bid >> 2) & 3, (F.bid >> 1) & 1, F.bid & 1); PHASE_SCAN(F, l); if (DUP(10)) { __syncthreads(); naive_scan(F, l, 1); } if (DUP(11)) { __syncthreads(); attn_phase(F, l, 2); } if (DUP(12)) { __syncthreads(); convert_moe_queue(F, l, 3); } } SEAM(pb + 3);
        if (IN(pb + 4)) { PHASE_FIN(F, l); if (DUP(4)) { __syncthreads(); PHASE_FIN(F, l); } } SEAM(pb + 4);
        if (IN(pb + 5)) { PHASE_OUTPROJ(F, l); if (DUP(5) && l == 0) { __syncthreads(); PHASE_OUTPROJ(F, l); } } SEAM(pb + 5);
        if (IN(pb + 6)) { PHASE_NORM2(F, l); } SEAM(pb + 6);
        if (IN(pb + 7)) { PHASE_SCATTER(F, l); if (DUP(7)) { __syncthreads(); PHASE_SCATTER(F, l); } } SEAM(pb + 7);
        if (IN(pb + 8)) { PHASE_GEMM1(F, l); if (DUP(8)) { __syncthreads(); PHASE_GEMM1(F, l); } } SEAM(pb + 8);
        if (IN(pb + 9)) { PHASE_GEMM2(F, l); if (DUP(9)) { __syncthreads(); PHASE_GEMM2(F, l); } } SEAM(pb + 9);
    }
    if (IN(21)) { phase_final(F, MK_STAGE >= 9); if (DUP(13)) { __syncthreads(); phase_final(F, MK_STAGE >= 9); } }
#undef IN
#undef SEAM
}

extern "C" void kernel_launch(void* const* d_in, const int* in_sizes, int n_in, void* d_out, int out_size, void* d_ws, size_t ws_size, hipStream_t stream) {
    static int grid = 0;
    if (grid == 0) {
        if (n_in != N_IN || out_size != NLAT * DM || ws_size < WS_END) { fprintf(stderr, "kernel_launch: unexpected shapes (n_in %d, out %d, ws %zu); nothing launched\n", n_in, out_size, ws_size); grid = -1; return; }
        int dev = 0, cus = 0, per_cu = 0;
        if (hipGetDevice(&dev) != hipSuccess || hipDeviceGetAttribute(&cus, hipDeviceAttributeMultiprocessorCount, dev) != hipSuccess) { grid = -1; return; }
        if (hipFuncSetAttribute((const void*)fwd_kernel, hipFuncAttributeMaxDynamicSharedMemorySize, LDS_BYTES) != hipSuccess) { fprintf(stderr, "kernel_launch: hipFuncSetAttribute failed\n"); grid = -1; return; }
        if (hipOccupancyMaxActiveBlocksPerMultiprocessor(&per_cu, (const void*)fwd_kernel, NTHREADS, LDS_BYTES) != hipSuccess || per_cu < 1) { fprintf(stderr, "kernel_launch: occupancy query says %d\n", per_cu); }
        (void)hipGetLastError();
        grid = cus;
        if (grid != 256) { fprintf(stderr, "kernel_launch: built for 256 CUs, device has %d; nothing launched\n", cus); grid = -1; return; }
    }
    if (grid < 0) return;
    if (hipMemsetAsync((char*)d_ws + WS_CTL, 0, CTL_ZERO_BYTES, stream) != hipSuccess) return;
    Args a{};
    for (int i = 0; i < N_IN; ++i) a.in[i] = (const float*)d_in[i];
    a.out = (float*)d_out; a.ws = (unsigned char*)d_ws;
#if MK_SPLIT
    for (int p = 0; p < N_PHASES; ++p) { a.ph_lo = p; a.ph_hi = p + 1; hipLaunchKernelGGL(fwd_kernel, dim3(grid), dim3(NTHREADS), LDS_BYTES, stream, a); }
#else
    a.ph_lo = 0; a.ph_hi = N_PHASES;
    hipLaunchKernelGGL(fwd_kernel, dim3(grid), dim3(NTHREADS), LDS_BYTES, stream, a);
#endif
    const hipError_t le = hipPeekAtLastError();
    if (le != hipSuccess) fprintf(stderr, "kernel_launch: launch failed: %s\n", hipGetErrorName(le));
}
```

```cpp
#include <hip/hip_runtime.h>
#include <cstdio>
#include <cstdint>

constexpr int DM = 2048, NB = 4, SEQ = 4096, CTXL = 256, DEPTH = 2;
constexpr int NLAT = NB * SEQ, NCTX = NB * CTXL, NTOK = NLAT + NCTX;
constexpr int NCT = NTOK / 64;
constexpr int IN_W = 4624, PW = 4864;
constexpr int PC_Q = 0, PC_K = 1024, PC_V = 1280, PC_DQ = 1536, PC_DK = 2048, PC_DV = 2560, PC_DG = 3072, PC_LX = 3584, PC_LY = 4096, PC_BETA = 4608, PC_DEC = 4616;
constexpr int NEXP = 32, TOPK = 4, DEXP = 1024;
constexpr int MOE_ROWS = 304 * 256;
constexpr float EPS = 1e-6f;
#ifndef MK_STAGE
#define MK_STAGE 99
#endif
namespace pg8 {
#define PG8_LAS __attribute__((address_space(3)))
typedef unsigned short bf16_t;
typedef short bf16x8 __attribute__((ext_vector_type(8)));
typedef float f32x4 __attribute__((ext_vector_type(4)));
typedef unsigned u32x4 __attribute__((ext_vector_type(4)));
typedef float f32x2 __attribute__((ext_vector_type(2)));
constexpr int BM = 256, BK = 64, HALF = 128, HTB = HALF * BK * 2  , STAGE_BYTES = 8 * HTB, NXCD = 8, WGM = 8;

__host__ __device__ __forceinline__ int lds_byte(int r, int c) { const int st = (r >> 4) * 2 + (c >> 5), rr = r & 15, cc = c & 31, ob = rr * 64 + cc * 2; return st * 1024 + (ob ^ (((ob >> 9) & 1) << 5)); }
__host__ __device__ __forceinline__ void stage_rc(int b, int& R, int& C) { const int st = b / 1024, sb = b % 1024, swz = sb ^ (((sb >> 9) & 1) << 5); R = (st >> 1) * 16 + swz / 64; C = (st & 1) * 32 + (swz % 64) / 2; }
__host__ __device__ __forceinline__ int perm32(int rho) { const int n = rho >> 4, i = rho & 15; return 8 * (i >> 2) + 4 * n + (i & 3); }

struct Unit { int pm, pn, e; };
typedef int v4i_t __attribute__((ext_vector_type(4)));
typedef int v8i_t __attribute__((ext_vector_type(8)));
struct Gemm { const bf16_t* A; const bf16_t* Bt; int M, N, K; int bscale = 0x7F7F7F7F; };

struct StaticOrder {
    static constexpr bool GATHER = false; const int* row_tab = nullptr;
    int nM, nN, nwg, G, c; const char* A; const char* Bt; size_t tstep;
    __device__ void init(const Gemm& g, int G_, int c_) { nM = g.M / BM; nN = g.N / BM; nwg = nM * nN; G = G_; c = c_; A = (const char*)g.A; Bt = (const char*)g.Bt; tstep = (size_t)BM * g.K * 2; }
    __device__ bool next(int i, Unit& u) const {
        const long L = (long)i * G + c; if (L >= nwg) return false;
        int wgid = (int)L; { const int q = nwg / NXCD, r = nwg % NXCD, xcd = wgid % NXCD, off = wgid / NXCD; wgid = (xcd < r ? xcd * (q + 1) : r * (q + 1) + (xcd - r) * q) + off; }
        const int nig = WGM * nN, gid = wgid / nig, fm = gid * WGM, gsz = (nM - fm) < WGM ? (nM - fm) : WGM;
        u.pm = fm + ((wgid % nig) % gsz); u.pn = (wgid % nig) / gsz; u.e = 0; return true;
    }
    __device__ __forceinline__ const char* a_ptr(const Unit& u) const { return A + (size_t)u.pm * tstep; }
    __device__ __forceinline__ const char* b_ptr(const Unit& u) const { return Bt + (size_t)u.pn * tstep; }
    __device__ __forceinline__ void a_ready(const Unit&) const {}
    __device__ __forceinline__ void done(const Unit&) const {}
};
__device__ __forceinline__ unsigned cvt_pk_bf16(float lo, float hi) { unsigned r; asm volatile("v_cvt_pk_bf16_f32 %0, %1, %2" : "=v"(r) : "v"(lo), "v"(hi)); return r; }
struct EpiBf16Plain {
    static constexpr bool PERM = true, AFTER_DRAIN = false;
    bf16_t* O; int ldc;
    __device__ __forceinline__ void operator()(const f32x4 (&acc)[2][2][4][2], const Unit& u, int wr, int wc, int fr, int fq) const {
        const int row0 = u.pm * BM + wr * 64 + fr, col0 = u.pn * BM + wc * 32 + 8 * fq;
#pragma unroll
        for (int ai = 0; ai < 2; ++ai)
#pragma unroll
            for (int m = 0; m < 4; ++m) { bf16_t* rowp = O + (size_t)(row0 + ai * HALF + m * 16) * ldc + col0;
#pragma unroll
                for (int bj = 0; bj < 2; ++bj) { const f32x4 v0 = acc[ai][bj][m][0], v1 = acc[ai][bj][m][1];
                    u32x4 w; w.x = cvt_pk_bf16(v0[0], v0[1]); w.y = cvt_pk_bf16(v0[2], v0[3]); w.z = cvt_pk_bf16(v1[0], v1[1]); w.w = cvt_pk_bf16(v1[2], v1[3]);
                    *(u32x4*)(rowp + bj * HALF) = w; } }
    }
};
struct EpiResGate {
    static constexpr bool PERM = false, AFTER_DRAIN = false;
    const float* base_lat; const float* base_ctx; float* out; const float* modg;
    __device__ __forceinline__ void operator()(const f32x4 (&acc)[2][2][4][2], const Unit& u, int wr, int wc, int fr, int fq) const {
        const int r = u.pm < 64 ? (u.pm >> 4) : 4; const int col0 = u.pn * BM + wc * 32 + 4 * fq;
        const float* g = modg + (size_t)r * 12288 + col0;
        f32x4 gv[2][2];
#pragma unroll
        for (int bj = 0; bj < 2; ++bj)
#pragma unroll
            for (int n = 0; n < 2; ++n) gv[bj][n] = *(const f32x4*)(g + bj * HALF + n * 16);
#pragma unroll
        for (int ai = 0; ai < 2; ++ai)
#pragma unroll
            for (int m = 0; m < 4; ++m) { const int row = u.pm * BM + ai * HALF + wr * 64 + m * 16 + fr;
                const float* bp = (row < 16384 ? base_lat + (size_t)row * 2048 : base_ctx + (size_t)(row - 16384) * 2048) + col0; float* op = out + (size_t)row * 2048 + col0;
#pragma unroll
                for (int bj = 0; bj < 2; ++bj)
#pragma unroll
                    for (int n = 0; n < 2; ++n) { const f32x4 b = *(const f32x4*)(bp + bj * HALF + n * 16); *(f32x4*)(op + bj * HALF + n * 16) = b + gv[bj][n] * acc[ai][bj][m][n]; }
                asm volatile("" ::: "memory"); }
    }
};
struct EpiSwiglu {
    static constexpr bool PERM = true, AFTER_DRAIN = false;
    bf16_t* O; const float* bgu;
    __device__ __forceinline__ void operator()(const f32x4 (&acc)[2][2][4][2], const Unit& u, int wr, int wc, int fr, int fq) const {
        const int row0 = u.pm * BM + wr * 64 + fr, cc0 = wc * 32 + 8 * fq;
        const float* bg = bgu + (size_t)u.e * 2048 + u.pn * 128 + cc0;
        f32x4 bglu[2], blin[2];
#pragma unroll
        for (int n = 0; n < 2; ++n) { bglu[n] = *(const f32x4*)(bg + 4 * n); blin[n] = *(const f32x4*)(bg + 1024 + 4 * n); }
#pragma unroll
        for (int ai = 0; ai < 2; ++ai)
#pragma unroll
            for (int m = 0; m < 4; ++m) { bf16_t* rowp = O + (size_t)(row0 + ai * HALF + m * 16) * 1024 + u.pn * 128 + cc0;
                float r[8];
#pragma unroll
                for (int n = 0; n < 2; ++n) { const f32x4 g = acc[ai][0][m][n] + bglu[n], l = acc[ai][1][m][n] + blin[n];
#pragma unroll
                    for (int i = 0; i < 4; ++i) { const float gg = fminf(g[i], 7.0f); const float ll = fminf(fmaxf(l[i], -7.0f), 7.0f);
                        r[4 * n + i] = (ll + 1.0f) * gg * __builtin_amdgcn_rcpf(1.0f + __builtin_amdgcn_exp2f(-1.702f * 1.4426950408889634f * gg)); } }
                u32x4 w; w.x = cvt_pk_bf16(r[0], r[1]); w.y = cvt_pk_bf16(r[2], r[3]); w.z = cvt_pk_bf16(r[4], r[5]); w.w = cvt_pk_bf16(r[6], r[7]);
                *(u32x4*)rowp = w; }
    }
};
struct EpiSwiglu8 {
    static constexpr bool PERM = true, AFTER_DRAIN = false;
    unsigned char* O; const float* bgu;
    __device__ __forceinline__ void operator()(const f32x4 (&acc)[2][2][4][2], const Unit& u, int wr, int wc, int fr, int fq) const {
        const int row0 = u.pm * BM + wr * 64 + fr, cc0 = wc * 32 + 8 * fq;
        const float* bg = bgu + (size_t)u.e * 2048 + u.pn * 128 + cc0;
        f32x4 bglu[2], blin[2];
#pragma unroll
        for (int n = 0; n < 2; ++n) { bglu[n] = *(const f32x4*)(bg + 4 * n); blin[n] = *(const f32x4*)(bg + 1024 + 4 * n); }
#pragma unroll
        for (int ai = 0; ai < 2; ++ai)
#pragma unroll
            for (int m = 0; m < 4; ++m) { unsigned char* rowp = O + (size_t)(row0 + ai * HALF + m * 16) * 1024 + u.pn * 128 + cc0;
                float r[8];
#pragma unroll
                for (int n = 0; n < 2; ++n) { const f32x4 g = acc[ai][0][m][n] + bglu[n], l = acc[ai][1][m][n] + blin[n];
#pragma unroll
                    for (int i = 0; i < 4; ++i) { const float gg = fminf(g[i], 7.0f); const float ll = fminf(fmaxf(l[i], -7.0f), 7.0f);
                        r[4 * n + i] = (ll + 1.0f) * gg * __builtin_amdgcn_rcpf(1.0f + __builtin_amdgcn_exp2f(-1.702f * 1.4426950408889634f * gg)); } }
                int w0 = 0, w1 = 0; w0 = __builtin_amdgcn_cvt_pk_fp8_f32(r[0], r[1], w0, false); w0 = __builtin_amdgcn_cvt_pk_fp8_f32(r[2], r[3], w0, true); w1 = __builtin_amdgcn_cvt_pk_fp8_f32(r[4], r[5], w1, false); w1 = __builtin_amdgcn_cvt_pk_fp8_f32(r[6], r[7], w1, true);
                typedef unsigned u32x2 __attribute__((ext_vector_type(2))); *(u32x2*)rowp = (u32x2){(unsigned)w0, (unsigned)w1}; }
    }
};
struct EpiDown {
    static constexpr bool PERM = true, AFTER_DRAIN = false;
    bf16_t* O; const float* bdn; const float* rowg;
    __device__ __forceinline__ void operator()(const f32x4 (&acc)[2][2][4][2], const Unit& u, int wr, int wc, int fr, int fq) const {
        const int row0 = u.pm * BM + wr * 64 + fr, col0 = u.pn * BM + wc * 32 + 8 * fq;
        const float* bb = bdn + (size_t)u.e * 2048 + col0;
        f32x4 bv[2][2];
#pragma unroll
        for (int bj = 0; bj < 2; ++bj)
#pragma unroll
            for (int n = 0; n < 2; ++n) bv[bj][n] = *(const f32x4*)(bb + bj * HALF + 4 * n);
#pragma unroll
        for (int ai = 0; ai < 2; ++ai)
#pragma unroll
            for (int m = 0; m < 4; ++m) { const int row = row0 + ai * HALF + m * 16; const float gt = rowg[row]; bf16_t* rowp = O + (size_t)row * 2048 + col0;
#pragma unroll
                for (int bj = 0; bj < 2; ++bj) { const f32x4 v0 = (acc[ai][bj][m][0] + bv[bj][0]) * gt, v1 = (acc[ai][bj][m][1] + bv[bj][1]) * gt;
                    u32x4 w; w.x = cvt_pk_bf16(v0[0], v0[1]); w.y = cvt_pk_bf16(v0[2], v0[3]); w.z = cvt_pk_bf16(v1[0], v1[1]); w.w = cvt_pk_bf16(v1[2], v1[3]);
                    *(u32x4*)(rowp + bj * HALF) = w; } }
    }
};
template <bool GATHER_> struct MoeOrderT {
    static constexpr bool GATHER = GATHER_;
    int c, nblk; const char* A; const char* Bt; size_t a_tstep, b_estep, b_tstep; const PG8_LAS int* blk_end; const int* row_tab;
    __device__ __forceinline__ bool next(int i, Unit& u) const {
#if defined(MOE_MAP) && MOE_MAP == 1
        const int L = i * 256 + c, rb = L >> 3, j = (L & 7);
#elif defined(MOE_MAP) && MOE_MAP == 2
        const int x = c & 7, jj = c >> 3, gi = i * 8 + x, rb = 8 * (gi >> 1) + (jj >> 2), j = (jj & 3) + 4 * (gi & 1);
#else
        const int x = c & 7, j = c >> 3, gi = i * 8 + x, rb = 4 * gi + (j >> 3);
#endif
        if (rb >= nblk) return false;
        int e = 0;
        for (int k = 0; k < 31; ++k) e += (rb >= blk_end[k]) ? 1 : 0;
        u.pm = rb; u.pn = j & 7; u.e = __builtin_amdgcn_readfirstlane(e); return true;
    }
    __device__ __forceinline__ const char* a_ptr(const Unit& u) const { return GATHER ? A : A + (size_t)u.pm * a_tstep; }
    __device__ __forceinline__ const char* b_ptr(const Unit& u) const { return Bt + (size_t)u.e * b_estep + (size_t)u.pn * b_tstep; }
    __device__ __forceinline__ void a_ready(const Unit&) const {}
    __device__ __forceinline__ void done(const Unit&) const {}
};
typedef MoeOrderT<false> MoeOrder;
typedef MoeOrderT<true> MoeOrderG;
template <class Epi, class Sched, bool ALIGN_EPI = false, bool SP2 = false, bool FP8 = false>
__device__ __forceinline__ void gemm_phase(PG8_LAS unsigned char* lds, const Gemm g, const Sched& S, const Epi& E) {
    int tid = threadIdx.x; asm volatile("" : "+v"(tid));
    const int wid = __builtin_amdgcn_readfirstlane(tid >> 6), lane = tid & 63, wr = wid >> 2, wc = wid & 3, fr = lane & 15, fq = lane >> 4;
    const int K = g.K, nt = K / BK;
    unsigned voffA[2], voffB[2];
#pragma unroll
    for (int i = 0; i < 2; ++i) { int R, C; stage_rc(tid * 16 + i * 8192, R, C); const int Rb = Epi::PERM ? ((R & ~31) + perm32(R & 31)) : R;
        voffA[i] = (unsigned)(R * K + C) * 2u; voffB[i] = (unsigned)(Rb * K + C) * 2u; }
    unsigned gc0[2] = {0u, 0u}, gc1[2] = {0u, 0u}; int gR = 0, gC = 0;
    if constexpr (Sched::GATHER) { stage_rc(tid * 16, gR, gC); }
#define PG8_GLOAD(dst0, dst1, u) do { const int* _rt = S.row_tab + (size_t)(u).pm * BM + gR; \
        dst0[0] = (unsigned)_rt[0] * (unsigned)(K * 2) + (unsigned)(gC * 2); dst0[1] = (unsigned)_rt[64] * (unsigned)(K * 2) + (unsigned)(gC * 2); \
        dst1[0] = (unsigned)_rt[128] * (unsigned)(K * 2) + (unsigned)(gC * 2); dst1[1] = (unsigned)_rt[192] * (unsigned)(K * 2) + (unsigned)(gC * 2); } while (0)
    const size_t kstep = (size_t)(BK * 2);
    const size_t hstep = (size_t)HALF * K * 2;
    const size_t tstep = 2 * hstep;
    const unsigned ldsw = (unsigned)wid * 1024u;
    const int aoff = lds_byte(wr * 64 + fr, fq * 8), boff = lds_byte(wc * 32 + fr, fq * 8);
#define PG8_SA(b, h) (((b) * 2 + (h)) * HTB)
#define PG8_SB(b, h) ((4 + (b) * 2 + (h)) * HTB)
#define PG8_STAGE(bufoff, gbase, voff) do { _Pragma("unroll") for (int _i = 0; _i < 2; ++_i) \
        __builtin_amdgcn_global_load_lds((const unsigned*)((const char*)(gbase) + (voff)[_i]), (PG8_LAS unsigned*)(lds + (bufoff) + ldsw + _i * 8192), 16, 0, 0); } while (0)
#define PG8_LD16(off) (*(const PG8_LAS v4i_t*)(lds + (off)))
#define PG8_LDA(dst, b, h) do { if constexpr (FP8) { _Pragma("unroll") for (int m = 0; m < 4; ++m) dst##8[m] = __builtin_shufflevector(PG8_LD16(PG8_SA(b, h) + aoff + m * 2048), PG8_LD16(PG8_SA(b, h) + aoff + m * 2048 + 1024), 0, 1, 2, 3, 4, 5, 6, 7); } \
        else { _Pragma("unroll") for (int m = 0; m < 4; ++m) _Pragma("unroll") for (int k = 0; k < 2; ++k) dst[m][k] = *(const PG8_LAS bf16x8*)(lds + PG8_SA(b, h) + aoff + m * 2048 + k * 1024); } } while (0)
#define PG8_LDB(dst, b, h) do { if constexpr (FP8) { _Pragma("unroll") for (int n = 0; n < 2; ++n) dst##8[n] = __builtin_shufflevector(PG8_LD16(PG8_SB(b, h) + boff + n * 2048), PG8_LD16(PG8_SB(b, h) + boff + n * 2048 + 1024), 0, 1, 2, 3, 4, 5, 6, 7); } \
        else { _Pragma("unroll") for (int n = 0; n < 2; ++n) _Pragma("unroll") for (int k = 0; k < 2; ++k) dst[n][k] = *(const PG8_LAS bf16x8*)(lds + PG8_SB(b, h) + boff + n * 2048 + k * 1024); } } while (0)
#define PG8_MMA(ai, bj, At, Bt) do { __builtin_amdgcn_s_setprio(1); \
        if constexpr (FP8) { _Pragma("unroll") for (int m = 0; m < 4; ++m) _Pragma("unroll") for (int n = 0; n < 2; ++n) \
            acc[ai][bj][m][n] = __builtin_amdgcn_mfma_scale_f32_16x16x128_f8f6f4(Bt##8[n], At##8[m], acc[ai][bj][m][n], 0, 0, 0, g.bscale, 0, g.bscale); }     \
        else { _Pragma("unroll") for (int m = 0; m < 4; ++m) _Pragma("unroll") for (int n = 0; n < 2; ++n) _Pragma("unroll") for (int k = 0; k < 2; ++k) \
            acc[ai][bj][m][n] = __builtin_amdgcn_mfma_f32_16x16x32_bf16(Bt[n][k], At[m][k], acc[ai][bj][m][n], 0, 0, 0); } \
        __builtin_amdgcn_s_setprio(0); } while (0)
#define PG8_WAIT_V(n) asm volatile("s_waitcnt vmcnt(" #n ")" ::: "memory")
#define PG8_WAIT_L(n) asm volatile("s_waitcnt lgkmcnt(" #n ")" ::: "memory")
#define PG8_BAR __builtin_amdgcn_s_barrier()
#define PG8_SCHED __builtin_amdgcn_sched_barrier(0)
    Unit cur, nxt; int ui = 0;
    if (!S.next(0, cur)) return;
    f32x4 acc[2][2][4][2];
#pragma unroll
    for (int a = 0; a < 2; ++a)
#pragma unroll
        for (int b = 0; b < 2; ++b)
#pragma unroll
            for (int m = 0; m < 4; ++m)
#pragma unroll
                for (int n = 0; n < 2; ++n) acc[a][b][m][n] = (f32x4){0.f, 0.f, 0.f, 0.f};
    bf16x8 At[4][2], B0[2][2], B1[2][2]; v8i_t At8[4], B08[2], B18[2];
    const char* cA = S.a_ptr(cur); const char* cB = S.b_ptr(cur);
    S.a_ready(cur);
    if constexpr (SP2) {
        if constexpr (Sched::GATHER) { PG8_GLOAD(gc0, gc1, cur);
        PG8_STAGE(PG8_SB(0, 0), cB, voffB); PG8_STAGE(PG8_SB(0, 1), cB + hstep, voffB); PG8_STAGE(PG8_SA(0, 0), cA, gc0); PG8_STAGE(PG8_SA(0, 1), cA, gc1);
        if (wr == 1) PG8_BAR;
        PG8_WAIT_V(2); PG8_BAR;
        PG8_STAGE(PG8_SB(1, 0), cB + kstep, voffB); PG8_STAGE(PG8_SA(1, 0), cA + kstep, gc0); PG8_STAGE(PG8_SB(1, 1), cB + hstep + kstep, voffB);
        } else {
        PG8_STAGE(PG8_SB(0, 0), cB, voffB); PG8_STAGE(PG8_SB(0, 1), cB + hstep, voffB); PG8_STAGE(PG8_SA(0, 0), cA, voffA); PG8_STAGE(PG8_SA(0, 1), cA + hstep, voffA);
        if (wr == 1) PG8_BAR;
        PG8_WAIT_V(2); PG8_BAR;
        PG8_STAGE(PG8_SB(1, 0), cB + kstep, voffB); PG8_STAGE(PG8_SA(1, 0), cA + kstep, voffA); PG8_STAGE(PG8_SB(1, 1), cB + hstep + kstep, voffB);
        }
        PG8_WAIT_V(6); PG8_BAR;
    } else {
        PG8_STAGE(PG8_SB(0, 0), cB, voffB); PG8_STAGE(PG8_SA(0, 0), cA, voffA); PG8_STAGE(PG8_SB(0, 1), cB + hstep, voffB); PG8_STAGE(PG8_SA(0, 1), cA + hstep, voffA);
        if (wr == 1) PG8_BAR;
        PG8_WAIT_V(4); PG8_BAR;
        PG8_STAGE(PG8_SB(1, 0), cB + kstep, voffB); PG8_STAGE(PG8_SA(1, 0), cA + kstep, voffA); PG8_STAGE(PG8_SB(1, 1), cB + hstep + kstep, voffB);
        PG8_WAIT_V(6); PG8_BAR;
    }
    for (;;) {
        const bool has_next = S.next(ui + 1, nxt);
        const char* nA = has_next ? S.a_ptr(nxt) : cA; const char* nB = has_next ? S.b_ptr(nxt) : cB;
#pragma unroll 1
        for (int t = 0; t < nt; t += 2) {
            const bool last = (t == nt - 2);
            const char* a1 = cA + (size_t)(t + 1) * kstep;
            const char* a2 = last ? nA : cA + (size_t)(t + 2) * kstep; const char* b2 = last ? nB : cB + (size_t)(t + 2) * kstep;
            const char* a3 = a2 + kstep; const char* b3 = b2 + kstep;
            if (last && has_next) S.a_ready(nxt);

            if constexpr (SP2) {
            PG8_LDB(B0, 0, 0); PG8_LDB(B1, 0, 1); PG8_SCHED; PG8_LDA(At, 0, 0); if constexpr (Sched::GATHER) PG8_STAGE(PG8_SA(1, 1), a1, gc1); else PG8_STAGE(PG8_SA(1, 1), a1 + hstep, voffA);
            if constexpr (Sched::GATHER) { if (last && has_next) PG8_GLOAD(gc0, gc1, nxt); }
            PG8_WAIT_V(8); PG8_WAIT_L(0); PG8_BAR; PG8_MMA(0, 0, At, B0); PG8_MMA(0, 1, At, B1); PG8_BAR; PG8_SCHED;
            PG8_LDA(At, 0, 1); PG8_STAGE(PG8_SB(0, 0), b2, voffB); PG8_STAGE(PG8_SB(0, 1), b2 + hstep, voffB); if constexpr (Sched::GATHER) PG8_STAGE(PG8_SA(0, 0), a2, gc0); else PG8_STAGE(PG8_SA(0, 0), a2, voffA);
            PG8_WAIT_V(8); PG8_WAIT_L(0); PG8_BAR; PG8_MMA(1, 0, At, B0); PG8_MMA(1, 1, At, B1); PG8_BAR; PG8_SCHED;
            PG8_LDB(B0, 1, 0); PG8_LDB(B1, 1, 1); PG8_SCHED; PG8_LDA(At, 1, 0); if constexpr (Sched::GATHER) PG8_STAGE(PG8_SA(0, 1), a2, gc1); else PG8_STAGE(PG8_SA(0, 1), a2 + hstep, voffA);
            PG8_WAIT_V(8); PG8_WAIT_L(0); PG8_BAR; PG8_MMA(0, 0, At, B0); PG8_MMA(0, 1, At, B1); PG8_BAR; PG8_SCHED;
            PG8_LDA(At, 1, 1); PG8_STAGE(PG8_SB(1, 0), b3, voffB); PG8_STAGE(PG8_SB(1, 1), b3 + hstep, voffB); if constexpr (Sched::GATHER) PG8_STAGE(PG8_SA(1, 0), a3, gc0); else PG8_STAGE(PG8_SA(1, 0), a3, voffA);
            PG8_WAIT_V(8); PG8_WAIT_L(0); PG8_BAR; PG8_MMA(1, 0, At, B0); PG8_MMA(1, 1, At, B1); PG8_BAR; PG8_SCHED;
            } else {
            PG8_LDB(B0, 0, 0); PG8_SCHED; PG8_LDA(At, 0, 0); PG8_STAGE(PG8_SA(1, 1), a1 + hstep, voffA);
            PG8_WAIT_L(8); PG8_BAR; PG8_WAIT_L(0); PG8_MMA(0, 0, At, B0); PG8_BAR; PG8_SCHED;
            PG8_LDB(B1, 0, 1); PG8_STAGE(PG8_SB(0, 0), b2, voffB);
            PG8_BAR; PG8_WAIT_L(0); PG8_MMA(0, 1, At, B1); PG8_BAR;
            PG8_LDA(At, 0, 1); PG8_STAGE(PG8_SA(0, 0), a2, voffA);
            PG8_BAR; PG8_WAIT_L(0); PG8_MMA(1, 0, At, B0); PG8_BAR; PG8_SCHED;
            PG8_STAGE(PG8_SB(0, 1), b2 + hstep, voffB);
            PG8_WAIT_V(6); PG8_BAR; PG8_MMA(1, 1, At, B1); PG8_BAR;
            PG8_LDB(B0, 1, 0); PG8_SCHED; PG8_LDA(At, 1, 0); PG8_STAGE(PG8_SA(0, 1), a2 + hstep, voffA);
            PG8_WAIT_L(8); PG8_BAR; PG8_WAIT_L(0); PG8_MMA(0, 0, At, B0); PG8_BAR; PG8_SCHED;
            PG8_LDB(B1, 1, 1); PG8_STAGE(PG8_SB(1, 0), b3, voffB);
            PG8_BAR; PG8_WAIT_L(0); PG8_MMA(0, 1, At, B1); PG8_BAR;
            PG8_LDA(At, 1, 1); PG8_STAGE(PG8_SA(1, 0), a3, voffA);
            PG8_BAR; PG8_WAIT_L(0); PG8_MMA(1, 0, At, B0); PG8_BAR; PG8_SCHED;
            PG8_STAGE(PG8_SB(1, 1), b3 + hstep, voffB);
            PG8_WAIT_V(6); PG8_BAR; PG8_MMA(1, 1, At, B1); PG8_BAR;
            }
        }
        if constexpr (ALIGN_EPI) { if (wr == 0) PG8_BAR; }
        if constexpr (!Epi::AFTER_DRAIN) { int fr_e = fr, fq_e = fq; asm volatile("" : "+v"(fr_e), "+v"(fq_e));
            E(acc, cur, wr, wc, fr_e, fq_e); S.done(cur); }
        if (!has_next) break;
#pragma unroll
        for (int a = 0; a < 2; ++a)
#pragma unroll
            for (int b = 0; b < 2; ++b)
#pragma unroll
                for (int m = 0; m < 4; ++m)
#pragma unroll
                    for (int n = 0; n < 2; ++n) acc[a][b][m][n] = (f32x4){0.f, 0.f, 0.f, 0.f};
        cur = nxt; cA = nA; cB = nB; ++ui;
        if constexpr (ALIGN_EPI) { if (wr == 1) PG8_BAR; }
    }
    PG8_WAIT_V(0);
    if constexpr (!ALIGN_EPI) { if (wr == 0) PG8_BAR; }
    PG8_BAR;
    if constexpr (Epi::AFTER_DRAIN) { E.fused(acc, cur, wr, wc, fr, fq, lds, wid, lane); S.done(cur); }
#undef PG8_GLOAD
#undef PG8_SA
#undef PG8_SB
#undef PG8_STAGE
#undef PG8_LDA
#undef PG8_LDB
#undef PG8_MMA
#undef PG8_LD16
#undef PG8_WAIT_V
#undef PG8_WAIT_L
#undef PG8_BAR
#undef PG8_SCHED
}
}

constexpr size_t MiB = 1u << 20;
constexpr size_t WS_CTL = 0, CTL_ZERO_BYTES = 1 * MiB;
constexpr size_t WS_MOD  = 1 * MiB;
constexpr size_t WS_WRT  = 2 * MiB;
constexpr size_t WS_MOEI = 3 * MiB;
constexpr size_t WS_LRC  = 6 * MiB;
constexpr size_t WS_DNS  = 12 * MiB;
constexpr size_t WS_WIN  = 16 * MiB;
constexpr size_t WS_WOUT = 56 * MiB;
constexpr size_t WS_WGU  = 72 * MiB;
constexpr size_t WS_WDN  = 584 * MiB;
constexpr size_t WS_X    = 840 * MiB;
constexpr size_t WS_H    = 976 * MiB;
constexpr size_t WS_P    = 1044 * MiB;
constexpr size_t WS_CC   = 1206 * MiB;
constexpr size_t WS_VT   = 1274 * MiB;
constexpr size_t WS_VTC  = WS_VT + 8 * MiB;
constexpr size_t WS_DNT  = 1284 * MiB;
constexpr size_t DNT_BYTES = 90112;
constexpr size_t WS_DNO  = 1472 * MiB;
constexpr size_t WS_LRH  = 1540 * MiB;
constexpr size_t WS_LRA  = 1608 * MiB;
constexpr size_t WS_XS   = 1676 * MiB;
constexpr size_t WS_ACT  = 1980 * MiB;
constexpr size_t WS_YS   = 2132 * MiB;
constexpr size_t WS_END  = 2436 * MiB;
constexpr int CW_TMO = 0;
constexpr int CW_BAR = 4096;
constexpr int CW_CNT = 8192;
constexpr int CW_ATQ = 12288;

constexpr int RING_OFF = 0, RING_BYTES = 131072;
constexpr int LDSCTL_OFF = RING_BYTES, MISC_OFF = LDSCTL_OFF + 320;
constexpr int LDS_X_OFF = RING_BYTES + 1024;
constexpr int LDS_BYTES = 147456;
constexpr int NWAVES = 8, NTHREADS = 512;

#define GAS __attribute__((address_space(1)))
#define LAS __attribute__((address_space(3)))
typedef unsigned short bf16;
typedef unsigned v4u __attribute__((ext_vector_type(4)));
typedef unsigned v2u __attribute__((ext_vector_type(2)));
typedef float f32x4 __attribute__((ext_vector_type(4)));
typedef float f32x16 __attribute__((ext_vector_type(16)));
typedef short bf16x8 __attribute__((ext_vector_type(8)));
typedef short bf16x4 __attribute__((ext_vector_type(4)));
typedef GAS unsigned gu32;
#define RLX_AGENT __ATOMIC_RELAXED, __HIP_MEMORY_SCOPE_AGENT
#define LDS_WAIT() asm volatile("s_waitcnt lgkmcnt(0)" ::: "memory")
#define VM_WAIT() asm volatile("s_waitcnt vmcnt(0)" ::: "memory")
#define LDS_BARRIER() asm volatile("s_waitcnt lgkmcnt(0)\n\ts_barrier" ::: "memory")
typedef __bf16 bf16x2_t __attribute__((ext_vector_type(2)));
typedef float f32x2_t __attribute__((ext_vector_type(2)));
__device__ __forceinline__ unsigned pk2(float lo, float hi) { const f32x2_t v = {lo, hi}; const bf16x2_t b = __builtin_convertvector(v, bf16x2_t); return __builtin_bit_cast(unsigned, b); }
__device__ __forceinline__ unsigned f2bf(float f) { return pk2(f, 0.f) & 0xffffu; }
__device__ __forceinline__ float bf2f(unsigned short b) { return __builtin_bit_cast(float, (unsigned)b << 16); }
__device__ __forceinline__ float bflo(unsigned w) { return __builtin_bit_cast(float, w << 16); }
__device__ __forceinline__ float bfhi(unsigned w) { return __builtin_bit_cast(float, w & 0xffff0000u); }
template <int CTRL> __device__ __forceinline__ float dpp_mov(float v) { return __builtin_bit_cast(float, __builtin_amdgcn_update_dpp(0, __builtin_bit_cast(int, v), CTRL, 0xF, 0xF, false)); }
__device__ __forceinline__ float wave_sum(float v) {
    v += dpp_mov<0xB1>(v); v += dpp_mov<0x4E>(v); v += dpp_mov<0x141>(v); v += dpp_mov<0x140>(v);
    const int iv = __builtin_bit_cast(int, v);
    const float r0 = __builtin_bit_cast(float, __builtin_amdgcn_readlane(iv, 0)), r1 = __builtin_bit_cast(float, __builtin_amdgcn_readlane(iv, 16)), r2 = __builtin_bit_cast(float, __builtin_amdgcn_readlane(iv, 32)), r3 = __builtin_bit_cast(float, __builtin_amdgcn_readlane(iv, 48));
    return (r0 + r1) + (r2 + r3);
}
__device__ __forceinline__ float sigmoidf_(float x) { return __builtin_amdgcn_rcpf(1.0f + __builtin_amdgcn_exp2f(-1.4426950408889634f * x)); }
__device__ __forceinline__ float siluf_(float x) { return x * sigmoidf_(x); }
__device__ __forceinline__ float softplusf_(float x) { return x > 20.f ? x : log1pf(__expf(x)); }

#define XB_TMO      128
#define XB_XCNT(j)  (256  + 64 * (j))
#define XB_XSUB(j)  (1280 + 64 * (j))
#define XB_XGEN(j)  (2304 + 64 * (j))
#define XB_TOP      3328
#define XB_TOPGEN   3392
#define XCD_BAR_WORDS 3456
#define XB_SPIN_CAP (1u << 18)

__device__ __forceinline__ unsigned xb_ld(unsigned* p)              { return __hip_atomic_load(p, __ATOMIC_RELAXED, __HIP_MEMORY_SCOPE_AGENT); }
__device__ __forceinline__ unsigned xb_add(unsigned* p, unsigned v) { return __hip_atomic_fetch_add(p, v, __ATOMIC_RELAXED, __HIP_MEMORY_SCOPE_AGENT); }
__device__ __forceinline__ unsigned xb_xcc_id() { return (unsigned)__builtin_amdgcn_s_getreg((3 << 11) | 20) & 0xFu; }
#define XB_SPIN(cond, bar) do { unsigned _sp = 0; while (cond) { __builtin_amdgcn_s_sleep(1); \
    if ((++_sp & 255u) == 0u) { if (xb_ld(&(bar)[XB_TMO])) break; if (_sp > XB_SPIN_CAP) { atomicAdd(&(bar)[XB_TMO], 1u); break; } } } } while (0)

struct XcdBarrier {
    unsigned* bar; unsigned x;
    volatile LAS unsigned* st;
};

__device__ __forceinline__ XcdBarrier xcd_barrier_post(unsigned* bar, volatile LAS unsigned* st) {
    XcdBarrier b; b.bar = bar; b.x = xb_xcc_id(); b.st = st;
    if (threadIdx.x == 0) (void)xb_add(&bar[XB_XCNT(b.x)], 1u);
    return b;
}
__device__ __forceinline__ void xcd_barrier_complete(unsigned* bar, unsigned x, unsigned& nloc, unsigned& nx) {
    const unsigned G = gridDim.x * gridDim.y * gridDim.z;
    unsigned sum, cnt, mine, sp = 0u;
    for (;;) {
        sum = 0u; cnt = 0u; mine = 0u;
#pragma unroll
        for (unsigned j = 0; j < 16; ++j) { const unsigned c = xb_ld(&bar[XB_XCNT(j)]); sum += c; cnt += (c > 0u) ? 1u : 0u; mine = (j == x) ? c : mine; }
        if (sum == G) break;
        __builtin_amdgcn_s_sleep(1);
        if ((++sp & 255u) == 0u) { if (xb_ld(&bar[XB_TMO])) break; if (sp > XB_SPIN_CAP) { atomicAdd(&bar[XB_TMO], 1u); break; } }
    }
    nloc = mine > 0u ? mine : 1u; nx = cnt > 0u ? cnt : 1u;
}

__device__ __forceinline__ void xcd_barrier(const XcdBarrier& b) {
    asm volatile("s_waitcnt vmcnt(0)" ::: "memory");
    __syncthreads();
    if (threadIdx.x == 0) {
        unsigned* bar = b.bar;
        __builtin_amdgcn_s_waitcnt(0);
        unsigned nloc = b.st[0], nx = b.st[1];
        if (nloc == 0u) { xcd_barrier_complete(bar, b.x, nloc, nx); b.st[0] = nloc; b.st[1] = nx; }
        const unsigned old = xb_add(&bar[XB_XSUB(b.x)], 1u);
        const unsigned gen = old / nloc;
        if (old + 1u == (gen + 1u) * nloc) {
            __builtin_amdgcn_fence(__ATOMIC_RELEASE, "agent");
            asm volatile("s_waitcnt vmcnt(0)" ::: "memory");
            const unsigned og = xb_add(&bar[XB_TOP], 1u);
            const unsigned tg = og / nx;
            if (og + 1u == (tg + 1u) * nx) xb_add(&bar[XB_TOPGEN], 1u);
            else XB_SPIN(xb_ld(&bar[XB_TOPGEN]) == tg, bar);
            __builtin_amdgcn_fence(__ATOMIC_ACQUIRE, "agent");
            xb_add(&bar[XB_XGEN(b.x)], 1u);
            asm volatile("s_waitcnt vmcnt(0)" ::: "memory");
        } else {
            XB_SPIN(xb_ld(&bar[XB_XGEN(b.x)]) == gen, bar);
            __builtin_amdgcn_fence(__ATOMIC_ACQUIRE, "agent");
            asm volatile("s_waitcnt vmcnt(0)" ::: "memory");
        }
    }
    __syncthreads();
}

enum InIdx { I_X = 0, I_C, I_CTX, I_CCTX, I_WMOD, I_BMOD, I_NMG, I_NFG, I_WIN, I_WOUT, I_SINK, I_DNCW, I_DNALOG, I_DNDT, I_DNNG, I_LRCW, I_LRCB, I_LRWR, I_LRBR, I_LRWI, I_LRBI, I_LRLAM,
             I_WROUT, I_BROUT, I_WGU, I_BGU, I_WDN, I_BDN, I_FNG, N_IN };
struct Frame {
    LAS unsigned char* lds;
    volatile LAS unsigned* MISC;
    gu32* ctl;
    int tid, lane, wave, G, bid;
    const float* const __attribute__((address_space(4)))* in;
    float* out; unsigned char* ws;
};
__device__ __forceinline__ int mod_row(int m) { return m < NLAT ? (m >> 12) : 4; }
__device__ __forceinline__ bool phase_enter(Frame& F) { int t = threadIdx.x; asm volatile("" : "+v"(t)); F.tid = t; F.lane = t & 63; F.wave = __builtin_amdgcn_readfirstlane(t >> 6); return true; }
__device__ __forceinline__ void seq_of(int m, int& t, int& T, int& base) { if (m < NLAT) { t = m & 4095; T = SEQ; base = m - t; } else { t = (m - NLAT) & 255; T = CTXL; base = m - t; } }
__device__ __forceinline__ float gelu_tanh(float x) { const float u = 0.7978845608028654f * (x + 0.044715f * x * x * x); return x * sigmoidf_(2.0f * u); }

__device__ __forceinline__ void transpose_item(const float* W, int K, int N, bf16* WT, int k0, int dstrow0, int srccol0, int nvalid, LAS float* scr, int lane) {
    { const int c4 = (lane & 7) * 4, kr = lane >> 3; f32x4 v[8];
#pragma unroll
      for (int i = 0; i < 8; ++i) { v[i] = (f32x4){0.f, 0.f, 0.f, 0.f}; if (c4 < nvalid) v[i] = __builtin_nontemporal_load((const f32x4*)(W + (size_t)(k0 + 8 * i + kr) * N + srccol0 + c4)); }
#pragma unroll
      for (int i = 0; i < 8; ++i) { LAS float* d = scr + (8 * i + kr) * 33 + c4; d[0] = v[i].x; d[1] = v[i].y; d[2] = v[i].z; d[3] = v[i].w; } }
    LDS_WAIT(); asm volatile("" ::: "memory");
    const int c = lane & 7;
#pragma unroll
    for (int jj = 0; jj < 4; ++jj) { const int n = (lane >> 3) + 8 * jj; const LAS float* s = scr + (8 * c) * 33 + n;
        v4u o; o.x = pk2(s[0 * 33], s[1 * 33]); o.y = pk2(s[2 * 33], s[3 * 33]); o.z = pk2(s[4 * 33], s[5 * 33]); o.w = pk2(s[6 * 33], s[7 * 33]);
        *(GAS v4u*)(WT + (size_t)(dstrow0 + n) * K + k0 + 8 * c) = o; }
    LDS_WAIT(); asm volatile("" ::: "memory");
}
__device__ __forceinline__ void transpose_item_f8(const float* W, int K, int N, unsigned char* WT, int k0, int dstrow0, int srccol0, float scale, LAS float* scr, int lane) {
    { const int c4 = (lane & 7) * 4, kr = lane >> 3; f32x4 v[8];
#pragma unroll
      for (int i = 0; i < 8; ++i) v[i] = __builtin_nontemporal_load((const f32x4*)(W + (size_t)(k0 + 8 * i + kr) * N + srccol0 + c4));
#pragma unroll
      for (int i = 0; i < 8; ++i) { LAS float* d = scr + (8 * i + kr) * 33 + c4; d[0] = v[i].x; d[1] = v[i].y; d[2] = v[i].z; d[3] = v[i].w; } }
    LDS_WAIT(); asm volatile("" ::: "memory");
    { const int n = lane >> 1, hf = lane & 1; const LAS float* s = scr + (32 * hf) * 33 + n; unsigned w[8];
#pragma unroll
      for (int i = 0; i < 8; ++i) { int x = 0; x = __builtin_amdgcn_cvt_pk_fp8_f32(s[(4 * i + 0) * 33] * scale, s[(4 * i + 1) * 33] * scale, x, false); x = __builtin_amdgcn_cvt_pk_fp8_f32(s[(4 * i + 2) * 33] * scale, s[(4 * i + 3) * 33] * scale, x, true); w[i] = (unsigned)x; }
      GAS v4u* o = (GAS v4u*)(WT + (size_t)(dstrow0 + n) * K + k0 + 32 * hf); o[0] = (v4u){w[0], w[1], w[2], w[3]}; o[1] = (v4u){w[4], w[5], w[6], w[7]}; }
    LDS_WAIT(); asm volatile("" ::: "memory");
}
__device__ __forceinline__ void p0_prologue(Frame& F) {
    {
        LAS float* sc = (LAS float*)(F.lds);
        LAS float* red = (LAS float*)(F.lds + 40960);
        bool have_sc = false;
        for (int wb = F.bid; wb < 192; wb += F.G) {
            if (!have_sc) {
                for (int i = F.tid; i < 5 * 2048; i += NTHREADS) { const int r = i >> 11, k = i & 2047; const float cv = r < 4 ? F.in[I_C][r * 2048 + k] : F.in[I_CCTX][k]; sc[i] = siluf_(cv); }
                have_sc = true; __syncthreads();
            }
            const int l = wb / 96, cb = wb % 96, kp = F.tid >> 5, cg = F.tid & 31, j0 = cb * 128 + cg * 4;
            const float* wp = F.in[I_WMOD] + ((size_t)l * 2048 + kp * 128) * 12288 + j0;
            f32x4 acc[5];
#pragma unroll
            for (int r = 0; r < 5; ++r) acc[r] = (f32x4){0.f, 0.f, 0.f, 0.f};
#pragma unroll 4
            for (int k = 0; k < 128; ++k) { const f32x4 w = *(const f32x4*)(wp + (size_t)k * 12288);
#pragma unroll
                for (int r = 0; r < 5; ++r) acc[r] += sc[r * 2048 + kp * 128 + k] * w; }
#pragma unroll
            for (int r = 0; r < 5; ++r) *(LAS f32x4*)(red + (kp * 5 + r) * 128 + cg * 4) = acc[r];
            __syncthreads();
            for (int i = F.tid; i < 640; i += NTHREADS) { const int r = i >> 7, col = i & 127; float s = F.in[I_BMOD][l * 12288 + cb * 128 + col];
#pragma unroll
                for (int q = 0; q < 16; ++q) s += red[(q * 5 + r) * 128 + col];
                ((float*)(F.ws + WS_MOD))[(size_t)(l * 5 + r) * 12288 + cb * 128 + col] = s; }
            __syncthreads();
        }
        __syncthreads();
    }
    {
        LAS float* scr = (LAS float*)(F.lds + F.wave * 16384);
        const int gw = F.bid * NWAVES + F.wave, NGW = F.G * NWAVES;
        constexpr int I_IN = 32 * 144, I_OUT = 32 * 64, I_RT = 32, I_16 = 32, PER_L = I_IN + I_OUT + I_RT + I_16;
        for (int it0 = gw; it0 < 2 * PER_L; it0 += NGW) {
            const int l = it0 / PER_L; int r = it0 % PER_L;
            if (r < I_IN) { const int nb = r % 144, kb = r / 144, d0 = nb * 32; int s0 = d0, nv = 32;
                if (d0 >= 3584) s0 = d0 + 16;
                transpose_item(F.in[I_WIN] + (size_t)l * 2048 * IN_W, 2048, IN_W, (bf16*)(F.ws + WS_WIN) + (size_t)l * PW * 2048, kb * 64, d0, s0, nv, scr, F.lane); continue; }
            r -= I_IN;
            if (r < I_OUT) { const int nb = r % 64, kb = r / 64;
                transpose_item(F.in[I_WOUT] + (size_t)l * 2048 * 2048, 2048, 2048, (bf16*)(F.ws + WS_WOUT) + (size_t)l * 2048 * 2048, kb * 64, nb * 32, nb * 32, 32, scr, F.lane); continue; }
            r -= I_OUT;
            if (r < I_RT) { transpose_item(F.in[I_WROUT] + (size_t)l * 2048 * 32, 2048, 32, (bf16*)(F.ws + WS_WRT) + (size_t)l * 32 * 2048, r * 64, 0, 0, 32, scr, F.lane); continue; }
            r -= I_RT;
            transpose_item(F.in[I_WIN] + (size_t)l * 2048 * IN_W, 2048, IN_W, (bf16*)(F.ws + WS_WRT + 512 * 1024) + (size_t)l * 32 * 2048, r * 64, 0, 3584, 16, scr, F.lane);
        }
    }
}
constexpr int CW_CVQ = 12288 + 512;
#ifndef FP8_GEMM2
#define FP8_GEMM2 0
#endif
constexpr float WGU_SCALE = 64.0f, WDN_SCALE = 64.0f; constexpr int WGU_E8M0 = 0x7C7C7C7C, WDN_E8M0 = 0x7C7C7C7C;
__device__ __forceinline__ void convert_moe_item(Frame& F, int l, int r, LAS float* scr) {
    constexpr int I_GU = 32 * 32 * 64;
    if (r < I_GU) { const int e = r / 2048, q = r % 2048, nb = q % 64, kb = q / 64; const int s0 = ((nb >> 2) & 1) * 1024 + (nb >> 3) * 128 + (nb & 3) * 32;
        transpose_item_f8(F.in[I_WGU] + (size_t)(l * 32 + e) * 2048 * 2048, 2048, 2048, F.ws + WS_WGU + (size_t)(l * 32 + e) * 2048 * 2048, kb * 64, nb * 32, s0, WGU_SCALE, scr, F.lane); return; }
    r -= I_GU;
    { const int e = r / 1024, q = r % 1024, nb = q % 64, kb = q / 64;
#if FP8_GEMM2
        transpose_item_f8(F.in[I_WDN] + (size_t)(l * 32 + e) * 1024 * 2048, 1024, 2048, F.ws + WS_WDN + (size_t)(l * 32 + e) * 2048 * 1024, kb * 64, nb * 32, nb * 32, WDN_SCALE, scr, F.lane);
#else
        transpose_item(F.in[I_WDN] + (size_t)(l * 32 + e) * 1024 * 2048, 1024, 2048, (bf16*)(F.ws + WS_WDN) + (size_t)(l * 32 + e) * 2048 * 1024, kb * 64, nb * 32, nb * 32, 32, scr, F.lane);
#endif
    }
}
constexpr int CVG = 8;
__device__ __forceinline__ bool convert_grab(Frame& F, int l, int rep, LAS float* scr) {
    constexpr int NIT = 32 * 32 * 64 + 32 * 16 * 64;
    int g = 0; if (F.lane == 0) g = (int)__hip_atomic_fetch_add(F.ctl + CW_CVQ + 64 * l + 8 * rep, 1u, RLX_AGENT); g = __builtin_amdgcn_readfirstlane(g);
    if (g * CVG >= NIT) return false;
#pragma unroll 1
    for (int k = 0; k < CVG; ++k) convert_moe_item(F, l, g * CVG + k, scr);
    return true;
}
__device__ __forceinline__ void convert_moe_queue(Frame& F, int l, int rep = 0) {
    LAS float* scr = (LAS float*)(F.lds + F.wave * 16384);
    __syncthreads();
    while (convert_grab(F, l, rep, scr)) {}
    __syncthreads();
}
constexpr int CW_TAIL = 16384;
__device__ __forceinline__ void tail_fill(Frame& F, int seam, int lt) {
    LAS int* flag = (LAS int*)(F.lds + LDS_X_OFF + 768);
    LAS float* scr = (LAS float*)(F.lds + F.wave * 16384);
    __syncthreads();
    if (F.tid == 0) (void)__hip_atomic_fetch_add(F.ctl + CW_TAIL + 64 * seam, 1u, RLX_AGENT);
    bool more = true;
    for (int it = 0; it < 4096; ++it) {
        if (F.tid == 0) *flag = (__hip_atomic_load(F.ctl + CW_TAIL + 64 * seam, RLX_AGENT) >= (unsigned)F.G) ? 1 : 0;
        __syncthreads();
        const int done = *flag;
        __syncthreads();
        if (done) break;
        if (more) more = convert_grab(F, lt, 0, scr); else __builtin_amdgcn_s_sleep(32);
    }
}

__device__ __forceinline__ void load_row(const float* src, int lane, f32x4 (&v)[8]) {
    const f32x4* p = (const f32x4*)src + lane;
#pragma unroll
    for (int j = 0; j < 8; ++j) v[j] = p[64 * j];
}
__device__ __forceinline__ void store_row(float* dst, int lane, const f32x4 (&v)[8]) {
    f32x4* p = (f32x4*)dst + lane;
#pragma unroll
    for (int j = 0; j < 8; ++j) p[64 * j] = v[j];
}
__device__ __forceinline__ void combine_row(Frame& F, int l, int m, int lane, f32x4 (&v)[8]) {
    const int* dest = (const int*)(F.ws + WS_MOEI + 2 * 512 * 1024) + m * 4;
    const float* g5 = (const float*)(F.ws + WS_MOD) + (size_t)(l * 5 + mod_row(m)) * 12288 + 5 * 2048;
    f32x4 acc[8];
#pragma unroll
    for (int j = 0; j < 8; ++j) acc[j] = (f32x4){0.f, 0.f, 0.f, 0.f};
#pragma unroll
    for (int k = 0; k < 4; ++k) { const int d = dest[k]; const v2u* yp = (const v2u*)((const bf16*)(F.ws + WS_YS) + (size_t)d * 2048) + lane;
#pragma unroll
        for (int j = 0; j < 8; ++j) { const v2u w = yp[64 * j]; acc[j] += (f32x4){bflo(w.x), bfhi(w.x), bflo(w.y), bfhi(w.y)}; } }
#pragma unroll
    for (int j = 0; j < 8; ++j) { const f32x4 gg = *((const f32x4*)g5 + lane + 64 * j); v[j] += gg * acc[j]; }
}
__device__ __forceinline__ void modnorm_store(const f32x4 (&v)[8], const float* g, const float* shift, const float* scale, bf16* hrow, int lane) {
    float ss = 0.f;
#pragma unroll
    for (int j = 0; j < 8; ++j) ss += (v[j].x * v[j].x + v[j].y * v[j].y) + (v[j].z * v[j].z + v[j].w * v[j].w);
    const float rstd = 1.0f / sqrtf(wave_sum(ss) * (1.0f / 2048.0f) + EPS);
    v2u* hp = (v2u*)hrow + lane;
#pragma unroll
    for (int j = 0; j < 8; ++j) { const f32x4 gg = *((const f32x4*)g + lane + 64 * j), sh = *((const f32x4*)shift + lane + 64 * j), sc = *((const f32x4*)scale + lane + 64 * j);
        const f32x4 y = (v[j] * rstd) * gg * (sc + 1.0f) + sh; v2u w; w.x = pk2(y.x, y.y); w.y = pk2(y.z, y.w); hp[64 * j] = w; }
}
constexpr size_t WS_W16 = WS_WRT + 512 * 1024;
__device__ __forceinline__ void phase_norm1(Frame& F, int l) {
    constexpr int TROW = 4112;
    LAS unsigned char* tile = F.lds; LAS float* part = (LAS float*)(F.lds + 66048);
    float* X = (float*)(F.ws + WS_X); bf16* H = (bf16*)(F.ws + WS_H); bf16* P = (bf16*)(F.ws + WS_P);
    const float* modp = (const float*)(F.ws + WS_MOD) + (size_t)l * 5 * 12288;
    const bf16* w16 = (const bf16*)(F.ws + WS_W16) + (size_t)l * 32 * 2048;
    for (int r0 = F.bid * 16; r0 < NTOK; r0 += F.G * 16) {
#pragma unroll 1
        for (int rr = 0; rr < 2; ++rr) { const int lr = 2 * F.wave + rr, m = r0 + lr;
            f32x4 v[8];
            if (l == 0) load_row(m < NLAT ? F.in[I_X] + (size_t)m * DM : F.in[I_CTX] + (size_t)(m - NLAT) * DM, F.lane, v);
            else { load_row(X + (size_t)m * DM, F.lane, v); if (MK_STAGE >= 9) { combine_row(F, l - 1, m, F.lane, v); store_row(X + (size_t)m * DM, F.lane, v); } }
            float ss = 0.f;
#pragma unroll
            for (int j = 0; j < 8; ++j) ss += (v[j].x * v[j].x + v[j].y * v[j].y) + (v[j].z * v[j].z + v[j].w * v[j].w);
            const float rstd = 1.0f / sqrtf(wave_sum(ss) * (1.0f / 2048.0f) + EPS);
            const float* mr = modp + (size_t)mod_row(m) * 12288; const float* g = F.in[I_NMG] + l * DM;
            v2u* hp = (v2u*)(H + (size_t)m * DM) + F.lane; LAS v2u* tp = (LAS v2u*)(tile + lr * TROW) + F.lane;
#pragma unroll
            for (int j = 0; j < 8; ++j) { const f32x4 gg = *((const f32x4*)g + F.lane + 64 * j), sh = *((const f32x4*)mr + F.lane + 64 * j), sc = *((const f32x4*)(mr + 2048) + F.lane + 64 * j);
                const f32x4 y = (v[j] * rstd) * gg * (sc + 1.0f) + sh; v2u w; w.x = pk2(y.x, y.y); w.y = pk2(y.z, y.w); hp[64 * j] = w; tp[64 * j] = w; }
        }
        __syncthreads();
        { const int row = F.lane & 15, q = F.lane >> 4; f32x4 acc = {0.f, 0.f, 0.f, 0.f};
#pragma unroll
          for (int ks = 0; ks < 8; ++ks) { const int k0 = 256 * F.wave + 32 * ks + 8 * q;
              const bf16x8 a = *(const LAS bf16x8*)(tile + row * TROW + k0 * 2); const bf16x8 b = *(const bf16x8*)(w16 + (size_t)row * 2048 + k0);
              acc = __builtin_amdgcn_mfma_f32_16x16x32_bf16(a, b, acc, 0, 0, 0); }
#pragma unroll
          for (int i = 0; i < 4; ++i) part[(F.wave * 16 + 4 * q + i) * 16 + row] = acc[i]; }
        __syncthreads();
        if (F.tid < 256) { const int rw = F.tid >> 4, c = F.tid & 15; float sacc = 0.f;
#pragma unroll
            for (int w = 0; w < 8; ++w) sacc += part[(w * 16 + rw) * 16 + c];
            P[(size_t)(r0 + rw) * PW + PC_BETA + c] = (bf16)f2bf(sacc); }
        __syncthreads();
    }
}
__device__ __forceinline__ void phase_final(Frame& F, bool with_combine) {
    const int gw = F.bid * NWAVES + F.wave, NGW = F.G * NWAVES;
    const float* X = (const float*)(F.ws + WS_X);
    for (int m = gw; m < NLAT; m += NGW) {
        f32x4 v[8];
        if (with_combine) { load_row(X + (size_t)m * DM, F.lane, v); combine_row(F, 1, m, F.lane, v); }
        else load_row(F.in[I_X] + (size_t)m * DM, F.lane, v);
        float ss = 0.f;
#pragma unroll
        for (int j = 0; j < 8; ++j) ss += (v[j].x * v[j].x + v[j].y * v[j].y) + (v[j].z * v[j].z + v[j].w * v[j].w);
        const float rstd = 1.0f / sqrtf(wave_sum(ss) * (1.0f / 2048.0f) + EPS);
        f32x4* op = (f32x4*)(F.out + (size_t)m * DM) + F.lane;
#pragma unroll
        for (int j = 0; j < 8; ++j) { const f32x4 gg = *((const f32x4*)F.in[I_FNG] + F.lane + 64 * j); op[64 * j] = v[j] * rstd * gg; }
    }
}

__device__ __forceinline__ void phase_inproj(Frame& F, int l) {
    pg8::Gemm g{(const bf16*)(F.ws + WS_H), (const bf16*)(F.ws + WS_WIN) + (size_t)l * PW * 2048, NTOK, 4608, 2048};
    pg8::StaticOrder S; S.init(g, F.G, F.bid);
    pg8::EpiBf16Plain E{(bf16*)(F.ws + WS_P), PW};
    pg8::gemm_phase<pg8::EpiBf16Plain, pg8::StaticOrder, true, true>(F.lds + RING_OFF, g, S, E);
}
__device__ __forceinline__ void phase_outproj(Frame& F, int l) {
    float* X = (float*)(F.ws + WS_X);
    pg8::Gemm g{(const bf16*)(F.ws + WS_CC), (const bf16*)(F.ws + WS_WOUT) + (size_t)l * 2048 * 2048, l == 0 ? NTOK : NLAT, 2048, 2048};
    pg8::StaticOrder S; S.init(g, F.G, F.bid);
    pg8::EpiResGate E{l == 0 ? F.in[I_X] : X, l == 0 ? F.in[I_CTX] : X + (size_t)NLAT * DM, X, (const float*)(F.ws + WS_MOD) + (size_t)l * 5 * 12288 + 2 * 2048};
    pg8::gemm_phase<pg8::EpiResGate, pg8::StaticOrder, true, true>(F.lds + RING_OFF, g, S, E);
}
#ifndef PHASE_INPROJ
#define PHASE_INPROJ(F, l) phase_inproj(F, l)
#endif
#ifndef PHASE_OUTPROJ
#define PHASE_OUTPROJ(F, l) phase_outproj(F, l)
#endif

constexpr size_t WS_H8 = WS_XS;
constexpr size_t MOEI_TOPE = WS_MOEI, MOEI_TOPG = WS_MOEI + 512 * 1024, MOEI_DEST = WS_MOEI + 2 * 512 * 1024, MOEI_ROWG = WS_MOEI + 3 * 512 * 1024, MOEI_ROWT = WS_MOEI + 4 * 512 * 1024;
__device__ __forceinline__ void phase_norm2(Frame& F, int l) {
    const int nrows = (l == 0) ? NTOK : NLAT;
    constexpr int TROW = 4112;
    LAS unsigned char* tile = F.lds;
    LAS float* part = (LAS float*)(F.lds + 66048);
    LAS float* lg = (LAS float*)(F.lds + 66048 + 16384);
    const float* X = (const float*)(F.ws + WS_X); bf16* H = (bf16*)(F.ws + WS_H);
    const float* modp = (const float*)(F.ws + WS_MOD) + (size_t)l * 5 * 12288;
    const bf16* wrt = (const bf16*)(F.ws + WS_WRT) + (size_t)l * 32 * 2048;
    int* tope = (int*)(F.ws + MOEI_TOPE); float* topg = (float*)(F.ws + MOEI_TOPG);
    for (int r0 = F.bid * 16; r0 < nrows; r0 += F.G * 16) {
#pragma unroll 1
        for (int rr = 0; rr < 2; ++rr) {
            const int lr = 2 * F.wave + rr, m = r0 + lr;
            f32x4 v[8]; load_row(X + (size_t)m * DM, F.lane, v);
            float ss = 0.f;
#pragma unroll
            for (int j = 0; j < 8; ++j) ss += (v[j].x * v[j].x + v[j].y * v[j].y) + (v[j].z * v[j].z + v[j].w * v[j].w);
            const float rstd = 1.0f / sqrtf(wave_sum(ss) * (1.0f / 2048.0f) + EPS);
            const float* mr = modp + (size_t)mod_row(m) * 12288; const float* g = F.in[I_NFG] + l * DM;
            unsigned* hp = (unsigned*)(F.ws + WS_H8 + (size_t)m * DM) + F.lane; LAS v2u* tp = (LAS v2u*)(tile + lr * TROW) + F.lane;
#pragma unroll
            for (int j = 0; j < 8; ++j) { const f32x4 gg = *((const f32x4*)g + F.lane + 64 * j), sh = *((const f32x4*)(mr + 3 * 2048) + F.lane + 64 * j), sc = *((const f32x4*)(mr + 4 * 2048) + F.lane + 64 * j);
                const f32x4 y = (v[j] * rstd) * gg * (sc + 1.0f) + sh; v2u w; w.x = pk2(y.x, y.y); w.y = pk2(y.z, y.w); tp[64 * j] = w;
                int x8 = 0; x8 = __builtin_amdgcn_cvt_pk_fp8_f32(y.x, y.y, x8, false); x8 = __builtin_amdgcn_cvt_pk_fp8_f32(y.z, y.w, x8, true); hp[64 * j] = (unsigned)x8; }
        }
        __syncthreads();
        {
            const int row = F.lane & 15, q = F.lane >> 4;
            f32x4 acc0 = {0.f, 0.f, 0.f, 0.f}, acc1 = {0.f, 0.f, 0.f, 0.f};
#pragma unroll
            for (int ks = 0; ks < 8; ++ks) { const int k0 = 256 * F.wave + 32 * ks + 8 * q;
                const bf16x8 a = *(const LAS bf16x8*)(tile + row * TROW + k0 * 2);
                const bf16x8 b0 = *(const bf16x8*)(wrt + (size_t)row * 2048 + k0), b1 = *(const bf16x8*)(wrt + (size_t)(16 + row) * 2048 + k0);
                acc0 = __builtin_amdgcn_mfma_f32_16x16x32_bf16(a, b0, acc0, 0, 0, 0); acc1 = __builtin_amdgcn_mfma_f32_16x16x32_bf16(a, b1, acc1, 0, 0, 0); }
#pragma unroll
            for (int i = 0; i < 4; ++i) { part[(F.wave * 16 + 4 * q + i) * 32 + row] = acc0[i]; part[(F.wave * 16 + 4 * q + i) * 32 + 16 + row] = acc1[i]; }
        }
        __syncthreads();
        { const int rw = F.tid >> 5, e = F.tid & 31; float s = F.in[I_BROUT][l * 32 + e];
#pragma unroll
          for (int w = 0; w < 8; ++w) s += part[(w * 16 + rw) * 32 + e];
          lg[rw * 32 + e] = s; }
        __syncthreads();
        if (F.tid < 16) { const int m = r0 + F.tid; float val[4]; int idx[4]; unsigned taken = 0u;
#pragma unroll
            for (int k = 0; k < 4; ++k) { float best = -3.0e38f; int bi = 0;
                for (int e = 0; e < 32; ++e) { const float x = lg[F.tid * 32 + e]; if (!((taken >> e) & 1u) && x > best) { best = x; bi = e; } }
                val[k] = best; idx[k] = bi; taken |= 1u << bi; }
            float p[4], sum = 0.f;
#pragma unroll
            for (int k = 0; k < 4; ++k) { p[k] = __expf(val[k] - val[0]); sum += p[k]; }
#pragma unroll
            for (int k = 0; k < 4; ++k) { const unsigned rank = __hip_atomic_fetch_add(F.ctl + CW_CNT + 64 * l + idx[k], 1u, RLX_AGENT);
                tope[m * 4 + k] = idx[k] | (int)(rank << 8); topg[m * 4 + k] = p[k] / sum; }
        }
        __syncthreads();
    }
}
__device__ __forceinline__ void moe_tables(Frame& F, int l) {
    LAS int* blk_end = (LAS int*)(F.lds + LDS_X_OFF); LAS int* pstart = blk_end + 32; LAS int* cnts = blk_end + 64;
    if (F.tid == 0) { int nb = 0;
        for (int e = 0; e < 32; ++e) { const int c = (int)__hip_atomic_load(F.ctl + CW_CNT + 64 * l + e, RLX_AGENT); cnts[e] = c; pstart[e] = nb * 256; nb += (c + 255) >> 8; blk_end[e] = nb; } }
    __syncthreads();
}
__device__ __forceinline__ void phase_scatter(Frame& F, int l) {
    const int nrows = (l == 0) ? NTOK : NLAT;
    moe_tables(F, l);
    const LAS int* blk_end = (const LAS int*)(F.lds + LDS_X_OFF); const LAS int* pstart = blk_end + 32; const LAS int* cnts = blk_end + 64;
    const int* tope = (const int*)(F.ws + MOEI_TOPE); const float* topg = (const float*)(F.ws + MOEI_TOPG);
    int* dest = (int*)(F.ws + MOEI_DEST); float* rowg = (float*)(F.ws + MOEI_ROWG); int* rowt = (int*)(F.ws + MOEI_ROWT);
    for (int a = F.bid * NTHREADS + F.tid; a < nrows * 4; a += F.G * NTHREADS) {
        const int te = tope[a], e = te & 255, rank = (int)((unsigned)te >> 8), d = pstart[e] + rank;
        dest[a] = d; rowg[d] = topg[a]; rowt[d] = a >> 2; }
    if (F.bid < 32) { const int e = F.bid, r0 = pstart[e] + cnts[e], r1 = blk_end[e] * 256;
        for (int r = r0 + F.tid; r < r1; r += NTHREADS) { rowt[r] = 0; rowg[r] = 0.f; } }
}
__device__ __forceinline__ void phase_gemm1(Frame& F, int l) {
    moe_tables(F, l);
    const LAS int* blk_end = (const LAS int*)(F.lds + LDS_X_OFF);
    pg8::Gemm g{(const bf16*)(F.ws + WS_H8), (const bf16*)(F.ws + WS_WGU + (size_t)l * 32 * 2048 * 2048), MOE_ROWS, 2048, 1024, WGU_E8M0};
    pg8::MoeOrderG S{F.bid, __builtin_amdgcn_readfirstlane(blk_end[31]), (const char*)g.A, (const char*)g.Bt, (size_t)256 * 2048, (size_t)2048 * 2048, (size_t)256 * 2048, blk_end, (const int*)(F.ws + MOEI_ROWT)};
#if FP8_GEMM2
    pg8::EpiSwiglu8 E{F.ws + WS_ACT, F.in[I_BGU] + (size_t)l * 32 * 2048};
    pg8::gemm_phase<pg8::EpiSwiglu8, pg8::MoeOrderG, true, true, true>(F.lds + RING_OFF, g, S, E);
#else
    pg8::EpiSwiglu E{(bf16*)(F.ws + WS_ACT), F.in[I_BGU] + (size_t)l * 32 * 2048};
    pg8::gemm_phase<pg8::EpiSwiglu, pg8::MoeOrderG, true, true, true>(F.lds + RING_OFF, g, S, E);
#endif
}
__device__ __forceinline__ void phase_gemm2(Frame& F, int l) {
    moe_tables(F, l);
    const LAS int* blk_end = (const LAS int*)(F.lds + LDS_X_OFF);
#if FP8_GEMM2
    pg8::Gemm g{(const bf16*)(F.ws + WS_ACT), (const bf16*)(F.ws + WS_WDN + (size_t)l * 32 * 2048 * 1024), MOE_ROWS, 2048, 512, WDN_E8M0};
    pg8::MoeOrder S{F.bid, __builtin_amdgcn_readfirstlane(blk_end[31]), (const char*)g.A, (const char*)g.Bt, (size_t)256 * 1024, (size_t)2048 * 1024, (size_t)256 * 1024, blk_end, nullptr};
    pg8::EpiDown E{(bf16*)(F.ws + WS_YS), F.in[I_BDN] + (size_t)l * 32 * 2048, (const float*)(F.ws + MOEI_ROWG)};
    pg8::gemm_phase<pg8::EpiDown, pg8::MoeOrder, true, true, true>(F.lds + RING_OFF, g, S, E);
#else
    pg8::Gemm g{(const bf16*)(F.ws + WS_ACT), (const bf16*)(F.ws + WS_WDN) + (size_t)l * 32 * 2048 * 1024, MOE_ROWS, 2048, 1024};
    pg8::MoeOrder S{F.bid, __builtin_amdgcn_readfirstlane(blk_end[31]), (const char*)g.A, (const char*)g.Bt, (size_t)256 * 1024 * 2, (size_t)2048 * 1024 * 2, (size_t)256 * 1024 * 2, blk_end, nullptr};
    pg8::EpiDown E{(bf16*)(F.ws + WS_YS), F.in[I_BDN] + (size_t)l * 32 * 2048, (const float*)(F.ws + MOEI_ROWG)};
    pg8::gemm_phase<pg8::EpiDown, pg8::MoeOrder, true, true>(F.lds + RING_OFF, g, S, E);
#endif
}
#ifndef PHASE_NORM2
#define PHASE_NORM2(F, l) phase_norm2(F, l)
#endif
#ifndef PHASE_SCATTER
#define PHASE_SCATTER(F, l) phase_scatter(F, l)
#endif
#ifndef PHASE_GEMM1
#define PHASE_GEMM1(F, l) phase_gemm1(F, l)
#endif
#ifndef PHASE_GEMM2
#define PHASE_GEMM2(F, l) phase_gemm2(F, l)
#endif
#define USE_MFMA_ATTN 1

__device__ __forceinline__ void attn_prep(Frame& F, int l) {
    bf16* P = (bf16*)(F.ws + WS_P);
    LAS unsigned short* vt = (LAS unsigned short*)F.lds;
    for (int ct = F.bid; ct < NCT; ct += F.G) {
        const int m0 = ct * 64; const bool lat = m0 < NLAT;
        __syncthreads();
        for (int i = F.tid; i < 64 * 32; i += NTHREADS) { const int tk = i >> 5, c8 = i & 31;
            const v4u w = *(const v4u*)(P + (size_t)(m0 + tk) * PW + PC_V + c8 * 8);
            const unsigned ww[4] = {w.x, w.y, w.z, w.w};
#pragma unroll
            for (int q = 0; q < 4; ++q) { vt[(c8 * 8 + 2 * q) * 66 + tk] = (unsigned short)(ww[q] & 0xffffu); vt[(c8 * 8 + 2 * q + 1) * 66 + tk] = (unsigned short)(ww[q] >> 16); } }
        if (lat) { const int tk = F.tid >> 3, kvh = (F.tid >> 1) & 3, hf = F.tid & 1; const int t = (m0 + tk) & 4095;
            bf16* kp = P + (size_t)(m0 + tk) * PW + PC_K + kvh * 64 + hf * 32;
            const v4u w0 = *(const v4u*)kp, w1 = *(const v4u*)(kp + 8), w2 = *(const v4u*)(kp + 16), w3 = *(const v4u*)(kp + 24);
            const unsigned lo[8] = {w0.x, w0.y, w0.z, w0.w, w1.x, w1.y, w1.z, w1.w}, hi_[8] = {w2.x, w2.y, w2.z, w2.w, w3.x, w3.y, w3.z, w3.w};
            const float pos = (float)(hf ? (t & 63) : (t >> 6)); unsigned o1[8], o2[8];
#pragma unroll
            for (int jj = 0; jj < 8; ++jj) { float r1[2], r2[2];
#pragma unroll
                for (int e = 0; e < 2; ++e) { const int j = 2 * jj + e; const float inv = __builtin_amdgcn_exp2f(-(float)j * 0.8304820237218406f); const float sn = __sinf(pos * inv), cs = __cosf(pos * inv);
                    const float x1 = e ? bfhi(lo[jj]) : bflo(lo[jj]), x2 = e ? bfhi(hi_[jj]) : bflo(hi_[jj]); r1[e] = x1 * cs - x2 * sn; r2[e] = x2 * cs + x1 * sn; }
                o1[jj] = pk2(r1[0], r1[1]); o2[jj] = pk2(r2[0], r2[1]); }
            *(v4u*)kp = (v4u){o1[0], o1[1], o1[2], o1[3]}; *(v4u*)(kp + 8) = (v4u){o1[4], o1[5], o1[6], o1[7]}; *(v4u*)(kp + 16) = (v4u){o2[0], o2[1], o2[2], o2[3]}; *(v4u*)(kp + 24) = (v4u){o2[4], o2[5], o2[6], o2[7]}; }
        __syncthreads();
        for (int i = F.tid; i < 256 * 8; i += NTHREADS) { const int col = i >> 3, c = i & 7, kvh = col >> 6, d = col & 63;
            v4u o; const LAS unsigned short* s = vt + col * 66 + c * 8;
            o.x = s[0] | ((unsigned)s[1] << 16); o.y = s[2] | ((unsigned)s[3] << 16); o.z = s[4] | ((unsigned)s[5] << 16); o.w = s[6] | ((unsigned)s[7] << 16);
            if (lat) { const int b = m0 >> 12, t0 = m0 & 4095; *(v4u*)((bf16*)(F.ws + WS_VT) + ((size_t)(b * 4 + kvh) * 64 + d) * SEQ + t0 + c * 8) = o; }
            else { const int mm = m0 - NLAT, b = mm >> 8, t0 = mm & 255; *(v4u*)((bf16*)(F.ws + WS_VTC) + ((size_t)(b * 4 + kvh) * 64 + d) * CTXL + t0 + c * 8) = o; } }
    }
    __syncthreads();
}

constexpr int AT_KP = 144, AT_VP = 136;
constexpr int AT_KOFF = 0, AT_VOFF = 64 * AT_KP, AT_TILE = 64 * AT_KP + 64 * AT_VP;
__device__ __forceinline__ void attn_unit(Frame& F, int l, int b, int kvh, int qi, int is_ctx) {
    const bf16* P = (const bf16*)(F.ws + WS_P); bf16* CC = (bf16*)(F.ws + WS_CC);
    int lane_o = F.lane; asm volatile("" : "+v"(lane_o));
    const int g = F.wave >> 1, qh = F.wave & 1, hq = kvh * 4 + g, r32 = lane_o & 31, hi = lane_o >> 5;
    const int rowbase = is_ctx ? NLAT + b * CTXL : b * SEQ;
    const int qa = qi * 128 + qh * 64;
    const float LOG2E = 1.4426950408889634f;
    bf16x8 qf[2][4];
#pragma unroll
    for (int qt = 0; qt < 2; ++qt) { const int tq = qa + 32 * qt + r32; const bf16* qp = P + (size_t)(rowbase + tq) * PW + PC_Q + hq * 64 + 8 * hi;
        float x[4][8];
#pragma unroll
        for (int s = 0; s < 4; ++s) { const v4u w = *(const v4u*)(qp + 16 * s); x[s][0] = bflo(w.x); x[s][1] = bfhi(w.x); x[s][2] = bflo(w.y); x[s][3] = bfhi(w.y); x[s][4] = bflo(w.z); x[s][5] = bfhi(w.z); x[s][6] = bflo(w.w); x[s][7] = bfhi(w.w); }
        if (!is_ctx) {
#pragma unroll
            for (int hf = 0; hf < 2; ++hf) { const float pos = (float)(hf ? (tq & 63) : (tq >> 6));
#pragma unroll
                for (int j = 0; j < 8; ++j) { const float inv = __builtin_amdgcn_exp2f(-(float)(8 * hi + j) * 0.8304820237218406f); const float sn = __sinf(pos * inv), cs = __cosf(pos * inv);
                    const float x1 = x[2 * hf][j], x2 = x[2 * hf + 1][j]; x[2 * hf][j] = x1 * cs - x2 * sn; x[2 * hf + 1][j] = x2 * cs + x1 * sn; } } }
        const float sc = 0.125f * LOG2E;
#pragma unroll
        for (int s = 0; s < 4; ++s) { v4u w; w.x = pk2(x[s][0] * sc, x[s][1] * sc); w.y = pk2(x[s][2] * sc, x[s][3] * sc); w.z = pk2(x[s][4] * sc, x[s][5] * sc); w.w = pk2(x[s][6] * sc, x[s][7] * sc); qf[qt][s] = __builtin_bit_cast(bf16x8, w); }
    }
    float mrun[2], lrun[2]; f32x16 O[2][2];
    { const float sk = F.in[I_SINK][l * 16 + hq] * LOG2E;
#pragma unroll
      for (int qt = 0; qt < 2; ++qt) { mrun[qt] = sk; lrun[qt] = hi ? 0.f : 1.f;
#pragma unroll
        for (int db = 0; db < 2; ++db)
#pragma unroll
            for (int r = 0; r < 16; ++r) O[qt][db][r] = 0.f; } }
    const int kt_lo = is_ctx ? 0 : (qi == 0 ? 2 : 0), nl = is_ctx ? 0 : (6 - (qi == 0 ? 2 : 0) - (qi == 31 ? 2 : 0)), ntile = nl + 4;
    const int rr = F.tid >> 3, cch = F.tid & 7;
    const bf16* kbase_l = P + (size_t)(b * SEQ + rr) * PW + PC_K + kvh * 64 + cch * 8; const bf16* kbase_c = P + (size_t)(NLAT + b * CTXL + rr) * PW + PC_K + kvh * 64 + cch * 8;
    const bf16* vbase_l = (const bf16*)(F.ws + WS_VT) + ((size_t)(b * 4 + kvh) * 64 + rr) * SEQ + cch * 8; const bf16* vbase_c = (const bf16*)(F.ws + WS_VTC) + ((size_t)(b * 4 + kvh) * 64 + rr) * CTXL + cch * 8;
    v4u kw, vw;
    { const bool loc0 = nl > 0; const int k00 = loc0 ? 128 * (qi - 1) + 64 * kt_lo : 0; kw = *(const v4u*)((loc0 ? kbase_l : kbase_c) + (size_t)k00 * PW); vw = *(const v4u*)((loc0 ? vbase_l : vbase_c) + k00); }
    LDS_BARRIER();
#pragma unroll 1
    for (int jt = 0; jt < ntile; ++jt) {
        const bool local = jt < nl; const int k0 = local ? 128 * (qi - 1) + 64 * (kt_lo + jt) : 64 * (jt - nl);
        const LAS unsigned char* KS = F.lds + (jt & 1) * AT_TILE + AT_KOFF; const LAS unsigned char* VS = F.lds + (jt & 1) * AT_TILE + AT_VOFF;
        { *(LAS v4u*)(F.lds + (jt & 1) * AT_TILE + AT_KOFF + rr * AT_KP + cch * 16) = kw;
          LAS v2u* vd = (LAS v2u*)(F.lds + (jt & 1) * AT_TILE + AT_VOFF + rr * AT_VP + cch * 16); vd[0] = (v2u){vw.x, vw.y}; vd[1] = (v2u){vw.z, vw.w}; }
        if (jt + 1 < ntile) { const bool ln = jt + 1 < nl; const int kn = ln ? 128 * (qi - 1) + 64 * (kt_lo + jt + 1) : 64 * (jt + 1 - nl);
            kw = *(const v4u*)((ln ? kbase_l : kbase_c) + (size_t)kn * PW); vw = *(const v4u*)((ln ? vbase_l : vbase_c) + kn); }
        LDS_BARRIER();
        if (local && (k0 + 63 < qa - 128 || k0 > qa + 63 + 128)) continue;
#pragma unroll 1
        for (int kb = 0; kb < 2; ++kb) {
            bf16x8 kf[4];
#pragma unroll
            for (int ss = 0; ss < 4; ++ss) kf[ss] = *(const LAS bf16x8*)(KS + (32 * kb + r32) * AT_KP + (16 * ss + 8 * hi) * 2);
            bf16x8 pb[2][2];
#pragma unroll
            for (int qt = 0; qt < 2; ++qt) { const int tq = qa + 32 * qt + r32;
                f32x16 s;
#pragma unroll
                for (int r = 0; r < 16; ++r) s[r] = 0.f;
#pragma unroll
                for (int ss = 0; ss < 4; ++ss) s = __builtin_amdgcn_mfma_f32_32x32x16_bf16(kf[ss], qf[qt][ss], s, 0, 0, 0);
                if (local) {
#pragma unroll
                    for (int r = 0; r < 16; ++r) { const int kidx = k0 + 32 * kb + (r & 3) + 8 * (r >> 2) + 4 * hi; const int dlt = kidx - tq; if (dlt > 128 || dlt < -128) s[r] = -1.0e30f; } }
                float mloc = s[0];
#pragma unroll
                for (int r = 1; r < 16; ++r) mloc = fmaxf(mloc, s[r]);
                mloc = fmaxf(mloc, __shfl_xor(mloc, 32));
                const float mnew = fmaxf(mrun[qt], mloc), alpha = __builtin_amdgcn_exp2f(mrun[qt] - mnew); mrun[qt] = mnew;
                float psum = 0.f;
#pragma unroll
                for (int r = 0; r < 16; ++r) { s[r] = __builtin_amdgcn_exp2f(s[r] - mnew); psum += s[r]; }
                lrun[qt] = lrun[qt] * alpha + psum;
#pragma unroll
                for (int db = 0; db < 2; ++db)
#pragma unroll
                    for (int r = 0; r < 16; ++r) O[qt][db][r] *= alpha;
#pragma unroll
                for (int s2 = 0; s2 < 2; ++s2) { v4u pw; pw.x = pk2(s[8 * s2 + 0], s[8 * s2 + 1]); pw.y = pk2(s[8 * s2 + 2], s[8 * s2 + 3]); pw.z = pk2(s[8 * s2 + 4], s[8 * s2 + 5]); pw.w = pk2(s[8 * s2 + 6], s[8 * s2 + 7]);
                    pb[qt][s2] = __builtin_bit_cast(bf16x8, pw); }
            }
#pragma unroll
            for (int s2 = 0; s2 < 2; ++s2)
#pragma unroll
                for (int db = 0; db < 2; ++db) { const LAS v2u* vp = (const LAS v2u*)(VS + (32 * db + r32) * AT_VP + (32 * kb + 16 * s2 + 4 * hi) * 2);
                    const v2u a0 = vp[0], a1 = vp[2]; v4u aw; aw.x = a0.x; aw.y = a0.y; aw.z = a1.x; aw.w = a1.y; const bf16x8 va = __builtin_bit_cast(bf16x8, aw);
                    O[0][db] = __builtin_amdgcn_mfma_f32_32x32x16_bf16(va, pb[0][s2], O[0][db], 0, 0, 0);
                    O[1][db] = __builtin_amdgcn_mfma_f32_32x32x16_bf16(va, pb[1][s2], O[1][db], 0, 0, 0); }
        }
    }
    int r32e = r32, hie = hi; asm volatile("" : "+v"(r32e), "+v"(hie));
#pragma unroll
    for (int qt = 0; qt < 2; ++qt) { const float lt = lrun[qt] + __shfl_xor(lrun[qt], 32); const float rl = 1.0f / lt; const int tq = qa + 32 * qt + r32e;
        bf16* op = CC + (size_t)(rowbase + tq) * DM + hq * 64 + 4 * hie;
#pragma unroll
        for (int db = 0; db < 2; ++db)
#pragma unroll
            for (int rq = 0; rq < 4; ++rq) { v2u w; w.x = pk2(O[qt][db][4 * rq] * rl, O[qt][db][4 * rq + 1] * rl); w.y = pk2(O[qt][db][4 * rq + 2] * rl, O[qt][db][4 * rq + 3] * rl);
                *(v2u*)(op + 32 * db + 8 * rq) = w; } }
}
__device__ __forceinline__ void attn_phase(Frame& F, int l, int rep = 0) {
    const int nunits = 512 + (l == 0 ? 32 : 0);
    LAS int* slot = (LAS int*)(F.lds + LDS_X_OFF + 512);
    for (;;) {
        __syncthreads();
        if (F.tid == 0) *slot = (int)__hip_atomic_fetch_add(F.ctl + CW_ATQ + 64 * l + 8 * rep, 1u, RLX_AGENT);
        __syncthreads();
        const int u = __builtin_amdgcn_readfirstlane(*slot);
        if (u >= nunits) break;
        if (u < 512) attn_unit(F, l, u >> 7, (u >> 5) & 3, u & 31, 0); else { const int v = u - 512; attn_unit(F, l, v >> 3, (v >> 1) & 3, v & 1, 1); }
    }
}
#define USE_CHUNK_DN 1
#ifndef DN_SPLIT
#define DN_SPLIT 2
#endif
#ifndef DN_REP_S1
#define DN_REP_S1 1
#endif
#ifndef DN_REP_S3B
#define DN_REP_S3B 1
#endif
#ifndef DN_REP_S3A
#define DN_REP_S3A 1
#endif
#ifndef DN_REP_S4
#define DN_REP_S4 1
#endif

constexpr int DN_F_NEGW = 0, DN_F_QG = 16, DN_F_QK = 32, DN_F_KGT = 40, DN_NFRAG = 56, DN_U_OFF = 57344;
constexpr int DP_QS = 0, DP_KS = 17408, DP_VS = 34816, DP_AS = 52224  , DP_TB = 69632, DP_TW = 78848, DP_QK = 88064, DP_RAW = 52224  , DP_SC = 104960, DP_TF = 106496  , DP_XS = 123904  ;
constexpr int DP_P = 272, DP_P2 = 144;
__device__ __forceinline__ int dn_rec(int b, int h, int dir, int np) { return ((b * 4 + h) * 2 + dir) * 68 + np; }
__device__ __forceinline__ void dn_chunk_of(int ct, int dir, int& b, int& np) { if (ct < 256) { b = ct >> 6; const int c = ct & 63; np = 4 + (dir ? 63 - c : c); } else { b = (ct - 256) >> 2; const int c = (ct - 256) & 3; np = dir ? 3 - c : c; } }
__device__ __forceinline__ unsigned short lds_u16(const LAS unsigned char* p) { return *(const LAS unsigned short*)p; }

__device__ __forceinline__ void dn_prep_unit(Frame& F, int l, int ct, int h, int dir) {
    const bf16* P = (const bf16*)(F.ws + WS_P);
    int lane = F.lane; asm volatile("" : "+v"(lane));
    const int wave = F.wave, i16 = lane & 15, q = lane >> 4;
    const int m0 = ct * 64; int t0, T, base; seq_of(m0, t0, T, base);
    int b, np; dn_chunk_of(ct, dir, b, np);
    unsigned char* tile = F.ws + WS_DNT + (size_t)dn_rec(b, h, dir, np) * DNT_BYTES;
    LAS unsigned char* L = F.lds;
    LAS float* SC = (LAS float*)(L + DP_SC);
    LDS_BARRIER();
    {
        const float* cw = F.in[I_DNCW] + (size_t)l * 4 * 1536;
        LAS float* cwl = (LAS float*)(L + DP_TF);
        for (int i = F.tid; i < 3 * 4 * 128; i += NTHREADS) { const int part = i >> 9, j = (i >> 7) & 3, ch = i & 127; cwl[i] = cw[j * 1536 + part * 512 + h * 128 + ch]; }
        unsigned short pbw = 0, paw = 0;
        if (wave == 0) { const int tok = dir ? 63 - lane : lane; pbw = P[(size_t)(m0 + tok) * PW + PC_BETA + dir * 4 + h]; paw = P[(size_t)(m0 + tok) * PW + PC_DEC + dir * 4 + h]; }
        for (int c = F.tid; c < 67 * 48; c += NTHREADS) { const int row = c / 48, ch = c % 48, part = ch >> 4, cc = ch & 15, tt = t0 + row - 2;
            v4u v = (v4u){0u, 0u, 0u, 0u};
            if (tt >= 0 && tt < T) v = *(const v4u*)(P + (size_t)(base + tt) * PW + PC_DQ + part * 512 + h * 128 + cc * 8);
            *(LAS v4u*)(L + DP_RAW + row * 784 + part * 256 + cc * 16) = v; }
        LDS_BARRIER();
#pragma unroll 1
        for (int rep = 0; rep < DN_REP_S1; ++rep)
#pragma unroll
        for (int part = 0; part < 3; ++part) { const int tok = F.tid >> 3, g8 = F.tid & 7;
            float sv[16];
#pragma unroll
            for (int k = 0; k < 16; ++k) sv[k] = 0.f;
#pragma unroll
            for (int j = 0; j < 4; ++j) { const LAS v4u* rp = (const LAS v4u*)(L + DP_RAW + (tok + j) * 784 + part * 256 + g8 * 32); const v4u r0 = rp[0], r1 = rp[1];
                const LAS f32x4* wp = (const LAS f32x4*)(cwl + (part * 4 + j) * 128 + g8 * 16); const f32x4 w0 = wp[0], w1 = wp[1], w2 = wp[2], w3 = wp[3];
                sv[0] += w0.x * bflo(r0.x); sv[1] += w0.y * bfhi(r0.x); sv[2] += w0.z * bflo(r0.y); sv[3] += w0.w * bfhi(r0.y); sv[4] += w1.x * bflo(r0.z); sv[5] += w1.y * bfhi(r0.z); sv[6] += w1.z * bflo(r0.w); sv[7] += w1.w * bfhi(r0.w);
                sv[8] += w2.x * bflo(r1.x); sv[9] += w2.y * bfhi(r1.x); sv[10] += w2.z * bflo(r1.y); sv[11] += w2.w * bfhi(r1.y); sv[12] += w3.x * bflo(r1.z); sv[13] += w3.y * bfhi(r1.z); sv[14] += w3.z * bflo(r1.w); sv[15] += w3.w * bfhi(r1.w); }
            float ss = 0.f;
#pragma unroll
            for (int k = 0; k < 16; ++k) { sv[k] = siluf_(sv[k]); ss += sv[k] * sv[k]; }
            if (part < 2) { ss += dpp_mov<0xB1>(ss); ss += dpp_mov<0x4E>(ss); ss += dpp_mov<0x141>(ss);
                const float f = (part == 0 ? 0.08838834764831845f : 1.0f) * __builtin_amdgcn_rsqf(ss + EPS);
#pragma unroll
                for (int k = 0; k < 16; ++k) sv[k] *= f; }
            LAS v4u* op = (LAS v4u*)(L + (part == 0 ? DP_QS : (part == 1 ? DP_KS : DP_VS)) + tok * DP_P + g8 * 32);
            op[0] = (v4u){pk2(sv[0], sv[1]), pk2(sv[2], sv[3]), pk2(sv[4], sv[5]), pk2(sv[6], sv[7])}; op[1] = (v4u){pk2(sv[8], sv[9]), pk2(sv[10], sv[11]), pk2(sv[12], sv[13]), pk2(sv[14], sv[15])}; }
        if (wave == 0) {
            const float pb = bf2f(pbw), pa = bf2f(paw);
            const float beta = sigmoidf_(pb); float gc = -__expf(F.in[I_DNALOG][l * 8 + dir * 4 + h]) * softplusf_(pa + F.in[I_DNDT][l * 8 + dir * 4 + h]);
#pragma unroll
            for (int o = 1; o < 64; o <<= 1) { const float v = __shfl_up(gc, o); if (lane >= o) gc += v; }
            const float glast = __shfl(gc, 63);
            SC[lane] = beta; SC[64 + lane] = gc; SC[128 + lane] = __expf(gc); SC[192 + lane] = __expf(glast - gc);
            if (lane == 63) ((float*)(F.ws + WS_DNS))[dn_rec(b, h, dir, np)] = __expf(glast);
        }
    }
    LDS_BARRIER();
#define DN_TOK(r) (dir ? 63 - (r) : (r))
#pragma unroll 1
    for (int rep = 0; rep < DN_REP_S3A; ++rep)
    {
        const int mb = wave & 3, which = wave >> 2;
        f32x4 acc[4];
#pragma unroll
        for (int nb = 0; nb < 4; ++nb) acc[nb] = (f32x4){0.f, 0.f, 0.f, 0.f};
        const LAS unsigned char* arow = L + (which ? DP_QS : DP_KS) + DN_TOK(16 * mb + i16) * DP_P + 16 * q;
#pragma unroll
        for (int ks = 0; ks < 4; ++ks) { const bf16x8 a = *(const LAS bf16x8*)(arow + 64 * ks);
#pragma unroll
            for (int nb = 0; nb < 4; ++nb) { const bf16x8 bb = *(const LAS bf16x8*)(L + DP_KS + DN_TOK(16 * nb + i16) * DP_P + 16 * q + 64 * ks);
                acc[nb] = __builtin_amdgcn_mfma_f32_16x16x32_bf16(a, bb, acc[nb], 0, 0, 0); } }
#pragma unroll
        for (int nb = 0; nb < 4; ++nb)
#pragma unroll
            for (int i = 0; i < 4; ++i) { const int r = 16 * mb + 4 * q + i, c = 16 * nb + i16; const float dec = __expf(SC[64 + r] - SC[64 + c]);
                if (which == 0) ((LAS float*)(L + DP_AS))[r * 68 + c] = (r > c) ? SC[r] * acc[nb][i] * dec : 0.f;
                else *(LAS unsigned short*)(L + DP_QK + r * DP_P2 + c * 2) = (unsigned short)f2bf((r >= c) ? acc[nb][i] * dec : 0.f); }
    }
    LDS_BARRIER();
#pragma unroll 1
    for (int rep = 0; rep < DN_REP_S3B; ++rep) {
    if (wave == 0) {
        const LAS float* As = (const LAS float*)(L + DP_AS); LAS float* Tf = (LAS float*)(L + DP_TF);
        const int g = lane >> 4, c = lane & 15;
        f32x4 ar[16][4];
#pragma unroll
        for (int r = 1; r < 16; ++r)
#pragma unroll
            for (int j4 = 0; j4 < (r + 3) / 4; ++j4) ar[r][j4] = *(const LAS f32x4*)(As + (16 * g + r) * 68 + 16 * g + 4 * j4);
        float t[16];
#pragma unroll
        for (int r = 0; r < 16; ++r) { float a0 = (c == r) ? 1.f : 0.f, a1 = 0.f;
#pragma unroll
            for (int j = 0; j < r; ++j) { const float av = ar[r][j >> 2][j & 3]; if (j & 1) a1 -= av * t[j]; else a0 -= av * t[j]; }
            t[r] = a0 + a1; Tf[(16 * g + r) * 68 + 16 * g + c] = t[r]; }
    }
    LDS_BARRIER();
    if (wave < 3) {
        const LAS float* As = (const LAS float*)(L + DP_AS); LAS float* Tf = (LAS float*)(L + DP_TF); LAS float* Xs = (LAS float*)(L + DP_XS) + wave * 272;
        const int J = wave;
#pragma unroll 1
        for (int I = J + 1; I < 4; ++I) {
            f32x4 acc = {0.f, 0.f, 0.f, 0.f};
#pragma unroll 1
            for (int K = J; K < I; ++K)
#pragma unroll
                for (int sk = 0; sk < 4; ++sk) acc = __builtin_amdgcn_mfma_f32_16x16x4f32(As[(16 * I + i16) * 68 + 16 * K + 4 * sk + q], Tf[(16 * K + 4 * sk + q) * 68 + 16 * J + i16], acc, 0, 0, 0);
#pragma unroll
            for (int i = 0; i < 4; ++i) Xs[(4 * q + i) * 17 + i16] = acc[i];
            LDS_WAIT(); asm volatile("" ::: "memory");
            f32x4 acc2 = {0.f, 0.f, 0.f, 0.f};
#pragma unroll
            for (int sk = 0; sk < 4; ++sk) acc2 = __builtin_amdgcn_mfma_f32_16x16x4f32(Tf[(16 * I + i16) * 68 + 16 * I + 4 * sk + q], Xs[(4 * sk + q) * 17 + i16], acc2, 0, 0, 0);
#pragma unroll
            for (int i = 0; i < 4; ++i) Tf[(16 * I + 4 * q + i) * 68 + 16 * J + i16] = -acc2[i];
            LDS_WAIT(); asm volatile("" ::: "memory");
        }
    }
    LDS_BARRIER();
    { const LAS float* Tf = (const LAS float*)(L + DP_TF); const int r = F.tid >> 3, c0 = (F.tid & 7) * 8; float vb[8], vw[8];
#pragma unroll
      for (int k = 0; k < 8; ++k) { const int c = c0 + k; const float v = ((r >> 4) >= (c >> 4)) ? Tf[r * 68 + c] : 0.f; const float bl = SC[c]; vb[k] = v * bl; vw[k] = vb[k] * SC[128 + c]; }
      v4u ob, ow; ob.x = pk2(vb[0], vb[1]); ob.y = pk2(vb[2], vb[3]); ob.z = pk2(vb[4], vb[5]); ob.w = pk2(vb[6], vb[7]); ow.x = pk2(vw[0], vw[1]); ow.y = pk2(vw[2], vw[3]); ow.z = pk2(vw[4], vw[5]); ow.w = pk2(vw[6], vw[7]);
      *(LAS v4u*)(L + DP_TB + r * DP_P2 + c0 * 2) = ob; *(LAS v4u*)(L + DP_TW + r * DP_P2 + c0 * 2) = ow; }
    }
    LDS_BARRIER();
    {
        const int nbp = wave & 3, which = wave >> 2;
        f32x4 acc[4][2];
#pragma unroll
        for (int mb = 0; mb < 4; ++mb) { acc[mb][0] = (f32x4){0.f, 0.f, 0.f, 0.f}; acc[mb][1] = (f32x4){0.f, 0.f, 0.f, 0.f}; }
#pragma unroll
        for (int ks = 0; ks < 2; ++ks) {
            bf16x8 bb[2];
#pragma unroll
            for (int nn = 0; nn < 2; ++nn) { const int n = 16 * (2 * nbp + nn) + i16; unsigned short e[8];
#pragma unroll
                for (int jj = 0; jj < 8; ++jj) e[jj] = lds_u16(L + (which ? DP_KS : DP_VS) + DN_TOK(32 * ks + 8 * q + jj) * DP_P + n * 2);
                v4u w; w.x = e[0] | ((unsigned)e[1] << 16); w.y = e[2] | ((unsigned)e[3] << 16); w.z = e[4] | ((unsigned)e[5] << 16); w.w = e[6] | ((unsigned)e[7] << 16); bb[nn] = __builtin_bit_cast(bf16x8, w); }
#pragma unroll
            for (int mb = 0; mb < 4; ++mb) { const bf16x8 a = *(const LAS bf16x8*)(L + (which ? DP_TW : DP_TB) + (16 * mb + i16) * DP_P2 + 64 * ks + 16 * q);
                acc[mb][0] = __builtin_amdgcn_mfma_f32_16x16x32_bf16(a, bb[0], acc[mb][0], 0, 0, 0); acc[mb][1] = __builtin_amdgcn_mfma_f32_16x16x32_bf16(a, bb[1], acc[mb][1], 0, 0, 0); } }
        if (which == 0) {
#pragma unroll
            for (int mb = 0; mb < 4; ++mb)
#pragma unroll
                for (int nn = 0; nn < 2; ++nn) *(f32x4*)(tile + DN_U_OFF + (size_t)((((2 * nbp + nn) * 4 + mb) * 64 + lane) * 16)) = acc[mb][nn];
        } else {
#pragma unroll
            for (int mb = 0; mb < 4; ++mb)
#pragma unroll
                for (int nn = 0; nn < 2; ++nn)
#pragma unroll
                    for (int i = 0; i < 4; ++i) *(LAS unsigned short*)(L + DP_AS + (16 * mb + 4 * q + i) * DP_P + (16 * (2 * nbp + nn) + i16) * 2) = (unsigned short)f2bf(-acc[mb][nn][i]);
        }
    }
    LDS_BARRIER();
#pragma unroll 1
    for (int rep = 0; rep < DN_REP_S4; ++rep)
#pragma unroll 1
    for (int fi = 0; fi < 7; ++fi) { const int f = wave * 7 + fi; v4u o;
        if (f < DN_F_QG) { const int mb = f >> 2, ks = f & 3; const LAS unsigned char* rp = L + DP_AS + (16 * mb + i16) * DP_P + (32 * ks + 4 * q) * 2;
            const v2u a = *(const LAS v2u*)rp, c = *(const LAS v2u*)(rp + 32); o.x = a.x; o.y = a.y; o.z = c.x; o.w = c.y; }
        else if (f < DN_F_QK) { const int ff = f - DN_F_QG, mb = ff >> 2, ks = ff & 3, r = 16 * mb + i16; const LAS unsigned char* rp = L + DP_QS + DN_TOK(r) * DP_P + (32 * ks + 4 * q) * 2; const float eg = SC[128 + r];
            const v2u a = *(const LAS v2u*)rp, c = *(const LAS v2u*)(rp + 32);
            o.x = pk2(bflo(a.x) * eg, bfhi(a.x) * eg); o.y = pk2(bflo(a.y) * eg, bfhi(a.y) * eg); o.z = pk2(bflo(c.x) * eg, bfhi(c.x) * eg); o.w = pk2(bflo(c.y) * eg, bfhi(c.y) * eg); }
        else if (f < DN_F_KGT) { const int ff = f - DN_F_QK, mb = ff >> 1, ks = ff & 1; const LAS unsigned char* rp = L + DP_QK + (16 * mb + i16) * DP_P2 + (32 * ks + 4 * q) * 2;
            const v2u a = *(const LAS v2u*)rp, c = *(const LAS v2u*)(rp + 32); o.x = a.x; o.y = a.y; o.z = c.x; o.w = c.y; }
        else { const int ff = f - DN_F_KGT, mb = ff >> 1, ks = ff & 1, dk = 16 * mb + i16; float e[8];
#pragma unroll
            for (int jj = 0; jj < 8; ++jj) { const int key = 32 * ks + 16 * (jj >> 2) + 4 * q + (jj & 3); e[jj] = bf2f(lds_u16(L + DP_KS + DN_TOK(key) * DP_P + dk * 2)) * SC[192 + key]; }
            o.x = pk2(e[0], e[1]); o.y = pk2(e[2], e[3]); o.z = pk2(e[4], e[5]); o.w = pk2(e[6], e[7]); }
        *(v4u*)(tile + (size_t)f * 1024 + lane * 16) = o; }
#undef DN_TOK
}
__device__ __forceinline__ void dn_prep(Frame& F, int l) {
    for (int u = F.bid; u < NCT * 4 * 2; u += F.G) dn_prep_unit(F, l, u >> 3, (u >> 1) & 3, u & 1);
    __syncthreads();
}

__device__ __forceinline__ void dn_scan(Frame& F, int l, int b, int h, int dir, int half) {
    int lane = F.lane; asm volatile("" : "+v"(lane));
    const int w = (DN_SPLIT == 2) ? half * 4 + (F.wave & 3) : F.wave, i16 = lane & 15, q = lane >> 4; const bool active = (DN_SPLIT == 2) ? (F.wave < 4) : true;
    const unsigned char* tiles = F.ws + WS_DNT + (size_t)dn_rec(b, h, dir, 0) * DNT_BYTES;
    const float* egl = (const float*)(F.ws + WS_DNS) + dn_rec(b, h, dir, 0);
    float* O = (float*)(F.ws + WS_DNO);
    LAS unsigned char* L = F.lds;
    f32x4 S[8];
#pragma unroll
    for (int i = 0; i < 8; ++i) S[i] = (f32x4){0.f, 0.f, 0.f, 0.f};
    v4u st[7]; f32x4 un[4];
#pragma unroll
    for (int mb = 0; mb < 4; ++mb) un[mb] = *(const f32x4*)(tiles + DN_U_OFF + (size_t)(((w * 4 + mb) * 64 + lane) * 16));
    LDS_BARRIER();
#pragma unroll
    for (int i = 0; i < 7; ++i) st[i] = *(const v4u*)(tiles + (size_t)(F.tid + i * NTHREADS) * 16);
#pragma unroll
    for (int i = 0; i < 7; ++i) *(LAS v4u*)(L + (F.tid + i * NTHREADS) * 16) = st[i];
#pragma unroll
    for (int i = 0; i < 7; ++i) st[i] = *(const v4u*)(tiles + DNT_BYTES + (size_t)(F.tid + i * NTHREADS) * 16);
    LDS_BARRIER();
#pragma unroll 1
    for (int n = 0; n < 68; ++n) {
        const unsigned char* tile = tiles + (size_t)n * DNT_BYTES; const LAS unsigned char* cur = L + (n & 1) * 57344;
        if (n + 1 < 68) {
#pragma unroll
            for (int i = 0; i < 7; ++i) *(LAS v4u*)(L + ((n + 1) & 1) * 57344 + (F.tid + i * NTHREADS) * 16) = st[i]; }
        if (n + 2 < 68) {
#pragma unroll
            for (int i = 0; i < 7; ++i) st[i] = *(const v4u*)(tile + 2 * DNT_BYTES + (size_t)(F.tid + i * NTHREADS) * 16); }
        if (active) {
        f32x4 vn[4];
#pragma unroll
        for (int mb = 0; mb < 4; ++mb) vn[mb] = un[mb];
        if (n + 1 < 68) {
#pragma unroll
            for (int mb = 0; mb < 4; ++mb) un[mb] = *(const f32x4*)(tile + DNT_BYTES + DN_U_OFF + (size_t)(((w * 4 + mb) * 64 + lane) * 16)); }
        const float el = egl[n];
        bf16x8 bS[4];
#pragma unroll
        for (int ks = 0; ks < 4; ++ks) { v4u x; x.x = pk2(S[2 * ks][0], S[2 * ks][1]); x.y = pk2(S[2 * ks][2], S[2 * ks][3]); x.z = pk2(S[2 * ks + 1][0], S[2 * ks + 1][1]); x.w = pk2(S[2 * ks + 1][2], S[2 * ks + 1][3]); bS[ks] = __builtin_bit_cast(bf16x8, x); }
        f32x4 o[4];
#pragma unroll
        for (int mb = 0; mb < 4; ++mb) { o[mb] = (f32x4){0.f, 0.f, 0.f, 0.f};
#pragma unroll
            for (int ks = 0; ks < 4; ++ks) { const bf16x8 aw = *(const LAS bf16x8*)(cur + (DN_F_NEGW + mb * 4 + ks) * 1024 + lane * 16), aq = *(const LAS bf16x8*)(cur + (DN_F_QG + mb * 4 + ks) * 1024 + lane * 16);
                vn[mb] = __builtin_amdgcn_mfma_f32_16x16x32_bf16(aw, bS[ks], vn[mb], 0, 0, 0); o[mb] = __builtin_amdgcn_mfma_f32_16x16x32_bf16(aq, bS[ks], o[mb], 0, 0, 0); } }
        bf16x8 bV[2];
#pragma unroll
        for (int ks = 0; ks < 2; ++ks) { v4u x; x.x = pk2(vn[2 * ks][0], vn[2 * ks][1]); x.y = pk2(vn[2 * ks][2], vn[2 * ks][3]); x.z = pk2(vn[2 * ks + 1][0], vn[2 * ks + 1][1]); x.w = pk2(vn[2 * ks + 1][2], vn[2 * ks + 1][3]); bV[ks] = __builtin_bit_cast(bf16x8, x); }
#pragma unroll
        for (int mb = 0; mb < 8; ++mb) { S[mb] = S[mb] * el;
#pragma unroll
            for (int ks = 0; ks < 2; ++ks) { const bf16x8 ak = *(const LAS bf16x8*)(cur + (DN_F_KGT + mb * 2 + ks) * 1024 + lane * 16); S[mb] = __builtin_amdgcn_mfma_f32_16x16x32_bf16(ak, bV[ks], S[mb], 0, 0, 0); } }
#pragma unroll
        for (int mb = 0; mb < 4; ++mb)
#pragma unroll
            for (int ks = 0; ks < 2; ++ks) { const bf16x8 aqk = *(const LAS bf16x8*)(cur + (DN_F_QK + mb * 2 + ks) * 1024 + lane * 16); o[mb] = __builtin_amdgcn_mfma_f32_16x16x32_bf16(aqk, bV[ks], o[mb], 0, 0, 0); }
        { int m0; if (n < 4) m0 = NLAT + b * CTXL + 64 * (dir ? 3 - n : n); else m0 = b * SEQ + 64 * (dir ? 63 - (n - 4) : (n - 4));
#pragma unroll
          for (int mb = 0; mb < 4; ++mb)
#pragma unroll
            for (int i = 0; i < 4; ++i) { const int r = 16 * mb + 4 * q + i, tok = dir ? 63 - r : r; O[((size_t)dir * NTOK + m0 + tok) * 512 + h * 128 + 16 * w + i16] = o[mb][i]; } }
        }
        LDS_BARRIER();
    }
}
#define USE_CHUNK_LRU 1

constexpr int LR_XF = 0  , LR_XB = 16640  , LR_WT = 25856  , LR_AA = 62720  , LR_UU = 96000  , LR_END = 129280;
constexpr size_t WS_LCA = WS_LRC, WS_LCH = WS_LRC + 2 * MiB, WS_LCI = WS_LRC + 4 * MiB;
__device__ __forceinline__ void lru_prep(Frame& F, int l) {
    const bf16* P = (const bf16*)(F.ws + WS_P);
    int lane = F.lane; asm volatile("" : "+v"(lane));
    const int wave = F.wave, i16 = lane & 15, q = lane >> 4, nb = F.bid & 7;
    LAS unsigned char* L = F.lds;
    LAS float* XF = (LAS float*)(L + LR_XF); LAS float* AA = (LAS float*)(L + LR_AA); LAS float* UU = (LAS float*)(L + LR_UU);
    bf16* HL = (bf16*)(F.ws + WS_LRH); bf16* AC = (bf16*)(F.ws + WS_LRA);
    __syncthreads();
    for (int e = F.tid; e < 4 * 4096; e += NTHREADS) { const int mat = e >> 12, ii = (e >> 6) & 63, j = e & 63, dir = mat >> 1;
        const float w = (mat & 1 ? F.in[I_LRWI] : F.in[I_LRWR])[((size_t)((l * 2 + dir) * 8 + nb)) * 4096 + ii * 64 + j];
        *(LAS unsigned short*)(L + LR_WT + (mat * 64 + j) * 144 + ii * 2) = (unsigned short)f2bf(w); }
    float cwv[4][8], cbv[8];
    { const int c8 = (F.tid & 7) * 8, ch0 = nb * 64 + c8; const float* cb = F.in[I_LRCB] + l * 512 + ch0; const float* cw = F.in[I_LRCW] + (size_t)l * 4 * 512 + ch0;
#pragma unroll
      for (int k = 0; k < 8; ++k) cbv[k] = cb[k];
#pragma unroll
      for (int j = 0; j < 4; ++j)
#pragma unroll
        for (int k = 0; k < 8; ++k) cwv[j][k] = cw[j * 512 + k]; }
    float gbr[4], gbi[4], gls[4];
    { const int dir = wave >> 2;
#pragma unroll
      for (int n = 0; n < 4; ++n) { const int ch = nb * 64 + 16 * n + i16; gbr[n] = F.in[I_LRBR][(l * 2 + dir) * 512 + ch]; gbi[n] = F.in[I_LRBI][(l * 2 + dir) * 512 + ch]; gls[n] = -softplusf_(-F.in[I_LRLAM][(l * 2 + dir) * 512 + ch]); } }
    v4u wv[4];
#define LR_LOADRAW(ctx) do { const int _m0 = (ctx) * 64; int _t0, _T, _base; seq_of(_m0, _t0, _T, _base); const int _tok = F.tid >> 3, _ch0 = nb * 64 + (F.tid & 7) * 8; \
        _Pragma("unroll") for (int j = 0; j < 4; ++j) { const int tt = _t0 + _tok + j - 2; wv[j] = (v4u){0u, 0u, 0u, 0u}; if (tt >= 0 && tt < _T) wv[j] = *(const v4u*)(P + (size_t)(_base + tt) * PW + PC_LX + _ch0); } } while (0)
    if ((F.bid >> 3) < NCT) LR_LOADRAW(F.bid >> 3);
    for (int ct = F.bid >> 3; ct < NCT; ct += F.G >> 3) {
        const int m0 = ct * 64;
        LDS_BARRIER();
        { const int tok = F.tid >> 3, c8 = (F.tid & 7) * 8, ch0 = nb * 64 + c8; float s[8];
#pragma unroll
          for (int k = 0; k < 8; ++k) s[k] = cbv[k];
#pragma unroll
          for (int j = 0; j < 4; ++j) { const v4u w = wv[j];
              s[0] += cwv[j][0] * bflo(w.x); s[1] += cwv[j][1] * bfhi(w.x); s[2] += cwv[j][2] * bflo(w.y); s[3] += cwv[j][3] * bfhi(w.y); s[4] += cwv[j][4] * bflo(w.z); s[5] += cwv[j][5] * bfhi(w.z); s[6] += cwv[j][6] * bflo(w.w); s[7] += cwv[j][7] * bfhi(w.w); }
#pragma unroll
          for (int k = 0; k < 8; ++k) XF[tok * 65 + c8 + k] = s[k];
          v4u o; o.x = pk2(s[0], s[1]); o.y = pk2(s[2], s[3]); o.z = pk2(s[4], s[5]); o.w = pk2(s[6], s[7]); *(LAS v4u*)(L + LR_XB + tok * 144 + c8 * 2) = o; }
        if (ct + (F.G >> 3) < NCT) LR_LOADRAW(ct + (F.G >> 3));
        LDS_BARRIER();
        { const int dir = wave >> 2, mb = wave & 3;
          f32x4 ar[4], ai[4];
#pragma unroll
          for (int n = 0; n < 4; ++n) { ar[n] = (f32x4){0.f, 0.f, 0.f, 0.f}; ai[n] = (f32x4){0.f, 0.f, 0.f, 0.f}; }
#pragma unroll
          for (int ks = 0; ks < 2; ++ks) { const bf16x8 a = *(const LAS bf16x8*)(L + LR_XB + (16 * mb + i16) * 144 + 64 * ks + 16 * q);
#pragma unroll
              for (int n = 0; n < 4; ++n) { const bf16x8 br = *(const LAS bf16x8*)(L + LR_WT + ((dir * 2 + 0) * 64 + 16 * n + i16) * 144 + 64 * ks + 16 * q), bi = *(const LAS bf16x8*)(L + LR_WT + ((dir * 2 + 1) * 64 + 16 * n + i16) * 144 + 64 * ks + 16 * q);
                  ar[n] = __builtin_amdgcn_mfma_f32_16x16x32_bf16(a, br, ar[n], 0, 0, 0); ai[n] = __builtin_amdgcn_mfma_f32_16x16x32_bf16(a, bi, ai[n], 0, 0, 0); } }
#pragma unroll
          for (int n = 0; n < 4; ++n) { const int j = 16 * n + i16; const float br_ = gbr[n], bi_ = gbi[n], logsig = gls[n];
#pragma unroll
              for (int i = 0; i < 4; ++i) { const int tok = 16 * mb + 4 * q + i; const float r = sigmoidf_(ar[n][i] + br_), ig = sigmoidf_(ai[n][i] + bi_);
                  const float log_a = 8.0f * r * logsig, a = __expf(log_a), y2 = 2.0f * log_a;
                  const float om = (y2 > -0.1f) ? -y2 * (1.0f + y2 * (0.5f + y2 * (0.16666667f + y2 * 0.041666668f))) : 1.0f - __expf(y2);
                  const float u = __builtin_amdgcn_sqrtf(om) * (ig * XF[tok * 65 + j]);
                  AA[(dir * 64 + tok) * 65 + j] = a; UU[(dir * 64 + tok) * 65 + j] = u; } } }
        LDS_BARRIER();
        if (F.tid < 128) { const int dir = F.tid >> 6, j = F.tid & 63, ch = nb * 64 + j; float h = 0.f, ac = 1.f;
            long o = (long)(((size_t)dir * NTOK + m0 + (dir ? 63 : 0)) * 512 + ch); const long ostep = dir ? -512 : 512;
#pragma unroll 1
            for (int s0 = 0; s0 < 64; s0 += 8) { float av[8], uv[8];
#pragma unroll
                for (int k = 0; k < 8; ++k) { const int tok = dir ? 63 - (s0 + k) : (s0 + k); av[k] = AA[(dir * 64 + tok) * 65 + j]; uv[k] = UU[(dir * 64 + tok) * 65 + j]; }
#pragma unroll
                for (int k = 0; k < 8; ++k) { h = av[k] * h + uv[k]; ac *= av[k]; HL[o] = (bf16)f2bf(h); AC[o] = (bf16)f2bf(ac); o += ostep; } }
            ((float*)(F.ws + WS_LCA))[((size_t)dir * NCT + ct) * 512 + ch] = ac; ((float*)(F.ws + WS_LCH))[((size_t)dir * NCT + ct) * 512 + ch] = h; }
    }
    LDS_BARRIER();
}
__device__ __forceinline__ void lru_carry(Frame& F, int idx) {
    const int ch = idx & 511, dir = (idx >> 9) & 1, b = idx >> 10;
    const float* CA = (const float*)(F.ws + WS_LCA); const float* CH = (const float*)(F.ws + WS_LCH); float* CI = (float*)(F.ws + WS_LCI);
    float h = 0.f;
#pragma unroll 4
    for (int n = 0; n < 68; ++n) { const int ct = n < 4 ? 256 + b * 4 + (dir ? 3 - n : n) : b * 64 + (dir ? 63 - (n - 4) : (n - 4)); const size_t o = ((size_t)dir * NCT + ct) * 512 + ch;
        CI[o] = h; h = CA[o] * h + CH[o]; }
}
__device__ __forceinline__ void lru_fin(Frame& F, int l) {
    const int nrows = (l == 0) ? NTOK : NLAT;
    const bf16* P = (const bf16*)(F.ws + WS_P); bf16* CC = (bf16*)(F.ws + WS_CC);
    const bf16* HL = (const bf16*)(F.ws + WS_LRH); const bf16* AC = (const bf16*)(F.ws + WS_LRA); const float* CI = (const float*)(F.ws + WS_LCI);
    for (size_t i = (size_t)F.bid * NTHREADS + F.tid; i < (size_t)nrows * 128; i += (size_t)F.G * NTHREADS) { const int m = (int)(i >> 7), c4 = (int)(i & 127) * 4, ct = m >> 6;
        const v2u hw0 = *(const v2u*)(HL + (size_t)m * 512 + c4), aw0 = *(const v2u*)(AC + (size_t)m * 512 + c4), hw1 = *(const v2u*)(HL + ((size_t)NTOK + m) * 512 + c4), aw1 = *(const v2u*)(AC + ((size_t)NTOK + m) * 512 + c4);
        const f32x4 h0 = {bflo(hw0.x), bfhi(hw0.x), bflo(hw0.y), bfhi(hw0.y)}, a0 = {bflo(aw0.x), bfhi(aw0.x), bflo(aw0.y), bfhi(aw0.y)}, h1 = {bflo(hw1.x), bfhi(hw1.x), bflo(hw1.y), bfhi(hw1.y)}, a1 = {bflo(aw1.x), bfhi(aw1.x), bflo(aw1.y), bfhi(aw1.y)};
        const f32x4 i0 = *(const f32x4*)(CI + (size_t)ct * 512 + c4), i1 = *(const f32x4*)(CI + ((size_t)NCT + ct) * 512 + c4);
        const f32x4 hs = (a0 * i0 + h0) + (a1 * i1 + h1); const v2u yw = *(const v2u*)(P + (size_t)m * PW + PC_LY + c4);
        v2u o; o.x = pk2(hs.x * gelu_tanh(bflo(yw.x)), hs.y * gelu_tanh(bfhi(yw.x))); o.y = pk2(hs.z * gelu_tanh(bflo(yw.y)), hs.w * gelu_tanh(bfhi(yw.y)));
        *(v2u*)(CC + (size_t)m * DM + 1536 + c4) = o; }
}

constexpr size_t WS_DNQ = WS_DNT;
constexpr size_t WS_BG = WS_DNS + 1 * MiB;
constexpr size_t WS_XC = WS_XS;

__device__ __forceinline__ void naive_prep(Frame& F, int l) {
    const bf16* P = (const bf16*)(F.ws + WS_P);
    const int gw = F.bid * NWAVES + F.wave, NGW = F.G * NWAVES;
#if !defined(USE_CHUNK_DN)
    {
        float* DNQ = (float*)(F.ws + WS_DNQ); float* BG = (float*)(F.ws + WS_BG);
        const float* cw = F.in[I_DNCW] + (size_t)l * 4 * 1536;
        for (int it = gw; it < NTOK * 4; it += NGW) {
            const int m = it >> 2, h = it & 3; int t, T, base; seq_of(m, t, T, base);
            float val[3][2];
#pragma unroll
            for (int part = 0; part < 3; ++part)
#pragma unroll
                for (int dd = 0; dd < 2; ++dd) { const int d = F.lane + 64 * dd, cch = part * 512 + h * 128 + d, col = PC_DQ + cch; float s = 0.f;
#pragma unroll
                    for (int j = 0; j < 4; ++j) { const int tt = t + j - 2; if (tt >= 0 && tt < T) s += cw[j * 1536 + cch] * bf2f(P[(size_t)(base + tt) * PW + col]); }
                    val[part][dd] = siluf_(s); }
            const float sq = wave_sum(val[0][0] * val[0][0] + val[0][1] * val[0][1]), sk = wave_sum(val[1][0] * val[1][0] + val[1][1] * val[1][1]);
            const float fq = 0.08838834764831845f / sqrtf(sq + EPS), fk = 1.0f / sqrtf(sk + EPS);
#pragma unroll
            for (int dd = 0; dd < 2; ++dd) { const int d = F.lane + 64 * dd; float* o = DNQ + (size_t)m * 1536 + h * 128 + d;
                o[0] = val[0][dd] * fq; o[512] = val[1][dd] * fk; o[1024] = val[2][dd]; }
            if (h == 0 && F.lane < 8) { const int dir = F.lane >> 2, hh = F.lane & 3;
                const float pb = bf2f(P[(size_t)m * PW + PC_BETA + F.lane]), pa = bf2f(P[(size_t)m * PW + PC_DEC + F.lane]);
                BG[m * 16 + F.lane] = sigmoidf_(pb);
                BG[m * 16 + 8 + F.lane] = -__expf(F.in[I_DNALOG][l * 8 + dir * 4 + hh]) * softplusf_(pa + F.in[I_DNDT][l * 8 + dir * 4 + hh]); }
        }
    }
#endif
#if !defined(USE_CHUNK_LRU)
    {
        LAS float* xc = (LAS float*)F.lds;
        float* A = (float*)(F.ws + WS_LRA); float* U = (float*)(F.ws + WS_LRH);
        const float* cw = F.in[I_LRCW] + (size_t)l * 4 * 512; const float* cb = F.in[I_LRCB] + l * 512;
        for (int m0 = F.bid * 8; m0 < NTOK; m0 += F.G * 8) {
            __syncthreads();
            for (int i = F.tid; i < 8 * 512; i += NTHREADS) { const int m = m0 + (i >> 9), ch = i & 511; int t, T, base; seq_of(m, t, T, base); float s = cb[ch];
#pragma unroll
                for (int j = 0; j < 4; ++j) { const int tt = t + j - 2; if (tt >= 0 && tt < T) s += cw[j * 512 + ch] * bf2f(P[(size_t)(base + tt) * PW + PC_LX + ch]); }
                xc[i] = s; }
            __syncthreads();
            for (int i = F.tid; i < 8 * 512 * 2; i += NTHREADS) { const int ch = i & 511, dir = (i >> 9) & 1, tk = i >> 10, m = m0 + tk, blk = ch >> 6, j = ch & 63;
                const float* wr = F.in[I_LRWR] + ((size_t)((l * 2 + dir) * 8 + blk)) * 4096 + j; const float* wi = F.in[I_LRWI] + ((size_t)((l * 2 + dir) * 8 + blk)) * 4096 + j;
                float sr = F.in[I_LRBR][(l * 2 + dir) * 512 + ch], si = F.in[I_LRBI][(l * 2 + dir) * 512 + ch];
#pragma unroll 8
                for (int ii = 0; ii < 64; ++ii) { const float x = xc[tk * 512 + blk * 64 + ii]; sr += x * wr[ii * 64]; si += x * wi[ii * 64]; }
                const float r = sigmoidf_(sr), ig = sigmoidf_(si); const float lam = F.in[I_LRLAM][(l * 2 + dir) * 512 + ch];
                const float logsig = -softplusf_(-lam);
                const float log_a = 8.0f * r * logsig; const float a = __expf(log_a);
                const float u = sqrtf(-expm1f(2.0f * log_a)) * (ig * xc[tk * 512 + ch]);
                A[((size_t)dir * NTOK + m) * 512 + ch] = a; U[((size_t)dir * NTOK + m) * 512 + ch] = u; }
        }
        __syncthreads();
    }
#endif
}

__device__ __forceinline__ void naive_attn_row(Frame& F, int l, int m, int hq) {
    const bf16* P = (const bf16*)(F.ws + WS_P); bf16* CC = (bf16*)(F.ws + WS_CC);
    const int d = F.lane, kvh = hq >> 2; int t, T, base; seq_of(m, t, T, base);
    const bool lat = m < NLAT; const int b = lat ? (m >> 12) : ((m - NLAT) >> 8);
    const int dd = d & 31, jf = dd & 15; const float inv = __powf(10000.0f, -(float)jf * (1.0f / 16.0f));
    const bool second = (dd >= 16), colhalf = (d >= 32);
    float q = bf2f(P[(size_t)m * PW + PC_Q + hq * 64 + d]);
    if (lat) { const float pos = (float)(colhalf ? (t & 63) : (t >> 6)); float sn, cs; sincosf(pos * inv, &sn, &cs); const float pr = __shfl_xor(q, 16); q = second ? (q * cs + pr * sn) : (q * cs - pr * sn); }
    q *= 0.125f;
    float mx = F.in[I_SINK][l * 16 + hq], den = 1.0f, acc = 0.f;
    if (lat) { const int t0 = t - 128 < 0 ? 0 : t - 128, t1 = t + 128 > SEQ - 1 ? SEQ - 1 : t + 128;
        for (int tk = t0; tk <= t1; ++tk) { const size_t r = (size_t)(base + tk) * PW; float k = bf2f(P[r + PC_K + kvh * 64 + d]); const float v = bf2f(P[r + PC_V + kvh * 64 + d]);
            const float pos = (float)(colhalf ? (tk & 63) : (tk >> 6)); float sn, cs; sincosf(pos * inv, &sn, &cs); const float pr = __shfl_xor(k, 16); k = second ? (k * cs + pr * sn) : (k * cs - pr * sn);
            const float s = wave_sum(q * k); const float mn = fmaxf(mx, s), f = __expf(mx - mn), p = __expf(s - mn); den = den * f + p; acc = acc * f + p * v; mx = mn; } }
    for (int c = 0; c < CTXL; ++c) { const size_t r = (size_t)(NLAT + b * CTXL + c) * PW; const float k = bf2f(P[r + PC_K + kvh * 64 + d]), v = bf2f(P[r + PC_V + kvh * 64 + d]);
        const float s = wave_sum(q * k); const float mn = fmaxf(mx, s), f = __expf(mx - mn), p = __expf(s - mn); den = den * f + p; acc = acc * f + p * v; mx = mn; }
    CC[(size_t)m * DM + hq * 64 + d] = (bf16)f2bf(acc / den);
}

__device__ __forceinline__ int scan_row(int n, int b, int dir) { if (n < CTXL) { const int t = dir ? (CTXL - 1 - n) : n; return NLAT + b * CTXL + t; } const int t = dir ? (SEQ - 1 - (n - CTXL)) : (n - CTXL); return b * SEQ + t; }
__device__ __forceinline__ void naive_scan(Frame& F, int l, int rep = 0) {
#if defined(USE_CHUNK_DN)
    if (F.bid < 32 * DN_SPLIT) { if (DN_SPLIT == 2) dn_scan(F, l, F.bid >> 4, (F.bid >> 2) & 3, (F.bid >> 1) & 1, F.bid & 1); else dn_scan(F, l, F.bid >> 3, (F.bid >> 1) & 3, F.bid & 1, 0); }
#else
    if (F.bid < 32) {
        const int b = F.bid >> 3, h = (F.bid >> 1) & 3, dir = F.bid & 1, dvc = F.tid & 127, kq = F.tid >> 7;
        const float* DNQ = (const float*)(F.ws + WS_DNQ); const float* BG = (const float*)(F.ws + WS_BG); float* O = (float*)(F.ws + WS_DNO);
        LAS float* buf = (LAS float*)F.lds;
        LAS float* red = buf + 768;
        LAS float* red2 = red + 512;
        float S[32];
#pragma unroll
        for (int i = 0; i < 32; ++i) S[i] = 0.f;
        constexpr int NT = CTXL + SEQ;
        { const int m = scan_row(0, b, dir); if (F.tid < 384) buf[F.tid] = DNQ[(size_t)m * 1536 + (F.tid >> 7) * 512 + h * 128 + (F.tid & 127)]; }
        __syncthreads();
#pragma unroll 1
        for (int n = 0; n < NT; ++n) {
            const int m = scan_row(n, b, dir); const LAS float* cur = buf + (n & 1) * 384;
            float nextv = 0.f; if (n + 1 < NT && F.tid < 384) { const int m2 = scan_row(n + 1, b, dir); nextv = DNQ[(size_t)m2 * 1536 + (F.tid >> 7) * 512 + h * 128 + (F.tid & 127)]; }
            const float beta = BG[m * 16 + dir * 4 + h], decay = __expf(BG[m * 16 + 8 + dir * 4 + h]);
            float ks = 0.f;
#pragma unroll
            for (int i = 0; i < 32; ++i) ks += cur[128 + kq * 32 + i] * S[i];
            red[kq * 128 + dvc] = ks;
            __syncthreads();
            const float kS = (red[dvc] + red[128 + dvc]) + (red[256 + dvc] + red[384 + dvc]);
            const float upd = beta * (cur[256 + dvc] - decay * kS);
            float os = 0.f;
#pragma unroll
            for (int i = 0; i < 32; ++i) { S[i] = decay * S[i] + cur[128 + kq * 32 + i] * upd; os += cur[kq * 32 + i] * S[i]; }
            red2[kq * 128 + dvc] = os;
            if (F.tid < 384) buf[((n + 1) & 1) * 384 + F.tid] = nextv;
            __syncthreads();
            if (kq == 0) O[((size_t)dir * NTOK + m) * 512 + h * 128 + dvc] = (red2[dvc] + red2[128 + dvc]) + (red2[256 + dvc] + red2[384 + dvc]);
        }
    }
#endif
#if defined(USE_CHUNK_LRU)
    else if (F.bid < 32 * DN_SPLIT + 8) { lru_carry(F, (F.bid - 32 * DN_SPLIT) * NTHREADS + F.tid); }
#else
    else if (F.bid < 40) {
        const int idx = (F.bid - 32) * NTHREADS + F.tid, ch = idx & 511, dir = (idx >> 9) & 1, b = idx >> 10;
        const float* A = (const float*)(F.ws + WS_LRA); float* U = (float*)(F.ws + WS_LRH);
        float hs = 0.f;
#pragma unroll 4
        for (int n = 0; n < CTXL + SEQ; ++n) { int m; if (n < CTXL) { const int t = dir ? (CTXL - 1 - n) : n; m = NLAT + b * CTXL + t; } else { const int t = dir ? (SEQ - 1 - (n - CTXL)) : (n - CTXL); m = b * SEQ + t; }
            const size_t o = ((size_t)dir * NTOK + m) * 512 + ch; hs = A[o] * hs + U[o]; U[o] = hs; }
    }
#endif
#if defined(USE_MFMA_ATTN)
    attn_phase(F, l, rep);
    convert_moe_queue(F, l, rep);
#else
    {
        const int nrows = (l == 0) ? NTOK : NLAT;
        for (;;) { int m = 0; if (F.lane == 0) m = (int)__hip_atomic_fetch_add(F.ctl + CW_ATQ + 64 * l, 1u, RLX_AGENT); m = __builtin_amdgcn_readfirstlane(m);
            if (m >= nrows) break;
#pragma unroll 1
            for (int hq = 0; hq < 16; ++hq) naive_attn_row(F, l, m, hq); }
    }
#endif
}

__device__ __forceinline__ void naive_fin(Frame& F, int l) {
    const int nrows = (l == 0) ? NTOK : NLAT;
    const bf16* P = (const bf16*)(F.ws + WS_P); bf16* CC = (bf16*)(F.ws + WS_CC);
    const int gw = F.bid * NWAVES + F.wave, NGW = F.G * NWAVES;
    const float* O = (const float*)(F.ws + WS_DNO); const float* HS = (const float*)(F.ws + WS_LRH);
    for (int it0 = gw * 2; it0 < nrows * 4; it0 += NGW * 2) {
        float2 oa[2], ob[2]; unsigned gw_[2];
#pragma unroll
        for (int k = 0; k < 2; ++k) { const int it = it0 + k, m = it >> 2, h = it & 3; const int c = h * 128 + 2 * F.lane;
            oa[k] = *(const float2*)(O + (size_t)m * 512 + c); ob[k] = *(const float2*)(O + ((size_t)NTOK + m) * 512 + c); gw_[k] = *(const unsigned*)(P + (size_t)m * PW + PC_DG + c); }
        const float2 ng = *(const float2*)(F.in[I_DNNG] + l * 128 + 2 * F.lane);
#pragma unroll
        for (int k = 0; k < 2; ++k) { const int it = it0 + k, m = it >> 2, h = it & 3; const float o0 = oa[k].x + ob[k].x, o1 = oa[k].y + ob[k].y;
            const float rstd = 1.0f / sqrtf(wave_sum(o0 * o0 + o1 * o1) * (1.0f / 128.0f) + EPS);
            *(unsigned*)(CC + (size_t)m * DM + 1024 + h * 128 + 2 * F.lane) = pk2(o0 * rstd * ng.x * siluf_(bflo(gw_[k])), o1 * rstd * ng.y * siluf_(bfhi(gw_[k]))); }
    }
#if defined(USE_CHUNK_LRU)
    lru_fin(F, l);
#else
    for (size_t i = (size_t)F.bid * NTHREADS + F.tid; i < (size_t)nrows * 512; i += (size_t)F.G * NTHREADS) { const int m = (int)(i >> 9), ch = (int)(i & 511);
        const float hsum = HS[(size_t)m * 512 + ch] + HS[((size_t)NTOK + m) * 512 + ch]; const float y = bf2f(P[(size_t)m * PW + PC_LY + ch]);
        CC[(size_t)m * DM + 1536 + ch] = (bf16)f2bf(hsum * gelu_tanh(y)); }
#endif
}
#ifndef PHASE_PREP
#if defined(USE_MFMA_ATTN)
#if defined(USE_CHUNK_DN)
#define PHASE_PREP(F, l) do { attn_prep(F, l); lru_prep(F, l); dn_prep(F, l); } while (0)
#else
#define PHASE_PREP(F, l) do { naive_prep(F, l); attn_prep(F, l); } while (0)
#endif
#else
#define PHASE_PREP(F, l) naive_prep(F, l)
#endif
#endif
#ifndef PHASE_SCAN
#define PHASE_SCAN(F, l) naive_scan(F, l)
#endif
#ifndef PHASE_FIN
#define PHASE_FIN(F, l) naive_fin(F, l)
#endif

#ifndef PHASE_INPROJ
#define PHASE_INPROJ(F, l) do {} while (0)
#endif
#ifndef PHASE_PREP
#define PHASE_PREP(F, l) do {} while (0)
#endif
#ifndef PHASE_SCAN
#define PHASE_SCAN(F, l) do {} while (0)
#endif
#ifndef PHASE_FIN
#define PHASE_FIN(F, l) do {} while (0)
#endif
#ifndef PHASE_OUTPROJ
#define PHASE_OUTPROJ(F, l) do {} while (0)
#endif
#ifndef PHASE_NORM2
#define PHASE_NORM2(F, l) do {} while (0)
#endif
#ifndef PHASE_SCATTER
#define PHASE_SCATTER(F, l) do {} while (0)
#endif
#ifndef PHASE_GEMM1
#define PHASE_GEMM1(F, l) do {} while (0)
#endif
#ifndef PHASE_GEMM2
#define PHASE_GEMM2(F, l) do {} while (0)
#endif

#ifndef MK_SPLIT
#define MK_SPLIT 0
#endif
#ifndef MK_STAGE
#define MK_STAGE 99
#endif
#ifndef MK_TAILFILL
#define MK_TAILFILL 0
#endif
#ifndef MK_DUP
#define MK_DUP 0
#endif
#define DUP(k) ((MK_DUP >> (k)) & 1)
constexpr int N_PHASES = 22;
struct Args { const float* in[N_IN]; float* out; unsigned char* ws; int ph_lo, ph_hi; };
static_assert(sizeof(Args) == (N_IN + 2) * 8 + 8, "Args has no padding");

__global__ void __launch_bounds__(NTHREADS, 2) fwd_kernel(Args args) {
    extern __shared__ __attribute__((aligned(16))) unsigned char lds[];
    Frame F;
    F.lds = (LAS unsigned char*)lds;
    F.MISC = (volatile LAS unsigned*)(F.lds + MISC_OFF);
    F.tid = threadIdx.x; F.lane = F.tid & 63; F.wave = __builtin_amdgcn_readfirstlane(F.tid >> 6);
    F.G = gridDim.x; F.bid = blockIdx.x;
    F.ws = args.ws; F.out = args.out; F.ctl = (gu32*)(args.ws + WS_CTL);
    F.in = (const float* const __attribute__((address_space(4)))*)__builtin_amdgcn_kernarg_segment_ptr();
    for (int u = F.tid; u < (LDS_BYTES - LDSCTL_OFF) / 4; u += NTHREADS) ((LAS unsigned*)(F.lds + LDSCTL_OFF))[u] = 0u;
    __syncthreads();
    XcdBarrier bar; bar.bar = (unsigned*)(F.ctl + CW_BAR); bar.x = 0; bar.st = nullptr;
    if (!MK_SPLIT) bar = xcd_barrier_post((unsigned*)(F.ctl + CW_BAR), F.MISC + 8);
    const int lo = args.ph_lo, hi = args.ph_hi;
#define IN(k) (lo <= (k) && (k) < hi && phase_enter(F))
#define INR(k) (lo <= (k) && (k) < hi)
#define SEAM(k) do { if (INR(k) && INR((k) + 1)) { if (MK_TAILFILL && (k) < 14) tail_fill(F, (k), (k) < 4 ? 0 : 1); xcd_barrier(bar); } } while (0)

    if (IN(0)) { p0_prologue(F); if (DUP(0)) { __syncthreads(); p0_prologue(F); } } SEAM(0);
#pragma unroll 1
    for (int l = 0; l < DEPTH; ++l) {
        const int pb = 1 + 10 * l;
        if (IN(pb + 0)) { phase_norm1(F, l); if (DUP(13) && l == 0) { __syncthreads(); phase_norm1(F, l); } } SEAM(pb + 0);
        if (IN(pb + 1)) { PHASE_INPROJ(F, l); if (DUP(1)) { __syncthreads(); PHASE_INPROJ(F, l); } } SEAM(pb + 1);
        if (IN(pb + 2)) { PHASE_PREP(F, l); if (DUP(2)) { __syncthreads(); dn_prep(F, l); } if (DUP(6)) { __syncthreads(); lru_prep(F, l); } } SEAM(pb + 2);
        if (IN(pb + 3)) { if (DUP(3) && F.bid < 64) dn_scan(F, l, F.bid >> 4, (F.bid >> 2) & 3, (F.bid >> 1) & 1, F.bid & 1); PHASE_SCAN(F, l); if (DUP(10)) { __syncthreads(); naive_scan(F, l, 1); } if (DUP(11)) { __syncthreads(); attn_phase(F, l, 2); } if (DUP(12)) { __syncthreads(); convert_moe_queue(F, l, 3); } } SEAM(pb + 3);
        if (IN(pb + 4)) { PHASE_FIN(F, l); if (DUP(4)) { __syncthreads(); PHASE_FIN(F, l); } } SEAM(pb + 4);
        if (IN(pb + 5)) { PHASE_OUTPROJ(F, l); if (DUP(5) && l == 0) { __syncthreads(); PHASE_OUTPROJ(F, l); } } SEAM(pb + 5);
        if (IN(pb + 6)) { PHASE_NORM2(F, l); } SEAM(pb + 6);
        if (IN(pb + 7)) { PHASE_SCATTER(F, l); if (DUP(7)) { __syncthreads(); PHASE_SCATTER(F, l); } } SEAM(pb + 7);
        if (IN(pb + 8)) { PHASE_GEMM1(F, l); if (DUP(8)) { __syncthreads(); PHASE_GEMM1(F, l); } } SEAM(pb + 8);
        if (IN(pb + 9)) { PHASE_GEMM2(F, l); if (DUP(9)) { __syncthreads(); PHASE_GEMM2(F, l); } } SEAM(pb + 9);
    }
    if (IN(21)) { phase_final(F, MK_STAGE >= 9); if (DUP(13)) { __syncthreads(); phase_final(F, MK_STAGE >= 9); } }
#undef IN
#undef SEAM
}

extern "C" void kernel_launch(void* const* d_in, const int* in_sizes, int n_in, void* d_out, int out_size, void* d_ws, size_t ws_size, hipStream_t stream) {
    static int grid = 0;
    if (grid == 0) {
        if (n_in != N_IN || out_size != NLAT * DM || ws_size < WS_END) { fprintf(stderr, "kernel_launch: unexpected shapes (n_in %d, out %d, ws %zu); nothing launched\n", n_in, out_size, ws_size); grid = -1; return; }
        int dev = 0, cus = 0, per_cu = 0;
        if (hipGetDevice(&dev) != hipSuccess || hipDeviceGetAttribute(&cus, hipDeviceAttributeMultiprocessorCount, dev) != hipSuccess) { grid = -1; return; }
        if (hipFuncSetAttribute((const void*)fwd_kernel, hipFuncAttributeMaxDynamicSharedMemorySize, LDS_BYTES) != hipSuccess) { fprintf(stderr, "kernel_launch: hipFuncSetAttribute failed\n"); grid = -1; return; }
        if (hipOccupancyMaxActiveBlocksPerMultiprocessor(&per_cu, (const void*)fwd_kernel, NTHREADS, LDS_BYTES) != hipSuccess || per_cu < 1) { fprintf(stderr, "kernel_launch: occupancy query says %d\n", per_cu); }
        (void)hipGetLastError();
        grid = cus;
        if (grid != 256) { fprintf(stderr, "kernel_launch: built for 256 CUs, device has %d; nothing launched\n", cus); grid = -1; return; }
    }
    if (grid < 0) return;
    if (hipMemsetAsync((char*)d_ws + WS_CTL, 0, CTL_ZERO_BYTES, stream) != hipSuccess) return;
    Args a{};
    for (int i = 0; i < N_IN; ++i) a.in[i] = (const float*)d_in[i];
    a.out = (float*)d_out; a.ws = (unsigned char*)d_ws;
#if MK_SPLIT
    for (int p = 0; p < N_PHASES; ++p) { a.ph_lo = p; a.ph_hi = p + 1; hipLaunchKernelGGL(fwd_kernel, dim3(grid), dim3(NTHREADS), LDS_BYTES, stream, a); }
#else
    a.ph_lo = 0; a.ph_hi = N_PHASES;
    hipLaunchKernelGGL(fwd_kernel, dim3(grid), dim3(NTHREADS), LDS_BYTES, stream, a);
#endif
    const hipError_t le = hipPeekAtLastError();
    if (le != hipSuccess) fprintf(stderr, "kernel_launch: launch failed: %s\n", hipGetErrorName(le));
}
```

```cpp
#include <hip/hip_runtime.h>
#include <cstdio>
#include <cstdint>

constexpr int DM = 2048, NB = 4, SEQ = 4096, CTXL = 256, DEPTH = 2;
constexpr int NLAT = NB * SEQ, NCTX = NB * CTXL, NTOK = NLAT + NCTX;
constexpr int NCT = NTOK / 64;
constexpr int IN_W = 4624, PW = 4864;
constexpr int PC_Q = 0, PC_K = 1024, PC_V = 1280, PC_DQ = 1536, PC_DK = 2048, PC_DV = 2560, PC_DG = 3072, PC_LX = 3584, PC_LY = 4096, PC_BETA = 4608, PC_DEC = 4616;
constexpr int NEXP = 32, TOPK = 4, DEXP = 1024;
constexpr int MOE_ROWS = 304 * 256;
constexpr float EPS = 1e-6f;
#ifndef MK_STAGE
#define MK_STAGE 99
#endif
namespace pg8 {
#define PG8_LAS __attribute__((address_space(3)))
typedef unsigned short bf16_t;
typedef short bf16x8 __attribute__((ext_vector_type(8)));
typedef float f32x4 __attribute__((ext_vector_type(4)));
typedef unsigned u32x4 __attribute__((ext_vector_type(4)));
typedef float f32x2 __attribute__((ext_vector_type(2)));
constexpr int BM = 256, BK = 64, HALF = 128, HTB = HALF * BK * 2  , STAGE_BYTES = 8 * HTB, NXCD = 8, WGM = 8;

__host__ __device__ __forceinline__ int lds_byte(int r, int c) { const int st = (r >> 4) * 2 + (c >> 5), rr = r & 15, cc = c & 31, ob = rr * 64 + cc * 2; return st * 1024 + (ob ^ (((ob >> 9) & 1) << 5)); }
__host__ __device__ __forceinline__ void stage_rc(int b, int& R, int& C) { const int st = b / 1024, sb = b % 1024, swz = sb ^ (((sb >> 9) & 1) << 5); R = (st >> 1) * 16 + swz / 64; C = (st & 1) * 32 + (swz % 64) / 2; }
__host__ __device__ __forceinline__ int perm32(int rho) { const int n = rho >> 4, i = rho & 15; return 8 * (i >> 2) + 4 * n + (i & 3); }

struct Unit { int pm, pn, e; };
typedef int v4i_t __attribute__((ext_vector_type(4)));
typedef int v8i_t __attribute__((ext_vector_type(8)));
struct Gemm { const bf16_t* A; const bf16_t* Bt; int M, N, K; int bscale = 0x7F7F7F7F; };

struct StaticOrder {
    static constexpr bool GATHER = false; const int* row_tab = nullptr;
    int nM, nN, nwg, G, c; const char* A; const char* Bt; size_t tstep;
    __device__ void init(const Gemm& g, int G_, int c_) { nM = g.M / BM; nN = g.N / BM; nwg = nM * nN; G = G_; c = c_; A = (const char*)g.A; Bt = (const char*)g.Bt; tstep = (size_t)BM * g.K * 2; }
    __device__ bool next(int i, Unit& u) const {
        const long L = (long)i * G + c; if (L >= nwg) return false;
        int wgid = (int)L; { const int q = nwg / NXCD, r = nwg % NXCD, xcd = wgid % NXCD, off = wgid / NXCD; wgid = (xcd < r ? xcd * (q + 1) : r * (q + 1) + (xcd - r) * q) + off; }
        const int nig = WGM * nN, gid = wgid / nig, fm = gid * WGM, gsz = (nM - fm) < WGM ? (nM - fm) : WGM;
        u.pm = fm + ((wgid % nig) % gsz); u.pn = (wgid % nig) / gsz; u.e = 0; return true;
    }
    __device__ __forceinline__ const char* a_ptr(const Unit& u) const { return A + (size_t)u.pm * tstep; }
    __device__ __forceinline__ const char* b_ptr(const Unit& u) const { return Bt + (size_t)u.pn * tstep; }
    __device__ __forceinline__ void a_ready(const Unit&) const {}
    __device__ __forceinline__ void done(const Unit&) const {}
};
__device__ __forceinline__ unsigned cvt_pk_bf16(float lo, float hi) { unsigned r; asm volatile("v_cvt_pk_bf16_f32 %0, %1, %2" : "=v"(r) : "v"(lo), "v"(hi)); return r; }
struct EpiBf16Plain {
    static constexpr bool PERM = true, AFTER_DRAIN = false;
    bf16_t* O; int ldc;
    __device__ __forceinline__ void operator()(const f32x4 (&acc)[2][2][4][2], const Unit& u, int wr, int wc, int fr, int fq) const {
        const int row0 = u.pm * BM + wr * 64 + fr, col0 = u.pn * BM + wc * 32 + 8 * fq;
#pragma unroll
        for (int ai = 0; ai < 2; ++ai)
#pragma unroll
            for (int m = 0; m < 4; ++m) { bf16_t* rowp = O + (size_t)(row0 + ai * HALF + m * 16) * ldc + col0;
#pragma unroll
                for (int bj = 0; bj < 2; ++bj) { const f32x4 v0 = acc[ai][bj][m][0], v1 = acc[ai][bj][m][1];
                    u32x4 w; w.x = cvt_pk_bf16(v0[0], v0[1]); w.y = cvt_pk_bf16(v0[2], v0[3]); w.z = cvt_pk_bf16(v1[0], v1[1]); w.w = cvt_pk_bf16(v1[2], v1[3]);
                    *(u32x4*)(rowp + bj * HALF) = w; } }
    }
};
struct EpiResGate {
    static constexpr bool PERM = false, AFTER_DRAIN = false;
    const float* base_lat; const float* base_ctx; float* out; const float* modg;
    __device__ __forceinline__ void operator()(const f32x4 (&acc)[2][2][4][2], const Unit& u, int wr, int wc, int fr, int fq) const {
        const int r = u.pm < 64 ? (u.pm >> 4) : 4; const int col0 = u.pn * BM + wc * 32 + 4 * fq;
        const float* g = modg + (size_t)r * 12288 + col0;
        f32x4 gv[2][2];
#pragma unroll
        for (int bj = 0; bj < 2; ++bj)
#pragma unroll
            for (int n = 0; n < 2; ++n) gv[bj][n] = *(const f32x4*)(g + bj * HALF + n * 16);
#pragma unroll
        for (int ai = 0; ai < 2; ++ai)
#pragma unroll
            for (int m = 0; m < 4; ++m) { const int row = u.pm * BM + ai * HALF + wr * 64 + m * 16 + fr;
                const float* bp = (row < 16384 ? base_lat + (size_t)row * 2048 : base_ctx + (size_t)(row - 16384) * 2048) + col0; float* op = out + (size_t)row * 2048 + col0;
#pragma unroll
                for (int bj = 0; bj < 2; ++bj)
#pragma unroll
                    for (int n = 0; n < 2; ++n) { const f32x4 b = *(const f32x4*)(bp + bj * HALF + n * 16); *(f32x4*)(op + bj * HALF + n * 16) = b + gv[bj][n] * acc[ai][bj][m][n]; }
                asm volatile("" ::: "memory"); }
    }
};
struct EpiSwiglu {
    static constexpr bool PERM = true, AFTER_DRAIN = false;
    bf16_t* O; const float* bgu;
    __device__ __forceinline__ void operator()(const f32x4 (&acc)[2][2][4][2], const Unit& u, int wr, int wc, int fr, int fq) const {
        const int row0 = u.pm * BM + wr * 64 + fr, cc0 = wc * 32 + 8 * fq;
        const float* bg = bgu + (size_t)u.e * 2048 + u.pn * 128 + cc0;
        f32x4 bglu[2], blin[2];
#pragma unroll
        for (int n = 0; n < 2; ++n) { bglu[n] = *(const f32x4*)(bg + 4 * n); blin[n] = *(const f32x4*)(bg + 1024 + 4 * n); }
#pragma unroll
        for (int ai = 0; ai < 2; ++ai)
#pragma unroll
            for (int m = 0; m < 4; ++m) { bf16_t* rowp = O + (size_t)(row0 + ai * HALF + m * 16) * 1024 + u.pn * 128 + cc0;
                float r[8];
#pragma unroll
                for (int n = 0; n < 2; ++n) { const f32x4 g = acc[ai][0][m][n] + bglu[n], l = acc[ai][1][m][n] + blin[n];
#pragma unroll
                    for (int i = 0; i < 4; ++i) { const float gg = fminf(g[i], 7.0f); const float ll = fminf(fmaxf(l[i], -7.0f), 7.0f);
                        r[4 * n + i] = (ll + 1.0f) * gg * __builtin_amdgcn_rcpf(1.0f + __builtin_amdgcn_exp2f(-1.702f * 1.4426950408889634f * gg)); } }
                u32x4 w; w.x = cvt_pk_bf16(r[0], r[1]); w.y = cvt_pk_bf16(r[2], r[3]); w.z = cvt_pk_bf16(r[4], r[5]); w.w = cvt_pk_bf16(r[6], r[7]);
                *(u32x4*)rowp = w; }
    }
};
struct EpiSwiglu8 {
    static constexpr bool PERM = true, AFTER_DRAIN = false;
    unsigned char* O; const float* bgu;
    __device__ __forceinline__ void operator()(const f32x4 (&acc)[2][2][4][2], const Unit& u, int wr, int wc, int fr, int fq) const {
        const int row0 = u.pm * BM + wr * 64 + fr, cc0 = wc * 32 + 8 * fq;
        const float* bg = bgu + (size_t)u.e * 2048 + u.pn * 128 + cc0;
        f32x4 bglu[2], blin[2];
#pragma unroll
        for (int n = 0; n < 2; ++n) { bglu[n] = *(const f32x4*)(bg + 4 * n); blin[n] = *(const f32x4*)(bg + 1024 + 4 * n); }
#pragma unroll
        for (int ai = 0; ai < 2; ++ai)
#pragma unroll
            for (int m = 0; m < 4; ++m) { unsigned char* rowp = O + (size_t)(row0 + ai * HALF + m * 16) * 1024 + u.pn * 128 + cc0;
                float r[8];
#pragma unroll
                for (int n = 0; n < 2; ++n) { const f32x4 g = acc[ai][0][m][n] + bglu[n], l = acc[ai][1][m][n] + blin[n];
#pragma unroll
                    for (int i = 0; i < 4; ++i) { const float gg = fminf(g[i], 7.0f); const float ll = fminf(fmaxf(l[i], -7.0f), 7.0f);
                        r[4 * n + i] = (ll + 1.0f) * gg * __builtin_amdgcn_rcpf(1.0f + __builtin_amdgcn_exp2f(-1.702f * 1.4426950408889634f * gg)); } }
                int w0 = 0, w1 = 0; w0 = __builtin_amdgcn_cvt_pk_fp8_f32(r[0], r[1], w0, false); w0 = __builtin_amdgcn_cvt_pk_fp8_f32(r[2], r[3], w0, true); w1 = __builtin_amdgcn_cvt_pk_fp8_f32(r[4], r[5], w1, false); w1 = __builtin_amdgcn_cvt_pk_fp8_f32(r[6], r[7], w1, true);
                typedef unsigned u32x2 __attribute__((ext_vector_type(2))); *(u32x2*)rowp = (u32x2){(unsigned)w0, (unsigned)w1}; }
    }
};
struct EpiDown {
    static constexpr bool PERM = true, AFTER_DRAIN = false;
    bf16_t* O; const float* bdn; const float* rowg;
    __device__ __forceinline__ void operator()(const f32x4 (&acc)[2][2][4][2], const Unit& u, int wr, int wc, int fr, int fq) const {
        const int row0 = u.pm * BM + wr * 64 + fr, col0 = u.pn * BM + wc * 32 + 8 * fq;
        const float* bb = bdn + (size_t)u.e * 2048 + col0;
        float gt[2][4];
#pragma unroll
        for (int ai = 0; ai < 2; ++ai)
#pragma unroll
            for (int m = 0; m < 4; ++m) gt[ai][m] = rowg[row0 + ai * HALF + m * 16];
#pragma unroll
        for (int bj = 0; bj < 2; ++bj) { const f32x4 b0 = *(const f32x4*)(bb + bj * HALF), b1 = *(const f32x4*)(bb + bj * HALF + 4);
#pragma unroll
            for (int ai = 0; ai < 2; ++ai)
#pragma unroll
                for (int m = 0; m < 4; ++m) { const int row = row0 + ai * HALF + m * 16; const f32x4 v0 = (acc[ai][bj][m][0] + b0) * gt[ai][m], v1 = (acc[ai][bj][m][1] + b1) * gt[ai][m];
                    u32x4 w; w.x = cvt_pk_bf16(v0[0], v0[1]); w.y = cvt_pk_bf16(v0[2], v0[3]); w.z = cvt_pk_bf16(v1[0], v1[1]); w.w = cvt_pk_bf16(v1[2], v1[3]);
                    *(u32x4*)(O + (size_t)row * 2048 + col0 + bj * HALF) = w; } }
    }
};
template <bool GATHER_> struct MoeOrderT {
    static constexpr bool GATHER = GATHER_;
    int c, nblk; const char* A; const char* Bt; size_t a_tstep, b_estep, b_tstep; const PG8_LAS int* blk_end; const int* row_tab;
    __device__ __forceinline__ bool next(int i, Unit& u) const {
#if defined(MOE_MAP) && MOE_MAP == 1
        const int L = i * 256 + c, rb = L >> 3, j = (L & 7);
#elif defined(MOE_MAP) && MOE_MAP == 2
        const int x = c & 7, jj = c >> 3, gi = i * 8 + x, rb = 8 * (gi >> 1) + (jj >> 2), j = (jj & 3) + 4 * (gi & 1);
#else
        const int x = c & 7, j = c >> 3, gi = i * 8 + x, rb = 4 * gi + (j >> 3);
#endif
        if (rb >= nblk) return false;
        int e = 0;
        for (int k = 0; k < 31; ++k) e += (rb >= blk_end[k]) ? 1 : 0;
        u.pm = rb; u.pn = j & 7; u.e = __builtin_amdgcn_readfirstlane(e); return true;
    }
    __device__ __forceinline__ const char* a_ptr(const Unit& u) const { return GATHER ? A : A + (size_t)u.pm * a_tstep; }
    __device__ __forceinline__ const char* b_ptr(const Unit& u) const { return Bt + (size_t)u.e * b_estep + (size_t)u.pn * b_tstep; }
    __device__ __forceinline__ void a_ready(const Unit&) const {}
    __device__ __forceinline__ void done(const Unit&) const {}
};
typedef MoeOrderT<false> MoeOrder;
typedef MoeOrderT<true> MoeOrderG;
template <class Epi, class Sched, bool ALIGN_EPI = false, bool SP2 = false, bool FP8 = false>
__device__ __forceinline__ void gemm_phase(PG8_LAS unsigned char* lds, const Gemm g, const Sched& S, const Epi& E) {
    int tid = threadIdx.x; asm volatile("" : "+v"(tid));
    const int wid = __builtin_amdgcn_readfirstlane(tid >> 6), lane = tid & 63, wr = wid >> 2, wc = wid & 3, fr = lane & 15, fq = lane >> 4;
    const int K = g.K, nt = K / BK;
    unsigned voffA[2], voffB[2];
#pragma unroll
    for (int i = 0; i < 2; ++i) { int R, C; stage_rc(tid * 16 + i * 8192, R, C); const int Rb = Epi::PERM ? ((R & ~31) + perm32(R & 31)) : R;
        voffA[i] = (unsigned)(R * K + C) * 2u; voffB[i] = (unsigned)(Rb * K + C) * 2u; }
    unsigned gc0[2] = {0u, 0u}, gc1[2] = {0u, 0u}; int gR = 0, gC = 0;
    if constexpr (Sched::GATHER) { stage_rc(tid * 16, gR, gC); }
#define PG8_GLOAD(dst0, dst1, u) do { const int* _rt = S.row_tab + (size_t)(u).pm * BM + gR; \
        dst0[0] = (unsigned)_rt[0] * (unsigned)(K * 2) + (unsigned)(gC * 2); dst0[1] = (unsigned)_rt[64] * (unsigned)(K * 2) + (unsigned)(gC * 2); \
        dst1[0] = (unsigned)_rt[128] * (unsigned)(K * 2) + (unsigned)(gC * 2); dst1[1] = (unsigned)_rt[192] * (unsigned)(K * 2) + (unsigned)(gC * 2); } while (0)
    const size_t kstep = (size_t)(BK * 2);
    const size_t hstep = (size_t)HALF * K * 2;
    const size_t tstep = 2 * hstep;
    const unsigned ldsw = (unsigned)wid * 1024u;
    const int aoff = lds_byte(wr * 64 + fr, fq * 8); int boff = lds_byte(wc * 32 + fr, fq * 8) + 4 * HTB;
    asm volatile("" : "+v"(boff));
#define PG8_SA(b, h) (((b) * 2 + (h)) * HTB)
#define PG8_SB(b, h) ((4 + (b) * 2 + (h)) * HTB)
#define PG8_SBR(b, h) (((b) * 2 + (h)) * HTB)
#define PG8_STAGE(bufoff, gbase, voff) do { _Pragma("unroll") for (int _i = 0; _i < 2; ++_i) \
        __builtin_amdgcn_global_load_lds((const unsigned*)((const char*)(gbase) + (voff)[_i]), (PG8_LAS unsigned*)(lds + (bufoff) + ldsw + _i * 8192), 16, 0, 0); } while (0)
#define PG8_LD16(off) (*(const PG8_LAS v4i_t*)(lds + (off)))
#define PG8_LDA(dst, b, h) do { if constexpr (FP8) { _Pragma("unroll") for (int m = 0; m < 4; ++m) dst##8[m] = __builtin_shufflevector(PG8_LD16(PG8_SA(b, h) + aoff + m * 2048), PG8_LD16(PG8_SA(b, h) + aoff + m * 2048 + 1024), 0, 1, 2, 3, 4, 5, 6, 7); } \
        else { _Pragma("unroll") for (int m = 0; m < 4; ++m) _Pragma("unroll") for (int k = 0; k < 2; ++k) dst[m][k] = *(const PG8_LAS bf16x8*)(lds + PG8_SA(b, h) + aoff + m * 2048 + k * 1024); } } while (0)
#define PG8_LDB(dst, b, h) do { if constexpr (FP8) { _Pragma("unroll") for (int n = 0; n < 2; ++n) dst##8[n] = __builtin_shufflevector(PG8_LD16(PG8_SBR(b, h) + boff + n * 2048), PG8_LD16(PG8_SBR(b, h) + boff + n * 2048 + 1024), 0, 1, 2, 3, 4, 5, 6, 7); } \
        else { _Pragma("unroll") for (int n = 0; n < 2; ++n) _Pragma("unroll") for (int k = 0; k < 2; ++k) dst[n][k] = *(const PG8_LAS bf16x8*)(lds + PG8_SBR(b, h) + boff + n * 2048 + k * 1024); } } while (0)
#define PG8_MMA(ai, bj, At, Bt) do { __builtin_amdgcn_s_setprio(1); \
        if constexpr (FP8) { _Pragma("unroll") for (int m = 0; m < 4; ++m) _Pragma("unroll") for (int n = 0; n < 2; ++n) \
            acc[ai][bj][m][n] = __builtin_amdgcn_mfma_scale_f32_16x16x128_f8f6f4(Bt##8[n], At##8[m], acc[ai][bj][m][n], 0, 0, 0, g.bscale, 0, g.bscale); }     \
        else { _Pragma("unroll") for (int m = 0; m < 4; ++m) _Pragma("unroll") for (int n = 0; n < 2; ++n) _Pragma("unroll") for (int k = 0; k < 2; ++k) \
            acc[ai][bj][m][n] = __builtin_amdgcn_mfma_f32_16x16x32_bf16(Bt[n][k], At[m][k], acc[ai][bj][m][n], 0, 0, 0); } \
        __builtin_amdgcn_s_setprio(0); } while (0)
#define PG8_WAIT_V(n) asm volatile("s_waitcnt vmcnt(" #n ")" ::: "memory")
#define PG8_WAIT_L(n) asm volatile("s_waitcnt lgkmcnt(" #n ")" ::: "memory")
#define PG8_BAR __builtin_amdgcn_s_barrier()
#define PG8_SCHED __builtin_amdgcn_sched_barrier(0)
    Unit cur, nxt; int ui = 0;
    if (!S.next(0, cur)) return;
    f32x4 acc[2][2][4][2];
#pragma unroll
    for (int a = 0; a < 2; ++a)
#pragma unroll
        for (int b = 0; b < 2; ++b)
#pragma unroll
            for (int m = 0; m < 4; ++m)
#pragma unroll
                for (int n = 0; n < 2; ++n) acc[a][b][m][n] = (f32x4){0.f, 0.f, 0.f, 0.f};
    bf16x8 At[4][2], B0[2][2], B1[2][2]; v8i_t At8[4], B08[2], B18[2];
    const char* cA = S.a_ptr(cur); const char* cB = S.b_ptr(cur);
    S.a_ready(cur);
    if constexpr (SP2) {
        if constexpr (Sched::GATHER) { PG8_GLOAD(gc0, gc1, cur);
        PG8_STAGE(PG8_SB(0, 0), cB, voffB); PG8_STAGE(PG8_SB(0, 1), cB + hstep, voffB); PG8_STAGE(PG8_SA(0, 0), cA, gc0); PG8_STAGE(PG8_SA(0, 1), cA, gc1);
        if (wr == 1) PG8_BAR;
        PG8_WAIT_V(2); PG8_BAR;
        PG8_STAGE(PG8_SB(1, 0), cB + kstep, voffB); PG8_STAGE(PG8_SA(1, 0), cA + kstep, gc0); PG8_STAGE(PG8_SB(1, 1), cB + hstep + kstep, voffB);
        } else {
        PG8_STAGE(PG8_SB(0, 0), cB, voffB); PG8_STAGE(PG8_SB(0, 1), cB + hstep, voffB); PG8_STAGE(PG8_SA(0, 0), cA, voffA); PG8_STAGE(PG8_SA(0, 1), cA + hstep, voffA);
        if (wr == 1) PG8_BAR;
        PG8_WAIT_V(2); PG8_BAR;
        PG8_STAGE(PG8_SB(1, 0), cB + kstep, voffB); PG8_STAGE(PG8_SA(1, 0), cA + kstep, voffA); PG8_STAGE(PG8_SB(1, 1), cB + hstep + kstep, voffB);
        }
        PG8_WAIT_V(6); PG8_BAR;
    } else {
        PG8_STAGE(PG8_SB(0, 0), cB, voffB); PG8_STAGE(PG8_SA(0, 0), cA, voffA); PG8_STAGE(PG8_SB(0, 1), cB + hstep, voffB); PG8_STAGE(PG8_SA(0, 1), cA + hstep, voffA);
        if (wr == 1) PG8_BAR;
        PG8_WAIT_V(4); PG8_BAR;
        PG8_STAGE(PG8_SB(1, 0), cB + kstep, voffB); PG8_STAGE(PG8_SA(1, 0), cA + kstep, voffA); PG8_STAGE(PG8_SB(1, 1), cB + hstep + kstep, voffB);
        PG8_WAIT_V(6); PG8_BAR;
    }
    for (;;) {
        const bool has_next = S.next(ui + 1, nxt);
        const char* nA = has_next ? S.a_ptr(nxt) : cA; const char* nB = has_next ? S.b_ptr(nxt) : cB;
#pragma unroll 1
        for (int t = 0; t < nt; t += 2) {
            const bool last = (t == nt - 2);
            const char* a1 = cA + (size_t)(t + 1) * kstep;
            const char* a2 = last ? nA : cA + (size_t)(t + 2) * kstep; const char* b2 = last ? nB : cB + (size_t)(t + 2) * kstep;
            const char* a3 = a2 + kstep; const char* b3 = b2 + kstep;
            if (last && has_next) S.a_ready(nxt);

            if constexpr (SP2) {
            PG8_LDB(B0, 0, 0); PG8_LDB(B1, 0, 1); PG8_SCHED; PG8_LDA(At, 0, 0); if constexpr (Sched::GATHER) PG8_STAGE(PG8_SA(1, 1), a1, gc1); else PG8_STAGE(PG8_SA(1, 1), a1 + hstep, voffA);
            if constexpr (Sched::GATHER) { if (last && has_next) PG8_GLOAD(gc0, gc1, nxt); }
            PG8_WAIT_V(8); PG8_WAIT_L(0); PG8_BAR; PG8_MMA(0, 0, At, B0); PG8_MMA(0, 1, At, B1); PG8_BAR; PG8_SCHED;
            PG8_LDA(At, 0, 1); PG8_STAGE(PG8_SB(0, 0), b2, voffB); PG8_STAGE(PG8_SB(0, 1), b2 + hstep, voffB); if constexpr (Sched::GATHER) PG8_STAGE(PG8_SA(0, 0), a2, gc0); else PG8_STAGE(PG8_SA(0, 0), a2, voffA);
            PG8_WAIT_V(8); PG8_WAIT_L(0); PG8_BAR; PG8_MMA(1, 0, At, B0); PG8_MMA(1, 1, At, B1); PG8_BAR; PG8_SCHED;
            PG8_LDB(B0, 1, 0); PG8_LDB(B1, 1, 1); PG8_SCHED; PG8_LDA(At, 1, 0); if constexpr (Sched::GATHER) PG8_STAGE(PG8_SA(0, 1), a2, gc1); else PG8_STAGE(PG8_SA(0, 1), a2 + hstep, voffA);
            PG8_WAIT_V(8); PG8_WAIT_L(0); PG8_BAR; PG8_MMA(0, 0, At, B0); PG8_MMA(0, 1, At, B1); PG8_BAR; PG8_SCHED;
            PG8_LDA(At, 1, 1); PG8_STAGE(PG8_SB(1, 0), b3, voffB); PG8_STAGE(PG8_SB(1, 1), b3 + hstep, voffB); if constexpr (Sched::GATHER) PG8_STAGE(PG8_SA(1, 0), a3, gc0); else PG8_STAGE(PG8_SA(1, 0), a3, voffA);
            PG8_WAIT_V(8); PG8_WAIT_L(0); PG8_BAR; PG8_MMA(1, 0, At, B0); PG8_MMA(1, 1, At, B1); PG8_BAR; PG8_SCHED;
            } else {
            PG8_LDB(B0, 0, 0); PG8_SCHED; PG8_LDA(At, 0, 0); PG8_STAGE(PG8_SA(1, 1), a1 + hstep, voffA);
            PG8_WAIT_L(8); PG8_BAR; PG8_WAIT_L(0); PG8_MMA(0, 0, At, B0); PG8_BAR; PG8_SCHED;
            PG8_LDB(B1, 0, 1); PG8_STAGE(PG8_SB(0, 0), b2, voffB);
            PG8_BAR; PG8_WAIT_L(0); PG8_MMA(0, 1, At, B1); PG8_BAR;
            PG8_LDA(At, 0, 1); PG8_STAGE(PG8_SA(0, 0), a2, voffA);
            PG8_BAR; PG8_WAIT_L(0); PG8_MMA(1, 0, At, B0); PG8_BAR; PG8_SCHED;
            PG8_STAGE(PG8_SB(0, 1), b2 + hstep, voffB);
            PG8_WAIT_V(6); PG8_BAR; PG8_MMA(1, 1, At, B1); PG8_BAR;
            PG8_LDB(B0, 1, 0); PG8_SCHED; PG8_LDA(At, 1, 0); PG8_STAGE(PG8_SA(0, 1), a2 + hstep, voffA);
            PG8_WAIT_L(8); PG8_BAR; PG8_WAIT_L(0); PG8_MMA(0, 0, At, B0); PG8_BAR; PG8_SCHED;
            PG8_LDB(B1, 1, 1); PG8_STAGE(PG8_SB(1, 0), b3, voffB);
            PG8_BAR; PG8_WAIT_L(0); PG8_MMA(0, 1, At, B1); PG8_BAR;
            PG8_LDA(At, 1, 1); PG8_STAGE(PG8_SA(1, 0), a3, voffA);
            PG8_BAR; PG8_WAIT_L(0); PG8_MMA(1, 0, At, B0); PG8_BAR; PG8_SCHED;
            PG8_STAGE(PG8_SB(1, 1), b3 + hstep, voffB);
            PG8_WAIT_V(6); PG8_BAR; PG8_MMA(1, 1, At, B1); PG8_BAR;
            }
        }
        if constexpr (ALIGN_EPI) { if (wr == 0) PG8_BAR; }
        if constexpr (!Epi::AFTER_DRAIN) { int fr_e = fr, fq_e = fq; asm volatile("" : "+v"(fr_e), "+v"(fq_e));
            E(acc, cur, wr, wc, fr_e, fq_e); S.done(cur); }
        if (!has_next) break;
#pragma unroll
        for (int a = 0; a < 2; ++a)
#pragma unroll
            for (int b = 0; b < 2; ++b)
#pragma unroll
                for (int m = 0; m < 4; ++m)
#pragma unroll
                    for (int n = 0; n < 2; ++n) acc[a][b][m][n] = (f32x4){0.f, 0.f, 0.f, 0.f};
        cur = nxt; cA = nA; cB = nB; ++ui;
        if constexpr (ALIGN_EPI) { if (wr == 1) PG8_BAR; }
    }
    PG8_WAIT_V(0);
    if constexpr (!ALIGN_EPI) { if (wr == 0) PG8_BAR; }
    PG8_BAR;
    if constexpr (Epi::AFTER_DRAIN) { E.fused(acc, cur, wr, wc, fr, fq, lds, wid, lane); S.done(cur); }
#undef PG8_GLOAD
#undef PG8_SA
#undef PG8_SB
#undef PG8_SBR
#undef PG8_STAGE
#undef PG8_LDA
#undef PG8_LDB
#undef PG8_MMA
#undef PG8_LD16
#undef PG8_WAIT_V
#undef PG8_WAIT_L
#undef PG8_BAR
#undef PG8_SCHED
}
}

constexpr size_t MiB = 1u << 20;
constexpr size_t WS_CTL = 0, CTL_ZERO_BYTES = 1 * MiB;
constexpr size_t WS_MOD  = 1 * MiB;
constexpr size_t WS_WRT  = 2 * MiB;
constexpr size_t WS_MOEI = 3 * MiB;
constexpr size_t WS_LRC  = 6 * MiB;
constexpr size_t WS_DNS  = 12 * MiB;
constexpr size_t WS_WIN  = 16 * MiB;
constexpr size_t WS_WOUT = 56 * MiB;
constexpr size_t WS_WGU  = 72 * MiB;
constexpr size_t WS_WDN  = 584 * MiB;
constexpr size_t WS_X    = 840 * MiB;
constexpr size_t WS_H    = 976 * MiB;
constexpr size_t WS_P    = 1044 * MiB;
constexpr size_t WS_CC   = 1206 * MiB;
constexpr size_t WS_VT   = 1274 * MiB;
constexpr size_t WS_VTC  = WS_VT + 8 * MiB;
constexpr size_t WS_DNT  = 1284 * MiB;
constexpr size_t DNT_BYTES = 90112;
constexpr size_t WS_DNO  = 1472 * MiB;
constexpr size_t WS_LRH  = 1540 * MiB;
constexpr size_t WS_LRA  = 1608 * MiB;
constexpr size_t WS_XS   = 1676 * MiB;
constexpr size_t WS_ACT  = 1980 * MiB;
constexpr size_t WS_YS   = 2132 * MiB;
constexpr size_t WS_END  = 2436 * MiB;
constexpr int CW_TMO = 0;
constexpr int CW_BAR = 4096;
constexpr int CW_CNT = 8192;
constexpr int CW_ATQ = 12288;

constexpr int RING_OFF = 0, RING_BYTES = 131072;
constexpr int LDSCTL_OFF = RING_BYTES, MISC_OFF = LDSCTL_OFF + 320;
constexpr int LDS_X_OFF = RING_BYTES + 1024;
constexpr int LDS_BYTES = 147456;
constexpr int NWAVES = 8, NTHREADS = 512;

#define GAS __attribute__((address_space(1)))
#define LAS __attribute__((address_space(3)))
typedef unsigned short bf16;
typedef unsigned v4u __attribute__((ext_vector_type(4)));
typedef unsigned v2u __attribute__((ext_vector_type(2)));
typedef float f32x4 __attribute__((ext_vector_type(4)));
typedef float f32x16 __attribute__((ext_vector_type(16)));
typedef short bf16x8 __attribute__((ext_vector_type(8)));
typedef short bf16x4 __attribute__((ext_vector_type(4)));
typedef GAS unsigned gu32;
#define RLX_AGENT __ATOMIC_RELAXED, __HIP_MEMORY_SCOPE_AGENT
#define LDS_WAIT() asm volatile("s_waitcnt lgkmcnt(0)" ::: "memory")
#define VM_WAIT() asm volatile("s_waitcnt vmcnt(0)" ::: "memory")
#define LDS_BARRIER() asm volatile("s_waitcnt lgkmcnt(0)\n\ts_barrier" ::: "memory")
typedef __bf16 bf16x2_t __attribute__((ext_vector_type(2)));
typedef float f32x2_t __attribute__((ext_vector_type(2)));
__device__ __forceinline__ unsigned pk2(float lo, float hi) { const f32x2_t v = {lo, hi}; const bf16x2_t b = __builtin_convertvector(v, bf16x2_t); return __builtin_bit_cast(unsigned, b); }
__device__ __forceinline__ unsigned f2bf(float f) { return pk2(f, 0.f) & 0xffffu; }
__device__ __forceinline__ float bf2f(unsigned short b) { return __builtin_bit_cast(float, (unsigned)b << 16); }
__device__ __forceinline__ float bflo(unsigned w) { return __builtin_bit_cast(float, w << 16); }
__device__ __forceinline__ float bfhi(unsigned w) { return __builtin_bit_cast(float, w & 0xffff0000u); }
template <int CTRL> __device__ __forceinline__ float dpp_mov(float v) { return __builtin_bit_cast(float, __builtin_amdgcn_update_dpp(0, __builtin_bit_cast(int, v), CTRL, 0xF, 0xF, false)); }
__device__ __forceinline__ float wave_sum(float v) {
    v += dpp_mov<0xB1>(v); v += dpp_mov<0x4E>(v); v += dpp_mov<0x141>(v); v += dpp_mov<0x140>(v);
    const int iv = __builtin_bit_cast(int, v);
    const float r0 = __builtin_bit_cast(float, __builtin_amdgcn_readlane(iv, 0)), r1 = __builtin_bit_cast(float, __builtin_amdgcn_readlane(iv, 16)), r2 = __builtin_bit_cast(float, __builtin_amdgcn_readlane(iv, 32)), r3 = __builtin_bit_cast(float, __builtin_amdgcn_readlane(iv, 48));
    return (r0 + r1) + (r2 + r3);
}
__device__ __forceinline__ float sigmoidf_(float x) { return __builtin_amdgcn_rcpf(1.0f + __builtin_amdgcn_exp2f(-1.4426950408889634f * x)); }
__device__ __forceinline__ float siluf_(float x) { return x * sigmoidf_(x); }
__device__ __forceinline__ float softplusf_(float x) { return x > 20.f ? x : log1pf(__expf(x)); }

#define XB_TMO      128
#define XB_XCNT(j)  (256  + 64 * (j))
#define XB_XSUB(j)  (1280 + 64 * (j))
#define XB_XGEN(j)  (2304 + 64 * (j))
#define XB_TOP      3328
#define XB_TOPGEN   3392
#define XCD_BAR_WORDS 3456
#define XB_SPIN_CAP (1u << 18)

__device__ __forceinline__ unsigned xb_ld(unsigned* p)              { return __hip_atomic_load(p, __ATOMIC_RELAXED, __HIP_MEMORY_SCOPE_AGENT); }
__device__ __forceinline__ unsigned xb_add(unsigned* p, unsigned v) { return __hip_atomic_fetch_add(p, v, __ATOMIC_RELAXED, __HIP_MEMORY_SCOPE_AGENT); }
__device__ __forceinline__ unsigned xb_xcc_id() { return (unsigned)__builtin_amdgcn_s_getreg((3 << 11) | 20) & 0xFu; }
#define XB_SPIN(cond, bar) do { unsigned _sp = 0; while (cond) { __builtin_amdgcn_s_sleep(1); \
    if ((++_sp & 255u) == 0u) { if (xb_ld(&(bar)[XB_TMO])) break; if (_sp > XB_SPIN_CAP) { atomicAdd(&(bar)[XB_TMO], 1u); break; } } } } while (0)

struct XcdBarrier {
    unsigned* bar; unsigned x;
    volatile LAS unsigned* st;
};

__device__ __forceinline__ XcdBarrier xcd_barrier_post(unsigned* bar, volatile LAS unsigned* st) {
    XcdBarrier b; b.bar = bar; b.x = xb_xcc_id(); b.st = st;
    if (threadIdx.x == 0) (void)xb_add(&bar[XB_XCNT(b.x)], 1u);
    return b;
}
__device__ __forceinline__ void xcd_barrier_complete(unsigned* bar, unsigned x, unsigned& nloc, unsigned& nx) {
    const unsigned G = gridDim.x * gridDim.y * gridDim.z;
    unsigned sum, cnt, mine, sp = 0u;
    for (;;) {
        sum = 0u; cnt = 0u; mine = 0u;
#pragma unroll
        for (unsigned j = 0; j < 16; ++j) { const unsigned c = xb_ld(&bar[XB_XCNT(j)]); sum += c; cnt += (c > 0u) ? 1u : 0u; mine = (j == x) ? c : mine; }
        if (sum == G) break;
        __builtin_amdgcn_s_sleep(1);
        if ((++sp & 255u) == 0u) { if (xb_ld(&bar[XB_TMO])) break; if (sp > XB_SPIN_CAP) { atomicAdd(&bar[XB_TMO], 1u); break; } }
    }
    nloc = mine > 0u ? mine : 1u; nx = cnt > 0u ? cnt : 1u;
}

__device__ __forceinline__ void xcd_barrier(const XcdBarrier& b) {
    asm volatile("s_waitcnt vmcnt(0)" ::: "memory");
    __syncthreads();
    if (threadIdx.x == 0) {
        unsigned* bar = b.bar;
        __builtin_amdgcn_s_waitcnt(0);
        unsigned nloc = b.st[0], nx = b.st[1];
        if (nloc == 0u) { xcd_barrier_complete(bar, b.x, nloc, nx); b.st[0] = nloc; b.st[1] = nx; }
        const unsigned old = xb_add(&bar[XB_XSUB(b.x)], 1u);
        const unsigned gen = old / nloc;
        if (old + 1u == (gen + 1u) * nloc) {
            __builtin_amdgcn_fence(__ATOMIC_RELEASE, "agent");
            asm volatile("s_waitcnt vmcnt(0)" ::: "memory");
            const unsigned og = xb_add(&bar[XB_TOP], 1u);
            const unsigned tg = og / nx;
            if (og + 1u == (tg + 1u) * nx) xb_add(&bar[XB_TOPGEN], 1u);
            else XB_SPIN(xb_ld(&bar[XB_TOPGEN]) == tg, bar);
            __builtin_amdgcn_fence(__ATOMIC_ACQUIRE, "agent");
            xb_add(&bar[XB_XGEN(b.x)], 1u);
            asm volatile("s_waitcnt vmcnt(0)" ::: "memory");
        } else {
            XB_SPIN(xb_ld(&bar[XB_XGEN(b.x)]) == gen, bar);
            __builtin_amdgcn_fence(__ATOMIC_ACQUIRE, "agent");
            asm volatile("s_waitcnt vmcnt(0)" ::: "memory");
        }
    }
    __syncthreads();
}

enum InIdx { I_X = 0, I_C, I_CTX, I_CCTX, I_WMOD, I_BMOD, I_NMG, I_NFG, I_WIN, I_WOUT, I_SINK, I_DNCW, I_DNALOG, I_DNDT, I_DNNG, I_LRCW, I_LRCB, I_LRWR, I_LRBR, I_LRWI, I_LRBI, I_LRLAM,
             I_WROUT, I_BROUT, I_WGU, I_BGU, I_WDN, I_BDN, I_FNG, N_IN };
struct Frame {
    LAS unsigned char* lds;
    volatile LAS unsigned* MISC;
    gu32* ctl;
    int tid, lane, wave, G, bid;
    const float* const __attribute__((address_space(4)))* in;
    float* out; unsigned char* ws;
};
__device__ __forceinline__ int mod_row(int m) { return m < NLAT ? (m >> 12) : 4; }
__device__ __forceinline__ bool phase_enter(Frame& F) { int t = threadIdx.x; asm volatile("" : "+v"(t)); F.tid = t; F.lane = t & 63; F.wave = __builtin_amdgcn_readfirstlane(t >> 6); return true; }
__device__ __forceinline__ void seq_of(int m, int& t, int& T, int& base) { if (m < NLAT) { t = m & 4095; T = SEQ; base = m - t; } else { t = (m - NLAT) & 255; T = CTXL; base = m - t; } }
__device__ __forceinline__ float gelu_tanh(float x) { const float u = 0.7978845608028654f * (x + 0.044715f * x * x * x); return x * sigmoidf_(2.0f * u); }

__device__ __forceinline__ void transpose_item(const float* W, int K, int N, bf16* WT, int k0, int dstrow0, int srccol0, int nvalid, LAS float* scr, int lane) {
    { const int c4 = (lane & 7) * 4, kr = lane >> 3; f32x4 v[8];
#pragma unroll
      for (int i = 0; i < 8; ++i) { v[i] = (f32x4){0.f, 0.f, 0.f, 0.f}; if (c4 < nvalid) v[i] = __builtin_nontemporal_load((const f32x4*)(W + (size_t)(k0 + 8 * i + kr) * N + srccol0 + c4)); }
#pragma unroll
      for (int i = 0; i < 8; ++i) { LAS float* d = scr + (8 * i + kr) * 33 + c4; d[0] = v[i].x; d[1] = v[i].y; d[2] = v[i].z; d[3] = v[i].w; } }
    LDS_WAIT(); asm volatile("" ::: "memory");
    const int c = lane & 7;
#pragma unroll
    for (int jj = 0; jj < 4; ++jj) { const int n = (lane >> 3) + 8 * jj; const LAS float* s = scr + (8 * c) * 33 + n;
        v4u o; o.x = pk2(s[0 * 33], s[1 * 33]); o.y = pk2(s[2 * 33], s[3 * 33]); o.z = pk2(s[4 * 33], s[5 * 33]); o.w = pk2(s[6 * 33], s[7 * 33]);
        *(GAS v4u*)(WT + (size_t)(dstrow0 + n) * K + k0 + 8 * c) = o; }
    LDS_WAIT(); asm volatile("" ::: "memory");
}
__device__ __forceinline__ void transpose_item_f8(const float* W, int K, int N, unsigned char* WT, int k0, int dstrow0, int srccol0, float scale, LAS float* scr, int lane) {
    { const int c4 = (lane & 7) * 4, kr = lane >> 3; f32x4 v[8];
#pragma unroll
      for (int i = 0; i < 8; ++i) v[i] = __builtin_nontemporal_load((const f32x4*)(W + (size_t)(k0 + 8 * i + kr) * N + srccol0 + c4));
#pragma unroll
      for (int i = 0; i < 8; ++i) { LAS float* d = scr + (8 * i + kr) * 33 + c4; d[0] = v[i].x; d[1] = v[i].y; d[2] = v[i].z; d[3] = v[i].w; } }
    LDS_WAIT(); asm volatile("" ::: "memory");
    { const int n = lane >> 1, hf = lane & 1; const LAS float* s = scr + (32 * hf) * 33 + n; unsigned w[8];
#pragma unroll
      for (int i = 0; i < 8; ++i) { int x = 0; x = __builtin_amdgcn_cvt_pk_fp8_f32(s[(4 * i + 0) * 33] * scale, s[(4 * i + 1) * 33] * scale, x, false); x = __builtin_amdgcn_cvt_pk_fp8_f32(s[(4 * i + 2) * 33] * scale, s[(4 * i + 3) * 33] * scale, x, true); w[i] = (unsigned)x; }
      GAS v4u* o = (GAS v4u*)(WT + (size_t)(dstrow0 + n) * K + k0 + 32 * hf); o[0] = (v4u){w[0], w[1], w[2], w[3]}; o[1] = (v4u){w[4], w[5], w[6], w[7]}; }
    LDS_WAIT(); asm volatile("" ::: "memory");
}
__device__ __forceinline__ void p0_prologue(Frame& F) {
    {
        LAS float* sc = (LAS float*)(F.lds);
        LAS float* red = (LAS float*)(F.lds + 40960);
        bool have_sc = false;
        for (int wb = F.bid; wb < 192; wb += F.G) {
            if (!have_sc) {
                for (int i = F.tid; i < 5 * 2048; i += NTHREADS) { const int r = i >> 11, k = i & 2047; const float cv = r < 4 ? F.in[I_C][r * 2048 + k] : F.in[I_CCTX][k]; sc[i] = siluf_(cv); }
                have_sc = true; __syncthreads();
            }
            const int l = wb / 96, cb = wb % 96, kp = F.tid >> 5, cg = F.tid & 31, j0 = cb * 128 + cg * 4;
            const float* wp = F.in[I_WMOD] + ((size_t)l * 2048 + kp * 128) * 12288 + j0;
            f32x4 acc[5];
#pragma unroll
            for (int r = 0; r < 5; ++r) acc[r] = (f32x4){0.f, 0.f, 0.f, 0.f};
#pragma unroll 4
            for (int k = 0; k < 128; ++k) { const f32x4 w = *(const f32x4*)(wp + (size_t)k * 12288);
#pragma unroll
                for (int r = 0; r < 5; ++r) acc[r] += sc[r * 2048 + kp * 128 + k] * w; }
#pragma unroll
            for (int r = 0; r < 5; ++r) *(LAS f32x4*)(red + (kp * 5 + r) * 128 + cg * 4) = acc[r];
            __syncthreads();
            for (int i = F.tid; i < 640; i += NTHREADS) { const int r = i >> 7, col = i & 127; float s = F.in[I_BMOD][l * 12288 + cb * 128 + col];
#pragma unroll
                for (int q = 0; q < 16; ++q) s += red[(q * 5 + r) * 128 + col];
                ((float*)(F.ws + WS_MOD))[(size_t)(l * 5 + r) * 12288 + cb * 128 + col] = s; }
            __syncthreads();
        }
        __syncthreads();
    }
    {
        LAS float* scr = (LAS float*)(F.lds + F.wave * 16384);
        const int gw = F.bid * NWAVES + F.wave, NGW = F.G * NWAVES;
        constexpr int I_IN = 32 * 144, I_OUT = 32 * 64, I_RT = 32, I_16 = 32, PER_L = I_IN + I_OUT + I_RT + I_16;
        for (int it0 = gw; it0 < 2 * PER_L; it0 += NGW) {
            const int l = it0 / PER_L; int r = it0 % PER_L;
            if (r < I_IN) { const int nb = r % 144, kb = r / 144, d0 = nb * 32; int s0 = d0, nv = 32;
                if (d0 >= 3584) s0 = d0 + 16;
                transpose_item(F.in[I_WIN] + (size_t)l * 2048 * IN_W, 2048, IN_W, (bf16*)(F.ws + WS_WIN) + (size_t)l * PW * 2048, kb * 64, d0, s0, nv, scr, F.lane); continue; }
            r -= I_IN;
            if (r < I_OUT) { const int nb = r % 64, kb = r / 64;
                transpose_item(F.in[I_WOUT] + (size_t)l * 2048 * 2048, 2048, 2048, (bf16*)(F.ws + WS_WOUT) + (size_t)l * 2048 * 2048, kb * 64, nb * 32, nb * 32, 32, scr, F.lane); continue; }
            r -= I_OUT;
            if (r < I_RT) { transpose_item(F.in[I_WROUT] + (size_t)l * 2048 * 32, 2048, 32, (bf16*)(F.ws + WS_WRT) + (size_t)l * 32 * 2048, r * 64, 0, 0, 32, scr, F.lane); continue; }
            r -= I_RT;
            transpose_item(F.in[I_WIN] + (size_t)l * 2048 * IN_W, 2048, IN_W, (bf16*)(F.ws + WS_WRT + 512 * 1024) + (size_t)l * 32 * 2048, r * 64, 0, 3584, 16, scr, F.lane);
        }
    }
}
constexpr int CW_CVQ = 12288 + 512;
#ifndef FP8_GEMM2
#define FP8_GEMM2 1
#endif
constexpr float WGU_SCALE = 64.0f, WDN_SCALE = 64.0f; constexpr int WGU_E8M0 = 0x7C7C7C7C, WDN_E8M0 = 0x7C7C7C7C;
__device__ __forceinline__ void convert_moe_item(Frame& F, int l, int r, LAS float* scr) {
    constexpr int I_GU = 32 * 32 * 64;
    if (r < I_GU) { const int e = r / 2048, q = r % 2048, nb = q % 64, kb = q / 64; const int s0 = ((nb >> 2) & 1) * 1024 + (nb >> 3) * 128 + (nb & 3) * 32;
        transpose_item_f8(F.in[I_WGU] + (size_t)(l * 32 + e) * 2048 * 2048, 2048, 2048, F.ws + WS_WGU + (size_t)(l * 32 + e) * 2048 * 2048, kb * 64, nb * 32, s0, WGU_SCALE, scr, F.lane); return; }
    r -= I_GU;
    { const int e = r / 1024, q = r % 1024, nb = q % 64, kb = q / 64;
#if FP8_GEMM2
        transpose_item_f8(F.in[I_WDN] + (size_t)(l * 32 + e) * 1024 * 2048, 1024, 2048, F.ws + WS_WDN + (size_t)(l * 32 + e) * 2048 * 1024, kb * 64, nb * 32, nb * 32, WDN_SCALE, scr, F.lane);
#else
        transpose_item(F.in[I_WDN] + (size_t)(l * 32 + e) * 1024 * 2048, 1024, 2048, (bf16*)(F.ws + WS_WDN) + (size_t)(l * 32 + e) * 2048 * 1024, kb * 64, nb * 32, nb * 32, 32, scr, F.lane);
#endif
    }
}
constexpr int CVG = 8;
__device__ __forceinline__ bool convert_grab(Frame& F, int l, int rep, LAS float* scr) {
    constexpr int NIT = 32 * 32 * 64 + 32 * 16 * 64;
    int g = 0; if (F.lane == 0) g = (int)__hip_atomic_fetch_add(F.ctl + CW_CVQ + 64 * l + 8 * rep, 1u, RLX_AGENT); g = __builtin_amdgcn_readfirstlane(g);
    if (g * CVG >= NIT) return false;
#pragma unroll 1
    for (int k = 0; k < CVG; ++k) convert_moe_item(F, l, g * CVG + k, scr);
    return true;
}
__device__ __forceinline__ void convert_moe_queue(Frame& F, int l, int rep = 0) {
    LAS float* scr = (LAS float*)(F.lds + F.wave * 16384);
    __syncthreads();
    while (convert_grab(F, l, rep, scr)) {}
    __syncthreads();
}
constexpr int CW_TAIL = 16384;
__device__ __forceinline__ void tail_fill(Frame& F, int seam, int lt) {
    LAS int* flag = (LAS int*)(F.lds + LDS_X_OFF + 768);
    LAS float* scr = (LAS float*)(F.lds + F.wave * 16384);
    __syncthreads();
    if (F.tid == 0) (void)__hip_atomic_fetch_add(F.ctl + CW_TAIL + 64 * seam, 1u, RLX_AGENT);
    bool more = true;
    for (int it = 0; it < 4096; ++it) {
        if (F.tid == 0) *flag = (__hip_atomic_load(F.ctl + CW_TAIL + 64 * seam, RLX_AGENT) >= (unsigned)F.G) ? 1 : 0;
        __syncthreads();
        const int done = *flag;
        __syncthreads();
        if (done) break;
        if (more) more = convert_grab(F, lt, 0, scr); else __builtin_amdgcn_s_sleep(32);
    }
}

__device__ __forceinline__ void load_row(const float* src, int lane, f32x4 (&v)[8]) {
    const f32x4* p = (const f32x4*)src + lane;
#pragma unroll
    for (int j = 0; j < 8; ++j) v[j] = p[64 * j];
}
__device__ __forceinline__ void store_row(float* dst, int lane, const f32x4 (&v)[8]) {
    f32x4* p = (f32x4*)dst + lane;
#pragma unroll
    for (int j = 0; j < 8; ++j) p[64 * j] = v[j];
}
__device__ __forceinline__ void combine_row(Frame& F, int l, int m, int lane, f32x4 (&v)[8]) {
    const int* dest = (const int*)(F.ws + WS_MOEI + 2 * 512 * 1024) + m * 4;
    const float* g5 = (const float*)(F.ws + WS_MOD) + (size_t)(l * 5 + mod_row(m)) * 12288 + 5 * 2048;
    f32x4 acc[8];
#pragma unroll
    for (int j = 0; j < 8; ++j) acc[j] = (f32x4){0.f, 0.f, 0.f, 0.f};
#pragma unroll
    for (int k = 0; k < 4; ++k) { const int d = dest[k]; const v2u* yp = (const v2u*)((const bf16*)(F.ws + WS_YS) + (size_t)d * 2048) + lane;
#pragma unroll
        for (int j = 0; j < 8; ++j) { const v2u w = yp[64 * j]; acc[j] += (f32x4){bflo(w.x), bfhi(w.x), bflo(w.y), bfhi(w.y)}; } }
#pragma unroll
    for (int j = 0; j < 8; ++j) { const f32x4 gg = *((const f32x4*)g5 + lane + 64 * j); v[j] += gg * acc[j]; }
}
__device__ __forceinline__ void modnorm_store(const f32x4 (&v)[8], const float* g, const float* shift, const float* scale, bf16* hrow, int lane) {
    float ss = 0.f;
#pragma unroll
    for (int j = 0; j < 8; ++j) ss += (v[j].x * v[j].x + v[j].y * v[j].y) + (v[j].z * v[j].z + v[j].w * v[j].w);
    const float rstd = 1.0f / sqrtf(wave_sum(ss) * (1.0f / 2048.0f) + EPS);
    v2u* hp = (v2u*)hrow + lane;
#pragma unroll
    for (int j = 0; j < 8; ++j) { const f32x4 gg = *((const f32x4*)g + lane + 64 * j), sh = *((const f32x4*)shift + lane + 64 * j), sc = *((const f32x4*)scale + lane + 64 * j);
        const f32x4 y = (v[j] * rstd) * gg * (sc + 1.0f) + sh; v2u w; w.x = pk2(y.x, y.y); w.y = pk2(y.z, y.w); hp[64 * j] = w; }
}
constexpr size_t WS_W16 = WS_WRT + 512 * 1024;
__device__ __forceinline__ void phase_norm1(Frame& F, int l) {
    constexpr int TROW = 4112;
    LAS unsigned char* tile = F.lds; LAS float* part = (LAS float*)(F.lds + 66048);
    float* X = (float*)(F.ws + WS_X); bf16* H = (bf16*)(F.ws + WS_H); bf16* P = (bf16*)(F.ws + WS_P);
    const float* modp = (const float*)(F.ws + WS_MOD) + (size_t)l * 5 * 12288;
    const bf16* w16 = (const bf16*)(F.ws + WS_W16) + (size_t)l * 32 * 2048;
    for (int r0 = F.bid * 16; r0 < NTOK; r0 += F.G * 16) {
#pragma unroll 1
        for (int rr = 0; rr < 2; ++rr) { const int lr = 2 * F.wave + rr, m = r0 + lr;
            f32x4 v[8];
            if (l == 0) load_row(m < NLAT ? F.in[I_X] + (size_t)m * DM : F.in[I_CTX] + (size_t)(m - NLAT) * DM, F.lane, v);
            else { load_row(X + (size_t)m * DM, F.lane, v); if (MK_STAGE >= 9) { combine_row(F, l - 1, m, F.lane, v); store_row(X + (size_t)m * DM, F.lane, v); } }
            float ss = 0.f;
#pragma unroll
            for (int j = 0; j < 8; ++j) ss += (v[j].x * v[j].x + v[j].y * v[j].y) + (v[j].z * v[j].z + v[j].w * v[j].w);
            const float rstd = 1.0f / sqrtf(wave_sum(ss) * (1.0f / 2048.0f) + EPS);
            const float* mr = modp + (size_t)mod_row(m) * 12288; const float* g = F.in[I_NMG] + l * DM;
            v2u* hp = (v2u*)(H + (size_t)m * DM) + F.lane; LAS v2u* tp = (LAS v2u*)(tile + lr * TROW) + F.lane;
#pragma unroll
            for (int j = 0; j < 8; ++j) { const f32x4 gg = *((const f32x4*)g + F.lane + 64 * j), sh = *((const f32x4*)mr + F.lane + 64 * j), sc = *((const f32x4*)(mr + 2048) + F.lane + 64 * j);
                const f32x4 y = (v[j] * rstd) * gg * (sc + 1.0f) + sh; v2u w; w.x = pk2(y.x, y.y); w.y = pk2(y.z, y.w); hp[64 * j] = w; tp[64 * j] = w; }
        }
        __syncthreads();
        { const int row = F.lane & 15, q = F.lane >> 4; f32x4 acc = {0.f, 0.f, 0.f, 0.f};
#pragma unroll
          for (int ks = 0; ks < 8; ++ks) { const int k0 = 256 * F.wave + 32 * ks + 8 * q;
              const bf16x8 a = *(const LAS bf16x8*)(tile + row * TROW + k0 * 2); const bf16x8 b = *(const bf16x8*)(w16 + (size_t)row * 2048 + k0);
              acc = __builtin_amdgcn_mfma_f32_16x16x32_bf16(a, b, acc, 0, 0, 0); }
#pragma unroll
          for (int i = 0; i < 4; ++i) part[(F.wave * 16 + 4 * q + i) * 16 + row] = acc[i]; }
        __syncthreads();
        if (F.tid < 256) { const int rw = F.tid >> 4, c = F.tid & 15; float sacc = 0.f;
#pragma unroll
            for (int w = 0; w < 8; ++w) sacc += part[(w * 16 + rw) * 16 + c];
            P[(size_t)(r0 + rw) * PW + PC_BETA + c] = (bf16)f2bf(sacc); }
        __syncthreads();
    }
}
__device__ __forceinline__ void phase_final(Frame& F, bool with_combine) {
    const int gw = F.bid * NWAVES + F.wave, NGW = F.G * NWAVES;
    const float* X = (const float*)(F.ws + WS_X);
    for (int m = gw; m < NLAT; m += NGW) {
        f32x4 v[8];
        if (with_combine) { load_row(X + (size_t)m * DM, F.lane, v); combine_row(F, 1, m, F.lane, v); }
        else load_row(F.in[I_X] + (size_t)m * DM, F.lane, v);
        float ss = 0.f;
#pragma unroll
        for (int j = 0; j < 8; ++j) ss += (v[j].x * v[j].x + v[j].y * v[j].y) + (v[j].z * v[j].z + v[j].w * v[j].w);
        const float rstd = 1.0f / sqrtf(wave_sum(ss) * (1.0f / 2048.0f) + EPS);
        f32x4* op = (f32x4*)(F.out + (size_t)m * DM) + F.lane;
#pragma unroll
        for (int j = 0; j < 8; ++j) { const f32x4 gg = *((const f32x4*)F.in[I_FNG] + F.lane + 64 * j); op[64 * j] = v[j] * rstd * gg; }
    }
}

__device__ __forceinline__ void phase_inproj(Frame& F, int l) {
    pg8::Gemm g{(const bf16*)(F.ws + WS_H), (const bf16*)(F.ws + WS_WIN) + (size_t)l * PW * 2048, NTOK, 4608, 2048};
    pg8::StaticOrder S; S.init(g, F.G, F.bid);
    pg8::EpiBf16Plain E{(bf16*)(F.ws + WS_P), PW};
    pg8::gemm_phase<pg8::EpiBf16Plain, pg8::StaticOrder, true, true>(F.lds + RING_OFF, g, S, E);
}
__device__ __forceinline__ void phase_outproj(Frame& F, int l) {
    float* X = (float*)(F.ws + WS_X);
    pg8::Gemm g{(const bf16*)(F.ws + WS_CC), (const bf16*)(F.ws + WS_WOUT) + (size_t)l * 2048 * 2048, l == 0 ? NTOK : NLAT, 2048, 2048};
    pg8::StaticOrder S; S.init(g, F.G, F.bid);
    pg8::EpiResGate E{l == 0 ? F.in[I_X] : X, l == 0 ? F.in[I_CTX] : X + (size_t)NLAT * DM, X, (const float*)(F.ws + WS_MOD) + (size_t)l * 5 * 12288 + 2 * 2048};
    pg8::gemm_phase<pg8::EpiResGate, pg8::StaticOrder, true, true>(F.lds + RING_OFF, g, S, E);
}
#ifndef PHASE_INPROJ
#define PHASE_INPROJ(F, l) phase_inproj(F, l)
#endif
#ifndef PHASE_OUTPROJ
#define PHASE_OUTPROJ(F, l) phase_outproj(F, l)
#endif

constexpr size_t WS_H8 = WS_XS;
constexpr size_t MOEI_TOPE = WS_MOEI, MOEI_TOPG = WS_MOEI + 512 * 1024, MOEI_DEST = WS_MOEI + 2 * 512 * 1024, MOEI_ROWG = WS_MOEI + 3 * 512 * 1024, MOEI_ROWT = WS_MOEI + 4 * 512 * 1024, MOEI_IDT = WS_MOEI + 5 * 512 * 1024;
__device__ __forceinline__ void phase_norm2(Frame& F, int l) {
    const int nrows = (l == 0) ? NTOK : NLAT;
    constexpr int TROW = 4112;
    LAS unsigned char* tile = F.lds;
    LAS float* part = (LAS float*)(F.lds + 66048);
    LAS float* lg = (LAS float*)(F.lds + 66048 + 16384);
    const float* X = (const float*)(F.ws + WS_X); bf16* H = (bf16*)(F.ws + WS_H);
    const float* modp = (const float*)(F.ws + WS_MOD) + (size_t)l * 5 * 12288;
    const bf16* wrt = (const bf16*)(F.ws + WS_WRT) + (size_t)l * 32 * 2048;
    int* tope = (int*)(F.ws + MOEI_TOPE); float* topg = (float*)(F.ws + MOEI_TOPG);
    for (int r0 = F.bid * 16; r0 < nrows; r0 += F.G * 16) {
#pragma unroll 1
        for (int rr = 0; rr < 2; ++rr) {
            const int lr = 2 * F.wave + rr, m = r0 + lr;
            f32x4 v[8]; load_row(X + (size_t)m * DM, F.lane, v);
            float ss = 0.f;
#pragma unroll
            for (int j = 0; j < 8; ++j) ss += (v[j].x * v[j].x + v[j].y * v[j].y) + (v[j].z * v[j].z + v[j].w * v[j].w);
            const float rstd = 1.0f / sqrtf(wave_sum(ss) * (1.0f / 2048.0f) + EPS);
            const float* mr = modp + (size_t)mod_row(m) * 12288; const float* g = F.in[I_NFG] + l * DM;
            unsigned* hp = (unsigned*)(F.ws + WS_H8 + (size_t)m * DM) + F.lane; LAS v2u* tp = (LAS v2u*)(tile + lr * TROW) + F.lane;
#pragma unroll
            for (int j = 0; j < 8; ++j) { const f32x4 gg = *((const f32x4*)g + F.lane + 64 * j), sh = *((const f32x4*)(mr + 3 * 2048) + F.lane + 64 * j), sc = *((const f32x4*)(mr + 4 * 2048) + F.lane + 64 * j);
                const f32x4 y = (v[j] * rstd) * gg * (sc + 1.0f) + sh; v2u w; w.x = pk2(y.x, y.y); w.y = pk2(y.z, y.w); tp[64 * j] = w;
                int x8 = 0; x8 = __builtin_amdgcn_cvt_pk_fp8_f32(y.x, y.y, x8, false); x8 = __builtin_amdgcn_cvt_pk_fp8_f32(y.z, y.w, x8, true); hp[64 * j] = (unsigned)x8; }
        }
        __syncthreads();
        {
            const int row = F.lane & 15, q = F.lane >> 4;
            f32x4 acc0 = {0.f, 0.f, 0.f, 0.f}, acc1 = {0.f, 0.f, 0.f, 0.f};
#pragma unroll
            for (int ks = 0; ks < 8; ++ks) { const int k0 = 256 * F.wave + 32 * ks + 8 * q;
                const bf16x8 a = *(const LAS bf16x8*)(tile + row * TROW + k0 * 2);
                const bf16x8 b0 = *(const bf16x8*)(wrt + (size_t)row * 2048 + k0), b1 = *(const bf16x8*)(wrt + (size_t)(16 + row) * 2048 + k0);
                acc0 = __builtin_amdgcn_mfma_f32_16x16x32_bf16(a, b0, acc0, 0, 0, 0); acc1 = __builtin_amdgcn_mfma_f32_16x16x32_bf16(a, b1, acc1, 0, 0, 0); }
#pragma unroll
            for (int i = 0; i < 4; ++i) { part[(F.wave * 16 + 4 * q + i) * 32 + row] = acc0[i]; part[(F.wave * 16 + 4 * q + i) * 32 + 16 + row] = acc1[i]; }
        }
        __syncthreads();
        { const int rw = F.tid >> 5, e = F.tid & 31; float s = F.in[I_BROUT][l * 32 + e];
#pragma unroll
          for (int w = 0; w < 8; ++w) s += part[(w * 16 + rw) * 32 + e];
          lg[rw * 32 + e] = s; }
        __syncthreads();
        if (F.tid < 16) { const int m = r0 + F.tid; float val[4]; int idx[4]; unsigned taken = 0u;
#pragma unroll
            for (int k = 0; k < 4; ++k) { float best = -3.0e38f; int bi = 0;
                for (int e = 0; e < 32; ++e) { const float x = lg[F.tid * 32 + e]; if (!((taken >> e) & 1u) && x > best) { best = x; bi = e; } }
                val[k] = best; idx[k] = bi; taken |= 1u << bi; }
            float p[4], sum = 0.f;
#pragma unroll
            for (int k = 0; k < 4; ++k) { p[k] = __expf(val[k] - val[0]); sum += p[k]; }
#pragma unroll
            for (int k = 0; k < 4; ++k) { const unsigned rank = __hip_atomic_fetch_add(F.ctl + CW_CNT + 64 * l + idx[k], 1u, RLX_AGENT);
                tope[m * 4 + k] = idx[k] | (int)(rank << 8); topg[m * 4 + k] = p[k] / sum; }
        }
        __syncthreads();
    }
}
__device__ __forceinline__ void moe_tables(Frame& F, int l) {
    LAS int* blk_end = (LAS int*)(F.lds + LDS_X_OFF); LAS int* pstart = blk_end + 32; LAS int* cnts = blk_end + 64;
    if (F.tid == 0) { int nb = 0;
        for (int e = 0; e < 32; ++e) { const int c = (int)__hip_atomic_load(F.ctl + CW_CNT + 64 * l + e, RLX_AGENT); cnts[e] = c; pstart[e] = nb * 256; nb += (c + 255) >> 8; blk_end[e] = nb; } }
    __syncthreads();
}
__device__ __forceinline__ void phase_scatter(Frame& F, int l) {
    const int nrows = (l == 0) ? NTOK : NLAT;
    moe_tables(F, l);
    const LAS int* blk_end = (const LAS int*)(F.lds + LDS_X_OFF); const LAS int* pstart = blk_end + 32; const LAS int* cnts = blk_end + 64;
    const int* tope = (const int*)(F.ws + MOEI_TOPE); const float* topg = (const float*)(F.ws + MOEI_TOPG);
    int* dest = (int*)(F.ws + MOEI_DEST); float* rowg = (float*)(F.ws + MOEI_ROWG); int* rowt = (int*)(F.ws + MOEI_ROWT);
    for (int a = F.bid * NTHREADS + F.tid; a < nrows * 4; a += F.G * NTHREADS) {
        const int te = tope[a], e = te & 255, rank = (int)((unsigned)te >> 8), d = pstart[e] + rank;
        dest[a] = d; rowg[d] = topg[a]; rowt[d] = a >> 2; }
#if FP8_GEMM2
    { int* idt = (int*)(F.ws + MOEI_IDT); for (int r = F.bid * NTHREADS + F.tid; r < MOE_ROWS; r += F.G * NTHREADS) idt[r] = r; }
#endif
    if (F.bid < 32) { const int e = F.bid, r0 = pstart[e] + cnts[e], r1 = blk_end[e] * 256;
        for (int r = r0 + F.tid; r < r1; r += NTHREADS) { rowt[r] = 0; rowg[r] = 0.f; } }
}
__device__ __forceinline__ void phase_gemm1(Frame& F, int l) {
    moe_tables(F, l);
    const LAS int* blk_end = (const LAS int*)(F.lds + LDS_X_OFF);
    pg8::Gemm g{(const bf16*)(F.ws + WS_H8), (const bf16*)(F.ws + WS_WGU + (size_t)l * 32 * 2048 * 2048), MOE_ROWS, 2048, 1024, WGU_E8M0};
    pg8::MoeOrderG S{F.bid, __builtin_amdgcn_readfirstlane(blk_end[31]), (const char*)g.A, (const char*)g.Bt, (size_t)256 * 2048, (size_t)2048 * 2048, (size_t)256 * 2048, blk_end, (const int*)(F.ws + MOEI_ROWT)};
#if FP8_GEMM2
    pg8::EpiSwiglu8 E{F.ws + WS_ACT, F.in[I_BGU] + (size_t)l * 32 * 2048};
    pg8::gemm_phase<pg8::EpiSwiglu8, pg8::MoeOrderG, true, true, true>(F.lds + RING_OFF, g, S, E);
#else
    pg8::EpiSwiglu E{(bf16*)(F.ws + WS_ACT), F.in[I_BGU] + (size_t)l * 32 * 2048};
    pg8::gemm_phase<pg8::EpiSwiglu, pg8::MoeOrderG, true, true, true>(F.lds + RING_OFF, g, S, E);
#endif
}
__device__ __forceinline__ void phase_gemm2(Frame& F, int l) {
    moe_tables(F, l);
    const LAS int* blk_end = (const LAS int*)(F.lds + LDS_X_OFF);
#if FP8_GEMM2
    pg8::Gemm g{(const bf16*)(F.ws + WS_ACT), (const bf16*)(F.ws + WS_WDN + (size_t)l * 32 * 2048 * 1024), MOE_ROWS, 2048, 512, WDN_E8M0};
    pg8::MoeOrderG S{F.bid, __builtin_amdgcn_readfirstlane(blk_end[31]), (const char*)g.A, (const char*)g.Bt, (size_t)256 * 1024, (size_t)2048 * 1024, (size_t)256 * 1024, blk_end, (const int*)(F.ws + MOEI_IDT)};
    pg8::EpiDown E{(bf16*)(F.ws + WS_YS), F.in[I_BDN] + (size_t)l * 32 * 2048, (const float*)(F.ws + MOEI_ROWG)};
    pg8::gemm_phase<pg8::EpiDown, pg8::MoeOrderG, true, true, true>(F.lds + RING_OFF, g, S, E);
#else
    pg8::Gemm g{(const bf16*)(F.ws + WS_ACT), (const bf16*)(F.ws + WS_WDN) + (size_t)l * 32 * 2048 * 1024, MOE_ROWS, 2048, 1024};
    pg8::MoeOrder S{F.bid, __builtin_amdgcn_readfirstlane(blk_end[31]), (const char*)g.A, (const char*)g.Bt, (size_t)256 * 1024 * 2, (size_t)2048 * 1024 * 2, (size_t)256 * 1024 * 2, blk_end, nullptr};
    pg8::EpiDown E{(bf16*)(F.ws + WS_YS), F.in[I_BDN] + (size_t)l * 32 * 2048, (const float*)(F.ws + MOEI_ROWG)};
    pg8::gemm_phase<pg8::EpiDown, pg8::MoeOrder, true, true>(F.lds + RING_OFF, g, S, E);
#endif
}
#ifndef PHASE_NORM2
#define PHASE_NORM2(F, l) phase_norm2(F, l)
#endif
#ifndef PHASE_SCATTER
#define PHASE_SCATTER(F, l) phase_scatter(F, l)
#endif
#ifndef PHASE_GEMM1
#define PHASE_GEMM1(F, l) phase_gemm1(F, l)
#endif
#ifndef PHASE_GEMM2
#define PHASE_GEMM2(F, l) phase_gemm2(F, l)
#endif
#define USE_MFMA_ATTN 1

__device__ __forceinline__ void attn_prep(Frame& F, int l) {
    bf16* P = (bf16*)(F.ws + WS_P);
    LAS unsigned short* vt = (LAS unsigned short*)F.lds;
    for (int ct = F.bid; ct < NCT; ct += F.G) {
        const int m0 = ct * 64; const bool lat = m0 < NLAT;
        __syncthreads();
        for (int i = F.tid; i < 64 * 32; i += NTHREADS) { const int tk = i >> 5, c8 = i & 31;
            const v4u w = *(const v4u*)(P + (size_t)(m0 + tk) * PW + PC_V + c8 * 8);
            const unsigned ww[4] = {w.x, w.y, w.z, w.w};
#pragma unroll
            for (int q = 0; q < 4; ++q) { vt[(c8 * 8 + 2 * q) * 66 + tk] = (unsigned short)(ww[q] & 0xffffu); vt[(c8 * 8 + 2 * q + 1) * 66 + tk] = (unsigned short)(ww[q] >> 16); } }
        if (lat) { const int tk = F.tid >> 3, kvh = (F.tid >> 1) & 3, hf = F.tid & 1; const int t = (m0 + tk) & 4095;
            bf16* kp = P + (size_t)(m0 + tk) * PW + PC_K + kvh * 64 + hf * 32;
            const v4u w0 = *(const v4u*)kp, w1 = *(const v4u*)(kp + 8), w2 = *(const v4u*)(kp + 16), w3 = *(const v4u*)(kp + 24);
            const unsigned lo[8] = {w0.x, w0.y, w0.z, w0.w, w1.x, w1.y, w1.z, w1.w}, hi_[8] = {w2.x, w2.y, w2.z, w2.w, w3.x, w3.y, w3.z, w3.w};
            const float pos = (float)(hf ? (t & 63) : (t >> 6)); unsigned o1[8], o2[8];
#pragma unroll
            for (int jj = 0; jj < 8; ++jj) { float r1[2], r2[2];
#pragma unroll
                for (int e = 0; e < 2; ++e) { const int j = 2 * jj + e; const float inv = __builtin_amdgcn_exp2f(-(float)j * 0.8304820237218406f); const float sn = __sinf(pos * inv), cs = __cosf(pos * inv);
                    const float x1 = e ? bfhi(lo[jj]) : bflo(lo[jj]), x2 = e ? bfhi(hi_[jj]) : bflo(hi_[jj]); r1[e] = x1 * cs - x2 * sn; r2[e] = x2 * cs + x1 * sn; }
                o1[jj] = pk2(r1[0], r1[1]); o2[jj] = pk2(r2[0], r2[1]); }
            *(v4u*)kp = (v4u){o1[0], o1[1], o1[2], o1[3]}; *(v4u*)(kp + 8) = (v4u){o1[4], o1[5], o1[6], o1[7]}; *(v4u*)(kp + 16) = (v4u){o2[0], o2[1], o2[2], o2[3]}; *(v4u*)(kp + 24) = (v4u){o2[4], o2[5], o2[6], o2[7]}; }
        __syncthreads();
        for (int i = F.tid; i < 256 * 8; i += NTHREADS) { const int col = i >> 3, c = i & 7, kvh = col >> 6, d = col & 63;
            v4u o; const LAS unsigned short* s = vt + col * 66 + c * 8;
            o.x = s[0] | ((unsigned)s[1] << 16); o.y = s[2] | ((unsigned)s[3] << 16); o.z = s[4] | ((unsigned)s[5] << 16); o.w = s[6] | ((unsigned)s[7] << 16);
            if (lat) { const int b = m0 >> 12, t0 = m0 & 4095; *(v4u*)((bf16*)(F.ws + WS_VT) + ((size_t)(b * 4 + kvh) * 64 + d) * SEQ + t0 + c * 8) = o; }
            else { const int mm = m0 - NLAT, b = mm >> 8, t0 = mm & 255; *(v4u*)((bf16*)(F.ws + WS_VTC) + ((size_t)(b * 4 + kvh) * 64 + d) * CTXL + t0 + c * 8) = o; } }
    }
    __syncthreads();
}

constexpr int AT_KP = 144, AT_VP = 136;
constexpr int AT_KOFF = 0, AT_VOFF = 64 * AT_KP, AT_TILE = 64 * AT_KP + 64 * AT_VP;
__device__ __forceinline__ void attn_unit(Frame& F, int l, int b, int kvh, int qi, int is_ctx) {
    const bf16* P = (const bf16*)(F.ws + WS_P); bf16* CC = (bf16*)(F.ws + WS_CC);
    int lane_o = F.lane; asm volatile("" : "+v"(lane_o));
    const int g = F.wave >> 1, qh = F.wave & 1, hq = kvh * 4 + g, r32 = lane_o & 31, hi = lane_o >> 5;
    const int rowbase = is_ctx ? NLAT + b * CTXL : b * SEQ;
    const int qa = qi * 128 + qh * 64;
    const float LOG2E = 1.4426950408889634f;
    bf16x8 qf[2][4];
#pragma unroll
    for (int qt = 0; qt < 2; ++qt) { const int tq = qa + 32 * qt + r32; const bf16* qp = P + (size_t)(rowbase + tq) * PW + PC_Q + hq * 64 + 8 * hi;
        float x[4][8];
#pragma unroll
        for (int s = 0; s < 4; ++s) { const v4u w = *(const v4u*)(qp + 16 * s); x[s][0] = bflo(w.x); x[s][1] = bfhi(w.x); x[s][2] = bflo(w.y); x[s][3] = bfhi(w.y); x[s][4] = bflo(w.z); x[s][5] = bfhi(w.z); x[s][6] = bflo(w.w); x[s][7] = bfhi(w.w); }
        if (!is_ctx) {
#pragma unroll
            for (int hf = 0; hf < 2; ++hf) { const float pos = (float)(hf ? (tq & 63) : (tq >> 6));
#pragma unroll
                for (int j = 0; j < 8; ++j) { const float inv = __builtin_amdgcn_exp2f(-(float)(8 * hi + j) * 0.8304820237218406f); const float sn = __sinf(pos * inv), cs = __cosf(pos * inv);
                    const float x1 = x[2 * hf][j], x2 = x[2 * hf + 1][j]; x[2 * hf][j] = x1 * cs - x2 * sn; x[2 * hf + 1][j] = x2 * cs + x1 * sn; } } }
        const float sc = 0.125f * LOG2E;
#pragma unroll
        for (int s = 0; s < 4; ++s) { v4u w; w.x = pk2(x[s][0] * sc, x[s][1] * sc); w.y = pk2(x[s][2] * sc, x[s][3] * sc); w.z = pk2(x[s][4] * sc, x[s][5] * sc); w.w = pk2(x[s][6] * sc, x[s][7] * sc); qf[qt][s] = __builtin_bit_cast(bf16x8, w); }
    }
    float mrun[2], lrun[2]; f32x16 O[2][2];
    { const float sk = F.in[I_SINK][l * 16 + hq] * LOG2E;
#pragma unroll
      for (int qt = 0; qt < 2; ++qt) { mrun[qt] = sk; lrun[qt] = hi ? 0.f : 1.f;
#pragma unroll
        for (int db = 0; db < 2; ++db)
#pragma unroll
            for (int r = 0; r < 16; ++r) O[qt][db][r] = 0.f; } }
    const int kt_lo = is_ctx ? 0 : (qi == 0 ? 2 : 0), nl = is_ctx ? 0 : (6 - (qi == 0 ? 2 : 0) - (qi == 31 ? 2 : 0)), ntile = nl + 4;
    const int rr = F.tid >> 3, cch = F.tid & 7;
    const bf16* kbase_l = P + (size_t)(b * SEQ + rr) * PW + PC_K + kvh * 64 + cch * 8; const bf16* kbase_c = P + (size_t)(NLAT + b * CTXL + rr) * PW + PC_K + kvh * 64 + cch * 8;
    const bf16* vbase_l = (const bf16*)(F.ws + WS_VT) + ((size_t)(b * 4 + kvh) * 64 + rr) * SEQ + cch * 8; const bf16* vbase_c = (const bf16*)(F.ws + WS_VTC) + ((size_t)(b * 4 + kvh) * 64 + rr) * CTXL + cch * 8;
    v4u kw, vw;
    { const bool loc0 = nl > 0; const int k00 = loc0 ? 128 * (qi - 1) + 64 * kt_lo : 0; kw = *(const v4u*)((loc0 ? kbase_l : kbase_c) + (size_t)k00 * PW); vw = *(const v4u*)((loc0 ? vbase_l : vbase_c) + k00); }
    LDS_BARRIER();
#pragma unroll 1
    for (int jt = 0; jt < ntile; ++jt) {
        const bool local = jt < nl; const int k0 = local ? 128 * (qi - 1) + 64 * (kt_lo + jt) : 64 * (jt - nl);
        const LAS unsigned char* KS = F.lds + (jt & 1) * AT_TILE + AT_KOFF; const LAS unsigned char* VS = F.lds + (jt & 1) * AT_TILE + AT_VOFF;
        { *(LAS v4u*)(F.lds + (jt & 1) * AT_TILE + AT_KOFF + rr * AT_KP + cch * 16) = kw;
          LAS v2u* vd = (LAS v2u*)(F.lds + (jt & 1) * AT_TILE + AT_VOFF + rr * AT_VP + cch * 16); vd[0] = (v2u){vw.x, vw.y}; vd[1] = (v2u){vw.z, vw.w}; }
        if (jt + 1 < ntile) { const bool ln = jt + 1 < nl; const int kn = ln ? 128 * (qi - 1) + 64 * (kt_lo + jt + 1) : 64 * (jt + 1 - nl);
            kw = *(const v4u*)((ln ? kbase_l : kbase_c) + (size_t)kn * PW); vw = *(const v4u*)((ln ? vbase_l : vbase_c) + kn); }
        LDS_BARRIER();
        if (local && (k0 + 63 < qa - 128 || k0 > qa + 63 + 128)) continue;
#pragma unroll 1
        for (int kb = 0; kb < 2; ++kb) {
            bf16x8 kf[4];
#pragma unroll
            for (int ss = 0; ss < 4; ++ss) kf[ss] = *(const LAS bf16x8*)(KS + (32 * kb + r32) * AT_KP + (16 * ss + 8 * hi) * 2);
            bf16x8 pb[2][2];
#pragma unroll
            for (int qt = 0; qt < 2; ++qt) { const int tq = qa + 32 * qt + r32;
                f32x16 s;
#pragma unroll
                for (int r = 0; r < 16; ++r) s[r] = 0.f;
#pragma unroll
                for (int ss = 0; ss < 4; ++ss) s = __builtin_amdgcn_mfma_f32_32x32x16_bf16(kf[ss], qf[qt][ss], s, 0, 0, 0);
                if (local) {
#pragma unroll
                    for (int r = 0; r < 16; ++r) { const int kidx = k0 + 32 * kb + (r & 3) + 8 * (r >> 2) + 4 * hi; const int dlt = kidx - tq; if (dlt > 128 || dlt < -128) s[r] = -1.0e30f; } }
                float mloc = s[0];
#pragma unroll
                for (int r = 1; r < 16; ++r) mloc = fmaxf(mloc, s[r]);
                mloc = fmaxf(mloc, __shfl_xor(mloc, 32));
                const float mnew = fmaxf(mrun[qt], mloc), alpha = __builtin_amdgcn_exp2f(mrun[qt] - mnew); mrun[qt] = mnew;
                float psum = 0.f;
#pragma unroll
                for (int r = 0; r < 16; ++r) { s[r] = __builtin_amdgcn_exp2f(s[r] - mnew); psum += s[r]; }
                lrun[qt] = lrun[qt] * alpha + psum;
#pragma unroll
                for (int db = 0; db < 2; ++db)
#pragma unroll
                    for (int r = 0; r < 16; ++r) O[qt][db][r] *= alpha;
#pragma unroll
                for (int s2 = 0; s2 < 2; ++s2) { v4u pw; pw.x = pk2(s[8 * s2 + 0], s[8 * s2 + 1]); pw.y = pk2(s[8 * s2 + 2], s[8 * s2 + 3]); pw.z = pk2(s[8 * s2 + 4], s[8 * s2 + 5]); pw.w = pk2(s[8 * s2 + 6], s[8 * s2 + 7]);
                    pb[qt][s2] = __builtin_bit_cast(bf16x8, pw); }
            }
#pragma unroll
            for (int s2 = 0; s2 < 2; ++s2)
#pragma unroll
                for (int db = 0; db < 2; ++db) { const LAS v2u* vp = (const LAS v2u*)(VS + (32 * db + r32) * AT_VP + (32 * kb + 16 * s2 + 4 * hi) * 2);
                    const v2u a0 = vp[0], a1 = vp[2]; v4u aw; aw.x = a0.x; aw.y = a0.y; aw.z = a1.x; aw.w = a1.y; const bf16x8 va = __builtin_bit_cast(bf16x8, aw);
                    O[0][db] = __builtin_amdgcn_mfma_f32_32x32x16_bf16(va, pb[0][s2], O[0][db], 0, 0, 0);
                    O[1][db] = __builtin_amdgcn_mfma_f32_32x32x16_bf16(va, pb[1][s2], O[1][db], 0, 0, 0); }
        }
    }
    int r32e = r32, hie = hi; asm volatile("" : "+v"(r32e), "+v"(hie));
#pragma unroll
    for (int qt = 0; qt < 2; ++qt) { const float lt = lrun[qt] + __shfl_xor(lrun[qt], 32); const float rl = 1.0f / lt; const int tq = qa + 32 * qt + r32e;
        bf16* op = CC + (size_t)(rowbase + tq) * DM + hq * 64 + 4 * hie;
#pragma unroll
        for (int db = 0; db < 2; ++db)
#pragma unroll
            for (int rq = 0; rq < 4; ++rq) { v2u w; w.x = pk2(O[qt][db][4 * rq] * rl, O[qt][db][4 * rq + 1] * rl); w.y = pk2(O[qt][db][4 * rq + 2] * rl, O[qt][db][4 * rq + 3] * rl);
                *(v2u*)(op + 32 * db + 8 * rq) = w; } }
}
__device__ __forceinline__ void attn_phase(Frame& F, int l, int rep = 0) {
    const int nunits = 512 + (l == 0 ? 32 : 0);
    LAS int* slot = (LAS int*)(F.lds + LDS_X_OFF + 512);
    for (;;) {
        __syncthreads();
        if (F.tid == 0) *slot = (int)__hip_atomic_fetch_add(F.ctl + CW_ATQ + 64 * l + 8 * rep, 1u, RLX_AGENT);
        __syncthreads();
        const int u = __builtin_amdgcn_readfirstlane(*slot);
        if (u >= nunits) break;
        if (u < 512) attn_unit(F, l, u >> 7, (u >> 5) & 3, u & 31, 0); else { const int v = u - 512; attn_unit(F, l, v >> 3, (v >> 1) & 3, v & 1, 1); }
    }
}
#define USE_CHUNK_DN 1
#ifndef DN_SPLIT
#define DN_SPLIT 2
#endif
#ifndef DN_REP_S1
#define DN_REP_S1 1
#endif
#ifndef DN_REP_S3B
#define DN_REP_S3B 1
#endif
#ifndef DN_REP_S3A
#define DN_REP_S3A 1
#endif
#ifndef DN_REP_S4
#define DN_REP_S4 1
#endif

constexpr int DN_F_NEGW = 0, DN_F_QG = 16, DN_F_QK = 32, DN_F_KGT = 40, DN_NFRAG = 56, DN_U_OFF = 57344;
constexpr int DP_QS = 0, DP_KS = 17408, DP_VS = 34816, DP_AS = 52224  , DP_TB = 69632, DP_TW = 78848, DP_QK = 88064, DP_RAW = 52224  , DP_SC = 104960, DP_TF = 106496  , DP_XS = 123904  ;
constexpr int DP_P = 272, DP_P2 = 144;
__device__ __forceinline__ int dn_rec(int b, int h, int dir, int np) { return ((b * 4 + h) * 2 + dir) * 68 + np; }
__device__ __forceinline__ void dn_chunk_of(int ct, int dir, int& b, int& np) { if (ct < 256) { b = ct >> 6; const int c = ct & 63; np = 4 + (dir ? 63 - c : c); } else { b = (ct - 256) >> 2; const int c = (ct - 256) & 3; np = dir ? 3 - c : c; } }
__device__ __forceinline__ unsigned short lds_u16(const LAS unsigned char* p) { return *(const LAS unsigned short*)p; }

__device__ __forceinline__ void dn_prep_unit(Frame& F, int l, int ct, int h, int dir) {
    const bf16* P = (const bf16*)(F.ws + WS_P);
    int lane = F.lane; asm volatile("" : "+v"(lane));
    const int wave = F.wave, i16 = lane & 15, q = lane >> 4;
    const int m0 = ct * 64; int t0, T, base; seq_of(m0, t0, T, base);
    int b, np; dn_chunk_of(ct, dir, b, np);
    unsigned char* tile = F.ws + WS_DNT + (size_t)dn_rec(b, h, dir, np) * DNT_BYTES;
    LAS unsigned char* L = F.lds;
    LAS float* SC = (LAS float*)(L + DP_SC);
    LDS_BARRIER();
    {
        const float* cw = F.in[I_DNCW] + (size_t)l * 4 * 1536;
        LAS float* cwl = (LAS float*)(L + DP_TF);
        for (int i = F.tid; i < 3 * 4 * 128; i += NTHREADS) { const int part = i >> 9, j = (i >> 7) & 3, ch = i & 127; cwl[i] = cw[j * 1536 + part * 512 + h * 128 + ch]; }
        unsigned short pbw = 0, paw = 0;
        if (wave == 0) { const int tok = dir ? 63 - lane : lane; pbw = P[(size_t)(m0 + tok) * PW + PC_BETA + dir * 4 + h]; paw = P[(size_t)(m0 + tok) * PW + PC_DEC + dir * 4 + h]; }
        for (int c = F.tid; c < 67 * 48; c += NTHREADS) { const int row = c / 48, ch = c % 48, part = ch >> 4, cc = ch & 15, tt = t0 + row - 2;
            v4u v = (v4u){0u, 0u, 0u, 0u};
            if (tt >= 0 && tt < T) v = *(const v4u*)(P + (size_t)(base + tt) * PW + PC_DQ + part * 512 + h * 128 + cc * 8);
            *(LAS v4u*)(L + DP_RAW + row * 784 + part * 256 + cc * 16) = v; }
        LDS_BARRIER();
#pragma unroll 1
        for (int rep = 0; rep < DN_REP_S1; ++rep)
#pragma unroll
        for (int part = 0; part < 3; ++part) { const int tok = F.tid >> 3, g8 = F.tid & 7;
            float sv[16];
#pragma unroll
            for (int k = 0; k < 16; ++k) sv[k] = 0.f;
#pragma unroll
            for (int j = 0; j < 4; ++j) { const LAS v4u* rp = (const LAS v4u*)(L + DP_RAW + (tok + j) * 784 + part * 256 + g8 * 32); const v4u r0 = rp[0], r1 = rp[1];
                const LAS f32x4* wp = (const LAS f32x4*)(cwl + (part * 4 + j) * 128 + g8 * 16); const f32x4 w0 = wp[0], w1 = wp[1], w2 = wp[2], w3 = wp[3];
                sv[0] += w0.x * bflo(r0.x); sv[1] += w0.y * bfhi(r0.x); sv[2] += w0.z * bflo(r0.y); sv[3] += w0.w * bfhi(r0.y); sv[4] += w1.x * bflo(r0.z); sv[5] += w1.y * bfhi(r0.z); sv[6] += w1.z * bflo(r0.w); sv[7] += w1.w * bfhi(r0.w);
                sv[8] += w2.x * bflo(r1.x); sv[9] += w2.y * bfhi(r1.x); sv[10] += w2.z * bflo(r1.y); sv[11] += w2.w * bfhi(r1.y); sv[12] += w3.x * bflo(r1.z); sv[13] += w3.y * bfhi(r1.z); sv[14] += w3.z * bflo(r1.w); sv[15] += w3.w * bfhi(r1.w); }
            float ss = 0.f;
#pragma unroll
            for (int k = 0; k < 16; ++k) { sv[k] = siluf_(sv[k]); ss += sv[k] * sv[k]; }
            if (part < 2) { ss += dpp_mov<0xB1>(ss); ss += dpp_mov<0x4E>(ss); ss += dpp_mov<0x141>(ss);
                const float f = (part == 0 ? 0.08838834764831845f : 1.0f) * __builtin_amdgcn_rsqf(ss + EPS);
#pragma unroll
                for (int k = 0; k < 16; ++k) sv[k] *= f; }
            LAS v4u* op = (LAS v4u*)(L + (part == 0 ? DP_QS : (part == 1 ? DP_KS : DP_VS)) + tok * DP_P + g8 * 32);
            op[0] = (v4u){pk2(sv[0], sv[1]), pk2(sv[2], sv[3]), pk2(sv[4], sv[5]), pk2(sv[6], sv[7])}; op[1] = (v4u){pk2(sv[8], sv[9]), pk2(sv[10], sv[11]), pk2(sv[12], sv[13]), pk2(sv[14], sv[15])}; }
        if (wave == 0) {
            const float pb = bf2f(pbw), pa = bf2f(paw);
            const float beta = sigmoidf_(pb); float gc = -__expf(F.in[I_DNALOG][l * 8 + dir * 4 + h]) * softplusf_(pa + F.in[I_DNDT][l * 8 + dir * 4 + h]);
#pragma unroll
            for (int o = 1; o < 64; o <<= 1) { const float v = __shfl_up(gc, o); if (lane >= o) gc += v; }
            const float glast = __shfl(gc, 63);
            SC[lane] = beta; SC[64 + lane] = gc; SC[128 + lane] = __expf(gc); SC[192 + lane] = __expf(glast - gc);
            if (lane == 63) ((float*)(F.ws + WS_DNS))[dn_rec(b, h, dir, np)] = __expf(glast);
        }
    }
    LDS_BARRIER();
#define DN_TOK(r) (dir ? 63 - (r) : (r))
#pragma unroll 1
    for (int rep = 0; rep < DN_REP_S3A; ++rep)
    {
        const int mb = wave & 3, which = wave >> 2;
        f32x4 acc[4];
#pragma unroll
        for (int nb = 0; nb < 4; ++nb) acc[nb] = (f32x4){0.f, 0.f, 0.f, 0.f};
        const LAS unsigned char* arow = L + (which ? DP_QS : DP_KS) + DN_TOK(16 * mb + i16) * DP_P + 16 * q;
#pragma unroll
        for (int ks = 0; ks < 4; ++ks) { const bf16x8 a = *(const LAS bf16x8*)(arow + 64 * ks);
#pragma unroll
            for (int nb = 0; nb < 4; ++nb) { const bf16x8 bb = *(const LAS bf16x8*)(L + DP_KS + DN_TOK(16 * nb + i16) * DP_P + 16 * q + 64 * ks);
                acc[nb] = __builtin_amdgcn_mfma_f32_16x16x32_bf16(a, bb, acc[nb], 0, 0, 0); } }
#pragma unroll
        for (int nb = 0; nb < 4; ++nb)
#pragma unroll
            for (int i = 0; i < 4; ++i) { const int r = 16 * mb + 4 * q + i, c = 16 * nb + i16; const float dec = __expf(SC[64 + r] - SC[64 + c]);
                if (which == 0) ((LAS float*)(L + DP_AS))[r * 68 + c] = (r > c) ? SC[r] * acc[nb][i] * dec : 0.f;
                else *(LAS unsigned short*)(L + DP_QK + r * DP_P2 + c * 2) = (unsigned short)f2bf((r >= c) ? acc[nb][i] * dec : 0.f); }
    }
    LDS_BARRIER();
#pragma unroll 1
    for (int rep = 0; rep < DN_REP_S3B; ++rep) {
    if (wave == 0) {
        const LAS float* As = (const LAS float*)(L + DP_AS); LAS float* Tf = (LAS float*)(L + DP_TF);
        const int g = lane >> 4, c = lane & 15;
        f32x4 ar[16][4];
#pragma unroll
        for (int r = 1; r < 16; ++r)
#pragma unroll
            for (int j4 = 0; j4 < (r + 3) / 4; ++j4) ar[r][j4] = *(const LAS f32x4*)(As + (16 * g + r) * 68 + 16 * g + 4 * j4);
        float t[16];
#pragma unroll
        for (int r = 0; r < 16; ++r) { float a0 = (c == r) ? 1.f : 0.f, a1 = 0.f;
#pragma unroll
            for (int j = 0; j < r; ++j) { const float av = ar[r][j >> 2][j & 3]; if (j & 1) a1 -= av * t[j]; else a0 -= av * t[j]; }
            t[r] = a0 + a1; Tf[(16 * g + r) * 68 + 16 * g + c] = t[r]; }
    }
    LDS_BARRIER();
    if (wave < 3) {
        const LAS float* As = (const LAS float*)(L + DP_AS); LAS float* Tf = (LAS float*)(L + DP_TF); LAS float* Xs = (LAS float*)(L + DP_XS) + wave * 272;
        const int J = wave;
#pragma unroll 1
        for (int I = J + 1; I < 4; ++I) {
            f32x4 acc = {0.f, 0.f, 0.f, 0.f};
#pragma unroll 1
            for (int K = J; K < I; ++K)
#pragma unroll
                for (int sk = 0; sk < 4; ++sk) acc = __builtin_amdgcn_mfma_f32_16x16x4f32(As[(16 * I + i16) * 68 + 16 * K + 4 * sk + q], Tf[(16 * K + 4 * sk + q) * 68 + 16 * J + i16], acc, 0, 0, 0);
#pragma unroll
            for (int i = 0; i < 4; ++i) Xs[(4 * q + i) * 17 + i16] = acc[i];
            LDS_WAIT(); asm volatile("" ::: "memory");
            f32x4 acc2 = {0.f, 0.f, 0.f, 0.f};
#pragma unroll
            for (int sk = 0; sk < 4; ++sk) acc2 = __builtin_amdgcn_mfma_f32_16x16x4f32(Tf[(16 * I + i16) * 68 + 16 * I + 4 * sk + q], Xs[(4 * sk + q) * 17 + i16], acc2, 0, 0, 0);
#pragma unroll
            for (int i = 0; i < 4; ++i) Tf[(16 * I + 4 * q + i) * 68 + 16 * J + i16] = -acc2[i];
            LDS_WAIT(); asm volatile("" ::: "memory");
        }
    }
    LDS_BARRIER();
    { const LAS float* Tf = (const LAS float*)(L + DP_TF); const int r = F.tid >> 3, c0 = (F.tid & 7) * 8; float vb[8], vw[8];
#pragma unroll
      for (int k = 0; k < 8; ++k) { const int c = c0 + k; const float v = ((r >> 4) >= (c >> 4)) ? Tf[r * 68 + c] : 0.f; const float bl = SC[c]; vb[k] = v * bl; vw[k] = vb[k] * SC[128 + c]; }
      v4u ob, ow; ob.x = pk2(vb[0], vb[1]); ob.y = pk2(vb[2], vb[3]); ob.z = pk2(vb[4], vb[5]); ob.w = pk2(vb[6], vb[7]); ow.x = pk2(vw[0], vw[1]); ow.y = pk2(vw[2], vw[3]); ow.z = pk2(vw[4], vw[5]); ow.w = pk2(vw[6], vw[7]);
      *(LAS v4u*)(L + DP_TB + r * DP_P2 + c0 * 2) = ob; *(LAS v4u*)(L + DP_TW + r * DP_P2 + c0 * 2) = ow; }
    }
    LDS_BARRIER();
    {
        const int nbp = wave & 3, which = wave >> 2;
        f32x4 acc[4][2];
#pragma unroll
        for (int mb = 0; mb < 4; ++mb) { acc[mb][0] = (f32x4){0.f, 0.f, 0.f, 0.f}; acc[mb][1] = (f32x4){0.f, 0.f, 0.f, 0.f}; }
#pragma unroll
        for (int ks = 0; ks < 2; ++ks) {
            bf16x8 bb[2];
#pragma unroll
            for (int nn = 0; nn < 2; ++nn) { const int n = 16 * (2 * nbp + nn) + i16; unsigned short e[8];
#pragma unroll
                for (int jj = 0; jj < 8; ++jj) e[jj] = lds_u16(L + (which ? DP_KS : DP_VS) + DN_TOK(32 * ks + 8 * q + jj) * DP_P + n * 2);
                v4u w; w.x = e[0] | ((unsigned)e[1] << 16); w.y = e[2] | ((unsigned)e[3] << 16); w.z = e[4] | ((unsigned)e[5] << 16); w.w = e[6] | ((unsigned)e[7] << 16); bb[nn] = __builtin_bit_cast(bf16x8, w); }
#pragma unroll
            for (int mb = 0; mb < 4; ++mb) { const bf16x8 a = *(const LAS bf16x8*)(L + (which ? DP_TW : DP_TB) + (16 * mb + i16) * DP_P2 + 64 * ks + 16 * q);
                acc[mb][0] = __builtin_amdgcn_mfma_f32_16x16x32_bf16(a, bb[0], acc[mb][0], 0, 0, 0); acc[mb][1] = __builtin_amdgcn_mfma_f32_16x16x32_bf16(a, bb[1], acc[mb][1], 0, 0, 0); } }
        if (which == 0) {
#pragma unroll
            for (int mb = 0; mb < 4; ++mb)
#pragma unroll
                for (int nn = 0; nn < 2; ++nn) *(f32x4*)(tile + DN_U_OFF + (size_t)((((2 * nbp + nn) * 4 + mb) * 64 + lane) * 16)) = acc[mb][nn];
        } else {
#pragma unroll
            for (int mb = 0; mb < 4; ++mb)
#pragma unroll
                for (int nn = 0; nn < 2; ++nn)
#pragma unroll
                    for (int i = 0; i < 4; ++i) *(LAS unsigned short*)(L + DP_AS + (16 * mb + 4 * q + i) * DP_P + (16 * (2 * nbp + nn) + i16) * 2) = (unsigned short)f2bf(-acc[mb][nn][i]);
        }
    }
    LDS_BARRIER();
#pragma unroll 1
    for (int rep = 0; rep < DN_REP_S4; ++rep)
#pragma unroll 1
    for (int fi = 0; fi < 7; ++fi) { const int f = wave * 7 + fi; v4u o;
        if (f < DN_F_QG) { const int mb = f >> 2, ks = f & 3; const LAS unsigned char* rp = L + DP_AS + (16 * mb + i16) * DP_P + (32 * ks + 4 * q) * 2;
            const v2u a = *(const LAS v2u*)rp, c = *(const LAS v2u*)(rp + 32); o.x = a.x; o.y = a.y; o.z = c.x; o.w = c.y; }
        else if (f < DN_F_QK) { const int ff = f - DN_F_QG, mb = ff >> 2, ks = ff & 3, r = 16 * mb + i16; const LAS unsigned char* rp = L + DP_QS + DN_TOK(r) * DP_P + (32 * ks + 4 * q) * 2; const float eg = SC[128 + r];
            const v2u a = *(const LAS v2u*)rp, c = *(const LAS v2u*)(rp + 32);
            o.x = pk2(bflo(a.x) * eg, bfhi(a.x) * eg); o.y = pk2(bflo(a.y) * eg, bfhi(a.y) * eg); o.z = pk2(bflo(c.x) * eg, bfhi(c.x) * eg); o.w = pk2(bflo(c.y) * eg, bfhi(c.y) * eg); }
        else if (f < DN_F_KGT) { const int ff = f - DN_F_QK, mb = ff >> 1, ks = ff & 1; const LAS unsigned char* rp = L + DP_QK + (16 * mb + i16) * DP_P2 + (32 * ks + 4 * q) * 2;
            const v2u a = *(const LAS v2u*)rp, c = *(const LAS v2u*)(rp + 32); o.x = a.x; o.y = a.y; o.z = c.x; o.w = c.y; }
        else { const int ff = f - DN_F_KGT, mb = ff >> 1, ks = ff & 1, dk = 16 * mb + i16; float e[8];
#pragma unroll
            for (int jj = 0; jj < 8; ++jj) { const int key = 32 * ks + 16 * (jj >> 2) + 4 * q + (jj & 3); e[jj] = bf2f(lds_u16(L + DP_KS + DN_TOK(key) * DP_P + dk * 2)) * SC[192 + key]; }
            o.x = pk2(e[0], e[1]); o.y = pk2(e[2], e[3]); o.z = pk2(e[4], e[5]); o.w = pk2(e[6], e[7]); }
        *(v4u*)(tile + (size_t)f * 1024 + lane * 16) = o; }
#undef DN_TOK
}
__device__ __forceinline__ void dn_prep(Frame& F, int l) {
    for (int u = F.bid; u < NCT * 4 * 2; u += F.G) dn_prep_unit(F, l, u >> 3, (u >> 1) & 3, u & 1);
    __syncthreads();
}

__device__ __forceinline__ void dn_scan(Frame& F, int l, int b, int h, int dir, int half) {
    int lane = F.lane; asm volatile("" : "+v"(lane));
    const int w = (DN_SPLIT == 2) ? half * 4 + (F.wave & 3) : F.wave, i16 = lane & 15, q = lane >> 4; const bool active = (DN_SPLIT == 2) ? (F.wave < 4) : true;
    const unsigned char* tiles = F.ws + WS_DNT + (size_t)dn_rec(b, h, dir, 0) * DNT_BYTES;
    const float* egl = (const float*)(F.ws + WS_DNS) + dn_rec(b, h, dir, 0);
    float* O = (float*)(F.ws + WS_DNO);
    LAS unsigned char* L = F.lds;
    f32x4 S[8];
#pragma unroll
    for (int i = 0; i < 8; ++i) S[i] = (f32x4){0.f, 0.f, 0.f, 0.f};
    v4u st[7]; f32x4 un[4];
#pragma unroll
    for (int mb = 0; mb < 4; ++mb) un[mb] = *(const f32x4*)(tiles + DN_U_OFF + (size_t)(((w * 4 + mb) * 64 + lane) * 16));
    LDS_BARRIER();
#pragma unroll
    for (int i = 0; i < 7; ++i) st[i] = *(const v4u*)(tiles + (size_t)(F.tid + i * NTHREADS) * 16);
#pragma unroll
    for (int i = 0; i < 7; ++i) *(LAS v4u*)(L + (F.tid + i * NTHREADS) * 16) = st[i];
#pragma unroll
    for (int i = 0; i < 7; ++i) st[i] = *(const v4u*)(tiles + DNT_BYTES + (size_t)(F.tid + i * NTHREADS) * 16);
    LDS_BARRIER();
#pragma unroll 1
    for (int n = 0; n < 68; ++n) {
        const unsigned char* tile = tiles + (size_t)n * DNT_BYTES; const LAS unsigned char* cur = L + (n & 1) * 57344;
        if (n + 1 < 68) {
#pragma unroll
            for (int i = 0; i < 7; ++i) *(LAS v4u*)(L + ((n + 1) & 1) * 57344 + (F.tid + i * NTHREADS) * 16) = st[i]; }
        if (n + 2 < 68) {
#pragma unroll
            for (int i = 0; i < 7; ++i) st[i] = *(const v4u*)(tile + 2 * DNT_BYTES + (size_t)(F.tid + i * NTHREADS) * 16); }
        if (active) {
        f32x4 vn[4];
#pragma unroll
        for (int mb = 0; mb < 4; ++mb) vn[mb] = un[mb];
        if (n + 1 < 68) {
#pragma unroll
            for (int mb = 0; mb < 4; ++mb) un[mb] = *(const f32x4*)(tile + DNT_BYTES + DN_U_OFF + (size_t)(((w * 4 + mb) * 64 + lane) * 16)); }
        const float el = egl[n];
        bf16x8 bS[4];
#pragma unroll
        for (int ks = 0; ks < 4; ++ks) { v4u x; x.x = pk2(S[2 * ks][0], S[2 * ks][1]); x.y = pk2(S[2 * ks][2], S[2 * ks][3]); x.z = pk2(S[2 * ks + 1][0], S[2 * ks + 1][1]); x.w = pk2(S[2 * ks + 1][2], S[2 * ks + 1][3]); bS[ks] = __builtin_bit_cast(bf16x8, x); }
        f32x4 o[4];
#pragma unroll
        for (int mb = 0; mb < 4; ++mb) { o[mb] = (f32x4){0.f, 0.f, 0.f, 0.f};
#pragma unroll
            for (int ks = 0; ks < 4; ++ks) { const bf16x8 aw = *(const LAS bf16x8*)(cur + (DN_F_NEGW + mb * 4 + ks) * 1024 + lane * 16), aq = *(const LAS bf16x8*)(cur + (DN_F_QG + mb * 4 + ks) * 1024 + lane * 16);
                vn[mb] = __builtin_amdgcn_mfma_f32_16x16x32_bf16(aw, bS[ks], vn[mb], 0, 0, 0); o[mb] = __builtin_amdgcn_mfma_f32_16x16x32_bf16(aq, bS[ks], o[mb], 0, 0, 0); } }
        bf16x8 bV[2];
#pragma unroll
        for (int ks = 0; ks < 2; ++ks) { v4u x; x.x = pk2(vn[2 * ks][0], vn[2 * ks][1]); x.y = pk2(vn[2 * ks][2], vn[2 * ks][3]); x.z = pk2(vn[2 * ks + 1][0], vn[2 * ks + 1][1]); x.w = pk2(vn[2 * ks + 1][2], vn[2 * ks + 1][3]); bV[ks] = __builtin_bit_cast(bf16x8, x); }
#pragma unroll
        for (int mb = 0; mb < 8; ++mb) { S[mb] = S[mb] * el;
#pragma unroll
            for (int ks = 0; ks < 2; ++ks) { const bf16x8 ak = *(const LAS bf16x8*)(cur + (DN_F_KGT + mb * 2 + ks) * 1024 + lane * 16); S[mb] = __builtin_amdgcn_mfma_f32_16x16x32_bf16(ak, bV[ks], S[mb], 0, 0, 0); } }
#pragma unroll
        for (int mb = 0; mb < 4; ++mb)
#pragma unroll
            for (int ks = 0; ks < 2; ++ks) { const bf16x8 aqk = *(const LAS bf16x8*)(cur + (DN_F_QK + mb * 2 + ks) * 1024 + lane * 16); o[mb] = __builtin_amdgcn_mfma_f32_16x16x32_bf16(aqk, bV[ks], o[mb], 0, 0, 0); }
        { int m0; if (n < 4) m0 = NLAT + b * CTXL + 64 * (dir ? 3 - n : n); else m0 = b * SEQ + 64 * (dir ? 63 - (n - 4) : (n - 4));
#pragma unroll
          for (int mb = 0; mb < 4; ++mb)
#pragma unroll
            for (int i = 0; i < 4; ++i) { const int r = 16 * mb + 4 * q + i, tok = dir ? 63 - r : r; O[((size_t)dir * NTOK + m0 + tok) * 512 + h * 128 + 16 * w + i16] = o[mb][i]; } }
        }
        LDS_BARRIER();
    }
}
#define USE_CHUNK_LRU 1

constexpr int LR_XF = 0  , LR_XB = 16640  , LR_WT = 25856  , LR_AA = 62720  , LR_UU = 96000  , LR_END = 129280;
constexpr size_t WS_LCA = WS_LRC, WS_LCH = WS_LRC + 2 * MiB, WS_LCI = WS_LRC + 4 * MiB;
__device__ __forceinline__ void lru_prep(Frame& F, int l) {
    const bf16* P = (const bf16*)(F.ws + WS_P);
    int lane = F.lane; asm volatile("" : "+v"(lane));
    const int wave = F.wave, i16 = lane & 15, q = lane >> 4, nb = F.bid & 7;
    LAS unsigned char* L = F.lds;
    LAS float* XF = (LAS float*)(L + LR_XF); LAS float* AA = (LAS float*)(L + LR_AA); LAS float* UU = (LAS float*)(L + LR_UU);
    bf16* HL = (bf16*)(F.ws + WS_LRH); bf16* AC = (bf16*)(F.ws + WS_LRA);
    __syncthreads();
    for (int e = F.tid; e < 4 * 4096; e += NTHREADS) { const int mat = e >> 12, ii = (e >> 6) & 63, j = e & 63, dir = mat >> 1;
        const float w = (mat & 1 ? F.in[I_LRWI] : F.in[I_LRWR])[((size_t)((l * 2 + dir) * 8 + nb)) * 4096 + ii * 64 + j];
        *(LAS unsigned short*)(L + LR_WT + (mat * 64 + j) * 144 + ii * 2) = (unsigned short)f2bf(w); }
    float cwv[4][8], cbv[8];
    { const int c8 = (F.tid & 7) * 8, ch0 = nb * 64 + c8; const float* cb = F.in[I_LRCB] + l * 512 + ch0; const float* cw = F.in[I_LRCW] + (size_t)l * 4 * 512 + ch0;
#pragma unroll
      for (int k = 0; k < 8; ++k) cbv[k] = cb[k];
#pragma unroll
      for (int j = 0; j < 4; ++j)
#pragma unroll
        for (int k = 0; k < 8; ++k) cwv[j][k] = cw[j * 512 + k]; }
    float gbr[4], gbi[4], gls[4];
    { const int dir = wave >> 2;
#pragma unroll
      for (int n = 0; n < 4; ++n) { const int ch = nb * 64 + 16 * n + i16; gbr[n] = F.in[I_LRBR][(l * 2 + dir) * 512 + ch]; gbi[n] = F.in[I_LRBI][(l * 2 + dir) * 512 + ch]; gls[n] = -softplusf_(-F.in[I_LRLAM][(l * 2 + dir) * 512 + ch]); } }
    v4u wv[4];
#define LR_LOADRAW(ctx) do { const int _m0 = (ctx) * 64; int _t0, _T, _base; seq_of(_m0, _t0, _T, _base); const int _tok = F.tid >> 3, _ch0 = nb * 64 + (F.tid & 7) * 8; \
        _Pragma("unroll") for (int j = 0; j < 4; ++j) { const int tt = _t0 + _tok + j - 2; wv[j] = (v4u){0u, 0u, 0u, 0u}; if (tt >= 0 && tt < _T) wv[j] = *(const v4u*)(P + (size_t)(_base + tt) * PW + PC_LX + _ch0); } } while (0)
    if ((F.bid >> 3) < NCT) LR_LOADRAW(F.bid >> 3);
    for (int ct = F.bid >> 3; ct < NCT; ct += F.G >> 3) {
        const int m0 = ct * 64;
        LDS_BARRIER();
        { const int tok = F.tid >> 3, c8 = (F.tid & 7) * 8, ch0 = nb * 64 + c8; float s[8];
#pragma unroll
          for (int k = 0; k < 8; ++k) s[k] = cbv[k];
#pragma unroll
          for (int j = 0; j < 4; ++j) { const v4u w = wv[j];
              s[0] += cwv[j][0] * bflo(w.x); s[1] += cwv[j][1] * bfhi(w.x); s[2] += cwv[j][2] * bflo(w.y); s[3] += cwv[j][3] * bfhi(w.y); s[4] += cwv[j][4] * bflo(w.z); s[5] += cwv[j][5] * bfhi(w.z); s[6] += cwv[j][6] * bflo(w.w); s[7] += cwv[j][7] * bfhi(w.w); }
#pragma unroll
          for (int k = 0; k < 8; ++k) XF[tok * 65 + c8 + k] = s[k];
          v4u o; o.x = pk2(s[0], s[1]); o.y = pk2(s[2], s[3]); o.z = pk2(s[4], s[5]); o.w = pk2(s[6], s[7]); *(LAS v4u*)(L + LR_XB + tok * 144 + c8 * 2) = o; }
        if (ct + (F.G >> 3) < NCT) LR_LOADRAW(ct + (F.G >> 3));
        LDS_BARRIER();
        { const int dir = wave >> 2, mb = wave & 3;
          f32x4 ar[4], ai[4];
#pragma unroll
          for (int n = 0; n < 4; ++n) { ar[n] = (f32x4){0.f, 0.f, 0.f, 0.f}; ai[n] = (f32x4){0.f, 0.f, 0.f, 0.f}; }
#pragma unroll
          for (int ks = 0; ks < 2; ++ks) { const bf16x8 a = *(const LAS bf16x8*)(L + LR_XB + (16 * mb + i16) * 144 + 64 * ks + 16 * q);
#pragma unroll
              for (int n = 0; n < 4; ++n) { const bf16x8 br = *(const LAS bf16x8*)(L + LR_WT + ((dir * 2 + 0) * 64 + 16 * n + i16) * 144 + 64 * ks + 16 * q), bi = *(const LAS bf16x8*)(L + LR_WT + ((dir * 2 + 1) * 64 + 16 * n + i16) * 144 + 64 * ks + 16 * q);
                  ar[n] = __builtin_amdgcn_mfma_f32_16x16x32_bf16(a, br, ar[n], 0, 0, 0); ai[n] = __builtin_amdgcn_mfma_f32_16x16x32_bf16(a, bi, ai[n], 0, 0, 0); } }
#pragma unroll
          for (int n = 0; n < 4; ++n) { const int j = 16 * n + i16; const float br_ = gbr[n], bi_ = gbi[n], logsig = gls[n];
#pragma unroll
              for (int i = 0; i < 4; ++i) { const int tok = 16 * mb + 4 * q + i; const float r = sigmoidf_(ar[n][i] + br_), ig = sigmoidf_(ai[n][i] + bi_);
                  const float log_a = 8.0f * r * logsig, a = __expf(log_a), y2 = 2.0f * log_a;
                  const float om = (y2 > -0.1f) ? -y2 * (1.0f + y2 * (0.5f + y2 * (0.16666667f + y2 * 0.041666668f))) : 1.0f - __expf(y2);
                  const float u = __builtin_amdgcn_sqrtf(om) * (ig * XF[tok * 65 + j]);
                  AA[(dir * 64 + tok) * 65 + j] = a; UU[(dir * 64 + tok) * 65 + j] = u; } } }
        LDS_BARRIER();
        if (F.tid < 128) { const int dir = F.tid >> 6, j = F.tid & 63, ch = nb * 64 + j; float h = 0.f, ac = 1.f;
            long o = (long)(((size_t)dir * NTOK + m0 + (dir ? 63 : 0)) * 512 + ch); const long ostep = dir ? -512 : 512;
#pragma unroll 1
            for (int s0 = 0; s0 < 64; s0 += 8) { float av[8], uv[8];
#pragma unroll
                for (int k = 0; k < 8; ++k) { const int tok = dir ? 63 - (s0 + k) : (s0 + k); av[k] = AA[(dir * 64 + tok) * 65 + j]; uv[k] = UU[(dir * 64 + tok) * 65 + j]; }
#pragma unroll
                for (int k = 0; k < 8; ++k) { h = av[k] * h + uv[k]; ac *= av[k]; HL[o] = (bf16)f2bf(h); AC[o] = (bf16)f2bf(ac); o += ostep; } }
            ((float*)(F.ws + WS_LCA))[((size_t)dir * NCT + ct) * 512 + ch] = ac; ((float*)(F.ws + WS_LCH))[((size_t)dir * NCT + ct) * 512 + ch] = h; }
    }
    LDS_BARRIER();
}
__device__ __forceinline__ void lru_carry(Frame& F, int idx) {
    const int ch = idx & 511, dir = (idx >> 9) & 1, b = idx >> 10;
    const float* CA = (const float*)(F.ws + WS_LCA); const float* CH = (const float*)(F.ws + WS_LCH); float* CI = (float*)(F.ws + WS_LCI);
    float h = 0.f;
#pragma unroll 4
    for (int n = 0; n < 68; ++n) { const int ct = n < 4 ? 256 + b * 4 + (dir ? 3 - n : n) : b * 64 + (dir ? 63 - (n - 4) : (n - 4)); const size_t o = ((size_t)dir * NCT + ct) * 512 + ch;
        CI[o] = h; h = CA[o] * h + CH[o]; }
}
__device__ __forceinline__ void lru_fin(Frame& F, int l) {
    const int nrows = (l == 0) ? NTOK : NLAT;
    const bf16* P = (const bf16*)(F.ws + WS_P); bf16* CC = (bf16*)(F.ws + WS_CC);
    const bf16* HL = (const bf16*)(F.ws + WS_LRH); const bf16* AC = (const bf16*)(F.ws + WS_LRA); const float* CI = (const float*)(F.ws + WS_LCI);
    for (size_t i = (size_t)F.bid * NTHREADS + F.tid; i < (size_t)nrows * 128; i += (size_t)F.G * NTHREADS) { const int m = (int)(i >> 7), c4 = (int)(i & 127) * 4, ct = m >> 6;
        const v2u hw0 = *(const v2u*)(HL + (size_t)m * 512 + c4), aw0 = *(const v2u*)(AC + (size_t)m * 512 + c4), hw1 = *(const v2u*)(HL + ((size_t)NTOK + m) * 512 + c4), aw1 = *(const v2u*)(AC + ((size_t)NTOK + m) * 512 + c4);
        const f32x4 h0 = {bflo(hw0.x), bfhi(hw0.x), bflo(hw0.y), bfhi(hw0.y)}, a0 = {bflo(aw0.x), bfhi(aw0.x), bflo(aw0.y), bfhi(aw0.y)}, h1 = {bflo(hw1.x), bfhi(hw1.x), bflo(hw1.y), bfhi(hw1.y)}, a1 = {bflo(aw1.x), bfhi(aw1.x), bflo(aw1.y), bfhi(aw1.y)};
        const f32x4 i0 = *(const f32x4*)(CI + (size_t)ct * 512 + c4), i1 = *(const f32x4*)(CI + ((size_t)NCT + ct) * 512 + c4);
        const f32x4 hs = (a0 * i0 + h0) + (a1 * i1 + h1); const v2u yw = *(const v2u*)(P + (size_t)m * PW + PC_LY + c4);
        v2u o; o.x = pk2(hs.x * gelu_tanh(bflo(yw.x)), hs.y * gelu_tanh(bfhi(yw.x))); o.y = pk2(hs.z * gelu_tanh(bflo(yw.y)), hs.w * gelu_tanh(bfhi(yw.y)));
        *(v2u*)(CC + (size_t)m * DM + 1536 + c4) = o; }
}

constexpr size_t WS_DNQ = WS_DNT;
constexpr size_t WS_BG = WS_DNS + 1 * MiB;
constexpr size_t WS_XC = WS_XS;

__device__ __forceinline__ void naive_prep(Frame& F, int l) {
    const bf16* P = (const bf16*)(F.ws + WS_P);
    const int gw = F.bid * NWAVES + F.wave, NGW = F.G * NWAVES;
#if !defined(USE_CHUNK_DN)
    {
        float* DNQ = (float*)(F.ws + WS_DNQ); float* BG = (float*)(F.ws + WS_BG);
        const float* cw = F.in[I_DNCW] + (size_t)l * 4 * 1536;
        for (int it = gw; it < NTOK * 4; it += NGW) {
            const int m = it >> 2, h = it & 3; int t, T, base; seq_of(m, t, T, base);
            float val[3][2];
#pragma unroll
            for (int part = 0; part < 3; ++part)
#pragma unroll
                for (int dd = 0; dd < 2; ++dd) { const int d = F.lane + 64 * dd, cch = part * 512 + h * 128 + d, col = PC_DQ + cch; float s = 0.f;
#pragma unroll
                    for (int j = 0; j < 4; ++j) { const int tt = t + j - 2; if (tt >= 0 && tt < T) s += cw[j * 1536 + cch] * bf2f(P[(size_t)(base + tt) * PW + col]); }
                    val[part][dd] = siluf_(s); }
            const float sq = wave_sum(val[0][0] * val[0][0] + val[0][1] * val[0][1]), sk = wave_sum(val[1][0] * val[1][0] + val[1][1] * val[1][1]);
            const float fq = 0.08838834764831845f / sqrtf(sq + EPS), fk = 1.0f / sqrtf(sk + EPS);
#pragma unroll
            for (int dd = 0; dd < 2; ++dd) { const int d = F.lane + 64 * dd; float* o = DNQ + (size_t)m * 1536 + h * 128 + d;
                o[0] = val[0][dd] * fq; o[512] = val[1][dd] * fk; o[1024] = val[2][dd]; }
            if (h == 0 && F.lane < 8) { const int dir = F.lane >> 2, hh = F.lane & 3;
                const float pb = bf2f(P[(size_t)m * PW + PC_BETA + F.lane]), pa = bf2f(P[(size_t)m * PW + PC_DEC + F.lane]);
                BG[m * 16 + F.lane] = sigmoidf_(pb);
                BG[m * 16 + 8 + F.lane] = -__expf(F.in[I_DNALOG][l * 8 + dir * 4 + hh]) * softplusf_(pa + F.in[I_DNDT][l * 8 + dir * 4 + hh]); }
        }
    }
#endif
#if !defined(USE_CHUNK_LRU)
    {
        LAS float* xc = (LAS float*)F.lds;
        float* A = (float*)(F.ws + WS_LRA); float* U = (float*)(F.ws + WS_LRH);
        const float* cw = F.in[I_LRCW] + (size_t)l * 4 * 512; const float* cb = F.in[I_LRCB] + l * 512;
        for (int m0 = F.bid * 8; m0 < NTOK; m0 += F.G * 8) {
            __syncthreads();
            for (int i = F.tid; i < 8 * 512; i += NTHREADS) { const int m = m0 + (i >> 9), ch = i & 511; int t, T, base; seq_of(m, t, T, base); float s = cb[ch];
#pragma unroll
                for (int j = 0; j < 4; ++j) { const int tt = t + j - 2; if (tt >= 0 && tt < T) s += cw[j * 512 + ch] * bf2f(P[(size_t)(base + tt) * PW + PC_LX + ch]); }
                xc[i] = s; }
            __syncthreads();
            for (int i = F.tid; i < 8 * 512 * 2; i += NTHREADS) { const int ch = i & 511, dir = (i >> 9) & 1, tk = i >> 10, m = m0 + tk, blk = ch >> 6, j = ch & 63;
                const float* wr = F.in[I_LRWR] + ((size_t)((l * 2 + dir) * 8 + blk)) * 4096 + j; const float* wi = F.in[I_LRWI] + ((size_t)((l * 2 + dir) * 8 + blk)) * 4096 + j;
                float sr = F.in[I_LRBR][(l * 2 + dir) * 512 + ch], si = F.in[I_LRBI][(l * 2 + dir) * 512 + ch];
#pragma unroll 8
                for (int ii = 0; ii < 64; ++ii) { const float x = xc[tk * 512 + blk * 64 + ii]; sr += x * wr[ii * 64]; si += x * wi[ii * 64]; }
                const float r = sigmoidf_(sr), ig = sigmoidf_(si); const float lam = F.in[I_LRLAM][(l * 2 + dir) * 512 + ch];
                const float logsig = -softplusf_(-lam);
                const float log_a = 8.0f * r * logsig; const float a = __expf(log_a);
                const float u = sqrtf(-expm1f(2.0f * log_a)) * (ig * xc[tk * 512 + ch]);
                A[((size_t)dir * NTOK + m) * 512 + ch] = a; U[((size_t)dir * NTOK + m) * 512 + ch] = u; }
        }
        __syncthreads();
    }
#endif
}

__device__ __forceinline__ void naive_attn_row(Frame& F, int l, int m, int hq) {
    const bf16* P = (const bf16*)(F.ws + WS_P); bf16* CC = (bf16*)(F.ws + WS_CC);
    const int d = F.lane, kvh = hq >> 2; int t, T, base; seq_of(m, t, T, base);
    const bool lat = m < NLAT; const int b = lat ? (m >> 12) : ((m - NLAT) >> 8);
    const int dd = d & 31, jf = dd & 15; const float inv = __powf(10000.0f, -(float)jf * (1.0f / 16.0f));
    const bool second = (dd >= 16), colhalf = (d >= 32);
    float q = bf2f(P[(size_t)m * PW + PC_Q + hq * 64 + d]);
    if (lat) { const float pos = (float)(colhalf ? (t & 63) : (t >> 6)); float sn, cs; sincosf(pos * inv, &sn, &cs); const float pr = __shfl_xor(q, 16); q = second ? (q * cs + pr * sn) : (q * cs - pr * sn); }
    q *= 0.125f;
    float mx = F.in[I_SINK][l * 16 + hq], den = 1.0f, acc = 0.f;
    if (lat) { const int t0 = t - 128 < 0 ? 0 : t - 128, t1 = t + 128 > SEQ - 1 ? SEQ - 1 : t + 128;
        for (int tk = t0; tk <= t1; ++tk) { const size_t r = (size_t)(base + tk) * PW; float k = bf2f(P[r + PC_K + kvh * 64 + d]); const float v = bf2f(P[r + PC_V + kvh * 64 + d]);
            const float pos = (float)(colhalf ? (tk & 63) : (tk >> 6)); float sn, cs; sincosf(pos * inv, &sn, &cs); const float pr = __shfl_xor(k, 16); k = second ? (k * cs + pr * sn) : (k * cs - pr * sn);
            const float s = wave_sum(q * k); const float mn = fmaxf(mx, s), f = __expf(mx - mn), p = __expf(s - mn); den = den * f + p; acc = acc * f + p * v; mx = mn; } }
    for (int c = 0; c < CTXL; ++c) { const size_t r = (size_t)(NLAT + b * CTXL + c) * PW; const float k = bf2f(P[r + PC_K + kvh * 64 + d]), v = bf2f(P[r + PC_V + kvh * 64 + d]);
        const float s = wave_sum(q * k); const float mn = fmaxf(mx, s), f = __expf(mx - mn), p = __expf(s - mn); den = den * f + p; acc = acc * f + p * v; mx = mn; }
    CC[(size_t)m * DM + hq * 64 + d] = (bf16)f2bf(acc / den);
}

__device__ __forceinline__ int scan_row(int n, int b, int dir) { if (n < CTXL) { const int t = dir ? (CTXL - 1 - n) : n; return NLAT + b * CTXL + t; } const int t = dir ? (SEQ - 1 - (n - CTXL)) : (n - CTXL); return b * SEQ + t; }
__device__ __forceinline__ void naive_scan(Frame& F, int l, int rep = 0) {
#if defined(USE_CHUNK_DN)
    if (F.bid < 32 * DN_SPLIT) { if (DN_SPLIT == 2) dn_scan(F, l, F.bid >> 4, (F.bid >> 2) & 3, (F.bid >> 1) & 1, F.bid & 1); else dn_scan(F, l, F.bid >> 3, (F.bid >> 1) & 3, F.bid & 1, 0); }
#else
    if (F.bid < 32) {
        const int b = F.bid >> 3, h = (F.bid >> 1) & 3, dir = F.bid & 1, dvc = F.tid & 127, kq = F.tid >> 7;
        const float* DNQ = (const float*)(F.ws + WS_DNQ); const float* BG = (const float*)(F.ws + WS_BG); float* O = (float*)(F.ws + WS_DNO);
        LAS float* buf = (LAS float*)F.lds;
        LAS float* red = buf + 768;
        LAS float* red2 = red + 512;
        float S[32];
#pragma unroll
        for (int i = 0; i < 32; ++i) S[i] = 0.f;
        constexpr int NT = CTXL + SEQ;
        { const int m = scan_row(0, b, dir); if (F.tid < 384) buf[F.tid] = DNQ[(size_t)m * 1536 + (F.tid >> 7) * 512 + h * 128 + (F.tid & 127)]; }
        __syncthreads();
#pragma unroll 1
        for (int n = 0; n < NT; ++n) {
            const int m = scan_row(n, b, dir); const LAS float* cur = buf + (n & 1) * 384;
            float nextv = 0.f; if (n + 1 < NT && F.tid < 384) { const int m2 = scan_row(n + 1, b, dir); nextv = DNQ[(size_t)m2 * 1536 + (F.tid >> 7) * 512 + h * 128 + (F.tid & 127)]; }
            const float beta = BG[m * 16 + dir * 4 + h], decay = __expf(BG[m * 16 + 8 + dir * 4 + h]);
            float ks = 0.f;
#pragma unroll
            for (int i = 0; i < 32; ++i) ks += cur[128 + kq * 32 + i] * S[i];
            red[kq * 128 + dvc] = ks;
            __syncthreads();
            const float kS = (red[dvc] + red[128 + dvc]) + (red[256 + dvc] + red[384 + dvc]);
            const float upd = beta * (cur[256 + dvc] - decay * kS);
            float os = 0.f;
#pragma unroll
            for (int i = 0; i < 32; ++i) { S[i] = decay * S[i] + cur[128 + kq * 32 + i] * upd; os += cur[kq * 32 + i] * S[i]; }
            red2[kq * 128 + dvc] = os;
            if (F.tid < 384) buf[((n + 1) & 1) * 384 + F.tid] = nextv;
            __syncthreads();
            if (kq == 0) O[((size_t)dir * NTOK + m) * 512 + h * 128 + dvc] = (red2[dvc] + red2[128 + dvc]) + (red2[256 + dvc] + red2[384 + dvc]);
        }
    }
#endif
#if defined(USE_CHUNK_LRU)
    else if (F.bid < 32 * DN_SPLIT + 8) { lru_carry(F, (F.bid - 32 * DN_SPLIT) * NTHREADS + F.tid); }
#else
    else if (F.bid < 40) {
        const int idx = (F.bid - 32) * NTHREADS + F.tid, ch = idx & 511, dir = (idx >> 9) & 1, b = idx >> 10;
        const float* A = (const float*)(F.ws + WS_LRA); float* U = (float*)(F.ws + WS_LRH);
        float hs = 0.f;
#pragma unroll 4
        for (int n = 0; n < CTXL + SEQ; ++n) { int m; if (n < CTXL) { const int t = dir ? (CTXL - 1 - n) : n; m = NLAT + b * CTXL + t; } else { const int t = dir ? (SEQ - 1 - (n - CTXL)) : (n - CTXL); m = b * SEQ + t; }
            const size_t o = ((size_t)dir * NTOK + m) * 512 + ch; hs = A[o] * hs + U[o]; U[o] = hs; }
    }
#endif
#if defined(USE_MFMA_ATTN)
    attn_phase(F, l, rep);
    convert_moe_queue(F, l, rep);
#else
    {
        const int nrows = (l == 0) ? NTOK : NLAT;
        for (;;) { int m = 0; if (F.lane == 0) m = (int)__hip_atomic_fetch_add(F.ctl + CW_ATQ + 64 * l, 1u, RLX_AGENT); m = __builtin_amdgcn_readfirstlane(m);
            if (m >= nrows) break;
#pragma unroll 1
            for (int hq = 0; hq < 16; ++hq) naive_attn_row(F, l, m, hq); }
    }
#endif
}

__device__ __forceinline__ void naive_fin(Frame& F, int l) {
    const int nrows = (l == 0) ? NTOK : NLAT;
    const bf16* P = (const bf16*)(F.ws + WS_P); bf16* CC = (bf16*)(F.ws + WS_CC);
    const int gw = F.bid * NWAVES + F.wave, NGW = F.G * NWAVES;
    const float* O = (const float*)(F.ws + WS_DNO); const float* HS = (const float*)(F.ws + WS_LRH);
    for (int it0 = gw * 2; it0 < nrows * 4; it0 += NGW * 2) {
        float2 oa[2], ob[2]; unsigned gw_[2];
#pragma unroll
        for (int k = 0; k < 2; ++k) { const int it = it0 + k, m = it >> 2, h = it & 3; const int c = h * 128 + 2 * F.lane;
            oa[k] = *(const float2*)(O + (size_t)m * 512 + c); ob[k] = *(const float2*)(O + ((size_t)NTOK + m) * 512 + c); gw_[k] = *(const unsigned*)(P + (size_t)m * PW + PC_DG + c); }
        const float2 ng = *(const float2*)(F.in[I_DNNG] + l * 128 + 2 * F.lane);
#pragma unroll
        for (int k = 0; k < 2; ++k) { const int it = it0 + k, m = it >> 2, h = it & 3; const float o0 = oa[k].x + ob[k].x, o1 = oa[k].y + ob[k].y;
            const float rstd = 1.0f / sqrtf(wave_sum(o0 * o0 + o1 * o1) * (1.0f / 128.0f) + EPS);
            *(unsigned*)(CC + (size_t)m * DM + 1024 + h * 128 + 2 * F.lane) = pk2(o0 * rstd * ng.x * siluf_(bflo(gw_[k])), o1 * rstd * ng.y * siluf_(bfhi(gw_[k]))); }
    }
#if defined(USE_CHUNK_LRU)
    lru_fin(F, l);
#else
    for (size_t i = (size_t)F.bid * NTHREADS + F.tid; i < (size_t)nrows * 512; i += (size_t)F.G * NTHREADS) { const int m = (int)(i >> 9), ch = (int)(i & 511);
        const float hsum = HS[(size_t)m * 512 + ch] + HS[((size_t)NTOK + m) * 512 + ch]; const float y = bf2f(P[(size_t)m * PW + PC_LY + ch]);
        CC[(size_t)m * DM + 1536 + ch] = (bf16)f2bf(hsum * gelu_tanh(y)); }
#endif
}
#ifndef PHASE_PREP
#if defined(USE_MFMA_ATTN)
#if defined(USE_CHUNK_DN)
#define PHASE_PREP(F, l) do { attn_prep(F, l); lru_prep(F, l); dn_prep(F, l); } while (0)
#else
#define PHASE_PREP(F, l) do { naive_prep(F, l); attn_prep(F, l); } while (0)
#endif
#else
#define PHASE_PREP(F, l) naive_prep(F, l)
#endif
#endif
#ifndef PHASE_SCAN
#define PHASE_SCAN(F, l) naive_scan(F, l)
#endif
#ifndef PHASE_FIN
#define PHASE_FIN(F, l) naive_fin(F, l)
#endif

#ifndef PHASE_INPROJ
#define PHASE_INPROJ(F, l) do {} while (0)
#endif
#ifndef PHASE_PREP
#define PHASE_PREP(F, l) do {} while (0)
#endif
#ifndef PHASE_SCAN
#define PHASE_SCAN(F, l) do {} while (0)
#endif
#ifndef PHASE_FIN
#define PHASE_FIN(F, l) do {} while (0)
#endif
#ifndef PHASE_OUTPROJ
#define PHASE_OUTPROJ(F, l) do {} while (0)
#endif
#ifndef PHASE_NORM2
#define PHASE_NORM2(F, l) do {} while (0)
#endif
#ifndef PHASE_SCATTER
#define PHASE_SCATTER(F, l) do {} while (0)
#endif
#ifndef PHASE_GEMM1
#define PHASE_GEMM1(F, l) do {} while (0)
#endif
#ifndef PHASE_GEMM2
#define PHASE_GEMM2(F, l) do {} while (0)
#endif

#ifndef MK_SPLIT
#define MK_SPLIT 0
#endif
#ifndef MK_STAGE
#define MK_STAGE 99
#endif
#ifndef MK_TAILFILL
#define MK_TAILFILL 0
#endif
#ifndef MK_DUP
#define MK_DUP 0
#endif
#define DUP(k) ((MK_DUP >> (k)) & 1)
constexpr int N_PHASES = 22;
struct Args { const float* in[N_IN]; float* out; unsigned char* ws; int ph_lo, ph_hi; };
static_assert(sizeof(Args) == (N_IN + 2) * 8 + 8, "Args has no padding");

__global__ void __launch_bounds__(NTHREADS, 2) fwd_kernel(Args args) {
    extern __shared__ __attribute__((aligned(16))) unsigned char lds[];
    Frame F;
    F.lds = (LAS unsigned char*)lds;
    F.MISC = (volatile LAS unsigned*)(F.lds + MISC_OFF);
    F.tid = threadIdx.x; F.lane = F.tid & 63; F.wave = __builtin_amdgcn_readfirstlane(F.tid >> 6);
    F.G = 256; F.bid = blockIdx.x;
    F.ws = args.ws; F.out = args.out; F.ctl = (gu32*)(args.ws + WS_CTL);
    F.in = (const float* const __attribute__((address_space(4)))*)__builtin_amdgcn_kernarg_segment_ptr();
    for (int u = F.tid; u < (LDS_BYTES - LDSCTL_OFF) / 4; u += NTHREADS) ((LAS unsigned*)(F.lds + LDSCTL_OFF))[u] = 0u;
    __syncthreads();
    XcdBarrier bar; bar.bar = (unsigned*)(F.ctl + CW_BAR); bar.x = 0; bar.st = nullptr;
    if (!MK_SPLIT) bar = xcd_barrier_post((unsigned*)(F.ctl + CW_BAR), F.MISC + 8);
    const int lo = args.ph_lo, hi = args.ph_hi;
#define IN(k) (lo <= (k) && (k) < hi && phase_enter(F))
#define INR(k) (lo <= (k) && (k) < hi)
#define SEAM(k) do { if (INR(k) && INR((k) + 1)) { if (MK_TAILFILL && (k) < 14) tail_fill(F, (k), (k) < 4 ? 0 : 1); xcd_barrier(bar); } } while (0)

    if (IN(0)) { p0_prologue(F); if (DUP(0)) { __syncthreads(); p0_prologue(F); } } SEAM(0);
#pragma unroll 1
    for (int l = 0; l < DEPTH; ++l) {
        const int pb = 1 + 10 * l;
        if (IN(pb + 0)) { phase_norm1(F, l); if (DUP(13) && l == 0) { __syncthreads(); phase_norm1(F, l); } } SEAM(pb + 0);
        if (IN(pb + 1)) { PHASE_INPROJ(F, l); if (DUP(1)) { __syncthreads(); PHASE_INPROJ(F, l); } } SEAM(pb + 1);
        if (IN(pb + 2)) { PHASE_PREP(F, l); if (DUP(2)) { __syncthreads(); dn_prep(F, l); } if (DUP(6)) { __syncthreads(); lru_prep(F, l); } } SEAM(pb + 2);
        if (IN(pb + 3)) { if (DUP(3) && F.bid < 64) dn_scan(F, l, F.bid >> 4, (F.bid >> 2) & 3, (F.bid >> 1) & 1, F.bid & 1); PHASE_SCAN(F, l); if (DUP(10)) { __syncthreads(); naive_scan(F, l, 1); } if (DUP(11)) { __syncthreads(); attn_phase(F, l, 2); } if (DUP(12)) { __syncthreads(); convert_moe_queue(F, l, 3); } } SEAM(pb + 3);
        if (IN(pb + 4)) { PHASE_FIN(F, l); if (DUP(4)) { __syncthreads(); PHASE_FIN(F, l); } } SEAM(pb + 4);
        if (IN(pb + 5)) { PHASE_OUTPROJ(F, l); if (DUP(5) && l == 0) { __syncthreads(); PHASE_OUTPROJ(F, l); } } SEAM(pb + 5);
        if (IN(pb + 6)) { PHASE_NORM2(F, l); } SEAM(pb + 6);
        if (IN(pb + 7)) { PHASE_SCATTER(F, l); if (DUP(7)) { __syncthreads(); PHASE_SCATTER(F, l); } } SEAM(pb + 7);
        if (IN(pb + 8)) { PHASE_GEMM1(F, l); if (DUP(8)) { __syncthreads(); PHASE_GEMM1(F, l); } } SEAM(pb + 8);
        if (IN(pb + 9)) { PHASE_GEMM2(F, l); if (DUP(9)) { __syncthreads(); PHASE_GEMM2(F, l); } } SEAM(pb + 9);
    }
    if (IN(21)) { phase_final(F, MK_STAGE >= 9); if (DUP(13)) { __syncthreads(); phase_final(F, MK_STAGE >= 9); } }
#undef IN
#undef SEAM
}

extern "C" void kernel_launch(void* const* d_in, const int* in_sizes, int n_in, void* d_out, int out_size, void* d_ws, size_t ws_size, hipStream_t stream) {
    static int grid = 0;
    if (grid == 0) {
        if (n_in != N_IN || out_size != NLAT * DM || ws_size < WS_END) { fprintf(stderr, "kernel_launch: unexpected shapes (n_in %d, out %d, ws %zu); nothing launched\n", n_in, out_size, ws_size); grid = -1; return; }
        int dev = 0, cus = 0, per_cu = 0;
        if (hipGetDevice(&dev) != hipSuccess || hipDeviceGetAttribute(&cus, hipDeviceAttributeMultiprocessorCount, dev) != hipSuccess) { grid = -1; return; }
        if (hipFuncSetAttribute((const void*)fwd_kernel, hipFuncAttributeMaxDynamicSharedMemorySize, LDS_BYTES) != hipSuccess) { fprintf(stderr, "kernel_launch: hipFuncSetAttribute failed\n"); grid = -1; return; }
        if (hipOccupancyMaxActiveBlocksPerMultiprocessor(&per_cu, (const void*)fwd_kernel, NTHREADS, LDS_BYTES) != hipSuccess || per_cu < 1) { fprintf(stderr, "kernel_launch: occupancy query says %d\n", per_cu); }
        (void)hipGetLastError();
        grid = cus;
        if (grid != 256) { fprintf(stderr, "kernel_launch: built for 256 CUs, device has %d; nothing launched\n", cus); grid = -1; return; }
    }
    if (grid < 0) return;
    if (hipMemsetAsync((char*)d_ws + WS_CTL, 0, CTL_ZERO_BYTES, stream) != hipSuccess) return;
    Args a{};
    for (int i = 0; i < N_IN; ++i) a.in[i] = (const float*)d_in[i];
    a.out = (float*)d_out; a.ws = (unsigned char*)d_ws;
#if MK_SPLIT
    for (int p = 0; p < N_PHASES; ++p) { a.ph_lo = p; a.ph_hi = p + 1; hipLaunchKernelGGL(fwd_kernel, dim3(grid), dim3(NTHREADS), LDS_BYTES, stream, a); }
#else
    a.ph_lo = 0; a.ph_hi = N_PHASES;
    hipLaunchKernelGGL(fwd_kernel, dim3(grid), dim3(NTHREADS), LDS_BYTES, stream, a);
#endif
    const hipError_t le = hipPeekAtLastError();
    if (le != hipSuccess) fprintf(stderr, "kernel_launch: launch failed: %s\n", hipGetErrorName(le));
}
```

```cpp
#include <hip/hip_runtime.h>
#include <cstdio>
#include <cstdint>

constexpr int DM = 2048, NB = 4, SEQ = 4096, CTXL = 256, DEPTH = 2;
constexpr int NLAT = NB * SEQ, NCTX = NB * CTXL, NTOK = NLAT + NCTX;
constexpr int NCT = NTOK / 64;
constexpr int IN_W = 4624, PW = 4864;
constexpr int PC_Q = 0, PC_K = 1024, PC_V = 1280, PC_DQ = 1536, PC_DK = 2048, PC_DV = 2560, PC_DG = 3072, PC_LX = 3584, PC_LY = 4096, PC_BETA = 4608, PC_DEC = 4616;
constexpr int NEXP = 32, TOPK = 4, DEXP = 1024;
constexpr int MOE_ROWS = 304 * 256;
constexpr float EPS = 1e-6f;
#ifndef MK_STAGE
#define MK_STAGE 99
#endif
#ifndef FP8_INPROJ
#define FP8_INPROJ 0
#endif
#ifndef FP8_OUTPROJ
#define FP8_OUTPROJ 0
#endif
#ifndef SCAN_SPLIT_ORDER
#define SCAN_SPLIT_ORDER 1
#endif
namespace pg8 {
#define PG8_LAS __attribute__((address_space(3)))
typedef unsigned short bf16_t;
typedef short bf16x8 __attribute__((ext_vector_type(8)));
typedef float f32x4 __attribute__((ext_vector_type(4)));
typedef unsigned u32x4 __attribute__((ext_vector_type(4)));
typedef float f32x2 __attribute__((ext_vector_type(2)));
constexpr int BM = 256, BK = 64, HALF = 128, HTB = HALF * BK * 2  , STAGE_BYTES = 8 * HTB, NXCD = 8, WGM = 8;

__host__ __device__ __forceinline__ int lds_byte(int r, int c) { const int st = (r >> 4) * 2 + (c >> 5), rr = r & 15, cc = c & 31, ob = rr * 64 + cc * 2; return st * 1024 + (ob ^ (((ob >> 9) & 1) << 5)); }
__host__ __device__ __forceinline__ void stage_rc(int b, int& R, int& C) { const int st = b / 1024, sb = b % 1024, swz = sb ^ (((sb >> 9) & 1) << 5); R = (st >> 1) * 16 + swz / 64; C = (st & 1) * 32 + (swz % 64) / 2; }
__host__ __device__ __forceinline__ int perm32(int rho) { const int n = rho >> 4, i = rho & 15; return 8 * (i >> 2) + 4 * n + (i & 3); }

struct Unit { int pm, pn, e; };
typedef int v4i_t __attribute__((ext_vector_type(4)));
typedef int v8i_t __attribute__((ext_vector_type(8)));
struct Gemm { const bf16_t* A; const bf16_t* Bt; int M, N, K; int bscale = 0x7F7F7F7F; };

struct StaticOrder {
    static constexpr bool GATHER = false; const int* row_tab = nullptr;
    int nM, nN, nwg, G, c; const char* A; const char* Bt; size_t tstep;
    __device__ void init(const Gemm& g, int G_, int c_) { nM = g.M / BM; nN = g.N / BM; nwg = nM * nN; G = G_; c = c_; A = (const char*)g.A; Bt = (const char*)g.Bt; tstep = (size_t)BM * g.K * 2; }
    __device__ bool next(int i, Unit& u) const {
        const long L = (long)i * G + c; if (L >= nwg) return false;
        int wgid = (int)L; { const int q = nwg / NXCD, r = nwg % NXCD, xcd = wgid % NXCD, off = wgid / NXCD; wgid = (xcd < r ? xcd * (q + 1) : r * (q + 1) + (xcd - r) * q) + off; }
        const int nig = WGM * nN, gid = wgid / nig, fm = gid * WGM, gsz = (nM - fm) < WGM ? (nM - fm) : WGM;
        u.pm = fm + ((wgid % nig) % gsz); u.pn = (wgid % nig) / gsz; u.e = 0; return true;
    }
    __device__ __forceinline__ const char* a_ptr(const Unit& u) const { return A + (size_t)u.pm * tstep; }
    __device__ __forceinline__ const char* b_ptr(const Unit& u) const { return Bt + (size_t)u.pn * tstep; }
    __device__ __forceinline__ void a_ready(const Unit&) const {}
    __device__ __forceinline__ void done(const Unit&) const {}
};
struct StaticOrderG : StaticOrder {
    static constexpr bool GATHER = true;
    __device__ __forceinline__ const char* a_ptr(const Unit&) const { return A; }
};
__device__ __forceinline__ unsigned cvt_pk_bf16(float lo, float hi) { unsigned r; asm volatile("v_cvt_pk_bf16_f32 %0, %1, %2" : "=v"(r) : "v"(lo), "v"(hi)); return r; }
struct EpiBf16Plain {
    static constexpr bool PERM = true, AFTER_DRAIN = false;
    bf16_t* O; int ldc;
    __device__ __forceinline__ void operator()(const f32x4 (&acc)[2][2][4][2], const Unit& u, int wr, int wc, int fr, int fq) const {
        const int row0 = u.pm * BM + wr * 64 + fr, col0 = u.pn * BM + wc * 32 + 8 * fq;
#pragma unroll
        for (int ai = 0; ai < 2; ++ai)
#pragma unroll
            for (int m = 0; m < 4; ++m) { bf16_t* rowp = O + (size_t)(row0 + ai * HALF + m * 16) * ldc + col0;
#pragma unroll
                for (int bj = 0; bj < 2; ++bj) { const f32x4 v0 = acc[ai][bj][m][0], v1 = acc[ai][bj][m][1];
                    u32x4 w; w.x = cvt_pk_bf16(v0[0], v0[1]); w.y = cvt_pk_bf16(v0[2], v0[3]); w.z = cvt_pk_bf16(v1[0], v1[1]); w.w = cvt_pk_bf16(v1[2], v1[3]);
                    *(u32x4*)(rowp + bj * HALF) = w; } }
    }
};
struct EpiResGate {
    static constexpr bool PERM = false, AFTER_DRAIN = false;
    const float* base_lat; const float* base_ctx; float* out; const float* modg;
    __device__ __forceinline__ void operator()(const f32x4 (&acc)[2][2][4][2], const Unit& u, int wr, int wc, int fr, int fq) const {
        const int r = u.pm < 64 ? (u.pm >> 4) : 4; const int col0 = u.pn * BM + wc * 32 + 4 * fq;
        const float* g = modg + (size_t)r * 12288 + col0;
        f32x4 gv[2][2];
#pragma unroll
        for (int bj = 0; bj < 2; ++bj)
#pragma unroll
            for (int n = 0; n < 2; ++n) gv[bj][n] = *(const f32x4*)(g + bj * HALF + n * 16);
#pragma unroll
        for (int ai = 0; ai < 2; ++ai)
#pragma unroll
            for (int m = 0; m < 4; ++m) { const int row = u.pm * BM + ai * HALF + wr * 64 + m * 16 + fr;
                const float* bp = (row < 16384 ? base_lat + (size_t)row * 2048 : base_ctx + (size_t)(row - 16384) * 2048) + col0; float* op = out + (size_t)row * 2048 + col0;
#pragma unroll
                for (int bj = 0; bj < 2; ++bj)
#pragma unroll
                    for (int n = 0; n < 2; ++n) { const f32x4 b = *(const f32x4*)(bp + bj * HALF + n * 16); *(f32x4*)(op + bj * HALF + n * 16) = b + gv[bj][n] * acc[ai][bj][m][n]; }
                asm volatile("" ::: "memory"); }
    }
};
struct EpiSwiglu {
    static constexpr bool PERM = true, AFTER_DRAIN = false;
    bf16_t* O; const float* bgu;
    __device__ __forceinline__ void operator()(const f32x4 (&acc)[2][2][4][2], const Unit& u, int wr, int wc, int fr, int fq) const {
        const int row0 = u.pm * BM + wr * 64 + fr, cc0 = wc * 32 + 8 * fq;
        const float* bg = bgu + (size_t)u.e * 2048 + u.pn * 128 + cc0;
        f32x4 bglu[2], blin[2];
#pragma unroll
        for (int n = 0; n < 2; ++n) { bglu[n] = *(const f32x4*)(bg + 4 * n); blin[n] = *(const f32x4*)(bg + 1024 + 4 * n); }
#pragma unroll
        for (int ai = 0; ai < 2; ++ai)
#pragma unroll
            for (int m = 0; m < 4; ++m) { bf16_t* rowp = O + (size_t)(row0 + ai * HALF + m * 16) * 1024 + u.pn * 128 + cc0;
                float r[8];
#pragma unroll
                for (int n = 0; n < 2; ++n) { const f32x4 g = acc[ai][0][m][n] + bglu[n], l = acc[ai][1][m][n] + blin[n];
#pragma unroll
                    for (int i = 0; i < 4; ++i) { const float gg = fminf(g[i], 7.0f); const float ll = fminf(fmaxf(l[i], -7.0f), 7.0f);
                        r[4 * n + i] = (ll + 1.0f) * gg * __builtin_amdgcn_rcpf(1.0f + __builtin_amdgcn_exp2f(-1.702f * 1.4426950408889634f * gg)); } }
                u32x4 w; w.x = cvt_pk_bf16(r[0], r[1]); w.y = cvt_pk_bf16(r[2], r[3]); w.z = cvt_pk_bf16(r[4], r[5]); w.w = cvt_pk_bf16(r[6], r[7]);
                *(u32x4*)rowp = w; }
    }
};
struct EpiSwiglu8 {
    static constexpr bool PERM = true, AFTER_DRAIN = false;
    unsigned char* O; const float* bgu;
    __device__ __forceinline__ void operator()(const f32x4 (&acc)[2][2][4][2], const Unit& u, int wr, int wc, int fr, int fq) const {
        const int row0 = u.pm * BM + wr * 64 + fr, cc0 = wc * 32 + 8 * fq;
        const float* bg = bgu + (size_t)u.e * 2048 + u.pn * 128 + cc0;
        f32x4 bglu[2], blin[2];
#pragma unroll
        for (int n = 0; n < 2; ++n) { bglu[n] = *(const f32x4*)(bg + 4 * n); blin[n] = *(const f32x4*)(bg + 1024 + 4 * n); }
#pragma unroll
        for (int ai = 0; ai < 2; ++ai)
#pragma unroll
            for (int m = 0; m < 4; ++m) { unsigned char* rowp = O + (size_t)(row0 + ai * HALF + m * 16) * 1024 + u.pn * 128 + cc0;
                float r[8];
#pragma unroll
                for (int n = 0; n < 2; ++n) { const f32x4 g = acc[ai][0][m][n] + bglu[n], l = acc[ai][1][m][n] + blin[n];
#pragma unroll
                    for (int i = 0; i < 4; ++i) { const float gg = fminf(g[i], 7.0f); const float ll = fminf(fmaxf(l[i], -7.0f), 7.0f);
                        r[4 * n + i] = (ll + 1.0f) * gg * __builtin_amdgcn_rcpf(1.0f + __builtin_amdgcn_exp2f(-1.702f * 1.4426950408889634f * gg)); } }
                int w0 = 0, w1 = 0; w0 = __builtin_amdgcn_cvt_pk_fp8_f32(r[0], r[1], w0, false); w0 = __builtin_amdgcn_cvt_pk_fp8_f32(r[2], r[3], w0, true); w1 = __builtin_amdgcn_cvt_pk_fp8_f32(r[4], r[5], w1, false); w1 = __builtin_amdgcn_cvt_pk_fp8_f32(r[6], r[7], w1, true);
                typedef unsigned u32x2 __attribute__((ext_vector_type(2))); *(u32x2*)rowp = (u32x2){(unsigned)w0, (unsigned)w1}; }
    }
};
struct EpiDown {
    static constexpr bool PERM = true, AFTER_DRAIN = false;
    bf16_t* O; const float* bdn; const float* rowg;
    __device__ __forceinline__ void operator()(const f32x4 (&acc)[2][2][4][2], const Unit& u, int wr, int wc, int fr, int fq) const {
        const int row0 = u.pm * BM + wr * 64 + fr, col0 = u.pn * BM + wc * 32 + 8 * fq;
        const float* bb = bdn + (size_t)u.e * 2048 + col0;
        float gt[2][4];
#pragma unroll
        for (int ai = 0; ai < 2; ++ai)
#pragma unroll
            for (int m = 0; m < 4; ++m) gt[ai][m] = rowg[row0 + ai * HALF + m * 16];
#pragma unroll
        for (int bj = 0; bj < 2; ++bj) { const f32x4 b0 = *(const f32x4*)(bb + bj * HALF), b1 = *(const f32x4*)(bb + bj * HALF + 4);
#pragma unroll
            for (int ai = 0; ai < 2; ++ai)
#pragma unroll
                for (int m = 0; m < 4; ++m) { const int row = row0 + ai * HALF + m * 16; const f32x4 v0 = (acc[ai][bj][m][0] + b0) * gt[ai][m], v1 = (acc[ai][bj][m][1] + b1) * gt[ai][m];
                    u32x4 w; w.x = cvt_pk_bf16(v0[0], v0[1]); w.y = cvt_pk_bf16(v0[2], v0[3]); w.z = cvt_pk_bf16(v1[0], v1[1]); w.w = cvt_pk_bf16(v1[2], v1[3]);
                    *(u32x4*)(O + (size_t)row * 2048 + col0 + bj * HALF) = w; } }
    }
};
template <bool GATHER_> struct MoeOrderT {
    static constexpr bool GATHER = GATHER_;
    int c, nblk; const char* A; const char* Bt; size_t a_tstep, b_estep, b_tstep; const PG8_LAS int* blk_end; const int* row_tab;
    __device__ __forceinline__ bool next(int i, Unit& u) const {
#if defined(MOE_MAP) && MOE_MAP == 1
        const int L = i * 256 + c, rb = L >> 3, j = (L & 7);
#elif defined(MOE_MAP) && MOE_MAP == 2
        const int x = c & 7, jj = c >> 3, gi = i * 8 + x, rb = 8 * (gi >> 1) + (jj >> 2), j = (jj & 3) + 4 * (gi & 1);
#else
        const int x = c & 7, j = c >> 3, gi = i * 8 + x, rb = 4 * gi + (j >> 3);
#endif
        if (rb >= nblk) return false;
        int e = 0;
        for (int k = 0; k < 31; ++k) e += (rb >= blk_end[k]) ? 1 : 0;
        u.pm = rb; u.pn = j & 7; u.e = __builtin_amdgcn_readfirstlane(e); return true;
    }
    __device__ __forceinline__ const char* a_ptr(const Unit& u) const { return GATHER ? A : A + (size_t)u.pm * a_tstep; }
    __device__ __forceinline__ const char* b_ptr(const Unit& u) const { return Bt + (size_t)u.e * b_estep + (size_t)u.pn * b_tstep; }
    __device__ __forceinline__ void a_ready(const Unit&) const {}
    __device__ __forceinline__ void done(const Unit&) const {}
};
typedef MoeOrderT<false> MoeOrder;
typedef MoeOrderT<true> MoeOrderG;
template <class Epi, class Sched, bool ALIGN_EPI = false, bool SP2 = false, bool FP8 = false>
__device__ __forceinline__ void gemm_phase(PG8_LAS unsigned char* lds, const Gemm g, const Sched& S, const Epi& E) {
    int tid = threadIdx.x; asm volatile("" : "+v"(tid));
    const int wid = __builtin_amdgcn_readfirstlane(tid >> 6), lane = tid & 63, wr = wid >> 2, wc = wid & 3, fr = lane & 15, fq = lane >> 4;
    const int K = g.K, nt = K / BK;
    unsigned voffA[2], voffB[2];
#pragma unroll
    for (int i = 0; i < 2; ++i) { int R, C; stage_rc(tid * 16 + i * 8192, R, C); const int Rb = Epi::PERM ? ((R & ~31) + perm32(R & 31)) : R;
        voffA[i] = (unsigned)(R * K + C) * 2u; voffB[i] = (unsigned)(Rb * K + C) * 2u; }
    unsigned gc0[2] = {0u, 0u}, gc1[2] = {0u, 0u}; int gR = 0, gC = 0;
    if constexpr (Sched::GATHER) { stage_rc(tid * 16, gR, gC); }
#define PG8_GLOAD(dst0, dst1, u) do { const int* _rt = S.row_tab + (size_t)(u).pm * BM + gR; \
        dst0[0] = (unsigned)_rt[0] * (unsigned)(K * 2) + (unsigned)(gC * 2); dst0[1] = (unsigned)_rt[64] * (unsigned)(K * 2) + (unsigned)(gC * 2); \
        dst1[0] = (unsigned)_rt[128] * (unsigned)(K * 2) + (unsigned)(gC * 2); dst1[1] = (unsigned)_rt[192] * (unsigned)(K * 2) + (unsigned)(gC * 2); } while (0)
    const size_t kstep = (size_t)(BK * 2);
    const size_t hstep = (size_t)HALF * K * 2;
    const size_t tstep = 2 * hstep;
    const unsigned ldsw = (unsigned)wid * 1024u;
    const int aoff = lds_byte(wr * 64 + fr, fq * 8); int boff = lds_byte(wc * 32 + fr, fq * 8) + 4 * HTB;
    asm volatile("" : "+v"(boff));
#define PG8_SA(b, h) (((b) * 2 + (h)) * HTB)
#define PG8_SB(b, h) ((4 + (b) * 2 + (h)) * HTB)
#define PG8_SBR(b, h) (((b) * 2 + (h)) * HTB)
#define PG8_STAGE(bufoff, gbase, voff) do { _Pragma("unroll") for (int _i = 0; _i < 2; ++_i) \
        __builtin_amdgcn_global_load_lds((const unsigned*)((const char*)(gbase) + (voff)[_i]), (PG8_LAS unsigned*)(lds + (bufoff) + ldsw + _i * 8192), 16, 0, 0); } while (0)
#define PG8_LD16(off) (*(const PG8_LAS v4i_t*)(lds + (off)))
#define PG8_LDA(dst, b, h) do { if constexpr (FP8) { _Pragma("unroll") for (int m = 0; m < 4; ++m) dst##8[m] = __builtin_shufflevector(PG8_LD16(PG8_SA(b, h) + aoff + m * 2048), PG8_LD16(PG8_SA(b, h) + aoff + m * 2048 + 1024), 0, 1, 2, 3, 4, 5, 6, 7); } \
        else { _Pragma("unroll") for (int m = 0; m < 4; ++m) _Pragma("unroll") for (int k = 0; k < 2; ++k) dst[m][k] = *(const PG8_LAS bf16x8*)(lds + PG8_SA(b, h) + aoff + m * 2048 + k * 1024); } } while (0)
#define PG8_LDB(dst, b, h) do { if constexpr (FP8) { _Pragma("unroll") for (int n = 0; n < 2; ++n) dst##8[n] = __builtin_shufflevector(PG8_LD16(PG8_SBR(b, h) + boff + n * 2048), PG8_LD16(PG8_SBR(b, h) + boff + n * 2048 + 1024), 0, 1, 2, 3, 4, 5, 6, 7); } \
        else { _Pragma("unroll") for (int n = 0; n < 2; ++n) _Pragma("unroll") for (int k = 0; k < 2; ++k) dst[n][k] = *(const PG8_LAS bf16x8*)(lds + PG8_SBR(b, h) + boff + n * 2048 + k * 1024); } } while (0)
#define PG8_MMA(ai, bj, At, Bt) do { __builtin_amdgcn_s_setprio(1); \
        if constexpr (FP8) { _Pragma("unroll") for (int m = 0; m < 4; ++m) _Pragma("unroll") for (int n = 0; n < 2; ++n) \
            acc[ai][bj][m][n] = __builtin_amdgcn_mfma_scale_f32_16x16x128_f8f6f4(Bt##8[n], At##8[m], acc[ai][bj][m][n], 0, 0, 0, g.bscale, 0, g.bscale); }     \
        else { _Pragma("unroll") for (int m = 0; m < 4; ++m) _Pragma("unroll") for (int n = 0; n < 2; ++n) _Pragma("unroll") for (int k = 0; k < 2; ++k) \
            acc[ai][bj][m][n] = __builtin_amdgcn_mfma_f32_16x16x32_bf16(Bt[n][k], At[m][k], acc[ai][bj][m][n], 0, 0, 0); } \
        __builtin_amdgcn_s_setprio(0); } while (0)
#define PG8_WAIT_V(n) asm volatile("s_waitcnt vmcnt(" #n ")" ::: "memory")
#define PG8_WAIT_L(n) asm volatile("s_waitcnt lgkmcnt(" #n ")" ::: "memory")
#define PG8_BAR __builtin_amdgcn_s_barrier()
#define PG8_SCHED __builtin_amdgcn_sched_barrier(0)
    Unit cur, nxt; int ui = 0;
    if (!S.next(0, cur)) return;
    f32x4 acc[2][2][4][2];
#pragma unroll
    for (int a = 0; a < 2; ++a)
#pragma unroll
        for (int b = 0; b < 2; ++b)
#pragma unroll
            for (int m = 0; m < 4; ++m)
#pragma unroll
                for (int n = 0; n < 2; ++n) acc[a][b][m][n] = (f32x4){0.f, 0.f, 0.f, 0.f};
    bf16x8 At[4][2], B0[2][2], B1[2][2]; v8i_t At8[4], B08[2], B18[2];
    const char* cA = S.a_ptr(cur); const char* cB = S.b_ptr(cur);
    S.a_ready(cur);
    if constexpr (SP2) {
        if constexpr (Sched::GATHER) { PG8_GLOAD(gc0, gc1, cur);
        PG8_STAGE(PG8_SB(0, 0), cB, voffB); PG8_STAGE(PG8_SB(0, 1), cB + hstep, voffB); PG8_STAGE(PG8_SA(0, 0), cA, gc0); PG8_STAGE(PG8_SA(0, 1), cA, gc1);
        if (wr == 1) PG8_BAR;
        PG8_WAIT_V(2); PG8_BAR;
        PG8_STAGE(PG8_SB(1, 0), cB + kstep, voffB); PG8_STAGE(PG8_SA(1, 0), cA + kstep, gc0); PG8_STAGE(PG8_SB(1, 1), cB + hstep + kstep, voffB);
        } else {
        PG8_STAGE(PG8_SB(0, 0), cB, voffB); PG8_STAGE(PG8_SB(0, 1), cB + hstep, voffB); PG8_STAGE(PG8_SA(0, 0), cA, voffA); PG8_STAGE(PG8_SA(0, 1), cA + hstep, voffA);
        if (wr == 1) PG8_BAR;
        PG8_WAIT_V(2); PG8_BAR;
        PG8_STAGE(PG8_SB(1, 0), cB + kstep, voffB); PG8_STAGE(PG8_SA(1, 0), cA + kstep, voffA); PG8_STAGE(PG8_SB(1, 1), cB + hstep + kstep, voffB);
        }
        PG8_WAIT_V(6); PG8_BAR;
    } else {
        PG8_STAGE(PG8_SB(0, 0), cB, voffB); PG8_STAGE(PG8_SA(0, 0), cA, voffA); PG8_STAGE(PG8_SB(0, 1), cB + hstep, voffB); PG8_STAGE(PG8_SA(0, 1), cA + hstep, voffA);
        if (wr == 1) PG8_BAR;
        PG8_WAIT_V(4); PG8_BAR;
        PG8_STAGE(PG8_SB(1, 0), cB + kstep, voffB); PG8_STAGE(PG8_SA(1, 0), cA + kstep, voffA); PG8_STAGE(PG8_SB(1, 1), cB + hstep + kstep, voffB);
        PG8_WAIT_V(6); PG8_BAR;
    }
    for (;;) {
        const bool has_next = S.next(ui + 1, nxt);
        const char* nA = has_next ? S.a_ptr(nxt) : cA; const char* nB = has_next ? S.b_ptr(nxt) : cB;
#pragma unroll 1
        for (int t = 0; t < nt; t += 2) {
            const bool last = (t == nt - 2);
            const char* a1 = cA + (size_t)(t + 1) * kstep;
            const char* a2 = last ? nA : cA + (size_t)(t + 2) * kstep; const char* b2 = last ? nB : cB + (size_t)(t + 2) * kstep;
            const char* a3 = a2 + kstep; const char* b3 = b2 + kstep;
            if (last && has_next) S.a_ready(nxt);

            if constexpr (SP2) {
            PG8_LDB(B0, 0, 0); PG8_LDB(B1, 0, 1); PG8_SCHED; PG8_LDA(At, 0, 0); if constexpr (Sched::GATHER) PG8_STAGE(PG8_SA(1, 1), a1, gc1); else PG8_STAGE(PG8_SA(1, 1), a1 + hstep, voffA);
            if constexpr (Sched::GATHER) { if (last && has_next) PG8_GLOAD(gc0, gc1, nxt); }
            PG8_WAIT_V(8); PG8_WAIT_L(0); PG8_BAR; PG8_MMA(0, 0, At, B0); PG8_MMA(0, 1, At, B1); PG8_BAR; PG8_SCHED;
            PG8_LDA(At, 0, 1); PG8_STAGE(PG8_SB(0, 0), b2, voffB); PG8_STAGE(PG8_SB(0, 1), b2 + hstep, voffB); if constexpr (Sched::GATHER) PG8_STAGE(PG8_SA(0, 0), a2, gc0); else PG8_STAGE(PG8_SA(0, 0), a2, voffA);
            PG8_WAIT_V(8); PG8_WAIT_L(0); PG8_BAR; PG8_MMA(1, 0, At, B0); PG8_MMA(1, 1, At, B1); PG8_BAR; PG8_SCHED;
            PG8_LDB(B0, 1, 0); PG8_LDB(B1, 1, 1); PG8_SCHED; PG8_LDA(At, 1, 0); if constexpr (Sched::GATHER) PG8_STAGE(PG8_SA(0, 1), a2, gc1); else PG8_STAGE(PG8_SA(0, 1), a2 + hstep, voffA);
            PG8_WAIT_V(8); PG8_WAIT_L(0); PG8_BAR; PG8_MMA(0, 0, At, B0); PG8_MMA(0, 1, At, B1); PG8_BAR; PG8_SCHED;
            PG8_LDA(At, 1, 1); PG8_STAGE(PG8_SB(1, 0), b3, voffB); PG8_STAGE(PG8_SB(1, 1), b3 + hstep, voffB); if constexpr (Sched::GATHER) PG8_STAGE(PG8_SA(1, 0), a3, gc0); else PG8_STAGE(PG8_SA(1, 0), a3, voffA);
            PG8_WAIT_V(8); PG8_WAIT_L(0); PG8_BAR; PG8_MMA(1, 0, At, B0); PG8_MMA(1, 1, At, B1); PG8_BAR; PG8_SCHED;
            } else {
            PG8_LDB(B0, 0, 0); PG8_SCHED; PG8_LDA(At, 0, 0); PG8_STAGE(PG8_SA(1, 1), a1 + hstep, voffA);
            PG8_WAIT_L(8); PG8_BAR; PG8_WAIT_L(0); PG8_MMA(0, 0, At, B0); PG8_BAR; PG8_SCHED;
            PG8_LDB(B1, 0, 1); PG8_STAGE(PG8_SB(0, 0), b2, voffB);
            PG8_BAR; PG8_WAIT_L(0); PG8_MMA(0, 1, At, B1); PG8_BAR;
            PG8_LDA(At, 0, 1); PG8_STAGE(PG8_SA(0, 0), a2, voffA);
            PG8_BAR; PG8_WAIT_L(0); PG8_MMA(1, 0, At, B0); PG8_BAR; PG8_SCHED;
            PG8_STAGE(PG8_SB(0, 1), b2 + hstep, voffB);
            PG8_WAIT_V(6); PG8_BAR; PG8_MMA(1, 1, At, B1); PG8_BAR;
            PG8_LDB(B0, 1, 0); PG8_SCHED; PG8_LDA(At, 1, 0); PG8_STAGE(PG8_SA(0, 1), a2 + hstep, voffA);
            PG8_WAIT_L(8); PG8_BAR; PG8_WAIT_L(0); PG8_MMA(0, 0, At, B0); PG8_BAR; PG8_SCHED;
            PG8_LDB(B1, 1, 1); PG8_STAGE(PG8_SB(1, 0), b3, voffB);
            PG8_BAR; PG8_WAIT_L(0); PG8_MMA(0, 1, At, B1); PG8_BAR;
            PG8_LDA(At, 1, 1); PG8_STAGE(PG8_SA(1, 0), a3, voffA);
            PG8_BAR; PG8_WAIT_L(0); PG8_MMA(1, 0, At, B0); PG8_BAR; PG8_SCHED;
            PG8_STAGE(PG8_SB(1, 1), b3 + hstep, voffB);
            PG8_WAIT_V(6); PG8_BAR; PG8_MMA(1, 1, At, B1); PG8_BAR;
            }
        }
        if constexpr (ALIGN_EPI) { if (wr == 0) PG8_BAR; }
        if constexpr (!Epi::AFTER_DRAIN) { int fr_e = fr, fq_e = fq; asm volatile("" : "+v"(fr_e), "+v"(fq_e));
            E(acc, cur, wr, wc, fr_e, fq_e); S.done(cur); }
        if (!has_next) break;
#pragma unroll
        for (int a = 0; a < 2; ++a)
#pragma unroll
            for (int b = 0; b < 2; ++b)
#pragma unroll
                for (int m = 0; m < 4; ++m)
#pragma unroll
                    for (int n = 0; n < 2; ++n) acc[a][b][m][n] = (f32x4){0.f, 0.f, 0.f, 0.f};
        cur = nxt; cA = nA; cB = nB; ++ui;
        if constexpr (ALIGN_EPI) { if (wr == 1) PG8_BAR; }
    }
    PG8_WAIT_V(0);
    if constexpr (!ALIGN_EPI) { if (wr == 0) PG8_BAR; }
    PG8_BAR;
    if constexpr (Epi::AFTER_DRAIN) { E.fused(acc, cur, wr, wc, fr, fq, lds, wid, lane); S.done(cur); }
#undef PG8_GLOAD
#undef PG8_SA
#undef PG8_SB
#undef PG8_SBR
#undef PG8_STAGE
#undef PG8_LDA
#undef PG8_LDB
#undef PG8_MMA
#undef PG8_LD16
#undef PG8_WAIT_V
#undef PG8_WAIT_L
#undef PG8_BAR
#undef PG8_SCHED
}
}

constexpr size_t MiB = 1u << 20;
constexpr size_t WS_CTL = 0, CTL_ZERO_BYTES = 1 * MiB;
constexpr size_t WS_MOD  = 1 * MiB;
constexpr size_t WS_WRT  = 2 * MiB;
constexpr size_t WS_MOEI = 3 * MiB;
constexpr size_t WS_IDT  = WS_MOEI + 5 * 512 * 1024;
constexpr size_t WS_LRC  = 6 * MiB;
constexpr size_t WS_DNS  = 12 * MiB;
constexpr size_t WS_WIN  = 16 * MiB;
constexpr size_t WS_WOUT = 56 * MiB;
constexpr size_t WS_WGU  = 72 * MiB;
constexpr size_t WS_WDN  = 584 * MiB;
constexpr size_t WS_X    = 840 * MiB;
constexpr size_t WS_H    = 976 * MiB;
constexpr size_t WS_P    = 1044 * MiB;
constexpr size_t WS_CC   = 1206 * MiB;
constexpr size_t WS_VT   = 1274 * MiB;
constexpr size_t WS_VTC  = WS_VT + 8 * MiB;
constexpr size_t WS_DNT  = 1284 * MiB;
constexpr size_t DNT_BYTES = 90112;
constexpr size_t WS_DNO  = 1472 * MiB;
constexpr size_t WS_LRH  = 1540 * MiB;
constexpr size_t WS_LRA  = 1608 * MiB;
constexpr size_t WS_XS   = 1676 * MiB;
constexpr size_t WS_ACT  = 1980 * MiB;
constexpr size_t WS_YS   = 2132 * MiB;
constexpr size_t WS_END  = 2436 * MiB;
constexpr int CW_TMO = 0;
constexpr int CW_BAR = 4096;
constexpr int CW_CNT = 8192;
constexpr int CW_ATQ = 12288;

constexpr int RING_OFF = 0, RING_BYTES = 131072;
constexpr int LDSCTL_OFF = RING_BYTES, MISC_OFF = LDSCTL_OFF + 320;
constexpr int LDS_X_OFF = RING_BYTES + 1024;
constexpr int LDS_BYTES = 147456;
constexpr int NWAVES = 8, NTHREADS = 512;

#define GAS __attribute__((address_space(1)))
#define LAS __attribute__((address_space(3)))
typedef unsigned short bf16;
typedef unsigned v4u __attribute__((ext_vector_type(4)));
typedef unsigned v2u __attribute__((ext_vector_type(2)));
typedef float f32x4 __attribute__((ext_vector_type(4)));
typedef float f32x16 __attribute__((ext_vector_type(16)));
typedef short bf16x8 __attribute__((ext_vector_type(8)));
typedef short bf16x4 __attribute__((ext_vector_type(4)));
typedef GAS unsigned gu32;
#define RLX_AGENT __ATOMIC_RELAXED, __HIP_MEMORY_SCOPE_AGENT
#define LDS_WAIT() asm volatile("s_waitcnt lgkmcnt(0)" ::: "memory")
#define VM_WAIT() asm volatile("s_waitcnt vmcnt(0)" ::: "memory")
#define LDS_BARRIER() asm volatile("s_waitcnt lgkmcnt(0)\n\ts_barrier" ::: "memory")
typedef __bf16 bf16x2_t __attribute__((ext_vector_type(2)));
typedef float f32x2_t __attribute__((ext_vector_type(2)));
__device__ __forceinline__ unsigned pk2(float lo, float hi) { const f32x2_t v = {lo, hi}; const bf16x2_t b = __builtin_convertvector(v, bf16x2_t); return __builtin_bit_cast(unsigned, b); }
__device__ __forceinline__ unsigned f2bf(float f) { return pk2(f, 0.f) & 0xffffu; }
__device__ __forceinline__ unsigned pk4_fp8(float a, float b, float c, float d) { int x = 0; x = __builtin_amdgcn_cvt_pk_fp8_f32(a, b, x, false); x = __builtin_amdgcn_cvt_pk_fp8_f32(c, d, x, true); return (unsigned)x; }
__device__ __forceinline__ float bf2f(unsigned short b) { return __builtin_bit_cast(float, (unsigned)b << 16); }
__device__ __forceinline__ float bflo(unsigned w) { return __builtin_bit_cast(float, w << 16); }
__device__ __forceinline__ float bfhi(unsigned w) { return __builtin_bit_cast(float, w & 0xffff0000u); }
template <int CTRL> __device__ __forceinline__ float dpp_mov(float v) { return __builtin_bit_cast(float, __builtin_amdgcn_update_dpp(0, __builtin_bit_cast(int, v), CTRL, 0xF, 0xF, false)); }
__device__ __forceinline__ float wave_sum(float v) {
    v += dpp_mov<0xB1>(v); v += dpp_mov<0x4E>(v); v += dpp_mov<0x141>(v); v += dpp_mov<0x140>(v);
    const int iv = __builtin_bit_cast(int, v);
    const float r0 = __builtin_bit_cast(float, __builtin_amdgcn_readlane(iv, 0)), r1 = __builtin_bit_cast(float, __builtin_amdgcn_readlane(iv, 16)), r2 = __builtin_bit_cast(float, __builtin_amdgcn_readlane(iv, 32)), r3 = __builtin_bit_cast(float, __builtin_amdgcn_readlane(iv, 48));
    return (r0 + r1) + (r2 + r3);
}
__device__ __forceinline__ float sigmoidf_(float x) { return __builtin_amdgcn_rcpf(1.0f + __builtin_amdgcn_exp2f(-1.4426950408889634f * x)); }
__device__ __forceinline__ float siluf_(float x) { return x * sigmoidf_(x); }
__device__ __forceinline__ float softplusf_(float x) { return x > 20.f ? x : log1pf(__expf(x)); }

#define XB_TMO      128
#define XB_XCNT(j)  (256  + 64 * (j))
#define XB_XSUB(j)  (1280 + 64 * (j))
#define XB_XGEN(j)  (2304 + 64 * (j))
#define XB_TOP      3328
#define XB_TOPGEN   3392
#define XCD_BAR_WORDS 3456
#define XB_SPIN_CAP (1u << 18)

__device__ __forceinline__ unsigned xb_ld(unsigned* p)              { return __hip_atomic_load(p, __ATOMIC_RELAXED, __HIP_MEMORY_SCOPE_AGENT); }
__device__ __forceinline__ unsigned xb_add(unsigned* p, unsigned v) { return __hip_atomic_fetch_add(p, v, __ATOMIC_RELAXED, __HIP_MEMORY_SCOPE_AGENT); }
__device__ __forceinline__ unsigned xb_xcc_id() { return (unsigned)__builtin_amdgcn_s_getreg((3 << 11) | 20) & 0xFu; }
#define XB_SPIN(cond, bar) do { unsigned _sp = 0; while (cond) { __builtin_amdgcn_s_sleep(1); \
    if ((++_sp & 255u) == 0u) { if (xb_ld(&(bar)[XB_TMO])) break; if (_sp > XB_SPIN_CAP) { atomicAdd(&(bar)[XB_TMO], 1u); break; } } } } while (0)

struct XcdBarrier {
    unsigned* bar; unsigned x;
    volatile LAS unsigned* st;
};

__device__ __forceinline__ XcdBarrier xcd_barrier_post(unsigned* bar, volatile LAS unsigned* st) {
    XcdBarrier b; b.bar = bar; b.x = xb_xcc_id(); b.st = st;
    if (threadIdx.x == 0) (void)xb_add(&bar[XB_XCNT(b.x)], 1u);
    return b;
}
__device__ __forceinline__ void xcd_barrier_complete(unsigned* bar, unsigned x, unsigned& nloc, unsigned& nx) {
    const unsigned G = gridDim.x * gridDim.y * gridDim.z;
    unsigned sum, cnt, mine, sp = 0u;
    for (;;) {
        sum = 0u; cnt = 0u; mine = 0u;
#pragma unroll
        for (unsigned j = 0; j < 16; ++j) { const unsigned c = xb_ld(&bar[XB_XCNT(j)]); sum += c; cnt += (c > 0u) ? 1u : 0u; mine = (j == x) ? c : mine; }
        if (sum == G) break;
        __builtin_amdgcn_s_sleep(1);
        if ((++sp & 255u) == 0u) { if (xb_ld(&bar[XB_TMO])) break; if (sp > XB_SPIN_CAP) { atomicAdd(&bar[XB_TMO], 1u); break; } }
    }
    nloc = mine > 0u ? mine : 1u; nx = cnt > 0u ? cnt : 1u;
}

__device__ __forceinline__ void xcd_barrier(const XcdBarrier& b) {
    asm volatile("s_waitcnt vmcnt(0)" ::: "memory");
    __syncthreads();
    if (threadIdx.x == 0) {
        unsigned* bar = b.bar;
        __builtin_amdgcn_s_waitcnt(0);
        unsigned nloc = b.st[0], nx = b.st[1];
        if (nloc == 0u) { xcd_barrier_complete(bar, b.x, nloc, nx); b.st[0] = nloc; b.st[1] = nx; }
        const unsigned old = xb_add(&bar[XB_XSUB(b.x)], 1u);
        const unsigned gen = old / nloc;
        if (old + 1u == (gen + 1u) * nloc) {
            __builtin_amdgcn_fence(__ATOMIC_RELEASE, "agent");
            asm volatile("s_waitcnt vmcnt(0)" ::: "memory");
            const unsigned og = xb_add(&bar[XB_TOP], 1u);
            const unsigned tg = og / nx;
            if (og + 1u == (tg + 1u) * nx) xb_add(&bar[XB_TOPGEN], 1u);
            else XB_SPIN(xb_ld(&bar[XB_TOPGEN]) == tg, bar);
            __builtin_amdgcn_fence(__ATOMIC_ACQUIRE, "agent");
            xb_add(&bar[XB_XGEN(b.x)], 1u);
            asm volatile("s_waitcnt vmcnt(0)" ::: "memory");
        } else {
            XB_SPIN(xb_ld(&bar[XB_XGEN(b.x)]) == gen, bar);
            __builtin_amdgcn_fence(__ATOMIC_ACQUIRE, "agent");
            asm volatile("s_waitcnt vmcnt(0)" ::: "memory");
        }
    }
    __syncthreads();
}

enum InIdx { I_X = 0, I_C, I_CTX, I_CCTX, I_WMOD, I_BMOD, I_NMG, I_NFG, I_WIN, I_WOUT, I_SINK, I_DNCW, I_DNALOG, I_DNDT, I_DNNG, I_LRCW, I_LRCB, I_LRWR, I_LRBR, I_LRWI, I_LRBI, I_LRLAM,
             I_WROUT, I_BROUT, I_WGU, I_BGU, I_WDN, I_BDN, I_FNG, N_IN };
struct Frame {
    LAS unsigned char* lds;
    volatile LAS unsigned* MISC;
    gu32* ctl;
    int tid, lane, wave, G, bid;
    const float* const __attribute__((address_space(4)))* in;
    float* out; unsigned char* ws;
};
__device__ __forceinline__ int mod_row(int m) { return m < NLAT ? (m >> 12) : 4; }
__device__ __forceinline__ bool phase_enter(Frame& F) { int t = threadIdx.x; asm volatile("" : "+v"(t)); F.tid = t; F.lane = t & 63; F.wave = __builtin_amdgcn_readfirstlane(t >> 6); return true; }
__device__ __forceinline__ void seq_of(int m, int& t, int& T, int& base) { if (m < NLAT) { t = m & 4095; T = SEQ; base = m - t; } else { t = (m - NLAT) & 255; T = CTXL; base = m - t; } }
__device__ __forceinline__ float gelu_tanh(float x) { const float u = 0.7978845608028654f * (x + 0.044715f * x * x * x); return x * sigmoidf_(2.0f * u); }

__device__ __forceinline__ void transpose_item(const float* W, int K, int N, bf16* WT, int k0, int dstrow0, int srccol0, int nvalid, LAS float* scr, int lane) {
    { const int c4 = (lane & 7) * 4, kr = lane >> 3; f32x4 v[8];
#pragma unroll
      for (int i = 0; i < 8; ++i) { v[i] = (f32x4){0.f, 0.f, 0.f, 0.f}; if (c4 < nvalid) v[i] = __builtin_nontemporal_load((const f32x4*)(W + (size_t)(k0 + 8 * i + kr) * N + srccol0 + c4)); }
#pragma unroll
      for (int i = 0; i < 8; ++i) { LAS float* d = scr + (8 * i + kr) * 33 + c4; d[0] = v[i].x; d[1] = v[i].y; d[2] = v[i].z; d[3] = v[i].w; } }
    LDS_WAIT(); asm volatile("" ::: "memory");
    const int c = lane & 7;
#pragma unroll
    for (int jj = 0; jj < 4; ++jj) { const int n = (lane >> 3) + 8 * jj; const LAS float* s = scr + (8 * c) * 33 + n;
        v4u o; o.x = pk2(s[0 * 33], s[1 * 33]); o.y = pk2(s[2 * 33], s[3 * 33]); o.z = pk2(s[4 * 33], s[5 * 33]); o.w = pk2(s[6 * 33], s[7 * 33]);
        *(GAS v4u*)(WT + (size_t)(dstrow0 + n) * K + k0 + 8 * c) = o; }
    LDS_WAIT(); asm volatile("" ::: "memory");
}
__device__ __forceinline__ void transpose_item_f8(const float* W, int K, int N, unsigned char* WT, int k0, int dstrow0, int srccol0, float scale, LAS float* scr, int lane) {
    { const int c4 = (lane & 7) * 4, kr = lane >> 3; f32x4 v[8];
#pragma unroll
      for (int i = 0; i < 8; ++i) v[i] = __builtin_nontemporal_load((const f32x4*)(W + (size_t)(k0 + 8 * i + kr) * N + srccol0 + c4));
#pragma unroll
      for (int i = 0; i < 8; ++i) { LAS float* d = scr + (8 * i + kr) * 33 + c4; d[0] = v[i].x; d[1] = v[i].y; d[2] = v[i].z; d[3] = v[i].w; } }
    LDS_WAIT(); asm volatile("" ::: "memory");
    { const int n = lane >> 1, hf = lane & 1; const LAS float* s = scr + (32 * hf) * 33 + n; unsigned w[8];
#pragma unroll
      for (int i = 0; i < 8; ++i) { int x = 0; x = __builtin_amdgcn_cvt_pk_fp8_f32(s[(4 * i + 0) * 33] * scale, s[(4 * i + 1) * 33] * scale, x, false); x = __builtin_amdgcn_cvt_pk_fp8_f32(s[(4 * i + 2) * 33] * scale, s[(4 * i + 3) * 33] * scale, x, true); w[i] = (unsigned)x; }
      v4u* o = (v4u*)(WT + (size_t)(dstrow0 + n) * K + k0 + 32 * hf); __builtin_nontemporal_store((v4u){w[0], w[1], w[2], w[3]}, o); __builtin_nontemporal_store((v4u){w[4], w[5], w[6], w[7]}, o + 1); }
    LDS_WAIT(); asm volatile("" ::: "memory");
}
__device__ __forceinline__ void p0_prologue(Frame& F) {
    {
        LAS float* sc = (LAS float*)(F.lds);
        LAS float* red = (LAS float*)(F.lds + 40960);
        bool have_sc = false;
        for (int wb = F.bid; wb < 192; wb += F.G) {
            if (!have_sc) {
                for (int i = F.tid; i < 5 * 2048; i += NTHREADS) { const int r = i >> 11, k = i & 2047; const float cv = r < 4 ? F.in[I_C][r * 2048 + k] : F.in[I_CCTX][k]; sc[i] = siluf_(cv); }
                have_sc = true; __syncthreads();
            }
            const int l = wb / 96, cb = wb % 96, kp = F.tid >> 5, cg = F.tid & 31, j0 = cb * 128 + cg * 4;
            const float* wp = F.in[I_WMOD] + ((size_t)l * 2048 + kp * 128) * 12288 + j0;
            f32x4 acc[5];
#pragma unroll
            for (int r = 0; r < 5; ++r) acc[r] = (f32x4){0.f, 0.f, 0.f, 0.f};
#pragma unroll 4
            for (int k = 0; k < 128; ++k) { const f32x4 w = *(const f32x4*)(wp + (size_t)k * 12288);
#pragma unroll
                for (int r = 0; r < 5; ++r) acc[r] += sc[r * 2048 + kp * 128 + k] * w; }
#pragma unroll
            for (int r = 0; r < 5; ++r) *(LAS f32x4*)(red + (kp * 5 + r) * 128 + cg * 4) = acc[r];
            __syncthreads();
            for (int i = F.tid; i < 640; i += NTHREADS) { const int r = i >> 7, col = i & 127; float s = F.in[I_BMOD][l * 12288 + cb * 128 + col];
#pragma unroll
                for (int q = 0; q < 16; ++q) s += red[(q * 5 + r) * 128 + col];
                ((float*)(F.ws + WS_MOD))[(size_t)(l * 5 + r) * 12288 + cb * 128 + col] = s; }
            __syncthreads();
        }
        __syncthreads();
    }
    { int* idt = (int*)(F.ws + WS_IDT); for (int r = F.bid * NTHREADS + F.tid; r < MOE_ROWS; r += F.G * NTHREADS) idt[r] = r; }
    {
        LAS float* scr = (LAS float*)(F.lds + F.wave * 16384);
        const int gw = F.bid * NWAVES + F.wave, NGW = F.G * NWAVES;
        constexpr int I_IN = 32 * 144, I_OUT = 32 * 64, I_RT = 32, I_16 = 32, PER_L = I_IN + I_OUT + I_RT + I_16;
        for (int it0 = gw; it0 < 2 * PER_L; it0 += NGW) {
            const int l = it0 / PER_L; int r = it0 % PER_L;
            if (r < I_IN) { const int nb = r % 144, kb = r / 144, d0 = nb * 32; int s0 = d0, nv = 32;
                if (d0 >= 3584) s0 = d0 + 16;
#if FP8_INPROJ
                transpose_item_f8(F.in[I_WIN] + (size_t)l * 2048 * IN_W, 2048, IN_W, F.ws + WS_WIN + (size_t)l * PW * 2048 * 2, kb * 64, d0, s0, 64.0f, scr, F.lane); continue; }
#else
                transpose_item(F.in[I_WIN] + (size_t)l * 2048 * IN_W, 2048, IN_W, (bf16*)(F.ws + WS_WIN) + (size_t)l * PW * 2048, kb * 64, d0, s0, nv, scr, F.lane); continue; }
#endif
            r -= I_IN;
            if (r < I_OUT) { const int nb = r % 64, kb = r / 64;
#if FP8_OUTPROJ
                transpose_item_f8(F.in[I_WOUT] + (size_t)l * 2048 * 2048, 2048, 2048, F.ws + WS_WOUT + (size_t)l * 2048 * 2048 * 2, kb * 64, nb * 32, nb * 32, 64.0f, scr, F.lane); continue; }
#else
                transpose_item(F.in[I_WOUT] + (size_t)l * 2048 * 2048, 2048, 2048, (bf16*)(F.ws + WS_WOUT) + (size_t)l * 2048 * 2048, kb * 64, nb * 32, nb * 32, 32, scr, F.lane); continue; }
#endif
            r -= I_OUT;
            if (r < I_RT) { transpose_item(F.in[I_WROUT] + (size_t)l * 2048 * 32, 2048, 32, (bf16*)(F.ws + WS_WRT) + (size_t)l * 32 * 2048, r * 64, 0, 0, 32, scr, F.lane); continue; }
            r -= I_RT;
            transpose_item(F.in[I_WIN] + (size_t)l * 2048 * IN_W, 2048, IN_W, (bf16*)(F.ws + WS_WRT + 512 * 1024) + (size_t)l * 32 * 2048, r * 64, 0, 3584, 16, scr, F.lane);
        }
    }
}
constexpr int CW_CVQ = 12288 + 512;
#ifndef FP8_GEMM2
#define FP8_GEMM2 1
#endif
constexpr float WGU_SCALE = 64.0f, WDN_SCALE = 64.0f; constexpr int WGU_E8M0 = 0x7C7C7C7C, WDN_E8M0 = 0x7C7C7C7C;
__device__ __forceinline__ void convert_moe_item(Frame& F, int l, int r, LAS float* scr) {
    constexpr int I_GU = 32 * 32 * 64;
    if (r < I_GU) { const int e = r / 2048, q = r % 2048, nb = q % 64, kb = q / 64; const int s0 = ((nb >> 2) & 1) * 1024 + (nb >> 3) * 128 + (nb & 3) * 32;
        transpose_item_f8(F.in[I_WGU] + (size_t)(l * 32 + e) * 2048 * 2048, 2048, 2048, F.ws + WS_WGU + (size_t)(l * 32 + e) * 2048 * 2048, kb * 64, nb * 32, s0, WGU_SCALE, scr, F.lane); return; }
    r -= I_GU;
    { const int e = r / 1024, q = r % 1024, nb = q % 64, kb = q / 64;
#if FP8_GEMM2
        transpose_item_f8(F.in[I_WDN] + (size_t)(l * 32 + e) * 1024 * 2048, 1024, 2048, F.ws + WS_WDN + (size_t)(l * 32 + e) * 2048 * 1024, kb * 64, nb * 32, nb * 32, WDN_SCALE, scr, F.lane);
#else
        transpose_item(F.in[I_WDN] + (size_t)(l * 32 + e) * 1024 * 2048, 1024, 2048, (bf16*)(F.ws + WS_WDN) + (size_t)(l * 32 + e) * 2048 * 1024, kb * 64, nb * 32, nb * 32, 32, scr, F.lane);
#endif
    }
}
constexpr int CVG = 8;
__device__ __forceinline__ bool convert_grab(Frame& F, int l, int rep, LAS float* scr) {
    constexpr int NIT = 32 * 32 * 64 + 32 * 16 * 64;
    int g = 0; if (F.lane == 0) g = (int)__hip_atomic_fetch_add(F.ctl + CW_CVQ + 64 * l + 8 * rep, 1u, RLX_AGENT); g = __builtin_amdgcn_readfirstlane(g);
    if (g * CVG >= NIT) return false;
#pragma unroll 1
    for (int k = 0; k < CVG; ++k) convert_moe_item(F, l, g * CVG + k, scr);
    return true;
}
__device__ __forceinline__ void convert_moe_queue(Frame& F, int l, int rep = 0) {
    LAS float* scr = (LAS float*)(F.lds + F.wave * 16384);
    __syncthreads();
    while (convert_grab(F, l, rep, scr)) {}
    __syncthreads();
}
constexpr int CW_TAIL = 16384;
__device__ __forceinline__ void tail_fill(Frame& F, int seam, int lt) {
    LAS int* flag = (LAS int*)(F.lds + LDS_X_OFF + 768);
    LAS float* scr = (LAS float*)(F.lds + F.wave * 16384);
    __syncthreads();
    if (F.tid == 0) (void)__hip_atomic_fetch_add(F.ctl + CW_TAIL + 64 * seam, 1u, RLX_AGENT);
    bool more = true;
    for (int it = 0; it < 4096; ++it) {
        if (F.tid == 0) *flag = (__hip_atomic_load(F.ctl + CW_TAIL + 64 * seam, RLX_AGENT) >= (unsigned)F.G) ? 1 : 0;
        __syncthreads();
        const int done = *flag;
        __syncthreads();
        if (done) break;
        if (more) more = convert_grab(F, lt, 0, scr); else __builtin_amdgcn_s_sleep(32);
    }
}

__device__ __forceinline__ void load_row(const float* src, int lane, f32x4 (&v)[8]) {
    const f32x4* p = (const f32x4*)src + lane;
#pragma unroll
    for (int j = 0; j < 8; ++j) v[j] = p[64 * j];
}
__device__ __forceinline__ void store_row(float* dst, int lane, const f32x4 (&v)[8]) {
    f32x4* p = (f32x4*)dst + lane;
#pragma unroll
    for (int j = 0; j < 8; ++j) p[64 * j] = v[j];
}
__device__ __forceinline__ void combine_row(Frame& F, int l, int m, int lane, f32x4 (&v)[8]) {
    const int* dest = (const int*)(F.ws + WS_MOEI + 2 * 512 * 1024) + m * 4;
    const float* g5 = (const float*)(F.ws + WS_MOD) + (size_t)(l * 5 + mod_row(m)) * 12288 + 5 * 2048;
    f32x4 acc[8];
#pragma unroll
    for (int j = 0; j < 8; ++j) acc[j] = (f32x4){0.f, 0.f, 0.f, 0.f};
#pragma unroll
    for (int k = 0; k < 4; ++k) { const int d = dest[k]; const v2u* yp = (const v2u*)((const bf16*)(F.ws + WS_YS) + (size_t)d * 2048) + lane;
#pragma unroll
        for (int j = 0; j < 8; ++j) { const v2u w = yp[64 * j]; acc[j] += (f32x4){bflo(w.x), bfhi(w.x), bflo(w.y), bfhi(w.y)}; } }
#pragma unroll
    for (int j = 0; j < 8; ++j) { const f32x4 gg = *((const f32x4*)g5 + lane + 64 * j); v[j] += gg * acc[j]; }
}
__device__ __forceinline__ void modnorm_store(const f32x4 (&v)[8], const float* g, const float* shift, const float* scale, bf16* hrow, int lane) {
    float ss = 0.f;
#pragma unroll
    for (int j = 0; j < 8; ++j) ss += (v[j].x * v[j].x + v[j].y * v[j].y) + (v[j].z * v[j].z + v[j].w * v[j].w);
    const float rstd = 1.0f / sqrtf(wave_sum(ss) * (1.0f / 2048.0f) + EPS);
    v2u* hp = (v2u*)hrow + lane;
#pragma unroll
    for (int j = 0; j < 8; ++j) { const f32x4 gg = *((const f32x4*)g + lane + 64 * j), sh = *((const f32x4*)shift + lane + 64 * j), sc = *((const f32x4*)scale + lane + 64 * j);
        const f32x4 y = (v[j] * rstd) * gg * (sc + 1.0f) + sh; v2u w; w.x = pk2(y.x, y.y); w.y = pk2(y.z, y.w); hp[64 * j] = w; }
}
constexpr size_t WS_W16 = WS_WRT + 512 * 1024;
__device__ __forceinline__ void phase_norm1(Frame& F, int l) {
    constexpr int TROW = 4112;
    LAS unsigned char* tile = F.lds; LAS float* part = (LAS float*)(F.lds + 66048);
    float* X = (float*)(F.ws + WS_X); bf16* H = (bf16*)(F.ws + WS_H); bf16* P = (bf16*)(F.ws + WS_P);
    const float* modp = (const float*)(F.ws + WS_MOD) + (size_t)l * 5 * 12288;
    const bf16* w16 = (const bf16*)(F.ws + WS_W16) + (size_t)l * 32 * 2048;
    for (int r0 = F.bid * 16; r0 < NTOK; r0 += F.G * 16) {
#pragma unroll 1
        for (int rr = 0; rr < 2; ++rr) { const int lr = 2 * F.wave + rr, m = r0 + lr;
            f32x4 v[8];
            if (l == 0) load_row(m < NLAT ? F.in[I_X] + (size_t)m * DM : F.in[I_CTX] + (size_t)(m - NLAT) * DM, F.lane, v);
            else { load_row(X + (size_t)m * DM, F.lane, v); if (MK_STAGE >= 9) { combine_row(F, l - 1, m, F.lane, v); store_row(X + (size_t)m * DM, F.lane, v); } }
            float ss = 0.f;
#pragma unroll
            for (int j = 0; j < 8; ++j) ss += (v[j].x * v[j].x + v[j].y * v[j].y) + (v[j].z * v[j].z + v[j].w * v[j].w);
            const float rstd = 1.0f / sqrtf(wave_sum(ss) * (1.0f / 2048.0f) + EPS);
            const float* mr = modp + (size_t)mod_row(m) * 12288; const float* g = F.in[I_NMG] + l * DM;
#if FP8_INPROJ
            unsigned* hp = (unsigned*)(F.ws + WS_XS + (size_t)m * DM) + F.lane; LAS v2u* tp = (LAS v2u*)(tile + lr * TROW) + F.lane;
#else
            v2u* hp = (v2u*)(H + (size_t)m * DM) + F.lane; LAS v2u* tp = (LAS v2u*)(tile + lr * TROW) + F.lane;
#endif
#pragma unroll
            for (int j = 0; j < 8; ++j) { const f32x4 gg = *((const f32x4*)g + F.lane + 64 * j), sh = *((const f32x4*)mr + F.lane + 64 * j), sc = *((const f32x4*)(mr + 2048) + F.lane + 64 * j);
                const f32x4 y = (v[j] * rstd) * gg * (sc + 1.0f) + sh; v2u w; w.x = pk2(y.x, y.y); w.y = pk2(y.z, y.w); tp[64 * j] = w;
#if FP8_INPROJ
                int x8 = 0; x8 = __builtin_amdgcn_cvt_pk_fp8_f32(y.x, y.y, x8, false); x8 = __builtin_amdgcn_cvt_pk_fp8_f32(y.z, y.w, x8, true); hp[64 * j] = (unsigned)x8; }
#else
                hp[64 * j] = w; }
#endif
        }
        __syncthreads();
        { const int row = F.lane & 15, q = F.lane >> 4; f32x4 acc = {0.f, 0.f, 0.f, 0.f};
#pragma unroll
          for (int ks = 0; ks < 8; ++ks) { const int k0 = 256 * F.wave + 32 * ks + 8 * q;
              const bf16x8 a = *(const LAS bf16x8*)(tile + row * TROW + k0 * 2); const bf16x8 b = *(const bf16x8*)(w16 + (size_t)row * 2048 + k0);
              acc = __builtin_amdgcn_mfma_f32_16x16x32_bf16(a, b, acc, 0, 0, 0); }
#pragma unroll
          for (int i = 0; i < 4; ++i) part[(F.wave * 16 + 4 * q + i) * 16 + row] = acc[i]; }
        __syncthreads();
        if (F.tid < 256) { const int rw = F.tid >> 4, c = F.tid & 15; float sacc = 0.f;
#pragma unroll
            for (int w = 0; w < 8; ++w) sacc += part[(w * 16 + rw) * 16 + c];
            P[(size_t)(r0 + rw) * PW + PC_BETA + c] = (bf16)f2bf(sacc); }
        __syncthreads();
    }
}
__device__ __forceinline__ void phase_final(Frame& F, bool with_combine) {
    const int gw = F.bid * NWAVES + F.wave, NGW = F.G * NWAVES;
    const float* X = (const float*)(F.ws + WS_X);
    for (int m = gw; m < NLAT; m += NGW) {
        f32x4 v[8];
        if (with_combine) { load_row(X + (size_t)m * DM, F.lane, v); combine_row(F, 1, m, F.lane, v); }
        else load_row(F.in[I_X] + (size_t)m * DM, F.lane, v);
        float ss = 0.f;
#pragma unroll
        for (int j = 0; j < 8; ++j) ss += (v[j].x * v[j].x + v[j].y * v[j].y) + (v[j].z * v[j].z + v[j].w * v[j].w);
        const float rstd = 1.0f / sqrtf(wave_sum(ss) * (1.0f / 2048.0f) + EPS);
        f32x4* op = (f32x4*)(F.out + (size_t)m * DM) + F.lane;
#pragma unroll
        for (int j = 0; j < 8; ++j) { const f32x4 gg = *((const f32x4*)F.in[I_FNG] + F.lane + 64 * j); op[64 * j] = v[j] * rstd * gg; }
    }
}

__device__ __forceinline__ void phase_inproj(Frame& F, int l) {
#if FP8_INPROJ
    pg8::Gemm g{(const bf16*)(F.ws + WS_XS), (const bf16*)(F.ws + WS_WIN + (size_t)l * PW * 2048 * 2), NTOK, 4608, 1024, 0x7C7C7C7C};
    pg8::StaticOrderG S; S.init(g, F.G, F.bid); S.row_tab = (const int*)(F.ws + WS_IDT);
    pg8::EpiBf16Plain E{(bf16*)(F.ws + WS_P), PW};
    pg8::gemm_phase<pg8::EpiBf16Plain, pg8::StaticOrderG, true, true, true>(F.lds + RING_OFF, g, S, E);
#else
    pg8::Gemm g{(const bf16*)(F.ws + WS_H), (const bf16*)(F.ws + WS_WIN) + (size_t)l * PW * 2048, NTOK, 4608, 2048};
    pg8::StaticOrder S; S.init(g, F.G, F.bid);
    pg8::EpiBf16Plain E{(bf16*)(F.ws + WS_P), PW};
    pg8::gemm_phase<pg8::EpiBf16Plain, pg8::StaticOrder, true, true>(F.lds + RING_OFF, g, S, E);
#endif
}
__device__ __forceinline__ void phase_outproj(Frame& F, int l) {
    float* X = (float*)(F.ws + WS_X);
#if FP8_OUTPROJ
    pg8::Gemm g{(const bf16*)(F.ws + WS_CC), (const bf16*)(F.ws + WS_WOUT + (size_t)l * 2048 * 2048 * 2), l == 0 ? NTOK : NLAT, 2048, 1024, 0x7C7C7C7C};
    pg8::StaticOrderG S; S.init(g, F.G, F.bid); S.row_tab = (const int*)(F.ws + WS_IDT);
#else
    pg8::Gemm g{(const bf16*)(F.ws + WS_CC), (const bf16*)(F.ws + WS_WOUT) + (size_t)l * 2048 * 2048, l == 0 ? NTOK : NLAT, 2048, 2048};
    pg8::StaticOrder S; S.init(g, F.G, F.bid);
#endif
    pg8::EpiResGate E{l == 0 ? F.in[I_X] : X, l == 0 ? F.in[I_CTX] : X + (size_t)NLAT * DM, X, (const float*)(F.ws + WS_MOD) + (size_t)l * 5 * 12288 + 2 * 2048};
#if FP8_OUTPROJ
    pg8::gemm_phase<pg8::EpiResGate, pg8::StaticOrderG, true, true, true>(F.lds + RING_OFF, g, S, E);
#else
    pg8::gemm_phase<pg8::EpiResGate, pg8::StaticOrder, true, true>(F.lds + RING_OFF, g, S, E);
#endif
}
#ifndef PHASE_INPROJ
#define PHASE_INPROJ(F, l) phase_inproj(F, l)
#endif
#ifndef PHASE_OUTPROJ
#define PHASE_OUTPROJ(F, l) phase_outproj(F, l)
#endif

constexpr size_t WS_H8 = WS_XS;
constexpr size_t MOEI_TOPE = WS_MOEI, MOEI_TOPG = WS_MOEI + 512 * 1024, MOEI_DEST = WS_MOEI + 2 * 512 * 1024, MOEI_ROWG = WS_MOEI + 3 * 512 * 1024, MOEI_ROWT = WS_MOEI + 4 * 512 * 1024, MOEI_IDT = WS_IDT;
__device__ __forceinline__ void phase_norm2(Frame& F, int l) {
    const int nrows = (l == 0) ? NTOK : NLAT;
    constexpr int TROW = 4112;
    LAS unsigned char* tile = F.lds;
    LAS float* part = (LAS float*)(F.lds + 66048);
    LAS float* lg = (LAS float*)(F.lds + 66048 + 16384);
    const float* X = (const float*)(F.ws + WS_X); bf16* H = (bf16*)(F.ws + WS_H);
    const float* modp = (const float*)(F.ws + WS_MOD) + (size_t)l * 5 * 12288;
    const bf16* wrt = (const bf16*)(F.ws + WS_WRT) + (size_t)l * 32 * 2048;
    int* tope = (int*)(F.ws + MOEI_TOPE); float* topg = (float*)(F.ws + MOEI_TOPG);
    for (int r0 = F.bid * 16; r0 < nrows; r0 += F.G * 16) {
#pragma unroll 1
        for (int rr = 0; rr < 2; ++rr) {
            const int lr = 2 * F.wave + rr, m = r0 + lr;
            f32x4 v[8]; load_row(X + (size_t)m * DM, F.lane, v);
            float ss = 0.f;
#pragma unroll
            for (int j = 0; j < 8; ++j) ss += (v[j].x * v[j].x + v[j].y * v[j].y) + (v[j].z * v[j].z + v[j].w * v[j].w);
            const float rstd = 1.0f / sqrtf(wave_sum(ss) * (1.0f / 2048.0f) + EPS);
            const float* mr = modp + (size_t)mod_row(m) * 12288; const float* g = F.in[I_NFG] + l * DM;
            unsigned* hp = (unsigned*)(F.ws + WS_H8 + (size_t)m * DM) + F.lane; LAS v2u* tp = (LAS v2u*)(tile + lr * TROW) + F.lane;
#pragma unroll
            for (int j = 0; j < 8; ++j) { const f32x4 gg = *((const f32x4*)g + F.lane + 64 * j), sh = *((const f32x4*)(mr + 3 * 2048) + F.lane + 64 * j), sc = *((const f32x4*)(mr + 4 * 2048) + F.lane + 64 * j);
                const f32x4 y = (v[j] * rstd) * gg * (sc + 1.0f) + sh; v2u w; w.x = pk2(y.x, y.y); w.y = pk2(y.z, y.w); tp[64 * j] = w;
                int x8 = 0; x8 = __builtin_amdgcn_cvt_pk_fp8_f32(y.x, y.y, x8, false); x8 = __builtin_amdgcn_cvt_pk_fp8_f32(y.z, y.w, x8, true); hp[64 * j] = (unsigned)x8; }
        }
        __syncthreads();
        {
            const int row = F.lane & 15, q = F.lane >> 4;
            f32x4 acc0 = {0.f, 0.f, 0.f, 0.f}, acc1 = {0.f, 0.f, 0.f, 0.f};
#pragma unroll
            for (int ks = 0; ks < 8; ++ks) { const int k0 = 256 * F.wave + 32 * ks + 8 * q;
                const bf16x8 a = *(const LAS bf16x8*)(tile + row * TROW + k0 * 2);
                const bf16x8 b0 = *(const bf16x8*)(wrt + (size_t)row * 2048 + k0), b1 = *(const bf16x8*)(wrt + (size_t)(16 + row) * 2048 + k0);
                acc0 = __builtin_amdgcn_mfma_f32_16x16x32_bf16(a, b0, acc0, 0, 0, 0); acc1 = __builtin_amdgcn_mfma_f32_16x16x32_bf16(a, b1, acc1, 0, 0, 0); }
#pragma unroll
            for (int i = 0; i < 4; ++i) { part[(F.wave * 16 + 4 * q + i) * 32 + row] = acc0[i]; part[(F.wave * 16 + 4 * q + i) * 32 + 16 + row] = acc1[i]; }
        }
        __syncthreads();
        { const int rw = F.tid >> 5, e = F.tid & 31; float s = F.in[I_BROUT][l * 32 + e];
#pragma unroll
          for (int w = 0; w < 8; ++w) s += part[(w * 16 + rw) * 32 + e];
          lg[rw * 32 + e] = s; }
        __syncthreads();
        if (F.tid < 16) { const int m = r0 + F.tid; float val[4]; int idx[4]; unsigned taken = 0u;
#pragma unroll
            for (int k = 0; k < 4; ++k) { float best = -3.0e38f; int bi = 0;
                for (int e = 0; e < 32; ++e) { const float x = lg[F.tid * 32 + e]; if (!((taken >> e) & 1u) && x > best) { best = x; bi = e; } }
                val[k] = best; idx[k] = bi; taken |= 1u << bi; }
            float p[4], sum = 0.f;
#pragma unroll
            for (int k = 0; k < 4; ++k) { p[k] = __expf(val[k] - val[0]); sum += p[k]; }
#pragma unroll
            for (int k = 0; k < 4; ++k) { const unsigned rank = __hip_atomic_fetch_add(F.ctl + CW_CNT + 64 * l + idx[k], 1u, RLX_AGENT);
                tope[m * 4 + k] = idx[k] | (int)(rank << 8); topg[m * 4 + k] = p[k] / sum; }
        }
        __syncthreads();
    }
}
__device__ __forceinline__ void moe_tables(Frame& F, int l) {
    LAS int* blk_end = (LAS int*)(F.lds + LDS_X_OFF); LAS int* pstart = blk_end + 32; LAS int* cnts = blk_end + 64;
    if (F.tid == 0) { int nb = 0;
        for (int e = 0; e < 32; ++e) { const int c = (int)__hip_atomic_load(F.ctl + CW_CNT + 64 * l + e, RLX_AGENT); cnts[e] = c; pstart[e] = nb * 256; nb += (c + 255) >> 8; blk_end[e] = nb; } }
    __syncthreads();
}
__device__ __forceinline__ void phase_scatter(Frame& F, int l) {
    const int nrows = (l == 0) ? NTOK : NLAT;
    moe_tables(F, l);
    const LAS int* blk_end = (const LAS int*)(F.lds + LDS_X_OFF); const LAS int* pstart = blk_end + 32; const LAS int* cnts = blk_end + 64;
    const int* tope = (const int*)(F.ws + MOEI_TOPE); const float* topg = (const float*)(F.ws + MOEI_TOPG);
    int* dest = (int*)(F.ws + MOEI_DEST); float* rowg = (float*)(F.ws + MOEI_ROWG); int* rowt = (int*)(F.ws + MOEI_ROWT);
    for (int a = F.bid * NTHREADS + F.tid; a < nrows * 4; a += F.G * NTHREADS) {
        const int te = tope[a], e = te & 255, rank = (int)((unsigned)te >> 8), d = pstart[e] + rank;
        dest[a] = d; rowg[d] = topg[a]; rowt[d] = a >> 2; }
    if (F.bid < 32) { const int e = F.bid, r0 = pstart[e] + cnts[e], r1 = blk_end[e] * 256;
        for (int r = r0 + F.tid; r < r1; r += NTHREADS) { rowt[r] = 0; rowg[r] = 0.f; } }
}
__device__ __forceinline__ void phase_gemm1(Frame& F, int l) {
    moe_tables(F, l);
    const LAS int* blk_end = (const LAS int*)(F.lds + LDS_X_OFF);
    pg8::Gemm g{(const bf16*)(F.ws + WS_H8), (const bf16*)(F.ws + WS_WGU + (size_t)l * 32 * 2048 * 2048), MOE_ROWS, 2048, 1024, WGU_E8M0};
    pg8::MoeOrderG S{F.bid, __builtin_amdgcn_readfirstlane(blk_end[31]), (const char*)g.A, (const char*)g.Bt, (size_t)256 * 2048, (size_t)2048 * 2048, (size_t)256 * 2048, blk_end, (const int*)(F.ws + MOEI_ROWT)};
#if FP8_GEMM2
    pg8::EpiSwiglu8 E{F.ws + WS_ACT, F.in[I_BGU] + (size_t)l * 32 * 2048};
    pg8::gemm_phase<pg8::EpiSwiglu8, pg8::MoeOrderG, true, true, true>(F.lds + RING_OFF, g, S, E);
#else
    pg8::EpiSwiglu E{(bf16*)(F.ws + WS_ACT), F.in[I_BGU] + (size_t)l * 32 * 2048};
    pg8::gemm_phase<pg8::EpiSwiglu, pg8::MoeOrderG, true, true, true>(F.lds + RING_OFF, g, S, E);
#endif
}
__device__ __forceinline__ void phase_gemm2(Frame& F, int l) {
    moe_tables(F, l);
    const LAS int* blk_end = (const LAS int*)(F.lds + LDS_X_OFF);
#if FP8_GEMM2
    pg8::Gemm g{(const bf16*)(F.ws + WS_ACT), (const bf16*)(F.ws + WS_WDN + (size_t)l * 32 * 2048 * 1024), MOE_ROWS, 2048, 512, WDN_E8M0};
    pg8::MoeOrderG S{F.bid, __builtin_amdgcn_readfirstlane(blk_end[31]), (const char*)g.A, (const char*)g.Bt, (size_t)256 * 1024, (size_t)2048 * 1024, (size_t)256 * 1024, blk_end, (const int*)(F.ws + MOEI_IDT)};
    pg8::EpiDown E{(bf16*)(F.ws + WS_YS), F.in[I_BDN] + (size_t)l * 32 * 2048, (const float*)(F.ws + MOEI_ROWG)};
    pg8::gemm_phase<pg8::EpiDown, pg8::MoeOrderG, true, true, true>(F.lds + RING_OFF, g, S, E);
#else
    pg8::Gemm g{(const bf16*)(F.ws + WS_ACT), (const bf16*)(F.ws + WS_WDN) + (size_t)l * 32 * 2048 * 1024, MOE_ROWS, 2048, 1024};
    pg8::MoeOrder S{F.bid, __builtin_amdgcn_readfirstlane(blk_end[31]), (const char*)g.A, (const char*)g.Bt, (size_t)256 * 1024 * 2, (size_t)2048 * 1024 * 2, (size_t)256 * 1024 * 2, blk_end, nullptr};
    pg8::EpiDown E{(bf16*)(F.ws + WS_YS), F.in[I_BDN] + (size_t)l * 32 * 2048, (const float*)(F.ws + MOEI_ROWG)};
    pg8::gemm_phase<pg8::EpiDown, pg8::MoeOrder, true, true>(F.lds + RING_OFF, g, S, E);
#endif
}
#ifndef PHASE_NORM2
#define PHASE_NORM2(F, l) phase_norm2(F, l)
#endif
#ifndef PHASE_SCATTER
#define PHASE_SCATTER(F, l) phase_scatter(F, l)
#endif
#ifndef PHASE_GEMM1
#define PHASE_GEMM1(F, l) phase_gemm1(F, l)
#endif
#ifndef PHASE_GEMM2
#define PHASE_GEMM2(F, l) phase_gemm2(F, l)
#endif
#define USE_MFMA_ATTN 1

__device__ __forceinline__ void attn_prep(Frame& F, int l) {
    bf16* P = (bf16*)(F.ws + WS_P);
    LAS unsigned short* vt = (LAS unsigned short*)F.lds;
    for (int ct = F.bid; ct < NCT; ct += F.G) {
        const int m0 = ct * 64; const bool lat = m0 < NLAT;
        __syncthreads();
        for (int i = F.tid; i < 64 * 32; i += NTHREADS) { const int tk = i >> 5, c8 = i & 31;
            const v4u w = *(const v4u*)(P + (size_t)(m0 + tk) * PW + PC_V + c8 * 8);
            const unsigned ww[4] = {w.x, w.y, w.z, w.w};
#pragma unroll
            for (int q = 0; q < 4; ++q) { vt[(c8 * 8 + 2 * q) * 66 + tk] = (unsigned short)(ww[q] & 0xffffu); vt[(c8 * 8 + 2 * q + 1) * 66 + tk] = (unsigned short)(ww[q] >> 16); } }
        if (lat) { const int tk = F.tid >> 3, kvh = (F.tid >> 1) & 3, hf = F.tid & 1; const int t = (m0 + tk) & 4095;
            bf16* kp = P + (size_t)(m0 + tk) * PW + PC_K + kvh * 64 + hf * 32;
            const v4u w0 = *(const v4u*)kp, w1 = *(const v4u*)(kp + 8), w2 = *(const v4u*)(kp + 16), w3 = *(const v4u*)(kp + 24);
            const unsigned lo[8] = {w0.x, w0.y, w0.z, w0.w, w1.x, w1.y, w1.z, w1.w}, hi_[8] = {w2.x, w2.y, w2.z, w2.w, w3.x, w3.y, w3.z, w3.w};
            const float pos = (float)(hf ? (t & 63) : (t >> 6)); unsigned o1[8], o2[8];
#pragma unroll
            for (int jj = 0; jj < 8; ++jj) { float r1[2], r2[2];
#pragma unroll
                for (int e = 0; e < 2; ++e) { const int j = 2 * jj + e; const float inv = __builtin_amdgcn_exp2f(-(float)j * 0.8304820237218406f); const float sn = __sinf(pos * inv), cs = __cosf(pos * inv);
                    const float x1 = e ? bfhi(lo[jj]) : bflo(lo[jj]), x2 = e ? bfhi(hi_[jj]) : bflo(hi_[jj]); r1[e] = x1 * cs - x2 * sn; r2[e] = x2 * cs + x1 * sn; }
                o1[jj] = pk2(r1[0], r1[1]); o2[jj] = pk2(r2[0], r2[1]); }
            *(v4u*)kp = (v4u){o1[0], o1[1], o1[2], o1[3]}; *(v4u*)(kp + 8) = (v4u){o1[4], o1[5], o1[6], o1[7]}; *(v4u*)(kp + 16) = (v4u){o2[0], o2[1], o2[2], o2[3]}; *(v4u*)(kp + 24) = (v4u){o2[4], o2[5], o2[6], o2[7]}; }
        __syncthreads();
        for (int i = F.tid; i < 256 * 8; i += NTHREADS) { const int col = i >> 3, c = i & 7, kvh = col >> 6, d = col & 63;
            v4u o; const LAS unsigned short* s = vt + col * 66 + c * 8;
            o.x = s[0] | ((unsigned)s[1] << 16); o.y = s[2] | ((unsigned)s[3] << 16); o.z = s[4] | ((unsigned)s[5] << 16); o.w = s[6] | ((unsigned)s[7] << 16);
            if (lat) { const int b = m0 >> 12, t0 = m0 & 4095; *(v4u*)((bf16*)(F.ws + WS_VT) + ((size_t)(b * 4 + kvh) * 64 + d) * SEQ + t0 + c * 8) = o; }
            else { const int mm = m0 - NLAT, b = mm >> 8, t0 = mm & 255; *(v4u*)((bf16*)(F.ws + WS_VTC) + ((size_t)(b * 4 + kvh) * 64 + d) * CTXL + t0 + c * 8) = o; } }
    }
    __syncthreads();
}

constexpr int AT_KP = 144, AT_VP = 136;
constexpr int AT_KOFF = 0, AT_VOFF = 64 * AT_KP, AT_TILE = 64 * AT_KP + 64 * AT_VP;
__device__ __forceinline__ void attn_unit(Frame& F, int l, int b, int kvh, int qi, int is_ctx) {
    const bf16* P = (const bf16*)(F.ws + WS_P); bf16* CC = (bf16*)(F.ws + WS_CC);
    int lane_o = F.lane; asm volatile("" : "+v"(lane_o));
    const int g = F.wave >> 1, qh = F.wave & 1, hq = kvh * 4 + g, r32 = lane_o & 31, hi = lane_o >> 5;
    const int rowbase = is_ctx ? NLAT + b * CTXL : b * SEQ;
    const int qa = qi * 128 + qh * 64;
    const float LOG2E = 1.4426950408889634f;
    bf16x8 qf[2][4];
#pragma unroll
    for (int qt = 0; qt < 2; ++qt) { const int tq = qa + 32 * qt + r32; const bf16* qp = P + (size_t)(rowbase + tq) * PW + PC_Q + hq * 64 + 8 * hi;
        float x[4][8];
#pragma unroll
        for (int s = 0; s < 4; ++s) { const v4u w = *(const v4u*)(qp + 16 * s); x[s][0] = bflo(w.x); x[s][1] = bfhi(w.x); x[s][2] = bflo(w.y); x[s][3] = bfhi(w.y); x[s][4] = bflo(w.z); x[s][5] = bfhi(w.z); x[s][6] = bflo(w.w); x[s][7] = bfhi(w.w); }
        if (!is_ctx) {
#pragma unroll
            for (int hf = 0; hf < 2; ++hf) { const float pos = (float)(hf ? (tq & 63) : (tq >> 6));
#pragma unroll
                for (int j = 0; j < 8; ++j) { const float inv = __builtin_amdgcn_exp2f(-(float)(8 * hi + j) * 0.8304820237218406f); const float sn = __sinf(pos * inv), cs = __cosf(pos * inv);
                    const float x1 = x[2 * hf][j], x2 = x[2 * hf + 1][j]; x[2 * hf][j] = x1 * cs - x2 * sn; x[2 * hf + 1][j] = x2 * cs + x1 * sn; } } }
        const float sc = 0.125f * LOG2E;
#pragma unroll
        for (int s = 0; s < 4; ++s) { v4u w; w.x = pk2(x[s][0] * sc, x[s][1] * sc); w.y = pk2(x[s][2] * sc, x[s][3] * sc); w.z = pk2(x[s][4] * sc, x[s][5] * sc); w.w = pk2(x[s][6] * sc, x[s][7] * sc); qf[qt][s] = __builtin_bit_cast(bf16x8, w); }
    }
    float mrun[2], lrun[2]; f32x16 O[2][2];
    { const float sk = F.in[I_SINK][l * 16 + hq] * LOG2E;
#pragma unroll
      for (int qt = 0; qt < 2; ++qt) { mrun[qt] = sk; lrun[qt] = hi ? 0.f : 1.f;
#pragma unroll
        for (int db = 0; db < 2; ++db)
#pragma unroll
            for (int r = 0; r < 16; ++r) O[qt][db][r] = 0.f; } }
    const int kt_lo = is_ctx ? 0 : (qi == 0 ? 2 : 0), nl = is_ctx ? 0 : (6 - (qi == 0 ? 2 : 0) - (qi == 31 ? 2 : 0)), ntile = nl + 4;
    const int rr = F.tid >> 3, cch = F.tid & 7;
    const bf16* kbase_l = P + (size_t)(b * SEQ + rr) * PW + PC_K + kvh * 64 + cch * 8; const bf16* kbase_c = P + (size_t)(NLAT + b * CTXL + rr) * PW + PC_K + kvh * 64 + cch * 8;
    const bf16* vbase_l = (const bf16*)(F.ws + WS_VT) + ((size_t)(b * 4 + kvh) * 64 + rr) * SEQ + cch * 8; const bf16* vbase_c = (const bf16*)(F.ws + WS_VTC) + ((size_t)(b * 4 + kvh) * 64 + rr) * CTXL + cch * 8;
    v4u kw, vw;
    { const bool loc0 = nl > 0; const int k00 = loc0 ? 128 * (qi - 1) + 64 * kt_lo : 0; kw = *(const v4u*)((loc0 ? kbase_l : kbase_c) + (size_t)k00 * PW); vw = *(const v4u*)((loc0 ? vbase_l : vbase_c) + k00); }
    LDS_BARRIER();
#pragma unroll 1
    for (int jt = 0; jt < ntile; ++jt) {
        const bool local = jt < nl; const int k0 = local ? 128 * (qi - 1) + 64 * (kt_lo + jt) : 64 * (jt - nl);
        const LAS unsigned char* KS = F.lds + (jt & 1) * AT_TILE + AT_KOFF; const LAS unsigned char* VS = F.lds + (jt & 1) * AT_TILE + AT_VOFF;
        { *(LAS v4u*)(F.lds + (jt & 1) * AT_TILE + AT_KOFF + rr * AT_KP + cch * 16) = kw;
          LAS v2u* vd = (LAS v2u*)(F.lds + (jt & 1) * AT_TILE + AT_VOFF + rr * AT_VP + cch * 16); vd[0] = (v2u){vw.x, vw.y}; vd[1] = (v2u){vw.z, vw.w}; }
        if (jt + 1 < ntile) { const bool ln = jt + 1 < nl; const int kn = ln ? 128 * (qi - 1) + 64 * (kt_lo + jt + 1) : 64 * (jt + 1 - nl);
            kw = *(const v4u*)((ln ? kbase_l : kbase_c) + (size_t)kn * PW); vw = *(const v4u*)((ln ? vbase_l : vbase_c) + kn); }
        LDS_BARRIER();
        if (local && (k0 + 63 < qa - 128 || k0 > qa + 63 + 128)) continue;
#pragma unroll 1
        for (int kb = 0; kb < 2; ++kb) {
            bf16x8 kf[4];
#pragma unroll
            for (int ss = 0; ss < 4; ++ss) kf[ss] = *(const LAS bf16x8*)(KS + (32 * kb + r32) * AT_KP + (16 * ss + 8 * hi) * 2);
            bf16x8 pb[2][2];
#pragma unroll
            for (int qt = 0; qt < 2; ++qt) { const int tq = qa + 32 * qt + r32;
                f32x16 s;
#pragma unroll
                for (int r = 0; r < 16; ++r) s[r] = 0.f;
#pragma unroll
                for (int ss = 0; ss < 4; ++ss) s = __builtin_amdgcn_mfma_f32_32x32x16_bf16(kf[ss], qf[qt][ss], s, 0, 0, 0);
                if (local) {
#pragma unroll
                    for (int r = 0; r < 16; ++r) { const int kidx = k0 + 32 * kb + (r & 3) + 8 * (r >> 2) + 4 * hi; const int dlt = kidx - tq; if (dlt > 128 || dlt < -128) s[r] = -1.0e30f; } }
                float mloc = s[0];
#pragma unroll
                for (int r = 1; r < 16; ++r) mloc = fmaxf(mloc, s[r]);
                mloc = fmaxf(mloc, __shfl_xor(mloc, 32));
                const float mnew = fmaxf(mrun[qt], mloc), alpha = __builtin_amdgcn_exp2f(mrun[qt] - mnew); mrun[qt] = mnew;
                float psum = 0.f;
#pragma unroll
                for (int r = 0; r < 16; ++r) { s[r] = __builtin_amdgcn_exp2f(s[r] - mnew); psum += s[r]; }
                lrun[qt] = lrun[qt] * alpha + psum;
#pragma unroll
                for (int db = 0; db < 2; ++db)
#pragma unroll
                    for (int r = 0; r < 16; ++r) O[qt][db][r] *= alpha;
#pragma unroll
                for (int s2 = 0; s2 < 2; ++s2) { v4u pw; pw.x = pk2(s[8 * s2 + 0], s[8 * s2 + 1]); pw.y = pk2(s[8 * s2 + 2], s[8 * s2 + 3]); pw.z = pk2(s[8 * s2 + 4], s[8 * s2 + 5]); pw.w = pk2(s[8 * s2 + 6], s[8 * s2 + 7]);
                    pb[qt][s2] = __builtin_bit_cast(bf16x8, pw); }
            }
#pragma unroll
            for (int s2 = 0; s2 < 2; ++s2)
#pragma unroll
                for (int db = 0; db < 2; ++db) { const LAS v2u* vp = (const LAS v2u*)(VS + (32 * db + r32) * AT_VP + (32 * kb + 16 * s2 + 4 * hi) * 2);
                    const v2u a0 = vp[0], a1 = vp[2]; v4u aw; aw.x = a0.x; aw.y = a0.y; aw.z = a1.x; aw.w = a1.y; const bf16x8 va = __builtin_bit_cast(bf16x8, aw);
                    O[0][db] = __builtin_amdgcn_mfma_f32_32x32x16_bf16(va, pb[0][s2], O[0][db], 0, 0, 0);
                    O[1][db] = __builtin_amdgcn_mfma_f32_32x32x16_bf16(va, pb[1][s2], O[1][db], 0, 0, 0); }
        }
    }
    int r32e = r32, hie = hi; asm volatile("" : "+v"(r32e), "+v"(hie));
#pragma unroll
    for (int qt = 0; qt < 2; ++qt) { const float lt = lrun[qt] + __shfl_xor(lrun[qt], 32); const float rl = 1.0f / lt; const int tq = qa + 32 * qt + r32e;
#if FP8_OUTPROJ
        unsigned char* op8 = (unsigned char*)CC + (size_t)(rowbase + tq) * DM + hq * 64 + 4 * hie;
#pragma unroll
        for (int db = 0; db < 2; ++db)
#pragma unroll
            for (int rq = 0; rq < 4; ++rq) *(unsigned*)(op8 + 32 * db + 8 * rq) = pk4_fp8(O[qt][db][4 * rq] * rl, O[qt][db][4 * rq + 1] * rl, O[qt][db][4 * rq + 2] * rl, O[qt][db][4 * rq + 3] * rl); }
#else
        bf16* op = CC + (size_t)(rowbase + tq) * DM + hq * 64 + 4 * hie;
#pragma unroll
        for (int db = 0; db < 2; ++db)
#pragma unroll
            for (int rq = 0; rq < 4; ++rq) { v2u w; w.x = pk2(O[qt][db][4 * rq] * rl, O[qt][db][4 * rq + 1] * rl); w.y = pk2(O[qt][db][4 * rq + 2] * rl, O[qt][db][4 * rq + 3] * rl);
                *(v2u*)(op + 32 * db + 8 * rq) = w; } }
#endif
}
__device__ __forceinline__ void attn_phase(Frame& F, int l, int rep = 0) {
    const int nunits = 512 + (l == 0 ? 32 : 0);
    LAS int* slot = (LAS int*)(F.lds + LDS_X_OFF + 512);
    for (;;) {
        __syncthreads();
        if (F.tid == 0) *slot = (int)__hip_atomic_fetch_add(F.ctl + CW_ATQ + 64 * l + 8 * rep, 1u, RLX_AGENT);
        __syncthreads();
        const int u = __builtin_amdgcn_readfirstlane(*slot);
        if (u >= nunits) break;
        if (u < 512) attn_unit(F, l, u >> 7, (u >> 5) & 3, u & 31, 0); else { const int v = u - 512; attn_unit(F, l, v >> 3, (v >> 1) & 3, v & 1, 1); }
    }
}
#define USE_CHUNK_DN 1
#ifndef DN_SPLIT
#define DN_SPLIT 2
#endif
#ifndef DN_REP_S1
#define DN_REP_S1 1
#endif
#ifndef DN_REP_S3B
#define DN_REP_S3B 1
#endif
#ifndef DN_REP_S3A
#define DN_REP_S3A 1
#endif
#ifndef DN_REP_S4
#define DN_REP_S4 1
#endif

constexpr int DN_F_NEGW = 0, DN_F_QG = 16, DN_F_QK = 32, DN_F_KGT = 40, DN_NFRAG = 56, DN_U_OFF = 57344;
constexpr int DP_QS = 0, DP_KS = 17408, DP_VS = 34816, DP_AS = 52224  , DP_TB = 69632, DP_TW = 78848, DP_QK = 88064, DP_RAW = 52224  , DP_SC = 104960, DP_TF = 106496  , DP_XS = 123904  ;
constexpr int DP_P = 272, DP_P2 = 144;
__device__ __forceinline__ int dn_rec(int b, int h, int dir, int np) { return ((b * 4 + h) * 2 + dir) * 68 + np; }
__device__ __forceinline__ void dn_chunk_of(int ct, int dir, int& b, int& np) { if (ct < 256) { b = ct >> 6; const int c = ct & 63; np = 4 + (dir ? 63 - c : c); } else { b = (ct - 256) >> 2; const int c = (ct - 256) & 3; np = dir ? 3 - c : c; } }
__device__ __forceinline__ unsigned short lds_u16(const LAS unsigned char* p) { return *(const LAS unsigned short*)p; }

__device__ __forceinline__ void dn_prep_unit(Frame& F, int l, int ct, int h, int dir) {
    const bf16* P = (const bf16*)(F.ws + WS_P);
    int lane = F.lane; asm volatile("" : "+v"(lane));
    const int wave = F.wave, i16 = lane & 15, q = lane >> 4;
    const int m0 = ct * 64; int t0, T, base; seq_of(m0, t0, T, base);
    int b, np; dn_chunk_of(ct, dir, b, np);
    unsigned char* tile = F.ws + WS_DNT + (size_t)dn_rec(b, h, dir, np) * DNT_BYTES;
    LAS unsigned char* L = F.lds;
    LAS float* SC = (LAS float*)(L + DP_SC);
    LDS_BARRIER();
    {
        const float* cw = F.in[I_DNCW] + (size_t)l * 4 * 1536;
        LAS float* cwl = (LAS float*)(L + DP_TF);
        for (int i = F.tid; i < 3 * 4 * 128; i += NTHREADS) { const int part = i >> 9, j = (i >> 7) & 3, ch = i & 127; cwl[i] = cw[j * 1536 + part * 512 + h * 128 + ch]; }
        unsigned short pbw = 0, paw = 0;
        if (wave == 0) { const int tok = dir ? 63 - lane : lane; pbw = P[(size_t)(m0 + tok) * PW + PC_BETA + dir * 4 + h]; paw = P[(size_t)(m0 + tok) * PW + PC_DEC + dir * 4 + h]; }
        for (int c = F.tid; c < 67 * 48; c += NTHREADS) { const int row = c / 48, ch = c % 48, part = ch >> 4, cc = ch & 15, tt = t0 + row - 2;
            v4u v = (v4u){0u, 0u, 0u, 0u};
            if (tt >= 0 && tt < T) v = *(const v4u*)(P + (size_t)(base + tt) * PW + PC_DQ + part * 512 + h * 128 + cc * 8);
            *(LAS v4u*)(L + DP_RAW + row * 784 + part * 256 + cc * 16) = v; }
        LDS_BARRIER();
#pragma unroll 1
        for (int rep = 0; rep < DN_REP_S1; ++rep)
#pragma unroll
        for (int part = 0; part < 3; ++part) { const int tok = F.tid >> 3, g8 = F.tid & 7;
            float sv[16];
#pragma unroll
            for (int k = 0; k < 16; ++k) sv[k] = 0.f;
#pragma unroll
            for (int j = 0; j < 4; ++j) { const LAS v4u* rp = (const LAS v4u*)(L + DP_RAW + (tok + j) * 784 + part * 256 + g8 * 32); const v4u r0 = rp[0], r1 = rp[1];
                const LAS f32x4* wp = (const LAS f32x4*)(cwl + (part * 4 + j) * 128 + g8 * 16); const f32x4 w0 = wp[0], w1 = wp[1], w2 = wp[2], w3 = wp[3];
                sv[0] += w0.x * bflo(r0.x); sv[1] += w0.y * bfhi(r0.x); sv[2] += w0.z * bflo(r0.y); sv[3] += w0.w * bfhi(r0.y); sv[4] += w1.x * bflo(r0.z); sv[5] += w1.y * bfhi(r0.z); sv[6] += w1.z * bflo(r0.w); sv[7] += w1.w * bfhi(r0.w);
                sv[8] += w2.x * bflo(r1.x); sv[9] += w2.y * bfhi(r1.x); sv[10] += w2.z * bflo(r1.y); sv[11] += w2.w * bfhi(r1.y); sv[12] += w3.x * bflo(r1.z); sv[13] += w3.y * bfhi(r1.z); sv[14] += w3.z * bflo(r1.w); sv[15] += w3.w * bfhi(r1.w); }
            float ss = 0.f;
#pragma unroll
            for (int k = 0; k < 16; ++k) { sv[k] = siluf_(sv[k]); ss += sv[k] * sv[k]; }
            if (part < 2) { ss += dpp_mov<0xB1>(ss); ss += dpp_mov<0x4E>(ss); ss += dpp_mov<0x141>(ss);
                const float f = (part == 0 ? 0.08838834764831845f : 1.0f) * __builtin_amdgcn_rsqf(ss + EPS);
#pragma unroll
                for (int k = 0; k < 16; ++k) sv[k] *= f; }
            LAS v4u* op = (LAS v4u*)(L + (part == 0 ? DP_QS : (part == 1 ? DP_KS : DP_VS)) + tok * DP_P + g8 * 32);
            op[0] = (v4u){pk2(sv[0], sv[1]), pk2(sv[2], sv[3]), pk2(sv[4], sv[5]), pk2(sv[6], sv[7])}; op[1] = (v4u){pk2(sv[8], sv[9]), pk2(sv[10], sv[11]), pk2(sv[12], sv[13]), pk2(sv[14], sv[15])}; }
        if (wave == 0) {
            const float pb = bf2f(pbw), pa = bf2f(paw);
            const float beta = sigmoidf_(pb); float gc = -__expf(F.in[I_DNALOG][l * 8 + dir * 4 + h]) * softplusf_(pa + F.in[I_DNDT][l * 8 + dir * 4 + h]);
#pragma unroll
            for (int o = 1; o < 64; o <<= 1) { const float v = __shfl_up(gc, o); if (lane >= o) gc += v; }
            const float glast = __shfl(gc, 63);
            SC[lane] = beta; SC[64 + lane] = gc; SC[128 + lane] = __expf(gc); SC[192 + lane] = __expf(glast - gc);
            if (lane == 63) ((float*)(F.ws + WS_DNS))[dn_rec(b, h, dir, np)] = __expf(glast);
        }
    }
    LDS_BARRIER();
#define DN_TOK(r) (dir ? 63 - (r) : (r))
#pragma unroll 1
    for (int rep = 0; rep < DN_REP_S3A; ++rep)
    {
        const int mb = wave & 3, which = wave >> 2;
        f32x4 acc[4];
#pragma unroll
        for (int nb = 0; nb < 4; ++nb) acc[nb] = (f32x4){0.f, 0.f, 0.f, 0.f};
        const LAS unsigned char* arow = L + (which ? DP_QS : DP_KS) + DN_TOK(16 * mb + i16) * DP_P + 16 * q;
#pragma unroll
        for (int ks = 0; ks < 4; ++ks) { const bf16x8 a = *(const LAS bf16x8*)(arow + 64 * ks);
#pragma unroll
            for (int nb = 0; nb < 4; ++nb) { const bf16x8 bb = *(const LAS bf16x8*)(L + DP_KS + DN_TOK(16 * nb + i16) * DP_P + 16 * q + 64 * ks);
                acc[nb] = __builtin_amdgcn_mfma_f32_16x16x32_bf16(a, bb, acc[nb], 0, 0, 0); } }
#pragma unroll
        for (int nb = 0; nb < 4; ++nb)
#pragma unroll
            for (int i = 0; i < 4; ++i) { const int r = 16 * mb + 4 * q + i, c = 16 * nb + i16; const float dec = __expf(SC[64 + r] - SC[64 + c]);
                if (which == 0) ((LAS float*)(L + DP_AS))[r * 68 + c] = (r > c) ? SC[r] * acc[nb][i] * dec : 0.f;
                else *(LAS unsigned short*)(L + DP_QK + r * DP_P2 + c * 2) = (unsigned short)f2bf((r >= c) ? acc[nb][i] * dec : 0.f); }
    }
    LDS_BARRIER();
#pragma unroll 1
    for (int rep = 0; rep < DN_REP_S3B; ++rep) {
    if (wave == 0) {
        const LAS float* As = (const LAS float*)(L + DP_AS); LAS float* Tf = (LAS float*)(L + DP_TF);
        const int g = lane >> 4, c = lane & 15;
        f32x4 ar[16][4];
#pragma unroll
        for (int r = 1; r < 16; ++r)
#pragma unroll
            for (int j4 = 0; j4 < (r + 3) / 4; ++j4) ar[r][j4] = *(const LAS f32x4*)(As + (16 * g + r) * 68 + 16 * g + 4 * j4);
        float t[16];
#pragma unroll
        for (int r = 0; r < 16; ++r) { float a0 = (c == r) ? 1.f : 0.f, a1 = 0.f;
#pragma unroll
            for (int j = 0; j < r; ++j) { const float av = ar[r][j >> 2][j & 3]; if (j & 1) a1 -= av * t[j]; else a0 -= av * t[j]; }
            t[r] = a0 + a1; Tf[(16 * g + r) * 68 + 16 * g + c] = t[r]; }
    }
    LDS_BARRIER();
    if (wave < 3) {
        const LAS float* As = (const LAS float*)(L + DP_AS); LAS float* Tf = (LAS float*)(L + DP_TF); LAS float* Xs = (LAS float*)(L + DP_XS) + wave * 272;
        const int J = wave;
#pragma unroll 1
        for (int I = J + 1; I < 4; ++I) {
            f32x4 acc = {0.f, 0.f, 0.f, 0.f};
#pragma unroll 1
            for (int K = J; K < I; ++K)
#pragma unroll
                for (int sk = 0; sk < 4; ++sk) acc = __builtin_amdgcn_mfma_f32_16x16x4f32(As[(16 * I + i16) * 68 + 16 * K + 4 * sk + q], Tf[(16 * K + 4 * sk + q) * 68 + 16 * J + i16], acc, 0, 0, 0);
#pragma unroll
            for (int i = 0; i < 4; ++i) Xs[(4 * q + i) * 17 + i16] = acc[i];
            LDS_WAIT(); asm volatile("" ::: "memory");
            f32x4 acc2 = {0.f, 0.f, 0.f, 0.f};
#pragma unroll
            for (int sk = 0; sk < 4; ++sk) acc2 = __builtin_amdgcn_mfma_f32_16x16x4f32(Tf[(16 * I + i16) * 68 + 16 * I + 4 * sk + q], Xs[(4 * sk + q) * 17 + i16], acc2, 0, 0, 0);
#pragma unroll
            for (int i = 0; i < 4; ++i) Tf[(16 * I + 4 * q + i) * 68 + 16 * J + i16] = -acc2[i];
            LDS_WAIT(); asm volatile("" ::: "memory");
        }
    }
    LDS_BARRIER();
    { const LAS float* Tf = (const LAS float*)(L + DP_TF); const int r = F.tid >> 3, c0 = (F.tid & 7) * 8; float vb[8], vw[8];
#pragma unroll
      for (int k = 0; k < 8; ++k) { const int c = c0 + k; const float v = ((r >> 4) >= (c >> 4)) ? Tf[r * 68 + c] : 0.f; const float bl = SC[c]; vb[k] = v * bl; vw[k] = vb[k] * SC[128 + c]; }
      v4u ob, ow; ob.x = pk2(vb[0], vb[1]); ob.y = pk2(vb[2], vb[3]); ob.z = pk2(vb[4], vb[5]); ob.w = pk2(vb[6], vb[7]); ow.x = pk2(vw[0], vw[1]); ow.y = pk2(vw[2], vw[3]); ow.z = pk2(vw[4], vw[5]); ow.w = pk2(vw[6], vw[7]);
      *(LAS v4u*)(L + DP_TB + r * DP_P2 + c0 * 2) = ob; *(LAS v4u*)(L + DP_TW + r * DP_P2 + c0 * 2) = ow; }
    }
    LDS_BARRIER();
    {
        const int nbp = wave & 3, which = wave >> 2;
        f32x4 acc[4][2];
#pragma unroll
        for (int mb = 0; mb < 4; ++mb) { acc[mb][0] = (f32x4){0.f, 0.f, 0.f, 0.f}; acc[mb][1] = (f32x4){0.f, 0.f, 0.f, 0.f}; }
#pragma unroll
        for (int ks = 0; ks < 2; ++ks) {
            bf16x8 bb[2];
#pragma unroll
            for (int nn = 0; nn < 2; ++nn) { const int n = 16 * (2 * nbp + nn) + i16; unsigned short e[8];
#pragma unroll
                for (int jj = 0; jj < 8; ++jj) e[jj] = lds_u16(L + (which ? DP_KS : DP_VS) + DN_TOK(32 * ks + 8 * q + jj) * DP_P + n * 2);
                v4u w; w.x = e[0] | ((unsigned)e[1] << 16); w.y = e[2] | ((unsigned)e[3] << 16); w.z = e[4] | ((unsigned)e[5] << 16); w.w = e[6] | ((unsigned)e[7] << 16); bb[nn] = __builtin_bit_cast(bf16x8, w); }
#pragma unroll
            for (int mb = 0; mb < 4; ++mb) { const bf16x8 a = *(const LAS bf16x8*)(L + (which ? DP_TW : DP_TB) + (16 * mb + i16) * DP_P2 + 64 * ks + 16 * q);
                acc[mb][0] = __builtin_amdgcn_mfma_f32_16x16x32_bf16(a, bb[0], acc[mb][0], 0, 0, 0); acc[mb][1] = __builtin_amdgcn_mfma_f32_16x16x32_bf16(a, bb[1], acc[mb][1], 0, 0, 0); } }
        if (which == 0) {
#pragma unroll
            for (int mb = 0; mb < 4; ++mb)
#pragma unroll
                for (int nn = 0; nn < 2; ++nn) *(f32x4*)(tile + DN_U_OFF + (size_t)((((2 * nbp + nn) * 4 + mb) * 64 + lane) * 16)) = acc[mb][nn];
        } else {
#pragma unroll
            for (int mb = 0; mb < 4; ++mb)
#pragma unroll
                for (int nn = 0; nn < 2; ++nn)
#pragma unroll
                    for (int i = 0; i < 4; ++i) *(LAS unsigned short*)(L + DP_AS + (16 * mb + 4 * q + i) * DP_P + (16 * (2 * nbp + nn) + i16) * 2) = (unsigned short)f2bf(-acc[mb][nn][i]);
        }
    }
    LDS_BARRIER();
#pragma unroll 1
    for (int rep = 0; rep < DN_REP_S4; ++rep)
#pragma unroll 1
    for (int fi = 0; fi < 7; ++fi) { const int f = wave * 7 + fi; v4u o;
        if (f < DN_F_QG) { const int mb = f >> 2, ks = f & 3; const LAS unsigned char* rp = L + DP_AS + (16 * mb + i16) * DP_P + (32 * ks + 4 * q) * 2;
            const v2u a = *(const LAS v2u*)rp, c = *(const LAS v2u*)(rp + 32); o.x = a.x; o.y = a.y; o.z = c.x; o.w = c.y; }
        else if (f < DN_F_QK) { const int ff = f - DN_F_QG, mb = ff >> 2, ks = ff & 3, r = 16 * mb + i16; const LAS unsigned char* rp = L + DP_QS + DN_TOK(r) * DP_P + (32 * ks + 4 * q) * 2; const float eg = SC[128 + r];
            const v2u a = *(const LAS v2u*)rp, c = *(const LAS v2u*)(rp + 32);
            o.x = pk2(bflo(a.x) * eg, bfhi(a.x) * eg); o.y = pk2(bflo(a.y) * eg, bfhi(a.y) * eg); o.z = pk2(bflo(c.x) * eg, bfhi(c.x) * eg); o.w = pk2(bflo(c.y) * eg, bfhi(c.y) * eg); }
        else if (f < DN_F_KGT) { const int ff = f - DN_F_QK, mb = ff >> 1, ks = ff & 1; const LAS unsigned char* rp = L + DP_QK + (16 * mb + i16) * DP_P2 + (32 * ks + 4 * q) * 2;
            const v2u a = *(const LAS v2u*)rp, c = *(const LAS v2u*)(rp + 32); o.x = a.x; o.y = a.y; o.z = c.x; o.w = c.y; }
        else { const int ff = f - DN_F_KGT, mb = ff >> 1, ks = ff & 1, dk = 16 * mb + i16; float e[8];
#pragma unroll
            for (int jj = 0; jj < 8; ++jj) { const int key = 32 * ks + 16 * (jj >> 2) + 4 * q + (jj & 3); e[jj] = bf2f(lds_u16(L + DP_KS + DN_TOK(key) * DP_P + dk * 2)) * SC[192 + key]; }
            o.x = pk2(e[0], e[1]); o.y = pk2(e[2], e[3]); o.z = pk2(e[4], e[5]); o.w = pk2(e[6], e[7]); }
        *(v4u*)(tile + (size_t)f * 1024 + lane * 16) = o; }
#undef DN_TOK
}
__device__ __forceinline__ void dn_prep(Frame& F, int l) {
    for (int u = F.bid; u < NCT * 4 * 2; u += F.G) dn_prep_unit(F, l, u >> 3, (u >> 1) & 3, u & 1);
    __syncthreads();
}

__device__ __forceinline__ void dn_scan(Frame& F, int l, int b, int h, int dir, int half) {
    int lane = F.lane; asm volatile("" : "+v"(lane));
    const int w = (DN_SPLIT == 2) ? half * 4 + (F.wave & 3) : F.wave, i16 = lane & 15, q = lane >> 4; const bool active = (DN_SPLIT == 2) ? (F.wave < 4) : true;
    const unsigned char* tiles = F.ws + WS_DNT + (size_t)dn_rec(b, h, dir, 0) * DNT_BYTES;
    const float* egl = (const float*)(F.ws + WS_DNS) + dn_rec(b, h, dir, 0);
    float* O = (float*)(F.ws + WS_DNO);
    LAS unsigned char* L = F.lds;
    f32x4 S[8];
#pragma unroll
    for (int i = 0; i < 8; ++i) S[i] = (f32x4){0.f, 0.f, 0.f, 0.f};
    v4u st[7]; f32x4 un[4];
#pragma unroll
    for (int mb = 0; mb < 4; ++mb) un[mb] = *(const f32x4*)(tiles + DN_U_OFF + (size_t)(((w * 4 + mb) * 64 + lane) * 16));
    LDS_BARRIER();
#pragma unroll
    for (int i = 0; i < 7; ++i) st[i] = *(const v4u*)(tiles + (size_t)(F.tid + i * NTHREADS) * 16);
#pragma unroll
    for (int i = 0; i < 7; ++i) *(LAS v4u*)(L + (F.tid + i * NTHREADS) * 16) = st[i];
#pragma unroll
    for (int i = 0; i < 7; ++i) st[i] = *(const v4u*)(tiles + DNT_BYTES + (size_t)(F.tid + i * NTHREADS) * 16);
    LDS_BARRIER();
#pragma unroll 1
    for (int n = 0; n < 68; ++n) {
        const unsigned char* tile = tiles + (size_t)n * DNT_BYTES; const LAS unsigned char* cur = L + (n & 1) * 57344;
        if (n + 1 < 68) {
#pragma unroll
            for (int i = 0; i < 7; ++i) *(LAS v4u*)(L + ((n + 1) & 1) * 57344 + (F.tid + i * NTHREADS) * 16) = st[i]; }
        if (n + 2 < 68) {
#pragma unroll
            for (int i = 0; i < 7; ++i) st[i] = *(const v4u*)(tile + 2 * DNT_BYTES + (size_t)(F.tid + i * NTHREADS) * 16); }
        if (active) {
        f32x4 vn[4];
#pragma unroll
        for (int mb = 0; mb < 4; ++mb) vn[mb] = un[mb];
        if (n + 1 < 68) {
#pragma unroll
            for (int mb = 0; mb < 4; ++mb) un[mb] = *(const f32x4*)(tile + DNT_BYTES + DN_U_OFF + (size_t)(((w * 4 + mb) * 64 + lane) * 16)); }
        const float el = egl[n];
        bf16x8 bS[4];
#pragma unroll
        for (int ks = 0; ks < 4; ++ks) { v4u x; x.x = pk2(S[2 * ks][0], S[2 * ks][1]); x.y = pk2(S[2 * ks][2], S[2 * ks][3]); x.z = pk2(S[2 * ks + 1][0], S[2 * ks + 1][1]); x.w = pk2(S[2 * ks + 1][2], S[2 * ks + 1][3]); bS[ks] = __builtin_bit_cast(bf16x8, x); }
        f32x4 o[4];
#pragma unroll
        for (int mb = 0; mb < 4; ++mb) { o[mb] = (f32x4){0.f, 0.f, 0.f, 0.f};
#pragma unroll
            for (int ks = 0; ks < 4; ++ks) { const bf16x8 aw = *(const LAS bf16x8*)(cur + (DN_F_NEGW + mb * 4 + ks) * 1024 + lane * 16), aq = *(const LAS bf16x8*)(cur + (DN_F_QG + mb * 4 + ks) * 1024 + lane * 16);
                vn[mb] = __builtin_amdgcn_mfma_f32_16x16x32_bf16(aw, bS[ks], vn[mb], 0, 0, 0); o[mb] = __builtin_amdgcn_mfma_f32_16x16x32_bf16(aq, bS[ks], o[mb], 0, 0, 0); } }
        bf16x8 bV[2];
#pragma unroll
        for (int ks = 0; ks < 2; ++ks) { v4u x; x.x = pk2(vn[2 * ks][0], vn[2 * ks][1]); x.y = pk2(vn[2 * ks][2], vn[2 * ks][3]); x.z = pk2(vn[2 * ks + 1][0], vn[2 * ks + 1][1]); x.w = pk2(vn[2 * ks + 1][2], vn[2 * ks + 1][3]); bV[ks] = __builtin_bit_cast(bf16x8, x); }
#pragma unroll
        for (int mb = 0; mb < 8; ++mb) { S[mb] = S[mb] * el;
#pragma unroll
            for (int ks = 0; ks < 2; ++ks) { const bf16x8 ak = *(const LAS bf16x8*)(cur + (DN_F_KGT + mb * 2 + ks) * 1024 + lane * 16); S[mb] = __builtin_amdgcn_mfma_f32_16x16x32_bf16(ak, bV[ks], S[mb], 0, 0, 0); } }
#pragma unroll
        for (int mb = 0; mb < 4; ++mb)
#pragma unroll
            for (int ks = 0; ks < 2; ++ks) { const bf16x8 aqk = *(const LAS bf16x8*)(cur + (DN_F_QK + mb * 2 + ks) * 1024 + lane * 16); o[mb] = __builtin_amdgcn_mfma_f32_16x16x32_bf16(aqk, bV[ks], o[mb], 0, 0, 0); }
        { int m0; if (n < 4) m0 = NLAT + b * CTXL + 64 * (dir ? 3 - n : n); else m0 = b * SEQ + 64 * (dir ? 63 - (n - 4) : (n - 4));
#pragma unroll
          for (int mb = 0; mb < 4; ++mb)
#pragma unroll
            for (int i = 0; i < 4; ++i) { const int r = 16 * mb + 4 * q + i, tok = dir ? 63 - r : r; O[((size_t)dir * NTOK + m0 + tok) * 512 + h * 128 + 16 * w + i16] = o[mb][i]; } }
        }
        LDS_BARRIER();
    }
}
#define USE_CHUNK_LRU 1

constexpr int LR_XF = 0  , LR_XB = 16640  , LR_WT = 25856  , LR_AA = 62720  , LR_UU = 96000  , LR_END = 129280;
constexpr size_t WS_LCA = WS_LRC, WS_LCH = WS_LRC + 2 * MiB, WS_LCI = WS_LRC + 4 * MiB;
__device__ __forceinline__ void lru_prep(Frame& F, int l) {
    const bf16* P = (const bf16*)(F.ws + WS_P);
    int lane = F.lane; asm volatile("" : "+v"(lane));
    const int wave = F.wave, i16 = lane & 15, q = lane >> 4, nb = F.bid & 7;
    LAS unsigned char* L = F.lds;
    LAS float* XF = (LAS float*)(L + LR_XF); LAS float* AA = (LAS float*)(L + LR_AA); LAS float* UU = (LAS float*)(L + LR_UU);
    bf16* HL = (bf16*)(F.ws + WS_LRH); bf16* AC = (bf16*)(F.ws + WS_LRA);
    __syncthreads();
    for (int e = F.tid; e < 4 * 4096; e += NTHREADS) { const int mat = e >> 12, ii = (e >> 6) & 63, j = e & 63, dir = mat >> 1;
        const float w = (mat & 1 ? F.in[I_LRWI] : F.in[I_LRWR])[((size_t)((l * 2 + dir) * 8 + nb)) * 4096 + ii * 64 + j];
        *(LAS unsigned short*)(L + LR_WT + (mat * 64 + j) * 144 + ii * 2) = (unsigned short)f2bf(w); }
    float cwv[4][8], cbv[8];
    { const int c8 = (F.tid & 7) * 8, ch0 = nb * 64 + c8; const float* cb = F.in[I_LRCB] + l * 512 + ch0; const float* cw = F.in[I_LRCW] + (size_t)l * 4 * 512 + ch0;
#pragma unroll
      for (int k = 0; k < 8; ++k) cbv[k] = cb[k];
#pragma unroll
      for (int j = 0; j < 4; ++j)
#pragma unroll
        for (int k = 0; k < 8; ++k) cwv[j][k] = cw[j * 512 + k]; }
    float gbr[4], gbi[4], gls[4];
    { const int dir = wave >> 2;
#pragma unroll
      for (int n = 0; n < 4; ++n) { const int ch = nb * 64 + 16 * n + i16; gbr[n] = F.in[I_LRBR][(l * 2 + dir) * 512 + ch]; gbi[n] = F.in[I_LRBI][(l * 2 + dir) * 512 + ch]; gls[n] = -softplusf_(-F.in[I_LRLAM][(l * 2 + dir) * 512 + ch]); } }
    v4u wv[4];
#define LR_LOADRAW(ctx) do { const int _m0 = (ctx) * 64; int _t0, _T, _base; seq_of(_m0, _t0, _T, _base); const int _tok = F.tid >> 3, _ch0 = nb * 64 + (F.tid & 7) * 8; \
        _Pragma("unroll") for (int j = 0; j < 4; ++j) { const int tt = _t0 + _tok + j - 2; wv[j] = (v4u){0u, 0u, 0u, 0u}; if (tt >= 0 && tt < _T) wv[j] = *(const v4u*)(P + (size_t)(_base + tt) * PW + PC_LX + _ch0); } } while (0)
    if ((F.bid >> 3) < NCT) LR_LOADRAW(F.bid >> 3);
    for (int ct = F.bid >> 3; ct < NCT; ct += F.G >> 3) {
        const int m0 = ct * 64;
        LDS_BARRIER();
        { const int tok = F.tid >> 3, c8 = (F.tid & 7) * 8, ch0 = nb * 64 + c8; float s[8];
#pragma unroll
          for (int k = 0; k < 8; ++k) s[k] = cbv[k];
#pragma unroll
          for (int j = 0; j < 4; ++j) { const v4u w = wv[j];
              s[0] += cwv[j][0] * bflo(w.x); s[1] += cwv[j][1] * bfhi(w.x); s[2] += cwv[j][2] * bflo(w.y); s[3] += cwv[j][3] * bfhi(w.y); s[4] += cwv[j][4] * bflo(w.z); s[5] += cwv[j][5] * bfhi(w.z); s[6] += cwv[j][6] * bflo(w.w); s[7] += cwv[j][7] * bfhi(w.w); }
#pragma unroll
          for (int k = 0; k < 8; ++k) XF[tok * 65 + c8 + k] = s[k];
          v4u o; o.x = pk2(s[0], s[1]); o.y = pk2(s[2], s[3]); o.z = pk2(s[4], s[5]); o.w = pk2(s[6], s[7]); *(LAS v4u*)(L + LR_XB + tok * 144 + c8 * 2) = o; }
        if (ct + (F.G >> 3) < NCT) LR_LOADRAW(ct + (F.G >> 3));
        LDS_BARRIER();
        { const int dir = wave >> 2, mb = wave & 3;
          f32x4 ar[4], ai[4];
#pragma unroll
          for (int n = 0; n < 4; ++n) { ar[n] = (f32x4){0.f, 0.f, 0.f, 0.f}; ai[n] = (f32x4){0.f, 0.f, 0.f, 0.f}; }
#pragma unroll
          for (int ks = 0; ks < 2; ++ks) { const bf16x8 a = *(const LAS bf16x8*)(L + LR_XB + (16 * mb + i16) * 144 + 64 * ks + 16 * q);
#pragma unroll
              for (int n = 0; n < 4; ++n) { const bf16x8 br = *(const LAS bf16x8*)(L + LR_WT + ((dir * 2 + 0) * 64 + 16 * n + i16) * 144 + 64 * ks + 16 * q), bi = *(const LAS bf16x8*)(L + LR_WT + ((dir * 2 + 1) * 64 + 16 * n + i16) * 144 + 64 * ks + 16 * q);
                  ar[n] = __builtin_amdgcn_mfma_f32_16x16x32_bf16(a, br, ar[n], 0, 0, 0); ai[n] = __builtin_amdgcn_mfma_f32_16x16x32_bf16(a, bi, ai[n], 0, 0, 0); } }
#pragma unroll
          for (int n = 0; n < 4; ++n) { const int j = 16 * n + i16; const float br_ = gbr[n], bi_ = gbi[n], logsig = gls[n];
#pragma unroll
              for (int i = 0; i < 4; ++i) { const int tok = 16 * mb + 4 * q + i; const float r = sigmoidf_(ar[n][i] + br_), ig = sigmoidf_(ai[n][i] + bi_);
                  const float log_a = 8.0f * r * logsig, a = __expf(log_a), y2 = 2.0f * log_a;
                  const float om = (y2 > -0.1f) ? -y2 * (1.0f + y2 * (0.5f + y2 * (0.16666667f + y2 * 0.041666668f))) : 1.0f - __expf(y2);
                  const float u = __builtin_amdgcn_sqrtf(om) * (ig * XF[tok * 65 + j]);
                  AA[(dir * 64 + tok) * 65 + j] = a; UU[(dir * 64 + tok) * 65 + j] = u; } } }
        LDS_BARRIER();
        if (F.tid < 128) { const int dir = F.tid >> 6, j = F.tid & 63, ch = nb * 64 + j; float h = 0.f, ac = 1.f;
            long o = (long)(((size_t)dir * NTOK + m0 + (dir ? 63 : 0)) * 512 + ch); const long ostep = dir ? -512 : 512;
#pragma unroll 1
            for (int s0 = 0; s0 < 64; s0 += 8) { float av[8], uv[8];
#pragma unroll
                for (int k = 0; k < 8; ++k) { const int tok = dir ? 63 - (s0 + k) : (s0 + k); av[k] = AA[(dir * 64 + tok) * 65 + j]; uv[k] = UU[(dir * 64 + tok) * 65 + j]; }
#pragma unroll
                for (int k = 0; k < 8; ++k) { h = av[k] * h + uv[k]; ac *= av[k]; HL[o] = (bf16)f2bf(h); AC[o] = (bf16)f2bf(ac); o += ostep; } }
            ((float*)(F.ws + WS_LCA))[((size_t)dir * NCT + ct) * 512 + ch] = ac; ((float*)(F.ws + WS_LCH))[((size_t)dir * NCT + ct) * 512 + ch] = h; }
    }
    LDS_BARRIER();
}
__device__ __forceinline__ void lru_carry(Frame& F, int idx) {
    const int ch = idx & 511, dir = (idx >> 9) & 1, b = idx >> 10;
    const float* CA = (const float*)(F.ws + WS_LCA); const float* CH = (const float*)(F.ws + WS_LCH); float* CI = (float*)(F.ws + WS_LCI);
    float h = 0.f;
#pragma unroll 4
    for (int n = 0; n < 68; ++n) { const int ct = n < 4 ? 256 + b * 4 + (dir ? 3 - n : n) : b * 64 + (dir ? 63 - (n - 4) : (n - 4)); const size_t o = ((size_t)dir * NCT + ct) * 512 + ch;
        CI[o] = h; h = CA[o] * h + CH[o]; }
}
__device__ __forceinline__ void lru_fin(Frame& F, int l) {
    const int nrows = (l == 0) ? NTOK : NLAT;
    const bf16* P = (const bf16*)(F.ws + WS_P); bf16* CC = (bf16*)(F.ws + WS_CC);
    const bf16* HL = (const bf16*)(F.ws + WS_LRH); const bf16* AC = (const bf16*)(F.ws + WS_LRA); const float* CI = (const float*)(F.ws + WS_LCI);
    for (size_t i = (size_t)F.bid * NTHREADS + F.tid; i < (size_t)nrows * 128; i += (size_t)F.G * NTHREADS) { const int m = (int)(i >> 7), c4 = (int)(i & 127) * 4, ct = m >> 6;
        const v2u hw0 = *(const v2u*)(HL + (size_t)m * 512 + c4), aw0 = *(const v2u*)(AC + (size_t)m * 512 + c4), hw1 = *(const v2u*)(HL + ((size_t)NTOK + m) * 512 + c4), aw1 = *(const v2u*)(AC + ((size_t)NTOK + m) * 512 + c4);
        const f32x4 h0 = {bflo(hw0.x), bfhi(hw0.x), bflo(hw0.y), bfhi(hw0.y)}, a0 = {bflo(aw0.x), bfhi(aw0.x), bflo(aw0.y), bfhi(aw0.y)}, h1 = {bflo(hw1.x), bfhi(hw1.x), bflo(hw1.y), bfhi(hw1.y)}, a1 = {bflo(aw1.x), bfhi(aw1.x), bflo(aw1.y), bfhi(aw1.y)};
        const f32x4 i0 = *(const f32x4*)(CI + (size_t)ct * 512 + c4), i1 = *(const f32x4*)(CI + ((size_t)NCT + ct) * 512 + c4);
        const f32x4 hs = (a0 * i0 + h0) + (a1 * i1 + h1); const v2u yw = *(const v2u*)(P + (size_t)m * PW + PC_LY + c4);
#if FP8_OUTPROJ
        *(unsigned*)((unsigned char*)CC + (size_t)m * DM + 1536 + c4) = pk4_fp8(hs.x * gelu_tanh(bflo(yw.x)), hs.y * gelu_tanh(bfhi(yw.x)), hs.z * gelu_tanh(bflo(yw.y)), hs.w * gelu_tanh(bfhi(yw.y))); }
#else
        v2u o; o.x = pk2(hs.x * gelu_tanh(bflo(yw.x)), hs.y * gelu_tanh(bfhi(yw.x))); o.y = pk2(hs.z * gelu_tanh(bflo(yw.y)), hs.w * gelu_tanh(bfhi(yw.y)));
        *(v2u*)(CC + (size_t)m * DM + 1536 + c4) = o; }
#endif
}

constexpr size_t WS_DNQ = WS_DNT;
constexpr size_t WS_BG = WS_DNS + 1 * MiB;
constexpr size_t WS_XC = WS_XS;

__device__ __forceinline__ void naive_prep(Frame& F, int l) {
    const bf16* P = (const bf16*)(F.ws + WS_P);
    const int gw = F.bid * NWAVES + F.wave, NGW = F.G * NWAVES;
#if !defined(USE_CHUNK_DN)
    {
        float* DNQ = (float*)(F.ws + WS_DNQ); float* BG = (float*)(F.ws + WS_BG);
        const float* cw = F.in[I_DNCW] + (size_t)l * 4 * 1536;
        for (int it = gw; it < NTOK * 4; it += NGW) {
            const int m = it >> 2, h = it & 3; int t, T, base; seq_of(m, t, T, base);
            float val[3][2];
#pragma unroll
            for (int part = 0; part < 3; ++part)
#pragma unroll
                for (int dd = 0; dd < 2; ++dd) { const int d = F.lane + 64 * dd, cch = part * 512 + h * 128 + d, col = PC_DQ + cch; float s = 0.f;
#pragma unroll
                    for (int j = 0; j < 4; ++j) { const int tt = t + j - 2; if (tt >= 0 && tt < T) s += cw[j * 1536 + cch] * bf2f(P[(size_t)(base + tt) * PW + col]); }
                    val[part][dd] = siluf_(s); }
            const float sq = wave_sum(val[0][0] * val[0][0] + val[0][1] * val[0][1]), sk = wave_sum(val[1][0] * val[1][0] + val[1][1] * val[1][1]);
            const float fq = 0.08838834764831845f / sqrtf(sq + EPS), fk = 1.0f / sqrtf(sk + EPS);
#pragma unroll
            for (int dd = 0; dd < 2; ++dd) { const int d = F.lane + 64 * dd; float* o = DNQ + (size_t)m * 1536 + h * 128 + d;
                o[0] = val[0][dd] * fq; o[512] = val[1][dd] * fk; o[1024] = val[2][dd]; }
            if (h == 0 && F.lane < 8) { const int dir = F.lane >> 2, hh = F.lane & 3;
                const float pb = bf2f(P[(size_t)m * PW + PC_BETA + F.lane]), pa = bf2f(P[(size_t)m * PW + PC_DEC + F.lane]);
                BG[m * 16 + F.lane] = sigmoidf_(pb);
                BG[m * 16 + 8 + F.lane] = -__expf(F.in[I_DNALOG][l * 8 + dir * 4 + hh]) * softplusf_(pa + F.in[I_DNDT][l * 8 + dir * 4 + hh]); }
        }
    }
#endif
#if !defined(USE_CHUNK_LRU)
    {
        LAS float* xc = (LAS float*)F.lds;
        float* A = (float*)(F.ws + WS_LRA); float* U = (float*)(F.ws + WS_LRH);
        const float* cw = F.in[I_LRCW] + (size_t)l * 4 * 512; const float* cb = F.in[I_LRCB] + l * 512;
        for (int m0 = F.bid * 8; m0 < NTOK; m0 += F.G * 8) {
            __syncthreads();
            for (int i = F.tid; i < 8 * 512; i += NTHREADS) { const int m = m0 + (i >> 9), ch = i & 511; int t, T, base; seq_of(m, t, T, base); float s = cb[ch];
#pragma unroll
                for (int j = 0; j < 4; ++j) { const int tt = t + j - 2; if (tt >= 0 && tt < T) s += cw[j * 512 + ch] * bf2f(P[(size_t)(base + tt) * PW + PC_LX + ch]); }
                xc[i] = s; }
            __syncthreads();
            for (int i = F.tid; i < 8 * 512 * 2; i += NTHREADS) { const int ch = i & 511, dir = (i >> 9) & 1, tk = i >> 10, m = m0 + tk, blk = ch >> 6, j = ch & 63;
                const float* wr = F.in[I_LRWR] + ((size_t)((l * 2 + dir) * 8 + blk)) * 4096 + j; const float* wi = F.in[I_LRWI] + ((size_t)((l * 2 + dir) * 8 + blk)) * 4096 + j;
                float sr = F.in[I_LRBR][(l * 2 + dir) * 512 + ch], si = F.in[I_LRBI][(l * 2 + dir) * 512 + ch];
#pragma unroll 8
                for (int ii = 0; ii < 64; ++ii) { const float x = xc[tk * 512 + blk * 64 + ii]; sr += x * wr[ii * 64]; si += x * wi[ii * 64]; }
                const float r = sigmoidf_(sr), ig = sigmoidf_(si); const float lam = F.in[I_LRLAM][(l * 2 + dir) * 512 + ch];
                const float logsig = -softplusf_(-lam);
                const float log_a = 8.0f * r * logsig; const float a = __expf(log_a);
                const float u = sqrtf(-expm1f(2.0f * log_a)) * (ig * xc[tk * 512 + ch]);
                A[((size_t)dir * NTOK + m) * 512 + ch] = a; U[((size_t)dir * NTOK + m) * 512 + ch] = u; }
        }
        __syncthreads();
    }
#endif
}

__device__ __forceinline__ void naive_attn_row(Frame& F, int l, int m, int hq) {
    const bf16* P = (const bf16*)(F.ws + WS_P); bf16* CC = (bf16*)(F.ws + WS_CC);
    const int d = F.lane, kvh = hq >> 2; int t, T, base; seq_of(m, t, T, base);
    const bool lat = m < NLAT; const int b = lat ? (m >> 12) : ((m - NLAT) >> 8);
    const int dd = d & 31, jf = dd & 15; const float inv = __powf(10000.0f, -(float)jf * (1.0f / 16.0f));
    const bool second = (dd >= 16), colhalf = (d >= 32);
    float q = bf2f(P[(size_t)m * PW + PC_Q + hq * 64 + d]);
    if (lat) { const float pos = (float)(colhalf ? (t & 63) : (t >> 6)); float sn, cs; sincosf(pos * inv, &sn, &cs); const float pr = __shfl_xor(q, 16); q = second ? (q * cs + pr * sn) : (q * cs - pr * sn); }
    q *= 0.125f;
    float mx = F.in[I_SINK][l * 16 + hq], den = 1.0f, acc = 0.f;
    if (lat) { const int t0 = t - 128 < 0 ? 0 : t - 128, t1 = t + 128 > SEQ - 1 ? SEQ - 1 : t + 128;
        for (int tk = t0; tk <= t1; ++tk) { const size_t r = (size_t)(base + tk) * PW; float k = bf2f(P[r + PC_K + kvh * 64 + d]); const float v = bf2f(P[r + PC_V + kvh * 64 + d]);
            const float pos = (float)(colhalf ? (tk & 63) : (tk >> 6)); float sn, cs; sincosf(pos * inv, &sn, &cs); const float pr = __shfl_xor(k, 16); k = second ? (k * cs + pr * sn) : (k * cs - pr * sn);
            const float s = wave_sum(q * k); const float mn = fmaxf(mx, s), f = __expf(mx - mn), p = __expf(s - mn); den = den * f + p; acc = acc * f + p * v; mx = mn; } }
    for (int c = 0; c < CTXL; ++c) { const size_t r = (size_t)(NLAT + b * CTXL + c) * PW; const float k = bf2f(P[r + PC_K + kvh * 64 + d]), v = bf2f(P[r + PC_V + kvh * 64 + d]);
        const float s = wave_sum(q * k); const float mn = fmaxf(mx, s), f = __expf(mx - mn), p = __expf(s - mn); den = den * f + p; acc = acc * f + p * v; mx = mn; }
    CC[(size_t)m * DM + hq * 64 + d] = (bf16)f2bf(acc / den);
}

__device__ __forceinline__ int scan_row(int n, int b, int dir) { if (n < CTXL) { const int t = dir ? (CTXL - 1 - n) : n; return NLAT + b * CTXL + t; } const int t = dir ? (SEQ - 1 - (n - CTXL)) : (n - CTXL); return b * SEQ + t; }
__device__ __forceinline__ void naive_scan(Frame& F, int l, int rep = 0) {
#if defined(USE_CHUNK_DN)
    if (F.bid < 32 * DN_SPLIT) { if (DN_SPLIT == 2) dn_scan(F, l, F.bid >> 4, (F.bid >> 2) & 3, (F.bid >> 1) & 1, F.bid & 1); else dn_scan(F, l, F.bid >> 3, (F.bid >> 1) & 3, F.bid & 1, 0); }
#else
    if (F.bid < 32) {
        const int b = F.bid >> 3, h = (F.bid >> 1) & 3, dir = F.bid & 1, dvc = F.tid & 127, kq = F.tid >> 7;
        const float* DNQ = (const float*)(F.ws + WS_DNQ); const float* BG = (const float*)(F.ws + WS_BG); float* O = (float*)(F.ws + WS_DNO);
        LAS float* buf = (LAS float*)F.lds;
        LAS float* red = buf + 768;
        LAS float* red2 = red + 512;
        float S[32];
#pragma unroll
        for (int i = 0; i < 32; ++i) S[i] = 0.f;
        constexpr int NT = CTXL + SEQ;
        { const int m = scan_row(0, b, dir); if (F.tid < 384) buf[F.tid] = DNQ[(size_t)m * 1536 + (F.tid >> 7) * 512 + h * 128 + (F.tid & 127)]; }
        __syncthreads();
#pragma unroll 1
        for (int n = 0; n < NT; ++n) {
            const int m = scan_row(n, b, dir); const LAS float* cur = buf + (n & 1) * 384;
            float nextv = 0.f; if (n + 1 < NT && F.tid < 384) { const int m2 = scan_row(n + 1, b, dir); nextv = DNQ[(size_t)m2 * 1536 + (F.tid >> 7) * 512 + h * 128 + (F.tid & 127)]; }
            const float beta = BG[m * 16 + dir * 4 + h], decay = __expf(BG[m * 16 + 8 + dir * 4 + h]);
            float ks = 0.f;
#pragma unroll
            for (int i = 0; i < 32; ++i) ks += cur[128 + kq * 32 + i] * S[i];
            red[kq * 128 + dvc] = ks;
            __syncthreads();
            const float kS = (red[dvc] + red[128 + dvc]) + (red[256 + dvc] + red[384 + dvc]);
            const float upd = beta * (cur[256 + dvc] - decay * kS);
            float os = 0.f;
#pragma unroll
            for (int i = 0; i < 32; ++i) { S[i] = decay * S[i] + cur[128 + kq * 32 + i] * upd; os += cur[kq * 32 + i] * S[i]; }
            red2[kq * 128 + dvc] = os;
            if (F.tid < 384) buf[((n + 1) & 1) * 384 + F.tid] = nextv;
            __syncthreads();
            if (kq == 0) O[((size_t)dir * NTOK + m) * 512 + h * 128 + dvc] = (red2[dvc] + red2[128 + dvc]) + (red2[256 + dvc] + red2[384 + dvc]);
        }
    }
#endif
#if defined(USE_CHUNK_LRU)
    else if (F.bid < 32 * DN_SPLIT + 8) { lru_carry(F, (F.bid - 32 * DN_SPLIT) * NTHREADS + F.tid); }
#else
    else if (F.bid < 40) {
        const int idx = (F.bid - 32) * NTHREADS + F.tid, ch = idx & 511, dir = (idx >> 9) & 1, b = idx >> 10;
        const float* A = (const float*)(F.ws + WS_LRA); float* U = (float*)(F.ws + WS_LRH);
        float hs = 0.f;
#pragma unroll 4
        for (int n = 0; n < CTXL + SEQ; ++n) { int m; if (n < CTXL) { const int t = dir ? (CTXL - 1 - n) : n; m = NLAT + b * CTXL + t; } else { const int t = dir ? (SEQ - 1 - (n - CTXL)) : (n - CTXL); m = b * SEQ + t; }
            const size_t o = ((size_t)dir * NTOK + m) * 512 + ch; hs = A[o] * hs + U[o]; U[o] = hs; }
    }
#endif
#if defined(USE_MFMA_ATTN)
#if SCAN_SPLIT_ORDER
    if (F.bid & 1) { convert_moe_queue(F, l, rep); attn_phase(F, l, rep); } else { attn_phase(F, l, rep); convert_moe_queue(F, l, rep); }
#else
    attn_phase(F, l, rep);
    convert_moe_queue(F, l, rep);
#endif
#else
    {
        const int nrows = (l == 0) ? NTOK : NLAT;
        for (;;) { int m = 0; if (F.lane == 0) m = (int)__hip_atomic_fetch_add(F.ctl + CW_ATQ + 64 * l, 1u, RLX_AGENT); m = __builtin_amdgcn_readfirstlane(m);
            if (m >= nrows) break;
#pragma unroll 1
            for (int hq = 0; hq < 16; ++hq) naive_attn_row(F, l, m, hq); }
    }
#endif
}

__device__ __forceinline__ void naive_fin(Frame& F, int l) {
    const int nrows = (l == 0) ? NTOK : NLAT;
    const bf16* P = (const bf16*)(F.ws + WS_P); bf16* CC = (bf16*)(F.ws + WS_CC);
    const int gw = F.bid * NWAVES + F.wave, NGW = F.G * NWAVES;
    const float* O = (const float*)(F.ws + WS_DNO); const float* HS = (const float*)(F.ws + WS_LRH);
    for (int it0 = gw * 2; it0 < nrows * 4; it0 += NGW * 2) {
        float2 oa[2], ob[2]; unsigned gw_[2];
#pragma unroll
        for (int k = 0; k < 2; ++k) { const int it = it0 + k, m = it >> 2, h = it & 3; const int c = h * 128 + 2 * F.lane;
            oa[k] = *(const float2*)(O + (size_t)m * 512 + c); ob[k] = *(const float2*)(O + ((size_t)NTOK + m) * 512 + c); gw_[k] = *(const unsigned*)(P + (size_t)m * PW + PC_DG + c); }
        const float2 ng = *(const float2*)(F.in[I_DNNG] + l * 128 + 2 * F.lane);
#pragma unroll
        for (int k = 0; k < 2; ++k) { const int it = it0 + k, m = it >> 2, h = it & 3; const float o0 = oa[k].x + ob[k].x, o1 = oa[k].y + ob[k].y;
            const float rstd = 1.0f / sqrtf(wave_sum(o0 * o0 + o1 * o1) * (1.0f / 128.0f) + EPS);
#if FP8_OUTPROJ
            *(unsigned short*)((unsigned char*)CC + (size_t)m * DM + 1024 + h * 128 + 2 * F.lane) = (unsigned short)(pk4_fp8(o0 * rstd * ng.x * siluf_(bflo(gw_[k])), o1 * rstd * ng.y * siluf_(bfhi(gw_[k])), 0.f, 0.f) & 0xffffu); }
#else
            *(unsigned*)(CC + (size_t)m * DM + 1024 + h * 128 + 2 * F.lane) = pk2(o0 * rstd * ng.x * siluf_(bflo(gw_[k])), o1 * rstd * ng.y * siluf_(bfhi(gw_[k]))); }
#endif
    }
#if defined(USE_CHUNK_LRU)
    lru_fin(F, l);
#else
    for (size_t i = (size_t)F.bid * NTHREADS + F.tid; i < (size_t)nrows * 512; i += (size_t)F.G * NTHREADS) { const int m = (int)(i >> 9), ch = (int)(i & 511);
        const float hsum = HS[(size_t)m * 512 + ch] + HS[((size_t)NTOK + m) * 512 + ch]; const float y = bf2f(P[(size_t)m * PW + PC_LY + ch]);
        CC[(size_t)m * DM + 1536 + ch] = (bf16)f2bf(hsum * gelu_tanh(y)); }
#endif
}
#ifndef PHASE_PREP
#if defined(USE_MFMA_ATTN)
#if defined(USE_CHUNK_DN)
#define PHASE_PREP(F, l) do { attn_prep(F, l); lru_prep(F, l); dn_prep(F, l); } while (0)
#else
#define PHASE_PREP(F, l) do { naive_prep(F, l); attn_prep(F, l); } while (0)
#endif
#else
#define PHASE_PREP(F, l) naive_prep(F, l)
#endif
#endif
#ifndef PHASE_SCAN
#define PHASE_SCAN(F, l) naive_scan(F, l)
#endif
#ifndef PHASE_FIN
#define PHASE_FIN(F, l) naive_fin(F, l)
#endif

#ifndef PHASE_INPROJ
#define PHASE_INPROJ(F, l) do {} while (0)
#endif
#ifndef PHASE_PREP
#define PHASE_PREP(F, l) do {} while (0)
#endif
#ifndef PHASE_SCAN
#define PHASE_SCAN(F, l) do {} while (0)
#endif
#ifndef PHASE_FIN
#define PHASE_FIN(F, l) do {} while (0)
#endif
#ifndef PHASE_OUTPROJ
#define PHASE_OUTPROJ(F, l) do {} while (0)
#endif
#ifndef PHASE_NORM2
#define PHASE_NORM2(F, l) do {} while (0)
#endif
#ifndef PHASE_SCATTER
#define PHASE_SCATTER(F, l) do {} while (0)
#endif
#ifndef PHASE_GEMM1
#define PHASE_GEMM1(F, l) do {} while (0)
#endif
#ifndef PHASE_GEMM2
#define PHASE_GEMM2(F, l) do {} while (0)
#endif

#ifndef MK_SPLIT
#define MK_SPLIT 0
#endif
#ifndef MK_STAGE
#define MK_STAGE 99
#endif
#ifndef MK_TAILFILL
#define MK_TAILFILL 0
#endif
#ifndef MK_DUP
#define MK_DUP 0
#endif
#define DUP(k) ((MK_DUP >> (k)) & 1)
constexpr int N_PHASES = 22;
struct Args { const float* in[N_IN]; float* out; unsigned char* ws; int ph_lo, ph_hi; };
static_assert(sizeof(Args) == (N_IN + 2) * 8 + 8, "Args has no padding");

__global__ void __launch_bounds__(NTHREADS, 2) fwd_kernel(Args args) {
    extern __shared__ __attribute__((aligned(16))) unsigned char lds[];
    Frame F;
    F.lds = (LAS unsigned char*)lds;
    F.MISC = (volatile LAS unsigned*)(F.lds + MISC_OFF);
    F.tid = threadIdx.x; F.lane = F.tid & 63; F.wave = __builtin_amdgcn_readfirstlane(F.tid >> 6);
    F.G = 256; F.bid = blockIdx.x;
    F.ws = args.ws; F.out = args.out; F.ctl = (gu32*)(args.ws + WS_CTL);
    F.in = (const float* const __attribute__((address_space(4)))*)__builtin_amdgcn_kernarg_segment_ptr();
    for (int u = F.tid; u < (LDS_BYTES - LDSCTL_OFF) / 4; u += NTHREADS) ((LAS unsigned*)(F.lds + LDSCTL_OFF))[u] = 0u;
    __syncthreads();
    XcdBarrier bar; bar.bar = (unsigned*)(F.ctl + CW_BAR); bar.x = 0; bar.st = nullptr;
    if (!MK_SPLIT) bar = xcd_barrier_post((unsigned*)(F.ctl + CW_BAR), F.MISC + 8);
    const int lo = args.ph_lo, hi = args.ph_hi;
#define IN(k) (lo <= (k) && (k) < hi && phase_enter(F))
#define INR(k) (lo <= (k) && (k) < hi)
#define SEAM(k) do { if (INR(k) && INR((k) + 1)) { if (MK_TAILFILL && (k) < 14) tail_fill(F, (k), (k) < 4 ? 0 : 1); xcd_barrier(bar); } } while (0)

    if (IN(0)) { p0_prologue(F); if (DUP(0)) { __syncthreads(); p0_prologue(F); } } SEAM(0);
#pragma unroll 1
    for (int l = 0; l < DEPTH; ++l) {
        const int pb = 1 + 10 * l;
        if (IN(pb + 0)) { phase_norm1(F, l); if (DUP(13) && l == 0) { __syncthreads(); phase_norm1(F, l); } } SEAM(pb + 0);
        if (IN(pb + 1)) { PHASE_INPROJ(F, l); if (DUP(1)) { __syncthreads(); PHASE_INPROJ(F, l); } } SEAM(pb + 1);
        if (IN(pb + 2)) { PHASE_PREP(F, l); if (DUP(2)) { __syncthreads(); dn_prep(F, l); } if (DUP(6)) { __syncthreads(); lru_prep(F, l); } } SEAM(pb + 2);
        if (IN(pb + 3)) { if (DUP(3) && F.bid < 64) dn_scan(F, l, F.bid >> 4, (F.bid >> 2) & 3, (F.bid >> 1) & 1, F.bid & 1); PHASE_SCAN(F, l); if (DUP(10)) { __syncthreads(); naive_scan(F, l, 1); } if (DUP(11)) { __syncthreads(); attn_phase(F, l, 2); } if (DUP(12)) { __syncthreads(); convert_moe_queue(F, l, 3); } } SEAM(pb + 3);
        if (IN(pb + 4)) { PHASE_FIN(F, l); if (DUP(4)) { __syncthreads(); PHASE_FIN(F, l); } } SEAM(pb + 4);
        if (IN(pb + 5)) { PHASE_OUTPROJ(F, l); if (DUP(5) && l == 0) { __syncthreads(); PHASE_OUTPROJ(F, l); } } SEAM(pb + 5);
        if (IN(pb + 6)) { PHASE_NORM2(F, l); } SEAM(pb + 6);
        if (IN(pb + 7)) { PHASE_SCATTER(F, l); if (DUP(7)) { __syncthreads(); PHASE_SCATTER(F, l); } } SEAM(pb + 7);
        if (IN(pb + 8)) { PHASE_GEMM1(F, l); if (DUP(8)) { __syncthreads(); PHASE_GEMM1(F, l); } } SEAM(pb + 8);
        if (IN(pb + 9)) { PHASE_GEMM2(F, l); if (DUP(9)) { __syncthreads(); PHASE_GEMM2(F, l); } } SEAM(pb + 9);
    }
    if (IN(21)) { phase_final(F, MK_STAGE >= 9); if (DUP(13)) { __syncthreads(); phase_final(F, MK_STAGE >= 9); } }
#undef IN
#undef SEAM
}

extern "C" void kernel_launch(void* const* d_in, const int* in_sizes, int n_in, void* d_out, int out_size, void* d_ws, size_t ws_size, hipStream_t stream) {
    static int grid = 0;
    if (grid == 0) {
        if (n_in != N_IN || out_size != NLAT * DM || ws_size < WS_END) { fprintf(stderr, "kernel_launch: unexpected shapes (n_in %d, out %d, ws %zu); nothing launched\n", n_in, out_size, ws_size); grid = -1; return; }
        int dev = 0, cus = 0, per_cu = 0;
        if (hipGetDevice(&dev) != hipSuccess || hipDeviceGetAttribute(&cus, hipDeviceAttributeMultiprocessorCount, dev) != hipSuccess) { grid = -1; return; }
        if (hipFuncSetAttribute((const void*)fwd_kernel, hipFuncAttributeMaxDynamicSharedMemorySize, LDS_BYTES) != hipSuccess) { fprintf(stderr, "kernel_launch: hipFuncSetAttribute failed\n"); grid = -1; return; }
        if (hipOccupancyMaxActiveBlocksPerMultiprocessor(&per_cu, (const void*)fwd_kernel, NTHREADS, LDS_BYTES) != hipSuccess || per_cu < 1) { fprintf(stderr, "kernel_launch: occupancy query says %d\n", per_cu); }
        (void)hipGetLastError();
        grid = cus;
        if (grid != 256) { fprintf(stderr, "kernel_launch: built for 256 CUs, device has %d; nothing launched\n", cus); grid = -1; return; }
    }
    if (grid < 0) return;
    if (hipMemsetAsync((char*)d_ws + WS_CTL, 0, CTL_ZERO_BYTES, stream) != hipSuccess) return;
    Args a{};
    for (int i = 0; i < N_IN; ++i) a.in[i] = (const float*)d_in[i];
    a.out = (float*)d_out; a.ws = (unsigned char*)d_ws;
#if MK_SPLIT
    for (int p = 0; p < N_PHASES; ++p) { a.ph_lo = p; a.ph_hi = p + 1; hipLaunchKernelGGL(fwd_kernel, dim3(grid), dim3(NTHREADS), LDS_BYTES, stream, a); }
#else
    a.ph_lo = 0; a.ph_hi = N_PHASES;
    hipLaunchKernelGGL(fwd_kernel, dim3(grid), dim3(NTHREADS), LDS_BYTES, stream, a);
#endif
    const hipError_t le = hipPeekAtLastError();
    if (le != hipSuccess) fprintf(stderr, "kernel_launch: launch failed: %s\n", hipGetErrorName(le));
}
```

```cpp
#include <hip/hip_runtime.h>
#include <cstdio>
#include <cstdint>

constexpr int DM = 2048, NB = 4, SEQ = 4096, CTXL = 256, DEPTH = 2;
constexpr int NLAT = NB * SEQ, NCTX = NB * CTXL, NTOK = NLAT + NCTX;
constexpr int NCT = NTOK / 64;
constexpr int IN_W = 4624, PW = 4864;
constexpr int PC_Q = 0, PC_K = 1024, PC_V = 1280, PC_DQ = 1536, PC_DK = 2048, PC_DV = 2560, PC_DG = 3072, PC_LX = 3584, PC_LY = 4096, PC_BETA = 4608, PC_DEC = 4616;
constexpr int NEXP = 32, TOPK = 4, DEXP = 1024;
constexpr int MOE_ROWS = 304 * 256;
constexpr float EPS = 1e-6f;
#ifndef MK_STAGE
#define MK_STAGE 99
#endif
#ifndef FP8_INPROJ
#define FP8_INPROJ 0
#endif
#ifndef FP8_OUTPROJ
#define FP8_OUTPROJ 0
#endif
#ifndef SCAN_SPLIT_ORDER
#define SCAN_SPLIT_ORDER 1
#endif
#ifndef X_BF16
#define X_BF16 1
#endif
namespace pg8 {
#define PG8_LAS __attribute__((address_space(3)))
typedef unsigned short bf16_t;
typedef short bf16x8 __attribute__((ext_vector_type(8)));
typedef float f32x4 __attribute__((ext_vector_type(4)));
typedef unsigned u32x4 __attribute__((ext_vector_type(4)));
typedef float f32x2 __attribute__((ext_vector_type(2)));
constexpr int BM = 256, BK = 64, HALF = 128, HTB = HALF * BK * 2  , STAGE_BYTES = 8 * HTB, NXCD = 8, WGM = 8;

__host__ __device__ __forceinline__ int lds_byte(int r, int c) { const int st = (r >> 4) * 2 + (c >> 5), rr = r & 15, cc = c & 31, ob = rr * 64 + cc * 2; return st * 1024 + (ob ^ (((ob >> 9) & 1) << 5)); }
__host__ __device__ __forceinline__ void stage_rc(int b, int& R, int& C) { const int st = b / 1024, sb = b % 1024, swz = sb ^ (((sb >> 9) & 1) << 5); R = (st >> 1) * 16 + swz / 64; C = (st & 1) * 32 + (swz % 64) / 2; }
__host__ __device__ __forceinline__ int perm32(int rho) { const int n = rho >> 4, i = rho & 15; return 8 * (i >> 2) + 4 * n + (i & 3); }

struct Unit { int pm, pn, e; };
typedef int v4i_t __attribute__((ext_vector_type(4)));
typedef int v8i_t __attribute__((ext_vector_type(8)));
struct Gemm { const bf16_t* A; const bf16_t* Bt; int M, N, K; int bscale = 0x7F7F7F7F; };

struct StaticOrder {
    static constexpr bool GATHER = false; const int* row_tab = nullptr;
    int nM, nN, nwg, G, c; const char* A; const char* Bt; size_t tstep;
    __device__ void init(const Gemm& g, int G_, int c_) { nM = g.M / BM; nN = g.N / BM; nwg = nM * nN; G = G_; c = c_; A = (const char*)g.A; Bt = (const char*)g.Bt; tstep = (size_t)BM * g.K * 2; }
    __device__ bool next(int i, Unit& u) const {
        const long L = (long)i * G + c; if (L >= nwg) return false;
        int wgid = (int)L; { const int q = nwg / NXCD, r = nwg % NXCD, xcd = wgid % NXCD, off = wgid / NXCD; wgid = (xcd < r ? xcd * (q + 1) : r * (q + 1) + (xcd - r) * q) + off; }
        const int nig = WGM * nN, gid = wgid / nig, fm = gid * WGM, gsz = (nM - fm) < WGM ? (nM - fm) : WGM;
        u.pm = fm + ((wgid % nig) % gsz); u.pn = (wgid % nig) / gsz; u.e = 0; return true;
    }
    __device__ __forceinline__ const char* a_ptr(const Unit& u) const { return A + (size_t)u.pm * tstep; }
    __device__ __forceinline__ const char* b_ptr(const Unit& u) const { return Bt + (size_t)u.pn * tstep; }
    __device__ __forceinline__ void a_ready(const Unit&) const {}
    __device__ __forceinline__ void done(const Unit&) const {}
};
struct StaticOrderG : StaticOrder {
    static constexpr bool GATHER = true;
    __device__ __forceinline__ const char* a_ptr(const Unit&) const { return A; }
};
__device__ __forceinline__ unsigned cvt_pk_bf16(float lo, float hi) { unsigned r; asm volatile("v_cvt_pk_bf16_f32 %0, %1, %2" : "=v"(r) : "v"(lo), "v"(hi)); return r; }
struct EpiBf16Plain {
    static constexpr bool PERM = true, AFTER_DRAIN = false;
    bf16_t* O; int ldc;
    __device__ __forceinline__ void operator()(const f32x4 (&acc)[2][2][4][2], const Unit& u, int wr, int wc, int fr, int fq) const {
        const int row0 = u.pm * BM + wr * 64 + fr, col0 = u.pn * BM + wc * 32 + 8 * fq;
#pragma unroll
        for (int ai = 0; ai < 2; ++ai)
#pragma unroll
            for (int m = 0; m < 4; ++m) { bf16_t* rowp = O + (size_t)(row0 + ai * HALF + m * 16) * ldc + col0;
#pragma unroll
                for (int bj = 0; bj < 2; ++bj) { const f32x4 v0 = acc[ai][bj][m][0], v1 = acc[ai][bj][m][1];
                    u32x4 w; w.x = cvt_pk_bf16(v0[0], v0[1]); w.y = cvt_pk_bf16(v0[2], v0[3]); w.z = cvt_pk_bf16(v1[0], v1[1]); w.w = cvt_pk_bf16(v1[2], v1[3]);
                    *(u32x4*)(rowp + bj * HALF) = w; } }
    }
};
struct EpiResGate {
    static constexpr bool PERM = false, AFTER_DRAIN = false;
    const float* base_lat; const float* base_ctx; float* out; const float* modg;
    __device__ __forceinline__ void operator()(const f32x4 (&acc)[2][2][4][2], const Unit& u, int wr, int wc, int fr, int fq) const {
        const int r = u.pm < 64 ? (u.pm >> 4) : 4; const int col0 = u.pn * BM + wc * 32 + 4 * fq;
        const float* g = modg + (size_t)r * 12288 + col0;
        f32x4 gv[2][2];
#pragma unroll
        for (int bj = 0; bj < 2; ++bj)
#pragma unroll
            for (int n = 0; n < 2; ++n) gv[bj][n] = *(const f32x4*)(g + bj * HALF + n * 16);
#pragma unroll
        for (int ai = 0; ai < 2; ++ai)
#pragma unroll
            for (int m = 0; m < 4; ++m) { const int row = u.pm * BM + ai * HALF + wr * 64 + m * 16 + fr;
                const float* bp = (row < 16384 ? base_lat + (size_t)row * 2048 : base_ctx + (size_t)(row - 16384) * 2048) + col0; float* op = out + (size_t)row * 2048 + col0;
#pragma unroll
                for (int bj = 0; bj < 2; ++bj)
#pragma unroll
                    for (int n = 0; n < 2; ++n) { const f32x4 b = *(const f32x4*)(bp + bj * HALF + n * 16); *(f32x4*)(op + bj * HALF + n * 16) = b + gv[bj][n] * acc[ai][bj][m][n]; }
                asm volatile("" ::: "memory"); }
    }
};
struct EpiResGateB {
    static constexpr bool PERM = true, AFTER_DRAIN = false;
    const float* base_lat; const float* base_ctx; const bf16_t* xb_in; bf16_t* xb_out; const float* modg; int f32base;
    __device__ __forceinline__ void operator()(const f32x4 (&acc)[2][2][4][2], const Unit& u, int wr, int wc, int fr, int fq) const {
        const int r = u.pm < 64 ? (u.pm >> 4) : 4; const int col0 = u.pn * BM + wc * 32 + 8 * fq;
        const float* g = modg + (size_t)r * 12288 + col0;
        f32x4 gv[2][2];
#pragma unroll
        for (int bj = 0; bj < 2; ++bj)
#pragma unroll
            for (int n = 0; n < 2; ++n) gv[bj][n] = *(const f32x4*)(g + bj * HALF + 4 * n);
#pragma unroll
        for (int ai = 0; ai < 2; ++ai)
#pragma unroll
            for (int m = 0; m < 4; ++m) { const int row = u.pm * BM + ai * HALF + wr * 64 + m * 16 + fr;
#pragma unroll
                for (int bj = 0; bj < 2; ++bj) { f32x4 b0, b1;
                    if (f32base) { const float* bp = (row < 16384 ? base_lat + (size_t)row * 2048 : base_ctx + (size_t)(row - 16384) * 2048) + col0 + bj * HALF; b0 = *(const f32x4*)bp; b1 = *(const f32x4*)(bp + 4); }
                    else { const u32x4 w = *(const u32x4*)(xb_in + (size_t)row * 2048 + col0 + bj * HALF);
                        b0 = (f32x4){__builtin_bit_cast(float, w.x << 16), __builtin_bit_cast(float, w.x & 0xffff0000u), __builtin_bit_cast(float, w.y << 16), __builtin_bit_cast(float, w.y & 0xffff0000u)};
                        b1 = (f32x4){__builtin_bit_cast(float, w.z << 16), __builtin_bit_cast(float, w.z & 0xffff0000u), __builtin_bit_cast(float, w.w << 16), __builtin_bit_cast(float, w.w & 0xffff0000u)}; }
                    const f32x4 v0 = b0 + gv[bj][0] * acc[ai][bj][m][0], v1 = b1 + gv[bj][1] * acc[ai][bj][m][1];
                    u32x4 o; o.x = cvt_pk_bf16(v0[0], v0[1]); o.y = cvt_pk_bf16(v0[2], v0[3]); o.z = cvt_pk_bf16(v1[0], v1[1]); o.w = cvt_pk_bf16(v1[2], v1[3]);
                    *(u32x4*)(xb_out + (size_t)row * 2048 + col0 + bj * HALF) = o; }
                asm volatile("" ::: "memory"); }
    }
};
struct EpiSwiglu {
    static constexpr bool PERM = true, AFTER_DRAIN = false;
    bf16_t* O; const float* bgu;
    __device__ __forceinline__ void operator()(const f32x4 (&acc)[2][2][4][2], const Unit& u, int wr, int wc, int fr, int fq) const {
        const int row0 = u.pm * BM + wr * 64 + fr, cc0 = wc * 32 + 8 * fq;
        const float* bg = bgu + (size_t)u.e * 2048 + u.pn * 128 + cc0;
        f32x4 bglu[2], blin[2];
#pragma unroll
        for (int n = 0; n < 2; ++n) { bglu[n] = *(const f32x4*)(bg + 4 * n); blin[n] = *(const f32x4*)(bg + 1024 + 4 * n); }
#pragma unroll
        for (int ai = 0; ai < 2; ++ai)
#pragma unroll
            for (int m = 0; m < 4; ++m) { bf16_t* rowp = O + (size_t)(row0 + ai * HALF + m * 16) * 1024 + u.pn * 128 + cc0;
                float r[8];
#pragma unroll
                for (int n = 0; n < 2; ++n) { const f32x4 g = acc[ai][0][m][n] + bglu[n], l = acc[ai][1][m][n] + blin[n];
#pragma unroll
                    for (int i = 0; i < 4; ++i) { const float gg = fminf(g[i], 7.0f); const float ll = fminf(fmaxf(l[i], -7.0f), 7.0f);
                        r[4 * n + i] = (ll + 1.0f) * gg * __builtin_amdgcn_rcpf(1.0f + __builtin_amdgcn_exp2f(-1.702f * 1.4426950408889634f * gg)); } }
                u32x4 w; w.x = cvt_pk_bf16(r[0], r[1]); w.y = cvt_pk_bf16(r[2], r[3]); w.z = cvt_pk_bf16(r[4], r[5]); w.w = cvt_pk_bf16(r[6], r[7]);
                *(u32x4*)rowp = w; }
    }
};
struct EpiSwiglu8 {
    static constexpr bool PERM = true, AFTER_DRAIN = false;
    unsigned char* O; const float* bgu;
    __device__ __forceinline__ void operator()(const f32x4 (&acc)[2][2][4][2], const Unit& u, int wr, int wc, int fr, int fq) const {
        const int row0 = u.pm * BM + wr * 64 + fr, cc0 = wc * 32 + 8 * fq;
        const float* bg = bgu + (size_t)u.e * 2048 + u.pn * 128 + cc0;
        f32x4 bglu[2], blin[2];
#pragma unroll
        for (int n = 0; n < 2; ++n) { bglu[n] = *(const f32x4*)(bg + 4 * n); blin[n] = *(const f32x4*)(bg + 1024 + 4 * n); }
#pragma unroll
        for (int ai = 0; ai < 2; ++ai)
#pragma unroll
            for (int m = 0; m < 4; ++m) { unsigned char* rowp = O + (size_t)(row0 + ai * HALF + m * 16) * 1024 + u.pn * 128 + cc0;
                float r[8];
#pragma unroll
                for (int n = 0; n < 2; ++n) { const f32x4 g = acc[ai][0][m][n] + bglu[n], l = acc[ai][1][m][n] + blin[n];
#pragma unroll
                    for (int i = 0; i < 4; ++i) { const float gg = fminf(g[i], 7.0f); const float ll = fminf(fmaxf(l[i], -7.0f), 7.0f);
                        r[4 * n + i] = (ll + 1.0f) * gg * __builtin_amdgcn_rcpf(1.0f + __builtin_amdgcn_exp2f(-1.702f * 1.4426950408889634f * gg)); } }
                int w0 = 0, w1 = 0; w0 = __builtin_amdgcn_cvt_pk_fp8_f32(r[0], r[1], w0, false); w0 = __builtin_amdgcn_cvt_pk_fp8_f32(r[2], r[3], w0, true); w1 = __builtin_amdgcn_cvt_pk_fp8_f32(r[4], r[5], w1, false); w1 = __builtin_amdgcn_cvt_pk_fp8_f32(r[6], r[7], w1, true);
                typedef unsigned u32x2 __attribute__((ext_vector_type(2))); *(u32x2*)rowp = (u32x2){(unsigned)w0, (unsigned)w1}; }
    }
};
struct EpiDown {
    static constexpr bool PERM = true, AFTER_DRAIN = false;
    bf16_t* O; const float* bdn; const float* rowg;
    __device__ __forceinline__ void operator()(const f32x4 (&acc)[2][2][4][2], const Unit& u, int wr, int wc, int fr, int fq) const {
        const int row0 = u.pm * BM + wr * 64 + fr, col0 = u.pn * BM + wc * 32 + 8 * fq;
        const float* bb = bdn + (size_t)u.e * 2048 + col0;
        float gt[2][4];
#pragma unroll
        for (int ai = 0; ai < 2; ++ai)
#pragma unroll
            for (int m = 0; m < 4; ++m) gt[ai][m] = rowg[row0 + ai * HALF + m * 16];
#pragma unroll
        for (int bj = 0; bj < 2; ++bj) { const f32x4 b0 = *(const f32x4*)(bb + bj * HALF), b1 = *(const f32x4*)(bb + bj * HALF + 4);
#pragma unroll
            for (int ai = 0; ai < 2; ++ai)
#pragma unroll
                for (int m = 0; m < 4; ++m) { const int row = row0 + ai * HALF + m * 16; const f32x4 v0 = (acc[ai][bj][m][0] + b0) * gt[ai][m], v1 = (acc[ai][bj][m][1] + b1) * gt[ai][m];
                    u32x4 w; w.x = cvt_pk_bf16(v0[0], v0[1]); w.y = cvt_pk_bf16(v0[2], v0[3]); w.z = cvt_pk_bf16(v1[0], v1[1]); w.w = cvt_pk_bf16(v1[2], v1[3]);
                    *(u32x4*)(O + (size_t)row * 2048 + col0 + bj * HALF) = w; } }
    }
};
template <bool GATHER_> struct MoeOrderT {
    static constexpr bool GATHER = GATHER_;
    int c, nblk; const char* A; const char* Bt; size_t a_tstep, b_estep, b_tstep; const PG8_LAS int* blk_end; const int* row_tab;
    __device__ __forceinline__ bool next(int i, Unit& u) const {
#if defined(MOE_MAP) && MOE_MAP == 1
        const int L = i * 256 + c, rb = L >> 3, j = (L & 7);
#elif defined(MOE_MAP) && MOE_MAP == 2
        const int x = c & 7, jj = c >> 3, gi = i * 8 + x, rb = 8 * (gi >> 1) + (jj >> 2), j = (jj & 3) + 4 * (gi & 1);
#else
        const int x = c & 7, j = c >> 3, gi = i * 8 + x, rb = 4 * gi + (j >> 3);
#endif
        if (rb >= nblk) return false;
        int e = 0;
        for (int k = 0; k < 31; ++k) e += (rb >= blk_end[k]) ? 1 : 0;
        u.pm = rb; u.pn = j & 7; u.e = __builtin_amdgcn_readfirstlane(e); return true;
    }
    __device__ __forceinline__ const char* a_ptr(const Unit& u) const { return GATHER ? A : A + (size_t)u.pm * a_tstep; }
    __device__ __forceinline__ const char* b_ptr(const Unit& u) const { return Bt + (size_t)u.e * b_estep + (size_t)u.pn * b_tstep; }
    __device__ __forceinline__ void a_ready(const Unit&) const {}
    __device__ __forceinline__ void done(const Unit&) const {}
};
typedef MoeOrderT<false> MoeOrder;
typedef MoeOrderT<true> MoeOrderG;
template <class Epi, class Sched, bool ALIGN_EPI = false, bool SP2 = false, bool FP8 = false>
__device__ __forceinline__ void gemm_phase(PG8_LAS unsigned char* lds, const Gemm g, const Sched& S, const Epi& E) {
    int tid = threadIdx.x; asm volatile("" : "+v"(tid));
    const int wid = __builtin_amdgcn_readfirstlane(tid >> 6), lane = tid & 63, wr = wid >> 2, wc = wid & 3, fr = lane & 15, fq = lane >> 4;
    const int K = g.K, nt = K / BK;
    unsigned voffA[2], voffB[2];
#pragma unroll
    for (int i = 0; i < 2; ++i) { int R, C; stage_rc(tid * 16 + i * 8192, R, C); const int Rb = Epi::PERM ? ((R & ~31) + perm32(R & 31)) : R;
        voffA[i] = (unsigned)(R * K + C) * 2u; voffB[i] = (unsigned)(Rb * K + C) * 2u; }
    unsigned gc0[2] = {0u, 0u}, gc1[2] = {0u, 0u}; int gR = 0, gC = 0;
    if constexpr (Sched::GATHER) { stage_rc(tid * 16, gR, gC); }
#define PG8_GLOAD(dst0, dst1, u) do { const int* _rt = S.row_tab + (size_t)(u).pm * BM + gR; \
        dst0[0] = (unsigned)_rt[0] * (unsigned)(K * 2) + (unsigned)(gC * 2); dst0[1] = (unsigned)_rt[64] * (unsigned)(K * 2) + (unsigned)(gC * 2); \
        dst1[0] = (unsigned)_rt[128] * (unsigned)(K * 2) + (unsigned)(gC * 2); dst1[1] = (unsigned)_rt[192] * (unsigned)(K * 2) + (unsigned)(gC * 2); } while (0)
    const size_t kstep = (size_t)(BK * 2);
    const size_t hstep = (size_t)HALF * K * 2;
    const size_t tstep = 2 * hstep;
    const unsigned ldsw = (unsigned)wid * 1024u;
    const int aoff = lds_byte(wr * 64 + fr, fq * 8); int boff = lds_byte(wc * 32 + fr, fq * 8) + 4 * HTB;
    asm volatile("" : "+v"(boff));
#define PG8_SA(b, h) (((b) * 2 + (h)) * HTB)
#define PG8_SB(b, h) ((4 + (b) * 2 + (h)) * HTB)
#define PG8_SBR(b, h) (((b) * 2 + (h)) * HTB)
#define PG8_STAGE(bufoff, gbase, voff) do { _Pragma("unroll") for (int _i = 0; _i < 2; ++_i) \
        __builtin_amdgcn_global_load_lds((const unsigned*)((const char*)(gbase) + (voff)[_i]), (PG8_LAS unsigned*)(lds + (bufoff) + ldsw + _i * 8192), 16, 0, 0); } while (0)
#define PG8_LD16(off) (*(const PG8_LAS v4i_t*)(lds + (off)))
#define PG8_LDA(dst, b, h) do { if constexpr (FP8) { _Pragma("unroll") for (int m = 0; m < 4; ++m) dst##8[m] = __builtin_shufflevector(PG8_LD16(PG8_SA(b, h) + aoff + m * 2048), PG8_LD16(PG8_SA(b, h) + aoff + m * 2048 + 1024), 0, 1, 2, 3, 4, 5, 6, 7); } \
        else { _Pragma("unroll") for (int m = 0; m < 4; ++m) _Pragma("unroll") for (int k = 0; k < 2; ++k) dst[m][k] = *(const PG8_LAS bf16x8*)(lds + PG8_SA(b, h) + aoff + m * 2048 + k * 1024); } } while (0)
#define PG8_LDB(dst, b, h) do { if constexpr (FP8) { _Pragma("unroll") for (int n = 0; n < 2; ++n) dst##8[n] = __builtin_shufflevector(PG8_LD16(PG8_SBR(b, h) + boff + n * 2048), PG8_LD16(PG8_SBR(b, h) + boff + n * 2048 + 1024), 0, 1, 2, 3, 4, 5, 6, 7); } \
        else { _Pragma("unroll") for (int n = 0; n < 2; ++n) _Pragma("unroll") for (int k = 0; k < 2; ++k) dst[n][k] = *(const PG8_LAS bf16x8*)(lds + PG8_SBR(b, h) + boff + n * 2048 + k * 1024); } } while (0)
#define PG8_MMA(ai, bj, At, Bt) do { __builtin_amdgcn_s_setprio(1); \
        if constexpr (FP8) { _Pragma("unroll") for (int m = 0; m < 4; ++m) _Pragma("unroll") for (int n = 0; n < 2; ++n) \
            acc[ai][bj][m][n] = __builtin_amdgcn_mfma_scale_f32_16x16x128_f8f6f4(Bt##8[n], At##8[m], acc[ai][bj][m][n], 0, 0, 0, g.bscale, 0, g.bscale); }     \
        else { _Pragma("unroll") for (int m = 0; m < 4; ++m) _Pragma("unroll") for (int n = 0; n < 2; ++n) _Pragma("unroll") for (int k = 0; k < 2; ++k) \
            acc[ai][bj][m][n] = __builtin_amdgcn_mfma_f32_16x16x32_bf16(Bt[n][k], At[m][k], acc[ai][bj][m][n], 0, 0, 0); } \
        __builtin_amdgcn_s_setprio(0); } while (0)
#define PG8_WAIT_V(n) asm volatile("s_waitcnt vmcnt(" #n ")" ::: "memory")
#define PG8_WAIT_L(n) asm volatile("s_waitcnt lgkmcnt(" #n ")" ::: "memory")
#define PG8_BAR __builtin_amdgcn_s_barrier()
#define PG8_SCHED __builtin_amdgcn_sched_barrier(0)
    Unit cur, nxt; int ui = 0;
    if (!S.next(0, cur)) return;
    f32x4 acc[2][2][4][2];
#pragma unroll
    for (int a = 0; a < 2; ++a)
#pragma unroll
        for (int b = 0; b < 2; ++b)
#pragma unroll
            for (int m = 0; m < 4; ++m)
#pragma unroll
                for (int n = 0; n < 2; ++n) acc[a][b][m][n] = (f32x4){0.f, 0.f, 0.f, 0.f};
    bf16x8 At[4][2], B0[2][2], B1[2][2]; v8i_t At8[4], B08[2], B18[2];
    const char* cA = S.a_ptr(cur); const char* cB = S.b_ptr(cur);
    S.a_ready(cur);
    if constexpr (SP2) {
        if constexpr (Sched::GATHER) { PG8_GLOAD(gc0, gc1, cur);
        PG8_STAGE(PG8_SB(0, 0), cB, voffB); PG8_STAGE(PG8_SB(0, 1), cB + hstep, voffB); PG8_STAGE(PG8_SA(0, 0), cA, gc0); PG8_STAGE(PG8_SA(0, 1), cA, gc1);
        if (wr == 1) PG8_BAR;
        PG8_WAIT_V(2); PG8_BAR;
        PG8_STAGE(PG8_SB(1, 0), cB + kstep, voffB); PG8_STAGE(PG8_SA(1, 0), cA + kstep, gc0); PG8_STAGE(PG8_SB(1, 1), cB + hstep + kstep, voffB);
        } else {
        PG8_STAGE(PG8_SB(0, 0), cB, voffB); PG8_STAGE(PG8_SB(0, 1), cB + hstep, voffB); PG8_STAGE(PG8_SA(0, 0), cA, voffA); PG8_STAGE(PG8_SA(0, 1), cA + hstep, voffA);
        if (wr == 1) PG8_BAR;
        PG8_WAIT_V(2); PG8_BAR;
        PG8_STAGE(PG8_SB(1, 0), cB + kstep, voffB); PG8_STAGE(PG8_SA(1, 0), cA + kstep, voffA); PG8_STAGE(PG8_SB(1, 1), cB + hstep + kstep, voffB);
        }
        PG8_WAIT_V(6); PG8_BAR;
    } else {
        PG8_STAGE(PG8_SB(0, 0), cB, voffB); PG8_STAGE(PG8_SA(0, 0), cA, voffA); PG8_STAGE(PG8_SB(0, 1), cB + hstep, voffB); PG8_STAGE(PG8_SA(0, 1), cA + hstep, voffA);
        if (wr == 1) PG8_BAR;
        PG8_WAIT_V(4); PG8_BAR;
        PG8_STAGE(PG8_SB(1, 0), cB + kstep, voffB); PG8_STAGE(PG8_SA(1, 0), cA + kstep, voffA); PG8_STAGE(PG8_SB(1, 1), cB + hstep + kstep, voffB);
        PG8_WAIT_V(6); PG8_BAR;
    }
    for (;;) {
        const bool has_next = S.next(ui + 1, nxt);
        const char* nA = has_next ? S.a_ptr(nxt) : cA; const char* nB = has_next ? S.b_ptr(nxt) : cB;
#pragma unroll 1
        for (int t = 0; t < nt; t += 2) {
            const bool last = (t == nt - 2);
            const char* a1 = cA + (size_t)(t + 1) * kstep;
            const char* a2 = last ? nA : cA + (size_t)(t + 2) * kstep; const char* b2 = last ? nB : cB + (size_t)(t + 2) * kstep;
            const char* a3 = a2 + kstep; const char* b3 = b2 + kstep;
            if (last && has_next) S.a_ready(nxt);

            if constexpr (SP2) {
            PG8_LDB(B0, 0, 0); PG8_LDB(B1, 0, 1); PG8_SCHED; PG8_LDA(At, 0, 0); if constexpr (Sched::GATHER) PG8_STAGE(PG8_SA(1, 1), a1, gc1); else PG8_STAGE(PG8_SA(1, 1), a1 + hstep, voffA);
            if constexpr (Sched::GATHER) { if (last && has_next) PG8_GLOAD(gc0, gc1, nxt); }
            PG8_WAIT_V(8); PG8_WAIT_L(0); PG8_BAR; PG8_MMA(0, 0, At, B0); PG8_MMA(0, 1, At, B1); PG8_BAR; PG8_SCHED;
            PG8_LDA(At, 0, 1); PG8_STAGE(PG8_SB(0, 0), b2, voffB); PG8_STAGE(PG8_SB(0, 1), b2 + hstep, voffB); if constexpr (Sched::GATHER) PG8_STAGE(PG8_SA(0, 0), a2, gc0); else PG8_STAGE(PG8_SA(0, 0), a2, voffA);
            PG8_WAIT_V(8); PG8_WAIT_L(0); PG8_BAR; PG8_MMA(1, 0, At, B0); PG8_MMA(1, 1, At, B1); PG8_BAR; PG8_SCHED;
            PG8_LDB(B0, 1, 0); PG8_LDB(B1, 1, 1); PG8_SCHED; PG8_LDA(At, 1, 0); if constexpr (Sched::GATHER) PG8_STAGE(PG8_SA(0, 1), a2, gc1); else PG8_STAGE(PG8_SA(0, 1), a2 + hstep, voffA);
            PG8_WAIT_V(8); PG8_WAIT_L(0); PG8_BAR; PG8_MMA(0, 0, At, B0); PG8_MMA(0, 1, At, B1); PG8_BAR; PG8_SCHED;
            PG8_LDA(At, 1, 1); PG8_STAGE(PG8_SB(1, 0), b3, voffB); PG8_STAGE(PG8_SB(1, 1), b3 + hstep, voffB); if constexpr (Sched::GATHER) PG8_STAGE(PG8_SA(1, 0), a3, gc0); else PG8_STAGE(PG8_SA(1, 0), a3, voffA);
            PG8_WAIT_V(8); PG8_WAIT_L(0); PG8_BAR; PG8_MMA(1, 0, At, B0); PG8_MMA(1, 1, At, B1); PG8_BAR; PG8_SCHED;
            } else {
            PG8_LDB(B0, 0, 0); PG8_SCHED; PG8_LDA(At, 0, 0); PG8_STAGE(PG8_SA(1, 1), a1 + hstep, voffA);
            PG8_WAIT_L(8); PG8_BAR; PG8_WAIT_L(0); PG8_MMA(0, 0, At, B0); PG8_BAR; PG8_SCHED;
            PG8_LDB(B1, 0, 1); PG8_STAGE(PG8_SB(0, 0), b2, voffB);
            PG8_BAR; PG8_WAIT_L(0); PG8_MMA(0, 1, At, B1); PG8_BAR;
            PG8_LDA(At, 0, 1); PG8_STAGE(PG8_SA(0, 0), a2, voffA);
            PG8_BAR; PG8_WAIT_L(0); PG8_MMA(1, 0, At, B0); PG8_BAR; PG8_SCHED;
            PG8_STAGE(PG8_SB(0, 1), b2 + hstep, voffB);
            PG8_WAIT_V(6); PG8_BAR; PG8_MMA(1, 1, At, B1); PG8_BAR;
            PG8_LDB(B0, 1, 0); PG8_SCHED; PG8_LDA(At, 1, 0); PG8_STAGE(PG8_SA(0, 1), a2 + hstep, voffA);
            PG8_WAIT_L(8); PG8_BAR; PG8_WAIT_L(0); PG8_MMA(0, 0, At, B0); PG8_BAR; PG8_SCHED;
            PG8_LDB(B1, 1, 1); PG8_STAGE(PG8_SB(1, 0), b3, voffB);
            PG8_BAR; PG8_WAIT_L(0); PG8_MMA(0, 1, At, B1); PG8_BAR;
            PG8_LDA(At, 1, 1); PG8_STAGE(PG8_SA(1, 0), a3, voffA);
            PG8_BAR; PG8_WAIT_L(0); PG8_MMA(1, 0, At, B0); PG8_BAR; PG8_SCHED;
            PG8_STAGE(PG8_SB(1, 1), b3 + hstep, voffB);
            PG8_WAIT_V(6); PG8_BAR; PG8_MMA(1, 1, At, B1); PG8_BAR;
            }
        }
        if constexpr (ALIGN_EPI) { if (wr == 0) PG8_BAR; }
        if constexpr (!Epi::AFTER_DRAIN) { int fr_e = fr, fq_e = fq; asm volatile("" : "+v"(fr_e), "+v"(fq_e));
            E(acc, cur, wr, wc, fr_e, fq_e); S.done(cur); }
        if (!has_next) break;
#pragma unroll
        for (int a = 0; a < 2; ++a)
#pragma unroll
            for (int b = 0; b < 2; ++b)
#pragma unroll
                for (int m = 0; m < 4; ++m)
#pragma unroll
                    for (int n = 0; n < 2; ++n) acc[a][b][m][n] = (f32x4){0.f, 0.f, 0.f, 0.f};
        cur = nxt; cA = nA; cB = nB; ++ui;
        if constexpr (ALIGN_EPI) { if (wr == 1) PG8_BAR; }
    }
    PG8_WAIT_V(0);
    if constexpr (!ALIGN_EPI) { if (wr == 0) PG8_BAR; }
    PG8_BAR;
    if constexpr (Epi::AFTER_DRAIN) { E.fused(acc, cur, wr, wc, fr, fq, lds, wid, lane); S.done(cur); }
#undef PG8_GLOAD
#undef PG8_SA
#undef PG8_SB
#undef PG8_SBR
#undef PG8_STAGE
#undef PG8_LDA
#undef PG8_LDB
#undef PG8_MMA
#undef PG8_LD16
#undef PG8_WAIT_V
#undef PG8_WAIT_L
#undef PG8_BAR
#undef PG8_SCHED
}
}

constexpr size_t MiB = 1u << 20;
constexpr size_t WS_CTL = 0, CTL_ZERO_BYTES = 1 * MiB;
constexpr size_t WS_MOD  = 1 * MiB;
constexpr size_t WS_WRT  = 2 * MiB;
constexpr size_t WS_MOEI = 3 * MiB;
constexpr size_t WS_IDT  = WS_MOEI + 5 * 512 * 1024;
constexpr size_t WS_LRC  = 6 * MiB;
constexpr size_t WS_DNS  = 12 * MiB;
constexpr size_t WS_WIN  = 16 * MiB;
constexpr size_t WS_WOUT = 56 * MiB;
constexpr size_t WS_WGU  = 72 * MiB;
constexpr size_t WS_WDN  = 584 * MiB;
constexpr size_t WS_X    = 840 * MiB;
constexpr size_t WS_H    = 976 * MiB;
constexpr size_t WS_P    = 1044 * MiB;
constexpr size_t WS_CC   = 1206 * MiB;
constexpr size_t WS_VT   = 1274 * MiB;
constexpr size_t WS_VTC  = WS_VT + 8 * MiB;
constexpr size_t WS_DNT  = 1284 * MiB;
constexpr size_t DNT_BYTES = 90112;
constexpr size_t WS_DNO  = 1472 * MiB;
constexpr size_t WS_LRH  = 1540 * MiB;
constexpr size_t WS_LRA  = 1608 * MiB;
constexpr size_t WS_XS   = 1676 * MiB;
constexpr size_t WS_ACT  = 1980 * MiB;
constexpr size_t WS_YS   = 2132 * MiB;
constexpr size_t WS_END  = 2436 * MiB;
constexpr int CW_TMO = 0;
constexpr int CW_BAR = 4096;
constexpr int CW_CNT = 8192;
constexpr int CW_ATQ = 12288;

constexpr int RING_OFF = 0, RING_BYTES = 131072;
constexpr int LDSCTL_OFF = RING_BYTES, MISC_OFF = LDSCTL_OFF + 320;
constexpr int LDS_X_OFF = RING_BYTES + 1024;
constexpr int LDS_BYTES = 147456;
constexpr int NWAVES = 8, NTHREADS = 512;

#define GAS __attribute__((address_space(1)))
#define LAS __attribute__((address_space(3)))
typedef unsigned short bf16;
typedef unsigned v4u __attribute__((ext_vector_type(4)));
typedef unsigned v2u __attribute__((ext_vector_type(2)));
typedef float f32x4 __attribute__((ext_vector_type(4)));
typedef float f32x16 __attribute__((ext_vector_type(16)));
typedef short bf16x8 __attribute__((ext_vector_type(8)));
typedef short bf16x4 __attribute__((ext_vector_type(4)));
typedef GAS unsigned gu32;
#define RLX_AGENT __ATOMIC_RELAXED, __HIP_MEMORY_SCOPE_AGENT
#define LDS_WAIT() asm volatile("s_waitcnt lgkmcnt(0)" ::: "memory")
#define VM_WAIT() asm volatile("s_waitcnt vmcnt(0)" ::: "memory")
#define LDS_BARRIER() asm volatile("s_waitcnt lgkmcnt(0)\n\ts_barrier" ::: "memory")
typedef __bf16 bf16x2_t __attribute__((ext_vector_type(2)));
typedef float f32x2_t __attribute__((ext_vector_type(2)));
__device__ __forceinline__ unsigned pk2(float lo, float hi) { const f32x2_t v = {lo, hi}; const bf16x2_t b = __builtin_convertvector(v, bf16x2_t); return __builtin_bit_cast(unsigned, b); }
__device__ __forceinline__ unsigned f2bf(float f) { return pk2(f, 0.f) & 0xffffu; }
__device__ __forceinline__ unsigned pk4_fp8(float a, float b, float c, float d) { int x = 0; x = __builtin_amdgcn_cvt_pk_fp8_f32(a, b, x, false); x = __builtin_amdgcn_cvt_pk_fp8_f32(c, d, x, true); return (unsigned)x; }
__device__ __forceinline__ float bf2f(unsigned short b) { return __builtin_bit_cast(float, (unsigned)b << 16); }
__device__ __forceinline__ float bflo(unsigned w) { return __builtin_bit_cast(float, w << 16); }
__device__ __forceinline__ float bfhi(unsigned w) { return __builtin_bit_cast(float, w & 0xffff0000u); }
template <int CTRL> __device__ __forceinline__ float dpp_mov(float v) { return __builtin_bit_cast(float, __builtin_amdgcn_update_dpp(0, __builtin_bit_cast(int, v), CTRL, 0xF, 0xF, false)); }
__device__ __forceinline__ float wave_sum(float v) {
    v += dpp_mov<0xB1>(v); v += dpp_mov<0x4E>(v); v += dpp_mov<0x141>(v); v += dpp_mov<0x140>(v);
    const int iv = __builtin_bit_cast(int, v);
    const float r0 = __builtin_bit_cast(float, __builtin_amdgcn_readlane(iv, 0)), r1 = __builtin_bit_cast(float, __builtin_amdgcn_readlane(iv, 16)), r2 = __builtin_bit_cast(float, __builtin_amdgcn_readlane(iv, 32)), r3 = __builtin_bit_cast(float, __builtin_amdgcn_readlane(iv, 48));
    return (r0 + r1) + (r2 + r3);
}
__device__ __forceinline__ float sigmoidf_(float x) { return __builtin_amdgcn_rcpf(1.0f + __builtin_amdgcn_exp2f(-1.4426950408889634f * x)); }
__device__ __forceinline__ float siluf_(float x) { return x * sigmoidf_(x); }
__device__ __forceinline__ float softplusf_(float x) { return x > 20.f ? x : log1pf(__expf(x)); }

#define XB_TMO      128
#define XB_XCNT(j)  (256  + 64 * (j))
#define XB_XSUB(j)  (1280 + 64 * (j))
#define XB_XGEN(j)  (2304 + 64 * (j))
#define XB_TOP      3328
#define XB_TOPGEN   3392
#define XCD_BAR_WORDS 3456
#define XB_SPIN_CAP (1u << 18)

__device__ __forceinline__ unsigned xb_ld(unsigned* p)              { return __hip_atomic_load(p, __ATOMIC_RELAXED, __HIP_MEMORY_SCOPE_AGENT); }
__device__ __forceinline__ unsigned xb_add(unsigned* p, unsigned v) { return __hip_atomic_fetch_add(p, v, __ATOMIC_RELAXED, __HIP_MEMORY_SCOPE_AGENT); }
__device__ __forceinline__ unsigned xb_xcc_id() { return (unsigned)__builtin_amdgcn_s_getreg((3 << 11) | 20) & 0xFu; }
#define XB_SPIN(cond, bar) do { unsigned _sp = 0; while (cond) { __builtin_amdgcn_s_sleep(1); \
    if ((++_sp & 255u) == 0u) { if (xb_ld(&(bar)[XB_TMO])) break; if (_sp > XB_SPIN_CAP) { atomicAdd(&(bar)[XB_TMO], 1u); break; } } } } while (0)

struct XcdBarrier {
    unsigned* bar; unsigned x;
    volatile LAS unsigned* st;
};

__device__ __forceinline__ XcdBarrier xcd_barrier_post(unsigned* bar, volatile LAS unsigned* st) {
    XcdBarrier b; b.bar = bar; b.x = xb_xcc_id(); b.st = st;
    if (threadIdx.x == 0) (void)xb_add(&bar[XB_XCNT(b.x)], 1u);
    return b;
}
__device__ __forceinline__ void xcd_barrier_complete(unsigned* bar, unsigned x, unsigned& nloc, unsigned& nx) {
    const unsigned G = gridDim.x * gridDim.y * gridDim.z;
    unsigned sum, cnt, mine, sp = 0u;
    for (;;) {
        sum = 0u; cnt = 0u; mine = 0u;
#pragma unroll
        for (unsigned j = 0; j < 16; ++j) { const unsigned c = xb_ld(&bar[XB_XCNT(j)]); sum += c; cnt += (c > 0u) ? 1u : 0u; mine = (j == x) ? c : mine; }
        if (sum == G) break;
        __builtin_amdgcn_s_sleep(1);
        if ((++sp & 255u) == 0u) { if (xb_ld(&bar[XB_TMO])) break; if (sp > XB_SPIN_CAP) { atomicAdd(&bar[XB_TMO], 1u); break; } }
    }
    nloc = mine > 0u ? mine : 1u; nx = cnt > 0u ? cnt : 1u;
}

__device__ __forceinline__ void xcd_barrier(const XcdBarrier& b) {
    asm volatile("s_waitcnt vmcnt(0)" ::: "memory");
    __syncthreads();
    if (threadIdx.x == 0) {
        unsigned* bar = b.bar;
        __builtin_amdgcn_s_waitcnt(0);
        unsigned nloc = b.st[0], nx = b.st[1];
        if (nloc == 0u) { xcd_barrier_complete(bar, b.x, nloc, nx); b.st[0] = nloc; b.st[1] = nx; }
        const unsigned old = xb_add(&bar[XB_XSUB(b.x)], 1u);
        const unsigned gen = old / nloc;
        if (old + 1u == (gen + 1u) * nloc) {
            __builtin_amdgcn_fence(__ATOMIC_RELEASE, "agent");
            asm volatile("s_waitcnt vmcnt(0)" ::: "memory");
            const unsigned og = xb_add(&bar[XB_TOP], 1u);
            const unsigned tg = og / nx;
            if (og + 1u == (tg + 1u) * nx) xb_add(&bar[XB_TOPGEN], 1u);
            else XB_SPIN(xb_ld(&bar[XB_TOPGEN]) == tg, bar);
            __builtin_amdgcn_fence(__ATOMIC_ACQUIRE, "agent");
            xb_add(&bar[XB_XGEN(b.x)], 1u);
            asm volatile("s_waitcnt vmcnt(0)" ::: "memory");
        } else {
            XB_SPIN(xb_ld(&bar[XB_XGEN(b.x)]) == gen, bar);
            __builtin_amdgcn_fence(__ATOMIC_ACQUIRE, "agent");
            asm volatile("s_waitcnt vmcnt(0)" ::: "memory");
        }
    }
    __syncthreads();
}

enum InIdx { I_X = 0, I_C, I_CTX, I_CCTX, I_WMOD, I_BMOD, I_NMG, I_NFG, I_WIN, I_WOUT, I_SINK, I_DNCW, I_DNALOG, I_DNDT, I_DNNG, I_LRCW, I_LRCB, I_LRWR, I_LRBR, I_LRWI, I_LRBI, I_LRLAM,
             I_WROUT, I_BROUT, I_WGU, I_BGU, I_WDN, I_BDN, I_FNG, N_IN };
struct Frame {
    LAS unsigned char* lds;
    volatile LAS unsigned* MISC;
    gu32* ctl;
    int tid, lane, wave, G, bid;
    const float* const __attribute__((address_space(4)))* in;
    float* out; unsigned char* ws;
};
__device__ __forceinline__ int mod_row(int m) { return m < NLAT ? (m >> 12) : 4; }
__device__ __forceinline__ bool phase_enter(Frame& F) { int t = threadIdx.x; asm volatile("" : "+v"(t)); F.tid = t; F.lane = t & 63; F.wave = __builtin_amdgcn_readfirstlane(t >> 6); return true; }
__device__ __forceinline__ void seq_of(int m, int& t, int& T, int& base) { if (m < NLAT) { t = m & 4095; T = SEQ; base = m - t; } else { t = (m - NLAT) & 255; T = CTXL; base = m - t; } }
__device__ __forceinline__ float gelu_tanh(float x) { const float u = 0.7978845608028654f * (x + 0.044715f * x * x * x); return x * sigmoidf_(2.0f * u); }

__device__ __forceinline__ void transpose_item(const float* W, int K, int N, bf16* WT, int k0, int dstrow0, int srccol0, int nvalid, LAS float* scr, int lane) {
    { const int c4 = (lane & 7) * 4, kr = lane >> 3; f32x4 v[8];
#pragma unroll
      for (int i = 0; i < 8; ++i) { v[i] = (f32x4){0.f, 0.f, 0.f, 0.f}; if (c4 < nvalid) v[i] = __builtin_nontemporal_load((const f32x4*)(W + (size_t)(k0 + 8 * i + kr) * N + srccol0 + c4)); }
#pragma unroll
      for (int i = 0; i < 8; ++i) { LAS float* d = scr + (8 * i + kr) * 33 + c4; d[0] = v[i].x; d[1] = v[i].y; d[2] = v[i].z; d[3] = v[i].w; } }
    LDS_WAIT(); asm volatile("" ::: "memory");
    const int c = lane & 7;
#pragma unroll
    for (int jj = 0; jj < 4; ++jj) { const int n = (lane >> 3) + 8 * jj; const LAS float* s = scr + (8 * c) * 33 + n;
        v4u o; o.x = pk2(s[0 * 33], s[1 * 33]); o.y = pk2(s[2 * 33], s[3 * 33]); o.z = pk2(s[4 * 33], s[5 * 33]); o.w = pk2(s[6 * 33], s[7 * 33]);
        *(GAS v4u*)(WT + (size_t)(dstrow0 + n) * K + k0 + 8 * c) = o; }
    LDS_WAIT(); asm volatile("" ::: "memory");
}
__device__ __forceinline__ void transpose_item_f8(const float* W, int K, int N, unsigned char* WT, int k0, int dstrow0, int srccol0, float scale, LAS float* scr, int lane) {
    { const int c4 = (lane & 7) * 4, kr = lane >> 3; f32x4 v[8];
#pragma unroll
      for (int i = 0; i < 8; ++i) v[i] = __builtin_nontemporal_load((const f32x4*)(W + (size_t)(k0 + 8 * i + kr) * N + srccol0 + c4));
#pragma unroll
      for (int i = 0; i < 8; ++i) { LAS float* d = scr + (8 * i + kr) * 33 + c4; d[0] = v[i].x; d[1] = v[i].y; d[2] = v[i].z; d[3] = v[i].w; } }
    LDS_WAIT(); asm volatile("" ::: "memory");
    { const int n = lane >> 1, hf = lane & 1; const LAS float* s = scr + (32 * hf) * 33 + n; unsigned w[8];
#pragma unroll
      for (int i = 0; i < 8; ++i) { int x = 0; x = __builtin_amdgcn_cvt_pk_fp8_f32(s[(4 * i + 0) * 33] * scale, s[(4 * i + 1) * 33] * scale, x, false); x = __builtin_amdgcn_cvt_pk_fp8_f32(s[(4 * i + 2) * 33] * scale, s[(4 * i + 3) * 33] * scale, x, true); w[i] = (unsigned)x; }
      v4u* o = (v4u*)(WT + (size_t)(dstrow0 + n) * K + k0 + 32 * hf); __builtin_nontemporal_store((v4u){w[0], w[1], w[2], w[3]}, o); __builtin_nontemporal_store((v4u){w[4], w[5], w[6], w[7]}, o + 1); }
    LDS_WAIT(); asm volatile("" ::: "memory");
}
__device__ __forceinline__ void p0_prologue(Frame& F) {
    {
        LAS float* sc = (LAS float*)(F.lds);
        LAS float* red = (LAS float*)(F.lds + 40960);
        bool have_sc = false;
        for (int wb = F.bid; wb < 192; wb += F.G) {
            if (!have_sc) {
                for (int i = F.tid; i < 5 * 2048; i += NTHREADS) { const int r = i >> 11, k = i & 2047; const float cv = r < 4 ? F.in[I_C][r * 2048 + k] : F.in[I_CCTX][k]; sc[i] = siluf_(cv); }
                have_sc = true; __syncthreads();
            }
            const int l = wb / 96, cb = wb % 96, kp = F.tid >> 5, cg = F.tid & 31, j0 = cb * 128 + cg * 4;
            const float* wp = F.in[I_WMOD] + ((size_t)l * 2048 + kp * 128) * 12288 + j0;
            f32x4 acc[5];
#pragma unroll
            for (int r = 0; r < 5; ++r) acc[r] = (f32x4){0.f, 0.f, 0.f, 0.f};
#pragma unroll 4
            for (int k = 0; k < 128; ++k) { const f32x4 w = *(const f32x4*)(wp + (size_t)k * 12288);
#pragma unroll
                for (int r = 0; r < 5; ++r) acc[r] += sc[r * 2048 + kp * 128 + k] * w; }
#pragma unroll
            for (int r = 0; r < 5; ++r) *(LAS f32x4*)(red + (kp * 5 + r) * 128 + cg * 4) = acc[r];
            __syncthreads();
            for (int i = F.tid; i < 640; i += NTHREADS) { const int r = i >> 7, col = i & 127; float s = F.in[I_BMOD][l * 12288 + cb * 128 + col];
#pragma unroll
                for (int q = 0; q < 16; ++q) s += red[(q * 5 + r) * 128 + col];
                ((float*)(F.ws + WS_MOD))[(size_t)(l * 5 + r) * 12288 + cb * 128 + col] = s; }
            __syncthreads();
        }
        __syncthreads();
    }
    { int* idt = (int*)(F.ws + WS_IDT); for (int r = F.bid * NTHREADS + F.tid; r < MOE_ROWS; r += F.G * NTHREADS) idt[r] = r; }
    {
        LAS float* scr = (LAS float*)(F.lds + F.wave * 16384);
        const int gw = F.bid * NWAVES + F.wave, NGW = F.G * NWAVES;
        constexpr int I_IN = 32 * 144, I_OUT = 32 * 64, I_RT = 32, I_16 = 32, PER_L = I_IN + I_OUT + I_RT + I_16;
        for (int it0 = gw; it0 < 2 * PER_L; it0 += NGW) {
            const int l = it0 / PER_L; int r = it0 % PER_L;
            if (r < I_IN) { const int nb = r % 144, kb = r / 144, d0 = nb * 32; int s0 = d0, nv = 32;
                if (d0 >= 3584) s0 = d0 + 16;
#if FP8_INPROJ
                transpose_item_f8(F.in[I_WIN] + (size_t)l * 2048 * IN_W, 2048, IN_W, F.ws + WS_WIN + (size_t)l * PW * 2048 * 2, kb * 64, d0, s0, 64.0f, scr, F.lane); continue; }
#else
                transpose_item(F.in[I_WIN] + (size_t)l * 2048 * IN_W, 2048, IN_W, (bf16*)(F.ws + WS_WIN) + (size_t)l * PW * 2048, kb * 64, d0, s0, nv, scr, F.lane); continue; }
#endif
            r -= I_IN;
            if (r < I_OUT) { const int nb = r % 64, kb = r / 64;
#if FP8_OUTPROJ
                transpose_item_f8(F.in[I_WOUT] + (size_t)l * 2048 * 2048, 2048, 2048, F.ws + WS_WOUT + (size_t)l * 2048 * 2048 * 2, kb * 64, nb * 32, nb * 32, 64.0f, scr, F.lane); continue; }
#else
                transpose_item(F.in[I_WOUT] + (size_t)l * 2048 * 2048, 2048, 2048, (bf16*)(F.ws + WS_WOUT) + (size_t)l * 2048 * 2048, kb * 64, nb * 32, nb * 32, 32, scr, F.lane); continue; }
#endif
            r -= I_OUT;
            if (r < I_RT) { transpose_item(F.in[I_WROUT] + (size_t)l * 2048 * 32, 2048, 32, (bf16*)(F.ws + WS_WRT) + (size_t)l * 32 * 2048, r * 64, 0, 0, 32, scr, F.lane); continue; }
            r -= I_RT;
            transpose_item(F.in[I_WIN] + (size_t)l * 2048 * IN_W, 2048, IN_W, (bf16*)(F.ws + WS_WRT + 512 * 1024) + (size_t)l * 32 * 2048, r * 64, 0, 3584, 16, scr, F.lane);
        }
    }
}
constexpr int CW_CVQ = 12288 + 512;
#ifndef FP8_GEMM2
#define FP8_GEMM2 1
#endif
constexpr float WGU_SCALE = 64.0f, WDN_SCALE = 64.0f; constexpr int WGU_E8M0 = 0x7C7C7C7C, WDN_E8M0 = 0x7C7C7C7C;
__device__ __forceinline__ void convert_moe_item(Frame& F, int l, int r, LAS float* scr) {
    constexpr int I_GU = 32 * 32 * 64;
    if (r < I_GU) { const int e = r / 2048, q = r % 2048, nb = q % 64, kb = q / 64; const int s0 = ((nb >> 2) & 1) * 1024 + (nb >> 3) * 128 + (nb & 3) * 32;
        transpose_item_f8(F.in[I_WGU] + (size_t)(l * 32 + e) * 2048 * 2048, 2048, 2048, F.ws + WS_WGU + (size_t)(l * 32 + e) * 2048 * 2048, kb * 64, nb * 32, s0, WGU_SCALE, scr, F.lane); return; }
    r -= I_GU;
    { const int e = r / 1024, q = r % 1024, nb = q % 64, kb = q / 64;
#if FP8_GEMM2
        transpose_item_f8(F.in[I_WDN] + (size_t)(l * 32 + e) * 1024 * 2048, 1024, 2048, F.ws + WS_WDN + (size_t)(l * 32 + e) * 2048 * 1024, kb * 64, nb * 32, nb * 32, WDN_SCALE, scr, F.lane);
#else
        transpose_item(F.in[I_WDN] + (size_t)(l * 32 + e) * 1024 * 2048, 1024, 2048, (bf16*)(F.ws + WS_WDN) + (size_t)(l * 32 + e) * 2048 * 1024, kb * 64, nb * 32, nb * 32, 32, scr, F.lane);
#endif
    }
}
constexpr int CVG = 8;
__device__ __forceinline__ bool convert_grab(Frame& F, int l, int rep, LAS float* scr) {
    constexpr int NIT = 32 * 32 * 64 + 32 * 16 * 64;
    int g = 0; if (F.lane == 0) g = (int)__hip_atomic_fetch_add(F.ctl + CW_CVQ + 64 * l + 8 * rep, 1u, RLX_AGENT); g = __builtin_amdgcn_readfirstlane(g);
    if (g * CVG >= NIT) return false;
#pragma unroll 1
    for (int k = 0; k < CVG; ++k) convert_moe_item(F, l, g * CVG + k, scr);
    return true;
}
__device__ __forceinline__ void convert_moe_queue(Frame& F, int l, int rep = 0) {
    LAS float* scr = (LAS float*)(F.lds + F.wave * 16384);
    __syncthreads();
    while (convert_grab(F, l, rep, scr)) {}
    __syncthreads();
}
constexpr int CW_TAIL = 16384;
__device__ __forceinline__ void tail_fill(Frame& F, int seam, int lt) {
    LAS int* flag = (LAS int*)(F.lds + LDS_X_OFF + 768);
    LAS float* scr = (LAS float*)(F.lds + F.wave * 16384);
    __syncthreads();
    if (F.tid == 0) (void)__hip_atomic_fetch_add(F.ctl + CW_TAIL + 64 * seam, 1u, RLX_AGENT);
    bool more = true;
    for (int it = 0; it < 4096; ++it) {
        if (F.tid == 0) *flag = (__hip_atomic_load(F.ctl + CW_TAIL + 64 * seam, RLX_AGENT) >= (unsigned)F.G) ? 1 : 0;
        __syncthreads();
        const int done = *flag;
        __syncthreads();
        if (done) break;
        if (more) more = convert_grab(F, lt, 0, scr); else __builtin_amdgcn_s_sleep(32);
    }
}

__device__ __forceinline__ void load_row(const float* src, int lane, f32x4 (&v)[8]) {
    const f32x4* p = (const f32x4*)src + lane;
#pragma unroll
    for (int j = 0; j < 8; ++j) v[j] = p[64 * j];
}
__device__ __forceinline__ void store_row(float* dst, int lane, const f32x4 (&v)[8]) {
    f32x4* p = (f32x4*)dst + lane;
#pragma unroll
    for (int j = 0; j < 8; ++j) p[64 * j] = v[j];
}
#if X_BF16
typedef bf16 xelem_t;
__device__ __forceinline__ void load_xrow(const bf16* src, int lane, f32x4 (&v)[8]) {
    const v2u* p = (const v2u*)src + lane;
#pragma unroll
    for (int j = 0; j < 8; ++j) { const v2u w = p[64 * j]; v[j] = (f32x4){bflo(w.x), bfhi(w.x), bflo(w.y), bfhi(w.y)}; }
}
__device__ __forceinline__ void store_xrow(bf16* dst, int lane, const f32x4 (&v)[8]) {
    v2u* p = (v2u*)dst + lane;
#pragma unroll
    for (int j = 0; j < 8; ++j) { v2u w; w.x = pk2(v[j].x, v[j].y); w.y = pk2(v[j].z, v[j].w); p[64 * j] = w; }
}
#else
typedef float xelem_t;
__device__ __forceinline__ void load_xrow(const float* src, int lane, f32x4 (&v)[8]) { load_row(src, lane, v); }
__device__ __forceinline__ void store_xrow(float* dst, int lane, const f32x4 (&v)[8]) { store_row(dst, lane, v); }
#endif
__device__ __forceinline__ void combine_row(Frame& F, int l, int m, int lane, f32x4 (&v)[8]) {
    const int* dest = (const int*)(F.ws + WS_MOEI + 2 * 512 * 1024) + m * 4;
    const float* g5 = (const float*)(F.ws + WS_MOD) + (size_t)(l * 5 + mod_row(m)) * 12288 + 5 * 2048;
    f32x4 acc[8];
#pragma unroll
    for (int j = 0; j < 8; ++j) acc[j] = (f32x4){0.f, 0.f, 0.f, 0.f};
#pragma unroll
    for (int k = 0; k < 4; ++k) { const int d = dest[k]; const v2u* yp = (const v2u*)((const bf16*)(F.ws + WS_YS) + (size_t)d * 2048) + lane;
#pragma unroll
        for (int j = 0; j < 8; ++j) { const v2u w = yp[64 * j]; acc[j] += (f32x4){bflo(w.x), bfhi(w.x), bflo(w.y), bfhi(w.y)}; } }
#pragma unroll
    for (int j = 0; j < 8; ++j) { const f32x4 gg = *((const f32x4*)g5 + lane + 64 * j); v[j] += gg * acc[j]; }
}
__device__ __forceinline__ void modnorm_store(const f32x4 (&v)[8], const float* g, const float* shift, const float* scale, bf16* hrow, int lane) {
    float ss = 0.f;
#pragma unroll
    for (int j = 0; j < 8; ++j) ss += (v[j].x * v[j].x + v[j].y * v[j].y) + (v[j].z * v[j].z + v[j].w * v[j].w);
    const float rstd = 1.0f / sqrtf(wave_sum(ss) * (1.0f / 2048.0f) + EPS);
    v2u* hp = (v2u*)hrow + lane;
#pragma unroll
    for (int j = 0; j < 8; ++j) { const f32x4 gg = *((const f32x4*)g + lane + 64 * j), sh = *((const f32x4*)shift + lane + 64 * j), sc = *((const f32x4*)scale + lane + 64 * j);
        const f32x4 y = (v[j] * rstd) * gg * (sc + 1.0f) + sh; v2u w; w.x = pk2(y.x, y.y); w.y = pk2(y.z, y.w); hp[64 * j] = w; }
}
constexpr size_t WS_W16 = WS_WRT + 512 * 1024;
__device__ __forceinline__ void phase_norm1(Frame& F, int l) {
    constexpr int TROW = 4112;
    LAS unsigned char* tile = F.lds; LAS float* part = (LAS float*)(F.lds + 66048);
    xelem_t* X = (xelem_t*)(F.ws + WS_X); bf16* H = (bf16*)(F.ws + WS_H); bf16* P = (bf16*)(F.ws + WS_P);
    const float* modp = (const float*)(F.ws + WS_MOD) + (size_t)l * 5 * 12288;
    const bf16* w16 = (const bf16*)(F.ws + WS_W16) + (size_t)l * 32 * 2048;
    for (int r0 = F.bid * 16; r0 < NTOK; r0 += F.G * 16) {
#pragma unroll 1
        for (int rr = 0; rr < 2; ++rr) { const int lr = 2 * F.wave + rr, m = r0 + lr;
            f32x4 v[8];
            if (l == 0) load_row(m < NLAT ? F.in[I_X] + (size_t)m * DM : F.in[I_CTX] + (size_t)(m - NLAT) * DM, F.lane, v);
            else { load_xrow(X + (size_t)m * DM, F.lane, v); if (MK_STAGE >= 9) { combine_row(F, l - 1, m, F.lane, v); store_xrow(X + (size_t)m * DM, F.lane, v); } }
            float ss = 0.f;
#pragma unroll
            for (int j = 0; j < 8; ++j) ss += (v[j].x * v[j].x + v[j].y * v[j].y) + (v[j].z * v[j].z + v[j].w * v[j].w);
            const float rstd = 1.0f / sqrtf(wave_sum(ss) * (1.0f / 2048.0f) + EPS);
            const float* mr = modp + (size_t)mod_row(m) * 12288; const float* g = F.in[I_NMG] + l * DM;
#if FP8_INPROJ
            unsigned* hp = (unsigned*)(F.ws + WS_XS + (size_t)m * DM) + F.lane; LAS v2u* tp = (LAS v2u*)(tile + lr * TROW) + F.lane;
#else
            v2u* hp = (v2u*)(H + (size_t)m * DM) + F.lane; LAS v2u* tp = (LAS v2u*)(tile + lr * TROW) + F.lane;
#endif
#pragma unroll
            for (int j = 0; j < 8; ++j) { const f32x4 gg = *((const f32x4*)g + F.lane + 64 * j), sh = *((const f32x4*)mr + F.lane + 64 * j), sc = *((const f32x4*)(mr + 2048) + F.lane + 64 * j);
                const f32x4 y = (v[j] * rstd) * gg * (sc + 1.0f) + sh; v2u w; w.x = pk2(y.x, y.y); w.y = pk2(y.z, y.w); tp[64 * j] = w;
#if FP8_INPROJ
                int x8 = 0; x8 = __builtin_amdgcn_cvt_pk_fp8_f32(y.x, y.y, x8, false); x8 = __builtin_amdgcn_cvt_pk_fp8_f32(y.z, y.w, x8, true); hp[64 * j] = (unsigned)x8; }
#else
                hp[64 * j] = w; }
#endif
        }
        __syncthreads();
        { const int row = F.lane & 15, q = F.lane >> 4; f32x4 acc = {0.f, 0.f, 0.f, 0.f};
#pragma unroll
          for (int ks = 0; ks < 8; ++ks) { const int k0 = 256 * F.wave + 32 * ks + 8 * q;
              const bf16x8 a = *(const LAS bf16x8*)(tile + row * TROW + k0 * 2); const bf16x8 b = *(const bf16x8*)(w16 + (size_t)row * 2048 + k0);
              acc = __builtin_amdgcn_mfma_f32_16x16x32_bf16(a, b, acc, 0, 0, 0); }
#pragma unroll
          for (int i = 0; i < 4; ++i) part[(F.wave * 16 + 4 * q + i) * 16 + row] = acc[i]; }
        __syncthreads();
        if (F.tid < 256) { const int rw = F.tid >> 4, c = F.tid & 15; float sacc = 0.f;
#pragma unroll
            for (int w = 0; w < 8; ++w) sacc += part[(w * 16 + rw) * 16 + c];
            P[(size_t)(r0 + rw) * PW + PC_BETA + c] = (bf16)f2bf(sacc); }
        __syncthreads();
    }
}
__device__ __forceinline__ void phase_final(Frame& F, bool with_combine) {
    const int gw = F.bid * NWAVES + F.wave, NGW = F.G * NWAVES;
    const xelem_t* X = (const xelem_t*)(F.ws + WS_X);
    for (int m = gw; m < NLAT; m += NGW) {
        f32x4 v[8];
        if (with_combine) { load_xrow(X + (size_t)m * DM, F.lane, v); combine_row(F, 1, m, F.lane, v); }
        else load_row(F.in[I_X] + (size_t)m * DM, F.lane, v);
        float ss = 0.f;
#pragma unroll
        for (int j = 0; j < 8; ++j) ss += (v[j].x * v[j].x + v[j].y * v[j].y) + (v[j].z * v[j].z + v[j].w * v[j].w);
        const float rstd = 1.0f / sqrtf(wave_sum(ss) * (1.0f / 2048.0f) + EPS);
        f32x4* op = (f32x4*)(F.out + (size_t)m * DM) + F.lane;
#pragma unroll
        for (int j = 0; j < 8; ++j) { const f32x4 gg = *((const f32x4*)F.in[I_FNG] + F.lane + 64 * j); op[64 * j] = v[j] * rstd * gg; }
    }
}

__device__ __forceinline__ void phase_inproj(Frame& F, int l) {
#if FP8_INPROJ
    pg8::Gemm g{(const bf16*)(F.ws + WS_XS), (const bf16*)(F.ws + WS_WIN + (size_t)l * PW * 2048 * 2), NTOK, 4608, 1024, 0x7C7C7C7C};
    pg8::StaticOrderG S; S.init(g, F.G, F.bid); S.row_tab = (const int*)(F.ws + WS_IDT);
    pg8::EpiBf16Plain E{(bf16*)(F.ws + WS_P), PW};
    pg8::gemm_phase<pg8::EpiBf16Plain, pg8::StaticOrderG, true, true, true>(F.lds + RING_OFF, g, S, E);
#else
    pg8::Gemm g{(const bf16*)(F.ws + WS_H), (const bf16*)(F.ws + WS_WIN) + (size_t)l * PW * 2048, NTOK, 4608, 2048};
    pg8::StaticOrder S; S.init(g, F.G, F.bid);
    pg8::EpiBf16Plain E{(bf16*)(F.ws + WS_P), PW};
    pg8::gemm_phase<pg8::EpiBf16Plain, pg8::StaticOrder, true, true>(F.lds + RING_OFF, g, S, E);
#endif
}
__device__ __forceinline__ void phase_outproj(Frame& F, int l) {
    float* X = (float*)(F.ws + WS_X);
#if FP8_OUTPROJ
    pg8::Gemm g{(const bf16*)(F.ws + WS_CC), (const bf16*)(F.ws + WS_WOUT + (size_t)l * 2048 * 2048 * 2), l == 0 ? NTOK : NLAT, 2048, 1024, 0x7C7C7C7C};
    pg8::StaticOrderG S; S.init(g, F.G, F.bid); S.row_tab = (const int*)(F.ws + WS_IDT);
#else
    pg8::Gemm g{(const bf16*)(F.ws + WS_CC), (const bf16*)(F.ws + WS_WOUT) + (size_t)l * 2048 * 2048, l == 0 ? NTOK : NLAT, 2048, 2048};
    pg8::StaticOrder S; S.init(g, F.G, F.bid);
#endif
#if X_BF16
    pg8::EpiResGateB E{F.in[I_X], F.in[I_CTX], (const bf16*)(F.ws + WS_X), (bf16*)(F.ws + WS_X), (const float*)(F.ws + WS_MOD) + (size_t)l * 5 * 12288 + 2 * 2048, l == 0 ? 1 : 0};
#define EPI_RES pg8::EpiResGateB
#else
    pg8::EpiResGate E{l == 0 ? F.in[I_X] : X, l == 0 ? F.in[I_CTX] : X + (size_t)NLAT * DM, X, (const float*)(F.ws + WS_MOD) + (size_t)l * 5 * 12288 + 2 * 2048};
#define EPI_RES pg8::EpiResGate
#endif
#if FP8_OUTPROJ
    pg8::gemm_phase<EPI_RES, pg8::StaticOrderG, true, true, true>(F.lds + RING_OFF, g, S, E);
#else
    pg8::gemm_phase<EPI_RES, pg8::StaticOrder, true, true>(F.lds + RING_OFF, g, S, E);
#endif
}
#ifndef PHASE_INPROJ
#define PHASE_INPROJ(F, l) phase_inproj(F, l)
#endif
#ifndef PHASE_OUTPROJ
#define PHASE_OUTPROJ(F, l) phase_outproj(F, l)
#endif

constexpr size_t WS_H8 = WS_XS;
constexpr size_t MOEI_TOPE = WS_MOEI, MOEI_TOPG = WS_MOEI + 512 * 1024, MOEI_DEST = WS_MOEI + 2 * 512 * 1024, MOEI_ROWG = WS_MOEI + 3 * 512 * 1024, MOEI_ROWT = WS_MOEI + 4 * 512 * 1024, MOEI_IDT = WS_IDT;
__device__ __forceinline__ void phase_norm2(Frame& F, int l) {
    const int nrows = (l == 0) ? NTOK : NLAT;
    constexpr int TROW = 4112;
    LAS unsigned char* tile = F.lds;
    LAS float* part = (LAS float*)(F.lds + 66048);
    LAS float* lg = (LAS float*)(F.lds + 66048 + 16384);
    const xelem_t* X = (const xelem_t*)(F.ws + WS_X); bf16* H = (bf16*)(F.ws + WS_H);
    const float* modp = (const float*)(F.ws + WS_MOD) + (size_t)l * 5 * 12288;
    const bf16* wrt = (const bf16*)(F.ws + WS_WRT) + (size_t)l * 32 * 2048;
    int* tope = (int*)(F.ws + MOEI_TOPE); float* topg = (float*)(F.ws + MOEI_TOPG);
    for (int r0 = F.bid * 16; r0 < nrows; r0 += F.G * 16) {
#pragma unroll 1
        for (int rr = 0; rr < 2; ++rr) {
            const int lr = 2 * F.wave + rr, m = r0 + lr;
            f32x4 v[8]; load_xrow(X + (size_t)m * DM, F.lane, v);
            float ss = 0.f;
#pragma unroll
            for (int j = 0; j < 8; ++j) ss += (v[j].x * v[j].x + v[j].y * v[j].y) + (v[j].z * v[j].z + v[j].w * v[j].w);
            const float rstd = 1.0f / sqrtf(wave_sum(ss) * (1.0f / 2048.0f) + EPS);
            const float* mr = modp + (size_t)mod_row(m) * 12288; const float* g = F.in[I_NFG] + l * DM;
            unsigned* hp = (unsigned*)(F.ws + WS_H8 + (size_t)m * DM) + F.lane; LAS v2u* tp = (LAS v2u*)(tile + lr * TROW) + F.lane;
#pragma unroll
            for (int j = 0; j < 8; ++j) { const f32x4 gg = *((const f32x4*)g + F.lane + 64 * j), sh = *((const f32x4*)(mr + 3 * 2048) + F.lane + 64 * j), sc = *((const f32x4*)(mr + 4 * 2048) + F.lane + 64 * j);
                const f32x4 y = (v[j] * rstd) * gg * (sc + 1.0f) + sh; v2u w; w.x = pk2(y.x, y.y); w.y = pk2(y.z, y.w); tp[64 * j] = w;
                int x8 = 0; x8 = __builtin_amdgcn_cvt_pk_fp8_f32(y.x, y.y, x8, false); x8 = __builtin_amdgcn_cvt_pk_fp8_f32(y.z, y.w, x8, true); hp[64 * j] = (unsigned)x8; }
        }
        __syncthreads();
        {
            const int row = F.lane & 15, q = F.lane >> 4;
            f32x4 acc0 = {0.f, 0.f, 0.f, 0.f}, acc1 = {0.f, 0.f, 0.f, 0.f};
#pragma unroll
            for (int ks = 0; ks < 8; ++ks) { const int k0 = 256 * F.wave + 32 * ks + 8 * q;
                const bf16x8 a = *(const LAS bf16x8*)(tile + row * TROW + k0 * 2);
                const bf16x8 b0 = *(const bf16x8*)(wrt + (size_t)row * 2048 + k0), b1 = *(const bf16x8*)(wrt + (size_t)(16 + row) * 2048 + k0);
                acc0 = __builtin_amdgcn_mfma_f32_16x16x32_bf16(a, b0, acc0, 0, 0, 0); acc1 = __builtin_amdgcn_mfma_f32_16x16x32_bf16(a, b1, acc1, 0, 0, 0); }
#pragma unroll
            for (int i = 0; i < 4; ++i) { part[(F.wave * 16 + 4 * q + i) * 32 + row] = acc0[i]; part[(F.wave * 16 + 4 * q + i) * 32 + 16 + row] = acc1[i]; }
        }
        __syncthreads();
        { const int rw = F.tid >> 5, e = F.tid & 31; float s = F.in[I_BROUT][l * 32 + e];
#pragma unroll
          for (int w = 0; w < 8; ++w) s += part[(w * 16 + rw) * 32 + e];
          lg[rw * 32 + e] = s; }
        __syncthreads();
        if (F.tid < 16) { const int m = r0 + F.tid; float val[4]; int idx[4]; unsigned taken = 0u;
#pragma unroll
            for (int k = 0; k < 4; ++k) { float best = -3.0e38f; int bi = 0;
                for (int e = 0; e < 32; ++e) { const float x = lg[F.tid * 32 + e]; if (!((taken >> e) & 1u) && x > best) { best = x; bi = e; } }
                val[k] = best; idx[k] = bi; taken |= 1u << bi; }
            float p[4], sum = 0.f;
#pragma unroll
            for (int k = 0; k < 4; ++k) { p[k] = __expf(val[k] - val[0]); sum += p[k]; }
#pragma unroll
            for (int k = 0; k < 4; ++k) { const unsigned rank = __hip_atomic_fetch_add(F.ctl + CW_CNT + 64 * l + idx[k], 1u, RLX_AGENT);
                tope[m * 4 + k] = idx[k] | (int)(rank << 8); topg[m * 4 + k] = p[k] / sum; }
        }
        __syncthreads();
    }
}
__device__ __forceinline__ void moe_tables(Frame& F, int l) {
    LAS int* blk_end = (LAS int*)(F.lds + LDS_X_OFF); LAS int* pstart = blk_end + 32; LAS int* cnts = blk_end + 64;
    if (F.tid == 0) { int nb = 0;
        for (int e = 0; e < 32; ++e) { const int c = (int)__hip_atomic_load(F.ctl + CW_CNT + 64 * l + e, RLX_AGENT); cnts[e] = c; pstart[e] = nb * 256; nb += (c + 255) >> 8; blk_end[e] = nb; } }
    __syncthreads();
}
__device__ __forceinline__ void phase_scatter(Frame& F, int l) {
    const int nrows = (l == 0) ? NTOK : NLAT;
    moe_tables(F, l);
    const LAS int* blk_end = (const LAS int*)(F.lds + LDS_X_OFF); const LAS int* pstart = blk_end + 32; const LAS int* cnts = blk_end + 64;
    const int* tope = (const int*)(F.ws + MOEI_TOPE); const float* topg = (const float*)(F.ws + MOEI_TOPG);
    int* dest = (int*)(F.ws + MOEI_DEST); float* rowg = (float*)(F.ws + MOEI_ROWG); int* rowt = (int*)(F.ws + MOEI_ROWT);
    for (int a = F.bid * NTHREADS + F.tid; a < nrows * 4; a += F.G * NTHREADS) {
        const int te = tope[a], e = te & 255, rank = (int)((unsigned)te >> 8), d = pstart[e] + rank;
        dest[a] = d; rowg[d] = topg[a]; rowt[d] = a >> 2; }
    if (F.bid < 32) { const int e = F.bid, r0 = pstart[e] + cnts[e], r1 = blk_end[e] * 256;
        for (int r = r0 + F.tid; r < r1; r += NTHREADS) { rowt[r] = 0; rowg[r] = 0.f; } }
}
__device__ __forceinline__ void phase_gemm1(Frame& F, int l) {
    moe_tables(F, l);
    const LAS int* blk_end = (const LAS int*)(F.lds + LDS_X_OFF);
    pg8::Gemm g{(const bf16*)(F.ws + WS_H8), (const bf16*)(F.ws + WS_WGU + (size_t)l * 32 * 2048 * 2048), MOE_ROWS, 2048, 1024, WGU_E8M0};
    pg8::MoeOrderG S{F.bid, __builtin_amdgcn_readfirstlane(blk_end[31]), (const char*)g.A, (const char*)g.Bt, (size_t)256 * 2048, (size_t)2048 * 2048, (size_t)256 * 2048, blk_end, (const int*)(F.ws + MOEI_ROWT)};
#if FP8_GEMM2
    pg8::EpiSwiglu8 E{F.ws + WS_ACT, F.in[I_BGU] + (size_t)l * 32 * 2048};
    pg8::gemm_phase<pg8::EpiSwiglu8, pg8::MoeOrderG, true, true, true>(F.lds + RING_OFF, g, S, E);
#else
    pg8::EpiSwiglu E{(bf16*)(F.ws + WS_ACT), F.in[I_BGU] + (size_t)l * 32 * 2048};
    pg8::gemm_phase<pg8::EpiSwiglu, pg8::MoeOrderG, true, true, true>(F.lds + RING_OFF, g, S, E);
#endif
}
__device__ __forceinline__ void phase_gemm2(Frame& F, int l) {
    moe_tables(F, l);
    const LAS int* blk_end = (const LAS int*)(F.lds + LDS_X_OFF);
#if FP8_GEMM2
    pg8::Gemm g{(const bf16*)(F.ws + WS_ACT), (const bf16*)(F.ws + WS_WDN + (size_t)l * 32 * 2048 * 1024), MOE_ROWS, 2048, 512, WDN_E8M0};
    pg8::MoeOrderG S{F.bid, __builtin_amdgcn_readfirstlane(blk_end[31]), (const char*)g.A, (const char*)g.Bt, (size_t)256 * 1024, (size_t)2048 * 1024, (size_t)256 * 1024, blk_end, (const int*)(F.ws + MOEI_IDT)};
    pg8::EpiDown E{(bf16*)(F.ws + WS_YS), F.in[I_BDN] + (size_t)l * 32 * 2048, (const float*)(F.ws + MOEI_ROWG)};
    pg8::gemm_phase<pg8::EpiDown, pg8::MoeOrderG, true, true, true>(F.lds + RING_OFF, g, S, E);
#else
    pg8::Gemm g{(const bf16*)(F.ws + WS_ACT), (const bf16*)(F.ws + WS_WDN) + (size_t)l * 32 * 2048 * 1024, MOE_ROWS, 2048, 1024};
    pg8::MoeOrder S{F.bid, __builtin_amdgcn_readfirstlane(blk_end[31]), (const char*)g.A, (const char*)g.Bt, (size_t)256 * 1024 * 2, (size_t)2048 * 1024 * 2, (size_t)256 * 1024 * 2, blk_end, nullptr};
    pg8::EpiDown E{(bf16*)(F.ws + WS_YS), F.in[I_BDN] + (size_t)l * 32 * 2048, (const float*)(F.ws + MOEI_ROWG)};
    pg8::gemm_phase<pg8::EpiDown, pg8::MoeOrder, true, true>(F.lds + RING_OFF, g, S, E);
#endif
}
#ifndef PHASE_NORM2
#define PHASE_NORM2(F, l) phase_norm2(F, l)
#endif
#ifndef PHASE_SCATTER
#define PHASE_SCATTER(F, l) phase_scatter(F, l)
#endif
#ifndef PHASE_GEMM1
#define PHASE_GEMM1(F, l) phase_gemm1(F, l)
#endif
#ifndef PHASE_GEMM2
#define PHASE_GEMM2(F, l) phase_gemm2(F, l)
#endif
#define USE_MFMA_ATTN 1

__device__ __forceinline__ void attn_prep(Frame& F, int l) {
    bf16* P = (bf16*)(F.ws + WS_P);
    LAS unsigned short* vt = (LAS unsigned short*)F.lds;
    for (int ct = F.bid; ct < NCT; ct += F.G) {
        const int m0 = ct * 64; const bool lat = m0 < NLAT;
        __syncthreads();
        for (int i = F.tid; i < 64 * 32; i += NTHREADS) { const int tk = i >> 5, c8 = i & 31;
            const v4u w = *(const v4u*)(P + (size_t)(m0 + tk) * PW + PC_V + c8 * 8);
            const unsigned ww[4] = {w.x, w.y, w.z, w.w};
#pragma unroll
            for (int q = 0; q < 4; ++q) { vt[(c8 * 8 + 2 * q) * 66 + tk] = (unsigned short)(ww[q] & 0xffffu); vt[(c8 * 8 + 2 * q + 1) * 66 + tk] = (unsigned short)(ww[q] >> 16); } }
        if (lat) { const int tk = F.tid >> 3, kvh = (F.tid >> 1) & 3, hf = F.tid & 1; const int t = (m0 + tk) & 4095;
            bf16* kp = P + (size_t)(m0 + tk) * PW + PC_K + kvh * 64 + hf * 32;
            const v4u w0 = *(const v4u*)kp, w1 = *(const v4u*)(kp + 8), w2 = *(const v4u*)(kp + 16), w3 = *(const v4u*)(kp + 24);
            const unsigned lo[8] = {w0.x, w0.y, w0.z, w0.w, w1.x, w1.y, w1.z, w1.w}, hi_[8] = {w2.x, w2.y, w2.z, w2.w, w3.x, w3.y, w3.z, w3.w};
            const float pos = (float)(hf ? (t & 63) : (t >> 6)); unsigned o1[8], o2[8];
#pragma unroll
            for (int jj = 0; jj < 8; ++jj) { float r1[2], r2[2];
#pragma unroll
                for (int e = 0; e < 2; ++e) { const int j = 2 * jj + e; const float inv = __builtin_amdgcn_exp2f(-(float)j * 0.8304820237218406f); const float sn = __sinf(pos * inv), cs = __cosf(pos * inv);
                    const float x1 = e ? bfhi(lo[jj]) : bflo(lo[jj]), x2 = e ? bfhi(hi_[jj]) : bflo(hi_[jj]); r1[e] = x1 * cs - x2 * sn; r2[e] = x2 * cs + x1 * sn; }
                o1[jj] = pk2(r1[0], r1[1]); o2[jj] = pk2(r2[0], r2[1]); }
            *(v4u*)kp = (v4u){o1[0], o1[1], o1[2], o1[3]}; *(v4u*)(kp + 8) = (v4u){o1[4], o1[5], o1[6], o1[7]}; *(v4u*)(kp + 16) = (v4u){o2[0], o2[1], o2[2], o2[3]}; *(v4u*)(kp + 24) = (v4u){o2[4], o2[5], o2[6], o2[7]}; }
        __syncthreads();
        for (int i = F.tid; i < 256 * 8; i += NTHREADS) { const int col = i >> 3, c = i & 7, kvh = col >> 6, d = col & 63;
            v4u o; const LAS unsigned short* s = vt + col * 66 + c * 8;
            o.x = s[0] | ((unsigned)s[1] << 16); o.y = s[2] | ((unsigned)s[3] << 16); o.z = s[4] | ((unsigned)s[5] << 16); o.w = s[6] | ((unsigned)s[7] << 16);
            if (lat) { const int b = m0 >> 12, t0 = m0 & 4095; *(v4u*)((bf16*)(F.ws + WS_VT) + ((size_t)(b * 4 + kvh) * 64 + d) * SEQ + t0 + c * 8) = o; }
            else { const int mm = m0 - NLAT, b = mm >> 8, t0 = mm & 255; *(v4u*)((bf16*)(F.ws + WS_VTC) + ((size_t)(b * 4 + kvh) * 64 + d) * CTXL + t0 + c * 8) = o; } }
    }
    __syncthreads();
}

constexpr int AT_KP = 144, AT_VP = 136;
constexpr int AT_KOFF = 0, AT_VOFF = 64 * AT_KP, AT_TILE = 64 * AT_KP + 64 * AT_VP;
__device__ __forceinline__ void attn_unit(Frame& F, int l, int b, int kvh, int qi, int is_ctx) {
    const bf16* P = (const bf16*)(F.ws + WS_P); bf16* CC = (bf16*)(F.ws + WS_CC);
    int lane_o = F.lane; asm volatile("" : "+v"(lane_o));
    const int g = F.wave >> 1, qh = F.wave & 1, hq = kvh * 4 + g, r32 = lane_o & 31, hi = lane_o >> 5;
    const int rowbase = is_ctx ? NLAT + b * CTXL : b * SEQ;
    const int qa = qi * 128 + qh * 64;
    const float LOG2E = 1.4426950408889634f;
    bf16x8 qf[2][4];
#pragma unroll
    for (int qt = 0; qt < 2; ++qt) { const int tq = qa + 32 * qt + r32; const bf16* qp = P + (size_t)(rowbase + tq) * PW + PC_Q + hq * 64 + 8 * hi;
        float x[4][8];
#pragma unroll
        for (int s = 0; s < 4; ++s) { const v4u w = *(const v4u*)(qp + 16 * s); x[s][0] = bflo(w.x); x[s][1] = bfhi(w.x); x[s][2] = bflo(w.y); x[s][3] = bfhi(w.y); x[s][4] = bflo(w.z); x[s][5] = bfhi(w.z); x[s][6] = bflo(w.w); x[s][7] = bfhi(w.w); }
        if (!is_ctx) {
#pragma unroll
            for (int hf = 0; hf < 2; ++hf) { const float pos = (float)(hf ? (tq & 63) : (tq >> 6));
#pragma unroll
                for (int j = 0; j < 8; ++j) { const float inv = __builtin_amdgcn_exp2f(-(float)(8 * hi + j) * 0.8304820237218406f); const float sn = __sinf(pos * inv), cs = __cosf(pos * inv);
                    const float x1 = x[2 * hf][j], x2 = x[2 * hf + 1][j]; x[2 * hf][j] = x1 * cs - x2 * sn; x[2 * hf + 1][j] = x2 * cs + x1 * sn; } } }
        const float sc = 0.125f * LOG2E;
#pragma unroll
        for (int s = 0; s < 4; ++s) { v4u w; w.x = pk2(x[s][0] * sc, x[s][1] * sc); w.y = pk2(x[s][2] * sc, x[s][3] * sc); w.z = pk2(x[s][4] * sc, x[s][5] * sc); w.w = pk2(x[s][6] * sc, x[s][7] * sc); qf[qt][s] = __builtin_bit_cast(bf16x8, w); }
    }
    float mrun[2], lrun[2]; f32x16 O[2][2];
    { const float sk = F.in[I_SINK][l * 16 + hq] * LOG2E;
#pragma unroll
      for (int qt = 0; qt < 2; ++qt) { mrun[qt] = sk; lrun[qt] = hi ? 0.f : 1.f;
#pragma unroll
        for (int db = 0; db < 2; ++db)
#pragma unroll
            for (int r = 0; r < 16; ++r) O[qt][db][r] = 0.f; } }
    const int kt_lo = is_ctx ? 0 : (qi == 0 ? 2 : 0), nl = is_ctx ? 0 : (6 - (qi == 0 ? 2 : 0) - (qi == 31 ? 2 : 0)), ntile = nl + 4;
    const int rr = F.tid >> 3, cch = F.tid & 7;
    const bf16* kbase_l = P + (size_t)(b * SEQ + rr) * PW + PC_K + kvh * 64 + cch * 8; const bf16* kbase_c = P + (size_t)(NLAT + b * CTXL + rr) * PW + PC_K + kvh * 64 + cch * 8;
    const bf16* vbase_l = (const bf16*)(F.ws + WS_VT) + ((size_t)(b * 4 + kvh) * 64 + rr) * SEQ + cch * 8; const bf16* vbase_c = (const bf16*)(F.ws + WS_VTC) + ((size_t)(b * 4 + kvh) * 64 + rr) * CTXL + cch * 8;
    v4u kw, vw;
    { const bool loc0 = nl > 0; const int k00 = loc0 ? 128 * (qi - 1) + 64 * kt_lo : 0; kw = *(const v4u*)((loc0 ? kbase_l : kbase_c) + (size_t)k00 * PW); vw = *(const v4u*)((loc0 ? vbase_l : vbase_c) + k00); }
    LDS_BARRIER();
#pragma unroll 1
    for (int jt = 0; jt < ntile; ++jt) {
        const bool local = jt < nl; const int k0 = local ? 128 * (qi - 1) + 64 * (kt_lo + jt) : 64 * (jt - nl);
        const LAS unsigned char* KS = F.lds + (jt & 1) * AT_TILE + AT_KOFF; const LAS unsigned char* VS = F.lds + (jt & 1) * AT_TILE + AT_VOFF;
        { *(LAS v4u*)(F.lds + (jt & 1) * AT_TILE + AT_KOFF + rr * AT_KP + cch * 16) = kw;
          LAS v2u* vd = (LAS v2u*)(F.lds + (jt & 1) * AT_TILE + AT_VOFF + rr * AT_VP + cch * 16); vd[0] = (v2u){vw.x, vw.y}; vd[1] = (v2u){vw.z, vw.w}; }
        if (jt + 1 < ntile) { const bool ln = jt + 1 < nl; const int kn = ln ? 128 * (qi - 1) + 64 * (kt_lo + jt + 1) : 64 * (jt + 1 - nl);
            kw = *(const v4u*)((ln ? kbase_l : kbase_c) + (size_t)kn * PW); vw = *(const v4u*)((ln ? vbase_l : vbase_c) + kn); }
        LDS_BARRIER();
        if (local && (k0 + 63 < qa - 128 || k0 > qa + 63 + 128)) continue;
#pragma unroll 1
        for (int kb = 0; kb < 2; ++kb) {
            bf16x8 kf[4];
#pragma unroll
            for (int ss = 0; ss < 4; ++ss) kf[ss] = *(const LAS bf16x8*)(KS + (32 * kb + r32) * AT_KP + (16 * ss + 8 * hi) * 2);
            bf16x8 pb[2][2];
#pragma unroll
            for (int qt = 0; qt < 2; ++qt) { const int tq = qa + 32 * qt + r32;
                f32x16 s;
#pragma unroll
                for (int r = 0; r < 16; ++r) s[r] = 0.f;
#pragma unroll
                for (int ss = 0; ss < 4; ++ss) s = __builtin_amdgcn_mfma_f32_32x32x16_bf16(kf[ss], qf[qt][ss], s, 0, 0, 0);
                if (local) {
#pragma unroll
                    for (int r = 0; r < 16; ++r) { const int kidx = k0 + 32 * kb + (r & 3) + 8 * (r >> 2) + 4 * hi; const int dlt = kidx - tq; if (dlt > 128 || dlt < -128) s[r] = -1.0e30f; } }
                float mloc = s[0];
#pragma unroll
                for (int r = 1; r < 16; ++r) mloc = fmaxf(mloc, s[r]);
                mloc = fmaxf(mloc, __shfl_xor(mloc, 32));
                const float mnew = fmaxf(mrun[qt], mloc), alpha = __builtin_amdgcn_exp2f(mrun[qt] - mnew); mrun[qt] = mnew;
                float psum = 0.f;
#pragma unroll
                for (int r = 0; r < 16; ++r) { s[r] = __builtin_amdgcn_exp2f(s[r] - mnew); psum += s[r]; }
                lrun[qt] = lrun[qt] * alpha + psum;
#pragma unroll
                for (int db = 0; db < 2; ++db)
#pragma unroll
                    for (int r = 0; r < 16; ++r) O[qt][db][r] *= alpha;
#pragma unroll
                for (int s2 = 0; s2 < 2; ++s2) { v4u pw; pw.x = pk2(s[8 * s2 + 0], s[8 * s2 + 1]); pw.y = pk2(s[8 * s2 + 2], s[8 * s2 + 3]); pw.z = pk2(s[8 * s2 + 4], s[8 * s2 + 5]); pw.w = pk2(s[8 * s2 + 6], s[8 * s2 + 7]);
                    pb[qt][s2] = __builtin_bit_cast(bf16x8, pw); }
            }
#pragma unroll
            for (int s2 = 0; s2 < 2; ++s2)
#pragma unroll
                for (int db = 0; db < 2; ++db) { const LAS v2u* vp = (const LAS v2u*)(VS + (32 * db + r32) * AT_VP + (32 * kb + 16 * s2 + 4 * hi) * 2);
                    const v2u a0 = vp[0], a1 = vp[2]; v4u aw; aw.x = a0.x; aw.y = a0.y; aw.z = a1.x; aw.w = a1.y; const bf16x8 va = __builtin_bit_cast(bf16x8, aw);
                    O[0][db] = __builtin_amdgcn_mfma_f32_32x32x16_bf16(va, pb[0][s2], O[0][db], 0, 0, 0);
                    O[1][db] = __builtin_amdgcn_mfma_f32_32x32x16_bf16(va, pb[1][s2], O[1][db], 0, 0, 0); }
        }
    }
    int r32e = r32, hie = hi; asm volatile("" : "+v"(r32e), "+v"(hie));
#pragma unroll
    for (int qt = 0; qt < 2; ++qt) { const float lt = lrun[qt] + __shfl_xor(lrun[qt], 32); const float rl = 1.0f / lt; const int tq = qa + 32 * qt + r32e;
#if FP8_OUTPROJ
        unsigned char* op8 = (unsigned char*)CC + (size_t)(rowbase + tq) * DM + hq * 64 + 4 * hie;
#pragma unroll
        for (int db = 0; db < 2; ++db)
#pragma unroll
            for (int rq = 0; rq < 4; ++rq) *(unsigned*)(op8 + 32 * db + 8 * rq) = pk4_fp8(O[qt][db][4 * rq] * rl, O[qt][db][4 * rq + 1] * rl, O[qt][db][4 * rq + 2] * rl, O[qt][db][4 * rq + 3] * rl); }
#else
        bf16* op = CC + (size_t)(rowbase + tq) * DM + hq * 64 + 4 * hie;
#pragma unroll
        for (int db = 0; db < 2; ++db)
#pragma unroll
            for (int rq = 0; rq < 4; ++rq) { v2u w; w.x = pk2(O[qt][db][4 * rq] * rl, O[qt][db][4 * rq + 1] * rl); w.y = pk2(O[qt][db][4 * rq + 2] * rl, O[qt][db][4 * rq + 3] * rl);
                *(v2u*)(op + 32 * db + 8 * rq) = w; } }
#endif
}
__device__ __forceinline__ void attn_phase(Frame& F, int l, int rep = 0) {
    const int nunits = 512 + (l == 0 ? 32 : 0);
    LAS int* slot = (LAS int*)(F.lds + LDS_X_OFF + 512);
    for (;;) {
        __syncthreads();
        if (F.tid == 0) *slot = (int)__hip_atomic_fetch_add(F.ctl + CW_ATQ + 64 * l + 8 * rep, 1u, RLX_AGENT);
        __syncthreads();
        const int u = __builtin_amdgcn_readfirstlane(*slot);
        if (u >= nunits) break;
        if (u < 512) attn_unit(F, l, u >> 7, (u >> 5) & 3, u & 31, 0); else { const int v = u - 512; attn_unit(F, l, v >> 3, (v >> 1) & 3, v & 1, 1); }
    }
}
#define USE_CHUNK_DN 1
#ifndef DN_SPLIT
#define DN_SPLIT 2
#endif
#ifndef DN_REP_S1
#define DN_REP_S1 1
#endif
#ifndef DN_REP_S3B
#define DN_REP_S3B 1
#endif
#ifndef DN_REP_S3A
#define DN_REP_S3A 1
#endif
#ifndef DN_REP_S4
#define DN_REP_S4 1
#endif

constexpr int DN_F_NEGW = 0, DN_F_QG = 16, DN_F_QK = 32, DN_F_KGT = 40, DN_NFRAG = 56, DN_U_OFF = 57344;
constexpr int DP_QS = 0, DP_KS = 17408, DP_VS = 34816, DP_AS = 52224  , DP_TB = 69632, DP_TW = 78848, DP_QK = 88064, DP_RAW = 52224  , DP_SC = 104960, DP_TF = 106496  , DP_XS = 123904  ;
constexpr int DP_P = 272, DP_P2 = 144;
__device__ __forceinline__ int dn_rec(int b, int h, int dir, int np) { return ((b * 4 + h) * 2 + dir) * 68 + np; }
__device__ __forceinline__ void dn_chunk_of(int ct, int dir, int& b, int& np) { if (ct < 256) { b = ct >> 6; const int c = ct & 63; np = 4 + (dir ? 63 - c : c); } else { b = (ct - 256) >> 2; const int c = (ct - 256) & 3; np = dir ? 3 - c : c; } }
__device__ __forceinline__ unsigned short lds_u16(const LAS unsigned char* p) { return *(const LAS unsigned short*)p; }

__device__ __forceinline__ void dn_prep_unit(Frame& F, int l, int ct, int h, int dir) {
    const bf16* P = (const bf16*)(F.ws + WS_P);
    int lane = F.lane; asm volatile("" : "+v"(lane));
    const int wave = F.wave, i16 = lane & 15, q = lane >> 4;
    const int m0 = ct * 64; int t0, T, base; seq_of(m0, t0, T, base);
    int b, np; dn_chunk_of(ct, dir, b, np);
    unsigned char* tile = F.ws + WS_DNT + (size_t)dn_rec(b, h, dir, np) * DNT_BYTES;
    LAS unsigned char* L = F.lds;
    LAS float* SC = (LAS float*)(L + DP_SC);
    LDS_BARRIER();
    {
        const float* cw = F.in[I_DNCW] + (size_t)l * 4 * 1536;
        LAS float* cwl = (LAS float*)(L + DP_TF);
        for (int i = F.tid; i < 3 * 4 * 128; i += NTHREADS) { const int part = i >> 9, j = (i >> 7) & 3, ch = i & 127; cwl[i] = cw[j * 1536 + part * 512 + h * 128 + ch]; }
        unsigned short pbw = 0, paw = 0;
        if (wave == 0) { const int tok = dir ? 63 - lane : lane; pbw = P[(size_t)(m0 + tok) * PW + PC_BETA + dir * 4 + h]; paw = P[(size_t)(m0 + tok) * PW + PC_DEC + dir * 4 + h]; }
        for (int c = F.tid; c < 67 * 48; c += NTHREADS) { const int row = c / 48, ch = c % 48, part = ch >> 4, cc = ch & 15, tt = t0 + row - 2;
            v4u v = (v4u){0u, 0u, 0u, 0u};
            if (tt >= 0 && tt < T) v = *(const v4u*)(P + (size_t)(base + tt) * PW + PC_DQ + part * 512 + h * 128 + cc * 8);
            *(LAS v4u*)(L + DP_RAW + row * 784 + part * 256 + cc * 16) = v; }
        LDS_BARRIER();
#pragma unroll 1
        for (int rep = 0; rep < DN_REP_S1; ++rep)
#pragma unroll
        for (int part = 0; part < 3; ++part) { const int tok = F.tid >> 3, g8 = F.tid & 7;
            float sv[16];
#pragma unroll
            for (int k = 0; k < 16; ++k) sv[k] = 0.f;
#pragma unroll
            for (int j = 0; j < 4; ++j) { const LAS v4u* rp = (const LAS v4u*)(L + DP_RAW + (tok + j) * 784 + part * 256 + g8 * 32); const v4u r0 = rp[0], r1 = rp[1];
                const LAS f32x4* wp = (const LAS f32x4*)(cwl + (part * 4 + j) * 128 + g8 * 16); const f32x4 w0 = wp[0], w1 = wp[1], w2 = wp[2], w3 = wp[3];
                sv[0] += w0.x * bflo(r0.x); sv[1] += w0.y * bfhi(r0.x); sv[2] += w0.z * bflo(r0.y); sv[3] += w0.w * bfhi(r0.y); sv[4] += w1.x * bflo(r0.z); sv[5] += w1.y * bfhi(r0.z); sv[6] += w1.z * bflo(r0.w); sv[7] += w1.w * bfhi(r0.w);
                sv[8] += w2.x * bflo(r1.x); sv[9] += w2.y * bfhi(r1.x); sv[10] += w2.z * bflo(r1.y); sv[11] += w2.w * bfhi(r1.y); sv[12] += w3.x * bflo(r1.z); sv[13] += w3.y * bfhi(r1.z); sv[14] += w3.z * bflo(r1.w); sv[15] += w3.w * bfhi(r1.w); }
            float ss = 0.f;
#pragma unroll
            for (int k = 0; k < 16; ++k) { sv[k] = siluf_(sv[k]); ss += sv[k] * sv[k]; }
            if (part < 2) { ss += dpp_mov<0xB1>(ss); ss += dpp_mov<0x4E>(ss); ss += dpp_mov<0x141>(ss);
                const float f = (part == 0 ? 0.08838834764831845f : 1.0f) * __builtin_amdgcn_rsqf(ss + EPS);
#pragma unroll
                for (int k = 0; k < 16; ++k) sv[k] *= f; }
            LAS v4u* op = (LAS v4u*)(L + (part == 0 ? DP_QS : (part == 1 ? DP_KS : DP_VS)) + tok * DP_P + g8 * 32);
            op[0] = (v4u){pk2(sv[0], sv[1]), pk2(sv[2], sv[3]), pk2(sv[4], sv[5]), pk2(sv[6], sv[7])}; op[1] = (v4u){pk2(sv[8], sv[9]), pk2(sv[10], sv[11]), pk2(sv[12], sv[13]), pk2(sv[14], sv[15])}; }
        if (wave == 0) {
            const float pb = bf2f(pbw), pa = bf2f(paw);
            const float beta = sigmoidf_(pb); float gc = -__expf(F.in[I_DNALOG][l * 8 + dir * 4 + h]) * softplusf_(pa + F.in[I_DNDT][l * 8 + dir * 4 + h]);
#pragma unroll
            for (int o = 1; o < 64; o <<= 1) { const float v = __shfl_up(gc, o); if (lane >= o) gc += v; }
            const float glast = __shfl(gc, 63);
            SC[lane] = beta; SC[64 + lane] = gc; SC[128 + lane] = __expf(gc); SC[192 + lane] = __expf(glast - gc);
            if (lane == 63) ((float*)(F.ws + WS_DNS))[dn_rec(b, h, dir, np)] = __expf(glast);
        }
    }
    LDS_BARRIER();
#define DN_TOK(r) (dir ? 63 - (r) : (r))
#pragma unroll 1
    for (int rep = 0; rep < DN_REP_S3A; ++rep)
    {
        const int mb = wave & 3, which = wave >> 2;
        f32x4 acc[4];
#pragma unroll
        for (int nb = 0; nb < 4; ++nb) acc[nb] = (f32x4){0.f, 0.f, 0.f, 0.f};
        const LAS unsigned char* arow = L + (which ? DP_QS : DP_KS) + DN_TOK(16 * mb + i16) * DP_P + 16 * q;
#pragma unroll
        for (int ks = 0; ks < 4; ++ks) { const bf16x8 a = *(const LAS bf16x8*)(arow + 64 * ks);
#pragma unroll
            for (int nb = 0; nb < 4; ++nb) { const bf16x8 bb = *(const LAS bf16x8*)(L + DP_KS + DN_TOK(16 * nb + i16) * DP_P + 16 * q + 64 * ks);
                acc[nb] = __builtin_amdgcn_mfma_f32_16x16x32_bf16(a, bb, acc[nb], 0, 0, 0); } }
#pragma unroll
        for (int nb = 0; nb < 4; ++nb)
#pragma unroll
            for (int i = 0; i < 4; ++i) { const int r = 16 * mb + 4 * q + i, c = 16 * nb + i16; const float dec = __expf(SC[64 + r] - SC[64 + c]);
                if (which == 0) ((LAS float*)(L + DP_AS))[r * 68 + c] = (r > c) ? SC[r] * acc[nb][i] * dec : 0.f;
                else *(LAS unsigned short*)(L + DP_QK + r * DP_P2 + c * 2) = (unsigned short)f2bf((r >= c) ? acc[nb][i] * dec : 0.f); }
    }
    LDS_BARRIER();
#pragma unroll 1
    for (int rep = 0; rep < DN_REP_S3B; ++rep) {
    if (wave == 0) {
        const LAS float* As = (const LAS float*)(L + DP_AS); LAS float* Tf = (LAS float*)(L + DP_TF);
        const int g = lane >> 4, c = lane & 15;
        f32x4 ar[16][4];
#pragma unroll
        for (int r = 1; r < 16; ++r)
#pragma unroll
            for (int j4 = 0; j4 < (r + 3) / 4; ++j4) ar[r][j4] = *(const LAS f32x4*)(As + (16 * g + r) * 68 + 16 * g + 4 * j4);
        float t[16];
#pragma unroll
        for (int r = 0; r < 16; ++r) { float a0 = (c == r) ? 1.f : 0.f, a1 = 0.f;
#pragma unroll
            for (int j = 0; j < r; ++j) { const float av = ar[r][j >> 2][j & 3]; if (j & 1) a1 -= av * t[j]; else a0 -= av * t[j]; }
            t[r] = a0 + a1; Tf[(16 * g + r) * 68 + 16 * g + c] = t[r]; }
    }
    LDS_BARRIER();
    if (wave < 3) {
        const LAS float* As = (const LAS float*)(L + DP_AS); LAS float* Tf = (LAS float*)(L + DP_TF); LAS float* Xs = (LAS float*)(L + DP_XS) + wave * 272;
        const int J = wave;
#pragma unroll 1
        for (int I = J + 1; I < 4; ++I) {
            f32x4 acc = {0.f, 0.f, 0.f, 0.f};
#pragma unroll 1
            for (int K = J; K < I; ++K)
#pragma unroll
                for (int sk = 0; sk < 4; ++sk) acc = __builtin_amdgcn_mfma_f32_16x16x4f32(As[(16 * I + i16) * 68 + 16 * K + 4 * sk + q], Tf[(16 * K + 4 * sk + q) * 68 + 16 * J + i16], acc, 0, 0, 0);
#pragma unroll
            for (int i = 0; i < 4; ++i) Xs[(4 * q + i) * 17 + i16] = acc[i];
            LDS_WAIT(); asm volatile("" ::: "memory");
            f32x4 acc2 = {0.f, 0.f, 0.f, 0.f};
#pragma unroll
            for (int sk = 0; sk < 4; ++sk) acc2 = __builtin_amdgcn_mfma_f32_16x16x4f32(Tf[(16 * I + i16) * 68 + 16 * I + 4 * sk + q], Xs[(4 * sk + q) * 17 + i16], acc2, 0, 0, 0);
#pragma unroll
            for (int i = 0; i < 4; ++i) Tf[(16 * I + 4 * q + i) * 68 + 16 * J + i16] = -acc2[i];
            LDS_WAIT(); asm volatile("" ::: "memory");
        }
    }
    LDS_BARRIER();
    { const LAS float* Tf = (const LAS float*)(L + DP_TF); const int r = F.tid >> 3, c0 = (F.tid & 7) * 8; float vb[8], vw[8];
#pragma unroll
      for (int k = 0; k < 8; ++k) { const int c = c0 + k; const float v = ((r >> 4) >= (c >> 4)) ? Tf[r * 68 + c] : 0.f; const float bl = SC[c]; vb[k] = v * bl; vw[k] = vb[k] * SC[128 + c]; }
      v4u ob, ow; ob.x = pk2(vb[0], vb[1]); ob.y = pk2(vb[2], vb[3]); ob.z = pk2(vb[4], vb[5]); ob.w = pk2(vb[6], vb[7]); ow.x = pk2(vw[0], vw[1]); ow.y = pk2(vw[2], vw[3]); ow.z = pk2(vw[4], vw[5]); ow.w = pk2(vw[6], vw[7]);
      *(LAS v4u*)(L + DP_TB + r * DP_P2 + c0 * 2) = ob; *(LAS v4u*)(L + DP_TW + r * DP_P2 + c0 * 2) = ow; }
    }
    LDS_BARRIER();
    {
        const int nbp = wave & 3, which = wave >> 2;
        f32x4 acc[4][2];
#pragma unroll
        for (int mb = 0; mb < 4; ++mb) { acc[mb][0] = (f32x4){0.f, 0.f, 0.f, 0.f}; acc[mb][1] = (f32x4){0.f, 0.f, 0.f, 0.f}; }
#pragma unroll
        for (int ks = 0; ks < 2; ++ks) {
            bf16x8 bb[2];
#pragma unroll
            for (int nn = 0; nn < 2; ++nn) { const int n = 16 * (2 * nbp + nn) + i16; unsigned short e[8];
#pragma unroll
                for (int jj = 0; jj < 8; ++jj) e[jj] = lds_u16(L + (which ? DP_KS : DP_VS) + DN_TOK(32 * ks + 8 * q + jj) * DP_P + n * 2);
                v4u w; w.x = e[0] | ((unsigned)e[1] << 16); w.y = e[2] | ((unsigned)e[3] << 16); w.z = e[4] | ((unsigned)e[5] << 16); w.w = e[6] | ((unsigned)e[7] << 16); bb[nn] = __builtin_bit_cast(bf16x8, w); }
#pragma unroll
            for (int mb = 0; mb < 4; ++mb) { const bf16x8 a = *(const LAS bf16x8*)(L + (which ? DP_TW : DP_TB) + (16 * mb + i16) * DP_P2 + 64 * ks + 16 * q);
                acc[mb][0] = __builtin_amdgcn_mfma_f32_16x16x32_bf16(a, bb[0], acc[mb][0], 0, 0, 0); acc[mb][1] = __builtin_amdgcn_mfma_f32_16x16x32_bf16(a, bb[1], acc[mb][1], 0, 0, 0); } }
        if (which == 0) {
#pragma unroll
            for (int mb = 0; mb < 4; ++mb)
#pragma unroll
                for (int nn = 0; nn < 2; ++nn) *(f32x4*)(tile + DN_U_OFF + (size_t)((((2 * nbp + nn) * 4 + mb) * 64 + lane) * 16)) = acc[mb][nn];
        } else {
#pragma unroll
            for (int mb = 0; mb < 4; ++mb)
#pragma unroll
                for (int nn = 0; nn < 2; ++nn)
#pragma unroll
                    for (int i = 0; i < 4; ++i) *(LAS unsigned short*)(L + DP_AS + (16 * mb + 4 * q + i) * DP_P + (16 * (2 * nbp + nn) + i16) * 2) = (unsigned short)f2bf(-acc[mb][nn][i]);
        }
    }
    LDS_BARRIER();
#pragma unroll 1
    for (int rep = 0; rep < DN_REP_S4; ++rep)
#pragma unroll 1
    for (int fi = 0; fi < 7; ++fi) { const int f = wave * 7 + fi; v4u o;
        if (f < DN_F_QG) { const int mb = f >> 2, ks = f & 3; const LAS unsigned char* rp = L + DP_AS + (16 * mb + i16) * DP_P + (32 * ks + 4 * q) * 2;
            const v2u a = *(const LAS v2u*)rp, c = *(const LAS v2u*)(rp + 32); o.x = a.x; o.y = a.y; o.z = c.x; o.w = c.y; }
        else if (f < DN_F_QK) { const int ff = f - DN_F_QG, mb = ff >> 2, ks = ff & 3, r = 16 * mb + i16; const LAS unsigned char* rp = L + DP_QS + DN_TOK(r) * DP_P + (32 * ks + 4 * q) * 2; const float eg = SC[128 + r];
            const v2u a = *(const LAS v2u*)rp, c = *(const LAS v2u*)(rp + 32);
            o.x = pk2(bflo(a.x) * eg, bfhi(a.x) * eg); o.y = pk2(bflo(a.y) * eg, bfhi(a.y) * eg); o.z = pk2(bflo(c.x) * eg, bfhi(c.x) * eg); o.w = pk2(bflo(c.y) * eg, bfhi(c.y) * eg); }
        else if (f < DN_F_KGT) { const int ff = f - DN_F_QK, mb = ff >> 1, ks = ff & 1; const LAS unsigned char* rp = L + DP_QK + (16 * mb + i16) * DP_P2 + (32 * ks + 4 * q) * 2;
            const v2u a = *(const LAS v2u*)rp, c = *(const LAS v2u*)(rp + 32); o.x = a.x; o.y = a.y; o.z = c.x; o.w = c.y; }
        else { const int ff = f - DN_F_KGT, mb = ff >> 1, ks = ff & 1, dk = 16 * mb + i16; float e[8];
#pragma unroll
            for (int jj = 0; jj < 8; ++jj) { const int key = 32 * ks + 16 * (jj >> 2) + 4 * q + (jj & 3); e[jj] = bf2f(lds_u16(L + DP_KS + DN_TOK(key) * DP_P + dk * 2)) * SC[192 + key]; }
            o.x = pk2(e[0], e[1]); o.y = pk2(e[2], e[3]); o.z = pk2(e[4], e[5]); o.w = pk2(e[6], e[7]); }
        *(v4u*)(tile + (size_t)f * 1024 + lane * 16) = o; }
#undef DN_TOK
}
__device__ __forceinline__ void dn_prep(Frame& F, int l) {
    for (int u = F.bid; u < NCT * 4 * 2; u += F.G) dn_prep_unit(F, l, u >> 3, (u >> 1) & 3, u & 1);
    __syncthreads();
}

__device__ __forceinline__ void dn_scan(Frame& F, int l, int b, int h, int dir, int half) {
    int lane = F.lane; asm volatile("" : "+v"(lane));
    const int w = (DN_SPLIT == 2) ? half * 4 + (F.wave & 3) : F.wave, i16 = lane & 15, q = lane >> 4; const bool active = (DN_SPLIT == 2) ? (F.wave < 4) : true;
    const unsigned char* tiles = F.ws + WS_DNT + (size_t)dn_rec(b, h, dir, 0) * DNT_BYTES;
    const float* egl = (const float*)(F.ws + WS_DNS) + dn_rec(b, h, dir, 0);
    float* O = (float*)(F.ws + WS_DNO);
    LAS unsigned char* L = F.lds;
    f32x4 S[8];
#pragma unroll
    for (int i = 0; i < 8; ++i) S[i] = (f32x4){0.f, 0.f, 0.f, 0.f};
    v4u st[7]; f32x4 un[4];
#pragma unroll
    for (int mb = 0; mb < 4; ++mb) un[mb] = *(const f32x4*)(tiles + DN_U_OFF + (size_t)(((w * 4 + mb) * 64 + lane) * 16));
    LDS_BARRIER();
#pragma unroll
    for (int i = 0; i < 7; ++i) st[i] = *(const v4u*)(tiles + (size_t)(F.tid + i * NTHREADS) * 16);
#pragma unroll
    for (int i = 0; i < 7; ++i) *(LAS v4u*)(L + (F.tid + i * NTHREADS) * 16) = st[i];
#pragma unroll
    for (int i = 0; i < 7; ++i) st[i] = *(const v4u*)(tiles + DNT_BYTES + (size_t)(F.tid + i * NTHREADS) * 16);
    LDS_BARRIER();
#pragma unroll 1
    for (int n = 0; n < 68; ++n) {
        const unsigned char* tile = tiles + (size_t)n * DNT_BYTES; const LAS unsigned char* cur = L + (n & 1) * 57344;
        if (n + 1 < 68) {
#pragma unroll
            for (int i = 0; i < 7; ++i) *(LAS v4u*)(L + ((n + 1) & 1) * 57344 + (F.tid + i * NTHREADS) * 16) = st[i]; }
        if (n + 2 < 68) {
#pragma unroll
            for (int i = 0; i < 7; ++i) st[i] = *(const v4u*)(tile + 2 * DNT_BYTES + (size_t)(F.tid + i * NTHREADS) * 16); }
        if (active) {
        f32x4 vn[4];
#pragma unroll
        for (int mb = 0; mb < 4; ++mb) vn[mb] = un[mb];
        if (n + 1 < 68) {
#pragma unroll
            for (int mb = 0; mb < 4; ++mb) un[mb] = *(const f32x4*)(tile + DNT_BYTES + DN_U_OFF + (size_t)(((w * 4 + mb) * 64 + lane) * 16)); }
        const float el = egl[n];
        bf16x8 bS[4];
#pragma unroll
        for (int ks = 0; ks < 4; ++ks) { v4u x; x.x = pk2(S[2 * ks][0], S[2 * ks][1]); x.y = pk2(S[2 * ks][2], S[2 * ks][3]); x.z = pk2(S[2 * ks + 1][0], S[2 * ks + 1][1]); x.w = pk2(S[2 * ks + 1][2], S[2 * ks + 1][3]); bS[ks] = __builtin_bit_cast(bf16x8, x); }
        f32x4 o[4];
#pragma unroll
        for (int mb = 0; mb < 4; ++mb) { o[mb] = (f32x4){0.f, 0.f, 0.f, 0.f};
#pragma unroll
            for (int ks = 0; ks < 4; ++ks) { const bf16x8 aw = *(const LAS bf16x8*)(cur + (DN_F_NEGW + mb * 4 + ks) * 1024 + lane * 16), aq = *(const LAS bf16x8*)(cur + (DN_F_QG + mb * 4 + ks) * 1024 + lane * 16);
                vn[mb] = __builtin_amdgcn_mfma_f32_16x16x32_bf16(aw, bS[ks], vn[mb], 0, 0, 0); o[mb] = __builtin_amdgcn_mfma_f32_16x16x32_bf16(aq, bS[ks], o[mb], 0, 0, 0); } }
        bf16x8 bV[2];
#pragma unroll
        for (int ks = 0; ks < 2; ++ks) { v4u x; x.x = pk2(vn[2 * ks][0], vn[2 * ks][1]); x.y = pk2(vn[2 * ks][2], vn[2 * ks][3]); x.z = pk2(vn[2 * ks + 1][0], vn[2 * ks + 1][1]); x.w = pk2(vn[2 * ks + 1][2], vn[2 * ks + 1][3]); bV[ks] = __builtin_bit_cast(bf16x8, x); }
#pragma unroll
        for (int mb = 0; mb < 8; ++mb) { S[mb] = S[mb] * el;
#pragma unroll
            for (int ks = 0; ks < 2; ++ks) { const bf16x8 ak = *(const LAS bf16x8*)(cur + (DN_F_KGT + mb * 2 + ks) * 1024 + lane * 16); S[mb] = __builtin_amdgcn_mfma_f32_16x16x32_bf16(ak, bV[ks], S[mb], 0, 0, 0); } }
#pragma unroll
        for (int mb = 0; mb < 4; ++mb)
#pragma unroll
            for (int ks = 0; ks < 2; ++ks) { const bf16x8 aqk = *(const LAS bf16x8*)(cur + (DN_F_QK + mb * 2 + ks) * 1024 + lane * 16); o[mb] = __builtin_amdgcn_mfma_f32_16x16x32_bf16(aqk, bV[ks], o[mb], 0, 0, 0); }
        { int m0; if (n < 4) m0 = NLAT + b * CTXL + 64 * (dir ? 3 - n : n); else m0 = b * SEQ + 64 * (dir ? 63 - (n - 4) : (n - 4));
#pragma unroll
          for (int mb = 0; mb < 4; ++mb)
#pragma unroll
            for (int i = 0; i < 4; ++i) { const int r = 16 * mb + 4 * q + i, tok = dir ? 63 - r : r; O[((size_t)dir * NTOK + m0 + tok) * 512 + h * 128 + 16 * w + i16] = o[mb][i]; } }
        }
        LDS_BARRIER();
    }
}
#define USE_CHUNK_LRU 1

constexpr int LR_XF = 0  , LR_XB = 16640  , LR_WT = 25856  , LR_AA = 62720  , LR_UU = 96000  , LR_END = 129280;
constexpr size_t WS_LCA = WS_LRC, WS_LCH = WS_LRC + 2 * MiB, WS_LCI = WS_LRC + 4 * MiB;
__device__ __forceinline__ void lru_prep(Frame& F, int l) {
    const bf16* P = (const bf16*)(F.ws + WS_P);
    int lane = F.lane; asm volatile("" : "+v"(lane));
    const int wave = F.wave, i16 = lane & 15, q = lane >> 4, nb = F.bid & 7;
    LAS unsigned char* L = F.lds;
    LAS float* XF = (LAS float*)(L + LR_XF); LAS float* AA = (LAS float*)(L + LR_AA); LAS float* UU = (LAS float*)(L + LR_UU);
    bf16* HL = (bf16*)(F.ws + WS_LRH); bf16* AC = (bf16*)(F.ws + WS_LRA);
    __syncthreads();
    for (int e = F.tid; e < 4 * 4096; e += NTHREADS) { const int mat = e >> 12, ii = (e >> 6) & 63, j = e & 63, dir = mat >> 1;
        const float w = (mat & 1 ? F.in[I_LRWI] : F.in[I_LRWR])[((size_t)((l * 2 + dir) * 8 + nb)) * 4096 + ii * 64 + j];
        *(LAS unsigned short*)(L + LR_WT + (mat * 64 + j) * 144 + ii * 2) = (unsigned short)f2bf(w); }
    float cwv[4][8], cbv[8];
    { const int c8 = (F.tid & 7) * 8, ch0 = nb * 64 + c8; const float* cb = F.in[I_LRCB] + l * 512 + ch0; const float* cw = F.in[I_LRCW] + (size_t)l * 4 * 512 + ch0;
#pragma unroll
      for (int k = 0; k < 8; ++k) cbv[k] = cb[k];
#pragma unroll
      for (int j = 0; j < 4; ++j)
#pragma unroll
        for (int k = 0; k < 8; ++k) cwv[j][k] = cw[j * 512 + k]; }
    float gbr[4], gbi[4], gls[4];
    { const int dir = wave >> 2;
#pragma unroll
      for (int n = 0; n < 4; ++n) { const int ch = nb * 64 + 16 * n + i16; gbr[n] = F.in[I_LRBR][(l * 2 + dir) * 512 + ch]; gbi[n] = F.in[I_LRBI][(l * 2 + dir) * 512 + ch]; gls[n] = -softplusf_(-F.in[I_LRLAM][(l * 2 + dir) * 512 + ch]); } }
    v4u wv[4];
#define LR_LOADRAW(ctx) do { const int _m0 = (ctx) * 64; int _t0, _T, _base; seq_of(_m0, _t0, _T, _base); const int _tok = F.tid >> 3, _ch0 = nb * 64 + (F.tid & 7) * 8; \
        _Pragma("unroll") for (int j = 0; j < 4; ++j) { const int tt = _t0 + _tok + j - 2; wv[j] = (v4u){0u, 0u, 0u, 0u}; if (tt >= 0 && tt < _T) wv[j] = *(const v4u*)(P + (size_t)(_base + tt) * PW + PC_LX + _ch0); } } while (0)
    if ((F.bid >> 3) < NCT) LR_LOADRAW(F.bid >> 3);
    for (int ct = F.bid >> 3; ct < NCT; ct += F.G >> 3) {
        const int m0 = ct * 64;
        LDS_BARRIER();
        { const int tok = F.tid >> 3, c8 = (F.tid & 7) * 8, ch0 = nb * 64 + c8; float s[8];
#pragma unroll
          for (int k = 0; k < 8; ++k) s[k] = cbv[k];
#pragma unroll
          for (int j = 0; j < 4; ++j) { const v4u w = wv[j];
              s[0] += cwv[j][0] * bflo(w.x); s[1] += cwv[j][1] * bfhi(w.x); s[2] += cwv[j][2] * bflo(w.y); s[3] += cwv[j][3] * bfhi(w.y); s[4] += cwv[j][4] * bflo(w.z); s[5] += cwv[j][5] * bfhi(w.z); s[6] += cwv[j][6] * bflo(w.w); s[7] += cwv[j][7] * bfhi(w.w); }
#pragma unroll
          for (int k = 0; k < 8; ++k) XF[tok * 65 + c8 + k] = s[k];
          v4u o; o.x = pk2(s[0], s[1]); o.y = pk2(s[2], s[3]); o.z = pk2(s[4], s[5]); o.w = pk2(s[6], s[7]); *(LAS v4u*)(L + LR_XB + tok * 144 + c8 * 2) = o; }
        if (ct + (F.G >> 3) < NCT) LR_LOADRAW(ct + (F.G >> 3));
        LDS_BARRIER();
        { const int dir = wave >> 2, mb = wave & 3;
          f32x4 ar[4], ai[4];
#pragma unroll
          for (int n = 0; n < 4; ++n) { ar[n] = (f32x4){0.f, 0.f, 0.f, 0.f}; ai[n] = (f32x4){0.f, 0.f, 0.f, 0.f}; }
#pragma unroll
          for (int ks = 0; ks < 2; ++ks) { const bf16x8 a = *(const LAS bf16x8*)(L + LR_XB + (16 * mb + i16) * 144 + 64 * ks + 16 * q);
#pragma unroll
              for (int n = 0; n < 4; ++n) { const bf16x8 br = *(const LAS bf16x8*)(L + LR_WT + ((dir * 2 + 0) * 64 + 16 * n + i16) * 144 + 64 * ks + 16 * q), bi = *(const LAS bf16x8*)(L + LR_WT + ((dir * 2 + 1) * 64 + 16 * n + i16) * 144 + 64 * ks + 16 * q);
                  ar[n] = __builtin_amdgcn_mfma_f32_16x16x32_bf16(a, br, ar[n], 0, 0, 0); ai[n] = __builtin_amdgcn_mfma_f32_16x16x32_bf16(a, bi, ai[n], 0, 0, 0); } }
#pragma unroll
          for (int n = 0; n < 4; ++n) { const int j = 16 * n + i16; const float br_ = gbr[n], bi_ = gbi[n], logsig = gls[n];
#pragma unroll
              for (int i = 0; i < 4; ++i) { const int tok = 16 * mb + 4 * q + i; const float r = sigmoidf_(ar[n][i] + br_), ig = sigmoidf_(ai[n][i] + bi_);
                  const float log_a = 8.0f * r * logsig, a = __expf(log_a), y2 = 2.0f * log_a;
                  const float om = (y2 > -0.1f) ? -y2 * (1.0f + y2 * (0.5f + y2 * (0.16666667f + y2 * 0.041666668f))) : 1.0f - __expf(y2);
                  const float u = __builtin_amdgcn_sqrtf(om) * (ig * XF[tok * 65 + j]);
                  AA[(dir * 64 + tok) * 65 + j] = a; UU[(dir * 64 + tok) * 65 + j] = u; } } }
        LDS_BARRIER();
        if (F.tid < 128) { const int dir = F.tid >> 6, j = F.tid & 63, ch = nb * 64 + j; float h = 0.f, ac = 1.f;
            long o = (long)(((size_t)dir * NTOK + m0 + (dir ? 63 : 0)) * 512 + ch); const long ostep = dir ? -512 : 512;
#pragma unroll 1
            for (int s0 = 0; s0 < 64; s0 += 8) { float av[8], uv[8];
#pragma unroll
                for (int k = 0; k < 8; ++k) { const int tok = dir ? 63 - (s0 + k) : (s0 + k); av[k] = AA[(dir * 64 + tok) * 65 + j]; uv[k] = UU[(dir * 64 + tok) * 65 + j]; }
#pragma unroll
                for (int k = 0; k < 8; ++k) { h = av[k] * h + uv[k]; ac *= av[k]; HL[o] = (bf16)f2bf(h); AC[o] = (bf16)f2bf(ac); o += ostep; } }
            ((float*)(F.ws + WS_LCA))[((size_t)dir * NCT + ct) * 512 + ch] = ac; ((float*)(F.ws + WS_LCH))[((size_t)dir * NCT + ct) * 512 + ch] = h; }
    }
    LDS_BARRIER();
}
__device__ __forceinline__ void lru_carry(Frame& F, int idx) {
    const int ch = idx & 511, dir = (idx >> 9) & 1, b = idx >> 10;
    const float* CA = (const float*)(F.ws + WS_LCA); const float* CH = (const float*)(F.ws + WS_LCH); float* CI = (float*)(F.ws + WS_LCI);
    float h = 0.f;
#pragma unroll 4
    for (int n = 0; n < 68; ++n) { const int ct = n < 4 ? 256 + b * 4 + (dir ? 3 - n : n) : b * 64 + (dir ? 63 - (n - 4) : (n - 4)); const size_t o = ((size_t)dir * NCT + ct) * 512 + ch;
        CI[o] = h; h = CA[o] * h + CH[o]; }
}
__device__ __forceinline__ void lru_fin(Frame& F, int l) {
    const int nrows = (l == 0) ? NTOK : NLAT;
    const bf16* P = (const bf16*)(F.ws + WS_P); bf16* CC = (bf16*)(F.ws + WS_CC);
    const bf16* HL = (const bf16*)(F.ws + WS_LRH); const bf16* AC = (const bf16*)(F.ws + WS_LRA); const float* CI = (const float*)(F.ws + WS_LCI);
    for (size_t i = (size_t)F.bid * NTHREADS + F.tid; i < (size_t)nrows * 128; i += (size_t)F.G * NTHREADS) { const int m = (int)(i >> 7), c4 = (int)(i & 127) * 4, ct = m >> 6;
        const v2u hw0 = *(const v2u*)(HL + (size_t)m * 512 + c4), aw0 = *(const v2u*)(AC + (size_t)m * 512 + c4), hw1 = *(const v2u*)(HL + ((size_t)NTOK + m) * 512 + c4), aw1 = *(const v2u*)(AC + ((size_t)NTOK + m) * 512 + c4);
        const f32x4 h0 = {bflo(hw0.x), bfhi(hw0.x), bflo(hw0.y), bfhi(hw0.y)}, a0 = {bflo(aw0.x), bfhi(aw0.x), bflo(aw0.y), bfhi(aw0.y)}, h1 = {bflo(hw1.x), bfhi(hw1.x), bflo(hw1.y), bfhi(hw1.y)}, a1 = {bflo(aw1.x), bfhi(aw1.x), bflo(aw1.y), bfhi(aw1.y)};
        const f32x4 i0 = *(const f32x4*)(CI + (size_t)ct * 512 + c4), i1 = *(const f32x4*)(CI + ((size_t)NCT + ct) * 512 + c4);
        const f32x4 hs = (a0 * i0 + h0) + (a1 * i1 + h1); const v2u yw = *(const v2u*)(P + (size_t)m * PW + PC_LY + c4);
#if FP8_OUTPROJ
        *(unsigned*)((unsigned char*)CC + (size_t)m * DM + 1536 + c4) = pk4_fp8(hs.x * gelu_tanh(bflo(yw.x)), hs.y * gelu_tanh(bfhi(yw.x)), hs.z * gelu_tanh(bflo(yw.y)), hs.w * gelu_tanh(bfhi(yw.y))); }
#else
        v2u o; o.x = pk2(hs.x * gelu_tanh(bflo(yw.x)), hs.y * gelu_tanh(bfhi(yw.x))); o.y = pk2(hs.z * gelu_tanh(bflo(yw.y)), hs.w * gelu_tanh(bfhi(yw.y)));
        *(v2u*)(CC + (size_t)m * DM + 1536 + c4) = o; }
#endif
}

constexpr size_t WS_DNQ = WS_DNT;
constexpr size_t WS_BG = WS_DNS + 1 * MiB;
constexpr size_t WS_XC = WS_XS;

__device__ __forceinline__ void naive_prep(Frame& F, int l) {
    const bf16* P = (const bf16*)(F.ws + WS_P);
    const int gw = F.bid * NWAVES + F.wave, NGW = F.G * NWAVES;
#if !defined(USE_CHUNK_DN)
    {
        float* DNQ = (float*)(F.ws + WS_DNQ); float* BG = (float*)(F.ws + WS_BG);
        const float* cw = F.in[I_DNCW] + (size_t)l * 4 * 1536;
        for (int it = gw; it < NTOK * 4; it += NGW) {
            const int m = it >> 2, h = it & 3; int t, T, base; seq_of(m, t, T, base);
            float val[3][2];
#pragma unroll
            for (int part = 0; part < 3; ++part)
#pragma unroll
                for (int dd = 0; dd < 2; ++dd) { const int d = F.lane + 64 * dd, cch = part * 512 + h * 128 + d, col = PC_DQ + cch; float s = 0.f;
#pragma unroll
                    for (int j = 0; j < 4; ++j) { const int tt = t + j - 2; if (tt >= 0 && tt < T) s += cw[j * 1536 + cch] * bf2f(P[(size_t)(base + tt) * PW + col]); }
                    val[part][dd] = siluf_(s); }
            const float sq = wave_sum(val[0][0] * val[0][0] + val[0][1] * val[0][1]), sk = wave_sum(val[1][0] * val[1][0] + val[1][1] * val[1][1]);
            const float fq = 0.08838834764831845f / sqrtf(sq + EPS), fk = 1.0f / sqrtf(sk + EPS);
#pragma unroll
            for (int dd = 0; dd < 2; ++dd) { const int d = F.lane + 64 * dd; float* o = DNQ + (size_t)m * 1536 + h * 128 + d;
                o[0] = val[0][dd] * fq; o[512] = val[1][dd] * fk; o[1024] = val[2][dd]; }
            if (h == 0 && F.lane < 8) { const int dir = F.lane >> 2, hh = F.lane & 3;
                const float pb = bf2f(P[(size_t)m * PW + PC_BETA + F.lane]), pa = bf2f(P[(size_t)m * PW + PC_DEC + F.lane]);
                BG[m * 16 + F.lane] = sigmoidf_(pb);
                BG[m * 16 + 8 + F.lane] = -__expf(F.in[I_DNALOG][l * 8 + dir * 4 + hh]) * softplusf_(pa + F.in[I_DNDT][l * 8 + dir * 4 + hh]); }
        }
    }
#endif
#if !defined(USE_CHUNK_LRU)
    {
        LAS float* xc = (LAS float*)F.lds;
        float* A = (float*)(F.ws + WS_LRA); float* U = (float*)(F.ws + WS_LRH);
        const float* cw = F.in[I_LRCW] + (size_t)l * 4 * 512; const float* cb = F.in[I_LRCB] + l * 512;
        for (int m0 = F.bid * 8; m0 < NTOK; m0 += F.G * 8) {
            __syncthreads();
            for (int i = F.tid; i < 8 * 512; i += NTHREADS) { const int m = m0 + (i >> 9), ch = i & 511; int t, T, base; seq_of(m, t, T, base); float s = cb[ch];
#pragma unroll
                for (int j = 0; j < 4; ++j) { const int tt = t + j - 2; if (tt >= 0 && tt < T) s += cw[j * 512 + ch] * bf2f(P[(size_t)(base + tt) * PW + PC_LX + ch]); }
                xc[i] = s; }
            __syncthreads();
            for (int i = F.tid; i < 8 * 512 * 2; i += NTHREADS) { const int ch = i & 511, dir = (i >> 9) & 1, tk = i >> 10, m = m0 + tk, blk = ch >> 6, j = ch & 63;
                const float* wr = F.in[I_LRWR] + ((size_t)((l * 2 + dir) * 8 + blk)) * 4096 + j; const float* wi = F.in[I_LRWI] + ((size_t)((l * 2 + dir) * 8 + blk)) * 4096 + j;
                float sr = F.in[I_LRBR][(l * 2 + dir) * 512 + ch], si = F.in[I_LRBI][(l * 2 + dir) * 512 + ch];
#pragma unroll 8
                for (int ii = 0; ii < 64; ++ii) { const float x = xc[tk * 512 + blk * 64 + ii]; sr += x * wr[ii * 64]; si += x * wi[ii * 64]; }
                const float r = sigmoidf_(sr), ig = sigmoidf_(si); const float lam = F.in[I_LRLAM][(l * 2 + dir) * 512 + ch];
                const float logsig = -softplusf_(-lam);
                const float log_a = 8.0f * r * logsig; const float a = __expf(log_a);
                const float u = sqrtf(-expm1f(2.0f * log_a)) * (ig * xc[tk * 512 + ch]);
                A[((size_t)dir * NTOK + m) * 512 + ch] = a; U[((size_t)dir * NTOK + m) * 512 + ch] = u; }
        }
        __syncthreads();
    }
#endif
}

__device__ __forceinline__ void naive_attn_row(Frame& F, int l, int m, int hq) {
    const bf16* P = (const bf16*)(F.ws + WS_P); bf16* CC = (bf16*)(F.ws + WS_CC);
    const int d = F.lane, kvh = hq >> 2; int t, T, base; seq_of(m, t, T, base);
    const bool lat = m < NLAT; const int b = lat ? (m >> 12) : ((m - NLAT) >> 8);
    const int dd = d & 31, jf = dd & 15; const float inv = __powf(10000.0f, -(float)jf * (1.0f / 16.0f));
    const bool second = (dd >= 16), colhalf = (d >= 32);
    float q = bf2f(P[(size_t)m * PW + PC_Q + hq * 64 + d]);
    if (lat) { const float pos = (float)(colhalf ? (t & 63) : (t >> 6)); float sn, cs; sincosf(pos * inv, &sn, &cs); const float pr = __shfl_xor(q, 16); q = second ? (q * cs + pr * sn) : (q * cs - pr * sn); }
    q *= 0.125f;
    float mx = F.in[I_SINK][l * 16 + hq], den = 1.0f, acc = 0.f;
    if (lat) { const int t0 = t - 128 < 0 ? 0 : t - 128, t1 = t + 128 > SEQ - 1 ? SEQ - 1 : t + 128;
        for (int tk = t0; tk <= t1; ++tk) { const size_t r = (size_t)(base + tk) * PW; float k = bf2f(P[r + PC_K + kvh * 64 + d]); const float v = bf2f(P[r + PC_V + kvh * 64 + d]);
            const float pos = (float)(colhalf ? (tk & 63) : (tk >> 6)); float sn, cs; sincosf(pos * inv, &sn, &cs); const float pr = __shfl_xor(k, 16); k = second ? (k * cs + pr * sn) : (k * cs - pr * sn);
            const float s = wave_sum(q * k); const float mn = fmaxf(mx, s), f = __expf(mx - mn), p = __expf(s - mn); den = den * f + p; acc = acc * f + p * v; mx = mn; } }
    for (int c = 0; c < CTXL; ++c) { const size_t r = (size_t)(NLAT + b * CTXL + c) * PW; const float k = bf2f(P[r + PC_K + kvh * 64 + d]), v = bf2f(P[r + PC_V + kvh * 64 + d]);
        const float s = wave_sum(q * k); const float mn = fmaxf(mx, s), f = __expf(mx - mn), p = __expf(s - mn); den = den * f + p; acc = acc * f + p * v; mx = mn; }
    CC[(size_t)m * DM + hq * 64 + d] = (bf16)f2bf(acc / den);
}

__device__ __forceinline__ int scan_row(int n, int b, int dir) { if (n < CTXL) { const int t = dir ? (CTXL - 1 - n) : n; return NLAT + b * CTXL + t; } const int t = dir ? (SEQ - 1 - (n - CTXL)) : (n - CTXL); return b * SEQ + t; }
__device__ __forceinline__ void naive_scan(Frame& F, int l, int rep = 0) {
#if defined(USE_CHUNK_DN)
    if (F.bid < 32 * DN_SPLIT) { if (DN_SPLIT == 2) dn_scan(F, l, F.bid >> 4, (F.bid >> 2) & 3, (F.bid >> 1) & 1, F.bid & 1); else dn_scan(F, l, F.bid >> 3, (F.bid >> 1) & 3, F.bid & 1, 0); }
#else
    if (F.bid < 32) {
        const int b = F.bid >> 3, h = (F.bid >> 1) & 3, dir = F.bid & 1, dvc = F.tid & 127, kq = F.tid >> 7;
        const float* DNQ = (const float*)(F.ws + WS_DNQ); const float* BG = (const float*)(F.ws + WS_BG); float* O = (float*)(F.ws + WS_DNO);
        LAS float* buf = (LAS float*)F.lds;
        LAS float* red = buf + 768;
        LAS float* red2 = red + 512;
        float S[32];
#pragma unroll
        for (int i = 0; i < 32; ++i) S[i] = 0.f;
        constexpr int NT = CTXL + SEQ;
        { const int m = scan_row(0, b, dir); if (F.tid < 384) buf[F.tid] = DNQ[(size_t)m * 1536 + (F.tid >> 7) * 512 + h * 128 + (F.tid & 127)]; }
        __syncthreads();
#pragma unroll 1
        for (int n = 0; n < NT; ++n) {
            const int m = scan_row(n, b, dir); const LAS float* cur = buf + (n & 1) * 384;
            float nextv = 0.f; if (n + 1 < NT && F.tid < 384) { const int m2 = scan_row(n + 1, b, dir); nextv = DNQ[(size_t)m2 * 1536 + (F.tid >> 7) * 512 + h * 128 + (F.tid & 127)]; }
            const float beta = BG[m * 16 + dir * 4 + h], decay = __expf(BG[m * 16 + 8 + dir * 4 + h]);
            float ks = 0.f;
#pragma unroll
            for (int i = 0; i < 32; ++i) ks += cur[128 + kq * 32 + i] * S[i];
            red[kq * 128 + dvc] = ks;
            __syncthreads();
            const float kS = (red[dvc] + red[128 + dvc]) + (red[256 + dvc] + red[384 + dvc]);
            const float upd = beta * (cur[256 + dvc] - decay * kS);
            float os = 0.f;
#pragma unroll
            for (int i = 0; i < 32; ++i) { S[i] = decay * S[i] + cur[128 + kq * 32 + i] * upd; os += cur[kq * 32 + i] * S[i]; }
            red2[kq * 128 + dvc] = os;
            if (F.tid < 384) buf[((n + 1) & 1) * 384 + F.tid] = nextv;
            __syncthreads();
            if (kq == 0) O[((size_t)dir * NTOK + m) * 512 + h * 128 + dvc] = (red2[dvc] + red2[128 + dvc]) + (red2[256 + dvc] + red2[384 + dvc]);
        }
    }
#endif
#if defined(USE_CHUNK_LRU)
    else if (F.bid < 32 * DN_SPLIT + 8) { lru_carry(F, (F.bid - 32 * DN_SPLIT) * NTHREADS + F.tid); }
#else
    else if (F.bid < 40) {
        const int idx = (F.bid - 32) * NTHREADS + F.tid, ch = idx & 511, dir = (idx >> 9) & 1, b = idx >> 10;
        const float* A = (const float*)(F.ws + WS_LRA); float* U = (float*)(F.ws + WS_LRH);
        float hs = 0.f;
#pragma unroll 4
        for (int n = 0; n < CTXL + SEQ; ++n) { int m; if (n < CTXL) { const int t = dir ? (CTXL - 1 - n) : n; m = NLAT + b * CTXL + t; } else { const int t = dir ? (SEQ - 1 - (n - CTXL)) : (n - CTXL); m = b * SEQ + t; }
            const size_t o = ((size_t)dir * NTOK + m) * 512 + ch; hs = A[o] * hs + U[o]; U[o] = hs; }
    }
#endif
#if defined(USE_MFMA_ATTN)
#if SCAN_SPLIT_ORDER
    if (F.bid & 1) { convert_moe_queue(F, l, rep); attn_phase(F, l, rep); } else { attn_phase(F, l, rep); convert_moe_queue(F, l, rep); }
#else
    attn_phase(F, l, rep);
    convert_moe_queue(F, l, rep);
#endif
#else
    {
        const int nrows = (l == 0) ? NTOK : NLAT;
        for (;;) { int m = 0; if (F.lane == 0) m = (int)__hip_atomic_fetch_add(F.ctl + CW_ATQ + 64 * l, 1u, RLX_AGENT); m = __builtin_amdgcn_readfirstlane(m);
            if (m >= nrows) break;
#pragma unroll 1
            for (int hq = 0; hq < 16; ++hq) naive_attn_row(F, l, m, hq); }
    }
#endif
}

__device__ __forceinline__ void naive_fin(Frame& F, int l) {
    const int nrows = (l == 0) ? NTOK : NLAT;
    const bf16* P = (const bf16*)(F.ws + WS_P); bf16* CC = (bf16*)(F.ws + WS_CC);
    const int gw = F.bid * NWAVES + F.wave, NGW = F.G * NWAVES;
    const float* O = (const float*)(F.ws + WS_DNO); const float* HS = (const float*)(F.ws + WS_LRH);
    for (int it0 = gw * 2; it0 < nrows * 4; it0 += NGW * 2) {
        float2 oa[2], ob[2]; unsigned gw_[2];
#pragma unroll
        for (int k = 0; k < 2; ++k) { const int it = it0 + k, m = it >> 2, h = it & 3; const int c = h * 128 + 2 * F.lane;
            oa[k] = *(const float2*)(O + (size_t)m * 512 + c); ob[k] = *(const float2*)(O + ((size_t)NTOK + m) * 512 + c); gw_[k] = *(const unsigned*)(P + (size_t)m * PW + PC_DG + c); }
        const float2 ng = *(const float2*)(F.in[I_DNNG] + l * 128 + 2 * F.lane);
#pragma unroll
        for (int k = 0; k < 2; ++k) { const int it = it0 + k, m = it >> 2, h = it & 3; const float o0 = oa[k].x + ob[k].x, o1 = oa[k].y + ob[k].y;
            const float rstd = 1.0f / sqrtf(wave_sum(o0 * o0 + o1 * o1) * (1.0f / 128.0f) + EPS);
#if FP8_OUTPROJ
            *(unsigned short*)((unsigned char*)CC + (size_t)m * DM + 1024 + h * 128 + 2 * F.lane) = (unsigned short)(pk4_fp8(o0 * rstd * ng.x * siluf_(bflo(gw_[k])), o1 * rstd * ng.y * siluf_(bfhi(gw_[k])), 0.f, 0.f) & 0xffffu); }
#else
            *(unsigned*)(CC + (size_t)m * DM + 1024 + h * 128 + 2 * F.lane) = pk2(o0 * rstd * ng.x * siluf_(bflo(gw_[k])), o1 * rstd * ng.y * siluf_(bfhi(gw_[k]))); }
#endif
    }
#if defined(USE_CHUNK_LRU)
    lru_fin(F, l);
#else
    for (size_t i = (size_t)F.bid * NTHREADS + F.tid; i < (size_t)nrows * 512; i += (size_t)F.G * NTHREADS) { const int m = (int)(i >> 9), ch = (int)(i & 511);
        const float hsum = HS[(size_t)m * 512 + ch] + HS[((size_t)NTOK + m) * 512 + ch]; const float y = bf2f(P[(size_t)m * PW + PC_LY + ch]);
        CC[(size_t)m * DM + 1536 + ch] = (bf16)f2bf(hsum * gelu_tanh(y)); }
#endif
}
#ifndef PHASE_PREP
#if defined(USE_MFMA_ATTN)
#if defined(USE_CHUNK_DN)
#define PHASE_PREP(F, l) do { attn_prep(F, l); lru_prep(F, l); dn_prep(F, l); } while (0)
#else
#define PHASE_PREP(F, l) do { naive_prep(F, l); attn_prep(F, l); } while (0)
#endif
#else
#define PHASE_PREP(F, l) naive_prep(F, l)
#endif
#endif
#ifndef PHASE_SCAN
#define PHASE_SCAN(F, l) naive_scan(F, l)
#endif
#ifndef PHASE_FIN
#define PHASE_FIN(F, l) naive_fin(F, l)
#endif

#ifndef PHASE_INPROJ
#define PHASE_INPROJ(F, l) do {} while (0)
#endif
#ifndef PHASE_PREP
#define PHASE_PREP(F, l) do {} while (0)
#endif
#ifndef PHASE_SCAN
#define PHASE_SCAN(F, l) do {} while (0)
#endif
#ifndef PHASE_FIN
#define PHASE_FIN(F, l) do {} while (0)
#endif
#ifndef PHASE_OUTPROJ
#define PHASE_OUTPROJ(F, l) do {} while (0)
#endif
#ifndef PHASE_NORM2
#define PHASE_NORM2(F, l) do {} while (0)
#endif
#ifndef PHASE_SCATTER
#define PHASE_SCATTER(F, l) do {} while (0)
#endif
#ifndef PHASE_GEMM1
#define PHASE_GEMM1(F, l) do {} while (0)
#endif
#ifndef PHASE_GEMM2
#define PHASE_GEMM2(F, l) do {} while (0)
#endif

#ifndef MK_SPLIT
#define MK_SPLIT 0
#endif
#ifndef MK_STAGE
#define MK_STAGE 99
#endif
#ifndef MK_TAILFILL
#define MK_TAILFILL 0
#endif
#ifndef MK_DUP
#define MK_DUP 0
#endif
#define DUP(k) ((MK_DUP >> (k)) & 1)
constexpr int N_PHASES = 22;
struct Args { const float* in[N_IN]; float* out; unsigned char* ws; int ph_lo, ph_hi; };
static_assert(sizeof(Args) == (N_IN + 2) * 8 + 8, "Args has no padding");

__global__ void __launch_bounds__(NTHREADS, 2) fwd_kernel(Args args) {
    extern __shared__ __attribute__((aligned(16))) unsigned char lds[];
    Frame F;
    F.lds = (LAS unsigned char*)lds;
    F.MISC = (volatile LAS unsigned*)(F.lds + MISC_OFF);
    F.tid = threadIdx.x; F.lane = F.tid & 63; F.wave = __builtin_amdgcn_readfirstlane(F.tid >> 6);
    F.G = 256; F.bid = blockIdx.x;
    F.ws = args.ws; F.out = args.out; F.ctl = (gu32*)(args.ws + WS_CTL);
    F.in = (const float* const __attribute__((address_space(4)))*)__builtin_amdgcn_kernarg_segment_ptr();
    for (int u = F.tid; u < (LDS_BYTES - LDSCTL_OFF) / 4; u += NTHREADS) ((LAS unsigned*)(F.lds + LDSCTL_OFF))[u] = 0u;
    __syncthreads();
    XcdBarrier bar; bar.bar = (unsigned*)(F.ctl + CW_BAR); bar.x = 0; bar.st = nullptr;
    if (!MK_SPLIT) bar = xcd_barrier_post((unsigned*)(F.ctl + CW_BAR), F.MISC + 8);
    const int lo = args.ph_lo, hi = args.ph_hi;
#define IN(k) (lo <= (k) && (k) < hi && phase_enter(F))
#define INR(k) (lo <= (k) && (k) < hi)
#define SEAM(k) do { if (INR(k) && INR((k) + 1)) { if (MK_TAILFILL && (k) < 14) tail_fill(F, (k), (k) < 4 ? 0 : 1); xcd_barrier(bar); } } while (0)

    if (IN(0)) { p0_prologue(F); if (DUP(0)) { __syncthreads(); p0_prologue(F); } } SEAM(0);
#pragma unroll 1
    for (int l = 0; l < DEPTH; ++l) {
        const int pb = 1 + 10 * l;
        if (IN(pb + 0)) { phase_norm1(F, l); if (DUP(13) && l == 0) { __syncthreads(); phase_norm1(F, l); } } SEAM(pb + 0);
        if (IN(pb + 1)) { PHASE_INPROJ(F, l); if (DUP(1)) { __syncthreads(); PHASE_INPROJ(F, l); } } SEAM(pb + 1);
        if (IN(pb + 2)) { PHASE_PREP(F, l); if (DUP(2)) { __syncthreads(); dn_prep(F, l); } if (DUP(6)) { __syncthreads(); lru_prep(F, l); } } SEAM(pb + 2);
        if (IN(pb + 3)) { if (DUP(3) && F.bid < 64) dn_scan(F, l, F.bid >> 4, (F.bid >> 2) & 3, (F.bid >> 1) & 1, F.bid & 1); PHASE_SCAN(F, l); if (DUP(10)) { __syncthreads(); naive_scan(F, l, 1); } if (DUP(11)) { __syncthreads(); attn_phase(F, l, 2); } if (DUP(12)) { __syncthreads(); convert_moe_queue(F, l, 3); } } SEAM(pb + 3);
        if (IN(pb + 4)) { PHASE_FIN(F, l); if (DUP(4)) { __syncthreads(); PHASE_FIN(F, l); } } SEAM(pb + 4);
        if (IN(pb + 5)) { PHASE_OUTPROJ(F, l); if (DUP(5) && l == 0) { __syncthreads(); PHASE_OUTPROJ(F, l); } } SEAM(pb + 5);
        if (IN(pb + 6)) { PHASE_NORM2(F, l); } SEAM(pb + 6);
        if (IN(pb + 7)) { PHASE_SCATTER(F, l); if (DUP(7)) { __syncthreads(); PHASE_SCATTER(F, l); } } SEAM(pb + 7);
        if (IN(pb + 8)) { PHASE_GEMM1(F, l); if (DUP(8)) { __syncthreads(); PHASE_GEMM1(F, l); } } SEAM(pb + 8);
        if (IN(pb + 9)) { PHASE_GEMM2(F, l); if (DUP(9)) { __syncthreads(); PHASE_GEMM2(F, l); } } SEAM(pb + 9);
    }
    if (IN(21)) { phase_final(F, MK_STAGE >= 9); if (DUP(13)) { __syncthreads(); phase_final(F, MK_STAGE >= 9); } }
#undef IN
#undef SEAM
}

extern "C" void kernel_launch(void* const* d_in, const int* in_sizes, int n_in, void* d_out, int out_size, void* d_ws, size_t ws_size, hipStream_t stream) {
    static int grid = 0;
    if (grid == 0) {
        if (n_in != N_IN || out_size != NLAT * DM || ws_size < WS_END) { fprintf(stderr, "kernel_launch: unexpected shapes (n_in %d, out %d, ws %zu); nothing launched\n", n_in, out_size, ws_size); grid = -1; return; }
        int dev = 0, cus = 0, per_cu = 0;
        if (hipGetDevice(&dev) != hipSuccess || hipDeviceGetAttribute(&cus, hipDeviceAttributeMultiprocessorCount, dev) != hipSuccess) { grid = -1; return; }
        if (hipFuncSetAttribute((const void*)fwd_kernel, hipFuncAttributeMaxDynamicSharedMemorySize, LDS_BYTES) != hipSuccess) { fprintf(stderr, "kernel_launch: hipFuncSetAttribute failed\n"); grid = -1; return; }
        if (hipOccupancyMaxActiveBlocksPerMultiprocessor(&per_cu, (const void*)fwd_kernel, NTHREADS, LDS_BYTES) != hipSuccess || per_cu < 1) { fprintf(stderr, "kernel_launch: occupancy query says %d\n", per_cu); }
        (void)hipGetLastError();
        grid = cus;
        if (grid != 256) { fprintf(stderr, "kernel_launch: built for 256 CUs, device has %d; nothing launched\n", cus); grid = -1; return; }
    }
    if (grid < 0) return;
    if (hipMemsetAsync((char*)d_ws + WS_CTL, 0, CTL_ZERO_BYTES, stream) != hipSuccess) return;
    Args a{};
    for (int i = 0; i < N_IN; ++i) a.in[i] = (const float*)d_in[i];
    a.out = (float*)d_out; a.ws = (unsigned char*)d_ws;
#if MK_SPLIT
    for (int p = 0; p < N_PHASES; ++p) { a.ph_lo = p; a.ph_hi = p + 1; hipLaunchKernelGGL(fwd_kernel, dim3(grid), dim3(NTHREADS), LDS_BYTES, stream, a); }
#else
    a.ph_lo = 0; a.ph_hi = N_PHASES;
    hipLaunchKernelGGL(fwd_kernel, dim3(grid), dim3(NTHREADS), LDS_BYTES, stream, a);
#endif
    const hipError_t le = hipPeekAtLastError();
    if (le != hipSuccess) fprintf(stderr, "kernel_launch: launch failed: %s\n", hipGetErrorName(le));
}
```

```cpp
#include <hip/hip_runtime.h>
#include <cstdio>
#include <cstdint>

constexpr int DM = 2048, NB = 4, SEQ = 4096, CTXL = 256, DEPTH = 2;
constexpr int NLAT = NB * SEQ, NCTX = NB * CTXL, NTOK = NLAT + NCTX;
constexpr int NCT = NTOK / 64;
constexpr int IN_W = 4624, PW = 4864;
constexpr int PC_Q = 0, PC_K = 1024, PC_V = 1280, PC_DQ = 1536, PC_DK = 2048, PC_DV = 2560, PC_DG = 3072, PC_LX = 3584, PC_LY = 4096, PC_BETA = 4608, PC_DEC = 4616;
constexpr int NEXP = 32, TOPK = 4, DEXP = 1024;
constexpr int MOE_ROWS = 304 * 256;
constexpr float EPS = 1e-6f;
#ifndef MK_STAGE
#define MK_STAGE 99
#endif
#ifndef FP8_INPROJ
#define FP8_INPROJ 0
#endif
#ifndef FP8_OUTPROJ
#define FP8_OUTPROJ 0
#endif
#ifndef SCAN_SPLIT_ORDER
#define SCAN_SPLIT_ORDER 1
#endif
#ifndef X_BF16
#define X_BF16 1
#endif
namespace pg8 {
#define PG8_LAS __attribute__((address_space(3)))
typedef unsigned short bf16_t;
typedef short bf16x8 __attribute__((ext_vector_type(8)));
typedef float f32x4 __attribute__((ext_vector_type(4)));
typedef unsigned u32x4 __attribute__((ext_vector_type(4)));
typedef float f32x2 __attribute__((ext_vector_type(2)));
constexpr int BM = 256, BK = 64, HALF = 128, HTB = HALF * BK * 2  , STAGE_BYTES = 8 * HTB, NXCD = 8, WGM = 8;

__host__ __device__ __forceinline__ int lds_byte(int r, int c) { const int st = (r >> 4) * 2 + (c >> 5), rr = r & 15, cc = c & 31, ob = rr * 64 + cc * 2; return st * 1024 + (ob ^ (((ob >> 9) & 1) << 5)); }
__host__ __device__ __forceinline__ void stage_rc(int b, int& R, int& C) { const int st = b / 1024, sb = b % 1024, swz = sb ^ (((sb >> 9) & 1) << 5); R = (st >> 1) * 16 + swz / 64; C = (st & 1) * 32 + (swz % 64) / 2; }
__host__ __device__ __forceinline__ int perm32(int rho) { const int n = rho >> 4, i = rho & 15; return 8 * (i >> 2) + 4 * n + (i & 3); }

struct Unit { int pm, pn, e; };
typedef int v4i_t __attribute__((ext_vector_type(4)));
typedef int v8i_t __attribute__((ext_vector_type(8)));
struct Gemm { const bf16_t* A; const bf16_t* Bt; int M, N, K; int bscale = 0x7F7F7F7F; };

struct StaticOrder {
    static constexpr bool GATHER = false; const int* row_tab = nullptr;
    int nM, nN, nwg, G, c; const char* A; const char* Bt; size_t tstep;
    __device__ void init(const Gemm& g, int G_, int c_) { nM = g.M / BM; nN = g.N / BM; nwg = nM * nN; G = G_; c = c_; A = (const char*)g.A; Bt = (const char*)g.Bt; tstep = (size_t)BM * g.K * 2; }
    __device__ bool next(int i, Unit& u) const {
        const long L = (long)i * G + c; if (L >= nwg) return false;
        int wgid = (int)L; { const int q = nwg / NXCD, r = nwg % NXCD, xcd = wgid % NXCD, off = wgid / NXCD; wgid = (xcd < r ? xcd * (q + 1) : r * (q + 1) + (xcd - r) * q) + off; }
        const int nig = WGM * nN, gid = wgid / nig, fm = gid * WGM, gsz = (nM - fm) < WGM ? (nM - fm) : WGM;
        u.pm = fm + ((wgid % nig) % gsz); u.pn = (wgid % nig) / gsz; u.e = 0; return true;
    }
    __device__ __forceinline__ const char* a_ptr(const Unit& u) const { return A + (size_t)u.pm * tstep; }
    __device__ __forceinline__ const char* b_ptr(const Unit& u) const { return Bt + (size_t)u.pn * tstep; }
    __device__ __forceinline__ void a_ready(const Unit&) const {}
    __device__ __forceinline__ void done(const Unit&) const {}
};
struct StaticOrderG : StaticOrder {
    static constexpr bool GATHER = true;
    __device__ __forceinline__ const char* a_ptr(const Unit&) const { return A; }
};
__device__ __forceinline__ unsigned cvt_pk_bf16(float lo, float hi) { unsigned r; asm volatile("v_cvt_pk_bf16_f32 %0, %1, %2" : "=v"(r) : "v"(lo), "v"(hi)); return r; }
struct EpiBf16Plain {
    static constexpr bool PERM = true, AFTER_DRAIN = false;
    bf16_t* O; int ldc;
    __device__ __forceinline__ void operator()(const f32x4 (&acc)[2][2][4][2], const Unit& u, int wr, int wc, int fr, int fq) const {
        const int row0 = u.pm * BM + wr * 64 + fr, col0 = u.pn * BM + wc * 32 + 8 * fq;
#pragma unroll
        for (int ai = 0; ai < 2; ++ai)
#pragma unroll
            for (int m = 0; m < 4; ++m) { bf16_t* rowp = O + (size_t)(row0 + ai * HALF + m * 16) * ldc + col0;
#pragma unroll
                for (int bj = 0; bj < 2; ++bj) { const f32x4 v0 = acc[ai][bj][m][0], v1 = acc[ai][bj][m][1];
                    u32x4 w; w.x = cvt_pk_bf16(v0[0], v0[1]); w.y = cvt_pk_bf16(v0[2], v0[3]); w.z = cvt_pk_bf16(v1[0], v1[1]); w.w = cvt_pk_bf16(v1[2], v1[3]);
                    *(u32x4*)(rowp + bj * HALF) = w; } }
    }
};
struct EpiResGate {
    static constexpr bool PERM = false, AFTER_DRAIN = false;
    const float* base_lat; const float* base_ctx; float* out; const float* modg;
    __device__ __forceinline__ void operator()(const f32x4 (&acc)[2][2][4][2], const Unit& u, int wr, int wc, int fr, int fq) const {
        const int r = u.pm < 64 ? (u.pm >> 4) : 4; const int col0 = u.pn * BM + wc * 32 + 4 * fq;
        const float* g = modg + (size_t)r * 12288 + col0;
        f32x4 gv[2][2];
#pragma unroll
        for (int bj = 0; bj < 2; ++bj)
#pragma unroll
            for (int n = 0; n < 2; ++n) gv[bj][n] = *(const f32x4*)(g + bj * HALF + n * 16);
#pragma unroll
        for (int ai = 0; ai < 2; ++ai)
#pragma unroll
            for (int m = 0; m < 4; ++m) { const int row = u.pm * BM + ai * HALF + wr * 64 + m * 16 + fr;
                const float* bp = (row < 16384 ? base_lat + (size_t)row * 2048 : base_ctx + (size_t)(row - 16384) * 2048) + col0; float* op = out + (size_t)row * 2048 + col0;
#pragma unroll
                for (int bj = 0; bj < 2; ++bj)
#pragma unroll
                    for (int n = 0; n < 2; ++n) { const f32x4 b = *(const f32x4*)(bp + bj * HALF + n * 16); *(f32x4*)(op + bj * HALF + n * 16) = b + gv[bj][n] * acc[ai][bj][m][n]; }
                asm volatile("" ::: "memory"); }
    }
};
struct EpiResGateB {
    static constexpr bool PERM = true, AFTER_DRAIN = false;
    const float* base_lat; const float* base_ctx; const bf16_t* xb_in; bf16_t* xb_out; const float* modg; int f32base;
    __device__ __forceinline__ void operator()(const f32x4 (&acc)[2][2][4][2], const Unit& u, int wr, int wc, int fr, int fq) const {
        const int r = u.pm < 64 ? (u.pm >> 4) : 4; const int col0 = u.pn * BM + wc * 32 + 8 * fq;
        const float* g = modg + (size_t)r * 12288 + col0;
        f32x4 gv[2][2];
#pragma unroll
        for (int bj = 0; bj < 2; ++bj)
#pragma unroll
            for (int n = 0; n < 2; ++n) gv[bj][n] = *(const f32x4*)(g + bj * HALF + 4 * n);
#pragma unroll
        for (int ai = 0; ai < 2; ++ai)
#pragma unroll
            for (int m = 0; m < 4; ++m) { const int row = u.pm * BM + ai * HALF + wr * 64 + m * 16 + fr;
#pragma unroll
                for (int bj = 0; bj < 2; ++bj) { f32x4 b0, b1;
                    if (f32base) { const float* bp = (row < 16384 ? base_lat + (size_t)row * 2048 : base_ctx + (size_t)(row - 16384) * 2048) + col0 + bj * HALF; b0 = *(const f32x4*)bp; b1 = *(const f32x4*)(bp + 4); }
                    else { const u32x4 w = *(const u32x4*)(xb_in + (size_t)row * 2048 + col0 + bj * HALF);
                        b0 = (f32x4){__builtin_bit_cast(float, w.x << 16), __builtin_bit_cast(float, w.x & 0xffff0000u), __builtin_bit_cast(float, w.y << 16), __builtin_bit_cast(float, w.y & 0xffff0000u)};
                        b1 = (f32x4){__builtin_bit_cast(float, w.z << 16), __builtin_bit_cast(float, w.z & 0xffff0000u), __builtin_bit_cast(float, w.w << 16), __builtin_bit_cast(float, w.w & 0xffff0000u)}; }
                    const f32x4 v0 = b0 + gv[bj][0] * acc[ai][bj][m][0], v1 = b1 + gv[bj][1] * acc[ai][bj][m][1];
                    u32x4 o; o.x = cvt_pk_bf16(v0[0], v0[1]); o.y = cvt_pk_bf16(v0[2], v0[3]); o.z = cvt_pk_bf16(v1[0], v1[1]); o.w = cvt_pk_bf16(v1[2], v1[3]);
                    *(u32x4*)(xb_out + (size_t)row * 2048 + col0 + bj * HALF) = o; }
                asm volatile("" ::: "memory"); }
    }
};
struct EpiSwiglu {
    static constexpr bool PERM = true, AFTER_DRAIN = false;
    bf16_t* O; const float* bgu;
    __device__ __forceinline__ void operator()(const f32x4 (&acc)[2][2][4][2], const Unit& u, int wr, int wc, int fr, int fq) const {
        const int row0 = u.pm * BM + wr * 64 + fr, cc0 = wc * 32 + 8 * fq;
        const float* bg = bgu + (size_t)u.e * 2048 + u.pn * 128 + cc0;
        f32x4 bglu[2], blin[2];
#pragma unroll
        for (int n = 0; n < 2; ++n) { bglu[n] = *(const f32x4*)(bg + 4 * n); blin[n] = *(const f32x4*)(bg + 1024 + 4 * n); }
#pragma unroll
        for (int ai = 0; ai < 2; ++ai)
#pragma unroll
            for (int m = 0; m < 4; ++m) { bf16_t* rowp = O + (size_t)(row0 + ai * HALF + m * 16) * 1024 + u.pn * 128 + cc0;
                float r[8];
#pragma unroll
                for (int n = 0; n < 2; ++n) { const f32x4 g = acc[ai][0][m][n] + bglu[n], l = acc[ai][1][m][n] + blin[n];
#pragma unroll
                    for (int i = 0; i < 4; ++i) { const float gg = fminf(g[i], 7.0f); const float ll = fminf(fmaxf(l[i], -7.0f), 7.0f);
                        r[4 * n + i] = (ll + 1.0f) * gg * __builtin_amdgcn_rcpf(1.0f + __builtin_amdgcn_exp2f(-1.702f * 1.4426950408889634f * gg)); } }
                u32x4 w; w.x = cvt_pk_bf16(r[0], r[1]); w.y = cvt_pk_bf16(r[2], r[3]); w.z = cvt_pk_bf16(r[4], r[5]); w.w = cvt_pk_bf16(r[6], r[7]);
                *(u32x4*)rowp = w; }
    }
};
struct EpiSwiglu8 {
    static constexpr bool PERM = true, AFTER_DRAIN = false;
    unsigned char* O; const float* bgu;
    __device__ __forceinline__ void operator()(const f32x4 (&acc)[2][2][4][2], const Unit& u, int wr, int wc, int fr, int fq) const {
        const int row0 = u.pm * BM + wr * 64 + fr, cc0 = wc * 32 + 8 * fq;
        const float* bg = bgu + (size_t)u.e * 2048 + u.pn * 128 + cc0;
        f32x4 bglu[2], blin[2];
#pragma unroll
        for (int n = 0; n < 2; ++n) { bglu[n] = *(const f32x4*)(bg + 4 * n); blin[n] = *(const f32x4*)(bg + 1024 + 4 * n); }
#pragma unroll
        for (int ai = 0; ai < 2; ++ai)
#pragma unroll
            for (int m = 0; m < 4; ++m) { unsigned char* rowp = O + (size_t)(row0 + ai * HALF + m * 16) * 1024 + u.pn * 128 + cc0;
                float r[8];
#pragma unroll
                for (int n = 0; n < 2; ++n) { const f32x4 g = acc[ai][0][m][n] + bglu[n], l = acc[ai][1][m][n] + blin[n];
#pragma unroll
                    for (int i = 0; i < 4; ++i) { const float gg = fminf(g[i], 7.0f); const float ll = fminf(fmaxf(l[i], -7.0f), 7.0f);
                        r[4 * n + i] = (ll + 1.0f) * gg * __builtin_amdgcn_rcpf(1.0f + __builtin_amdgcn_exp2f(-1.702f * 1.4426950408889634f * gg)); } }
                int w0 = 0, w1 = 0; w0 = __builtin_amdgcn_cvt_pk_fp8_f32(r[0], r[1], w0, false); w0 = __builtin_amdgcn_cvt_pk_fp8_f32(r[2], r[3], w0, true); w1 = __builtin_amdgcn_cvt_pk_fp8_f32(r[4], r[5], w1, false); w1 = __builtin_amdgcn_cvt_pk_fp8_f32(r[6], r[7], w1, true);
                typedef unsigned u32x2 __attribute__((ext_vector_type(2))); *(u32x2*)rowp = (u32x2){(unsigned)w0, (unsigned)w1}; }
    }
};
struct EpiDown {
    static constexpr bool PERM = true, AFTER_DRAIN = false;
    bf16_t* O; const float* bdn; const float* rowg;
    __device__ __forceinline__ void operator()(const f32x4 (&acc)[2][2][4][2], const Unit& u, int wr, int wc, int fr, int fq) const {
        const int row0 = u.pm * BM + wr * 64 + fr, col0 = u.pn * BM + wc * 32 + 8 * fq;
        const float* bb = bdn + (size_t)u.e * 2048 + col0;
        float gt[2][4];
#pragma unroll
        for (int ai = 0; ai < 2; ++ai)
#pragma unroll
            for (int m = 0; m < 4; ++m) gt[ai][m] = rowg[row0 + ai * HALF + m * 16];
#pragma unroll
        for (int bj = 0; bj < 2; ++bj) { const f32x4 b0 = *(const f32x4*)(bb + bj * HALF), b1 = *(const f32x4*)(bb + bj * HALF + 4);
#pragma unroll
            for (int ai = 0; ai < 2; ++ai)
#pragma unroll
                for (int m = 0; m < 4; ++m) { const int row = row0 + ai * HALF + m * 16; const f32x4 v0 = (acc[ai][bj][m][0] + b0) * gt[ai][m], v1 = (acc[ai][bj][m][1] + b1) * gt[ai][m];
                    u32x4 w; w.x = cvt_pk_bf16(v0[0], v0[1]); w.y = cvt_pk_bf16(v0[2], v0[3]); w.z = cvt_pk_bf16(v1[0], v1[1]); w.w = cvt_pk_bf16(v1[2], v1[3]);
                    *(u32x4*)(O + (size_t)row * 2048 + col0 + bj * HALF) = w; } }
    }
};
template <bool GATHER_> struct MoeOrderT {
    static constexpr bool GATHER = GATHER_;
    int c, nblk; const char* A; const char* Bt; size_t a_tstep, b_estep, b_tstep; const PG8_LAS int* blk_end; const int* row_tab;
    __device__ __forceinline__ bool next(int i, Unit& u) const {
#if defined(MOE_MAP) && MOE_MAP == 1
        const int L = i * 256 + c, rb = L >> 3, j = (L & 7);
#elif defined(MOE_MAP) && MOE_MAP == 2
        const int x = c & 7, jj = c >> 3, gi = i * 8 + x, rb = 8 * (gi >> 1) + (jj >> 2), j = (jj & 3) + 4 * (gi & 1);
#else
        const int x = c & 7, j = c >> 3, gi = i * 8 + x, rb = 4 * gi + (j >> 3);
#endif
        if (rb >= nblk) return false;
        int e = 0;
        for (int k = 0; k < 31; ++k) e += (rb >= blk_end[k]) ? 1 : 0;
        u.pm = rb; u.pn = j & 7; u.e = __builtin_amdgcn_readfirstlane(e); return true;
    }
    __device__ __forceinline__ const char* a_ptr(const Unit& u) const { return GATHER ? A : A + (size_t)u.pm * a_tstep; }
    __device__ __forceinline__ const char* b_ptr(const Unit& u) const { return Bt + (size_t)u.e * b_estep + (size_t)u.pn * b_tstep; }
    __device__ __forceinline__ void a_ready(const Unit&) const {}
    __device__ __forceinline__ void done(const Unit&) const {}
};
typedef MoeOrderT<false> MoeOrder;
typedef MoeOrderT<true> MoeOrderG;
template <class Epi, class Sched, bool ALIGN_EPI = false, bool SP2 = false, bool FP8 = false>
__device__ __forceinline__ void gemm_phase(PG8_LAS unsigned char* lds, const Gemm g, const Sched& S, const Epi& E) {
    int tid = threadIdx.x; asm volatile("" : "+v"(tid));
    const int wid = __builtin_amdgcn_readfirstlane(tid >> 6), lane = tid & 63, wr = wid >> 2, wc = wid & 3, fr = lane & 15, fq = lane >> 4;
    const int K = g.K, nt = K / BK;
    unsigned voffA[2], voffB[2];
#pragma unroll
    for (int i = 0; i < 2; ++i) { int R, C; stage_rc(tid * 16 + i * 8192, R, C); const int Rb = Epi::PERM ? ((R & ~31) + perm32(R & 31)) : R;
        voffA[i] = (unsigned)(R * K + C) * 2u; voffB[i] = (unsigned)(Rb * K + C) * 2u; }
    unsigned gc0[2] = {0u, 0u}, gc1[2] = {0u, 0u}; int gR = 0, gC = 0;
    if constexpr (Sched::GATHER) { stage_rc(tid * 16, gR, gC); }
#define PG8_GLOAD(dst0, dst1, u) do { const int* _rt = S.row_tab + (size_t)(u).pm * BM + gR; \
        dst0[0] = (unsigned)_rt[0] * (unsigned)(K * 2) + (unsigned)(gC * 2); dst0[1] = (unsigned)_rt[64] * (unsigned)(K * 2) + (unsigned)(gC * 2); \
        dst1[0] = (unsigned)_rt[128] * (unsigned)(K * 2) + (unsigned)(gC * 2); dst1[1] = (unsigned)_rt[192] * (unsigned)(K * 2) + (unsigned)(gC * 2); } while (0)
    const size_t kstep = (size_t)(BK * 2);
    const size_t hstep = (size_t)HALF * K * 2;
    const size_t tstep = 2 * hstep;
    const unsigned ldsw = (unsigned)wid * 1024u;
    const int aoff = lds_byte(wr * 64 + fr, fq * 8); int boff = lds_byte(wc * 32 + fr, fq * 8) + 4 * HTB;
    asm volatile("" : "+v"(boff));
#define PG8_SA(b, h) (((b) * 2 + (h)) * HTB)
#define PG8_SB(b, h) ((4 + (b) * 2 + (h)) * HTB)
#define PG8_SBR(b, h) (((b) * 2 + (h)) * HTB)
#define PG8_STAGE(bufoff, gbase, voff) do { _Pragma("unroll") for (int _i = 0; _i < 2; ++_i) \
        __builtin_amdgcn_global_load_lds((const unsigned*)((const char*)(gbase) + (voff)[_i]), (PG8_LAS unsigned*)(lds + (bufoff) + ldsw + _i * 8192), 16, 0, 0); } while (0)
#define PG8_LD16(off) (*(const PG8_LAS v4i_t*)(lds + (off)))
#define PG8_LDA(dst, b, h) do { if constexpr (FP8) { _Pragma("unroll") for (int m = 0; m < 4; ++m) dst##8[m] = __builtin_shufflevector(PG8_LD16(PG8_SA(b, h) + aoff + m * 2048), PG8_LD16(PG8_SA(b, h) + aoff + m * 2048 + 1024), 0, 1, 2, 3, 4, 5, 6, 7); } \
        else { _Pragma("unroll") for (int m = 0; m < 4; ++m) _Pragma("unroll") for (int k = 0; k < 2; ++k) dst[m][k] = *(const PG8_LAS bf16x8*)(lds + PG8_SA(b, h) + aoff + m * 2048 + k * 1024); } } while (0)
#define PG8_LDB(dst, b, h) do { if constexpr (FP8) { _Pragma("unroll") for (int n = 0; n < 2; ++n) dst##8[n] = __builtin_shufflevector(PG8_LD16(PG8_SBR(b, h) + boff + n * 2048), PG8_LD16(PG8_SBR(b, h) + boff + n * 2048 + 1024), 0, 1, 2, 3, 4, 5, 6, 7); } \
        else { _Pragma("unroll") for (int n = 0; n < 2; ++n) _Pragma("unroll") for (int k = 0; k < 2; ++k) dst[n][k] = *(const PG8_LAS bf16x8*)(lds + PG8_SBR(b, h) + boff + n * 2048 + k * 1024); } } while (0)
#define PG8_MMA(ai, bj, At, Bt) do { __builtin_amdgcn_s_setprio(1); \
        if constexpr (FP8) { _Pragma("unroll") for (int m = 0; m < 4; ++m) _Pragma("unroll") for (int n = 0; n < 2; ++n) \
            acc[ai][bj][m][n] = __builtin_amdgcn_mfma_scale_f32_16x16x128_f8f6f4(Bt##8[n], At##8[m], acc[ai][bj][m][n], 0, 0, 0, g.bscale, 0, g.bscale); }     \
        else { _Pragma("unroll") for (int m = 0; m < 4; ++m) _Pragma("unroll") for (int n = 0; n < 2; ++n) _Pragma("unroll") for (int k = 0; k < 2; ++k) \
            acc[ai][bj][m][n] = __builtin_amdgcn_mfma_f32_16x16x32_bf16(Bt[n][k], At[m][k], acc[ai][bj][m][n], 0, 0, 0); } \
        __builtin_amdgcn_s_setprio(0); } while (0)
#define PG8_WAIT_V(n) asm volatile("s_waitcnt vmcnt(" #n ")" ::: "memory")
#define PG8_WAIT_L(n) asm volatile("s_waitcnt lgkmcnt(" #n ")" ::: "memory")
#define PG8_BAR __builtin_amdgcn_s_barrier()
#define PG8_SCHED __builtin_amdgcn_sched_barrier(0)
    Unit cur, nxt; int ui = 0;
    if (!S.next(0, cur)) return;
    f32x4 acc[2][2][4][2];
#pragma unroll
    for (int a = 0; a < 2; ++a)
#pragma unroll
        for (int b = 0; b < 2; ++b)
#pragma unroll
            for (int m = 0; m < 4; ++m)
#pragma unroll
                for (int n = 0; n < 2; ++n) acc[a][b][m][n] = (f32x4){0.f, 0.f, 0.f, 0.f};
    bf16x8 At[4][2], B0[2][2], B1[2][2]; v8i_t At8[4], B08[2], B18[2];
    const char* cA = S.a_ptr(cur); const char* cB = S.b_ptr(cur);
    S.a_ready(cur);
    if constexpr (SP2) {
        if constexpr (Sched::GATHER) { PG8_GLOAD(gc0, gc1, cur);
        PG8_STAGE(PG8_SB(0, 0), cB, voffB); PG8_STAGE(PG8_SB(0, 1), cB + hstep, voffB); PG8_STAGE(PG8_SA(0, 0), cA, gc0); PG8_STAGE(PG8_SA(0, 1), cA, gc1);
        if (wr == 1) PG8_BAR;
        PG8_WAIT_V(2); PG8_BAR;
        PG8_STAGE(PG8_SB(1, 0), cB + kstep, voffB); PG8_STAGE(PG8_SA(1, 0), cA + kstep, gc0); PG8_STAGE(PG8_SB(1, 1), cB + hstep + kstep, voffB);
        } else {
        PG8_STAGE(PG8_SB(0, 0), cB, voffB); PG8_STAGE(PG8_SB(0, 1), cB + hstep, voffB); PG8_STAGE(PG8_SA(0, 0), cA, voffA); PG8_STAGE(PG8_SA(0, 1), cA + hstep, voffA);
        if (wr == 1) PG8_BAR;
        PG8_WAIT_V(2); PG8_BAR;
        PG8_STAGE(PG8_SB(1, 0), cB + kstep, voffB); PG8_STAGE(PG8_SA(1, 0), cA + kstep, voffA); PG8_STAGE(PG8_SB(1, 1), cB + hstep + kstep, voffB);
        }
        PG8_WAIT_V(6); PG8_BAR;
    } else {
        PG8_STAGE(PG8_SB(0, 0), cB, voffB); PG8_STAGE(PG8_SA(0, 0), cA, voffA); PG8_STAGE(PG8_SB(0, 1), cB + hstep, voffB); PG8_STAGE(PG8_SA(0, 1), cA + hstep, voffA);
        if (wr == 1) PG8_BAR;
        PG8_WAIT_V(4); PG8_BAR;
        PG8_STAGE(PG8_SB(1, 0), cB + kstep, voffB); PG8_STAGE(PG8_SA(1, 0), cA + kstep, voffA); PG8_STAGE(PG8_SB(1, 1), cB + hstep + kstep, voffB);
        PG8_WAIT_V(6); PG8_BAR;
    }
    for (;;) {
        const bool has_next = S.next(ui + 1, nxt);
        const char* nA = has_next ? S.a_ptr(nxt) : cA; const char* nB = has_next ? S.b_ptr(nxt) : cB;
#pragma unroll 1
        for (int t = 0; t < nt; t += 2) {
            const bool last = (t == nt - 2);
            const char* a1 = cA + (size_t)(t + 1) * kstep;
            const char* a2 = last ? nA : cA + (size_t)(t + 2) * kstep; const char* b2 = last ? nB : cB + (size_t)(t + 2) * kstep;
            const char* a3 = a2 + kstep; const char* b3 = b2 + kstep;
            if (last && has_next) S.a_ready(nxt);

            if constexpr (SP2) {
            PG8_LDB(B0, 0, 0); PG8_LDB(B1, 0, 1); PG8_SCHED; PG8_LDA(At, 0, 0); if constexpr (Sched::GATHER) PG8_STAGE(PG8_SA(1, 1), a1, gc1); else PG8_STAGE(PG8_SA(1, 1), a1 + hstep, voffA);
            if constexpr (Sched::GATHER) { if (last && has_next) PG8_GLOAD(gc0, gc1, nxt); }
            PG8_WAIT_V(8); PG8_WAIT_L(0); PG8_BAR; PG8_MMA(0, 0, At, B0); PG8_MMA(0, 1, At, B1); PG8_BAR; PG8_SCHED;
            PG8_LDA(At, 0, 1); PG8_STAGE(PG8_SB(0, 0), b2, voffB); PG8_STAGE(PG8_SB(0, 1), b2 + hstep, voffB); if constexpr (Sched::GATHER) PG8_STAGE(PG8_SA(0, 0), a2, gc0); else PG8_STAGE(PG8_SA(0, 0), a2, voffA);
            PG8_WAIT_V(8); PG8_WAIT_L(0); PG8_BAR; PG8_MMA(1, 0, At, B0); PG8_MMA(1, 1, At, B1); PG8_BAR; PG8_SCHED;
            PG8_LDB(B0, 1, 0); PG8_LDB(B1, 1, 1); PG8_SCHED; PG8_LDA(At, 1, 0); if constexpr (Sched::GATHER) PG8_STAGE(PG8_SA(0, 1), a2, gc1); else PG8_STAGE(PG8_SA(0, 1), a2 + hstep, voffA);
            PG8_WAIT_V(8); PG8_WAIT_L(0); PG8_BAR; PG8_MMA(0, 0, At, B0); PG8_MMA(0, 1, At, B1); PG8_BAR; PG8_SCHED;
            PG8_LDA(At, 1, 1); PG8_STAGE(PG8_SB(1, 0), b3, voffB); PG8_STAGE(PG8_SB(1, 1), b3 + hstep, voffB); if constexpr (Sched::GATHER) PG8_STAGE(PG8_SA(1, 0), a3, gc0); else PG8_STAGE(PG8_SA(1, 0), a3, voffA);
            PG8_WAIT_V(8); PG8_WAIT_L(0); PG8_BAR; PG8_MMA(1, 0, At, B0); PG8_MMA(1, 1, At, B1); PG8_BAR; PG8_SCHED;
            } else {
            PG8_LDB(B0, 0, 0); PG8_SCHED; PG8_LDA(At, 0, 0); PG8_STAGE(PG8_SA(1, 1), a1 + hstep, voffA);
            PG8_WAIT_L(8); PG8_BAR; PG8_WAIT_L(0); PG8_MMA(0, 0, At, B0); PG8_BAR; PG8_SCHED;
            PG8_LDB(B1, 0, 1); PG8_STAGE(PG8_SB(0, 0), b2, voffB);
            PG8_BAR; PG8_WAIT_L(0); PG8_MMA(0, 1, At, B1); PG8_BAR;
            PG8_LDA(At, 0, 1); PG8_STAGE(PG8_SA(0, 0), a2, voffA);
            PG8_BAR; PG8_WAIT_L(0); PG8_MMA(1, 0, At, B0); PG8_BAR; PG8_SCHED;
            PG8_STAGE(PG8_SB(0, 1), b2 + hstep, voffB);
            PG8_WAIT_V(6); PG8_BAR; PG8_MMA(1, 1, At, B1); PG8_BAR;
            PG8_LDB(B0, 1, 0); PG8_SCHED; PG8_LDA(At, 1, 0); PG8_STAGE(PG8_SA(0, 1), a2 + hstep, voffA);
            PG8_WAIT_L(8); PG8_BAR; PG8_WAIT_L(0); PG8_MMA(0, 0, At, B0); PG8_BAR; PG8_SCHED;
            PG8_LDB(B1, 1, 1); PG8_STAGE(PG8_SB(1, 0), b3, voffB);
            PG8_BAR; PG8_WAIT_L(0); PG8_MMA(0, 1, At, B1); PG8_BAR;
            PG8_LDA(At, 1, 1); PG8_STAGE(PG8_SA(1, 0), a3, voffA);
            PG8_BAR; PG8_WAIT_L(0); PG8_MMA(1, 0, At, B0); PG8_BAR; PG8_SCHED;
            PG8_STAGE(PG8_SB(1, 1), b3 + hstep, voffB);
            PG8_WAIT_V(6); PG8_BAR; PG8_MMA(1, 1, At, B1); PG8_BAR;
            }
        }
        if constexpr (ALIGN_EPI) { if (wr == 0) PG8_BAR; }
        if constexpr (!Epi::AFTER_DRAIN) { int fr_e = fr, fq_e = fq; asm volatile("" : "+v"(fr_e), "+v"(fq_e));
            E(acc, cur, wr, wc, fr_e, fq_e); S.done(cur); }
        if (!has_next) break;
#pragma unroll
        for (int a = 0; a < 2; ++a)
#pragma unroll
            for (int b = 0; b < 2; ++b)
#pragma unroll
                for (int m = 0; m < 4; ++m)
#pragma unroll
                    for (int n = 0; n < 2; ++n) acc[a][b][m][n] = (f32x4){0.f, 0.f, 0.f, 0.f};
        cur = nxt; cA = nA; cB = nB; ++ui;
        if constexpr (ALIGN_EPI) { if (wr == 1) PG8_BAR; }
    }
    PG8_WAIT_V(0);
    if constexpr (!ALIGN_EPI) { if (wr == 0) PG8_BAR; }
    PG8_BAR;
    if constexpr (Epi::AFTER_DRAIN) { E.fused(acc, cur, wr, wc, fr, fq, lds, wid, lane); S.done(cur); }
#undef PG8_GLOAD
#undef PG8_SA
#undef PG8_SB
#undef PG8_SBR
#undef PG8_STAGE
#undef PG8_LDA
#undef PG8_LDB
#undef PG8_MMA
#undef PG8_LD16
#undef PG8_WAIT_V
#undef PG8_WAIT_L
#undef PG8_BAR
#undef PG8_SCHED
}
}

constexpr size_t MiB = 1u << 20;
constexpr size_t WS_CTL = 0, CTL_ZERO_BYTES = 1 * MiB;
constexpr size_t WS_MOD  = 1 * MiB;
constexpr size_t WS_WRT  = 2 * MiB;
constexpr size_t WS_MOEI = 3 * MiB;
constexpr size_t WS_IDT  = WS_MOEI + 5 * 512 * 1024;
constexpr size_t WS_LRC  = 6 * MiB;
constexpr size_t WS_DNS  = 12 * MiB;
constexpr size_t WS_WIN  = 16 * MiB;
constexpr size_t WS_WOUT = 56 * MiB;
constexpr size_t WS_WGU  = 72 * MiB;
constexpr size_t WS_WDN  = 584 * MiB;
constexpr size_t WS_X    = 840 * MiB;
constexpr size_t WS_H    = 976 * MiB;
constexpr size_t WS_P    = 1044 * MiB;
constexpr size_t WS_CC   = 1206 * MiB;
constexpr size_t WS_VT   = 1274 * MiB;
constexpr size_t WS_VTC  = WS_VT + 8 * MiB;
constexpr size_t WS_DNT  = 1284 * MiB;
constexpr size_t DNT_BYTES = 90112;
constexpr size_t WS_DNO  = 1472 * MiB;
constexpr size_t WS_LRH  = 1540 * MiB;
constexpr size_t WS_LRA  = 1608 * MiB;
constexpr size_t WS_XS   = 1676 * MiB;
constexpr size_t WS_ACT  = 1980 * MiB;
constexpr size_t WS_YS   = 2132 * MiB;
constexpr size_t WS_END  = 2436 * MiB;
constexpr int CW_TMO = 0;
constexpr int CW_BAR = 4096;
constexpr int CW_CNT = 8192;
constexpr int CW_ATQ = 12288;

constexpr int RING_OFF = 0, RING_BYTES = 131072;
constexpr int LDSCTL_OFF = RING_BYTES, MISC_OFF = LDSCTL_OFF + 320;
constexpr int LDS_X_OFF = RING_BYTES + 1024;
constexpr int LDS_BYTES = 147456;
constexpr int NWAVES = 8, NTHREADS = 512;

#define GAS __attribute__((address_space(1)))
#define LAS __attribute__((address_space(3)))
typedef unsigned short bf16;
typedef unsigned v4u __attribute__((ext_vector_type(4)));
typedef unsigned v2u __attribute__((ext_vector_type(2)));
typedef float f32x4 __attribute__((ext_vector_type(4)));
typedef float f32x16 __attribute__((ext_vector_type(16)));
typedef short bf16x8 __attribute__((ext_vector_type(8)));
typedef short bf16x4 __attribute__((ext_vector_type(4)));
typedef GAS unsigned gu32;
#define RLX_AGENT __ATOMIC_RELAXED, __HIP_MEMORY_SCOPE_AGENT
#define LDS_WAIT() asm volatile("s_waitcnt lgkmcnt(0)" ::: "memory")
#define VM_WAIT() asm volatile("s_waitcnt vmcnt(0)" ::: "memory")
#define LDS_BARRIER() asm volatile("s_waitcnt lgkmcnt(0)\n\ts_barrier" ::: "memory")
typedef __bf16 bf16x2_t __attribute__((ext_vector_type(2)));
typedef float f32x2_t __attribute__((ext_vector_type(2)));
__device__ __forceinline__ unsigned pk2(float lo, float hi) { const f32x2_t v = {lo, hi}; const bf16x2_t b = __builtin_convertvector(v, bf16x2_t); return __builtin_bit_cast(unsigned, b); }
__device__ __forceinline__ unsigned f2bf(float f) { return pk2(f, 0.f) & 0xffffu; }
__device__ __forceinline__ unsigned pk4_fp8(float a, float b, float c, float d) { int x = 0; x = __builtin_amdgcn_cvt_pk_fp8_f32(a, b, x, false); x = __builtin_amdgcn_cvt_pk_fp8_f32(c, d, x, true); return (unsigned)x; }
__device__ __forceinline__ float bf2f(unsigned short b) { return __builtin_bit_cast(float, (unsigned)b << 16); }
__device__ __forceinline__ float bflo(unsigned w) { return __builtin_bit_cast(float, w << 16); }
__device__ __forceinline__ float bfhi(unsigned w) { return __builtin_bit_cast(float, w & 0xffff0000u); }
template <int CTRL> __device__ __forceinline__ float dpp_mov(float v) { return __builtin_bit_cast(float, __builtin_amdgcn_update_dpp(0, __builtin_bit_cast(int, v), CTRL, 0xF, 0xF, false)); }
__device__ __forceinline__ float wave_sum(float v) {
    v += dpp_mov<0xB1>(v); v += dpp_mov<0x4E>(v); v += dpp_mov<0x141>(v); v += dpp_mov<0x140>(v);
    const int iv = __builtin_bit_cast(int, v);
    const float r0 = __builtin_bit_cast(float, __builtin_amdgcn_readlane(iv, 0)), r1 = __builtin_bit_cast(float, __builtin_amdgcn_readlane(iv, 16)), r2 = __builtin_bit_cast(float, __builtin_amdgcn_readlane(iv, 32)), r3 = __builtin_bit_cast(float, __builtin_amdgcn_readlane(iv, 48));
    return (r0 + r1) + (r2 + r3);
}
__device__ __forceinline__ float sigmoidf_(float x) { return __builtin_amdgcn_rcpf(1.0f + __builtin_amdgcn_exp2f(-1.4426950408889634f * x)); }
__device__ __forceinline__ float siluf_(float x) { return x * sigmoidf_(x); }
__device__ __forceinline__ float softplusf_(float x) { return x > 20.f ? x : log1pf(__expf(x)); }

#define XB_TMO      128
#define XB_XCNT(j)  (256  + 64 * (j))
#define XB_XSUB(j)  (1280 + 64 * (j))
#define XB_XGEN(j)  (2304 + 64 * (j))
#define XB_TOP      3328
#define XB_TOPGEN   3392
#define XCD_BAR_WORDS 3456
#define XB_SPIN_CAP (1u << 18)

__device__ __forceinline__ unsigned xb_ld(unsigned* p)              { return __hip_atomic_load(p, __ATOMIC_RELAXED, __HIP_MEMORY_SCOPE_AGENT); }
__device__ __forceinline__ unsigned xb_add(unsigned* p, unsigned v) { return __hip_atomic_fetch_add(p, v, __ATOMIC_RELAXED, __HIP_MEMORY_SCOPE_AGENT); }
__device__ __forceinline__ unsigned xb_xcc_id() { return (unsigned)__builtin_amdgcn_s_getreg((3 << 11) | 20) & 0xFu; }
#define XB_SPIN(cond, bar) do { unsigned _sp = 0; while (cond) { __builtin_amdgcn_s_sleep(1); \
    if ((++_sp & 255u) == 0u) { if (xb_ld(&(bar)[XB_TMO])) break; if (_sp > XB_SPIN_CAP) { atomicAdd(&(bar)[XB_TMO], 1u); break; } } } } while (0)

struct XcdBarrier {
    unsigned* bar; unsigned x;
    volatile LAS unsigned* st;
};

__device__ __forceinline__ XcdBarrier xcd_barrier_post(unsigned* bar, volatile LAS unsigned* st) {
    XcdBarrier b; b.bar = bar; b.x = xb_xcc_id(); b.st = st;
    if (threadIdx.x == 0) (void)xb_add(&bar[XB_XCNT(b.x)], 1u);
    return b;
}
__device__ __forceinline__ void xcd_barrier_complete(unsigned* bar, unsigned x, unsigned& nloc, unsigned& nx) {
    const unsigned G = gridDim.x * gridDim.y * gridDim.z;
    unsigned sum, cnt, mine, sp = 0u;
    for (;;) {
        sum = 0u; cnt = 0u; mine = 0u;
#pragma unroll
        for (unsigned j = 0; j < 16; ++j) { const unsigned c = xb_ld(&bar[XB_XCNT(j)]); sum += c; cnt += (c > 0u) ? 1u : 0u; mine = (j == x) ? c : mine; }
        if (sum == G) break;
        __builtin_amdgcn_s_sleep(1);
        if ((++sp & 255u) == 0u) { if (xb_ld(&bar[XB_TMO])) break; if (sp > XB_SPIN_CAP) { atomicAdd(&bar[XB_TMO], 1u); break; } }
    }
    nloc = mine > 0u ? mine : 1u; nx = cnt > 0u ? cnt : 1u;
}

__device__ __forceinline__ void xcd_barrier(const XcdBarrier& b) {
    asm volatile("s_waitcnt vmcnt(0)" ::: "memory");
    __syncthreads();
    if (threadIdx.x == 0) {
        unsigned* bar = b.bar;
        __builtin_amdgcn_s_waitcnt(0);
        unsigned nloc = b.st[0], nx = b.st[1];
        if (nloc == 0u) { xcd_barrier_complete(bar, b.x, nloc, nx); b.st[0] = nloc; b.st[1] = nx; }
        const unsigned old = xb_add(&bar[XB_XSUB(b.x)], 1u);
        const unsigned gen = old / nloc;
        if (old + 1u == (gen + 1u) * nloc) {
            __builtin_amdgcn_fence(__ATOMIC_RELEASE, "agent");
            asm volatile("s_waitcnt vmcnt(0)" ::: "memory");
            const unsigned og = xb_add(&bar[XB_TOP], 1u);
            const unsigned tg = og / nx;
            if (og + 1u == (tg + 1u) * nx) xb_add(&bar[XB_TOPGEN], 1u);
            else XB_SPIN(xb_ld(&bar[XB_TOPGEN]) == tg, bar);
            __builtin_amdgcn_fence(__ATOMIC_ACQUIRE, "agent");
            xb_add(&bar[XB_XGEN(b.x)], 1u);
            asm volatile("s_waitcnt vmcnt(0)" ::: "memory");
        } else {
            XB_SPIN(xb_ld(&bar[XB_XGEN(b.x)]) == gen, bar);
            __builtin_amdgcn_fence(__ATOMIC_ACQUIRE, "agent");
            asm volatile("s_waitcnt vmcnt(0)" ::: "memory");
        }
    }
    __syncthreads();
}

enum InIdx { I_X = 0, I_C, I_CTX, I_CCTX, I_WMOD, I_BMOD, I_NMG, I_NFG, I_WIN, I_WOUT, I_SINK, I_DNCW, I_DNALOG, I_DNDT, I_DNNG, I_LRCW, I_LRCB, I_LRWR, I_LRBR, I_LRWI, I_LRBI, I_LRLAM,
             I_WROUT, I_BROUT, I_WGU, I_BGU, I_WDN, I_BDN, I_FNG, N_IN };
struct Frame {
    LAS unsigned char* lds;
    volatile LAS unsigned* MISC;
    gu32* ctl;
    int tid, lane, wave, G, bid;
    const float* const __attribute__((address_space(4)))* in;
    float* out; unsigned char* ws;
};
__device__ __forceinline__ int mod_row(int m) { return m < NLAT ? (m >> 12) : 4; }
__device__ __forceinline__ bool phase_enter(Frame& F) { int t = threadIdx.x; asm volatile("" : "+v"(t)); F.tid = t; F.lane = t & 63; F.wave = __builtin_amdgcn_readfirstlane(t >> 6); return true; }
__device__ __forceinline__ void seq_of(int m, int& t, int& T, int& base) { if (m < NLAT) { t = m & 4095; T = SEQ; base = m - t; } else { t = (m - NLAT) & 255; T = CTXL; base = m - t; } }
__device__ __forceinline__ float gelu_tanh(float x) { const float u = 0.7978845608028654f * (x + 0.044715f * x * x * x); return x * sigmoidf_(2.0f * u); }

__device__ __forceinline__ void transpose_item(const float* W, int K, int N, bf16* WT, int k0, int dstrow0, int srccol0, int nvalid, LAS float* scr, int lane) {
    { const int c4 = (lane & 7) * 4, kr = lane >> 3; f32x4 v[8];
#pragma unroll
      for (int i = 0; i < 8; ++i) { v[i] = (f32x4){0.f, 0.f, 0.f, 0.f}; if (c4 < nvalid) v[i] = __builtin_nontemporal_load((const f32x4*)(W + (size_t)(k0 + 8 * i + kr) * N + srccol0 + c4)); }
#pragma unroll
      for (int i = 0; i < 8; ++i) { LAS float* d = scr + (8 * i + kr) * 33 + c4; d[0] = v[i].x; d[1] = v[i].y; d[2] = v[i].z; d[3] = v[i].w; } }
    LDS_WAIT(); asm volatile("" ::: "memory");
    const int c = lane & 7;
#pragma unroll
    for (int jj = 0; jj < 4; ++jj) { const int n = (lane >> 3) + 8 * jj; const LAS float* s = scr + (8 * c) * 33 + n;
        v4u o; o.x = pk2(s[0 * 33], s[1 * 33]); o.y = pk2(s[2 * 33], s[3 * 33]); o.z = pk2(s[4 * 33], s[5 * 33]); o.w = pk2(s[6 * 33], s[7 * 33]);
        *(GAS v4u*)(WT + (size_t)(dstrow0 + n) * K + k0 + 8 * c) = o; }
    LDS_WAIT(); asm volatile("" ::: "memory");
}
__device__ __forceinline__ void transpose_item_f8(const float* W, int K, int N, unsigned char* WT, int k0, int dstrow0, int srccol0, float scale, LAS float* scr, int lane) {
    { const int c4 = (lane & 7) * 4, kr = lane >> 3; f32x4 v[8];
#pragma unroll
      for (int i = 0; i < 8; ++i) v[i] = __builtin_nontemporal_load((const f32x4*)(W + (size_t)(k0 + 8 * i + kr) * N + srccol0 + c4));
#pragma unroll
      for (int i = 0; i < 8; ++i) { LAS float* d = scr + (8 * i + kr) * 33 + c4; d[0] = v[i].x; d[1] = v[i].y; d[2] = v[i].z; d[3] = v[i].w; } }
    LDS_WAIT(); asm volatile("" ::: "memory");
    { const int n = lane >> 1, hf = lane & 1; const LAS float* s = scr + (32 * hf) * 33 + n; unsigned w[8];
#pragma unroll
      for (int i = 0; i < 8; ++i) { int x = 0; x = __builtin_amdgcn_cvt_pk_fp8_f32(s[(4 * i + 0) * 33] * scale, s[(4 * i + 1) * 33] * scale, x, false); x = __builtin_amdgcn_cvt_pk_fp8_f32(s[(4 * i + 2) * 33] * scale, s[(4 * i + 3) * 33] * scale, x, true); w[i] = (unsigned)x; }
      v4u* o = (v4u*)(WT + (size_t)(dstrow0 + n) * K + k0 + 32 * hf); __builtin_nontemporal_store((v4u){w[0], w[1], w[2], w[3]}, o); __builtin_nontemporal_store((v4u){w[4], w[5], w[6], w[7]}, o + 1); }
    LDS_WAIT(); asm volatile("" ::: "memory");
}
__device__ __forceinline__ void p0_prologue(Frame& F) {
    {
        LAS float* sc = (LAS float*)(F.lds);
        LAS float* red = (LAS float*)(F.lds + 40960);
        bool have_sc = false;
        for (int wb = F.bid; wb < 192; wb += F.G) {
            if (!have_sc) {
                for (int i = F.tid; i < 5 * 2048; i += NTHREADS) { const int r = i >> 11, k = i & 2047; const float cv = r < 4 ? F.in[I_C][r * 2048 + k] : F.in[I_CCTX][k]; sc[i] = siluf_(cv); }
                have_sc = true; __syncthreads();
            }
            const int l = wb / 96, cb = wb % 96, kp = F.tid >> 5, cg = F.tid & 31, j0 = cb * 128 + cg * 4;
            const float* wp = F.in[I_WMOD] + ((size_t)l * 2048 + kp * 128) * 12288 + j0;
            f32x4 acc[5];
#pragma unroll
            for (int r = 0; r < 5; ++r) acc[r] = (f32x4){0.f, 0.f, 0.f, 0.f};
#pragma unroll 4
            for (int k = 0; k < 128; ++k) { const f32x4 w = *(const f32x4*)(wp + (size_t)k * 12288);
#pragma unroll
                for (int r = 0; r < 5; ++r) acc[r] += sc[r * 2048 + kp * 128 + k] * w; }
#pragma unroll
            for (int r = 0; r < 5; ++r) *(LAS f32x4*)(red + (kp * 5 + r) * 128 + cg * 4) = acc[r];
            __syncthreads();
            for (int i = F.tid; i < 640; i += NTHREADS) { const int r = i >> 7, col = i & 127; float s = F.in[I_BMOD][l * 12288 + cb * 128 + col];
#pragma unroll
                for (int q = 0; q < 16; ++q) s += red[(q * 5 + r) * 128 + col];
                ((float*)(F.ws + WS_MOD))[(size_t)(l * 5 + r) * 12288 + cb * 128 + col] = s; }
            __syncthreads();
        }
        __syncthreads();
    }
    { int* idt = (int*)(F.ws + WS_IDT); for (int r = F.bid * NTHREADS + F.tid; r < MOE_ROWS; r += F.G * NTHREADS) idt[r] = r; }
    {
        LAS float* scr = (LAS float*)(F.lds + F.wave * 16384);
        const int gw = F.bid * NWAVES + F.wave, NGW = F.G * NWAVES;
        constexpr int I_IN = 32 * 144, I_OUT = 32 * 64, I_RT = 32, I_16 = 32, PER_L = I_IN + I_OUT + I_RT + I_16;
        for (int it0 = gw; it0 < 2 * PER_L; it0 += NGW) {
            const int l = it0 / PER_L; int r = it0 % PER_L;
            if (r < I_IN) { const int nb = r % 144, kb = r / 144, d0 = nb * 32; int s0 = d0, nv = 32;
                if (d0 >= 3584) s0 = d0 + 16;
#if FP8_INPROJ
                transpose_item_f8(F.in[I_WIN] + (size_t)l * 2048 * IN_W, 2048, IN_W, F.ws + WS_WIN + (size_t)l * PW * 2048 * 2, kb * 64, d0, s0, 64.0f, scr, F.lane); continue; }
#else
                transpose_item(F.in[I_WIN] + (size_t)l * 2048 * IN_W, 2048, IN_W, (bf16*)(F.ws + WS_WIN) + (size_t)l * PW * 2048, kb * 64, d0, s0, nv, scr, F.lane); continue; }
#endif
            r -= I_IN;
            if (r < I_OUT) { const int nb = r % 64, kb = r / 64;
#if FP8_OUTPROJ
                transpose_item_f8(F.in[I_WOUT] + (size_t)l * 2048 * 2048, 2048, 2048, F.ws + WS_WOUT + (size_t)l * 2048 * 2048 * 2, kb * 64, nb * 32, nb * 32, 64.0f, scr, F.lane); continue; }
#else
                transpose_item(F.in[I_WOUT] + (size_t)l * 2048 * 2048, 2048, 2048, (bf16*)(F.ws + WS_WOUT) + (size_t)l * 2048 * 2048, kb * 64, nb * 32, nb * 32, 32, scr, F.lane); continue; }
#endif
            r -= I_OUT;
            if (r < I_RT) { transpose_item(F.in[I_WROUT] + (size_t)l * 2048 * 32, 2048, 32, (bf16*)(F.ws + WS_WRT) + (size_t)l * 32 * 2048, r * 64, 0, 0, 32, scr, F.lane); continue; }
            r -= I_RT;
            transpose_item(F.in[I_WIN] + (size_t)l * 2048 * IN_W, 2048, IN_W, (bf16*)(F.ws + WS_WRT + 512 * 1024) + (size_t)l * 32 * 2048, r * 64, 0, 3584, 16, scr, F.lane);
        }
    }
}
constexpr int CW_CVQ = 12288 + 512;
#ifndef FP8_GEMM2
#define FP8_GEMM2 1
#endif
constexpr float WGU_SCALE = 64.0f, WDN_SCALE = 64.0f; constexpr int WGU_E8M0 = 0x7C7C7C7C, WDN_E8M0 = 0x7C7C7C7C;
__device__ __forceinline__ void convert_moe_item(Frame& F, int l, int r, LAS float* scr) {
    constexpr int I_GU = 32 * 32 * 64;
    if (r < I_GU) { const int e = r / 2048, q = r % 2048, nb = q % 64, kb = q / 64; const int s0 = ((nb >> 2) & 1) * 1024 + (nb >> 3) * 128 + (nb & 3) * 32;
        transpose_item_f8(F.in[I_WGU] + (size_t)(l * 32 + e) * 2048 * 2048, 2048, 2048, F.ws + WS_WGU + (size_t)(l * 32 + e) * 2048 * 2048, kb * 64, nb * 32, s0, WGU_SCALE, scr, F.lane); return; }
    r -= I_GU;
    { const int e = r / 1024, q = r % 1024, nb = q % 64, kb = q / 64;
#if FP8_GEMM2
        transpose_item_f8(F.in[I_WDN] + (size_t)(l * 32 + e) * 1024 * 2048, 1024, 2048, F.ws + WS_WDN + (size_t)(l * 32 + e) * 2048 * 1024, kb * 64, nb * 32, nb * 32, WDN_SCALE, scr, F.lane);
#else
        transpose_item(F.in[I_WDN] + (size_t)(l * 32 + e) * 1024 * 2048, 1024, 2048, (bf16*)(F.ws + WS_WDN) + (size_t)(l * 32 + e) * 2048 * 1024, kb * 64, nb * 32, nb * 32, 32, scr, F.lane);
#endif
    }
}
constexpr int CVG = 8;
__device__ __forceinline__ bool convert_grab(Frame& F, int l, int rep, LAS float* scr) {
    constexpr int NIT = 32 * 32 * 64 + 32 * 16 * 64;
    int g = 0; if (F.lane == 0) g = (int)__hip_atomic_fetch_add(F.ctl + CW_CVQ + 64 * l + 8 * rep, 1u, RLX_AGENT); g = __builtin_amdgcn_readfirstlane(g);
    if (g * CVG >= NIT) return false;
#pragma unroll 1
    for (int k = 0; k < CVG; ++k) convert_moe_item(F, l, g * CVG + k, scr);
    return true;
}
__device__ __forceinline__ void convert_moe_queue(Frame& F, int l, int rep = 0) {
    LAS float* scr = (LAS float*)(F.lds + F.wave * 16384);
    __syncthreads();
    while (convert_grab(F, l, rep, scr)) {}
    __syncthreads();
}
constexpr int CW_TAIL = 16384;
__device__ __forceinline__ void tail_fill(Frame& F, int seam, int lt) {
    LAS int* flag = (LAS int*)(F.lds + LDS_X_OFF + 768);
    LAS float* scr = (LAS float*)(F.lds + F.wave * 16384);
    __syncthreads();
    if (F.tid == 0) (void)__hip_atomic_fetch_add(F.ctl + CW_TAIL + 64 * seam, 1u, RLX_AGENT);
    bool more = true;
    for (int it = 0; it < 4096; ++it) {
        if (F.tid == 0) *flag = (__hip_atomic_load(F.ctl + CW_TAIL + 64 * seam, RLX_AGENT) >= (unsigned)F.G) ? 1 : 0;
        __syncthreads();
        const int done = *flag;
        __syncthreads();
        if (done) break;
        if (more) more = convert_grab(F, lt, 0, scr); else __builtin_amdgcn_s_sleep(32);
    }
}

__device__ __forceinline__ void load_row(const float* src, int lane, f32x4 (&v)[8]) {
    const f32x4* p = (const f32x4*)src + lane;
#pragma unroll
    for (int j = 0; j < 8; ++j) v[j] = p[64 * j];
}
__device__ __forceinline__ void store_row(float* dst, int lane, const f32x4 (&v)[8]) {
    f32x4* p = (f32x4*)dst + lane;
#pragma unroll
    for (int j = 0; j < 8; ++j) p[64 * j] = v[j];
}
#if X_BF16
typedef bf16 xelem_t;
__device__ __forceinline__ void load_xrow(const bf16* src, int lane, f32x4 (&v)[8]) {
    const v2u* p = (const v2u*)src + lane;
#pragma unroll
    for (int j = 0; j < 8; ++j) { const v2u w = p[64 * j]; v[j] = (f32x4){bflo(w.x), bfhi(w.x), bflo(w.y), bfhi(w.y)}; }
}
__device__ __forceinline__ void store_xrow(bf16* dst, int lane, const f32x4 (&v)[8]) {
    v2u* p = (v2u*)dst + lane;
#pragma unroll
    for (int j = 0; j < 8; ++j) { v2u w; w.x = pk2(v[j].x, v[j].y); w.y = pk2(v[j].z, v[j].w); p[64 * j] = w; }
}
#else
typedef float xelem_t;
__device__ __forceinline__ void load_xrow(const float* src, int lane, f32x4 (&v)[8]) { load_row(src, lane, v); }
__device__ __forceinline__ void store_xrow(float* dst, int lane, const f32x4 (&v)[8]) { store_row(dst, lane, v); }
#endif
__device__ __forceinline__ void combine_row(Frame& F, int l, int m, int lane, f32x4 (&v)[8]) {
    const int* dest = (const int*)(F.ws + WS_MOEI + 2 * 512 * 1024) + m * 4;
    const float* g5 = (const float*)(F.ws + WS_MOD) + (size_t)(l * 5 + mod_row(m)) * 12288 + 5 * 2048;
    f32x4 acc[8];
#pragma unroll
    for (int j = 0; j < 8; ++j) acc[j] = (f32x4){0.f, 0.f, 0.f, 0.f};
#pragma unroll
    for (int k = 0; k < 4; ++k) { const int d = dest[k]; const v2u* yp = (const v2u*)((const bf16*)(F.ws + WS_YS) + (size_t)d * 2048) + lane;
#pragma unroll
        for (int j = 0; j < 8; ++j) { const v2u w = yp[64 * j]; acc[j] += (f32x4){bflo(w.x), bfhi(w.x), bflo(w.y), bfhi(w.y)}; } }
#pragma unroll
    for (int j = 0; j < 8; ++j) { const f32x4 gg = *((const f32x4*)g5 + lane + 64 * j); v[j] += gg * acc[j]; }
}
__device__ __forceinline__ void modnorm_store(const f32x4 (&v)[8], const float* g, const float* shift, const float* scale, bf16* hrow, int lane) {
    float ss = 0.f;
#pragma unroll
    for (int j = 0; j < 8; ++j) ss += (v[j].x * v[j].x + v[j].y * v[j].y) + (v[j].z * v[j].z + v[j].w * v[j].w);
    const float rstd = 1.0f / sqrtf(wave_sum(ss) * (1.0f / 2048.0f) + EPS);
    v2u* hp = (v2u*)hrow + lane;
#pragma unroll
    for (int j = 0; j < 8; ++j) { const f32x4 gg = *((const f32x4*)g + lane + 64 * j), sh = *((const f32x4*)shift + lane + 64 * j), sc = *((const f32x4*)scale + lane + 64 * j);
        const f32x4 y = (v[j] * rstd) * gg * (sc + 1.0f) + sh; v2u w; w.x = pk2(y.x, y.y); w.y = pk2(y.z, y.w); hp[64 * j] = w; }
}
constexpr size_t WS_W16 = WS_WRT + 512 * 1024;
__device__ __forceinline__ void phase_norm1(Frame& F, int l) {
    constexpr int TROW = 4112;
    LAS unsigned char* tile = F.lds; LAS float* part = (LAS float*)(F.lds + 66048);
    xelem_t* X = (xelem_t*)(F.ws + WS_X); bf16* H = (bf16*)(F.ws + WS_H); bf16* P = (bf16*)(F.ws + WS_P);
    const float* modp = (const float*)(F.ws + WS_MOD) + (size_t)l * 5 * 12288;
    const bf16* w16 = (const bf16*)(F.ws + WS_W16) + (size_t)l * 32 * 2048;
    for (int r0 = F.bid * 16; r0 < NTOK; r0 += F.G * 16) {
#pragma unroll 1
        for (int rr = 0; rr < 2; ++rr) { const int lr = 2 * F.wave + rr, m = r0 + lr;
            f32x4 v[8];
            if (l == 0) load_row(m < NLAT ? F.in[I_X] + (size_t)m * DM : F.in[I_CTX] + (size_t)(m - NLAT) * DM, F.lane, v);
            else { load_xrow(X + (size_t)m * DM, F.lane, v); if (MK_STAGE >= 9) { combine_row(F, l - 1, m, F.lane, v); store_xrow(X + (size_t)m * DM, F.lane, v); } }
            float ss = 0.f;
#pragma unroll
            for (int j = 0; j < 8; ++j) ss += (v[j].x * v[j].x + v[j].y * v[j].y) + (v[j].z * v[j].z + v[j].w * v[j].w);
            const float rstd = 1.0f / sqrtf(wave_sum(ss) * (1.0f / 2048.0f) + EPS);
            const float* mr = modp + (size_t)mod_row(m) * 12288; const float* g = F.in[I_NMG] + l * DM;
#if FP8_INPROJ
            unsigned* hp = (unsigned*)(F.ws + WS_XS + (size_t)m * DM) + F.lane; LAS v2u* tp = (LAS v2u*)(tile + lr * TROW) + F.lane;
#else
            v2u* hp = (v2u*)(H + (size_t)m * DM) + F.lane; LAS v2u* tp = (LAS v2u*)(tile + lr * TROW) + F.lane;
#endif
#pragma unroll
            for (int j = 0; j < 8; ++j) { const f32x4 gg = *((const f32x4*)g + F.lane + 64 * j), sh = *((const f32x4*)mr + F.lane + 64 * j), sc = *((const f32x4*)(mr + 2048) + F.lane + 64 * j);
                const f32x4 y = (v[j] * rstd) * gg * (sc + 1.0f) + sh; v2u w; w.x = pk2(y.x, y.y); w.y = pk2(y.z, y.w); tp[64 * j] = w;
#if FP8_INPROJ
                int x8 = 0; x8 = __builtin_amdgcn_cvt_pk_fp8_f32(y.x, y.y, x8, false); x8 = __builtin_amdgcn_cvt_pk_fp8_f32(y.z, y.w, x8, true); hp[64 * j] = (unsigned)x8; }
#else
                hp[64 * j] = w; }
#endif
        }
        __syncthreads();
        { const int row = F.lane & 15, q = F.lane >> 4; f32x4 acc = {0.f, 0.f, 0.f, 0.f};
#pragma unroll
          for (int ks = 0; ks < 8; ++ks) { const int k0 = 256 * F.wave + 32 * ks + 8 * q;
              const bf16x8 a = *(const LAS bf16x8*)(tile + row * TROW + k0 * 2); const bf16x8 b = *(const bf16x8*)(w16 + (size_t)row * 2048 + k0);
              acc = __builtin_amdgcn_mfma_f32_16x16x32_bf16(a, b, acc, 0, 0, 0); }
#pragma unroll
          for (int i = 0; i < 4; ++i) part[(F.wave * 16 + 4 * q + i) * 16 + row] = acc[i]; }
        __syncthreads();
        if (F.tid < 256) { const int rw = F.tid >> 4, c = F.tid & 15; float sacc = 0.f;
#pragma unroll
            for (int w = 0; w < 8; ++w) sacc += part[(w * 16 + rw) * 16 + c];
            P[(size_t)(r0 + rw) * PW + PC_BETA + c] = (bf16)f2bf(sacc); }
        __syncthreads();
    }
}
__device__ __forceinline__ void phase_final(Frame& F, bool with_combine) {
    const int gw = F.bid * NWAVES + F.wave, NGW = F.G * NWAVES;
    const xelem_t* X = (const xelem_t*)(F.ws + WS_X);
    for (int m = gw; m < NLAT; m += NGW) {
        f32x4 v[8];
        if (with_combine) { load_xrow(X + (size_t)m * DM, F.lane, v); combine_row(F, 1, m, F.lane, v); }
        else load_row(F.in[I_X] + (size_t)m * DM, F.lane, v);
        float ss = 0.f;
#pragma unroll
        for (int j = 0; j < 8; ++j) ss += (v[j].x * v[j].x + v[j].y * v[j].y) + (v[j].z * v[j].z + v[j].w * v[j].w);
        const float rstd = 1.0f / sqrtf(wave_sum(ss) * (1.0f / 2048.0f) + EPS);
        f32x4* op = (f32x4*)(F.out + (size_t)m * DM) + F.lane;
#pragma unroll
        for (int j = 0; j < 8; ++j) { const f32x4 gg = *((const f32x4*)F.in[I_FNG] + F.lane + 64 * j); op[64 * j] = v[j] * rstd * gg; }
    }
}

__device__ __forceinline__ void phase_inproj(Frame& F, int l) {
#if FP8_INPROJ
    pg8::Gemm g{(const bf16*)(F.ws + WS_XS), (const bf16*)(F.ws + WS_WIN + (size_t)l * PW * 2048 * 2), NTOK, 4608, 1024, 0x7C7C7C7C};
    pg8::StaticOrderG S; S.init(g, F.G, F.bid); S.row_tab = (const int*)(F.ws + WS_IDT);
    pg8::EpiBf16Plain E{(bf16*)(F.ws + WS_P), PW};
    pg8::gemm_phase<pg8::EpiBf16Plain, pg8::StaticOrderG, true, true, true>(F.lds + RING_OFF, g, S, E);
#else
    pg8::Gemm g{(const bf16*)(F.ws + WS_H), (const bf16*)(F.ws + WS_WIN) + (size_t)l * PW * 2048, NTOK, 4608, 2048};
    pg8::StaticOrder S; S.init(g, F.G, F.bid);
    pg8::EpiBf16Plain E{(bf16*)(F.ws + WS_P), PW};
    pg8::gemm_phase<pg8::EpiBf16Plain, pg8::StaticOrder, true, true>(F.lds + RING_OFF, g, S, E);
#endif
}
__device__ __forceinline__ void phase_outproj(Frame& F, int l) {
    float* X = (float*)(F.ws + WS_X);
#if FP8_OUTPROJ
    pg8::Gemm g{(const bf16*)(F.ws + WS_CC), (const bf16*)(F.ws + WS_WOUT + (size_t)l * 2048 * 2048 * 2), l == 0 ? NTOK : NLAT, 2048, 1024, 0x7C7C7C7C};
    pg8::StaticOrderG S; S.init(g, F.G, F.bid); S.row_tab = (const int*)(F.ws + WS_IDT);
#else
    pg8::Gemm g{(const bf16*)(F.ws + WS_CC), (const bf16*)(F.ws + WS_WOUT) + (size_t)l * 2048 * 2048, l == 0 ? NTOK : NLAT, 2048, 2048};
    pg8::StaticOrder S; S.init(g, F.G, F.bid);
#endif
#if X_BF16
    pg8::EpiResGateB E{F.in[I_X], F.in[I_CTX], (const bf16*)(F.ws + WS_X), (bf16*)(F.ws + WS_X), (const float*)(F.ws + WS_MOD) + (size_t)l * 5 * 12288 + 2 * 2048, l == 0 ? 1 : 0};
#define EPI_RES pg8::EpiResGateB
#else
    pg8::EpiResGate E{l == 0 ? F.in[I_X] : X, l == 0 ? F.in[I_CTX] : X + (size_t)NLAT * DM, X, (const float*)(F.ws + WS_MOD) + (size_t)l * 5 * 12288 + 2 * 2048};
#define EPI_RES pg8::EpiResGate
#endif
#if FP8_OUTPROJ
    pg8::gemm_phase<EPI_RES, pg8::StaticOrderG, true, true, true>(F.lds + RING_OFF, g, S, E);
#else
    pg8::gemm_phase<EPI_RES, pg8::StaticOrder, true, true>(F.lds + RING_OFF, g, S, E);
#endif
}
#ifndef PHASE_INPROJ
#define PHASE_INPROJ(F, l) phase_inproj(F, l)
#endif
#ifndef PHASE_OUTPROJ
#define PHASE_OUTPROJ(F, l) phase_outproj(F, l)
#endif

constexpr size_t WS_H8 = WS_XS;
constexpr size_t MOEI_TOPE = WS_MOEI, MOEI_TOPG = WS_MOEI + 512 * 1024, MOEI_DEST = WS_MOEI + 2 * 512 * 1024, MOEI_ROWG = WS_MOEI + 3 * 512 * 1024, MOEI_ROWT = WS_MOEI + 4 * 512 * 1024, MOEI_IDT = WS_IDT;
__device__ __forceinline__ void phase_norm2(Frame& F, int l) {
    const int nrows = (l == 0) ? NTOK : NLAT;
    constexpr int TROW = 4112;
    LAS unsigned char* tile = F.lds;
    LAS float* part = (LAS float*)(F.lds + 66048);
    LAS float* lg = (LAS float*)(F.lds + 66048 + 16384);
    const xelem_t* X = (const xelem_t*)(F.ws + WS_X); bf16* H = (bf16*)(F.ws + WS_H);
    const float* modp = (const float*)(F.ws + WS_MOD) + (size_t)l * 5 * 12288;
    const bf16* wrt = (const bf16*)(F.ws + WS_WRT) + (size_t)l * 32 * 2048;
    int* tope = (int*)(F.ws + MOEI_TOPE); float* topg = (float*)(F.ws + MOEI_TOPG);
    for (int r0 = F.bid * 16; r0 < nrows; r0 += F.G * 16) {
#pragma unroll 1
        for (int rr = 0; rr < 2; ++rr) {
            const int lr = 2 * F.wave + rr, m = r0 + lr;
            f32x4 v[8]; load_xrow(X + (size_t)m * DM, F.lane, v);
            float ss = 0.f;
#pragma unroll
            for (int j = 0; j < 8; ++j) ss += (v[j].x * v[j].x + v[j].y * v[j].y) + (v[j].z * v[j].z + v[j].w * v[j].w);
            const float rstd = 1.0f / sqrtf(wave_sum(ss) * (1.0f / 2048.0f) + EPS);
            const float* mr = modp + (size_t)mod_row(m) * 12288; const float* g = F.in[I_NFG] + l * DM;
            unsigned* hp = (unsigned*)(F.ws + WS_H8 + (size_t)m * DM) + F.lane; LAS v2u* tp = (LAS v2u*)(tile + lr * TROW) + F.lane;
#pragma unroll
            for (int j = 0; j < 8; ++j) { const f32x4 gg = *((const f32x4*)g + F.lane + 64 * j), sh = *((const f32x4*)(mr + 3 * 2048) + F.lane + 64 * j), sc = *((const f32x4*)(mr + 4 * 2048) + F.lane + 64 * j);
                const f32x4 y = (v[j] * rstd) * gg * (sc + 1.0f) + sh; v2u w; w.x = pk2(y.x, y.y); w.y = pk2(y.z, y.w); tp[64 * j] = w;
                int x8 = 0; x8 = __builtin_amdgcn_cvt_pk_fp8_f32(y.x, y.y, x8, false); x8 = __builtin_amdgcn_cvt_pk_fp8_f32(y.z, y.w, x8, true); hp[64 * j] = (unsigned)x8; }
        }
        __syncthreads();
        {
            const int row = F.lane & 15, q = F.lane >> 4;
            f32x4 acc0 = {0.f, 0.f, 0.f, 0.f}, acc1 = {0.f, 0.f, 0.f, 0.f};
#pragma unroll
            for (int ks = 0; ks < 8; ++ks) { const int k0 = 256 * F.wave + 32 * ks + 8 * q;
                const bf16x8 a = *(const LAS bf16x8*)(tile + row * TROW + k0 * 2);
                const bf16x8 b0 = *(const bf16x8*)(wrt + (size_t)row * 2048 + k0), b1 = *(const bf16x8*)(wrt + (size_t)(16 + row) * 2048 + k0);
                acc0 = __builtin_amdgcn_mfma_f32_16x16x32_bf16(a, b0, acc0, 0, 0, 0); acc1 = __builtin_amdgcn_mfma_f32_16x16x32_bf16(a, b1, acc1, 0, 0, 0); }
#pragma unroll
            for (int i = 0; i < 4; ++i) { part[(F.wave * 16 + 4 * q + i) * 32 + row] = acc0[i]; part[(F.wave * 16 + 4 * q + i) * 32 + 16 + row] = acc1[i]; }
        }
        __syncthreads();
        { const int rw = F.tid >> 5, e = F.tid & 31; float s = F.in[I_BROUT][l * 32 + e];
#pragma unroll
          for (int w = 0; w < 8; ++w) s += part[(w * 16 + rw) * 32 + e];
          lg[rw * 32 + e] = s; }
        __syncthreads();
        if (F.tid < 16) { const int m = r0 + F.tid; float val[4]; int idx[4]; unsigned taken = 0u;
#pragma unroll
            for (int k = 0; k < 4; ++k) { float best = -3.0e38f; int bi = 0;
                for (int e = 0; e < 32; ++e) { const float x = lg[F.tid * 32 + e]; if (!((taken >> e) & 1u) && x > best) { best = x; bi = e; } }
                val[k] = best; idx[k] = bi; taken |= 1u << bi; }
            float p[4], sum = 0.f;
#pragma unroll
            for (int k = 0; k < 4; ++k) { p[k] = __expf(val[k] - val[0]); sum += p[k]; }
#pragma unroll
            for (int k = 0; k < 4; ++k) { const unsigned rank = __hip_atomic_fetch_add(F.ctl + CW_CNT + 64 * l + idx[k], 1u, RLX_AGENT);
                tope[m * 4 + k] = idx[k] | (int)(rank << 8); topg[m * 4 + k] = p[k] / sum; }
        }
        __syncthreads();
    }
}
__device__ __forceinline__ void moe_tables(Frame& F, int l) {
    LAS int* blk_end = (LAS int*)(F.lds + LDS_X_OFF); LAS int* pstart = blk_end + 32; LAS int* cnts = blk_end + 64;
    if (F.tid == 0) { int nb = 0;
        for (int e = 0; e < 32; ++e) { const int c = (int)__hip_atomic_load(F.ctl + CW_CNT + 64 * l + e, RLX_AGENT); cnts[e] = c; pstart[e] = nb * 256; nb += (c + 255) >> 8; blk_end[e] = nb; } }
    __syncthreads();
}
__device__ __forceinline__ void phase_scatter(Frame& F, int l) {
    const int nrows = (l == 0) ? NTOK : NLAT;
    moe_tables(F, l);
    const LAS int* blk_end = (const LAS int*)(F.lds + LDS_X_OFF); const LAS int* pstart = blk_end + 32; const LAS int* cnts = blk_end + 64;
    const int* tope = (const int*)(F.ws + MOEI_TOPE); const float* topg = (const float*)(F.ws + MOEI_TOPG);
    int* dest = (int*)(F.ws + MOEI_DEST); float* rowg = (float*)(F.ws + MOEI_ROWG); int* rowt = (int*)(F.ws + MOEI_ROWT);
    for (int a = F.bid * NTHREADS + F.tid; a < nrows * 4; a += F.G * NTHREADS) {
        const int te = tope[a], e = te & 255, rank = (int)((unsigned)te >> 8), d = pstart[e] + rank;
        dest[a] = d; rowg[d] = topg[a]; rowt[d] = a >> 2; }
    if (F.bid < 32) { const int e = F.bid, r0 = pstart[e] + cnts[e], r1 = blk_end[e] * 256;
        for (int r = r0 + F.tid; r < r1; r += NTHREADS) { rowt[r] = 0; rowg[r] = 0.f; } }
}
__device__ __forceinline__ void phase_gemm1(Frame& F, int l) {
    moe_tables(F, l);
    const LAS int* blk_end = (const LAS int*)(F.lds + LDS_X_OFF);
    pg8::Gemm g{(const bf16*)(F.ws + WS_H8), (const bf16*)(F.ws + WS_WGU + (size_t)l * 32 * 2048 * 2048), MOE_ROWS, 2048, 1024, WGU_E8M0};
    pg8::MoeOrderG S{F.bid, __builtin_amdgcn_readfirstlane(blk_end[31]), (const char*)g.A, (const char*)g.Bt, (size_t)256 * 2048, (size_t)2048 * 2048, (size_t)256 * 2048, blk_end, (const int*)(F.ws + MOEI_ROWT)};
#if FP8_GEMM2
    pg8::EpiSwiglu8 E{F.ws + WS_ACT, F.in[I_BGU] + (size_t)l * 32 * 2048};
    pg8::gemm_phase<pg8::EpiSwiglu8, pg8::MoeOrderG, true, true, true>(F.lds + RING_OFF, g, S, E);
#else
    pg8::EpiSwiglu E{(bf16*)(F.ws + WS_ACT), F.in[I_BGU] + (size_t)l * 32 * 2048};
    pg8::gemm_phase<pg8::EpiSwiglu, pg8::MoeOrderG, true, true, true>(F.lds + RING_OFF, g, S, E);
#endif
}
__device__ __forceinline__ void phase_gemm2(Frame& F, int l) {
    moe_tables(F, l);
    const LAS int* blk_end = (const LAS int*)(F.lds + LDS_X_OFF);
#if FP8_GEMM2
    pg8::Gemm g{(const bf16*)(F.ws + WS_ACT), (const bf16*)(F.ws + WS_WDN + (size_t)l * 32 * 2048 * 1024), MOE_ROWS, 2048, 512, WDN_E8M0};
    pg8::MoeOrderG S{F.bid, __builtin_amdgcn_readfirstlane(blk_end[31]), (const char*)g.A, (const char*)g.Bt, (size_t)256 * 1024, (size_t)2048 * 1024, (size_t)256 * 1024, blk_end, (const int*)(F.ws + MOEI_IDT)};
    pg8::EpiDown E{(bf16*)(F.ws + WS_YS), F.in[I_BDN] + (size_t)l * 32 * 2048, (const float*)(F.ws + MOEI_ROWG)};
    pg8::gemm_phase<pg8::EpiDown, pg8::MoeOrderG, true, true, true>(F.lds + RING_OFF, g, S, E);
#else
    pg8::Gemm g{(const bf16*)(F.ws + WS_ACT), (const bf16*)(F.ws + WS_WDN) + (size_t)l * 32 * 2048 * 1024, MOE_ROWS, 2048, 1024};
    pg8::MoeOrder S{F.bid, __builtin_amdgcn_readfirstlane(blk_end[31]), (const char*)g.A, (const char*)g.Bt, (size_t)256 * 1024 * 2, (size_t)2048 * 1024 * 2, (size_t)256 * 1024 * 2, blk_end, nullptr};
    pg8::EpiDown E{(bf16*)(F.ws + WS_YS), F.in[I_BDN] + (size_t)l * 32 * 2048, (const float*)(F.ws + MOEI_ROWG)};
    pg8::gemm_phase<pg8::EpiDown, pg8::MoeOrder, true, true>(F.lds + RING_OFF, g, S, E);
#endif
}
#ifndef PHASE_NORM2
#define PHASE_NORM2(F, l) phase_norm2(F, l)
#endif
#ifndef PHASE_SCATTER
#define PHASE_SCATTER(F, l) phase_scatter(F, l)
#endif
#ifndef PHASE_GEMM1
#define PHASE_GEMM1(F, l) phase_gemm1(F, l)
#endif
#ifndef PHASE_GEMM2
#define PHASE_GEMM2(F, l) phase_gemm2(F, l)
#endif
#define USE_MFMA_ATTN 1

__device__ __forceinline__ void attn_prep(Frame& F, int l) {
    bf16* P = (bf16*)(F.ws + WS_P);
    LAS unsigned short* vt = (LAS unsigned short*)F.lds;
    for (int ct = F.bid; ct < NCT; ct += F.G) {
        const int m0 = ct * 64; const bool lat = m0 < NLAT;
        __syncthreads();
        for (int i = F.tid; i < 64 * 32; i += NTHREADS) { const int tk = i >> 5, c8 = i & 31;
            const v4u w = *(const v4u*)(P + (size_t)(m0 + tk) * PW + PC_V + c8 * 8);
            const unsigned ww[4] = {w.x, w.y, w.z, w.w};
#pragma unroll
            for (int q = 0; q < 4; ++q) { vt[(c8 * 8 + 2 * q) * 66 + tk] = (unsigned short)(ww[q] & 0xffffu); vt[(c8 * 8 + 2 * q + 1) * 66 + tk] = (unsigned short)(ww[q] >> 16); } }
        if (lat) { const int tk = F.tid >> 3, kvh = (F.tid >> 1) & 3, hf = F.tid & 1; const int t = (m0 + tk) & 4095;
            bf16* kp = P + (size_t)(m0 + tk) * PW + PC_K + kvh * 64 + hf * 32;
            const v4u w0 = *(const v4u*)kp, w1 = *(const v4u*)(kp + 8), w2 = *(const v4u*)(kp + 16), w3 = *(const v4u*)(kp + 24);
            const unsigned lo[8] = {w0.x, w0.y, w0.z, w0.w, w1.x, w1.y, w1.z, w1.w}, hi_[8] = {w2.x, w2.y, w2.z, w2.w, w3.x, w3.y, w3.z, w3.w};
            const float pos = (float)(hf ? (t & 63) : (t >> 6)); unsigned o1[8], o2[8];
#pragma unroll
            for (int jj = 0; jj < 8; ++jj) { float r1[2], r2[2];
#pragma unroll
                for (int e = 0; e < 2; ++e) { const int j = 2 * jj + e; const float inv = __builtin_amdgcn_exp2f(-(float)j * 0.8304820237218406f); const float sn = __sinf(pos * inv), cs = __cosf(pos * inv);
                    const float x1 = e ? bfhi(lo[jj]) : bflo(lo[jj]), x2 = e ? bfhi(hi_[jj]) : bflo(hi_[jj]); r1[e] = x1 * cs - x2 * sn; r2[e] = x2 * cs + x1 * sn; }
                o1[jj] = pk2(r1[0], r1[1]); o2[jj] = pk2(r2[0], r2[1]); }
            *(v4u*)kp = (v4u){o1[0], o1[1], o1[2], o1[3]}; *(v4u*)(kp + 8) = (v4u){o1[4], o1[5], o1[6], o1[7]}; *(v4u*)(kp + 16) = (v4u){o2[0], o2[1], o2[2], o2[3]}; *(v4u*)(kp + 24) = (v4u){o2[4], o2[5], o2[6], o2[7]}; }
        __syncthreads();
        for (int i = F.tid; i < 256 * 8; i += NTHREADS) { const int col = i >> 3, c = i & 7, kvh = col >> 6, d = col & 63;
            v4u o; const LAS unsigned short* s = vt + col * 66 + c * 8;
            o.x = s[0] | ((unsigned)s[1] << 16); o.y = s[2] | ((unsigned)s[3] << 16); o.z = s[4] | ((unsigned)s[5] << 16); o.w = s[6] | ((unsigned)s[7] << 16);
            if (lat) { const int b = m0 >> 12, t0 = m0 & 4095; *(v4u*)((bf16*)(F.ws + WS_VT) + ((size_t)(b * 4 + kvh) * 64 + d) * SEQ + t0 + c * 8) = o; }
            else { const int mm = m0 - NLAT, b = mm >> 8, t0 = mm & 255; *(v4u*)((bf16*)(F.ws + WS_VTC) + ((size_t)(b * 4 + kvh) * 64 + d) * CTXL + t0 + c * 8) = o; } }
    }
    __syncthreads();
}

constexpr int AT_KP = 144, AT_VP = 136;
constexpr int AT_KOFF = 0, AT_VOFF = 64 * AT_KP, AT_TILE = 64 * AT_KP + 64 * AT_VP;
__device__ __forceinline__ void attn_unit(Frame& F, int l, int b, int kvh, int qi, int is_ctx) {
    const bf16* P = (const bf16*)(F.ws + WS_P); bf16* CC = (bf16*)(F.ws + WS_CC);
    int lane_o = F.lane; asm volatile("" : "+v"(lane_o));
    const int g = F.wave >> 1, qh = F.wave & 1, hq = kvh * 4 + g, r32 = lane_o & 31, hi = lane_o >> 5;
    const int rowbase = is_ctx ? NLAT + b * CTXL : b * SEQ;
    const int qa = qi * 128 + qh * 64;
    const float LOG2E = 1.4426950408889634f;
    bf16x8 qf[2][4];
#pragma unroll
    for (int qt = 0; qt < 2; ++qt) { const int tq = qa + 32 * qt + r32; const bf16* qp = P + (size_t)(rowbase + tq) * PW + PC_Q + hq * 64 + 8 * hi;
        float x[4][8];
#pragma unroll
        for (int s = 0; s < 4; ++s) { const v4u w = *(const v4u*)(qp + 16 * s); x[s][0] = bflo(w.x); x[s][1] = bfhi(w.x); x[s][2] = bflo(w.y); x[s][3] = bfhi(w.y); x[s][4] = bflo(w.z); x[s][5] = bfhi(w.z); x[s][6] = bflo(w.w); x[s][7] = bfhi(w.w); }
        if (!is_ctx) {
#pragma unroll
            for (int hf = 0; hf < 2; ++hf) { const float pos = (float)(hf ? (tq & 63) : (tq >> 6));
#pragma unroll
                for (int j = 0; j < 8; ++j) { const float inv = __builtin_amdgcn_exp2f(-(float)(8 * hi + j) * 0.8304820237218406f); const float sn = __sinf(pos * inv), cs = __cosf(pos * inv);
                    const float x1 = x[2 * hf][j], x2 = x[2 * hf + 1][j]; x[2 * hf][j] = x1 * cs - x2 * sn; x[2 * hf + 1][j] = x2 * cs + x1 * sn; } } }
        const float sc = 0.125f * LOG2E;
#pragma unroll
        for (int s = 0; s < 4; ++s) { v4u w; w.x = pk2(x[s][0] * sc, x[s][1] * sc); w.y = pk2(x[s][2] * sc, x[s][3] * sc); w.z = pk2(x[s][4] * sc, x[s][5] * sc); w.w = pk2(x[s][6] * sc, x[s][7] * sc); qf[qt][s] = __builtin_bit_cast(bf16x8, w); }
    }
    float mrun[2], lrun[2]; f32x16 O[2][2];
    { const float sk = F.in[I_SINK][l * 16 + hq] * LOG2E;
#pragma unroll
      for (int qt = 0; qt < 2; ++qt) { mrun[qt] = sk; lrun[qt] = hi ? 0.f : 1.f;
#pragma unroll
        for (int db = 0; db < 2; ++db)
#pragma unroll
            for (int r = 0; r < 16; ++r) O[qt][db][r] = 0.f; } }
    const int kt_lo = is_ctx ? 0 : (qi == 0 ? 2 : 0), nl = is_ctx ? 0 : (6 - (qi == 0 ? 2 : 0) - (qi == 31 ? 2 : 0)), ntile = nl + 4;
    const int rr = F.tid >> 3, cch = F.tid & 7;
    const bf16* kbase_l = P + (size_t)(b * SEQ + rr) * PW + PC_K + kvh * 64 + cch * 8; const bf16* kbase_c = P + (size_t)(NLAT + b * CTXL + rr) * PW + PC_K + kvh * 64 + cch * 8;
    const bf16* vbase_l = (const bf16*)(F.ws + WS_VT) + ((size_t)(b * 4 + kvh) * 64 + rr) * SEQ + cch * 8; const bf16* vbase_c = (const bf16*)(F.ws + WS_VTC) + ((size_t)(b * 4 + kvh) * 64 + rr) * CTXL + cch * 8;
    v4u kw, vw;
    { const bool loc0 = nl > 0; const int k00 = loc0 ? 128 * (qi - 1) + 64 * kt_lo : 0; kw = *(const v4u*)((loc0 ? kbase_l : kbase_c) + (size_t)k00 * PW); vw = *(const v4u*)((loc0 ? vbase_l : vbase_c) + k00); }
    LDS_BARRIER();
#pragma unroll 1
    for (int jt = 0; jt < ntile; ++jt) {
        const bool local = jt < nl; const int k0 = local ? 128 * (qi - 1) + 64 * (kt_lo + jt) : 64 * (jt - nl);
        const LAS unsigned char* KS = F.lds + (jt & 1) * AT_TILE + AT_KOFF; const LAS unsigned char* VS = F.lds + (jt & 1) * AT_TILE + AT_VOFF;
        { *(LAS v4u*)(F.lds + (jt & 1) * AT_TILE + AT_KOFF + rr * AT_KP + cch * 16) = kw;
          LAS v2u* vd = (LAS v2u*)(F.lds + (jt & 1) * AT_TILE + AT_VOFF + rr * AT_VP + cch * 16); vd[0] = (v2u){vw.x, vw.y}; vd[1] = (v2u){vw.z, vw.w}; }
        if (jt + 1 < ntile) { const bool ln = jt + 1 < nl; const int kn = ln ? 128 * (qi - 1) + 64 * (kt_lo + jt + 1) : 64 * (jt + 1 - nl);
            kw = *(const v4u*)((ln ? kbase_l : kbase_c) + (size_t)kn * PW); vw = *(const v4u*)((ln ? vbase_l : vbase_c) + kn); }
        LDS_BARRIER();
        if (local && (k0 + 63 < qa - 128 || k0 > qa + 63 + 128)) continue;
#pragma unroll 1
        for (int kb = 0; kb < 2; ++kb) {
            bf16x8 kf[4];
#pragma unroll
            for (int ss = 0; ss < 4; ++ss) kf[ss] = *(const LAS bf16x8*)(KS + (32 * kb + r32) * AT_KP + (16 * ss + 8 * hi) * 2);
            bf16x8 pb[2][2];
#pragma unroll
            for (int qt = 0; qt < 2; ++qt) { const int tq = qa + 32 * qt + r32;
                f32x16 s;
#pragma unroll
                for (int r = 0; r < 16; ++r) s[r] = 0.f;
#pragma unroll
                for (int ss = 0; ss < 4; ++ss) s = __builtin_amdgcn_mfma_f32_32x32x16_bf16(kf[ss], qf[qt][ss], s, 0, 0, 0);
                if (local) {
#pragma unroll
                    for (int r = 0; r < 16; ++r) { const int kidx = k0 + 32 * kb + (r & 3) + 8 * (r >> 2) + 4 * hi; const int dlt = kidx - tq; if (dlt > 128 || dlt < -128) s[r] = -1.0e30f; } }
                float mloc = s[0];
#pragma unroll
                for (int r = 1; r < 16; ++r) mloc = fmaxf(mloc, s[r]);
                mloc = fmaxf(mloc, __shfl_xor(mloc, 32));
                const float mnew = fmaxf(mrun[qt], mloc), alpha = __builtin_amdgcn_exp2f(mrun[qt] - mnew); mrun[qt] = mnew;
                float psum = 0.f;
#pragma unroll
                for (int r = 0; r < 16; ++r) { s[r] = __builtin_amdgcn_exp2f(s[r] - mnew); psum += s[r]; }
                lrun[qt] = lrun[qt] * alpha + psum;
#pragma unroll
                for (int db = 0; db < 2; ++db)
#pragma unroll
                    for (int r = 0; r < 16; ++r) O[qt][db][r] *= alpha;
#pragma unroll
                for (int s2 = 0; s2 < 2; ++s2) { v4u pw; pw.x = pk2(s[8 * s2 + 0], s[8 * s2 + 1]); pw.y = pk2(s[8 * s2 + 2], s[8 * s2 + 3]); pw.z = pk2(s[8 * s2 + 4], s[8 * s2 + 5]); pw.w = pk2(s[8 * s2 + 6], s[8 * s2 + 7]);
                    pb[qt][s2] = __builtin_bit_cast(bf16x8, pw); }
            }
#pragma unroll
            for (int s2 = 0; s2 < 2; ++s2)
#pragma unroll
                for (int db = 0; db < 2; ++db) { const LAS v2u* vp = (const LAS v2u*)(VS + (32 * db + r32) * AT_VP + (32 * kb + 16 * s2 + 4 * hi) * 2);
                    const v2u a0 = vp[0], a1 = vp[2]; v4u aw; aw.x = a0.x; aw.y = a0.y; aw.z = a1.x; aw.w = a1.y; const bf16x8 va = __builtin_bit_cast(bf16x8, aw);
                    O[0][db] = __builtin_amdgcn_mfma_f32_32x32x16_bf16(va, pb[0][s2], O[0][db], 0, 0, 0);
                    O[1][db] = __builtin_amdgcn_mfma_f32_32x32x16_bf16(va, pb[1][s2], O[1][db], 0, 0, 0); }
        }
    }
    int r32e = r32, hie = hi; asm volatile("" : "+v"(r32e), "+v"(hie));
#pragma unroll
    for (int qt = 0; qt < 2; ++qt) { const float lt = lrun[qt] + __shfl_xor(lrun[qt], 32); const float rl = 1.0f / lt; const int tq = qa + 32 * qt + r32e;
#if FP8_OUTPROJ
        unsigned char* op8 = (unsigned char*)CC + (size_t)(rowbase + tq) * DM + hq * 64 + 4 * hie;
#pragma unroll
        for (int db = 0; db < 2; ++db)
#pragma unroll
            for (int rq = 0; rq < 4; ++rq) *(unsigned*)(op8 + 32 * db + 8 * rq) = pk4_fp8(O[qt][db][4 * rq] * rl, O[qt][db][4 * rq + 1] * rl, O[qt][db][4 * rq + 2] * rl, O[qt][db][4 * rq + 3] * rl); }
#else
        bf16* op = CC + (size_t)(rowbase + tq) * DM + hq * 64 + 4 * hie;
#pragma unroll
        for (int db = 0; db < 2; ++db)
#pragma unroll
            for (int rq = 0; rq < 4; ++rq) { v2u w; w.x = pk2(O[qt][db][4 * rq] * rl, O[qt][db][4 * rq + 1] * rl); w.y = pk2(O[qt][db][4 * rq + 2] * rl, O[qt][db][4 * rq + 3] * rl);
                *(v2u*)(op + 32 * db + 8 * rq) = w; } }
#endif
}
__device__ __forceinline__ void attn_phase(Frame& F, int l, int rep = 0) {
    const int nunits = 512 + (l == 0 ? 32 : 0);
    LAS int* slot = (LAS int*)(F.lds + LDS_X_OFF + 512);
    for (;;) {
        __syncthreads();
        if (F.tid == 0) *slot = (int)__hip_atomic_fetch_add(F.ctl + CW_ATQ + 64 * l + 8 * rep, 1u, RLX_AGENT);
        __syncthreads();
        const int u = __builtin_amdgcn_readfirstlane(*slot);
        if (u >= nunits) break;
        if (u < 512) attn_unit(F, l, u >> 7, (u >> 5) & 3, u & 31, 0); else { const int v = u - 512; attn_unit(F, l, v >> 3, (v >> 1) & 3, v & 1, 1); }
    }
}
#define USE_CHUNK_DN 1
#ifndef DN_SPLIT
#define DN_SPLIT 2
#endif
#ifndef DN_REP_S1
#define DN_REP_S1 1
#endif
#ifndef DN_REP_S3B
#define DN_REP_S3B 1
#endif
#ifndef DN_REP_S3A
#define DN_REP_S3A 1
#endif
#ifndef DN_REP_S4
#define DN_REP_S4 1
#endif

constexpr int DN_F_NEGW = 0, DN_F_QG = 16, DN_F_QK = 32, DN_F_KGT = 40, DN_NFRAG = 56, DN_U_OFF = 57344;
constexpr int DP_QS = 0, DP_KS = 17408, DP_VS = 34816, DP_AS = 52224  , DP_TB = 69632, DP_TW = 78848, DP_QK = 88064, DP_RAW = 52224  , DP_SC = 104960, DP_TF = 106496  , DP_XS = 123904  ;
constexpr int DP_P = 272, DP_P2 = 144;
__device__ __forceinline__ int dn_rec(int b, int h, int dir, int np) { return ((b * 4 + h) * 2 + dir) * 68 + np; }
__device__ __forceinline__ void dn_chunk_of(int ct, int dir, int& b, int& np) { if (ct < 256) { b = ct >> 6; const int c = ct & 63; np = 4 + (dir ? 63 - c : c); } else { b = (ct - 256) >> 2; const int c = (ct - 256) & 3; np = dir ? 3 - c : c; } }
__device__ __forceinline__ unsigned short lds_u16(const LAS unsigned char* p) { return *(const LAS unsigned short*)p; }

__device__ __forceinline__ void dn_prep_unit(Frame& F, int l, int ct, int h, int dir) {
    const bf16* P = (const bf16*)(F.ws + WS_P);
    int lane = F.lane; asm volatile("" : "+v"(lane));
    const int wave = F.wave, i16 = lane & 15, q = lane >> 4;
    const int m0 = ct * 64; int t0, T, base; seq_of(m0, t0, T, base);
    int b, np; dn_chunk_of(ct, dir, b, np);
    unsigned char* tile = F.ws + WS_DNT + (size_t)dn_rec(b, h, dir, np) * DNT_BYTES;
    LAS unsigned char* L = F.lds;
    LAS float* SC = (LAS float*)(L + DP_SC);
    LDS_BARRIER();
    {
        const float* cw = F.in[I_DNCW] + (size_t)l * 4 * 1536;
        LAS float* cwl = (LAS float*)(L + DP_TF);
        for (int i = F.tid; i < 3 * 4 * 128; i += NTHREADS) { const int part = i >> 9, j = (i >> 7) & 3, ch = i & 127; cwl[i] = cw[j * 1536 + part * 512 + h * 128 + ch]; }
        unsigned short pbw = 0, paw = 0;
        if (wave == 0) { const int tok = dir ? 63 - lane : lane; pbw = P[(size_t)(m0 + tok) * PW + PC_BETA + dir * 4 + h]; paw = P[(size_t)(m0 + tok) * PW + PC_DEC + dir * 4 + h]; }
        for (int c = F.tid; c < 67 * 48; c += NTHREADS) { const int row = c / 48, ch = c % 48, part = ch >> 4, cc = ch & 15, tt = t0 + row - 2;
            v4u v = (v4u){0u, 0u, 0u, 0u};
            if (tt >= 0 && tt < T) v = *(const v4u*)(P + (size_t)(base + tt) * PW + PC_DQ + part * 512 + h * 128 + cc * 8);
            *(LAS v4u*)(L + DP_RAW + row * 784 + part * 256 + cc * 16) = v; }
        LDS_BARRIER();
#pragma unroll 1
        for (int rep = 0; rep < DN_REP_S1; ++rep)
#pragma unroll
        for (int part = 0; part < 3; ++part) { const int tok = F.tid >> 3, g8 = F.tid & 7;
            float sv[16];
#pragma unroll
            for (int k = 0; k < 16; ++k) sv[k] = 0.f;
#pragma unroll
            for (int j = 0; j < 4; ++j) { const LAS v4u* rp = (const LAS v4u*)(L + DP_RAW + (tok + j) * 784 + part * 256 + g8 * 32); const v4u r0 = rp[0], r1 = rp[1];
                const LAS f32x4* wp = (const LAS f32x4*)(cwl + (part * 4 + j) * 128 + g8 * 16); const f32x4 w0 = wp[0], w1 = wp[1], w2 = wp[2], w3 = wp[3];
                sv[0] += w0.x * bflo(r0.x); sv[1] += w0.y * bfhi(r0.x); sv[2] += w0.z * bflo(r0.y); sv[3] += w0.w * bfhi(r0.y); sv[4] += w1.x * bflo(r0.z); sv[5] += w1.y * bfhi(r0.z); sv[6] += w1.z * bflo(r0.w); sv[7] += w1.w * bfhi(r0.w);
                sv[8] += w2.x * bflo(r1.x); sv[9] += w2.y * bfhi(r1.x); sv[10] += w2.z * bflo(r1.y); sv[11] += w2.w * bfhi(r1.y); sv[12] += w3.x * bflo(r1.z); sv[13] += w3.y * bfhi(r1.z); sv[14] += w3.z * bflo(r1.w); sv[15] += w3.w * bfhi(r1.w); }
            float ss = 0.f;
#pragma unroll
            for (int k = 0; k < 16; ++k) { sv[k] = siluf_(sv[k]); ss += sv[k] * sv[k]; }
            if (part < 2) { ss += dpp_mov<0xB1>(ss); ss += dpp_mov<0x4E>(ss); ss += dpp_mov<0x141>(ss);
                const float f = (part == 0 ? 0.08838834764831845f : 1.0f) * __builtin_amdgcn_rsqf(ss + EPS);
#pragma unroll
                for (int k = 0; k < 16; ++k) sv[k] *= f; }
            LAS v4u* op = (LAS v4u*)(L + (part == 0 ? DP_QS : (part == 1 ? DP_KS : DP_VS)) + tok * DP_P + g8 * 32);
            op[0] = (v4u){pk2(sv[0], sv[1]), pk2(sv[2], sv[3]), pk2(sv[4], sv[5]), pk2(sv[6], sv[7])}; op[1] = (v4u){pk2(sv[8], sv[9]), pk2(sv[10], sv[11]), pk2(sv[12], sv[13]), pk2(sv[14], sv[15])}; }
        if (wave == 0) {
            const float pb = bf2f(pbw), pa = bf2f(paw);
            const float beta = sigmoidf_(pb); float gc = -__expf(F.in[I_DNALOG][l * 8 + dir * 4 + h]) * softplusf_(pa + F.in[I_DNDT][l * 8 + dir * 4 + h]);
#pragma unroll
            for (int o = 1; o < 64; o <<= 1) { const float v = __shfl_up(gc, o); if (lane >= o) gc += v; }
            const float glast = __shfl(gc, 63);
            SC[lane] = beta; SC[64 + lane] = gc; SC[128 + lane] = __expf(gc); SC[192 + lane] = __expf(glast - gc);
            if (lane == 63) ((float*)(F.ws + WS_DNS))[dn_rec(b, h, dir, np)] = __expf(glast);
        }
    }
    LDS_BARRIER();
#define DN_TOK(r) (dir ? 63 - (r) : (r))
#pragma unroll 1
    for (int rep = 0; rep < DN_REP_S3A; ++rep)
    {
        const int mb = wave & 3, which = wave >> 2;
        f32x4 acc[4];
#pragma unroll
        for (int nb = 0; nb < 4; ++nb) acc[nb] = (f32x4){0.f, 0.f, 0.f, 0.f};
        const LAS unsigned char* arow = L + (which ? DP_QS : DP_KS) + DN_TOK(16 * mb + i16) * DP_P + 16 * q;
#pragma unroll
        for (int ks = 0; ks < 4; ++ks) { const bf16x8 a = *(const LAS bf16x8*)(arow + 64 * ks);
#pragma unroll
            for (int nb = 0; nb < 4; ++nb) { const bf16x8 bb = *(const LAS bf16x8*)(L + DP_KS + DN_TOK(16 * nb + i16) * DP_P + 16 * q + 64 * ks);
                acc[nb] = __builtin_amdgcn_mfma_f32_16x16x32_bf16(a, bb, acc[nb], 0, 0, 0); } }
#pragma unroll
        for (int nb = 0; nb < 4; ++nb)
#pragma unroll
            for (int i = 0; i < 4; ++i) { const int r = 16 * mb + 4 * q + i, c = 16 * nb + i16; const float dec = __expf(SC[64 + r] - SC[64 + c]);
                if (which == 0) ((LAS float*)(L + DP_AS))[r * 68 + c] = (r > c) ? SC[r] * acc[nb][i] * dec : 0.f;
                else *(LAS unsigned short*)(L + DP_QK + r * DP_P2 + c * 2) = (unsigned short)f2bf((r >= c) ? acc[nb][i] * dec : 0.f); }
    }
    LDS_BARRIER();
#pragma unroll 1
    for (int rep = 0; rep < DN_REP_S3B; ++rep) {
    if (wave == 0) {
        const LAS float* As = (const LAS float*)(L + DP_AS); LAS float* Tf = (LAS float*)(L + DP_TF);
        const int g = lane >> 4, c = lane & 15;
        f32x4 ar[16][4];
#pragma unroll
        for (int r = 1; r < 16; ++r)
#pragma unroll
            for (int j4 = 0; j4 < (r + 3) / 4; ++j4) ar[r][j4] = *(const LAS f32x4*)(As + (16 * g + r) * 68 + 16 * g + 4 * j4);
        float t[16];
#pragma unroll
        for (int r = 0; r < 16; ++r) { float a0 = (c == r) ? 1.f : 0.f, a1 = 0.f;
#pragma unroll
            for (int j = 0; j < r; ++j) { const float av = ar[r][j >> 2][j & 3]; if (j & 1) a1 -= av * t[j]; else a0 -= av * t[j]; }
            t[r] = a0 + a1; Tf[(16 * g + r) * 68 + 16 * g + c] = t[r]; }
    }
    LDS_BARRIER();
    if (wave < 3) {
        const LAS float* As = (const LAS float*)(L + DP_AS); LAS float* Tf = (LAS float*)(L + DP_TF); LAS float* Xs = (LAS float*)(L + DP_XS) + wave * 272;
        const int J = wave;
#pragma unroll 1
        for (int I = J + 1; I < 4; ++I) {
            f32x4 acc = {0.f, 0.f, 0.f, 0.f};
#pragma unroll 1
            for (int K = J; K < I; ++K)
#pragma unroll
                for (int sk = 0; sk < 4; ++sk) acc = __builtin_amdgcn_mfma_f32_16x16x4f32(As[(16 * I + i16) * 68 + 16 * K + 4 * sk + q], Tf[(16 * K + 4 * sk + q) * 68 + 16 * J + i16], acc, 0, 0, 0);
#pragma unroll
            for (int i = 0; i < 4; ++i) Xs[(4 * q + i) * 17 + i16] = acc[i];
            LDS_WAIT(); asm volatile("" ::: "memory");
            f32x4 acc2 = {0.f, 0.f, 0.f, 0.f};
#pragma unroll
            for (int sk = 0; sk < 4; ++sk) acc2 = __builtin_amdgcn_mfma_f32_16x16x4f32(Tf[(16 * I + i16) * 68 + 16 * I + 4 * sk + q], Xs[(4 * sk + q) * 17 + i16], acc2, 0, 0, 0);
#pragma unroll
            for (int i = 0; i < 4; ++i) Tf[(16 * I + 4 * q + i) * 68 + 16 * J + i16] = -acc2[i];
            LDS_WAIT(); asm volatile("" ::: "memory");
        }
    }
    LDS_BARRIER();
    { const LAS float* Tf = (const LAS float*)(L + DP_TF); const int r = F.tid >> 3, c0 = (F.tid & 7) * 8; float vb[8], vw[8];
#pragma unroll
      for (int k = 0; k < 8; ++k) { const int c = c0 + k; const float v = ((r >> 4) >= (c >> 4)) ? Tf[r * 68 + c] : 0.f; const float bl = SC[c]; vb[k] = v * bl; vw[k] = vb[k] * SC[128 + c]; }
      v4u ob, ow; ob.x = pk2(vb[0], vb[1]); ob.y = pk2(vb[2], vb[3]); ob.z = pk2(vb[4], vb[5]); ob.w = pk2(vb[6], vb[7]); ow.x = pk2(vw[0], vw[1]); ow.y = pk2(vw[2], vw[3]); ow.z = pk2(vw[4], vw[5]); ow.w = pk2(vw[6], vw[7]);
      *(LAS v4u*)(L + DP_TB + r * DP_P2 + c0 * 2) = ob; *(LAS v4u*)(L + DP_TW + r * DP_P2 + c0 * 2) = ow; }
    }
    LDS_BARRIER();
    {
        const int nbp = wave & 3, which = wave >> 2;
        f32x4 acc[4][2];
#pragma unroll
        for (int mb = 0; mb < 4; ++mb) { acc[mb][0] = (f32x4){0.f, 0.f, 0.f, 0.f}; acc[mb][1] = (f32x4){0.f, 0.f, 0.f, 0.f}; }
#pragma unroll
        for (int ks = 0; ks < 2; ++ks) {
            bf16x8 bb[2];
#pragma unroll
            for (int nn = 0; nn < 2; ++nn) { const int n = 16 * (2 * nbp + nn) + i16; unsigned short e[8];
#pragma unroll
                for (int jj = 0; jj < 8; ++jj) e[jj] = lds_u16(L + (which ? DP_KS : DP_VS) + DN_TOK(32 * ks + 8 * q + jj) * DP_P + n * 2);
                v4u w; w.x = e[0] | ((unsigned)e[1] << 16); w.y = e[2] | ((unsigned)e[3] << 16); w.z = e[4] | ((unsigned)e[5] << 16); w.w = e[6] | ((unsigned)e[7] << 16); bb[nn] = __builtin_bit_cast(bf16x8, w); }
#pragma unroll
            for (int mb = 0; mb < 4; ++mb) { const bf16x8 a = *(const LAS bf16x8*)(L + (which ? DP_TW : DP_TB) + (16 * mb + i16) * DP_P2 + 64 * ks + 16 * q);
                acc[mb][0] = __builtin_amdgcn_mfma_f32_16x16x32_bf16(a, bb[0], acc[mb][0], 0, 0, 0); acc[mb][1] = __builtin_amdgcn_mfma_f32_16x16x32_bf16(a, bb[1], acc[mb][1], 0, 0, 0); } }
        if (which == 0) {
#pragma unroll
            for (int mb = 0; mb < 4; ++mb)
#pragma unroll
                for (int nn = 0; nn < 2; ++nn) *(f32x4*)(tile + DN_U_OFF + (size_t)((((2 * nbp + nn) * 4 + mb) * 64 + lane) * 16)) = acc[mb][nn];
        } else {
#pragma unroll
            for (int mb = 0; mb < 4; ++mb)
#pragma unroll
                for (int nn = 0; nn < 2; ++nn)
#pragma unroll
                    for (int i = 0; i < 4; ++i) *(LAS unsigned short*)(L + DP_AS + (16 * mb + 4 * q + i) * DP_P + (16 * (2 * nbp + nn) + i16) * 2) = (unsigned short)f2bf(-acc[mb][nn][i]);
        }
    }
    LDS_BARRIER();
#pragma unroll 1
    for (int rep = 0; rep < DN_REP_S4; ++rep)
#pragma unroll 1
    for (int fi = 0; fi < 7; ++fi) { const int f = wave * 7 + fi; v4u o;
        if (f < DN_F_QG) { const int mb = f >> 2, ks = f & 3; const LAS unsigned char* rp = L + DP_AS + (16 * mb + i16) * DP_P + (32 * ks + 4 * q) * 2;
            const v2u a = *(const LAS v2u*)rp, c = *(const LAS v2u*)(rp + 32); o.x = a.x; o.y = a.y; o.z = c.x; o.w = c.y; }
        else if (f < DN_F_QK) { const int ff = f - DN_F_QG, mb = ff >> 2, ks = ff & 3, r = 16 * mb + i16; const LAS unsigned char* rp = L + DP_QS + DN_TOK(r) * DP_P + (32 * ks + 4 * q) * 2; const float eg = SC[128 + r];
            const v2u a = *(const LAS v2u*)rp, c = *(const LAS v2u*)(rp + 32);
            o.x = pk2(bflo(a.x) * eg, bfhi(a.x) * eg); o.y = pk2(bflo(a.y) * eg, bfhi(a.y) * eg); o.z = pk2(bflo(c.x) * eg, bfhi(c.x) * eg); o.w = pk2(bflo(c.y) * eg, bfhi(c.y) * eg); }
        else if (f < DN_F_KGT) { const int ff = f - DN_F_QK, mb = ff >> 1, ks = ff & 1; const LAS unsigned char* rp = L + DP_QK + (16 * mb + i16) * DP_P2 + (32 * ks + 4 * q) * 2;
            const v2u a = *(const LAS v2u*)rp, c = *(const LAS v2u*)(rp + 32); o.x = a.x; o.y = a.y; o.z = c.x; o.w = c.y; }
        else { const int ff = f - DN_F_KGT, mb = ff >> 1, ks = ff & 1, dk = 16 * mb + i16; float e[8];
#pragma unroll
            for (int jj = 0; jj < 8; ++jj) { const int key = 32 * ks + 16 * (jj >> 2) + 4 * q + (jj & 3); e[jj] = bf2f(lds_u16(L + DP_KS + DN_TOK(key) * DP_P + dk * 2)) * SC[192 + key]; }
            o.x = pk2(e[0], e[1]); o.y = pk2(e[2], e[3]); o.z = pk2(e[4], e[5]); o.w = pk2(e[6], e[7]); }
        *(v4u*)(tile + (size_t)f * 1024 + lane * 16) = o; }
#undef DN_TOK
}
__device__ __forceinline__ void dn_prep(Frame& F, int l) {
    for (int u = F.bid; u < NCT * 4 * 2; u += F.G) dn_prep_unit(F, l, u >> 3, (u >> 1) & 3, u & 1);
    __syncthreads();
}

__device__ __forceinline__ void dn_scan(Frame& F, int l, int b, int h, int dir, int half) {
    int lane = F.lane; asm volatile("" : "+v"(lane));
    const int w = (DN_SPLIT == 2) ? half * 4 + (F.wave & 3) : F.wave, i16 = lane & 15, q = lane >> 4; const bool active = (DN_SPLIT == 2) ? (F.wave < 4) : true;
    const unsigned char* tiles = F.ws + WS_DNT + (size_t)dn_rec(b, h, dir, 0) * DNT_BYTES;
    const float* egl = (const float*)(F.ws + WS_DNS) + dn_rec(b, h, dir, 0);
    bf16* Ob = (bf16*)(F.ws + WS_DNO);
    LAS unsigned char* L = F.lds;
    f32x4 S[8];
#pragma unroll
    for (int i = 0; i < 8; ++i) S[i] = (f32x4){0.f, 0.f, 0.f, 0.f};
    v4u st[7]; f32x4 un[4];
#pragma unroll
    for (int mb = 0; mb < 4; ++mb) un[mb] = *(const f32x4*)(tiles + DN_U_OFF + (size_t)(((w * 4 + mb) * 64 + lane) * 16));
    LDS_BARRIER();
#pragma unroll
    for (int i = 0; i < 7; ++i) st[i] = *(const v4u*)(tiles + (size_t)(F.tid + i * NTHREADS) * 16);
#pragma unroll
    for (int i = 0; i < 7; ++i) *(LAS v4u*)(L + (F.tid + i * NTHREADS) * 16) = st[i];
#pragma unroll
    for (int i = 0; i < 7; ++i) st[i] = *(const v4u*)(tiles + DNT_BYTES + (size_t)(F.tid + i * NTHREADS) * 16);
    LDS_BARRIER();
#pragma unroll 1
    for (int n = 0; n < 68; ++n) {
        const unsigned char* tile = tiles + (size_t)n * DNT_BYTES; const LAS unsigned char* cur = L + (n & 1) * 57344;
        if (n + 1 < 68) {
#pragma unroll
            for (int i = 0; i < 7; ++i) *(LAS v4u*)(L + ((n + 1) & 1) * 57344 + (F.tid + i * NTHREADS) * 16) = st[i]; }
        if (n + 2 < 68) {
#pragma unroll
            for (int i = 0; i < 7; ++i) st[i] = *(const v4u*)(tile + 2 * DNT_BYTES + (size_t)(F.tid + i * NTHREADS) * 16); }
        if (active) {
        f32x4 vn[4];
#pragma unroll
        for (int mb = 0; mb < 4; ++mb) vn[mb] = un[mb];
        if (n + 1 < 68) {
#pragma unroll
            for (int mb = 0; mb < 4; ++mb) un[mb] = *(const f32x4*)(tile + DNT_BYTES + DN_U_OFF + (size_t)(((w * 4 + mb) * 64 + lane) * 16)); }
        const float el = egl[n];
        bf16x8 bS[4];
#pragma unroll
        for (int ks = 0; ks < 4; ++ks) { v4u x; x.x = pk2(S[2 * ks][0], S[2 * ks][1]); x.y = pk2(S[2 * ks][2], S[2 * ks][3]); x.z = pk2(S[2 * ks + 1][0], S[2 * ks + 1][1]); x.w = pk2(S[2 * ks + 1][2], S[2 * ks + 1][3]); bS[ks] = __builtin_bit_cast(bf16x8, x); }
        f32x4 o[4];
#pragma unroll
        for (int mb = 0; mb < 4; ++mb) { o[mb] = (f32x4){0.f, 0.f, 0.f, 0.f};
#pragma unroll
            for (int ks = 0; ks < 4; ++ks) { const bf16x8 aw = *(const LAS bf16x8*)(cur + (DN_F_NEGW + mb * 4 + ks) * 1024 + lane * 16), aq = *(const LAS bf16x8*)(cur + (DN_F_QG + mb * 4 + ks) * 1024 + lane * 16);
                vn[mb] = __builtin_amdgcn_mfma_f32_16x16x32_bf16(aw, bS[ks], vn[mb], 0, 0, 0); o[mb] = __builtin_amdgcn_mfma_f32_16x16x32_bf16(aq, bS[ks], o[mb], 0, 0, 0); } }
        bf16x8 bV[2];
#pragma unroll
        for (int ks = 0; ks < 2; ++ks) { v4u x; x.x = pk2(vn[2 * ks][0], vn[2 * ks][1]); x.y = pk2(vn[2 * ks][2], vn[2 * ks][3]); x.z = pk2(vn[2 * ks + 1][0], vn[2 * ks + 1][1]); x.w = pk2(vn[2 * ks + 1][2], vn[2 * ks + 1][3]); bV[ks] = __builtin_bit_cast(bf16x8, x); }
#pragma unroll
        for (int mb = 0; mb < 8; ++mb) { S[mb] = S[mb] * el;
#pragma unroll
            for (int ks = 0; ks < 2; ++ks) { const bf16x8 ak = *(const LAS bf16x8*)(cur + (DN_F_KGT + mb * 2 + ks) * 1024 + lane * 16); S[mb] = __builtin_amdgcn_mfma_f32_16x16x32_bf16(ak, bV[ks], S[mb], 0, 0, 0); } }
#pragma unroll
        for (int mb = 0; mb < 4; ++mb)
#pragma unroll
            for (int ks = 0; ks < 2; ++ks) { const bf16x8 aqk = *(const LAS bf16x8*)(cur + (DN_F_QK + mb * 2 + ks) * 1024 + lane * 16); o[mb] = __builtin_amdgcn_mfma_f32_16x16x32_bf16(aqk, bV[ks], o[mb], 0, 0, 0); }
        { int m0; if (n < 4) m0 = NLAT + b * CTXL + 64 * (dir ? 3 - n : n); else m0 = b * SEQ + 64 * (dir ? 63 - (n - 4) : (n - 4));
#pragma unroll
          for (int mb = 0; mb < 4; ++mb)
#pragma unroll
            for (int i = 0; i < 4; ++i) { const int r = 16 * mb + 4 * q + i, tok = dir ? 63 - r : r; Ob[((size_t)dir * NTOK + m0 + tok) * 512 + h * 128 + 16 * w + i16] = (bf16)f2bf(o[mb][i]); } }
        }
        LDS_BARRIER();
    }
}
#define USE_CHUNK_LRU 1

constexpr int LR_XF = 0  , LR_XB = 16640  , LR_WT = 25856  , LR_AA = 62720  , LR_UU = 96000  , LR_END = 129280;
constexpr size_t WS_LCA = WS_LRC, WS_LCH = WS_LRC + 2 * MiB, WS_LCI = WS_LRC + 4 * MiB;
__device__ __forceinline__ void lru_prep(Frame& F, int l) {
    const bf16* P = (const bf16*)(F.ws + WS_P);
    int lane = F.lane; asm volatile("" : "+v"(lane));
    const int wave = F.wave, i16 = lane & 15, q = lane >> 4, nb = F.bid & 7;
    LAS unsigned char* L = F.lds;
    LAS float* XF = (LAS float*)(L + LR_XF); LAS float* AA = (LAS float*)(L + LR_AA); LAS float* UU = (LAS float*)(L + LR_UU);
    bf16* HL = (bf16*)(F.ws + WS_LRH); bf16* AC = (bf16*)(F.ws + WS_LRA);
    __syncthreads();
    for (int e = F.tid; e < 4 * 4096; e += NTHREADS) { const int mat = e >> 12, ii = (e >> 6) & 63, j = e & 63, dir = mat >> 1;
        const float w = (mat & 1 ? F.in[I_LRWI] : F.in[I_LRWR])[((size_t)((l * 2 + dir) * 8 + nb)) * 4096 + ii * 64 + j];
        *(LAS unsigned short*)(L + LR_WT + (mat * 64 + j) * 144 + ii * 2) = (unsigned short)f2bf(w); }
    float cwv[4][8], cbv[8];
    { const int c8 = (F.tid & 7) * 8, ch0 = nb * 64 + c8; const float* cb = F.in[I_LRCB] + l * 512 + ch0; const float* cw = F.in[I_LRCW] + (size_t)l * 4 * 512 + ch0;
#pragma unroll
      for (int k = 0; k < 8; ++k) cbv[k] = cb[k];
#pragma unroll
      for (int j = 0; j < 4; ++j)
#pragma unroll
        for (int k = 0; k < 8; ++k) cwv[j][k] = cw[j * 512 + k]; }
    float gbr[4], gbi[4], gls[4];
    { const int dir = wave >> 2;
#pragma unroll
      for (int n = 0; n < 4; ++n) { const int ch = nb * 64 + 16 * n + i16; gbr[n] = F.in[I_LRBR][(l * 2 + dir) * 512 + ch]; gbi[n] = F.in[I_LRBI][(l * 2 + dir) * 512 + ch]; gls[n] = -softplusf_(-F.in[I_LRLAM][(l * 2 + dir) * 512 + ch]); } }
    v4u wv[4];
#define LR_LOADRAW(ctx) do { const int _m0 = (ctx) * 64; int _t0, _T, _base; seq_of(_m0, _t0, _T, _base); const int _tok = F.tid >> 3, _ch0 = nb * 64 + (F.tid & 7) * 8; \
        _Pragma("unroll") for (int j = 0; j < 4; ++j) { const int tt = _t0 + _tok + j - 2; wv[j] = (v4u){0u, 0u, 0u, 0u}; if (tt >= 0 && tt < _T) wv[j] = *(const v4u*)(P + (size_t)(_base + tt) * PW + PC_LX + _ch0); } } while (0)
    if ((F.bid >> 3) < NCT) LR_LOADRAW(F.bid >> 3);
    for (int ct = F.bid >> 3; ct < NCT; ct += F.G >> 3) {
        const int m0 = ct * 64;
        LDS_BARRIER();
        { const int tok = F.tid >> 3, c8 = (F.tid & 7) * 8, ch0 = nb * 64 + c8; float s[8];
#pragma unroll
          for (int k = 0; k < 8; ++k) s[k] = cbv[k];
#pragma unroll
          for (int j = 0; j < 4; ++j) { const v4u w = wv[j];
              s[0] += cwv[j][0] * bflo(w.x); s[1] += cwv[j][1] * bfhi(w.x); s[2] += cwv[j][2] * bflo(w.y); s[3] += cwv[j][3] * bfhi(w.y); s[4] += cwv[j][4] * bflo(w.z); s[5] += cwv[j][5] * bfhi(w.z); s[6] += cwv[j][6] * bflo(w.w); s[7] += cwv[j][7] * bfhi(w.w); }
#pragma unroll
          for (int k = 0; k < 8; ++k) XF[tok * 65 + c8 + k] = s[k];
          v4u o; o.x = pk2(s[0], s[1]); o.y = pk2(s[2], s[3]); o.z = pk2(s[4], s[5]); o.w = pk2(s[6], s[7]); *(LAS v4u*)(L + LR_XB + tok * 144 + c8 * 2) = o; }
        if (ct + (F.G >> 3) < NCT) LR_LOADRAW(ct + (F.G >> 3));
        LDS_BARRIER();
        { const int dir = wave >> 2, mb = wave & 3;
          f32x4 ar[4], ai[4];
#pragma unroll
          for (int n = 0; n < 4; ++n) { ar[n] = (f32x4){0.f, 0.f, 0.f, 0.f}; ai[n] = (f32x4){0.f, 0.f, 0.f, 0.f}; }
#pragma unroll
          for (int ks = 0; ks < 2; ++ks) { const bf16x8 a = *(const LAS bf16x8*)(L + LR_XB + (16 * mb + i16) * 144 + 64 * ks + 16 * q);
#pragma unroll
              for (int n = 0; n < 4; ++n) { const bf16x8 br = *(const LAS bf16x8*)(L + LR_WT + ((dir * 2 + 0) * 64 + 16 * n + i16) * 144 + 64 * ks + 16 * q), bi = *(const LAS bf16x8*)(L + LR_WT + ((dir * 2 + 1) * 64 + 16 * n + i16) * 144 + 64 * ks + 16 * q);
                  ar[n] = __builtin_amdgcn_mfma_f32_16x16x32_bf16(a, br, ar[n], 0, 0, 0); ai[n] = __builtin_amdgcn_mfma_f32_16x16x32_bf16(a, bi, ai[n], 0, 0, 0); } }
#pragma unroll
          for (int n = 0; n < 4; ++n) { const int j = 16 * n + i16; const float br_ = gbr[n], bi_ = gbi[n], logsig = gls[n];
#pragma unroll
              for (int i = 0; i < 4; ++i) { const int tok = 16 * mb + 4 * q + i; const float r = sigmoidf_(ar[n][i] + br_), ig = sigmoidf_(ai[n][i] + bi_);
                  const float log_a = 8.0f * r * logsig, a = __expf(log_a), y2 = 2.0f * log_a;
                  const float om = (y2 > -0.1f) ? -y2 * (1.0f + y2 * (0.5f + y2 * (0.16666667f + y2 * 0.041666668f))) : 1.0f - __expf(y2);
                  const float u = __builtin_amdgcn_sqrtf(om) * (ig * XF[tok * 65 + j]);
                  AA[(dir * 64 + tok) * 65 + j] = a; UU[(dir * 64 + tok) * 65 + j] = u; } } }
        LDS_BARRIER();
        if (F.tid < 128) { const int dir = F.tid >> 6, j = F.tid & 63, ch = nb * 64 + j; float h = 0.f, ac = 1.f;
            long o = (long)(((size_t)dir * NTOK + m0 + (dir ? 63 : 0)) * 512 + ch); const long ostep = dir ? -512 : 512;
#pragma unroll 1
            for (int s0 = 0; s0 < 64; s0 += 8) { float av[8], uv[8];
#pragma unroll
                for (int k = 0; k < 8; ++k) { const int tok = dir ? 63 - (s0 + k) : (s0 + k); av[k] = AA[(dir * 64 + tok) * 65 + j]; uv[k] = UU[(dir * 64 + tok) * 65 + j]; }
#pragma unroll
                for (int k = 0; k < 8; ++k) { h = av[k] * h + uv[k]; ac *= av[k]; HL[o] = (bf16)f2bf(h); AC[o] = (bf16)f2bf(ac); o += ostep; } }
            ((float*)(F.ws + WS_LCA))[((size_t)dir * NCT + ct) * 512 + ch] = ac; ((float*)(F.ws + WS_LCH))[((size_t)dir * NCT + ct) * 512 + ch] = h; }
    }
    LDS_BARRIER();
}
__device__ __forceinline__ void lru_carry(Frame& F, int idx) {
    const int ch = idx & 511, dir = (idx >> 9) & 1, b = idx >> 10;
    const float* CA = (const float*)(F.ws + WS_LCA); const float* CH = (const float*)(F.ws + WS_LCH); float* CI = (float*)(F.ws + WS_LCI);
    float h = 0.f;
#pragma unroll 4
    for (int n = 0; n < 68; ++n) { const int ct = n < 4 ? 256 + b * 4 + (dir ? 3 - n : n) : b * 64 + (dir ? 63 - (n - 4) : (n - 4)); const size_t o = ((size_t)dir * NCT + ct) * 512 + ch;
        CI[o] = h; h = CA[o] * h + CH[o]; }
}
__device__ __forceinline__ void lru_fin(Frame& F, int l) {
    const int nrows = (l == 0) ? NTOK : NLAT;
    const bf16* P = (const bf16*)(F.ws + WS_P); bf16* CC = (bf16*)(F.ws + WS_CC);
    const bf16* HL = (const bf16*)(F.ws + WS_LRH); const bf16* AC = (const bf16*)(F.ws + WS_LRA); const float* CI = (const float*)(F.ws + WS_LCI);
    for (size_t i = (size_t)F.bid * NTHREADS + F.tid; i < (size_t)nrows * 128; i += (size_t)F.G * NTHREADS) { const int m = (int)(i >> 7), c4 = (int)(i & 127) * 4, ct = m >> 6;
        const v2u hw0 = *(const v2u*)(HL + (size_t)m * 512 + c4), aw0 = *(const v2u*)(AC + (size_t)m * 512 + c4), hw1 = *(const v2u*)(HL + ((size_t)NTOK + m) * 512 + c4), aw1 = *(const v2u*)(AC + ((size_t)NTOK + m) * 512 + c4);
        const f32x4 h0 = {bflo(hw0.x), bfhi(hw0.x), bflo(hw0.y), bfhi(hw0.y)}, a0 = {bflo(aw0.x), bfhi(aw0.x), bflo(aw0.y), bfhi(aw0.y)}, h1 = {bflo(hw1.x), bfhi(hw1.x), bflo(hw1.y), bfhi(hw1.y)}, a1 = {bflo(aw1.x), bfhi(aw1.x), bflo(aw1.y), bfhi(aw1.y)};
        const f32x4 i0 = *(const f32x4*)(CI + (size_t)ct * 512 + c4), i1 = *(const f32x4*)(CI + ((size_t)NCT + ct) * 512 + c4);
        const f32x4 hs = (a0 * i0 + h0) + (a1 * i1 + h1); const v2u yw = *(const v2u*)(P + (size_t)m * PW + PC_LY + c4);
#if FP8_OUTPROJ
        *(unsigned*)((unsigned char*)CC + (size_t)m * DM + 1536 + c4) = pk4_fp8(hs.x * gelu_tanh(bflo(yw.x)), hs.y * gelu_tanh(bfhi(yw.x)), hs.z * gelu_tanh(bflo(yw.y)), hs.w * gelu_tanh(bfhi(yw.y))); }
#else
        v2u o; o.x = pk2(hs.x * gelu_tanh(bflo(yw.x)), hs.y * gelu_tanh(bfhi(yw.x))); o.y = pk2(hs.z * gelu_tanh(bflo(yw.y)), hs.w * gelu_tanh(bfhi(yw.y)));
        *(v2u*)(CC + (size_t)m * DM + 1536 + c4) = o; }
#endif
}

constexpr size_t WS_DNQ = WS_DNT;
constexpr size_t WS_BG = WS_DNS + 1 * MiB;
constexpr size_t WS_XC = WS_XS;

__device__ __forceinline__ void naive_prep(Frame& F, int l) {
    const bf16* P = (const bf16*)(F.ws + WS_P);
    const int gw = F.bid * NWAVES + F.wave, NGW = F.G * NWAVES;
#if !defined(USE_CHUNK_DN)
    {
        float* DNQ = (float*)(F.ws + WS_DNQ); float* BG = (float*)(F.ws + WS_BG);
        const float* cw = F.in[I_DNCW] + (size_t)l * 4 * 1536;
        for (int it = gw; it < NTOK * 4; it += NGW) {
            const int m = it >> 2, h = it & 3; int t, T, base; seq_of(m, t, T, base);
            float val[3][2];
#pragma unroll
            for (int part = 0; part < 3; ++part)
#pragma unroll
                for (int dd = 0; dd < 2; ++dd) { const int d = F.lane + 64 * dd, cch = part * 512 + h * 128 + d, col = PC_DQ + cch; float s = 0.f;
#pragma unroll
                    for (int j = 0; j < 4; ++j) { const int tt = t + j - 2; if (tt >= 0 && tt < T) s += cw[j * 1536 + cch] * bf2f(P[(size_t)(base + tt) * PW + col]); }
                    val[part][dd] = siluf_(s); }
            const float sq = wave_sum(val[0][0] * val[0][0] + val[0][1] * val[0][1]), sk = wave_sum(val[1][0] * val[1][0] + val[1][1] * val[1][1]);
            const float fq = 0.08838834764831845f / sqrtf(sq + EPS), fk = 1.0f / sqrtf(sk + EPS);
#pragma unroll
            for (int dd = 0; dd < 2; ++dd) { const int d = F.lane + 64 * dd; float* o = DNQ + (size_t)m * 1536 + h * 128 + d;
                o[0] = val[0][dd] * fq; o[512] = val[1][dd] * fk; o[1024] = val[2][dd]; }
            if (h == 0 && F.lane < 8) { const int dir = F.lane >> 2, hh = F.lane & 3;
                const float pb = bf2f(P[(size_t)m * PW + PC_BETA + F.lane]), pa = bf2f(P[(size_t)m * PW + PC_DEC + F.lane]);
                BG[m * 16 + F.lane] = sigmoidf_(pb);
                BG[m * 16 + 8 + F.lane] = -__expf(F.in[I_DNALOG][l * 8 + dir * 4 + hh]) * softplusf_(pa + F.in[I_DNDT][l * 8 + dir * 4 + hh]); }
        }
    }
#endif
#if !defined(USE_CHUNK_LRU)
    {
        LAS float* xc = (LAS float*)F.lds;
        float* A = (float*)(F.ws + WS_LRA); float* U = (float*)(F.ws + WS_LRH);
        const float* cw = F.in[I_LRCW] + (size_t)l * 4 * 512; const float* cb = F.in[I_LRCB] + l * 512;
        for (int m0 = F.bid * 8; m0 < NTOK; m0 += F.G * 8) {
            __syncthreads();
            for (int i = F.tid; i < 8 * 512; i += NTHREADS) { const int m = m0 + (i >> 9), ch = i & 511; int t, T, base; seq_of(m, t, T, base); float s = cb[ch];
#pragma unroll
                for (int j = 0; j < 4; ++j) { const int tt = t + j - 2; if (tt >= 0 && tt < T) s += cw[j * 512 + ch] * bf2f(P[(size_t)(base + tt) * PW + PC_LX + ch]); }
                xc[i] = s; }
            __syncthreads();
            for (int i = F.tid; i < 8 * 512 * 2; i += NTHREADS) { const int ch = i & 511, dir = (i >> 9) & 1, tk = i >> 10, m = m0 + tk, blk = ch >> 6, j = ch & 63;
                const float* wr = F.in[I_LRWR] + ((size_t)((l * 2 + dir) * 8 + blk)) * 4096 + j; const float* wi = F.in[I_LRWI] + ((size_t)((l * 2 + dir) * 8 + blk)) * 4096 + j;
                float sr = F.in[I_LRBR][(l * 2 + dir) * 512 + ch], si = F.in[I_LRBI][(l * 2 + dir) * 512 + ch];
#pragma unroll 8
                for (int ii = 0; ii < 64; ++ii) { const float x = xc[tk * 512 + blk * 64 + ii]; sr += x * wr[ii * 64]; si += x * wi[ii * 64]; }
                const float r = sigmoidf_(sr), ig = sigmoidf_(si); const float lam = F.in[I_LRLAM][(l * 2 + dir) * 512 + ch];
                const float logsig = -softplusf_(-lam);
                const float log_a = 8.0f * r * logsig; const float a = __expf(log_a);
                const float u = sqrtf(-expm1f(2.0f * log_a)) * (ig * xc[tk * 512 + ch]);
                A[((size_t)dir * NTOK + m) * 512 + ch] = a; U[((size_t)dir * NTOK + m) * 512 + ch] = u; }
        }
        __syncthreads();
    }
#endif
}

__device__ __forceinline__ void naive_attn_row(Frame& F, int l, int m, int hq) {
    const bf16* P = (const bf16*)(F.ws + WS_P); bf16* CC = (bf16*)(F.ws + WS_CC);
    const int d = F.lane, kvh = hq >> 2; int t, T, base; seq_of(m, t, T, base);
    const bool lat = m < NLAT; const int b = lat ? (m >> 12) : ((m - NLAT) >> 8);
    const int dd = d & 31, jf = dd & 15; const float inv = __powf(10000.0f, -(float)jf * (1.0f / 16.0f));
    const bool second = (dd >= 16), colhalf = (d >= 32);
    float q = bf2f(P[(size_t)m * PW + PC_Q + hq * 64 + d]);
    if (lat) { const float pos = (float)(colhalf ? (t & 63) : (t >> 6)); float sn, cs; sincosf(pos * inv, &sn, &cs); const float pr = __shfl_xor(q, 16); q = second ? (q * cs + pr * sn) : (q * cs - pr * sn); }
    q *= 0.125f;
    float mx = F.in[I_SINK][l * 16 + hq], den = 1.0f, acc = 0.f;
    if (lat) { const int t0 = t - 128 < 0 ? 0 : t - 128, t1 = t + 128 > SEQ - 1 ? SEQ - 1 : t + 128;
        for (int tk = t0; tk <= t1; ++tk) { const size_t r = (size_t)(base + tk) * PW; float k = bf2f(P[r + PC_K + kvh * 64 + d]); const float v = bf2f(P[r + PC_V + kvh * 64 + d]);
            const float pos = (float)(colhalf ? (tk & 63) : (tk >> 6)); float sn, cs; sincosf(pos * inv, &sn, &cs); const float pr = __shfl_xor(k, 16); k = second ? (k * cs + pr * sn) : (k * cs - pr * sn);
            const float s = wave_sum(q * k); const float mn = fmaxf(mx, s), f = __expf(mx - mn), p = __expf(s - mn); den = den * f + p; acc = acc * f + p * v; mx = mn; } }
    for (int c = 0; c < CTXL; ++c) { const size_t r = (size_t)(NLAT + b * CTXL + c) * PW; const float k = bf2f(P[r + PC_K + kvh * 64 + d]), v = bf2f(P[r + PC_V + kvh * 64 + d]);
        const float s = wave_sum(q * k); const float mn = fmaxf(mx, s), f = __expf(mx - mn), p = __expf(s - mn); den = den * f + p; acc = acc * f + p * v; mx = mn; }
    CC[(size_t)m * DM + hq * 64 + d] = (bf16)f2bf(acc / den);
}

__device__ __forceinline__ int scan_row(int n, int b, int dir) { if (n < CTXL) { const int t = dir ? (CTXL - 1 - n) : n; return NLAT + b * CTXL + t; } const int t = dir ? (SEQ - 1 - (n - CTXL)) : (n - CTXL); return b * SEQ + t; }
__device__ __forceinline__ void naive_scan(Frame& F, int l, int rep = 0) {
#if defined(USE_CHUNK_DN)
    if (F.bid < 32 * DN_SPLIT) { if (DN_SPLIT == 2) dn_scan(F, l, F.bid >> 4, (F.bid >> 2) & 3, (F.bid >> 1) & 1, F.bid & 1); else dn_scan(F, l, F.bid >> 3, (F.bid >> 1) & 3, F.bid & 1, 0); }
#else
    if (F.bid < 32) {
        const int b = F.bid >> 3, h = (F.bid >> 1) & 3, dir = F.bid & 1, dvc = F.tid & 127, kq = F.tid >> 7;
        const float* DNQ = (const float*)(F.ws + WS_DNQ); const float* BG = (const float*)(F.ws + WS_BG); float* O = (float*)(F.ws + WS_DNO);
        LAS float* buf = (LAS float*)F.lds;
        LAS float* red = buf + 768;
        LAS float* red2 = red + 512;
        float S[32];
#pragma unroll
        for (int i = 0; i < 32; ++i) S[i] = 0.f;
        constexpr int NT = CTXL + SEQ;
        { const int m = scan_row(0, b, dir); if (F.tid < 384) buf[F.tid] = DNQ[(size_t)m * 1536 + (F.tid >> 7) * 512 + h * 128 + (F.tid & 127)]; }
        __syncthreads();
#pragma unroll 1
        for (int n = 0; n < NT; ++n) {
            const int m = scan_row(n, b, dir); const LAS float* cur = buf + (n & 1) * 384;
            float nextv = 0.f; if (n + 1 < NT && F.tid < 384) { const int m2 = scan_row(n + 1, b, dir); nextv = DNQ[(size_t)m2 * 1536 + (F.tid >> 7) * 512 + h * 128 + (F.tid & 127)]; }
            const float beta = BG[m * 16 + dir * 4 + h], decay = __expf(BG[m * 16 + 8 + dir * 4 + h]);
            float ks = 0.f;
#pragma unroll
            for (int i = 0; i < 32; ++i) ks += cur[128 + kq * 32 + i] * S[i];
            red[kq * 128 + dvc] = ks;
            __syncthreads();
            const float kS = (red[dvc] + red[128 + dvc]) + (red[256 + dvc] + red[384 + dvc]);
            const float upd = beta * (cur[256 + dvc] - decay * kS);
            float os = 0.f;
#pragma unroll
            for (int i = 0; i < 32; ++i) { S[i] = decay * S[i] + cur[128 + kq * 32 + i] * upd; os += cur[kq * 32 + i] * S[i]; }
            red2[kq * 128 + dvc] = os;
            if (F.tid < 384) buf[((n + 1) & 1) * 384 + F.tid] = nextv;
            __syncthreads();
            if (kq == 0) O[((size_t)dir * NTOK + m) * 512 + h * 128 + dvc] = (red2[dvc] + red2[128 + dvc]) + (red2[256 + dvc] + red2[384 + dvc]);
        }
    }
#endif
#if defined(USE_CHUNK_LRU)
    else if (F.bid < 32 * DN_SPLIT + 8) { lru_carry(F, (F.bid - 32 * DN_SPLIT) * NTHREADS + F.tid); }
#else
    else if (F.bid < 40) {
        const int idx = (F.bid - 32) * NTHREADS + F.tid, ch = idx & 511, dir = (idx >> 9) & 1, b = idx >> 10;
        const float* A = (const float*)(F.ws + WS_LRA); float* U = (float*)(F.ws + WS_LRH);
        float hs = 0.f;
#pragma unroll 4
        for (int n = 0; n < CTXL + SEQ; ++n) { int m; if (n < CTXL) { const int t = dir ? (CTXL - 1 - n) : n; m = NLAT + b * CTXL + t; } else { const int t = dir ? (SEQ - 1 - (n - CTXL)) : (n - CTXL); m = b * SEQ + t; }
            const size_t o = ((size_t)dir * NTOK + m) * 512 + ch; hs = A[o] * hs + U[o]; U[o] = hs; }
    }
#endif
#if defined(USE_MFMA_ATTN)
#if SCAN_SPLIT_ORDER
    if (F.bid & 1) { convert_moe_queue(F, l, rep); attn_phase(F, l, rep); } else { attn_phase(F, l, rep); convert_moe_queue(F, l, rep); }
#else
    attn_phase(F, l, rep);
    convert_moe_queue(F, l, rep);
#endif
#else
    {
        const int nrows = (l == 0) ? NTOK : NLAT;
        for (;;) { int m = 0; if (F.lane == 0) m = (int)__hip_atomic_fetch_add(F.ctl + CW_ATQ + 64 * l, 1u, RLX_AGENT); m = __builtin_amdgcn_readfirstlane(m);
            if (m >= nrows) break;
#pragma unroll 1
            for (int hq = 0; hq < 16; ++hq) naive_attn_row(F, l, m, hq); }
    }
#endif
}

__device__ __forceinline__ void naive_fin(Frame& F, int l) {
    const int nrows = (l == 0) ? NTOK : NLAT;
    const bf16* P = (const bf16*)(F.ws + WS_P); bf16* CC = (bf16*)(F.ws + WS_CC);
    const int gw = F.bid * NWAVES + F.wave, NGW = F.G * NWAVES;
    const float* O = (const float*)(F.ws + WS_DNO); const float* HS = (const float*)(F.ws + WS_LRH);
    for (int it0 = gw * 2; it0 < nrows * 4; it0 += NGW * 2) {
        float2 oa[2], ob[2]; unsigned gw_[2];
#pragma unroll
        for (int k = 0; k < 2; ++k) { const int it = it0 + k, m = it >> 2, h = it & 3; const int c = h * 128 + 2 * F.lane;
            { const bf16* Ob = (const bf16*)(F.ws + WS_DNO); const unsigned wa = *(const unsigned*)(Ob + (size_t)m * 512 + c), wb = *(const unsigned*)(Ob + ((size_t)NTOK + m) * 512 + c); oa[k] = make_float2(bflo(wa), bfhi(wa)); ob[k] = make_float2(bflo(wb), bfhi(wb)); } gw_[k] = *(const unsigned*)(P + (size_t)m * PW + PC_DG + c); }
        const float2 ng = *(const float2*)(F.in[I_DNNG] + l * 128 + 2 * F.lane);
#pragma unroll
        for (int k = 0; k < 2; ++k) { const int it = it0 + k, m = it >> 2, h = it & 3; const float o0 = oa[k].x + ob[k].x, o1 = oa[k].y + ob[k].y;
            const float rstd = 1.0f / sqrtf(wave_sum(o0 * o0 + o1 * o1) * (1.0f / 128.0f) + EPS);
#if FP8_OUTPROJ
            *(unsigned short*)((unsigned char*)CC + (size_t)m * DM + 1024 + h * 128 + 2 * F.lane) = (unsigned short)(pk4_fp8(o0 * rstd * ng.x * siluf_(bflo(gw_[k])), o1 * rstd * ng.y * siluf_(bfhi(gw_[k])), 0.f, 0.f) & 0xffffu); }
#else
            *(unsigned*)(CC + (size_t)m * DM + 1024 + h * 128 + 2 * F.lane) = pk2(o0 * rstd * ng.x * siluf_(bflo(gw_[k])), o1 * rstd * ng.y * siluf_(bfhi(gw_[k]))); }
#endif
    }
#if defined(USE_CHUNK_LRU)
    lru_fin(F, l);
#else
    for (size_t i = (size_t)F.bid * NTHREADS + F.tid; i < (size_t)nrows * 512; i += (size_t)F.G * NTHREADS) { const int m = (int)(i >> 9), ch = (int)(i & 511);
        const float hsum = HS[(size_t)m * 512 + ch] + HS[((size_t)NTOK + m) * 512 + ch]; const float y = bf2f(P[(size_t)m * PW + PC_LY + ch]);
        CC[(size_t)m * DM + 1536 + ch] = (bf16)f2bf(hsum * gelu_tanh(y)); }
#endif
}
#ifndef PHASE_PREP
#if defined(USE_MFMA_ATTN)
#if defined(USE_CHUNK_DN)
#define PHASE_PREP(F, l) do { attn_prep(F, l); lru_prep(F, l); dn_prep(F, l); } while (0)
#else
#define PHASE_PREP(F, l) do { naive_prep(F, l); attn_prep(F, l); } while (0)
#endif
#else
#define PHASE_PREP(F, l) naive_prep(F, l)
#endif
#endif
#ifndef PHASE_SCAN
#define PHASE_SCAN(F, l) naive_scan(F, l)
#endif
#ifndef PHASE_FIN
#define PHASE_FIN(F, l) naive_fin(F, l)
#endif

#ifndef PHASE_INPROJ
#define PHASE_INPROJ(F, l) do {} while (0)
#endif
#ifndef PHASE_PREP
#define PHASE_PREP(F, l) do {} while (0)
#endif
#ifndef PHASE_SCAN
#define PHASE_SCAN(F, l) do {} while (0)
#endif
#ifndef PHASE_FIN
#define PHASE_FIN(F, l) do {} while (0)
#endif
#ifndef PHASE_OUTPROJ
#define PHASE_OUTPROJ(F, l) do {} while (0)
#endif
#ifndef PHASE_NORM2
#define PHASE_NORM2(F, l) do {} while (0)
#endif
#ifndef PHASE_SCATTER
#define PHASE_SCATTER(F, l) do {} while (0)
#endif
#ifndef PHASE_GEMM1
#define PHASE_GEMM1(F, l) do {} while (0)
#endif
#ifndef PHASE_GEMM2
#define PHASE_GEMM2(F, l) do {} while (0)
#endif

#ifndef MK_SPLIT
#define MK_SPLIT 0
#endif
#ifndef MK_STAGE
#define MK_STAGE 99
#endif
#ifndef MK_TAILFILL
#define MK_TAILFILL 0
#endif
#ifndef MK_DUP
#define MK_DUP 0
#endif
#define DUP(k) ((MK_DUP >> (k)) & 1)
constexpr int N_PHASES = 22;
struct Args { const float* in[N_IN]; float* out; unsigned char* ws; int ph_lo, ph_hi; };
static_assert(sizeof(Args) == (N_IN + 2) * 8 + 8, "Args has no padding");

__global__ void __launch_bounds__(NTHREADS, 2) fwd_kernel(Args args) {
    extern __shared__ __attribute__((aligned(16))) unsigned char lds[];
    Frame F;
    F.lds = (LAS unsigned char*)lds;
    F.MISC = (volatile LAS unsigned*)(F.lds + MISC_OFF);
    F.tid = threadIdx.x; F.lane = F.tid & 63; F.wave = __builtin_amdgcn_readfirstlane(F.tid >> 6);
    F.G = 256; F.bid = blockIdx.x;
    F.ws = args.ws; F.out = args.out; F.ctl = (gu32*)(args.ws + WS_CTL);
    F.in = (const float* const __attribute__((address_space(4)))*)__builtin_amdgcn_kernarg_segment_ptr();
    for (int u = F.tid; u < (LDS_BYTES - LDSCTL_OFF) / 4; u += NTHREADS) ((LAS unsigned*)(F.lds + LDSCTL_OFF))[u] = 0u;
    __syncthreads();
    XcdBarrier bar; bar.bar = (unsigned*)(F.ctl + CW_BAR); bar.x = 0; bar.st = nullptr;
    if (!MK_SPLIT) bar = xcd_barrier_post((unsigned*)(F.ctl + CW_BAR), F.MISC + 8);
    const int lo = args.ph_lo, hi = args.ph_hi;
#define IN(k) (lo <= (k) && (k) < hi && phase_enter(F))
#define INR(k) (lo <= (k) && (k) < hi)
#define SEAM(k) do { if (INR(k) && INR((k) + 1)) { if (MK_TAILFILL && (k) < 14) tail_fill(F, (k), (k) < 4 ? 0 : 1); xcd_barrier(bar); } } while (0)

    if (IN(0)) { p0_prologue(F); if (DUP(0)) { __syncthreads(); p0_prologue(F); } } SEAM(0);
#pragma unroll 1
    for (int l = 0; l < DEPTH; ++l) {
        const int pb = 1 + 10 * l;
        if (IN(pb + 0)) { phase_norm1(F, l); if (DUP(13) && l == 0) { __syncthreads(); phase_norm1(F, l); } } SEAM(pb + 0);
        if (IN(pb + 1)) { PHASE_INPROJ(F, l); if (DUP(1)) { __syncthreads(); PHASE_INPROJ(F, l); } } SEAM(pb + 1);
        if (IN(pb + 2)) { PHASE_PREP(F, l); if (DUP(2)) { __syncthreads(); dn_prep(F, l); } if (DUP(6)) { __syncthreads(); lru_prep(F, l); } } SEAM(pb + 2);
        if (IN(pb + 3)) { if (DUP(3) && F.bid < 64) dn_scan(F, l, F.bid >> 4, (F.bid >> 2) & 3, (F.bid >> 1) & 1, F.bid & 1); PHASE_SCAN(F, l); if (DUP(10)) { __syncthreads(); naive_scan(F, l, 1); } if (DUP(11)) { __syncthreads(); attn_phase(F, l, 2); } if (DUP(12)) { __syncthreads(); convert_moe_queue(F, l, 3); } } SEAM(pb + 3);
        if (IN(pb + 4)) { PHASE_FIN(F, l); if (DUP(4)) { __syncthreads(); PHASE_FIN(F, l); } } SEAM(pb + 4);
        if (IN(pb + 5)) { PHASE_OUTPROJ(F, l); if (DUP(5) && l == 0) { __syncthreads(); PHASE_OUTPROJ(F, l); } } SEAM(pb + 5);
        if (IN(pb + 6)) { PHASE_NORM2(F, l); } SEAM(pb + 6);
        if (IN(pb + 7)) { PHASE_SCATTER(F, l); if (DUP(7)) { __syncthreads(); PHASE_SCATTER(F, l); } } SEAM(pb + 7);
        if (IN(pb + 8)) { PHASE_GEMM1(F, l); if (DUP(8)) { __syncthreads(); PHASE_GEMM1(F, l); } } SEAM(pb + 8);
        if (IN(pb + 9)) { PHASE_GEMM2(F, l); if (DUP(9)) { __syncthreads(); PHASE_GEMM2(F, l); } } SEAM(pb + 9);
    }
    if (IN(21)) { phase_final(F, MK_STAGE >= 9); if (DUP(13)) { __syncthreads(); phase_final(F, MK_STAGE >= 9); } }
#undef IN
#undef SEAM
}

extern "C" void kernel_launch(void* const* d_in, const int* in_sizes, int n_in, void* d_out, int out_size, void* d_ws, size_t ws_size, hipStream_t stream) {
    static int grid = 0;
    if (grid == 0) {
        if (n_in != N_IN || out_size != NLAT * DM || ws_size < WS_END) { fprintf(stderr, "kernel_launch: unexpected shapes (n_in %d, out %d, ws %zu); nothing launched\n", n_in, out_size, ws_size); grid = -1; return; }
        int dev = 0, cus = 0, per_cu = 0;
        if (hipGetDevice(&dev) != hipSuccess || hipDeviceGetAttribute(&cus, hipDeviceAttributeMultiprocessorCount, dev) != hipSuccess) { grid = -1; return; }
        if (hipFuncSetAttribute((const void*)fwd_kernel, hipFuncAttributeMaxDynamicSharedMemorySize, LDS_BYTES) != hipSuccess) { fprintf(stderr, "kernel_launch: hipFuncSetAttribute failed\n"); grid = -1; return; }
        if (hipOccupancyMaxActiveBlocksPerMultiprocessor(&per_cu, (const void*)fwd_kernel, NTHREADS, LDS_BYTES) != hipSuccess || per_cu < 1) { fprintf(stderr, "kernel_launch: occupancy query says %d\n", per_cu); }
        (void)hipGetLastError();
        grid = cus;
        if (grid != 256) { fprintf(stderr, "kernel_launch: built for 256 CUs, device has %d; nothing launched\n", cus); grid = -1; return; }
    }
    if (grid < 0) return;
    if (hipMemsetAsync((char*)d_ws + WS_CTL, 0, CTL_ZERO_BYTES, stream) != hipSuccess) return;
    Args a{};
    for (int i = 0; i < N_IN; ++i) a.in[i] = (const float*)d_in[i];
    a.out = (float*)d_out; a.ws = (unsigned char*)d_ws;
#if MK_SPLIT
    for (int p = 0; p < N_PHASES; ++p) { a.ph_lo = p; a.ph_hi = p + 1; hipLaunchKernelGGL(fwd_kernel, dim3(grid), dim3(NTHREADS), LDS_BYTES, stream, a); }
#else
    a.ph_lo = 0; a.ph_hi = N_PHASES;
    hipLaunchKernelGGL(fwd_kernel, dim3(grid), dim3(NTHREADS), LDS_BYTES, stream, a);
#endif
    const hipError_t le = hipPeekAtLastError();
    if (le != hipSuccess) fprintf(stderr, "kernel_launch: launch failed: %s\n", hipGetErrorName(le));
}
```

```cpp
#include <hip/hip_runtime.h>
#include <cstdio>
#include <cstdint>

constexpr int DM = 2048, NB = 4, SEQ = 4096, CTXL = 256, DEPTH = 2;
constexpr int NLAT = NB * SEQ, NCTX = NB * CTXL, NTOK = NLAT + NCTX;
constexpr int NCT = NTOK / 64;
constexpr int IN_W = 4624, PW = 4864;
constexpr int PC_Q = 0, PC_K = 1024, PC_V = 1280, PC_DQ = 1536, PC_DK = 2048, PC_DV = 2560, PC_DG = 3072, PC_LX = 3584, PC_LY = 4096, PC_BETA = 4608, PC_DEC = 4616;
constexpr int NEXP = 32, TOPK = 4, DEXP = 1024;
constexpr int MOE_ROWS = 304 * 256;
constexpr float EPS = 1e-6f;
#ifndef MK_STAGE
#define MK_STAGE 99
#endif
#ifndef FP8_INPROJ
#define FP8_INPROJ 0
#endif
#ifndef FP8_OUTPROJ
#define FP8_OUTPROJ 0
#endif
#ifndef SCAN_SPLIT_ORDER
#define SCAN_SPLIT_ORDER 1
#endif
#ifndef X_BF16
#define X_BF16 1
#endif
#ifndef SCAN_ATTN_FIRST
#define SCAN_ATTN_FIRST 2
#endif
#ifndef OUTPROJ_SLACK_TICKS
#define OUTPROJ_SLACK_TICKS 0
#endif
#ifndef YS_FP8
#define YS_FP8 1
#endif
namespace pg8 {
#define PG8_LAS __attribute__((address_space(3)))
typedef unsigned short bf16_t;
typedef short bf16x8 __attribute__((ext_vector_type(8)));
typedef float f32x4 __attribute__((ext_vector_type(4)));
typedef unsigned u32x4 __attribute__((ext_vector_type(4)));
typedef float f32x2 __attribute__((ext_vector_type(2)));
constexpr int BM = 256, BK = 64, HALF = 128, HTB = HALF * BK * 2  , STAGE_BYTES = 8 * HTB, NXCD = 8, WGM = 8;

__host__ __device__ __forceinline__ int lds_byte(int r, int c) { const int st = (r >> 4) * 2 + (c >> 5), rr = r & 15, cc = c & 31, ob = rr * 64 + cc * 2; return st * 1024 + (ob ^ (((ob >> 9) & 1) << 5)); }
__host__ __device__ __forceinline__ void stage_rc(int b, int& R, int& C) { const int st = b / 1024, sb = b % 1024, swz = sb ^ (((sb >> 9) & 1) << 5); R = (st >> 1) * 16 + swz / 64; C = (st & 1) * 32 + (swz % 64) / 2; }
__host__ __device__ __forceinline__ int perm32(int rho) { const int n = rho >> 4, i = rho & 15; return 8 * (i >> 2) + 4 * n + (i & 3); }

struct Unit { int pm, pn, e; };
typedef int v4i_t __attribute__((ext_vector_type(4)));
typedef int v8i_t __attribute__((ext_vector_type(8)));
struct Gemm { const bf16_t* A; const bf16_t* Bt; int M, N, K; int bscale = 0x7F7F7F7F; };

struct StaticOrder {
    static constexpr bool GATHER = false, IDENT = false; const int* row_tab = nullptr;
    int nM, nN, nwg, G, c; const char* A; const char* Bt; size_t tstep;
    __device__ void init(const Gemm& g, int G_, int c_) { nM = g.M / BM; nN = g.N / BM; nwg = nM * nN; G = G_; c = c_; A = (const char*)g.A; Bt = (const char*)g.Bt; tstep = (size_t)BM * g.K * 2; }
    __device__ bool next(int i, Unit& u) const {
        const long L = (long)i * G + c; if (L >= nwg) return false;
        int wgid = (int)L; { const int q = nwg / NXCD, r = nwg % NXCD, xcd = wgid % NXCD, off = wgid / NXCD; wgid = (xcd < r ? xcd * (q + 1) : r * (q + 1) + (xcd - r) * q) + off; }
        const int nig = WGM * nN, gid = wgid / nig, fm = gid * WGM, gsz = (nM - fm) < WGM ? (nM - fm) : WGM;
        u.pm = fm + ((wgid % nig) % gsz); u.pn = (wgid % nig) / gsz; u.e = 0; return true;
    }
    __device__ __forceinline__ const char* a_ptr(const Unit& u) const { return A + (size_t)u.pm * tstep; }
    __device__ __forceinline__ const char* b_ptr(const Unit& u) const { return Bt + (size_t)u.pn * tstep; }
    __device__ __forceinline__ void a_ready(const Unit&) const {}
    __device__ __forceinline__ void done(const Unit&) const {}
};
struct StaticOrderG : StaticOrder {
    static constexpr bool GATHER = true, IDENT = true;
    __device__ __forceinline__ const char* a_ptr(const Unit&) const { return A; }
};
__device__ __forceinline__ unsigned cvt_pk_bf16(float lo, float hi) { unsigned r; asm volatile("v_cvt_pk_bf16_f32 %0, %1, %2" : "=v"(r) : "v"(lo), "v"(hi)); return r; }
struct EpiBf16Plain {
    static constexpr bool PERM = true, AFTER_DRAIN = false;
    bf16_t* O; int ldc;
    __device__ __forceinline__ void operator()(const f32x4 (&acc)[2][2][4][2], const Unit& u, int wr, int wc, int fr, int fq) const {
        const int row0 = u.pm * BM + wr * 64 + fr, col0 = u.pn * BM + wc * 32 + 8 * fq;
#pragma unroll
        for (int ai = 0; ai < 2; ++ai)
#pragma unroll
            for (int m = 0; m < 4; ++m) { bf16_t* rowp = O + (size_t)(row0 + ai * HALF + m * 16) * ldc + col0;
#pragma unroll
                for (int bj = 0; bj < 2; ++bj) { const f32x4 v0 = acc[ai][bj][m][0], v1 = acc[ai][bj][m][1];
                    u32x4 w; w.x = cvt_pk_bf16(v0[0], v0[1]); w.y = cvt_pk_bf16(v0[2], v0[3]); w.z = cvt_pk_bf16(v1[0], v1[1]); w.w = cvt_pk_bf16(v1[2], v1[3]);
                    *(u32x4*)(rowp + bj * HALF) = w; } }
    }
};
struct EpiResGate {
    static constexpr bool PERM = false, AFTER_DRAIN = false;
    const float* base_lat; const float* base_ctx; float* out; const float* modg;
    __device__ __forceinline__ void operator()(const f32x4 (&acc)[2][2][4][2], const Unit& u, int wr, int wc, int fr, int fq) const {
        const int r = u.pm < 64 ? (u.pm >> 4) : 4; const int col0 = u.pn * BM + wc * 32 + 4 * fq;
        const float* g = modg + (size_t)r * 12288 + col0;
        f32x4 gv[2][2];
#pragma unroll
        for (int bj = 0; bj < 2; ++bj)
#pragma unroll
            for (int n = 0; n < 2; ++n) gv[bj][n] = *(const f32x4*)(g + bj * HALF + n * 16);
#pragma unroll
        for (int ai = 0; ai < 2; ++ai)
#pragma unroll
            for (int m = 0; m < 4; ++m) { const int row = u.pm * BM + ai * HALF + wr * 64 + m * 16 + fr;
                const float* bp = (row < 16384 ? base_lat + (size_t)row * 2048 : base_ctx + (size_t)(row - 16384) * 2048) + col0; float* op = out + (size_t)row * 2048 + col0;
#pragma unroll
                for (int bj = 0; bj < 2; ++bj)
#pragma unroll
                    for (int n = 0; n < 2; ++n) { const f32x4 b = *(const f32x4*)(bp + bj * HALF + n * 16); *(f32x4*)(op + bj * HALF + n * 16) = b + gv[bj][n] * acc[ai][bj][m][n]; }
                asm volatile("" ::: "memory"); }
    }
};
struct EpiResGateB {
    static constexpr bool PERM = true, AFTER_DRAIN = false;
    const float* base_lat; const float* base_ctx; const bf16_t* xb_in; bf16_t* xb_out; const float* modg; int f32base;
    __device__ __forceinline__ void operator()(const f32x4 (&acc)[2][2][4][2], const Unit& u, int wr, int wc, int fr, int fq) const {
        const int r = u.pm < 64 ? (u.pm >> 4) : 4; const int col0 = u.pn * BM + wc * 32 + 8 * fq;
        const float* g = modg + (size_t)r * 12288 + col0;
        f32x4 gv[2][2];
#pragma unroll
        for (int bj = 0; bj < 2; ++bj)
#pragma unroll
            for (int n = 0; n < 2; ++n) gv[bj][n] = *(const f32x4*)(g + bj * HALF + 4 * n);
#pragma unroll
        for (int ai = 0; ai < 2; ++ai)
#pragma unroll
            for (int m = 0; m < 4; ++m) { const int row = u.pm * BM + ai * HALF + wr * 64 + m * 16 + fr;
#pragma unroll
                for (int bj = 0; bj < 2; ++bj) { f32x4 b0, b1;
                    if (f32base) { const float* bp = (row < 16384 ? base_lat + (size_t)row * 2048 : base_ctx + (size_t)(row - 16384) * 2048) + col0 + bj * HALF; b0 = *(const f32x4*)bp; b1 = *(const f32x4*)(bp + 4); }
                    else { const u32x4 w = *(const u32x4*)(xb_in + (size_t)row * 2048 + col0 + bj * HALF);
                        b0 = (f32x4){__builtin_bit_cast(float, w.x << 16), __builtin_bit_cast(float, w.x & 0xffff0000u), __builtin_bit_cast(float, w.y << 16), __builtin_bit_cast(float, w.y & 0xffff0000u)};
                        b1 = (f32x4){__builtin_bit_cast(float, w.z << 16), __builtin_bit_cast(float, w.z & 0xffff0000u), __builtin_bit_cast(float, w.w << 16), __builtin_bit_cast(float, w.w & 0xffff0000u)}; }
                    const f32x4 v0 = b0 + gv[bj][0] * acc[ai][bj][m][0], v1 = b1 + gv[bj][1] * acc[ai][bj][m][1];
                    u32x4 o; o.x = cvt_pk_bf16(v0[0], v0[1]); o.y = cvt_pk_bf16(v0[2], v0[3]); o.z = cvt_pk_bf16(v1[0], v1[1]); o.w = cvt_pk_bf16(v1[2], v1[3]);
                    *(u32x4*)(xb_out + (size_t)row * 2048 + col0 + bj * HALF) = o; }
                asm volatile("" ::: "memory"); }
    }
};
struct EpiSwiglu {
    static constexpr bool PERM = true, AFTER_DRAIN = false;
    bf16_t* O; const float* bgu;
    __device__ __forceinline__ void operator()(const f32x4 (&acc)[2][2][4][2], const Unit& u, int wr, int wc, int fr, int fq) const {
        const int row0 = u.pm * BM + wr * 64 + fr, cc0 = wc * 32 + 8 * fq;
        const float* bg = bgu + (size_t)u.e * 2048 + u.pn * 128 + cc0;
        f32x4 bglu[2], blin[2];
#pragma unroll
        for (int n = 0; n < 2; ++n) { bglu[n] = *(const f32x4*)(bg + 4 * n); blin[n] = *(const f32x4*)(bg + 1024 + 4 * n); }
#pragma unroll
        for (int ai = 0; ai < 2; ++ai)
#pragma unroll
            for (int m = 0; m < 4; ++m) { bf16_t* rowp = O + (size_t)(row0 + ai * HALF + m * 16) * 1024 + u.pn * 128 + cc0;
                float r[8];
#pragma unroll
                for (int n = 0; n < 2; ++n) { const f32x4 g = acc[ai][0][m][n] + bglu[n], l = acc[ai][1][m][n] + blin[n];
#pragma unroll
                    for (int i = 0; i < 4; ++i) { const float gg = fminf(g[i], 7.0f); const float ll = fminf(fmaxf(l[i], -7.0f), 7.0f);
                        r[4 * n + i] = (ll + 1.0f) * gg * __builtin_amdgcn_rcpf(1.0f + __builtin_amdgcn_exp2f(-1.702f * 1.4426950408889634f * gg)); } }
                u32x4 w; w.x = cvt_pk_bf16(r[0], r[1]); w.y = cvt_pk_bf16(r[2], r[3]); w.z = cvt_pk_bf16(r[4], r[5]); w.w = cvt_pk_bf16(r[6], r[7]);
                *(u32x4*)rowp = w; }
    }
};
struct EpiSwiglu8 {
    static constexpr bool PERM = true, AFTER_DRAIN = false;
    unsigned char* O; const float* bgu;
    __device__ __forceinline__ void operator()(const f32x4 (&acc)[2][2][4][2], const Unit& u, int wr, int wc, int fr, int fq) const {
        const int row0 = u.pm * BM + wr * 64 + fr, cc0 = wc * 32 + 8 * fq;
        const float* bg = bgu + (size_t)u.e * 2048 + u.pn * 128 + cc0;
        f32x4 bglu[2], blin[2];
#pragma unroll
        for (int n = 0; n < 2; ++n) { bglu[n] = *(const f32x4*)(bg + 4 * n); blin[n] = *(const f32x4*)(bg + 1024 + 4 * n); }
#pragma unroll
        for (int ai = 0; ai < 2; ++ai)
#pragma unroll
            for (int m = 0; m < 4; ++m) { unsigned char* rowp = O + (size_t)(row0 + ai * HALF + m * 16) * 1024 + u.pn * 128 + cc0;
                float r[8];
#pragma unroll
                for (int n = 0; n < 2; ++n) { const f32x4 g = acc[ai][0][m][n] + bglu[n], l = acc[ai][1][m][n] + blin[n];
#pragma unroll
                    for (int i = 0; i < 4; ++i) { const float gg = fminf(g[i], 7.0f); const float ll = fminf(fmaxf(l[i], -7.0f), 7.0f);
                        r[4 * n + i] = (ll + 1.0f) * gg * __builtin_amdgcn_rcpf(1.0f + __builtin_amdgcn_exp2f(-1.702f * 1.4426950408889634f * gg)); } }
                int w0 = 0, w1 = 0; w0 = __builtin_amdgcn_cvt_pk_fp8_f32(r[0], r[1], w0, false); w0 = __builtin_amdgcn_cvt_pk_fp8_f32(r[2], r[3], w0, true); w1 = __builtin_amdgcn_cvt_pk_fp8_f32(r[4], r[5], w1, false); w1 = __builtin_amdgcn_cvt_pk_fp8_f32(r[6], r[7], w1, true);
                typedef unsigned u32x2 __attribute__((ext_vector_type(2))); *(u32x2*)rowp = (u32x2){(unsigned)w0, (unsigned)w1}; }
    }
};
struct EpiDown {
    static constexpr bool PERM = true, AFTER_DRAIN = false;
    bf16_t* O; const float* bdn; const float* rowg;
    __device__ __forceinline__ void operator()(const f32x4 (&acc)[2][2][4][2], const Unit& u, int wr, int wc, int fr, int fq) const {
        const int row0 = u.pm * BM + wr * 64 + fr, col0 = u.pn * BM + wc * 32 + 8 * fq;
        const float* bb = bdn + (size_t)u.e * 2048 + col0;
        float gt[2][4];
#pragma unroll
        for (int ai = 0; ai < 2; ++ai)
#pragma unroll
            for (int m = 0; m < 4; ++m) gt[ai][m] = rowg[row0 + ai * HALF + m * 16];
#pragma unroll
        for (int bj = 0; bj < 2; ++bj) { const f32x4 b0 = *(const f32x4*)(bb + bj * HALF), b1 = *(const f32x4*)(bb + bj * HALF + 4);
#pragma unroll
            for (int ai = 0; ai < 2; ++ai)
#pragma unroll
                for (int m = 0; m < 4; ++m) { const int row = row0 + ai * HALF + m * 16; const f32x4 v0 = (acc[ai][bj][m][0] + b0) * gt[ai][m], v1 = (acc[ai][bj][m][1] + b1) * gt[ai][m];
                    u32x4 w; w.x = cvt_pk_bf16(v0[0], v0[1]); w.y = cvt_pk_bf16(v0[2], v0[3]); w.z = cvt_pk_bf16(v1[0], v1[1]); w.w = cvt_pk_bf16(v1[2], v1[3]);
                    *(u32x4*)(O + (size_t)row * 2048 + col0 + bj * HALF) = w; } }
    }
};
struct EpiDown8 {
    static constexpr bool PERM = true, AFTER_DRAIN = false;
    unsigned char* O; const float* bdn; const float* rowg;
    __device__ __forceinline__ void operator()(const f32x4 (&acc)[2][2][4][2], const Unit& u, int wr, int wc, int fr, int fq) const {
        const int row0 = u.pm * BM + wr * 64 + fr, col0 = u.pn * BM + wc * 32 + 8 * fq;
        const float* bb = bdn + (size_t)u.e * 2048 + col0;
        float gt[2][4];
#pragma unroll
        for (int ai = 0; ai < 2; ++ai)
#pragma unroll
            for (int m = 0; m < 4; ++m) gt[ai][m] = 16.0f * rowg[row0 + ai * HALF + m * 16];
#pragma unroll
        for (int bj = 0; bj < 2; ++bj) { const f32x4 b0 = *(const f32x4*)(bb + bj * HALF), b1 = *(const f32x4*)(bb + bj * HALF + 4);
#pragma unroll
            for (int ai = 0; ai < 2; ++ai)
#pragma unroll
                for (int m = 0; m < 4; ++m) { const int row = row0 + ai * HALF + m * 16; const f32x4 v0 = (acc[ai][bj][m][0] + b0) * gt[ai][m], v1 = (acc[ai][bj][m][1] + b1) * gt[ai][m];
                    int w0 = 0, w1 = 0; w0 = __builtin_amdgcn_cvt_pk_fp8_f32(v0[0], v0[1], w0, false); w0 = __builtin_amdgcn_cvt_pk_fp8_f32(v0[2], v0[3], w0, true); w1 = __builtin_amdgcn_cvt_pk_fp8_f32(v1[0], v1[1], w1, false); w1 = __builtin_amdgcn_cvt_pk_fp8_f32(v1[2], v1[3], w1, true);
                    typedef unsigned u32x2 __attribute__((ext_vector_type(2))); *(u32x2*)(O + (size_t)row * 2048 + col0 + bj * HALF) = (u32x2){(unsigned)w0, (unsigned)w1}; } }
    }
};
template <bool GATHER_, bool IDENT_ = false> struct MoeOrderT {
    static constexpr bool GATHER = GATHER_, IDENT = IDENT_;
    int c, nblk; const char* A; const char* Bt; size_t a_tstep, b_estep, b_tstep; const PG8_LAS int* blk_end; const int* row_tab;
    __device__ __forceinline__ bool next(int i, Unit& u) const {
#if defined(MOE_MAP) && MOE_MAP == 1
        const int L = i * 256 + c, rb = L >> 3, j = (L & 7);
#elif defined(MOE_MAP) && MOE_MAP == 2
        const int x = c & 7, jj = c >> 3, gi = i * 8 + x, rb = 8 * (gi >> 1) + (jj >> 2), j = (jj & 3) + 4 * (gi & 1);
#else
        const int x = c & 7, j = c >> 3, gi = i * 8 + x, rb = 4 * gi + (j >> 3);
#endif
        if (rb >= nblk) return false;
        int e = 0;
        for (int k = 0; k < 31; ++k) e += (rb >= blk_end[k]) ? 1 : 0;
        u.pm = rb; u.pn = j & 7; u.e = __builtin_amdgcn_readfirstlane(e); return true;
    }
    __device__ __forceinline__ const char* a_ptr(const Unit& u) const { return GATHER ? A : A + (size_t)u.pm * a_tstep; }
    __device__ __forceinline__ const char* b_ptr(const Unit& u) const { return Bt + (size_t)u.e * b_estep + (size_t)u.pn * b_tstep; }
    __device__ __forceinline__ void a_ready(const Unit&) const {}
    __device__ __forceinline__ void done(const Unit&) const {}
};
typedef MoeOrderT<false> MoeOrder;
typedef MoeOrderT<true> MoeOrderG;
typedef MoeOrderT<true, true> MoeOrderI;
template <class Epi, class Sched, bool ALIGN_EPI = false, bool SP2 = false, bool FP8 = false>
__device__ __forceinline__ void gemm_phase(PG8_LAS unsigned char* lds, const Gemm g, const Sched& S, const Epi& E) {
    int tid = threadIdx.x; asm volatile("" : "+v"(tid));
    const int wid = __builtin_amdgcn_readfirstlane(tid >> 6), lane = tid & 63, wr = wid >> 2, wc = wid & 3, fr = lane & 15, fq = lane >> 4;
    const int K = g.K, nt = K / BK;
    unsigned voffA[2], voffB[2];
#pragma unroll
    for (int i = 0; i < 2; ++i) { int R, C; stage_rc(tid * 16 + i * 8192, R, C); const int Rb = Epi::PERM ? ((R & ~31) + perm32(R & 31)) : R;
        voffA[i] = (unsigned)(R * K + C) * 2u; voffB[i] = (unsigned)(Rb * K + C) * 2u; }
    unsigned gc0[2] = {0u, 0u}, gc1[2] = {0u, 0u}; int gR = 0, gC = 0;
    if constexpr (Sched::GATHER) { stage_rc(tid * 16, gR, gC); }
#define PG8_GLOAD(dst0, dst1, u) do { if constexpr (Sched::IDENT) { const unsigned _r0 = (unsigned)((u).pm * BM + gR);     \
        dst0[0] = _r0 * (unsigned)(K * 2) + (unsigned)(gC * 2); dst0[1] = (_r0 + 64u) * (unsigned)(K * 2) + (unsigned)(gC * 2); dst1[0] = (_r0 + 128u) * (unsigned)(K * 2) + (unsigned)(gC * 2); dst1[1] = (_r0 + 192u) * (unsigned)(K * 2) + (unsigned)(gC * 2); } \
      else { const int* _rt = S.row_tab + (size_t)(u).pm * BM + gR; \
        dst0[0] = (unsigned)_rt[0] * (unsigned)(K * 2) + (unsigned)(gC * 2); dst0[1] = (unsigned)_rt[64] * (unsigned)(K * 2) + (unsigned)(gC * 2); \
        dst1[0] = (unsigned)_rt[128] * (unsigned)(K * 2) + (unsigned)(gC * 2); dst1[1] = (unsigned)_rt[192] * (unsigned)(K * 2) + (unsigned)(gC * 2); } } while (0)
    const size_t kstep = (size_t)(BK * 2);
    const size_t hstep = (size_t)HALF * K * 2;
    const size_t tstep = 2 * hstep;
    const unsigned ldsw = (unsigned)wid * 1024u;
    const int aoff = lds_byte(wr * 64 + fr, fq * 8); int boff = lds_byte(wc * 32 + fr, fq * 8) + 4 * HTB;
    asm volatile("" : "+v"(boff));
#define PG8_SA(b, h) (((b) * 2 + (h)) * HTB)
#define PG8_SB(b, h) ((4 + (b) * 2 + (h)) * HTB)
#define PG8_SBR(b, h) (((b) * 2 + (h)) * HTB)
#define PG8_STAGE(bufoff, gbase, voff) do { _Pragma("unroll") for (int _i = 0; _i < 2; ++_i) \
        __builtin_amdgcn_global_load_lds((const unsigned*)((const char*)(gbase) + (voff)[_i]), (PG8_LAS unsigned*)(lds + (bufoff) + ldsw + _i * 8192), 16, 0, 0); } while (0)
#define PG8_LD16(off) (*(const PG8_LAS v4i_t*)(lds + (off)))
#define PG8_LDA(dst, b, h) do { if constexpr (FP8) { _Pragma("unroll") for (int m = 0; m < 4; ++m) dst##8[m] = __builtin_shufflevector(PG8_LD16(PG8_SA(b, h) + aoff + m * 2048), PG8_LD16(PG8_SA(b, h) + aoff + m * 2048 + 1024), 0, 1, 2, 3, 4, 5, 6, 7); } \
        else { _Pragma("unroll") for (int m = 0; m < 4; ++m) _Pragma("unroll") for (int k = 0; k < 2; ++k) dst[m][k] = *(const PG8_LAS bf16x8*)(lds + PG8_SA(b, h) + aoff + m * 2048 + k * 1024); } } while (0)
#define PG8_LDB(dst, b, h) do { if constexpr (FP8) { _Pragma("unroll") for (int n = 0; n < 2; ++n) dst##8[n] = __builtin_shufflevector(PG8_LD16(PG8_SBR(b, h) + boff + n * 2048), PG8_LD16(PG8_SBR(b, h) + boff + n * 2048 + 1024), 0, 1, 2, 3, 4, 5, 6, 7); } \
        else { _Pragma("unroll") for (int n = 0; n < 2; ++n) _Pragma("unroll") for (int k = 0; k < 2; ++k) dst[n][k] = *(const PG8_LAS bf16x8*)(lds + PG8_SBR(b, h) + boff + n * 2048 + k * 1024); } } while (0)
#define PG8_MMA(ai, bj, At, Bt) do { __builtin_amdgcn_s_setprio(1); \
        if constexpr (FP8) { _Pragma("unroll") for (int m = 0; m < 4; ++m) _Pragma("unroll") for (int n = 0; n < 2; ++n) \
            acc[ai][bj][m][n] = __builtin_amdgcn_mfma_scale_f32_16x16x128_f8f6f4(Bt##8[n], At##8[m], acc[ai][bj][m][n], 0, 0, 0, g.bscale, 0, g.bscale); }     \
        else { _Pragma("unroll") for (int m = 0; m < 4; ++m) _Pragma("unroll") for (int n = 0; n < 2; ++n) _Pragma("unroll") for (int k = 0; k < 2; ++k) \
            acc[ai][bj][m][n] = __builtin_amdgcn_mfma_f32_16x16x32_bf16(Bt[n][k], At[m][k], acc[ai][bj][m][n], 0, 0, 0); } \
        __builtin_amdgcn_s_setprio(0); } while (0)
#define PG8_WAIT_V(n) asm volatile("s_waitcnt vmcnt(" #n ")" ::: "memory")
#define PG8_WAIT_L(n) asm volatile("s_waitcnt lgkmcnt(" #n ")" ::: "memory")
#define PG8_BAR __builtin_amdgcn_s_barrier()
#define PG8_SCHED __builtin_amdgcn_sched_barrier(0)
    Unit cur, nxt; int ui = 0;
    if (!S.next(0, cur)) return;
    f32x4 acc[2][2][4][2];
#pragma unroll
    for (int a = 0; a < 2; ++a)
#pragma unroll
        for (int b = 0; b < 2; ++b)
#pragma unroll
            for (int m = 0; m < 4; ++m)
#pragma unroll
                for (int n = 0; n < 2; ++n) acc[a][b][m][n] = (f32x4){0.f, 0.f, 0.f, 0.f};
    bf16x8 At[4][2], B0[2][2], B1[2][2]; v8i_t At8[4], B08[2], B18[2];
    const char* cA = S.a_ptr(cur); const char* cB = S.b_ptr(cur);
    S.a_ready(cur);
    if constexpr (SP2) {
        if constexpr (Sched::GATHER) { PG8_GLOAD(gc0, gc1, cur);
        PG8_STAGE(PG8_SB(0, 0), cB, voffB); PG8_STAGE(PG8_SB(0, 1), cB + hstep, voffB); PG8_STAGE(PG8_SA(0, 0), cA, gc0); PG8_STAGE(PG8_SA(0, 1), cA, gc1);
        if (wr == 1) PG8_BAR;
        PG8_WAIT_V(2); PG8_BAR;
        PG8_STAGE(PG8_SB(1, 0), cB + kstep, voffB); PG8_STAGE(PG8_SA(1, 0), cA + kstep, gc0); PG8_STAGE(PG8_SB(1, 1), cB + hstep + kstep, voffB);
        } else {
        PG8_STAGE(PG8_SB(0, 0), cB, voffB); PG8_STAGE(PG8_SB(0, 1), cB + hstep, voffB); PG8_STAGE(PG8_SA(0, 0), cA, voffA); PG8_STAGE(PG8_SA(0, 1), cA + hstep, voffA);
        if (wr == 1) PG8_BAR;
        PG8_WAIT_V(2); PG8_BAR;
        PG8_STAGE(PG8_SB(1, 0), cB + kstep, voffB); PG8_STAGE(PG8_SA(1, 0), cA + kstep, voffA); PG8_STAGE(PG8_SB(1, 1), cB + hstep + kstep, voffB);
        }
        PG8_WAIT_V(6); PG8_BAR;
    } else {
        PG8_STAGE(PG8_SB(0, 0), cB, voffB); PG8_STAGE(PG8_SA(0, 0), cA, voffA); PG8_STAGE(PG8_SB(0, 1), cB + hstep, voffB); PG8_STAGE(PG8_SA(0, 1), cA + hstep, voffA);
        if (wr == 1) PG8_BAR;
        PG8_WAIT_V(4); PG8_BAR;
        PG8_STAGE(PG8_SB(1, 0), cB + kstep, voffB); PG8_STAGE(PG8_SA(1, 0), cA + kstep, voffA); PG8_STAGE(PG8_SB(1, 1), cB + hstep + kstep, voffB);
        PG8_WAIT_V(6); PG8_BAR;
    }
    for (;;) {
        const bool has_next = S.next(ui + 1, nxt);
        const char* nA = has_next ? S.a_ptr(nxt) : cA; const char* nB = has_next ? S.b_ptr(nxt) : cB;
#pragma unroll 1
        for (int t = 0; t < nt; t += 2) {
            const bool last = (t == nt - 2);
            const char* a1 = cA + (size_t)(t + 1) * kstep;
            const char* a2 = last ? nA : cA + (size_t)(t + 2) * kstep; const char* b2 = last ? nB : cB + (size_t)(t + 2) * kstep;
            const char* a3 = a2 + kstep; const char* b3 = b2 + kstep;
            if (last && has_next) S.a_ready(nxt);

            if constexpr (SP2) {
            PG8_LDB(B0, 0, 0); PG8_LDB(B1, 0, 1); PG8_SCHED; PG8_LDA(At, 0, 0); if constexpr (Sched::GATHER) PG8_STAGE(PG8_SA(1, 1), a1, gc1); else PG8_STAGE(PG8_SA(1, 1), a1 + hstep, voffA);
            if constexpr (Sched::GATHER) { if (last && has_next) PG8_GLOAD(gc0, gc1, nxt); }
            PG8_WAIT_V(8); PG8_WAIT_L(0); PG8_BAR; PG8_MMA(0, 0, At, B0); PG8_MMA(0, 1, At, B1); PG8_BAR; PG8_SCHED;
            PG8_LDA(At, 0, 1); PG8_STAGE(PG8_SB(0, 0), b2, voffB); PG8_STAGE(PG8_SB(0, 1), b2 + hstep, voffB); if constexpr (Sched::GATHER) PG8_STAGE(PG8_SA(0, 0), a2, gc0); else PG8_STAGE(PG8_SA(0, 0), a2, voffA);
            PG8_WAIT_V(8); PG8_WAIT_L(0); PG8_BAR; PG8_MMA(1, 0, At, B0); PG8_MMA(1, 1, At, B1); PG8_BAR; PG8_SCHED;
            PG8_LDB(B0, 1, 0); PG8_LDB(B1, 1, 1); PG8_SCHED; PG8_LDA(At, 1, 0); if constexpr (Sched::GATHER) PG8_STAGE(PG8_SA(0, 1), a2, gc1); else PG8_STAGE(PG8_SA(0, 1), a2 + hstep, voffA);
            PG8_WAIT_V(8); PG8_WAIT_L(0); PG8_BAR; PG8_MMA(0, 0, At, B0); PG8_MMA(0, 1, At, B1); PG8_BAR; PG8_SCHED;
            PG8_LDA(At, 1, 1); PG8_STAGE(PG8_SB(1, 0), b3, voffB); PG8_STAGE(PG8_SB(1, 1), b3 + hstep, voffB); if constexpr (Sched::GATHER) PG8_STAGE(PG8_SA(1, 0), a3, gc0); else PG8_STAGE(PG8_SA(1, 0), a3, voffA);
            PG8_WAIT_V(8); PG8_WAIT_L(0); PG8_BAR; PG8_MMA(1, 0, At, B0); PG8_MMA(1, 1, At, B1); PG8_BAR; PG8_SCHED;
            } else {
            PG8_LDB(B0, 0, 0); PG8_SCHED; PG8_LDA(At, 0, 0); PG8_STAGE(PG8_SA(1, 1), a1 + hstep, voffA);
            PG8_WAIT_L(8); PG8_BAR; PG8_WAIT_L(0); PG8_MMA(0, 0, At, B0); PG8_BAR; PG8_SCHED;
            PG8_LDB(B1, 0, 1); PG8_STAGE(PG8_SB(0, 0), b2, voffB);
            PG8_BAR; PG8_WAIT_L(0); PG8_MMA(0, 1, At, B1); PG8_BAR;
            PG8_LDA(At, 0, 1); PG8_STAGE(PG8_SA(0, 0), a2, voffA);
            PG8_BAR; PG8_WAIT_L(0); PG8_MMA(1, 0, At, B0); PG8_BAR; PG8_SCHED;
            PG8_STAGE(PG8_SB(0, 1), b2 + hstep, voffB);
            PG8_WAIT_V(6); PG8_BAR; PG8_MMA(1, 1, At, B1); PG8_BAR;
            PG8_LDB(B0, 1, 0); PG8_SCHED; PG8_LDA(At, 1, 0); PG8_STAGE(PG8_SA(0, 1), a2 + hstep, voffA);
            PG8_WAIT_L(8); PG8_BAR; PG8_WAIT_L(0); PG8_MMA(0, 0, At, B0); PG8_BAR; PG8_SCHED;
            PG8_LDB(B1, 1, 1); PG8_STAGE(PG8_SB(1, 0), b3, voffB);
            PG8_BAR; PG8_WAIT_L(0); PG8_MMA(0, 1, At, B1); PG8_BAR;
            PG8_LDA(At, 1, 1); PG8_STAGE(PG8_SA(1, 0), a3, voffA);
            PG8_BAR; PG8_WAIT_L(0); PG8_MMA(1, 0, At, B0); PG8_BAR; PG8_SCHED;
            PG8_STAGE(PG8_SB(1, 1), b3 + hstep, voffB);
            PG8_WAIT_V(6); PG8_BAR; PG8_MMA(1, 1, At, B1); PG8_BAR;
            }
        }
        if constexpr (ALIGN_EPI) { if (wr == 0) PG8_BAR; }
        if constexpr (!Epi::AFTER_DRAIN) { int fr_e = fr, fq_e = fq; asm volatile("" : "+v"(fr_e), "+v"(fq_e));
            E(acc, cur, wr, wc, fr_e, fq_e); S.done(cur); }
        if (!has_next) break;
#pragma unroll
        for (int a = 0; a < 2; ++a)
#pragma unroll
            for (int b = 0; b < 2; ++b)
#pragma unroll
                for (int m = 0; m < 4; ++m)
#pragma unroll
                    for (int n = 0; n < 2; ++n) acc[a][b][m][n] = (f32x4){0.f, 0.f, 0.f, 0.f};
        cur = nxt; cA = nA; cB = nB; ++ui;
        if constexpr (ALIGN_EPI) { if (wr == 1) PG8_BAR; }
    }
    PG8_WAIT_V(0);
    if constexpr (!ALIGN_EPI) { if (wr == 0) PG8_BAR; }
    PG8_BAR;
    if constexpr (Epi::AFTER_DRAIN) { E.fused(acc, cur, wr, wc, fr, fq, lds, wid, lane); S.done(cur); }
#undef PG8_GLOAD
#undef PG8_SA
#undef PG8_SB
#undef PG8_SBR
#undef PG8_STAGE
#undef PG8_LDA
#undef PG8_LDB
#undef PG8_MMA
#undef PG8_LD16
#undef PG8_WAIT_V
#undef PG8_WAIT_L
#undef PG8_BAR
#undef PG8_SCHED
}
}

constexpr size_t MiB = 1u << 20;
constexpr size_t WS_CTL = 0, CTL_ZERO_BYTES = 1 * MiB;
constexpr size_t WS_MOD  = 1 * MiB;
constexpr size_t WS_WRT  = 2 * MiB;
constexpr size_t WS_MOEI = 3 * MiB;
constexpr size_t WS_IDT  = WS_MOEI + 5 * 512 * 1024;
constexpr size_t WS_LRC  = 6 * MiB;
constexpr size_t WS_DNS  = 12 * MiB;
constexpr size_t WS_WIN  = 16 * MiB;
constexpr size_t WS_WOUT = 56 * MiB;
constexpr size_t WS_WGU  = 72 * MiB;
constexpr size_t WS_WDN  = 584 * MiB;
constexpr size_t WS_X    = 840 * MiB;
constexpr size_t WS_H    = 976 * MiB;
constexpr size_t WS_P    = 1044 * MiB;
constexpr size_t WS_CC   = 1206 * MiB;
constexpr size_t WS_VT   = 1274 * MiB;
constexpr size_t WS_VTC  = WS_VT + 8 * MiB;
constexpr size_t WS_DNT  = 1284 * MiB;
constexpr size_t DNT_BYTES = 90112;
constexpr size_t WS_DNO  = 1472 * MiB;
constexpr size_t WS_LRH  = 1540 * MiB;
constexpr size_t WS_LRA  = 1608 * MiB;
constexpr size_t WS_XS   = 1676 * MiB;
constexpr size_t WS_ACT  = 1980 * MiB;
constexpr size_t WS_YS   = 2132 * MiB;
constexpr size_t WS_END  = 2436 * MiB;
constexpr int CW_TMO = 0;
constexpr int CW_BAR = 4096;
constexpr int CW_CNT = 8192;
constexpr int CW_ATQ = 12288;

constexpr int RING_OFF = 0, RING_BYTES = 131072;
constexpr int LDSCTL_OFF = RING_BYTES, MISC_OFF = LDSCTL_OFF + 320;
constexpr int LDS_X_OFF = RING_BYTES + 1024;
constexpr int LDS_BYTES = 147456;
constexpr int NWAVES = 8, NTHREADS = 512;

#define GAS __attribute__((address_space(1)))
#define LAS __attribute__((address_space(3)))
typedef unsigned short bf16;
typedef unsigned v4u __attribute__((ext_vector_type(4)));
typedef unsigned v2u __attribute__((ext_vector_type(2)));
typedef float f32x4 __attribute__((ext_vector_type(4)));
typedef float f32x16 __attribute__((ext_vector_type(16)));
typedef short bf16x8 __attribute__((ext_vector_type(8)));
typedef short bf16x4 __attribute__((ext_vector_type(4)));
typedef GAS unsigned gu32;
#define RLX_AGENT __ATOMIC_RELAXED, __HIP_MEMORY_SCOPE_AGENT
#define LDS_WAIT() asm volatile("s_waitcnt lgkmcnt(0)" ::: "memory")
#define VM_WAIT() asm volatile("s_waitcnt vmcnt(0)" ::: "memory")
#define LDS_BARRIER() asm volatile("s_waitcnt lgkmcnt(0)\n\ts_barrier" ::: "memory")
typedef __bf16 bf16x2_t __attribute__((ext_vector_type(2)));
typedef float f32x2_t __attribute__((ext_vector_type(2)));
__device__ __forceinline__ unsigned pk2(float lo, float hi) { const f32x2_t v = {lo, hi}; const bf16x2_t b = __builtin_convertvector(v, bf16x2_t); return __builtin_bit_cast(unsigned, b); }
__device__ __forceinline__ unsigned f2bf(float f) { return pk2(f, 0.f) & 0xffffu; }
__device__ __forceinline__ unsigned pk4_fp8(float a, float b, float c, float d) { int x = 0; x = __builtin_amdgcn_cvt_pk_fp8_f32(a, b, x, false); x = __builtin_amdgcn_cvt_pk_fp8_f32(c, d, x, true); return (unsigned)x; }
__device__ __forceinline__ float bf2f(unsigned short b) { return __builtin_bit_cast(float, (unsigned)b << 16); }
__device__ __forceinline__ float bflo(unsigned w) { return __builtin_bit_cast(float, w << 16); }
__device__ __forceinline__ float bfhi(unsigned w) { return __builtin_bit_cast(float, w & 0xffff0000u); }
template <int CTRL> __device__ __forceinline__ float dpp_mov(float v) { return __builtin_bit_cast(float, __builtin_amdgcn_update_dpp(0, __builtin_bit_cast(int, v), CTRL, 0xF, 0xF, false)); }
__device__ __forceinline__ float wave_sum(float v) {
    v += dpp_mov<0xB1>(v); v += dpp_mov<0x4E>(v); v += dpp_mov<0x141>(v); v += dpp_mov<0x140>(v);
    const int iv = __builtin_bit_cast(int, v);
    const float r0 = __builtin_bit_cast(float, __builtin_amdgcn_readlane(iv, 0)), r1 = __builtin_bit_cast(float, __builtin_amdgcn_readlane(iv, 16)), r2 = __builtin_bit_cast(float, __builtin_amdgcn_readlane(iv, 32)), r3 = __builtin_bit_cast(float, __builtin_amdgcn_readlane(iv, 48));
    return (r0 + r1) + (r2 + r3);
}
__device__ __forceinline__ float sigmoidf_(float x) { return __builtin_amdgcn_rcpf(1.0f + __builtin_amdgcn_exp2f(-1.4426950408889634f * x)); }
__device__ __forceinline__ float siluf_(float x) { return x * sigmoidf_(x); }
__device__ __forceinline__ float softplusf_(float x) { return x > 20.f ? x : log1pf(__expf(x)); }

#define XB_TMO      128
#define XB_XCNT(j)  (256  + 64 * (j))
#define XB_XSUB(j)  (1280 + 64 * (j))
#define XB_XGEN(j)  (2304 + 64 * (j))
#define XB_TOP      3328
#define XB_TOPGEN   3392
#define XCD_BAR_WORDS 3456
#define XB_SPIN_CAP (1u << 18)

__device__ __forceinline__ unsigned xb_ld(unsigned* p)              { return __hip_atomic_load(p, __ATOMIC_RELAXED, __HIP_MEMORY_SCOPE_AGENT); }
__device__ __forceinline__ unsigned xb_add(unsigned* p, unsigned v) { return __hip_atomic_fetch_add(p, v, __ATOMIC_RELAXED, __HIP_MEMORY_SCOPE_AGENT); }
__device__ __forceinline__ unsigned xb_xcc_id() { return (unsigned)__builtin_amdgcn_s_getreg((3 << 11) | 20) & 0xFu; }
#define XB_SPIN(cond, bar) do { unsigned _sp = 0; while (cond) { __builtin_amdgcn_s_sleep(1); \
    if ((++_sp & 255u) == 0u) { if (xb_ld(&(bar)[XB_TMO])) break; if (_sp > XB_SPIN_CAP) { atomicAdd(&(bar)[XB_TMO], 1u); break; } } } } while (0)

struct XcdBarrier {
    unsigned* bar; unsigned x;
    volatile LAS unsigned* st;
};

__device__ __forceinline__ XcdBarrier xcd_barrier_post(unsigned* bar, volatile LAS unsigned* st) {
    XcdBarrier b; b.bar = bar; b.x = xb_xcc_id(); b.st = st;
    if (threadIdx.x == 0) (void)xb_add(&bar[XB_XCNT(b.x)], 1u);
    return b;
}
__device__ __forceinline__ void xcd_barrier_complete(unsigned* bar, unsigned x, unsigned& nloc, unsigned& nx) {
    const unsigned G = gridDim.x * gridDim.y * gridDim.z;
    unsigned sum, cnt, mine, sp = 0u;
    for (;;) {
        sum = 0u; cnt = 0u; mine = 0u;
#pragma unroll
        for (unsigned j = 0; j < 16; ++j) { const unsigned c = xb_ld(&bar[XB_XCNT(j)]); sum += c; cnt += (c > 0u) ? 1u : 0u; mine = (j == x) ? c : mine; }
        if (sum == G) break;
        __builtin_amdgcn_s_sleep(1);
        if ((++sp & 255u) == 0u) { if (xb_ld(&bar[XB_TMO])) break; if (sp > XB_SPIN_CAP) { atomicAdd(&bar[XB_TMO], 1u); break; } }
    }
    nloc = mine > 0u ? mine : 1u; nx = cnt > 0u ? cnt : 1u;
}

__device__ __forceinline__ void xcd_barrier(const XcdBarrier& b) {
    asm volatile("s_waitcnt vmcnt(0)" ::: "memory");
    __syncthreads();
    if (threadIdx.x == 0) {
        unsigned* bar = b.bar;
        __builtin_amdgcn_s_waitcnt(0);
        unsigned nloc = b.st[0], nx = b.st[1];
        if (nloc == 0u) { xcd_barrier_complete(bar, b.x, nloc, nx); b.st[0] = nloc; b.st[1] = nx; }
        const unsigned old = xb_add(&bar[XB_XSUB(b.x)], 1u);
        const unsigned gen = old / nloc;
        if (old + 1u == (gen + 1u) * nloc) {
            __builtin_amdgcn_fence(__ATOMIC_RELEASE, "agent");
            asm volatile("s_waitcnt vmcnt(0)" ::: "memory");
            const unsigned og = xb_add(&bar[XB_TOP], 1u);
            const unsigned tg = og / nx;
            if (og + 1u == (tg + 1u) * nx) xb_add(&bar[XB_TOPGEN], 1u);
            else XB_SPIN(xb_ld(&bar[XB_TOPGEN]) == tg, bar);
            __builtin_amdgcn_fence(__ATOMIC_ACQUIRE, "agent");
            xb_add(&bar[XB_XGEN(b.x)], 1u);
            asm volatile("s_waitcnt vmcnt(0)" ::: "memory");
        } else {
            XB_SPIN(xb_ld(&bar[XB_XGEN(b.x)]) == gen, bar);
            __builtin_amdgcn_fence(__ATOMIC_ACQUIRE, "agent");
            asm volatile("s_waitcnt vmcnt(0)" ::: "memory");
        }
    }
    __syncthreads();
}

enum InIdx { I_X = 0, I_C, I_CTX, I_CCTX, I_WMOD, I_BMOD, I_NMG, I_NFG, I_WIN, I_WOUT, I_SINK, I_DNCW, I_DNALOG, I_DNDT, I_DNNG, I_LRCW, I_LRCB, I_LRWR, I_LRBR, I_LRWI, I_LRBI, I_LRLAM,
             I_WROUT, I_BROUT, I_WGU, I_BGU, I_WDN, I_BDN, I_FNG, N_IN };
struct Frame {
    LAS unsigned char* lds;
    volatile LAS unsigned* MISC;
    gu32* ctl;
    int tid, lane, wave, G, bid;
    const float* const __attribute__((address_space(4)))* in;
    float* out; unsigned char* ws;
};
__device__ __forceinline__ int mod_row(int m) { return m < NLAT ? (m >> 12) : 4; }
__device__ __forceinline__ bool phase_enter(Frame& F) { int t = threadIdx.x; asm volatile("" : "+v"(t)); F.tid = t; F.lane = t & 63; F.wave = __builtin_amdgcn_readfirstlane(t >> 6); return true; }
__device__ __forceinline__ void seq_of(int m, int& t, int& T, int& base) { if (m < NLAT) { t = m & 4095; T = SEQ; base = m - t; } else { t = (m - NLAT) & 255; T = CTXL; base = m - t; } }
__device__ __forceinline__ float gelu_tanh(float x) { const float u = 0.7978845608028654f * (x + 0.044715f * x * x * x); return x * sigmoidf_(2.0f * u); }

__device__ __forceinline__ void transpose_item(const float* W, int K, int N, bf16* WT, int k0, int dstrow0, int srccol0, int nvalid, LAS float* scr, int lane) {
    { const int c4 = (lane & 7) * 4, kr = lane >> 3; f32x4 v[8];
#pragma unroll
      for (int i = 0; i < 8; ++i) { v[i] = (f32x4){0.f, 0.f, 0.f, 0.f}; if (c4 < nvalid) v[i] = __builtin_nontemporal_load((const f32x4*)(W + (size_t)(k0 + 8 * i + kr) * N + srccol0 + c4)); }
#pragma unroll
      for (int i = 0; i < 8; ++i) { LAS float* d = scr + (8 * i + kr) * 33 + c4; d[0] = v[i].x; d[1] = v[i].y; d[2] = v[i].z; d[3] = v[i].w; } }
    LDS_WAIT(); asm volatile("" ::: "memory");
    const int c = lane & 7;
#pragma unroll
    for (int jj = 0; jj < 4; ++jj) { const int n = (lane >> 3) + 8 * jj; const LAS float* s = scr + (8 * c) * 33 + n;
        v4u o; o.x = pk2(s[0 * 33], s[1 * 33]); o.y = pk2(s[2 * 33], s[3 * 33]); o.z = pk2(s[4 * 33], s[5 * 33]); o.w = pk2(s[6 * 33], s[7 * 33]);
        *(GAS v4u*)(WT + (size_t)(dstrow0 + n) * K + k0 + 8 * c) = o; }
    LDS_WAIT(); asm volatile("" ::: "memory");
}
__device__ __forceinline__ void transpose_item_f8(const float* W, int K, int N, unsigned char* WT, int k0, int dstrow0, int srccol0, float scale, LAS float* scr, int lane) {
    { const int c4 = (lane & 7) * 4, kr = lane >> 3; f32x4 v[8];
#pragma unroll
      for (int i = 0; i < 8; ++i) v[i] = __builtin_nontemporal_load((const f32x4*)(W + (size_t)(k0 + 8 * i + kr) * N + srccol0 + c4));
#pragma unroll
      for (int i = 0; i < 8; ++i) { LAS float* d = scr + (8 * i + kr) * 33 + c4; d[0] = v[i].x; d[1] = v[i].y; d[2] = v[i].z; d[3] = v[i].w; } }
    LDS_WAIT(); asm volatile("" ::: "memory");
    { const int n = lane >> 1, hf = lane & 1; const LAS float* s = scr + (32 * hf) * 33 + n; unsigned w[8];
#pragma unroll
      for (int i = 0; i < 8; ++i) { int x = 0; x = __builtin_amdgcn_cvt_pk_fp8_f32(s[(4 * i + 0) * 33] * scale, s[(4 * i + 1) * 33] * scale, x, false); x = __builtin_amdgcn_cvt_pk_fp8_f32(s[(4 * i + 2) * 33] * scale, s[(4 * i + 3) * 33] * scale, x, true); w[i] = (unsigned)x; }
      v4u* o = (v4u*)(WT + (size_t)(dstrow0 + n) * K + k0 + 32 * hf); __builtin_nontemporal_store((v4u){w[0], w[1], w[2], w[3]}, o); __builtin_nontemporal_store((v4u){w[4], w[5], w[6], w[7]}, o + 1); }
    LDS_WAIT(); asm volatile("" ::: "memory");
}
__device__ __forceinline__ void p0_prologue(Frame& F) {
    {
        LAS float* sc = (LAS float*)(F.lds);
        LAS float* red = (LAS float*)(F.lds + 40960);
        bool have_sc = false;
        for (int wb = F.bid; wb < 192; wb += F.G) {
            if (!have_sc) {
                for (int i = F.tid; i < 5 * 2048; i += NTHREADS) { const int r = i >> 11, k = i & 2047; const float cv = r < 4 ? F.in[I_C][r * 2048 + k] : F.in[I_CCTX][k]; sc[i] = siluf_(cv); }
                have_sc = true; __syncthreads();
            }
            const int l = wb / 96, cb = wb % 96, kp = F.tid >> 5, cg = F.tid & 31, j0 = cb * 128 + cg * 4;
            const float* wp = F.in[I_WMOD] + ((size_t)l * 2048 + kp * 128) * 12288 + j0;
            f32x4 acc[5];
#pragma unroll
            for (int r = 0; r < 5; ++r) acc[r] = (f32x4){0.f, 0.f, 0.f, 0.f};
#pragma unroll 4
            for (int k = 0; k < 128; ++k) { const f32x4 w = *(const f32x4*)(wp + (size_t)k * 12288);
#pragma unroll
                for (int r = 0; r < 5; ++r) acc[r] += sc[r * 2048 + kp * 128 + k] * w; }
#pragma unroll
            for (int r = 0; r < 5; ++r) *(LAS f32x4*)(red + (kp * 5 + r) * 128 + cg * 4) = acc[r];
            __syncthreads();
            for (int i = F.tid; i < 640; i += NTHREADS) { const int r = i >> 7, col = i & 127; float s = F.in[I_BMOD][l * 12288 + cb * 128 + col];
#pragma unroll
                for (int q = 0; q < 16; ++q) s += red[(q * 5 + r) * 128 + col];
                ((float*)(F.ws + WS_MOD))[(size_t)(l * 5 + r) * 12288 + cb * 128 + col] = s; }
            __syncthreads();
        }
        __syncthreads();
    }
    { int* idt = (int*)(F.ws + WS_IDT); for (int r = F.bid * NTHREADS + F.tid; r < MOE_ROWS; r += F.G * NTHREADS) idt[r] = r; }
    {
        LAS float* scr = (LAS float*)(F.lds + F.wave * 16384);
        const int gw = F.bid * NWAVES + F.wave, NGW = F.G * NWAVES;
        constexpr int I_IN = 32 * 144, I_OUT = 32 * 64, I_RT = 32, I_16 = 32, PER_L = I_IN + I_OUT + I_RT + I_16;
        for (int it0 = gw; it0 < 2 * PER_L; it0 += NGW) {
            const int l = it0 / PER_L; int r = it0 % PER_L;
            if (r < I_IN) { const int nb = r % 144, kb = r / 144, d0 = nb * 32; int s0 = d0, nv = 32;
                if (d0 >= 3584) s0 = d0 + 16;
#if FP8_INPROJ
                transpose_item_f8(F.in[I_WIN] + (size_t)l * 2048 * IN_W, 2048, IN_W, F.ws + WS_WIN + (size_t)l * PW * 2048 * 2, kb * 64, d0, s0, 64.0f, scr, F.lane); continue; }
#else
                transpose_item(F.in[I_WIN] + (size_t)l * 2048 * IN_W, 2048, IN_W, (bf16*)(F.ws + WS_WIN) + (size_t)l * PW * 2048, kb * 64, d0, s0, nv, scr, F.lane); continue; }
#endif
            r -= I_IN;
            if (r < I_OUT) { const int nb = r % 64, kb = r / 64;
#if FP8_OUTPROJ
                transpose_item_f8(F.in[I_WOUT] + (size_t)l * 2048 * 2048, 2048, 2048, F.ws + WS_WOUT + (size_t)l * 2048 * 2048 * 2, kb * 64, nb * 32, nb * 32, 64.0f, scr, F.lane); continue; }
#else
                transpose_item(F.in[I_WOUT] + (size_t)l * 2048 * 2048, 2048, 2048, (bf16*)(F.ws + WS_WOUT) + (size_t)l * 2048 * 2048, kb * 64, nb * 32, nb * 32, 32, scr, F.lane); continue; }
#endif
            r -= I_OUT;
            if (r < I_RT) { transpose_item(F.in[I_WROUT] + (size_t)l * 2048 * 32, 2048, 32, (bf16*)(F.ws + WS_WRT) + (size_t)l * 32 * 2048, r * 64, 0, 0, 32, scr, F.lane); continue; }
            r -= I_RT;
            transpose_item(F.in[I_WIN] + (size_t)l * 2048 * IN_W, 2048, IN_W, (bf16*)(F.ws + WS_WRT + 512 * 1024) + (size_t)l * 32 * 2048, r * 64, 0, 3584, 16, scr, F.lane);
        }
    }
}
constexpr int CW_CVQ = 12288 + 512;
#ifndef FP8_GEMM2
#define FP8_GEMM2 1
#endif
constexpr float WGU_SCALE = 64.0f, WDN_SCALE = 64.0f; constexpr int WGU_E8M0 = 0x7C7C7C7C, WDN_E8M0 = 0x7C7C7C7C;
__device__ __forceinline__ void convert_moe_item(Frame& F, int l, int r, LAS float* scr) {
    constexpr int I_GU = 32 * 32 * 64;
    if (r < I_GU) { const int e = r / 2048, q = r % 2048, nb = q % 64, kb = q / 64; const int s0 = ((nb >> 2) & 1) * 1024 + (nb >> 3) * 128 + (nb & 3) * 32;
        transpose_item_f8(F.in[I_WGU] + (size_t)(l * 32 + e) * 2048 * 2048, 2048, 2048, F.ws + WS_WGU + (size_t)(l * 32 + e) * 2048 * 2048, kb * 64, nb * 32, s0, WGU_SCALE, scr, F.lane); return; }
    r -= I_GU;
    { const int e = r / 1024, q = r % 1024, nb = q % 64, kb = q / 64;
#if FP8_GEMM2
        transpose_item_f8(F.in[I_WDN] + (size_t)(l * 32 + e) * 1024 * 2048, 1024, 2048, F.ws + WS_WDN + (size_t)(l * 32 + e) * 2048 * 1024, kb * 64, nb * 32, nb * 32, WDN_SCALE, scr, F.lane);
#else
        transpose_item(F.in[I_WDN] + (size_t)(l * 32 + e) * 1024 * 2048, 1024, 2048, (bf16*)(F.ws + WS_WDN) + (size_t)(l * 32 + e) * 2048 * 1024, kb * 64, nb * 32, nb * 32, 32, scr, F.lane);
#endif
    }
}
constexpr int CVG = 8;
__device__ __forceinline__ bool convert_grab(Frame& F, int l, int rep, LAS float* scr) {
    constexpr int NIT = 32 * 32 * 64 + 32 * 16 * 64;
    int g = 0; if (F.lane == 0) g = (int)__hip_atomic_fetch_add(F.ctl + CW_CVQ + 64 * l + 8 * rep, 1u, RLX_AGENT); g = __builtin_amdgcn_readfirstlane(g);
    if (g * CVG >= NIT) return false;
#pragma unroll 1
    for (int k = 0; k < CVG; ++k) convert_moe_item(F, l, g * CVG + k, scr);
    return true;
}
__device__ __forceinline__ void convert_moe_queue(Frame& F, int l, int rep = 0) {
    LAS float* scr = (LAS float*)(F.lds + F.wave * 16384);
    __syncthreads();
    while (convert_grab(F, l, rep, scr)) {}
    __syncthreads();
}
constexpr int CW_TAIL = 16384;
__device__ __forceinline__ void tail_fill(Frame& F, int seam, int lt) {
    LAS int* flag = (LAS int*)(F.lds + LDS_X_OFF + 768);
    LAS float* scr = (LAS float*)(F.lds + F.wave * 16384);
    __syncthreads();
    if (F.tid == 0) (void)__hip_atomic_fetch_add(F.ctl + CW_TAIL + 64 * seam, 1u, RLX_AGENT);
    bool more = true;
    for (int it = 0; it < 4096; ++it) {
        if (F.tid == 0) *flag = (__hip_atomic_load(F.ctl + CW_TAIL + 64 * seam, RLX_AGENT) >= (unsigned)F.G) ? 1 : 0;
        __syncthreads();
        const int done = *flag;
        __syncthreads();
        if (done) break;
        if (more) more = convert_grab(F, lt, 0, scr); else __builtin_amdgcn_s_sleep(32);
    }
}
__device__ __forceinline__ void convert_moe_timed(Frame& F, int l, unsigned long long budget) {
    LAS float* scr = (LAS float*)(F.lds + F.wave * 16384);
    const unsigned long long t0 = __builtin_amdgcn_s_memrealtime();
    __syncthreads();
    while (__builtin_amdgcn_s_memrealtime() - t0 < budget) { if (!convert_grab(F, l, 0, scr)) break; }
    __syncthreads();
}

__device__ __forceinline__ void load_row(const float* src, int lane, f32x4 (&v)[8]) {
    const f32x4* p = (const f32x4*)src + lane;
#pragma unroll
    for (int j = 0; j < 8; ++j) v[j] = p[64 * j];
}
__device__ __forceinline__ void store_row(float* dst, int lane, const f32x4 (&v)[8]) {
    f32x4* p = (f32x4*)dst + lane;
#pragma unroll
    for (int j = 0; j < 8; ++j) p[64 * j] = v[j];
}
#if X_BF16
typedef bf16 xelem_t;
__device__ __forceinline__ void load_xrow(const bf16* src, int lane, f32x4 (&v)[8]) {
    const v2u* p = (const v2u*)src + lane;
#pragma unroll
    for (int j = 0; j < 8; ++j) { const v2u w = p[64 * j]; v[j] = (f32x4){bflo(w.x), bfhi(w.x), bflo(w.y), bfhi(w.y)}; }
}
__device__ __forceinline__ void store_xrow(bf16* dst, int lane, const f32x4 (&v)[8]) {
    v2u* p = (v2u*)dst + lane;
#pragma unroll
    for (int j = 0; j < 8; ++j) { v2u w; w.x = pk2(v[j].x, v[j].y); w.y = pk2(v[j].z, v[j].w); p[64 * j] = w; }
}
#else
typedef float xelem_t;
__device__ __forceinline__ void load_xrow(const float* src, int lane, f32x4 (&v)[8]) { load_row(src, lane, v); }
__device__ __forceinline__ void store_xrow(float* dst, int lane, const f32x4 (&v)[8]) { store_row(dst, lane, v); }
#endif
__device__ __forceinline__ void combine_row(Frame& F, int l, int m, int lane, f32x4 (&v)[8]) {
    const int* dest = (const int*)(F.ws + WS_MOEI + 2 * 512 * 1024) + m * 4;
    const float* g5 = (const float*)(F.ws + WS_MOD) + (size_t)(l * 5 + mod_row(m)) * 12288 + 5 * 2048;
    f32x4 acc[8];
#pragma unroll
    for (int j = 0; j < 8; ++j) acc[j] = (f32x4){0.f, 0.f, 0.f, 0.f};
#if YS_FP8
    typedef float f32x2c __attribute__((ext_vector_type(2)));
#pragma unroll
    for (int k = 0; k < 4; ++k) { const int d = dest[k]; const unsigned* yp = (const unsigned*)(F.ws + WS_YS + (size_t)d * 2048) + lane;
#pragma unroll
        for (int j = 0; j < 8; ++j) { const int w = (int)yp[64 * j]; const f32x2c lo = __builtin_amdgcn_cvt_pk_f32_fp8(w, false), hi = __builtin_amdgcn_cvt_pk_f32_fp8(w, true); acc[j] += (f32x4){lo.x, lo.y, hi.x, hi.y}; } }
#pragma unroll
    for (int j = 0; j < 8; ++j) { const f32x4 gg = *((const f32x4*)g5 + lane + 64 * j); v[j] += gg * acc[j] * 0.0625f; }
#else
#pragma unroll
    for (int k = 0; k < 4; ++k) { const int d = dest[k]; const v2u* yp = (const v2u*)((const bf16*)(F.ws + WS_YS) + (size_t)d * 2048) + lane;
#pragma unroll
        for (int j = 0; j < 8; ++j) { const v2u w = yp[64 * j]; acc[j] += (f32x4){bflo(w.x), bfhi(w.x), bflo(w.y), bfhi(w.y)}; } }
#pragma unroll
    for (int j = 0; j < 8; ++j) { const f32x4 gg = *((const f32x4*)g5 + lane + 64 * j); v[j] += gg * acc[j]; }
#endif
}
__device__ __forceinline__ void modnorm_store(const f32x4 (&v)[8], const float* g, const float* shift, const float* scale, bf16* hrow, int lane) {
    float ss = 0.f;
#pragma unroll
    for (int j = 0; j < 8; ++j) ss += (v[j].x * v[j].x + v[j].y * v[j].y) + (v[j].z * v[j].z + v[j].w * v[j].w);
    const float rstd = 1.0f / sqrtf(wave_sum(ss) * (1.0f / 2048.0f) + EPS);
    v2u* hp = (v2u*)hrow + lane;
#pragma unroll
    for (int j = 0; j < 8; ++j) { const f32x4 gg = *((const f32x4*)g + lane + 64 * j), sh = *((const f32x4*)shift + lane + 64 * j), sc = *((const f32x4*)scale + lane + 64 * j);
        const f32x4 y = (v[j] * rstd) * gg * (sc + 1.0f) + sh; v2u w; w.x = pk2(y.x, y.y); w.y = pk2(y.z, y.w); hp[64 * j] = w; }
}
constexpr size_t WS_W16 = WS_WRT + 512 * 1024;
__device__ __forceinline__ void phase_norm1(Frame& F, int l) {
    constexpr int TROW = 4112;
    LAS unsigned char* tile = F.lds; LAS float* part = (LAS float*)(F.lds + 66048);
    xelem_t* X = (xelem_t*)(F.ws + WS_X); bf16* H = (bf16*)(F.ws + WS_H); bf16* P = (bf16*)(F.ws + WS_P);
    const float* modp = (const float*)(F.ws + WS_MOD) + (size_t)l * 5 * 12288;
    const bf16* w16 = (const bf16*)(F.ws + WS_W16) + (size_t)l * 32 * 2048;
    for (int r0 = F.bid * 16; r0 < NTOK; r0 += F.G * 16) {
#pragma unroll 1
        for (int rr = 0; rr < 2; ++rr) { const int lr = 2 * F.wave + rr, m = r0 + lr;
            f32x4 v[8];
            if (l == 0) load_row(m < NLAT ? F.in[I_X] + (size_t)m * DM : F.in[I_CTX] + (size_t)(m - NLAT) * DM, F.lane, v);
            else { load_xrow(X + (size_t)m * DM, F.lane, v); if (MK_STAGE >= 9) { combine_row(F, l - 1, m, F.lane, v); store_xrow(X + (size_t)m * DM, F.lane, v); } }
            float ss = 0.f;
#pragma unroll
            for (int j = 0; j < 8; ++j) ss += (v[j].x * v[j].x + v[j].y * v[j].y) + (v[j].z * v[j].z + v[j].w * v[j].w);
            const float rstd = 1.0f / sqrtf(wave_sum(ss) * (1.0f / 2048.0f) + EPS);
            const float* mr = modp + (size_t)mod_row(m) * 12288; const float* g = F.in[I_NMG] + l * DM;
#if FP8_INPROJ
            unsigned* hp = (unsigned*)(F.ws + WS_XS + (size_t)m * DM) + F.lane; LAS v2u* tp = (LAS v2u*)(tile + lr * TROW) + F.lane;
#else
            v2u* hp = (v2u*)(H + (size_t)m * DM) + F.lane; LAS v2u* tp = (LAS v2u*)(tile + lr * TROW) + F.lane;
#endif
#pragma unroll
            for (int j = 0; j < 8; ++j) { const f32x4 gg = *((const f32x4*)g + F.lane + 64 * j), sh = *((const f32x4*)mr + F.lane + 64 * j), sc = *((const f32x4*)(mr + 2048) + F.lane + 64 * j);
                const f32x4 y = (v[j] * rstd) * gg * (sc + 1.0f) + sh; v2u w; w.x = pk2(y.x, y.y); w.y = pk2(y.z, y.w); tp[64 * j] = w;
#if FP8_INPROJ
                int x8 = 0; x8 = __builtin_amdgcn_cvt_pk_fp8_f32(y.x, y.y, x8, false); x8 = __builtin_amdgcn_cvt_pk_fp8_f32(y.z, y.w, x8, true); hp[64 * j] = (unsigned)x8; }
#else
                hp[64 * j] = w; }
#endif
        }
        __syncthreads();
        { const int row = F.lane & 15, q = F.lane >> 4; f32x4 acc = {0.f, 0.f, 0.f, 0.f};
#pragma unroll
          for (int ks = 0; ks < 8; ++ks) { const int k0 = 256 * F.wave + 32 * ks + 8 * q;
              const bf16x8 a = *(const LAS bf16x8*)(tile + row * TROW + k0 * 2); const bf16x8 b = *(const bf16x8*)(w16 + (size_t)row * 2048 + k0);
              acc = __builtin_amdgcn_mfma_f32_16x16x32_bf16(a, b, acc, 0, 0, 0); }
#pragma unroll
          for (int i = 0; i < 4; ++i) part[(F.wave * 16 + 4 * q + i) * 16 + row] = acc[i]; }
        __syncthreads();
        if (F.tid < 256) { const int rw = F.tid >> 4, c = F.tid & 15; float sacc = 0.f;
#pragma unroll
            for (int w = 0; w < 8; ++w) sacc += part[(w * 16 + rw) * 16 + c];
            P[(size_t)(r0 + rw) * PW + PC_BETA + c] = (bf16)f2bf(sacc); }
        __syncthreads();
    }
}
__device__ __forceinline__ void phase_final(Frame& F, bool with_combine) {
    const int gw = F.bid * NWAVES + F.wave, NGW = F.G * NWAVES;
    const xelem_t* X = (const xelem_t*)(F.ws + WS_X);
    for (int m = gw; m < NLAT; m += NGW) {
        f32x4 v[8];
        if (with_combine) { load_xrow(X + (size_t)m * DM, F.lane, v); combine_row(F, 1, m, F.lane, v); }
        else load_row(F.in[I_X] + (size_t)m * DM, F.lane, v);
        float ss = 0.f;
#pragma unroll
        for (int j = 0; j < 8; ++j) ss += (v[j].x * v[j].x + v[j].y * v[j].y) + (v[j].z * v[j].z + v[j].w * v[j].w);
        const float rstd = 1.0f / sqrtf(wave_sum(ss) * (1.0f / 2048.0f) + EPS);
        f32x4* op = (f32x4*)(F.out + (size_t)m * DM) + F.lane;
#pragma unroll
        for (int j = 0; j < 8; ++j) { const f32x4 gg = *((const f32x4*)F.in[I_FNG] + F.lane + 64 * j); op[64 * j] = v[j] * rstd * gg; }
    }
}

__device__ __forceinline__ void phase_inproj(Frame& F, int l) {
#if FP8_INPROJ
    pg8::Gemm g{(const bf16*)(F.ws + WS_XS), (const bf16*)(F.ws + WS_WIN + (size_t)l * PW * 2048 * 2), NTOK, 4608, 1024, 0x7C7C7C7C};
    pg8::StaticOrderG S; S.init(g, F.G, F.bid); S.row_tab = (const int*)(F.ws + WS_IDT);
    pg8::EpiBf16Plain E{(bf16*)(F.ws + WS_P), PW};
    pg8::gemm_phase<pg8::EpiBf16Plain, pg8::StaticOrderG, true, true, true>(F.lds + RING_OFF, g, S, E);
#else
    pg8::Gemm g{(const bf16*)(F.ws + WS_H), (const bf16*)(F.ws + WS_WIN) + (size_t)l * PW * 2048, NTOK, 4608, 2048};
    pg8::StaticOrder S; S.init(g, F.G, F.bid);
    pg8::EpiBf16Plain E{(bf16*)(F.ws + WS_P), PW};
    pg8::gemm_phase<pg8::EpiBf16Plain, pg8::StaticOrder, true, true>(F.lds + RING_OFF, g, S, E);
#endif
}
__device__ __forceinline__ void phase_outproj(Frame& F, int l) {
    float* X = (float*)(F.ws + WS_X);
#if FP8_OUTPROJ
    pg8::Gemm g{(const bf16*)(F.ws + WS_CC), (const bf16*)(F.ws + WS_WOUT + (size_t)l * 2048 * 2048 * 2), l == 0 ? NTOK : NLAT, 2048, 1024, 0x7C7C7C7C};
    pg8::StaticOrderG S; S.init(g, F.G, F.bid); S.row_tab = (const int*)(F.ws + WS_IDT);
#else
    pg8::Gemm g{(const bf16*)(F.ws + WS_CC), (const bf16*)(F.ws + WS_WOUT) + (size_t)l * 2048 * 2048, l == 0 ? NTOK : NLAT, 2048, 2048};
    pg8::StaticOrder S; S.init(g, F.G, F.bid);
#endif
#if X_BF16
    pg8::EpiResGateB E{F.in[I_X], F.in[I_CTX], (const bf16*)(F.ws + WS_X), (bf16*)(F.ws + WS_X), (const float*)(F.ws + WS_MOD) + (size_t)l * 5 * 12288 + 2 * 2048, l == 0 ? 1 : 0};
#define EPI_RES pg8::EpiResGateB
#else
    pg8::EpiResGate E{l == 0 ? F.in[I_X] : X, l == 0 ? F.in[I_CTX] : X + (size_t)NLAT * DM, X, (const float*)(F.ws + WS_MOD) + (size_t)l * 5 * 12288 + 2 * 2048};
#define EPI_RES pg8::EpiResGate
#endif
#if FP8_OUTPROJ
    pg8::gemm_phase<EPI_RES, pg8::StaticOrderG, true, true, true>(F.lds + RING_OFF, g, S, E);
#else
    pg8::gemm_phase<EPI_RES, pg8::StaticOrder, true, true>(F.lds + RING_OFF, g, S, E);
#endif
    if (OUTPROJ_SLACK_TICKS > 0 && l == 0 && F.bid >= 32) convert_moe_timed(F, 1, OUTPROJ_SLACK_TICKS);
}
#ifndef PHASE_INPROJ
#define PHASE_INPROJ(F, l) phase_inproj(F, l)
#endif
#ifndef PHASE_OUTPROJ
#define PHASE_OUTPROJ(F, l) phase_outproj(F, l)
#endif

constexpr size_t WS_H8 = WS_XS;
constexpr size_t MOEI_TOPE = WS_MOEI, MOEI_TOPG = WS_MOEI + 512 * 1024, MOEI_DEST = WS_MOEI + 2 * 512 * 1024, MOEI_ROWG = WS_MOEI + 3 * 512 * 1024, MOEI_ROWT = WS_MOEI + 4 * 512 * 1024, MOEI_IDT = WS_IDT;
__device__ __forceinline__ void phase_norm2(Frame& F, int l) {
    const int nrows = (l == 0) ? NTOK : NLAT;
    constexpr int TROW = 4112;
    LAS unsigned char* tile = F.lds;
    LAS float* part = (LAS float*)(F.lds + 66048);
    LAS float* lg = (LAS float*)(F.lds + 66048 + 16384);
    const xelem_t* X = (const xelem_t*)(F.ws + WS_X); bf16* H = (bf16*)(F.ws + WS_H);
    const float* modp = (const float*)(F.ws + WS_MOD) + (size_t)l * 5 * 12288;
    const bf16* wrt = (const bf16*)(F.ws + WS_WRT) + (size_t)l * 32 * 2048;
    int* tope = (int*)(F.ws + MOEI_TOPE); float* topg = (float*)(F.ws + MOEI_TOPG);
    for (int r0 = F.bid * 16; r0 < nrows; r0 += F.G * 16) {
#pragma unroll 1
        for (int rr = 0; rr < 2; ++rr) {
            const int lr = 2 * F.wave + rr, m = r0 + lr;
            f32x4 v[8]; load_xrow(X + (size_t)m * DM, F.lane, v);
            float ss = 0.f;
#pragma unroll
            for (int j = 0; j < 8; ++j) ss += (v[j].x * v[j].x + v[j].y * v[j].y) + (v[j].z * v[j].z + v[j].w * v[j].w);
            const float rstd = 1.0f / sqrtf(wave_sum(ss) * (1.0f / 2048.0f) + EPS);
            const float* mr = modp + (size_t)mod_row(m) * 12288; const float* g = F.in[I_NFG] + l * DM;
            unsigned* hp = (unsigned*)(F.ws + WS_H8 + (size_t)m * DM) + F.lane; LAS v2u* tp = (LAS v2u*)(tile + lr * TROW) + F.lane;
#pragma unroll
            for (int j = 0; j < 8; ++j) { const f32x4 gg = *((const f32x4*)g + F.lane + 64 * j), sh = *((const f32x4*)(mr + 3 * 2048) + F.lane + 64 * j), sc = *((const f32x4*)(mr + 4 * 2048) + F.lane + 64 * j);
                const f32x4 y = (v[j] * rstd) * gg * (sc + 1.0f) + sh; v2u w; w.x = pk2(y.x, y.y); w.y = pk2(y.z, y.w); tp[64 * j] = w;
                int x8 = 0; x8 = __builtin_amdgcn_cvt_pk_fp8_f32(y.x, y.y, x8, false); x8 = __builtin_amdgcn_cvt_pk_fp8_f32(y.z, y.w, x8, true); hp[64 * j] = (unsigned)x8; }
        }
        __syncthreads();
        {
            const int row = F.lane & 15, q = F.lane >> 4;
            f32x4 acc0 = {0.f, 0.f, 0.f, 0.f}, acc1 = {0.f, 0.f, 0.f, 0.f};
#pragma unroll
            for (int ks = 0; ks < 8; ++ks) { const int k0 = 256 * F.wave + 32 * ks + 8 * q;
                const bf16x8 a = *(const LAS bf16x8*)(tile + row * TROW + k0 * 2);
                const bf16x8 b0 = *(const bf16x8*)(wrt + (size_t)row * 2048 + k0), b1 = *(const bf16x8*)(wrt + (size_t)(16 + row) * 2048 + k0);
                acc0 = __builtin_amdgcn_mfma_f32_16x16x32_bf16(a, b0, acc0, 0, 0, 0); acc1 = __builtin_amdgcn_mfma_f32_16x16x32_bf16(a, b1, acc1, 0, 0, 0); }
#pragma unroll
            for (int i = 0; i < 4; ++i) { part[(F.wave * 16 + 4 * q + i) * 32 + row] = acc0[i]; part[(F.wave * 16 + 4 * q + i) * 32 + 16 + row] = acc1[i]; }
        }
        __syncthreads();
        { const int rw = F.tid >> 5, e = F.tid & 31; float s = F.in[I_BROUT][l * 32 + e];
#pragma unroll
          for (int w = 0; w < 8; ++w) s += part[(w * 16 + rw) * 32 + e];
          lg[rw * 32 + e] = s; }
        __syncthreads();
        if (F.tid < 16) { const int m = r0 + F.tid; float val[4]; int idx[4]; unsigned taken = 0u;
#pragma unroll
            for (int k = 0; k < 4; ++k) { float best = -3.0e38f; int bi = 0;
                for (int e = 0; e < 32; ++e) { const float x = lg[F.tid * 32 + e]; if (!((taken >> e) & 1u) && x > best) { best = x; bi = e; } }
                val[k] = best; idx[k] = bi; taken |= 1u << bi; }
            float p[4], sum = 0.f;
#pragma unroll
            for (int k = 0; k < 4; ++k) { p[k] = __expf(val[k] - val[0]); sum += p[k]; }
#pragma unroll
            for (int k = 0; k < 4; ++k) { const unsigned rank = __hip_atomic_fetch_add(F.ctl + CW_CNT + 64 * l + idx[k], 1u, RLX_AGENT);
                tope[m * 4 + k] = idx[k] | (int)(rank << 8); topg[m * 4 + k] = p[k] / sum; }
        }
        __syncthreads();
    }
}
__device__ __forceinline__ void moe_tables(Frame& F, int l) {
    LAS int* blk_end = (LAS int*)(F.lds + LDS_X_OFF); LAS int* pstart = blk_end + 32; LAS int* cnts = blk_end + 64;
    if (F.tid < 32) cnts[F.tid] = (int)__hip_atomic_load(F.ctl + CW_CNT + 64 * l + F.tid, RLX_AGENT);
    __syncthreads();
    if (F.tid == 0) { int nb = 0;
#pragma unroll
        for (int e = 0; e < 32; ++e) { const int c = cnts[e]; pstart[e] = nb * 256; nb += (c + 255) >> 8; blk_end[e] = nb; } }
    __syncthreads();
}
__device__ __forceinline__ void phase_scatter(Frame& F, int l) {
    const int nrows = (l == 0) ? NTOK : NLAT;
    moe_tables(F, l);
    const LAS int* blk_end = (const LAS int*)(F.lds + LDS_X_OFF); const LAS int* pstart = blk_end + 32; const LAS int* cnts = blk_end + 64;
    const int* tope = (const int*)(F.ws + MOEI_TOPE); const float* topg = (const float*)(F.ws + MOEI_TOPG);
    int* dest = (int*)(F.ws + MOEI_DEST); float* rowg = (float*)(F.ws + MOEI_ROWG); int* rowt = (int*)(F.ws + MOEI_ROWT);
    for (int a = F.bid * NTHREADS + F.tid; a < nrows * 4; a += F.G * NTHREADS) {
        const int te = tope[a], e = te & 255, rank = (int)((unsigned)te >> 8), d = pstart[e] + rank;
        dest[a] = d; rowg[d] = topg[a]; rowt[d] = a >> 2; }
    if (F.bid < 32) { const int e = F.bid, r0 = pstart[e] + cnts[e], r1 = blk_end[e] * 256;
        for (int r = r0 + F.tid; r < r1; r += NTHREADS) { rowt[r] = 0; rowg[r] = 0.f; } }
}
__device__ __forceinline__ void phase_gemm1(Frame& F, int l) {
    moe_tables(F, l);
    const LAS int* blk_end = (const LAS int*)(F.lds + LDS_X_OFF);
    pg8::Gemm g{(const bf16*)(F.ws + WS_H8), (const bf16*)(F.ws + WS_WGU + (size_t)l * 32 * 2048 * 2048), MOE_ROWS, 2048, 1024, WGU_E8M0};
    pg8::MoeOrderG S{F.bid, __builtin_amdgcn_readfirstlane(blk_end[31]), (const char*)g.A, (const char*)g.Bt, (size_t)256 * 2048, (size_t)2048 * 2048, (size_t)256 * 2048, blk_end, (const int*)(F.ws + MOEI_ROWT)};
#if FP8_GEMM2
    pg8::EpiSwiglu8 E{F.ws + WS_ACT, F.in[I_BGU] + (size_t)l * 32 * 2048};
    pg8::gemm_phase<pg8::EpiSwiglu8, pg8::MoeOrderG, true, true, true>(F.lds + RING_OFF, g, S, E);
#else
    pg8::EpiSwiglu E{(bf16*)(F.ws + WS_ACT), F.in[I_BGU] + (size_t)l * 32 * 2048};
    pg8::gemm_phase<pg8::EpiSwiglu, pg8::MoeOrderG, true, true, true>(F.lds + RING_OFF, g, S, E);
#endif
}
__device__ __forceinline__ void phase_gemm2(Frame& F, int l) {
    moe_tables(F, l);
    const LAS int* blk_end = (const LAS int*)(F.lds + LDS_X_OFF);
#if FP8_GEMM2
    pg8::Gemm g{(const bf16*)(F.ws + WS_ACT), (const bf16*)(F.ws + WS_WDN + (size_t)l * 32 * 2048 * 1024), MOE_ROWS, 2048, 512, WDN_E8M0};
    pg8::MoeOrderI S{F.bid, __builtin_amdgcn_readfirstlane(blk_end[31]), (const char*)g.A, (const char*)g.Bt, (size_t)256 * 1024, (size_t)2048 * 1024, (size_t)256 * 1024, blk_end, nullptr};
#if YS_FP8
    pg8::EpiDown8 E{F.ws + WS_YS, F.in[I_BDN] + (size_t)l * 32 * 2048, (const float*)(F.ws + MOEI_ROWG)};
    pg8::gemm_phase<pg8::EpiDown8, pg8::MoeOrderI, true, true, true>(F.lds + RING_OFF, g, S, E);
#else
    pg8::EpiDown E{(bf16*)(F.ws + WS_YS), F.in[I_BDN] + (size_t)l * 32 * 2048, (const float*)(F.ws + MOEI_ROWG)};
    pg8::gemm_phase<pg8::EpiDown, pg8::MoeOrderI, true, true, true>(F.lds + RING_OFF, g, S, E);
#endif
#else
    pg8::Gemm g{(const bf16*)(F.ws + WS_ACT), (const bf16*)(F.ws + WS_WDN) + (size_t)l * 32 * 2048 * 1024, MOE_ROWS, 2048, 1024};
    pg8::MoeOrder S{F.bid, __builtin_amdgcn_readfirstlane(blk_end[31]), (const char*)g.A, (const char*)g.Bt, (size_t)256 * 1024 * 2, (size_t)2048 * 1024 * 2, (size_t)256 * 1024 * 2, blk_end, nullptr};
    pg8::EpiDown E{(bf16*)(F.ws + WS_YS), F.in[I_BDN] + (size_t)l * 32 * 2048, (const float*)(F.ws + MOEI_ROWG)};
    pg8::gemm_phase<pg8::EpiDown, pg8::MoeOrder, true, true>(F.lds + RING_OFF, g, S, E);
#endif
}
#ifndef PHASE_NORM2
#define PHASE_NORM2(F, l) phase_norm2(F, l)
#endif
#ifndef PHASE_SCATTER
#define PHASE_SCATTER(F, l) phase_scatter(F, l)
#endif
#ifndef PHASE_GEMM1
#define PHASE_GEMM1(F, l) phase_gemm1(F, l)
#endif
#ifndef PHASE_GEMM2
#define PHASE_GEMM2(F, l) phase_gemm2(F, l)
#endif
#define USE_MFMA_ATTN 1

__device__ __forceinline__ void attn_prep(Frame& F, int l) {
    bf16* P = (bf16*)(F.ws + WS_P);
    LAS unsigned short* vt = (LAS unsigned short*)F.lds;
    for (int ct = F.bid; ct < NCT; ct += F.G) {
        const int m0 = ct * 64; const bool lat = m0 < NLAT;
        __syncthreads();
        for (int i = F.tid; i < 64 * 32; i += NTHREADS) { const int tk = i >> 5, c8 = i & 31;
            const v4u w = *(const v4u*)(P + (size_t)(m0 + tk) * PW + PC_V + c8 * 8);
            const unsigned ww[4] = {w.x, w.y, w.z, w.w};
#pragma unroll
            for (int q = 0; q < 4; ++q) { vt[(c8 * 8 + 2 * q) * 66 + tk] = (unsigned short)(ww[q] & 0xffffu); vt[(c8 * 8 + 2 * q + 1) * 66 + tk] = (unsigned short)(ww[q] >> 16); } }
        if (lat) { const int tk = F.tid >> 3, kvh = (F.tid >> 1) & 3, hf = F.tid & 1; const int t = (m0 + tk) & 4095;
            bf16* kp = P + (size_t)(m0 + tk) * PW + PC_K + kvh * 64 + hf * 32;
            const v4u w0 = *(const v4u*)kp, w1 = *(const v4u*)(kp + 8), w2 = *(const v4u*)(kp + 16), w3 = *(const v4u*)(kp + 24);
            const unsigned lo[8] = {w0.x, w0.y, w0.z, w0.w, w1.x, w1.y, w1.z, w1.w}, hi_[8] = {w2.x, w2.y, w2.z, w2.w, w3.x, w3.y, w3.z, w3.w};
            const float pos = (float)(hf ? (t & 63) : (t >> 6)); unsigned o1[8], o2[8];
#pragma unroll
            for (int jj = 0; jj < 8; ++jj) { float r1[2], r2[2];
#pragma unroll
                for (int e = 0; e < 2; ++e) { const int j = 2 * jj + e; const float inv = __builtin_amdgcn_exp2f(-(float)j * 0.8304820237218406f); const float sn = __sinf(pos * inv), cs = __cosf(pos * inv);
                    const float x1 = e ? bfhi(lo[jj]) : bflo(lo[jj]), x2 = e ? bfhi(hi_[jj]) : bflo(hi_[jj]); r1[e] = x1 * cs - x2 * sn; r2[e] = x2 * cs + x1 * sn; }
                o1[jj] = pk2(r1[0], r1[1]); o2[jj] = pk2(r2[0], r2[1]); }
            *(v4u*)kp = (v4u){o1[0], o1[1], o1[2], o1[3]}; *(v4u*)(kp + 8) = (v4u){o1[4], o1[5], o1[6], o1[7]}; *(v4u*)(kp + 16) = (v4u){o2[0], o2[1], o2[2], o2[3]}; *(v4u*)(kp + 24) = (v4u){o2[4], o2[5], o2[6], o2[7]}; }
        __syncthreads();
        for (int i = F.tid; i < 256 * 8; i += NTHREADS) { const int col = i >> 3, c = i & 7, kvh = col >> 6, d = col & 63;
            v4u o; const LAS unsigned short* s = vt + col * 66 + c * 8;
            o.x = s[0] | ((unsigned)s[1] << 16); o.y = s[2] | ((unsigned)s[3] << 16); o.z = s[4] | ((unsigned)s[5] << 16); o.w = s[6] | ((unsigned)s[7] << 16);
            if (lat) { const int b = m0 >> 12, t0 = m0 & 4095; *(v4u*)((bf16*)(F.ws + WS_VT) + ((size_t)(b * 4 + kvh) * 64 + d) * SEQ + t0 + c * 8) = o; }
            else { const int mm = m0 - NLAT, b = mm >> 8, t0 = mm & 255; *(v4u*)((bf16*)(F.ws + WS_VTC) + ((size_t)(b * 4 + kvh) * 64 + d) * CTXL + t0 + c * 8) = o; } }
    }
    __syncthreads();
}

constexpr int AT_KP = 144, AT_VP = 136;
constexpr int AT_KOFF = 0, AT_VOFF = 64 * AT_KP, AT_TILE = 64 * AT_KP + 64 * AT_VP;
__device__ __forceinline__ void attn_unit(Frame& F, int l, int b, int kvh, int qi, int is_ctx) {
    const bf16* P = (const bf16*)(F.ws + WS_P); bf16* CC = (bf16*)(F.ws + WS_CC);
    int lane_o = F.lane; asm volatile("" : "+v"(lane_o));
    const int g = F.wave >> 1, qh = F.wave & 1, hq = kvh * 4 + g, r32 = lane_o & 31, hi = lane_o >> 5;
    const int rowbase = is_ctx ? NLAT + b * CTXL : b * SEQ;
    const int qa = qi * 128 + qh * 64;
    const float LOG2E = 1.4426950408889634f;
    bf16x8 qf[2][4];
#pragma unroll
    for (int qt = 0; qt < 2; ++qt) { const int tq = qa + 32 * qt + r32; const bf16* qp = P + (size_t)(rowbase + tq) * PW + PC_Q + hq * 64 + 8 * hi;
        float x[4][8];
#pragma unroll
        for (int s = 0; s < 4; ++s) { const v4u w = *(const v4u*)(qp + 16 * s); x[s][0] = bflo(w.x); x[s][1] = bfhi(w.x); x[s][2] = bflo(w.y); x[s][3] = bfhi(w.y); x[s][4] = bflo(w.z); x[s][5] = bfhi(w.z); x[s][6] = bflo(w.w); x[s][7] = bfhi(w.w); }
        if (!is_ctx) {
#pragma unroll
            for (int hf = 0; hf < 2; ++hf) { const float pos = (float)(hf ? (tq & 63) : (tq >> 6));
#pragma unroll
                for (int j = 0; j < 8; ++j) { const float inv = __builtin_amdgcn_exp2f(-(float)(8 * hi + j) * 0.8304820237218406f); const float sn = __sinf(pos * inv), cs = __cosf(pos * inv);
                    const float x1 = x[2 * hf][j], x2 = x[2 * hf + 1][j]; x[2 * hf][j] = x1 * cs - x2 * sn; x[2 * hf + 1][j] = x2 * cs + x1 * sn; } } }
        const float sc = 0.125f * LOG2E;
#pragma unroll
        for (int s = 0; s < 4; ++s) { v4u w; w.x = pk2(x[s][0] * sc, x[s][1] * sc); w.y = pk2(x[s][2] * sc, x[s][3] * sc); w.z = pk2(x[s][4] * sc, x[s][5] * sc); w.w = pk2(x[s][6] * sc, x[s][7] * sc); qf[qt][s] = __builtin_bit_cast(bf16x8, w); }
    }
    float mrun[2], lrun[2]; f32x16 O[2][2];
    { const float sk = F.in[I_SINK][l * 16 + hq] * LOG2E;
#pragma unroll
      for (int qt = 0; qt < 2; ++qt) { mrun[qt] = sk; lrun[qt] = hi ? 0.f : 1.f;
#pragma unroll
        for (int db = 0; db < 2; ++db)
#pragma unroll
            for (int r = 0; r < 16; ++r) O[qt][db][r] = 0.f; } }
    const int kt_lo = is_ctx ? 0 : (qi == 0 ? 2 : 0), nl = is_ctx ? 0 : (6 - (qi == 0 ? 2 : 0) - (qi == 31 ? 2 : 0)), ntile = nl + 4;
    const int rr = F.tid >> 3, cch = F.tid & 7;
    const bf16* kbase_l = P + (size_t)(b * SEQ + rr) * PW + PC_K + kvh * 64 + cch * 8; const bf16* kbase_c = P + (size_t)(NLAT + b * CTXL + rr) * PW + PC_K + kvh * 64 + cch * 8;
    const bf16* vbase_l = (const bf16*)(F.ws + WS_VT) + ((size_t)(b * 4 + kvh) * 64 + rr) * SEQ + cch * 8; const bf16* vbase_c = (const bf16*)(F.ws + WS_VTC) + ((size_t)(b * 4 + kvh) * 64 + rr) * CTXL + cch * 8;
    v4u kw, vw;
    { const bool loc0 = nl > 0; const int k00 = loc0 ? 128 * (qi - 1) + 64 * kt_lo : 0; kw = *(const v4u*)((loc0 ? kbase_l : kbase_c) + (size_t)k00 * PW); vw = *(const v4u*)((loc0 ? vbase_l : vbase_c) + k00); }
    LDS_BARRIER();
#pragma unroll 1
    for (int jt = 0; jt < ntile; ++jt) {
        const bool local = jt < nl; const int k0 = local ? 128 * (qi - 1) + 64 * (kt_lo + jt) : 64 * (jt - nl);
        const LAS unsigned char* KS = F.lds + (jt & 1) * AT_TILE + AT_KOFF; const LAS unsigned char* VS = F.lds + (jt & 1) * AT_TILE + AT_VOFF;
        { *(LAS v4u*)(F.lds + (jt & 1) * AT_TILE + AT_KOFF + rr * AT_KP + cch * 16) = kw;
          LAS v2u* vd = (LAS v2u*)(F.lds + (jt & 1) * AT_TILE + AT_VOFF + rr * AT_VP + cch * 16); vd[0] = (v2u){vw.x, vw.y}; vd[1] = (v2u){vw.z, vw.w}; }
        if (jt + 1 < ntile) { const bool ln = jt + 1 < nl; const int kn = ln ? 128 * (qi - 1) + 64 * (kt_lo + jt + 1) : 64 * (jt + 1 - nl);
            kw = *(const v4u*)((ln ? kbase_l : kbase_c) + (size_t)kn * PW); vw = *(const v4u*)((ln ? vbase_l : vbase_c) + kn); }
        LDS_BARRIER();
        if (local && (k0 + 63 < qa - 128 || k0 > qa + 63 + 128)) continue;
#pragma unroll 1
        for (int kb = 0; kb < 2; ++kb) {
            bf16x8 kf[4];
#pragma unroll
            for (int ss = 0; ss < 4; ++ss) kf[ss] = *(const LAS bf16x8*)(KS + (32 * kb + r32) * AT_KP + (16 * ss + 8 * hi) * 2);
            bf16x8 pb[2][2];
#pragma unroll
            for (int qt = 0; qt < 2; ++qt) { const int tq = qa + 32 * qt + r32;
                f32x16 s;
#pragma unroll
                for (int r = 0; r < 16; ++r) s[r] = 0.f;
#pragma unroll
                for (int ss = 0; ss < 4; ++ss) s = __builtin_amdgcn_mfma_f32_32x32x16_bf16(kf[ss], qf[qt][ss], s, 0, 0, 0);
                if (local) {
#pragma unroll
                    for (int r = 0; r < 16; ++r) { const int kidx = k0 + 32 * kb + (r & 3) + 8 * (r >> 2) + 4 * hi; const int dlt = kidx - tq; if (dlt > 128 || dlt < -128) s[r] = -1.0e30f; } }
                float mloc = s[0];
#pragma unroll
                for (int r = 1; r < 16; ++r) mloc = fmaxf(mloc, s[r]);
                mloc = fmaxf(mloc, __shfl_xor(mloc, 32));
                const float mnew = fmaxf(mrun[qt], mloc), alpha = __builtin_amdgcn_exp2f(mrun[qt] - mnew); mrun[qt] = mnew;
                float psum = 0.f;
#pragma unroll
                for (int r = 0; r < 16; ++r) { s[r] = __builtin_amdgcn_exp2f(s[r] - mnew); psum += s[r]; }
                lrun[qt] = lrun[qt] * alpha + psum;
#pragma unroll
                for (int db = 0; db < 2; ++db)
#pragma unroll
                    for (int r = 0; r < 16; ++r) O[qt][db][r] *= alpha;
#pragma unroll
                for (int s2 = 0; s2 < 2; ++s2) { v4u pw; pw.x = pk2(s[8 * s2 + 0], s[8 * s2 + 1]); pw.y = pk2(s[8 * s2 + 2], s[8 * s2 + 3]); pw.z = pk2(s[8 * s2 + 4], s[8 * s2 + 5]); pw.w = pk2(s[8 * s2 + 6], s[8 * s2 + 7]);
                    pb[qt][s2] = __builtin_bit_cast(bf16x8, pw); }
            }
#pragma unroll
            for (int s2 = 0; s2 < 2; ++s2)
#pragma unroll
                for (int db = 0; db < 2; ++db) { const LAS v2u* vp = (const LAS v2u*)(VS + (32 * db + r32) * AT_VP + (32 * kb + 16 * s2 + 4 * hi) * 2);
                    const v2u a0 = vp[0], a1 = vp[2]; v4u aw; aw.x = a0.x; aw.y = a0.y; aw.z = a1.x; aw.w = a1.y; const bf16x8 va = __builtin_bit_cast(bf16x8, aw);
                    O[0][db] = __builtin_amdgcn_mfma_f32_32x32x16_bf16(va, pb[0][s2], O[0][db], 0, 0, 0);
                    O[1][db] = __builtin_amdgcn_mfma_f32_32x32x16_bf16(va, pb[1][s2], O[1][db], 0, 0, 0); }
        }
    }
    int r32e = r32, hie = hi; asm volatile("" : "+v"(r32e), "+v"(hie));
#pragma unroll
    for (int qt = 0; qt < 2; ++qt) { const float lt = lrun[qt] + __shfl_xor(lrun[qt], 32); const float rl = 1.0f / lt; const int tq = qa + 32 * qt + r32e;
#if FP8_OUTPROJ
        unsigned char* op8 = (unsigned char*)CC + (size_t)(rowbase + tq) * DM + hq * 64 + 4 * hie;
#pragma unroll
        for (int db = 0; db < 2; ++db)
#pragma unroll
            for (int rq = 0; rq < 4; ++rq) *(unsigned*)(op8 + 32 * db + 8 * rq) = pk4_fp8(O[qt][db][4 * rq] * rl, O[qt][db][4 * rq + 1] * rl, O[qt][db][4 * rq + 2] * rl, O[qt][db][4 * rq + 3] * rl); }
#else
        bf16* op = CC + (size_t)(rowbase + tq) * DM + hq * 64 + 4 * hie;
#pragma unroll
        for (int db = 0; db < 2; ++db)
#pragma unroll
            for (int rq = 0; rq < 4; ++rq) { v2u w; w.x = pk2(O[qt][db][4 * rq] * rl, O[qt][db][4 * rq + 1] * rl); w.y = pk2(O[qt][db][4 * rq + 2] * rl, O[qt][db][4 * rq + 3] * rl);
                *(v2u*)(op + 32 * db + 8 * rq) = w; } }
#endif
}
__device__ __forceinline__ void attn_phase(Frame& F, int l, int rep = 0) {
    const int nunits = 512 + (l == 0 ? 32 : 0);
    LAS int* slot = (LAS int*)(F.lds + LDS_X_OFF + 512);
    for (;;) {
        __syncthreads();
        if (F.tid == 0) *slot = (int)__hip_atomic_fetch_add(F.ctl + CW_ATQ + 64 * l + 8 * rep, 1u, RLX_AGENT);
        __syncthreads();
        const int u = __builtin_amdgcn_readfirstlane(*slot);
        if (u >= nunits) break;
        if (u < 512) attn_unit(F, l, u >> 7, (u >> 5) & 3, u & 31, 0); else { const int v = u - 512; attn_unit(F, l, v >> 3, (v >> 1) & 3, v & 1, 1); }
    }
}
#define USE_CHUNK_DN 1
#ifndef DN_SPLIT
#define DN_SPLIT 2
#endif
#ifndef DN_REP_S1
#define DN_REP_S1 1
#endif
#ifndef DN_REP_S3B
#define DN_REP_S3B 1
#endif
#ifndef DN_REP_S3A
#define DN_REP_S3A 1
#endif
#ifndef DN_REP_S4
#define DN_REP_S4 1
#endif

constexpr int DN_F_NEGW = 0, DN_F_QG = 16, DN_F_QK = 32, DN_F_KGT = 40, DN_NFRAG = 56, DN_U_OFF = 57344;
constexpr int DP_QS = 0, DP_KS = 17408, DP_VS = 34816, DP_AS = 52224  , DP_TB = 69632, DP_TW = 78848, DP_QK = 88064, DP_RAW = 52224  , DP_SC = 104960, DP_TF = 106496  , DP_XS = 123904  ;
constexpr int DP_P = 272, DP_P2 = 144;
__device__ __forceinline__ int dn_rec(int b, int h, int dir, int np) { return ((b * 4 + h) * 2 + dir) * 68 + np; }
__device__ __forceinline__ void dn_chunk_of(int ct, int dir, int& b, int& np) { if (ct < 256) { b = ct >> 6; const int c = ct & 63; np = 4 + (dir ? 63 - c : c); } else { b = (ct - 256) >> 2; const int c = (ct - 256) & 3; np = dir ? 3 - c : c; } }
__device__ __forceinline__ unsigned short lds_u16(const LAS unsigned char* p) { return *(const LAS unsigned short*)p; }

__device__ __forceinline__ void dn_prep_unit(Frame& F, int l, int ct, int h, int dir) {
    const bf16* P = (const bf16*)(F.ws + WS_P);
    int lane = F.lane; asm volatile("" : "+v"(lane));
    const int wave = F.wave, i16 = lane & 15, q = lane >> 4;
    const int m0 = ct * 64; int t0, T, base; seq_of(m0, t0, T, base);
    int b, np; dn_chunk_of(ct, dir, b, np);
    unsigned char* tile = F.ws + WS_DNT + (size_t)dn_rec(b, h, dir, np) * DNT_BYTES;
    LAS unsigned char* L = F.lds;
    LAS float* SC = (LAS float*)(L + DP_SC);
    LDS_BARRIER();
    {
        const float* cw = F.in[I_DNCW] + (size_t)l * 4 * 1536;
        LAS float* cwl = (LAS float*)(L + DP_TF);
        for (int i = F.tid; i < 3 * 4 * 128; i += NTHREADS) { const int part = i >> 9, j = (i >> 7) & 3, ch = i & 127; cwl[i] = cw[j * 1536 + part * 512 + h * 128 + ch]; }
        unsigned short pbw = 0, paw = 0;
        if (wave == 0) { const int tok = dir ? 63 - lane : lane; pbw = P[(size_t)(m0 + tok) * PW + PC_BETA + dir * 4 + h]; paw = P[(size_t)(m0 + tok) * PW + PC_DEC + dir * 4 + h]; }
        for (int c = F.tid; c < 67 * 48; c += NTHREADS) { const int row = c / 48, ch = c % 48, part = ch >> 4, cc = ch & 15, tt = t0 + row - 2;
            v4u v = (v4u){0u, 0u, 0u, 0u};
            if (tt >= 0 && tt < T) v = *(const v4u*)(P + (size_t)(base + tt) * PW + PC_DQ + part * 512 + h * 128 + cc * 8);
            *(LAS v4u*)(L + DP_RAW + row * 784 + part * 256 + cc * 16) = v; }
        LDS_BARRIER();
#pragma unroll 1
        for (int rep = 0; rep < DN_REP_S1; ++rep)
#pragma unroll
        for (int part = 0; part < 3; ++part) { const int tok = F.tid >> 3, g8 = F.tid & 7;
            float sv[16];
#pragma unroll
            for (int k = 0; k < 16; ++k) sv[k] = 0.f;
#pragma unroll
            for (int j = 0; j < 4; ++j) { const LAS v4u* rp = (const LAS v4u*)(L + DP_RAW + (tok + j) * 784 + part * 256 + g8 * 32); const v4u r0 = rp[0], r1 = rp[1];
                const LAS f32x4* wp = (const LAS f32x4*)(cwl + (part * 4 + j) * 128 + g8 * 16); const f32x4 w0 = wp[0], w1 = wp[1], w2 = wp[2], w3 = wp[3];
                sv[0] += w0.x * bflo(r0.x); sv[1] += w0.y * bfhi(r0.x); sv[2] += w0.z * bflo(r0.y); sv[3] += w0.w * bfhi(r0.y); sv[4] += w1.x * bflo(r0.z); sv[5] += w1.y * bfhi(r0.z); sv[6] += w1.z * bflo(r0.w); sv[7] += w1.w * bfhi(r0.w);
                sv[8] += w2.x * bflo(r1.x); sv[9] += w2.y * bfhi(r1.x); sv[10] += w2.z * bflo(r1.y); sv[11] += w2.w * bfhi(r1.y); sv[12] += w3.x * bflo(r1.z); sv[13] += w3.y * bfhi(r1.z); sv[14] += w3.z * bflo(r1.w); sv[15] += w3.w * bfhi(r1.w); }
            float ss = 0.f;
#pragma unroll
            for (int k = 0; k < 16; ++k) { sv[k] = siluf_(sv[k]); ss += sv[k] * sv[k]; }
            if (part < 2) { ss += dpp_mov<0xB1>(ss); ss += dpp_mov<0x4E>(ss); ss += dpp_mov<0x141>(ss);
                const float f = (part == 0 ? 0.08838834764831845f : 1.0f) * __builtin_amdgcn_rsqf(ss + EPS);
#pragma unroll
                for (int k = 0; k < 16; ++k) sv[k] *= f; }
            LAS v4u* op = (LAS v4u*)(L + (part == 0 ? DP_QS : (part == 1 ? DP_KS : DP_VS)) + tok * DP_P + g8 * 32);
            op[0] = (v4u){pk2(sv[0], sv[1]), pk2(sv[2], sv[3]), pk2(sv[4], sv[5]), pk2(sv[6], sv[7])}; op[1] = (v4u){pk2(sv[8], sv[9]), pk2(sv[10], sv[11]), pk2(sv[12], sv[13]), pk2(sv[14], sv[15])}; }
        if (wave == 0) {
            const float pb = bf2f(pbw), pa = bf2f(paw);
            const float beta = sigmoidf_(pb); float gc = -__expf(F.in[I_DNALOG][l * 8 + dir * 4 + h]) * softplusf_(pa + F.in[I_DNDT][l * 8 + dir * 4 + h]);
#pragma unroll
            for (int o = 1; o < 64; o <<= 1) { const float v = __shfl_up(gc, o); if (lane >= o) gc += v; }
            const float glast = __shfl(gc, 63);
            SC[lane] = beta; SC[64 + lane] = gc; SC[128 + lane] = __expf(gc); SC[192 + lane] = __expf(glast - gc);
            if (lane == 63) ((float*)(F.ws + WS_DNS))[dn_rec(b, h, dir, np)] = __expf(glast);
        }
    }
    LDS_BARRIER();
#define DN_TOK(r) (dir ? 63 - (r) : (r))
#pragma unroll 1
    for (int rep = 0; rep < DN_REP_S3A; ++rep)
    {
        const int mb = wave & 3, which = wave >> 2;
        f32x4 acc[4];
#pragma unroll
        for (int nb = 0; nb < 4; ++nb) acc[nb] = (f32x4){0.f, 0.f, 0.f, 0.f};
        const LAS unsigned char* arow = L + (which ? DP_QS : DP_KS) + DN_TOK(16 * mb + i16) * DP_P + 16 * q;
#pragma unroll
        for (int ks = 0; ks < 4; ++ks) { const bf16x8 a = *(const LAS bf16x8*)(arow + 64 * ks);
#pragma unroll
            for (int nb = 0; nb < 4; ++nb) { const bf16x8 bb = *(const LAS bf16x8*)(L + DP_KS + DN_TOK(16 * nb + i16) * DP_P + 16 * q + 64 * ks);
                acc[nb] = __builtin_amdgcn_mfma_f32_16x16x32_bf16(a, bb, acc[nb], 0, 0, 0); } }
#pragma unroll
        for (int nb = 0; nb < 4; ++nb)
#pragma unroll
            for (int i = 0; i < 4; ++i) { const int r = 16 * mb + 4 * q + i, c = 16 * nb + i16; const float dec = __expf(SC[64 + r] - SC[64 + c]);
                if (which == 0) ((LAS float*)(L + DP_AS))[r * 68 + c] = (r > c) ? SC[r] * acc[nb][i] * dec : 0.f;
                else *(LAS unsigned short*)(L + DP_QK + r * DP_P2 + c * 2) = (unsigned short)f2bf((r >= c) ? acc[nb][i] * dec : 0.f); }
    }
    LDS_BARRIER();
#define DN_EMIT_FRAG(f_) do { const int fx_ = (f_); v4u o; \
        if (fx_ < DN_F_QG) { const int mb = fx_ >> 2, ks = fx_ & 3; const LAS unsigned char* rp = L + DP_AS + (16 * mb + i16) * DP_P + (32 * ks + 4 * q) * 2; \
            const v2u a = *(const LAS v2u*)rp, c = *(const LAS v2u*)(rp + 32); o.x = a.x; o.y = a.y; o.z = c.x; o.w = c.y; } \
        else if (fx_ < DN_F_QK) { const int ff = fx_ - DN_F_QG, mb = ff >> 2, ks = ff & 3, r = 16 * mb + i16; const LAS unsigned char* rp = L + DP_QS + DN_TOK(r) * DP_P + (32 * ks + 4 * q) * 2; const float eg = SC[128 + r]; \
            const v2u a = *(const LAS v2u*)rp, c = *(const LAS v2u*)(rp + 32); \
            o.x = pk2(bflo(a.x) * eg, bfhi(a.x) * eg); o.y = pk2(bflo(a.y) * eg, bfhi(a.y) * eg); o.z = pk2(bflo(c.x) * eg, bfhi(c.x) * eg); o.w = pk2(bflo(c.y) * eg, bfhi(c.y) * eg); } \
        else if (fx_ < DN_F_KGT) { const int ff = fx_ - DN_F_QK, mb = ff >> 1, ks = ff & 1; const LAS unsigned char* rp = L + DP_QK + (16 * mb + i16) * DP_P2 + (32 * ks + 4 * q) * 2; \
            const v2u a = *(const LAS v2u*)rp, c = *(const LAS v2u*)(rp + 32); o.x = a.x; o.y = a.y; o.z = c.x; o.w = c.y; } \
        else { const int ff = fx_ - DN_F_KGT, mb = ff >> 1, ks = ff & 1, dk = 16 * mb + i16; float e[8]; \
            _Pragma("unroll") for (int jj = 0; jj < 8; ++jj) { const int key = 32 * ks + 16 * (jj >> 2) + 4 * q + (jj & 3); e[jj] = bf2f(lds_u16(L + DP_KS + DN_TOK(key) * DP_P + dk * 2)) * SC[192 + key]; } \
            o.x = pk2(e[0], e[1]); o.y = pk2(e[2], e[3]); o.z = pk2(e[4], e[5]); o.w = pk2(e[6], e[7]); } \
        *(v4u*)(tile + (size_t)fx_ * 1024 + lane * 16) = o; } while (0)
#pragma unroll 1
    for (int rep = 0; rep < DN_REP_S3B; ++rep) {
    if (wave == 0) {
        const LAS float* As = (const LAS float*)(L + DP_AS); LAS float* Tf = (LAS float*)(L + DP_TF);
        const int g = lane >> 4, c = lane & 15;
        f32x4 ar[16][4];
#pragma unroll
        for (int r = 1; r < 16; ++r)
#pragma unroll
            for (int j4 = 0; j4 < (r + 3) / 4; ++j4) ar[r][j4] = *(const LAS f32x4*)(As + (16 * g + r) * 68 + 16 * g + 4 * j4);
        float t[16];
#pragma unroll
        for (int r = 0; r < 16; ++r) { float a0 = (c == r) ? 1.f : 0.f, a1 = 0.f;
#pragma unroll
            for (int j = 0; j < r; ++j) { const float av = ar[r][j >> 2][j & 3]; if (j & 1) a1 -= av * t[j]; else a0 -= av * t[j]; }
            t[r] = a0 + a1; Tf[(16 * g + r) * 68 + 16 * g + c] = t[r]; }
    } else if (rep == 0) {
#pragma unroll 1
        for (int fi = 0; fi < 3; ++fi) DN_EMIT_FRAG(16 + (wave - 1) * 3 + fi);
    }
    LDS_BARRIER();
    if (wave < 3) {
        const LAS float* As = (const LAS float*)(L + DP_AS); LAS float* Tf = (LAS float*)(L + DP_TF); LAS float* Xs = (LAS float*)(L + DP_XS) + wave * 272;
        const int J = wave;
#pragma unroll 1
        for (int I = J + 1; I < 4; ++I) {
            f32x4 acc = {0.f, 0.f, 0.f, 0.f};
#pragma unroll 1
            for (int K = J; K < I; ++K)
#pragma unroll
                for (int sk = 0; sk < 4; ++sk) acc = __builtin_amdgcn_mfma_f32_16x16x4f32(As[(16 * I + i16) * 68 + 16 * K + 4 * sk + q], Tf[(16 * K + 4 * sk + q) * 68 + 16 * J + i16], acc, 0, 0, 0);
#pragma unroll
            for (int i = 0; i < 4; ++i) Xs[(4 * q + i) * 17 + i16] = acc[i];
            LDS_WAIT(); asm volatile("" ::: "memory");
            f32x4 acc2 = {0.f, 0.f, 0.f, 0.f};
#pragma unroll
            for (int sk = 0; sk < 4; ++sk) acc2 = __builtin_amdgcn_mfma_f32_16x16x4f32(Tf[(16 * I + i16) * 68 + 16 * I + 4 * sk + q], Xs[(4 * sk + q) * 17 + i16], acc2, 0, 0, 0);
#pragma unroll
            for (int i = 0; i < 4; ++i) Tf[(16 * I + 4 * q + i) * 68 + 16 * J + i16] = -acc2[i];
            LDS_WAIT(); asm volatile("" ::: "memory");
        }
    } else if (rep == 0) {
#pragma unroll 1
        for (int fi = 0; fi < 4; ++fi) { const int f = 37 + (wave - 3) * 4 + fi; if (f < DN_NFRAG) DN_EMIT_FRAG(f); }
    }
    LDS_BARRIER();
    { const LAS float* Tf = (const LAS float*)(L + DP_TF); const int r = F.tid >> 3, c0 = (F.tid & 7) * 8; float vb[8], vw[8];
#pragma unroll
      for (int k = 0; k < 8; ++k) { const int c = c0 + k; const float v = ((r >> 4) >= (c >> 4)) ? Tf[r * 68 + c] : 0.f; const float bl = SC[c]; vb[k] = v * bl; vw[k] = vb[k] * SC[128 + c]; }
      v4u ob, ow; ob.x = pk2(vb[0], vb[1]); ob.y = pk2(vb[2], vb[3]); ob.z = pk2(vb[4], vb[5]); ob.w = pk2(vb[6], vb[7]); ow.x = pk2(vw[0], vw[1]); ow.y = pk2(vw[2], vw[3]); ow.z = pk2(vw[4], vw[5]); ow.w = pk2(vw[6], vw[7]);
      *(LAS v4u*)(L + DP_TB + r * DP_P2 + c0 * 2) = ob; *(LAS v4u*)(L + DP_TW + r * DP_P2 + c0 * 2) = ow; }
    }
    LDS_BARRIER();
    {
        const int nbp = wave & 3, which = wave >> 2;
        f32x4 acc[4][2];
#pragma unroll
        for (int mb = 0; mb < 4; ++mb) { acc[mb][0] = (f32x4){0.f, 0.f, 0.f, 0.f}; acc[mb][1] = (f32x4){0.f, 0.f, 0.f, 0.f}; }
#pragma unroll
        for (int ks = 0; ks < 2; ++ks) {
            bf16x8 bb[2];
#pragma unroll
            for (int nn = 0; nn < 2; ++nn) { const int n = 16 * (2 * nbp + nn) + i16; unsigned short e[8];
#pragma unroll
                for (int jj = 0; jj < 8; ++jj) e[jj] = lds_u16(L + (which ? DP_KS : DP_VS) + DN_TOK(32 * ks + 8 * q + jj) * DP_P + n * 2);
                v4u w; w.x = e[0] | ((unsigned)e[1] << 16); w.y = e[2] | ((unsigned)e[3] << 16); w.z = e[4] | ((unsigned)e[5] << 16); w.w = e[6] | ((unsigned)e[7] << 16); bb[nn] = __builtin_bit_cast(bf16x8, w); }
#pragma unroll
            for (int mb = 0; mb < 4; ++mb) { const bf16x8 a = *(const LAS bf16x8*)(L + (which ? DP_TW : DP_TB) + (16 * mb + i16) * DP_P2 + 64 * ks + 16 * q);
                acc[mb][0] = __builtin_amdgcn_mfma_f32_16x16x32_bf16(a, bb[0], acc[mb][0], 0, 0, 0); acc[mb][1] = __builtin_amdgcn_mfma_f32_16x16x32_bf16(a, bb[1], acc[mb][1], 0, 0, 0); } }
        if (which == 0) {
#pragma unroll
            for (int mb = 0; mb < 4; ++mb)
#pragma unroll
                for (int nn = 0; nn < 2; ++nn) *(f32x4*)(tile + DN_U_OFF + (size_t)((((2 * nbp + nn) * 4 + mb) * 64 + lane) * 16)) = acc[mb][nn];
        } else {
#pragma unroll
            for (int mb = 0; mb < 4; ++mb)
#pragma unroll
                for (int nn = 0; nn < 2; ++nn)
#pragma unroll
                    for (int i = 0; i < 4; ++i) *(LAS unsigned short*)(L + DP_AS + (16 * mb + 4 * q + i) * DP_P + (16 * (2 * nbp + nn) + i16) * 2) = (unsigned short)f2bf(-acc[mb][nn][i]);
        }
    }
    LDS_BARRIER();
#pragma unroll 1
    for (int fi = 0; fi < 2; ++fi) { const int f = wave * 2 + fi; DN_EMIT_FRAG(f); }
#undef DN_EMIT_FRAG
#undef DN_TOK
}
__device__ __forceinline__ void dn_prep(Frame& F, int l) {
    for (int u = F.bid; u < NCT * 4 * 2; u += F.G) dn_prep_unit(F, l, u >> 3, (u >> 1) & 3, u & 1);
    __syncthreads();
}

__device__ __forceinline__ void dn_scan(Frame& F, int l, int b, int h, int dir, int half) {
    int lane = F.lane; asm volatile("" : "+v"(lane));
    const int w = (DN_SPLIT == 2) ? half * 4 + (F.wave & 3) : F.wave, i16 = lane & 15, q = lane >> 4; const bool active = (DN_SPLIT == 2) ? (F.wave < 4) : true;
    const unsigned char* tiles = F.ws + WS_DNT + (size_t)dn_rec(b, h, dir, 0) * DNT_BYTES;
    const float* egl = (const float*)(F.ws + WS_DNS) + dn_rec(b, h, dir, 0);
    bf16* Ob = (bf16*)(F.ws + WS_DNO);
    LAS unsigned char* L = F.lds;
    f32x4 S[8];
#pragma unroll
    for (int i = 0; i < 8; ++i) S[i] = (f32x4){0.f, 0.f, 0.f, 0.f};
    v4u st[7]; f32x4 un[4];
#pragma unroll
    for (int mb = 0; mb < 4; ++mb) un[mb] = *(const f32x4*)(tiles + DN_U_OFF + (size_t)(((w * 4 + mb) * 64 + lane) * 16));
    LDS_BARRIER();
#pragma unroll
    for (int i = 0; i < 7; ++i) st[i] = *(const v4u*)(tiles + (size_t)(F.tid + i * NTHREADS) * 16);
#pragma unroll
    for (int i = 0; i < 7; ++i) *(LAS v4u*)(L + (F.tid + i * NTHREADS) * 16) = st[i];
#pragma unroll
    for (int i = 0; i < 7; ++i) st[i] = *(const v4u*)(tiles + DNT_BYTES + (size_t)(F.tid + i * NTHREADS) * 16);
    LDS_BARRIER();
#pragma unroll 1
    for (int n = 0; n < 68; ++n) {
        const unsigned char* tile = tiles + (size_t)n * DNT_BYTES; const LAS unsigned char* cur = L + (n & 1) * 57344;
        if (n + 1 < 68) {
#pragma unroll
            for (int i = 0; i < 7; ++i) *(LAS v4u*)(L + ((n + 1) & 1) * 57344 + (F.tid + i * NTHREADS) * 16) = st[i]; }
        if (n + 2 < 68) {
#pragma unroll
            for (int i = 0; i < 7; ++i) st[i] = *(const v4u*)(tile + 2 * DNT_BYTES + (size_t)(F.tid + i * NTHREADS) * 16); }
        if (active) {
        f32x4 vn[4];
#pragma unroll
        for (int mb = 0; mb < 4; ++mb) vn[mb] = un[mb];
        if (n + 1 < 68) {
#pragma unroll
            for (int mb = 0; mb < 4; ++mb) un[mb] = *(const f32x4*)(tile + DNT_BYTES + DN_U_OFF + (size_t)(((w * 4 + mb) * 64 + lane) * 16)); }
        const float el = egl[n];
        bf16x8 bS[4];
#pragma unroll
        for (int ks = 0; ks < 4; ++ks) { v4u x; x.x = pk2(S[2 * ks][0], S[2 * ks][1]); x.y = pk2(S[2 * ks][2], S[2 * ks][3]); x.z = pk2(S[2 * ks + 1][0], S[2 * ks + 1][1]); x.w = pk2(S[2 * ks + 1][2], S[2 * ks + 1][3]); bS[ks] = __builtin_bit_cast(bf16x8, x); }
        f32x4 o[4];
#pragma unroll
        for (int mb = 0; mb < 4; ++mb) { o[mb] = (f32x4){0.f, 0.f, 0.f, 0.f};
#pragma unroll
            for (int ks = 0; ks < 4; ++ks) { const bf16x8 aw = *(const LAS bf16x8*)(cur + (DN_F_NEGW + mb * 4 + ks) * 1024 + lane * 16), aq = *(const LAS bf16x8*)(cur + (DN_F_QG + mb * 4 + ks) * 1024 + lane * 16);
                vn[mb] = __builtin_amdgcn_mfma_f32_16x16x32_bf16(aw, bS[ks], vn[mb], 0, 0, 0); o[mb] = __builtin_amdgcn_mfma_f32_16x16x32_bf16(aq, bS[ks], o[mb], 0, 0, 0); } }
        bf16x8 bV[2];
#pragma unroll
        for (int ks = 0; ks < 2; ++ks) { v4u x; x.x = pk2(vn[2 * ks][0], vn[2 * ks][1]); x.y = pk2(vn[2 * ks][2], vn[2 * ks][3]); x.z = pk2(vn[2 * ks + 1][0], vn[2 * ks + 1][1]); x.w = pk2(vn[2 * ks + 1][2], vn[2 * ks + 1][3]); bV[ks] = __builtin_bit_cast(bf16x8, x); }
#pragma unroll
        for (int mb = 0; mb < 8; ++mb) { S[mb] = S[mb] * el;
#pragma unroll
            for (int ks = 0; ks < 2; ++ks) { const bf16x8 ak = *(const LAS bf16x8*)(cur + (DN_F_KGT + mb * 2 + ks) * 1024 + lane * 16); S[mb] = __builtin_amdgcn_mfma_f32_16x16x32_bf16(ak, bV[ks], S[mb], 0, 0, 0); } }
#pragma unroll
        for (int mb = 0; mb < 4; ++mb)
#pragma unroll
            for (int ks = 0; ks < 2; ++ks) { const bf16x8 aqk = *(const LAS bf16x8*)(cur + (DN_F_QK + mb * 2 + ks) * 1024 + lane * 16); o[mb] = __builtin_amdgcn_mfma_f32_16x16x32_bf16(aqk, bV[ks], o[mb], 0, 0, 0); }
        { int m0; if (n < 4) m0 = NLAT + b * CTXL + 64 * (dir ? 3 - n : n); else m0 = b * SEQ + 64 * (dir ? 63 - (n - 4) : (n - 4));
#pragma unroll
          for (int mb = 0; mb < 4; ++mb)
#pragma unroll
            for (int i = 0; i < 4; ++i) { const int r = 16 * mb + 4 * q + i, tok = dir ? 63 - r : r; Ob[((size_t)dir * NTOK + m0 + tok) * 512 + h * 128 + 16 * w + i16] = (bf16)f2bf(o[mb][i]); } }
        }
        LDS_BARRIER();
    }
}
#define USE_CHUNK_LRU 1

constexpr int LR_XF = 0  , LR_XB = 16640  , LR_WT = 25856  , LR_AA = 62720  , LR_UU = 96000  , LR_END = 129280;
constexpr size_t WS_LCA = WS_LRC, WS_LCH = WS_LRC + 2 * MiB, WS_LCI = WS_LRC + 4 * MiB;
__device__ __forceinline__ void lru_prep(Frame& F, int l) {
    const bf16* P = (const bf16*)(F.ws + WS_P);
    int lane = F.lane; asm volatile("" : "+v"(lane));
    const int wave = F.wave, i16 = lane & 15, q = lane >> 4, nb = F.bid & 7;
    LAS unsigned char* L = F.lds;
    LAS float* XF = (LAS float*)(L + LR_XF); LAS float* AA = (LAS float*)(L + LR_AA); LAS float* UU = (LAS float*)(L + LR_UU);
    bf16* HL = (bf16*)(F.ws + WS_LRH); bf16* AC = (bf16*)(F.ws + WS_LRA);
    __syncthreads();
    for (int e = F.tid; e < 4 * 4096; e += NTHREADS) { const int mat = e >> 12, ii = (e >> 6) & 63, j = e & 63, dir = mat >> 1;
        const float w = (mat & 1 ? F.in[I_LRWI] : F.in[I_LRWR])[((size_t)((l * 2 + dir) * 8 + nb)) * 4096 + ii * 64 + j];
        *(LAS unsigned short*)(L + LR_WT + (mat * 64 + j) * 144 + ii * 2) = (unsigned short)f2bf(w); }
    float cwv[4][8], cbv[8];
    { const int c8 = (F.tid & 7) * 8, ch0 = nb * 64 + c8; const float* cb = F.in[I_LRCB] + l * 512 + ch0; const float* cw = F.in[I_LRCW] + (size_t)l * 4 * 512 + ch0;
#pragma unroll
      for (int k = 0; k < 8; ++k) cbv[k] = cb[k];
#pragma unroll
      for (int j = 0; j < 4; ++j)
#pragma unroll
        for (int k = 0; k < 8; ++k) cwv[j][k] = cw[j * 512 + k]; }
    float gbr[4], gbi[4], gls[4];
    { const int dir = wave >> 2;
#pragma unroll
      for (int n = 0; n < 4; ++n) { const int ch = nb * 64 + 16 * n + i16; gbr[n] = F.in[I_LRBR][(l * 2 + dir) * 512 + ch]; gbi[n] = F.in[I_LRBI][(l * 2 + dir) * 512 + ch]; gls[n] = -softplusf_(-F.in[I_LRLAM][(l * 2 + dir) * 512 + ch]); } }
    v4u wvA[4], wvB[4];
#define LR_LOADRAW(ctx) do { if (F.tid >= 128) { const int _m0 = (ctx) * 64; int _t0, _T, _base; seq_of(_m0, _t0, _T, _base); const int _ch0 = nb * 64 + (F.tid & 7) * 8, _tokA = (F.tid - 128) >> 3, _tokB = (F.tid + 256) >> 3; \
        _Pragma("unroll") for (int j = 0; j < 4; ++j) { const int tt = _t0 + _tokA + j - 2; wvA[j] = (v4u){0u, 0u, 0u, 0u}; if (tt >= 0 && tt < _T) wvA[j] = *(const v4u*)(P + (size_t)(_base + tt) * PW + PC_LX + _ch0); } \
        if (F.tid < 256) { _Pragma("unroll") for (int j = 0; j < 4; ++j) { const int tt = _t0 + _tokB + j - 2; wvB[j] = (v4u){0u, 0u, 0u, 0u}; if (tt >= 0 && tt < _T) wvB[j] = *(const v4u*)(P + (size_t)(_base + tt) * PW + PC_LX + _ch0); } } } } while (0)
#define LR_S1ITEM(wv_, tok_) do { const int tok = (tok_), c8 = (F.tid & 7) * 8; float s[8]; \
        _Pragma("unroll") for (int k = 0; k < 8; ++k) s[k] = cbv[k]; \
        _Pragma("unroll") for (int j = 0; j < 4; ++j) { const v4u w = wv_[j]; \
            s[0] += cwv[j][0] * bflo(w.x); s[1] += cwv[j][1] * bfhi(w.x); s[2] += cwv[j][2] * bflo(w.y); s[3] += cwv[j][3] * bfhi(w.y); s[4] += cwv[j][4] * bflo(w.z); s[5] += cwv[j][5] * bfhi(w.z); s[6] += cwv[j][6] * bflo(w.w); s[7] += cwv[j][7] * bfhi(w.w); } \
        _Pragma("unroll") for (int k = 0; k < 8; ++k) XF[tok * 65 + c8 + k] = s[k]; \
        v4u o; o.x = pk2(s[0], s[1]); o.y = pk2(s[2], s[3]); o.z = pk2(s[4], s[5]); o.w = pk2(s[6], s[7]); *(LAS v4u*)(L + LR_XB + tok * 144 + c8 * 2) = o; } while (0)
#define LR_S1() do { if (F.tid >= 128) { LR_S1ITEM(wvA, (F.tid - 128) >> 3); if (F.tid < 256) LR_S1ITEM(wvB, (F.tid + 256) >> 3); } } while (0)
    if ((F.bid >> 3) < NCT) { LR_LOADRAW(F.bid >> 3); LR_S1(); }
    for (int ct = F.bid >> 3; ct < NCT; ct += F.G >> 3) {
        const int m0 = ct * 64; const bool has_next = ct + (F.G >> 3) < NCT;
        if (has_next) LR_LOADRAW(ct + (F.G >> 3));
        LDS_BARRIER();
        { const int dir = wave >> 2, mb = wave & 3;
          f32x4 ar[4], ai[4];
#pragma unroll
          for (int n = 0; n < 4; ++n) { ar[n] = (f32x4){0.f, 0.f, 0.f, 0.f}; ai[n] = (f32x4){0.f, 0.f, 0.f, 0.f}; }
#pragma unroll
          for (int ks = 0; ks < 2; ++ks) { const bf16x8 a = *(const LAS bf16x8*)(L + LR_XB + (16 * mb + i16) * 144 + 64 * ks + 16 * q);
#pragma unroll
              for (int n = 0; n < 4; ++n) { const bf16x8 br = *(const LAS bf16x8*)(L + LR_WT + ((dir * 2 + 0) * 64 + 16 * n + i16) * 144 + 64 * ks + 16 * q), bi = *(const LAS bf16x8*)(L + LR_WT + ((dir * 2 + 1) * 64 + 16 * n + i16) * 144 + 64 * ks + 16 * q);
                  ar[n] = __builtin_amdgcn_mfma_f32_16x16x32_bf16(a, br, ar[n], 0, 0, 0); ai[n] = __builtin_amdgcn_mfma_f32_16x16x32_bf16(a, bi, ai[n], 0, 0, 0); } }
#pragma unroll
          for (int n = 0; n < 4; ++n) { const int j = 16 * n + i16; const float br_ = gbr[n], bi_ = gbi[n], logsig = gls[n];
#pragma unroll
              for (int i = 0; i < 4; ++i) { const int tok = 16 * mb + 4 * q + i; const float r = sigmoidf_(ar[n][i] + br_), ig = sigmoidf_(ai[n][i] + bi_);
                  const float log_a = 8.0f * r * logsig, a = __expf(log_a), y2 = 2.0f * log_a;
                  const float om = (y2 > -0.1f) ? -y2 * (1.0f + y2 * (0.5f + y2 * (0.16666667f + y2 * 0.041666668f))) : 1.0f - __expf(y2);
                  const float u = __builtin_amdgcn_sqrtf(om) * (ig * XF[tok * 65 + j]);
                  AA[(dir * 64 + tok) * 65 + j] = a; UU[(dir * 64 + tok) * 65 + j] = u; } } }
        LDS_BARRIER();
        if (F.tid < 128) { const int dir = F.tid >> 6, j = F.tid & 63, ch = nb * 64 + j; float h = 0.f, ac = 1.f;
            long o = (long)(((size_t)dir * NTOK + m0 + (dir ? 63 : 0)) * 512 + ch); const long ostep = dir ? -512 : 512;
#pragma unroll 1
            for (int s0 = 0; s0 < 64; s0 += 8) { float av[8], uv[8];
#pragma unroll
                for (int k = 0; k < 8; ++k) { const int tok = dir ? 63 - (s0 + k) : (s0 + k); av[k] = AA[(dir * 64 + tok) * 65 + j]; uv[k] = UU[(dir * 64 + tok) * 65 + j]; }
#pragma unroll
                for (int k = 0; k < 8; ++k) { h = av[k] * h + uv[k]; ac *= av[k]; HL[o] = (bf16)f2bf(h); AC[o] = (bf16)f2bf(ac); o += ostep; } }
            ((float*)(F.ws + WS_LCA))[((size_t)dir * NCT + ct) * 512 + ch] = ac; ((float*)(F.ws + WS_LCH))[((size_t)dir * NCT + ct) * 512 + ch] = h; }
        else if (has_next) LR_S1();
    }
    LDS_BARRIER();
}
__device__ __forceinline__ void lru_carry(Frame& F, int idx) {
    const int ch = idx & 511, dir = (idx >> 9) & 1, b = idx >> 10;
    const float* CA = (const float*)(F.ws + WS_LCA); const float* CH = (const float*)(F.ws + WS_LCH); float* CI = (float*)(F.ws + WS_LCI);
    float h = 0.f;
#pragma unroll 4
    for (int n = 0; n < 68; ++n) { const int ct = n < 4 ? 256 + b * 4 + (dir ? 3 - n : n) : b * 64 + (dir ? 63 - (n - 4) : (n - 4)); const size_t o = ((size_t)dir * NCT + ct) * 512 + ch;
        CI[o] = h; h = CA[o] * h + CH[o]; }
}
__device__ __forceinline__ void lru_fin(Frame& F, int l) {
    const int nrows = (l == 0) ? NTOK : NLAT;
    const bf16* P = (const bf16*)(F.ws + WS_P); bf16* CC = (bf16*)(F.ws + WS_CC);
    const bf16* HL = (const bf16*)(F.ws + WS_LRH); const bf16* AC = (const bf16*)(F.ws + WS_LRA); const float* CI = (const float*)(F.ws + WS_LCI);
    for (size_t i = (size_t)F.bid * NTHREADS + F.tid; i < (size_t)nrows * 128; i += (size_t)F.G * NTHREADS) { const int m = (int)(i >> 7), c4 = (int)(i & 127) * 4, ct = m >> 6;
        const v2u hw0 = *(const v2u*)(HL + (size_t)m * 512 + c4), aw0 = *(const v2u*)(AC + (size_t)m * 512 + c4), hw1 = *(const v2u*)(HL + ((size_t)NTOK + m) * 512 + c4), aw1 = *(const v2u*)(AC + ((size_t)NTOK + m) * 512 + c4);
        const f32x4 h0 = {bflo(hw0.x), bfhi(hw0.x), bflo(hw0.y), bfhi(hw0.y)}, a0 = {bflo(aw0.x), bfhi(aw0.x), bflo(aw0.y), bfhi(aw0.y)}, h1 = {bflo(hw1.x), bfhi(hw1.x), bflo(hw1.y), bfhi(hw1.y)}, a1 = {bflo(aw1.x), bfhi(aw1.x), bflo(aw1.y), bfhi(aw1.y)};
        const f32x4 i0 = *(const f32x4*)(CI + (size_t)ct * 512 + c4), i1 = *(const f32x4*)(CI + ((size_t)NCT + ct) * 512 + c4);
        const f32x4 hs = (a0 * i0 + h0) + (a1 * i1 + h1); const v2u yw = *(const v2u*)(P + (size_t)m * PW + PC_LY + c4);
#if FP8_OUTPROJ
        *(unsigned*)((unsigned char*)CC + (size_t)m * DM + 1536 + c4) = pk4_fp8(hs.x * gelu_tanh(bflo(yw.x)), hs.y * gelu_tanh(bfhi(yw.x)), hs.z * gelu_tanh(bflo(yw.y)), hs.w * gelu_tanh(bfhi(yw.y))); }
#else
        v2u o; o.x = pk2(hs.x * gelu_tanh(bflo(yw.x)), hs.y * gelu_tanh(bfhi(yw.x))); o.y = pk2(hs.z * gelu_tanh(bflo(yw.y)), hs.w * gelu_tanh(bfhi(yw.y)));
        *(v2u*)(CC + (size_t)m * DM + 1536 + c4) = o; }
#endif
}

constexpr size_t WS_DNQ = WS_DNT;
constexpr size_t WS_BG = WS_DNS + 1 * MiB;
constexpr size_t WS_XC = WS_XS;

__device__ __forceinline__ void naive_prep(Frame& F, int l) {
    const bf16* P = (const bf16*)(F.ws + WS_P);
    const int gw = F.bid * NWAVES + F.wave, NGW = F.G * NWAVES;
#if !defined(USE_CHUNK_DN)
    {
        float* DNQ = (float*)(F.ws + WS_DNQ); float* BG = (float*)(F.ws + WS_BG);
        const float* cw = F.in[I_DNCW] + (size_t)l * 4 * 1536;
        for (int it = gw; it < NTOK * 4; it += NGW) {
            const int m = it >> 2, h = it & 3; int t, T, base; seq_of(m, t, T, base);
            float val[3][2];
#pragma unroll
            for (int part = 0; part < 3; ++part)
#pragma unroll
                for (int dd = 0; dd < 2; ++dd) { const int d = F.lane + 64 * dd, cch = part * 512 + h * 128 + d, col = PC_DQ + cch; float s = 0.f;
#pragma unroll
                    for (int j = 0; j < 4; ++j) { const int tt = t + j - 2; if (tt >= 0 && tt < T) s += cw[j * 1536 + cch] * bf2f(P[(size_t)(base + tt) * PW + col]); }
                    val[part][dd] = siluf_(s); }
            const float sq = wave_sum(val[0][0] * val[0][0] + val[0][1] * val[0][1]), sk = wave_sum(val[1][0] * val[1][0] + val[1][1] * val[1][1]);
            const float fq = 0.08838834764831845f / sqrtf(sq + EPS), fk = 1.0f / sqrtf(sk + EPS);
#pragma unroll
            for (int dd = 0; dd < 2; ++dd) { const int d = F.lane + 64 * dd; float* o = DNQ + (size_t)m * 1536 + h * 128 + d;
                o[0] = val[0][dd] * fq; o[512] = val[1][dd] * fk; o[1024] = val[2][dd]; }
            if (h == 0 && F.lane < 8) { const int dir = F.lane >> 2, hh = F.lane & 3;
                const float pb = bf2f(P[(size_t)m * PW + PC_BETA + F.lane]), pa = bf2f(P[(size_t)m * PW + PC_DEC + F.lane]);
                BG[m * 16 + F.lane] = sigmoidf_(pb);
                BG[m * 16 + 8 + F.lane] = -__expf(F.in[I_DNALOG][l * 8 + dir * 4 + hh]) * softplusf_(pa + F.in[I_DNDT][l * 8 + dir * 4 + hh]); }
        }
    }
#endif
#if !defined(USE_CHUNK_LRU)
    {
        LAS float* xc = (LAS float*)F.lds;
        float* A = (float*)(F.ws + WS_LRA); float* U = (float*)(F.ws + WS_LRH);
        const float* cw = F.in[I_LRCW] + (size_t)l * 4 * 512; const float* cb = F.in[I_LRCB] + l * 512;
        for (int m0 = F.bid * 8; m0 < NTOK; m0 += F.G * 8) {
            __syncthreads();
            for (int i = F.tid; i < 8 * 512; i += NTHREADS) { const int m = m0 + (i >> 9), ch = i & 511; int t, T, base; seq_of(m, t, T, base); float s = cb[ch];
#pragma unroll
                for (int j = 0; j < 4; ++j) { const int tt = t + j - 2; if (tt >= 0 && tt < T) s += cw[j * 512 + ch] * bf2f(P[(size_t)(base + tt) * PW + PC_LX + ch]); }
                xc[i] = s; }
            __syncthreads();
            for (int i = F.tid; i < 8 * 512 * 2; i += NTHREADS) { const int ch = i & 511, dir = (i >> 9) & 1, tk = i >> 10, m = m0 + tk, blk = ch >> 6, j = ch & 63;
                const float* wr = F.in[I_LRWR] + ((size_t)((l * 2 + dir) * 8 + blk)) * 4096 + j; const float* wi = F.in[I_LRWI] + ((size_t)((l * 2 + dir) * 8 + blk)) * 4096 + j;
                float sr = F.in[I_LRBR][(l * 2 + dir) * 512 + ch], si = F.in[I_LRBI][(l * 2 + dir) * 512 + ch];
#pragma unroll 8
                for (int ii = 0; ii < 64; ++ii) { const float x = xc[tk * 512 + blk * 64 + ii]; sr += x * wr[ii * 64]; si += x * wi[ii * 64]; }
                const float r = sigmoidf_(sr), ig = sigmoidf_(si); const float lam = F.in[I_LRLAM][(l * 2 + dir) * 512 + ch];
                const float logsig = -softplusf_(-lam);
                const float log_a = 8.0f * r * logsig; const float a = __expf(log_a);
                const float u = sqrtf(-expm1f(2.0f * log_a)) * (ig * xc[tk * 512 + ch]);
                A[((size_t)dir * NTOK + m) * 512 + ch] = a; U[((size_t)dir * NTOK + m) * 512 + ch] = u; }
        }
        __syncthreads();
    }
#endif
}

__device__ __forceinline__ void naive_attn_row(Frame& F, int l, int m, int hq) {
    const bf16* P = (const bf16*)(F.ws + WS_P); bf16* CC = (bf16*)(F.ws + WS_CC);
    const int d = F.lane, kvh = hq >> 2; int t, T, base; seq_of(m, t, T, base);
    const bool lat = m < NLAT; const int b = lat ? (m >> 12) : ((m - NLAT) >> 8);
    const int dd = d & 31, jf = dd & 15; const float inv = __powf(10000.0f, -(float)jf * (1.0f / 16.0f));
    const bool second = (dd >= 16), colhalf = (d >= 32);
    float q = bf2f(P[(size_t)m * PW + PC_Q + hq * 64 + d]);
    if (lat) { const float pos = (float)(colhalf ? (t & 63) : (t >> 6)); float sn, cs; sincosf(pos * inv, &sn, &cs); const float pr = __shfl_xor(q, 16); q = second ? (q * cs + pr * sn) : (q * cs - pr * sn); }
    q *= 0.125f;
    float mx = F.in[I_SINK][l * 16 + hq], den = 1.0f, acc = 0.f;
    if (lat) { const int t0 = t - 128 < 0 ? 0 : t - 128, t1 = t + 128 > SEQ - 1 ? SEQ - 1 : t + 128;
        for (int tk = t0; tk <= t1; ++tk) { const size_t r = (size_t)(base + tk) * PW; float k = bf2f(P[r + PC_K + kvh * 64 + d]); const float v = bf2f(P[r + PC_V + kvh * 64 + d]);
            const float pos = (float)(colhalf ? (tk & 63) : (tk >> 6)); float sn, cs; sincosf(pos * inv, &sn, &cs); const float pr = __shfl_xor(k, 16); k = second ? (k * cs + pr * sn) : (k * cs - pr * sn);
            const float s = wave_sum(q * k); const float mn = fmaxf(mx, s), f = __expf(mx - mn), p = __expf(s - mn); den = den * f + p; acc = acc * f + p * v; mx = mn; } }
    for (int c = 0; c < CTXL; ++c) { const size_t r = (size_t)(NLAT + b * CTXL + c) * PW; const float k = bf2f(P[r + PC_K + kvh * 64 + d]), v = bf2f(P[r + PC_V + kvh * 64 + d]);
        const float s = wave_sum(q * k); const float mn = fmaxf(mx, s), f = __expf(mx - mn), p = __expf(s - mn); den = den * f + p; acc = acc * f + p * v; mx = mn; }
    CC[(size_t)m * DM + hq * 64 + d] = (bf16)f2bf(acc / den);
}

__device__ __forceinline__ int scan_row(int n, int b, int dir) { if (n < CTXL) { const int t = dir ? (CTXL - 1 - n) : n; return NLAT + b * CTXL + t; } const int t = dir ? (SEQ - 1 - (n - CTXL)) : (n - CTXL); return b * SEQ + t; }
__device__ __forceinline__ void naive_scan(Frame& F, int l, int rep = 0) {
#if defined(USE_CHUNK_DN)
    if (F.bid < 32 * DN_SPLIT) { if (DN_SPLIT == 2) dn_scan(F, l, F.bid >> 4, (F.bid >> 2) & 3, (F.bid >> 1) & 1, F.bid & 1); else dn_scan(F, l, F.bid >> 3, (F.bid >> 1) & 3, F.bid & 1, 0); }
#else
    if (F.bid < 32) {
        const int b = F.bid >> 3, h = (F.bid >> 1) & 3, dir = F.bid & 1, dvc = F.tid & 127, kq = F.tid >> 7;
        const float* DNQ = (const float*)(F.ws + WS_DNQ); const float* BG = (const float*)(F.ws + WS_BG); float* O = (float*)(F.ws + WS_DNO);
        LAS float* buf = (LAS float*)F.lds;
        LAS float* red = buf + 768;
        LAS float* red2 = red + 512;
        float S[32];
#pragma unroll
        for (int i = 0; i < 32; ++i) S[i] = 0.f;
        constexpr int NT = CTXL + SEQ;
        { const int m = scan_row(0, b, dir); if (F.tid < 384) buf[F.tid] = DNQ[(size_t)m * 1536 + (F.tid >> 7) * 512 + h * 128 + (F.tid & 127)]; }
        __syncthreads();
#pragma unroll 1
        for (int n = 0; n < NT; ++n) {
            const int m = scan_row(n, b, dir); const LAS float* cur = buf + (n & 1) * 384;
            float nextv = 0.f; if (n + 1 < NT && F.tid < 384) { const int m2 = scan_row(n + 1, b, dir); nextv = DNQ[(size_t)m2 * 1536 + (F.tid >> 7) * 512 + h * 128 + (F.tid & 127)]; }
            const float beta = BG[m * 16 + dir * 4 + h], decay = __expf(BG[m * 16 + 8 + dir * 4 + h]);
            float ks = 0.f;
#pragma unroll
            for (int i = 0; i < 32; ++i) ks += cur[128 + kq * 32 + i] * S[i];
            red[kq * 128 + dvc] = ks;
            __syncthreads();
            const float kS = (red[dvc] + red[128 + dvc]) + (red[256 + dvc] + red[384 + dvc]);
            const float upd = beta * (cur[256 + dvc] - decay * kS);
            float os = 0.f;
#pragma unroll
            for (int i = 0; i < 32; ++i) { S[i] = decay * S[i] + cur[128 + kq * 32 + i] * upd; os += cur[kq * 32 + i] * S[i]; }
            red2[kq * 128 + dvc] = os;
            if (F.tid < 384) buf[((n + 1) & 1) * 384 + F.tid] = nextv;
            __syncthreads();
            if (kq == 0) O[((size_t)dir * NTOK + m) * 512 + h * 128 + dvc] = (red2[dvc] + red2[128 + dvc]) + (red2[256 + dvc] + red2[384 + dvc]);
        }
    }
#endif
#if defined(USE_CHUNK_LRU)
    else if (F.bid < 32 * DN_SPLIT + 8) { lru_carry(F, (F.bid - 32 * DN_SPLIT) * NTHREADS + F.tid); }
#else
    else if (F.bid < 40) {
        const int idx = (F.bid - 32) * NTHREADS + F.tid, ch = idx & 511, dir = (idx >> 9) & 1, b = idx >> 10;
        const float* A = (const float*)(F.ws + WS_LRA); float* U = (float*)(F.ws + WS_LRH);
        float hs = 0.f;
#pragma unroll 4
        for (int n = 0; n < CTXL + SEQ; ++n) { int m; if (n < CTXL) { const int t = dir ? (CTXL - 1 - n) : n; m = NLAT + b * CTXL + t; } else { const int t = dir ? (SEQ - 1 - (n - CTXL)) : (n - CTXL); m = b * SEQ + t; }
            const size_t o = ((size_t)dir * NTOK + m) * 512 + ch; hs = A[o] * hs + U[o]; U[o] = hs; }
    }
#endif
#if defined(USE_MFMA_ATTN)
#if SCAN_SPLIT_ORDER
    if ((F.bid & 3) >= SCAN_ATTN_FIRST) { convert_moe_queue(F, l, rep); attn_phase(F, l, rep); } else { attn_phase(F, l, rep); convert_moe_queue(F, l, rep); }
#else
    attn_phase(F, l, rep);
    convert_moe_queue(F, l, rep);
#endif
#else
    {
        const int nrows = (l == 0) ? NTOK : NLAT;
        for (;;) { int m = 0; if (F.lane == 0) m = (int)__hip_atomic_fetch_add(F.ctl + CW_ATQ + 64 * l, 1u, RLX_AGENT); m = __builtin_amdgcn_readfirstlane(m);
            if (m >= nrows) break;
#pragma unroll 1
            for (int hq = 0; hq < 16; ++hq) naive_attn_row(F, l, m, hq); }
    }
#endif
}

__device__ __forceinline__ void naive_fin(Frame& F, int l) {
    const int nrows = (l == 0) ? NTOK : NLAT;
    const bf16* P = (const bf16*)(F.ws + WS_P); bf16* CC = (bf16*)(F.ws + WS_CC);
    const int gw = F.bid * NWAVES + F.wave, NGW = F.G * NWAVES;
    const float* O = (const float*)(F.ws + WS_DNO); const float* HS = (const float*)(F.ws + WS_LRH);
    for (int it0 = gw * 2; it0 < nrows * 4; it0 += NGW * 2) {
        float2 oa[2], ob[2]; unsigned gw_[2];
#pragma unroll
        for (int k = 0; k < 2; ++k) { const int it = it0 + k, m = it >> 2, h = it & 3; const int c = h * 128 + 2 * F.lane;
            { const bf16* Ob = (const bf16*)(F.ws + WS_DNO); const unsigned wa = *(const unsigned*)(Ob + (size_t)m * 512 + c), wb = *(const unsigned*)(Ob + ((size_t)NTOK + m) * 512 + c); oa[k] = make_float2(bflo(wa), bfhi(wa)); ob[k] = make_float2(bflo(wb), bfhi(wb)); } gw_[k] = *(const unsigned*)(P + (size_t)m * PW + PC_DG + c); }
        const float2 ng = *(const float2*)(F.in[I_DNNG] + l * 128 + 2 * F.lane);
#pragma unroll
        for (int k = 0; k < 2; ++k) { const int it = it0 + k, m = it >> 2, h = it & 3; const float o0 = oa[k].x + ob[k].x, o1 = oa[k].y + ob[k].y;
            const float rstd = 1.0f / sqrtf(wave_sum(o0 * o0 + o1 * o1) * (1.0f / 128.0f) + EPS);
#if FP8_OUTPROJ
            *(unsigned short*)((unsigned char*)CC + (size_t)m * DM + 1024 + h * 128 + 2 * F.lane) = (unsigned short)(pk4_fp8(o0 * rstd * ng.x * siluf_(bflo(gw_[k])), o1 * rstd * ng.y * siluf_(bfhi(gw_[k])), 0.f, 0.f) & 0xffffu); }
#else
            *(unsigned*)(CC + (size_t)m * DM + 1024 + h * 128 + 2 * F.lane) = pk2(o0 * rstd * ng.x * siluf_(bflo(gw_[k])), o1 * rstd * ng.y * siluf_(bfhi(gw_[k]))); }
#endif
    }
#if defined(USE_CHUNK_LRU)
    lru_fin(F, l);
#else
    for (size_t i = (size_t)F.bid * NTHREADS + F.tid; i < (size_t)nrows * 512; i += (size_t)F.G * NTHREADS) { const int m = (int)(i >> 9), ch = (int)(i & 511);
        const float hsum = HS[(size_t)m * 512 + ch] + HS[((size_t)NTOK + m) * 512 + ch]; const float y = bf2f(P[(size_t)m * PW + PC_LY + ch]);
        CC[(size_t)m * DM + 1536 + ch] = (bf16)f2bf(hsum * gelu_tanh(y)); }
#endif
}
#ifndef PHASE_PREP
#if defined(USE_MFMA_ATTN)
#if defined(USE_CHUNK_DN)
#define PHASE_PREP(F, l) do { attn_prep(F, l); lru_prep(F, l); dn_prep(F, l); } while (0)
#else
#define PHASE_PREP(F, l) do { naive_prep(F, l); attn_prep(F, l); } while (0)
#endif
#else
#define PHASE_PREP(F, l) naive_prep(F, l)
#endif
#endif
#ifndef PHASE_SCAN
#define PHASE_SCAN(F, l) naive_scan(F, l)
#endif
#ifndef PHASE_FIN
#define PHASE_FIN(F, l) naive_fin(F, l)
#endif

#ifndef PHASE_INPROJ
#define PHASE_INPROJ(F, l) do {} while (0)
#endif
#ifndef PHASE_PREP
#define PHASE_PREP(F, l) do {} while (0)
#endif
#ifndef PHASE_SCAN
#define PHASE_SCAN(F, l) do {} while (0)
#endif
#ifndef PHASE_FIN
#define PHASE_FIN(F, l) do {} while (0)
#endif
#ifndef PHASE_OUTPROJ
#define PHASE_OUTPROJ(F, l) do {} while (0)
#endif
#ifndef PHASE_NORM2
#define PHASE_NORM2(F, l) do {} while (0)
#endif
#ifndef PHASE_SCATTER
#define PHASE_SCATTER(F, l) do {} while (0)
#endif
#ifndef PHASE_GEMM1
#define PHASE_GEMM1(F, l) do {} while (0)
#endif
#ifndef PHASE_GEMM2
#define PHASE_GEMM2(F, l) do {} while (0)
#endif

#ifndef MK_SPLIT
#define MK_SPLIT 0
#endif
#ifndef MK_STAGE
#define MK_STAGE 99
#endif
#ifndef MK_TAILFILL
#define MK_TAILFILL 0
#endif
#ifndef MK_DUP
#define MK_DUP 0
#endif
#define DUP(k) ((MK_DUP >> (k)) & 1)
constexpr int N_PHASES = 22;
struct Args { const float* in[N_IN]; float* out; unsigned char* ws; int ph_lo, ph_hi; };
static_assert(sizeof(Args) == (N_IN + 2) * 8 + 8, "Args has no padding");

__global__ void __launch_bounds__(NTHREADS, 2) fwd_kernel(Args args) {
    extern __shared__ __attribute__((aligned(16))) unsigned char lds[];
    Frame F;
    F.lds = (LAS unsigned char*)lds;
    F.MISC = (volatile LAS unsigned*)(F.lds + MISC_OFF);
    F.tid = threadIdx.x; F.lane = F.tid & 63; F.wave = __builtin_amdgcn_readfirstlane(F.tid >> 6);
    F.G = 256; F.bid = blockIdx.x;
    F.ws = args.ws; F.out = args.out; F.ctl = (gu32*)(args.ws + WS_CTL);
    F.in = (const float* const __attribute__((address_space(4)))*)__builtin_amdgcn_kernarg_segment_ptr();
    for (int u = F.tid; u < (LDS_BYTES - LDSCTL_OFF) / 4; u += NTHREADS) ((LAS unsigned*)(F.lds + LDSCTL_OFF))[u] = 0u;
    __syncthreads();
    XcdBarrier bar; bar.bar = (unsigned*)(F.ctl + CW_BAR); bar.x = 0; bar.st = nullptr;
    if (!MK_SPLIT) bar = xcd_barrier_post((unsigned*)(F.ctl + CW_BAR), F.MISC + 8);
    const int lo = args.ph_lo, hi = args.ph_hi;
#define IN(k) (lo <= (k) && (k) < hi && phase_enter(F))
#define INR(k) (lo <= (k) && (k) < hi)
#define SEAM(k) do { if (INR(k) && INR((k) + 1)) { if (MK_TAILFILL && (k) < 14) tail_fill(F, (k), (k) < 4 ? 0 : 1); xcd_barrier(bar); } } while (0)

    if (IN(0)) { p0_prologue(F); if (DUP(0)) { __syncthreads(); p0_prologue(F); } } SEAM(0);
#pragma unroll 1
    for (int l = 0; l < DEPTH; ++l) {
        const int pb = 1 + 10 * l;
        if (IN(pb + 0)) { phase_norm1(F, l); if (DUP(13) && l == 0) { __syncthreads(); phase_norm1(F, l); } } SEAM(pb + 0);
        if (IN(pb + 1)) { PHASE_INPROJ(F, l); if (DUP(1)) { __syncthreads(); PHASE_INPROJ(F, l); } } SEAM(pb + 1);
        if (IN(pb + 2)) { PHASE_PREP(F, l); if (DUP(2)) { __syncthreads(); dn_prep(F, l); } if (DUP(6)) { __syncthreads(); lru_prep(F, l); } } SEAM(pb + 2);
        if (IN(pb + 3)) { if (DUP(3) && F.bid < 64) dn_scan(F, l, F.bid >> 4, (F.bid >> 2) & 3, (F.bid >> 1) & 1, F.bid & 1); PHASE_SCAN(F, l); if (DUP(10)) { __syncthreads(); naive_scan(F, l, 1); } if (DUP(11)) { __syncthreads(); attn_phase(F, l, 2); } if (DUP(12)) { __syncthreads(); convert_moe_queue(F, l, 3); } } SEAM(pb + 3);
        if (IN(pb + 4)) { PHASE_FIN(F, l); if (DUP(4)) { __syncthreads(); PHASE_FIN(F, l); } } SEAM(pb + 4);
        if (IN(pb + 5)) { PHASE_OUTPROJ(F, l); if (DUP(5) && l == 0) { __syncthreads(); PHASE_OUTPROJ(F, l); } } SEAM(pb + 5);
        if (IN(pb + 6)) { PHASE_NORM2(F, l); } SEAM(pb + 6);
        if (IN(pb + 7)) { PHASE_SCATTER(F, l); if (DUP(7)) { __syncthreads(); PHASE_SCATTER(F, l); } } SEAM(pb + 7);
        if (IN(pb + 8)) { PHASE_GEMM1(F, l); if (DUP(8)) { __syncthreads(); PHASE_GEMM1(F, l); } } SEAM(pb + 8);
        if (IN(pb + 9)) { PHASE_GEMM2(F, l); if (DUP(9)) { __syncthreads(); PHASE_GEMM2(F, l); } } SEAM(pb + 9);
    }
    if (IN(21)) { phase_final(F, MK_STAGE >= 9); if (DUP(13)) { __syncthreads(); phase_final(F, MK_STAGE >= 9); } }
#undef IN
#undef SEAM
}

extern "C" void kernel_launch(void* const* d_in, const int* in_sizes, int n_in, void* d_out, int out_size, void* d_ws, size_t ws_size, hipStream_t stream) {
    static int grid = 0;
    if (grid == 0) {
        if (n_in != N_IN || out_size != NLAT * DM || ws_size < WS_END) { fprintf(stderr, "kernel_launch: unexpected shapes (n_in %d, out %d, ws %zu); nothing launched\n", n_in, out_size, ws_size); grid = -1; return; }
        int dev = 0, cus = 0, per_cu = 0;
        if (hipGetDevice(&dev) != hipSuccess || hipDeviceGetAttribute(&cus, hipDeviceAttributeMultiprocessorCount, dev) != hipSuccess) { grid = -1; return; }
        if (hipFuncSetAttribute((const void*)fwd_kernel, hipFuncAttributeMaxDynamicSharedMemorySize, LDS_BYTES) != hipSuccess) { fprintf(stderr, "kernel_launch: hipFuncSetAttribute failed\n"); grid = -1; return; }
        if (hipOccupancyMaxActiveBlocksPerMultiprocessor(&per_cu, (const void*)fwd_kernel, NTHREADS, LDS_BYTES) != hipSuccess || per_cu < 1) { fprintf(stderr, "kernel_launch: occupancy query says %d\n", per_cu); }
        (void)hipGetLastError();
        grid = cus;
        if (grid != 256) { fprintf(stderr, "kernel_launch: built for 256 CUs, device has %d; nothing launched\n", cus); grid = -1; return; }
    }
    if (grid < 0) return;
    if (hipMemsetAsync((char*)d_ws + WS_CTL, 0, CTL_ZERO_BYTES, stream) != hipSuccess) return;
    Args a{};
    for (int i = 0; i < N_IN; ++i) a.in[i] = (const float*)d_in[i];
    a.out = (float*)d_out; a.ws = (unsigned char*)d_ws;
#if MK_SPLIT
    for (int p = 0; p < N_PHASES; ++p) { a.ph_lo = p; a.ph_hi = p + 1; hipLaunchKernelGGL(fwd_kernel, dim3(grid), dim3(NTHREADS), LDS_BYTES, stream, a); }
#else
    a.ph_lo = 0; a.ph_hi = N_PHASES;
    hipLaunchKernelGGL(fwd_kernel, dim3(grid), dim3(NTHREADS), LDS_BYTES, stream, a);
#endif
    const hipError_t le = hipPeekAtLastError();
    if (le != hipSuccess) fprintf(stderr, "kernel_launch: launch failed: %s\n", hipGetErrorName(le));
}
```

```cpp
#include <hip/hip_runtime.h>
#include <cstdio>
#include <cstdint>

constexpr int DM = 2048, NB = 4, SEQ = 4096, CTXL = 256, DEPTH = 2;
constexpr int NLAT = NB * SEQ, NCTX = NB * CTXL, NTOK = NLAT + NCTX;
constexpr int NCT = NTOK / 64;
constexpr int IN_W = 4624, PW = 4864;
constexpr int PC_Q = 0, PC_K = 1024, PC_V = 1280, PC_DQ = 1536, PC_DK = 2048, PC_DV = 2560, PC_DG = 3072, PC_LX = 3584, PC_LY = 4096, PC_BETA = 4608, PC_DEC = 4616;
constexpr int NEXP = 32, TOPK = 4, DEXP = 1024;
constexpr int MOE_ROWS = 304 * 256;
constexpr float EPS = 1e-6f;
#ifndef MK_STAGE
#define MK_STAGE 99
#endif
#ifndef FP8_INPROJ
#define FP8_INPROJ 0
#endif
#ifndef FP8_OUTPROJ
#define FP8_OUTPROJ 0
#endif
#ifndef SCAN_SPLIT_ORDER
#define SCAN_SPLIT_ORDER 1
#endif
#ifndef X_BF16
#define X_BF16 1
#endif
#ifndef SCAN_ATTN_FIRST
#define SCAN_ATTN_FIRST 2
#endif
#ifndef OUTPROJ_SLACK_TICKS
#define OUTPROJ_SLACK_TICKS 0
#endif
#ifndef YS_FP8
#define YS_FP8 1
#endif
#ifndef I8_INPROJ
#define I8_INPROJ 1
#endif
namespace pg8 {
#define PG8_LAS __attribute__((address_space(3)))
typedef unsigned short bf16_t;
typedef short bf16x8 __attribute__((ext_vector_type(8)));
typedef float f32x4 __attribute__((ext_vector_type(4)));
typedef unsigned u32x4 __attribute__((ext_vector_type(4)));
typedef float f32x2 __attribute__((ext_vector_type(2)));
constexpr int BM = 256, BK = 64, HALF = 128, HTB = HALF * BK * 2  , STAGE_BYTES = 8 * HTB, NXCD = 8, WGM = 8;

__host__ __device__ __forceinline__ int lds_byte(int r, int c) { const int st = (r >> 4) * 2 + (c >> 5), rr = r & 15, cc = c & 31, ob = rr * 64 + cc * 2; return st * 1024 + (ob ^ (((ob >> 9) & 1) << 5)); }
__host__ __device__ __forceinline__ void stage_rc(int b, int& R, int& C) { const int st = b / 1024, sb = b % 1024, swz = sb ^ (((sb >> 9) & 1) << 5); R = (st >> 1) * 16 + swz / 64; C = (st & 1) * 32 + (swz % 64) / 2; }
__host__ __device__ __forceinline__ int perm32(int rho) { const int n = rho >> 4, i = rho & 15; return 8 * (i >> 2) + 4 * n + (i & 3); }

struct Unit { int pm, pn, e; };
typedef int v4i_t __attribute__((ext_vector_type(4)));
typedef int v8i_t __attribute__((ext_vector_type(8)));
struct Gemm { const bf16_t* A; const bf16_t* Bt; int M, N, K; int bscale = 0x7F7F7F7F; };

struct StaticOrder {
    static constexpr bool GATHER = false, IDENT = false; const int* row_tab = nullptr;
    int nM, nN, nwg, G, c; const char* A; const char* Bt; size_t tstep;
    __device__ void init(const Gemm& g, int G_, int c_) { nM = g.M / BM; nN = g.N / BM; nwg = nM * nN; G = G_; c = c_; A = (const char*)g.A; Bt = (const char*)g.Bt; tstep = (size_t)BM * g.K * 2; }
    __device__ bool next(int i, Unit& u) const {
        const long L = (long)i * G + c; if (L >= nwg) return false;
        int wgid = (int)L; { const int q = nwg / NXCD, r = nwg % NXCD, xcd = wgid % NXCD, off = wgid / NXCD; wgid = (xcd < r ? xcd * (q + 1) : r * (q + 1) + (xcd - r) * q) + off; }
        const int nig = WGM * nN, gid = wgid / nig, fm = gid * WGM, gsz = (nM - fm) < WGM ? (nM - fm) : WGM;
        u.pm = fm + ((wgid % nig) % gsz); u.pn = (wgid % nig) / gsz; u.e = 0; return true;
    }
    __device__ __forceinline__ const char* a_ptr(const Unit& u) const { return A + (size_t)u.pm * tstep; }
    __device__ __forceinline__ const char* b_ptr(const Unit& u) const { return Bt + (size_t)u.pn * tstep; }
    __device__ __forceinline__ void a_ready(const Unit&) const {}
    __device__ __forceinline__ void done(const Unit&) const {}
};
struct StaticOrderG : StaticOrder {
    static constexpr bool GATHER = true, IDENT = true;
    __device__ __forceinline__ const char* a_ptr(const Unit&) const { return A; }
};
__device__ __forceinline__ unsigned cvt_pk_bf16(float lo, float hi) { unsigned r; asm volatile("v_cvt_pk_bf16_f32 %0, %1, %2" : "=v"(r) : "v"(lo), "v"(hi)); return r; }
struct EpiBf16Plain {
    static constexpr bool PERM = true, AFTER_DRAIN = false;
    bf16_t* O; int ldc;
    __device__ __forceinline__ void operator()(const f32x4 (&acc)[2][2][4][2], const Unit& u, int wr, int wc, int fr, int fq) const {
        const int row0 = u.pm * BM + wr * 64 + fr, col0 = u.pn * BM + wc * 32 + 8 * fq;
#pragma unroll
        for (int ai = 0; ai < 2; ++ai)
#pragma unroll
            for (int m = 0; m < 4; ++m) { bf16_t* rowp = O + (size_t)(row0 + ai * HALF + m * 16) * ldc + col0;
#pragma unroll
                for (int bj = 0; bj < 2; ++bj) { const f32x4 v0 = acc[ai][bj][m][0], v1 = acc[ai][bj][m][1];
                    u32x4 w; w.x = cvt_pk_bf16(v0[0], v0[1]); w.y = cvt_pk_bf16(v0[2], v0[3]); w.z = cvt_pk_bf16(v1[0], v1[1]); w.w = cvt_pk_bf16(v1[2], v1[3]);
                    *(u32x4*)(rowp + bj * HALF) = w; } }
    }
};
struct EpiBf16PlainI8 {
    static constexpr bool PERM = true, AFTER_DRAIN = false;
    bf16_t* O; int ldc; const float* rs; const float* cs;
    __device__ __forceinline__ void operator()(const f32x4 (&acc)[2][2][4][2], const Unit& u, int wr, int wc, int fr, int fq) const {
        const int row0 = u.pm * BM + wr * 64 + fr, col0 = u.pn * BM + wc * 32 + 8 * fq;
        f32x4 cv[2][2];
#pragma unroll
        for (int bj = 0; bj < 2; ++bj)
#pragma unroll
            for (int n = 0; n < 2; ++n) cv[bj][n] = *(const f32x4*)(cs + col0 + bj * HALF + 4 * n);
#pragma unroll
        for (int ai = 0; ai < 2; ++ai)
#pragma unroll
            for (int m = 0; m < 4; ++m) { const int row = row0 + ai * HALF + m * 16; const float r = rs[row]; bf16_t* rowp = O + (size_t)row * ldc + col0;
#pragma unroll
                for (int bj = 0; bj < 2; ++bj) { const v4i_t i0 = __builtin_bit_cast(v4i_t, acc[ai][bj][m][0]), i1 = __builtin_bit_cast(v4i_t, acc[ai][bj][m][1]);
                    const f32x4 v0 = (f32x4){(float)i0.x, (float)i0.y, (float)i0.z, (float)i0.w} * cv[bj][0] * r, v1 = (f32x4){(float)i1.x, (float)i1.y, (float)i1.z, (float)i1.w} * cv[bj][1] * r;
                    u32x4 w; w.x = cvt_pk_bf16(v0[0], v0[1]); w.y = cvt_pk_bf16(v0[2], v0[3]); w.z = cvt_pk_bf16(v1[0], v1[1]); w.w = cvt_pk_bf16(v1[2], v1[3]);
                    *(u32x4*)(rowp + bj * HALF) = w; } }
    }
};
struct EpiResGate {
    static constexpr bool PERM = false, AFTER_DRAIN = false;
    const float* base_lat; const float* base_ctx; float* out; const float* modg;
    __device__ __forceinline__ void operator()(const f32x4 (&acc)[2][2][4][2], const Unit& u, int wr, int wc, int fr, int fq) const {
        const int r = u.pm < 64 ? (u.pm >> 4) : 4; const int col0 = u.pn * BM + wc * 32 + 4 * fq;
        const float* g = modg + (size_t)r * 12288 + col0;
        f32x4 gv[2][2];
#pragma unroll
        for (int bj = 0; bj < 2; ++bj)
#pragma unroll
            for (int n = 0; n < 2; ++n) gv[bj][n] = *(const f32x4*)(g + bj * HALF + n * 16);
#pragma unroll
        for (int ai = 0; ai < 2; ++ai)
#pragma unroll
            for (int m = 0; m < 4; ++m) { const int row = u.pm * BM + ai * HALF + wr * 64 + m * 16 + fr;
                const float* bp = (row < 16384 ? base_lat + (size_t)row * 2048 : base_ctx + (size_t)(row - 16384) * 2048) + col0; float* op = out + (size_t)row * 2048 + col0;
#pragma unroll
                for (int bj = 0; bj < 2; ++bj)
#pragma unroll
                    for (int n = 0; n < 2; ++n) { const f32x4 b = *(const f32x4*)(bp + bj * HALF + n * 16); *(f32x4*)(op + bj * HALF + n * 16) = b + gv[bj][n] * acc[ai][bj][m][n]; }
                asm volatile("" ::: "memory"); }
    }
};
struct EpiResGateB {
    static constexpr bool PERM = true, AFTER_DRAIN = false;
    const float* base_lat; const float* base_ctx; const bf16_t* xb_in; bf16_t* xb_out; const float* modg; int f32base;
    __device__ __forceinline__ void operator()(const f32x4 (&acc)[2][2][4][2], const Unit& u, int wr, int wc, int fr, int fq) const {
        const int r = u.pm < 64 ? (u.pm >> 4) : 4; const int col0 = u.pn * BM + wc * 32 + 8 * fq;
        const float* g = modg + (size_t)r * 12288 + col0;
        f32x4 gv[2][2];
#pragma unroll
        for (int bj = 0; bj < 2; ++bj)
#pragma unroll
            for (int n = 0; n < 2; ++n) gv[bj][n] = *(const f32x4*)(g + bj * HALF + 4 * n);
#pragma unroll
        for (int ai = 0; ai < 2; ++ai)
#pragma unroll
            for (int m = 0; m < 4; ++m) { const int row = u.pm * BM + ai * HALF + wr * 64 + m * 16 + fr;
#pragma unroll
                for (int bj = 0; bj < 2; ++bj) { f32x4 b0, b1;
                    if (f32base) { const float* bp = (row < 16384 ? base_lat + (size_t)row * 2048 : base_ctx + (size_t)(row - 16384) * 2048) + col0 + bj * HALF; b0 = *(const f32x4*)bp; b1 = *(const f32x4*)(bp + 4); }
                    else { const u32x4 w = *(const u32x4*)(xb_in + (size_t)row * 2048 + col0 + bj * HALF);
                        b0 = (f32x4){__builtin_bit_cast(float, w.x << 16), __builtin_bit_cast(float, w.x & 0xffff0000u), __builtin_bit_cast(float, w.y << 16), __builtin_bit_cast(float, w.y & 0xffff0000u)};
                        b1 = (f32x4){__builtin_bit_cast(float, w.z << 16), __builtin_bit_cast(float, w.z & 0xffff0000u), __builtin_bit_cast(float, w.w << 16), __builtin_bit_cast(float, w.w & 0xffff0000u)}; }
                    const f32x4 v0 = b0 + gv[bj][0] * acc[ai][bj][m][0], v1 = b1 + gv[bj][1] * acc[ai][bj][m][1];
                    u32x4 o; o.x = cvt_pk_bf16(v0[0], v0[1]); o.y = cvt_pk_bf16(v0[2], v0[3]); o.z = cvt_pk_bf16(v1[0], v1[1]); o.w = cvt_pk_bf16(v1[2], v1[3]);
                    *(u32x4*)(xb_out + (size_t)row * 2048 + col0 + bj * HALF) = o; }
                asm volatile("" ::: "memory"); }
    }
};
struct EpiSwiglu {
    static constexpr bool PERM = true, AFTER_DRAIN = false;
    bf16_t* O; const float* bgu;
    __device__ __forceinline__ void operator()(const f32x4 (&acc)[2][2][4][2], const Unit& u, int wr, int wc, int fr, int fq) const {
        const int row0 = u.pm * BM + wr * 64 + fr, cc0 = wc * 32 + 8 * fq;
        const float* bg = bgu + (size_t)u.e * 2048 + u.pn * 128 + cc0;
        f32x4 bglu[2], blin[2];
#pragma unroll
        for (int n = 0; n < 2; ++n) { bglu[n] = *(const f32x4*)(bg + 4 * n); blin[n] = *(const f32x4*)(bg + 1024 + 4 * n); }
#pragma unroll
        for (int ai = 0; ai < 2; ++ai)
#pragma unroll
            for (int m = 0; m < 4; ++m) { bf16_t* rowp = O + (size_t)(row0 + ai * HALF + m * 16) * 1024 + u.pn * 128 + cc0;
                float r[8];
#pragma unroll
                for (int n = 0; n < 2; ++n) { const f32x4 g = acc[ai][0][m][n] + bglu[n], l = acc[ai][1][m][n] + blin[n];
#pragma unroll
                    for (int i = 0; i < 4; ++i) { const float gg = fminf(g[i], 7.0f); const float ll = fminf(fmaxf(l[i], -7.0f), 7.0f);
                        r[4 * n + i] = (ll + 1.0f) * gg * __builtin_amdgcn_rcpf(1.0f + __builtin_amdgcn_exp2f(-1.702f * 1.4426950408889634f * gg)); } }
                u32x4 w; w.x = cvt_pk_bf16(r[0], r[1]); w.y = cvt_pk_bf16(r[2], r[3]); w.z = cvt_pk_bf16(r[4], r[5]); w.w = cvt_pk_bf16(r[6], r[7]);
                *(u32x4*)rowp = w; }
    }
};
struct EpiSwiglu8 {
    static constexpr bool PERM = true, AFTER_DRAIN = false;
    unsigned char* O; const float* bgu;
    __device__ __forceinline__ void operator()(const f32x4 (&acc)[2][2][4][2], const Unit& u, int wr, int wc, int fr, int fq) const {
        const int row0 = u.pm * BM + wr * 64 + fr, cc0 = wc * 32 + 8 * fq;
        const float* bg = bgu + (size_t)u.e * 2048 + u.pn * 128 + cc0;
        f32x4 bglu[2], blin[2];
#pragma unroll
        for (int n = 0; n < 2; ++n) { bglu[n] = *(const f32x4*)(bg + 4 * n); blin[n] = *(const f32x4*)(bg + 1024 + 4 * n); }
#pragma unroll
        for (int ai = 0; ai < 2; ++ai)
#pragma unroll
            for (int m = 0; m < 4; ++m) { unsigned char* rowp = O + (size_t)(row0 + ai * HALF + m * 16) * 1024 + u.pn * 128 + cc0;
                float r[8];
#pragma unroll
                for (int n = 0; n < 2; ++n) { const f32x4 g = acc[ai][0][m][n] + bglu[n], l = acc[ai][1][m][n] + blin[n];
#pragma unroll
                    for (int i = 0; i < 4; ++i) { const float gg = fminf(g[i], 7.0f); const float ll = fminf(fmaxf(l[i], -7.0f), 7.0f);
                        r[4 * n + i] = (ll + 1.0f) * gg * __builtin_amdgcn_rcpf(1.0f + __builtin_amdgcn_exp2f(-1.702f * 1.4426950408889634f * gg)); } }
                int w0 = 0, w1 = 0; w0 = __builtin_amdgcn_cvt_pk_fp8_f32(r[0], r[1], w0, false); w0 = __builtin_amdgcn_cvt_pk_fp8_f32(r[2], r[3], w0, true); w1 = __builtin_amdgcn_cvt_pk_fp8_f32(r[4], r[5], w1, false); w1 = __builtin_amdgcn_cvt_pk_fp8_f32(r[6], r[7], w1, true);
                typedef unsigned u32x2 __attribute__((ext_vector_type(2))); *(u32x2*)rowp = (u32x2){(unsigned)w0, (unsigned)w1}; }
    }
};
struct EpiDown {
    static constexpr bool PERM = true, AFTER_DRAIN = false;
    bf16_t* O; const float* bdn; const float* rowg;
    __device__ __forceinline__ void operator()(const f32x4 (&acc)[2][2][4][2], const Unit& u, int wr, int wc, int fr, int fq) const {
        const int row0 = u.pm * BM + wr * 64 + fr, col0 = u.pn * BM + wc * 32 + 8 * fq;
        const float* bb = bdn + (size_t)u.e * 2048 + col0;
        float gt[2][4];
#pragma unroll
        for (int ai = 0; ai < 2; ++ai)
#pragma unroll
            for (int m = 0; m < 4; ++m) gt[ai][m] = rowg[row0 + ai * HALF + m * 16];
#pragma unroll
        for (int bj = 0; bj < 2; ++bj) { const f32x4 b0 = *(const f32x4*)(bb + bj * HALF), b1 = *(const f32x4*)(bb + bj * HALF + 4);
#pragma unroll
            for (int ai = 0; ai < 2; ++ai)
#pragma unroll
                for (int m = 0; m < 4; ++m) { const int row = row0 + ai * HALF + m * 16; const f32x4 v0 = (acc[ai][bj][m][0] + b0) * gt[ai][m], v1 = (acc[ai][bj][m][1] + b1) * gt[ai][m];
                    u32x4 w; w.x = cvt_pk_bf16(v0[0], v0[1]); w.y = cvt_pk_bf16(v0[2], v0[3]); w.z = cvt_pk_bf16(v1[0], v1[1]); w.w = cvt_pk_bf16(v1[2], v1[3]);
                    *(u32x4*)(O + (size_t)row * 2048 + col0 + bj * HALF) = w; } }
    }
};
struct EpiDown8 {
    static constexpr bool PERM = true, AFTER_DRAIN = false;
    unsigned char* O; const float* bdn; const float* rowg;
    __device__ __forceinline__ void operator()(const f32x4 (&acc)[2][2][4][2], const Unit& u, int wr, int wc, int fr, int fq) const {
        const int row0 = u.pm * BM + wr * 64 + fr, col0 = u.pn * BM + wc * 32 + 8 * fq;
        const float* bb = bdn + (size_t)u.e * 2048 + col0;
        float gt[2][4];
#pragma unroll
        for (int ai = 0; ai < 2; ++ai)
#pragma unroll
            for (int m = 0; m < 4; ++m) gt[ai][m] = 16.0f * rowg[row0 + ai * HALF + m * 16];
#pragma unroll
        for (int bj = 0; bj < 2; ++bj) { const f32x4 b0 = *(const f32x4*)(bb + bj * HALF), b1 = *(const f32x4*)(bb + bj * HALF + 4);
#pragma unroll
            for (int ai = 0; ai < 2; ++ai)
#pragma unroll
                for (int m = 0; m < 4; ++m) { const int row = row0 + ai * HALF + m * 16; const f32x4 v0 = (acc[ai][bj][m][0] + b0) * gt[ai][m], v1 = (acc[ai][bj][m][1] + b1) * gt[ai][m];
                    int w0 = 0, w1 = 0; w0 = __builtin_amdgcn_cvt_pk_fp8_f32(v0[0], v0[1], w0, false); w0 = __builtin_amdgcn_cvt_pk_fp8_f32(v0[2], v0[3], w0, true); w1 = __builtin_amdgcn_cvt_pk_fp8_f32(v1[0], v1[1], w1, false); w1 = __builtin_amdgcn_cvt_pk_fp8_f32(v1[2], v1[3], w1, true);
                    typedef unsigned u32x2 __attribute__((ext_vector_type(2))); *(u32x2*)(O + (size_t)row * 2048 + col0 + bj * HALF) = (u32x2){(unsigned)w0, (unsigned)w1}; } }
    }
};
template <bool GATHER_, bool IDENT_ = false> struct MoeOrderT {
    static constexpr bool GATHER = GATHER_, IDENT = IDENT_;
    int c, nblk; const char* A; const char* Bt; size_t a_tstep, b_estep, b_tstep; const PG8_LAS int* blk_end; const int* row_tab;
    __device__ __forceinline__ bool next(int i, Unit& u) const {
#if defined(MOE_MAP) && MOE_MAP == 1
        const int L = i * 256 + c, rb = L >> 3, j = (L & 7);
#elif defined(MOE_MAP) && MOE_MAP == 2
        const int x = c & 7, jj = c >> 3, gi = i * 8 + x, rb = 8 * (gi >> 1) + (jj >> 2), j = (jj & 3) + 4 * (gi & 1);
#else
        const int x = c & 7, j = c >> 3, gi = i * 8 + x, rb = 4 * gi + (j >> 3);
#endif
        if (rb >= nblk) return false;
        int e = 0;
        for (int k = 0; k < 31; ++k) e += (rb >= blk_end[k]) ? 1 : 0;
        u.pm = rb; u.pn = j & 7; u.e = __builtin_amdgcn_readfirstlane(e); return true;
    }
    __device__ __forceinline__ const char* a_ptr(const Unit& u) const { return GATHER ? A : A + (size_t)u.pm * a_tstep; }
    __device__ __forceinline__ const char* b_ptr(const Unit& u) const { return Bt + (size_t)u.e * b_estep + (size_t)u.pn * b_tstep; }
    __device__ __forceinline__ void a_ready(const Unit&) const {}
    __device__ __forceinline__ void done(const Unit&) const {}
};
typedef MoeOrderT<false> MoeOrder;
typedef MoeOrderT<true> MoeOrderG;
typedef MoeOrderT<true, true> MoeOrderI;
template <class Epi, class Sched, bool ALIGN_EPI = false, bool SP2 = false, bool FP8 = false, bool I8 = false>
__device__ __forceinline__ void gemm_phase(PG8_LAS unsigned char* lds, const Gemm g, const Sched& S, const Epi& E) {
    int tid = threadIdx.x; asm volatile("" : "+v"(tid));
    const int wid = __builtin_amdgcn_readfirstlane(tid >> 6), lane = tid & 63, wr = wid >> 2, wc = wid & 3, fr = lane & 15, fq = lane >> 4;
    const int K = g.K, nt = K / BK;
    unsigned voffA[2], voffB[2];
#pragma unroll
    for (int i = 0; i < 2; ++i) { int R, C; stage_rc(tid * 16 + i * 8192, R, C); const int Rb = Epi::PERM ? ((R & ~31) + perm32(R & 31)) : R;
        voffA[i] = (unsigned)(R * K + C) * 2u; voffB[i] = (unsigned)(Rb * K + C) * 2u; }
    unsigned gc0[2] = {0u, 0u}, gc1[2] = {0u, 0u}; int gR = 0, gC = 0;
    if constexpr (Sched::GATHER) { stage_rc(tid * 16, gR, gC); }
#define PG8_GLOAD(dst0, dst1, u) do { if constexpr (Sched::IDENT) { const unsigned _r0 = (unsigned)((u).pm * BM + gR);     \
        dst0[0] = _r0 * (unsigned)(K * 2) + (unsigned)(gC * 2); dst0[1] = (_r0 + 64u) * (unsigned)(K * 2) + (unsigned)(gC * 2); dst1[0] = (_r0 + 128u) * (unsigned)(K * 2) + (unsigned)(gC * 2); dst1[1] = (_r0 + 192u) * (unsigned)(K * 2) + (unsigned)(gC * 2); } \
      else { const int* _rt = S.row_tab + (size_t)(u).pm * BM + gR; \
        dst0[0] = (unsigned)_rt[0] * (unsigned)(K * 2) + (unsigned)(gC * 2); dst0[1] = (unsigned)_rt[64] * (unsigned)(K * 2) + (unsigned)(gC * 2); \
        dst1[0] = (unsigned)_rt[128] * (unsigned)(K * 2) + (unsigned)(gC * 2); dst1[1] = (unsigned)_rt[192] * (unsigned)(K * 2) + (unsigned)(gC * 2); } } while (0)
    const size_t kstep = (size_t)(BK * 2);
    const size_t hstep = (size_t)HALF * K * 2;
    const size_t tstep = 2 * hstep;
    const unsigned ldsw = (unsigned)wid * 1024u;
    const int aoff = lds_byte(wr * 64 + fr, fq * 8); int boff = lds_byte(wc * 32 + fr, fq * 8) + 4 * HTB;
    asm volatile("" : "+v"(boff));
#define PG8_SA(b, h) (((b) * 2 + (h)) * HTB)
#define PG8_SB(b, h) ((4 + (b) * 2 + (h)) * HTB)
#define PG8_SBR(b, h) (((b) * 2 + (h)) * HTB)
#define PG8_STAGE(bufoff, gbase, voff) do { _Pragma("unroll") for (int _i = 0; _i < 2; ++_i) \
        __builtin_amdgcn_global_load_lds((const unsigned*)((const char*)(gbase) + (voff)[_i]), (PG8_LAS unsigned*)(lds + (bufoff) + ldsw + _i * 8192), 16, 0, 0); } while (0)
#define PG8_LD16(off) (*(const PG8_LAS v4i_t*)(lds + (off)))
#define PG8_LDA(dst, b, h) do { if constexpr (FP8) { _Pragma("unroll") for (int m = 0; m < 4; ++m) dst##8[m] = __builtin_shufflevector(PG8_LD16(PG8_SA(b, h) + aoff + m * 2048), PG8_LD16(PG8_SA(b, h) + aoff + m * 2048 + 1024), 0, 1, 2, 3, 4, 5, 6, 7); } \
        else { _Pragma("unroll") for (int m = 0; m < 4; ++m) _Pragma("unroll") for (int k = 0; k < 2; ++k) dst[m][k] = *(const PG8_LAS bf16x8*)(lds + PG8_SA(b, h) + aoff + m * 2048 + k * 1024); } } while (0)
#define PG8_LDB(dst, b, h) do { if constexpr (FP8) { _Pragma("unroll") for (int n = 0; n < 2; ++n) dst##8[n] = __builtin_shufflevector(PG8_LD16(PG8_SBR(b, h) + boff + n * 2048), PG8_LD16(PG8_SBR(b, h) + boff + n * 2048 + 1024), 0, 1, 2, 3, 4, 5, 6, 7); } \
        else { _Pragma("unroll") for (int n = 0; n < 2; ++n) _Pragma("unroll") for (int k = 0; k < 2; ++k) dst[n][k] = *(const PG8_LAS bf16x8*)(lds + PG8_SBR(b, h) + boff + n * 2048 + k * 1024); } } while (0)
#define PG8_MMA(ai, bj, At, Bt) do { __builtin_amdgcn_s_setprio(1); \
        if constexpr (FP8) { _Pragma("unroll") for (int m = 0; m < 4; ++m) _Pragma("unroll") for (int n = 0; n < 2; ++n) \
            acc[ai][bj][m][n] = __builtin_amdgcn_mfma_scale_f32_16x16x128_f8f6f4(Bt##8[n], At##8[m], acc[ai][bj][m][n], 0, 0, 0, g.bscale, 0, g.bscale); }     \
        else if constexpr (I8) { _Pragma("unroll") for (int m = 0; m < 4; ++m) _Pragma("unroll") for (int n = 0; n < 2; ++n) _Pragma("unroll") for (int k = 0; k < 2; ++k) \
            acc[ai][bj][m][n] = __builtin_bit_cast(f32x4, __builtin_amdgcn_mfma_i32_16x16x64_i8(__builtin_bit_cast(v4i_t, Bt[n][k]), __builtin_bit_cast(v4i_t, At[m][k]), __builtin_bit_cast(v4i_t, acc[ai][bj][m][n]), 0, 0, 0)); } \
        else { _Pragma("unroll") for (int m = 0; m < 4; ++m) _Pragma("unroll") for (int n = 0; n < 2; ++n) _Pragma("unroll") for (int k = 0; k < 2; ++k) \
            acc[ai][bj][m][n] = __builtin_amdgcn_mfma_f32_16x16x32_bf16(Bt[n][k], At[m][k], acc[ai][bj][m][n], 0, 0, 0); } \
        __builtin_amdgcn_s_setprio(0); } while (0)
#define PG8_WAIT_V(n) asm volatile("s_waitcnt vmcnt(" #n ")" ::: "memory")
#define PG8_WAIT_L(n) asm volatile("s_waitcnt lgkmcnt(" #n ")" ::: "memory")
#define PG8_BAR __builtin_amdgcn_s_barrier()
#define PG8_SCHED __builtin_amdgcn_sched_barrier(0)
    Unit cur, nxt; int ui = 0;
    if (!S.next(0, cur)) return;
    f32x4 acc[2][2][4][2];
#pragma unroll
    for (int a = 0; a < 2; ++a)
#pragma unroll
        for (int b = 0; b < 2; ++b)
#pragma unroll
            for (int m = 0; m < 4; ++m)
#pragma unroll
                for (int n = 0; n < 2; ++n) acc[a][b][m][n] = (f32x4){0.f, 0.f, 0.f, 0.f};
    bf16x8 At[4][2], B0[2][2], B1[2][2]; v8i_t At8[4], B08[2], B18[2];
    const char* cA = S.a_ptr(cur); const char* cB = S.b_ptr(cur);
    S.a_ready(cur);
    if constexpr (SP2) {
        if constexpr (Sched::GATHER) { PG8_GLOAD(gc0, gc1, cur);
        PG8_STAGE(PG8_SB(0, 0), cB, voffB); PG8_STAGE(PG8_SB(0, 1), cB + hstep, voffB); PG8_STAGE(PG8_SA(0, 0), cA, gc0); PG8_STAGE(PG8_SA(0, 1), cA, gc1);
        if (wr == 1) PG8_BAR;
        PG8_WAIT_V(2); PG8_BAR;
        PG8_STAGE(PG8_SB(1, 0), cB + kstep, voffB); PG8_STAGE(PG8_SA(1, 0), cA + kstep, gc0); PG8_STAGE(PG8_SB(1, 1), cB + hstep + kstep, voffB);
        } else {
        PG8_STAGE(PG8_SB(0, 0), cB, voffB); PG8_STAGE(PG8_SB(0, 1), cB + hstep, voffB); PG8_STAGE(PG8_SA(0, 0), cA, voffA); PG8_STAGE(PG8_SA(0, 1), cA + hstep, voffA);
        if (wr == 1) PG8_BAR;
        PG8_WAIT_V(2); PG8_BAR;
        PG8_STAGE(PG8_SB(1, 0), cB + kstep, voffB); PG8_STAGE(PG8_SA(1, 0), cA + kstep, voffA); PG8_STAGE(PG8_SB(1, 1), cB + hstep + kstep, voffB);
        }
        PG8_WAIT_V(6); PG8_BAR;
    } else {
        PG8_STAGE(PG8_SB(0, 0), cB, voffB); PG8_STAGE(PG8_SA(0, 0), cA, voffA); PG8_STAGE(PG8_SB(0, 1), cB + hstep, voffB); PG8_STAGE(PG8_SA(0, 1), cA + hstep, voffA);
        if (wr == 1) PG8_BAR;
        PG8_WAIT_V(4); PG8_BAR;
        PG8_STAGE(PG8_SB(1, 0), cB + kstep, voffB); PG8_STAGE(PG8_SA(1, 0), cA + kstep, voffA); PG8_STAGE(PG8_SB(1, 1), cB + hstep + kstep, voffB);
        PG8_WAIT_V(6); PG8_BAR;
    }
    for (;;) {
        const bool has_next = S.next(ui + 1, nxt);
        const char* nA = has_next ? S.a_ptr(nxt) : cA; const char* nB = has_next ? S.b_ptr(nxt) : cB;
#pragma unroll 1
        for (int t = 0; t < nt; t += 2) {
            const bool last = (t == nt - 2);
            const char* a1 = cA + (size_t)(t + 1) * kstep;
            const char* a2 = last ? nA : cA + (size_t)(t + 2) * kstep; const char* b2 = last ? nB : cB + (size_t)(t + 2) * kstep;
            const char* a3 = a2 + kstep; const char* b3 = b2 + kstep;
            if (last && has_next) S.a_ready(nxt);

            if constexpr (SP2) {
            PG8_LDB(B0, 0, 0); PG8_LDB(B1, 0, 1); PG8_SCHED; PG8_LDA(At, 0, 0); if constexpr (Sched::GATHER) PG8_STAGE(PG8_SA(1, 1), a1, gc1); else PG8_STAGE(PG8_SA(1, 1), a1 + hstep, voffA);
            if constexpr (Sched::GATHER) { if (last && has_next) PG8_GLOAD(gc0, gc1, nxt); }
            PG8_WAIT_V(8); PG8_WAIT_L(0); PG8_BAR; PG8_MMA(0, 0, At, B0); PG8_MMA(0, 1, At, B1); PG8_BAR; PG8_SCHED;
            PG8_LDA(At, 0, 1); PG8_STAGE(PG8_SB(0, 0), b2, voffB); PG8_STAGE(PG8_SB(0, 1), b2 + hstep, voffB); if constexpr (Sched::GATHER) PG8_STAGE(PG8_SA(0, 0), a2, gc0); else PG8_STAGE(PG8_SA(0, 0), a2, voffA);
            PG8_WAIT_V(8); PG8_WAIT_L(0); PG8_BAR; PG8_MMA(1, 0, At, B0); PG8_MMA(1, 1, At, B1); PG8_BAR; PG8_SCHED;
            PG8_LDB(B0, 1, 0); PG8_LDB(B1, 1, 1); PG8_SCHED; PG8_LDA(At, 1, 0); if constexpr (Sched::GATHER) PG8_STAGE(PG8_SA(0, 1), a2, gc1); else PG8_STAGE(PG8_SA(0, 1), a2 + hstep, voffA);
            PG8_WAIT_V(8); PG8_WAIT_L(0); PG8_BAR; PG8_MMA(0, 0, At, B0); PG8_MMA(0, 1, At, B1); PG8_BAR; PG8_SCHED;
            PG8_LDA(At, 1, 1); PG8_STAGE(PG8_SB(1, 0), b3, voffB); PG8_STAGE(PG8_SB(1, 1), b3 + hstep, voffB); if constexpr (Sched::GATHER) PG8_STAGE(PG8_SA(1, 0), a3, gc0); else PG8_STAGE(PG8_SA(1, 0), a3, voffA);
            PG8_WAIT_V(8); PG8_WAIT_L(0); PG8_BAR; PG8_MMA(1, 0, At, B0); PG8_MMA(1, 1, At, B1); PG8_BAR; PG8_SCHED;
            } else {
            PG8_LDB(B0, 0, 0); PG8_SCHED; PG8_LDA(At, 0, 0); PG8_STAGE(PG8_SA(1, 1), a1 + hstep, voffA);
            PG8_WAIT_L(8); PG8_BAR; PG8_WAIT_L(0); PG8_MMA(0, 0, At, B0); PG8_BAR; PG8_SCHED;
            PG8_LDB(B1, 0, 1); PG8_STAGE(PG8_SB(0, 0), b2, voffB);
            PG8_BAR; PG8_WAIT_L(0); PG8_MMA(0, 1, At, B1); PG8_BAR;
            PG8_LDA(At, 0, 1); PG8_STAGE(PG8_SA(0, 0), a2, voffA);
            PG8_BAR; PG8_WAIT_L(0); PG8_MMA(1, 0, At, B0); PG8_BAR; PG8_SCHED;
            PG8_STAGE(PG8_SB(0, 1), b2 + hstep, voffB);
            PG8_WAIT_V(6); PG8_BAR; PG8_MMA(1, 1, At, B1); PG8_BAR;
            PG8_LDB(B0, 1, 0); PG8_SCHED; PG8_LDA(At, 1, 0); PG8_STAGE(PG8_SA(0, 1), a2 + hstep, voffA);
            PG8_WAIT_L(8); PG8_BAR; PG8_WAIT_L(0); PG8_MMA(0, 0, At, B0); PG8_BAR; PG8_SCHED;
            PG8_LDB(B1, 1, 1); PG8_STAGE(PG8_SB(1, 0), b3, voffB);
            PG8_BAR; PG8_WAIT_L(0); PG8_MMA(0, 1, At, B1); PG8_BAR;
            PG8_LDA(At, 1, 1); PG8_STAGE(PG8_SA(1, 0), a3, voffA);
            PG8_BAR; PG8_WAIT_L(0); PG8_MMA(1, 0, At, B0); PG8_BAR; PG8_SCHED;
            PG8_STAGE(PG8_SB(1, 1), b3 + hstep, voffB);
            PG8_WAIT_V(6); PG8_BAR; PG8_MMA(1, 1, At, B1); PG8_BAR;
            }
        }
        if constexpr (ALIGN_EPI) { if (wr == 0) PG8_BAR; }
        if constexpr (!Epi::AFTER_DRAIN) { int fr_e = fr, fq_e = fq; asm volatile("" : "+v"(fr_e), "+v"(fq_e));
            E(acc, cur, wr, wc, fr_e, fq_e); S.done(cur); }
        if (!has_next) break;
#pragma unroll
        for (int a = 0; a < 2; ++a)
#pragma unroll
            for (int b = 0; b < 2; ++b)
#pragma unroll
                for (int m = 0; m < 4; ++m)
#pragma unroll
                    for (int n = 0; n < 2; ++n) acc[a][b][m][n] = (f32x4){0.f, 0.f, 0.f, 0.f};
        cur = nxt; cA = nA; cB = nB; ++ui;
        if constexpr (ALIGN_EPI) { if (wr == 1) PG8_BAR; }
    }
    PG8_WAIT_V(0);
    if constexpr (!ALIGN_EPI) { if (wr == 0) PG8_BAR; }
    PG8_BAR;
    if constexpr (Epi::AFTER_DRAIN) { E.fused(acc, cur, wr, wc, fr, fq, lds, wid, lane); S.done(cur); }
#undef PG8_GLOAD
#undef PG8_SA
#undef PG8_SB
#undef PG8_SBR
#undef PG8_STAGE
#undef PG8_LDA
#undef PG8_LDB
#undef PG8_MMA
#undef PG8_LD16
#undef PG8_WAIT_V
#undef PG8_WAIT_L
#undef PG8_BAR
#undef PG8_SCHED
}
}

constexpr size_t MiB = 1u << 20;
constexpr size_t WS_CTL = 0, CTL_ZERO_BYTES = 1 * MiB;
constexpr size_t WS_MOD  = 1 * MiB;
constexpr size_t WS_WRT  = 2 * MiB;
constexpr size_t WS_MOEI = 3 * MiB;
constexpr size_t WS_IDT  = WS_MOEI + 5 * 512 * 1024;
constexpr size_t WS_LRC  = 6 * MiB;
constexpr size_t WS_DNS  = 12 * MiB;
constexpr size_t WS_RS   = WS_DNS + 2 * MiB;
constexpr size_t WS_CS   = WS_DNS + 3 * MiB;
constexpr size_t WS_WIN  = 16 * MiB;
constexpr size_t WS_WOUT = 56 * MiB;
constexpr size_t WS_WGU  = 72 * MiB;
constexpr size_t WS_WDN  = 584 * MiB;
constexpr size_t WS_X    = 840 * MiB;
constexpr size_t WS_H    = 976 * MiB;
constexpr size_t WS_P    = 1044 * MiB;
constexpr size_t WS_CC   = 1206 * MiB;
constexpr size_t WS_VT   = 1274 * MiB;
constexpr size_t WS_VTC  = WS_VT + 8 * MiB;
constexpr size_t WS_DNT  = 1284 * MiB;
constexpr size_t DNT_BYTES = 90112;
constexpr size_t WS_DNO  = 1472 * MiB;
constexpr size_t WS_LRH  = 1540 * MiB;
constexpr size_t WS_LRA  = 1608 * MiB;
constexpr size_t WS_XS   = 1676 * MiB;
constexpr size_t WS_ACT  = 1980 * MiB;
constexpr size_t WS_YS   = 2132 * MiB;
constexpr size_t WS_END  = 2436 * MiB;
constexpr int CW_TMO = 0;
constexpr int CW_BAR = 4096;
constexpr int CW_CNT = 8192;
constexpr int CW_CMAX = 32768;
constexpr int CW_ATQ = 12288;

constexpr int RING_OFF = 0, RING_BYTES = 131072;
constexpr int LDSCTL_OFF = RING_BYTES, MISC_OFF = LDSCTL_OFF + 320;
constexpr int LDS_X_OFF = RING_BYTES + 1024;
constexpr int LDS_BYTES = 147456;
constexpr int NWAVES = 8, NTHREADS = 512;

#define GAS __attribute__((address_space(1)))
#define LAS __attribute__((address_space(3)))
typedef unsigned short bf16;
typedef unsigned v4u __attribute__((ext_vector_type(4)));
typedef unsigned v2u __attribute__((ext_vector_type(2)));
typedef float f32x4 __attribute__((ext_vector_type(4)));
typedef float f32x16 __attribute__((ext_vector_type(16)));
typedef short bf16x8 __attribute__((ext_vector_type(8)));
typedef short bf16x4 __attribute__((ext_vector_type(4)));
typedef GAS unsigned gu32;
#define RLX_AGENT __ATOMIC_RELAXED, __HIP_MEMORY_SCOPE_AGENT
#define LDS_WAIT() asm volatile("s_waitcnt lgkmcnt(0)" ::: "memory")
#define VM_WAIT() asm volatile("s_waitcnt vmcnt(0)" ::: "memory")
#define LDS_BARRIER() asm volatile("s_waitcnt lgkmcnt(0)\n\ts_barrier" ::: "memory")
typedef __bf16 bf16x2_t __attribute__((ext_vector_type(2)));
typedef float f32x2_t __attribute__((ext_vector_type(2)));
__device__ __forceinline__ unsigned pk2(float lo, float hi) { const f32x2_t v = {lo, hi}; const bf16x2_t b = __builtin_convertvector(v, bf16x2_t); return __builtin_bit_cast(unsigned, b); }
__device__ __forceinline__ unsigned f2bf(float f) { return pk2(f, 0.f) & 0xffffu; }
__device__ __forceinline__ unsigned pk4_fp8(float a, float b, float c, float d) { int x = 0; x = __builtin_amdgcn_cvt_pk_fp8_f32(a, b, x, false); x = __builtin_amdgcn_cvt_pk_fp8_f32(c, d, x, true); return (unsigned)x; }
__device__ __forceinline__ float bf2f(unsigned short b) { return __builtin_bit_cast(float, (unsigned)b << 16); }
__device__ __forceinline__ float bflo(unsigned w) { return __builtin_bit_cast(float, w << 16); }
__device__ __forceinline__ float bfhi(unsigned w) { return __builtin_bit_cast(float, w & 0xffff0000u); }
template <int CTRL> __device__ __forceinline__ float dpp_mov(float v) { return __builtin_bit_cast(float, __builtin_amdgcn_update_dpp(0, __builtin_bit_cast(int, v), CTRL, 0xF, 0xF, false)); }
__device__ __forceinline__ float wave_sum(float v) {
    v += dpp_mov<0xB1>(v); v += dpp_mov<0x4E>(v); v += dpp_mov<0x141>(v); v += dpp_mov<0x140>(v);
    const int iv = __builtin_bit_cast(int, v);
    const float r0 = __builtin_bit_cast(float, __builtin_amdgcn_readlane(iv, 0)), r1 = __builtin_bit_cast(float, __builtin_amdgcn_readlane(iv, 16)), r2 = __builtin_bit_cast(float, __builtin_amdgcn_readlane(iv, 32)), r3 = __builtin_bit_cast(float, __builtin_amdgcn_readlane(iv, 48));
    return (r0 + r1) + (r2 + r3);
}
__device__ __forceinline__ float wave_max(float v) {
    v = fmaxf(v, dpp_mov<0xB1>(v)); v = fmaxf(v, dpp_mov<0x4E>(v)); v = fmaxf(v, dpp_mov<0x141>(v)); v = fmaxf(v, dpp_mov<0x140>(v));
    const int iv = __builtin_bit_cast(int, v);
    const float r0 = __builtin_bit_cast(float, __builtin_amdgcn_readlane(iv, 0)), r1 = __builtin_bit_cast(float, __builtin_amdgcn_readlane(iv, 16)), r2 = __builtin_bit_cast(float, __builtin_amdgcn_readlane(iv, 32)), r3 = __builtin_bit_cast(float, __builtin_amdgcn_readlane(iv, 48));
    return fmaxf(fmaxf(r0, r1), fmaxf(r2, r3));
}
__device__ __forceinline__ unsigned pk4_i8(float a, float b, float c, float d) {
    const int ia = (int)__builtin_rintf(a), ib = (int)__builtin_rintf(b), ic = (int)__builtin_rintf(c), id = (int)__builtin_rintf(d);
    return (unsigned)(ia & 255) | ((unsigned)(ib & 255) << 8) | ((unsigned)(ic & 255) << 16) | ((unsigned)id << 24);
}
__device__ __forceinline__ float sigmoidf_(float x) { return __builtin_amdgcn_rcpf(1.0f + __builtin_amdgcn_exp2f(-1.4426950408889634f * x)); }
__device__ __forceinline__ float siluf_(float x) { return x * sigmoidf_(x); }
__device__ __forceinline__ float softplusf_(float x) { return x > 20.f ? x : log1pf(__expf(x)); }

#define XB_TMO      128
#define XB_XCNT(j)  (256  + 64 * (j))
#define XB_XSUB(j)  (1280 + 64 * (j))
#define XB_XGEN(j)  (2304 + 64 * (j))
#define XB_TOP      3328
#define XB_TOPGEN   3392
#define XCD_BAR_WORDS 3456
#define XB_SPIN_CAP (1u << 18)

__device__ __forceinline__ unsigned xb_ld(unsigned* p)              { return __hip_atomic_load(p, __ATOMIC_RELAXED, __HIP_MEMORY_SCOPE_AGENT); }
__device__ __forceinline__ unsigned xb_add(unsigned* p, unsigned v) { return __hip_atomic_fetch_add(p, v, __ATOMIC_RELAXED, __HIP_MEMORY_SCOPE_AGENT); }
__device__ __forceinline__ unsigned xb_xcc_id() { return (unsigned)__builtin_amdgcn_s_getreg((3 << 11) | 20) & 0xFu; }
#define XB_SPIN(cond, bar) do { unsigned _sp = 0; while (cond) { __builtin_amdgcn_s_sleep(1); \
    if ((++_sp & 255u) == 0u) { if (xb_ld(&(bar)[XB_TMO])) break; if (_sp > XB_SPIN_CAP) { atomicAdd(&(bar)[XB_TMO], 1u); break; } } } } while (0)

struct XcdBarrier {
    unsigned* bar; unsigned x;
    volatile LAS unsigned* st;
};

__device__ __forceinline__ XcdBarrier xcd_barrier_post(unsigned* bar, volatile LAS unsigned* st) {
    XcdBarrier b; b.bar = bar; b.x = xb_xcc_id(); b.st = st;
    if (threadIdx.x == 0) (void)xb_add(&bar[XB_XCNT(b.x)], 1u);
    return b;
}
__device__ __forceinline__ void xcd_barrier_complete(unsigned* bar, unsigned x, unsigned& nloc, unsigned& nx) {
    const unsigned G = gridDim.x * gridDim.y * gridDim.z;
    unsigned sum, cnt, mine, sp = 0u;
    for (;;) {
        sum = 0u; cnt = 0u; mine = 0u;
#pragma unroll
        for (unsigned j = 0; j < 16; ++j) { const unsigned c = xb_ld(&bar[XB_XCNT(j)]); sum += c; cnt += (c > 0u) ? 1u : 0u; mine = (j == x) ? c : mine; }
        if (sum == G) break;
        __builtin_amdgcn_s_sleep(1);
        if ((++sp & 255u) == 0u) { if (xb_ld(&bar[XB_TMO])) break; if (sp > XB_SPIN_CAP) { atomicAdd(&bar[XB_TMO], 1u); break; } }
    }
    nloc = mine > 0u ? mine : 1u; nx = cnt > 0u ? cnt : 1u;
}

__device__ __forceinline__ void xcd_barrier(const XcdBarrier& b) {
    asm volatile("s_waitcnt vmcnt(0)" ::: "memory");
    __syncthreads();
    if (threadIdx.x == 0) {
        unsigned* bar = b.bar;
        __builtin_amdgcn_s_waitcnt(0);
        unsigned nloc = b.st[0], nx = b.st[1];
        if (nloc == 0u) { xcd_barrier_complete(bar, b.x, nloc, nx); b.st[0] = nloc; b.st[1] = nx; }
        const unsigned old = xb_add(&bar[XB_XSUB(b.x)], 1u);
        const unsigned gen = old / nloc;
        if (old + 1u == (gen + 1u) * nloc) {
            __builtin_amdgcn_fence(__ATOMIC_RELEASE, "agent");
            asm volatile("s_waitcnt vmcnt(0)" ::: "memory");
            const unsigned og = xb_add(&bar[XB_TOP], 1u);
            const unsigned tg = og / nx;
            if (og + 1u == (tg + 1u) * nx) xb_add(&bar[XB_TOPGEN], 1u);
            else XB_SPIN(xb_ld(&bar[XB_TOPGEN]) == tg, bar);
            __builtin_amdgcn_fence(__ATOMIC_ACQUIRE, "agent");
            xb_add(&bar[XB_XGEN(b.x)], 1u);
            asm volatile("s_waitcnt vmcnt(0)" ::: "memory");
        } else {
            XB_SPIN(xb_ld(&bar[XB_XGEN(b.x)]) == gen, bar);
            __builtin_amdgcn_fence(__ATOMIC_ACQUIRE, "agent");
            asm volatile("s_waitcnt vmcnt(0)" ::: "memory");
        }
    }
    __syncthreads();
}

enum InIdx { I_X = 0, I_C, I_CTX, I_CCTX, I_WMOD, I_BMOD, I_NMG, I_NFG, I_WIN, I_WOUT, I_SINK, I_DNCW, I_DNALOG, I_DNDT, I_DNNG, I_LRCW, I_LRCB, I_LRWR, I_LRBR, I_LRWI, I_LRBI, I_LRLAM,
             I_WROUT, I_BROUT, I_WGU, I_BGU, I_WDN, I_BDN, I_FNG, N_IN };
struct Frame {
    LAS unsigned char* lds;
    volatile LAS unsigned* MISC;
    gu32* ctl;
    int tid, lane, wave, G, bid;
    const float* const __attribute__((address_space(4)))* in;
    float* out; unsigned char* ws;
};
__device__ __forceinline__ int mod_row(int m) { return m < NLAT ? (m >> 12) : 4; }
__device__ __forceinline__ bool phase_enter(Frame& F) { int t = threadIdx.x; asm volatile("" : "+v"(t)); F.tid = t; F.lane = t & 63; F.wave = __builtin_amdgcn_readfirstlane(t >> 6); return true; }
__device__ __forceinline__ void seq_of(int m, int& t, int& T, int& base) { if (m < NLAT) { t = m & 4095; T = SEQ; base = m - t; } else { t = (m - NLAT) & 255; T = CTXL; base = m - t; } }
__device__ __forceinline__ float gelu_tanh(float x) { const float u = 0.7978845608028654f * (x + 0.044715f * x * x * x); return x * sigmoidf_(2.0f * u); }

__device__ __forceinline__ void transpose_item(const float* W, int K, int N, bf16* WT, int k0, int dstrow0, int srccol0, int nvalid, LAS float* scr, int lane) {
    { const int c4 = (lane & 7) * 4, kr = lane >> 3; f32x4 v[8];
#pragma unroll
      for (int i = 0; i < 8; ++i) { v[i] = (f32x4){0.f, 0.f, 0.f, 0.f}; if (c4 < nvalid) v[i] = __builtin_nontemporal_load((const f32x4*)(W + (size_t)(k0 + 8 * i + kr) * N + srccol0 + c4)); }
#pragma unroll
      for (int i = 0; i < 8; ++i) { LAS float* d = scr + (8 * i + kr) * 33 + c4; d[0] = v[i].x; d[1] = v[i].y; d[2] = v[i].z; d[3] = v[i].w; } }
    LDS_WAIT(); asm volatile("" ::: "memory");
    const int c = lane & 7;
#pragma unroll
    for (int jj = 0; jj < 4; ++jj) { const int n = (lane >> 3) + 8 * jj; const LAS float* s = scr + (8 * c) * 33 + n;
        v4u o; o.x = pk2(s[0 * 33], s[1 * 33]); o.y = pk2(s[2 * 33], s[3 * 33]); o.z = pk2(s[4 * 33], s[5 * 33]); o.w = pk2(s[6 * 33], s[7 * 33]);
        *(GAS v4u*)(WT + (size_t)(dstrow0 + n) * K + k0 + 8 * c) = o; }
    LDS_WAIT(); asm volatile("" ::: "memory");
}
__device__ __forceinline__ void transpose_item_f8(const float* W, int K, int N, unsigned char* WT, int k0, int dstrow0, int srccol0, float scale, LAS float* scr, int lane) {
    { const int c4 = (lane & 7) * 4, kr = lane >> 3; f32x4 v[8];
#pragma unroll
      for (int i = 0; i < 8; ++i) v[i] = __builtin_nontemporal_load((const f32x4*)(W + (size_t)(k0 + 8 * i + kr) * N + srccol0 + c4));
#pragma unroll
      for (int i = 0; i < 8; ++i) { LAS float* d = scr + (8 * i + kr) * 33 + c4; d[0] = v[i].x; d[1] = v[i].y; d[2] = v[i].z; d[3] = v[i].w; } }
    LDS_WAIT(); asm volatile("" ::: "memory");
    { const int n = lane >> 1, hf = lane & 1; const LAS float* s = scr + (32 * hf) * 33 + n; unsigned w[8];
#pragma unroll
      for (int i = 0; i < 8; ++i) { int x = 0; x = __builtin_amdgcn_cvt_pk_fp8_f32(s[(4 * i + 0) * 33] * scale, s[(4 * i + 1) * 33] * scale, x, false); x = __builtin_amdgcn_cvt_pk_fp8_f32(s[(4 * i + 2) * 33] * scale, s[(4 * i + 3) * 33] * scale, x, true); w[i] = (unsigned)x; }
      v4u* o = (v4u*)(WT + (size_t)(dstrow0 + n) * K + k0 + 32 * hf); __builtin_nontemporal_store((v4u){w[0], w[1], w[2], w[3]}, o); __builtin_nontemporal_store((v4u){w[4], w[5], w[6], w[7]}, o + 1); }
    LDS_WAIT(); asm volatile("" ::: "memory");
}
__device__ __forceinline__ void transpose_item_i8(const float* W, int K, int N, unsigned char* WT, int k0, int dstrow0, int srccol0, const gu32* cmax, float* cs, LAS float* scr, int lane) {
    { const int c4 = (lane & 7) * 4, kr = lane >> 3; f32x4 v[8];
#pragma unroll
      for (int i = 0; i < 8; ++i) v[i] = *(const f32x4*)(W + (size_t)(k0 + 8 * i + kr) * N + srccol0 + c4);
#pragma unroll
      for (int i = 0; i < 8; ++i) { LAS float* d = scr + (8 * i + kr) * 33 + c4; d[0] = v[i].x; d[1] = v[i].y; d[2] = v[i].z; d[3] = v[i].w; } }
    LDS_WAIT(); asm volatile("" ::: "memory");
    { const int n = lane >> 1, hf = lane & 1; const LAS float* sp = scr + (32 * hf) * 33 + n; unsigned w[8];
      const float sc = cs[dstrow0 + n]; const float inv = sc > 0.f ? 1.0f / sc : 0.f;
#pragma unroll
      for (int i = 0; i < 8; ++i) w[i] = pk4_i8(sp[(4 * i + 0) * 33] * inv, sp[(4 * i + 1) * 33] * inv, sp[(4 * i + 2) * 33] * inv, sp[(4 * i + 3) * 33] * inv);
      GAS v4u* o = (GAS v4u*)(WT + (size_t)(dstrow0 + n) * K + k0 + 32 * hf); o[0] = (v4u){w[0], w[1], w[2], w[3]}; o[1] = (v4u){w[4], w[5], w[6], w[7]}; }
    LDS_WAIT(); asm volatile("" ::: "memory");
}
__device__ __forceinline__ void p0_prologue_a(Frame& F) {
    {
        LAS float* sc = (LAS float*)(F.lds);
        LAS float* red = (LAS float*)(F.lds + 40960);
        bool have_sc = false;
        for (int wb = F.bid; wb < 192; wb += F.G) {
            if (!have_sc) {
                for (int i = F.tid; i < 5 * 2048; i += NTHREADS) { const int r = i >> 11, k = i & 2047; const float cv = r < 4 ? F.in[I_C][r * 2048 + k] : F.in[I_CCTX][k]; sc[i] = siluf_(cv); }
                have_sc = true; __syncthreads();
            }
            const int l = wb / 96, cb = wb % 96, kp = F.tid >> 5, cg = F.tid & 31, j0 = cb * 128 + cg * 4;
            const float* wp = F.in[I_WMOD] + ((size_t)l * 2048 + kp * 128) * 12288 + j0;
            f32x4 acc[5];
#pragma unroll
            for (int r = 0; r < 5; ++r) acc[r] = (f32x4){0.f, 0.f, 0.f, 0.f};
#pragma unroll 4
            for (int k = 0; k < 128; ++k) { const f32x4 w = *(const f32x4*)(wp + (size_t)k * 12288);
#pragma unroll
                for (int r = 0; r < 5; ++r) acc[r] += sc[r * 2048 + kp * 128 + k] * w; }
#pragma unroll
            for (int r = 0; r < 5; ++r) *(LAS f32x4*)(red + (kp * 5 + r) * 128 + cg * 4) = acc[r];
            __syncthreads();
            for (int i = F.tid; i < 640; i += NTHREADS) { const int r = i >> 7, col = i & 127; float s = F.in[I_BMOD][l * 12288 + cb * 128 + col];
#pragma unroll
                for (int q = 0; q < 16; ++q) s += red[(q * 5 + r) * 128 + col];
                ((float*)(F.ws + WS_MOD))[(size_t)(l * 5 + r) * 12288 + cb * 128 + col] = s; }
            __syncthreads();
        }
        __syncthreads();
    }
#if I8_INPROJ
    {
        const int gw = F.bid * NWAVES + F.wave, NGW = F.G * NWAVES;
        for (int it = gw; it < 2 * 144; it += NGW) { const int l = it / 144, nb = it % 144, d0 = nb * 32, s0 = d0 >= 3584 ? d0 + 16 : d0;
            const float* W = F.in[I_WIN] + (size_t)l * 2048 * IN_W; const int c4 = (F.lane & 7) * 4, kr = F.lane >> 3;
            f32x4 mx = {0.f, 0.f, 0.f, 0.f};
#pragma unroll 2
            for (int sub = 0; sub < 32; ++sub) { f32x4 v[8];
#pragma unroll
                for (int i = 0; i < 8; ++i) v[i] = *(const f32x4*)(W + (size_t)(sub * 64 + 8 * i + kr) * IN_W + s0 + c4);
#pragma unroll
                for (int i = 0; i < 8; ++i) { mx.x = fmaxf(mx.x, fabsf(v[i].x)); mx.y = fmaxf(mx.y, fabsf(v[i].y)); mx.z = fmaxf(mx.z, fabsf(v[i].z)); mx.w = fmaxf(mx.w, fabsf(v[i].w)); } }
#pragma unroll
            for (int o = 8; o < 64; o <<= 1) { mx.x = fmaxf(mx.x, __shfl_xor(mx.x, o)); mx.y = fmaxf(mx.y, __shfl_xor(mx.y, o)); mx.z = fmaxf(mx.z, __shfl_xor(mx.z, o)); mx.w = fmaxf(mx.w, __shfl_xor(mx.w, o)); }
            if (kr == 0) *(f32x4*)((float*)(F.ws + WS_CS) + l * 4608 + d0 + c4) = mx * (1.0f / 127.0f);
        }
    }
#endif
}
__device__ __forceinline__ void p0_prologue_b(Frame& F) {
    { int* idt = (int*)(F.ws + WS_IDT); for (int r = F.bid * NTHREADS + F.tid; r < MOE_ROWS; r += F.G * NTHREADS) idt[r] = r; }
    {
        LAS float* scr = (LAS float*)(F.lds + F.wave * 16384);
        const int gw = F.bid * NWAVES + F.wave, NGW = F.G * NWAVES;
        constexpr int I_IN = 32 * 144, I_OUT = 32 * 64, I_RT = 32, I_16 = 32, PER_L = I_IN + I_OUT + I_RT + I_16;
        for (int it0 = gw; it0 < 2 * PER_L; it0 += NGW) {
            const int l = it0 / PER_L; int r = it0 % PER_L;
            if (r < I_IN) { const int nb = r % 144, kb = r / 144, d0 = nb * 32; int s0 = d0, nv = 32;
                if (d0 >= 3584) s0 = d0 + 16;
#if I8_INPROJ
                transpose_item_i8(F.in[I_WIN] + (size_t)l * 2048 * IN_W, 2048, IN_W, F.ws + WS_WIN + (size_t)l * PW * 2048 * 2, kb * 64, d0, s0, F.ctl + CW_CMAX + l * 4608, (float*)(F.ws + WS_CS) + l * 4608, scr, F.lane); continue; }
#elif FP8_INPROJ
                transpose_item_f8(F.in[I_WIN] + (size_t)l * 2048 * IN_W, 2048, IN_W, F.ws + WS_WIN + (size_t)l * PW * 2048 * 2, kb * 64, d0, s0, 64.0f, scr, F.lane); continue; }
#else
                transpose_item(F.in[I_WIN] + (size_t)l * 2048 * IN_W, 2048, IN_W, (bf16*)(F.ws + WS_WIN) + (size_t)l * PW * 2048, kb * 64, d0, s0, nv, scr, F.lane); continue; }
#endif
            r -= I_IN;
            if (r < I_OUT) { const int nb = r % 64, kb = r / 64;
#if FP8_OUTPROJ
                transpose_item_f8(F.in[I_WOUT] + (size_t)l * 2048 * 2048, 2048, 2048, F.ws + WS_WOUT + (size_t)l * 2048 * 2048 * 2, kb * 64, nb * 32, nb * 32, 64.0f, scr, F.lane); continue; }
#else
                transpose_item(F.in[I_WOUT] + (size_t)l * 2048 * 2048, 2048, 2048, (bf16*)(F.ws + WS_WOUT) + (size_t)l * 2048 * 2048, kb * 64, nb * 32, nb * 32, 32, scr, F.lane); continue; }
#endif
            r -= I_OUT;
            if (r < I_RT) { transpose_item(F.in[I_WROUT] + (size_t)l * 2048 * 32, 2048, 32, (bf16*)(F.ws + WS_WRT) + (size_t)l * 32 * 2048, r * 64, 0, 0, 32, scr, F.lane); continue; }
            r -= I_RT;
            transpose_item(F.in[I_WIN] + (size_t)l * 2048 * IN_W, 2048, IN_W, (bf16*)(F.ws + WS_WRT + 512 * 1024) + (size_t)l * 32 * 2048, r * 64, 0, 3584, 16, scr, F.lane);
        }
    }
}
constexpr int CW_CVQ = 12288 + 512;
#ifndef FP8_GEMM2
#define FP8_GEMM2 1
#endif
constexpr float WGU_SCALE = 64.0f, WDN_SCALE = 64.0f; constexpr int WGU_E8M0 = 0x7C7C7C7C, WDN_E8M0 = 0x7C7C7C7C;
__device__ __forceinline__ void convert_moe_item(Frame& F, int l, int r, LAS float* scr) {
    constexpr int I_GU = 32 * 32 * 64;
    if (r < I_GU) { const int e = r / 2048, q = r % 2048, nb = q % 64, kb = q / 64; const int s0 = ((nb >> 2) & 1) * 1024 + (nb >> 3) * 128 + (nb & 3) * 32;
        transpose_item_f8(F.in[I_WGU] + (size_t)(l * 32 + e) * 2048 * 2048, 2048, 2048, F.ws + WS_WGU + (size_t)(l * 32 + e) * 2048 * 2048, kb * 64, nb * 32, s0, WGU_SCALE, scr, F.lane); return; }
    r -= I_GU;
    { const int e = r / 1024, q = r % 1024, nb = q % 64, kb = q / 64;
#if FP8_GEMM2
        transpose_item_f8(F.in[I_WDN] + (size_t)(l * 32 + e) * 1024 * 2048, 1024, 2048, F.ws + WS_WDN + (size_t)(l * 32 + e) * 2048 * 1024, kb * 64, nb * 32, nb * 32, WDN_SCALE, scr, F.lane);
#else
        transpose_item(F.in[I_WDN] + (size_t)(l * 32 + e) * 1024 * 2048, 1024, 2048, (bf16*)(F.ws + WS_WDN) + (size_t)(l * 32 + e) * 2048 * 1024, kb * 64, nb * 32, nb * 32, 32, scr, F.lane);
#endif
    }
}
constexpr int CVG = 8;
__device__ __forceinline__ bool convert_grab(Frame& F, int l, int rep, LAS float* scr) {
    constexpr int NIT = 32 * 32 * 64 + 32 * 16 * 64;
    int g = 0; if (F.lane == 0) g = (int)__hip_atomic_fetch_add(F.ctl + CW_CVQ + 64 * l + 8 * rep, 1u, RLX_AGENT); g = __builtin_amdgcn_readfirstlane(g);
    if (g * CVG >= NIT) return false;
#pragma unroll 1
    for (int k = 0; k < CVG; ++k) convert_moe_item(F, l, g * CVG + k, scr);
    return true;
}
__device__ __forceinline__ void convert_moe_queue(Frame& F, int l, int rep = 0) {
    LAS float* scr = (LAS float*)(F.lds + F.wave * 16384);
    __syncthreads();
    while (convert_grab(F, l, rep, scr)) {}
    __syncthreads();
}
constexpr int CW_TAIL = 16384;
__device__ __forceinline__ void tail_fill(Frame& F, int seam, int lt) {
    LAS int* flag = (LAS int*)(F.lds + LDS_X_OFF + 768);
    LAS float* scr = (LAS float*)(F.lds + F.wave * 16384);
    __syncthreads();
    if (F.tid == 0) (void)__hip_atomic_fetch_add(F.ctl + CW_TAIL + 64 * seam, 1u, RLX_AGENT);
    bool more = true;
    for (int it = 0; it < 4096; ++it) {
        if (F.tid == 0) *flag = (__hip_atomic_load(F.ctl + CW_TAIL + 64 * seam, RLX_AGENT) >= (unsigned)F.G) ? 1 : 0;
        __syncthreads();
        const int done = *flag;
        __syncthreads();
        if (done) break;
        if (more) more = convert_grab(F, lt, 0, scr); else __builtin_amdgcn_s_sleep(32);
    }
}
__device__ __forceinline__ void convert_moe_timed(Frame& F, int l, unsigned long long budget) {
    LAS float* scr = (LAS float*)(F.lds + F.wave * 16384);
    const unsigned long long t0 = __builtin_amdgcn_s_memrealtime();
    __syncthreads();
    while (__builtin_amdgcn_s_memrealtime() - t0 < budget) { if (!convert_grab(F, l, 0, scr)) break; }
    __syncthreads();
}

__device__ __forceinline__ void load_row(const float* src, int lane, f32x4 (&v)[8]) {
    const f32x4* p = (const f32x4*)src + lane;
#pragma unroll
    for (int j = 0; j < 8; ++j) v[j] = p[64 * j];
}
__device__ __forceinline__ void store_row(float* dst, int lane, const f32x4 (&v)[8]) {
    f32x4* p = (f32x4*)dst + lane;
#pragma unroll
    for (int j = 0; j < 8; ++j) p[64 * j] = v[j];
}
#if X_BF16
typedef bf16 xelem_t;
__device__ __forceinline__ void load_xrow(const bf16* src, int lane, f32x4 (&v)[8]) {
    const v2u* p = (const v2u*)src + lane;
#pragma unroll
    for (int j = 0; j < 8; ++j) { const v2u w = p[64 * j]; v[j] = (f32x4){bflo(w.x), bfhi(w.x), bflo(w.y), bfhi(w.y)}; }
}
__device__ __forceinline__ void store_xrow(bf16* dst, int lane, const f32x4 (&v)[8]) {
    v2u* p = (v2u*)dst + lane;
#pragma unroll
    for (int j = 0; j < 8; ++j) { v2u w; w.x = pk2(v[j].x, v[j].y); w.y = pk2(v[j].z, v[j].w); p[64 * j] = w; }
}
#else
typedef float xelem_t;
__device__ __forceinline__ void load_xrow(const float* src, int lane, f32x4 (&v)[8]) { load_row(src, lane, v); }
__device__ __forceinline__ void store_xrow(float* dst, int lane, const f32x4 (&v)[8]) { store_row(dst, lane, v); }
#endif
__device__ __forceinline__ void combine_row(Frame& F, int l, int m, int lane, f32x4 (&v)[8]) {
    const int* dest = (const int*)(F.ws + WS_MOEI + 2 * 512 * 1024) + m * 4;
    const float* g5 = (const float*)(F.ws + WS_MOD) + (size_t)(l * 5 + mod_row(m)) * 12288 + 5 * 2048;
    f32x4 acc[8];
#pragma unroll
    for (int j = 0; j < 8; ++j) acc[j] = (f32x4){0.f, 0.f, 0.f, 0.f};
#if YS_FP8
    typedef float f32x2c __attribute__((ext_vector_type(2)));
#pragma unroll
    for (int k = 0; k < 4; ++k) { const int d = dest[k]; const unsigned* yp = (const unsigned*)(F.ws + WS_YS + (size_t)d * 2048) + lane;
#pragma unroll
        for (int j = 0; j < 8; ++j) { const int w = (int)yp[64 * j]; const f32x2c lo = __builtin_amdgcn_cvt_pk_f32_fp8(w, false), hi = __builtin_amdgcn_cvt_pk_f32_fp8(w, true); acc[j] += (f32x4){lo.x, lo.y, hi.x, hi.y}; } }
#pragma unroll
    for (int j = 0; j < 8; ++j) { const f32x4 gg = *((const f32x4*)g5 + lane + 64 * j); v[j] += gg * acc[j] * 0.0625f; }
#else
#pragma unroll
    for (int k = 0; k < 4; ++k) { const int d = dest[k]; const v2u* yp = (const v2u*)((const bf16*)(F.ws + WS_YS) + (size_t)d * 2048) + lane;
#pragma unroll
        for (int j = 0; j < 8; ++j) { const v2u w = yp[64 * j]; acc[j] += (f32x4){bflo(w.x), bfhi(w.x), bflo(w.y), bfhi(w.y)}; } }
#pragma unroll
    for (int j = 0; j < 8; ++j) { const f32x4 gg = *((const f32x4*)g5 + lane + 64 * j); v[j] += gg * acc[j]; }
#endif
}
__device__ __forceinline__ void modnorm_store(const f32x4 (&v)[8], const float* g, const float* shift, const float* scale, bf16* hrow, int lane) {
    float ss = 0.f;
#pragma unroll
    for (int j = 0; j < 8; ++j) ss += (v[j].x * v[j].x + v[j].y * v[j].y) + (v[j].z * v[j].z + v[j].w * v[j].w);
    const float rstd = 1.0f / sqrtf(wave_sum(ss) * (1.0f / 2048.0f) + EPS);
    v2u* hp = (v2u*)hrow + lane;
#pragma unroll
    for (int j = 0; j < 8; ++j) { const f32x4 gg = *((const f32x4*)g + lane + 64 * j), sh = *((const f32x4*)shift + lane + 64 * j), sc = *((const f32x4*)scale + lane + 64 * j);
        const f32x4 y = (v[j] * rstd) * gg * (sc + 1.0f) + sh; v2u w; w.x = pk2(y.x, y.y); w.y = pk2(y.z, y.w); hp[64 * j] = w; }
}
constexpr size_t WS_W16 = WS_WRT + 512 * 1024;
__device__ __forceinline__ void phase_norm1(Frame& F, int l) {
    constexpr int TROW = 4112;
    LAS unsigned char* tile = F.lds; LAS float* part = (LAS float*)(F.lds + 66048);
    xelem_t* X = (xelem_t*)(F.ws + WS_X); bf16* H = (bf16*)(F.ws + WS_H); bf16* P = (bf16*)(F.ws + WS_P);
    const float* modp = (const float*)(F.ws + WS_MOD) + (size_t)l * 5 * 12288;
    const bf16* w16 = (const bf16*)(F.ws + WS_W16) + (size_t)l * 32 * 2048;
    for (int r0 = F.bid * 16; r0 < NTOK; r0 += F.G * 16) {
#pragma unroll 1
        for (int rr = 0; rr < 2; ++rr) { const int lr = 2 * F.wave + rr, m = r0 + lr;
            f32x4 v[8];
            if (l == 0) load_row(m < NLAT ? F.in[I_X] + (size_t)m * DM : F.in[I_CTX] + (size_t)(m - NLAT) * DM, F.lane, v);
            else { load_xrow(X + (size_t)m * DM, F.lane, v); if (MK_STAGE >= 9) { combine_row(F, l - 1, m, F.lane, v); store_xrow(X + (size_t)m * DM, F.lane, v); } }
            float ss = 0.f;
#pragma unroll
            for (int j = 0; j < 8; ++j) ss += (v[j].x * v[j].x + v[j].y * v[j].y) + (v[j].z * v[j].z + v[j].w * v[j].w);
            const float rstd = 1.0f / sqrtf(wave_sum(ss) * (1.0f / 2048.0f) + EPS);
            const float* mr = modp + (size_t)mod_row(m) * 12288; const float* g = F.in[I_NMG] + l * DM;
#if I8_INPROJ
            LAS v2u* tp = (LAS v2u*)(tile + lr * TROW) + F.lane; float amax = 0.f;
#pragma unroll
            for (int j = 0; j < 8; ++j) { const f32x4 gg = *((const f32x4*)g + F.lane + 64 * j), sh = *((const f32x4*)mr + F.lane + 64 * j), sc = *((const f32x4*)(mr + 2048) + F.lane + 64 * j);
                const f32x4 y = (v[j] * rstd) * gg * (sc + 1.0f) + sh; v[j] = y; v2u w; w.x = pk2(y.x, y.y); w.y = pk2(y.z, y.w); tp[64 * j] = w;
                amax = fmaxf(amax, fmaxf(fmaxf(fabsf(y.x), fabsf(y.y)), fmaxf(fabsf(y.z), fabsf(y.w)))); }
            amax = wave_max(amax); const float inv = amax > 0.f ? 127.0f / amax : 0.f;
            unsigned* hp = (unsigned*)(F.ws + WS_XS + (size_t)m * DM) + F.lane;
#pragma unroll
            for (int j = 0; j < 8; ++j) hp[64 * j] = pk4_i8(v[j].x * inv, v[j].y * inv, v[j].z * inv, v[j].w * inv);
            if (F.lane == 0) ((float*)(F.ws + WS_RS))[m] = amax * (1.0f / 127.0f);
#else
#if FP8_INPROJ
            unsigned* hp = (unsigned*)(F.ws + WS_XS + (size_t)m * DM) + F.lane; LAS v2u* tp = (LAS v2u*)(tile + lr * TROW) + F.lane;
#else
            v2u* hp = (v2u*)(H + (size_t)m * DM) + F.lane; LAS v2u* tp = (LAS v2u*)(tile + lr * TROW) + F.lane;
#endif
#pragma unroll
            for (int j = 0; j < 8; ++j) { const f32x4 gg = *((const f32x4*)g + F.lane + 64 * j), sh = *((const f32x4*)mr + F.lane + 64 * j), sc = *((const f32x4*)(mr + 2048) + F.lane + 64 * j);
                const f32x4 y = (v[j] * rstd) * gg * (sc + 1.0f) + sh; v2u w; w.x = pk2(y.x, y.y); w.y = pk2(y.z, y.w); tp[64 * j] = w;
#if FP8_INPROJ
                int x8 = 0; x8 = __builtin_amdgcn_cvt_pk_fp8_f32(y.x, y.y, x8, false); x8 = __builtin_amdgcn_cvt_pk_fp8_f32(y.z, y.w, x8, true); hp[64 * j] = (unsigned)x8; }
#else
                hp[64 * j] = w; }
#endif
#endif
        }
        __syncthreads();
        { const int row = F.lane & 15, q = F.lane >> 4; f32x4 acc = {0.f, 0.f, 0.f, 0.f};
#pragma unroll
          for (int ks = 0; ks < 8; ++ks) { const int k0 = 256 * F.wave + 32 * ks + 8 * q;
              const bf16x8 a = *(const LAS bf16x8*)(tile + row * TROW + k0 * 2); const bf16x8 b = *(const bf16x8*)(w16 + (size_t)row * 2048 + k0);
              acc = __builtin_amdgcn_mfma_f32_16x16x32_bf16(a, b, acc, 0, 0, 0); }
#pragma unroll
          for (int i = 0; i < 4; ++i) part[(F.wave * 16 + 4 * q + i) * 16 + row] = acc[i]; }
        __syncthreads();
        if (F.tid < 256) { const int rw = F.tid >> 4, c = F.tid & 15; float sacc = 0.f;
#pragma unroll
            for (int w = 0; w < 8; ++w) sacc += part[(w * 16 + rw) * 16 + c];
            P[(size_t)(r0 + rw) * PW + PC_BETA + c] = (bf16)f2bf(sacc); }
        __syncthreads();
    }
}
__device__ __forceinline__ void phase_final(Frame& F, bool with_combine) {
    const int gw = F.bid * NWAVES + F.wave, NGW = F.G * NWAVES;
    const xelem_t* X = (const xelem_t*)(F.ws + WS_X);
    for (int m = gw; m < NLAT; m += NGW) {
        f32x4 v[8];
        if (with_combine) { load_xrow(X + (size_t)m * DM, F.lane, v); combine_row(F, 1, m, F.lane, v); }
        else load_row(F.in[I_X] + (size_t)m * DM, F.lane, v);
        float ss = 0.f;
#pragma unroll
        for (int j = 0; j < 8; ++j) ss += (v[j].x * v[j].x + v[j].y * v[j].y) + (v[j].z * v[j].z + v[j].w * v[j].w);
        const float rstd = 1.0f / sqrtf(wave_sum(ss) * (1.0f / 2048.0f) + EPS);
        f32x4* op = (f32x4*)(F.out + (size_t)m * DM) + F.lane;
#pragma unroll
        for (int j = 0; j < 8; ++j) { const f32x4 gg = *((const f32x4*)F.in[I_FNG] + F.lane + 64 * j); op[64 * j] = v[j] * rstd * gg; }
    }
}

__device__ __forceinline__ void phase_inproj(Frame& F, int l) {
#if I8_INPROJ
    pg8::Gemm g{(const bf16*)(F.ws + WS_XS), (const bf16*)(F.ws + WS_WIN + (size_t)l * PW * 2048 * 2), NTOK, 4608, 1024};
    pg8::StaticOrderG S; S.init(g, F.G, F.bid);
    pg8::EpiBf16PlainI8 E{(bf16*)(F.ws + WS_P), PW, (const float*)(F.ws + WS_RS), (const float*)(F.ws + WS_CS) + l * 4608};
    pg8::gemm_phase<pg8::EpiBf16PlainI8, pg8::StaticOrderG, true, true, false, true>(F.lds + RING_OFF, g, S, E);
#elif FP8_INPROJ
    pg8::Gemm g{(const bf16*)(F.ws + WS_XS), (const bf16*)(F.ws + WS_WIN + (size_t)l * PW * 2048 * 2), NTOK, 4608, 1024, 0x7C7C7C7C};
    pg8::StaticOrderG S; S.init(g, F.G, F.bid); S.row_tab = (const int*)(F.ws + WS_IDT);
    pg8::EpiBf16Plain E{(bf16*)(F.ws + WS_P), PW};
    pg8::gemm_phase<pg8::EpiBf16Plain, pg8::StaticOrderG, true, true, true>(F.lds + RING_OFF, g, S, E);
#else
    pg8::Gemm g{(const bf16*)(F.ws + WS_H), (const bf16*)(F.ws + WS_WIN) + (size_t)l * PW * 2048, NTOK, 4608, 2048};
    pg8::StaticOrder S; S.init(g, F.G, F.bid);
    pg8::EpiBf16Plain E{(bf16*)(F.ws + WS_P), PW};
    pg8::gemm_phase<pg8::EpiBf16Plain, pg8::StaticOrder, true, true>(F.lds + RING_OFF, g, S, E);
#endif
}
__device__ __forceinline__ void phase_outproj(Frame& F, int l) {
    float* X = (float*)(F.ws + WS_X);
#if FP8_OUTPROJ
    pg8::Gemm g{(const bf16*)(F.ws + WS_CC), (const bf16*)(F.ws + WS_WOUT + (size_t)l * 2048 * 2048 * 2), l == 0 ? NTOK : NLAT, 2048, 1024, 0x7C7C7C7C};
    pg8::StaticOrderG S; S.init(g, F.G, F.bid); S.row_tab = (const int*)(F.ws + WS_IDT);
#else
    pg8::Gemm g{(const bf16*)(F.ws + WS_CC), (const bf16*)(F.ws + WS_WOUT) + (size_t)l * 2048 * 2048, l == 0 ? NTOK : NLAT, 2048, 2048};
    pg8::StaticOrder S; S.init(g, F.G, F.bid);
#endif
#if X_BF16
    pg8::EpiResGateB E{F.in[I_X], F.in[I_CTX], (const bf16*)(F.ws + WS_X), (bf16*)(F.ws + WS_X), (const float*)(F.ws + WS_MOD) + (size_t)l * 5 * 12288 + 2 * 2048, l == 0 ? 1 : 0};
#define EPI_RES pg8::EpiResGateB
#else
    pg8::EpiResGate E{l == 0 ? F.in[I_X] : X, l == 0 ? F.in[I_CTX] : X + (size_t)NLAT * DM, X, (const float*)(F.ws + WS_MOD) + (size_t)l * 5 * 12288 + 2 * 2048};
#define EPI_RES pg8::EpiResGate
#endif
#if FP8_OUTPROJ
    pg8::gemm_phase<EPI_RES, pg8::StaticOrderG, true, true, true>(F.lds + RING_OFF, g, S, E);
#else
    pg8::gemm_phase<EPI_RES, pg8::StaticOrder, true, true>(F.lds + RING_OFF, g, S, E);
#endif
    if (OUTPROJ_SLACK_TICKS > 0 && l == 0 && F.bid >= 32) convert_moe_timed(F, 1, OUTPROJ_SLACK_TICKS);
}
#ifndef PHASE_INPROJ
#define PHASE_INPROJ(F, l) phase_inproj(F, l)
#endif
#ifndef PHASE_OUTPROJ
#define PHASE_OUTPROJ(F, l) phase_outproj(F, l)
#endif

constexpr size_t WS_H8 = WS_XS;
constexpr size_t MOEI_TOPE = WS_MOEI, MOEI_TOPG = WS_MOEI + 512 * 1024, MOEI_DEST = WS_MOEI + 2 * 512 * 1024, MOEI_ROWG = WS_MOEI + 3 * 512 * 1024, MOEI_ROWT = WS_MOEI + 4 * 512 * 1024, MOEI_IDT = WS_IDT;
__device__ __forceinline__ void phase_norm2(Frame& F, int l) {
    const int nrows = (l == 0) ? NTOK : NLAT;
    constexpr int TROW = 4112;
    LAS unsigned char* tile = F.lds;
    LAS float* part = (LAS float*)(F.lds + 66048);
    LAS float* lg = (LAS float*)(F.lds + 66048 + 16384);
    const xelem_t* X = (const xelem_t*)(F.ws + WS_X); bf16* H = (bf16*)(F.ws + WS_H);
    const float* modp = (const float*)(F.ws + WS_MOD) + (size_t)l * 5 * 12288;
    const bf16* wrt = (const bf16*)(F.ws + WS_WRT) + (size_t)l * 32 * 2048;
    int* tope = (int*)(F.ws + MOEI_TOPE); float* topg = (float*)(F.ws + MOEI_TOPG);
    for (int r0 = F.bid * 16; r0 < nrows; r0 += F.G * 16) {
#pragma unroll 1
        for (int rr = 0; rr < 2; ++rr) {
            const int lr = 2 * F.wave + rr, m = r0 + lr;
            f32x4 v[8]; load_xrow(X + (size_t)m * DM, F.lane, v);
            float ss = 0.f;
#pragma unroll
            for (int j = 0; j < 8; ++j) ss += (v[j].x * v[j].x + v[j].y * v[j].y) + (v[j].z * v[j].z + v[j].w * v[j].w);
            const float rstd = 1.0f / sqrtf(wave_sum(ss) * (1.0f / 2048.0f) + EPS);
            const float* mr = modp + (size_t)mod_row(m) * 12288; const float* g = F.in[I_NFG] + l * DM;
            unsigned* hp = (unsigned*)(F.ws + WS_H8 + (size_t)m * DM) + F.lane; LAS v2u* tp = (LAS v2u*)(tile + lr * TROW) + F.lane;
#pragma unroll
            for (int j = 0; j < 8; ++j) { const f32x4 gg = *((const f32x4*)g + F.lane + 64 * j), sh = *((const f32x4*)(mr + 3 * 2048) + F.lane + 64 * j), sc = *((const f32x4*)(mr + 4 * 2048) + F.lane + 64 * j);
                const f32x4 y = (v[j] * rstd) * gg * (sc + 1.0f) + sh; v2u w; w.x = pk2(y.x, y.y); w.y = pk2(y.z, y.w); tp[64 * j] = w;
                int x8 = 0; x8 = __builtin_amdgcn_cvt_pk_fp8_f32(y.x, y.y, x8, false); x8 = __builtin_amdgcn_cvt_pk_fp8_f32(y.z, y.w, x8, true); hp[64 * j] = (unsigned)x8; }
        }
        __syncthreads();
        {
            const int row = F.lane & 15, q = F.lane >> 4;
            f32x4 acc0 = {0.f, 0.f, 0.f, 0.f}, acc1 = {0.f, 0.f, 0.f, 0.f};
#pragma unroll
            for (int ks = 0; ks < 8; ++ks) { const int k0 = 256 * F.wave + 32 * ks + 8 * q;
                const bf16x8 a = *(const LAS bf16x8*)(tile + row * TROW + k0 * 2);
                const bf16x8 b0 = *(const bf16x8*)(wrt + (size_t)row * 2048 + k0), b1 = *(const bf16x8*)(wrt + (size_t)(16 + row) * 2048 + k0);
                acc0 = __builtin_amdgcn_mfma_f32_16x16x32_bf16(a, b0, acc0, 0, 0, 0); acc1 = __builtin_amdgcn_mfma_f32_16x16x32_bf16(a, b1, acc1, 0, 0, 0); }
#pragma unroll
            for (int i = 0; i < 4; ++i) { part[(F.wave * 16 + 4 * q + i) * 32 + row] = acc0[i]; part[(F.wave * 16 + 4 * q + i) * 32 + 16 + row] = acc1[i]; }
        }
        __syncthreads();
        { const int rw = F.tid >> 5, e = F.tid & 31; float s = F.in[I_BROUT][l * 32 + e];
#pragma unroll
          for (int w = 0; w < 8; ++w) s += part[(w * 16 + rw) * 32 + e];
          lg[rw * 32 + e] = s; }
        __syncthreads();
        if (F.tid < 16) { const int m = r0 + F.tid; float val[4]; int idx[4]; unsigned taken = 0u;
#pragma unroll
            for (int k = 0; k < 4; ++k) { float best = -3.0e38f; int bi = 0;
                for (int e = 0; e < 32; ++e) { const float x = lg[F.tid * 32 + e]; if (!((taken >> e) & 1u) && x > best) { best = x; bi = e; } }
                val[k] = best; idx[k] = bi; taken |= 1u << bi; }
            float p[4], sum = 0.f;
#pragma unroll
            for (int k = 0; k < 4; ++k) { p[k] = __expf(val[k] - val[0]); sum += p[k]; }
#pragma unroll
            for (int k = 0; k < 4; ++k) { const unsigned rank = __hip_atomic_fetch_add(F.ctl + CW_CNT + 64 * l + idx[k], 1u, RLX_AGENT);
                tope[m * 4 + k] = idx[k] | (int)(rank << 8); topg[m * 4 + k] = p[k] / sum; }
        }
        __syncthreads();
    }
}
__device__ __forceinline__ void moe_tables(Frame& F, int l) {
    LAS int* blk_end = (LAS int*)(F.lds + LDS_X_OFF); LAS int* pstart = blk_end + 32; LAS int* cnts = blk_end + 64;
    if (F.tid == 0) { int nb = 0;
        for (int e = 0; e < 32; ++e) { const int c = (int)__hip_atomic_load(F.ctl + CW_CNT + 64 * l + e, RLX_AGENT); cnts[e] = c; pstart[e] = nb * 256; nb += (c + 255) >> 8; blk_end[e] = nb; } }
    __syncthreads();
}
__device__ __forceinline__ void phase_scatter(Frame& F, int l) {
    const int nrows = (l == 0) ? NTOK : NLAT;
    moe_tables(F, l);
    const LAS int* blk_end = (const LAS int*)(F.lds + LDS_X_OFF); const LAS int* pstart = blk_end + 32; const LAS int* cnts = blk_end + 64;
    const int* tope = (const int*)(F.ws + MOEI_TOPE); const float* topg = (const float*)(F.ws + MOEI_TOPG);
    int* dest = (int*)(F.ws + MOEI_DEST); float* rowg = (float*)(F.ws + MOEI_ROWG); int* rowt = (int*)(F.ws + MOEI_ROWT);
    for (int a = F.bid * NTHREADS + F.tid; a < nrows * 4; a += F.G * NTHREADS) {
        const int te = tope[a], e = te & 255, rank = (int)((unsigned)te >> 8), d = pstart[e] + rank;
        dest[a] = d; rowg[d] = topg[a]; rowt[d] = a >> 2; }
    if (F.bid < 32) { const int e = F.bid, r0 = pstart[e] + cnts[e], r1 = blk_end[e] * 256;
        for (int r = r0 + F.tid; r < r1; r += NTHREADS) { rowt[r] = 0; rowg[r] = 0.f; } }
}
__device__ __forceinline__ void phase_gemm1(Frame& F, int l) {
    moe_tables(F, l);
    const LAS int* blk_end = (const LAS int*)(F.lds + LDS_X_OFF);
    pg8::Gemm g{(const bf16*)(F.ws + WS_H8), (const bf16*)(F.ws + WS_WGU + (size_t)l * 32 * 2048 * 2048), MOE_ROWS, 2048, 1024, WGU_E8M0};
    pg8::MoeOrderG S{F.bid, __builtin_amdgcn_readfirstlane(blk_end[31]), (const char*)g.A, (const char*)g.Bt, (size_t)256 * 2048, (size_t)2048 * 2048, (size_t)256 * 2048, blk_end, (const int*)(F.ws + MOEI_ROWT)};
#if FP8_GEMM2
    pg8::EpiSwiglu8 E{F.ws + WS_ACT, F.in[I_BGU] + (size_t)l * 32 * 2048};
    pg8::gemm_phase<pg8::EpiSwiglu8, pg8::MoeOrderG, true, true, true>(F.lds + RING_OFF, g, S, E);
#else
    pg8::EpiSwiglu E{(bf16*)(F.ws + WS_ACT), F.in[I_BGU] + (size_t)l * 32 * 2048};
    pg8::gemm_phase<pg8::EpiSwiglu, pg8::MoeOrderG, true, true, true>(F.lds + RING_OFF, g, S, E);
#endif
}
__device__ __forceinline__ void phase_gemm2(Frame& F, int l) {
    moe_tables(F, l);
    const LAS int* blk_end = (const LAS int*)(F.lds + LDS_X_OFF);
#if FP8_GEMM2
    pg8::Gemm g{(const bf16*)(F.ws + WS_ACT), (const bf16*)(F.ws + WS_WDN + (size_t)l * 32 * 2048 * 1024), MOE_ROWS, 2048, 512, WDN_E8M0};
    pg8::MoeOrderI S{F.bid, __builtin_amdgcn_readfirstlane(blk_end[31]), (const char*)g.A, (const char*)g.Bt, (size_t)256 * 1024, (size_t)2048 * 1024, (size_t)256 * 1024, blk_end, nullptr};
#if YS_FP8
    pg8::EpiDown8 E{F.ws + WS_YS, F.in[I_BDN] + (size_t)l * 32 * 2048, (const float*)(F.ws + MOEI_ROWG)};
    pg8::gemm_phase<pg8::EpiDown8, pg8::MoeOrderI, true, true, true>(F.lds + RING_OFF, g, S, E);
#else
    pg8::EpiDown E{(bf16*)(F.ws + WS_YS), F.in[I_BDN] + (size_t)l * 32 * 2048, (const float*)(F.ws + MOEI_ROWG)};
    pg8::gemm_phase<pg8::EpiDown, pg8::MoeOrderI, true, true, true>(F.lds + RING_OFF, g, S, E);
#endif
#else
    pg8::Gemm g{(const bf16*)(F.ws + WS_ACT), (const bf16*)(F.ws + WS_WDN) + (size_t)l * 32 * 2048 * 1024, MOE_ROWS, 2048, 1024};
    pg8::MoeOrder S{F.bid, __builtin_amdgcn_readfirstlane(blk_end[31]), (const char*)g.A, (const char*)g.Bt, (size_t)256 * 1024 * 2, (size_t)2048 * 1024 * 2, (size_t)256 * 1024 * 2, blk_end, nullptr};
    pg8::EpiDown E{(bf16*)(F.ws + WS_YS), F.in[I_BDN] + (size_t)l * 32 * 2048, (const float*)(F.ws + MOEI_ROWG)};
    pg8::gemm_phase<pg8::EpiDown, pg8::MoeOrder, true, true>(F.lds + RING_OFF, g, S, E);
#endif
}
#ifndef PHASE_NORM2
#define PHASE_NORM2(F, l) phase_norm2(F, l)
#endif
#ifndef PHASE_SCATTER
#define PHASE_SCATTER(F, l) phase_scatter(F, l)
#endif
#ifndef PHASE_GEMM1
#define PHASE_GEMM1(F, l) phase_gemm1(F, l)
#endif
#ifndef PHASE_GEMM2
#define PHASE_GEMM2(F, l) phase_gemm2(F, l)
#endif
#define USE_MFMA_ATTN 1

__device__ __forceinline__ void attn_prep(Frame& F, int l) {
    bf16* P = (bf16*)(F.ws + WS_P);
    LAS unsigned short* vt = (LAS unsigned short*)F.lds;
    for (int ct = F.bid; ct < NCT; ct += F.G) {
        const int m0 = ct * 64; const bool lat = m0 < NLAT;
        __syncthreads();
        for (int i = F.tid; i < 64 * 32; i += NTHREADS) { const int tk = i >> 5, c8 = i & 31;
            const v4u w = *(const v4u*)(P + (size_t)(m0 + tk) * PW + PC_V + c8 * 8);
            const unsigned ww[4] = {w.x, w.y, w.z, w.w};
#pragma unroll
            for (int q = 0; q < 4; ++q) { vt[(c8 * 8 + 2 * q) * 66 + tk] = (unsigned short)(ww[q] & 0xffffu); vt[(c8 * 8 + 2 * q + 1) * 66 + tk] = (unsigned short)(ww[q] >> 16); } }
        if (lat) { const int tk = F.tid >> 3, kvh = (F.tid >> 1) & 3, hf = F.tid & 1; const int t = (m0 + tk) & 4095;
            bf16* kp = P + (size_t)(m0 + tk) * PW + PC_K + kvh * 64 + hf * 32;
            const v4u w0 = *(const v4u*)kp, w1 = *(const v4u*)(kp + 8), w2 = *(const v4u*)(kp + 16), w3 = *(const v4u*)(kp + 24);
            const unsigned lo[8] = {w0.x, w0.y, w0.z, w0.w, w1.x, w1.y, w1.z, w1.w}, hi_[8] = {w2.x, w2.y, w2.z, w2.w, w3.x, w3.y, w3.z, w3.w};
            const float pos = (float)(hf ? (t & 63) : (t >> 6)); unsigned o1[8], o2[8];
#pragma unroll
            for (int jj = 0; jj < 8; ++jj) { float r1[2], r2[2];
#pragma unroll
                for (int e = 0; e < 2; ++e) { const int j = 2 * jj + e; const float inv = __builtin_amdgcn_exp2f(-(float)j * 0.8304820237218406f); const float sn = __sinf(pos * inv), cs = __cosf(pos * inv);
                    const float x1 = e ? bfhi(lo[jj]) : bflo(lo[jj]), x2 = e ? bfhi(hi_[jj]) : bflo(hi_[jj]); r1[e] = x1 * cs - x2 * sn; r2[e] = x2 * cs + x1 * sn; }
                o1[jj] = pk2(r1[0], r1[1]); o2[jj] = pk2(r2[0], r2[1]); }
            *(v4u*)kp = (v4u){o1[0], o1[1], o1[2], o1[3]}; *(v4u*)(kp + 8) = (v4u){o1[4], o1[5], o1[6], o1[7]}; *(v4u*)(kp + 16) = (v4u){o2[0], o2[1], o2[2], o2[3]}; *(v4u*)(kp + 24) = (v4u){o2[4], o2[5], o2[6], o2[7]}; }
        __syncthreads();
        for (int i = F.tid; i < 256 * 8; i += NTHREADS) { const int col = i >> 3, c = i & 7, kvh = col >> 6, d = col & 63;
            v4u o; const LAS unsigned short* s = vt + col * 66 + c * 8;
            o.x = s[0] | ((unsigned)s[1] << 16); o.y = s[2] | ((unsigned)s[3] << 16); o.z = s[4] | ((unsigned)s[5] << 16); o.w = s[6] | ((unsigned)s[7] << 16);
            if (lat) { const int b = m0 >> 12, t0 = m0 & 4095; *(v4u*)((bf16*)(F.ws + WS_VT) + ((size_t)(b * 4 + kvh) * 64 + d) * SEQ + t0 + c * 8) = o; }
            else { const int mm = m0 - NLAT, b = mm >> 8, t0 = mm & 255; *(v4u*)((bf16*)(F.ws + WS_VTC) + ((size_t)(b * 4 + kvh) * 64 + d) * CTXL + t0 + c * 8) = o; } }
    }
    __syncthreads();
}

constexpr int AT_KP = 144, AT_VP = 136;
constexpr int AT_KOFF = 0, AT_VOFF = 64 * AT_KP, AT_TILE = 64 * AT_KP + 64 * AT_VP;
__device__ __forceinline__ void attn_unit(Frame& F, int l, int b, int kvh, int qi, int is_ctx) {
    const bf16* P = (const bf16*)(F.ws + WS_P); bf16* CC = (bf16*)(F.ws + WS_CC);
    int lane_o = F.lane; asm volatile("" : "+v"(lane_o));
    const int g = F.wave >> 1, qh = F.wave & 1, hq = kvh * 4 + g, r32 = lane_o & 31, hi = lane_o >> 5;
    const int rowbase = is_ctx ? NLAT + b * CTXL : b * SEQ;
    const int qa = qi * 128 + qh * 64;
    const float LOG2E = 1.4426950408889634f;
    bf16x8 qf[2][4];
#pragma unroll
    for (int qt = 0; qt < 2; ++qt) { const int tq = qa + 32 * qt + r32; const bf16* qp = P + (size_t)(rowbase + tq) * PW + PC_Q + hq * 64 + 8 * hi;
        float x[4][8];
#pragma unroll
        for (int s = 0; s < 4; ++s) { const v4u w = *(const v4u*)(qp + 16 * s); x[s][0] = bflo(w.x); x[s][1] = bfhi(w.x); x[s][2] = bflo(w.y); x[s][3] = bfhi(w.y); x[s][4] = bflo(w.z); x[s][5] = bfhi(w.z); x[s][6] = bflo(w.w); x[s][7] = bfhi(w.w); }
        if (!is_ctx) {
#pragma unroll
            for (int hf = 0; hf < 2; ++hf) { const float pos = (float)(hf ? (tq & 63) : (tq >> 6));
#pragma unroll
                for (int j = 0; j < 8; ++j) { const float inv = __builtin_amdgcn_exp2f(-(float)(8 * hi + j) * 0.8304820237218406f); const float sn = __sinf(pos * inv), cs = __cosf(pos * inv);
                    const float x1 = x[2 * hf][j], x2 = x[2 * hf + 1][j]; x[2 * hf][j] = x1 * cs - x2 * sn; x[2 * hf + 1][j] = x2 * cs + x1 * sn; } } }
        const float sc = 0.125f * LOG2E;
#pragma unroll
        for (int s = 0; s < 4; ++s) { v4u w; w.x = pk2(x[s][0] * sc, x[s][1] * sc); w.y = pk2(x[s][2] * sc, x[s][3] * sc); w.z = pk2(x[s][4] * sc, x[s][5] * sc); w.w = pk2(x[s][6] * sc, x[s][7] * sc); qf[qt][s] = __builtin_bit_cast(bf16x8, w); }
    }
    float mrun[2], lrun[2]; f32x16 O[2][2];
    { const float sk = F.in[I_SINK][l * 16 + hq] * LOG2E;
#pragma unroll
      for (int qt = 0; qt < 2; ++qt) { mrun[qt] = sk; lrun[qt] = hi ? 0.f : 1.f;
#pragma unroll
        for (int db = 0; db < 2; ++db)
#pragma unroll
            for (int r = 0; r < 16; ++r) O[qt][db][r] = 0.f; } }
    const int kt_lo = is_ctx ? 0 : (qi == 0 ? 2 : 0), nl = is_ctx ? 0 : (6 - (qi == 0 ? 2 : 0) - (qi == 31 ? 2 : 0)), ntile = nl + 4;
    const int rr = F.tid >> 3, cch = F.tid & 7;
    const bf16* kbase_l = P + (size_t)(b * SEQ + rr) * PW + PC_K + kvh * 64 + cch * 8; const bf16* kbase_c = P + (size_t)(NLAT + b * CTXL + rr) * PW + PC_K + kvh * 64 + cch * 8;
    const bf16* vbase_l = (const bf16*)(F.ws + WS_VT) + ((size_t)(b * 4 + kvh) * 64 + rr) * SEQ + cch * 8; const bf16* vbase_c = (const bf16*)(F.ws + WS_VTC) + ((size_t)(b * 4 + kvh) * 64 + rr) * CTXL + cch * 8;
    v4u kw, vw;
    { const bool loc0 = nl > 0; const int k00 = loc0 ? 128 * (qi - 1) + 64 * kt_lo : 0; kw = *(const v4u*)((loc0 ? kbase_l : kbase_c) + (size_t)k00 * PW); vw = *(const v4u*)((loc0 ? vbase_l : vbase_c) + k00); }
    LDS_BARRIER();
#pragma unroll 1
    for (int jt = 0; jt < ntile; ++jt) {
        const bool local = jt < nl; const int k0 = local ? 128 * (qi - 1) + 64 * (kt_lo + jt) : 64 * (jt - nl);
        const LAS unsigned char* KS = F.lds + (jt & 1) * AT_TILE + AT_KOFF; const LAS unsigned char* VS = F.lds + (jt & 1) * AT_TILE + AT_VOFF;
        { *(LAS v4u*)(F.lds + (jt & 1) * AT_TILE + AT_KOFF + rr * AT_KP + cch * 16) = kw;
          LAS v2u* vd = (LAS v2u*)(F.lds + (jt & 1) * AT_TILE + AT_VOFF + rr * AT_VP + cch * 16); vd[0] = (v2u){vw.x, vw.y}; vd[1] = (v2u){vw.z, vw.w}; }
        if (jt + 1 < ntile) { const bool ln = jt + 1 < nl; const int kn = ln ? 128 * (qi - 1) + 64 * (kt_lo + jt + 1) : 64 * (jt + 1 - nl);
            kw = *(const v4u*)((ln ? kbase_l : kbase_c) + (size_t)kn * PW); vw = *(const v4u*)((ln ? vbase_l : vbase_c) + kn); }
        LDS_BARRIER();
        if (local && (k0 + 63 < qa - 128 || k0 > qa + 63 + 128)) continue;
#pragma unroll 1
        for (int kb = 0; kb < 2; ++kb) {
            bf16x8 kf[4];
#pragma unroll
            for (int ss = 0; ss < 4; ++ss) kf[ss] = *(const LAS bf16x8*)(KS + (32 * kb + r32) * AT_KP + (16 * ss + 8 * hi) * 2);
            bf16x8 pb[2][2];
#pragma unroll
            for (int qt = 0; qt < 2; ++qt) { const int tq = qa + 32 * qt + r32;
                f32x16 s;
#pragma unroll
                for (int r = 0; r < 16; ++r) s[r] = 0.f;
#pragma unroll
                for (int ss = 0; ss < 4; ++ss) s = __builtin_amdgcn_mfma_f32_32x32x16_bf16(kf[ss], qf[qt][ss], s, 0, 0, 0);
                if (local) {
#pragma unroll
                    for (int r = 0; r < 16; ++r) { const int kidx = k0 + 32 * kb + (r & 3) + 8 * (r >> 2) + 4 * hi; const int dlt = kidx - tq; if (dlt > 128 || dlt < -128) s[r] = -1.0e30f; } }
                float mloc = s[0];
#pragma unroll
                for (int r = 1; r < 16; ++r) mloc = fmaxf(mloc, s[r]);
                mloc = fmaxf(mloc, __shfl_xor(mloc, 32));
                const float mnew = fmaxf(mrun[qt], mloc), alpha = __builtin_amdgcn_exp2f(mrun[qt] - mnew); mrun[qt] = mnew;
                float psum = 0.f;
#pragma unroll
                for (int r = 0; r < 16; ++r) { s[r] = __builtin_amdgcn_exp2f(s[r] - mnew); psum += s[r]; }
                lrun[qt] = lrun[qt] * alpha + psum;
#pragma unroll
                for (int db = 0; db < 2; ++db)
#pragma unroll
                    for (int r = 0; r < 16; ++r) O[qt][db][r] *= alpha;
#pragma unroll
                for (int s2 = 0; s2 < 2; ++s2) { v4u pw; pw.x = pk2(s[8 * s2 + 0], s[8 * s2 + 1]); pw.y = pk2(s[8 * s2 + 2], s[8 * s2 + 3]); pw.z = pk2(s[8 * s2 + 4], s[8 * s2 + 5]); pw.w = pk2(s[8 * s2 + 6], s[8 * s2 + 7]);
                    pb[qt][s2] = __builtin_bit_cast(bf16x8, pw); }
            }
#pragma unroll
            for (int s2 = 0; s2 < 2; ++s2)
#pragma unroll
                for (int db = 0; db < 2; ++db) { const LAS v2u* vp = (const LAS v2u*)(VS + (32 * db + r32) * AT_VP + (32 * kb + 16 * s2 + 4 * hi) * 2);
                    const v2u a0 = vp[0], a1 = vp[2]; v4u aw; aw.x = a0.x; aw.y = a0.y; aw.z = a1.x; aw.w = a1.y; const bf16x8 va = __builtin_bit_cast(bf16x8, aw);
                    O[0][db] = __builtin_amdgcn_mfma_f32_32x32x16_bf16(va, pb[0][s2], O[0][db], 0, 0, 0);
                    O[1][db] = __builtin_amdgcn_mfma_f32_32x32x16_bf16(va, pb[1][s2], O[1][db], 0, 0, 0); }
        }
    }
    int r32e = r32, hie = hi; asm volatile("" : "+v"(r32e), "+v"(hie));
#pragma unroll
    for (int qt = 0; qt < 2; ++qt) { const float lt = lrun[qt] + __shfl_xor(lrun[qt], 32); const float rl = 1.0f / lt; const int tq = qa + 32 * qt + r32e;
#if FP8_OUTPROJ
        unsigned char* op8 = (unsigned char*)CC + (size_t)(rowbase + tq) * DM + hq * 64 + 4 * hie;
#pragma unroll
        for (int db = 0; db < 2; ++db)
#pragma unroll
            for (int rq = 0; rq < 4; ++rq) *(unsigned*)(op8 + 32 * db + 8 * rq) = pk4_fp8(O[qt][db][4 * rq] * rl, O[qt][db][4 * rq + 1] * rl, O[qt][db][4 * rq + 2] * rl, O[qt][db][4 * rq + 3] * rl); }
#else
        bf16* op = CC + (size_t)(rowbase + tq) * DM + hq * 64 + 4 * hie;
#pragma unroll
        for (int db = 0; db < 2; ++db)
#pragma unroll
            for (int rq = 0; rq < 4; ++rq) { v2u w; w.x = pk2(O[qt][db][4 * rq] * rl, O[qt][db][4 * rq + 1] * rl); w.y = pk2(O[qt][db][4 * rq + 2] * rl, O[qt][db][4 * rq + 3] * rl);
                *(v2u*)(op + 32 * db + 8 * rq) = w; } }
#endif
}
__device__ __forceinline__ void attn_phase(Frame& F, int l, int rep = 0) {
    const int nunits = 512 + (l == 0 ? 32 : 0);
    LAS int* slot = (LAS int*)(F.lds + LDS_X_OFF + 512);
    for (;;) {
        __syncthreads();
        if (F.tid == 0) *slot = (int)__hip_atomic_fetch_add(F.ctl + CW_ATQ + 64 * l + 8 * rep, 1u, RLX_AGENT);
        __syncthreads();
        const int u = __builtin_amdgcn_readfirstlane(*slot);
        if (u >= nunits) break;
        if (u < 512) attn_unit(F, l, u >> 7, (u >> 5) & 3, u & 31, 0); else { const int v = u - 512; attn_unit(F, l, v >> 3, (v >> 1) & 3, v & 1, 1); }
    }
}
#define USE_CHUNK_DN 1
#ifndef DN_SPLIT
#define DN_SPLIT 2
#endif
#ifndef DN_REP_S1
#define DN_REP_S1 1
#endif
#ifndef DN_REP_S3B
#define DN_REP_S3B 1
#endif
#ifndef DN_REP_S3A
#define DN_REP_S3A 1
#endif
#ifndef DN_REP_S4
#define DN_REP_S4 1
#endif

constexpr int DN_F_NEGW = 0, DN_F_QG = 16, DN_F_QK = 32, DN_F_KGT = 40, DN_NFRAG = 56, DN_U_OFF = 57344;
constexpr int DP_QS = 0, DP_KS = 17408, DP_VS = 34816, DP_AS = 52224  , DP_TB = 69632, DP_TW = 78848, DP_QK = 88064, DP_RAW = 52224  , DP_SC = 104960, DP_TF = 106496  , DP_XS = 123904  ;
constexpr int DP_P = 272, DP_P2 = 144;
__device__ __forceinline__ int dn_rec(int b, int h, int dir, int np) { return ((b * 4 + h) * 2 + dir) * 68 + np; }
__device__ __forceinline__ void dn_chunk_of(int ct, int dir, int& b, int& np) { if (ct < 256) { b = ct >> 6; const int c = ct & 63; np = 4 + (dir ? 63 - c : c); } else { b = (ct - 256) >> 2; const int c = (ct - 256) & 3; np = dir ? 3 - c : c; } }
__device__ __forceinline__ unsigned short lds_u16(const LAS unsigned char* p) { return *(const LAS unsigned short*)p; }

__device__ __forceinline__ void dn_prep_unit(Frame& F, int l, int ct, int h, int dir) {
    const bf16* P = (const bf16*)(F.ws + WS_P);
    int lane = F.lane; asm volatile("" : "+v"(lane));
    const int wave = F.wave, i16 = lane & 15, q = lane >> 4;
    const int m0 = ct * 64; int t0, T, base; seq_of(m0, t0, T, base);
    int b, np; dn_chunk_of(ct, dir, b, np);
    unsigned char* tile = F.ws + WS_DNT + (size_t)dn_rec(b, h, dir, np) * DNT_BYTES;
    LAS unsigned char* L = F.lds;
    LAS float* SC = (LAS float*)(L + DP_SC);
    LDS_BARRIER();
    {
        const float* cw = F.in[I_DNCW] + (size_t)l * 4 * 1536;
        LAS float* cwl = (LAS float*)(L + DP_TF);
        for (int i = F.tid; i < 3 * 4 * 128; i += NTHREADS) { const int part = i >> 9, j = (i >> 7) & 3, ch = i & 127; cwl[i] = cw[j * 1536 + part * 512 + h * 128 + ch]; }
        unsigned short pbw = 0, paw = 0;
        if (wave == 0) { const int tok = dir ? 63 - lane : lane; pbw = P[(size_t)(m0 + tok) * PW + PC_BETA + dir * 4 + h]; paw = P[(size_t)(m0 + tok) * PW + PC_DEC + dir * 4 + h]; }
        for (int c = F.tid; c < 67 * 48; c += NTHREADS) { const int row = c / 48, ch = c % 48, part = ch >> 4, cc = ch & 15, tt = t0 + row - 2;
            v4u v = (v4u){0u, 0u, 0u, 0u};
            if (tt >= 0 && tt < T) v = *(const v4u*)(P + (size_t)(base + tt) * PW + PC_DQ + part * 512 + h * 128 + cc * 8);
            *(LAS v4u*)(L + DP_RAW + row * 784 + part * 256 + cc * 16) = v; }
        LDS_BARRIER();
#pragma unroll 1
        for (int rep = 0; rep < DN_REP_S1; ++rep)
#pragma unroll
        for (int part = 0; part < 3; ++part) { const int tok = F.tid >> 3, g8 = F.tid & 7;
            float sv[16];
#pragma unroll
            for (int k = 0; k < 16; ++k) sv[k] = 0.f;
#pragma unroll
            for (int j = 0; j < 4; ++j) { const LAS v4u* rp = (const LAS v4u*)(L + DP_RAW + (tok + j) * 784 + part * 256 + g8 * 32); const v4u r0 = rp[0], r1 = rp[1];
                const LAS f32x4* wp = (const LAS f32x4*)(cwl + (part * 4 + j) * 128 + g8 * 16); const f32x4 w0 = wp[0], w1 = wp[1], w2 = wp[2], w3 = wp[3];
                sv[0] += w0.x * bflo(r0.x); sv[1] += w0.y * bfhi(r0.x); sv[2] += w0.z * bflo(r0.y); sv[3] += w0.w * bfhi(r0.y); sv[4] += w1.x * bflo(r0.z); sv[5] += w1.y * bfhi(r0.z); sv[6] += w1.z * bflo(r0.w); sv[7] += w1.w * bfhi(r0.w);
                sv[8] += w2.x * bflo(r1.x); sv[9] += w2.y * bfhi(r1.x); sv[10] += w2.z * bflo(r1.y); sv[11] += w2.w * bfhi(r1.y); sv[12] += w3.x * bflo(r1.z); sv[13] += w3.y * bfhi(r1.z); sv[14] += w3.z * bflo(r1.w); sv[15] += w3.w * bfhi(r1.w); }
            float ss = 0.f;
#pragma unroll
            for (int k = 0; k < 16; ++k) { sv[k] = siluf_(sv[k]); ss += sv[k] * sv[k]; }
            if (part < 2) { ss += dpp_mov<0xB1>(ss); ss += dpp_mov<0x4E>(ss); ss += dpp_mov<0x141>(ss);
                const float f = (part == 0 ? 0.08838834764831845f : 1.0f) * __builtin_amdgcn_rsqf(ss + EPS);
#pragma unroll
                for (int k = 0; k < 16; ++k) sv[k] *= f; }
            LAS v4u* op = (LAS v4u*)(L + (part == 0 ? DP_QS : (part == 1 ? DP_KS : DP_VS)) + tok * DP_P + g8 * 32);
            op[0] = (v4u){pk2(sv[0], sv[1]), pk2(sv[2], sv[3]), pk2(sv[4], sv[5]), pk2(sv[6], sv[7])}; op[1] = (v4u){pk2(sv[8], sv[9]), pk2(sv[10], sv[11]), pk2(sv[12], sv[13]), pk2(sv[14], sv[15])}; }
        if (wave == 0) {
            const float pb = bf2f(pbw), pa = bf2f(paw);
            const float beta = sigmoidf_(pb); float gc = -__expf(F.in[I_DNALOG][l * 8 + dir * 4 + h]) * softplusf_(pa + F.in[I_DNDT][l * 8 + dir * 4 + h]);
#pragma unroll
            for (int o = 1; o < 64; o <<= 1) { const float v = __shfl_up(gc, o); if (lane >= o) gc += v; }
            const float glast = __shfl(gc, 63);
            SC[lane] = beta; SC[64 + lane] = gc; SC[128 + lane] = __expf(gc); SC[192 + lane] = __expf(glast - gc);
            if (lane == 63) ((float*)(F.ws + WS_DNS))[dn_rec(b, h, dir, np)] = __expf(glast);
        }
    }
    LDS_BARRIER();
#define DN_TOK(r) (dir ? 63 - (r) : (r))
#pragma unroll 1
    for (int rep = 0; rep < DN_REP_S3A; ++rep)
    {
        const int mb = wave & 3, which = wave >> 2;
        f32x4 acc[4];
#pragma unroll
        for (int nb = 0; nb < 4; ++nb) acc[nb] = (f32x4){0.f, 0.f, 0.f, 0.f};
        const LAS unsigned char* arow = L + (which ? DP_QS : DP_KS) + DN_TOK(16 * mb + i16) * DP_P + 16 * q;
#pragma unroll
        for (int ks = 0; ks < 4; ++ks) { const bf16x8 a = *(const LAS bf16x8*)(arow + 64 * ks);
#pragma unroll
            for (int nb = 0; nb < 4; ++nb) { const bf16x8 bb = *(const LAS bf16x8*)(L + DP_KS + DN_TOK(16 * nb + i16) * DP_P + 16 * q + 64 * ks);
                acc[nb] = __builtin_amdgcn_mfma_f32_16x16x32_bf16(a, bb, acc[nb], 0, 0, 0); } }
#pragma unroll
        for (int nb = 0; nb < 4; ++nb)
#pragma unroll
            for (int i = 0; i < 4; ++i) { const int r = 16 * mb + 4 * q + i, c = 16 * nb + i16; const float dec = __expf(SC[64 + r] - SC[64 + c]);
                if (which == 0) ((LAS float*)(L + DP_AS))[r * 68 + c] = (r > c) ? SC[r] * acc[nb][i] * dec : 0.f;
                else *(LAS unsigned short*)(L + DP_QK + r * DP_P2 + c * 2) = (unsigned short)f2bf((r >= c) ? acc[nb][i] * dec : 0.f); }
    }
    LDS_BARRIER();
#define DN_EMIT_FRAG(f_) do { const int fx_ = (f_); v4u o; \
        if (fx_ < DN_F_QG) { const int mb = fx_ >> 2, ks = fx_ & 3; const LAS unsigned char* rp = L + DP_AS + (16 * mb + i16) * DP_P + (32 * ks + 4 * q) * 2; \
            const v2u a = *(const LAS v2u*)rp, c = *(const LAS v2u*)(rp + 32); o.x = a.x; o.y = a.y; o.z = c.x; o.w = c.y; } \
        else if (fx_ < DN_F_QK) { const int ff = fx_ - DN_F_QG, mb = ff >> 2, ks = ff & 3, r = 16 * mb + i16; const LAS unsigned char* rp = L + DP_QS + DN_TOK(r) * DP_P + (32 * ks + 4 * q) * 2; const float eg = SC[128 + r]; \
            const v2u a = *(const LAS v2u*)rp, c = *(const LAS v2u*)(rp + 32); \
            o.x = pk2(bflo(a.x) * eg, bfhi(a.x) * eg); o.y = pk2(bflo(a.y) * eg, bfhi(a.y) * eg); o.z = pk2(bflo(c.x) * eg, bfhi(c.x) * eg); o.w = pk2(bflo(c.y) * eg, bfhi(c.y) * eg); } \
        else if (fx_ < DN_F_KGT) { const int ff = fx_ - DN_F_QK, mb = ff >> 1, ks = ff & 1; const LAS unsigned char* rp = L + DP_QK + (16 * mb + i16) * DP_P2 + (32 * ks + 4 * q) * 2; \
            const v2u a = *(const LAS v2u*)rp, c = *(const LAS v2u*)(rp + 32); o.x = a.x; o.y = a.y; o.z = c.x; o.w = c.y; } \
        else { const int ff = fx_ - DN_F_KGT, mb = ff >> 1, ks = ff & 1, dk = 16 * mb + i16; float e[8]; \
            _Pragma("unroll") for (int jj = 0; jj < 8; ++jj) { const int key = 32 * ks + 16 * (jj >> 2) + 4 * q + (jj & 3); e[jj] = bf2f(lds_u16(L + DP_KS + DN_TOK(key) * DP_P + dk * 2)) * SC[192 + key]; } \
            o.x = pk2(e[0], e[1]); o.y = pk2(e[2], e[3]); o.z = pk2(e[4], e[5]); o.w = pk2(e[6], e[7]); } \
        *(v4u*)(tile + (size_t)fx_ * 1024 + lane * 16) = o; } while (0)
#pragma unroll 1
    for (int rep = 0; rep < DN_REP_S3B; ++rep) {
    if (wave == 0) {
        const LAS float* As = (const LAS float*)(L + DP_AS); LAS float* Tf = (LAS float*)(L + DP_TF);
        const int g = lane >> 4, c = lane & 15;
        f32x4 ar[16][4];
#pragma unroll
        for (int r = 1; r < 16; ++r)
#pragma unroll
            for (int j4 = 0; j4 < (r + 3) / 4; ++j4) ar[r][j4] = *(const LAS f32x4*)(As + (16 * g + r) * 68 + 16 * g + 4 * j4);
        float t[16];
#pragma unroll
        for (int r = 0; r < 16; ++r) { float a0 = (c == r) ? 1.f : 0.f, a1 = 0.f;
#pragma unroll
            for (int j = 0; j < r; ++j) { const float av = ar[r][j >> 2][j & 3]; if (j & 1) a1 -= av * t[j]; else a0 -= av * t[j]; }
            t[r] = a0 + a1; Tf[(16 * g + r) * 68 + 16 * g + c] = t[r]; }
    } else if (rep == 0) {
#pragma unroll 1
        for (int fi = 0; fi < 3; ++fi) DN_EMIT_FRAG(16 + (wave - 1) * 3 + fi);
    }
    LDS_BARRIER();
    if (wave < 3) {
        const LAS float* As = (const LAS float*)(L + DP_AS); LAS float* Tf = (LAS float*)(L + DP_TF); LAS float* Xs = (LAS float*)(L + DP_XS) + wave * 272;
        const int J = wave;
#pragma unroll 1
        for (int I = J + 1; I < 4; ++I) {
            f32x4 acc = {0.f, 0.f, 0.f, 0.f};
#pragma unroll 1
            for (int K = J; K < I; ++K)
#pragma unroll
                for (int sk = 0; sk < 4; ++sk) acc = __builtin_amdgcn_mfma_f32_16x16x4f32(As[(16 * I + i16) * 68 + 16 * K + 4 * sk + q], Tf[(16 * K + 4 * sk + q) * 68 + 16 * J + i16], acc, 0, 0, 0);
#pragma unroll
            for (int i = 0; i < 4; ++i) Xs[(4 * q + i) * 17 + i16] = acc[i];
            LDS_WAIT(); asm volatile("" ::: "memory");
            f32x4 acc2 = {0.f, 0.f, 0.f, 0.f};
#pragma unroll
            for (int sk = 0; sk < 4; ++sk) acc2 = __builtin_amdgcn_mfma_f32_16x16x4f32(Tf[(16 * I + i16) * 68 + 16 * I + 4 * sk + q], Xs[(4 * sk + q) * 17 + i16], acc2, 0, 0, 0);
#pragma unroll
            for (int i = 0; i < 4; ++i) Tf[(16 * I + 4 * q + i) * 68 + 16 * J + i16] = -acc2[i];
            LDS_WAIT(); asm volatile("" ::: "memory");
        }
    } else if (rep == 0) {
#pragma unroll 1
        for (int fi = 0; fi < 4; ++fi) { const int f = 37 + (wave - 3) * 4 + fi; if (f < DN_NFRAG) DN_EMIT_FRAG(f); }
    }
    LDS_BARRIER();
    { const LAS float* Tf = (const LAS float*)(L + DP_TF); const int r = F.tid >> 3, c0 = (F.tid & 7) * 8; float vb[8], vw[8];
#pragma unroll
      for (int k = 0; k < 8; ++k) { const int c = c0 + k; const float v = ((r >> 4) >= (c >> 4)) ? Tf[r * 68 + c] : 0.f; const float bl = SC[c]; vb[k] = v * bl; vw[k] = vb[k] * SC[128 + c]; }
      v4u ob, ow; ob.x = pk2(vb[0], vb[1]); ob.y = pk2(vb[2], vb[3]); ob.z = pk2(vb[4], vb[5]); ob.w = pk2(vb[6], vb[7]); ow.x = pk2(vw[0], vw[1]); ow.y = pk2(vw[2], vw[3]); ow.z = pk2(vw[4], vw[5]); ow.w = pk2(vw[6], vw[7]);
      *(LAS v4u*)(L + DP_TB + r * DP_P2 + c0 * 2) = ob; *(LAS v4u*)(L + DP_TW + r * DP_P2 + c0 * 2) = ow; }
    }
    LDS_BARRIER();
    {
        const int nbp = wave & 3, which = wave >> 2;
        f32x4 acc[4][2];
#pragma unroll
        for (int mb = 0; mb < 4; ++mb) { acc[mb][0] = (f32x4){0.f, 0.f, 0.f, 0.f}; acc[mb][1] = (f32x4){0.f, 0.f, 0.f, 0.f}; }
#pragma unroll
        for (int ks = 0; ks < 2; ++ks) {
            bf16x8 bb[2];
#pragma unroll
            for (int nn = 0; nn < 2; ++nn) { const int n = 16 * (2 * nbp + nn) + i16; unsigned short e[8];
#pragma unroll
                for (int jj = 0; jj < 8; ++jj) e[jj] = lds_u16(L + (which ? DP_KS : DP_VS) + DN_TOK(32 * ks + 8 * q + jj) * DP_P + n * 2);
                v4u w; w.x = e[0] | ((unsigned)e[1] << 16); w.y = e[2] | ((unsigned)e[3] << 16); w.z = e[4] | ((unsigned)e[5] << 16); w.w = e[6] | ((unsigned)e[7] << 16); bb[nn] = __builtin_bit_cast(bf16x8, w); }
#pragma unroll
            for (int mb = 0; mb < 4; ++mb) { const bf16x8 a = *(const LAS bf16x8*)(L + (which ? DP_TW : DP_TB) + (16 * mb + i16) * DP_P2 + 64 * ks + 16 * q);
                acc[mb][0] = __builtin_amdgcn_mfma_f32_16x16x32_bf16(a, bb[0], acc[mb][0], 0, 0, 0); acc[mb][1] = __builtin_amdgcn_mfma_f32_16x16x32_bf16(a, bb[1], acc[mb][1], 0, 0, 0); } }
        if (which == 0) {
#pragma unroll
            for (int mb = 0; mb < 4; ++mb)
#pragma unroll
                for (int nn = 0; nn < 2; ++nn) *(f32x4*)(tile + DN_U_OFF + (size_t)((((2 * nbp + nn) * 4 + mb) * 64 + lane) * 16)) = acc[mb][nn];
        } else {
#pragma unroll
            for (int mb = 0; mb < 4; ++mb)
#pragma unroll
                for (int nn = 0; nn < 2; ++nn)
#pragma unroll
                    for (int i = 0; i < 4; ++i) *(LAS unsigned short*)(L + DP_AS + (16 * mb + 4 * q + i) * DP_P + (16 * (2 * nbp + nn) + i16) * 2) = (unsigned short)f2bf(-acc[mb][nn][i]);
        }
    }
    LDS_BARRIER();
#pragma unroll 1
    for (int fi = 0; fi < 2; ++fi) { const int f = wave * 2 + fi; DN_EMIT_FRAG(f); }
#undef DN_EMIT_FRAG
#undef DN_TOK
}
__device__ __forceinline__ void dn_prep(Frame& F, int l) {
    for (int u = F.bid; u < NCT * 4 * 2; u += F.G) dn_prep_unit(F, l, u >> 3, (u >> 1) & 3, u & 1);
    __syncthreads();
}

__device__ __forceinline__ void dn_scan(Frame& F, int l, int b, int h, int dir, int half) {
    int lane = F.lane; asm volatile("" : "+v"(lane));
    const int w = (DN_SPLIT == 2) ? half * 4 + (F.wave & 3) : F.wave, i16 = lane & 15, q = lane >> 4; const bool active = (DN_SPLIT == 2) ? (F.wave < 4) : true;
    const unsigned char* tiles = F.ws + WS_DNT + (size_t)dn_rec(b, h, dir, 0) * DNT_BYTES;
    const float* egl = (const float*)(F.ws + WS_DNS) + dn_rec(b, h, dir, 0);
    bf16* Ob = (bf16*)(F.ws + WS_DNO);
    LAS unsigned char* L = F.lds;
    f32x4 S[8];
#pragma unroll
    for (int i = 0; i < 8; ++i) S[i] = (f32x4){0.f, 0.f, 0.f, 0.f};
    v4u st[7]; f32x4 un[4];
#pragma unroll
    for (int mb = 0; mb < 4; ++mb) un[mb] = *(const f32x4*)(tiles + DN_U_OFF + (size_t)(((w * 4 + mb) * 64 + lane) * 16));
    LDS_BARRIER();
#pragma unroll
    for (int i = 0; i < 7; ++i) st[i] = *(const v4u*)(tiles + (size_t)(F.tid + i * NTHREADS) * 16);
#pragma unroll
    for (int i = 0; i < 7; ++i) *(LAS v4u*)(L + (F.tid + i * NTHREADS) * 16) = st[i];
#pragma unroll
    for (int i = 0; i < 7; ++i) st[i] = *(const v4u*)(tiles + DNT_BYTES + (size_t)(F.tid + i * NTHREADS) * 16);
    LDS_BARRIER();
#pragma unroll 1
    for (int n = 0; n < 68; ++n) {
        const unsigned char* tile = tiles + (size_t)n * DNT_BYTES; const LAS unsigned char* cur = L + (n & 1) * 57344;
        if (n + 1 < 68) {
#pragma unroll
            for (int i = 0; i < 7; ++i) *(LAS v4u*)(L + ((n + 1) & 1) * 57344 + (F.tid + i * NTHREADS) * 16) = st[i]; }
        if (n + 2 < 68) {
#pragma unroll
            for (int i = 0; i < 7; ++i) st[i] = *(const v4u*)(tile + 2 * DNT_BYTES + (size_t)(F.tid + i * NTHREADS) * 16); }
        if (active) {
        f32x4 vn[4];
#pragma unroll
        for (int mb = 0; mb < 4; ++mb) vn[mb] = un[mb];
        if (n + 1 < 68) {
#pragma unroll
            for (int mb = 0; mb < 4; ++mb) un[mb] = *(const f32x4*)(tile + DNT_BYTES + DN_U_OFF + (size_t)(((w * 4 + mb) * 64 + lane) * 16)); }
        const float el = egl[n];
        bf16x8 bS[4];
#pragma unroll
        for (int ks = 0; ks < 4; ++ks) { v4u x; x.x = pk2(S[2 * ks][0], S[2 * ks][1]); x.y = pk2(S[2 * ks][2], S[2 * ks][3]); x.z = pk2(S[2 * ks + 1][0], S[2 * ks + 1][1]); x.w = pk2(S[2 * ks + 1][2], S[2 * ks + 1][3]); bS[ks] = __builtin_bit_cast(bf16x8, x); }
        f32x4 o[4];
#pragma unroll
        for (int mb = 0; mb < 4; ++mb) { o[mb] = (f32x4){0.f, 0.f, 0.f, 0.f};
#pragma unroll
            for (int ks = 0; ks < 4; ++ks) { const bf16x8 aw = *(const LAS bf16x8*)(cur + (DN_F_NEGW + mb * 4 + ks) * 1024 + lane * 16), aq = *(const LAS bf16x8*)(cur + (DN_F_QG + mb * 4 + ks) * 1024 + lane * 16);
                vn[mb] = __builtin_amdgcn_mfma_f32_16x16x32_bf16(aw, bS[ks], vn[mb], 0, 0, 0); o[mb] = __builtin_amdgcn_mfma_f32_16x16x32_bf16(aq, bS[ks], o[mb], 0, 0, 0); } }
        bf16x8 bV[2];
#pragma unroll
        for (int ks = 0; ks < 2; ++ks) { v4u x; x.x = pk2(vn[2 * ks][0], vn[2 * ks][1]); x.y = pk2(vn[2 * ks][2], vn[2 * ks][3]); x.z = pk2(vn[2 * ks + 1][0], vn[2 * ks + 1][1]); x.w = pk2(vn[2 * ks + 1][2], vn[2 * ks + 1][3]); bV[ks] = __builtin_bit_cast(bf16x8, x); }
#pragma unroll
        for (int mb = 0; mb < 8; ++mb) { S[mb] = S[mb] * el;
#pragma unroll
            for (int ks = 0; ks < 2; ++ks) { const bf16x8 ak = *(const LAS bf16x8*)(cur + (DN_F_KGT + mb * 2 + ks) * 1024 + lane * 16); S[mb] = __builtin_amdgcn_mfma_f32_16x16x32_bf16(ak, bV[ks], S[mb], 0, 0, 0); } }
#pragma unroll
        for (int mb = 0; mb < 4; ++mb)
#pragma unroll
            for (int ks = 0; ks < 2; ++ks) { const bf16x8 aqk = *(const LAS bf16x8*)(cur + (DN_F_QK + mb * 2 + ks) * 1024 + lane * 16); o[mb] = __builtin_amdgcn_mfma_f32_16x16x32_bf16(aqk, bV[ks], o[mb], 0, 0, 0); }
        { int m0; if (n < 4) m0 = NLAT + b * CTXL + 64 * (dir ? 3 - n : n); else m0 = b * SEQ + 64 * (dir ? 63 - (n - 4) : (n - 4));
#pragma unroll
          for (int mb = 0; mb < 4; ++mb)
#pragma unroll
            for (int i = 0; i < 4; ++i) { const int r = 16 * mb + 4 * q + i, tok = dir ? 63 - r : r; Ob[((size_t)dir * NTOK + m0 + tok) * 512 + h * 128 + 16 * w + i16] = (bf16)f2bf(o[mb][i]); } }
        }
        LDS_BARRIER();
    }
}
#define USE_CHUNK_LRU 1

constexpr int LR_XF = 0  , LR_XB = 16640  , LR_WT = 25856  , LR_AA = 62720  , LR_UU = 96000  , LR_END = 129280;
constexpr size_t WS_LCA = WS_LRC, WS_LCH = WS_LRC + 2 * MiB, WS_LCI = WS_LRC + 4 * MiB;
__device__ __forceinline__ void lru_prep(Frame& F, int l) {
    const bf16* P = (const bf16*)(F.ws + WS_P);
    int lane = F.lane; asm volatile("" : "+v"(lane));
    const int wave = F.wave, i16 = lane & 15, q = lane >> 4, nb = F.bid & 7;
    LAS unsigned char* L = F.lds;
    LAS float* XF = (LAS float*)(L + LR_XF); LAS float* AA = (LAS float*)(L + LR_AA); LAS float* UU = (LAS float*)(L + LR_UU);
    bf16* HL = (bf16*)(F.ws + WS_LRH); bf16* AC = (bf16*)(F.ws + WS_LRA);
    __syncthreads();
    for (int e = F.tid; e < 4 * 4096; e += NTHREADS) { const int mat = e >> 12, ii = (e >> 6) & 63, j = e & 63, dir = mat >> 1;
        const float w = (mat & 1 ? F.in[I_LRWI] : F.in[I_LRWR])[((size_t)((l * 2 + dir) * 8 + nb)) * 4096 + ii * 64 + j];
        *(LAS unsigned short*)(L + LR_WT + (mat * 64 + j) * 144 + ii * 2) = (unsigned short)f2bf(w); }
    float cwv[4][8], cbv[8];
    { const int c8 = (F.tid & 7) * 8, ch0 = nb * 64 + c8; const float* cb = F.in[I_LRCB] + l * 512 + ch0; const float* cw = F.in[I_LRCW] + (size_t)l * 4 * 512 + ch0;
#pragma unroll
      for (int k = 0; k < 8; ++k) cbv[k] = cb[k];
#pragma unroll
      for (int j = 0; j < 4; ++j)
#pragma unroll
        for (int k = 0; k < 8; ++k) cwv[j][k] = cw[j * 512 + k]; }
    float gbr[4], gbi[4], gls[4];
    { const int dir = wave >> 2;
#pragma unroll
      for (int n = 0; n < 4; ++n) { const int ch = nb * 64 + 16 * n + i16; gbr[n] = F.in[I_LRBR][(l * 2 + dir) * 512 + ch]; gbi[n] = F.in[I_LRBI][(l * 2 + dir) * 512 + ch]; gls[n] = -softplusf_(-F.in[I_LRLAM][(l * 2 + dir) * 512 + ch]); } }
    v4u wvA[4], wvB[4];
#define LR_LOADRAW(ctx) do { if (F.tid >= 128) { const int _m0 = (ctx) * 64; int _t0, _T, _base; seq_of(_m0, _t0, _T, _base); const int _ch0 = nb * 64 + (F.tid & 7) * 8, _tokA = (F.tid - 128) >> 3, _tokB = (F.tid + 256) >> 3; \
        _Pragma("unroll") for (int j = 0; j < 4; ++j) { const int tt = _t0 + _tokA + j - 2; wvA[j] = (v4u){0u, 0u, 0u, 0u}; if (tt >= 0 && tt < _T) wvA[j] = *(const v4u*)(P + (size_t)(_base + tt) * PW + PC_LX + _ch0); } \
        if (F.tid < 256) { _Pragma("unroll") for (int j = 0; j < 4; ++j) { const int tt = _t0 + _tokB + j - 2; wvB[j] = (v4u){0u, 0u, 0u, 0u}; if (tt >= 0 && tt < _T) wvB[j] = *(const v4u*)(P + (size_t)(_base + tt) * PW + PC_LX + _ch0); } } } } while (0)
#define LR_S1ITEM(wv_, tok_) do { const int tok = (tok_), c8 = (F.tid & 7) * 8; float s[8]; \
        _Pragma("unroll") for (int k = 0; k < 8; ++k) s[k] = cbv[k]; \
        _Pragma("unroll") for (int j = 0; j < 4; ++j) { const v4u w = wv_[j]; \
            s[0] += cwv[j][0] * bflo(w.x); s[1] += cwv[j][1] * bfhi(w.x); s[2] += cwv[j][2] * bflo(w.y); s[3] += cwv[j][3] * bfhi(w.y); s[4] += cwv[j][4] * bflo(w.z); s[5] += cwv[j][5] * bfhi(w.z); s[6] += cwv[j][6] * bflo(w.w); s[7] += cwv[j][7] * bfhi(w.w); } \
        _Pragma("unroll") for (int k = 0; k < 8; ++k) XF[tok * 65 + c8 + k] = s[k]; \
        v4u o; o.x = pk2(s[0], s[1]); o.y = pk2(s[2], s[3]); o.z = pk2(s[4], s[5]); o.w = pk2(s[6], s[7]); *(LAS v4u*)(L + LR_XB + tok * 144 + c8 * 2) = o; } while (0)
#define LR_S1() do { if (F.tid >= 128) { LR_S1ITEM(wvA, (F.tid - 128) >> 3); if (F.tid < 256) LR_S1ITEM(wvB, (F.tid + 256) >> 3); } } while (0)
    if ((F.bid >> 3) < NCT) { LR_LOADRAW(F.bid >> 3); LR_S1(); }
    for (int ct = F.bid >> 3; ct < NCT; ct += F.G >> 3) {
        const int m0 = ct * 64; const bool has_next = ct + (F.G >> 3) < NCT;
        if (has_next) LR_LOADRAW(ct + (F.G >> 3));
        LDS_BARRIER();
        { const int dir = wave >> 2, mb = wave & 3;
          f32x4 ar[4], ai[4];
#pragma unroll
          for (int n = 0; n < 4; ++n) { ar[n] = (f32x4){0.f, 0.f, 0.f, 0.f}; ai[n] = (f32x4){0.f, 0.f, 0.f, 0.f}; }
#pragma unroll
          for (int ks = 0; ks < 2; ++ks) { const bf16x8 a = *(const LAS bf16x8*)(L + LR_XB + (16 * mb + i16) * 144 + 64 * ks + 16 * q);
#pragma unroll
              for (int n = 0; n < 4; ++n) { const bf16x8 br = *(const LAS bf16x8*)(L + LR_WT + ((dir * 2 + 0) * 64 + 16 * n + i16) * 144 + 64 * ks + 16 * q), bi = *(const LAS bf16x8*)(L + LR_WT + ((dir * 2 + 1) * 64 + 16 * n + i16) * 144 + 64 * ks + 16 * q);
                  ar[n] = __builtin_amdgcn_mfma_f32_16x16x32_bf16(a, br, ar[n], 0, 0, 0); ai[n] = __builtin_amdgcn_mfma_f32_16x16x32_bf16(a, bi, ai[n], 0, 0, 0); } }
#pragma unroll
          for (int n = 0; n < 4; ++n) { const int j = 16 * n + i16; const float br_ = gbr[n], bi_ = gbi[n], logsig = gls[n];
#pragma unroll
              for (int i = 0; i < 4; ++i) { const int tok = 16 * mb + 4 * q + i; const float r = sigmoidf_(ar[n][i] + br_), ig = sigmoidf_(ai[n][i] + bi_);
                  const float log_a = 8.0f * r * logsig, a = __expf(log_a), y2 = 2.0f * log_a;
                  const float om = (y2 > -0.1f) ? -y2 * (1.0f + y2 * (0.5f + y2 * (0.16666667f + y2 * 0.041666668f))) : 1.0f - __expf(y2);
                  const float u = __builtin_amdgcn_sqrtf(om) * (ig * XF[tok * 65 + j]);
                  AA[(dir * 64 + tok) * 65 + j] = a; UU[(dir * 64 + tok) * 65 + j] = u; } } }
        LDS_BARRIER();
        if (F.tid < 128) { const int dir = F.tid >> 6, j = F.tid & 63, ch = nb * 64 + j; float h = 0.f, ac = 1.f;
            long o = (long)(((size_t)dir * NTOK + m0 + (dir ? 63 : 0)) * 512 + ch); const long ostep = dir ? -512 : 512;
#pragma unroll 1
            for (int s0 = 0; s0 < 64; s0 += 8) { float av[8], uv[8];
#pragma unroll
                for (int k = 0; k < 8; ++k) { const int tok = dir ? 63 - (s0 + k) : (s0 + k); av[k] = AA[(dir * 64 + tok) * 65 + j]; uv[k] = UU[(dir * 64 + tok) * 65 + j]; }
#pragma unroll
                for (int k = 0; k < 8; ++k) { h = av[k] * h + uv[k]; ac *= av[k]; HL[o] = (bf16)f2bf(h); AC[o] = (bf16)f2bf(ac); o += ostep; } }
            ((float*)(F.ws + WS_LCA))[((size_t)dir * NCT + ct) * 512 + ch] = ac; ((float*)(F.ws + WS_LCH))[((size_t)dir * NCT + ct) * 512 + ch] = h; }
        else if (has_next) LR_S1();
    }
    LDS_BARRIER();
}
__device__ __forceinline__ void lru_carry(Frame& F, int idx) {
    const int ch = idx & 511, dir = (idx >> 9) & 1, b = idx >> 10;
    const float* CA = (const float*)(F.ws + WS_LCA); const float* CH = (const float*)(F.ws + WS_LCH); float* CI = (float*)(F.ws + WS_LCI);
    float h = 0.f;
#pragma unroll 4
    for (int n = 0; n < 68; ++n) { const int ct = n < 4 ? 256 + b * 4 + (dir ? 3 - n : n) : b * 64 + (dir ? 63 - (n - 4) : (n - 4)); const size_t o = ((size_t)dir * NCT + ct) * 512 + ch;
        CI[o] = h; h = CA[o] * h + CH[o]; }
}
__device__ __forceinline__ void lru_fin(Frame& F, int l) {
    const int nrows = (l == 0) ? NTOK : NLAT;
    const bf16* P = (const bf16*)(F.ws + WS_P); bf16* CC = (bf16*)(F.ws + WS_CC);
    const bf16* HL = (const bf16*)(F.ws + WS_LRH); const bf16* AC = (const bf16*)(F.ws + WS_LRA); const float* CI = (const float*)(F.ws + WS_LCI);
    for (size_t i = (size_t)F.bid * NTHREADS + F.tid; i < (size_t)nrows * 128; i += (size_t)F.G * NTHREADS) { const int m = (int)(i >> 7), c4 = (int)(i & 127) * 4, ct = m >> 6;
        const v2u hw0 = *(const v2u*)(HL + (size_t)m * 512 + c4), aw0 = *(const v2u*)(AC + (size_t)m * 512 + c4), hw1 = *(const v2u*)(HL + ((size_t)NTOK + m) * 512 + c4), aw1 = *(const v2u*)(AC + ((size_t)NTOK + m) * 512 + c4);
        const f32x4 h0 = {bflo(hw0.x), bfhi(hw0.x), bflo(hw0.y), bfhi(hw0.y)}, a0 = {bflo(aw0.x), bfhi(aw0.x), bflo(aw0.y), bfhi(aw0.y)}, h1 = {bflo(hw1.x), bfhi(hw1.x), bflo(hw1.y), bfhi(hw1.y)}, a1 = {bflo(aw1.x), bfhi(aw1.x), bflo(aw1.y), bfhi(aw1.y)};
        const f32x4 i0 = *(const f32x4*)(CI + (size_t)ct * 512 + c4), i1 = *(const f32x4*)(CI + ((size_t)NCT + ct) * 512 + c4);
        const f32x4 hs = (a0 * i0 + h0) + (a1 * i1 + h1); const v2u yw = *(const v2u*)(P + (size_t)m * PW + PC_LY + c4);
#if FP8_OUTPROJ
        *(unsigned*)((unsigned char*)CC + (size_t)m * DM + 1536 + c4) = pk4_fp8(hs.x * gelu_tanh(bflo(yw.x)), hs.y * gelu_tanh(bfhi(yw.x)), hs.z * gelu_tanh(bflo(yw.y)), hs.w * gelu_tanh(bfhi(yw.y))); }
#else
        v2u o; o.x = pk2(hs.x * gelu_tanh(bflo(yw.x)), hs.y * gelu_tanh(bfhi(yw.x))); o.y = pk2(hs.z * gelu_tanh(bflo(yw.y)), hs.w * gelu_tanh(bfhi(yw.y)));
        *(v2u*)(CC + (size_t)m * DM + 1536 + c4) = o; }
#endif
}

constexpr size_t WS_DNQ = WS_DNT;
constexpr size_t WS_BG = WS_DNS + 1 * MiB;
constexpr size_t WS_XC = WS_XS;

__device__ __forceinline__ void naive_prep(Frame& F, int l) {
    const bf16* P = (const bf16*)(F.ws + WS_P);
    const int gw = F.bid * NWAVES + F.wave, NGW = F.G * NWAVES;
#if !defined(USE_CHUNK_DN)
    {
        float* DNQ = (float*)(F.ws + WS_DNQ); float* BG = (float*)(F.ws + WS_BG);
        const float* cw = F.in[I_DNCW] + (size_t)l * 4 * 1536;
        for (int it = gw; it < NTOK * 4; it += NGW) {
            const int m = it >> 2, h = it & 3; int t, T, base; seq_of(m, t, T, base);
            float val[3][2];
#pragma unroll
            for (int part = 0; part < 3; ++part)
#pragma unroll
                for (int dd = 0; dd < 2; ++dd) { const int d = F.lane + 64 * dd, cch = part * 512 + h * 128 + d, col = PC_DQ + cch; float s = 0.f;
#pragma unroll
                    for (int j = 0; j < 4; ++j) { const int tt = t + j - 2; if (tt >= 0 && tt < T) s += cw[j * 1536 + cch] * bf2f(P[(size_t)(base + tt) * PW + col]); }
                    val[part][dd] = siluf_(s); }
            const float sq = wave_sum(val[0][0] * val[0][0] + val[0][1] * val[0][1]), sk = wave_sum(val[1][0] * val[1][0] + val[1][1] * val[1][1]);
            const float fq = 0.08838834764831845f / sqrtf(sq + EPS), fk = 1.0f / sqrtf(sk + EPS);
#pragma unroll
            for (int dd = 0; dd < 2; ++dd) { const int d = F.lane + 64 * dd; float* o = DNQ + (size_t)m * 1536 + h * 128 + d;
                o[0] = val[0][dd] * fq; o[512] = val[1][dd] * fk; o[1024] = val[2][dd]; }
            if (h == 0 && F.lane < 8) { const int dir = F.lane >> 2, hh = F.lane & 3;
                const float pb = bf2f(P[(size_t)m * PW + PC_BETA + F.lane]), pa = bf2f(P[(size_t)m * PW + PC_DEC + F.lane]);
                BG[m * 16 + F.lane] = sigmoidf_(pb);
                BG[m * 16 + 8 + F.lane] = -__expf(F.in[I_DNALOG][l * 8 + dir * 4 + hh]) * softplusf_(pa + F.in[I_DNDT][l * 8 + dir * 4 + hh]); }
        }
    }
#endif
#if !defined(USE_CHUNK_LRU)
    {
        LAS float* xc = (LAS float*)F.lds;
        float* A = (float*)(F.ws + WS_LRA); float* U = (float*)(F.ws + WS_LRH);
        const float* cw = F.in[I_LRCW] + (size_t)l * 4 * 512; const float* cb = F.in[I_LRCB] + l * 512;
        for (int m0 = F.bid * 8; m0 < NTOK; m0 += F.G * 8) {
            __syncthreads();
            for (int i = F.tid; i < 8 * 512; i += NTHREADS) { const int m = m0 + (i >> 9), ch = i & 511; int t, T, base; seq_of(m, t, T, base); float s = cb[ch];
#pragma unroll
                for (int j = 0; j < 4; ++j) { const int tt = t + j - 2; if (tt >= 0 && tt < T) s += cw[j * 512 + ch] * bf2f(P[(size_t)(base + tt) * PW + PC_LX + ch]); }
                xc[i] = s; }
            __syncthreads();
            for (int i = F.tid; i < 8 * 512 * 2; i += NTHREADS) { const int ch = i & 511, dir = (i >> 9) & 1, tk = i >> 10, m = m0 + tk, blk = ch >> 6, j = ch & 63;
                const float* wr = F.in[I_LRWR] + ((size_t)((l * 2 + dir) * 8 + blk)) * 4096 + j; const float* wi = F.in[I_LRWI] + ((size_t)((l * 2 + dir) * 8 + blk)) * 4096 + j;
                float sr = F.in[I_LRBR][(l * 2 + dir) * 512 + ch], si = F.in[I_LRBI][(l * 2 + dir) * 512 + ch];
#pragma unroll 8
                for (int ii = 0; ii < 64; ++ii) { const float x = xc[tk * 512 + blk * 64 + ii]; sr += x * wr[ii * 64]; si += x * wi[ii * 64]; }
                const float r = sigmoidf_(sr), ig = sigmoidf_(si); const float lam = F.in[I_LRLAM][(l * 2 + dir) * 512 + ch];
                const float logsig = -softplusf_(-lam);
                const float log_a = 8.0f * r * logsig; const float a = __expf(log_a);
                const float u = sqrtf(-expm1f(2.0f * log_a)) * (ig * xc[tk * 512 + ch]);
                A[((size_t)dir * NTOK + m) * 512 + ch] = a; U[((size_t)dir * NTOK + m) * 512 + ch] = u; }
        }
        __syncthreads();
    }
#endif
}

__device__ __forceinline__ void naive_attn_row(Frame& F, int l, int m, int hq) {
    const bf16* P = (const bf16*)(F.ws + WS_P); bf16* CC = (bf16*)(F.ws + WS_CC);
    const int d = F.lane, kvh = hq >> 2; int t, T, base; seq_of(m, t, T, base);
    const bool lat = m < NLAT; const int b = lat ? (m >> 12) : ((m - NLAT) >> 8);
    const int dd = d & 31, jf = dd & 15; const float inv = __powf(10000.0f, -(float)jf * (1.0f / 16.0f));
    const bool second = (dd >= 16), colhalf = (d >= 32);
    float q = bf2f(P[(size_t)m * PW + PC_Q + hq * 64 + d]);
    if (lat) { const float pos = (float)(colhalf ? (t & 63) : (t >> 6)); float sn, cs; sincosf(pos * inv, &sn, &cs); const float pr = __shfl_xor(q, 16); q = second ? (q * cs + pr * sn) : (q * cs - pr * sn); }
    q *= 0.125f;
    float mx = F.in[I_SINK][l * 16 + hq], den = 1.0f, acc = 0.f;
    if (lat) { const int t0 = t - 128 < 0 ? 0 : t - 128, t1 = t + 128 > SEQ - 1 ? SEQ - 1 : t + 128;
        for (int tk = t0; tk <= t1; ++tk) { const size_t r = (size_t)(base + tk) * PW; float k = bf2f(P[r + PC_K + kvh * 64 + d]); const float v = bf2f(P[r + PC_V + kvh * 64 + d]);
            const float pos = (float)(colhalf ? (tk & 63) : (tk >> 6)); float sn, cs; sincosf(pos * inv, &sn, &cs); const float pr = __shfl_xor(k, 16); k = second ? (k * cs + pr * sn) : (k * cs - pr * sn);
            const float s = wave_sum(q * k); const float mn = fmaxf(mx, s), f = __expf(mx - mn), p = __expf(s - mn); den = den * f + p; acc = acc * f + p * v; mx = mn; } }
    for (int c = 0; c < CTXL; ++c) { const size_t r = (size_t)(NLAT + b * CTXL + c) * PW; const float k = bf2f(P[r + PC_K + kvh * 64 + d]), v = bf2f(P[r + PC_V + kvh * 64 + d]);
        const float s = wave_sum(q * k); const float mn = fmaxf(mx, s), f = __expf(mx - mn), p = __expf(s - mn); den = den * f + p; acc = acc * f + p * v; mx = mn; }
    CC[(size_t)m * DM + hq * 64 + d] = (bf16)f2bf(acc / den);
}

__device__ __forceinline__ int scan_row(int n, int b, int dir) { if (n < CTXL) { const int t = dir ? (CTXL - 1 - n) : n; return NLAT + b * CTXL + t; } const int t = dir ? (SEQ - 1 - (n - CTXL)) : (n - CTXL); return b * SEQ + t; }
__device__ __forceinline__ void naive_scan(Frame& F, int l, int rep = 0) {
#if defined(USE_CHUNK_DN)
    if (F.bid < 32 * DN_SPLIT) { if (DN_SPLIT == 2) dn_scan(F, l, F.bid >> 4, (F.bid >> 2) & 3, (F.bid >> 1) & 1, F.bid & 1); else dn_scan(F, l, F.bid >> 3, (F.bid >> 1) & 3, F.bid & 1, 0); }
#else
    if (F.bid < 32) {
        const int b = F.bid >> 3, h = (F.bid >> 1) & 3, dir = F.bid & 1, dvc = F.tid & 127, kq = F.tid >> 7;
        const float* DNQ = (const float*)(F.ws + WS_DNQ); const float* BG = (const float*)(F.ws + WS_BG); float* O = (float*)(F.ws + WS_DNO);
        LAS float* buf = (LAS float*)F.lds;
        LAS float* red = buf + 768;
        LAS float* red2 = red + 512;
        float S[32];
#pragma unroll
        for (int i = 0; i < 32; ++i) S[i] = 0.f;
        constexpr int NT = CTXL + SEQ;
        { const int m = scan_row(0, b, dir); if (F.tid < 384) buf[F.tid] = DNQ[(size_t)m * 1536 + (F.tid >> 7) * 512 + h * 128 + (F.tid & 127)]; }
        __syncthreads();
#pragma unroll 1
        for (int n = 0; n < NT; ++n) {
            const int m = scan_row(n, b, dir); const LAS float* cur = buf + (n & 1) * 384;
            float nextv = 0.f; if (n + 1 < NT && F.tid < 384) { const int m2 = scan_row(n + 1, b, dir); nextv = DNQ[(size_t)m2 * 1536 + (F.tid >> 7) * 512 + h * 128 + (F.tid & 127)]; }
            const float beta = BG[m * 16 + dir * 4 + h], decay = __expf(BG[m * 16 + 8 + dir * 4 + h]);
            float ks = 0.f;
#pragma unroll
            for (int i = 0; i < 32; ++i) ks += cur[128 + kq * 32 + i] * S[i];
            red[kq * 128 + dvc] = ks;
            __syncthreads();
            const float kS = (red[dvc] + red[128 + dvc]) + (red[256 + dvc] + red[384 + dvc]);
            const float upd = beta * (cur[256 + dvc] - decay * kS);
            float os = 0.f;
#pragma unroll
            for (int i = 0; i < 32; ++i) { S[i] = decay * S[i] + cur[128 + kq * 32 + i] * upd; os += cur[kq * 32 + i] * S[i]; }
            red2[kq * 128 + dvc] = os;
            if (F.tid < 384) buf[((n + 1) & 1) * 384 + F.tid] = nextv;
            __syncthreads();
            if (kq == 0) O[((size_t)dir * NTOK + m) * 512 + h * 128 + dvc] = (red2[dvc] + red2[128 + dvc]) + (red2[256 + dvc] + red2[384 + dvc]);
        }
    }
#endif
#if defined(USE_CHUNK_LRU)
    else if (F.bid < 32 * DN_SPLIT + 8) { lru_carry(F, (F.bid - 32 * DN_SPLIT) * NTHREADS + F.tid); }
#else
    else if (F.bid < 40) {
        const int idx = (F.bid - 32) * NTHREADS + F.tid, ch = idx & 511, dir = (idx >> 9) & 1, b = idx >> 10;
        const float* A = (const float*)(F.ws + WS_LRA); float* U = (float*)(F.ws + WS_LRH);
        float hs = 0.f;
#pragma unroll 4
        for (int n = 0; n < CTXL + SEQ; ++n) { int m; if (n < CTXL) { const int t = dir ? (CTXL - 1 - n) : n; m = NLAT + b * CTXL + t; } else { const int t = dir ? (SEQ - 1 - (n - CTXL)) : (n - CTXL); m = b * SEQ + t; }
            const size_t o = ((size_t)dir * NTOK + m) * 512 + ch; hs = A[o] * hs + U[o]; U[o] = hs; }
    }
#endif
#if defined(USE_MFMA_ATTN)
#if SCAN_SPLIT_ORDER
    if ((F.bid & 3) >= SCAN_ATTN_FIRST) { convert_moe_queue(F, l, rep); attn_phase(F, l, rep); } else { attn_phase(F, l, rep); convert_moe_queue(F, l, rep); }
#else
    attn_phase(F, l, rep);
    convert_moe_queue(F, l, rep);
#endif
#else
    {
        const int nrows = (l == 0) ? NTOK : NLAT;
        for (;;) { int m = 0; if (F.lane == 0) m = (int)__hip_atomic_fetch_add(F.ctl + CW_ATQ + 64 * l, 1u, RLX_AGENT); m = __builtin_amdgcn_readfirstlane(m);
            if (m >= nrows) break;
#pragma unroll 1
            for (int hq = 0; hq < 16; ++hq) naive_attn_row(F, l, m, hq); }
    }
#endif
}

__device__ __forceinline__ void naive_fin(Frame& F, int l) {
    const int nrows = (l == 0) ? NTOK : NLAT;
    const bf16* P = (const bf16*)(F.ws + WS_P); bf16* CC = (bf16*)(F.ws + WS_CC);
    const int gw = F.bid * NWAVES + F.wave, NGW = F.G * NWAVES;
    const float* O = (const float*)(F.ws + WS_DNO); const float* HS = (const float*)(F.ws + WS_LRH);
    for (int it0 = gw * 2; it0 < nrows * 4; it0 += NGW * 2) {
        float2 oa[2], ob[2]; unsigned gw_[2];
#pragma unroll
        for (int k = 0; k < 2; ++k) { const int it = it0 + k, m = it >> 2, h = it & 3; const int c = h * 128 + 2 * F.lane;
            { const bf16* Ob = (const bf16*)(F.ws + WS_DNO); const unsigned wa = *(const unsigned*)(Ob + (size_t)m * 512 + c), wb = *(const unsigned*)(Ob + ((size_t)NTOK + m) * 512 + c); oa[k] = make_float2(bflo(wa), bfhi(wa)); ob[k] = make_float2(bflo(wb), bfhi(wb)); } gw_[k] = *(const unsigned*)(P + (size_t)m * PW + PC_DG + c); }
        const float2 ng = *(const float2*)(F.in[I_DNNG] + l * 128 + 2 * F.lane);
#pragma unroll
        for (int k = 0; k < 2; ++k) { const int it = it0 + k, m = it >> 2, h = it & 3; const float o0 = oa[k].x + ob[k].x, o1 = oa[k].y + ob[k].y;
            const float rstd = 1.0f / sqrtf(wave_sum(o0 * o0 + o1 * o1) * (1.0f / 128.0f) + EPS);
#if FP8_OUTPROJ
            *(unsigned short*)((unsigned char*)CC + (size_t)m * DM + 1024 + h * 128 + 2 * F.lane) = (unsigned short)(pk4_fp8(o0 * rstd * ng.x * siluf_(bflo(gw_[k])), o1 * rstd * ng.y * siluf_(bfhi(gw_[k])), 0.f, 0.f) & 0xffffu); }
#else
            *(unsigned*)(CC + (size_t)m * DM + 1024 + h * 128 + 2 * F.lane) = pk2(o0 * rstd * ng.x * siluf_(bflo(gw_[k])), o1 * rstd * ng.y * siluf_(bfhi(gw_[k]))); }
#endif
    }
#if defined(USE_CHUNK_LRU)
    lru_fin(F, l);
#else
    for (size_t i = (size_t)F.bid * NTHREADS + F.tid; i < (size_t)nrows * 512; i += (size_t)F.G * NTHREADS) { const int m = (int)(i >> 9), ch = (int)(i & 511);
        const float hsum = HS[(size_t)m * 512 + ch] + HS[((size_t)NTOK + m) * 512 + ch]; const float y = bf2f(P[(size_t)m * PW + PC_LY + ch]);
        CC[(size_t)m * DM + 1536 + ch] = (bf16)f2bf(hsum * gelu_tanh(y)); }
#endif
}
#ifndef PHASE_PREP
#if defined(USE_MFMA_ATTN)
#if defined(USE_CHUNK_DN)
#define PHASE_PREP(F, l) do { attn_prep(F, l); lru_prep(F, l); dn_prep(F, l); } while (0)
#else
#define PHASE_PREP(F, l) do { naive_prep(F, l); attn_prep(F, l); } while (0)
#endif
#else
#define PHASE_PREP(F, l) naive_prep(F, l)
#endif
#endif
#ifndef PHASE_SCAN
#define PHASE_SCAN(F, l) naive_scan(F, l)
#endif
#ifndef PHASE_FIN
#define PHASE_FIN(F, l) naive_fin(F, l)
#endif

#ifndef PHASE_INPROJ
#define PHASE_INPROJ(F, l) do {} while (0)
#endif
#ifndef PHASE_PREP
#define PHASE_PREP(F, l) do {} while (0)
#endif
#ifndef PHASE_SCAN
#define PHASE_SCAN(F, l) do {} while (0)
#endif
#ifndef PHASE_FIN
#define PHASE_FIN(F, l) do {} while (0)
#endif
#ifndef PHASE_OUTPROJ
#define PHASE_OUTPROJ(F, l) do {} while (0)
#endif
#ifndef PHASE_NORM2
#define PHASE_NORM2(F, l) do {} while (0)
#endif
#ifndef PHASE_SCATTER
#define PHASE_SCATTER(F, l) do {} while (0)
#endif
#ifndef PHASE_GEMM1
#define PHASE_GEMM1(F, l) do {} while (0)
#endif
#ifndef PHASE_GEMM2
#define PHASE_GEMM2(F, l) do {} while (0)
#endif

#ifndef MK_SPLIT
#define MK_SPLIT 0
#endif
#ifndef MK_STAGE
#define MK_STAGE 99
#endif
#ifndef MK_TAILFILL
#define MK_TAILFILL 0
#endif
#ifndef MK_DUP
#define MK_DUP 0
#endif
#define DUP(k) ((MK_DUP >> (k)) & 1)
constexpr int N_PHASES = 23;
struct Args { const float* in[N_IN]; float* out; unsigned char* ws; int ph_lo, ph_hi; };
static_assert(sizeof(Args) == (N_IN + 2) * 8 + 8, "Args has no padding");

__global__ void __launch_bounds__(NTHREADS, 2) fwd_kernel(Args args) {
    extern __shared__ __attribute__((aligned(16))) unsigned char lds[];
    Frame F;
    F.lds = (LAS unsigned char*)lds;
    F.MISC = (volatile LAS unsigned*)(F.lds + MISC_OFF);
    F.tid = threadIdx.x; F.lane = F.tid & 63; F.wave = __builtin_amdgcn_readfirstlane(F.tid >> 6);
    F.G = 256; F.bid = blockIdx.x;
    F.ws = args.ws; F.out = args.out; F.ctl = (gu32*)(args.ws + WS_CTL);
    F.in = (const float* const __attribute__((address_space(4)))*)__builtin_amdgcn_kernarg_segment_ptr();
    for (int u = F.tid; u < (LDS_BYTES - LDSCTL_OFF) / 4; u += NTHREADS) ((LAS unsigned*)(F.lds + LDSCTL_OFF))[u] = 0u;
    __syncthreads();
    XcdBarrier bar; bar.bar = (unsigned*)(F.ctl + CW_BAR); bar.x = 0; bar.st = nullptr;
    if (!MK_SPLIT) bar = xcd_barrier_post((unsigned*)(F.ctl + CW_BAR), F.MISC + 8);
    const int lo = args.ph_lo, hi = args.ph_hi;
#define IN(k) (lo <= (k) && (k) < hi && phase_enter(F))
#define INR(k) (lo <= (k) && (k) < hi)
#define SEAM(k) do { if (INR(k) && INR((k) + 1)) { if (MK_TAILFILL && (k) < 15) tail_fill(F, (k), (k) < 5 ? 0 : 1); xcd_barrier(bar); } } while (0)

    if (IN(0)) { p0_prologue_a(F); } SEAM(0);
    if (IN(1)) { p0_prologue_b(F); if (DUP(0)) { __syncthreads(); p0_prologue_b(F); } } SEAM(1);
#pragma unroll 1
    for (int l = 0; l < DEPTH; ++l) {
        const int pb = 2 + 10 * l;
        if (IN(pb + 0)) { phase_norm1(F, l); if (DUP(13) && l == 0) { __syncthreads(); phase_norm1(F, l); } } SEAM(pb + 0);
        if (IN(pb + 1)) { PHASE_INPROJ(F, l); if (DUP(1)) { __syncthreads(); PHASE_INPROJ(F, l); } } SEAM(pb + 1);
        if (IN(pb + 2)) { PHASE_PREP(F, l); if (DUP(2)) { __syncthreads(); dn_prep(F, l); } if (DUP(6)) { __syncthreads(); lru_prep(F, l); } } SEAM(pb + 2);
        if (IN(pb + 3)) { if (DUP(3) && F.bid < 64) dn_scan(F, l, F.bid >> 4, (F.bid >> 2) & 3, (F.bid >> 1) & 1, F.bid & 1); PHASE_SCAN(F, l); if (DUP(10)) { __syncthreads(); naive_scan(F, l, 1); } if (DUP(11)) { __syncthreads(); attn_phase(F, l, 2); } if (DUP(12)) { __syncthreads(); convert_moe_queue(F, l, 3); } } SEAM(pb + 3);
        if (IN(pb + 4)) { PHASE_FIN(F, l); if (DUP(4)) { __syncthreads(); PHASE_FIN(F, l); } } SEAM(pb + 4);
        if (IN(pb + 5)) { PHASE_OUTPROJ(F, l); if (DUP(5) && l == 0) { __syncthreads(); PHASE_OUTPROJ(F, l); } } SEAM(pb + 5);
        if (IN(pb + 6)) { PHASE_NORM2(F, l); } SEAM(pb + 6);
        if (IN(pb + 7)) { PHASE_SCATTER(F, l); if (DUP(7)) { __syncthreads(); PHASE_SCATTER(F, l); } } SEAM(pb + 7);
        if (IN(pb + 8)) { PHASE_GEMM1(F, l); if (DUP(8)) { __syncthreads(); PHASE_GEMM1(F, l); } } SEAM(pb + 8);
        if (IN(pb + 9)) { PHASE_GEMM2(F, l); if (DUP(9)) { __syncthreads(); PHASE_GEMM2(F, l); } } SEAM(pb + 9);
    }
    if (IN(22)) { phase_final(F, MK_STAGE >= 9); if (DUP(13)) { __syncthreads(); phase_final(F, MK_STAGE >= 9); } }
#undef IN
#undef SEAM
}

extern "C" void kernel_launch(void* const* d_in, const int* in_sizes, int n_in, void* d_out, int out_size, void* d_ws, size_t ws_size, hipStream_t stream) {
    static int grid = 0;
    if (grid == 0) {
        if (n_in != N_IN || out_size != NLAT * DM || ws_size < WS_END) { fprintf(stderr, "kernel_launch: unexpected shapes (n_in %d, out %d, ws %zu); nothing launched\n", n_in, out_size, ws_size); grid = -1; return; }
        int dev = 0, cus = 0, per_cu = 0;
        if (hipGetDevice(&dev) != hipSuccess || hipDeviceGetAttribute(&cus, hipDeviceAttributeMultiprocessorCount, dev) != hipSuccess) { grid = -1; return; }
        if (hipFuncSetAttribute((const void*)fwd_kernel, hipFuncAttributeMaxDynamicSharedMemorySize, LDS_BYTES) != hipSuccess) { fprintf(stderr, "kernel_launch: hipFuncSetAttribute failed\n"); grid = -1; return; }
        if (hipOccupancyMaxActiveBlocksPerMultiprocessor(&per_cu, (const void*)fwd_kernel, NTHREADS, LDS_BYTES) != hipSuccess || per_cu < 1) { fprintf(stderr, "kernel_launch: occupancy query says %d\n", per_cu); }
        (void)hipGetLastError();
        grid = cus;
        if (grid != 256) { fprintf(stderr, "kernel_launch: built for 256 CUs, device has %d; nothing launched\n", cus); grid = -1; return; }
    }
    if (grid < 0) return;
    if (hipMemsetAsync((char*)d_ws + WS_CTL, 0, CTL_ZERO_BYTES, stream) != hipSuccess) return;
    Args a{};
    for (int i = 0; i < N_IN; ++i) a.in[i] = (const float*)d_in[i];
    a.out = (float*)d_out; a.ws = (unsigned char*)d_ws;
#if MK_SPLIT
    for (int p = 0; p < N_PHASES; ++p) { a.ph_lo = p; a.ph_hi = p + 1; hipLaunchKernelGGL(fwd_kernel, dim3(grid), dim3(NTHREADS), LDS_BYTES, stream, a); }
#else
    a.ph_lo = 0; a.ph_hi = N_PHASES;
    hipLaunchKernelGGL(fwd_kernel, dim3(grid), dim3(NTHREADS), LDS_BYTES, stream, a);
#endif
    const hipError_t le = hipPeekAtLastError();
    if (le != hipSuccess) fprintf(stderr, "kernel_launch: launch failed: %s\n", hipGetErrorName(le));
}
```

```cpp
#include <hip/hip_runtime.h>
#include <cstdio>
#include <cstdint>

constexpr int DM = 2048, NB = 4, SEQ = 4096, CTXL = 256, DEPTH = 2;
constexpr int NLAT = NB * SEQ, NCTX = NB * CTXL, NTOK = NLAT + NCTX;
constexpr int NCT = NTOK / 64;
constexpr int IN_W = 4624, PW = 4864;
constexpr int PC_Q = 0, PC_K = 1024, PC_V = 1280, PC_DQ = 1536, PC_DK = 2048, PC_DV = 2560, PC_DG = 3072, PC_LX = 3584, PC_LY = 4096, PC_BETA = 4608, PC_DEC = 4616;
constexpr int NEXP = 32, TOPK = 4, DEXP = 1024;
constexpr int MOE_ROWS = 304 * 256;
constexpr float EPS = 1e-6f;
#ifndef MK_STAGE
#define MK_STAGE 99
#endif
#ifndef FP8_INPROJ
#define FP8_INPROJ 0
#endif
#ifndef FP8_OUTPROJ
#define FP8_OUTPROJ 0
#endif
#ifndef SCAN_SPLIT_ORDER
#define SCAN_SPLIT_ORDER 1
#endif
#ifndef X_BF16
#define X_BF16 1
#endif
#ifndef SCAN_ATTN_FIRST
#define SCAN_ATTN_FIRST 2
#endif
#ifndef OUTPROJ_SLACK_TICKS
#define OUTPROJ_SLACK_TICKS 0
#endif
#ifndef YS_FP8
#define YS_FP8 1
#endif
#ifndef MK_TIME
#define MK_TIME 0
#endif
#ifndef I8_INPROJ
#define I8_INPROJ 1
#endif
namespace pg8 {
#define PG8_LAS __attribute__((address_space(3)))
typedef unsigned short bf16_t;
typedef short bf16x8 __attribute__((ext_vector_type(8)));
typedef float f32x4 __attribute__((ext_vector_type(4)));
typedef unsigned u32x4 __attribute__((ext_vector_type(4)));
typedef float f32x2 __attribute__((ext_vector_type(2)));
constexpr int BM = 256, BK = 64, HALF = 128, HTB = HALF * BK * 2  , STAGE_BYTES = 8 * HTB, NXCD = 8, WGM = 8;

__host__ __device__ __forceinline__ int lds_byte(int r, int c) { const int st = (r >> 4) * 2 + (c >> 5), rr = r & 15, cc = c & 31, ob = rr * 64 + cc * 2; return st * 1024 + (ob ^ (((ob >> 9) & 1) << 5)); }
__host__ __device__ __forceinline__ void stage_rc(int b, int& R, int& C) { const int st = b / 1024, sb = b % 1024, swz = sb ^ (((sb >> 9) & 1) << 5); R = (st >> 1) * 16 + swz / 64; C = (st & 1) * 32 + (swz % 64) / 2; }
__host__ __device__ __forceinline__ int perm32(int rho) { const int n = rho >> 4, i = rho & 15; return 8 * (i >> 2) + 4 * n + (i & 3); }

struct Unit { int pm, pn, e; };
typedef int v4i_t __attribute__((ext_vector_type(4)));
typedef int v8i_t __attribute__((ext_vector_type(8)));
struct Gemm { const bf16_t* A; const bf16_t* Bt; int M, N, K; int bscale = 0x7F7F7F7F; };

struct StaticOrder {
    static constexpr bool GATHER = false, IDENT = false; const int* row_tab = nullptr;
    int nM, nN, nwg, G, c; const char* A; const char* Bt; size_t tstep;
    __device__ void init(const Gemm& g, int G_, int c_) { nM = g.M / BM; nN = g.N / BM; nwg = nM * nN; G = G_; c = c_; A = (const char*)g.A; Bt = (const char*)g.Bt; tstep = (size_t)BM * g.K * 2; }
    __device__ bool next(int i, Unit& u) const {
        const long L = (long)i * G + c; if (L >= nwg) return false;
        int wgid = (int)L; { const int q = nwg / NXCD, r = nwg % NXCD, xcd = wgid % NXCD, off = wgid / NXCD; wgid = (xcd < r ? xcd * (q + 1) : r * (q + 1) + (xcd - r) * q) + off; }
        const int nig = WGM * nN, gid = wgid / nig, fm = gid * WGM, gsz = (nM - fm) < WGM ? (nM - fm) : WGM;
        u.pm = fm + ((wgid % nig) % gsz); u.pn = (wgid % nig) / gsz; u.e = 0; return true;
    }
    __device__ __forceinline__ const char* a_ptr(const Unit& u) const { return A + (size_t)u.pm * tstep; }
    __device__ __forceinline__ const char* b_ptr(const Unit& u) const { return Bt + (size_t)u.pn * tstep; }
    __device__ __forceinline__ void a_ready(const Unit&) const {}
    __device__ __forceinline__ void done(const Unit&) const {}
};
struct StaticOrderG : StaticOrder {
    static constexpr bool GATHER = true, IDENT = true;
    __device__ __forceinline__ const char* a_ptr(const Unit&) const { return A; }
};
__device__ __forceinline__ unsigned cvt_pk_bf16(float lo, float hi) { unsigned r; asm volatile("v_cvt_pk_bf16_f32 %0, %1, %2" : "=v"(r) : "v"(lo), "v"(hi)); return r; }
struct EpiBf16Plain {
    static constexpr bool PERM = true, AFTER_DRAIN = false;
    bf16_t* O; int ldc;
    __device__ __forceinline__ void operator()(const f32x4 (&acc)[2][2][4][2], const Unit& u, int wr, int wc, int fr, int fq) const {
        const int row0 = u.pm * BM + wr * 64 + fr, col0 = u.pn * BM + wc * 32 + 8 * fq;
#pragma unroll
        for (int ai = 0; ai < 2; ++ai)
#pragma unroll
            for (int m = 0; m < 4; ++m) { bf16_t* rowp = O + (size_t)(row0 + ai * HALF + m * 16) * ldc + col0;
#pragma unroll
                for (int bj = 0; bj < 2; ++bj) { const f32x4 v0 = acc[ai][bj][m][0], v1 = acc[ai][bj][m][1];
                    u32x4 w; w.x = cvt_pk_bf16(v0[0], v0[1]); w.y = cvt_pk_bf16(v0[2], v0[3]); w.z = cvt_pk_bf16(v1[0], v1[1]); w.w = cvt_pk_bf16(v1[2], v1[3]);
                    *(u32x4*)(rowp + bj * HALF) = w; } }
    }
};
struct EpiBf16PlainI8 {
    static constexpr bool PERM = true, AFTER_DRAIN = false;
    bf16_t* O; int ldc; const float* rs; const float* cs;
    __device__ __forceinline__ void operator()(const f32x4 (&acc)[2][2][4][2], const Unit& u, int wr, int wc, int fr, int fq) const {
        const int row0 = u.pm * BM + wr * 64 + fr, col0 = u.pn * BM + wc * 32 + 8 * fq;
        f32x4 cv[2][2];
#pragma unroll
        for (int bj = 0; bj < 2; ++bj)
#pragma unroll
            for (int n = 0; n < 2; ++n) cv[bj][n] = *(const f32x4*)(cs + col0 + bj * HALF + 4 * n);
#pragma unroll
        for (int ai = 0; ai < 2; ++ai)
#pragma unroll
            for (int m = 0; m < 4; ++m) { const int row = row0 + ai * HALF + m * 16; const float r = rs[row]; bf16_t* rowp = O + (size_t)row * ldc + col0;
#pragma unroll
                for (int bj = 0; bj < 2; ++bj) { const v4i_t i0 = __builtin_bit_cast(v4i_t, acc[ai][bj][m][0]), i1 = __builtin_bit_cast(v4i_t, acc[ai][bj][m][1]);
                    const f32x4 v0 = (f32x4){(float)i0.x, (float)i0.y, (float)i0.z, (float)i0.w} * cv[bj][0] * r, v1 = (f32x4){(float)i1.x, (float)i1.y, (float)i1.z, (float)i1.w} * cv[bj][1] * r;
                    u32x4 w; w.x = cvt_pk_bf16(v0[0], v0[1]); w.y = cvt_pk_bf16(v0[2], v0[3]); w.z = cvt_pk_bf16(v1[0], v1[1]); w.w = cvt_pk_bf16(v1[2], v1[3]);
                    *(u32x4*)(rowp + bj * HALF) = w; } }
    }
};
struct EpiResGate {
    static constexpr bool PERM = false, AFTER_DRAIN = false;
    const float* base_lat; const float* base_ctx; float* out; const float* modg;
    __device__ __forceinline__ void operator()(const f32x4 (&acc)[2][2][4][2], const Unit& u, int wr, int wc, int fr, int fq) const {
        const int r = u.pm < 64 ? (u.pm >> 4) : 4; const int col0 = u.pn * BM + wc * 32 + 4 * fq;
        const float* g = modg + (size_t)r * 12288 + col0;
        f32x4 gv[2][2];
#pragma unroll
        for (int bj = 0; bj < 2; ++bj)
#pragma unroll
            for (int n = 0; n < 2; ++n) gv[bj][n] = *(const f32x4*)(g + bj * HALF + n * 16);
#pragma unroll
        for (int ai = 0; ai < 2; ++ai)
#pragma unroll
            for (int m = 0; m < 4; ++m) { const int row = u.pm * BM + ai * HALF + wr * 64 + m * 16 + fr;
                const float* bp = (row < 16384 ? base_lat + (size_t)row * 2048 : base_ctx + (size_t)(row - 16384) * 2048) + col0; float* op = out + (size_t)row * 2048 + col0;
#pragma unroll
                for (int bj = 0; bj < 2; ++bj)
#pragma unroll
                    for (int n = 0; n < 2; ++n) { const f32x4 b = *(const f32x4*)(bp + bj * HALF + n * 16); *(f32x4*)(op + bj * HALF + n * 16) = b + gv[bj][n] * acc[ai][bj][m][n]; }
                asm volatile("" ::: "memory"); }
    }
};
struct EpiResGateB {
    static constexpr bool PERM = true, AFTER_DRAIN = false;
    const float* base_lat; const float* base_ctx; const bf16_t* xb_in; bf16_t* xb_out; const float* modg; int f32base;
    __device__ __forceinline__ void operator()(const f32x4 (&acc)[2][2][4][2], const Unit& u, int wr, int wc, int fr, int fq) const {
        const int r = u.pm < 64 ? (u.pm >> 4) : 4; const int col0 = u.pn * BM + wc * 32 + 8 * fq;
        const float* g = modg + (size_t)r * 12288 + col0;
        f32x4 gv[2][2];
#pragma unroll
        for (int bj = 0; bj < 2; ++bj)
#pragma unroll
            for (int n = 0; n < 2; ++n) gv[bj][n] = *(const f32x4*)(g + bj * HALF + 4 * n);
#pragma unroll
        for (int ai = 0; ai < 2; ++ai)
#pragma unroll
            for (int m = 0; m < 4; ++m) { const int row = u.pm * BM + ai * HALF + wr * 64 + m * 16 + fr;
#pragma unroll
                for (int bj = 0; bj < 2; ++bj) { f32x4 b0, b1;
                    if (f32base) { const float* bp = (row < 16384 ? base_lat + (size_t)row * 2048 : base_ctx + (size_t)(row - 16384) * 2048) + col0 + bj * HALF; b0 = *(const f32x4*)bp; b1 = *(const f32x4*)(bp + 4); }
                    else { const u32x4 w = *(const u32x4*)(xb_in + (size_t)row * 2048 + col0 + bj * HALF);
                        b0 = (f32x4){__builtin_bit_cast(float, w.x << 16), __builtin_bit_cast(float, w.x & 0xffff0000u), __builtin_bit_cast(float, w.y << 16), __builtin_bit_cast(float, w.y & 0xffff0000u)};
                        b1 = (f32x4){__builtin_bit_cast(float, w.z << 16), __builtin_bit_cast(float, w.z & 0xffff0000u), __builtin_bit_cast(float, w.w << 16), __builtin_bit_cast(float, w.w & 0xffff0000u)}; }
                    const f32x4 v0 = b0 + gv[bj][0] * acc[ai][bj][m][0], v1 = b1 + gv[bj][1] * acc[ai][bj][m][1];
                    u32x4 o; o.x = cvt_pk_bf16(v0[0], v0[1]); o.y = cvt_pk_bf16(v0[2], v0[3]); o.z = cvt_pk_bf16(v1[0], v1[1]); o.w = cvt_pk_bf16(v1[2], v1[3]);
                    *(u32x4*)(xb_out + (size_t)row * 2048 + col0 + bj * HALF) = o; }
                asm volatile("" ::: "memory"); }
    }
};
struct EpiSwiglu {
    static constexpr bool PERM = true, AFTER_DRAIN = false;
    bf16_t* O; const float* bgu;
    __device__ __forceinline__ void operator()(const f32x4 (&acc)[2][2][4][2], const Unit& u, int wr, int wc, int fr, int fq) const {
        const int row0 = u.pm * BM + wr * 64 + fr, cc0 = wc * 32 + 8 * fq;
        const float* bg = bgu + (size_t)u.e * 2048 + u.pn * 128 + cc0;
        f32x4 bglu[2], blin[2];
#pragma unroll
        for (int n = 0; n < 2; ++n) { bglu[n] = *(const f32x4*)(bg + 4 * n); blin[n] = *(const f32x4*)(bg + 1024 + 4 * n); }
#pragma unroll
        for (int ai = 0; ai < 2; ++ai)
#pragma unroll
            for (int m = 0; m < 4; ++m) { bf16_t* rowp = O + (size_t)(row0 + ai * HALF + m * 16) * 1024 + u.pn * 128 + cc0;
                float r[8];
#pragma unroll
                for (int n = 0; n < 2; ++n) { const f32x4 g = acc[ai][0][m][n] + bglu[n], l = acc[ai][1][m][n] + blin[n];
#pragma unroll
                    for (int i = 0; i < 4; ++i) { const float gg = fminf(g[i], 7.0f); const float ll = fminf(fmaxf(l[i], -7.0f), 7.0f);
                        r[4 * n + i] = (ll + 1.0f) * gg * __builtin_amdgcn_rcpf(1.0f + __builtin_amdgcn_exp2f(-1.702f * 1.4426950408889634f * gg)); } }
                u32x4 w; w.x = cvt_pk_bf16(r[0], r[1]); w.y = cvt_pk_bf16(r[2], r[3]); w.z = cvt_pk_bf16(r[4], r[5]); w.w = cvt_pk_bf16(r[6], r[7]);
                *(u32x4*)rowp = w; }
    }
};
struct EpiSwiglu8 {
    static constexpr bool PERM = true, AFTER_DRAIN = false;
    unsigned char* O; const float* bgu;
    __device__ __forceinline__ void operator()(const f32x4 (&acc)[2][2][4][2], const Unit& u, int wr, int wc, int fr, int fq) const {
        const int row0 = u.pm * BM + wr * 64 + fr, cc0 = wc * 32 + 8 * fq;
        const float* bg = bgu + (size_t)u.e * 2048 + u.pn * 128 + cc0;
        f32x4 bglu[2], blin[2];
#pragma unroll
        for (int n = 0; n < 2; ++n) { bglu[n] = *(const f32x4*)(bg + 4 * n); blin[n] = *(const f32x4*)(bg + 1024 + 4 * n); }
#pragma unroll
        for (int ai = 0; ai < 2; ++ai)
#pragma unroll
            for (int m = 0; m < 4; ++m) { unsigned char* rowp = O + (size_t)(row0 + ai * HALF + m * 16) * 1024 + u.pn * 128 + cc0;
                float r[8];
#pragma unroll
                for (int n = 0; n < 2; ++n) { const f32x4 g = acc[ai][0][m][n] + bglu[n], l = acc[ai][1][m][n] + blin[n];
#pragma unroll
                    for (int i = 0; i < 4; ++i) { const float gg = fminf(g[i], 7.0f); const float ll = fminf(fmaxf(l[i], -7.0f), 7.0f);
                        r[4 * n + i] = (ll + 1.0f) * gg * __builtin_amdgcn_rcpf(1.0f + __builtin_amdgcn_exp2f(-1.702f * 1.4426950408889634f * gg)); } }
                int w0 = 0, w1 = 0; w0 = __builtin_amdgcn_cvt_pk_fp8_f32(r[0], r[1], w0, false); w0 = __builtin_amdgcn_cvt_pk_fp8_f32(r[2], r[3], w0, true); w1 = __builtin_amdgcn_cvt_pk_fp8_f32(r[4], r[5], w1, false); w1 = __builtin_amdgcn_cvt_pk_fp8_f32(r[6], r[7], w1, true);
                typedef unsigned u32x2 __attribute__((ext_vector_type(2))); *(u32x2*)rowp = (u32x2){(unsigned)w0, (unsigned)w1}; }
    }
};
struct EpiDown {
    static constexpr bool PERM = true, AFTER_DRAIN = false;
    bf16_t* O; const float* bdn; const float* rowg;
    __device__ __forceinline__ void operator()(const f32x4 (&acc)[2][2][4][2], const Unit& u, int wr, int wc, int fr, int fq) const {
        const int row0 = u.pm * BM + wr * 64 + fr, col0 = u.pn * BM + wc * 32 + 8 * fq;
        const float* bb = bdn + (size_t)u.e * 2048 + col0;
        float gt[2][4];
#pragma unroll
        for (int ai = 0; ai < 2; ++ai)
#pragma unroll
            for (int m = 0; m < 4; ++m) gt[ai][m] = rowg[row0 + ai * HALF + m * 16];
#pragma unroll
        for (int bj = 0; bj < 2; ++bj) { const f32x4 b0 = *(const f32x4*)(bb + bj * HALF), b1 = *(const f32x4*)(bb + bj * HALF + 4);
#pragma unroll
            for (int ai = 0; ai < 2; ++ai)
#pragma unroll
                for (int m = 0; m < 4; ++m) { const int row = row0 + ai * HALF + m * 16; const f32x4 v0 = (acc[ai][bj][m][0] + b0) * gt[ai][m], v1 = (acc[ai][bj][m][1] + b1) * gt[ai][m];
                    u32x4 w; w.x = cvt_pk_bf16(v0[0], v0[1]); w.y = cvt_pk_bf16(v0[2], v0[3]); w.z = cvt_pk_bf16(v1[0], v1[1]); w.w = cvt_pk_bf16(v1[2], v1[3]);
                    *(u32x4*)(O + (size_t)row * 2048 + col0 + bj * HALF) = w; } }
    }
};
struct EpiDown8 {
    static constexpr bool PERM = true, AFTER_DRAIN = false;
    unsigned char* O; const float* bdn; const float* rowg;
    __device__ __forceinline__ void operator()(const f32x4 (&acc)[2][2][4][2], const Unit& u, int wr, int wc, int fr, int fq) const {
        const int row0 = u.pm * BM + wr * 64 + fr, col0 = u.pn * BM + wc * 32 + 8 * fq;
        const float* bb = bdn + (size_t)u.e * 2048 + col0;
        float gt[2][4];
#pragma unroll
        for (int ai = 0; ai < 2; ++ai)
#pragma unroll
            for (int m = 0; m < 4; ++m) gt[ai][m] = 16.0f * rowg[row0 + ai * HALF + m * 16];
#pragma unroll
        for (int bj = 0; bj < 2; ++bj) { const f32x4 b0 = *(const f32x4*)(bb + bj * HALF), b1 = *(const f32x4*)(bb + bj * HALF + 4);
#pragma unroll
            for (int ai = 0; ai < 2; ++ai)
#pragma unroll
                for (int m = 0; m < 4; ++m) { const int row = row0 + ai * HALF + m * 16; const f32x4 v0 = (acc[ai][bj][m][0] + b0) * gt[ai][m], v1 = (acc[ai][bj][m][1] + b1) * gt[ai][m];
                    int w0 = 0, w1 = 0; w0 = __builtin_amdgcn_cvt_pk_fp8_f32(v0[0], v0[1], w0, false); w0 = __builtin_amdgcn_cvt_pk_fp8_f32(v0[2], v0[3], w0, true); w1 = __builtin_amdgcn_cvt_pk_fp8_f32(v1[0], v1[1], w1, false); w1 = __builtin_amdgcn_cvt_pk_fp8_f32(v1[2], v1[3], w1, true);
                    typedef unsigned u32x2 __attribute__((ext_vector_type(2))); *(u32x2*)(O + (size_t)row * 2048 + col0 + bj * HALF) = (u32x2){(unsigned)w0, (unsigned)w1}; } }
    }
};
template <bool GATHER_, bool IDENT_ = false> struct MoeOrderT {
    static constexpr bool GATHER = GATHER_, IDENT = IDENT_;
    int c, nblk; const char* A; const char* Bt; size_t a_tstep, b_estep, b_tstep; const PG8_LAS int* blk_end; const int* row_tab;
    __device__ __forceinline__ bool next(int i, Unit& u) const {
#if defined(MOE_MAP) && MOE_MAP == 1
        const int L = i * 256 + c, rb = L >> 3, j = (L & 7);
#elif defined(MOE_MAP) && MOE_MAP == 2
        const int x = c & 7, jj = c >> 3, gi = i * 8 + x, rb = 8 * (gi >> 1) + (jj >> 2), j = (jj & 3) + 4 * (gi & 1);
#else
        const int x = c & 7, j = c >> 3, gi = i * 8 + x, rb = 4 * gi + (j >> 3);
#endif
        if (rb >= nblk) return false;
        int e = 0;
        for (int k = 0; k < 31; ++k) e += (rb >= blk_end[k]) ? 1 : 0;
        u.pm = rb; u.pn = j & 7; u.e = __builtin_amdgcn_readfirstlane(e); return true;
    }
    __device__ __forceinline__ const char* a_ptr(const Unit& u) const { return GATHER ? A : A + (size_t)u.pm * a_tstep; }
    __device__ __forceinline__ const char* b_ptr(const Unit& u) const { return Bt + (size_t)u.e * b_estep + (size_t)u.pn * b_tstep; }
    __device__ __forceinline__ void a_ready(const Unit&) const {}
    __device__ __forceinline__ void done(const Unit&) const {}
};
typedef MoeOrderT<false> MoeOrder;
typedef MoeOrderT<true> MoeOrderG;
typedef MoeOrderT<true, true> MoeOrderI;
template <class Epi, class Sched, bool ALIGN_EPI = false, bool SP2 = false, bool FP8 = false, bool I8 = false>
__device__ __forceinline__ void gemm_phase(PG8_LAS unsigned char* lds, const Gemm g, const Sched& S, const Epi& E) {
    int tid = threadIdx.x; asm volatile("" : "+v"(tid));
    const int wid = __builtin_amdgcn_readfirstlane(tid >> 6), lane = tid & 63, wr = wid >> 2, wc = wid & 3, fr = lane & 15, fq = lane >> 4;
    const int K = g.K, nt = K / BK;
    unsigned voffA[2], voffB[2];
#pragma unroll
    for (int i = 0; i < 2; ++i) { int R, C; stage_rc(tid * 16 + i * 8192, R, C); const int Rb = Epi::PERM ? ((R & ~31) + perm32(R & 31)) : R;
        voffA[i] = (unsigned)(R * K + C) * 2u; voffB[i] = (unsigned)(Rb * K + C) * 2u; }
    unsigned gc0[2] = {0u, 0u}, gc1[2] = {0u, 0u}; int gR = 0, gC = 0;
    if constexpr (Sched::GATHER) { stage_rc(tid * 16, gR, gC); }
#define PG8_GLOAD(dst0, dst1, u) do { if constexpr (Sched::IDENT) { const unsigned _r0 = (unsigned)((u).pm * BM + gR);     \
        dst0[0] = _r0 * (unsigned)(K * 2) + (unsigned)(gC * 2); dst0[1] = (_r0 + 64u) * (unsigned)(K * 2) + (unsigned)(gC * 2); dst1[0] = (_r0 + 128u) * (unsigned)(K * 2) + (unsigned)(gC * 2); dst1[1] = (_r0 + 192u) * (unsigned)(K * 2) + (unsigned)(gC * 2); } \
      else { const int* _rt = S.row_tab + (size_t)(u).pm * BM + gR; \
        dst0[0] = (unsigned)_rt[0] * (unsigned)(K * 2) + (unsigned)(gC * 2); dst0[1] = (unsigned)_rt[64] * (unsigned)(K * 2) + (unsigned)(gC * 2); \
        dst1[0] = (unsigned)_rt[128] * (unsigned)(K * 2) + (unsigned)(gC * 2); dst1[1] = (unsigned)_rt[192] * (unsigned)(K * 2) + (unsigned)(gC * 2); } } while (0)
    const size_t kstep = (size_t)(BK * 2);
    const size_t hstep = (size_t)HALF * K * 2;
    const size_t tstep = 2 * hstep;
    const unsigned ldsw = (unsigned)wid * 1024u;
    const int aoff = lds_byte(wr * 64 + fr, fq * 8); int boff = lds_byte(wc * 32 + fr, fq * 8) + 4 * HTB;
    asm volatile("" : "+v"(boff));
#define PG8_SA(b, h) (((b) * 2 + (h)) * HTB)
#define PG8_SB(b, h) ((4 + (b) * 2 + (h)) * HTB)
#define PG8_SBR(b, h) (((b) * 2 + (h)) * HTB)
#define PG8_STAGE(bufoff, gbase, voff) do { _Pragma("unroll") for (int _i = 0; _i < 2; ++_i) \
        __builtin_amdgcn_global_load_lds((const unsigned*)((const char*)(gbase) + (voff)[_i]), (PG8_LAS unsigned*)(lds + (bufoff) + ldsw + _i * 8192), 16, 0, 0); } while (0)
#define PG8_LD16(off) (*(const PG8_LAS v4i_t*)(lds + (off)))
#define PG8_LDA(dst, b, h) do { if constexpr (FP8) { _Pragma("unroll") for (int m = 0; m < 4; ++m) dst##8[m] = __builtin_shufflevector(PG8_LD16(PG8_SA(b, h) + aoff + m * 2048), PG8_LD16(PG8_SA(b, h) + aoff + m * 2048 + 1024), 0, 1, 2, 3, 4, 5, 6, 7); } \
        else { _Pragma("unroll") for (int m = 0; m < 4; ++m) _Pragma("unroll") for (int k = 0; k < 2; ++k) dst[m][k] = *(const PG8_LAS bf16x8*)(lds + PG8_SA(b, h) + aoff + m * 2048 + k * 1024); } } while (0)
#define PG8_LDB(dst, b, h) do { if constexpr (FP8) { _Pragma("unroll") for (int n = 0; n < 2; ++n) dst##8[n] = __builtin_shufflevector(PG8_LD16(PG8_SBR(b, h) + boff + n * 2048), PG8_LD16(PG8_SBR(b, h) + boff + n * 2048 + 1024), 0, 1, 2, 3, 4, 5, 6, 7); } \
        else { _Pragma("unroll") for (int n = 0; n < 2; ++n) _Pragma("unroll") for (int k = 0; k < 2; ++k) dst[n][k] = *(const PG8_LAS bf16x8*)(lds + PG8_SBR(b, h) + boff + n * 2048 + k * 1024); } } while (0)
#define PG8_MMA(ai, bj, At, Bt) do { __builtin_amdgcn_s_setprio(1); \
        if constexpr (FP8) { _Pragma("unroll") for (int m = 0; m < 4; ++m) _Pragma("unroll") for (int n = 0; n < 2; ++n) \
            acc[ai][bj][m][n] = __builtin_amdgcn_mfma_scale_f32_16x16x128_f8f6f4(Bt##8[n], At##8[m], acc[ai][bj][m][n], 0, 0, 0, g.bscale, 0, g.bscale); }     \
        else if constexpr (I8) { _Pragma("unroll") for (int m = 0; m < 4; ++m) _Pragma("unroll") for (int n = 0; n < 2; ++n) _Pragma("unroll") for (int k = 0; k < 2; ++k) \
            acc[ai][bj][m][n] = __builtin_bit_cast(f32x4, __builtin_amdgcn_mfma_i32_16x16x64_i8(__builtin_bit_cast(v4i_t, Bt[n][k]), __builtin_bit_cast(v4i_t, At[m][k]), __builtin_bit_cast(v4i_t, acc[ai][bj][m][n]), 0, 0, 0)); } \
        else { _Pragma("unroll") for (int m = 0; m < 4; ++m) _Pragma("unroll") for (int n = 0; n < 2; ++n) _Pragma("unroll") for (int k = 0; k < 2; ++k) \
            acc[ai][bj][m][n] = __builtin_amdgcn_mfma_f32_16x16x32_bf16(Bt[n][k], At[m][k], acc[ai][bj][m][n], 0, 0, 0); } \
        __builtin_amdgcn_s_setprio(0); } while (0)
#define PG8_WAIT_V(n) asm volatile("s_waitcnt vmcnt(" #n ")" ::: "memory")
#define PG8_WAIT_L(n) asm volatile("s_waitcnt lgkmcnt(" #n ")" ::: "memory")
#define PG8_BAR __builtin_amdgcn_s_barrier()
#define PG8_SCHED __builtin_amdgcn_sched_barrier(0)
    Unit cur, nxt; int ui = 0;
    if (!S.next(0, cur)) return;
    f32x4 acc[2][2][4][2];
#pragma unroll
    for (int a = 0; a < 2; ++a)
#pragma unroll
        for (int b = 0; b < 2; ++b)
#pragma unroll
            for (int m = 0; m < 4; ++m)
#pragma unroll
                for (int n = 0; n < 2; ++n) acc[a][b][m][n] = (f32x4){0.f, 0.f, 0.f, 0.f};
    bf16x8 At[4][2], B0[2][2], B1[2][2]; v8i_t At8[4], B08[2], B18[2];
    const char* cA = S.a_ptr(cur); const char* cB = S.b_ptr(cur);
    S.a_ready(cur);
    if constexpr (SP2) {
        if constexpr (Sched::GATHER) { PG8_GLOAD(gc0, gc1, cur);
        PG8_STAGE(PG8_SB(0, 0), cB, voffB); PG8_STAGE(PG8_SB(0, 1), cB + hstep, voffB); PG8_STAGE(PG8_SA(0, 0), cA, gc0); PG8_STAGE(PG8_SA(0, 1), cA, gc1);
        if (wr == 1) PG8_BAR;
        PG8_WAIT_V(2); PG8_BAR;
        PG8_STAGE(PG8_SB(1, 0), cB + kstep, voffB); PG8_STAGE(PG8_SA(1, 0), cA + kstep, gc0); PG8_STAGE(PG8_SB(1, 1), cB + hstep + kstep, voffB);
        } else {
        PG8_STAGE(PG8_SB(0, 0), cB, voffB); PG8_STAGE(PG8_SB(0, 1), cB + hstep, voffB); PG8_STAGE(PG8_SA(0, 0), cA, voffA); PG8_STAGE(PG8_SA(0, 1), cA + hstep, voffA);
        if (wr == 1) PG8_BAR;
        PG8_WAIT_V(2); PG8_BAR;
        PG8_STAGE(PG8_SB(1, 0), cB + kstep, voffB); PG8_STAGE(PG8_SA(1, 0), cA + kstep, voffA); PG8_STAGE(PG8_SB(1, 1), cB + hstep + kstep, voffB);
        }
        PG8_WAIT_V(6); PG8_BAR;
    } else {
        PG8_STAGE(PG8_SB(0, 0), cB, voffB); PG8_STAGE(PG8_SA(0, 0), cA, voffA); PG8_STAGE(PG8_SB(0, 1), cB + hstep, voffB); PG8_STAGE(PG8_SA(0, 1), cA + hstep, voffA);
        if (wr == 1) PG8_BAR;
        PG8_WAIT_V(4); PG8_BAR;
        PG8_STAGE(PG8_SB(1, 0), cB + kstep, voffB); PG8_STAGE(PG8_SA(1, 0), cA + kstep, voffA); PG8_STAGE(PG8_SB(1, 1), cB + hstep + kstep, voffB);
        PG8_WAIT_V(6); PG8_BAR;
    }
    for (;;) {
        const bool has_next = S.next(ui + 1, nxt);
        const char* nA = has_next ? S.a_ptr(nxt) : cA; const char* nB = has_next ? S.b_ptr(nxt) : cB;
#pragma unroll 1
        for (int t = 0; t < nt; t += 2) {
            const bool last = (t == nt - 2);
            const char* a1 = cA + (size_t)(t + 1) * kstep;
            const char* a2 = last ? nA : cA + (size_t)(t + 2) * kstep; const char* b2 = last ? nB : cB + (size_t)(t + 2) * kstep;
            const char* a3 = a2 + kstep; const char* b3 = b2 + kstep;
            if (last && has_next) S.a_ready(nxt);

            if constexpr (SP2) {
            PG8_LDB(B0, 0, 0); PG8_LDB(B1, 0, 1); PG8_SCHED; PG8_LDA(At, 0, 0); if constexpr (Sched::GATHER) PG8_STAGE(PG8_SA(1, 1), a1, gc1); else PG8_STAGE(PG8_SA(1, 1), a1 + hstep, voffA);
            if constexpr (Sched::GATHER) { if (last && has_next) PG8_GLOAD(gc0, gc1, nxt); }
            PG8_WAIT_V(8); PG8_WAIT_L(0); PG8_BAR; PG8_MMA(0, 0, At, B0); PG8_MMA(0, 1, At, B1); PG8_BAR; PG8_SCHED;
            PG8_LDA(At, 0, 1); PG8_STAGE(PG8_SB(0, 0), b2, voffB); PG8_STAGE(PG8_SB(0, 1), b2 + hstep, voffB); if constexpr (Sched::GATHER) PG8_STAGE(PG8_SA(0, 0), a2, gc0); else PG8_STAGE(PG8_SA(0, 0), a2, voffA);
            PG8_WAIT_V(8); PG8_WAIT_L(0); PG8_BAR; PG8_MMA(1, 0, At, B0); PG8_MMA(1, 1, At, B1); PG8_BAR; PG8_SCHED;
            PG8_LDB(B0, 1, 0); PG8_LDB(B1, 1, 1); PG8_SCHED; PG8_LDA(At, 1, 0); if constexpr (Sched::GATHER) PG8_STAGE(PG8_SA(0, 1), a2, gc1); else PG8_STAGE(PG8_SA(0, 1), a2 + hstep, voffA);
            PG8_WAIT_V(8); PG8_WAIT_L(0); PG8_BAR; PG8_MMA(0, 0, At, B0); PG8_MMA(0, 1, At, B1); PG8_BAR; PG8_SCHED;
            PG8_LDA(At, 1, 1); PG8_STAGE(PG8_SB(1, 0), b3, voffB); PG8_STAGE(PG8_SB(1, 1), b3 + hstep, voffB); if constexpr (Sched::GATHER) PG8_STAGE(PG8_SA(1, 0), a3, gc0); else PG8_STAGE(PG8_SA(1, 0), a3, voffA);
            PG8_WAIT_V(8); PG8_WAIT_L(0); PG8_BAR; PG8_MMA(1, 0, At, B0); PG8_MMA(1, 1, At, B1); PG8_BAR; PG8_SCHED;
            } else {
            PG8_LDB(B0, 0, 0); PG8_SCHED; PG8_LDA(At, 0, 0); PG8_STAGE(PG8_SA(1, 1), a1 + hstep, voffA);
            PG8_WAIT_L(8); PG8_BAR; PG8_WAIT_L(0); PG8_MMA(0, 0, At, B0); PG8_BAR; PG8_SCHED;
            PG8_LDB(B1, 0, 1); PG8_STAGE(PG8_SB(0, 0), b2, voffB);
            PG8_BAR; PG8_WAIT_L(0); PG8_MMA(0, 1, At, B1); PG8_BAR;
            PG8_LDA(At, 0, 1); PG8_STAGE(PG8_SA(0, 0), a2, voffA);
            PG8_BAR; PG8_WAIT_L(0); PG8_MMA(1, 0, At, B0); PG8_BAR; PG8_SCHED;
            PG8_STAGE(PG8_SB(0, 1), b2 + hstep, voffB);
            PG8_WAIT_V(6); PG8_BAR; PG8_MMA(1, 1, At, B1); PG8_BAR;
            PG8_LDB(B0, 1, 0); PG8_SCHED; PG8_LDA(At, 1, 0); PG8_STAGE(PG8_SA(0, 1), a2 + hstep, voffA);
            PG8_WAIT_L(8); PG8_BAR; PG8_WAIT_L(0); PG8_MMA(0, 0, At, B0); PG8_BAR; PG8_SCHED;
            PG8_LDB(B1, 1, 1); PG8_STAGE(PG8_SB(1, 0), b3, voffB);
            PG8_BAR; PG8_WAIT_L(0); PG8_MMA(0, 1, At, B1); PG8_BAR;
            PG8_LDA(At, 1, 1); PG8_STAGE(PG8_SA(1, 0), a3, voffA);
            PG8_BAR; PG8_WAIT_L(0); PG8_MMA(1, 0, At, B0); PG8_BAR; PG8_SCHED;
            PG8_STAGE(PG8_SB(1, 1), b3 + hstep, voffB);
            PG8_WAIT_V(6); PG8_BAR; PG8_MMA(1, 1, At, B1); PG8_BAR;
            }
        }
        if constexpr (ALIGN_EPI) { if (wr == 0) PG8_BAR; }
        if constexpr (!Epi::AFTER_DRAIN) { int fr_e = fr, fq_e = fq; asm volatile("" : "+v"(fr_e), "+v"(fq_e));
            E(acc, cur, wr, wc, fr_e, fq_e); S.done(cur); }
        if (!has_next) break;
#pragma unroll
        for (int a = 0; a < 2; ++a)
#pragma unroll
            for (int b = 0; b < 2; ++b)
#pragma unroll
                for (int m = 0; m < 4; ++m)
#pragma unroll
                    for (int n = 0; n < 2; ++n) acc[a][b][m][n] = (f32x4){0.f, 0.f, 0.f, 0.f};
        cur = nxt; cA = nA; cB = nB; ++ui;
        if constexpr (ALIGN_EPI) { if (wr == 1) PG8_BAR; }
    }
    PG8_WAIT_V(0);
    if constexpr (!ALIGN_EPI) { if (wr == 0) PG8_BAR; }
    PG8_BAR;
    if constexpr (Epi::AFTER_DRAIN) { E.fused(acc, cur, wr, wc, fr, fq, lds, wid, lane); S.done(cur); }
#undef PG8_GLOAD
#undef PG8_SA
#undef PG8_SB
#undef PG8_SBR
#undef PG8_STAGE
#undef PG8_LDA
#undef PG8_LDB
#undef PG8_MMA
#undef PG8_LD16
#undef PG8_WAIT_V
#undef PG8_WAIT_L
#undef PG8_BAR
#undef PG8_SCHED
}
}

constexpr size_t MiB = 1u << 20;
constexpr size_t WS_CTL = 0, CTL_ZERO_BYTES = 1 * MiB;
constexpr size_t WS_MOD  = 1 * MiB;
constexpr size_t WS_WRT  = 2 * MiB;
constexpr size_t WS_MOEI = 3 * MiB;
constexpr size_t WS_IDT  = WS_MOEI + 5 * 512 * 1024;
constexpr size_t WS_LRC  = 6 * MiB;
constexpr size_t WS_DNS  = 12 * MiB;
constexpr size_t WS_RS   = WS_DNS + 2 * MiB;
constexpr size_t WS_CS   = WS_DNS + 3 * MiB;
constexpr size_t WS_WIN  = 16 * MiB;
constexpr size_t WS_WOUT = 56 * MiB;
constexpr size_t WS_WGU  = 72 * MiB;
constexpr size_t WS_WDN  = 584 * MiB;
constexpr size_t WS_X    = 840 * MiB;
constexpr size_t WS_H    = 976 * MiB;
constexpr size_t WS_P    = 1044 * MiB;
constexpr size_t WS_CC   = 1206 * MiB;
constexpr size_t WS_VT   = 1274 * MiB;
constexpr size_t WS_VTC  = WS_VT + 8 * MiB;
constexpr size_t WS_DNT  = 1284 * MiB;
constexpr size_t DNT_BYTES = 90112;
constexpr size_t WS_DNO  = 1472 * MiB;
constexpr size_t WS_LRH  = 1540 * MiB;
constexpr size_t WS_LRA  = 1608 * MiB;
constexpr size_t WS_XS   = 1676 * MiB;
constexpr size_t WS_ACT  = 1980 * MiB;
constexpr size_t WS_YS   = 2132 * MiB;
constexpr size_t WS_END  = 2436 * MiB;
constexpr int CW_TMO = 0;
constexpr int CW_BAR = 4096;
constexpr int CW_CNT = 8192;
constexpr int CW_CMAX = 32768;
constexpr int CW_ATQ = 12288;

constexpr int RING_OFF = 0, RING_BYTES = 131072;
constexpr int LDSCTL_OFF = RING_BYTES, MISC_OFF = LDSCTL_OFF + 320;
constexpr int LDS_X_OFF = RING_BYTES + 1024;
constexpr int LDS_BYTES = 147456;
constexpr int NWAVES = 8, NTHREADS = 512;

#define GAS __attribute__((address_space(1)))
#define LAS __attribute__((address_space(3)))
typedef unsigned short bf16;
typedef unsigned v4u __attribute__((ext_vector_type(4)));
typedef unsigned v2u __attribute__((ext_vector_type(2)));
typedef float f32x4 __attribute__((ext_vector_type(4)));
typedef float f32x16 __attribute__((ext_vector_type(16)));
typedef short bf16x8 __attribute__((ext_vector_type(8)));
typedef short bf16x4 __attribute__((ext_vector_type(4)));
typedef GAS unsigned gu32;
#define RLX_AGENT __ATOMIC_RELAXED, __HIP_MEMORY_SCOPE_AGENT
#define LDS_WAIT() asm volatile("s_waitcnt lgkmcnt(0)" ::: "memory")
#define VM_WAIT() asm volatile("s_waitcnt vmcnt(0)" ::: "memory")
#define LDS_BARRIER() asm volatile("s_waitcnt lgkmcnt(0)\n\ts_barrier" ::: "memory")
typedef __bf16 bf16x2_t __attribute__((ext_vector_type(2)));
typedef float f32x2_t __attribute__((ext_vector_type(2)));
__device__ __forceinline__ unsigned pk2(float lo, float hi) { const f32x2_t v = {lo, hi}; const bf16x2_t b = __builtin_convertvector(v, bf16x2_t); return __builtin_bit_cast(unsigned, b); }
__device__ __forceinline__ unsigned f2bf(float f) { return pk2(f, 0.f) & 0xffffu; }
__device__ __forceinline__ unsigned pk4_fp8(float a, float b, float c, float d) { int x = 0; x = __builtin_amdgcn_cvt_pk_fp8_f32(a, b, x, false); x = __builtin_amdgcn_cvt_pk_fp8_f32(c, d, x, true); return (unsigned)x; }
__device__ __forceinline__ float bf2f(unsigned short b) { return __builtin_bit_cast(float, (unsigned)b << 16); }
__device__ __forceinline__ float bflo(unsigned w) { return __builtin_bit_cast(float, w << 16); }
__device__ __forceinline__ float bfhi(unsigned w) { return __builtin_bit_cast(float, w & 0xffff0000u); }
template <int CTRL> __device__ __forceinline__ float dpp_mov(float v) { return __builtin_bit_cast(float, __builtin_amdgcn_update_dpp(0, __builtin_bit_cast(int, v), CTRL, 0xF, 0xF, false)); }
__device__ __forceinline__ float wave_sum(float v) {
    v += dpp_mov<0xB1>(v); v += dpp_mov<0x4E>(v); v += dpp_mov<0x141>(v); v += dpp_mov<0x140>(v);
    const int iv = __builtin_bit_cast(int, v);
    const float r0 = __builtin_bit_cast(float, __builtin_amdgcn_readlane(iv, 0)), r1 = __builtin_bit_cast(float, __builtin_amdgcn_readlane(iv, 16)), r2 = __builtin_bit_cast(float, __builtin_amdgcn_readlane(iv, 32)), r3 = __builtin_bit_cast(float, __builtin_amdgcn_readlane(iv, 48));
    return (r0 + r1) + (r2 + r3);
}
__device__ __forceinline__ float wave_max(float v) {
    v = fmaxf(v, dpp_mov<0xB1>(v)); v = fmaxf(v, dpp_mov<0x4E>(v)); v = fmaxf(v, dpp_mov<0x141>(v)); v = fmaxf(v, dpp_mov<0x140>(v));
    const int iv = __builtin_bit_cast(int, v);
    const float r0 = __builtin_bit_cast(float, __builtin_amdgcn_readlane(iv, 0)), r1 = __builtin_bit_cast(float, __builtin_amdgcn_readlane(iv, 16)), r2 = __builtin_bit_cast(float, __builtin_amdgcn_readlane(iv, 32)), r3 = __builtin_bit_cast(float, __builtin_amdgcn_readlane(iv, 48));
    return fmaxf(fmaxf(r0, r1), fmaxf(r2, r3));
}
__device__ __forceinline__ unsigned pk4_i8(float a, float b, float c, float d) {
    const int ia = (int)__builtin_rintf(a), ib = (int)__builtin_rintf(b), ic = (int)__builtin_rintf(c), id = (int)__builtin_rintf(d);
    return (unsigned)(ia & 255) | ((unsigned)(ib & 255) << 8) | ((unsigned)(ic & 255) << 16) | ((unsigned)id << 24);
}
__device__ __forceinline__ float sigmoidf_(float x) { return __builtin_amdgcn_rcpf(1.0f + __builtin_amdgcn_exp2f(-1.4426950408889634f * x)); }
__device__ __forceinline__ float siluf_(float x) { return x * sigmoidf_(x); }
__device__ __forceinline__ float softplusf_(float x) { return x > 20.f ? x : log1pf(__expf(x)); }

#define XB_TMO      128
#define XB_XCNT(j)  (256  + 64 * (j))
#define XB_XSUB(j)  (1280 + 64 * (j))
#define XB_XGEN(j)  (2304 + 64 * (j))
#define XB_TOP      3328
#define XB_TOPGEN   3392
#define XCD_BAR_WORDS 3456
#define XB_SPIN_CAP (1u << 18)

__device__ __forceinline__ unsigned xb_ld(unsigned* p)              { return __hip_atomic_load(p, __ATOMIC_RELAXED, __HIP_MEMORY_SCOPE_AGENT); }
__device__ __forceinline__ unsigned xb_add(unsigned* p, unsigned v) { return __hip_atomic_fetch_add(p, v, __ATOMIC_RELAXED, __HIP_MEMORY_SCOPE_AGENT); }
__device__ __forceinline__ unsigned xb_xcc_id() { return (unsigned)__builtin_amdgcn_s_getreg((3 << 11) | 20) & 0xFu; }
#define XB_SPIN(cond, bar) do { unsigned _sp = 0; while (cond) { __builtin_amdgcn_s_sleep(1); \
    if ((++_sp & 255u) == 0u) { if (xb_ld(&(bar)[XB_TMO])) break; if (_sp > XB_SPIN_CAP) { atomicAdd(&(bar)[XB_TMO], 1u); break; } } } } while (0)

struct XcdBarrier {
    unsigned* bar; unsigned x;
    volatile LAS unsigned* st;
};

__device__ __forceinline__ XcdBarrier xcd_barrier_post(unsigned* bar, volatile LAS unsigned* st) {
    XcdBarrier b; b.bar = bar; b.x = xb_xcc_id(); b.st = st;
    if (threadIdx.x == 0) (void)xb_add(&bar[XB_XCNT(b.x)], 1u);
    return b;
}
__device__ __forceinline__ void xcd_barrier_complete(unsigned* bar, unsigned x, unsigned& nloc, unsigned& nx) {
    const unsigned G = gridDim.x * gridDim.y * gridDim.z;
    unsigned sum, cnt, mine, sp = 0u;
    for (;;) {
        sum = 0u; cnt = 0u; mine = 0u;
#pragma unroll
        for (unsigned j = 0; j < 16; ++j) { const unsigned c = xb_ld(&bar[XB_XCNT(j)]); sum += c; cnt += (c > 0u) ? 1u : 0u; mine = (j == x) ? c : mine; }
        if (sum == G) break;
        __builtin_amdgcn_s_sleep(1);
        if ((++sp & 255u) == 0u) { if (xb_ld(&bar[XB_TMO])) break; if (sp > XB_SPIN_CAP) { atomicAdd(&bar[XB_TMO], 1u); break; } }
    }
    nloc = mine > 0u ? mine : 1u; nx = cnt > 0u ? cnt : 1u;
}

__device__ __forceinline__ void xcd_barrier(const XcdBarrier& b) {
    asm volatile("s_waitcnt vmcnt(0)" ::: "memory");
    __syncthreads();
    if (threadIdx.x == 0) {
        unsigned* bar = b.bar;
        __builtin_amdgcn_s_waitcnt(0);
        unsigned nloc = b.st[0], nx = b.st[1];
        if (nloc == 0u) { xcd_barrier_complete(bar, b.x, nloc, nx); b.st[0] = nloc; b.st[1] = nx; }
        const unsigned old = xb_add(&bar[XB_XSUB(b.x)], 1u);
        const unsigned gen = old / nloc;
        if (old + 1u == (gen + 1u) * nloc) {
            __builtin_amdgcn_fence(__ATOMIC_RELEASE, "agent");
            asm volatile("s_waitcnt vmcnt(0)" ::: "memory");
            const unsigned og = xb_add(&bar[XB_TOP], 1u);
            const unsigned tg = og / nx;
            if (og + 1u == (tg + 1u) * nx) xb_add(&bar[XB_TOPGEN], 1u);
            else XB_SPIN(xb_ld(&bar[XB_TOPGEN]) == tg, bar);
            __builtin_amdgcn_fence(__ATOMIC_ACQUIRE, "agent");
            xb_add(&bar[XB_XGEN(b.x)], 1u);
            asm volatile("s_waitcnt vmcnt(0)" ::: "memory");
        } else {
            XB_SPIN(xb_ld(&bar[XB_XGEN(b.x)]) == gen, bar);
            __builtin_amdgcn_fence(__ATOMIC_ACQUIRE, "agent");
            asm volatile("s_waitcnt vmcnt(0)" ::: "memory");
        }
    }
    __syncthreads();
}

enum InIdx { I_X = 0, I_C, I_CTX, I_CCTX, I_WMOD, I_BMOD, I_NMG, I_NFG, I_WIN, I_WOUT, I_SINK, I_DNCW, I_DNALOG, I_DNDT, I_DNNG, I_LRCW, I_LRCB, I_LRWR, I_LRBR, I_LRWI, I_LRBI, I_LRLAM,
             I_WROUT, I_BROUT, I_WGU, I_BGU, I_WDN, I_BDN, I_FNG, N_IN };
struct Frame {
    LAS unsigned char* lds;
    volatile LAS unsigned* MISC;
    gu32* ctl;
    int tid, lane, wave, G, bid;
    const float* const __attribute__((address_space(4)))* in;
    float* out; unsigned char* ws;
};
__device__ __forceinline__ int mod_row(int m) { return m < NLAT ? (m >> 12) : 4; }
__device__ __forceinline__ bool phase_enter(Frame& F) { int t = threadIdx.x; asm volatile("" : "+v"(t)); F.tid = t; F.lane = t & 63; F.wave = __builtin_amdgcn_readfirstlane(t >> 6); return true; }
__device__ __forceinline__ void seq_of(int m, int& t, int& T, int& base) { if (m < NLAT) { t = m & 4095; T = SEQ; base = m - t; } else { t = (m - NLAT) & 255; T = CTXL; base = m - t; } }
__device__ __forceinline__ float gelu_tanh(float x) { const float u = 0.7978845608028654f * (x + 0.044715f * x * x * x); return x * sigmoidf_(2.0f * u); }

__device__ __forceinline__ void transpose_item(const float* W, int K, int N, bf16* WT, int k0, int dstrow0, int srccol0, int nvalid, LAS float* scr, int lane) {
    { const int c4 = (lane & 7) * 4, kr = lane >> 3; f32x4 v[8];
#pragma unroll
      for (int i = 0; i < 8; ++i) { v[i] = (f32x4){0.f, 0.f, 0.f, 0.f}; if (c4 < nvalid) v[i] = __builtin_nontemporal_load((const f32x4*)(W + (size_t)(k0 + 8 * i + kr) * N + srccol0 + c4)); }
#pragma unroll
      for (int i = 0; i < 8; ++i) { LAS float* d = scr + (8 * i + kr) * 33 + c4; d[0] = v[i].x; d[1] = v[i].y; d[2] = v[i].z; d[3] = v[i].w; } }
    LDS_WAIT(); asm volatile("" ::: "memory");
    const int c = lane & 7;
#pragma unroll
    for (int jj = 0; jj < 4; ++jj) { const int n = (lane >> 3) + 8 * jj; const LAS float* s = scr + (8 * c) * 33 + n;
        v4u o; o.x = pk2(s[0 * 33], s[1 * 33]); o.y = pk2(s[2 * 33], s[3 * 33]); o.z = pk2(s[4 * 33], s[5 * 33]); o.w = pk2(s[6 * 33], s[7 * 33]);
        *(GAS v4u*)(WT + (size_t)(dstrow0 + n) * K + k0 + 8 * c) = o; }
    LDS_WAIT(); asm volatile("" ::: "memory");
}
__device__ __forceinline__ void transpose_item_f8(const float* W, int K, int N, unsigned char* WT, int k0, int dstrow0, int srccol0, float scale, LAS float* scr, int lane) {
    { const int c4 = (lane & 7) * 4, kr = lane >> 3; f32x4 v[8];
#pragma unroll
      for (int i = 0; i < 8; ++i) v[i] = __builtin_nontemporal_load((const f32x4*)(W + (size_t)(k0 + 8 * i + kr) * N + srccol0 + c4));
#pragma unroll
      for (int i = 0; i < 8; ++i) { LAS float* d = scr + (8 * i + kr) * 33 + c4; d[0] = v[i].x; d[1] = v[i].y; d[2] = v[i].z; d[3] = v[i].w; } }
    LDS_WAIT(); asm volatile("" ::: "memory");
    { const int n = lane >> 1, hf = lane & 1; const LAS float* s = scr + (32 * hf) * 33 + n; unsigned w[8];
#pragma unroll
      for (int i = 0; i < 8; ++i) { int x = 0; x = __builtin_amdgcn_cvt_pk_fp8_f32(s[(4 * i + 0) * 33] * scale, s[(4 * i + 1) * 33] * scale, x, false); x = __builtin_amdgcn_cvt_pk_fp8_f32(s[(4 * i + 2) * 33] * scale, s[(4 * i + 3) * 33] * scale, x, true); w[i] = (unsigned)x; }
      v4u* o = (v4u*)(WT + (size_t)(dstrow0 + n) * K + k0 + 32 * hf); __builtin_nontemporal_store((v4u){w[0], w[1], w[2], w[3]}, o); __builtin_nontemporal_store((v4u){w[4], w[5], w[6], w[7]}, o + 1); }
    LDS_WAIT(); asm volatile("" ::: "memory");
}
__device__ __forceinline__ void transpose_item_i8(const float* W, int K, int N, unsigned char* WT, int k0, int dstrow0, int srccol0, const gu32* cmax, float* cs, LAS float* scr, int lane) {
    { const int c4 = (lane & 7) * 4, kr = lane >> 3; f32x4 v[8];
#pragma unroll
      for (int i = 0; i < 8; ++i) v[i] = *(const f32x4*)(W + (size_t)(k0 + 8 * i + kr) * N + srccol0 + c4);
#pragma unroll
      for (int i = 0; i < 8; ++i) { LAS float* d = scr + (8 * i + kr) * 33 + c4; d[0] = v[i].x; d[1] = v[i].y; d[2] = v[i].z; d[3] = v[i].w; } }
    LDS_WAIT(); asm volatile("" ::: "memory");
    { const int n = lane >> 1, hf = lane & 1; const LAS float* sp = scr + (32 * hf) * 33 + n; unsigned w[8];
      const float sc = cs[dstrow0 + n]; const float inv = sc > 0.f ? 1.0f / sc : 0.f;
#pragma unroll
      for (int i = 0; i < 8; ++i) w[i] = pk4_i8(sp[(4 * i + 0) * 33] * inv, sp[(4 * i + 1) * 33] * inv, sp[(4 * i + 2) * 33] * inv, sp[(4 * i + 3) * 33] * inv);
      GAS v4u* o = (GAS v4u*)(WT + (size_t)(dstrow0 + n) * K + k0 + 32 * hf); o[0] = (v4u){w[0], w[1], w[2], w[3]}; o[1] = (v4u){w[4], w[5], w[6], w[7]}; }
    LDS_WAIT(); asm volatile("" ::: "memory");
}
__device__ __forceinline__ void p0_prologue_a(Frame& F) {
    {
        LAS float* sc = (LAS float*)(F.lds);
        LAS float* red = (LAS float*)(F.lds + 40960);
        bool have_sc = false;
        for (int wb = F.bid; wb < 192; wb += F.G) {
            if (!have_sc) {
                for (int i = F.tid; i < 5 * 2048; i += NTHREADS) { const int r = i >> 11, k = i & 2047; const float cv = r < 4 ? F.in[I_C][r * 2048 + k] : F.in[I_CCTX][k]; sc[i] = siluf_(cv); }
                have_sc = true; __syncthreads();
            }
            const int l = wb / 96, cb = wb % 96, kp = F.tid >> 5, cg = F.tid & 31, j0 = cb * 128 + cg * 4;
            const float* wp = F.in[I_WMOD] + ((size_t)l * 2048 + kp * 128) * 12288 + j0;
            f32x4 acc[5];
#pragma unroll
            for (int r = 0; r < 5; ++r) acc[r] = (f32x4){0.f, 0.f, 0.f, 0.f};
#pragma unroll 4
            for (int k = 0; k < 128; ++k) { const f32x4 w = *(const f32x4*)(wp + (size_t)k * 12288);
#pragma unroll
                for (int r = 0; r < 5; ++r) acc[r] += sc[r * 2048 + kp * 128 + k] * w; }
#pragma unroll
            for (int r = 0; r < 5; ++r) *(LAS f32x4*)(red + (kp * 5 + r) * 128 + cg * 4) = acc[r];
            __syncthreads();
            for (int i = F.tid; i < 640; i += NTHREADS) { const int r = i >> 7, col = i & 127; float s = F.in[I_BMOD][l * 12288 + cb * 128 + col];
#pragma unroll
                for (int q = 0; q < 16; ++q) s += red[(q * 5 + r) * 128 + col];
                ((float*)(F.ws + WS_MOD))[(size_t)(l * 5 + r) * 12288 + cb * 128 + col] = s; }
            __syncthreads();
        }
        __syncthreads();
    }
#if I8_INPROJ
    {
        const int gw = F.bid * NWAVES + F.wave, NGW = F.G * NWAVES;
        for (int it = gw; it < 2 * 144; it += NGW) { const int l = it / 144, nb = it % 144, d0 = nb * 32, s0 = d0 >= 3584 ? d0 + 16 : d0;
            const float* W = F.in[I_WIN] + (size_t)l * 2048 * IN_W; const int c4 = (F.lane & 7) * 4, kr = F.lane >> 3;
            f32x4 mx = {0.f, 0.f, 0.f, 0.f};
#pragma unroll 2
            for (int sub = 0; sub < 32; ++sub) { f32x4 v[8];
#pragma unroll
                for (int i = 0; i < 8; ++i) v[i] = *(const f32x4*)(W + (size_t)(sub * 64 + 8 * i + kr) * IN_W + s0 + c4);
#pragma unroll
                for (int i = 0; i < 8; ++i) { mx.x = fmaxf(mx.x, fabsf(v[i].x)); mx.y = fmaxf(mx.y, fabsf(v[i].y)); mx.z = fmaxf(mx.z, fabsf(v[i].z)); mx.w = fmaxf(mx.w, fabsf(v[i].w)); } }
#pragma unroll
            for (int o = 8; o < 64; o <<= 1) { mx.x = fmaxf(mx.x, __shfl_xor(mx.x, o)); mx.y = fmaxf(mx.y, __shfl_xor(mx.y, o)); mx.z = fmaxf(mx.z, __shfl_xor(mx.z, o)); mx.w = fmaxf(mx.w, __shfl_xor(mx.w, o)); }
            if (kr == 0) *(f32x4*)((float*)(F.ws + WS_CS) + l * 4608 + d0 + c4) = mx * (1.0f / 127.0f);
        }
    }
#endif
}
__device__ __forceinline__ void p0_prologue_b(Frame& F) {
    { int* idt = (int*)(F.ws + WS_IDT); for (int r = F.bid * NTHREADS + F.tid; r < MOE_ROWS; r += F.G * NTHREADS) idt[r] = r; }
    {
        LAS float* scr = (LAS float*)(F.lds + F.wave * 16384);
        const int gw = F.bid * NWAVES + F.wave, NGW = F.G * NWAVES;
        constexpr int I_IN = 32 * 144, I_OUT = 32 * 64, I_RT = 32, I_16 = 32, PER_L = I_IN + I_OUT + I_RT + I_16;
        for (int it0 = gw; it0 < 2 * PER_L; it0 += NGW) {
            const int l = it0 / PER_L; int r = it0 % PER_L;
            if (r < I_IN) { const int nb = r % 144, kb = r / 144, d0 = nb * 32; int s0 = d0, nv = 32;
                if (d0 >= 3584) s0 = d0 + 16;
#if I8_INPROJ
                transpose_item_i8(F.in[I_WIN] + (size_t)l * 2048 * IN_W, 2048, IN_W, F.ws + WS_WIN + (size_t)l * PW * 2048 * 2, kb * 64, d0, s0, F.ctl + CW_CMAX + l * 4608, (float*)(F.ws + WS_CS) + l * 4608, scr, F.lane); continue; }
#elif FP8_INPROJ
                transpose_item_f8(F.in[I_WIN] + (size_t)l * 2048 * IN_W, 2048, IN_W, F.ws + WS_WIN + (size_t)l * PW * 2048 * 2, kb * 64, d0, s0, 64.0f, scr, F.lane); continue; }
#else
                transpose_item(F.in[I_WIN] + (size_t)l * 2048 * IN_W, 2048, IN_W, (bf16*)(F.ws + WS_WIN) + (size_t)l * PW * 2048, kb * 64, d0, s0, nv, scr, F.lane); continue; }
#endif
            r -= I_IN;
            if (r < I_OUT) { const int nb = r % 64, kb = r / 64;
#if FP8_OUTPROJ
                transpose_item_f8(F.in[I_WOUT] + (size_t)l * 2048 * 2048, 2048, 2048, F.ws + WS_WOUT + (size_t)l * 2048 * 2048 * 2, kb * 64, nb * 32, nb * 32, 64.0f, scr, F.lane); continue; }
#else
                transpose_item(F.in[I_WOUT] + (size_t)l * 2048 * 2048, 2048, 2048, (bf16*)(F.ws + WS_WOUT) + (size_t)l * 2048 * 2048, kb * 64, nb * 32, nb * 32, 32, scr, F.lane); continue; }
#endif
            r -= I_OUT;
            if (r < I_RT) { transpose_item(F.in[I_WROUT] + (size_t)l * 2048 * 32, 2048, 32, (bf16*)(F.ws + WS_WRT) + (size_t)l * 32 * 2048, r * 64, 0, 0, 32, scr, F.lane); continue; }
            r -= I_RT;
            transpose_item(F.in[I_WIN] + (size_t)l * 2048 * IN_W, 2048, IN_W, (bf16*)(F.ws + WS_WRT + 512 * 1024) + (size_t)l * 32 * 2048, r * 64, 0, 3584, 16, scr, F.lane);
        }
    }
}
constexpr int CW_CVQ = 12288 + 512;
#ifndef FP8_GEMM2
#define FP8_GEMM2 1
#endif
constexpr float WGU_SCALE = 64.0f, WDN_SCALE = 64.0f; constexpr int WGU_E8M0 = 0x7C7C7C7C, WDN_E8M0 = 0x7C7C7C7C;
__device__ __forceinline__ void convert_moe_item(Frame& F, int l, int r, LAS float* scr) {
    constexpr int I_GU = 32 * 32 * 64;
    if (r < I_GU) { const int e = r / 2048, q = r % 2048, nb = q % 64, kb = q / 64; const int s0 = ((nb >> 2) & 1) * 1024 + (nb >> 3) * 128 + (nb & 3) * 32;
        transpose_item_f8(F.in[I_WGU] + (size_t)(l * 32 + e) * 2048 * 2048, 2048, 2048, F.ws + WS_WGU + (size_t)(l * 32 + e) * 2048 * 2048, kb * 64, nb * 32, s0, WGU_SCALE, scr, F.lane); return; }
    r -= I_GU;
    { const int e = r / 1024, q = r % 1024, nb = q % 64, kb = q / 64;
#if FP8_GEMM2
        transpose_item_f8(F.in[I_WDN] + (size_t)(l * 32 + e) * 1024 * 2048, 1024, 2048, F.ws + WS_WDN + (size_t)(l * 32 + e) * 2048 * 1024, kb * 64, nb * 32, nb * 32, WDN_SCALE, scr, F.lane);
#else
        transpose_item(F.in[I_WDN] + (size_t)(l * 32 + e) * 1024 * 2048, 1024, 2048, (bf16*)(F.ws + WS_WDN) + (size_t)(l * 32 + e) * 2048 * 1024, kb * 64, nb * 32, nb * 32, 32, scr, F.lane);
#endif
    }
}
constexpr int CVG = 8;
#ifndef CV_PIPE
#define CV_PIPE 1
#endif
__device__ __forceinline__ void cv_decode(Frame& F, int l, int r, const float*& src, unsigned char*& dst, int& K) {
    constexpr int I_GU = 32 * 32 * 64;
    if (r < I_GU) { const int e = r / 2048, q = r % 2048, nb = q % 64, kb = q / 64; const int s0 = ((nb >> 2) & 1) * 1024 + (nb >> 3) * 128 + (nb & 3) * 32;
        src = F.in[I_WGU] + (size_t)(l * 32 + e) * 2048 * 2048 + (size_t)(kb * 64) * 2048 + s0; dst = F.ws + WS_WGU + (size_t)(l * 32 + e) * 2048 * 2048 + (size_t)(nb * 32) * 2048 + kb * 64; K = 2048; }
    else { r -= I_GU; const int e = r / 1024, q = r % 1024, nb = q % 64, kb = q / 64;
        src = F.in[I_WDN] + (size_t)(l * 32 + e) * 1024 * 2048 + (size_t)(kb * 64) * 2048 + nb * 32; dst = F.ws + WS_WDN + (size_t)(l * 32 + e) * 2048 * 1024 + (size_t)(nb * 32) * 1024 + kb * 64; K = 1024; }
}
__device__ __forceinline__ void cv_load(const float* src, f32x4 (&v)[8], int lane) { const int c4 = (lane & 7) * 4, kr = lane >> 3;
#pragma unroll
    for (int i = 0; i < 8; ++i) v[i] = __builtin_nontemporal_load((const f32x4*)(src + (size_t)(8 * i + kr) * 2048 + c4)); }
__device__ __forceinline__ void cv_finish(const f32x4 (&v)[8], unsigned char* dst, int K, float scale, LAS float* scr, int lane) {
    { const int c4 = (lane & 7) * 4, kr = lane >> 3;
#pragma unroll
      for (int i = 0; i < 8; ++i) { LAS float* d = scr + (8 * i + kr) * 33 + c4; d[0] = v[i].x; d[1] = v[i].y; d[2] = v[i].z; d[3] = v[i].w; } }
    LDS_WAIT(); asm volatile("" ::: "memory");
    { const int n = lane >> 1, hf = lane & 1; const LAS float* s = scr + (32 * hf) * 33 + n; unsigned w[8];
#pragma unroll
      for (int i = 0; i < 8; ++i) { int x = 0; x = __builtin_amdgcn_cvt_pk_fp8_f32(s[(4 * i + 0) * 33] * scale, s[(4 * i + 1) * 33] * scale, x, false); x = __builtin_amdgcn_cvt_pk_fp8_f32(s[(4 * i + 2) * 33] * scale, s[(4 * i + 3) * 33] * scale, x, true); w[i] = (unsigned)x; }
      v4u* o = (v4u*)(dst + (size_t)n * K + 32 * hf); __builtin_nontemporal_store((v4u){w[0], w[1], w[2], w[3]}, o); __builtin_nontemporal_store((v4u){w[4], w[5], w[6], w[7]}, o + 1); }
    LDS_WAIT(); asm volatile("" ::: "memory");
}
__device__ __forceinline__ bool convert_grab(Frame& F, int l, int rep, LAS float* scr) {
    constexpr int NIT = 32 * 32 * 64 + 32 * 16 * 64;
    int g = 0; if (F.lane == 0) g = (int)__hip_atomic_fetch_add(F.ctl + CW_CVQ + 64 * l + 8 * rep, 1u, RLX_AGENT); g = __builtin_amdgcn_readfirstlane(g);
    if (g * CVG >= NIT) return false;
#if CV_PIPE && FP8_GEMM2
    static_assert(WGU_SCALE == WDN_SCALE, "one scale for both expert matrices");
    { const int r0 = g * CVG; f32x4 va[8], vb[8]; const float* sp; unsigned char* d0; unsigned char* d1; int K0, K1;
      cv_decode(F, l, r0, sp, d0, K0); cv_load(sp, va, F.lane);
#pragma unroll
      for (int k = 0; k < CVG; k += 2) {
          cv_decode(F, l, r0 + k + 1, sp, d1, K1); cv_load(sp, vb, F.lane);
          cv_finish(va, d0, K0, WGU_SCALE, scr, F.lane);
          if (k + 2 < CVG) { cv_decode(F, l, r0 + k + 2, sp, d0, K0); cv_load(sp, va, F.lane); }
          cv_finish(vb, d1, K1, WGU_SCALE, scr, F.lane);
      } }
#else
#pragma unroll 1
    for (int k = 0; k < CVG; ++k) convert_moe_item(F, l, g * CVG + k, scr);
#endif
    return true;
}
__device__ __forceinline__ void convert_moe_queue(Frame& F, int l, int rep = 0) {
    LAS float* scr = (LAS float*)(F.lds + F.wave * 16384);
    __syncthreads();
    while (convert_grab(F, l, rep, scr)) {}
    __syncthreads();
}
constexpr int CW_TAIL = 16384;
__device__ __forceinline__ void tail_fill(Frame& F, int seam, int lt) {
    LAS int* flag = (LAS int*)(F.lds + LDS_X_OFF + 768);
    LAS float* scr = (LAS float*)(F.lds + F.wave * 16384);
    __syncthreads();
    if (F.tid == 0) (void)__hip_atomic_fetch_add(F.ctl + CW_TAIL + 64 * seam, 1u, RLX_AGENT);
    bool more = true;
    for (int it = 0; it < 4096; ++it) {
        if (F.tid == 0) *flag = (__hip_atomic_load(F.ctl + CW_TAIL + 64 * seam, RLX_AGENT) >= (unsigned)F.G) ? 1 : 0;
        __syncthreads();
        const int done = *flag;
        __syncthreads();
        if (done) break;
        if (more) more = convert_grab(F, lt, 0, scr); else __builtin_amdgcn_s_sleep(32);
    }
}
__device__ __forceinline__ void convert_moe_timed(Frame& F, int l, unsigned long long budget) {
    LAS float* scr = (LAS float*)(F.lds + F.wave * 16384);
    const unsigned long long t0 = __builtin_amdgcn_s_memrealtime();
    __syncthreads();
    while (__builtin_amdgcn_s_memrealtime() - t0 < budget) { if (!convert_grab(F, l, 0, scr)) break; }
    __syncthreads();
}

__device__ __forceinline__ void load_row(const float* src, int lane, f32x4 (&v)[8]) {
    const f32x4* p = (const f32x4*)src + lane;
#pragma unroll
    for (int j = 0; j < 8; ++j) v[j] = p[64 * j];
}
__device__ __forceinline__ void store_row(float* dst, int lane, const f32x4 (&v)[8]) {
    f32x4* p = (f32x4*)dst + lane;
#pragma unroll
    for (int j = 0; j < 8; ++j) p[64 * j] = v[j];
}
#if X_BF16
typedef bf16 xelem_t;
__device__ __forceinline__ void load_xrow(const bf16* src, int lane, f32x4 (&v)[8]) {
    const v2u* p = (const v2u*)src + lane;
#pragma unroll
    for (int j = 0; j < 8; ++j) { const v2u w = p[64 * j]; v[j] = (f32x4){bflo(w.x), bfhi(w.x), bflo(w.y), bfhi(w.y)}; }
}
__device__ __forceinline__ void store_xrow(bf16* dst, int lane, const f32x4 (&v)[8]) {
    v2u* p = (v2u*)dst + lane;
#pragma unroll
    for (int j = 0; j < 8; ++j) { v2u w; w.x = pk2(v[j].x, v[j].y); w.y = pk2(v[j].z, v[j].w); p[64 * j] = w; }
}
#else
typedef float xelem_t;
__device__ __forceinline__ void load_xrow(const float* src, int lane, f32x4 (&v)[8]) { load_row(src, lane, v); }
__device__ __forceinline__ void store_xrow(float* dst, int lane, const f32x4 (&v)[8]) { store_row(dst, lane, v); }
#endif
__device__ __forceinline__ void combine_row(Frame& F, int l, int m, int lane, f32x4 (&v)[8]) {
    const int* dest = (const int*)(F.ws + WS_MOEI + 2 * 512 * 1024) + m * 4;
    const float* g5 = (const float*)(F.ws + WS_MOD) + (size_t)(l * 5 + mod_row(m)) * 12288 + 5 * 2048;
    f32x4 acc[8];
#pragma unroll
    for (int j = 0; j < 8; ++j) acc[j] = (f32x4){0.f, 0.f, 0.f, 0.f};
#if YS_FP8
    typedef float f32x2c __attribute__((ext_vector_type(2)));
#pragma unroll
    for (int k = 0; k < 4; ++k) { const int d = dest[k]; const unsigned* yp = (const unsigned*)(F.ws + WS_YS + (size_t)d * 2048) + lane;
#pragma unroll
        for (int j = 0; j < 8; ++j) { const int w = (int)yp[64 * j]; const f32x2c lo = __builtin_amdgcn_cvt_pk_f32_fp8(w, false), hi = __builtin_amdgcn_cvt_pk_f32_fp8(w, true); acc[j] += (f32x4){lo.x, lo.y, hi.x, hi.y}; } }
#pragma unroll
    for (int j = 0; j < 8; ++j) { const f32x4 gg = *((const f32x4*)g5 + lane + 64 * j); v[j] += gg * acc[j] * 0.0625f; }
#else
#pragma unroll
    for (int k = 0; k < 4; ++k) { const int d = dest[k]; const v2u* yp = (const v2u*)((const bf16*)(F.ws + WS_YS) + (size_t)d * 2048) + lane;
#pragma unroll
        for (int j = 0; j < 8; ++j) { const v2u w = yp[64 * j]; acc[j] += (f32x4){bflo(w.x), bfhi(w.x), bflo(w.y), bfhi(w.y)}; } }
#pragma unroll
    for (int j = 0; j < 8; ++j) { const f32x4 gg = *((const f32x4*)g5 + lane + 64 * j); v[j] += gg * acc[j]; }
#endif
}
__device__ __forceinline__ void modnorm_store(const f32x4 (&v)[8], const float* g, const float* shift, const float* scale, bf16* hrow, int lane) {
    float ss = 0.f;
#pragma unroll
    for (int j = 0; j < 8; ++j) ss += (v[j].x * v[j].x + v[j].y * v[j].y) + (v[j].z * v[j].z + v[j].w * v[j].w);
    const float rstd = 1.0f / sqrtf(wave_sum(ss) * (1.0f / 2048.0f) + EPS);
    v2u* hp = (v2u*)hrow + lane;
#pragma unroll
    for (int j = 0; j < 8; ++j) { const f32x4 gg = *((const f32x4*)g + lane + 64 * j), sh = *((const f32x4*)shift + lane + 64 * j), sc = *((const f32x4*)scale + lane + 64 * j);
        const f32x4 y = (v[j] * rstd) * gg * (sc + 1.0f) + sh; v2u w; w.x = pk2(y.x, y.y); w.y = pk2(y.z, y.w); hp[64 * j] = w; }
}
constexpr size_t WS_W16 = WS_WRT + 512 * 1024;
__device__ __forceinline__ void phase_norm1(Frame& F, int l) {
    constexpr int TROW = 4112;
    LAS unsigned char* tile = F.lds; LAS float* part = (LAS float*)(F.lds + 66048);
    xelem_t* X = (xelem_t*)(F.ws + WS_X); bf16* H = (bf16*)(F.ws + WS_H); bf16* P = (bf16*)(F.ws + WS_P);
    const float* modp = (const float*)(F.ws + WS_MOD) + (size_t)l * 5 * 12288;
    const bf16* w16 = (const bf16*)(F.ws + WS_W16) + (size_t)l * 32 * 2048;
    for (int r0 = F.bid * 16; r0 < NTOK; r0 += F.G * 16) {
#pragma unroll 1
        for (int rr = 0; rr < 2; ++rr) { const int lr = 2 * F.wave + rr, m = r0 + lr;
            f32x4 v[8];
            if (l == 0) load_row(m < NLAT ? F.in[I_X] + (size_t)m * DM : F.in[I_CTX] + (size_t)(m - NLAT) * DM, F.lane, v);
            else { load_xrow(X + (size_t)m * DM, F.lane, v); if (MK_STAGE >= 9) { combine_row(F, l - 1, m, F.lane, v); store_xrow(X + (size_t)m * DM, F.lane, v); } }
            float ss = 0.f;
#pragma unroll
            for (int j = 0; j < 8; ++j) ss += (v[j].x * v[j].x + v[j].y * v[j].y) + (v[j].z * v[j].z + v[j].w * v[j].w);
            const float rstd = 1.0f / sqrtf(wave_sum(ss) * (1.0f / 2048.0f) + EPS);
            const float* mr = modp + (size_t)mod_row(m) * 12288; const float* g = F.in[I_NMG] + l * DM;
#if I8_INPROJ
            LAS v2u* tp = (LAS v2u*)(tile + lr * TROW) + F.lane; float amax = 0.f;
#pragma unroll
            for (int j = 0; j < 8; ++j) { const f32x4 gg = *((const f32x4*)g + F.lane + 64 * j), sh = *((const f32x4*)mr + F.lane + 64 * j), sc = *((const f32x4*)(mr + 2048) + F.lane + 64 * j);
                const f32x4 y = (v[j] * rstd) * gg * (sc + 1.0f) + sh; v[j] = y; v2u w; w.x = pk2(y.x, y.y); w.y = pk2(y.z, y.w); tp[64 * j] = w;
                amax = fmaxf(amax, fmaxf(fmaxf(fabsf(y.x), fabsf(y.y)), fmaxf(fabsf(y.z), fabsf(y.w)))); }
            amax = wave_max(amax); const float inv = amax > 0.f ? 127.0f / amax : 0.f;
            unsigned* hp = (unsigned*)(F.ws + WS_XS + (size_t)m * DM) + F.lane;
#pragma unroll
            for (int j = 0; j < 8; ++j) hp[64 * j] = pk4_i8(v[j].x * inv, v[j].y * inv, v[j].z * inv, v[j].w * inv);
            if (F.lane == 0) ((float*)(F.ws + WS_RS))[m] = amax * (1.0f / 127.0f);
#else
#if FP8_INPROJ
            unsigned* hp = (unsigned*)(F.ws + WS_XS + (size_t)m * DM) + F.lane; LAS v2u* tp = (LAS v2u*)(tile + lr * TROW) + F.lane;
#else
            v2u* hp = (v2u*)(H + (size_t)m * DM) + F.lane; LAS v2u* tp = (LAS v2u*)(tile + lr * TROW) + F.lane;
#endif
#pragma unroll
            for (int j = 0; j < 8; ++j) { const f32x4 gg = *((const f32x4*)g + F.lane + 64 * j), sh = *((const f32x4*)mr + F.lane + 64 * j), sc = *((const f32x4*)(mr + 2048) + F.lane + 64 * j);
                const f32x4 y = (v[j] * rstd) * gg * (sc + 1.0f) + sh; v2u w; w.x = pk2(y.x, y.y); w.y = pk2(y.z, y.w); tp[64 * j] = w;
#if FP8_INPROJ
                int x8 = 0; x8 = __builtin_amdgcn_cvt_pk_fp8_f32(y.x, y.y, x8, false); x8 = __builtin_amdgcn_cvt_pk_fp8_f32(y.z, y.w, x8, true); hp[64 * j] = (unsigned)x8; }
#else
                hp[64 * j] = w; }
#endif
#endif
        }
        __syncthreads();
        { const int row = F.lane & 15, q = F.lane >> 4; f32x4 acc = {0.f, 0.f, 0.f, 0.f};
#pragma unroll
          for (int ks = 0; ks < 8; ++ks) { const int k0 = 256 * F.wave + 32 * ks + 8 * q;
              const bf16x8 a = *(const LAS bf16x8*)(tile + row * TROW + k0 * 2); const bf16x8 b = *(const bf16x8*)(w16 + (size_t)row * 2048 + k0);
              acc = __builtin_amdgcn_mfma_f32_16x16x32_bf16(a, b, acc, 0, 0, 0); }
#pragma unroll
          for (int i = 0; i < 4; ++i) part[(F.wave * 16 + 4 * q + i) * 16 + row] = acc[i]; }
        __syncthreads();
        if (F.tid < 256) { const int rw = F.tid >> 4, c = F.tid & 15; float sacc = 0.f;
#pragma unroll
            for (int w = 0; w < 8; ++w) sacc += part[(w * 16 + rw) * 16 + c];
            P[(size_t)(r0 + rw) * PW + PC_BETA + c] = (bf16)f2bf(sacc); }
        __syncthreads();
    }
}
__device__ __forceinline__ void phase_final(Frame& F, bool with_combine) {
    const int gw = F.bid * NWAVES + F.wave, NGW = F.G * NWAVES;
    const xelem_t* X = (const xelem_t*)(F.ws + WS_X);
    for (int m = gw; m < NLAT; m += NGW) {
        f32x4 v[8];
        if (with_combine) { load_xrow(X + (size_t)m * DM, F.lane, v); combine_row(F, 1, m, F.lane, v); }
        else load_row(F.in[I_X] + (size_t)m * DM, F.lane, v);
        float ss = 0.f;
#pragma unroll
        for (int j = 0; j < 8; ++j) ss += (v[j].x * v[j].x + v[j].y * v[j].y) + (v[j].z * v[j].z + v[j].w * v[j].w);
        const float rstd = 1.0f / sqrtf(wave_sum(ss) * (1.0f / 2048.0f) + EPS);
        f32x4* op = (f32x4*)(F.out + (size_t)m * DM) + F.lane;
#pragma unroll
        for (int j = 0; j < 8; ++j) { const f32x4 gg = *((const f32x4*)F.in[I_FNG] + F.lane + 64 * j); op[64 * j] = v[j] * rstd * gg; }
    }
}

__device__ __forceinline__ void phase_inproj(Frame& F, int l) {
#if I8_INPROJ
    pg8::Gemm g{(const bf16*)(F.ws + WS_XS), (const bf16*)(F.ws + WS_WIN + (size_t)l * PW * 2048 * 2), NTOK, 4608, 1024};
    pg8::StaticOrderG S; S.init(g, F.G, F.bid);
    pg8::EpiBf16PlainI8 E{(bf16*)(F.ws + WS_P), PW, (const float*)(F.ws + WS_RS), (const float*)(F.ws + WS_CS) + l * 4608};
    pg8::gemm_phase<pg8::EpiBf16PlainI8, pg8::StaticOrderG, true, true, false, true>(F.lds + RING_OFF, g, S, E);
#elif FP8_INPROJ
    pg8::Gemm g{(const bf16*)(F.ws + WS_XS), (const bf16*)(F.ws + WS_WIN + (size_t)l * PW * 2048 * 2), NTOK, 4608, 1024, 0x7C7C7C7C};
    pg8::StaticOrderG S; S.init(g, F.G, F.bid); S.row_tab = (const int*)(F.ws + WS_IDT);
    pg8::EpiBf16Plain E{(bf16*)(F.ws + WS_P), PW};
    pg8::gemm_phase<pg8::EpiBf16Plain, pg8::StaticOrderG, true, true, true>(F.lds + RING_OFF, g, S, E);
#else
    pg8::Gemm g{(const bf16*)(F.ws + WS_H), (const bf16*)(F.ws + WS_WIN) + (size_t)l * PW * 2048, NTOK, 4608, 2048};
    pg8::StaticOrder S; S.init(g, F.G, F.bid);
    pg8::EpiBf16Plain E{(bf16*)(F.ws + WS_P), PW};
    pg8::gemm_phase<pg8::EpiBf16Plain, pg8::StaticOrder, true, true>(F.lds + RING_OFF, g, S, E);
#endif
}
__device__ __forceinline__ void phase_outproj(Frame& F, int l) {
    float* X = (float*)(F.ws + WS_X);
#if FP8_OUTPROJ
    pg8::Gemm g{(const bf16*)(F.ws + WS_CC), (const bf16*)(F.ws + WS_WOUT + (size_t)l * 2048 * 2048 * 2), l == 0 ? NTOK : NLAT, 2048, 1024, 0x7C7C7C7C};
    pg8::StaticOrderG S; S.init(g, F.G, F.bid); S.row_tab = (const int*)(F.ws + WS_IDT);
#else
    pg8::Gemm g{(const bf16*)(F.ws + WS_CC), (const bf16*)(F.ws + WS_WOUT) + (size_t)l * 2048 * 2048, l == 0 ? NTOK : NLAT, 2048, 2048};
    pg8::StaticOrder S; S.init(g, F.G, F.bid);
#endif
#if X_BF16
    pg8::EpiResGateB E{F.in[I_X], F.in[I_CTX], (const bf16*)(F.ws + WS_X), (bf16*)(F.ws + WS_X), (const float*)(F.ws + WS_MOD) + (size_t)l * 5 * 12288 + 2 * 2048, l == 0 ? 1 : 0};
#define EPI_RES pg8::EpiResGateB
#else
    pg8::EpiResGate E{l == 0 ? F.in[I_X] : X, l == 0 ? F.in[I_CTX] : X + (size_t)NLAT * DM, X, (const float*)(F.ws + WS_MOD) + (size_t)l * 5 * 12288 + 2 * 2048};
#define EPI_RES pg8::EpiResGate
#endif
#if FP8_OUTPROJ
    pg8::gemm_phase<EPI_RES, pg8::StaticOrderG, true, true, true>(F.lds + RING_OFF, g, S, E);
#else
    pg8::gemm_phase<EPI_RES, pg8::StaticOrder, true, true>(F.lds + RING_OFF, g, S, E);
#endif
    if (OUTPROJ_SLACK_TICKS > 0 && l == 0 && F.bid >= 32) convert_moe_timed(F, 1, OUTPROJ_SLACK_TICKS);
}
#ifndef PHASE_INPROJ
#define PHASE_INPROJ(F, l) phase_inproj(F, l)
#endif
#ifndef PHASE_OUTPROJ
#define PHASE_OUTPROJ(F, l) phase_outproj(F, l)
#endif

constexpr size_t WS_H8 = WS_XS;
constexpr size_t MOEI_TOPE = WS_MOEI, MOEI_TOPG = WS_MOEI + 512 * 1024, MOEI_DEST = WS_MOEI + 2 * 512 * 1024, MOEI_ROWG = WS_MOEI + 3 * 512 * 1024, MOEI_ROWT = WS_MOEI + 4 * 512 * 1024, MOEI_IDT = WS_IDT;
__device__ __forceinline__ void phase_norm2(Frame& F, int l) {
    const int nrows = (l == 0) ? NTOK : NLAT;
    constexpr int TROW = 4112;
    LAS unsigned char* tile = F.lds;
    LAS float* part = (LAS float*)(F.lds + 66048);
    LAS float* lg = (LAS float*)(F.lds + 66048 + 16384);
    const xelem_t* X = (const xelem_t*)(F.ws + WS_X); bf16* H = (bf16*)(F.ws + WS_H);
    const float* modp = (const float*)(F.ws + WS_MOD) + (size_t)l * 5 * 12288;
    const bf16* wrt = (const bf16*)(F.ws + WS_WRT) + (size_t)l * 32 * 2048;
    int* tope = (int*)(F.ws + MOEI_TOPE); float* topg = (float*)(F.ws + MOEI_TOPG);
    LAS float* selv = lg + 512; LAS int* seli = (LAS int*)(selv + 64); LAS int* cntl = seli + 64; LAS int* basel = cntl + 32; LAS int* ent = basel + 32;
    if (F.tid < 32) cntl[F.tid] = 0;
    int pass = 0;
    for (int r0 = F.bid * 16; r0 < nrows; r0 += F.G * 16, ++pass) {
#pragma unroll 1
        for (int rr = 0; rr < 2; ++rr) {
            const int lr = 2 * F.wave + rr, m = r0 + lr;
            f32x4 v[8]; load_xrow(X + (size_t)m * DM, F.lane, v);
            float ss = 0.f;
#pragma unroll
            for (int j = 0; j < 8; ++j) ss += (v[j].x * v[j].x + v[j].y * v[j].y) + (v[j].z * v[j].z + v[j].w * v[j].w);
            const float rstd = 1.0f / sqrtf(wave_sum(ss) * (1.0f / 2048.0f) + EPS);
            const float* mr = modp + (size_t)mod_row(m) * 12288; const float* g = F.in[I_NFG] + l * DM;
            unsigned* hp = (unsigned*)(F.ws + WS_H8 + (size_t)m * DM) + F.lane; LAS v2u* tp = (LAS v2u*)(tile + lr * TROW) + F.lane;
#pragma unroll
            for (int j = 0; j < 8; ++j) { const f32x4 gg = *((const f32x4*)g + F.lane + 64 * j), sh = *((const f32x4*)(mr + 3 * 2048) + F.lane + 64 * j), sc = *((const f32x4*)(mr + 4 * 2048) + F.lane + 64 * j);
                const f32x4 y = (v[j] * rstd) * gg * (sc + 1.0f) + sh; v2u w; w.x = pk2(y.x, y.y); w.y = pk2(y.z, y.w); tp[64 * j] = w;
                int x8 = 0; x8 = __builtin_amdgcn_cvt_pk_fp8_f32(y.x, y.y, x8, false); x8 = __builtin_amdgcn_cvt_pk_fp8_f32(y.z, y.w, x8, true); hp[64 * j] = (unsigned)x8; }
        }
        __syncthreads();
        {
            const int row = F.lane & 15, q = F.lane >> 4;
            f32x4 acc0 = {0.f, 0.f, 0.f, 0.f}, acc1 = {0.f, 0.f, 0.f, 0.f};
#pragma unroll
            for (int ks = 0; ks < 8; ++ks) { const int k0 = 256 * F.wave + 32 * ks + 8 * q;
                const bf16x8 a = *(const LAS bf16x8*)(tile + row * TROW + k0 * 2);
                const bf16x8 b0 = *(const bf16x8*)(wrt + (size_t)row * 2048 + k0), b1 = *(const bf16x8*)(wrt + (size_t)(16 + row) * 2048 + k0);
                acc0 = __builtin_amdgcn_mfma_f32_16x16x32_bf16(a, b0, acc0, 0, 0, 0); acc1 = __builtin_amdgcn_mfma_f32_16x16x32_bf16(a, b1, acc1, 0, 0, 0); }
#pragma unroll
            for (int i = 0; i < 4; ++i) { part[(F.wave * 16 + 4 * q + i) * 32 + row] = acc0[i]; part[(F.wave * 16 + 4 * q + i) * 32 + 16 + row] = acc1[i]; }
        }
        __syncthreads();
        { const int rw = F.tid >> 5, e = F.tid & 31; float s = F.in[I_BROUT][l * 32 + e];
#pragma unroll
          for (int w = 0; w < 8; ++w) s += part[(w * 16 + rw) * 32 + e];
          lg[rw * 32 + e] = s; }
        __syncthreads();
        { const int rw = F.tid >> 5, e = F.tid & 31; const float x = lg[rw * 32 + e]; int rank = 0;
#pragma unroll
          for (int q = 0; q < 8; ++q) { const f32x4 y = *(const LAS f32x4*)(lg + rw * 32 + 4 * q);
#pragma unroll
              for (int c = 0; c < 4; ++c) rank += (y[c] > x || (y[c] == x && 4 * q + c < e)) ? 1 : 0; }
          if (rank < 4) { const int loc = __hip_atomic_fetch_add(cntl + e, 1, __ATOMIC_RELAXED, __HIP_MEMORY_SCOPE_WORKGROUP); selv[rw * 4 + rank] = x; seli[rw * 4 + rank] = e | (loc << 8); } }
        __syncthreads();
        if (F.tid < 64) { const int rw = F.tid >> 2, k = F.tid & 3; const f32x4 v = *(const LAS f32x4*)(selv + rw * 4);
            const float p0 = 1.0f, p1 = __expf(v[1] - v[0]), p2 = __expf(v[2] - v[0]), p3 = __expf(v[3] - v[0]); const float pk = k == 0 ? p0 : k == 1 ? p1 : k == 2 ? p2 : p3;
            topg[(r0 + rw) * 4 + k] = pk / (((p0 + p1) + p2) + p3); ent[pass * 64 + F.tid] = seli[F.tid]; }
        __syncthreads();
    }
    if (F.tid < 32) basel[F.tid] = (int)__hip_atomic_fetch_add(F.ctl + CW_CNT + 2048 * l + 64 * F.tid, (unsigned)cntl[F.tid], RLX_AGENT);
    __syncthreads();
    for (int i = F.tid; i < pass * 64; i += NTHREADS) { const int pp = i >> 6, w = i & 63, m = F.bid * 16 + pp * F.G * 16 + (w >> 2); const int te = ent[i];
        tope[m * 4 + (w & 3)] = te + (basel[te & 255] << 8); }
}
__device__ __forceinline__ void moe_tables(Frame& F, int l) {
    LAS int* blk_end = (LAS int*)(F.lds + LDS_X_OFF); LAS int* pstart = blk_end + 32; LAS int* cnts = blk_end + 64;
    if (F.tid == 0) { int nb = 0;
        for (int e = 0; e < 32; ++e) { const int c = (int)__hip_atomic_load(F.ctl + CW_CNT + 2048 * l + 64 * e, RLX_AGENT); cnts[e] = c; pstart[e] = nb * 256; nb += (c + 255) >> 8; blk_end[e] = nb; } }
    __syncthreads();
}
__device__ __forceinline__ void phase_scatter(Frame& F, int l) {
    const int nrows = (l == 0) ? NTOK : NLAT;
    moe_tables(F, l);
    const LAS int* blk_end = (const LAS int*)(F.lds + LDS_X_OFF); const LAS int* pstart = blk_end + 32; const LAS int* cnts = blk_end + 64;
    const int* tope = (const int*)(F.ws + MOEI_TOPE); const float* topg = (const float*)(F.ws + MOEI_TOPG);
    int* dest = (int*)(F.ws + MOEI_DEST); float* rowg = (float*)(F.ws + MOEI_ROWG); int* rowt = (int*)(F.ws + MOEI_ROWT);
    for (int a = F.bid * NTHREADS + F.tid; a < nrows * 4; a += F.G * NTHREADS) {
        const int te = tope[a], e = te & 255, rank = (int)((unsigned)te >> 8), d = pstart[e] + rank;
        dest[a] = d; rowg[d] = topg[a]; rowt[d] = a >> 2; }
    if (F.bid < 32) { const int e = F.bid, r0 = pstart[e] + cnts[e], r1 = blk_end[e] * 256;
        for (int r = r0 + F.tid; r < r1; r += NTHREADS) { rowt[r] = 0; rowg[r] = 0.f; } }
}
__device__ __forceinline__ void phase_gemm1(Frame& F, int l) {
    moe_tables(F, l);
    const LAS int* blk_end = (const LAS int*)(F.lds + LDS_X_OFF);
    pg8::Gemm g{(const bf16*)(F.ws + WS_H8), (const bf16*)(F.ws + WS_WGU + (size_t)l * 32 * 2048 * 2048), MOE_ROWS, 2048, 1024, WGU_E8M0};
    pg8::MoeOrderG S{F.bid, __builtin_amdgcn_readfirstlane(blk_end[31]), (const char*)g.A, (const char*)g.Bt, (size_t)256 * 2048, (size_t)2048 * 2048, (size_t)256 * 2048, blk_end, (const int*)(F.ws + MOEI_ROWT)};
#if FP8_GEMM2
    pg8::EpiSwiglu8 E{F.ws + WS_ACT, F.in[I_BGU] + (size_t)l * 32 * 2048};
    pg8::gemm_phase<pg8::EpiSwiglu8, pg8::MoeOrderG, true, true, true>(F.lds + RING_OFF, g, S, E);
#else
    pg8::EpiSwiglu E{(bf16*)(F.ws + WS_ACT), F.in[I_BGU] + (size_t)l * 32 * 2048};
    pg8::gemm_phase<pg8::EpiSwiglu, pg8::MoeOrderG, true, true, true>(F.lds + RING_OFF, g, S, E);
#endif
}
__device__ __forceinline__ void phase_gemm2(Frame& F, int l) {
    moe_tables(F, l);
    const LAS int* blk_end = (const LAS int*)(F.lds + LDS_X_OFF);
#if FP8_GEMM2
    pg8::Gemm g{(const bf16*)(F.ws + WS_ACT), (const bf16*)(F.ws + WS_WDN + (size_t)l * 32 * 2048 * 1024), MOE_ROWS, 2048, 512, WDN_E8M0};
    pg8::MoeOrderI S{F.bid, __builtin_amdgcn_readfirstlane(blk_end[31]), (const char*)g.A, (const char*)g.Bt, (size_t)256 * 1024, (size_t)2048 * 1024, (size_t)256 * 1024, blk_end, nullptr};
#if YS_FP8
    pg8::EpiDown8 E{F.ws + WS_YS, F.in[I_BDN] + (size_t)l * 32 * 2048, (const float*)(F.ws + MOEI_ROWG)};
    pg8::gemm_phase<pg8::EpiDown8, pg8::MoeOrderI, true, true, true>(F.lds + RING_OFF, g, S, E);
#else
    pg8::EpiDown E{(bf16*)(F.ws + WS_YS), F.in[I_BDN] + (size_t)l * 32 * 2048, (const float*)(F.ws + MOEI_ROWG)};
    pg8::gemm_phase<pg8::EpiDown, pg8::MoeOrderI, true, true, true>(F.lds + RING_OFF, g, S, E);
#endif
#else
    pg8::Gemm g{(const bf16*)(F.ws + WS_ACT), (const bf16*)(F.ws + WS_WDN) + (size_t)l * 32 * 2048 * 1024, MOE_ROWS, 2048, 1024};
    pg8::MoeOrder S{F.bid, __builtin_amdgcn_readfirstlane(blk_end[31]), (const char*)g.A, (const char*)g.Bt, (size_t)256 * 1024 * 2, (size_t)2048 * 1024 * 2, (size_t)256 * 1024 * 2, blk_end, nullptr};
    pg8::EpiDown E{(bf16*)(F.ws + WS_YS), F.in[I_BDN] + (size_t)l * 32 * 2048, (const float*)(F.ws + MOEI_ROWG)};
    pg8::gemm_phase<pg8::EpiDown, pg8::MoeOrder, true, true>(F.lds + RING_OFF, g, S, E);
#endif
}
#ifndef PHASE_NORM2
#define PHASE_NORM2(F, l) phase_norm2(F, l)
#endif
#ifndef PHASE_SCATTER
#define PHASE_SCATTER(F, l) phase_scatter(F, l)
#endif
#ifndef PHASE_GEMM1
#define PHASE_GEMM1(F, l) phase_gemm1(F, l)
#endif
#ifndef PHASE_GEMM2
#define PHASE_GEMM2(F, l) phase_gemm2(F, l)
#endif
#define USE_MFMA_ATTN 1

__device__ __forceinline__ void attn_prep(Frame& F, int l) {
    bf16* P = (bf16*)(F.ws + WS_P);
    LAS unsigned short* vt = (LAS unsigned short*)F.lds;
    for (int ct = F.bid; ct < NCT; ct += F.G) {
        const int m0 = ct * 64; const bool lat = m0 < NLAT;
        __syncthreads();
        for (int i = F.tid; i < 64 * 32; i += NTHREADS) { const int tk = i >> 5, c8 = i & 31;
            const v4u w = *(const v4u*)(P + (size_t)(m0 + tk) * PW + PC_V + c8 * 8);
            const unsigned ww[4] = {w.x, w.y, w.z, w.w};
#pragma unroll
            for (int q = 0; q < 4; ++q) { vt[(c8 * 8 + 2 * q) * 66 + tk] = (unsigned short)(ww[q] & 0xffffu); vt[(c8 * 8 + 2 * q + 1) * 66 + tk] = (unsigned short)(ww[q] >> 16); } }
        if (lat) { const int tk = F.tid >> 3, kvh = (F.tid >> 1) & 3, hf = F.tid & 1; const int t = (m0 + tk) & 4095;
            bf16* kp = P + (size_t)(m0 + tk) * PW + PC_K + kvh * 64 + hf * 32;
            const v4u w0 = *(const v4u*)kp, w1 = *(const v4u*)(kp + 8), w2 = *(const v4u*)(kp + 16), w3 = *(const v4u*)(kp + 24);
            const unsigned lo[8] = {w0.x, w0.y, w0.z, w0.w, w1.x, w1.y, w1.z, w1.w}, hi_[8] = {w2.x, w2.y, w2.z, w2.w, w3.x, w3.y, w3.z, w3.w};
            const float pos = (float)(hf ? (t & 63) : (t >> 6)); unsigned o1[8], o2[8];
#pragma unroll
            for (int jj = 0; jj < 8; ++jj) { float r1[2], r2[2];
#pragma unroll
                for (int e = 0; e < 2; ++e) { const int j = 2 * jj + e; const float inv = __builtin_amdgcn_exp2f(-(float)j * 0.8304820237218406f); const float sn = __sinf(pos * inv), cs = __cosf(pos * inv);
                    const float x1 = e ? bfhi(lo[jj]) : bflo(lo[jj]), x2 = e ? bfhi(hi_[jj]) : bflo(hi_[jj]); r1[e] = x1 * cs - x2 * sn; r2[e] = x2 * cs + x1 * sn; }
                o1[jj] = pk2(r1[0], r1[1]); o2[jj] = pk2(r2[0], r2[1]); }
            *(v4u*)kp = (v4u){o1[0], o1[1], o1[2], o1[3]}; *(v4u*)(kp + 8) = (v4u){o1[4], o1[5], o1[6], o1[7]}; *(v4u*)(kp + 16) = (v4u){o2[0], o2[1], o2[2], o2[3]}; *(v4u*)(kp + 24) = (v4u){o2[4], o2[5], o2[6], o2[7]}; }
        __syncthreads();
        for (int i = F.tid; i < 256 * 8; i += NTHREADS) { const int col = i >> 3, c = i & 7, kvh = col >> 6, d = col & 63;
            v4u o; const LAS unsigned short* s = vt + col * 66 + c * 8;
            o.x = s[0] | ((unsigned)s[1] << 16); o.y = s[2] | ((unsigned)s[3] << 16); o.z = s[4] | ((unsigned)s[5] << 16); o.w = s[6] | ((unsigned)s[7] << 16);
            if (lat) { const int b = m0 >> 12, t0 = m0 & 4095; *(v4u*)((bf16*)(F.ws + WS_VT) + ((size_t)(b * 4 + kvh) * 64 + d) * SEQ + t0 + c * 8) = o; }
            else { const int mm = m0 - NLAT, b = mm >> 8, t0 = mm & 255; *(v4u*)((bf16*)(F.ws + WS_VTC) + ((size_t)(b * 4 + kvh) * 64 + d) * CTXL + t0 + c * 8) = o; } }
    }
    __syncthreads();
}

constexpr int AT_KP = 144, AT_VP = 136;
constexpr int AT_KOFF = 0, AT_VOFF = 64 * AT_KP, AT_TILE = 64 * AT_KP + 64 * AT_VP;
__device__ __forceinline__ void attn_unit(Frame& F, int l, int b, int kvh, int qi, int is_ctx) {
    const bf16* P = (const bf16*)(F.ws + WS_P); bf16* CC = (bf16*)(F.ws + WS_CC);
    int lane_o = F.lane; asm volatile("" : "+v"(lane_o));
    const int g = F.wave >> 1, qh = F.wave & 1, hq = kvh * 4 + g, r32 = lane_o & 31, hi = lane_o >> 5;
    const int rowbase = is_ctx ? NLAT + b * CTXL : b * SEQ;
    const int qa = qi * 128 + qh * 64;
    const float LOG2E = 1.4426950408889634f;
    bf16x8 qf[2][4];
#pragma unroll
    for (int qt = 0; qt < 2; ++qt) { const int tq = qa + 32 * qt + r32; const bf16* qp = P + (size_t)(rowbase + tq) * PW + PC_Q + hq * 64 + 8 * hi;
        float x[4][8];
#pragma unroll
        for (int s = 0; s < 4; ++s) { const v4u w = *(const v4u*)(qp + 16 * s); x[s][0] = bflo(w.x); x[s][1] = bfhi(w.x); x[s][2] = bflo(w.y); x[s][3] = bfhi(w.y); x[s][4] = bflo(w.z); x[s][5] = bfhi(w.z); x[s][6] = bflo(w.w); x[s][7] = bfhi(w.w); }
        if (!is_ctx) {
#pragma unroll
            for (int hf = 0; hf < 2; ++hf) { const float pos = (float)(hf ? (tq & 63) : (tq >> 6));
#pragma unroll
                for (int j = 0; j < 8; ++j) { const float inv = __builtin_amdgcn_exp2f(-(float)(8 * hi + j) * 0.8304820237218406f); const float sn = __sinf(pos * inv), cs = __cosf(pos * inv);
                    const float x1 = x[2 * hf][j], x2 = x[2 * hf + 1][j]; x[2 * hf][j] = x1 * cs - x2 * sn; x[2 * hf + 1][j] = x2 * cs + x1 * sn; } } }
        const float sc = 0.125f * LOG2E;
#pragma unroll
        for (int s = 0; s < 4; ++s) { v4u w; w.x = pk2(x[s][0] * sc, x[s][1] * sc); w.y = pk2(x[s][2] * sc, x[s][3] * sc); w.z = pk2(x[s][4] * sc, x[s][5] * sc); w.w = pk2(x[s][6] * sc, x[s][7] * sc); qf[qt][s] = __builtin_bit_cast(bf16x8, w); }
    }
    float mrun[2], lrun[2]; f32x16 O[2][2];
    { const float sk = F.in[I_SINK][l * 16 + hq] * LOG2E;
#pragma unroll
      for (int qt = 0; qt < 2; ++qt) { mrun[qt] = sk; lrun[qt] = hi ? 0.f : 1.f;
#pragma unroll
        for (int db = 0; db < 2; ++db)
#pragma unroll
            for (int r = 0; r < 16; ++r) O[qt][db][r] = 0.f; } }
    const int kt_lo = is_ctx ? 0 : (qi == 0 ? 2 : 0), nl = is_ctx ? 0 : (6 - (qi == 0 ? 2 : 0) - (qi == 31 ? 2 : 0)), ntile = nl + 4;
    const int rr = F.tid >> 3, cch = F.tid & 7;
    const bf16* kbase_l = P + (size_t)(b * SEQ + rr) * PW + PC_K + kvh * 64 + cch * 8; const bf16* kbase_c = P + (size_t)(NLAT + b * CTXL + rr) * PW + PC_K + kvh * 64 + cch * 8;
    const bf16* vbase_l = (const bf16*)(F.ws + WS_VT) + ((size_t)(b * 4 + kvh) * 64 + rr) * SEQ + cch * 8; const bf16* vbase_c = (const bf16*)(F.ws + WS_VTC) + ((size_t)(b * 4 + kvh) * 64 + rr) * CTXL + cch * 8;
    v4u kw, vw;
    { const bool loc0 = nl > 0; const int k00 = loc0 ? 128 * (qi - 1) + 64 * kt_lo : 0; kw = *(const v4u*)((loc0 ? kbase_l : kbase_c) + (size_t)k00 * PW); vw = *(const v4u*)((loc0 ? vbase_l : vbase_c) + k00); }
    LDS_BARRIER();
#pragma unroll 1
    for (int jt = 0; jt < ntile; ++jt) {
        const bool local = jt < nl; const int k0 = local ? 128 * (qi - 1) + 64 * (kt_lo + jt) : 64 * (jt - nl);
        const LAS unsigned char* KS = F.lds + (jt & 1) * AT_TILE + AT_KOFF; const LAS unsigned char* VS = F.lds + (jt & 1) * AT_TILE + AT_VOFF;
        { *(LAS v4u*)(F.lds + (jt & 1) * AT_TILE + AT_KOFF + rr * AT_KP + cch * 16) = kw;
          LAS v2u* vd = (LAS v2u*)(F.lds + (jt & 1) * AT_TILE + AT_VOFF + rr * AT_VP + cch * 16); vd[0] = (v2u){vw.x, vw.y}; vd[1] = (v2u){vw.z, vw.w}; }
        if (jt + 1 < ntile) { const bool ln = jt + 1 < nl; const int kn = ln ? 128 * (qi - 1) + 64 * (kt_lo + jt + 1) : 64 * (jt + 1 - nl);
            kw = *(const v4u*)((ln ? kbase_l : kbase_c) + (size_t)kn * PW); vw = *(const v4u*)((ln ? vbase_l : vbase_c) + kn); }
        LDS_BARRIER();
        if (local && (k0 + 63 < qa - 128 || k0 > qa + 63 + 128)) continue;
#pragma unroll 1
        for (int kb = 0; kb < 2; ++kb) {
            bf16x8 kf[4];
#pragma unroll
            for (int ss = 0; ss < 4; ++ss) kf[ss] = *(const LAS bf16x8*)(KS + (32 * kb + r32) * AT_KP + (16 * ss + 8 * hi) * 2);
            bf16x8 pb[2][2];
#pragma unroll
            for (int qt = 0; qt < 2; ++qt) { const int tq = qa + 32 * qt + r32;
                f32x16 s;
#pragma unroll
                for (int r = 0; r < 16; ++r) s[r] = 0.f;
#pragma unroll
                for (int ss = 0; ss < 4; ++ss) s = __builtin_amdgcn_mfma_f32_32x32x16_bf16(kf[ss], qf[qt][ss], s, 0, 0, 0);
                if (local) {
#pragma unroll
                    for (int r = 0; r < 16; ++r) { const int kidx = k0 + 32 * kb + (r & 3) + 8 * (r >> 2) + 4 * hi; const int dlt = kidx - tq; if (dlt > 128 || dlt < -128) s[r] = -1.0e30f; } }
                float mloc = s[0];
#pragma unroll
                for (int r = 1; r < 16; ++r) mloc = fmaxf(mloc, s[r]);
                mloc = fmaxf(mloc, __shfl_xor(mloc, 32));
                const float mnew = fmaxf(mrun[qt], mloc), alpha = __builtin_amdgcn_exp2f(mrun[qt] - mnew); mrun[qt] = mnew;
                float psum = 0.f;
#pragma unroll
                for (int r = 0; r < 16; ++r) { s[r] = __builtin_amdgcn_exp2f(s[r] - mnew); psum += s[r]; }
                lrun[qt] = lrun[qt] * alpha + psum;
#pragma unroll
                for (int db = 0; db < 2; ++db)
#pragma unroll
                    for (int r = 0; r < 16; ++r) O[qt][db][r] *= alpha;
#pragma unroll
                for (int s2 = 0; s2 < 2; ++s2) { v4u pw; pw.x = pk2(s[8 * s2 + 0], s[8 * s2 + 1]); pw.y = pk2(s[8 * s2 + 2], s[8 * s2 + 3]); pw.z = pk2(s[8 * s2 + 4], s[8 * s2 + 5]); pw.w = pk2(s[8 * s2 + 6], s[8 * s2 + 7]);
                    pb[qt][s2] = __builtin_bit_cast(bf16x8, pw); }
            }
#pragma unroll
            for (int s2 = 0; s2 < 2; ++s2)
#pragma unroll
                for (int db = 0; db < 2; ++db) { const LAS v2u* vp = (const LAS v2u*)(VS + (32 * db + r32) * AT_VP + (32 * kb + 16 * s2 + 4 * hi) * 2);
                    const v2u a0 = vp[0], a1 = vp[2]; v4u aw; aw.x = a0.x; aw.y = a0.y; aw.z = a1.x; aw.w = a1.y; const bf16x8 va = __builtin_bit_cast(bf16x8, aw);
                    O[0][db] = __builtin_amdgcn_mfma_f32_32x32x16_bf16(va, pb[0][s2], O[0][db], 0, 0, 0);
                    O[1][db] = __builtin_amdgcn_mfma_f32_32x32x16_bf16(va, pb[1][s2], O[1][db], 0, 0, 0); }
        }
    }
    int r32e = r32, hie = hi; asm volatile("" : "+v"(r32e), "+v"(hie));
#pragma unroll
    for (int qt = 0; qt < 2; ++qt) { const float lt = lrun[qt] + __shfl_xor(lrun[qt], 32); const float rl = 1.0f / lt; const int tq = qa + 32 * qt + r32e;
#if FP8_OUTPROJ
        unsigned char* op8 = (unsigned char*)CC + (size_t)(rowbase + tq) * DM + hq * 64 + 4 * hie;
#pragma unroll
        for (int db = 0; db < 2; ++db)
#pragma unroll
            for (int rq = 0; rq < 4; ++rq) *(unsigned*)(op8 + 32 * db + 8 * rq) = pk4_fp8(O[qt][db][4 * rq] * rl, O[qt][db][4 * rq + 1] * rl, O[qt][db][4 * rq + 2] * rl, O[qt][db][4 * rq + 3] * rl); }
#else
        bf16* op = CC + (size_t)(rowbase + tq) * DM + hq * 64 + 4 * hie;
#pragma unroll
        for (int db = 0; db < 2; ++db)
#pragma unroll
            for (int rq = 0; rq < 4; ++rq) { v2u w; w.x = pk2(O[qt][db][4 * rq] * rl, O[qt][db][4 * rq + 1] * rl); w.y = pk2(O[qt][db][4 * rq + 2] * rl, O[qt][db][4 * rq + 3] * rl);
                *(v2u*)(op + 32 * db + 8 * rq) = w; } }
#endif
}
__device__ __forceinline__ void attn_phase(Frame& F, int l, int rep = 0) {
    const int nunits = 512 + (l == 0 ? 32 : 0);
    LAS int* slot = (LAS int*)(F.lds + LDS_X_OFF + 512);
    for (;;) {
        __syncthreads();
        if (F.tid == 0) *slot = (int)__hip_atomic_fetch_add(F.ctl + CW_ATQ + 64 * l + 8 * rep, 1u, RLX_AGENT);
        __syncthreads();
        const int u = __builtin_amdgcn_readfirstlane(*slot);
        if (u >= nunits) break;
        if (u < 512) attn_unit(F, l, u >> 7, (u >> 5) & 3, u & 31, 0); else { const int v = u - 512; attn_unit(F, l, v >> 3, (v >> 1) & 3, v & 1, 1); }
    }
}
#define USE_CHUNK_DN 1
#ifndef DN_SPLIT
#define DN_SPLIT 2
#endif
#ifndef DN_REP_S1
#define DN_REP_S1 1
#endif
#ifndef DN_REP_S3B
#define DN_REP_S3B 1
#endif
#ifndef DN_REP_S3A
#define DN_REP_S3A 1
#endif
#ifndef DN_REP_S4
#define DN_REP_S4 1
#endif

constexpr int DN_F_NEGW = 0, DN_F_QG = 16, DN_F_QK = 32, DN_F_KGT = 40, DN_NFRAG = 56, DN_U_OFF = 57344;
constexpr int DP_QS = 0, DP_KS = 17408, DP_VS = 34816, DP_AS = 52224  , DP_TB = 69632, DP_TW = 78848, DP_QK = 88064, DP_RAW = 52224  , DP_SC = 104960, DP_TF = 106496  , DP_XS = 123904  ;
constexpr int DP_P = 272, DP_P2 = 144;
__device__ __forceinline__ int dn_rec(int b, int h, int dir, int np) { return ((b * 4 + h) * 2 + dir) * 68 + np; }
__device__ __forceinline__ void dn_chunk_of(int ct, int dir, int& b, int& np) { if (ct < 256) { b = ct >> 6; const int c = ct & 63; np = 4 + (dir ? 63 - c : c); } else { b = (ct - 256) >> 2; const int c = (ct - 256) & 3; np = dir ? 3 - c : c; } }
__device__ __forceinline__ unsigned short lds_u16(const LAS unsigned char* p) { return *(const LAS unsigned short*)p; }

__device__ __forceinline__ void dn_prep_unit(Frame& F, int l, int ct, int h, int dir) {
    const bf16* P = (const bf16*)(F.ws + WS_P);
    int lane = F.lane; asm volatile("" : "+v"(lane));
    const int wave = F.wave, i16 = lane & 15, q = lane >> 4;
    const int m0 = ct * 64; int t0, T, base; seq_of(m0, t0, T, base);
    int b, np; dn_chunk_of(ct, dir, b, np);
    unsigned char* tile = F.ws + WS_DNT + (size_t)dn_rec(b, h, dir, np) * DNT_BYTES;
    LAS unsigned char* L = F.lds;
    LAS float* SC = (LAS float*)(L + DP_SC);
    LDS_BARRIER();
    {
        const float* cw = F.in[I_DNCW] + (size_t)l * 4 * 1536;
        LAS float* cwl = (LAS float*)(L + DP_TF);
        for (int i = F.tid; i < 3 * 4 * 128; i += NTHREADS) { const int part = i >> 9, j = (i >> 7) & 3, ch = i & 127; cwl[i] = cw[j * 1536 + part * 512 + h * 128 + ch]; }
        unsigned short pbw = 0, paw = 0;
        if (wave == 0) { const int tok = dir ? 63 - lane : lane; pbw = P[(size_t)(m0 + tok) * PW + PC_BETA + dir * 4 + h]; paw = P[(size_t)(m0 + tok) * PW + PC_DEC + dir * 4 + h]; }
        for (int c = F.tid; c < 67 * 48; c += NTHREADS) { const int row = c / 48, ch = c % 48, part = ch >> 4, cc = ch & 15, tt = t0 + row - 2;
            v4u v = (v4u){0u, 0u, 0u, 0u};
            if (tt >= 0 && tt < T) v = *(const v4u*)(P + (size_t)(base + tt) * PW + PC_DQ + part * 512 + h * 128 + cc * 8);
            *(LAS v4u*)(L + DP_RAW + row * 784 + part * 256 + cc * 16) = v; }
        LDS_BARRIER();
#pragma unroll 1
        for (int rep = 0; rep < DN_REP_S1; ++rep)
#pragma unroll
        for (int part = 0; part < 3; ++part) { const int tok = F.tid >> 3, g8 = F.tid & 7;
            float sv[16];
#pragma unroll
            for (int k = 0; k < 16; ++k) sv[k] = 0.f;
#pragma unroll
            for (int j = 0; j < 4; ++j) { const LAS v4u* rp = (const LAS v4u*)(L + DP_RAW + (tok + j) * 784 + part * 256 + g8 * 32); const v4u r0 = rp[0], r1 = rp[1];
                const LAS f32x4* wp = (const LAS f32x4*)(cwl + (part * 4 + j) * 128 + g8 * 16); const f32x4 w0 = wp[0], w1 = wp[1], w2 = wp[2], w3 = wp[3];
                sv[0] += w0.x * bflo(r0.x); sv[1] += w0.y * bfhi(r0.x); sv[2] += w0.z * bflo(r0.y); sv[3] += w0.w * bfhi(r0.y); sv[4] += w1.x * bflo(r0.z); sv[5] += w1.y * bfhi(r0.z); sv[6] += w1.z * bflo(r0.w); sv[7] += w1.w * bfhi(r0.w);
                sv[8] += w2.x * bflo(r1.x); sv[9] += w2.y * bfhi(r1.x); sv[10] += w2.z * bflo(r1.y); sv[11] += w2.w * bfhi(r1.y); sv[12] += w3.x * bflo(r1.z); sv[13] += w3.y * bfhi(r1.z); sv[14] += w3.z * bflo(r1.w); sv[15] += w3.w * bfhi(r1.w); }
            float ss = 0.f;
#pragma unroll
            for (int k = 0; k < 16; ++k) { sv[k] = siluf_(sv[k]); ss += sv[k] * sv[k]; }
            if (part < 2) { ss += dpp_mov<0xB1>(ss); ss += dpp_mov<0x4E>(ss); ss += dpp_mov<0x141>(ss);
                const float f = (part == 0 ? 0.08838834764831845f : 1.0f) * __builtin_amdgcn_rsqf(ss + EPS);
#pragma unroll
                for (int k = 0; k < 16; ++k) sv[k] *= f; }
            LAS v4u* op = (LAS v4u*)(L + (part == 0 ? DP_QS : (part == 1 ? DP_KS : DP_VS)) + tok * DP_P + g8 * 32);
            op[0] = (v4u){pk2(sv[0], sv[1]), pk2(sv[2], sv[3]), pk2(sv[4], sv[5]), pk2(sv[6], sv[7])}; op[1] = (v4u){pk2(sv[8], sv[9]), pk2(sv[10], sv[11]), pk2(sv[12], sv[13]), pk2(sv[14], sv[15])}; }
        if (wave == 0) {
            const float pb = bf2f(pbw), pa = bf2f(paw);
            const float beta = sigmoidf_(pb); float gc = -__expf(F.in[I_DNALOG][l * 8 + dir * 4 + h]) * softplusf_(pa + F.in[I_DNDT][l * 8 + dir * 4 + h]);
#pragma unroll
            for (int o = 1; o < 64; o <<= 1) { const float v = __shfl_up(gc, o); if (lane >= o) gc += v; }
            const float glast = __shfl(gc, 63);
            SC[lane] = beta; SC[64 + lane] = gc; SC[128 + lane] = __expf(gc); SC[192 + lane] = __expf(glast - gc);
            if (lane == 63) ((float*)(F.ws + WS_DNS))[dn_rec(b, h, dir, np)] = __expf(glast);
        }
    }
    LDS_BARRIER();
#define DN_TOK(r) (dir ? 63 - (r) : (r))
#pragma unroll 1
    for (int rep = 0; rep < DN_REP_S3A; ++rep)
    {
        const int mb = wave & 3, which = wave >> 2;
        f32x4 acc[4];
#pragma unroll
        for (int nb = 0; nb < 4; ++nb) acc[nb] = (f32x4){0.f, 0.f, 0.f, 0.f};
        const LAS unsigned char* arow = L + (which ? DP_QS : DP_KS) + DN_TOK(16 * mb + i16) * DP_P + 16 * q;
#pragma unroll
        for (int ks = 0; ks < 4; ++ks) { const bf16x8 a = *(const LAS bf16x8*)(arow + 64 * ks);
#pragma unroll
            for (int nb = 0; nb < 4; ++nb) { const bf16x8 bb = *(const LAS bf16x8*)(L + DP_KS + DN_TOK(16 * nb + i16) * DP_P + 16 * q + 64 * ks);
                acc[nb] = __builtin_amdgcn_mfma_f32_16x16x32_bf16(a, bb, acc[nb], 0, 0, 0); } }
#pragma unroll
        for (int nb = 0; nb < 4; ++nb)
#pragma unroll
            for (int i = 0; i < 4; ++i) { const int r = 16 * mb + 4 * q + i, c = 16 * nb + i16; const float dec = __expf(SC[64 + r] - SC[64 + c]);
                if (which == 0) ((LAS float*)(L + DP_AS))[r * 68 + c] = (r > c) ? SC[r] * acc[nb][i] * dec : 0.f;
                else *(LAS unsigned short*)(L + DP_QK + r * DP_P2 + c * 2) = (unsigned short)f2bf((r >= c) ? acc[nb][i] * dec : 0.f); }
    }
    LDS_BARRIER();
#define DN_EMIT_FRAG(f_) do { const int fx_ = (f_); v4u o; \
        if (fx_ < DN_F_QG) { const int mb = fx_ >> 2, ks = fx_ & 3; const LAS unsigned char* rp = L + DP_AS + (16 * mb + i16) * DP_P + (32 * ks + 4 * q) * 2; \
            const v2u a = *(const LAS v2u*)rp, c = *(const LAS v2u*)(rp + 32); o.x = a.x; o.y = a.y; o.z = c.x; o.w = c.y; } \
        else if (fx_ < DN_F_QK) { const int ff = fx_ - DN_F_QG, mb = ff >> 2, ks = ff & 3, r = 16 * mb + i16; const LAS unsigned char* rp = L + DP_QS + DN_TOK(r) * DP_P + (32 * ks + 4 * q) * 2; const float eg = SC[128 + r]; \
            const v2u a = *(const LAS v2u*)rp, c = *(const LAS v2u*)(rp + 32); \
            o.x = pk2(bflo(a.x) * eg, bfhi(a.x) * eg); o.y = pk2(bflo(a.y) * eg, bfhi(a.y) * eg); o.z = pk2(bflo(c.x) * eg, bfhi(c.x) * eg); o.w = pk2(bflo(c.y) * eg, bfhi(c.y) * eg); } \
        else if (fx_ < DN_F_KGT) { const int ff = fx_ - DN_F_QK, mb = ff >> 1, ks = ff & 1; const LAS unsigned char* rp = L + DP_QK + (16 * mb + i16) * DP_P2 + (32 * ks + 4 * q) * 2; \
            const v2u a = *(const LAS v2u*)rp, c = *(const LAS v2u*)(rp + 32); o.x = a.x; o.y = a.y; o.z = c.x; o.w = c.y; } \
        else { const int ff = fx_ - DN_F_KGT, mb = ff >> 1, ks = ff & 1, dk = 16 * mb + i16; float e[8]; \
            _Pragma("unroll") for (int jj = 0; jj < 8; ++jj) { const int key = 32 * ks + 16 * (jj >> 2) + 4 * q + (jj & 3); e[jj] = bf2f(lds_u16(L + DP_KS + DN_TOK(key) * DP_P + dk * 2)) * SC[192 + key]; } \
            o.x = pk2(e[0], e[1]); o.y = pk2(e[2], e[3]); o.z = pk2(e[4], e[5]); o.w = pk2(e[6], e[7]); } \
        *(v4u*)(tile + (size_t)fx_ * 1024 + lane * 16) = o; } while (0)
#pragma unroll 1
    for (int rep = 0; rep < DN_REP_S3B; ++rep) {
    if (wave == 0) {
        const LAS float* As = (const LAS float*)(L + DP_AS); LAS float* Tf = (LAS float*)(L + DP_TF);
        const int g = lane >> 4, c = lane & 15;
        f32x4 ar[16][4];
#pragma unroll
        for (int r = 1; r < 16; ++r)
#pragma unroll
            for (int j4 = 0; j4 < (r + 3) / 4; ++j4) ar[r][j4] = *(const LAS f32x4*)(As + (16 * g + r) * 68 + 16 * g + 4 * j4);
        float t[16];
#pragma unroll
        for (int r = 0; r < 16; ++r) { float a0 = (c == r) ? 1.f : 0.f, a1 = 0.f;
#pragma unroll
            for (int j = 0; j < r; ++j) { const float av = ar[r][j >> 2][j & 3]; if (j & 1) a1 -= av * t[j]; else a0 -= av * t[j]; }
            t[r] = a0 + a1; Tf[(16 * g + r) * 68 + 16 * g + c] = t[r]; }
    } else if (rep == 0) {
#pragma unroll 1
        for (int fi = 0; fi < 3; ++fi) DN_EMIT_FRAG(16 + (wave - 1) * 3 + fi);
    }
    LDS_BARRIER();
    if (wave < 3) {
        const LAS float* As = (const LAS float*)(L + DP_AS); LAS float* Tf = (LAS float*)(L + DP_TF); LAS float* Xs = (LAS float*)(L + DP_XS) + wave * 272;
        const int J = wave;
#pragma unroll 1
        for (int I = J + 1; I < 4; ++I) {
            f32x4 acc = {0.f, 0.f, 0.f, 0.f};
#pragma unroll 1
            for (int K = J; K < I; ++K)
#pragma unroll
                for (int sk = 0; sk < 4; ++sk) acc = __builtin_amdgcn_mfma_f32_16x16x4f32(As[(16 * I + i16) * 68 + 16 * K + 4 * sk + q], Tf[(16 * K + 4 * sk + q) * 68 + 16 * J + i16], acc, 0, 0, 0);
#pragma unroll
            for (int i = 0; i < 4; ++i) Xs[(4 * q + i) * 17 + i16] = acc[i];
            LDS_WAIT(); asm volatile("" ::: "memory");
            f32x4 acc2 = {0.f, 0.f, 0.f, 0.f};
#pragma unroll
            for (int sk = 0; sk < 4; ++sk) acc2 = __builtin_amdgcn_mfma_f32_16x16x4f32(Tf[(16 * I + i16) * 68 + 16 * I + 4 * sk + q], Xs[(4 * sk + q) * 17 + i16], acc2, 0, 0, 0);
#pragma unroll
            for (int i = 0; i < 4; ++i) Tf[(16 * I + 4 * q + i) * 68 + 16 * J + i16] = -acc2[i];
            LDS_WAIT(); asm volatile("" ::: "memory");
        }
    } else if (rep == 0) {
#pragma unroll 1
        for (int fi = 0; fi < 4; ++fi) { const int f = 37 + (wave - 3) * 4 + fi; if (f < DN_NFRAG) DN_EMIT_FRAG(f); }
    }
    LDS_BARRIER();
    { const LAS float* Tf = (const LAS float*)(L + DP_TF); const int r = F.tid >> 3, c0 = (F.tid & 7) * 8; float vb[8], vw[8];
#pragma unroll
      for (int k = 0; k < 8; ++k) { const int c = c0 + k; const float v = ((r >> 4) >= (c >> 4)) ? Tf[r * 68 + c] : 0.f; const float bl = SC[c]; vb[k] = v * bl; vw[k] = vb[k] * SC[128 + c]; }
      v4u ob, ow; ob.x = pk2(vb[0], vb[1]); ob.y = pk2(vb[2], vb[3]); ob.z = pk2(vb[4], vb[5]); ob.w = pk2(vb[6], vb[7]); ow.x = pk2(vw[0], vw[1]); ow.y = pk2(vw[2], vw[3]); ow.z = pk2(vw[4], vw[5]); ow.w = pk2(vw[6], vw[7]);
      *(LAS v4u*)(L + DP_TB + r * DP_P2 + c0 * 2) = ob; *(LAS v4u*)(L + DP_TW + r * DP_P2 + c0 * 2) = ow; }
    }
    LDS_BARRIER();
    {
        const int nbp = wave & 3, which = wave >> 2;
        f32x4 acc[4][2];
#pragma unroll
        for (int mb = 0; mb < 4; ++mb) { acc[mb][0] = (f32x4){0.f, 0.f, 0.f, 0.f}; acc[mb][1] = (f32x4){0.f, 0.f, 0.f, 0.f}; }
#pragma unroll
        for (int ks = 0; ks < 2; ++ks) {
            bf16x8 bb[2];
#pragma unroll
            for (int nn = 0; nn < 2; ++nn) { const int n = 16 * (2 * nbp + nn) + i16; unsigned short e[8];
#pragma unroll
                for (int jj = 0; jj < 8; ++jj) e[jj] = lds_u16(L + (which ? DP_KS : DP_VS) + DN_TOK(32 * ks + 8 * q + jj) * DP_P + n * 2);
                v4u w; w.x = e[0] | ((unsigned)e[1] << 16); w.y = e[2] | ((unsigned)e[3] << 16); w.z = e[4] | ((unsigned)e[5] << 16); w.w = e[6] | ((unsigned)e[7] << 16); bb[nn] = __builtin_bit_cast(bf16x8, w); }
#pragma unroll
            for (int mb = 0; mb < 4; ++mb) { const bf16x8 a = *(const LAS bf16x8*)(L + (which ? DP_TW : DP_TB) + (16 * mb + i16) * DP_P2 + 64 * ks + 16 * q);
                acc[mb][0] = __builtin_amdgcn_mfma_f32_16x16x32_bf16(a, bb[0], acc[mb][0], 0, 0, 0); acc[mb][1] = __builtin_amdgcn_mfma_f32_16x16x32_bf16(a, bb[1], acc[mb][1], 0, 0, 0); } }
        if (which == 0) {
#pragma unroll
            for (int mb = 0; mb < 4; ++mb)
#pragma unroll
                for (int nn = 0; nn < 2; ++nn) *(f32x4*)(tile + DN_U_OFF + (size_t)((((2 * nbp + nn) * 4 + mb) * 64 + lane) * 16)) = acc[mb][nn];
        } else {
#pragma unroll
            for (int mb = 0; mb < 4; ++mb)
#pragma unroll
                for (int nn = 0; nn < 2; ++nn)
#pragma unroll
                    for (int i = 0; i < 4; ++i) *(LAS unsigned short*)(L + DP_AS + (16 * mb + 4 * q + i) * DP_P + (16 * (2 * nbp + nn) + i16) * 2) = (unsigned short)f2bf(-acc[mb][nn][i]);
        }
    }
    LDS_BARRIER();
#pragma unroll 1
    for (int fi = 0; fi < 2; ++fi) { const int f = wave * 2 + fi; DN_EMIT_FRAG(f); }
#undef DN_EMIT_FRAG
#undef DN_TOK
}
__device__ __forceinline__ void dn_prep(Frame& F, int l) {
    for (int u = F.bid; u < NCT * 4 * 2; u += F.G) dn_prep_unit(F, l, u >> 3, (u >> 1) & 3, u & 1);
    __syncthreads();
}

__device__ __forceinline__ void dn_scan(Frame& F, int l, int b, int h, int dir, int half) {
    int lane = F.lane; asm volatile("" : "+v"(lane));
    const int w = (DN_SPLIT == 2) ? half * 4 + (F.wave & 3) : F.wave, i16 = lane & 15, q = lane >> 4; const bool active = (DN_SPLIT == 2) ? (F.wave < 4) : true;
    const unsigned char* tiles = F.ws + WS_DNT + (size_t)dn_rec(b, h, dir, 0) * DNT_BYTES;
    const float* egl = (const float*)(F.ws + WS_DNS) + dn_rec(b, h, dir, 0);
    bf16* Ob = (bf16*)(F.ws + WS_DNO);
    LAS unsigned char* L = F.lds;
    f32x4 S[8];
#pragma unroll
    for (int i = 0; i < 8; ++i) S[i] = (f32x4){0.f, 0.f, 0.f, 0.f};
    v4u st[7]; f32x4 un[4];
#pragma unroll
    for (int mb = 0; mb < 4; ++mb) un[mb] = *(const f32x4*)(tiles + DN_U_OFF + (size_t)(((w * 4 + mb) * 64 + lane) * 16));
    LDS_BARRIER();
#pragma unroll
    for (int i = 0; i < 7; ++i) st[i] = *(const v4u*)(tiles + (size_t)(F.tid + i * NTHREADS) * 16);
#pragma unroll
    for (int i = 0; i < 7; ++i) *(LAS v4u*)(L + (F.tid + i * NTHREADS) * 16) = st[i];
#pragma unroll
    for (int i = 0; i < 7; ++i) st[i] = *(const v4u*)(tiles + DNT_BYTES + (size_t)(F.tid + i * NTHREADS) * 16);
    LDS_BARRIER();
#pragma unroll 1
    for (int n = 0; n < 68; ++n) {
        const unsigned char* tile = tiles + (size_t)n * DNT_BYTES; const LAS unsigned char* cur = L + (n & 1) * 57344;
        if (n + 1 < 68) {
#pragma unroll
            for (int i = 0; i < 7; ++i) *(LAS v4u*)(L + ((n + 1) & 1) * 57344 + (F.tid + i * NTHREADS) * 16) = st[i]; }
        if (n + 2 < 68) {
#pragma unroll
            for (int i = 0; i < 7; ++i) st[i] = *(const v4u*)(tile + 2 * DNT_BYTES + (size_t)(F.tid + i * NTHREADS) * 16); }
        if (active) {
        f32x4 vn[4];
#pragma unroll
        for (int mb = 0; mb < 4; ++mb) vn[mb] = un[mb];
        if (n + 1 < 68) {
#pragma unroll
            for (int mb = 0; mb < 4; ++mb) un[mb] = *(const f32x4*)(tile + DNT_BYTES + DN_U_OFF + (size_t)(((w * 4 + mb) * 64 + lane) * 16)); }
        const float el = egl[n];
        bf16x8 bS[4];
#pragma unroll
        for (int ks = 0; ks < 4; ++ks) { v4u x; x.x = pk2(S[2 * ks][0], S[2 * ks][1]); x.y = pk2(S[2 * ks][2], S[2 * ks][3]); x.z = pk2(S[2 * ks + 1][0], S[2 * ks + 1][1]); x.w = pk2(S[2 * ks + 1][2], S[2 * ks + 1][3]); bS[ks] = __builtin_bit_cast(bf16x8, x); }
        f32x4 o[4];
#pragma unroll
        for (int mb = 0; mb < 4; ++mb) { o[mb] = (f32x4){0.f, 0.f, 0.f, 0.f};
#pragma unroll
            for (int ks = 0; ks < 4; ++ks) { const bf16x8 aw = *(const LAS bf16x8*)(cur + (DN_F_NEGW + mb * 4 + ks) * 1024 + lane * 16), aq = *(const LAS bf16x8*)(cur + (DN_F_QG + mb * 4 + ks) * 1024 + lane * 16);
                vn[mb] = __builtin_amdgcn_mfma_f32_16x16x32_bf16(aw, bS[ks], vn[mb], 0, 0, 0); o[mb] = __builtin_amdgcn_mfma_f32_16x16x32_bf16(aq, bS[ks], o[mb], 0, 0, 0); } }
        bf16x8 bV[2];
#pragma unroll
        for (int ks = 0; ks < 2; ++ks) { v4u x; x.x = pk2(vn[2 * ks][0], vn[2 * ks][1]); x.y = pk2(vn[2 * ks][2], vn[2 * ks][3]); x.z = pk2(vn[2 * ks + 1][0], vn[2 * ks + 1][1]); x.w = pk2(vn[2 * ks + 1][2], vn[2 * ks + 1][3]); bV[ks] = __builtin_bit_cast(bf16x8, x); }
#pragma unroll
        for (int mb = 0; mb < 8; ++mb) { S[mb] = S[mb] * el;
#pragma unroll
            for (int ks = 0; ks < 2; ++ks) { const bf16x8 ak = *(const LAS bf16x8*)(cur + (DN_F_KGT + mb * 2 + ks) * 1024 + lane * 16); S[mb] = __builtin_amdgcn_mfma_f32_16x16x32_bf16(ak, bV[ks], S[mb], 0, 0, 0); } }
#pragma unroll
        for (int mb = 0; mb < 4; ++mb)
#pragma unroll
            for (int ks = 0; ks < 2; ++ks) { const bf16x8 aqk = *(const LAS bf16x8*)(cur + (DN_F_QK + mb * 2 + ks) * 1024 + lane * 16); o[mb] = __builtin_amdgcn_mfma_f32_16x16x32_bf16(aqk, bV[ks], o[mb], 0, 0, 0); }
        { int m0; if (n < 4) m0 = NLAT + b * CTXL + 64 * (dir ? 3 - n : n); else m0 = b * SEQ + 64 * (dir ? 63 - (n - 4) : (n - 4));
#pragma unroll
          for (int mb = 0; mb < 4; ++mb)
#pragma unroll
            for (int i = 0; i < 4; ++i) { const int r = 16 * mb + 4 * q + i, tok = dir ? 63 - r : r; Ob[((size_t)dir * NTOK + m0 + tok) * 512 + h * 128 + 16 * w + i16] = (bf16)f2bf(o[mb][i]); } }
        }
        LDS_BARRIER();
    }
}
#define USE_CHUNK_LRU 1

constexpr int LR_XF = 0  , LR_XB = 16640  , LR_WT = 25856  , LR_AA = 62720  , LR_UU = 96000  , LR_END = 129280;
constexpr size_t WS_LCA = WS_LRC, WS_LCH = WS_LRC + 2 * MiB, WS_LCI = WS_LRC + 4 * MiB;
__device__ __forceinline__ void lru_prep(Frame& F, int l) {
    const bf16* P = (const bf16*)(F.ws + WS_P);
    int lane = F.lane; asm volatile("" : "+v"(lane));
    const int wave = F.wave, i16 = lane & 15, q = lane >> 4, nb = F.bid & 7;
    LAS unsigned char* L = F.lds;
    LAS float* XF = (LAS float*)(L + LR_XF); LAS float* AA = (LAS float*)(L + LR_AA); LAS float* UU = (LAS float*)(L + LR_UU);
    bf16* HL = (bf16*)(F.ws + WS_LRH); bf16* AC = (bf16*)(F.ws + WS_LRA);
    __syncthreads();
    for (int e = F.tid; e < 4 * 4096; e += NTHREADS) { const int mat = e >> 12, ii = (e >> 6) & 63, j = e & 63, dir = mat >> 1;
        const float w = (mat & 1 ? F.in[I_LRWI] : F.in[I_LRWR])[((size_t)((l * 2 + dir) * 8 + nb)) * 4096 + ii * 64 + j];
        *(LAS unsigned short*)(L + LR_WT + (mat * 64 + j) * 144 + ii * 2) = (unsigned short)f2bf(w); }
    float cwv[4][8], cbv[8];
    { const int c8 = (F.tid & 7) * 8, ch0 = nb * 64 + c8; const float* cb = F.in[I_LRCB] + l * 512 + ch0; const float* cw = F.in[I_LRCW] + (size_t)l * 4 * 512 + ch0;
#pragma unroll
      for (int k = 0; k < 8; ++k) cbv[k] = cb[k];
#pragma unroll
      for (int j = 0; j < 4; ++j)
#pragma unroll
        for (int k = 0; k < 8; ++k) cwv[j][k] = cw[j * 512 + k]; }
    float gbr[4], gbi[4], gls[4];
    { const int dir = wave >> 2;
#pragma unroll
      for (int n = 0; n < 4; ++n) { const int ch = nb * 64 + 16 * n + i16; gbr[n] = F.in[I_LRBR][(l * 2 + dir) * 512 + ch]; gbi[n] = F.in[I_LRBI][(l * 2 + dir) * 512 + ch]; gls[n] = -softplusf_(-F.in[I_LRLAM][(l * 2 + dir) * 512 + ch]); } }
    v4u wvA[4], wvB[4];
#define LR_LOADRAW(ctx) do { if (F.tid >= 128) { const int _m0 = (ctx) * 64; int _t0, _T, _base; seq_of(_m0, _t0, _T, _base); const int _ch0 = nb * 64 + (F.tid & 7) * 8, _tokA = (F.tid - 128) >> 3, _tokB = (F.tid + 256) >> 3; \
        _Pragma("unroll") for (int j = 0; j < 4; ++j) { const int tt = _t0 + _tokA + j - 2; wvA[j] = (v4u){0u, 0u, 0u, 0u}; if (tt >= 0 && tt < _T) wvA[j] = *(const v4u*)(P + (size_t)(_base + tt) * PW + PC_LX + _ch0); } \
        if (F.tid < 256) { _Pragma("unroll") for (int j = 0; j < 4; ++j) { const int tt = _t0 + _tokB + j - 2; wvB[j] = (v4u){0u, 0u, 0u, 0u}; if (tt >= 0 && tt < _T) wvB[j] = *(const v4u*)(P + (size_t)(_base + tt) * PW + PC_LX + _ch0); } } } } while (0)
#define LR_S1ITEM(wv_, tok_) do { const int tok = (tok_), c8 = (F.tid & 7) * 8; float s[8]; \
        _Pragma("unroll") for (int k = 0; k < 8; ++k) s[k] = cbv[k]; \
        _Pragma("unroll") for (int j = 0; j < 4; ++j) { const v4u w = wv_[j]; \
            s[0] += cwv[j][0] * bflo(w.x); s[1] += cwv[j][1] * bfhi(w.x); s[2] += cwv[j][2] * bflo(w.y); s[3] += cwv[j][3] * bfhi(w.y); s[4] += cwv[j][4] * bflo(w.z); s[5] += cwv[j][5] * bfhi(w.z); s[6] += cwv[j][6] * bflo(w.w); s[7] += cwv[j][7] * bfhi(w.w); } \
        _Pragma("unroll") for (int k = 0; k < 8; ++k) XF[tok * 65 + c8 + k] = s[k]; \
        v4u o; o.x = pk2(s[0], s[1]); o.y = pk2(s[2], s[3]); o.z = pk2(s[4], s[5]); o.w = pk2(s[6], s[7]); *(LAS v4u*)(L + LR_XB + tok * 144 + c8 * 2) = o; } while (0)
#define LR_S1() do { if (F.tid >= 128) { LR_S1ITEM(wvA, (F.tid - 128) >> 3); if (F.tid < 256) LR_S1ITEM(wvB, (F.tid + 256) >> 3); } } while (0)
    if ((F.bid >> 3) < NCT) { LR_LOADRAW(F.bid >> 3); LR_S1(); }
    for (int ct = F.bid >> 3; ct < NCT; ct += F.G >> 3) {
        const int m0 = ct * 64; const bool has_next = ct + (F.G >> 3) < NCT;
        if (has_next) LR_LOADRAW(ct + (F.G >> 3));
        LDS_BARRIER();
        { const int dir = wave >> 2, mb = wave & 3;
          f32x4 ar[4], ai[4];
#pragma unroll
          for (int n = 0; n < 4; ++n) { ar[n] = (f32x4){0.f, 0.f, 0.f, 0.f}; ai[n] = (f32x4){0.f, 0.f, 0.f, 0.f}; }
#pragma unroll
          for (int ks = 0; ks < 2; ++ks) { const bf16x8 a = *(const LAS bf16x8*)(L + LR_XB + (16 * mb + i16) * 144 + 64 * ks + 16 * q);
#pragma unroll
              for (int n = 0; n < 4; ++n) { const bf16x8 br = *(const LAS bf16x8*)(L + LR_WT + ((dir * 2 + 0) * 64 + 16 * n + i16) * 144 + 64 * ks + 16 * q), bi = *(const LAS bf16x8*)(L + LR_WT + ((dir * 2 + 1) * 64 + 16 * n + i16) * 144 + 64 * ks + 16 * q);
                  ar[n] = __builtin_amdgcn_mfma_f32_16x16x32_bf16(a, br, ar[n], 0, 0, 0); ai[n] = __builtin_amdgcn_mfma_f32_16x16x32_bf16(a, bi, ai[n], 0, 0, 0); } }
#pragma unroll
          for (int n = 0; n < 4; ++n) { const int j = 16 * n + i16; const float br_ = gbr[n], bi_ = gbi[n], logsig = gls[n];
#pragma unroll
              for (int i = 0; i < 4; ++i) { const int tok = 16 * mb + 4 * q + i; const float r = sigmoidf_(ar[n][i] + br_), ig = sigmoidf_(ai[n][i] + bi_);
                  const float log_a = 8.0f * r * logsig, a = __expf(log_a), y2 = 2.0f * log_a;
                  const float om = (y2 > -0.1f) ? -y2 * (1.0f + y2 * (0.5f + y2 * (0.16666667f + y2 * 0.041666668f))) : 1.0f - __expf(y2);
                  const float u = __builtin_amdgcn_sqrtf(om) * (ig * XF[tok * 65 + j]);
                  AA[(dir * 64 + tok) * 65 + j] = a; UU[(dir * 64 + tok) * 65 + j] = u; } } }
        LDS_BARRIER();
        if (F.tid < 128) { const int dir = F.tid >> 6, j = F.tid & 63, ch = nb * 64 + j; float h = 0.f, ac = 1.f;
            long o = (long)(((size_t)dir * NTOK + m0 + (dir ? 63 : 0)) * 512 + ch); const long ostep = dir ? -512 : 512;
#pragma unroll 1
            for (int s0 = 0; s0 < 64; s0 += 8) { float av[8], uv[8];
#pragma unroll
                for (int k = 0; k < 8; ++k) { const int tok = dir ? 63 - (s0 + k) : (s0 + k); av[k] = AA[(dir * 64 + tok) * 65 + j]; uv[k] = UU[(dir * 64 + tok) * 65 + j]; }
#pragma unroll
                for (int k = 0; k < 8; ++k) { h = av[k] * h + uv[k]; ac *= av[k]; HL[o] = (bf16)f2bf(h); AC[o] = (bf16)f2bf(ac); o += ostep; } }
            ((float*)(F.ws + WS_LCA))[((size_t)dir * NCT + ct) * 512 + ch] = ac; ((float*)(F.ws + WS_LCH))[((size_t)dir * NCT + ct) * 512 + ch] = h; }
        else if (has_next) LR_S1();
    }
    LDS_BARRIER();
}
__device__ __forceinline__ void lru_carry(Frame& F, int idx) {
    const int ch = idx & 511, dir = (idx >> 9) & 1, b = idx >> 10;
    const float* CA = (const float*)(F.ws + WS_LCA); const float* CH = (const float*)(F.ws + WS_LCH); float* CI = (float*)(F.ws + WS_LCI);
    float h = 0.f;
#pragma unroll 4
    for (int n = 0; n < 68; ++n) { const int ct = n < 4 ? 256 + b * 4 + (dir ? 3 - n : n) : b * 64 + (dir ? 63 - (n - 4) : (n - 4)); const size_t o = ((size_t)dir * NCT + ct) * 512 + ch;
        CI[o] = h; h = CA[o] * h + CH[o]; }
}
__device__ __forceinline__ void lru_fin(Frame& F, int l) {
    const int nrows = (l == 0) ? NTOK : NLAT;
    const bf16* P = (const bf16*)(F.ws + WS_P); bf16* CC = (bf16*)(F.ws + WS_CC);
    const bf16* HL = (const bf16*)(F.ws + WS_LRH); const bf16* AC = (const bf16*)(F.ws + WS_LRA); const float* CI = (const float*)(F.ws + WS_LCI);
    for (size_t i = (size_t)F.bid * NTHREADS + F.tid; i < (size_t)nrows * 128; i += (size_t)F.G * NTHREADS) { const int m = (int)(i >> 7), c4 = (int)(i & 127) * 4, ct = m >> 6;
        const v2u hw0 = *(const v2u*)(HL + (size_t)m * 512 + c4), aw0 = *(const v2u*)(AC + (size_t)m * 512 + c4), hw1 = *(const v2u*)(HL + ((size_t)NTOK + m) * 512 + c4), aw1 = *(const v2u*)(AC + ((size_t)NTOK + m) * 512 + c4);
        const f32x4 h0 = {bflo(hw0.x), bfhi(hw0.x), bflo(hw0.y), bfhi(hw0.y)}, a0 = {bflo(aw0.x), bfhi(aw0.x), bflo(aw0.y), bfhi(aw0.y)}, h1 = {bflo(hw1.x), bfhi(hw1.x), bflo(hw1.y), bfhi(hw1.y)}, a1 = {bflo(aw1.x), bfhi(aw1.x), bflo(aw1.y), bfhi(aw1.y)};
        const f32x4 i0 = *(const f32x4*)(CI + (size_t)ct * 512 + c4), i1 = *(const f32x4*)(CI + ((size_t)NCT + ct) * 512 + c4);
        const f32x4 hs = (a0 * i0 + h0) + (a1 * i1 + h1); const v2u yw = *(const v2u*)(P + (size_t)m * PW + PC_LY + c4);
#if FP8_OUTPROJ
        *(unsigned*)((unsigned char*)CC + (size_t)m * DM + 1536 + c4) = pk4_fp8(hs.x * gelu_tanh(bflo(yw.x)), hs.y * gelu_tanh(bfhi(yw.x)), hs.z * gelu_tanh(bflo(yw.y)), hs.w * gelu_tanh(bfhi(yw.y))); }
#else
        v2u o; o.x = pk2(hs.x * gelu_tanh(bflo(yw.x)), hs.y * gelu_tanh(bfhi(yw.x))); o.y = pk2(hs.z * gelu_tanh(bflo(yw.y)), hs.w * gelu_tanh(bfhi(yw.y)));
        *(v2u*)(CC + (size_t)m * DM + 1536 + c4) = o; }
#endif
}

constexpr size_t WS_DNQ = WS_DNT;
constexpr size_t WS_BG = WS_DNS + 1 * MiB;
constexpr size_t WS_XC = WS_XS;

__device__ __forceinline__ void naive_prep(Frame& F, int l) {
    const bf16* P = (const bf16*)(F.ws + WS_P);
    const int gw = F.bid * NWAVES + F.wave, NGW = F.G * NWAVES;
#if !defined(USE_CHUNK_DN)
    {
        float* DNQ = (float*)(F.ws + WS_DNQ); float* BG = (float*)(F.ws + WS_BG);
        const float* cw = F.in[I_DNCW] + (size_t)l * 4 * 1536;
        for (int it = gw; it < NTOK * 4; it += NGW) {
            const int m = it >> 2, h = it & 3; int t, T, base; seq_of(m, t, T, base);
            float val[3][2];
#pragma unroll
            for (int part = 0; part < 3; ++part)
#pragma unroll
                for (int dd = 0; dd < 2; ++dd) { const int d = F.lane + 64 * dd, cch = part * 512 + h * 128 + d, col = PC_DQ + cch; float s = 0.f;
#pragma unroll
                    for (int j = 0; j < 4; ++j) { const int tt = t + j - 2; if (tt >= 0 && tt < T) s += cw[j * 1536 + cch] * bf2f(P[(size_t)(base + tt) * PW + col]); }
                    val[part][dd] = siluf_(s); }
            const float sq = wave_sum(val[0][0] * val[0][0] + val[0][1] * val[0][1]), sk = wave_sum(val[1][0] * val[1][0] + val[1][1] * val[1][1]);
            const float fq = 0.08838834764831845f / sqrtf(sq + EPS), fk = 1.0f / sqrtf(sk + EPS);
#pragma unroll
            for (int dd = 0; dd < 2; ++dd) { const int d = F.lane + 64 * dd; float* o = DNQ + (size_t)m * 1536 + h * 128 + d;
                o[0] = val[0][dd] * fq; o[512] = val[1][dd] * fk; o[1024] = val[2][dd]; }
            if (h == 0 && F.lane < 8) { const int dir = F.lane >> 2, hh = F.lane & 3;
                const float pb = bf2f(P[(size_t)m * PW + PC_BETA + F.lane]), pa = bf2f(P[(size_t)m * PW + PC_DEC + F.lane]);
                BG[m * 16 + F.lane] = sigmoidf_(pb);
                BG[m * 16 + 8 + F.lane] = -__expf(F.in[I_DNALOG][l * 8 + dir * 4 + hh]) * softplusf_(pa + F.in[I_DNDT][l * 8 + dir * 4 + hh]); }
        }
    }
#endif
#if !defined(USE_CHUNK_LRU)
    {
        LAS float* xc = (LAS float*)F.lds;
        float* A = (float*)(F.ws + WS_LRA); float* U = (float*)(F.ws + WS_LRH);
        const float* cw = F.in[I_LRCW] + (size_t)l * 4 * 512; const float* cb = F.in[I_LRCB] + l * 512;
        for (int m0 = F.bid * 8; m0 < NTOK; m0 += F.G * 8) {
            __syncthreads();
            for (int i = F.tid; i < 8 * 512; i += NTHREADS) { const int m = m0 + (i >> 9), ch = i & 511; int t, T, base; seq_of(m, t, T, base); float s = cb[ch];
#pragma unroll
                for (int j = 0; j < 4; ++j) { const int tt = t + j - 2; if (tt >= 0 && tt < T) s += cw[j * 512 + ch] * bf2f(P[(size_t)(base + tt) * PW + PC_LX + ch]); }
                xc[i] = s; }
            __syncthreads();
            for (int i = F.tid; i < 8 * 512 * 2; i += NTHREADS) { const int ch = i & 511, dir = (i >> 9) & 1, tk = i >> 10, m = m0 + tk, blk = ch >> 6, j = ch & 63;
                const float* wr = F.in[I_LRWR] + ((size_t)((l * 2 + dir) * 8 + blk)) * 4096 + j; const float* wi = F.in[I_LRWI] + ((size_t)((l * 2 + dir) * 8 + blk)) * 4096 + j;
                float sr = F.in[I_LRBR][(l * 2 + dir) * 512 + ch], si = F.in[I_LRBI][(l * 2 + dir) * 512 + ch];
#pragma unroll 8
                for (int ii = 0; ii < 64; ++ii) { const float x = xc[tk * 512 + blk * 64 + ii]; sr += x * wr[ii * 64]; si += x * wi[ii * 64]; }
                const float r = sigmoidf_(sr), ig = sigmoidf_(si); const float lam = F.in[I_LRLAM][(l * 2 + dir) * 512 + ch];
                const float logsig = -softplusf_(-lam);
                const float log_a = 8.0f * r * logsig; const float a = __expf(log_a);
                const float u = sqrtf(-expm1f(2.0f * log_a)) * (ig * xc[tk * 512 + ch]);
                A[((size_t)dir * NTOK + m) * 512 + ch] = a; U[((size_t)dir * NTOK + m) * 512 + ch] = u; }
        }
        __syncthreads();
    }
#endif
}

__device__ __forceinline__ void naive_attn_row(Frame& F, int l, int m, int hq) {
    const bf16* P = (const bf16*)(F.ws + WS_P); bf16* CC = (bf16*)(F.ws + WS_CC);
    const int d = F.lane, kvh = hq >> 2; int t, T, base; seq_of(m, t, T, base);
    const bool lat = m < NLAT; const int b = lat ? (m >> 12) : ((m - NLAT) >> 8);
    const int dd = d & 31, jf = dd & 15; const float inv = __powf(10000.0f, -(float)jf * (1.0f / 16.0f));
    const bool second = (dd >= 16), colhalf = (d >= 32);
    float q = bf2f(P[(size_t)m * PW + PC_Q + hq * 64 + d]);
    if (lat) { const float pos = (float)(colhalf ? (t & 63) : (t >> 6)); float sn, cs; sincosf(pos * inv, &sn, &cs); const float pr = __shfl_xor(q, 16); q = second ? (q * cs + pr * sn) : (q * cs - pr * sn); }
    q *= 0.125f;
    float mx = F.in[I_SINK][l * 16 + hq], den = 1.0f, acc = 0.f;
    if (lat) { const int t0 = t - 128 < 0 ? 0 : t - 128, t1 = t + 128 > SEQ - 1 ? SEQ - 1 : t + 128;
        for (int tk = t0; tk <= t1; ++tk) { const size_t r = (size_t)(base + tk) * PW; float k = bf2f(P[r + PC_K + kvh * 64 + d]); const float v = bf2f(P[r + PC_V + kvh * 64 + d]);
            const float pos = (float)(colhalf ? (tk & 63) : (tk >> 6)); float sn, cs; sincosf(pos * inv, &sn, &cs); const float pr = __shfl_xor(k, 16); k = second ? (k * cs + pr * sn) : (k * cs - pr * sn);
            const float s = wave_sum(q * k); const float mn = fmaxf(mx, s), f = __expf(mx - mn), p = __expf(s - mn); den = den * f + p; acc = acc * f + p * v; mx = mn; } }
    for (int c = 0; c < CTXL; ++c) { const size_t r = (size_t)(NLAT + b * CTXL + c) * PW; const float k = bf2f(P[r + PC_K + kvh * 64 + d]), v = bf2f(P[r + PC_V + kvh * 64 + d]);
        const float s = wave_sum(q * k); const float mn = fmaxf(mx, s), f = __expf(mx - mn), p = __expf(s - mn); den = den * f + p; acc = acc * f + p * v; mx = mn; }
    CC[(size_t)m * DM + hq * 64 + d] = (bf16)f2bf(acc / den);
}

__device__ __forceinline__ int scan_row(int n, int b, int dir) { if (n < CTXL) { const int t = dir ? (CTXL - 1 - n) : n; return NLAT + b * CTXL + t; } const int t = dir ? (SEQ - 1 - (n - CTXL)) : (n - CTXL); return b * SEQ + t; }
__device__ __forceinline__ void naive_scan(Frame& F, int l, int rep = 0) {
#if defined(USE_CHUNK_DN)
    if (F.bid < 32 * DN_SPLIT) { if (DN_SPLIT == 2) dn_scan(F, l, F.bid >> 4, (F.bid >> 2) & 3, (F.bid >> 1) & 1, F.bid & 1); else dn_scan(F, l, F.bid >> 3, (F.bid >> 1) & 3, F.bid & 1, 0); }
#else
    if (F.bid < 32) {
        const int b = F.bid >> 3, h = (F.bid >> 1) & 3, dir = F.bid & 1, dvc = F.tid & 127, kq = F.tid >> 7;
        const float* DNQ = (const float*)(F.ws + WS_DNQ); const float* BG = (const float*)(F.ws + WS_BG); float* O = (float*)(F.ws + WS_DNO);
        LAS float* buf = (LAS float*)F.lds;
        LAS float* red = buf + 768;
        LAS float* red2 = red + 512;
        float S[32];
#pragma unroll
        for (int i = 0; i < 32; ++i) S[i] = 0.f;
        constexpr int NT = CTXL + SEQ;
        { const int m = scan_row(0, b, dir); if (F.tid < 384) buf[F.tid] = DNQ[(size_t)m * 1536 + (F.tid >> 7) * 512 + h * 128 + (F.tid & 127)]; }
        __syncthreads();
#pragma unroll 1
        for (int n = 0; n < NT; ++n) {
            const int m = scan_row(n, b, dir); const LAS float* cur = buf + (n & 1) * 384;
            float nextv = 0.f; if (n + 1 < NT && F.tid < 384) { const int m2 = scan_row(n + 1, b, dir); nextv = DNQ[(size_t)m2 * 1536 + (F.tid >> 7) * 512 + h * 128 + (F.tid & 127)]; }
            const float beta = BG[m * 16 + dir * 4 + h], decay = __expf(BG[m * 16 + 8 + dir * 4 + h]);
            float ks = 0.f;
#pragma unroll
            for (int i = 0; i < 32; ++i) ks += cur[128 + kq * 32 + i] * S[i];
            red[kq * 128 + dvc] = ks;
            __syncthreads();
            const float kS = (red[dvc] + red[128 + dvc]) + (red[256 + dvc] + red[384 + dvc]);
            const float upd = beta * (cur[256 + dvc] - decay * kS);
            float os = 0.f;
#pragma unroll
            for (int i = 0; i < 32; ++i) { S[i] = decay * S[i] + cur[128 + kq * 32 + i] * upd; os += cur[kq * 32 + i] * S[i]; }
            red2[kq * 128 + dvc] = os;
            if (F.tid < 384) buf[((n + 1) & 1) * 384 + F.tid] = nextv;
            __syncthreads();
            if (kq == 0) O[((size_t)dir * NTOK + m) * 512 + h * 128 + dvc] = (red2[dvc] + red2[128 + dvc]) + (red2[256 + dvc] + red2[384 + dvc]);
        }
    }
#endif
#if defined(USE_CHUNK_LRU)
    else if (F.bid < 32 * DN_SPLIT + 8) { lru_carry(F, (F.bid - 32 * DN_SPLIT) * NTHREADS + F.tid); }
#else
    else if (F.bid < 40) {
        const int idx = (F.bid - 32) * NTHREADS + F.tid, ch = idx & 511, dir = (idx >> 9) & 1, b = idx >> 10;
        const float* A = (const float*)(F.ws + WS_LRA); float* U = (float*)(F.ws + WS_LRH);
        float hs = 0.f;
#pragma unroll 4
        for (int n = 0; n < CTXL + SEQ; ++n) { int m; if (n < CTXL) { const int t = dir ? (CTXL - 1 - n) : n; m = NLAT + b * CTXL + t; } else { const int t = dir ? (SEQ - 1 - (n - CTXL)) : (n - CTXL); m = b * SEQ + t; }
            const size_t o = ((size_t)dir * NTOK + m) * 512 + ch; hs = A[o] * hs + U[o]; U[o] = hs; }
    }
#endif
#if defined(USE_MFMA_ATTN)
#if SCAN_SPLIT_ORDER
    if ((F.bid & 3) >= SCAN_ATTN_FIRST) { convert_moe_queue(F, l, rep); attn_phase(F, l, rep); } else { attn_phase(F, l, rep); convert_moe_queue(F, l, rep); }
#else
    attn_phase(F, l, rep);
    convert_moe_queue(F, l, rep);
#endif
#else
    {
        const int nrows = (l == 0) ? NTOK : NLAT;
        for (;;) { int m = 0; if (F.lane == 0) m = (int)__hip_atomic_fetch_add(F.ctl + CW_ATQ + 64 * l, 1u, RLX_AGENT); m = __builtin_amdgcn_readfirstlane(m);
            if (m >= nrows) break;
#pragma unroll 1
            for (int hq = 0; hq < 16; ++hq) naive_attn_row(F, l, m, hq); }
    }
#endif
}

__device__ __forceinline__ void naive_fin(Frame& F, int l) {
    const int nrows = (l == 0) ? NTOK : NLAT;
    const bf16* P = (const bf16*)(F.ws + WS_P); bf16* CC = (bf16*)(F.ws + WS_CC);
    const int gw = F.bid * NWAVES + F.wave, NGW = F.G * NWAVES;
    const float* O = (const float*)(F.ws + WS_DNO); const float* HS = (const float*)(F.ws + WS_LRH);
    for (int it0 = gw * 2; it0 < nrows * 4; it0 += NGW * 2) {
        float2 oa[2], ob[2]; unsigned gw_[2];
#pragma unroll
        for (int k = 0; k < 2; ++k) { const int it = it0 + k, m = it >> 2, h = it & 3; const int c = h * 128 + 2 * F.lane;
            { const bf16* Ob = (const bf16*)(F.ws + WS_DNO); const unsigned wa = *(const unsigned*)(Ob + (size_t)m * 512 + c), wb = *(const unsigned*)(Ob + ((size_t)NTOK + m) * 512 + c); oa[k] = make_float2(bflo(wa), bfhi(wa)); ob[k] = make_float2(bflo(wb), bfhi(wb)); } gw_[k] = *(const unsigned*)(P + (size_t)m * PW + PC_DG + c); }
        const float2 ng = *(const float2*)(F.in[I_DNNG] + l * 128 + 2 * F.lane);
#pragma unroll
        for (int k = 0; k < 2; ++k) { const int it = it0 + k, m = it >> 2, h = it & 3; const float o0 = oa[k].x + ob[k].x, o1 = oa[k].y + ob[k].y;
            const float rstd = 1.0f / sqrtf(wave_sum(o0 * o0 + o1 * o1) * (1.0f / 128.0f) + EPS);
#if FP8_OUTPROJ
            *(unsigned short*)((unsigned char*)CC + (size_t)m * DM + 1024 + h * 128 + 2 * F.lane) = (unsigned short)(pk4_fp8(o0 * rstd * ng.x * siluf_(bflo(gw_[k])), o1 * rstd * ng.y * siluf_(bfhi(gw_[k])), 0.f, 0.f) & 0xffffu); }
#else
            *(unsigned*)(CC + (size_t)m * DM + 1024 + h * 128 + 2 * F.lane) = pk2(o0 * rstd * ng.x * siluf_(bflo(gw_[k])), o1 * rstd * ng.y * siluf_(bfhi(gw_[k]))); }
#endif
    }
#if defined(USE_CHUNK_LRU)
    lru_fin(F, l);
#else
    for (size_t i = (size_t)F.bid * NTHREADS + F.tid; i < (size_t)nrows * 512; i += (size_t)F.G * NTHREADS) { const int m = (int)(i >> 9), ch = (int)(i & 511);
        const float hsum = HS[(size_t)m * 512 + ch] + HS[((size_t)NTOK + m) * 512 + ch]; const float y = bf2f(P[(size_t)m * PW + PC_LY + ch]);
        CC[(size_t)m * DM + 1536 + ch] = (bf16)f2bf(hsum * gelu_tanh(y)); }
#endif
}
#ifndef PHASE_PREP
#if defined(USE_MFMA_ATTN)
#if defined(USE_CHUNK_DN)
#define PHASE_PREP(F, l) do { attn_prep(F, l); lru_prep(F, l); dn_prep(F, l); } while (0)
#else
#define PHASE_PREP(F, l) do { naive_prep(F, l); attn_prep(F, l); } while (0)
#endif
#else
#define PHASE_PREP(F, l) naive_prep(F, l)
#endif
#endif
#ifndef PHASE_SCAN
#define PHASE_SCAN(F, l) naive_scan(F, l)
#endif
#ifndef PHASE_FIN
#define PHASE_FIN(F, l) naive_fin(F, l)
#endif

#ifndef PHASE_INPROJ
#define PHASE_INPROJ(F, l) do {} while (0)
#endif
#ifndef PHASE_PREP
#define PHASE_PREP(F, l) do {} while (0)
#endif
#ifndef PHASE_SCAN
#define PHASE_SCAN(F, l) do {} while (0)
#endif
#ifndef PHASE_FIN
#define PHASE_FIN(F, l) do {} while (0)
#endif
#ifndef PHASE_OUTPROJ
#define PHASE_OUTPROJ(F, l) do {} while (0)
#endif
#ifndef PHASE_NORM2
#define PHASE_NORM2(F, l) do {} while (0)
#endif
#ifndef PHASE_SCATTER
#define PHASE_SCATTER(F, l) do {} while (0)
#endif
#ifndef PHASE_GEMM1
#define PHASE_GEMM1(F, l) do {} while (0)
#endif
#ifndef PHASE_GEMM2
#define PHASE_GEMM2(F, l) do {} while (0)
#endif

#ifndef MK_SPLIT
#define MK_SPLIT 0
#endif
#ifndef MK_STAGE
#define MK_STAGE 99
#endif
#ifndef MK_TAILFILL
#define MK_TAILFILL 0
#endif
#ifndef MK_DUP
#define MK_DUP 0
#endif
#define DUP(k) ((MK_DUP >> (k)) & 1)
#define TCTL() ((gu32*)(((unsigned char* const __attribute__((address_space(4)))*)__builtin_amdgcn_kernarg_segment_ptr())[N_IN + 1] + WS_CTL))
#define TMARK(c, sgn) do { if (((MK_TIME >> (c)) & 1) && blockIdx.x == 0 && threadIdx.x == 0) (void)__hip_atomic_fetch_add(TCTL() + 20480, sgn (unsigned)__builtin_amdgcn_s_memrealtime(), RLX_AGENT); } while (0)
constexpr int N_PHASES = 23;
struct Args { const float* in[N_IN]; float* out; unsigned char* ws; int ph_lo, ph_hi; };
static_assert(sizeof(Args) == (N_IN + 2) * 8 + 8, "Args has no padding");

__global__ void __launch_bounds__(NTHREADS, 2) fwd_kernel(Args args) {
    extern __shared__ __attribute__((aligned(16))) unsigned char lds[];
    Frame F;
    F.lds = (LAS unsigned char*)lds;
    F.MISC = (volatile LAS unsigned*)(F.lds + MISC_OFF);
    F.tid = threadIdx.x; F.lane = F.tid & 63; F.wave = __builtin_amdgcn_readfirstlane(F.tid >> 6);
    F.G = 256; F.bid = blockIdx.x;
    F.ws = args.ws; F.out = args.out; F.ctl = (gu32*)(args.ws + WS_CTL);
    F.in = (const float* const __attribute__((address_space(4)))*)__builtin_amdgcn_kernarg_segment_ptr();
    for (int u = F.tid; u < (LDS_BYTES - LDSCTL_OFF) / 4; u += NTHREADS) ((LAS unsigned*)(F.lds + LDSCTL_OFF))[u] = 0u;
    __syncthreads();
    XcdBarrier bar; bar.bar = (unsigned*)(F.ctl + CW_BAR); bar.x = 0; bar.st = nullptr;
    if (!MK_SPLIT) bar = xcd_barrier_post((unsigned*)(F.ctl + CW_BAR), F.MISC + 8);
    const int lo = args.ph_lo, hi = args.ph_hi;
#define IN(k) (lo <= (k) && (k) < hi && phase_enter(F))
#define INR(k) (lo <= (k) && (k) < hi)
#define SEAM(k) do { if (INR(k) && INR((k) + 1)) { if (MK_TAILFILL && (k) < 15) tail_fill(F, (k), (k) < 5 ? 0 : 1); xcd_barrier(bar); } } while (0)

    TMARK(10, 0u - ); if (IN(0)) { p0_prologue_a(F); } SEAM(0); TMARK(10, );
    TMARK(11, 0u - ); if (IN(1)) { p0_prologue_b(F); if (DUP(0)) { __syncthreads(); p0_prologue_b(F); } } SEAM(1); TMARK(11, );
#pragma unroll 1
    for (int l = 0; l < DEPTH; ++l) {
        const int pb = 2 + 10 * l;
        TMARK(0, 0u - ); if (IN(pb + 0)) { phase_norm1(F, l); if (DUP(13) && l == 0) { __syncthreads(); phase_norm1(F, l); } } SEAM(pb + 0); TMARK(0, );
        TMARK(1, 0u - ); if (IN(pb + 1)) { PHASE_INPROJ(F, l); if (DUP(1)) { __syncthreads(); PHASE_INPROJ(F, l); } } SEAM(pb + 1); TMARK(1, );
        TMARK(2, 0u - ); if (IN(pb + 2)) { PHASE_PREP(F, l); if (DUP(2)) { __syncthreads(); dn_prep(F, l); } if (DUP(6)) { __syncthreads(); lru_prep(F, l); } } SEAM(pb + 2); TMARK(2, );
        TMARK(3, 0u - ); if (IN(pb + 3)) { if (DUP(3) && F.bid < 64) dn_scan(F, l, F.bid >> 4, (F.bid >> 2) & 3, (F.bid >> 1) & 1, F.bid & 1); PHASE_SCAN(F, l); if (DUP(10)) { __syncthreads(); naive_scan(F, l, 1); } if (DUP(11)) { __syncthreads(); attn_phase(F, l, 2); } if (DUP(12)) { __syncthreads(); convert_moe_queue(F, l, 3); } } SEAM(pb + 3); TMARK(3, );
        TMARK(4, 0u - ); if (IN(pb + 4)) { PHASE_FIN(F, l); if (DUP(4)) { __syncthreads(); PHASE_FIN(F, l); } } SEAM(pb + 4); TMARK(4, );
        TMARK(5, 0u - ); if (IN(pb + 5)) { PHASE_OUTPROJ(F, l); if (DUP(5) && l == 0) { __syncthreads(); PHASE_OUTPROJ(F, l); } } SEAM(pb + 5); TMARK(5, );
        TMARK(6, 0u - ); if (IN(pb + 6)) { PHASE_NORM2(F, l); } SEAM(pb + 6); TMARK(6, );
        TMARK(7, 0u - ); if (IN(pb + 7)) { PHASE_SCATTER(F, l); if (DUP(7)) { __syncthreads(); PHASE_SCATTER(F, l); } } SEAM(pb + 7); TMARK(7, );
        TMARK(8, 0u - ); if (IN(pb + 8)) { PHASE_GEMM1(F, l); if (DUP(8)) { __syncthreads(); PHASE_GEMM1(F, l); } } SEAM(pb + 8); TMARK(8, );
        TMARK(9, 0u - ); if (IN(pb + 9)) { PHASE_GEMM2(F, l); if (DUP(9)) { __syncthreads(); PHASE_GEMM2(F, l); } } SEAM(pb + 9); TMARK(9, );
    }
    TMARK(12, 0u - ); if (IN(22)) { phase_final(F, MK_STAGE >= 9); if (DUP(13)) { __syncthreads(); phase_final(F, MK_STAGE >= 9); } }
#if MK_TIME
    __syncthreads(); TMARK(12, );
    if (blockIdx.x == 0 && threadIdx.x == 0) { const unsigned t0_ = (unsigned)__builtin_amdgcn_s_memrealtime(); unsigned d_ = __hip_atomic_load(TCTL() + 20480, RLX_AGENT);
        while ((unsigned)__builtin_amdgcn_s_memrealtime() - t0_ < d_) __builtin_amdgcn_s_sleep(8); }
#endif
#undef IN
#undef SEAM
}

extern "C" void kernel_launch(void* const* d_in, const int* in_sizes, int n_in, void* d_out, int out_size, void* d_ws, size_t ws_size, hipStream_t stream) {
    static int grid = 0;
    if (grid == 0) {
        if (n_in != N_IN || out_size != NLAT * DM || ws_size < WS_END) { fprintf(stderr, "kernel_launch: unexpected shapes (n_in %d, out %d, ws %zu); nothing launched\n", n_in, out_size, ws_size); grid = -1; return; }
        int dev = 0, cus = 0, per_cu = 0;
        if (hipGetDevice(&dev) != hipSuccess || hipDeviceGetAttribute(&cus, hipDeviceAttributeMultiprocessorCount, dev) != hipSuccess) { grid = -1; return; }
        if (hipFuncSetAttribute((const void*)fwd_kernel, hipFuncAttributeMaxDynamicSharedMemorySize, LDS_BYTES) != hipSuccess) { fprintf(stderr, "kernel_launch: hipFuncSetAttribute failed\n"); grid = -1; return; }
        if (hipOccupancyMaxActiveBlocksPerMultiprocessor(&per_cu, (const void*)fwd_kernel, NTHREADS, LDS_BYTES) != hipSuccess || per_cu < 1) { fprintf(stderr, "kernel_launch: occupancy query says %d\n", per_cu); }
        (void)hipGetLastError();
        grid = cus;
        if (grid != 256) { fprintf(stderr, "kernel_launch: built for 256 CUs, device has %d; nothing launched\n", cus); grid = -1; return; }
    }
    if (grid < 0) return;
    if (hipMemsetAsync((char*)d_ws + WS_CTL, 0, CTL_ZERO_BYTES, stream) != hipSuccess) return;
    Args a{};
    for (int i = 0; i < N_IN; ++i) a.in[i] = (const float*)d_in[i];
    a.out = (float*)d_out; a.ws = (unsigned char*)d_ws;
#if MK_SPLIT
    for (int p = 0; p < N_PHASES; ++p) { a.ph_lo = p; a.ph_hi = p + 1; hipLaunchKernelGGL(fwd_kernel, dim3(grid), dim3(NTHREADS), LDS_BYTES, stream, a); }
#else
    a.ph_lo = 0; a.ph_hi = N_PHASES;
    hipLaunchKernelGGL(fwd_kernel, dim3(grid), dim3(NTHREADS), LDS_BYTES, stream, a);
#endif
    const hipError_t le = hipPeekAtLastError();
    if (le != hipSuccess) fprintf(stderr, "kernel_launch: launch failed: %s\n", hipGetErrorName(le));
}
```

```cpp
#include <hip/hip_runtime.h>
#include <cstdio>
#include <cstdint>

constexpr int DM = 2048, NB = 4, SEQ = 4096, CTXL = 256, DEPTH = 2;
constexpr int NLAT = NB * SEQ, NCTX = NB * CTXL, NTOK = NLAT + NCTX;
constexpr int NCT = NTOK / 64;
constexpr int IN_W = 4624, PW = 4864;
constexpr int PC_Q = 0, PC_K = 1024, PC_V = 1280, PC_DQ = 1536, PC_DK = 2048, PC_DV = 2560, PC_DG = 3072, PC_LX = 3584, PC_LY = 4096, PC_BETA = 4608, PC_DEC = 4616;
constexpr int NEXP = 32, TOPK = 4, DEXP = 1024;
constexpr int MOE_ROWS = 304 * 256;
constexpr float EPS = 1e-6f;
#ifndef MK_SPLIT
#define MK_SPLIT 0
#endif
#ifndef MK_STAGE
#define MK_STAGE 99
#endif
#ifndef FP8_INPROJ
#define FP8_INPROJ 0
#endif
#ifndef FP8_OUTPROJ
#define FP8_OUTPROJ 0
#endif
#ifndef SCAN_SPLIT_ORDER
#define SCAN_SPLIT_ORDER 1
#endif
#ifndef X_BF16
#define X_BF16 1
#endif
#ifndef SCAN_ATTN_FIRST
#define SCAN_ATTN_FIRST 2
#endif
#ifndef OUTPROJ_SLACK_TICKS
#define OUTPROJ_SLACK_TICKS 0
#endif
#ifndef YS_FP8
#define YS_FP8 1
#endif
#ifndef MK_TIME
#define MK_TIME 0
#endif
#ifndef I8_INPROJ
#define I8_INPROJ 1
#endif
namespace pg8 {
#define PG8_LAS __attribute__((address_space(3)))
typedef unsigned short bf16_t;
typedef short bf16x8 __attribute__((ext_vector_type(8)));
typedef float f32x4 __attribute__((ext_vector_type(4)));
typedef unsigned u32x4 __attribute__((ext_vector_type(4)));
typedef float f32x2 __attribute__((ext_vector_type(2)));
constexpr int BM = 256, BK = 64, HALF = 128, HTB = HALF * BK * 2  , STAGE_BYTES = 8 * HTB, NXCD = 8, WGM = 8;

__host__ __device__ __forceinline__ int lds_byte(int r, int c) { const int st = (r >> 4) * 2 + (c >> 5), rr = r & 15, cc = c & 31, ob = rr * 64 + cc * 2; return st * 1024 + (ob ^ (((ob >> 9) & 1) << 5)); }
__host__ __device__ __forceinline__ void stage_rc(int b, int& R, int& C) { const int st = b / 1024, sb = b % 1024, swz = sb ^ (((sb >> 9) & 1) << 5); R = (st >> 1) * 16 + swz / 64; C = (st & 1) * 32 + (swz % 64) / 2; }
__host__ __device__ __forceinline__ int perm32(int rho) { const int n = rho >> 4, i = rho & 15; return 8 * (i >> 2) + 4 * n + (i & 3); }

struct Unit { int pm, pn, e; };
typedef int v4i_t __attribute__((ext_vector_type(4)));
typedef int v8i_t __attribute__((ext_vector_type(8)));
struct Gemm { const bf16_t* A; const bf16_t* Bt; int M, N, K; int bscale = 0x7F7F7F7F; };

struct StaticOrder {
    static constexpr bool GATHER = false, IDENT = false; const int* row_tab = nullptr;
    int nM, nN, nwg, G, c; const char* A; const char* Bt; size_t tstep;
    __device__ void init(const Gemm& g, int G_, int c_) { nM = g.M / BM; nN = g.N / BM; nwg = nM * nN; G = G_; c = c_; A = (const char*)g.A; Bt = (const char*)g.Bt; tstep = (size_t)BM * g.K * 2; }
    __device__ bool next(int i, Unit& u) const {
        const long L = (long)i * G + c; if (L >= nwg) return false;
        int wgid = (int)L; { const int q = nwg / NXCD, r = nwg % NXCD, xcd = wgid % NXCD, off = wgid / NXCD; wgid = (xcd < r ? xcd * (q + 1) : r * (q + 1) + (xcd - r) * q) + off; }
        const int nig = WGM * nN, gid = wgid / nig, fm = gid * WGM, gsz = (nM - fm) < WGM ? (nM - fm) : WGM;
        u.pm = fm + ((wgid % nig) % gsz); u.pn = (wgid % nig) / gsz; u.e = 0; return true;
    }
    __device__ __forceinline__ const char* a_ptr(const Unit& u) const { return A + (size_t)u.pm * tstep; }
    __device__ __forceinline__ const char* b_ptr(const Unit& u) const { return Bt + (size_t)u.pn * tstep; }
    __device__ __forceinline__ void a_ready(const Unit&) const {}
    __device__ __forceinline__ void done(const Unit&) const {}
};
struct StaticOrderG : StaticOrder {
    static constexpr bool GATHER = true, IDENT = true;
    __device__ __forceinline__ const char* a_ptr(const Unit&) const { return A; }
};
__device__ __forceinline__ unsigned cvt_pk_bf16(float lo, float hi) { unsigned r; asm volatile("v_cvt_pk_bf16_f32 %0, %1, %2" : "=v"(r) : "v"(lo), "v"(hi)); return r; }
struct EpiBf16Plain {
    static constexpr bool PERM = true, AFTER_DRAIN = false;
    bf16_t* O; int ldc;
    __device__ __forceinline__ void operator()(const f32x4 (&acc)[2][2][4][2], const Unit& u, int wr, int wc, int fr, int fq) const {
        const int row0 = u.pm * BM + wr * 64 + fr, col0 = u.pn * BM + wc * 32 + 8 * fq;
#pragma unroll
        for (int ai = 0; ai < 2; ++ai)
#pragma unroll
            for (int m = 0; m < 4; ++m) { bf16_t* rowp = O + (size_t)(row0 + ai * HALF + m * 16) * ldc + col0;
#pragma unroll
                for (int bj = 0; bj < 2; ++bj) { const f32x4 v0 = acc[ai][bj][m][0], v1 = acc[ai][bj][m][1];
                    u32x4 w; w.x = cvt_pk_bf16(v0[0], v0[1]); w.y = cvt_pk_bf16(v0[2], v0[3]); w.z = cvt_pk_bf16(v1[0], v1[1]); w.w = cvt_pk_bf16(v1[2], v1[3]);
                    *(u32x4*)(rowp + bj * HALF) = w; } }
    }
};
struct EpiBf16PlainI8 {
    static constexpr bool PERM = true, AFTER_DRAIN = false;
    bf16_t* O; int ldc; const float* rs; const float* cs;
    __device__ __forceinline__ void operator()(const f32x4 (&acc)[2][2][4][2], const Unit& u, int wr, int wc, int fr, int fq) const {
        const int row0 = u.pm * BM + wr * 64 + fr, col0 = u.pn * BM + wc * 32 + 8 * fq;
        f32x4 cv[2][2];
#pragma unroll
        for (int bj = 0; bj < 2; ++bj)
#pragma unroll
            for (int n = 0; n < 2; ++n) cv[bj][n] = *(const f32x4*)(cs + col0 + bj * HALF + 4 * n);
        float rr[2][4];
#pragma unroll
        for (int ai = 0; ai < 2; ++ai)
#pragma unroll
            for (int m = 0; m < 4; ++m) rr[ai][m] = rs[row0 + ai * HALF + m * 16];
        asm volatile("" : "+v"(rr[0][0]), "+v"(rr[0][1]), "+v"(rr[0][2]), "+v"(rr[0][3]), "+v"(rr[1][0]), "+v"(rr[1][1]), "+v"(rr[1][2]), "+v"(rr[1][3]));
#pragma unroll
        for (int ai = 0; ai < 2; ++ai)
#pragma unroll
            for (int m = 0; m < 4; ++m) { const int row = row0 + ai * HALF + m * 16; const float r = rr[ai][m]; bf16_t* rowp = O + (size_t)row * ldc + col0;
#pragma unroll
                for (int bj = 0; bj < 2; ++bj) { const v4i_t i0 = __builtin_bit_cast(v4i_t, acc[ai][bj][m][0]), i1 = __builtin_bit_cast(v4i_t, acc[ai][bj][m][1]);
                    const f32x4 v0 = (f32x4){(float)i0.x, (float)i0.y, (float)i0.z, (float)i0.w} * cv[bj][0] * r, v1 = (f32x4){(float)i1.x, (float)i1.y, (float)i1.z, (float)i1.w} * cv[bj][1] * r;
                    u32x4 w; w.x = cvt_pk_bf16(v0[0], v0[1]); w.y = cvt_pk_bf16(v0[2], v0[3]); w.z = cvt_pk_bf16(v1[0], v1[1]); w.w = cvt_pk_bf16(v1[2], v1[3]);
                    *(u32x4*)(rowp + bj * HALF) = w; } }
    }
};
struct EpiResGate {
    static constexpr bool PERM = false, AFTER_DRAIN = false;
    const float* base_lat; const float* base_ctx; float* out; const float* modg;
    __device__ __forceinline__ void operator()(const f32x4 (&acc)[2][2][4][2], const Unit& u, int wr, int wc, int fr, int fq) const {
        const int r = u.pm < 64 ? (u.pm >> 4) : 4; const int col0 = u.pn * BM + wc * 32 + 4 * fq;
        const float* g = modg + (size_t)r * 12288 + col0;
        f32x4 gv[2][2];
#pragma unroll
        for (int bj = 0; bj < 2; ++bj)
#pragma unroll
            for (int n = 0; n < 2; ++n) gv[bj][n] = *(const f32x4*)(g + bj * HALF + n * 16);
#pragma unroll
        for (int ai = 0; ai < 2; ++ai)
#pragma unroll
            for (int m = 0; m < 4; ++m) { const int row = u.pm * BM + ai * HALF + wr * 64 + m * 16 + fr;
                const float* bp = (row < 16384 ? base_lat + (size_t)row * 2048 : base_ctx + (size_t)(row - 16384) * 2048) + col0; float* op = out + (size_t)row * 2048 + col0;
#pragma unroll
                for (int bj = 0; bj < 2; ++bj)
#pragma unroll
                    for (int n = 0; n < 2; ++n) { const f32x4 b = *(const f32x4*)(bp + bj * HALF + n * 16); *(f32x4*)(op + bj * HALF + n * 16) = b + gv[bj][n] * acc[ai][bj][m][n]; }
                asm volatile("" ::: "memory"); }
    }
};
template <bool F32BASE> struct EpiResGateBT {
    static constexpr bool PERM = true, AFTER_DRAIN = false;
    const float* base_lat; const float* base_ctx; const bf16_t* xb_in; bf16_t* xb_out; const float* modg;
    __device__ __forceinline__ void operator()(const f32x4 (&acc)[2][2][4][2], const Unit& u, int wr, int wc, int fr, int fq) const {
        const int r = u.pm < 64 ? (u.pm >> 4) : 4; const int col0 = u.pn * BM + wc * 32 + 8 * fq;
        const float* g = modg + (size_t)r * 12288 + col0;
        f32x4 gv[2][2];
#pragma unroll
        for (int bj = 0; bj < 2; ++bj)
#pragma unroll
            for (int n = 0; n < 2; ++n) gv[bj][n] = *(const f32x4*)(g + bj * HALF + 4 * n);
        f32x4 rf[2][4]; u32x4 ru[2][2];
#define RG_LOAD(s_, slot_) do { const int row_ = u.pm * BM + ((s_) >> 2) * HALF + wr * 64 + ((s_) & 3) * 16 + fr; \
            if constexpr (F32BASE) { const float* bp_ = (row_ < 16384 ? base_lat + (size_t)row_ * 2048 : base_ctx + (size_t)(row_ - 16384) * 2048) + col0; \
                rf[slot_][0] = *(const f32x4*)bp_; rf[slot_][1] = *(const f32x4*)(bp_ + 4); rf[slot_][2] = *(const f32x4*)(bp_ + HALF); rf[slot_][3] = *(const f32x4*)(bp_ + HALF + 4); } \
            else { const bf16_t* xp_ = xb_in + (size_t)row_ * 2048 + col0; ru[slot_][0] = *(const u32x4*)xp_; ru[slot_][1] = *(const u32x4*)(xp_ + HALF); } } while (0)
        RG_LOAD(0, 0);
#pragma unroll
        for (int s = 0; s < 8; ++s) { const int cur = s & 1, ai = s >> 2, m = s & 3; const int row = u.pm * BM + ai * HALF + wr * 64 + m * 16 + fr;
            if (s + 1 < 8) RG_LOAD(s + 1, cur ^ 1);
            asm volatile("" ::: "memory");
#pragma unroll
            for (int bj = 0; bj < 2; ++bj) { f32x4 b0, b1;
                if constexpr (F32BASE) { b0 = rf[cur][2 * bj]; b1 = rf[cur][2 * bj + 1]; }
                else { const u32x4 w = ru[cur][bj];
                    b0 = (f32x4){__builtin_bit_cast(float, w.x << 16), __builtin_bit_cast(float, w.x & 0xffff0000u), __builtin_bit_cast(float, w.y << 16), __builtin_bit_cast(float, w.y & 0xffff0000u)};
                    b1 = (f32x4){__builtin_bit_cast(float, w.z << 16), __builtin_bit_cast(float, w.z & 0xffff0000u), __builtin_bit_cast(float, w.w << 16), __builtin_bit_cast(float, w.w & 0xffff0000u)}; }
                const f32x4 v0 = b0 + gv[bj][0] * acc[ai][bj][m][0], v1 = b1 + gv[bj][1] * acc[ai][bj][m][1];
                u32x4 o; o.x = cvt_pk_bf16(v0[0], v0[1]); o.y = cvt_pk_bf16(v0[2], v0[3]); o.z = cvt_pk_bf16(v1[0], v1[1]); o.w = cvt_pk_bf16(v1[2], v1[3]);
                *(u32x4*)(xb_out + (size_t)row * 2048 + col0 + bj * HALF) = o; }
            asm volatile("" ::: "memory"); }
#undef RG_LOAD
    }
};
struct EpiSwiglu {
    static constexpr bool PERM = true, AFTER_DRAIN = false;
    bf16_t* O; const float* bgu;
    __device__ __forceinline__ void operator()(const f32x4 (&acc)[2][2][4][2], const Unit& u, int wr, int wc, int fr, int fq) const {
        const int row0 = u.pm * BM + wr * 64 + fr, cc0 = wc * 32 + 8 * fq;
        const float* bg = bgu + (size_t)u.e * 2048 + u.pn * 128 + cc0;
        f32x4 bglu[2], blin[2];
#pragma unroll
        for (int n = 0; n < 2; ++n) { bglu[n] = *(const f32x4*)(bg + 4 * n); blin[n] = *(const f32x4*)(bg + 1024 + 4 * n); }
#pragma unroll
        for (int ai = 0; ai < 2; ++ai)
#pragma unroll
            for (int m = 0; m < 4; ++m) { bf16_t* rowp = O + (size_t)(row0 + ai * HALF + m * 16) * 1024 + u.pn * 128 + cc0;
                float r[8];
#pragma unroll
                for (int n = 0; n < 2; ++n) { const f32x4 g = acc[ai][0][m][n] + bglu[n], l = acc[ai][1][m][n] + blin[n];
#pragma unroll
                    for (int i = 0; i < 4; ++i) { const float gg = fminf(g[i], 7.0f); const float ll = fminf(fmaxf(l[i], -7.0f), 7.0f);
                        r[4 * n + i] = (ll + 1.0f) * gg * __builtin_amdgcn_rcpf(1.0f + __builtin_amdgcn_exp2f(-1.702f * 1.4426950408889634f * gg)); } }
                u32x4 w; w.x = cvt_pk_bf16(r[0], r[1]); w.y = cvt_pk_bf16(r[2], r[3]); w.z = cvt_pk_bf16(r[4], r[5]); w.w = cvt_pk_bf16(r[6], r[7]);
                *(u32x4*)rowp = w; }
    }
};
struct EpiSwiglu8 {
    static constexpr bool PERM = true, AFTER_DRAIN = false;
    unsigned char* O; const float* bgu;
    __device__ __forceinline__ void operator()(const f32x4 (&acc)[2][2][4][2], const Unit& u, int wr, int wc, int fr, int fq) const {
        const int row0 = u.pm * BM + wr * 64 + fr, cc0 = wc * 32 + 8 * fq;
        const float* bg = bgu + (size_t)u.e * 2048 + u.pn * 128 + cc0;
        f32x4 bglu[2], blin[2];
#pragma unroll
        for (int n = 0; n < 2; ++n) { bglu[n] = *(const f32x4*)(bg + 4 * n); blin[n] = *(const f32x4*)(bg + 1024 + 4 * n); }
#pragma unroll
        for (int ai = 0; ai < 2; ++ai)
#pragma unroll
            for (int m = 0; m < 4; ++m) { unsigned char* rowp = O + (size_t)(row0 + ai * HALF + m * 16) * 1024 + u.pn * 128 + cc0;
                float r[8];
#pragma unroll
                for (int n = 0; n < 2; ++n) { const f32x4 g = acc[ai][0][m][n] + bglu[n], l = acc[ai][1][m][n] + blin[n];
#pragma unroll
                    for (int i = 0; i < 4; ++i) { const float gg = fminf(g[i], 7.0f); const float ll = fminf(fmaxf(l[i], -7.0f), 7.0f);
                        r[4 * n + i] = (ll + 1.0f) * gg * __builtin_amdgcn_rcpf(1.0f + __builtin_amdgcn_exp2f(-1.702f * 1.4426950408889634f * gg)); } }
                int w0 = 0, w1 = 0; w0 = __builtin_amdgcn_cvt_pk_fp8_f32(r[0], r[1], w0, false); w0 = __builtin_amdgcn_cvt_pk_fp8_f32(r[2], r[3], w0, true); w1 = __builtin_amdgcn_cvt_pk_fp8_f32(r[4], r[5], w1, false); w1 = __builtin_amdgcn_cvt_pk_fp8_f32(r[6], r[7], w1, true);
                typedef unsigned u32x2 __attribute__((ext_vector_type(2))); *(u32x2*)rowp = (u32x2){(unsigned)w0, (unsigned)w1}; }
    }
};
struct EpiDown {
    static constexpr bool PERM = true, AFTER_DRAIN = false;
    bf16_t* O; const float* bdn; const float* rowg;
    __device__ __forceinline__ void operator()(const f32x4 (&acc)[2][2][4][2], const Unit& u, int wr, int wc, int fr, int fq) const {
        const int row0 = u.pm * BM + wr * 64 + fr, col0 = u.pn * BM + wc * 32 + 8 * fq;
        const float* bb = bdn + (size_t)u.e * 2048 + col0;
        float gt[2][4];
#pragma unroll
        for (int ai = 0; ai < 2; ++ai)
#pragma unroll
            for (int m = 0; m < 4; ++m) gt[ai][m] = rowg[row0 + ai * HALF + m * 16];
#pragma unroll
        for (int bj = 0; bj < 2; ++bj) { const f32x4 b0 = *(const f32x4*)(bb + bj * HALF), b1 = *(const f32x4*)(bb + bj * HALF + 4);
#pragma unroll
            for (int ai = 0; ai < 2; ++ai)
#pragma unroll
                for (int m = 0; m < 4; ++m) { const int row = row0 + ai * HALF + m * 16; const f32x4 v0 = (acc[ai][bj][m][0] + b0) * gt[ai][m], v1 = (acc[ai][bj][m][1] + b1) * gt[ai][m];
                    u32x4 w; w.x = cvt_pk_bf16(v0[0], v0[1]); w.y = cvt_pk_bf16(v0[2], v0[3]); w.z = cvt_pk_bf16(v1[0], v1[1]); w.w = cvt_pk_bf16(v1[2], v1[3]);
                    *(u32x4*)(O + (size_t)row * 2048 + col0 + bj * HALF) = w; } }
    }
};
struct EpiDown8 {
    static constexpr bool PERM = true, AFTER_DRAIN = false;
    unsigned char* O; const float* bdn; const float* rowg;
    __device__ __forceinline__ void operator()(const f32x4 (&acc)[2][2][4][2], const Unit& u, int wr, int wc, int fr, int fq) const {
        const int row0 = u.pm * BM + wr * 64 + fr, col0 = u.pn * BM + wc * 32 + 8 * fq;
        const float* bb = bdn + (size_t)u.e * 2048 + col0;
        float gt[2][4];
#pragma unroll
        for (int ai = 0; ai < 2; ++ai)
#pragma unroll
            for (int m = 0; m < 4; ++m) gt[ai][m] = rowg[row0 + ai * HALF + m * 16];
        f32x4 bz[2][2];
#pragma unroll
        for (int bj = 0; bj < 2; ++bj) { bz[bj][0] = *(const f32x4*)(bb + bj * HALF); bz[bj][1] = *(const f32x4*)(bb + bj * HALF + 4); }
        asm volatile("" : "+v"(gt[0][0]), "+v"(gt[0][1]), "+v"(gt[0][2]), "+v"(gt[0][3]), "+v"(gt[1][0]), "+v"(gt[1][1]), "+v"(gt[1][2]), "+v"(gt[1][3]), "+v"(bz[0][0]), "+v"(bz[0][1]), "+v"(bz[1][0]), "+v"(bz[1][1]));
#pragma unroll
        for (int ai = 0; ai < 2; ++ai)
#pragma unroll
            for (int m = 0; m < 4; ++m) gt[ai][m] *= 16.0f;
#pragma unroll
        for (int bj = 0; bj < 2; ++bj) { const f32x4 b0 = bz[bj][0], b1 = bz[bj][1];
#pragma unroll
            for (int ai = 0; ai < 2; ++ai)
#pragma unroll
                for (int m = 0; m < 4; ++m) { const int row = row0 + ai * HALF + m * 16; const f32x4 v0 = (acc[ai][bj][m][0] + b0) * gt[ai][m], v1 = (acc[ai][bj][m][1] + b1) * gt[ai][m];
                    int w0 = 0, w1 = 0; w0 = __builtin_amdgcn_cvt_pk_fp8_f32(v0[0], v0[1], w0, false); w0 = __builtin_amdgcn_cvt_pk_fp8_f32(v0[2], v0[3], w0, true); w1 = __builtin_amdgcn_cvt_pk_fp8_f32(v1[0], v1[1], w1, false); w1 = __builtin_amdgcn_cvt_pk_fp8_f32(v1[2], v1[3], w1, true);
                    typedef unsigned u32x2 __attribute__((ext_vector_type(2))); *(u32x2*)(O + (size_t)row * 2048 + col0 + bj * HALF) = (u32x2){(unsigned)w0, (unsigned)w1}; } }
    }
};
template <bool GATHER_, bool IDENT_ = false> struct MoeOrderT {
    static constexpr bool GATHER = GATHER_, IDENT = IDENT_;
    int c, nblk; const char* A; const char* Bt; size_t a_tstep, b_estep, b_tstep; const PG8_LAS int* blk_end; const int* row_tab;
    __device__ __forceinline__ bool next(int i, Unit& u) const {
#if defined(MOE_MAP) && MOE_MAP == 1
        const int L = i * 256 + c, rb = L >> 3, j = (L & 7);
#elif defined(MOE_MAP) && MOE_MAP == 2
        const int x = c & 7, jj = c >> 3, gi = i * 8 + x, rb = 8 * (gi >> 1) + (jj >> 2), j = (jj & 3) + 4 * (gi & 1);
#else
        const int x = c & 7, j = c >> 3, gi = i * 8 + x, rb = 4 * gi + (j >> 3);
#endif
        if (rb >= nblk) return false;
        int e = 0;
        for (int k = 0; k < 31; ++k) e += (rb >= blk_end[k]) ? 1 : 0;
        u.pm = rb; u.pn = j & 7; u.e = __builtin_amdgcn_readfirstlane(e); return true;
    }
    __device__ __forceinline__ const char* a_ptr(const Unit& u) const { return GATHER ? A : A + (size_t)u.pm * a_tstep; }
    __device__ __forceinline__ const char* b_ptr(const Unit& u) const { return Bt + (size_t)u.e * b_estep + (size_t)u.pn * b_tstep; }
    __device__ __forceinline__ void a_ready(const Unit&) const {}
    __device__ __forceinline__ void done(const Unit&) const {}
};
typedef MoeOrderT<false> MoeOrder;
typedef MoeOrderT<true> MoeOrderG;
typedef MoeOrderT<true, true> MoeOrderI;
template <class Epi, class Sched, bool ALIGN_EPI = false, bool SP2 = false, bool FP8 = false, bool I8 = false>
__device__ __forceinline__ void gemm_phase(PG8_LAS unsigned char* lds, const Gemm g, const Sched& S, const Epi& E) {
    int tid = threadIdx.x; asm volatile("" : "+v"(tid));
    const int wid = __builtin_amdgcn_readfirstlane(tid >> 6), lane = tid & 63, wr = wid >> 2, wc = wid & 3, fr = lane & 15, fq = lane >> 4;
    const int K = g.K, nt = K / BK;
    unsigned voffA[2], voffB[2];
#pragma unroll
    for (int i = 0; i < 2; ++i) { int R, C; stage_rc(tid * 16 + i * 8192, R, C); const int Rb = Epi::PERM ? ((R & ~31) + perm32(R & 31)) : R;
        voffA[i] = (unsigned)(R * K + C) * 2u; voffB[i] = (unsigned)(Rb * K + C) * 2u; }
    unsigned gc0[2] = {0u, 0u}, gc1[2] = {0u, 0u}; int gR = 0, gC = 0;
    if constexpr (Sched::GATHER) { stage_rc(tid * 16, gR, gC); }
#define PG8_GLOAD(dst0, dst1, u) do { if constexpr (Sched::IDENT) { const unsigned _r0 = (unsigned)((u).pm * BM + gR);     \
        dst0[0] = _r0 * (unsigned)(K * 2) + (unsigned)(gC * 2); dst0[1] = (_r0 + 64u) * (unsigned)(K * 2) + (unsigned)(gC * 2); dst1[0] = (_r0 + 128u) * (unsigned)(K * 2) + (unsigned)(gC * 2); dst1[1] = (_r0 + 192u) * (unsigned)(K * 2) + (unsigned)(gC * 2); } \
      else { const int* _rt = S.row_tab + (size_t)(u).pm * BM + gR; \
        dst0[0] = (unsigned)_rt[0] * (unsigned)(K * 2) + (unsigned)(gC * 2); dst0[1] = (unsigned)_rt[64] * (unsigned)(K * 2) + (unsigned)(gC * 2); \
        dst1[0] = (unsigned)_rt[128] * (unsigned)(K * 2) + (unsigned)(gC * 2); dst1[1] = (unsigned)_rt[192] * (unsigned)(K * 2) + (unsigned)(gC * 2); } } while (0)
    const size_t kstep = (size_t)(BK * 2);
    const size_t hstep = (size_t)HALF * K * 2;
    const size_t tstep = 2 * hstep;
    const unsigned ldsw = (unsigned)wid * 1024u;
    const int aoff = lds_byte(wr * 64 + fr, fq * 8); int boff = lds_byte(wc * 32 + fr, fq * 8) + 4 * HTB;
    asm volatile("" : "+v"(boff));
#define PG8_SA(b, h) (((b) * 2 + (h)) * HTB)
#define PG8_SB(b, h) ((4 + (b) * 2 + (h)) * HTB)
#define PG8_SBR(b, h) (((b) * 2 + (h)) * HTB)
#define PG8_STAGE(bufoff, gbase, voff) do { _Pragma("unroll") for (int _i = 0; _i < 2; ++_i) \
        __builtin_amdgcn_global_load_lds((const unsigned*)((const char*)(gbase) + (voff)[_i]), (PG8_LAS unsigned*)(lds + (bufoff) + ldsw + _i * 8192), 16, 0, 0); } while (0)
#define PG8_LD16(off) (*(const PG8_LAS v4i_t*)(lds + (off)))
#define PG8_LDA(dst, b, h) do { if constexpr (FP8) { _Pragma("unroll") for (int m = 0; m < 4; ++m) dst##8[m] = __builtin_shufflevector(PG8_LD16(PG8_SA(b, h) + aoff + m * 2048), PG8_LD16(PG8_SA(b, h) + aoff + m * 2048 + 1024), 0, 1, 2, 3, 4, 5, 6, 7); } \
        else { _Pragma("unroll") for (int m = 0; m < 4; ++m) _Pragma("unroll") for (int k = 0; k < 2; ++k) dst[m][k] = *(const PG8_LAS bf16x8*)(lds + PG8_SA(b, h) + aoff + m * 2048 + k * 1024); } } while (0)
#define PG8_LDB(dst, b, h) do { if constexpr (FP8) { _Pragma("unroll") for (int n = 0; n < 2; ++n) dst##8[n] = __builtin_shufflevector(PG8_LD16(PG8_SBR(b, h) + boff + n * 2048), PG8_LD16(PG8_SBR(b, h) + boff + n * 2048 + 1024), 0, 1, 2, 3, 4, 5, 6, 7); } \
        else { _Pragma("unroll") for (int n = 0; n < 2; ++n) _Pragma("unroll") for (int k = 0; k < 2; ++k) dst[n][k] = *(const PG8_LAS bf16x8*)(lds + PG8_SBR(b, h) + boff + n * 2048 + k * 1024); } } while (0)
#define PG8_MMA(ai, bj, At, Bt) do { __builtin_amdgcn_s_setprio(1); \
        if constexpr (FP8) { _Pragma("unroll") for (int m = 0; m < 4; ++m) _Pragma("unroll") for (int n = 0; n < 2; ++n) \
            acc[ai][bj][m][n] = __builtin_amdgcn_mfma_scale_f32_16x16x128_f8f6f4(Bt##8[n], At##8[m], acc[ai][bj][m][n], 0, 0, 0, g.bscale, 0, g.bscale); }     \
        else if constexpr (I8) { _Pragma("unroll") for (int m = 0; m < 4; ++m) _Pragma("unroll") for (int n = 0; n < 2; ++n) _Pragma("unroll") for (int k = 0; k < 2; ++k) \
            acc[ai][bj][m][n] = __builtin_bit_cast(f32x4, __builtin_amdgcn_mfma_i32_16x16x64_i8(__builtin_bit_cast(v4i_t, Bt[n][k]), __builtin_bit_cast(v4i_t, At[m][k]), __builtin_bit_cast(v4i_t, acc[ai][bj][m][n]), 0, 0, 0)); } \
        else { _Pragma("unroll") for (int m = 0; m < 4; ++m) _Pragma("unroll") for (int n = 0; n < 2; ++n) _Pragma("unroll") for (int k = 0; k < 2; ++k) \
            acc[ai][bj][m][n] = __builtin_amdgcn_mfma_f32_16x16x32_bf16(Bt[n][k], At[m][k], acc[ai][bj][m][n], 0, 0, 0); } \
        __builtin_amdgcn_s_setprio(0); } while (0)
#define PG8_WAIT_V(n) asm volatile("s_waitcnt vmcnt(" #n ")" ::: "memory")
#define PG8_WAIT_L(n) asm volatile("s_waitcnt lgkmcnt(" #n ")" ::: "memory")
#define PG8_BAR __builtin_amdgcn_s_barrier()
#define PG8_SCHED __builtin_amdgcn_sched_barrier(0)
    Unit cur, nxt; int ui = 0;
    if (!S.next(0, cur)) return;
    f32x4 acc[2][2][4][2];
#pragma unroll
    for (int a = 0; a < 2; ++a)
#pragma unroll
        for (int b = 0; b < 2; ++b)
#pragma unroll
            for (int m = 0; m < 4; ++m)
#pragma unroll
                for (int n = 0; n < 2; ++n) acc[a][b][m][n] = (f32x4){0.f, 0.f, 0.f, 0.f};
    bf16x8 At[4][2], B0[2][2], B1[2][2]; v8i_t At8[4], B08[2], B18[2];
    const char* cA = S.a_ptr(cur); const char* cB = S.b_ptr(cur);
    S.a_ready(cur);
    if constexpr (SP2) {
        if constexpr (Sched::GATHER) { PG8_GLOAD(gc0, gc1, cur);
        PG8_STAGE(PG8_SB(0, 0), cB, voffB); PG8_STAGE(PG8_SB(0, 1), cB + hstep, voffB); PG8_STAGE(PG8_SA(0, 0), cA, gc0); PG8_STAGE(PG8_SA(0, 1), cA, gc1);
        if (wr == 1) PG8_BAR;
        PG8_WAIT_V(2); PG8_BAR;
        PG8_STAGE(PG8_SB(1, 0), cB + kstep, voffB); PG8_STAGE(PG8_SA(1, 0), cA + kstep, gc0); PG8_STAGE(PG8_SB(1, 1), cB + hstep + kstep, voffB);
        } else {
        PG8_STAGE(PG8_SB(0, 0), cB, voffB); PG8_STAGE(PG8_SB(0, 1), cB + hstep, voffB); PG8_STAGE(PG8_SA(0, 0), cA, voffA); PG8_STAGE(PG8_SA(0, 1), cA + hstep, voffA);
        if (wr == 1) PG8_BAR;
        PG8_WAIT_V(2); PG8_BAR;
        PG8_STAGE(PG8_SB(1, 0), cB + kstep, voffB); PG8_STAGE(PG8_SA(1, 0), cA + kstep, voffA); PG8_STAGE(PG8_SB(1, 1), cB + hstep + kstep, voffB);
        }
        PG8_WAIT_V(6); PG8_BAR;
    } else {
        PG8_STAGE(PG8_SB(0, 0), cB, voffB); PG8_STAGE(PG8_SA(0, 0), cA, voffA); PG8_STAGE(PG8_SB(0, 1), cB + hstep, voffB); PG8_STAGE(PG8_SA(0, 1), cA + hstep, voffA);
        if (wr == 1) PG8_BAR;
        PG8_WAIT_V(4); PG8_BAR;
        PG8_STAGE(PG8_SB(1, 0), cB + kstep, voffB); PG8_STAGE(PG8_SA(1, 0), cA + kstep, voffA); PG8_STAGE(PG8_SB(1, 1), cB + hstep + kstep, voffB);
        PG8_WAIT_V(6); PG8_BAR;
    }
    for (;;) {
        const bool has_next = S.next(ui + 1, nxt);
        const char* nA = has_next ? S.a_ptr(nxt) : cA; const char* nB = has_next ? S.b_ptr(nxt) : cB;
#pragma unroll 1
        for (int t = 0; t < nt; t += 2) {
            const bool last = (t == nt - 2);
            const char* a1 = cA + (size_t)(t + 1) * kstep;
            const char* a2 = last ? nA : cA + (size_t)(t + 2) * kstep; const char* b2 = last ? nB : cB + (size_t)(t + 2) * kstep;
            const char* a3 = a2 + kstep; const char* b3 = b2 + kstep;
            if (last && has_next) S.a_ready(nxt);

            if constexpr (SP2) {
            PG8_LDB(B0, 0, 0); PG8_LDB(B1, 0, 1); PG8_SCHED; PG8_LDA(At, 0, 0); if constexpr (Sched::GATHER) PG8_STAGE(PG8_SA(1, 1), a1, gc1); else PG8_STAGE(PG8_SA(1, 1), a1 + hstep, voffA);
            if constexpr (Sched::GATHER) { if (last && has_next) PG8_GLOAD(gc0, gc1, nxt); }
            PG8_WAIT_V(8); PG8_WAIT_L(0); PG8_BAR; PG8_MMA(0, 0, At, B0); PG8_MMA(0, 1, At, B1); PG8_BAR; PG8_SCHED;
            PG8_LDA(At, 0, 1); PG8_STAGE(PG8_SB(0, 0), b2, voffB); PG8_STAGE(PG8_SB(0, 1), b2 + hstep, voffB); if constexpr (Sched::GATHER) PG8_STAGE(PG8_SA(0, 0), a2, gc0); else PG8_STAGE(PG8_SA(0, 0), a2, voffA);
            PG8_WAIT_V(8); PG8_WAIT_L(0); PG8_BAR; PG8_MMA(1, 0, At, B0); PG8_MMA(1, 1, At, B1); PG8_BAR; PG8_SCHED;
            PG8_LDB(B0, 1, 0); PG8_LDB(B1, 1, 1); PG8_SCHED; PG8_LDA(At, 1, 0); if constexpr (Sched::GATHER) PG8_STAGE(PG8_SA(0, 1), a2, gc1); else PG8_STAGE(PG8_SA(0, 1), a2 + hstep, voffA);
            PG8_WAIT_V(8); PG8_WAIT_L(0); PG8_BAR; PG8_MMA(0, 0, At, B0); PG8_MMA(0, 1, At, B1); PG8_BAR; PG8_SCHED;
            PG8_LDA(At, 1, 1); PG8_STAGE(PG8_SB(1, 0), b3, voffB); PG8_STAGE(PG8_SB(1, 1), b3 + hstep, voffB); if constexpr (Sched::GATHER) PG8_STAGE(PG8_SA(1, 0), a3, gc0); else PG8_STAGE(PG8_SA(1, 0), a3, voffA);
            PG8_WAIT_V(8); PG8_WAIT_L(0); PG8_BAR; PG8_MMA(1, 0, At, B0); PG8_MMA(1, 1, At, B1); PG8_BAR; PG8_SCHED;
            } else {
            PG8_LDB(B0, 0, 0); PG8_SCHED; PG8_LDA(At, 0, 0); PG8_STAGE(PG8_SA(1, 1), a1 + hstep, voffA);
            PG8_WAIT_L(8); PG8_BAR; PG8_WAIT_L(0); PG8_MMA(0, 0, At, B0); PG8_BAR; PG8_SCHED;
            PG8_LDB(B1, 0, 1); PG8_STAGE(PG8_SB(0, 0), b2, voffB);
            PG8_BAR; PG8_WAIT_L(0); PG8_MMA(0, 1, At, B1); PG8_BAR;
            PG8_LDA(At, 0, 1); PG8_STAGE(PG8_SA(0, 0), a2, voffA);
            PG8_BAR; PG8_WAIT_L(0); PG8_MMA(1, 0, At, B0); PG8_BAR; PG8_SCHED;
            PG8_STAGE(PG8_SB(0, 1), b2 + hstep, voffB);
            PG8_WAIT_V(6); PG8_BAR; PG8_MMA(1, 1, At, B1); PG8_BAR;
            PG8_LDB(B0, 1, 0); PG8_SCHED; PG8_LDA(At, 1, 0); PG8_STAGE(PG8_SA(0, 1), a2 + hstep, voffA);
            PG8_WAIT_L(8); PG8_BAR; PG8_WAIT_L(0); PG8_MMA(0, 0, At, B0); PG8_BAR; PG8_SCHED;
            PG8_LDB(B1, 1, 1); PG8_STAGE(PG8_SB(1, 0), b3, voffB);
            PG8_BAR; PG8_WAIT_L(0); PG8_MMA(0, 1, At, B1); PG8_BAR;
            PG8_LDA(At, 1, 1); PG8_STAGE(PG8_SA(1, 0), a3, voffA);
            PG8_BAR; PG8_WAIT_L(0); PG8_MMA(1, 0, At, B0); PG8_BAR; PG8_SCHED;
            PG8_STAGE(PG8_SB(1, 1), b3 + hstep, voffB);
            PG8_WAIT_V(6); PG8_BAR; PG8_MMA(1, 1, At, B1); PG8_BAR;
            }
        }
        if constexpr (ALIGN_EPI) { if (wr == 0) PG8_BAR; }
        if constexpr (!Epi::AFTER_DRAIN) { int fr_e = fr, fq_e = fq; asm volatile("" : "+v"(fr_e), "+v"(fq_e));
            E(acc, cur, wr, wc, fr_e, fq_e); S.done(cur); }
        if (!has_next) break;
#pragma unroll
        for (int a = 0; a < 2; ++a)
#pragma unroll
            for (int b = 0; b < 2; ++b)
#pragma unroll
                for (int m = 0; m < 4; ++m)
#pragma unroll
                    for (int n = 0; n < 2; ++n) acc[a][b][m][n] = (f32x4){0.f, 0.f, 0.f, 0.f};
        cur = nxt; cA = nA; cB = nB; ++ui;
        if constexpr (ALIGN_EPI) { if (wr == 1) PG8_BAR; }
    }
    PG8_WAIT_V(0);
    if constexpr (!ALIGN_EPI) { if (wr == 0) PG8_BAR; }
    PG8_BAR;
    if constexpr (Epi::AFTER_DRAIN) { E.fused(acc, cur, wr, wc, fr, fq, lds, wid, lane); S.done(cur); }
#undef PG8_GLOAD
#undef PG8_SA
#undef PG8_SB
#undef PG8_SBR
#undef PG8_STAGE
#undef PG8_LDA
#undef PG8_LDB
#undef PG8_MMA
#undef PG8_LD16
#undef PG8_WAIT_V
#undef PG8_WAIT_L
#undef PG8_BAR
#undef PG8_SCHED
}
}

constexpr size_t MiB = 1u << 20;
constexpr size_t WS_CTL = 0, CTL_ZERO_BYTES = 1 * MiB;
constexpr size_t WS_MOD  = 1 * MiB;
constexpr size_t WS_WRT  = 2 * MiB;
constexpr size_t WS_MOEI = 3 * MiB;
constexpr size_t WS_IDT  = WS_MOEI + 5 * 512 * 1024;
constexpr size_t WS_LRC  = 6 * MiB;
constexpr size_t WS_DNS  = 12 * MiB;
constexpr size_t WS_RS   = WS_DNS + 2 * MiB;
constexpr size_t WS_CS   = WS_DNS + 3 * MiB;
constexpr size_t WS_WIN  = 16 * MiB;
constexpr size_t WS_WOUT = 56 * MiB;
constexpr size_t WS_WGU  = 72 * MiB;
constexpr size_t WS_WDN  = 584 * MiB;
constexpr size_t WS_X    = 840 * MiB;
constexpr size_t WS_H    = 976 * MiB;
constexpr size_t WS_P    = 1044 * MiB;
constexpr size_t WS_CC   = 1206 * MiB;
constexpr size_t WS_VT   = 1274 * MiB;
constexpr size_t WS_VTC  = WS_VT + 8 * MiB;
constexpr size_t WS_DNT  = 1284 * MiB;
constexpr size_t DNT_BYTES = 90112;
constexpr size_t WS_DNO  = 1472 * MiB;
constexpr size_t WS_LRH  = 1540 * MiB;
constexpr size_t WS_LRA  = 1608 * MiB;
constexpr size_t WS_XS   = 1676 * MiB;
constexpr size_t WS_ACT  = 1980 * MiB;
constexpr size_t WS_YS   = 2132 * MiB;
constexpr size_t WS_END  = 2436 * MiB;
constexpr int CW_TMO = 0;
constexpr int CW_BAR = 4096;
constexpr int CW_CSQ = 24576;
constexpr int CW_CNT = 8192;
constexpr int CW_CMAX = 32768;
constexpr int CW_ATQ = 12288;

constexpr int RING_OFF = 0, RING_BYTES = 131072;
constexpr int LDSCTL_OFF = RING_BYTES, MISC_OFF = LDSCTL_OFF + 320;
constexpr int LDS_X_OFF = RING_BYTES + 1024;
constexpr int LDS_BYTES = 147456;
constexpr int NWAVES = 8, NTHREADS = 512;

#define GAS __attribute__((address_space(1)))
#define LAS __attribute__((address_space(3)))
typedef unsigned short bf16;
typedef unsigned v4u __attribute__((ext_vector_type(4)));
typedef unsigned v2u __attribute__((ext_vector_type(2)));
typedef float f32x4 __attribute__((ext_vector_type(4)));
typedef float f32x16 __attribute__((ext_vector_type(16)));
typedef short bf16x8 __attribute__((ext_vector_type(8)));
typedef short bf16x4 __attribute__((ext_vector_type(4)));
typedef GAS unsigned gu32;
#define RLX_AGENT __ATOMIC_RELAXED, __HIP_MEMORY_SCOPE_AGENT
#define LDS_WAIT() asm volatile("s_waitcnt lgkmcnt(0)" ::: "memory")
#define VM_WAIT() asm volatile("s_waitcnt vmcnt(0)" ::: "memory")
#define LDS_BARRIER() asm volatile("s_waitcnt lgkmcnt(0)\n\ts_barrier" ::: "memory")
typedef __bf16 bf16x2_t __attribute__((ext_vector_type(2)));
typedef float f32x2_t __attribute__((ext_vector_type(2)));
__device__ __forceinline__ unsigned pk2(float lo, float hi) { const f32x2_t v = {lo, hi}; const bf16x2_t b = __builtin_convertvector(v, bf16x2_t); return __builtin_bit_cast(unsigned, b); }
__device__ __forceinline__ unsigned f2bf(float f) { return pk2(f, 0.f) & 0xffffu; }
__device__ __forceinline__ unsigned pk4_fp8(float a, float b, float c, float d) { int x = 0; x = __builtin_amdgcn_cvt_pk_fp8_f32(a, b, x, false); x = __builtin_amdgcn_cvt_pk_fp8_f32(c, d, x, true); return (unsigned)x; }
__device__ __forceinline__ float bf2f(unsigned short b) { return __builtin_bit_cast(float, (unsigned)b << 16); }
__device__ __forceinline__ float bflo(unsigned w) { return __builtin_bit_cast(float, w << 16); }
__device__ __forceinline__ float bfhi(unsigned w) { return __builtin_bit_cast(float, w & 0xffff0000u); }
template <int CTRL> __device__ __forceinline__ float dpp_mov(float v) { return __builtin_bit_cast(float, __builtin_amdgcn_update_dpp(0, __builtin_bit_cast(int, v), CTRL, 0xF, 0xF, false)); }
__device__ __forceinline__ float wave_sum(float v) {
    v += dpp_mov<0xB1>(v); v += dpp_mov<0x4E>(v); v += dpp_mov<0x141>(v); v += dpp_mov<0x140>(v);
    const int iv = __builtin_bit_cast(int, v);
    const float r0 = __builtin_bit_cast(float, __builtin_amdgcn_readlane(iv, 0)), r1 = __builtin_bit_cast(float, __builtin_amdgcn_readlane(iv, 16)), r2 = __builtin_bit_cast(float, __builtin_amdgcn_readlane(iv, 32)), r3 = __builtin_bit_cast(float, __builtin_amdgcn_readlane(iv, 48));
    return (r0 + r1) + (r2 + r3);
}
__device__ __forceinline__ float wave_max(float v) {
    v = fmaxf(v, dpp_mov<0xB1>(v)); v = fmaxf(v, dpp_mov<0x4E>(v)); v = fmaxf(v, dpp_mov<0x141>(v)); v = fmaxf(v, dpp_mov<0x140>(v));
    const int iv = __builtin_bit_cast(int, v);
    const float r0 = __builtin_bit_cast(float, __builtin_amdgcn_readlane(iv, 0)), r1 = __builtin_bit_cast(float, __builtin_amdgcn_readlane(iv, 16)), r2 = __builtin_bit_cast(float, __builtin_amdgcn_readlane(iv, 32)), r3 = __builtin_bit_cast(float, __builtin_amdgcn_readlane(iv, 48));
    return fmaxf(fmaxf(r0, r1), fmaxf(r2, r3));
}
__device__ __forceinline__ unsigned pk4_i8(float a, float b, float c, float d) {
    const int ia = (int)__builtin_rintf(a), ib = (int)__builtin_rintf(b), ic = (int)__builtin_rintf(c), id = (int)__builtin_rintf(d);
    return (unsigned)(ia & 255) | ((unsigned)(ib & 255) << 8) | ((unsigned)(ic & 255) << 16) | ((unsigned)id << 24);
}
__device__ __forceinline__ float sigmoidf_(float x) { return __builtin_amdgcn_rcpf(1.0f + __builtin_amdgcn_exp2f(-1.4426950408889634f * x)); }
__device__ __forceinline__ float siluf_(float x) { return x * sigmoidf_(x); }
__device__ __forceinline__ float softplusf_(float x) { return x > 20.f ? x : log1pf(__expf(x)); }

#define XB_TMO      128
#define XB_XCNT(j)  (256  + 64 * (j))
#define XB_XSUB(j)  (1280 + 64 * (j))
#define XB_XGEN(j)  (2304 + 64 * (j))
#define XB_TOP      3328
#define XB_TOPGEN   3392
#define XCD_BAR_WORDS 3456
#define XB_SPIN_CAP (1u << 18)

__device__ __forceinline__ unsigned xb_ld(unsigned* p)              { return __hip_atomic_load(p, __ATOMIC_RELAXED, __HIP_MEMORY_SCOPE_AGENT); }
__device__ __forceinline__ unsigned xb_add(unsigned* p, unsigned v) { return __hip_atomic_fetch_add(p, v, __ATOMIC_RELAXED, __HIP_MEMORY_SCOPE_AGENT); }
__device__ __forceinline__ unsigned xb_xcc_id() { return (unsigned)__builtin_amdgcn_s_getreg((3 << 11) | 20) & 0xFu; }
#define XB_SPIN(cond, bar) do { unsigned _sp = 0; while (cond) { __builtin_amdgcn_s_sleep(1); \
    if ((++_sp & 255u) == 0u) { if (xb_ld(&(bar)[XB_TMO])) break; if (_sp > XB_SPIN_CAP) { atomicAdd(&(bar)[XB_TMO], 1u); break; } } } } while (0)

struct XcdBarrier {
    unsigned* bar; unsigned x;
    volatile LAS unsigned* st;
};

__device__ __forceinline__ XcdBarrier xcd_barrier_post(unsigned* bar, volatile LAS unsigned* st) {
    XcdBarrier b; b.bar = bar; b.x = xb_xcc_id(); b.st = st;
    if (threadIdx.x == 0) (void)xb_add(&bar[XB_XCNT(b.x)], 1u);
    return b;
}
__device__ __forceinline__ void xcd_barrier_complete(unsigned* bar, unsigned x, unsigned& nloc, unsigned& nx) {
    const unsigned G = gridDim.x * gridDim.y * gridDim.z;
    unsigned sum, cnt, mine, sp = 0u;
    for (;;) {
        sum = 0u; cnt = 0u; mine = 0u;
#pragma unroll
        for (unsigned j = 0; j < 16; ++j) { const unsigned c = xb_ld(&bar[XB_XCNT(j)]); sum += c; cnt += (c > 0u) ? 1u : 0u; mine = (j == x) ? c : mine; }
        if (sum == G) break;
        __builtin_amdgcn_s_sleep(1);
        if ((++sp & 255u) == 0u) { if (xb_ld(&bar[XB_TMO])) break; if (sp > XB_SPIN_CAP) { atomicAdd(&bar[XB_TMO], 1u); break; } }
    }
    nloc = mine > 0u ? mine : 1u; nx = cnt > 0u ? cnt : 1u;
}

__device__ __forceinline__ void xcd_barrier(const XcdBarrier& b) {
    asm volatile("s_waitcnt vmcnt(0)" ::: "memory");
    __syncthreads();
    if (threadIdx.x == 0) {
        unsigned* bar = b.bar;
        __builtin_amdgcn_s_waitcnt(0);
        unsigned nloc = b.st[0], nx = b.st[1];
        if (nloc == 0u) { xcd_barrier_complete(bar, b.x, nloc, nx); b.st[0] = nloc; b.st[1] = nx; }
        const unsigned old = xb_add(&bar[XB_XSUB(b.x)], 1u);
        const unsigned gen = old / nloc;
        if (old + 1u == (gen + 1u) * nloc) {
            __builtin_amdgcn_fence(__ATOMIC_RELEASE, "agent");
            asm volatile("s_waitcnt vmcnt(0)" ::: "memory");
            const unsigned og = xb_add(&bar[XB_TOP], 1u);
            const unsigned tg = og / nx;
            if (og + 1u == (tg + 1u) * nx) xb_add(&bar[XB_TOPGEN], 1u);
            else XB_SPIN(xb_ld(&bar[XB_TOPGEN]) == tg, bar);
            __builtin_amdgcn_fence(__ATOMIC_ACQUIRE, "agent");
            xb_add(&bar[XB_XGEN(b.x)], 1u);
            asm volatile("s_waitcnt vmcnt(0)" ::: "memory");
        } else {
            XB_SPIN(xb_ld(&bar[XB_XGEN(b.x)]) == gen, bar);
            __builtin_amdgcn_fence(__ATOMIC_ACQUIRE, "agent");
            asm volatile("s_waitcnt vmcnt(0)" ::: "memory");
        }
    }
    __syncthreads();
}

enum InIdx { I_X = 0, I_C, I_CTX, I_CCTX, I_WMOD, I_BMOD, I_NMG, I_NFG, I_WIN, I_WOUT, I_SINK, I_DNCW, I_DNALOG, I_DNDT, I_DNNG, I_LRCW, I_LRCB, I_LRWR, I_LRBR, I_LRWI, I_LRBI, I_LRLAM,
             I_WROUT, I_BROUT, I_WGU, I_BGU, I_WDN, I_BDN, I_FNG, N_IN };
struct Frame {
    LAS unsigned char* lds;
    volatile LAS unsigned* MISC;
    gu32* ctl;
    int tid, lane, wave, G, bid;
    const float* const __attribute__((address_space(4)))* in;
    float* out; unsigned char* ws;
};
__device__ __forceinline__ int mod_row(int m) { return m < NLAT ? (m >> 12) : 4; }
__device__ __forceinline__ bool phase_enter(Frame& F) { int t = threadIdx.x; asm volatile("" : "+v"(t)); F.tid = t; F.lane = t & 63; F.wave = __builtin_amdgcn_readfirstlane(t >> 6); return true; }
__device__ __forceinline__ void seq_of(int m, int& t, int& T, int& base) { if (m < NLAT) { t = m & 4095; T = SEQ; base = m - t; } else { t = (m - NLAT) & 255; T = CTXL; base = m - t; } }
__device__ __forceinline__ float gelu_tanh(float x) { const float u = 0.7978845608028654f * (x + 0.044715f * x * x * x); return x * sigmoidf_(2.0f * u); }

__device__ __forceinline__ void transpose_item(const float* W, int K, int N, bf16* WT, int k0, int dstrow0, int srccol0, int nvalid, LAS float* scr, int lane) {
    { const int c4 = (lane & 7) * 4, kr = lane >> 3; f32x4 v[8];
#pragma unroll
      for (int i = 0; i < 8; ++i) { v[i] = (f32x4){0.f, 0.f, 0.f, 0.f}; if (c4 < nvalid) v[i] = __builtin_nontemporal_load((const f32x4*)(W + (size_t)(k0 + 8 * i + kr) * N + srccol0 + c4)); }
#pragma unroll
      for (int i = 0; i < 8; ++i) { LAS float* d = scr + (8 * i + kr) * 33 + c4; d[0] = v[i].x; d[1] = v[i].y; d[2] = v[i].z; d[3] = v[i].w; } }
    LDS_WAIT(); asm volatile("" ::: "memory");
    const int c = lane & 7;
#pragma unroll
    for (int jj = 0; jj < 4; ++jj) { const int n = (lane >> 3) + 8 * jj; const LAS float* s = scr + (8 * c) * 33 + n;
        v4u o; o.x = pk2(s[0 * 33], s[1 * 33]); o.y = pk2(s[2 * 33], s[3 * 33]); o.z = pk2(s[4 * 33], s[5 * 33]); o.w = pk2(s[6 * 33], s[7 * 33]);
        *(GAS v4u*)(WT + (size_t)(dstrow0 + n) * K + k0 + 8 * c) = o; }
    LDS_WAIT(); asm volatile("" ::: "memory");
}
__device__ __forceinline__ void transpose_item_f8(const float* W, int K, int N, unsigned char* WT, int k0, int dstrow0, int srccol0, float scale, LAS float* scr, int lane) {
    { const int c4 = (lane & 7) * 4, kr = lane >> 3; f32x4 v[8];
#pragma unroll
      for (int i = 0; i < 8; ++i) v[i] = __builtin_nontemporal_load((const f32x4*)(W + (size_t)(k0 + 8 * i + kr) * N + srccol0 + c4));
#pragma unroll
      for (int i = 0; i < 8; ++i) { LAS float* d = scr + (8 * i + kr) * 33 + c4; d[0] = v[i].x; d[1] = v[i].y; d[2] = v[i].z; d[3] = v[i].w; } }
    LDS_WAIT(); asm volatile("" ::: "memory");
    { const int n = lane >> 1, hf = lane & 1; const LAS float* s = scr + (32 * hf) * 33 + n; unsigned w[8];
#pragma unroll
      for (int i = 0; i < 8; ++i) { int x = 0; x = __builtin_amdgcn_cvt_pk_fp8_f32(s[(4 * i + 0) * 33] * scale, s[(4 * i + 1) * 33] * scale, x, false); x = __builtin_amdgcn_cvt_pk_fp8_f32(s[(4 * i + 2) * 33] * scale, s[(4 * i + 3) * 33] * scale, x, true); w[i] = (unsigned)x; }
      v4u* o = (v4u*)(WT + (size_t)(dstrow0 + n) * K + k0 + 32 * hf); __builtin_nontemporal_store((v4u){w[0], w[1], w[2], w[3]}, o); __builtin_nontemporal_store((v4u){w[4], w[5], w[6], w[7]}, o + 1); }
    LDS_WAIT(); asm volatile("" ::: "memory");
}
__device__ __forceinline__ void transpose_item_i8(const float* W, int K, int N, unsigned char* WT, int k0, int dstrow0, int srccol0, const gu32* cmax, float* cs, LAS float* scr, int lane) {
    { const int c4 = (lane & 7) * 4, kr = lane >> 3; f32x4 v[8];
#pragma unroll
      for (int i = 0; i < 8; ++i) v[i] = *(const f32x4*)(W + (size_t)(k0 + 8 * i + kr) * N + srccol0 + c4);
#pragma unroll
      for (int i = 0; i < 8; ++i) { LAS float* d = scr + (8 * i + kr) * 33 + c4; d[0] = v[i].x; d[1] = v[i].y; d[2] = v[i].z; d[3] = v[i].w; } }
    LDS_WAIT(); asm volatile("" ::: "memory");
    { const int n = lane >> 1, hf = lane & 1; const LAS float* sp = scr + (32 * hf) * 33 + n; unsigned w[8];
      const float sc = cs[dstrow0 + n]; const float inv = sc > 0.f ? 1.0f / sc : 0.f;
#pragma unroll
      for (int i = 0; i < 8; ++i) w[i] = pk4_i8(sp[(4 * i + 0) * 33] * inv, sp[(4 * i + 1) * 33] * inv, sp[(4 * i + 2) * 33] * inv, sp[(4 * i + 3) * 33] * inv);
      GAS v4u* o = (GAS v4u*)(WT + (size_t)(dstrow0 + n) * K + k0 + 32 * hf); o[0] = (v4u){w[0], w[1], w[2], w[3]}; o[1] = (v4u){w[4], w[5], w[6], w[7]}; }
    LDS_WAIT(); asm volatile("" ::: "memory");
}
__device__ __forceinline__ void p0_prologue_a(Frame& F) {
    {
        LAS float* sc = (LAS float*)(F.lds);
        LAS float* red = (LAS float*)(F.lds + 40960);
        bool have_sc = false;
        for (int wb = F.bid; wb < 192; wb += F.G) {
            if (!have_sc) {
#pragma unroll 1
                for (int r = 0; r < 5; ++r) { const float* csrc = r < 4 ? F.in[I_C] + r * 2048 : F.in[I_CCTX]; float cv[4];
#pragma unroll
                    for (int k = 0; k < 4; ++k) cv[k] = csrc[F.tid + k * NTHREADS];
                    asm volatile("" : "+v"(cv[0]), "+v"(cv[1]), "+v"(cv[2]), "+v"(cv[3]));
#pragma unroll
                    for (int k = 0; k < 4; ++k) sc[r * 2048 + F.tid + k * NTHREADS] = siluf_(cv[k]); }
                have_sc = true; __syncthreads();
            }
            const int l = wb / 96, cb = wb % 96, kp = F.tid >> 5, cg = F.tid & 31, j0 = cb * 128 + cg * 4;
            const float* wp = F.in[I_WMOD] + ((size_t)l * 2048 + kp) * 12288 + j0;
            f32x4 acc[5];
#pragma unroll
            for (int r = 0; r < 5; ++r) acc[r] = (f32x4){0.f, 0.f, 0.f, 0.f};
            f32x4 wq0[8], wq1[8];
#define GV_LOAD(w_, k0_) _Pragma("unroll") for (int i_ = 0; i_ < 8; ++i_) w_[i_] = *(const f32x4*)(wp + (size_t)((k0_) + i_) * 16 * 12288)
#define GV_USE(w_, k0_) _Pragma("unroll") for (int i_ = 0; i_ < 8; ++i_) { _Pragma("unroll") for (int r = 0; r < 5; ++r) acc[r] += sc[r * 2048 + kp + 16 * ((k0_) + i_)] * w_[i_]; }
            GV_LOAD(wq0, 0);
#pragma unroll 1
            for (int k = 0; k < 128; k += 16) {
                GV_LOAD(wq1, k + 8); asm volatile("" ::: "memory");
                GV_USE(wq0, k);
                if (k + 16 < 128) { GV_LOAD(wq0, k + 16); } asm volatile("" ::: "memory");
                GV_USE(wq1, k + 8); }
#undef GV_LOAD
#undef GV_USE
#pragma unroll
            for (int r = 0; r < 5; ++r) *(LAS f32x4*)(red + (kp * 5 + r) * 128 + cg * 4) = acc[r];
            __syncthreads();
            for (int i = F.tid; i < 640; i += NTHREADS) { const int r = i >> 7, col = i & 127; float s = F.in[I_BMOD][l * 12288 + cb * 128 + col];
#pragma unroll
                for (int q = 0; q < 16; ++q) s += red[(q * 5 + r) * 128 + col];
                ((float*)(F.ws + WS_MOD))[(size_t)(l * 5 + r) * 12288 + cb * 128 + col] = s; }
            __syncthreads();
        }
        __syncthreads();
    }
#if I8_INPROJ
    {
        for (int it = F.wave * 64 + (F.bid - 192); F.bid >= 192 && it < 2 * 144; it += 512) {
            const int l = it / 144, nb = it % 144, d0 = nb * 32, s0 = d0 >= 3584 ? d0 + 16 : d0;
            const float* W = F.in[I_WIN] + (size_t)l * 2048 * IN_W; const int c4 = (F.lane & 7) * 4, kr = F.lane >> 3;
            f32x4 mx = {0.f, 0.f, 0.f, 0.f};
#pragma unroll 4
            for (int sub = 0; sub < 32; ++sub) { f32x4 v[8];
#pragma unroll
                for (int i = 0; i < 8; ++i) v[i] = *(const f32x4*)(W + (size_t)(sub * 64 + 8 * i + kr) * IN_W + s0 + c4);
#pragma unroll
                for (int i = 0; i < 8; ++i) { mx.x = fmaxf(mx.x, fabsf(v[i].x)); mx.y = fmaxf(mx.y, fabsf(v[i].y)); mx.z = fmaxf(mx.z, fabsf(v[i].z)); mx.w = fmaxf(mx.w, fabsf(v[i].w)); } }
#pragma unroll
            for (int o = 8; o < 64; o <<= 1) { mx.x = fmaxf(mx.x, __shfl_xor(mx.x, o)); mx.y = fmaxf(mx.y, __shfl_xor(mx.y, o)); mx.z = fmaxf(mx.z, __shfl_xor(mx.z, o)); mx.w = fmaxf(mx.w, __shfl_xor(mx.w, o)); }
            if (kr == 0) *(f32x4*)((float*)(F.ws + WS_CS) + l * 4608 + d0 + c4) = mx * (1.0f / 127.0f);
        }
    }
#endif
    if (F.bid >= 192 && F.wave == 7) { const int it = F.bid - 192, l = it >> 5, r = it & 31;
        transpose_item(F.in[I_WIN] + (size_t)l * 2048 * IN_W, 2048, IN_W, (bf16*)(F.ws + WS_WRT + 512 * 1024) + (size_t)l * 32 * 2048, r * 64, 0, 3584, 16, (LAS float*)(F.lds + F.wave * 16384), F.lane); }
}
__device__ __forceinline__ void p0_prologue_b(Frame& F) {
    { int* idt = (int*)(F.ws + WS_IDT); for (int r = F.bid * NTHREADS + F.tid; r < MOE_ROWS; r += F.G * NTHREADS) idt[r] = r; }
    {
        LAS float* scr = (LAS float*)(F.lds + F.wave * 16384);
        const int gw = F.bid * NWAVES + F.wave, NGW = F.G * NWAVES;
        constexpr int I_IN = 32 * 144, I_OUT = 32 * 64, I_RT = 32, PER_L = I_IN + I_OUT + I_RT;
        for (int it0 = gw; it0 < 2 * PER_L; it0 += NGW) {
            const int l = it0 / PER_L; int r = it0 % PER_L;
            if (r < I_IN) { const int nb = r % 144, kb = r / 144, d0 = nb * 32; int s0 = d0, nv = 32;
                if (d0 >= 3584) s0 = d0 + 16;
#if I8_INPROJ
                transpose_item_i8(F.in[I_WIN] + (size_t)l * 2048 * IN_W, 2048, IN_W, F.ws + WS_WIN + (size_t)l * PW * 2048 * 2, kb * 64, d0, s0, F.ctl + CW_CMAX + l * 4608, (float*)(F.ws + WS_CS) + l * 4608, scr, F.lane); continue; }
#elif FP8_INPROJ
                transpose_item_f8(F.in[I_WIN] + (size_t)l * 2048 * IN_W, 2048, IN_W, F.ws + WS_WIN + (size_t)l * PW * 2048 * 2, kb * 64, d0, s0, 64.0f, scr, F.lane); continue; }
#else
                transpose_item(F.in[I_WIN] + (size_t)l * 2048 * IN_W, 2048, IN_W, (bf16*)(F.ws + WS_WIN) + (size_t)l * PW * 2048, kb * 64, d0, s0, nv, scr, F.lane); continue; }
#endif
            r -= I_IN;
            if (r < I_OUT) { const int nb = r % 64, kb = r / 64;
#if FP8_OUTPROJ
                transpose_item_f8(F.in[I_WOUT] + (size_t)l * 2048 * 2048, 2048, 2048, F.ws + WS_WOUT + (size_t)l * 2048 * 2048 * 2, kb * 64, nb * 32, nb * 32, 64.0f, scr, F.lane); continue; }
#else
                transpose_item(F.in[I_WOUT] + (size_t)l * 2048 * 2048, 2048, 2048, (bf16*)(F.ws + WS_WOUT) + (size_t)l * 2048 * 2048, kb * 64, nb * 32, nb * 32, 32, scr, F.lane); continue; }
#endif
            r -= I_OUT;
            transpose_item(F.in[I_WROUT] + (size_t)l * 2048 * 32, 2048, 32, (bf16*)(F.ws + WS_WRT) + (size_t)l * 32 * 2048, r * 64, 0, 0, 32, scr, F.lane);
        }
    }
    __syncthreads();
}
constexpr int CW_CVQ = 12288 + 512;
#ifndef FP8_GEMM2
#define FP8_GEMM2 1
#endif
constexpr float WGU_SCALE = 64.0f, WDN_SCALE = 64.0f; constexpr int WGU_E8M0 = 0x7C7C7C7C, WDN_E8M0 = 0x7C7C7C7C;
__device__ __forceinline__ void convert_moe_item(Frame& F, int l, int r, LAS float* scr) {
    constexpr int I_GU = 32 * 32 * 64;
    if (r < I_GU) { const int e = r / 2048, q = r % 2048, nb = q % 64, kb = q / 64; const int s0 = ((nb >> 2) & 1) * 1024 + (nb >> 3) * 128 + (nb & 3) * 32;
        transpose_item_f8(F.in[I_WGU] + (size_t)(l * 32 + e) * 2048 * 2048, 2048, 2048, F.ws + WS_WGU + (size_t)(l * 32 + e) * 2048 * 2048, kb * 64, nb * 32, s0, WGU_SCALE, scr, F.lane); return; }
    r -= I_GU;
    { const int e = r / 1024, q = r % 1024, nb = q % 64, kb = q / 64;
#if FP8_GEMM2
        transpose_item_f8(F.in[I_WDN] + (size_t)(l * 32 + e) * 1024 * 2048, 1024, 2048, F.ws + WS_WDN + (size_t)(l * 32 + e) * 2048 * 1024, kb * 64, nb * 32, nb * 32, WDN_SCALE, scr, F.lane);
#else
        transpose_item(F.in[I_WDN] + (size_t)(l * 32 + e) * 1024 * 2048, 1024, 2048, (bf16*)(F.ws + WS_WDN) + (size_t)(l * 32 + e) * 2048 * 1024, kb * 64, nb * 32, nb * 32, 32, scr, F.lane);
#endif
    }
}
constexpr int CVG = 8;
#ifndef CV_PIPE
#define CV_PIPE 1
#endif
__device__ __forceinline__ void cv_decode(Frame& F, int l, int r, const float*& src, unsigned char*& dst, int& K) {
    constexpr int I_GU = 32 * 32 * 64;
    if (r < I_GU) { const int e = r / 2048, q = r % 2048, nb = q % 64, kb = q / 64; const int s0 = ((nb >> 2) & 1) * 1024 + (nb >> 3) * 128 + (nb & 3) * 32;
        src = F.in[I_WGU] + (size_t)(l * 32 + e) * 2048 * 2048 + (size_t)(kb * 64) * 2048 + s0; dst = F.ws + WS_WGU + (size_t)(l * 32 + e) * 2048 * 2048 + (size_t)(nb * 32) * 2048 + kb * 64; K = 2048; }
    else { r -= I_GU; const int e = r / 1024, q = r % 1024, nb = q % 64, kb = q / 64;
        src = F.in[I_WDN] + (size_t)(l * 32 + e) * 1024 * 2048 + (size_t)(kb * 64) * 2048 + nb * 32; dst = F.ws + WS_WDN + (size_t)(l * 32 + e) * 2048 * 1024 + (size_t)(nb * 32) * 1024 + kb * 64; K = 1024; }
}
__device__ __forceinline__ void cv_load(const float* src, f32x4 (&v)[8], int lane) { const int c4 = (lane & 7) * 4, kr = lane >> 3;
#pragma unroll
    for (int i = 0; i < 8; ++i) v[i] = __builtin_nontemporal_load((const f32x4*)(src + (size_t)(8 * i + kr) * 2048 + c4)); }
__device__ __forceinline__ void cv_finish(const f32x4 (&v)[8], unsigned char* dst, int K, float scale, LAS float* scr, int lane) {
    { const int c4 = (lane & 7) * 4, kr = lane >> 3;
#pragma unroll
      for (int i = 0; i < 8; ++i) { LAS float* d = scr + (8 * i + kr) * 33 + c4; d[0] = v[i].x; d[1] = v[i].y; d[2] = v[i].z; d[3] = v[i].w; } }
    LDS_WAIT(); asm volatile("" ::: "memory");
    { const int n = lane >> 1, hf = lane & 1; const LAS float* s = scr + (32 * hf) * 33 + n; unsigned w[8];
      f32x4 q[8];
#pragma unroll
      for (int i = 0; i < 8; ++i) q[i] = (f32x4){s[(4 * i + 0) * 33], s[(4 * i + 1) * 33], s[(4 * i + 2) * 33], s[(4 * i + 3) * 33]};
      asm volatile("" : "+v"(q[0]), "+v"(q[1]), "+v"(q[2]), "+v"(q[3]), "+v"(q[4]), "+v"(q[5]), "+v"(q[6]), "+v"(q[7]));
#pragma unroll
      for (int i = 0; i < 8; ++i) { int x = 0; x = __builtin_amdgcn_cvt_pk_fp8_f32(q[i].x * scale, q[i].y * scale, x, false); x = __builtin_amdgcn_cvt_pk_fp8_f32(q[i].z * scale, q[i].w * scale, x, true); w[i] = (unsigned)x; }
      v4u* o = (v4u*)(dst + (size_t)n * K + 32 * hf); __builtin_nontemporal_store((v4u){w[0], w[1], w[2], w[3]}, o); __builtin_nontemporal_store((v4u){w[4], w[5], w[6], w[7]}, o + 1); }
    LDS_WAIT(); asm volatile("" ::: "memory");
}
__device__ __forceinline__ bool convert_grab(Frame& F, int l, int rep, LAS float* scr) {
    constexpr int NIT = 32 * 32 * 64 + 32 * 16 * 64;
    int g = 0; if (F.lane == 0) g = (int)__hip_atomic_fetch_add(F.ctl + CW_CVQ + 64 * l + 8 * rep, 1u, RLX_AGENT); g = __builtin_amdgcn_readfirstlane(g);
    if (g * CVG >= NIT) return false;
#if CV_PIPE && FP8_GEMM2
    static_assert(WGU_SCALE == WDN_SCALE, "one scale for both expert matrices");
    { const int r0 = g * CVG; f32x4 va[8], vb[8]; const float* sp; unsigned char* d0; unsigned char* d1; int K0, K1;
      cv_decode(F, l, r0, sp, d0, K0); cv_load(sp, va, F.lane);
#pragma unroll
      for (int k = 0; k < CVG; k += 2) {
          cv_decode(F, l, r0 + k + 1, sp, d1, K1); cv_load(sp, vb, F.lane);
          cv_finish(va, d0, K0, WGU_SCALE, scr, F.lane);
          if (k + 2 < CVG) { cv_decode(F, l, r0 + k + 2, sp, d0, K0); cv_load(sp, va, F.lane); }
          cv_finish(vb, d1, K1, WGU_SCALE, scr, F.lane);
      } }
#else
#pragma unroll 1
    for (int k = 0; k < CVG; ++k) convert_moe_item(F, l, g * CVG + k, scr);
#endif
    return true;
}
__device__ __forceinline__ void convert_moe_queue(Frame& F, int l, int rep = 0) {
    LAS float* scr = (LAS float*)(F.lds + F.wave * 16384);
    __syncthreads();
    while (convert_grab(F, l, rep, scr)) {}
    __syncthreads();
}
constexpr int CW_TAIL = 16384;
__device__ __forceinline__ void tail_fill(Frame& F, int seam, int lt) {
    LAS int* flag = (LAS int*)(F.lds + LDS_X_OFF + 768);
    LAS float* scr = (LAS float*)(F.lds + F.wave * 16384);
    __syncthreads();
    if (F.tid == 0) (void)__hip_atomic_fetch_add(F.ctl + CW_TAIL + 64 * seam, 1u, RLX_AGENT);
    bool more = true;
    for (int it = 0; it < 4096; ++it) {
        if (F.tid == 0) *flag = (__hip_atomic_load(F.ctl + CW_TAIL + 64 * seam, RLX_AGENT) >= (unsigned)F.G) ? 1 : 0;
        __syncthreads();
        const int done = *flag;
        __syncthreads();
        if (done) break;
        if (more) more = convert_grab(F, lt, 0, scr); else __builtin_amdgcn_s_sleep(32);
    }
}
__device__ __forceinline__ void convert_moe_timed(Frame& F, int l, unsigned long long budget) {
    LAS float* scr = (LAS float*)(F.lds + F.wave * 16384);
    const unsigned long long t0 = __builtin_amdgcn_s_memrealtime();
    __syncthreads();
    while (__builtin_amdgcn_s_memrealtime() - t0 < budget) { if (!convert_grab(F, l, 0, scr)) break; }
    __syncthreads();
}

__device__ __forceinline__ void load_row(const float* src, int lane, f32x4 (&v)[8]) {
    const f32x4* p = (const f32x4*)src + lane;
#pragma unroll
    for (int j = 0; j < 8; ++j) v[j] = p[64 * j];
}
__device__ __forceinline__ void store_row(float* dst, int lane, const f32x4 (&v)[8]) {
    f32x4* p = (f32x4*)dst + lane;
#pragma unroll
    for (int j = 0; j < 8; ++j) p[64 * j] = v[j];
}
#if X_BF16
typedef bf16 xelem_t;
__device__ __forceinline__ void load_xrow(const bf16* src, int lane, f32x4 (&v)[8]) {
    const v2u* p = (const v2u*)src + lane;
#pragma unroll
    for (int j = 0; j < 8; ++j) { const v2u w = p[64 * j]; v[j] = (f32x4){bflo(w.x), bfhi(w.x), bflo(w.y), bfhi(w.y)}; }
}
__device__ __forceinline__ void store_xrow(bf16* dst, int lane, const f32x4 (&v)[8]) {
    v2u* p = (v2u*)dst + lane;
#pragma unroll
    for (int j = 0; j < 8; ++j) { v2u w; w.x = pk2(v[j].x, v[j].y); w.y = pk2(v[j].z, v[j].w); p[64 * j] = w; }
}
#else
typedef float xelem_t;
__device__ __forceinline__ void load_xrow(const float* src, int lane, f32x4 (&v)[8]) { load_row(src, lane, v); }
__device__ __forceinline__ void store_xrow(float* dst, int lane, const f32x4 (&v)[8]) { store_row(dst, lane, v); }
#endif
__device__ __forceinline__ void combine_row(Frame& F, int l, int m, int lane, f32x4 (&v)[8]) {
    const int* dest = (const int*)(F.ws + WS_MOEI + 2 * 512 * 1024) + m * 4;
    const float* g5 = (const float*)(F.ws + WS_MOD) + (size_t)(l * 5 + mod_row(m)) * 12288 + 5 * 2048;
    f32x4 acc[8];
#pragma unroll
    for (int j = 0; j < 8; ++j) acc[j] = (f32x4){0.f, 0.f, 0.f, 0.f};
#if YS_FP8
    typedef float f32x2c __attribute__((ext_vector_type(2)));
#pragma unroll
    for (int k = 0; k < 4; ++k) { const int d = dest[k]; const unsigned* yp = (const unsigned*)(F.ws + WS_YS + (size_t)d * 2048) + lane;
#pragma unroll
        for (int j = 0; j < 8; ++j) { const int w = (int)yp[64 * j]; const f32x2c lo = __builtin_amdgcn_cvt_pk_f32_fp8(w, false), hi = __builtin_amdgcn_cvt_pk_f32_fp8(w, true); acc[j] += (f32x4){lo.x, lo.y, hi.x, hi.y}; } }
#pragma unroll
    for (int j = 0; j < 8; ++j) { const f32x4 gg = *((const f32x4*)g5 + lane + 64 * j); v[j] += gg * acc[j] * 0.0625f; }
#else
#pragma unroll
    for (int k = 0; k < 4; ++k) { const int d = dest[k]; const v2u* yp = (const v2u*)((const bf16*)(F.ws + WS_YS) + (size_t)d * 2048) + lane;
#pragma unroll
        for (int j = 0; j < 8; ++j) { const v2u w = yp[64 * j]; acc[j] += (f32x4){bflo(w.x), bfhi(w.x), bflo(w.y), bfhi(w.y)}; } }
#pragma unroll
    for (int j = 0; j < 8; ++j) { const f32x4 gg = *((const f32x4*)g5 + lane + 64 * j); v[j] += gg * acc[j]; }
#endif
}
__device__ __forceinline__ void combine_row_g(Frame& F, int m, int lane, f32x4 (&v)[8], const f32x4 (&g5)[8]) {
    const int* dest = (const int*)(F.ws + WS_MOEI + 2 * 512 * 1024) + m * 4;
    f32x4 acc[8];
#pragma unroll
    for (int j = 0; j < 8; ++j) acc[j] = (f32x4){0.f, 0.f, 0.f, 0.f};
    typedef float f32x2c __attribute__((ext_vector_type(2)));
    const pg8::v4i_t d4 = *(const pg8::v4i_t*)dest;
#pragma unroll
    for (int k = 0; k < 4; ++k) { const int d = d4[k]; const unsigned* yp = (const unsigned*)(F.ws + WS_YS + (size_t)d * 2048) + lane;
#pragma unroll
        for (int j = 0; j < 8; ++j) { const int w = (int)yp[64 * j]; const f32x2c lo = __builtin_amdgcn_cvt_pk_f32_fp8(w, false), hi = __builtin_amdgcn_cvt_pk_f32_fp8(w, true); acc[j] += (f32x4){lo.x, lo.y, hi.x, hi.y}; } }
#pragma unroll
    for (int j = 0; j < 8; ++j) v[j] += g5[j] * acc[j] * 0.0625f;
}
__device__ __forceinline__ void combine_row_l(Frame& F, int m, int lane, f32x4 (&v)[8], const LAS f32x4* g5, const pg8::v4i_t d4) {
    typedef float f32x2c __attribute__((ext_vector_type(2)));
    v4u ya[4], yb[4];
#pragma unroll
    for (int k = 0; k < 4; ++k) { const unsigned* yp = (const unsigned*)(F.ws + WS_YS + (size_t)d4[k] * 2048) + lane;
        ya[k] = (v4u){__builtin_nontemporal_load(yp), __builtin_nontemporal_load(yp + 64), __builtin_nontemporal_load(yp + 128), __builtin_nontemporal_load(yp + 192)}; yb[k] = (v4u){__builtin_nontemporal_load(yp + 256), __builtin_nontemporal_load(yp + 320), __builtin_nontemporal_load(yp + 384), __builtin_nontemporal_load(yp + 448)}; }
    asm volatile("" : "+v"(ya[0]), "+v"(yb[0]), "+v"(ya[1]), "+v"(yb[1]), "+v"(ya[2]), "+v"(yb[2]), "+v"(ya[3]), "+v"(yb[3]));
    f32x4 acc[8];
#pragma unroll
    for (int j = 0; j < 8; ++j) acc[j] = (f32x4){0.f, 0.f, 0.f, 0.f};
#pragma unroll
    for (int k = 0; k < 4; ++k)
#pragma unroll
        for (int j = 0; j < 8; ++j) { const int w = (int)(j < 4 ? ya[k][j] : yb[k][j - 4]); const f32x2c lo = __builtin_amdgcn_cvt_pk_f32_fp8(w, false), hi = __builtin_amdgcn_cvt_pk_f32_fp8(w, true); acc[j] += (f32x4){lo.x, lo.y, hi.x, hi.y}; }
#pragma unroll
    for (int j = 0; j < 8; ++j) v[j] += g5[lane + 64 * j] * acc[j] * 0.0625f;
}
__device__ __forceinline__ int pass_row0(int bid, int p) { return p < 4 ? bid * 64 + p * 16 : NLAT + bid * 16; }
__device__ __forceinline__ void modnorm_store(const f32x4 (&v)[8], const float* g, const float* shift, const float* scale, bf16* hrow, int lane) {
    float ss = 0.f;
#pragma unroll
    for (int j = 0; j < 8; ++j) ss += (v[j].x * v[j].x + v[j].y * v[j].y) + (v[j].z * v[j].z + v[j].w * v[j].w);
    const float rstd = 1.0f / sqrtf(wave_sum(ss) * (1.0f / 2048.0f) + EPS);
    v2u* hp = (v2u*)hrow + lane;
#pragma unroll
    for (int j = 0; j < 8; ++j) { const f32x4 gg = *((const f32x4*)g + lane + 64 * j), sh = *((const f32x4*)shift + lane + 64 * j), sc = *((const f32x4*)scale + lane + 64 * j);
        const f32x4 y = (v[j] * rstd) * gg * (sc + 1.0f) + sh; v2u w; w.x = pk2(y.x, y.y); w.y = pk2(y.z, y.w); hp[64 * j] = w; }
}
constexpr size_t WS_W16 = WS_WRT + 512 * 1024;
__device__ __forceinline__ void phase_norm1(Frame& F, int l) {
    constexpr int TROW = 4112;
    LAS unsigned char* tile = F.lds; LAS float* part = (LAS float*)(F.lds + 66048);
    xelem_t* X = (xelem_t*)(F.ws + WS_X); bf16* H = (bf16*)(F.ws + WS_H); bf16* P = (bf16*)(F.ws + WS_P);
    const float* modp = (const float*)(F.ws + WS_MOD) + (size_t)l * 5 * 12288;
    const bf16* w16 = (const bf16*)(F.ws + WS_W16) + (size_t)l * 32 * 2048;
    static_assert(YS_FP8 && I8_INPROJ, "norm phases: cached-modulation form");
    bf16x8 WB[8];
    { const int row = F.lane & 15, q = F.lane >> 4;
#pragma unroll
      for (int ks = 0; ks < 8; ++ks) WB[ks] = *(const bf16x8*)(w16 + (size_t)row * 2048 + 256 * F.wave + 32 * ks + 8 * q); }
    LAS f32x4* MAl = (LAS f32x4*)(F.lds + 81920); LAS f32x4* MSl = MAl + 512; LAS f32x4* G5l = MSl + 512;
    const int np = F.bid < 64 ? 5 : 4;
#pragma unroll 1
    for (int p = 0; p < np; ++p) { const int r0 = pass_row0(F.bid, p);
        if (p == 0 || p == 4) { const float* mr = modp + (size_t)mod_row(r0) * 12288; const float* g = F.in[I_NMG] + l * DM; const float* g5 = (const float*)(F.ws + WS_MOD) + (size_t)((l > 0 ? l - 1 : 0) * 5 + mod_row(r0)) * 12288 + 5 * 2048;
            { const int i = F.tid; const f32x4 gg = *((const f32x4*)g + i), sh = *((const f32x4*)mr + i), sc = *((const f32x4*)(mr + 2048) + i);
              MAl[i] = gg * (sc + 1.0f); MSl[i] = sh; if (l > 0) G5l[i] = *((const f32x4*)g5 + i); }
            LDS_BARRIER(); }
#pragma unroll 1
        for (int rr = 0; rr < 2; ++rr) { const int lr = 2 * F.wave + rr, m = r0 + lr;
            f32x4 v[8];
            if (l == 0) load_row(m < NLAT ? F.in[I_X] + (size_t)m * DM : F.in[I_CTX] + (size_t)(m - NLAT) * DM, F.lane, v);
            else {
                v2u xw[8]; { const v2u* px = (const v2u*)(X + (size_t)m * DM) + F.lane;
#pragma unroll
                  for (int j = 0; j < 8; ++j) xw[j] = px[64 * j]; }
                pg8::v4i_t d4 = *(const pg8::v4i_t*)((const int*)(F.ws + WS_MOEI + 2 * 512 * 1024) + m * 4);
                asm volatile("" : "+v"(xw[0]), "+v"(xw[1]), "+v"(xw[2]), "+v"(xw[3]), "+v"(xw[4]), "+v"(xw[5]), "+v"(xw[6]), "+v"(xw[7]), "+v"(d4));
#pragma unroll
                for (int j = 0; j < 8; ++j) v[j] = (f32x4){bflo(xw[j].x), bfhi(xw[j].x), bflo(xw[j].y), bfhi(xw[j].y)};
                if (MK_STAGE >= 9) { combine_row_l(F, m, F.lane, v, G5l, d4); store_xrow(X + (size_t)m * DM, F.lane, v); } }
            float ss = 0.f;
#pragma unroll
            for (int j = 0; j < 8; ++j) ss += (v[j].x * v[j].x + v[j].y * v[j].y) + (v[j].z * v[j].z + v[j].w * v[j].w);
            const float rstd = 1.0f / sqrtf(wave_sum(ss) * (1.0f / 2048.0f) + EPS);
#if I8_INPROJ
            LAS v2u* tp = (LAS v2u*)(tile + lr * TROW) + F.lane; float amax = 0.f;
#pragma unroll
            for (int j = 0; j < 8; ++j) { const f32x4 y = (v[j] * rstd) * MAl[F.lane + 64 * j] + MSl[F.lane + 64 * j]; v[j] = y; v2u w; w.x = pk2(y.x, y.y); w.y = pk2(y.z, y.w); tp[64 * j] = w;
                amax = fmaxf(amax, fmaxf(fmaxf(fabsf(y.x), fabsf(y.y)), fmaxf(fabsf(y.z), fabsf(y.w)))); }
            amax = wave_max(amax); const float inv = amax > 0.f ? 127.0f / amax : 0.f;
            unsigned* hp = (unsigned*)(F.ws + WS_XS + (size_t)m * DM) + F.lane;
#pragma unroll
            for (int j = 0; j < 8; ++j) hp[64 * j] = pk4_i8(v[j].x * inv, v[j].y * inv, v[j].z * inv, v[j].w * inv);
            if (F.lane == 0) ((float*)(F.ws + WS_RS))[m] = amax * (1.0f / 127.0f);
#endif
        }
        LDS_BARRIER();
        { const int row = F.lane & 15, q = F.lane >> 4; f32x4 acc = {0.f, 0.f, 0.f, 0.f};
#pragma unroll
          for (int ks = 0; ks < 8; ++ks) { const int k0 = 256 * F.wave + 32 * ks + 8 * q;
              const bf16x8 a = *(const LAS bf16x8*)(tile + row * TROW + k0 * 2);
              acc = __builtin_amdgcn_mfma_f32_16x16x32_bf16(a, WB[ks], acc, 0, 0, 0); }
#pragma unroll
          for (int i = 0; i < 4; ++i) part[(F.wave * 16 + 4 * q + i) * 16 + row] = acc[i]; }
        LDS_BARRIER();
        if (F.tid < 256) { const int rw = F.tid >> 4, c = F.tid & 15; float sacc = 0.f;
#pragma unroll
            for (int w = 0; w < 8; ++w) sacc += part[(w * 16 + rw) * 16 + c];
            P[(size_t)(r0 + rw) * PW + PC_BETA + c] = (bf16)f2bf(sacc); }
        LDS_BARRIER();
    }
}
__device__ __forceinline__ void phase_final(Frame& F, bool with_combine) {
    const int gw = F.bid * NWAVES + F.wave, NGW = F.G * NWAVES;
    const xelem_t* X = (const xelem_t*)(F.ws + WS_X);
    f32x4 G5[8], FG[8];
    { const float* g5 = (const float*)(F.ws + WS_MOD) + (size_t)(1 * 5 + mod_row(gw * 8)) * 12288 + 5 * 2048;
#pragma unroll
      for (int j = 0; j < 8; ++j) { G5[j] = *((const f32x4*)g5 + F.lane + 64 * j); FG[j] = *((const f32x4*)F.in[I_FNG] + F.lane + 64 * j); } }
    (void)NGW;
#pragma unroll 1
    for (int m = gw * 8; m < gw * 8 + 8; ++m) {
        f32x4 v[8];
        if (with_combine) { load_xrow(X + (size_t)m * DM, F.lane, v); combine_row_g(F, m, F.lane, v, G5); }
        else load_row(F.in[I_X] + (size_t)m * DM, F.lane, v);
        float ss = 0.f;
#pragma unroll
        for (int j = 0; j < 8; ++j) ss += (v[j].x * v[j].x + v[j].y * v[j].y) + (v[j].z * v[j].z + v[j].w * v[j].w);
        const float rstd = 1.0f / sqrtf(wave_sum(ss) * (1.0f / 2048.0f) + EPS);
        f32x4* op = (f32x4*)(F.out + (size_t)m * DM) + F.lane;
#pragma unroll
        for (int j = 0; j < 8; ++j) op[64 * j] = v[j] * rstd * FG[j];
    }
}

__device__ __forceinline__ void phase_inproj(Frame& F, int l) {
#if I8_INPROJ
    pg8::Gemm g{(const bf16*)(F.ws + WS_XS), (const bf16*)(F.ws + WS_WIN + (size_t)l * PW * 2048 * 2), NTOK, 4608, 1024};
    pg8::StaticOrderG S; S.init(g, F.G, F.bid);
    pg8::EpiBf16PlainI8 E{(bf16*)(F.ws + WS_P), PW, (const float*)(F.ws + WS_RS), (const float*)(F.ws + WS_CS) + l * 4608};
    pg8::gemm_phase<pg8::EpiBf16PlainI8, pg8::StaticOrderG, true, true, false, true>(F.lds + RING_OFF, g, S, E);
#elif FP8_INPROJ
    pg8::Gemm g{(const bf16*)(F.ws + WS_XS), (const bf16*)(F.ws + WS_WIN + (size_t)l * PW * 2048 * 2), NTOK, 4608, 1024, 0x7C7C7C7C};
    pg8::StaticOrderG S; S.init(g, F.G, F.bid); S.row_tab = (const int*)(F.ws + WS_IDT);
    pg8::EpiBf16Plain E{(bf16*)(F.ws + WS_P), PW};
    pg8::gemm_phase<pg8::EpiBf16Plain, pg8::StaticOrderG, true, true, true>(F.lds + RING_OFF, g, S, E);
#else
    pg8::Gemm g{(const bf16*)(F.ws + WS_H), (const bf16*)(F.ws + WS_WIN) + (size_t)l * PW * 2048, NTOK, 4608, 2048};
    pg8::StaticOrder S; S.init(g, F.G, F.bid);
    pg8::EpiBf16Plain E{(bf16*)(F.ws + WS_P), PW};
    pg8::gemm_phase<pg8::EpiBf16Plain, pg8::StaticOrder, true, true>(F.lds + RING_OFF, g, S, E);
#endif
}
__device__ __forceinline__ void phase_outproj(Frame& F, int l) {
    static_assert(X_BF16 && !FP8_OUTPROJ, "out-projection: bf16 operands, bf16 residual stream");
    pg8::Gemm g{(const bf16*)(F.ws + WS_CC), (const bf16*)(F.ws + WS_WOUT) + (size_t)l * 2048 * 2048, l == 0 ? NTOK : NLAT, 2048, 2048};
    pg8::StaticOrder S; S.init(g, F.G, F.bid);
    const float* modg = (const float*)(F.ws + WS_MOD) + (size_t)l * 5 * 12288 + 2 * 2048;
    if (l == 0) { pg8::EpiResGateBT<true> E{F.in[I_X], F.in[I_CTX], (const bf16*)(F.ws + WS_X), (bf16*)(F.ws + WS_X), modg}; pg8::gemm_phase<pg8::EpiResGateBT<true>, pg8::StaticOrder, true, true>(F.lds + RING_OFF, g, S, E); }
    else { pg8::EpiResGateBT<false> E{F.in[I_X], F.in[I_CTX], (const bf16*)(F.ws + WS_X), (bf16*)(F.ws + WS_X), modg}; pg8::gemm_phase<pg8::EpiResGateBT<false>, pg8::StaticOrder, true, true>(F.lds + RING_OFF, g, S, E); }
}
#ifndef PHASE_INPROJ
#define PHASE_INPROJ(F, l) phase_inproj(F, l)
#endif
#ifndef PHASE_OUTPROJ
#define PHASE_OUTPROJ(F, l) phase_outproj(F, l)
#endif

constexpr size_t WS_H8 = WS_XS;
constexpr size_t MOEI_TOPE = WS_MOEI, MOEI_TOPG = WS_MOEI + 512 * 1024, MOEI_DEST = WS_MOEI + 2 * 512 * 1024, MOEI_ROWG = WS_MOEI + 3 * 512 * 1024, MOEI_ROWT = WS_MOEI + 4 * 512 * 1024, MOEI_IDT = WS_IDT;
__device__ __forceinline__ void phase_norm2(Frame& F, int l) {
    const int nrows = (l == 0) ? NTOK : NLAT;
    constexpr int TROW = 4112;
    LAS unsigned char* tile = F.lds;
    LAS float* part = (LAS float*)(F.lds + 66048);
    LAS float* lg = (LAS float*)(F.lds + 66048 + 16384);
    const xelem_t* X = (const xelem_t*)(F.ws + WS_X); bf16* H = (bf16*)(F.ws + WS_H);
    const float* modp = (const float*)(F.ws + WS_MOD) + (size_t)l * 5 * 12288;
    const bf16* wrt = (const bf16*)(F.ws + WS_WRT) + (size_t)l * 32 * 2048;
    int* tope = (int*)(F.ws + MOEI_TOPE); float* topg = (float*)(F.ws + MOEI_TOPG);
    LAS float* selv = lg + 512; LAS int* seli = (LAS int*)(selv + 64); LAS int* cntl = seli + 64; LAS int* basel = cntl + 32; LAS int* ent = basel + 32;
    if (F.tid < 32) cntl[F.tid] = 0;
    bf16x8 RB0[8], RB1[8];
    { const int row = F.lane & 15, q = F.lane >> 4;
#pragma unroll
      for (int ks = 0; ks < 8; ++ks) { const int k0 = 256 * F.wave + 32 * ks + 8 * q; RB0[ks] = *(const bf16x8*)(wrt + (size_t)row * 2048 + k0); RB1[ks] = *(const bf16x8*)(wrt + (size_t)(16 + row) * 2048 + k0); } }
    f32x4 MA[8], MS[8];
    const int np = (nrows > NLAT && F.bid < 64) ? 5 : 4;
#pragma unroll 1
    for (int pass = 0; pass < np; ++pass) { const int r0 = pass_row0(F.bid, pass);
        if (pass == 0 || pass == 4) { const float* mr = modp + (size_t)mod_row(r0) * 12288; const float* g = F.in[I_NFG] + l * DM;
#pragma unroll
            for (int j = 0; j < 8; ++j) { const f32x4 gg = *((const f32x4*)g + F.lane + 64 * j), sh = *((const f32x4*)(mr + 3 * 2048) + F.lane + 64 * j), sc = *((const f32x4*)(mr + 4 * 2048) + F.lane + 64 * j);
                MA[j] = gg * (sc + 1.0f); MS[j] = sh; } }
#pragma unroll 1
        for (int rr = 0; rr < 2; ++rr) {
            const int lr = 2 * F.wave + rr, m = r0 + lr;
            f32x4 v[8]; load_xrow(X + (size_t)m * DM, F.lane, v);
            float ss = 0.f;
#pragma unroll
            for (int j = 0; j < 8; ++j) ss += (v[j].x * v[j].x + v[j].y * v[j].y) + (v[j].z * v[j].z + v[j].w * v[j].w);
            const float rstd = 1.0f / sqrtf(wave_sum(ss) * (1.0f / 2048.0f) + EPS);
            unsigned* hp = (unsigned*)(F.ws + WS_H8 + (size_t)m * DM) + F.lane; LAS v2u* tp = (LAS v2u*)(tile + lr * TROW) + F.lane;
#pragma unroll
            for (int j = 0; j < 8; ++j) { const f32x4 y = (v[j] * rstd) * MA[j] + MS[j]; v2u w; w.x = pk2(y.x, y.y); w.y = pk2(y.z, y.w); tp[64 * j] = w;
                int x8 = 0; x8 = __builtin_amdgcn_cvt_pk_fp8_f32(y.x, y.y, x8, false); x8 = __builtin_amdgcn_cvt_pk_fp8_f32(y.z, y.w, x8, true); hp[64 * j] = (unsigned)x8; }
        }
        LDS_BARRIER();
        {
            const int row = F.lane & 15, q = F.lane >> 4;
            f32x4 acc0 = {0.f, 0.f, 0.f, 0.f}, acc1 = {0.f, 0.f, 0.f, 0.f};
#pragma unroll
            for (int ks = 0; ks < 8; ++ks) { const int k0 = 256 * F.wave + 32 * ks + 8 * q;
                const bf16x8 a = *(const LAS bf16x8*)(tile + row * TROW + k0 * 2);
                acc0 = __builtin_amdgcn_mfma_f32_16x16x32_bf16(a, RB0[ks], acc0, 0, 0, 0); acc1 = __builtin_amdgcn_mfma_f32_16x16x32_bf16(a, RB1[ks], acc1, 0, 0, 0); }
#pragma unroll
            for (int i = 0; i < 4; ++i) { part[(F.wave * 16 + 4 * q + i) * 32 + row] = acc0[i]; part[(F.wave * 16 + 4 * q + i) * 32 + 16 + row] = acc1[i]; }
        }
        LDS_BARRIER();
        { const int rw = F.tid >> 5, e = F.tid & 31; float s = F.in[I_BROUT][l * 32 + e];
#pragma unroll
          for (int w = 0; w < 8; ++w) s += part[(w * 16 + rw) * 32 + e];
          lg[rw * 32 + e] = s; }
        LDS_BARRIER();
        { const int rw = F.tid >> 5, e = F.tid & 31; const float x = lg[rw * 32 + e]; int rank = 0;
#pragma unroll
          for (int q = 0; q < 8; ++q) { const f32x4 y = *(const LAS f32x4*)(lg + rw * 32 + 4 * q);
#pragma unroll
              for (int c = 0; c < 4; ++c) rank += (y[c] > x || (y[c] == x && 4 * q + c < e)) ? 1 : 0; }
          if (rank < 4) { const int loc = __hip_atomic_fetch_add(cntl + e, 1, __ATOMIC_RELAXED, __HIP_MEMORY_SCOPE_WORKGROUP); selv[rw * 4 + rank] = x; seli[rw * 4 + rank] = e | (loc << 8); } }
        LDS_BARRIER();
        if (F.tid < 64) { const int rw = F.tid >> 2, k = F.tid & 3; const f32x4 v = *(const LAS f32x4*)(selv + rw * 4);
            const float p0 = 1.0f, p1 = __expf(v[1] - v[0]), p2 = __expf(v[2] - v[0]), p3 = __expf(v[3] - v[0]); const float pk = k == 0 ? p0 : k == 1 ? p1 : k == 2 ? p2 : p3;
            topg[(r0 + rw) * 4 + k] = pk / (((p0 + p1) + p2) + p3); ent[pass * 64 + F.tid] = seli[F.tid]; }
        LDS_BARRIER();
    }
    if (F.tid < 32) basel[F.tid] = (int)__hip_atomic_fetch_add(F.ctl + CW_CNT + 2048 * l + 64 * F.tid, (unsigned)cntl[F.tid], RLX_AGENT);
    LDS_BARRIER();
    for (int i = F.tid; i < np * 64; i += NTHREADS) { const int pp = i >> 6, w = i & 63, m = pass_row0(F.bid, pp) + (w >> 2); const int te = ent[i];
        tope[m * 4 + (w & 3)] = te + (basel[te & 255] << 8); }
}
__device__ __forceinline__ void moe_tables(Frame& F, int l) {
    LAS int* blk_end = (LAS int*)(F.lds + LDS_X_OFF); LAS int* pstart = blk_end + 32; LAS int* cnts = blk_end + 64;
    if (F.tid < 32) cnts[F.tid] = (int)__hip_atomic_load(F.ctl + CW_CNT + 2048 * l + 64 * F.tid, RLX_AGENT);
    __syncthreads();
    if (F.tid == 0) { int nb = 0;
#pragma unroll
        for (int e = 0; e < 32; ++e) { const int c = cnts[e]; pstart[e] = nb * 256; nb += (c + 255) >> 8; blk_end[e] = nb; } }
    __syncthreads();
}
__device__ __forceinline__ void phase_scatter(Frame& F, int l) {
    const int nrows = (l == 0) ? NTOK : NLAT;
    moe_tables(F, l);
    const LAS int* blk_end = (const LAS int*)(F.lds + LDS_X_OFF); const LAS int* pstart = blk_end + 32; const LAS int* cnts = blk_end + 64;
    const int* tope = (const int*)(F.ws + MOEI_TOPE); const float* topg = (const float*)(F.ws + MOEI_TOPG);
    int* dest = (int*)(F.ws + MOEI_DEST); float* rowg = (float*)(F.ws + MOEI_ROWG); int* rowt = (int*)(F.ws + MOEI_ROWT);
    for (int a = F.bid * NTHREADS + F.tid; a < nrows * 4; a += F.G * NTHREADS) {
        const int te = tope[a], e = te & 255, rank = (int)((unsigned)te >> 8), d = pstart[e] + rank;
        dest[a] = d; rowg[d] = topg[a]; rowt[d] = a >> 2; }
    if (F.bid < 32) { const int e = F.bid, r0 = pstart[e] + cnts[e], r1 = blk_end[e] * 256;
        for (int r = r0 + F.tid; r < r1; r += NTHREADS) { rowt[r] = 0; rowg[r] = 0.f; } }
}
__device__ __forceinline__ void phase_gemm1(Frame& F, int l) {
    if (MK_SPLIT) moe_tables(F, l);
    const LAS int* blk_end = (const LAS int*)(F.lds + LDS_X_OFF);
    pg8::Gemm g{(const bf16*)(F.ws + WS_H8), (const bf16*)(F.ws + WS_WGU + (size_t)l * 32 * 2048 * 2048), MOE_ROWS, 2048, 1024, WGU_E8M0};
    pg8::MoeOrderG S{F.bid, __builtin_amdgcn_readfirstlane(blk_end[31]), (const char*)g.A, (const char*)g.Bt, (size_t)256 * 2048, (size_t)2048 * 2048, (size_t)256 * 2048, blk_end, (const int*)(F.ws + MOEI_ROWT)};
#if FP8_GEMM2
    pg8::EpiSwiglu8 E{F.ws + WS_ACT, F.in[I_BGU] + (size_t)l * 32 * 2048};
    pg8::gemm_phase<pg8::EpiSwiglu8, pg8::MoeOrderG, true, true, true>(F.lds + RING_OFF, g, S, E);
#else
    pg8::EpiSwiglu E{(bf16*)(F.ws + WS_ACT), F.in[I_BGU] + (size_t)l * 32 * 2048};
    pg8::gemm_phase<pg8::EpiSwiglu, pg8::MoeOrderG, true, true, true>(F.lds + RING_OFF, g, S, E);
#endif
}
__device__ __forceinline__ void phase_gemm2(Frame& F, int l) {
    if (MK_SPLIT) moe_tables(F, l);
    const LAS int* blk_end = (const LAS int*)(F.lds + LDS_X_OFF);
#if FP8_GEMM2
    pg8::Gemm g{(const bf16*)(F.ws + WS_ACT), (const bf16*)(F.ws + WS_WDN + (size_t)l * 32 * 2048 * 1024), MOE_ROWS, 2048, 512, WDN_E8M0};
    pg8::MoeOrderI S{F.bid, __builtin_amdgcn_readfirstlane(blk_end[31]), (const char*)g.A, (const char*)g.Bt, (size_t)256 * 1024, (size_t)2048 * 1024, (size_t)256 * 1024, blk_end, nullptr};
#if YS_FP8
    pg8::EpiDown8 E{F.ws + WS_YS, F.in[I_BDN] + (size_t)l * 32 * 2048, (const float*)(F.ws + MOEI_ROWG)};
    pg8::gemm_phase<pg8::EpiDown8, pg8::MoeOrderI, true, true, true>(F.lds + RING_OFF, g, S, E);
#else
    pg8::EpiDown E{(bf16*)(F.ws + WS_YS), F.in[I_BDN] + (size_t)l * 32 * 2048, (const float*)(F.ws + MOEI_ROWG)};
    pg8::gemm_phase<pg8::EpiDown, pg8::MoeOrderI, true, true, true>(F.lds + RING_OFF, g, S, E);
#endif
#else
    pg8::Gemm g{(const bf16*)(F.ws + WS_ACT), (const bf16*)(F.ws + WS_WDN) + (size_t)l * 32 * 2048 * 1024, MOE_ROWS, 2048, 1024};
    pg8::MoeOrder S{F.bid, __builtin_amdgcn_readfirstlane(blk_end[31]), (const char*)g.A, (const char*)g.Bt, (size_t)256 * 1024 * 2, (size_t)2048 * 1024 * 2, (size_t)256 * 1024 * 2, blk_end, nullptr};
    pg8::EpiDown E{(bf16*)(F.ws + WS_YS), F.in[I_BDN] + (size_t)l * 32 * 2048, (const float*)(F.ws + MOEI_ROWG)};
    pg8::gemm_phase<pg8::EpiDown, pg8::MoeOrder, true, true>(F.lds + RING_OFF, g, S, E);
#endif
}
#ifndef PHASE_NORM2
#define PHASE_NORM2(F, l) phase_norm2(F, l)
#endif
#ifndef PHASE_SCATTER
#define PHASE_SCATTER(F, l) phase_scatter(F, l)
#endif
#ifndef PHASE_GEMM1
#define PHASE_GEMM1(F, l) phase_gemm1(F, l)
#endif
#ifndef PHASE_GEMM2
#define PHASE_GEMM2(F, l) phase_gemm2(F, l)
#endif
#define USE_MFMA_ATTN 1

__device__ __forceinline__ void attn_prep(Frame& F, int l) {
    bf16* P = (bf16*)(F.ws + WS_P);
    LAS unsigned short* vt = (LAS unsigned short*)F.lds;
    for (int ct = F.bid; ct < NCT; ct += F.G) {
        const int m0 = ct * 64; const bool lat = m0 < NLAT;
        __syncthreads();
        v4u vw[4];
#pragma unroll
        for (int k = 0; k < 4; ++k) { const int i = F.tid + k * NTHREADS, tk = i >> 5, c8 = i & 31; vw[k] = *(const v4u*)(P + (size_t)(m0 + tk) * PW + PC_V + c8 * 8); }
        asm volatile("" : "+v"(vw[0]), "+v"(vw[1]), "+v"(vw[2]), "+v"(vw[3]));
#pragma unroll
        for (int k = 0; k < 4; ++k) { const int i = F.tid + k * NTHREADS, tk = i >> 5, c8 = i & 31;
            const v4u w = vw[k];
            const unsigned ww[4] = {w.x, w.y, w.z, w.w};
#pragma unroll
            for (int q = 0; q < 4; ++q) { vt[(c8 * 8 + 2 * q) * 66 + tk] = (unsigned short)(ww[q] & 0xffffu); vt[(c8 * 8 + 2 * q + 1) * 66 + tk] = (unsigned short)(ww[q] >> 16); } }
        if (lat) { const int tk = F.tid >> 3, kvh = (F.tid >> 1) & 3, hf = F.tid & 1; const int t = (m0 + tk) & 4095;
            bf16* kp = P + (size_t)(m0 + tk) * PW + PC_K + kvh * 64 + hf * 32;
            const v4u w0 = *(const v4u*)kp, w1 = *(const v4u*)(kp + 8), w2 = *(const v4u*)(kp + 16), w3 = *(const v4u*)(kp + 24);
            const unsigned lo[8] = {w0.x, w0.y, w0.z, w0.w, w1.x, w1.y, w1.z, w1.w}, hi_[8] = {w2.x, w2.y, w2.z, w2.w, w3.x, w3.y, w3.z, w3.w};
            const float pos = (float)(hf ? (t & 63) : (t >> 6)); unsigned o1[8], o2[8];
#pragma unroll
            for (int jj = 0; jj < 8; ++jj) { float r1[2], r2[2];
#pragma unroll
                for (int e = 0; e < 2; ++e) { const int j = 2 * jj + e; const float inv = __builtin_amdgcn_exp2f(-(float)j * 0.8304820237218406f); const float sn = __sinf(pos * inv), cs = __cosf(pos * inv);
                    const float x1 = e ? bfhi(lo[jj]) : bflo(lo[jj]), x2 = e ? bfhi(hi_[jj]) : bflo(hi_[jj]); r1[e] = x1 * cs - x2 * sn; r2[e] = x2 * cs + x1 * sn; }
                o1[jj] = pk2(r1[0], r1[1]); o2[jj] = pk2(r2[0], r2[1]); }
            *(v4u*)kp = (v4u){o1[0], o1[1], o1[2], o1[3]}; *(v4u*)(kp + 8) = (v4u){o1[4], o1[5], o1[6], o1[7]}; *(v4u*)(kp + 16) = (v4u){o2[0], o2[1], o2[2], o2[3]}; *(v4u*)(kp + 24) = (v4u){o2[4], o2[5], o2[6], o2[7]}; }
        __syncthreads();
        for (int i = F.tid; i < 256 * 8; i += NTHREADS) { const int col = i >> 3, c = i & 7, kvh = col >> 6, d = col & 63;
            v4u o; const LAS unsigned short* s = vt + col * 66 + c * 8;
            o.x = s[0] | ((unsigned)s[1] << 16); o.y = s[2] | ((unsigned)s[3] << 16); o.z = s[4] | ((unsigned)s[5] << 16); o.w = s[6] | ((unsigned)s[7] << 16);
            if (lat) { const int b = m0 >> 12, t0 = m0 & 4095; *(v4u*)((bf16*)(F.ws + WS_VT) + ((size_t)(b * 4 + kvh) * 64 + d) * SEQ + t0 + c * 8) = o; }
            else { const int mm = m0 - NLAT, b = mm >> 8, t0 = mm & 255; *(v4u*)((bf16*)(F.ws + WS_VTC) + ((size_t)(b * 4 + kvh) * 64 + d) * CTXL + t0 + c * 8) = o; } }
    }
    __syncthreads();
}

constexpr int AT_KP = 144, AT_VP = 136;
constexpr int AT_KOFF = 0, AT_VOFF = 64 * AT_KP, AT_TILE = 64 * AT_KP + 64 * AT_VP;
__device__ __forceinline__ void attn_unit(Frame& F, int l, int b, int kvh, int qi, int is_ctx) {
    const bf16* P = (const bf16*)(F.ws + WS_P); bf16* CC = (bf16*)(F.ws + WS_CC);
    int lane_o = F.lane; asm volatile("" : "+v"(lane_o));
    const int g = F.wave >> 1, qh = F.wave & 1, hq = kvh * 4 + g, r32 = lane_o & 31, hi = lane_o >> 5;
    const int rowbase = is_ctx ? NLAT + b * CTXL : b * SEQ;
    const int qa = qi * 128 + qh * 64;
    const float LOG2E = 1.4426950408889634f;
    bf16x8 qf[2][4];
#pragma unroll
    for (int qt = 0; qt < 2; ++qt) { const int tq = qa + 32 * qt + r32; const bf16* qp = P + (size_t)(rowbase + tq) * PW + PC_Q + hq * 64 + 8 * hi;
        float x[4][8];
#pragma unroll
        for (int s = 0; s < 4; ++s) { const v4u w = *(const v4u*)(qp + 16 * s); x[s][0] = bflo(w.x); x[s][1] = bfhi(w.x); x[s][2] = bflo(w.y); x[s][3] = bfhi(w.y); x[s][4] = bflo(w.z); x[s][5] = bfhi(w.z); x[s][6] = bflo(w.w); x[s][7] = bfhi(w.w); }
        if (!is_ctx) {
#pragma unroll
            for (int hf = 0; hf < 2; ++hf) { const float pos = (float)(hf ? (tq & 63) : (tq >> 6));
#pragma unroll
                for (int j = 0; j < 8; ++j) { const float inv = __builtin_amdgcn_exp2f(-(float)(8 * hi + j) * 0.8304820237218406f); const float sn = __sinf(pos * inv), cs = __cosf(pos * inv);
                    const float x1 = x[2 * hf][j], x2 = x[2 * hf + 1][j]; x[2 * hf][j] = x1 * cs - x2 * sn; x[2 * hf + 1][j] = x2 * cs + x1 * sn; } } }
        const float sc = 0.125f * LOG2E;
#pragma unroll
        for (int s = 0; s < 4; ++s) { v4u w; w.x = pk2(x[s][0] * sc, x[s][1] * sc); w.y = pk2(x[s][2] * sc, x[s][3] * sc); w.z = pk2(x[s][4] * sc, x[s][5] * sc); w.w = pk2(x[s][6] * sc, x[s][7] * sc); qf[qt][s] = __builtin_bit_cast(bf16x8, w); }
    }
    float mrun[2], lrun[2]; f32x16 O[2][2];
    { const float sk = F.in[I_SINK][l * 16 + hq] * LOG2E;
#pragma unroll
      for (int qt = 0; qt < 2; ++qt) { mrun[qt] = sk; lrun[qt] = hi ? 0.f : 1.f;
#pragma unroll
        for (int db = 0; db < 2; ++db)
#pragma unroll
            for (int r = 0; r < 16; ++r) O[qt][db][r] = 0.f; } }
    const int kt_lo = is_ctx ? 0 : (qi == 0 ? 2 : 0), nl = is_ctx ? 0 : (6 - (qi == 0 ? 2 : 0) - (qi == 31 ? 2 : 0)), ntile = nl + 4;
    const int rr = F.tid >> 3, cch = F.tid & 7;
    const bf16* kbase_l = P + (size_t)(b * SEQ + rr) * PW + PC_K + kvh * 64 + cch * 8; const bf16* kbase_c = P + (size_t)(NLAT + b * CTXL + rr) * PW + PC_K + kvh * 64 + cch * 8;
    const bf16* vbase_l = (const bf16*)(F.ws + WS_VT) + ((size_t)(b * 4 + kvh) * 64 + rr) * SEQ + cch * 8; const bf16* vbase_c = (const bf16*)(F.ws + WS_VTC) + ((size_t)(b * 4 + kvh) * 64 + rr) * CTXL + cch * 8;
    v4u kw, vw;
    { const bool loc0 = nl > 0; const int k00 = loc0 ? 128 * (qi - 1) + 64 * kt_lo : 0; kw = *(const v4u*)((loc0 ? kbase_l : kbase_c) + (size_t)k00 * PW); vw = *(const v4u*)((loc0 ? vbase_l : vbase_c) + k00); }
    LDS_BARRIER();
#pragma unroll 1
    for (int jt = 0; jt < ntile; ++jt) {
        const bool local = jt < nl; const int k0 = local ? 128 * (qi - 1) + 64 * (kt_lo + jt) : 64 * (jt - nl);
        const LAS unsigned char* KS = F.lds + (jt & 1) * AT_TILE + AT_KOFF; const LAS unsigned char* VS = F.lds + (jt & 1) * AT_TILE + AT_VOFF;
        { *(LAS v4u*)(F.lds + (jt & 1) * AT_TILE + AT_KOFF + rr * AT_KP + cch * 16) = kw;
          LAS v2u* vd = (LAS v2u*)(F.lds + (jt & 1) * AT_TILE + AT_VOFF + rr * AT_VP + cch * 16); vd[0] = (v2u){vw.x, vw.y}; vd[1] = (v2u){vw.z, vw.w}; }
        if (jt + 1 < ntile) { const bool ln = jt + 1 < nl; const int kn = ln ? 128 * (qi - 1) + 64 * (kt_lo + jt + 1) : 64 * (jt + 1 - nl);
            kw = *(const v4u*)((ln ? kbase_l : kbase_c) + (size_t)kn * PW); vw = *(const v4u*)((ln ? vbase_l : vbase_c) + kn); }
        LDS_BARRIER();
        if (local && (k0 + 63 < qa - 128 || k0 > qa + 63 + 128)) continue;
#pragma unroll 1
        for (int kb = 0; kb < 2; ++kb) {
            bf16x8 kf[4];
#pragma unroll
            for (int ss = 0; ss < 4; ++ss) kf[ss] = *(const LAS bf16x8*)(KS + (32 * kb + r32) * AT_KP + (16 * ss + 8 * hi) * 2);
            bf16x8 pb[2][2];
#pragma unroll
            for (int qt = 0; qt < 2; ++qt) { const int tq = qa + 32 * qt + r32;
                f32x16 s;
#pragma unroll
                for (int r = 0; r < 16; ++r) s[r] = 0.f;
#pragma unroll
                for (int ss = 0; ss < 4; ++ss) s = __builtin_amdgcn_mfma_f32_32x32x16_bf16(kf[ss], qf[qt][ss], s, 0, 0, 0);
                if (local) {
#pragma unroll
                    for (int r = 0; r < 16; ++r) { const int kidx = k0 + 32 * kb + (r & 3) + 8 * (r >> 2) + 4 * hi; const int dlt = kidx - tq; if (dlt > 128 || dlt < -128) s[r] = -1.0e30f; } }
                float mloc = s[0];
#pragma unroll
                for (int r = 1; r < 16; ++r) mloc = fmaxf(mloc, s[r]);
                mloc = fmaxf(mloc, __shfl_xor(mloc, 32));
                const float mnew = fmaxf(mrun[qt], mloc), alpha = __builtin_amdgcn_exp2f(mrun[qt] - mnew); mrun[qt] = mnew;
                float psum = 0.f;
#pragma unroll
                for (int r = 0; r < 16; ++r) { s[r] = __builtin_amdgcn_exp2f(s[r] - mnew); psum += s[r]; }
                lrun[qt] = lrun[qt] * alpha + psum;
#pragma unroll
                for (int db = 0; db < 2; ++db)
#pragma unroll
                    for (int r = 0; r < 16; ++r) O[qt][db][r] *= alpha;
#pragma unroll
                for (int s2 = 0; s2 < 2; ++s2) { v4u pw; pw.x = pk2(s[8 * s2 + 0], s[8 * s2 + 1]); pw.y = pk2(s[8 * s2 + 2], s[8 * s2 + 3]); pw.z = pk2(s[8 * s2 + 4], s[8 * s2 + 5]); pw.w = pk2(s[8 * s2 + 6], s[8 * s2 + 7]);
                    pb[qt][s2] = __builtin_bit_cast(bf16x8, pw); }
            }
#pragma unroll
            for (int s2 = 0; s2 < 2; ++s2)
#pragma unroll
                for (int db = 0; db < 2; ++db) { const LAS v2u* vp = (const LAS v2u*)(VS + (32 * db + r32) * AT_VP + (32 * kb + 16 * s2 + 4 * hi) * 2);
                    const v2u a0 = vp[0], a1 = vp[2]; v4u aw; aw.x = a0.x; aw.y = a0.y; aw.z = a1.x; aw.w = a1.y; const bf16x8 va = __builtin_bit_cast(bf16x8, aw);
                    O[0][db] = __builtin_amdgcn_mfma_f32_32x32x16_bf16(va, pb[0][s2], O[0][db], 0, 0, 0);
                    O[1][db] = __builtin_amdgcn_mfma_f32_32x32x16_bf16(va, pb[1][s2], O[1][db], 0, 0, 0); }
        }
    }
    int r32e = r32, hie = hi; asm volatile("" : "+v"(r32e), "+v"(hie));
#pragma unroll
    for (int qt = 0; qt < 2; ++qt) { const float lt = lrun[qt] + __shfl_xor(lrun[qt], 32); const float rl = 1.0f / lt; const int tq = qa + 32 * qt + r32e;
#if FP8_OUTPROJ
        unsigned char* op8 = (unsigned char*)CC + (size_t)(rowbase + tq) * DM + hq * 64 + 4 * hie;
#pragma unroll
        for (int db = 0; db < 2; ++db)
#pragma unroll
            for (int rq = 0; rq < 4; ++rq) *(unsigned*)(op8 + 32 * db + 8 * rq) = pk4_fp8(O[qt][db][4 * rq] * rl, O[qt][db][4 * rq + 1] * rl, O[qt][db][4 * rq + 2] * rl, O[qt][db][4 * rq + 3] * rl); }
#else
        bf16* op = CC + (size_t)(rowbase + tq) * DM + hq * 64 + 4 * hie;
#pragma unroll
        for (int db = 0; db < 2; ++db)
#pragma unroll
            for (int rq = 0; rq < 4; ++rq) { v2u w; w.x = pk2(O[qt][db][4 * rq] * rl, O[qt][db][4 * rq + 1] * rl); w.y = pk2(O[qt][db][4 * rq + 2] * rl, O[qt][db][4 * rq + 3] * rl);
                *(v2u*)(op + 32 * db + 8 * rq) = w; } }
#endif
}
__device__ __forceinline__ void attn_phase(Frame& F, int l, int rep = 0) {
    const int nunits = 512 + (l == 0 ? 32 : 0);
    LAS int* slot = (LAS int*)(F.lds + LDS_X_OFF + 512);
    for (;;) {
        __syncthreads();
        if (F.tid == 0) *slot = (int)__hip_atomic_fetch_add(F.ctl + CW_ATQ + 64 * l + 8 * rep, 1u, RLX_AGENT);
        __syncthreads();
        const int u = __builtin_amdgcn_readfirstlane(*slot);
        if (u >= nunits) break;
        if (u < 512) attn_unit(F, l, u >> 7, (u >> 5) & 3, u & 31, 0); else { const int v = u - 512; attn_unit(F, l, v >> 3, (v >> 1) & 3, v & 1, 1); }
    }
}
#define USE_CHUNK_DN 1
#ifndef DN_SPLIT
#define DN_SPLIT 1
#endif
#ifndef DN_REP_S1
#define DN_REP_S1 1
#endif
#ifndef DN_REP_S3B
#define DN_REP_S3B 1
#endif
#ifndef DN_REP_S3A
#define DN_REP_S3A 1
#endif
#ifndef DN_REP_S4
#define DN_REP_S4 1
#endif

constexpr int DN_F_NEGW = 0, DN_F_QG = 16, DN_F_QK = 32, DN_F_KGT = 40, DN_NFRAG = 56, DN_U_OFF = 57344;
constexpr int DP_QS = 0, DP_KS = 17408, DP_VS = 34816, DP_AS = 52224  , DP_TB = 69632, DP_TW = 78848, DP_QK = 88064, DP_RAW = 52224  , DP_SC = 104960, DP_TF = 106496  , DP_XS = 123904  ;
constexpr int DP_P = 272, DP_P2 = 144;
__device__ __forceinline__ int dn_rec(int b, int h, int dir, int np) { return ((b * 4 + h) * 2 + dir) * 68 + np; }
__device__ __forceinline__ void dn_chunk_of(int ct, int dir, int& b, int& np) { if (ct < 256) { b = ct >> 6; const int c = ct & 63; np = 4 + (dir ? 63 - c : c); } else { b = (ct - 256) >> 2; const int c = (ct - 256) & 3; np = dir ? 3 - c : c; } }
__device__ __forceinline__ unsigned short lds_u16(const LAS unsigned char* p) { return *(const LAS unsigned short*)p; }

__device__ __forceinline__ void dn_prep_unit(Frame& F, int l, int ct, int h, int dir) {
    const bf16* P = (const bf16*)(F.ws + WS_P);
    int lane = F.lane; asm volatile("" : "+v"(lane));
    const int wave = F.wave, i16 = lane & 15, q = lane >> 4;
    const int m0 = ct * 64; int t0, T, base; seq_of(m0, t0, T, base);
    int b, np; dn_chunk_of(ct, dir, b, np);
    unsigned char* tile = F.ws + WS_DNT + (size_t)dn_rec(b, h, dir, np) * DNT_BYTES;
    LAS unsigned char* L = F.lds;
    LAS float* SC = (LAS float*)(L + DP_SC);
    LDS_BARRIER();
    {
        const float* cw = F.in[I_DNCW] + (size_t)l * 4 * 1536;
        LAS float* cwl = (LAS float*)(L + DP_TF);
        float cw3[3];
#pragma unroll
        for (int k = 0; k < 3; ++k) { const int i = F.tid + k * NTHREADS, part = i >> 9, j = (i >> 7) & 3, ch = i & 127; cw3[k] = cw[j * 1536 + part * 512 + h * 128 + ch]; }
        unsigned short pbw = 0, paw = 0;
        if (wave == 0) { const int tok = dir ? 63 - lane : lane; pbw = P[(size_t)(m0 + tok) * PW + PC_BETA + dir * 4 + h]; paw = P[(size_t)(m0 + tok) * PW + PC_DEC + dir * 4 + h]; }
        v4u rv[7];
#pragma unroll
        for (int k = 0; k < 7; ++k) { const int c = F.tid + k * NTHREADS, row = c / 48, ch = c % 48, part = ch >> 4, cc = ch & 15, tt = t0 + row - 2;
            rv[k] = (v4u){0u, 0u, 0u, 0u};
            if (c < 67 * 48 && tt >= 0 && tt < T) rv[k] = *(const v4u*)(P + (size_t)(base + tt) * PW + PC_DQ + part * 512 + h * 128 + cc * 8); }
        asm volatile("" : "+v"(cw3[0]), "+v"(cw3[1]), "+v"(cw3[2]), "+v"(rv[0]), "+v"(rv[1]), "+v"(rv[2]), "+v"(rv[3]), "+v"(rv[4]), "+v"(rv[5]), "+v"(rv[6]));
#pragma unroll
        for (int k = 0; k < 3; ++k) cwl[F.tid + k * NTHREADS] = cw3[k];
#pragma unroll
        for (int k = 0; k < 7; ++k) { const int c = F.tid + k * NTHREADS, row = c / 48, ch = c % 48, part = ch >> 4, cc = ch & 15;
            if (c < 67 * 48) *(LAS v4u*)(L + DP_RAW + row * 784 + part * 256 + cc * 16) = rv[k]; }
        LDS_BARRIER();
#pragma unroll 1
        for (int rep = 0; rep < DN_REP_S1; ++rep)
#pragma unroll
        for (int part = 0; part < 3; ++part) { const int tok = F.tid >> 3, g8 = F.tid & 7;
            float sv[16];
#pragma unroll
            for (int k = 0; k < 16; ++k) sv[k] = 0.f;
#pragma unroll
            for (int j = 0; j < 4; ++j) { const LAS v4u* rp = (const LAS v4u*)(L + DP_RAW + (tok + j) * 784 + part * 256 + g8 * 32); const v4u r0 = rp[0], r1 = rp[1];
                const LAS f32x4* wp = (const LAS f32x4*)(cwl + (part * 4 + j) * 128 + g8 * 16); const f32x4 w0 = wp[0], w1 = wp[1], w2 = wp[2], w3 = wp[3];
                sv[0] += w0.x * bflo(r0.x); sv[1] += w0.y * bfhi(r0.x); sv[2] += w0.z * bflo(r0.y); sv[3] += w0.w * bfhi(r0.y); sv[4] += w1.x * bflo(r0.z); sv[5] += w1.y * bfhi(r0.z); sv[6] += w1.z * bflo(r0.w); sv[7] += w1.w * bfhi(r0.w);
                sv[8] += w2.x * bflo(r1.x); sv[9] += w2.y * bfhi(r1.x); sv[10] += w2.z * bflo(r1.y); sv[11] += w2.w * bfhi(r1.y); sv[12] += w3.x * bflo(r1.z); sv[13] += w3.y * bfhi(r1.z); sv[14] += w3.z * bflo(r1.w); sv[15] += w3.w * bfhi(r1.w); }
            float ss = 0.f;
#pragma unroll
            for (int k = 0; k < 16; ++k) { sv[k] = siluf_(sv[k]); ss += sv[k] * sv[k]; }
            if (part < 2) { ss += dpp_mov<0xB1>(ss); ss += dpp_mov<0x4E>(ss); ss += dpp_mov<0x141>(ss);
                const float f = (part == 0 ? 0.08838834764831845f : 1.0f) * __builtin_amdgcn_rsqf(ss + EPS);
#pragma unroll
                for (int k = 0; k < 16; ++k) sv[k] *= f; }
            LAS v4u* op = (LAS v4u*)(L + (part == 0 ? DP_QS : (part == 1 ? DP_KS : DP_VS)) + tok * DP_P + g8 * 32);
            op[0] = (v4u){pk2(sv[0], sv[1]), pk2(sv[2], sv[3]), pk2(sv[4], sv[5]), pk2(sv[6], sv[7])}; op[1] = (v4u){pk2(sv[8], sv[9]), pk2(sv[10], sv[11]), pk2(sv[12], sv[13]), pk2(sv[14], sv[15])}; }
        if (wave == 0) {
            const float pb = bf2f(pbw), pa = bf2f(paw);
            const float beta = sigmoidf_(pb); float gc = -__expf(F.in[I_DNALOG][l * 8 + dir * 4 + h]) * softplusf_(pa + F.in[I_DNDT][l * 8 + dir * 4 + h]);
#pragma unroll
            for (int o = 1; o < 64; o <<= 1) { const float v = __shfl_up(gc, o); if (lane >= o) gc += v; }
            const float glast = __shfl(gc, 63);
            SC[lane] = beta; SC[64 + lane] = gc; SC[128 + lane] = __expf(gc); SC[192 + lane] = __expf(glast - gc);
            if (lane == 63) ((float*)(F.ws + WS_DNS))[dn_rec(b, h, dir, np)] = __expf(glast);
        }
    }
    LDS_BARRIER();
#define DN_TOK(r) (dir ? 63 - (r) : (r))
#pragma unroll 1
    for (int rep = 0; rep < DN_REP_S3A; ++rep)
    {
        const int mb = wave & 3, which = wave >> 2;
        f32x4 acc[4];
#pragma unroll
        for (int nb = 0; nb < 4; ++nb) acc[nb] = (f32x4){0.f, 0.f, 0.f, 0.f};
        const LAS unsigned char* arow = L + (which ? DP_QS : DP_KS) + DN_TOK(16 * mb + i16) * DP_P + 16 * q;
#pragma unroll
        for (int ks = 0; ks < 4; ++ks) { bf16x8 a = *(const LAS bf16x8*)(arow + 64 * ks); bf16x8 bb[4];
#pragma unroll
            for (int nb = 0; nb < 4; ++nb) bb[nb] = *(const LAS bf16x8*)(L + DP_KS + DN_TOK(16 * nb + i16) * DP_P + 16 * q + 64 * ks);
            asm volatile("" : "+v"(a), "+v"(bb[0]), "+v"(bb[1]), "+v"(bb[2]), "+v"(bb[3]));
#pragma unroll
            for (int nb = 0; nb < 4; ++nb) acc[nb] = __builtin_amdgcn_mfma_f32_16x16x32_bf16(a, bb[nb], acc[nb], 0, 0, 0); }
#pragma unroll
        for (int nb = 0; nb < 4; ++nb)
#pragma unroll
            for (int i = 0; i < 4; ++i) { const int r = 16 * mb + 4 * q + i, c = 16 * nb + i16; const float dec = __expf(SC[64 + r] - SC[64 + c]);
                if (which == 0) ((LAS float*)(L + DP_AS))[r * 68 + c] = (r > c) ? SC[r] * acc[nb][i] * dec : 0.f;
                else *(LAS unsigned short*)(L + DP_QK + r * DP_P2 + c * 2) = (unsigned short)f2bf((r >= c) ? acc[nb][i] * dec : 0.f); }
    }
    LDS_BARRIER();
#define DN_EMIT_FRAG(f_) do { const int fx_ = (f_); v4u o; \
        if (fx_ < DN_F_QG) { const int mb = fx_ >> 2, ks = fx_ & 3; const LAS unsigned char* rp = L + DP_AS + (16 * mb + i16) * DP_P + (32 * ks + 4 * q) * 2; \
            const v2u a = *(const LAS v2u*)rp, c = *(const LAS v2u*)(rp + 32); o.x = a.x; o.y = a.y; o.z = c.x; o.w = c.y; } \
        else if (fx_ < DN_F_QK) { const int ff = fx_ - DN_F_QG, mb = ff >> 2, ks = ff & 3, r = 16 * mb + i16; const LAS unsigned char* rp = L + DP_QS + DN_TOK(r) * DP_P + (32 * ks + 4 * q) * 2; const float eg = SC[128 + r]; \
            const v2u a = *(const LAS v2u*)rp, c = *(const LAS v2u*)(rp + 32); \
            o.x = pk2(bflo(a.x) * eg, bfhi(a.x) * eg); o.y = pk2(bflo(a.y) * eg, bfhi(a.y) * eg); o.z = pk2(bflo(c.x) * eg, bfhi(c.x) * eg); o.w = pk2(bflo(c.y) * eg, bfhi(c.y) * eg); } \
        else if (fx_ < DN_F_KGT) { const int ff = fx_ - DN_F_QK, mb = ff >> 1, ks = ff & 1; const LAS unsigned char* rp = L + DP_QK + (16 * mb + i16) * DP_P2 + (32 * ks + 4 * q) * 2; \
            const v2u a = *(const LAS v2u*)rp, c = *(const LAS v2u*)(rp + 32); o.x = a.x; o.y = a.y; o.z = c.x; o.w = c.y; } \
        else { const int ff = fx_ - DN_F_KGT, mb = ff >> 1, ks = ff & 1, dk = 16 * mb + i16; float e[8]; \
            _Pragma("unroll") for (int jj = 0; jj < 8; ++jj) { const int key = 32 * ks + 16 * (jj >> 2) + 4 * q + (jj & 3); e[jj] = bf2f(lds_u16(L + DP_KS + DN_TOK(key) * DP_P + dk * 2)) * SC[192 + key]; } \
            o.x = pk2(e[0], e[1]); o.y = pk2(e[2], e[3]); o.z = pk2(e[4], e[5]); o.w = pk2(e[6], e[7]); } \
        *(v4u*)(tile + (size_t)fx_ * 1024 + lane * 16) = o; } while (0)
#pragma unroll 1
    for (int rep = 0; rep < DN_REP_S3B; ++rep) {
    if (wave == 0) {
        const LAS float* As = (const LAS float*)(L + DP_AS); LAS float* Tf = (LAS float*)(L + DP_TF);
        const int g = lane >> 4, c = lane & 15;
        f32x4 ar[16][4];
#pragma unroll
        for (int r = 1; r < 16; ++r)
#pragma unroll
            for (int j4 = 0; j4 < (r + 3) / 4; ++j4) ar[r][j4] = *(const LAS f32x4*)(As + (16 * g + r) * 68 + 16 * g + 4 * j4);
        float t[16];
#pragma unroll
        for (int r = 0; r < 16; ++r) { float a0 = (c == r) ? 1.f : 0.f, a1 = 0.f;
#pragma unroll
            for (int j = 0; j < r; ++j) { const float av = ar[r][j >> 2][j & 3]; if (j & 1) a1 -= av * t[j]; else a0 -= av * t[j]; }
            t[r] = a0 + a1; Tf[(16 * g + r) * 68 + 16 * g + c] = t[r]; }
    } else if (rep == 0) {
#pragma unroll 1
        for (int fi = 0; fi < 3; ++fi) DN_EMIT_FRAG(16 + (wave - 1) * 3 + fi);
    }
    LDS_BARRIER();
    if (wave < 3) {
        const LAS float* As = (const LAS float*)(L + DP_AS); LAS float* Tf = (LAS float*)(L + DP_TF); LAS float* Xs = (LAS float*)(L + DP_XS) + wave * 272;
        const int J = wave;
#pragma unroll 1
        for (int I = J + 1; I < 4; ++I) {
            f32x4 acc = {0.f, 0.f, 0.f, 0.f};
#pragma unroll 1
            for (int K = J; K < I; ++K) { float av[4], tv[4];
#pragma unroll
                for (int sk = 0; sk < 4; ++sk) { av[sk] = As[(16 * I + i16) * 68 + 16 * K + 4 * sk + q]; tv[sk] = Tf[(16 * K + 4 * sk + q) * 68 + 16 * J + i16]; }
                asm volatile("" : "+v"(av[0]), "+v"(av[1]), "+v"(av[2]), "+v"(av[3]), "+v"(tv[0]), "+v"(tv[1]), "+v"(tv[2]), "+v"(tv[3]));
#pragma unroll
                for (int sk = 0; sk < 4; ++sk) acc = __builtin_amdgcn_mfma_f32_16x16x4f32(av[sk], tv[sk], acc, 0, 0, 0); }
#pragma unroll
            for (int i = 0; i < 4; ++i) Xs[(4 * q + i) * 17 + i16] = acc[i];
            LDS_WAIT(); asm volatile("" ::: "memory");
            f32x4 acc2 = {0.f, 0.f, 0.f, 0.f}; float tv2[4], xv[4];
#pragma unroll
            for (int sk = 0; sk < 4; ++sk) { tv2[sk] = Tf[(16 * I + i16) * 68 + 16 * I + 4 * sk + q]; xv[sk] = Xs[(4 * sk + q) * 17 + i16]; }
            asm volatile("" : "+v"(tv2[0]), "+v"(tv2[1]), "+v"(tv2[2]), "+v"(tv2[3]), "+v"(xv[0]), "+v"(xv[1]), "+v"(xv[2]), "+v"(xv[3]));
#pragma unroll
            for (int sk = 0; sk < 4; ++sk) acc2 = __builtin_amdgcn_mfma_f32_16x16x4f32(tv2[sk], xv[sk], acc2, 0, 0, 0);
#pragma unroll
            for (int i = 0; i < 4; ++i) Tf[(16 * I + 4 * q + i) * 68 + 16 * J + i16] = -acc2[i];
            LDS_WAIT(); asm volatile("" ::: "memory");
        }
    } else if (rep == 0) {
#pragma unroll 1
        for (int fi = 0; fi < 4; ++fi) { const int f = 37 + (wave - 3) * 4 + fi; if (f < DN_NFRAG) DN_EMIT_FRAG(f); }
    }
    LDS_BARRIER();
    { const LAS float* Tf = (const LAS float*)(L + DP_TF); const int r = F.tid >> 3, c0 = (F.tid & 7) * 8; float vb[8], vw[8];
#pragma unroll
      for (int k = 0; k < 8; ++k) { const int c = c0 + k; const float v = ((r >> 4) >= (c >> 4)) ? Tf[r * 68 + c] : 0.f; const float bl = SC[c]; vb[k] = v * bl; vw[k] = vb[k] * SC[128 + c]; }
      v4u ob, ow; ob.x = pk2(vb[0], vb[1]); ob.y = pk2(vb[2], vb[3]); ob.z = pk2(vb[4], vb[5]); ob.w = pk2(vb[6], vb[7]); ow.x = pk2(vw[0], vw[1]); ow.y = pk2(vw[2], vw[3]); ow.z = pk2(vw[4], vw[5]); ow.w = pk2(vw[6], vw[7]);
      *(LAS v4u*)(L + DP_TB + r * DP_P2 + c0 * 2) = ob; *(LAS v4u*)(L + DP_TW + r * DP_P2 + c0 * 2) = ow; }
    }
    LDS_BARRIER();
    {
        const int nbp = wave & 3, which = wave >> 2;
        f32x4 acc[4][2];
#pragma unroll
        for (int mb = 0; mb < 4; ++mb) { acc[mb][0] = (f32x4){0.f, 0.f, 0.f, 0.f}; acc[mb][1] = (f32x4){0.f, 0.f, 0.f, 0.f}; }
#pragma unroll
        for (int ks = 0; ks < 2; ++ks) {
            bf16x8 bb[2];
#pragma unroll
            for (int nn = 0; nn < 2; ++nn) { const int n = 16 * (2 * nbp + nn) + i16; unsigned short e[8];
#pragma unroll
                for (int jj = 0; jj < 8; ++jj) e[jj] = lds_u16(L + (which ? DP_KS : DP_VS) + DN_TOK(32 * ks + 8 * q + jj) * DP_P + n * 2);
                v4u w; w.x = e[0] | ((unsigned)e[1] << 16); w.y = e[2] | ((unsigned)e[3] << 16); w.z = e[4] | ((unsigned)e[5] << 16); w.w = e[6] | ((unsigned)e[7] << 16); bb[nn] = __builtin_bit_cast(bf16x8, w); }
            bf16x8 a4[4];
#pragma unroll
            for (int mb = 0; mb < 4; ++mb) a4[mb] = *(const LAS bf16x8*)(L + (which ? DP_TW : DP_TB) + (16 * mb + i16) * DP_P2 + 64 * ks + 16 * q);
            asm volatile("" : "+v"(a4[0]), "+v"(a4[1]), "+v"(a4[2]), "+v"(a4[3]), "+v"(bb[0]), "+v"(bb[1]));
#pragma unroll
            for (int mb = 0; mb < 4; ++mb) { acc[mb][0] = __builtin_amdgcn_mfma_f32_16x16x32_bf16(a4[mb], bb[0], acc[mb][0], 0, 0, 0); acc[mb][1] = __builtin_amdgcn_mfma_f32_16x16x32_bf16(a4[mb], bb[1], acc[mb][1], 0, 0, 0); } }
        if (which == 0) {
#pragma unroll
            for (int mb = 0; mb < 4; ++mb)
#pragma unroll
                for (int nn = 0; nn < 2; ++nn) *(f32x4*)(tile + DN_U_OFF + (size_t)((((2 * nbp + nn) * 4 + mb) * 64 + lane) * 16)) = acc[mb][nn];
        } else {
#pragma unroll
            for (int mb = 0; mb < 4; ++mb)
#pragma unroll
                for (int nn = 0; nn < 2; ++nn)
#pragma unroll
                    for (int i = 0; i < 4; ++i) *(LAS unsigned short*)(L + DP_AS + (16 * mb + 4 * q + i) * DP_P + (16 * (2 * nbp + nn) + i16) * 2) = (unsigned short)f2bf(-acc[mb][nn][i]);
        }
    }
    LDS_BARRIER();
#pragma unroll 1
    for (int fi = 0; fi < 2; ++fi) { const int f = wave * 2 + fi; DN_EMIT_FRAG(f); }
#undef DN_EMIT_FRAG
#undef DN_TOK
}
__device__ __forceinline__ void dn_prep(Frame& F, int l) {
    for (int u = F.bid; u < NCT * 4 * 2; u += F.G) dn_prep_unit(F, l, u >> 3, (u >> 1) & 3, u & 1);
    __syncthreads();
}

__device__ __forceinline__ void dn_scan(Frame& F, int l, int b, int h, int dir, int half) {
    int lane = F.lane; asm volatile("" : "+v"(lane));
    const int w = (DN_SPLIT == 2) ? half * 4 + (F.wave & 3) : F.wave, i16 = lane & 15, q = lane >> 4; const bool active = (DN_SPLIT == 2) ? (F.wave < 4) : true;
    const unsigned char* tiles = F.ws + WS_DNT + (size_t)dn_rec(b, h, dir, 0) * DNT_BYTES;
    const float* egl = (const float*)(F.ws + WS_DNS) + dn_rec(b, h, dir, 0);
    bf16* Ob = (bf16*)(F.ws + WS_DNO);
    LAS unsigned char* L = F.lds;
    f32x4 S[8];
#pragma unroll
    for (int i = 0; i < 8; ++i) S[i] = (f32x4){0.f, 0.f, 0.f, 0.f};
    v4u st[7]; f32x4 un[4];
#pragma unroll
    for (int mb = 0; mb < 4; ++mb) un[mb] = *(const f32x4*)(tiles + DN_U_OFF + (size_t)(((w * 4 + mb) * 64 + lane) * 16));
    LDS_BARRIER();
#pragma unroll
    for (int i = 0; i < 7; ++i) st[i] = *(const v4u*)(tiles + (size_t)(F.tid + i * NTHREADS) * 16);
#pragma unroll
    for (int i = 0; i < 7; ++i) *(LAS v4u*)(L + (F.tid + i * NTHREADS) * 16) = st[i];
#pragma unroll
    for (int i = 0; i < 7; ++i) st[i] = *(const v4u*)(tiles + DNT_BYTES + (size_t)(F.tid + i * NTHREADS) * 16);
    LDS_BARRIER();
#pragma unroll 1
    for (int n = 0; n < 68; ++n) {
        const unsigned char* tile = tiles + (size_t)n * DNT_BYTES; const LAS unsigned char* cur = L + (n & 1) * 57344;
        if (n + 1 < 68) {
#pragma unroll
            for (int i = 0; i < 7; ++i) *(LAS v4u*)(L + ((n + 1) & 1) * 57344 + (F.tid + i * NTHREADS) * 16) = st[i]; }
        if (n + 2 < 68) {
#pragma unroll
            for (int i = 0; i < 7; ++i) st[i] = *(const v4u*)(tile + 2 * DNT_BYTES + (size_t)(F.tid + i * NTHREADS) * 16); }
        if (active) {
        f32x4 vn[4];
#pragma unroll
        for (int mb = 0; mb < 4; ++mb) vn[mb] = un[mb];
        if (n + 1 < 68) {
#pragma unroll
            for (int mb = 0; mb < 4; ++mb) un[mb] = *(const f32x4*)(tile + DNT_BYTES + DN_U_OFF + (size_t)(((w * 4 + mb) * 64 + lane) * 16)); }
        const float el = egl[n];
        bf16x8 bS[4];
#pragma unroll
        for (int ks = 0; ks < 4; ++ks) { v4u x; x.x = pk2(S[2 * ks][0], S[2 * ks][1]); x.y = pk2(S[2 * ks][2], S[2 * ks][3]); x.z = pk2(S[2 * ks + 1][0], S[2 * ks + 1][1]); x.w = pk2(S[2 * ks + 1][2], S[2 * ks + 1][3]); bS[ks] = __builtin_bit_cast(bf16x8, x); }
        f32x4 o[4];
#pragma unroll
        for (int mb = 0; mb < 4; ++mb) { o[mb] = (f32x4){0.f, 0.f, 0.f, 0.f};
            bf16x8 aw[4], aq[4];
#pragma unroll
            for (int ks = 0; ks < 4; ++ks) { aw[ks] = *(const LAS bf16x8*)(cur + (DN_F_NEGW + mb * 4 + ks) * 1024 + lane * 16); aq[ks] = *(const LAS bf16x8*)(cur + (DN_F_QG + mb * 4 + ks) * 1024 + lane * 16); }
            asm volatile("" : "+v"(aw[0]), "+v"(aw[1]), "+v"(aw[2]), "+v"(aw[3]), "+v"(aq[0]), "+v"(aq[1]), "+v"(aq[2]), "+v"(aq[3]));
#pragma unroll
            for (int ks = 0; ks < 4; ++ks) { vn[mb] = __builtin_amdgcn_mfma_f32_16x16x32_bf16(aw[ks], bS[ks], vn[mb], 0, 0, 0); o[mb] = __builtin_amdgcn_mfma_f32_16x16x32_bf16(aq[ks], bS[ks], o[mb], 0, 0, 0); } }
        bf16x8 bV[2];
#pragma unroll
        for (int ks = 0; ks < 2; ++ks) { v4u x; x.x = pk2(vn[2 * ks][0], vn[2 * ks][1]); x.y = pk2(vn[2 * ks][2], vn[2 * ks][3]); x.z = pk2(vn[2 * ks + 1][0], vn[2 * ks + 1][1]); x.w = pk2(vn[2 * ks + 1][2], vn[2 * ks + 1][3]); bV[ks] = __builtin_bit_cast(bf16x8, x); }
#pragma unroll
        for (int g4 = 0; g4 < 2; ++g4) { bf16x8 ak[8];
#pragma unroll
            for (int i = 0; i < 8; ++i) ak[i] = *(const LAS bf16x8*)(cur + (DN_F_KGT + g4 * 8 + i) * 1024 + lane * 16);
            asm volatile("" : "+v"(ak[0]), "+v"(ak[1]), "+v"(ak[2]), "+v"(ak[3]), "+v"(ak[4]), "+v"(ak[5]), "+v"(ak[6]), "+v"(ak[7]));
#pragma unroll
            for (int i = 0; i < 8; ++i) { const int mb = g4 * 4 + (i >> 1), ks = i & 1; if (ks == 0) S[mb] = S[mb] * el; S[mb] = __builtin_amdgcn_mfma_f32_16x16x32_bf16(ak[i], bV[ks], S[mb], 0, 0, 0); } }
        { bf16x8 aqk[8];
#pragma unroll
          for (int i = 0; i < 8; ++i) aqk[i] = *(const LAS bf16x8*)(cur + (DN_F_QK + i) * 1024 + lane * 16);
          asm volatile("" : "+v"(aqk[0]), "+v"(aqk[1]), "+v"(aqk[2]), "+v"(aqk[3]), "+v"(aqk[4]), "+v"(aqk[5]), "+v"(aqk[6]), "+v"(aqk[7]));
#pragma unroll
          for (int i = 0; i < 8; ++i) o[i >> 1] = __builtin_amdgcn_mfma_f32_16x16x32_bf16(aqk[i], bV[i & 1], o[i >> 1], 0, 0, 0); }
        { int m0; if (n < 4) m0 = NLAT + b * CTXL + 64 * (dir ? 3 - n : n); else m0 = b * SEQ + 64 * (dir ? 63 - (n - 4) : (n - 4));
#pragma unroll
          for (int mb = 0; mb < 4; ++mb)
#pragma unroll
            for (int i = 0; i < 4; ++i) { const int r = 16 * mb + 4 * q + i, tok = dir ? 63 - r : r; Ob[((size_t)dir * NTOK + m0 + tok) * 512 + h * 128 + 16 * w + i16] = (bf16)f2bf(o[mb][i]); } }
        }
        LDS_BARRIER();
    }
}
#define USE_CHUNK_LRU 1

constexpr int LR_XF = 0  , LR_XB = 16640  , LR_WT = 25856  , LR_AA = 62720  , LR_UU = 96000  , LR_END = 129280;
constexpr size_t WS_LCA = WS_LRC, WS_LCH = WS_LRC + 2 * MiB, WS_LCI = WS_LRC + 4 * MiB;
__device__ __forceinline__ void lru_prep(Frame& F, int l) {
    const bf16* P = (const bf16*)(F.ws + WS_P);
    int lane = F.lane; asm volatile("" : "+v"(lane));
    const int wave = F.wave, i16 = lane & 15, q = lane >> 4, nb = F.bid & 7;
    LAS unsigned char* L = F.lds;
    LAS float* XF = (LAS float*)(L + LR_XF); LAS float* AA = (LAS float*)(L + LR_AA); LAS float* UU = (LAS float*)(L + LR_UU);
    bf16* HL = (bf16*)(F.ws + WS_LRH); bf16* AC = (bf16*)(F.ws + WS_LRA);
    __syncthreads();
#pragma unroll 1
    for (int mat = 0; mat < 4; ++mat) { const int dir = mat >> 1; const float* wsrc = (mat & 1 ? F.in[I_LRWI] : F.in[I_LRWR]) + ((size_t)((l * 2 + dir) * 8 + nb)) * 4096;
        float wv[8];
#pragma unroll
        for (int k = 0; k < 8; ++k) wv[k] = wsrc[F.tid + k * NTHREADS];
        asm volatile("" : "+v"(wv[0]), "+v"(wv[1]), "+v"(wv[2]), "+v"(wv[3]), "+v"(wv[4]), "+v"(wv[5]), "+v"(wv[6]), "+v"(wv[7]));
#pragma unroll
        for (int k = 0; k < 8; ++k) { const int e = F.tid + k * NTHREADS, ii = e >> 6, j = e & 63; *(LAS unsigned short*)(L + LR_WT + (mat * 64 + j) * 144 + ii * 2) = (unsigned short)f2bf(wv[k]); } }
    float cwv[4][8], cbv[8];
    { const int c8 = (F.tid & 7) * 8, ch0 = nb * 64 + c8; const float* cb = F.in[I_LRCB] + l * 512 + ch0; const float* cw = F.in[I_LRCW] + (size_t)l * 4 * 512 + ch0;
#pragma unroll
      for (int k = 0; k < 8; ++k) cbv[k] = cb[k];
#pragma unroll
      for (int j = 0; j < 4; ++j)
#pragma unroll
        for (int k = 0; k < 8; ++k) cwv[j][k] = cw[j * 512 + k]; }
    float gbr[4], gbi[4], gls[4];
    { const int dir = wave >> 2;
#pragma unroll
      for (int n = 0; n < 4; ++n) { const int ch = nb * 64 + 16 * n + i16; gbr[n] = F.in[I_LRBR][(l * 2 + dir) * 512 + ch]; gbi[n] = F.in[I_LRBI][(l * 2 + dir) * 512 + ch]; gls[n] = -softplusf_(-F.in[I_LRLAM][(l * 2 + dir) * 512 + ch]); } }
    v4u wvA[4], wvB[4];
#define LR_LOADRAW(ctx) do { if (F.tid >= 128) { const int _m0 = (ctx) * 64; int _t0, _T, _base; seq_of(_m0, _t0, _T, _base); const int _ch0 = nb * 64 + (F.tid & 7) * 8, _tokA = (F.tid - 128) >> 3, _tokB = (F.tid + 256) >> 3; \
        _Pragma("unroll") for (int j = 0; j < 4; ++j) { const int tt = _t0 + _tokA + j - 2; wvA[j] = (v4u){0u, 0u, 0u, 0u}; if (tt >= 0 && tt < _T) wvA[j] = *(const v4u*)(P + (size_t)(_base + tt) * PW + PC_LX + _ch0); } \
        if (F.tid < 256) { _Pragma("unroll") for (int j = 0; j < 4; ++j) { const int tt = _t0 + _tokB + j - 2; wvB[j] = (v4u){0u, 0u, 0u, 0u}; if (tt >= 0 && tt < _T) wvB[j] = *(const v4u*)(P + (size_t)(_base + tt) * PW + PC_LX + _ch0); } } } } while (0)
#define LR_S1ITEM(wv_, tok_) do { const int tok = (tok_), c8 = (F.tid & 7) * 8; float s[8]; \
        _Pragma("unroll") for (int k = 0; k < 8; ++k) s[k] = cbv[k]; \
        _Pragma("unroll") for (int j = 0; j < 4; ++j) { const v4u w = wv_[j]; \
            s[0] += cwv[j][0] * bflo(w.x); s[1] += cwv[j][1] * bfhi(w.x); s[2] += cwv[j][2] * bflo(w.y); s[3] += cwv[j][3] * bfhi(w.y); s[4] += cwv[j][4] * bflo(w.z); s[5] += cwv[j][5] * bfhi(w.z); s[6] += cwv[j][6] * bflo(w.w); s[7] += cwv[j][7] * bfhi(w.w); } \
        _Pragma("unroll") for (int k = 0; k < 8; ++k) XF[tok * 65 + c8 + k] = s[k]; \
        v4u o; o.x = pk2(s[0], s[1]); o.y = pk2(s[2], s[3]); o.z = pk2(s[4], s[5]); o.w = pk2(s[6], s[7]); *(LAS v4u*)(L + LR_XB + tok * 144 + c8 * 2) = o; } while (0)
#define LR_S1() do { if (F.tid >= 128) { LR_S1ITEM(wvA, (F.tid - 128) >> 3); if (F.tid < 256) LR_S1ITEM(wvB, (F.tid + 256) >> 3); } } while (0)
    if ((F.bid >> 3) < NCT) { LR_LOADRAW(F.bid >> 3); LR_S1(); }
    for (int ct = F.bid >> 3; ct < NCT; ct += F.G >> 3) {
        const int m0 = ct * 64; const bool has_next = ct + (F.G >> 3) < NCT;
        if (has_next) LR_LOADRAW(ct + (F.G >> 3));
        LDS_BARRIER();
        { const int dir = wave >> 2, mb = wave & 3;
          f32x4 ar[4], ai[4];
#pragma unroll
          for (int n = 0; n < 4; ++n) { ar[n] = (f32x4){0.f, 0.f, 0.f, 0.f}; ai[n] = (f32x4){0.f, 0.f, 0.f, 0.f}; }
#pragma unroll
          for (int ks = 0; ks < 2; ++ks) { const bf16x8 a = *(const LAS bf16x8*)(L + LR_XB + (16 * mb + i16) * 144 + 64 * ks + 16 * q);
#pragma unroll
              for (int n = 0; n < 4; ++n) { const bf16x8 br = *(const LAS bf16x8*)(L + LR_WT + ((dir * 2 + 0) * 64 + 16 * n + i16) * 144 + 64 * ks + 16 * q), bi = *(const LAS bf16x8*)(L + LR_WT + ((dir * 2 + 1) * 64 + 16 * n + i16) * 144 + 64 * ks + 16 * q);
                  ar[n] = __builtin_amdgcn_mfma_f32_16x16x32_bf16(a, br, ar[n], 0, 0, 0); ai[n] = __builtin_amdgcn_mfma_f32_16x16x32_bf16(a, bi, ai[n], 0, 0, 0); } }
#pragma unroll
          for (int n = 0; n < 4; ++n) { const int j = 16 * n + i16; const float br_ = gbr[n], bi_ = gbi[n], logsig = gls[n];
#pragma unroll
              for (int i = 0; i < 4; ++i) { const int tok = 16 * mb + 4 * q + i; const float r = sigmoidf_(ar[n][i] + br_), ig = sigmoidf_(ai[n][i] + bi_);
                  const float log_a = 8.0f * r * logsig, a = __expf(log_a), y2 = 2.0f * log_a;
                  const float om = (y2 > -0.1f) ? -y2 * (1.0f + y2 * (0.5f + y2 * (0.16666667f + y2 * 0.041666668f))) : 1.0f - __expf(y2);
                  const float u = __builtin_amdgcn_sqrtf(om) * (ig * XF[tok * 65 + j]);
                  AA[(dir * 64 + tok) * 65 + j] = a; UU[(dir * 64 + tok) * 65 + j] = u; } } }
        LDS_BARRIER();
        if (F.tid < 128) { const int dir = F.tid >> 6, j = F.tid & 63, ch = nb * 64 + j; float h = 0.f, ac = 1.f;
            long o = (long)(((size_t)dir * NTOK + m0 + (dir ? 63 : 0)) * 512 + ch); const long ostep = dir ? -512 : 512;
#pragma unroll 1
            for (int s0 = 0; s0 < 64; s0 += 8) { float av[8], uv[8];
#pragma unroll
                for (int k = 0; k < 8; ++k) { const int tok = dir ? 63 - (s0 + k) : (s0 + k); av[k] = AA[(dir * 64 + tok) * 65 + j]; uv[k] = UU[(dir * 64 + tok) * 65 + j]; }
#pragma unroll
                for (int k = 0; k < 8; ++k) { h = av[k] * h + uv[k]; ac *= av[k]; HL[o] = (bf16)f2bf(h); AC[o] = (bf16)f2bf(ac); o += ostep; } }
            ((float*)(F.ws + WS_LCA))[((size_t)dir * NCT + ct) * 512 + ch] = ac; ((float*)(F.ws + WS_LCH))[((size_t)dir * NCT + ct) * 512 + ch] = h; }
        else if (has_next) LR_S1();
    }
    LDS_BARRIER();
}
__device__ __forceinline__ void lru_carry(Frame& F, int idx) {
    const int ch = idx & 511, dir = (idx >> 9) & 1, b = idx >> 10;
    const float* CA = (const float*)(F.ws + WS_LCA); const float* CH = (const float*)(F.ws + WS_LCH); float* CI = (float*)(F.ws + WS_LCI);
    float h = 0.f;
#pragma unroll 1
    for (int n0 = 0; n0 < 68; n0 += 17) { float ca[17], cv[17];
#pragma unroll
        for (int k = 0; k < 17; ++k) { const int n = n0 + k, ct = n < 4 ? 256 + b * 4 + (dir ? 3 - n : n) : b * 64 + (dir ? 63 - (n - 4) : (n - 4)); const size_t o = ((size_t)dir * NCT + ct) * 512 + ch; ca[k] = CA[o]; cv[k] = CH[o]; }
        asm volatile("" : "+v"(ca[0]), "+v"(ca[1]), "+v"(ca[2]), "+v"(ca[3]), "+v"(ca[4]), "+v"(ca[5]), "+v"(ca[6]), "+v"(ca[7]), "+v"(ca[8]), "+v"(ca[9]), "+v"(ca[10]), "+v"(ca[11]), "+v"(ca[12]), "+v"(ca[13]), "+v"(ca[14]), "+v"(ca[15]), "+v"(ca[16]));
        asm volatile("" : "+v"(cv[0]), "+v"(cv[1]), "+v"(cv[2]), "+v"(cv[3]), "+v"(cv[4]), "+v"(cv[5]), "+v"(cv[6]), "+v"(cv[7]), "+v"(cv[8]), "+v"(cv[9]), "+v"(cv[10]), "+v"(cv[11]), "+v"(cv[12]), "+v"(cv[13]), "+v"(cv[14]), "+v"(cv[15]), "+v"(cv[16]));
#pragma unroll
        for (int k = 0; k < 17; ++k) { const int n = n0 + k, ct = n < 4 ? 256 + b * 4 + (dir ? 3 - n : n) : b * 64 + (dir ? 63 - (n - 4) : (n - 4)); const size_t o = ((size_t)dir * NCT + ct) * 512 + ch; CI[o] = h; h = ca[k] * h + cv[k]; } }
}
__device__ __forceinline__ void lru_fin(Frame& F, int l) {
    const int nrows = (l == 0) ? NTOK : NLAT;
    const bf16* P = (const bf16*)(F.ws + WS_P); bf16* CC = (bf16*)(F.ws + WS_CC);
    const bf16* HL = (const bf16*)(F.ws + WS_LRH); const bf16* AC = (const bf16*)(F.ws + WS_LRA); const float* CI = (const float*)(F.ws + WS_LCI);
    for (size_t i = (size_t)F.bid * NTHREADS + F.tid; i < (size_t)nrows * 128; i += (size_t)F.G * NTHREADS) { const int m = (int)(i >> 7), c4 = (int)(i & 127) * 4, ct = m >> 6;
        const v2u hw0 = *(const v2u*)(HL + (size_t)m * 512 + c4), aw0 = *(const v2u*)(AC + (size_t)m * 512 + c4), hw1 = *(const v2u*)(HL + ((size_t)NTOK + m) * 512 + c4), aw1 = *(const v2u*)(AC + ((size_t)NTOK + m) * 512 + c4);
        const f32x4 h0 = {bflo(hw0.x), bfhi(hw0.x), bflo(hw0.y), bfhi(hw0.y)}, a0 = {bflo(aw0.x), bfhi(aw0.x), bflo(aw0.y), bfhi(aw0.y)}, h1 = {bflo(hw1.x), bfhi(hw1.x), bflo(hw1.y), bfhi(hw1.y)}, a1 = {bflo(aw1.x), bfhi(aw1.x), bflo(aw1.y), bfhi(aw1.y)};
        const f32x4 i0 = *(const f32x4*)(CI + (size_t)ct * 512 + c4), i1 = *(const f32x4*)(CI + ((size_t)NCT + ct) * 512 + c4);
        const f32x4 hs = (a0 * i0 + h0) + (a1 * i1 + h1); const v2u yw = *(const v2u*)(P + (size_t)m * PW + PC_LY + c4);
#if FP8_OUTPROJ
        *(unsigned*)((unsigned char*)CC + (size_t)m * DM + 1536 + c4) = pk4_fp8(hs.x * gelu_tanh(bflo(yw.x)), hs.y * gelu_tanh(bfhi(yw.x)), hs.z * gelu_tanh(bflo(yw.y)), hs.w * gelu_tanh(bfhi(yw.y))); }
#else
        v2u o; o.x = pk2(hs.x * gelu_tanh(bflo(yw.x)), hs.y * gelu_tanh(bfhi(yw.x))); o.y = pk2(hs.z * gelu_tanh(bflo(yw.y)), hs.w * gelu_tanh(bfhi(yw.y)));
        *(v2u*)(CC + (size_t)m * DM + 1536 + c4) = o; }
#endif
}

constexpr size_t WS_DNQ = WS_DNT;
constexpr size_t WS_BG = WS_DNS + 1 * MiB;
constexpr size_t WS_XC = WS_XS;

__device__ __forceinline__ void naive_prep(Frame& F, int l) {
    const bf16* P = (const bf16*)(F.ws + WS_P);
    const int gw = F.bid * NWAVES + F.wave, NGW = F.G * NWAVES;
#if !defined(USE_CHUNK_DN)
    {
        float* DNQ = (float*)(F.ws + WS_DNQ); float* BG = (float*)(F.ws + WS_BG);
        const float* cw = F.in[I_DNCW] + (size_t)l * 4 * 1536;
        for (int it = gw; it < NTOK * 4; it += NGW) {
            const int m = it >> 2, h = it & 3; int t, T, base; seq_of(m, t, T, base);
            float val[3][2];
#pragma unroll
            for (int part = 0; part < 3; ++part)
#pragma unroll
                for (int dd = 0; dd < 2; ++dd) { const int d = F.lane + 64 * dd, cch = part * 512 + h * 128 + d, col = PC_DQ + cch; float s = 0.f;
#pragma unroll
                    for (int j = 0; j < 4; ++j) { const int tt = t + j - 2; if (tt >= 0 && tt < T) s += cw[j * 1536 + cch] * bf2f(P[(size_t)(base + tt) * PW + col]); }
                    val[part][dd] = siluf_(s); }
            const float sq = wave_sum(val[0][0] * val[0][0] + val[0][1] * val[0][1]), sk = wave_sum(val[1][0] * val[1][0] + val[1][1] * val[1][1]);
            const float fq = 0.08838834764831845f / sqrtf(sq + EPS), fk = 1.0f / sqrtf(sk + EPS);
#pragma unroll
            for (int dd = 0; dd < 2; ++dd) { const int d = F.lane + 64 * dd; float* o = DNQ + (size_t)m * 1536 + h * 128 + d;
                o[0] = val[0][dd] * fq; o[512] = val[1][dd] * fk; o[1024] = val[2][dd]; }
            if (h == 0 && F.lane < 8) { const int dir = F.lane >> 2, hh = F.lane & 3;
                const float pb = bf2f(P[(size_t)m * PW + PC_BETA + F.lane]), pa = bf2f(P[(size_t)m * PW + PC_DEC + F.lane]);
                BG[m * 16 + F.lane] = sigmoidf_(pb);
                BG[m * 16 + 8 + F.lane] = -__expf(F.in[I_DNALOG][l * 8 + dir * 4 + hh]) * softplusf_(pa + F.in[I_DNDT][l * 8 + dir * 4 + hh]); }
        }
    }
#endif
#if !defined(USE_CHUNK_LRU)
    {
        LAS float* xc = (LAS float*)F.lds;
        float* A = (float*)(F.ws + WS_LRA); float* U = (float*)(F.ws + WS_LRH);
        const float* cw = F.in[I_LRCW] + (size_t)l * 4 * 512; const float* cb = F.in[I_LRCB] + l * 512;
        for (int m0 = F.bid * 8; m0 < NTOK; m0 += F.G * 8) {
            __syncthreads();
            for (int i = F.tid; i < 8 * 512; i += NTHREADS) { const int m = m0 + (i >> 9), ch = i & 511; int t, T, base; seq_of(m, t, T, base); float s = cb[ch];
#pragma unroll
                for (int j = 0; j < 4; ++j) { const int tt = t + j - 2; if (tt >= 0 && tt < T) s += cw[j * 512 + ch] * bf2f(P[(size_t)(base + tt) * PW + PC_LX + ch]); }
                xc[i] = s; }
            __syncthreads();
            for (int i = F.tid; i < 8 * 512 * 2; i += NTHREADS) { const int ch = i & 511, dir = (i >> 9) & 1, tk = i >> 10, m = m0 + tk, blk = ch >> 6, j = ch & 63;
                const float* wr = F.in[I_LRWR] + ((size_t)((l * 2 + dir) * 8 + blk)) * 4096 + j; const float* wi = F.in[I_LRWI] + ((size_t)((l * 2 + dir) * 8 + blk)) * 4096 + j;
                float sr = F.in[I_LRBR][(l * 2 + dir) * 512 + ch], si = F.in[I_LRBI][(l * 2 + dir) * 512 + ch];
#pragma unroll 8
                for (int ii = 0; ii < 64; ++ii) { const float x = xc[tk * 512 + blk * 64 + ii]; sr += x * wr[ii * 64]; si += x * wi[ii * 64]; }
                const float r = sigmoidf_(sr), ig = sigmoidf_(si); const float lam = F.in[I_LRLAM][(l * 2 + dir) * 512 + ch];
                const float logsig = -softplusf_(-lam);
                const float log_a = 8.0f * r * logsig; const float a = __expf(log_a);
                const float u = sqrtf(-expm1f(2.0f * log_a)) * (ig * xc[tk * 512 + ch]);
                A[((size_t)dir * NTOK + m) * 512 + ch] = a; U[((size_t)dir * NTOK + m) * 512 + ch] = u; }
        }
        __syncthreads();
    }
#endif
}

__device__ __forceinline__ void naive_attn_row(Frame& F, int l, int m, int hq) {
    const bf16* P = (const bf16*)(F.ws + WS_P); bf16* CC = (bf16*)(F.ws + WS_CC);
    const int d = F.lane, kvh = hq >> 2; int t, T, base; seq_of(m, t, T, base);
    const bool lat = m < NLAT; const int b = lat ? (m >> 12) : ((m - NLAT) >> 8);
    const int dd = d & 31, jf = dd & 15; const float inv = __powf(10000.0f, -(float)jf * (1.0f / 16.0f));
    const bool second = (dd >= 16), colhalf = (d >= 32);
    float q = bf2f(P[(size_t)m * PW + PC_Q + hq * 64 + d]);
    if (lat) { const float pos = (float)(colhalf ? (t & 63) : (t >> 6)); float sn, cs; sincosf(pos * inv, &sn, &cs); const float pr = __shfl_xor(q, 16); q = second ? (q * cs + pr * sn) : (q * cs - pr * sn); }
    q *= 0.125f;
    float mx = F.in[I_SINK][l * 16 + hq], den = 1.0f, acc = 0.f;
    if (lat) { const int t0 = t - 128 < 0 ? 0 : t - 128, t1 = t + 128 > SEQ - 1 ? SEQ - 1 : t + 128;
        for (int tk = t0; tk <= t1; ++tk) { const size_t r = (size_t)(base + tk) * PW; float k = bf2f(P[r + PC_K + kvh * 64 + d]); const float v = bf2f(P[r + PC_V + kvh * 64 + d]);
            const float pos = (float)(colhalf ? (tk & 63) : (tk >> 6)); float sn, cs; sincosf(pos * inv, &sn, &cs); const float pr = __shfl_xor(k, 16); k = second ? (k * cs + pr * sn) : (k * cs - pr * sn);
            const float s = wave_sum(q * k); const float mn = fmaxf(mx, s), f = __expf(mx - mn), p = __expf(s - mn); den = den * f + p; acc = acc * f + p * v; mx = mn; } }
    for (int c = 0; c < CTXL; ++c) { const size_t r = (size_t)(NLAT + b * CTXL + c) * PW; const float k = bf2f(P[r + PC_K + kvh * 64 + d]), v = bf2f(P[r + PC_V + kvh * 64 + d]);
        const float s = wave_sum(q * k); const float mn = fmaxf(mx, s), f = __expf(mx - mn), p = __expf(s - mn); den = den * f + p; acc = acc * f + p * v; mx = mn; }
    CC[(size_t)m * DM + hq * 64 + d] = (bf16)f2bf(acc / den);
}

__device__ __forceinline__ int scan_row(int n, int b, int dir) { if (n < CTXL) { const int t = dir ? (CTXL - 1 - n) : n; return NLAT + b * CTXL + t; } const int t = dir ? (SEQ - 1 - (n - CTXL)) : (n - CTXL); return b * SEQ + t; }
__device__ __forceinline__ void naive_scan(Frame& F, int l, int rep = 0) {
#if defined(USE_CHUNK_DN)
    if (F.bid < 32 * DN_SPLIT) { if (DN_SPLIT == 2) dn_scan(F, l, F.bid >> 4, (F.bid >> 2) & 3, (F.bid >> 1) & 1, F.bid & 1); else dn_scan(F, l, F.bid >> 3, (F.bid >> 1) & 3, F.bid & 1, 0); }
#else
    if (F.bid < 32) {
        const int b = F.bid >> 3, h = (F.bid >> 1) & 3, dir = F.bid & 1, dvc = F.tid & 127, kq = F.tid >> 7;
        const float* DNQ = (const float*)(F.ws + WS_DNQ); const float* BG = (const float*)(F.ws + WS_BG); float* O = (float*)(F.ws + WS_DNO);
        LAS float* buf = (LAS float*)F.lds;
        LAS float* red = buf + 768;
        LAS float* red2 = red + 512;
        float S[32];
#pragma unroll
        for (int i = 0; i < 32; ++i) S[i] = 0.f;
        constexpr int NT = CTXL + SEQ;
        { const int m = scan_row(0, b, dir); if (F.tid < 384) buf[F.tid] = DNQ[(size_t)m * 1536 + (F.tid >> 7) * 512 + h * 128 + (F.tid & 127)]; }
        __syncthreads();
#pragma unroll 1
        for (int n = 0; n < NT; ++n) {
            const int m = scan_row(n, b, dir); const LAS float* cur = buf + (n & 1) * 384;
            float nextv = 0.f; if (n + 1 < NT && F.tid < 384) { const int m2 = scan_row(n + 1, b, dir); nextv = DNQ[(size_t)m2 * 1536 + (F.tid >> 7) * 512 + h * 128 + (F.tid & 127)]; }
            const float beta = BG[m * 16 + dir * 4 + h], decay = __expf(BG[m * 16 + 8 + dir * 4 + h]);
            float ks = 0.f;
#pragma unroll
            for (int i = 0; i < 32; ++i) ks += cur[128 + kq * 32 + i] * S[i];
            red[kq * 128 + dvc] = ks;
            __syncthreads();
            const float kS = (red[dvc] + red[128 + dvc]) + (red[256 + dvc] + red[384 + dvc]);
            const float upd = beta * (cur[256 + dvc] - decay * kS);
            float os = 0.f;
#pragma unroll
            for (int i = 0; i < 32; ++i) { S[i] = decay * S[i] + cur[128 + kq * 32 + i] * upd; os += cur[kq * 32 + i] * S[i]; }
            red2[kq * 128 + dvc] = os;
            if (F.tid < 384) buf[((n + 1) & 1) * 384 + F.tid] = nextv;
            __syncthreads();
            if (kq == 0) O[((size_t)dir * NTOK + m) * 512 + h * 128 + dvc] = (red2[dvc] + red2[128 + dvc]) + (red2[256 + dvc] + red2[384 + dvc]);
        }
    }
#endif
#if defined(USE_CHUNK_LRU)
    else if (F.bid < 32 * DN_SPLIT + 8) { lru_carry(F, (F.bid - 32 * DN_SPLIT) * NTHREADS + F.tid); }
#else
    else if (F.bid < 40) {
        const int idx = (F.bid - 32) * NTHREADS + F.tid, ch = idx & 511, dir = (idx >> 9) & 1, b = idx >> 10;
        const float* A = (const float*)(F.ws + WS_LRA); float* U = (float*)(F.ws + WS_LRH);
        float hs = 0.f;
#pragma unroll 4
        for (int n = 0; n < CTXL + SEQ; ++n) { int m; if (n < CTXL) { const int t = dir ? (CTXL - 1 - n) : n; m = NLAT + b * CTXL + t; } else { const int t = dir ? (SEQ - 1 - (n - CTXL)) : (n - CTXL); m = b * SEQ + t; }
            const size_t o = ((size_t)dir * NTOK + m) * 512 + ch; hs = A[o] * hs + U[o]; U[o] = hs; }
    }
#endif
#if defined(USE_MFMA_ATTN)
#if SCAN_SPLIT_ORDER
    if ((F.bid & 3) >= SCAN_ATTN_FIRST) { convert_moe_queue(F, l, rep); attn_phase(F, l, rep); } else { attn_phase(F, l, rep); convert_moe_queue(F, l, rep); }
#else
    attn_phase(F, l, rep);
    convert_moe_queue(F, l, rep);
#endif
#else
    {
        const int nrows = (l == 0) ? NTOK : NLAT;
        for (;;) { int m = 0; if (F.lane == 0) m = (int)__hip_atomic_fetch_add(F.ctl + CW_ATQ + 64 * l, 1u, RLX_AGENT); m = __builtin_amdgcn_readfirstlane(m);
            if (m >= nrows) break;
#pragma unroll 1
            for (int hq = 0; hq < 16; ++hq) naive_attn_row(F, l, m, hq); }
    }
#endif
}

__device__ __forceinline__ void naive_fin(Frame& F, int l) {
    const int nrows = (l == 0) ? NTOK : NLAT;
    const bf16* P = (const bf16*)(F.ws + WS_P); bf16* CC = (bf16*)(F.ws + WS_CC);
    const int gw = F.bid * NWAVES + F.wave, NGW = F.G * NWAVES;
    const float* O = (const float*)(F.ws + WS_DNO); const float* HS = (const float*)(F.ws + WS_LRH);
    for (int it0 = gw * 2; it0 < nrows * 4; it0 += NGW * 2) {
        float2 oa[2], ob[2]; unsigned gw_[2];
#pragma unroll
        for (int k = 0; k < 2; ++k) { const int it = it0 + k, m = it >> 2, h = it & 3; const int c = h * 128 + 2 * F.lane;
            { const bf16* Ob = (const bf16*)(F.ws + WS_DNO); const unsigned wa = *(const unsigned*)(Ob + (size_t)m * 512 + c), wb = *(const unsigned*)(Ob + ((size_t)NTOK + m) * 512 + c); oa[k] = make_float2(bflo(wa), bfhi(wa)); ob[k] = make_float2(bflo(wb), bfhi(wb)); } gw_[k] = *(const unsigned*)(P + (size_t)m * PW + PC_DG + c); }
        const float2 ng = *(const float2*)(F.in[I_DNNG] + l * 128 + 2 * F.lane);
#pragma unroll
        for (int k = 0; k < 2; ++k) { const int it = it0 + k, m = it >> 2, h = it & 3; const float o0 = oa[k].x + ob[k].x, o1 = oa[k].y + ob[k].y;
            const float rstd = 1.0f / sqrtf(wave_sum(o0 * o0 + o1 * o1) * (1.0f / 128.0f) + EPS);
#if FP8_OUTPROJ
            *(unsigned short*)((unsigned char*)CC + (size_t)m * DM + 1024 + h * 128 + 2 * F.lane) = (unsigned short)(pk4_fp8(o0 * rstd * ng.x * siluf_(bflo(gw_[k])), o1 * rstd * ng.y * siluf_(bfhi(gw_[k])), 0.f, 0.f) & 0xffffu); }
#else
            *(unsigned*)(CC + (size_t)m * DM + 1024 + h * 128 + 2 * F.lane) = pk2(o0 * rstd * ng.x * siluf_(bflo(gw_[k])), o1 * rstd * ng.y * siluf_(bfhi(gw_[k]))); }
#endif
    }
#if defined(USE_CHUNK_LRU)
    lru_fin(F, l);
#else
    for (size_t i = (size_t)F.bid * NTHREADS + F.tid; i < (size_t)nrows * 512; i += (size_t)F.G * NTHREADS) { const int m = (int)(i >> 9), ch = (int)(i & 511);
        const float hsum = HS[(size_t)m * 512 + ch] + HS[((size_t)NTOK + m) * 512 + ch]; const float y = bf2f(P[(size_t)m * PW + PC_LY + ch]);
        CC[(size_t)m * DM + 1536 + ch] = (bf16)f2bf(hsum * gelu_tanh(y)); }
#endif
}
#ifndef FIN_ROWS
#define FIN_ROWS 1
#endif
#if FIN_ROWS
__device__ __forceinline__ void unpack8(const v4u w, float (&o)[8]) { o[0] = bflo(w.x); o[1] = bfhi(w.x); o[2] = bflo(w.y); o[3] = bfhi(w.y); o[4] = bflo(w.z); o[5] = bfhi(w.z); o[6] = bflo(w.w); o[7] = bfhi(w.w); }
__device__ __forceinline__ void fin_rows(Frame& F, int l) {
    const int nrows = (l == 0) ? NTOK : NLAT;
    const bf16* P = (const bf16*)(F.ws + WS_P); bf16* CC = (bf16*)(F.ws + WS_CC); const bf16* Ob = (const bf16*)(F.ws + WS_DNO);
    const bf16* HL = (const bf16*)(F.ws + WS_LRH); const bf16* AC = (const bf16*)(F.ws + WS_LRA); const float* CI = (const float*)(F.ws + WS_LCI);
    const int gw = F.bid * NWAVES + F.wave, NGW = F.G * NWAVES, c8 = F.lane * 8;
    const float* ngp = F.in[I_DNNG] + l * 128 + (F.lane & 15) * 8; const f32x4 ng0 = *(const f32x4*)ngp, ng1 = *(const f32x4*)(ngp + 4);
#pragma unroll 1
    for (int m = gw; m < nrows; m += NGW) {
        const int ct = m >> 6;
        const v4u wof = *(const v4u*)(Ob + (size_t)m * 512 + c8), wob = *(const v4u*)(Ob + ((size_t)NTOK + m) * 512 + c8), wg = *(const v4u*)(P + (size_t)m * PW + PC_DG + c8);
        const v4u wh0 = *(const v4u*)(HL + (size_t)m * 512 + c8), wc0 = *(const v4u*)(AC + (size_t)m * 512 + c8), wh1 = *(const v4u*)(HL + ((size_t)NTOK + m) * 512 + c8), wc1 = *(const v4u*)(AC + ((size_t)NTOK + m) * 512 + c8);
        const f32x4 i0a = *(const f32x4*)(CI + (size_t)ct * 512 + c8), i0b = *(const f32x4*)(CI + (size_t)ct * 512 + c8 + 4), i1a = *(const f32x4*)(CI + ((size_t)NCT + ct) * 512 + c8), i1b = *(const f32x4*)(CI + ((size_t)NCT + ct) * 512 + c8 + 4);
        const v4u wy = *(const v4u*)(P + (size_t)m * PW + PC_LY + c8);
        float vd[8], vl[8];
        { float of[8], ob[8], gt[8]; unpack8(wof, of); unpack8(wob, ob); unpack8(wg, gt); float ss = 0.f;
#pragma unroll
          for (int e = 0; e < 8; ++e) { of[e] += ob[e]; ss += of[e] * of[e]; }
          ss += dpp_mov<0xB1>(ss); ss += dpp_mov<0x4E>(ss); ss += dpp_mov<0x141>(ss); ss += dpp_mov<0x140>(ss);
          const float rstd = 1.0f / sqrtf(ss * (1.0f / 128.0f) + EPS);
#pragma unroll
          for (int e = 0; e < 8; ++e) vd[e] = of[e] * rstd * (e < 4 ? ng0[e] : ng1[e - 4]) * siluf_(gt[e]); }
        { float h0[8], a0[8], h1[8], a1[8], y[8]; unpack8(wh0, h0); unpack8(wc0, a0); unpack8(wh1, h1); unpack8(wc1, a1); unpack8(wy, y);
#pragma unroll
          for (int e = 0; e < 8; ++e) { const float i0 = e < 4 ? i0a[e] : i0b[e - 4], i1 = e < 4 ? i1a[e] : i1b[e - 4]; vl[e] = ((a0[e] * i0 + h0[e]) + (a1[e] * i1 + h1[e])) * gelu_tanh(y[e]); } }
        bf16* o = CC + (size_t)m * DM + 1024 + c8;
        *(v4u*)(o) = (v4u){pk2(vd[0], vd[1]), pk2(vd[2], vd[3]), pk2(vd[4], vd[5]), pk2(vd[6], vd[7])};
        *(v4u*)(o + 512) = (v4u){pk2(vl[0], vl[1]), pk2(vl[2], vl[3]), pk2(vl[4], vl[5]), pk2(vl[6], vl[7])};
    }
}
#define PHASE_FIN(F, l) fin_rows(F, l)
#endif
#ifndef PHASE_PREP
#if defined(USE_MFMA_ATTN)
#if defined(USE_CHUNK_DN)
#define PHASE_PREP(F, l) do { attn_prep(F, l); lru_prep(F, l); dn_prep(F, l); } while (0)
#else
#define PHASE_PREP(F, l) do { naive_prep(F, l); attn_prep(F, l); } while (0)
#endif
#else
#define PHASE_PREP(F, l) naive_prep(F, l)
#endif
#endif
#ifndef PHASE_SCAN
#define PHASE_SCAN(F, l) naive_scan(F, l)
#endif
#ifndef PHASE_FIN
#define PHASE_FIN(F, l) naive_fin(F, l)
#endif

#ifndef PHASE_INPROJ
#define PHASE_INPROJ(F, l) do {} while (0)
#endif
#ifndef PHASE_PREP
#define PHASE_PREP(F, l) do {} while (0)
#endif
#ifndef PHASE_SCAN
#define PHASE_SCAN(F, l) do {} while (0)
#endif
#ifndef PHASE_FIN
#define PHASE_FIN(F, l) do {} while (0)
#endif
#ifndef PHASE_OUTPROJ
#define PHASE_OUTPROJ(F, l) do {} while (0)
#endif
#ifndef PHASE_NORM2
#define PHASE_NORM2(F, l) do {} while (0)
#endif
#ifndef PHASE_SCATTER
#define PHASE_SCATTER(F, l) do {} while (0)
#endif
#ifndef PHASE_GEMM1
#define PHASE_GEMM1(F, l) do {} while (0)
#endif
#ifndef PHASE_GEMM2
#define PHASE_GEMM2(F, l) do {} while (0)
#endif

#ifndef MK_SPLIT
#define MK_SPLIT 0
#endif
#ifndef MK_STAGE
#define MK_STAGE 99
#endif
#ifndef MK_TAILFILL
#define MK_TAILFILL 0
#endif
#ifndef MK_DUP
#define MK_DUP 0
#endif
#define DUP(k) ((MK_DUP >> (k)) & 1)
#define TCTL() ((gu32*)(((unsigned char* const __attribute__((address_space(4)))*)__builtin_amdgcn_kernarg_segment_ptr())[N_IN + 1] + WS_CTL))
#define TMARK(c, sgn) do { if (((MK_TIME >> (c)) & 1) && blockIdx.x == 0 && threadIdx.x == 0) (void)__hip_atomic_fetch_add(TCTL() + 20480, sgn (unsigned)__builtin_amdgcn_s_memrealtime(), RLX_AGENT); } while (0)
constexpr int N_PHASES = 23;
struct Args { const float* in[N_IN]; float* out; unsigned char* ws; int ph_lo, ph_hi; };
static_assert(sizeof(Args) == (N_IN + 2) * 8 + 8, "Args has no padding");

__global__ void __launch_bounds__(NTHREADS, 2) fwd_kernel(Args args) {
    extern __shared__ __attribute__((aligned(16))) unsigned char lds[];
    Frame F;
    F.lds = (LAS unsigned char*)lds;
    F.MISC = (volatile LAS unsigned*)(F.lds + MISC_OFF);
    F.tid = threadIdx.x; F.lane = F.tid & 63; F.wave = __builtin_amdgcn_readfirstlane(F.tid >> 6);
    F.G = 256; F.bid = blockIdx.x;
    F.ws = args.ws; F.out = args.out; F.ctl = (gu32*)(args.ws + WS_CTL);
    F.in = (const float* const __attribute__((address_space(4)))*)__builtin_amdgcn_kernarg_segment_ptr();
    for (int u = F.tid; u < (LDS_BYTES - LDSCTL_OFF) / 4; u += NTHREADS) ((LAS unsigned*)(F.lds + LDSCTL_OFF))[u] = 0u;
    __syncthreads();
    XcdBarrier bar; bar.bar = (unsigned*)(F.ctl + CW_BAR); bar.x = 0; bar.st = nullptr;
    if (!MK_SPLIT) bar = xcd_barrier_post((unsigned*)(F.ctl + CW_BAR), F.MISC + 8);
    const int lo = args.ph_lo, hi = args.ph_hi;
#define IN(k) (lo <= (k) && (k) < hi && phase_enter(F))
#define INR(k) (lo <= (k) && (k) < hi)
#define SEAM(k) do { if (INR(k) && INR((k) + 1)) { if (MK_TAILFILL && (k) < 15) tail_fill(F, (k), (k) < 5 ? 0 : 1); xcd_barrier(bar); } } while (0)

    TMARK(10, 0u - ); if (IN(0)) { p0_prologue_a(F); } SEAM(0); TMARK(10, );
    TMARK(11, 0u - ); if (IN(1)) { p0_prologue_b(F); if (DUP(0)) { __syncthreads(); p0_prologue_b(F); } }
#pragma unroll 1
    for (int l = 0; l < DEPTH; ++l) {
        const int pb = 2 + 10 * l;
        TMARK(0, 0u - ); if (IN(pb + 0)) { phase_norm1(F, l); if (DUP(13) && l == 0) { __syncthreads(); phase_norm1(F, l); } } SEAM(pb + 0); TMARK(0, );
        TMARK(1, 0u - ); if (IN(pb + 1)) { PHASE_INPROJ(F, l); if (DUP(1)) { __syncthreads(); PHASE_INPROJ(F, l); } } SEAM(pb + 1); TMARK(1, );
        TMARK(2, 0u - ); if (IN(pb + 2)) { PHASE_PREP(F, l); if (DUP(2)) { __syncthreads(); dn_prep(F, l); } if (DUP(6)) { __syncthreads(); lru_prep(F, l); } } SEAM(pb + 2); TMARK(2, );
        TMARK(3, 0u - ); if (IN(pb + 3)) { if (DUP(3) && F.bid < 64) dn_scan(F, l, F.bid >> 4, (F.bid >> 2) & 3, (F.bid >> 1) & 1, F.bid & 1); PHASE_SCAN(F, l); if (DUP(10)) { __syncthreads(); naive_scan(F, l, 1); } if (DUP(11)) { __syncthreads(); attn_phase(F, l, 2); } if (DUP(12)) { __syncthreads(); convert_moe_queue(F, l, 3); } } SEAM(pb + 3); TMARK(3, );
        TMARK(4, 0u - ); if (IN(pb + 4)) { PHASE_FIN(F, l); if (DUP(4)) { __syncthreads(); PHASE_FIN(F, l); } } SEAM(pb + 4); TMARK(4, );
        TMARK(5, 0u - ); if (IN(pb + 5)) { PHASE_OUTPROJ(F, l); if (DUP(5) && l == 0) { __syncthreads(); PHASE_OUTPROJ(F, l); } } SEAM(pb + 5); TMARK(5, );
        TMARK(6, 0u - ); if (IN(pb + 6)) { PHASE_NORM2(F, l); } SEAM(pb + 6); TMARK(6, );
        TMARK(7, 0u - ); if (IN(pb + 7)) { PHASE_SCATTER(F, l); if (DUP(7)) { __syncthreads(); PHASE_SCATTER(F, l); } } SEAM(pb + 7); TMARK(7, );
        TMARK(8, 0u - ); if (IN(pb + 8)) { PHASE_GEMM1(F, l); if (DUP(8)) { __syncthreads(); PHASE_GEMM1(F, l); } } SEAM(pb + 8); TMARK(8, );
        TMARK(9, 0u - ); if (IN(pb + 9)) { PHASE_GEMM2(F, l); if (DUP(9)) { __syncthreads(); PHASE_GEMM2(F, l); } } SEAM(pb + 9); TMARK(9, );
    }
    TMARK(12, 0u - ); if (IN(22)) { phase_final(F, MK_STAGE >= 9); if (DUP(13)) { __syncthreads(); phase_final(F, MK_STAGE >= 9); } }
#if MK_TIME
    __syncthreads(); TMARK(12, );
    if (blockIdx.x == 0 && threadIdx.x == 0) { const unsigned t0_ = (unsigned)__builtin_amdgcn_s_memrealtime(); unsigned d_ = __hip_atomic_load(TCTL() + 20480, RLX_AGENT);
        while ((unsigned)__builtin_amdgcn_s_memrealtime() - t0_ < d_) __builtin_amdgcn_s_sleep(8); }
#endif
#undef IN
#undef SEAM
}

extern "C" void kernel_launch(void* const* d_in, const int* in_sizes, int n_in, void* d_out, int out_size, void* d_ws, size_t ws_size, hipStream_t stream) {
    static int grid = 0;
    if (grid == 0) {
        if (n_in != N_IN || out_size != NLAT * DM || ws_size < WS_END) { fprintf(stderr, "kernel_launch: unexpected shapes (n_in %d, out %d, ws %zu); nothing launched\n", n_in, out_size, ws_size); grid = -1; return; }
        int dev = 0, cus = 0, per_cu = 0;
        if (hipGetDevice(&dev) != hipSuccess || hipDeviceGetAttribute(&cus, hipDeviceAttributeMultiprocessorCount, dev) != hipSuccess) { grid = -1; return; }
        if (hipFuncSetAttribute((const void*)fwd_kernel, hipFuncAttributeMaxDynamicSharedMemorySize, LDS_BYTES) != hipSuccess) { fprintf(stderr, "kernel_launch: hipFuncSetAttribute failed\n"); grid = -1; return; }
        if (hipOccupancyMaxActiveBlocksPerMultiprocessor(&per_cu, (const void*)fwd_kernel, NTHREADS, LDS_BYTES) != hipSuccess || per_cu < 1) { fprintf(stderr, "kernel_launch: occupancy query says %d\n", per_cu); }
        (void)hipGetLastError();
        grid = cus;
        if (grid != 256) { fprintf(stderr, "kernel_launch: built for 256 CUs, device has %d; nothing launched\n", cus); grid = -1; return; }
    }
    if (grid < 0) return;
    if (hipMemsetAsync((char*)d_ws + WS_CTL, 0, CTL_ZERO_BYTES, stream) != hipSuccess) return;
    Args a{};
    for (int i = 0; i < N_IN; ++i) a.in[i] = (const float*)d_in[i];
    a.out = (float*)d_out; a.ws = (unsigned char*)d_ws;
#if MK_SPLIT
    for (int p = 0; p < N_PHASES; ++p) { a.ph_lo = p; a.ph_hi = p + 1; hipLaunchKernelGGL(fwd_kernel, dim3(grid), dim3(NTHREADS), LDS_BYTES, stream, a); }
#else
    a.ph_lo = 0; a.ph_hi = N_PHASES;
    hipLaunchKernelGGL(fwd_kernel, dim3(grid), dim3(NTHREADS), LDS_BYTES, stream, a);
#endif
    const hipError_t le = hipPeekAtLastError();
    if (le != hipSuccess) fprintf(stderr, "kernel_launch: launch failed: %s\n", hipGetErrorName(le));
}
```
